# Optimizing an MI355X kernel written in HIP

```python
import math
import jax
import jax.numpy as jnp
from jax import lax
import numpy as np

D_MODEL = 2048
BATCH = 16
SEQ = 2048
DEPTH = 2

N_META = 16
ROPE_THETA = 10000.0
EPS = 1e-6
Q_BLOCK = 128
SPARSE_Q_BLOCK = 32
TOPK_MAX = 256

MLA_HEADS = 8
MLA_Q_RANK = 512
MLA_KV_RANK = 512
MLA_NOPE = 128
MLA_ROPE = 64
MLA_V = 128
MLA_QK = MLA_NOPE + MLA_ROPE

DSA_HEADS = 8
DSA_HEAD_DIM = 128
IDX_HEADS = 16
IDX_DIM = 64

DIFF_HEADS = 4
DIFF_HEAD_DIM = 128
DIFF_V = 2 * DIFF_HEAD_DIM

N_BRANCH = 3
BRANCH_WIDTH = 1024
D_FF = ((8 * D_MODEL + 3 * 256 - 1) // (3 * 256)) * 256

IN_PROJ_SIZES = (
    MLA_Q_RANK, MLA_KV_RANK, MLA_ROPE,
    DSA_HEADS * DSA_HEAD_DIM, DSA_HEADS * DSA_HEAD_DIM, DSA_HEADS * DSA_HEAD_DIM,
    IDX_HEADS * IDX_DIM, IDX_DIM, IDX_HEADS,
    DIFF_HEADS * 2 * DIFF_HEAD_DIM, DIFF_HEADS * 2 * DIFF_HEAD_DIM, DIFF_HEADS * DIFF_V,
    N_BRANCH * D_MODEL,
)
D_IN = sum(IN_PROJ_SIZES)

kernel_name = 'hybrid_mla_dsa_diffattn_gated_block'


def rms_norm(x, g):
    xf = x.astype(jnp.float32)
    y = xf * lax.rsqrt(jnp.mean(xf * xf, axis=-1, keepdims=True) + EPS)
    return (y * g.astype(jnp.float32)).astype(x.dtype)


def rope(x, pos):
    d = x.shape[-1]
    half = d // 2
    inv = ROPE_THETA ** (-jnp.arange(half, dtype=jnp.float32) * (2.0 / d))
    ang = pos.astype(jnp.float32)[:, None] * inv[None, :]
    ang = ang.reshape((ang.shape[0],) + (1,) * (x.ndim - 3) + (half,))
    cos, sin = jnp.cos(ang), jnp.sin(ang)
    xf = x.astype(jnp.float32)
    x1, x2 = xf[..., :half], xf[..., half:]
    return jnp.concatenate([x1 * cos - x2 * sin, x2 * cos + x1 * sin], axis=-1).astype(x.dtype)


def _split_cols(a, sizes):
    out, start = [], 0
    for s in sizes:
        out.append(a[..., start:start + s])
        start += s
    return out


def _causal_mask(i, block, lk):
    qpos = i * block + jnp.arange(block)
    return jnp.arange(lk)[None, :] <= qpos[:, None]


def sweep_query_blocks(fn, block, *qs):
    b, lp = qs[0].shape[:2]
    nb = lp // block
    xs = tuple(jnp.moveaxis(a.reshape((b, nb, block) + a.shape[2:]), 1, 0) for a in qs)
    out = lax.map(lambda args: fn(args[0], *args[1:]), (jnp.arange(nb),) + xs)
    out = jnp.moveaxis(out, 0, 1)
    return out.reshape((b, lp) + out.shape[3:])


def dense_causal_attention(q, k, v, scale):
    lk = k.shape[1]

    def blk(i, qb):
        s = jnp.einsum('bqhd,bkhd->bhqk', qb, k).astype(jnp.float32) * scale
        s = jnp.where(_causal_mask(i, Q_BLOCK, lk), s, -jnp.inf)
        p = jax.nn.softmax(s, axis=-1).astype(v.dtype)
        return jnp.einsum('bhqk,bkhd->bqhd', p, v)

    return sweep_query_blocks(blk, Q_BLOCK, q)


def mla_attention(c_q, c_kv, k_pe, q_norm_g, kv_norm_g, w_q_up, w_kv_up, qk_g, pos):
    b, lp, _ = c_q.shape
    q = (rms_norm(c_q, q_norm_g) @ w_q_up).reshape(b, lp, MLA_HEADS, MLA_QK)
    kv = (rms_norm(c_kv, kv_norm_g) @ w_kv_up).reshape(b, lp, MLA_HEADS, MLA_NOPE + MLA_V)
    k_nope, v = kv[..., :MLA_NOPE], kv[..., MLA_NOPE:]
    k = jnp.concatenate(
        [k_nope, jnp.broadcast_to(k_pe[:, :, None, :], (b, lp, MLA_HEADS, MLA_ROPE))], axis=-1)
    q = rms_norm(q, qk_g[0])
    k = rms_norm(k, qk_g[1])
    q = jnp.concatenate([q[..., :MLA_NOPE], rope(q[..., MLA_NOPE:], pos)], axis=-1)
    k = jnp.concatenate([k[..., :MLA_NOPE], rope(k[..., MLA_NOPE:], pos)], axis=-1)
    o = dense_causal_attention(q, k, v, MLA_QK ** -0.5)
    return o.reshape(b, lp, BRANCH_WIDTH)


def dsa_attention(q, k, v, iq, ik, iw, qk_g, pos, topk):
    b, lp, _ = q.shape
    q = rope(rms_norm(q.reshape(b, lp, DSA_HEADS, DSA_HEAD_DIM), qk_g[0]), pos)
    k = rope(rms_norm(k.reshape(b, lp, DSA_HEADS, DSA_HEAD_DIM), qk_g[1]), pos)
    v = v.reshape(b, lp, DSA_HEADS, DSA_HEAD_DIM)
    iq = rope(iq.reshape(b, lp, IDX_HEADS, IDX_DIM), pos)
    ik = rope(ik[:, :, None, :], pos)[:, :, 0, :]
    iw = iw.astype(jnp.float32) * (IDX_HEADS ** -0.5 * IDX_DIM ** -0.5)
    gather = jax.vmap(lambda src, idx: src[idx])

    def blk(i, qb, iqb, iwb):
        causal = _causal_mask(i, SPARSE_Q_BLOCK, lp)
        logits = jnp.einsum('bqhd,bsd->bqhs', iqb, ik).astype(jnp.float32)
        score = jnp.einsum('bqhs,bqh->bqs', jax.nn.relu(logits), iwb)
        score = jnp.where(causal, score, -jnp.inf)
        _, sel = lax.top_k(score, topk)
        qpos = i * SPARSE_Q_BLOCK + jnp.arange(SPARSE_Q_BLOCK)
        valid = sel <= qpos[None, :, None]
        k_sel = gather(k, sel)
        v_sel = gather(v, sel)
        s = jnp.einsum('bqhd,bqkhd->bhqk', qb, k_sel).astype(jnp.float32) * (DSA_HEAD_DIM ** -0.5)
        s = jnp.where(valid[:, None], s, -jnp.inf)
        p = jax.nn.softmax(s, axis=-1).astype(v.dtype)
        return jnp.einsum('bhqk,bqkhd->bqhd', p, v_sel)

    o = sweep_query_blocks(blk, SPARSE_Q_BLOCK, q, iq, iw)
    return o.reshape(b, lp, BRANCH_WIDTH)


def diff_attention(q, k, v, qk_g, lam_vecs, subln_g, pos, lambda_init):
    b, lp, _ = q.shape
    q = rope(rms_norm(q.reshape(b, lp, DIFF_HEADS, 2, DIFF_HEAD_DIM), qk_g[0]), pos)
    k = rope(rms_norm(k.reshape(b, lp, DIFF_HEADS, 2, DIFF_HEAD_DIM), qk_g[1]), pos)
    v = v.reshape(b, lp, DIFF_HEADS, DIFF_V)
    lv = lam_vecs.astype(jnp.float32)
    lam = jnp.exp(jnp.sum(lv[0] * lv[1])) - jnp.exp(jnp.sum(lv[2] * lv[3])) + lambda_init

    def blk(i, qb):
        s = jnp.einsum('bqhjd,bkhjd->bhjqk', qb, k).astype(jnp.float32) * (DIFF_HEAD_DIM ** -0.5)
        s = jnp.where(_causal_mask(i, Q_BLOCK, lp), s, -jnp.inf)
        p = jax.nn.softmax(s, axis=-1)
        a = (p[:, :, 0] - lam * p[:, :, 1]).astype(v.dtype)
        return jnp.einsum('bhqk,bkhd->bqhd', a, v)

    o = sweep_query_blocks(blk, Q_BLOCK, q)
    o = rms_norm(o, subln_g) * (1.0 - lambda_init)
    return o.reshape(b, lp, BRANCH_WIDTH)


def swiglu(xn, w_in, w_out):
    gu = xn @ w_in
    return (jax.nn.silu(gu[..., :D_FF]) * gu[..., D_FF:]) @ w_out


def setup_inputs(seed: int = 0) -> dict:
    key = jax.random.key(seed)
    ks = jax.random.split(key, 20)
    f32 = jnp.float32
    nrm = jax.random.normal

    def gain(k, shape):
        return 1.0 + 0.02 * nrm(k, shape, f32)

    return {
        'x': nrm(ks[0], (BATCH, SEQ, D_MODEL), f32),
        'meta': nrm(ks[1], (N_META, D_MODEL), f32),
        'ln1_g': gain(ks[2], (DEPTH, D_MODEL)),
        'w_in': nrm(ks[3], (DEPTH, D_MODEL, D_IN), f32) * D_MODEL ** -0.5,
        'b_gate': 0.02 * nrm(ks[4], (DEPTH, N_BRANCH * D_MODEL), f32),
        'mla_q_norm_g': gain(ks[5], (DEPTH, MLA_Q_RANK)),
        'mla_kv_norm_g': gain(ks[6], (DEPTH, MLA_KV_RANK)),
        'w_mla_q_up': nrm(ks[7], (DEPTH, MLA_Q_RANK, MLA_HEADS * MLA_QK), f32) * MLA_Q_RANK ** -0.5,
        'w_mla_kv_up': nrm(ks[8], (DEPTH, MLA_KV_RANK, MLA_HEADS * (MLA_NOPE + MLA_V)), f32) * MLA_KV_RANK ** -0.5,
        'mla_qk_g': gain(ks[9], (DEPTH, 2, MLA_QK)),
        'dsa_qk_g': gain(ks[10], (DEPTH, 2, DSA_HEAD_DIM)),
        'diff_qk_g': gain(ks[11], (DEPTH, 2, DIFF_HEAD_DIM)),
        'diff_lambda': 0.1 * nrm(ks[12], (DEPTH, 4, DIFF_HEAD_DIM), f32),
        'diff_subln_g': gain(ks[13], (DEPTH, DIFF_V)),
        'w_branch': nrm(ks[14], (DEPTH, N_BRANCH, BRANCH_WIDTH, D_MODEL), f32) * BRANCH_WIDTH ** -0.5,
        'w_o': nrm(ks[15], (DEPTH, D_MODEL, D_MODEL), f32) * D_MODEL ** -0.5,
        'ln2_g': gain(ks[16], (DEPTH, D_MODEL)),
        'w_ffn_in': nrm(ks[17], (DEPTH, D_MODEL, 2 * D_FF), f32) * D_MODEL ** -0.5,
        'w_ffn_out': nrm(ks[18], (DEPTH, D_FF, D_MODEL), f32) * D_FF ** -0.5,
    }


def reference(x, meta, ln1_g, w_in, b_gate, mla_q_norm_g, mla_kv_norm_g, w_mla_q_up, w_mla_kv_up,
              mla_qk_g, dsa_qk_g, diff_qk_g, diff_lambda, diff_subln_g, w_branch, w_o, ln2_g,
              w_ffn_in, w_ffn_out):
    b, s, d = x.shape
    topk = min(TOPK_MAX, s // 4)
    l_tot = N_META + s
    lp = -(-l_tot // Q_BLOCK) * Q_BLOCK
    pos = jnp.arange(lp)
    h = jnp.concatenate(
        [jnp.broadcast_to(meta[None].astype(x.dtype), (b, N_META, d)), x,
         jnp.zeros((b, lp - l_tot, d), x.dtype)], axis=1)
    for layer in range(DEPTH):
        lambda_init = 0.8 - 0.6 * math.exp(-0.3 * layer)
        xn = rms_norm(h, ln1_g[layer])
        (c_q, c_kv, k_pe, dq, dk, dv, iq, ik, iw, fq, fk, fv, g) = _split_cols(
            xn @ w_in[layer], IN_PROJ_SIZES)
        o_a = mla_attention(c_q, c_kv, k_pe, mla_q_norm_g[layer], mla_kv_norm_g[layer],
                            w_mla_q_up[layer], w_mla_kv_up[layer], mla_qk_g[layer], pos)
        o_b = dsa_attention(dq, dk, dv, iq, ik, iw, dsa_qk_g[layer], pos, topk)
        o_c = diff_attention(fq, fk, fv, diff_qk_g[layer], diff_lambda[layer],
                             diff_subln_g[layer], pos, lambda_init)
        gates = jax.nn.sigmoid((g + b_gate[layer]).astype(jnp.float32)).astype(h.dtype)
        gates = gates.reshape(b, lp, N_BRANCH, d)
        merged = (gates[:, :, 0] * (o_a @ w_branch[layer, 0])
                  + gates[:, :, 1] * (o_b @ w_branch[layer, 1])
                  + gates[:, :, 2] * (o_c @ w_branch[layer, 2]))
        h = h + merged @ w_o[layer]
        h = h + swiglu(rms_norm(h, ln2_g[layer]), w_ffn_in[layer], w_ffn_out[layer])
    return h[:, N_META:N_META + s]
```

```cpp
#include <hip/hip_runtime.h>
#include <cstdio>
#include <cstdint>

#ifndef PHMASK
#define PHMASK 0x7fff
#endif
#ifndef DBG_BM
#define DBG_BM 7
#endif
#ifndef DBG_BR
#define DBG_BR 0
#endif
#ifndef DBG_SA
#define DBG_SA 1.0f
#endif
#ifndef DBG_SF
#define DBG_SF 1.0f
#endif
#ifndef MK_ONE_LAUNCH
#define MK_ONE_LAUNCH 0
#endif

#define LAS __attribute__((address_space(3)))
#define GAS __attribute__((address_space(1)))
typedef unsigned short bf16_t;
typedef short bf16x8 __attribute__((ext_vector_type(8)));
typedef float f32x4 __attribute__((ext_vector_type(4)));
typedef float f32x2 __attribute__((ext_vector_type(2)));
typedef unsigned u32x4 __attribute__((ext_vector_type(4)));
typedef unsigned u32x2 __attribute__((ext_vector_type(2)));

constexpr int DM = 2048, NB = 16, SEQ = 2048, NMETA = 16, MBLK = 256;
constexpr int R = MBLK + NB * SEQ;
constexpr int NPM = R / 256;
constexpr int NTOK = NB * SEQ;
constexpr int DFF = 5632;
constexpr int PW = 8448;
constexpr int C_CQ = 0, C_CKV = 512, C_KPE = 1024, C_IK = 1088, C_IW = 1152, C_DQ = 1280, C_DK = 2304, C_DV = 3328, C_IQ = 4352,
              C_FQ = 5376, C_FK = 6400, C_FV = 7424;
constexpr int C_KVRAW = 1280, C_QRAW = 3328, C_KPEH = 4864;
constexpr int C_OA = 0, C_OB = C_DQ, C_OC = C_FQ, C_MERGED = 2304;
constexpr int BMW = 66;
constexpr float EPS = 1e-6f;
constexpr float LOG2E = 1.4426950408889634f;
constexpr float C2_128 = 0.08838834764831845f * LOG2E;
constexpr float C2_192 = 0.07216878364870323f * LOG2E;
constexpr int D_IN = 14480;

constexpr size_t MiB = 1u << 20;
constexpr size_t WS_CTL = 0, CTL_BYTES = 1 * MiB;
constexpr size_t WS_RSTD = 1 * MiB;
constexpr size_t WS_HMETA = 2 * MiB;
constexpr size_t WS_BM = 4 * MiB;
constexpr size_t WS_WB = 16 * MiB;
constexpr size_t WB_IN = 0, WB_G = WB_IN + (size_t)8448 * 2048 * 2, WB_QUP = WB_G + (size_t)6144 * 2048 * 2, WB_KVUP = WB_QUP + (size_t)1536 * 512 * 2,
                 WB_BR = WB_KVUP + (size_t)2048 * 512 * 2, WB_O = WB_BR + (size_t)3 * 2048 * 1024 * 2, WB_F1 = WB_O + (size_t)2048 * 2048 * 2,
                 WB_F2 = WB_F1 + (size_t)11264 * 2048 * 2, WB_END = WB_F2 + (size_t)2048 * 5632 * 2;
constexpr size_t WS_XN = 164 * MiB;
constexpr size_t WS_P = 294 * MiB;
constexpr size_t WS_GS = 828 * MiB;
constexpr size_t WS_END = 960 * MiB;
static_assert(WS_GS + (size_t)R * 2048 * 2 <= WS_END && WS_WB + WB_END <= WS_XN && WS_XN + (size_t)R * 2048 * 2 <= WS_P && WS_P + (size_t)R * PW * 2 <= WS_GS, "ws map");
constexpr int CW_BAR = 4096, CW_Q = 16384;

__device__ __forceinline__ float bf2f(bf16_t v) { return __uint_as_float((unsigned)v << 16); }
__device__ __forceinline__ unsigned f2bf(float f) { unsigned u = __float_as_uint(f); return (u + 0x7fffu + ((u >> 16) & 1u)) >> 16; }
__device__ __forceinline__ unsigned pk2(float lo, float hi) { return f2bf(lo) | (f2bf(hi) << 16); }
typedef __bf16 bf16x2_t __attribute__((ext_vector_type(2)));
__device__ __forceinline__ unsigned cvt_pk_bf16(float lo, float hi) { f32x2 v = {lo, hi}; bf16x2_t b = __builtin_convertvector(v, bf16x2_t); return __builtin_bit_cast(unsigned, b); }
__device__ __forceinline__ float wave_sum(float v) {
#pragma unroll
    for (int o = 1; o < 64; o <<= 1) v += __shfl_xor(v, o);
    return v;
}
__device__ __forceinline__ float wave_max(float v) {
#pragma unroll
    for (int o = 1; o < 64; o <<= 1) v = fmaxf(v, __shfl_xor(v, o));
    return v;
}
#define LDS_WAIT() asm volatile("s_waitcnt lgkmcnt(0)" ::: "memory")
#define VM_WAIT() asm volatile("s_waitcnt vmcnt(0)" ::: "memory")
__device__ __forceinline__ int row_pos(int r) { return r < MBLK ? (r >= MBLK - NMETA ? r - (MBLK - NMETA) : 0) : NMETA + ((r - MBLK) & (SEQ - 1)); }
__device__ __forceinline__ void rope_cs(int pos, int i, float two_over_d, float& c, float& s) {
    const float inv = __builtin_amdgcn_exp2f(-(float)i * two_over_d * 13.287712379549449f);
    float rev = (float)pos * inv * 0.15915494309189535f;
    rev -= floorf(rev);
    s = __builtin_amdgcn_sinf(rev); c = __builtin_amdgcn_cosf(rev);
}

namespace pg8 {
constexpr int BM = 256, BK = 64, HALF = 128, HTB = HALF * BK * 2, STAGE_BYTES = 8 * HTB;
__device__ __forceinline__ int lds_byte(int r, int c) { const int st = (r >> 4) * 2 + (c >> 5), rr = r & 15, cc = c & 31, ob = rr * 64 + cc * 2; return st * 1024 + (ob ^ (((ob >> 9) & 1) << 5)); }
__device__ __forceinline__ void stage_rc(int b, int& R_, int& C_) { const int st = b / 1024, sb = b % 1024, swz = sb ^ (((sb >> 9) & 1) << 5); R_ = (st >> 1) * 16 + swz / 64; C_ = (st & 1) * 32 + (swz % 64) / 2; }
__device__ __forceinline__ int perm32(int rho) { const int n = rho >> 4, i = rho & 15; return 8 * (i >> 2) + 4 * n + (i & 3); }

struct Unit { const char* A; const char* B; unsigned lda2, ldb2; int nt, pm, pn, kind, ocol; };

__device__ __forceinline__ void tile_of(int L, int nM, int nN, int& pm, int& pn) {
    const int nwg = nM * nN; int wgid = L;
    { const int q = nwg / 8, r = nwg % 8, xcd = wgid % 8, off = wgid / 8; wgid = (xcd < r ? xcd * (q + 1) : r * (q + 1) + (xcd - r) * q) + off; }
    const int nig = 8 * nN, gid = wgid / nig, fm = gid * 8, gsz = (nM - fm) < 8 ? (nM - fm) : 8;
    pm = fm + ((wgid % nig) % gsz); pn = (wgid % nig) / gsz;
}

template <class Epi, class Sched>
__device__ __forceinline__ void gemm_phase(LAS unsigned char* lds, const Sched& S, const Epi& E) {
    int tid = threadIdx.x; asm volatile("" : "+v"(tid));
    const int wid = __builtin_amdgcn_readfirstlane(tid >> 6), lane = tid & 63, wr = wid >> 2, wc = wid & 3, fr = lane & 15, fq = lane >> 4;
    unsigned rA[2], rB[2], cc[2];
#pragma unroll
    for (int i = 0; i < 2; ++i) { int R_, C_; stage_rc(tid * 16 + i * 8192, R_, C_); rA[i] = (unsigned)R_; rB[i] = (unsigned)(Epi::PERM ? ((R_ & ~31) + perm32(R_ & 31)) : R_); cc[i] = (unsigned)C_ * 2u; }
    const size_t kstep = (size_t)(BK * 2);
    const unsigned ldsw = (unsigned)wid * 1024u;
    const int aoff = lds_byte(wr * 64 + fr, fq * 8), boff = lds_byte(wc * 32 + fr, fq * 8);
#define PG8_SA(b, h) (((b) * 2 + (h)) * HTB)
#define PG8_SB(b, h) ((4 + (b) * 2 + (h)) * HTB)
#define PG8_STAGE(bufoff, gbase, rr, ld2) do { _Pragma("unroll") for (int _i = 0; _i < 2; ++_i) \
        __builtin_amdgcn_global_load_lds((const unsigned*)((const char*)(gbase) + ((rr)[_i] * (ld2) + cc[_i])), (LAS unsigned*)(lds + (bufoff) + ldsw + _i * 8192), 16, 0, 0); } while (0)
#define PG8_LDA(dst, b, h) do { _Pragma("unroll") for (int m = 0; m < 4; ++m) _Pragma("unroll") for (int k = 0; k < 2; ++k) dst[m][k] = *(const LAS bf16x8*)(lds + PG8_SA(b, h) + aoff + m * 2048 + k * 1024); } while (0)
#define PG8_LDB(dst, b, h) do { _Pragma("unroll") for (int n = 0; n < 2; ++n) _Pragma("unroll") for (int k = 0; k < 2; ++k) dst[n][k] = *(const LAS bf16x8*)(lds + PG8_SB(b, h) + boff + n * 2048 + k * 1024); } while (0)
#define PG8_MMA(ai, bj, At, Bt) do { __builtin_amdgcn_s_setprio(1); _Pragma("unroll") for (int m = 0; m < 4; ++m) _Pragma("unroll") for (int n = 0; n < 2; ++n) _Pragma("unroll") for (int k = 0; k < 2; ++k) \
        acc[ai][bj][m][n] = __builtin_amdgcn_mfma_f32_16x16x32_bf16(Bt[n][k], At[m][k], acc[ai][bj][m][n], 0, 0, 0); __builtin_amdgcn_s_setprio(0); } while (0)
#define PG8_WAIT_V(n) asm volatile("s_waitcnt vmcnt(" #n ")" ::: "memory")
#define PG8_WAIT_L(n) asm volatile("s_waitcnt lgkmcnt(" #n ")" ::: "memory")
#define PG8_BAR __builtin_amdgcn_s_barrier()
#define PG8_SCHED __builtin_amdgcn_sched_barrier(0)
    Unit cur, nxt; int ui = 0;
    if (!S.next(0, cur)) return;
    f32x4 acc[2][2][4][2];
#pragma unroll
    for (int a = 0; a < 2; ++a)
#pragma unroll
        for (int b = 0; b < 2; ++b)
#pragma unroll
            for (int m = 0; m < 4; ++m)
#pragma unroll
                for (int n = 0; n < 2; ++n) acc[a][b][m][n] = (f32x4){0.f, 0.f, 0.f, 0.f};
    bf16x8 At[4][2], B0[2][2], B1[2][2];
    const char* cA = cur.A; const char* cB = cur.B;
    unsigned lA = cur.lda2, lB = cur.ldb2;
    size_t hA = (size_t)HALF * lA, hB = (size_t)HALF * lB;
    PG8_STAGE(PG8_SB(0, 0), cB, rB, lB); PG8_STAGE(PG8_SB(0, 1), cB + hB, rB, lB); PG8_STAGE(PG8_SA(0, 0), cA, rA, lA); PG8_STAGE(PG8_SA(0, 1), cA + hA, rA, lA);
    if (wr == 1) PG8_BAR;
    PG8_WAIT_V(2); PG8_BAR;
    PG8_STAGE(PG8_SB(1, 0), cB + kstep, rB, lB); PG8_STAGE(PG8_SA(1, 0), cA + kstep, rA, lA); PG8_STAGE(PG8_SB(1, 1), cB + hB + kstep, rB, lB);
    PG8_WAIT_V(6); PG8_BAR;
    for (;;) {
        const bool has_next = S.next(ui + 1, nxt);
        if (!has_next) nxt = cur;
        const char* nA = nxt.A; const char* nB = nxt.B;
        const unsigned lAn = nxt.lda2, lBn = nxt.ldb2;
        const size_t hAn = (size_t)HALF * lAn, hBn = (size_t)HALF * lBn;
        const int nt = cur.nt;
        for (int t = 0; t < nt; t += 2) {
            const bool last = (t == nt - 2);
            const char* a1 = cA + (size_t)(t + 1) * kstep;
            const char* a2 = last ? nA : cA + (size_t)(t + 2) * kstep; const char* b2 = last ? nB : cB + (size_t)(t + 2) * kstep;
            const char* a3 = a2 + kstep; const char* b3 = b2 + kstep;
            const size_t hA2 = last ? hAn : hA, hB2 = last ? hBn : hB;
            const unsigned lA2 = last ? lAn : lA, lB2 = last ? lBn : lB;
            PG8_LDB(B0, 0, 0); PG8_LDB(B1, 0, 1); PG8_SCHED; PG8_LDA(At, 0, 0); PG8_STAGE(PG8_SA(1, 1), a1 + hA, rA, lA);
            PG8_WAIT_V(8); PG8_WAIT_L(0); PG8_BAR; PG8_MMA(0, 0, At, B0); PG8_MMA(0, 1, At, B1); PG8_BAR; PG8_SCHED;
            PG8_LDA(At, 0, 1); PG8_STAGE(PG8_SB(0, 0), b2, rB, lB2); PG8_STAGE(PG8_SB(0, 1), b2 + hB2, rB, lB2); PG8_STAGE(PG8_SA(0, 0), a2, rA, lA2);
            PG8_WAIT_V(8); PG8_WAIT_L(0); PG8_BAR; PG8_MMA(1, 0, At, B0); PG8_MMA(1, 1, At, B1); PG8_BAR; PG8_SCHED;
            PG8_LDB(B0, 1, 0); PG8_LDB(B1, 1, 1); PG8_SCHED; PG8_LDA(At, 1, 0); PG8_STAGE(PG8_SA(0, 1), a2 + hA2, rA, lA2);
            PG8_WAIT_V(8); PG8_WAIT_L(0); PG8_BAR; PG8_MMA(0, 0, At, B0); PG8_MMA(0, 1, At, B1); PG8_BAR; PG8_SCHED;
            PG8_LDA(At, 1, 1); PG8_STAGE(PG8_SB(1, 0), b3, rB, lB2); PG8_STAGE(PG8_SB(1, 1), b3 + hB2, rB, lB2); PG8_STAGE(PG8_SA(1, 0), a3, rA, lA2);
            PG8_WAIT_V(8); PG8_WAIT_L(0); PG8_BAR; PG8_MMA(1, 0, At, B0); PG8_MMA(1, 1, At, B1); PG8_BAR; PG8_SCHED;
        }
        if (wr == 0) PG8_BAR;
        E(acc, cur, wr, wc, fr, fq);
        if (!has_next) break;
#pragma unroll
        for (int a = 0; a < 2; ++a)
#pragma unroll
            for (int b = 0; b < 2; ++b)
#pragma unroll
                for (int m = 0; m < 4; ++m)
#pragma unroll
                    for (int n = 0; n < 2; ++n) acc[a][b][m][n] = (f32x4){0.f, 0.f, 0.f, 0.f};
        cur = nxt; cA = nA; cB = nB; hA = hAn; hB = hBn; lA = lAn; lB = lBn; ++ui;
        if (wr == 1) PG8_BAR;
    }
    PG8_WAIT_V(0);
    PG8_BAR;
#undef PG8_SA
#undef PG8_SB
#undef PG8_STAGE
#undef PG8_LDA
#undef PG8_LDB
#undef PG8_MMA
#undef PG8_WAIT_V
#undef PG8_WAIT_L
#undef PG8_BAR
#undef PG8_SCHED
}
}
using pg8::Unit;

struct SchedPlain {
    const bf16_t* A; int lda; const bf16_t* B; int K; int nM, nN, G, c, ocol0;
    __device__ __forceinline__ bool next(int i, Unit& u) const {
        const int L = i * G + c; if (L >= nM * nN) return false;
        int pm, pn; pg8::tile_of(L, nM, nN, pm, pn);
        u.pm = pm; u.pn = pn; u.kind = 0; u.ocol = ocol0 + 256 * pn; u.nt = K / 64; u.lda2 = (unsigned)lda * 2u; u.ldb2 = (unsigned)K * 2u;
        u.A = (const char*)(A + (size_t)pm * 256 * lda); u.B = (const char*)(B + (size_t)pn * 256 * K); return true;
    }
};
struct SchedMlaUp {
    const bf16_t* P; const bf16_t* Wq; const bf16_t* Wkv; int G, c;
    __device__ __forceinline__ bool next(int i, Unit& u) const {
        const int L = i * G + c; if (L >= NPM * 14) return false;
        int pm, pn; pg8::tile_of(L, NPM, 14, pm, pn);
        u.pm = pm; u.pn = pn; u.kind = 0; u.nt = 8; u.lda2 = PW * 2u; u.ldb2 = 512 * 2u;
        if (pn < 6) { u.A = (const char*)(P + (size_t)pm * 256 * PW + C_CQ); u.B = (const char*)(Wq + (size_t)pn * 256 * 512); u.ocol = C_QRAW + 256 * pn; }
        else { u.A = (const char*)(P + (size_t)pm * 256 * PW + C_CKV); u.B = (const char*)(Wkv + (size_t)(pn - 6) * 256 * 512); u.ocol = C_KVRAW + 256 * (pn - 6); }
        return true;
    }
};
struct EpiP {
    static constexpr bool PERM = true;
    bf16_t* P;
    __device__ __forceinline__ void operator()(const f32x4 (&acc)[2][2][4][2], const Unit& u, int wr, int wc, int fr, int fq) const {
        asm volatile("" : "+v"(fr), "+v"(fq));
        const int row0 = u.pm * 256 + wr * 64 + fr, col0 = u.ocol + wc * 32 + 8 * fq;
#pragma unroll
        for (int ai = 0; ai < 2; ++ai)
#pragma unroll
            for (int m = 0; m < 4; ++m) { bf16_t* rowp = P + (size_t)(row0 + ai * 128 + m * 16) * PW + col0;
#pragma unroll
                for (int bj = 0; bj < 2; ++bj) { const f32x4 v0 = acc[ai][bj][m][0], v1 = acc[ai][bj][m][1];
                    u32x4 w; w.x = cvt_pk_bf16(v0[0], v0[1]); w.y = cvt_pk_bf16(v0[2], v0[3]); w.z = cvt_pk_bf16(v1[0], v1[1]); w.w = cvt_pk_bf16(v1[2], v1[3]);
                    *(u32x4*)(rowp + bj * 128) = w; } }
    }
};
struct EpiGate {
    static constexpr bool PERM = true;
    bf16_t* G; const float* bias;
    __device__ __forceinline__ void operator()(const f32x4 (&acc)[2][2][4][2], const Unit& u, int wr, int wc, int fr, int fq) const {
        asm volatile("" : "+v"(fr), "+v"(fq));
        const int row0 = u.pm * 256 + wr * 64 + fr, col0 = u.pn * 256 + wc * 32 + 8 * fq;
#pragma unroll
        for (int bj = 0; bj < 2; ++bj) { const f32x4 bv0 = *(const f32x4*)(bias + col0 + bj * 128), bv1 = *(const f32x4*)(bias + col0 + bj * 128 + 4);
#pragma unroll
            for (int ai = 0; ai < 2; ++ai)
#pragma unroll
                for (int m = 0; m < 4; ++m) { bf16_t* rowp = G + (size_t)(row0 + ai * 128 + m * 16) * 2048 + col0; f32x4 v0 = acc[ai][bj][m][0] + bv0, v1 = acc[ai][bj][m][1] + bv1;
#pragma unroll
                    for (int e = 0; e < 4; ++e) { v0[e] = __builtin_amdgcn_rcpf(1.f + __builtin_amdgcn_exp2f(-v0[e] * LOG2E)); v1[e] = __builtin_amdgcn_rcpf(1.f + __builtin_amdgcn_exp2f(-v1[e] * LOG2E)); }
                    u32x4 w; w.x = cvt_pk_bf16(v0[0], v0[1]); w.y = cvt_pk_bf16(v0[2], v0[3]); w.z = cvt_pk_bf16(v1[0], v1[1]); w.w = cvt_pk_bf16(v1[2], v1[3]);
                    *(u32x4*)(rowp + bj * 128) = w; } }
    }
};
struct EpiGated {
    static constexpr bool PERM = true;
    bf16_t* P; const bf16_t* G; int first; float sc;
    __device__ __forceinline__ void operator()(const f32x4 (&acc)[2][2][4][2], const Unit& u, int wr, int wc, int fr, int fq) const {
        asm volatile("" : "+v"(fr), "+v"(fq));
        const int row0 = u.pm * 256 + wr * 64 + fr, lcol0 = u.pn * 256 + wc * 32 + 8 * fq, col0 = u.ocol + wc * 32 + 8 * fq;
#pragma unroll
        for (int ai = 0; ai < 2; ++ai)
#pragma unroll
            for (int m = 0; m < 4; ++m) { bf16_t* rowp = P + (size_t)(row0 + ai * 128 + m * 16) * PW + col0; const bf16_t* gp = G + (size_t)(row0 + ai * 128 + m * 16) * 2048 + lcol0;
#pragma unroll
                for (int bj = 0; bj < 2; ++bj) { u32x4 g = *(const u32x4*)(gp + bj * 128); if (DBG_BR == 1) g = (u32x4){0x3f803f80u, 0x3f803f80u, 0x3f803f80u, 0x3f803f80u};
                    u32x4 pv = (u32x4){0u, 0u, 0u, 0u}; if (!first) pv = *(const u32x4*)(rowp + bj * 128);
                    const f32x4 v0 = acc[ai][bj][m][0] * sc, v1 = acc[ai][bj][m][1] * sc;
                    float o[8];
                    o[0] = __uint_as_float(pv.x << 16) + __uint_as_float(g.x << 16) * v0[0]; o[1] = __uint_as_float(pv.x & 0xffff0000u) + __uint_as_float(g.x & 0xffff0000u) * v0[1];
                    o[2] = __uint_as_float(pv.y << 16) + __uint_as_float(g.y << 16) * v0[2]; o[3] = __uint_as_float(pv.y & 0xffff0000u) + __uint_as_float(g.y & 0xffff0000u) * v0[3];
                    o[4] = __uint_as_float(pv.z << 16) + __uint_as_float(g.z << 16) * v1[0]; o[5] = __uint_as_float(pv.z & 0xffff0000u) + __uint_as_float(g.z & 0xffff0000u) * v1[1];
                    o[6] = __uint_as_float(pv.w << 16) + __uint_as_float(g.w << 16) * v1[2]; o[7] = __uint_as_float(pv.w & 0xffff0000u) + __uint_as_float(g.w & 0xffff0000u) * v1[3];
                    u32x4 w; w.x = cvt_pk_bf16(o[0], o[1]); w.y = cvt_pk_bf16(o[2], o[3]); w.z = cvt_pk_bf16(o[4], o[5]); w.w = cvt_pk_bf16(o[6], o[7]);
                    *(u32x4*)(rowp + bj * 128) = w; }
                asm volatile("" ::: "memory"); }
    }
};
struct EpiRes {
    static constexpr bool PERM = false;
    const float* base_tok; float* out_tok; float* hmeta; float dbg;
    __device__ __forceinline__ void operator()(const f32x4 (&acc)[2][2][4][2], const Unit& u, int wr, int wc, int fr, int fq) const {
        asm volatile("" : "+v"(fr), "+v"(fq));
        const float* bp; float* op;
        if (u.pm == 0) { bp = hmeta; op = hmeta; } else { bp = base_tok + (size_t)(u.pm - 1) * 256 * DM; op = out_tok + (size_t)(u.pm - 1) * 256 * DM; }
        const int lrow0 = wr * 64 + fr, col0 = u.pn * 256 + wc * 32 + 4 * fq;
#pragma unroll
        for (int ai = 0; ai < 2; ++ai)
#pragma unroll
            for (int m = 0; m < 4; ++m) { const size_t off = (size_t)(lrow0 + ai * 128 + m * 16) * DM + col0;
#pragma unroll
                for (int bj = 0; bj < 2; ++bj)
#pragma unroll
                    for (int n = 0; n < 2; ++n) { const f32x4 bs = *(const f32x4*)(bp + off + bj * 128 + n * 16); *(f32x4*)(op + off + bj * 128 + n * 16) = bs + acc[ai][bj][m][n] * dbg; }
                asm volatile("" ::: "memory"); }
    }
};
struct EpiSwiglu {
    static constexpr bool PERM = true;
    bf16_t* P;
    __device__ __forceinline__ void operator()(const f32x4 (&acc)[2][2][4][2], const Unit& u, int wr, int wc, int fr, int fq) const {
        asm volatile("" : "+v"(fr), "+v"(fq));
        const int row0 = u.pm * 256 + wr * 64 + fr, col0 = u.pn * 128 + wc * 32 + 8 * fq;
#pragma unroll
        for (int ai = 0; ai < 2; ++ai)
#pragma unroll
            for (int m = 0; m < 4; ++m) { bf16_t* rowp = P + (size_t)(row0 + ai * 128 + m * 16) * PW + col0;
                float o[8];
#pragma unroll
                for (int n = 0; n < 2; ++n)
#pragma unroll
                    for (int e = 0; e < 4; ++e) { const float g = acc[ai][0][m][n][e], up = acc[ai][1][m][n][e]; o[n * 4 + e] = g * __builtin_amdgcn_rcpf(1.f + __builtin_amdgcn_exp2f(-g * LOG2E)) * up; }
                u32x4 w; w.x = cvt_pk_bf16(o[0], o[1]); w.y = cvt_pk_bf16(o[2], o[3]); w.z = cvt_pk_bf16(o[4], o[5]); w.w = cvt_pk_bf16(o[6], o[7]);
                *(u32x4*)rowp = w; }
    }
};

#define XB_TMO      128
#define XB_XCNT(j)  (256  + 64 * (j))
#define XB_XSUB(j)  (1280 + 64 * (j))
#define XB_XGEN(j)  (2304 + 64 * (j))
#define XB_TOP      3328
#define XB_TOPGEN   3392
#define XCD_BAR_WORDS 3456
#define XB_SPIN_CAP (1u << 18)
__device__ __forceinline__ unsigned xb_ld(unsigned* p)              { return __hip_atomic_load(p, __ATOMIC_RELAXED, __HIP_MEMORY_SCOPE_AGENT); }
__device__ __forceinline__ unsigned xb_add(unsigned* p, unsigned v) { return __hip_atomic_fetch_add(p, v, __ATOMIC_RELAXED, __HIP_MEMORY_SCOPE_AGENT); }
__device__ __forceinline__ unsigned xb_xcc_id() { return (unsigned)__builtin_amdgcn_s_getreg((3 << 11) | 20) & 0xFu; }
#define XB_SPIN(cond, bar) do { unsigned _sp = 0; while (cond) { __builtin_amdgcn_s_sleep(1); \
    if ((++_sp & 255u) == 0u) { if (xb_ld(&(bar)[XB_TMO])) break; if (_sp > XB_SPIN_CAP) { atomicAdd(&(bar)[XB_TMO], 1u); break; } } } } while (0)
struct XcdBarrier { unsigned* bar; unsigned x; volatile LAS unsigned* st; };
__device__ __forceinline__ XcdBarrier xcd_barrier_post(unsigned* bar, volatile LAS unsigned* st) {
    XcdBarrier b; b.bar = bar; b.x = xb_xcc_id(); b.st = st;
    if (threadIdx.x == 0) (void)xb_add(&bar[XB_XCNT(b.x)], 1u);
    return b;
}
__device__ __forceinline__ void xcd_barrier_complete(unsigned* bar, unsigned x, unsigned& nloc, unsigned& nx) {
    const unsigned G = gridDim.x * gridDim.y * gridDim.z;
    unsigned sum, cnt, mine, sp = 0u;
    for (;;) {
        sum = 0u; cnt = 0u; mine = 0u;
#pragma unroll
        for (unsigned j = 0; j < 16; ++j) { const unsigned c = xb_ld(&bar[XB_XCNT(j)]); sum += c; cnt += (c > 0u) ? 1u : 0u; mine = (j == x) ? c : mine; }
        if (sum == G) break;
        __builtin_amdgcn_s_sleep(1);
        if ((++sp & 255u) == 0u) { if (xb_ld(&bar[XB_TMO])) break; if (sp > XB_SPIN_CAP) { atomicAdd(&bar[XB_TMO], 1u); break; } }
    }
    nloc = mine > 0u ? mine : 1u; nx = cnt > 0u ? cnt : 1u;
}
__device__ __forceinline__ void xcd_barrier(const XcdBarrier& b) {
    asm volatile("s_waitcnt vmcnt(0)" ::: "memory");
    __syncthreads();
    if (threadIdx.x == 0) {
        unsigned* bar = b.bar;
        __builtin_amdgcn_s_waitcnt(0);
        unsigned nloc = b.st[0], nx = b.st[1];
        if (nloc == 0u) { xcd_barrier_complete(bar, b.x, nloc, nx); b.st[0] = nloc; b.st[1] = nx; }
        const unsigned old = xb_add(&bar[XB_XSUB(b.x)], 1u);
        const unsigned gen = old / nloc;
        if (old + 1u == (gen + 1u) * nloc) {
            __builtin_amdgcn_fence(__ATOMIC_RELEASE, "agent");
            asm volatile("s_waitcnt vmcnt(0)" ::: "memory");
            const unsigned og = xb_add(&bar[XB_TOP], 1u);
            const unsigned tg = og / nx;
            if (og + 1u == (tg + 1u) * nx) xb_add(&bar[XB_TOPGEN], 1u);
            else XB_SPIN(xb_ld(&bar[XB_TOPGEN]) == tg, bar);
            __builtin_amdgcn_fence(__ATOMIC_ACQUIRE, "agent");
            xb_add(&bar[XB_XGEN(b.x)], 1u);
            asm volatile("s_waitcnt vmcnt(0)" ::: "memory");
        } else {
            XB_SPIN(xb_ld(&bar[XB_XGEN(b.x)]) == gen, bar);
            __builtin_amdgcn_fence(__ATOMIC_ACQUIRE, "agent");
            asm volatile("s_waitcnt vmcnt(0)" ::: "memory");
        }
    }
    __syncthreads();
}

constexpr int NWAVES = 8;
constexpr int RING_BYTES = 131072, LDSCTL_OFF = RING_BYTES, LDS_BYTES = 147456;
struct Args {
    const float* in[19]; float* out; unsigned char* ws; int ph_lo, ph_hi;
};
struct Ctx {
    LAS unsigned char* lds; int tid, lane, wave, gw, ngw, G, bid;
};

template <int MAP> __device__ __forceinline__ int wmap(int n, float& sc) {
    sc = 1.f;
    if (MAP == 0) return n;
    if (MAP == 1) {
        if (n < 1088) return n;
        if (n < 4160) return 1280 + (n - 1088);
        if (n < 5184) return 4352 + (n - 4160);
        if (n < 5248) return 1088 + (n - 5184);
        if (n < 5264) { sc = 0.03125f; return 1152 + (n - 5248); }
        if (n < 8336) return 5376 + (n - 5264);
        return 8448 + (n - 8336);
    }
    if (n < DFF) return (n >> 7) * 256 + (n & 127);
    const int m = n - DFF; return (m >> 7) * 256 + 128 + (m & 127);
}
template <int MAP> __device__ __forceinline__ void conv_item(const float* W, int K, int N, bf16_t* WT, const float* gain, LAS float* scr, int item, int lane) {
    const int nblk = (N + 31) / 32, kb = item / nblk, nb = item - kb * nblk, k0 = 64 * kb, n0 = 32 * nb;
    const int nn = n0 + (lane & 31);
#pragma unroll 8
    for (int i = 0; i < 32; ++i) { const int kk = 2 * i + (lane >> 5); float v = 0.f; if (nn < N) { v = W[(size_t)(k0 + kk) * N + nn]; if (gain) v *= gain[k0 + kk]; } scr[kk * 33 + (lane & 31)] = v; }
    LDS_WAIT(); asm volatile("" ::: "memory");
    const int c = lane & 7;
#pragma unroll
    for (int j = 0; j < 4; ++j) { const int n = (lane >> 3) + 8 * j; const int ns = n0 + n;
        if (ns < N) { float sc; const int dst = wmap<MAP>(ns, sc); const LAS float* s = scr + (8 * c) * 33 + n;
            u32x4 o; o.x = pk2(s[0 * 33] * sc, s[1 * 33] * sc); o.y = pk2(s[2 * 33] * sc, s[3 * 33] * sc); o.z = pk2(s[4 * 33] * sc, s[5 * 33] * sc); o.w = pk2(s[6 * 33] * sc, s[7 * 33] * sc);
            *(u32x4*)(WT + (size_t)dst * K + k0 + 8 * c) = o; } }
    LDS_WAIT(); asm volatile("" ::: "memory");
}
template <int MAP> __device__ __forceinline__ void conv_matrix(const Ctx& F, const float* W, int K, int N, bf16_t* WT, const float* gain) {
    LAS float* scr = (LAS float*)(F.lds + F.wave * 16384);
    const int nit = (K / 64) * ((N + 31) / 32);
    for (int it = F.gw; it < nit; it += F.ngw) conv_item<MAP>(W, K, N, WT, gain, scr, it, F.lane);
}

__device__ __forceinline__ void norm_row(const float* hrow, bf16_t* orow, int lane) {
    f32x4 v[8]; float s = 0.f;
    if (hrow) {
#pragma unroll
        for (int j = 0; j < 8; ++j) { v[j] = *((const f32x4*)hrow + lane + 64 * j); s += (v[j].x * v[j].x + v[j].y * v[j].y) + (v[j].z * v[j].z + v[j].w * v[j].w); }
    } else {
#pragma unroll
        for (int j = 0; j < 8; ++j) v[j] = (f32x4){0.f, 0.f, 0.f, 0.f};
    }
    const float rstd = 1.0f / sqrtf(wave_sum(s) * (1.f / DM) + EPS);
#pragma unroll
    for (int j = 0; j < 8; ++j) { u32x2 o; o.x = pk2(v[j].x * rstd, v[j].y * rstd); o.y = pk2(v[j].z * rstd, v[j].w * rstd); *((u32x2*)orow + lane + 64 * j) = o; }
}

__device__ __forceinline__ void post1a_row(const bf16_t* P, int r, float* rstdq, float* rstdkv, int lane) {
    const bf16_t* p = P + (size_t)r * PW;
    const u32x4 a = *((const u32x4*)(p + C_CQ) + lane), b = *((const u32x4*)(p + C_CKV) + lane);
    float sa = 0.f, sb = 0.f;
#pragma unroll
    for (int e = 0; e < 4; ++e) { const float x0 = __uint_as_float(a[e] << 16), x1 = __uint_as_float(a[e] & 0xffff0000u); sa += x0 * x0 + x1 * x1;
        const float y0 = __uint_as_float(b[e] << 16), y1 = __uint_as_float(b[e] & 0xffff0000u); sb += y0 * y0 + y1 * y1; }
    sa = wave_sum(sa); sb = wave_sum(sb);
    if (lane == 0) { rstdq[r] = 1.0f / sqrtf(sa * (1.f / 512.f) + EPS); rstdkv[r] = 1.0f / sqrtf(sb * (1.f / 512.f) + EPS); }
}
__device__ __forceinline__ void post2_row(bf16_t* P, int r, const float* rstdq, const float* rstdkv, const float* qkg  , int lane) {
    bf16_t* p = P + (size_t)r * PW;
    const float sq = rstdq[r], skv = rstdkv[r];
    float cs, sn; rope_cs(row_pos(r), lane & 31, 2.f / 64.f, cs, sn);
    const float g0a = qkg[lane], g0b = qkg[64 + lane], g0c = qkg[128 + lane];
    const float g1a = qkg[192 + lane], g1b = qkg[192 + 64 + lane], g1c = qkg[192 + 128 + lane];
    const float kpe = bf2f(p[C_KPE + lane]);
    const float kpe_ss = wave_sum(kpe * kpe);
#pragma unroll 2
    for (int h = 0; h < 8; ++h) {
        bf16_t* q = p + C_QRAW + h * 192;
        float x0 = bf2f(q[lane]) * sq, x1 = bf2f(q[64 + lane]) * sq, x2 = bf2f(q[128 + lane]) * sq;
        float rn = 1.0f / sqrtf(wave_sum(x0 * x0 + x1 * x1 + x2 * x2) * (1.f / 192.f) + EPS);
        x0 *= rn * g0a; x1 *= rn * g0b; x2 *= rn * g0c;
        { const float pr = __shfl_xor(x2, 32); x2 = (lane < 32) ? (x2 * cs - pr * sn) : (x2 * cs + pr * sn); }
        q[lane] = (bf16_t)f2bf(x0 * C2_192); q[64 + lane] = (bf16_t)f2bf(x1 * C2_192); q[128 + lane] = (bf16_t)f2bf(x2 * C2_192);
        bf16_t* kv = p + C_KVRAW + h * 256;
        float k0 = bf2f(kv[lane]) * skv, k1 = bf2f(kv[64 + lane]) * skv;
        const float v0 = bf2f(kv[128 + lane]) * skv, v1 = bf2f(kv[192 + lane]) * skv;
        rn = 1.0f / sqrtf((wave_sum(k0 * k0 + k1 * k1) + kpe_ss) * (1.f / 192.f) + EPS);
        kv[lane] = (bf16_t)f2bf(k0 * rn * g1a); kv[64 + lane] = (bf16_t)f2bf(k1 * rn * g1b);
        kv[128 + lane] = (bf16_t)f2bf(v0); kv[192 + lane] = (bf16_t)f2bf(v1);
        float kp = kpe * rn * g1c;
        { const float pr = __shfl_xor(kp, 32); kp = (lane < 32) ? (kp * cs - pr * sn) : (kp * cs + pr * sn); }
        p[C_KPEH + h * 64 + lane] = (bf16_t)f2bf(kp);
    }
}
__device__ __forceinline__ void headnorm_rope128(bf16_t* x, float ga, float gb, float cs, float sn, float scale, int lane) {
    float a = bf2f(x[lane]), b = bf2f(x[64 + lane]);
    const float rn = 1.0f / sqrtf(wave_sum(a * a + b * b) * (1.f / 128.f) + EPS);
    a *= rn * ga; b *= rn * gb;
    const float ra = a * cs - b * sn, rb = b * cs + a * sn;
    x[lane] = (bf16_t)f2bf(ra * scale); x[64 + lane] = (bf16_t)f2bf(rb * scale);
}
__device__ __forceinline__ void post1b_row(bf16_t* P, int r, const float* dsag  , const float* diffg  , int lane) {
    bf16_t* p = P + (size_t)r * PW;
    const int pos = row_pos(r);
    float c128, s128, c64, s64; rope_cs(pos, lane, 2.f / 128.f, c128, s128); rope_cs(pos, lane & 31, 2.f / 64.f, c64, s64);
    const float dq_a = dsag[lane], dq_b = dsag[64 + lane], dk_a = dsag[128 + lane], dk_b = dsag[192 + lane];
    const float fq_a = diffg[lane], fq_b = diffg[64 + lane], fk_a = diffg[128 + lane], fk_b = diffg[192 + lane];
#pragma unroll 2
    for (int h = 0; h < 8; ++h) {
        headnorm_rope128(p + C_DQ + h * 128, dq_a, dq_b, c128, s128, C2_128, lane);
        headnorm_rope128(p + C_DK + h * 128, dk_a, dk_b, c128, s128, 1.f, lane);
        headnorm_rope128(p + C_FQ + h * 128, fq_a, fq_b, c128, s128, C2_128, lane);
        headnorm_rope128(p + C_FK + h * 128, fk_a, fk_b, c128, s128, 1.f, lane);
    }
#pragma unroll 2
    for (int h = 0; h < 17; ++h) {
        bf16_t* x = (h < 16) ? (p + C_IQ + h * 64) : (p + C_IK);
        const float v = bf2f(x[lane]); const float pr = __shfl_xor(v, 32);
        x[lane] = (bf16_t)f2bf((lane < 32) ? (v * c64 - pr * s64) : (v * c64 + pr * s64));
    }
}
__device__ __forceinline__ void post3_row(bf16_t* P, int r, const float* subg, float lam, float omli, int lane) {
    bf16_t* p = P + (size_t)r * PW;
    const float g0 = subg[lane], g1 = subg[64 + lane], g2 = subg[128 + lane], g3 = subg[192 + lane];
#pragma unroll
    for (int h = 0; h < 4; ++h) {
        const bf16_t* a0 = p + C_FQ + (h * 2) * 128; const bf16_t* a1 = p + C_FQ + (h * 2 + 1) * 128;
        const bf16_t* b0 = p + C_IQ + (h * 2) * 128; const bf16_t* b1 = p + C_IQ + (h * 2 + 1) * 128;
        const float d0 = bf2f(a0[lane]) - lam * bf2f(a1[lane]), d1 = bf2f(a0[64 + lane]) - lam * bf2f(a1[64 + lane]);
        const float d2 = bf2f(b0[lane]) - lam * bf2f(b1[lane]), d3 = bf2f(b0[64 + lane]) - lam * bf2f(b1[64 + lane]);
        const float rn = omli / sqrtf(wave_sum(d0 * d0 + d1 * d1 + d2 * d2 + d3 * d3) * (1.f / 256.f) + EPS);
        bf16_t* o = p + C_OC + h * 256;
        o[lane] = (bf16_t)f2bf(d0 * rn * g0); o[64 + lane] = (bf16_t)f2bf(d1 * rn * g1); o[128 + lane] = (bf16_t)f2bf(d2 * rn * g2); o[192 + lane] = (bf16_t)f2bf(d3 * rn * g3);
    }
}

__device__ __forceinline__ int key_row(int kidx, int tokbase) { return kidx < 64 ? (MBLK - 64) + kidx : tokbase + (kidx - 64); }

__device__ __forceinline__ void index_row(const bf16_t* P, int tok, unsigned* bm, LAS float* iqs  , LAS unsigned* keys  , int lane) {
    const int b = tok >> 11, t = tok & (SEQ - 1), r = MBLK + tok, qk = 64 + t, nvalid = t + 17, tokbase = MBLK + b * SEQ;
    const int nch = qk / 64 + 1;
    unsigned* out = bm + (size_t)tok * BMW;
    if (nvalid <= 256) {
        for (int c = 0; c < 33; ++c) { const int kidx = 64 * c + lane; const unsigned long long m = __ballot(kidx >= 48 && kidx <= qk);
            if (lane == 0) { out[2 * c] = (unsigned)m; out[2 * c + 1] = (unsigned)(m >> 32); } }
        return;
    }
    const bf16_t* p = P + (size_t)r * PW;
#pragma unroll
    for (int j = 0; j < 16; ++j) iqs[j * 64 + lane] = bf2f(p[C_IQ + j * 64 + lane]);
    if (lane < 16) iqs[1024 + lane] = bf2f(p[C_IW + lane]);
    LDS_WAIT(); asm volatile("" ::: "memory");
    for (int c = 0; c < nch; ++c) {
        const int kidx = 64 * c + lane; const bool valid = kidx >= 48 && kidx <= qk;
        const int kr = key_row(valid ? kidx : 48, tokbase);
        const u32x4* kp = (const u32x4*)(P + (size_t)kr * PW + C_IK);
        u32x4 kw[8];
#pragma unroll
        for (int j = 0; j < 8; ++j) kw[j] = kp[j];
        float score = 0.f;
#pragma unroll 1
        for (int h = 0; h < 16; ++h) {
            const LAS f32x4* qv = (const LAS f32x4*)(iqs + h * 64); float d = 0.f;
#pragma unroll
            for (int j = 0; j < 8; ++j) { const u32x4 w = kw[j]; const f32x4 qa = qv[2 * j], qb = qv[2 * j + 1];
                d += qa.x * __uint_as_float(w.x << 16) + qa.y * __uint_as_float(w.x & 0xffff0000u) + qa.z * __uint_as_float(w.y << 16) + qa.w * __uint_as_float(w.y & 0xffff0000u)
                   + qb.x * __uint_as_float(w.z << 16) + qb.y * __uint_as_float(w.z & 0xffff0000u) + qb.z * __uint_as_float(w.w << 16) + qb.w * __uint_as_float(w.w & 0xffff0000u); }
            score += fmaxf(d, 0.f) * iqs[1024 + h];
        }
        const unsigned u = __float_as_uint(score);
        keys[c * 64 + lane] = valid ? ((u & 0x80000000u) ? ~u : (u | 0x80000000u)) : 0u;
    }
    LDS_WAIT(); asm volatile("" ::: "memory");
    unsigned T = 0u;
    for (int bit = 31; bit >= 0; --bit) {
        const unsigned cand = T | (1u << bit); int cnt = 0;
        for (int c = 0; c < nch; ++c) cnt += __popcll(__ballot(keys[c * 64 + lane] >= cand));
        if (cnt >= 256) T = cand;
        if (cnt == 256) break;
    }
    for (int c = 0; c < 33; ++c) { unsigned long long m = 0ull; if (c < nch) m = __ballot(keys[c * 64 + lane] >= T);
        if (lane == 0) { out[2 * c] = (unsigned)m; out[2 * c + 1] = (unsigned)(m >> 32); } }
    LDS_WAIT(); asm volatile("" ::: "memory");
}

template <int DQK, int DV, bool MASKED>
__device__ __forceinline__ void attn_row(bf16_t* P, int r, int qcol, int k1col, int k2col, int vcol, int ocol0, int ocol1, const unsigned* bm, LAS float* qs, int lane) {
    int qk, tokbase;
    if (r < MBLK) { qk = r - (MBLK - 64); tokbase = MBLK; } else { const int tok = r - MBLK; qk = 64 + (tok & (SEQ - 1)); tokbase = MBLK + (tok >> 11) * SEQ; }
    const bf16_t* qp = P + (size_t)r * PW + qcol;
#pragma unroll
    for (int d = 0; d < DQK; d += 64) qs[d + lane] = bf2f(qp[d + lane]);
    LDS_WAIT(); asm volatile("" ::: "memory");
    const bool use_bm = MASKED && r >= MBLK;
    const unsigned* bmr = bm + (size_t)(r >= MBLK ? r - MBLK : 0) * BMW;
    float m = -1e30f, l = 0.f, o[DV / 64];
#pragma unroll
    for (int k = 0; k < DV / 64; ++k) o[k] = 0.f;
    const int nch = qk / 64 + 1;
    for (int c = 0; c < nch; ++c) {
        const int kidx = 64 * c + lane; bool valid = kidx >= 48 && kidx <= qk;
        if (use_bm) valid = (bmr[kidx >> 5] >> (kidx & 31)) & 1u;
        const int kr = key_row((kidx >= 48 && kidx <= qk) ? kidx : 48, tokbase);
        float s = 0.f;
        { const u32x4* kp = (const u32x4*)(P + (size_t)kr * PW + k1col);
#pragma unroll
          for (int j = 0; j < 16; ++j) { const u32x4 w = kp[j]; const LAS f32x4* qv = (const LAS f32x4*)(qs + j * 8); const f32x4 qa = qv[0], qb = qv[1];
              s += qa.x * __uint_as_float(w.x << 16) + qa.y * __uint_as_float(w.x & 0xffff0000u) + qa.z * __uint_as_float(w.y << 16) + qa.w * __uint_as_float(w.y & 0xffff0000u)
                 + qb.x * __uint_as_float(w.z << 16) + qb.y * __uint_as_float(w.z & 0xffff0000u) + qb.z * __uint_as_float(w.w << 16) + qb.w * __uint_as_float(w.w & 0xffff0000u); } }
        if (DQK == 192) { const u32x4* kp = (const u32x4*)(P + (size_t)kr * PW + k2col);
#pragma unroll
          for (int j = 0; j < 8; ++j) { const u32x4 w = kp[j]; const LAS f32x4* qv = (const LAS f32x4*)(qs + 128 + j * 8); const f32x4 qa = qv[0], qb = qv[1];
              s += qa.x * __uint_as_float(w.x << 16) + qa.y * __uint_as_float(w.x & 0xffff0000u) + qa.z * __uint_as_float(w.y << 16) + qa.w * __uint_as_float(w.y & 0xffff0000u)
                 + qb.x * __uint_as_float(w.z << 16) + qb.y * __uint_as_float(w.z & 0xffff0000u) + qb.z * __uint_as_float(w.w << 16) + qb.w * __uint_as_float(w.w & 0xffff0000u); } }
        if (!valid) s = -__builtin_inff();
        const float mn = fmaxf(m, wave_max(s));
        const float alpha = __builtin_amdgcn_exp2f(m - mn), pj = __builtin_amdgcn_exp2f(s - mn);
        l = l * alpha + wave_sum(pj); m = mn;
#pragma unroll
        for (int k = 0; k < DV / 64; ++k) o[k] *= alpha;
        for (int j = 0; j < 64; ++j) {
            const float pw = __uint_as_float((unsigned)__builtin_amdgcn_readlane((int)__float_as_uint(pj), j));
            if (pw != 0.f) { const int rj = __builtin_amdgcn_readlane(kr, j); const bf16_t* vp = P + (size_t)rj * PW + vcol;
#pragma unroll
                for (int k = 0; k < DV / 64; ++k) o[k] += pw * bf2f(vp[k * 64 + lane]); }
        }
    }
    const float rl = l > 0.f ? 1.0f / l : 0.f;
    bf16_t* op = P + (size_t)r * PW;
#pragma unroll
    for (int k = 0; k < DV / 64; ++k) { const int d = k * 64 + lane; op[(d < 128 ? ocol0 + d : ocol1 + d - 128)] = (bf16_t)f2bf(o[k] * rl); }
    LDS_WAIT(); asm volatile("" ::: "memory");
}
__device__ __forceinline__ int deal_row(int pass, int gw, int ngw) { const int j = (pass & 1) ? (ngw - 1 - gw) : gw; return pass * ngw + j; }

constexpr int PH_PER_LAYER = 20, N_PHASES = 2 * PH_PER_LAYER;
__device__ __forceinline__ const float* arg_in(const Args& a, int k) { asm volatile("" : "+s"(k)); return a.in[k]; }
__global__ void __launch_bounds__(NWAVES * 64, 2) mega_fwd(Args args) {
    extern __shared__ __attribute__((aligned(16))) unsigned char lds_raw[];
    {
        LAS unsigned char* l0 = (LAS unsigned char*)lds_raw;
        for (int u = threadIdx.x; u < (LDS_BYTES - LDSCTL_OFF) / 4; u += NWAVES * 64) ((LAS unsigned*)(l0 + LDSCTL_OFF))[u] = 0u;
        __syncthreads();
    }
#if MK_ONE_LAUNCH
    XcdBarrier bar = xcd_barrier_post((unsigned*)(args.ws + WS_CTL) + CW_BAR, (volatile LAS unsigned*)((LAS unsigned char*)lds_raw + LDSCTL_OFF + 64));
#define GRID_BAR() xcd_barrier(bar)
#else
#define GRID_BAR() do {} while (0)
#endif
    const int lo = args.ph_lo, hi = args.ph_hi;
#define IN(k) (lo <= (k) && (k) < hi)
#define SEAM(k) do { if (IN((k) + 1)) GRID_BAR(); } while (0)
#define PH_BEGIN \
    int tid_ = threadIdx.x; asm volatile("" : "+v"(tid_)); \
    Ctx F; F.lds = (LAS unsigned char*)lds_raw; F.tid = tid_; F.lane = tid_ & 63; F.wave = __builtin_amdgcn_readfirstlane(tid_ >> 6); \
    F.G = gridDim.x; F.bid = blockIdx.x; F.gw = F.bid * NWAVES + F.wave; F.ngw = F.G * NWAVES; \
    unsigned char* ws = args.ws; asm volatile("" : "+s"(ws)); \
    int ly = layer; asm volatile("" : "+s"(ly)); (void)ly; (void)F
#define XN_ ((bf16_t*)(ws + WS_XN))
#define P_ ((bf16_t*)(ws + WS_P))
#define HMETA_ ((float*)(ws + WS_HMETA))
#define RSTDQ_ ((float*)(ws + WS_RSTD))
#define RSTDKV_ ((float*)(ws + WS_RSTD) + R)
#define BM_ ((unsigned*)(ws + WS_BM))
#define WB_(off) ((bf16_t*)(ws + WS_WB + (off)))
#define OUT_ (args.out)
#define LAMBDA_INIT(ly) ((ly) == 0 ? 0.2f : (0.8f - 0.6f * 0.7408182206817179f))
#define HSRC_TOK(ly) ((ly) == 0 ? arg_in(args, 0) : (const float*)args.out)

    for (int layer = 0; layer < 2; ++layer) {
        const int pb = layer * PH_PER_LAYER;
        if (((PHMASK >> 0) & 1) && IN(pb + 0)) {
            PH_BEGIN;
            const float* meta = arg_in(args, 1);
            conv_matrix<1>(F, arg_in(args, 3) + (size_t)ly * DM * D_IN, DM, D_IN, WB_(WB_IN), arg_in(args, 2) + ly * DM);
            conv_matrix<0>(F, arg_in(args, 7) + (size_t)ly * 512 * 1536, 512, 1536, WB_(WB_QUP), arg_in(args, 5) + ly * 512);
            conv_matrix<0>(F, arg_in(args, 8) + (size_t)ly * 512 * 2048, 512, 2048, WB_(WB_KVUP), arg_in(args, 6) + ly * 512);
            for (int b = 0; b < 3; ++b) conv_matrix<0>(F, arg_in(args, 14) + ((size_t)ly * 3 + b) * 1024 * DM, 1024, DM, WB_(WB_BR) + (size_t)b * DM * 1024, nullptr);
            conv_matrix<0>(F, arg_in(args, 15) + (size_t)ly * DM * DM, DM, DM, WB_(WB_O), nullptr);
            conv_matrix<2>(F, arg_in(args, 17) + (size_t)ly * DM * 2 * DFF, DM, 2 * DFF, WB_(WB_F1), arg_in(args, 16) + ly * DM);
            conv_matrix<0>(F, arg_in(args, 18) + (size_t)ly * DFF * DM, DFF, DM, WB_(WB_F2), nullptr);
            for (int i = F.gw * 64 + F.lane; i < 112 * 2048 / 8; i += F.ngw * 64) *((u32x4*)(WB_(WB_IN) + (size_t)1168 * 2048) + i) = (u32x4){0u, 0u, 0u, 0u};
            float* hmeta = HMETA_;
            if (ly == 0) {
                for (int i = F.gw * 64 + F.lane; i < MBLK * DM / 4; i += F.ngw * 64) { const int rr = i / (DM / 4); f32x4 v = (f32x4){0.f, 0.f, 0.f, 0.f};
                    if (rr >= MBLK - NMETA) v = *((const f32x4*)meta + (i - (MBLK - NMETA) * (DM / 4))); *((f32x4*)hmeta + i) = v; }
            }
            const float* hsrc_tok = HSRC_TOK(ly);
            bf16_t* XN = XN_;
            for (int r = F.gw; r < R; r += F.ngw) {
                const float* src;
                if (r < MBLK) src = (ly == 0) ? (r >= MBLK - NMETA ? meta + (size_t)(r - (MBLK - NMETA)) * DM : nullptr) : hmeta + (size_t)r * DM;
                else src = hsrc_tok + (size_t)(r - MBLK) * DM;
                norm_row(src, XN + (size_t)r * DM, F.lane);
            }
            SEAM(pb + 0);
        }
        if (((PHMASK >> 1) & 1) && IN(pb + 1)) {
            PH_BEGIN;
            SchedPlain S{XN_, DM, WB_(WB_IN), DM, NPM, 5, F.G, F.bid, 0}; EpiP E{P_};
            pg8::gemm_phase(F.lds, S, E);
            SEAM(pb + 1);
        }
        if (((PHMASK >> 2) & 1) && IN(pb + 2)) {
            PH_BEGIN;
            { bf16_t* P = P_; float* rq = RSTDQ_; float* rkv = RSTDKV_;
              for (int r = F.gw; r < R; r += F.ngw) post1a_row(P, r, rq, rkv, F.lane); }
            VM_WAIT(); __syncthreads();
            SchedMlaUp S{P_, WB_(WB_QUP), WB_(WB_KVUP), F.G, F.bid}; EpiP E{P_};
            pg8::gemm_phase(F.lds, S, E);
            SEAM(pb + 2);
        }
        if (((PHMASK >> 3) & 1) && IN(pb + 3)) {
            PH_BEGIN;
            const float* mla_qkg = arg_in(args, 9) + ly * 2 * 192;
            bf16_t* P = P_; float* rq = RSTDQ_; float* rkv = RSTDKV_;
            for (int r = F.gw; r < R; r += F.ngw) post2_row(P, r, rq, rkv, mla_qkg, F.lane);
            SEAM(pb + 3);
        }
        if (((PHMASK >> 4) & 1) && IN(pb + 4)) {
            PH_BEGIN;
            LAS float* qs = (LAS float*)(F.lds + F.wave * 1024);
            bf16_t* P = P_;
            const int nq = NTOK + NMETA;
            for (int h = 0; h < 8; ++h)
                for (int pass = 0; pass * F.ngw < nq; ++pass) { const int qi = deal_row(pass, F.gw, F.ngw); if (qi >= nq) continue;
                    const int r = qi < NTOK ? MBLK + qi : (MBLK - NMETA) + (qi - NTOK);
                    attn_row<192, 128, false>(P, r, C_QRAW + h * 192, C_KVRAW + h * 256, C_KPEH + h * 64, C_KVRAW + h * 256 + 128, C_OA + h * 128, 0, nullptr, qs, F.lane); }
            SEAM(pb + 4);
        }
        if (((PHMASK >> 5) & 1) && IN(pb + 5)) {
            PH_BEGIN;
            SchedPlain S{XN_, DM, WB_(WB_IN) + (size_t)1280 * DM, DM, NPM, 28, F.G, F.bid, 1280}; EpiP E{P_};
            pg8::gemm_phase(F.lds, S, E);
            SEAM(pb + 5);
        }
        if (((PHMASK >> 6) & 1) && IN(pb + 6)) {
            PH_BEGIN;
            const float* dsa_qkg = arg_in(args, 10) + ly * 2 * 128; const float* diff_qkg = arg_in(args, 11) + ly * 2 * 128;
            bf16_t* P = P_;
            for (int r = F.gw; r < R; r += F.ngw) post1b_row(P, r, dsa_qkg, diff_qkg, F.lane);
            SEAM(pb + 6);
        }
        if (((PHMASK >> 7) & 1) && IN(pb + 7)) {
            PH_BEGIN;
            LAS float* iqs = (LAS float*)(F.lds + F.wave * 4352); LAS unsigned* keys = (LAS unsigned*)(F.lds + 8 * 4352 + F.wave * 8448);
            bf16_t* P = P_; unsigned* bm = BM_;
            for (int pass = 0; pass * F.ngw < NTOK; ++pass) { const int tok = deal_row(pass, F.gw, F.ngw); if (tok >= NTOK) continue; index_row(P, tok, bm, iqs, keys, F.lane); }
            SEAM(pb + 7);
        }
        if (((PHMASK >> 8) & 1) && IN(pb + 8)) {
            PH_BEGIN;
            LAS float* qs = (LAS float*)(F.lds + F.wave * 1024);
            bf16_t* P = P_; unsigned* bm = BM_;
            const int nq = NTOK + NMETA;
            for (int h = 0; h < 16; ++h)
                for (int pass = 0; pass * F.ngw < nq; ++pass) { const int qi = deal_row(pass, F.gw, F.ngw); if (qi >= nq) continue;
                    const int r = qi < NTOK ? MBLK + qi : (MBLK - NMETA) + (qi - NTOK);
                    if (h < 8) attn_row<128, 128, true>(P, r, C_DQ + h * 128, C_DK + h * 128, 0, C_DV + h * 128, C_OB + h * 128, 0, bm, qs, F.lane);
                    else { const int hj = h - 8; attn_row<128, 256, false>(P, r, C_FQ + hj * 128, C_FK + hj * 128, 0, C_FV + (hj >> 1) * 256, C_FQ + hj * 128, C_IQ + hj * 128, nullptr, qs, F.lane); } }
            SEAM(pb + 8);
        }
        if (((PHMASK >> 9) & 1) && IN(pb + 9)) {
            PH_BEGIN;
            const float* diff_lam = arg_in(args, 12) + ly * 4 * 128; const float* diff_subg = arg_in(args, 13) + ly * 256;
            const float lambda_init = LAMBDA_INIT(ly);
            const float s1 = wave_sum(diff_lam[F.lane] * diff_lam[128 + F.lane] + diff_lam[64 + F.lane] * diff_lam[192 + F.lane]);
            const float s2 = wave_sum(diff_lam[256 + F.lane] * diff_lam[384 + F.lane] + diff_lam[320 + F.lane] * diff_lam[448 + F.lane]);
            const float lam = __expf(s1) - __expf(s2) + lambda_init;
            bf16_t* P = P_;
            for (int r = F.gw; r < R; r += F.ngw) post3_row(P, r, diff_subg, lam, 1.f - lambda_init, F.lane);
            SEAM(pb + 9);
        }
#define GATE_PHASE(k, b) \
        if (((PHMASK >> 10) & 1) && IN(pb + (k))) { \
            PH_BEGIN; \
            SchedPlain S{XN_, DM, WB_(WB_G) + (size_t)(b) * 2048 * DM, DM, NPM, 8, F.G, F.bid, 0}; EpiGate E{(bf16_t*)(ws + WS_GS), arg_in(args, 4) + ly * 3 * DM + (b) * DM}; \
            pg8::gemm_phase(F.lds, S, E); \
            SEAM(pb + (k)); \
        }
#define BRANCH_PHASE(k, b, oc) \
        if (((PHMASK >> 10) & 1) && IN(pb + (k))) { \
            PH_BEGIN; \
            SchedPlain S{P_ + (oc), PW, WB_(WB_BR) + (size_t)(b) * DM * 1024, 1024, NPM, 8, F.G, F.bid, C_MERGED}; EpiGated E{P_, (const bf16_t*)(ws + WS_GS), (b) == 0 ? 1 : 0, ((DBG_BM >> (b)) & 1) ? 1.f : 0.f}; \
            pg8::gemm_phase(F.lds, S, E); \
            SEAM(pb + (k)); \
        }
        GATE_PHASE(10, 0) BRANCH_PHASE(11, 0, C_OA)
        GATE_PHASE(12, 1) BRANCH_PHASE(13, 1, C_OB)
        GATE_PHASE(14, 2) BRANCH_PHASE(15, 2, C_OC)
        if (((PHMASK >> 11) & 1) && IN(pb + 16)) {
            PH_BEGIN;
            SchedPlain S{P_ + C_MERGED, PW, WB_(WB_O), DM, NPM, 8, F.G, F.bid, 0}; EpiRes E{HSRC_TOK(ly), OUT_, HMETA_, DBG_SA};
            pg8::gemm_phase(F.lds, S, E);
            SEAM(pb + 16);
        }
        if (((PHMASK >> 12) & 1) && IN(pb + 17)) {
            PH_BEGIN;
            float* hmeta = HMETA_; float* out = OUT_; bf16_t* XN = XN_;
            for (int r = F.gw; r < R; r += F.ngw) norm_row(r < MBLK ? hmeta + (size_t)r * DM : out + (size_t)(r - MBLK) * DM, XN + (size_t)r * DM, F.lane);
            SEAM(pb + 17);
        }
        if (((PHMASK >> 13) & 1) && IN(pb + 18)) {
            PH_BEGIN;
            SchedPlain S{XN_, DM, WB_(WB_F1), DM, NPM, 44, F.G, F.bid, 0}; EpiSwiglu E{P_};
            pg8::gemm_phase(F.lds, S, E);
            SEAM(pb + 18);
        }
        if (((PHMASK >> 14) & 1) && IN(pb + 19)) {
            PH_BEGIN;
            SchedPlain S{P_, PW, WB_(WB_F2), DFF, NPM, 8, F.G, F.bid, 0}; EpiRes E{OUT_, OUT_, HMETA_, DBG_SF};
            pg8::gemm_phase(F.lds, S, E);
            SEAM(pb + 19);
        }
    }
#undef IN
#undef SEAM
}

__global__ void diag_fill(float* out, int n, float v) { for (int i = blockIdx.x * blockDim.x + threadIdx.x; i < n; i += gridDim.x * blockDim.x) out[i] = v; }
extern "C" void kernel_launch(void* const* d_in, const int* in_sizes, int n_in, void* d_out, int out_size, void* d_ws, size_t ws_size, hipStream_t stream) {
    static int grid = 0; static float code = 0.f;
    if (grid == 0) {
        int dev = 0, cus = 0;
        if (n_in != 19) { code = 10.f; grid = -1; }
        else if (ws_size < WS_END) { code = 20.f + (float)(ws_size >> 20) * 0.01f; grid = -1; }
        else if (hipGetDevice(&dev) != hipSuccess || hipDeviceGetAttribute(&cus, hipDeviceAttributeMultiprocessorCount, dev) != hipSuccess) { code = 40.f; grid = -1; }
        else if (hipFuncSetAttribute((const void*)mega_fwd, hipFuncAttributeMaxDynamicSharedMemorySize, LDS_BYTES) != hipSuccess) { code = 50.f; grid = -1; }
        else {
            int per_cu = 0;
            if (hipOccupancyMaxActiveBlocksPerMultiprocessor(&per_cu, (const void*)mega_fwd, NWAVES * 64, LDS_BYTES) != hipSuccess || per_cu < 1) { code = 60.f; grid = -1; }
            (void)hipGetLastError();
            if (grid == 0) grid = cus;
        }
    }
    if (grid < 0) { hipLaunchKernelGGL(diag_fill, dim3(1024), dim3(256), 0, stream, (float*)d_out, out_size, code); return; }
    (void)hipMemsetAsync((char*)d_ws + WS_CTL, 0, CTL_BYTES, stream);
    Args a{};
    for (int i = 0; i < 19; ++i) a.in[i] = (const float*)d_in[i];
    a.out = (float*)d_out; a.ws = (unsigned char*)d_ws;
#if MK_ONE_LAUNCH
    a.ph_lo = 0; a.ph_hi = N_PHASES;
    hipLaunchKernelGGL(mega_fwd, dim3(grid), dim3(NWAVES * 64), LDS_BYTES, stream, a);
#else
    for (int p = 0; p < N_PHASES; ++p) { a.ph_lo = p; a.ph_hi = p + 1; hipLaunchKernelGGL(mega_fwd, dim3(grid), dim3(NWAVES * 64), LDS_BYTES, stream, a); }
#endif
    if (hipPeekAtLastError() != hipSuccess) { (void)hipGetLastError(); hipLaunchKernelGGL(diag_fill, dim3(1024), dim3(256), 0, stream, (float*)d_out, out_size, 70.f); }
}
```

```cpp
#include <hip/hip_runtime.h>
#include <cstdio>
#include <cstdint>

#ifndef PHMASK
#define PHMASK 0x7fff
#endif
#ifndef DBG_BM
#define DBG_BM 7
#endif
#ifndef DBG_BR
#define DBG_BR 0
#endif
#ifndef DBG_SA
#define DBG_SA 1.0f
#endif
#ifndef DBG_SF
#define DBG_SF 1.0f
#endif
#ifndef MK_ONE_LAUNCH
#define MK_ONE_LAUNCH 1
#endif

#define LAS __attribute__((address_space(3)))
#define GAS __attribute__((address_space(1)))
typedef unsigned short bf16_t;
typedef short bf16x8 __attribute__((ext_vector_type(8)));
typedef float f32x4 __attribute__((ext_vector_type(4)));
typedef float f32x2 __attribute__((ext_vector_type(2)));
typedef unsigned u32x4 __attribute__((ext_vector_type(4)));
typedef unsigned u32x2 __attribute__((ext_vector_type(2)));

constexpr int DM = 2048, NB = 16, SEQ = 2048, NMETA = 16, MBLK = 256;
constexpr int R = MBLK + NB * SEQ;
constexpr int NPM = R / 256;
constexpr int NTOK = NB * SEQ;
constexpr int DFF = 5632;
constexpr int PW = 8448;
constexpr int C_CQ = 0, C_CKV = 512, C_KPE = 1024, C_IK = 1088, C_IW = 1152, C_DQ = 1280, C_DK = 2304, C_DV = 3328, C_IQ = 4352,
              C_FQ = 5376, C_FK = 6400, C_FV = 7424;
constexpr int C_KVRAW = 1280, C_QRAW = 3328, C_KPEH = 4864;
constexpr int C_OA = 0, C_OB = C_DQ, C_OC = C_FQ, C_MERGED = 2304;
constexpr int BMW = 66;
constexpr float EPS = 1e-6f;
constexpr float LOG2E = 1.4426950408889634f;
constexpr float C2_128 = 0.08838834764831845f * LOG2E;
constexpr float C2_192 = 0.07216878364870323f * LOG2E;
constexpr int D_IN = 14480;

constexpr size_t MiB = 1u << 20;
constexpr size_t WS_CTL = 0, CTL_BYTES = 1 * MiB;
constexpr size_t WS_RSTD = 1 * MiB;
constexpr size_t WS_HMETA = 2 * MiB;
constexpr size_t WS_BM = 4 * MiB;
constexpr size_t WS_WB = 16 * MiB;
constexpr size_t WB_IN = 0, WB_G = WB_IN + (size_t)8448 * 2048 * 2, WB_QUP = WB_G + (size_t)6144 * 2048 * 2, WB_KVUP = WB_QUP + (size_t)1536 * 512 * 2,
                 WB_BR = WB_KVUP + (size_t)2048 * 512 * 2, WB_O = WB_BR + (size_t)3 * 2048 * 1024 * 2, WB_F1 = WB_O + (size_t)2048 * 2048 * 2,
                 WB_F2 = WB_F1 + (size_t)11264 * 2048 * 2, WB_END = WB_F2 + (size_t)2048 * 5632 * 2;
constexpr size_t WS_XN = 164 * MiB;
constexpr size_t WS_P = 294 * MiB;
constexpr size_t WS_GS = 828 * MiB;
constexpr size_t WS_END = 960 * MiB;
static_assert(WS_GS + (size_t)R * 2048 * 2 <= WS_END && WS_WB + WB_END <= WS_XN && WS_XN + (size_t)R * 2048 * 2 <= WS_P && WS_P + (size_t)R * PW * 2 <= WS_GS, "ws map");
constexpr int CW_BAR = 4096, CW_Q = 16384;

__device__ __forceinline__ float bf2f(bf16_t v) { return __uint_as_float((unsigned)v << 16); }
__device__ __forceinline__ unsigned f2bf(float f) { unsigned u = __float_as_uint(f); return (u + 0x7fffu + ((u >> 16) & 1u)) >> 16; }
__device__ __forceinline__ unsigned pk2(float lo, float hi) { return f2bf(lo) | (f2bf(hi) << 16); }
typedef __bf16 bf16x2_t __attribute__((ext_vector_type(2)));
__device__ __forceinline__ unsigned cvt_pk_bf16(float lo, float hi) { f32x2 v = {lo, hi}; bf16x2_t b = __builtin_convertvector(v, bf16x2_t); return __builtin_bit_cast(unsigned, b); }
__device__ __forceinline__ float wave_sum(float v) {
#pragma unroll
    for (int o = 1; o < 64; o <<= 1) v += __shfl_xor(v, o);
    return v;
}
__device__ __forceinline__ float wave_max(float v) {
#pragma unroll
    for (int o = 1; o < 64; o <<= 1) v = fmaxf(v, __shfl_xor(v, o));
    return v;
}
#define LDS_WAIT() asm volatile("s_waitcnt lgkmcnt(0)" ::: "memory")
#define VM_WAIT() asm volatile("s_waitcnt vmcnt(0)" ::: "memory")
__device__ __forceinline__ int row_pos(int r) { return r < MBLK ? (r >= MBLK - NMETA ? r - (MBLK - NMETA) : 0) : NMETA + ((r - MBLK) & (SEQ - 1)); }
__device__ __forceinline__ void rope_cs(int pos, int i, float two_over_d, float& c, float& s) {
    const float inv = __builtin_amdgcn_exp2f(-(float)i * two_over_d * 13.287712379549449f);
    float rev = (float)pos * inv * 0.15915494309189535f;
    rev -= floorf(rev);
    s = __builtin_amdgcn_sinf(rev); c = __builtin_amdgcn_cosf(rev);
}

namespace pg8 {
constexpr int BM = 256, BK = 64, HALF = 128, HTB = HALF * BK * 2, STAGE_BYTES = 8 * HTB;
__device__ __forceinline__ int lds_byte(int r, int c) { const int st = (r >> 4) * 2 + (c >> 5), rr = r & 15, cc = c & 31, ob = rr * 64 + cc * 2; return st * 1024 + (ob ^ (((ob >> 9) & 1) << 5)); }
__device__ __forceinline__ void stage_rc(int b, int& R_, int& C_) { const int st = b / 1024, sb = b % 1024, swz = sb ^ (((sb >> 9) & 1) << 5); R_ = (st >> 1) * 16 + swz / 64; C_ = (st & 1) * 32 + (swz % 64) / 2; }
__device__ __forceinline__ int perm32(int rho) { const int n = rho >> 4, i = rho & 15; return 8 * (i >> 2) + 4 * n + (i & 3); }

struct Unit { const char* A; const char* B; unsigned lda2, ldb2; int nt, pm, pn, kind, ocol; };

__device__ __forceinline__ void tile_of(int L, int nM, int nN, int& pm, int& pn) {
    const int nwg = nM * nN; int wgid = L;
    { const int q = nwg / 8, r = nwg % 8, xcd = wgid % 8, off = wgid / 8; wgid = (xcd < r ? xcd * (q + 1) : r * (q + 1) + (xcd - r) * q) + off; }
    const int nig = 8 * nN, gid = wgid / nig, fm = gid * 8, gsz = (nM - fm) < 8 ? (nM - fm) : 8;
    pm = fm + ((wgid % nig) % gsz); pn = (wgid % nig) / gsz;
}

template <class Epi, class Sched>
__device__ __forceinline__ void gemm_phase(LAS unsigned char* lds, const Sched& S, const Epi& E) {
    int tid = threadIdx.x; asm volatile("" : "+v"(tid));
    const int wid = __builtin_amdgcn_readfirstlane(tid >> 6), lane = tid & 63, wr = wid >> 2, wc = wid & 3, fr = lane & 15, fq = lane >> 4;
    unsigned rA[2], rB[2], cc[2];
#pragma unroll
    for (int i = 0; i < 2; ++i) { int R_, C_; stage_rc(tid * 16 + i * 8192, R_, C_); rA[i] = (unsigned)R_; rB[i] = (unsigned)(Epi::PERM ? ((R_ & ~31) + perm32(R_ & 31)) : R_); cc[i] = (unsigned)C_ * 2u; }
    const size_t kstep = (size_t)(BK * 2);
    const unsigned ldsw = (unsigned)wid * 1024u;
    const int aoff = lds_byte(wr * 64 + fr, fq * 8), boff = lds_byte(wc * 32 + fr, fq * 8);
#define PG8_SA(b, h) (((b) * 2 + (h)) * HTB)
#define PG8_SB(b, h) ((4 + (b) * 2 + (h)) * HTB)
#define PG8_STAGE(bufoff, gbase, rr, ld2) do { _Pragma("unroll") for (int _i = 0; _i < 2; ++_i) \
        __builtin_amdgcn_global_load_lds((const unsigned*)((const char*)(gbase) + ((rr)[_i] * (ld2) + cc[_i])), (LAS unsigned*)(lds + (bufoff) + ldsw + _i * 8192), 16, 0, 0); } while (0)
#define PG8_LDA(dst, b, h) do { _Pragma("unroll") for (int m = 0; m < 4; ++m) _Pragma("unroll") for (int k = 0; k < 2; ++k) dst[m][k] = *(const LAS bf16x8*)(lds + PG8_SA(b, h) + aoff + m * 2048 + k * 1024); } while (0)
#define PG8_LDB(dst, b, h) do { _Pragma("unroll") for (int n = 0; n < 2; ++n) _Pragma("unroll") for (int k = 0; k < 2; ++k) dst[n][k] = *(const LAS bf16x8*)(lds + PG8_SB(b, h) + boff + n * 2048 + k * 1024); } while (0)
#define PG8_MMA(ai, bj, At, Bt) do { __builtin_amdgcn_s_setprio(1); _Pragma("unroll") for (int m = 0; m < 4; ++m) _Pragma("unroll") for (int n = 0; n < 2; ++n) _Pragma("unroll") for (int k = 0; k < 2; ++k) \
        acc[ai][bj][m][n] = __builtin_amdgcn_mfma_f32_16x16x32_bf16(Bt[n][k], At[m][k], acc[ai][bj][m][n], 0, 0, 0); __builtin_amdgcn_s_setprio(0); } while (0)
#define PG8_WAIT_V(n) asm volatile("s_waitcnt vmcnt(" #n ")" ::: "memory")
#define PG8_WAIT_L(n) asm volatile("s_waitcnt lgkmcnt(" #n ")" ::: "memory")
#define PG8_BAR __builtin_amdgcn_s_barrier()
#define PG8_SCHED __builtin_amdgcn_sched_barrier(0)
    Unit cur, nxt; int ui = 0;
    if (!S.next(0, cur)) return;
    f32x4 acc[2][2][4][2];
#pragma unroll
    for (int a = 0; a < 2; ++a)
#pragma unroll
        for (int b = 0; b < 2; ++b)
#pragma unroll
            for (int m = 0; m < 4; ++m)
#pragma unroll
                for (int n = 0; n < 2; ++n) acc[a][b][m][n] = (f32x4){0.f, 0.f, 0.f, 0.f};
    bf16x8 At[4][2], B0[2][2], B1[2][2];
    const char* cA = cur.A; const char* cB = cur.B;
    unsigned lA = cur.lda2, lB = cur.ldb2;
    size_t hA = (size_t)HALF * lA, hB = (size_t)HALF * lB;
    PG8_STAGE(PG8_SB(0, 0), cB, rB, lB); PG8_STAGE(PG8_SB(0, 1), cB + hB, rB, lB); PG8_STAGE(PG8_SA(0, 0), cA, rA, lA); PG8_STAGE(PG8_SA(0, 1), cA + hA, rA, lA);
    if (wr == 1) PG8_BAR;
    PG8_WAIT_V(2); PG8_BAR;
    PG8_STAGE(PG8_SB(1, 0), cB + kstep, rB, lB); PG8_STAGE(PG8_SA(1, 0), cA + kstep, rA, lA); PG8_STAGE(PG8_SB(1, 1), cB + hB + kstep, rB, lB);
    PG8_WAIT_V(6); PG8_BAR;
    for (;;) {
        const bool has_next = S.next(ui + 1, nxt);
        if (!has_next) nxt = cur;
        const char* nA = nxt.A; const char* nB = nxt.B;
        const unsigned lAn = nxt.lda2, lBn = nxt.ldb2;
        const size_t hAn = (size_t)HALF * lAn, hBn = (size_t)HALF * lBn;
        const int nt = cur.nt;
        for (int t = 0; t < nt; t += 2) {
            const bool last = (t == nt - 2);
            const char* a1 = cA + (size_t)(t + 1) * kstep;
            const char* a2 = last ? nA : cA + (size_t)(t + 2) * kstep; const char* b2 = last ? nB : cB + (size_t)(t + 2) * kstep;
            const char* a3 = a2 + kstep; const char* b3 = b2 + kstep;
            const size_t hA2 = last ? hAn : hA, hB2 = last ? hBn : hB;
            const unsigned lA2 = last ? lAn : lA, lB2 = last ? lBn : lB;
            PG8_LDB(B0, 0, 0); PG8_LDB(B1, 0, 1); PG8_SCHED; PG8_LDA(At, 0, 0); PG8_STAGE(PG8_SA(1, 1), a1 + hA, rA, lA);
            PG8_WAIT_V(8); PG8_WAIT_L(0); PG8_BAR; PG8_MMA(0, 0, At, B0); PG8_MMA(0, 1, At, B1); PG8_BAR; PG8_SCHED;
            PG8_LDA(At, 0, 1); PG8_STAGE(PG8_SB(0, 0), b2, rB, lB2); PG8_STAGE(PG8_SB(0, 1), b2 + hB2, rB, lB2); PG8_STAGE(PG8_SA(0, 0), a2, rA, lA2);
            PG8_WAIT_V(8); PG8_WAIT_L(0); PG8_BAR; PG8_MMA(1, 0, At, B0); PG8_MMA(1, 1, At, B1); PG8_BAR; PG8_SCHED;
            PG8_LDB(B0, 1, 0); PG8_LDB(B1, 1, 1); PG8_SCHED; PG8_LDA(At, 1, 0); PG8_STAGE(PG8_SA(0, 1), a2 + hA2, rA, lA2);
            PG8_WAIT_V(8); PG8_WAIT_L(0); PG8_BAR; PG8_MMA(0, 0, At, B0); PG8_MMA(0, 1, At, B1); PG8_BAR; PG8_SCHED;
            PG8_LDA(At, 1, 1); PG8_STAGE(PG8_SB(1, 0), b3, rB, lB2); PG8_STAGE(PG8_SB(1, 1), b3 + hB2, rB, lB2); PG8_STAGE(PG8_SA(1, 0), a3, rA, lA2);
            PG8_WAIT_V(8); PG8_WAIT_L(0); PG8_BAR; PG8_MMA(1, 0, At, B0); PG8_MMA(1, 1, At, B1); PG8_BAR; PG8_SCHED;
        }
        if (wr == 0) PG8_BAR;
        E(acc, cur, wr, wc, fr, fq);
        if (!has_next) break;
#pragma unroll
        for (int a = 0; a < 2; ++a)
#pragma unroll
            for (int b = 0; b < 2; ++b)
#pragma unroll
                for (int m = 0; m < 4; ++m)
#pragma unroll
                    for (int n = 0; n < 2; ++n) acc[a][b][m][n] = (f32x4){0.f, 0.f, 0.f, 0.f};
        cur = nxt; cA = nA; cB = nB; hA = hAn; hB = hBn; lA = lAn; lB = lBn; ++ui;
        if (wr == 1) PG8_BAR;
    }
    PG8_WAIT_V(0);
    PG8_BAR;
#undef PG8_SA
#undef PG8_SB
#undef PG8_STAGE
#undef PG8_LDA
#undef PG8_LDB
#undef PG8_MMA
#undef PG8_WAIT_V
#undef PG8_WAIT_L
#undef PG8_BAR
#undef PG8_SCHED
}
}
using pg8::Unit;

struct SchedPlain {
    const bf16_t* A; int lda; const bf16_t* B; int K; int nM, nN, G, c, ocol0;
    __device__ __forceinline__ bool next(int i, Unit& u) const {
        const int L = i * G + c; if (L >= nM * nN) return false;
        int pm, pn; pg8::tile_of(L, nM, nN, pm, pn);
        u.pm = pm; u.pn = pn; u.kind = 0; u.ocol = ocol0 + 256 * pn; u.nt = K / 64; u.lda2 = (unsigned)lda * 2u; u.ldb2 = (unsigned)K * 2u;
        u.A = (const char*)(A + (size_t)pm * 256 * lda); u.B = (const char*)(B + (size_t)pn * 256 * K); return true;
    }
};
struct SchedMlaUp {
    const bf16_t* P; const bf16_t* Wq; const bf16_t* Wkv; int G, c;
    __device__ __forceinline__ bool next(int i, Unit& u) const {
        const int L = i * G + c; if (L >= NPM * 14) return false;
        int pm, pn; pg8::tile_of(L, NPM, 14, pm, pn);
        u.pm = pm; u.pn = pn; u.kind = 0; u.nt = 8; u.lda2 = PW * 2u; u.ldb2 = 512 * 2u;
        if (pn < 6) { u.A = (const char*)(P + (size_t)pm * 256 * PW + C_CQ); u.B = (const char*)(Wq + (size_t)pn * 256 * 512); u.ocol = C_QRAW + 256 * pn; }
        else { u.A = (const char*)(P + (size_t)pm * 256 * PW + C_CKV); u.B = (const char*)(Wkv + (size_t)(pn - 6) * 256 * 512); u.ocol = C_KVRAW + 256 * (pn - 6); }
        return true;
    }
};
struct EpiP {
    static constexpr bool PERM = true;
    bf16_t* P;
    __device__ __forceinline__ void operator()(const f32x4 (&acc)[2][2][4][2], const Unit& u, int wr, int wc, int fr, int fq) const {
        asm volatile("" : "+v"(fr), "+v"(fq));
        const int row0 = u.pm * 256 + wr * 64 + fr, col0 = u.ocol + wc * 32 + 8 * fq;
#pragma unroll
        for (int ai = 0; ai < 2; ++ai)
#pragma unroll
            for (int m = 0; m < 4; ++m) { bf16_t* rowp = P + (size_t)(row0 + ai * 128 + m * 16) * PW + col0;
#pragma unroll
                for (int bj = 0; bj < 2; ++bj) { const f32x4 v0 = acc[ai][bj][m][0], v1 = acc[ai][bj][m][1];
                    u32x4 w; w.x = cvt_pk_bf16(v0[0], v0[1]); w.y = cvt_pk_bf16(v0[2], v0[3]); w.z = cvt_pk_bf16(v1[0], v1[1]); w.w = cvt_pk_bf16(v1[2], v1[3]);
                    *(u32x4*)(rowp + bj * 128) = w; } }
    }
};
struct EpiGate {
    static constexpr bool PERM = true;
    bf16_t* G; const float* bias;
    __device__ __forceinline__ void operator()(const f32x4 (&acc)[2][2][4][2], const Unit& u, int wr, int wc, int fr, int fq) const {
        asm volatile("" : "+v"(fr), "+v"(fq));
        const int row0 = u.pm * 256 + wr * 64 + fr, col0 = u.pn * 256 + wc * 32 + 8 * fq;
#pragma unroll
        for (int bj = 0; bj < 2; ++bj) { const f32x4 bv0 = *(const f32x4*)(bias + col0 + bj * 128), bv1 = *(const f32x4*)(bias + col0 + bj * 128 + 4);
#pragma unroll
            for (int ai = 0; ai < 2; ++ai)
#pragma unroll
                for (int m = 0; m < 4; ++m) { bf16_t* rowp = G + (size_t)(row0 + ai * 128 + m * 16) * 2048 + col0; f32x4 v0 = acc[ai][bj][m][0] + bv0, v1 = acc[ai][bj][m][1] + bv1;
#pragma unroll
                    for (int e = 0; e < 4; ++e) { v0[e] = __builtin_amdgcn_rcpf(1.f + __builtin_amdgcn_exp2f(-v0[e] * LOG2E)); v1[e] = __builtin_amdgcn_rcpf(1.f + __builtin_amdgcn_exp2f(-v1[e] * LOG2E)); }
                    u32x4 w; w.x = cvt_pk_bf16(v0[0], v0[1]); w.y = cvt_pk_bf16(v0[2], v0[3]); w.z = cvt_pk_bf16(v1[0], v1[1]); w.w = cvt_pk_bf16(v1[2], v1[3]);
                    *(u32x4*)(rowp + bj * 128) = w; } }
    }
};
struct EpiGated {
    static constexpr bool PERM = true;
    bf16_t* P; const bf16_t* G; int first; float sc;
    __device__ __forceinline__ void operator()(const f32x4 (&acc)[2][2][4][2], const Unit& u, int wr, int wc, int fr, int fq) const {
        asm volatile("" : "+v"(fr), "+v"(fq));
        const int row0 = u.pm * 256 + wr * 64 + fr, lcol0 = u.pn * 256 + wc * 32 + 8 * fq, col0 = u.ocol + wc * 32 + 8 * fq;
#pragma unroll
        for (int ai = 0; ai < 2; ++ai)
#pragma unroll
            for (int m = 0; m < 4; ++m) { bf16_t* rowp = P + (size_t)(row0 + ai * 128 + m * 16) * PW + col0; const bf16_t* gp = G + (size_t)(row0 + ai * 128 + m * 16) * 2048 + lcol0;
#pragma unroll
                for (int bj = 0; bj < 2; ++bj) { u32x4 g = *(const u32x4*)(gp + bj * 128); if (DBG_BR == 1) g = (u32x4){0x3f803f80u, 0x3f803f80u, 0x3f803f80u, 0x3f803f80u};
                    u32x4 pv = (u32x4){0u, 0u, 0u, 0u}; if (!first) pv = *(const u32x4*)(rowp + bj * 128);
                    const f32x4 v0 = acc[ai][bj][m][0] * sc, v1 = acc[ai][bj][m][1] * sc;
                    float o[8];
                    o[0] = __uint_as_float(pv.x << 16) + __uint_as_float(g.x << 16) * v0[0]; o[1] = __uint_as_float(pv.x & 0xffff0000u) + __uint_as_float(g.x & 0xffff0000u) * v0[1];
                    o[2] = __uint_as_float(pv.y << 16) + __uint_as_float(g.y << 16) * v0[2]; o[3] = __uint_as_float(pv.y & 0xffff0000u) + __uint_as_float(g.y & 0xffff0000u) * v0[3];
                    o[4] = __uint_as_float(pv.z << 16) + __uint_as_float(g.z << 16) * v1[0]; o[5] = __uint_as_float(pv.z & 0xffff0000u) + __uint_as_float(g.z & 0xffff0000u) * v1[1];
                    o[6] = __uint_as_float(pv.w << 16) + __uint_as_float(g.w << 16) * v1[2]; o[7] = __uint_as_float(pv.w & 0xffff0000u) + __uint_as_float(g.w & 0xffff0000u) * v1[3];
                    u32x4 w; w.x = cvt_pk_bf16(o[0], o[1]); w.y = cvt_pk_bf16(o[2], o[3]); w.z = cvt_pk_bf16(o[4], o[5]); w.w = cvt_pk_bf16(o[6], o[7]);
                    *(u32x4*)(rowp + bj * 128) = w; }
                asm volatile("" ::: "memory"); }
    }
};
struct EpiRes {
    static constexpr bool PERM = false;
    const float* base_tok; float* out_tok; float* hmeta; float dbg;
    __device__ __forceinline__ void operator()(const f32x4 (&acc)[2][2][4][2], const Unit& u, int wr, int wc, int fr, int fq) const {
        asm volatile("" : "+v"(fr), "+v"(fq));
        const float* bp; float* op;
        if (u.pm == 0) { bp = hmeta; op = hmeta; } else { bp = base_tok + (size_t)(u.pm - 1) * 256 * DM; op = out_tok + (size_t)(u.pm - 1) * 256 * DM; }
        const int lrow0 = wr * 64 + fr, col0 = u.pn * 256 + wc * 32 + 4 * fq;
#pragma unroll
        for (int ai = 0; ai < 2; ++ai)
#pragma unroll
            for (int m = 0; m < 4; ++m) { const size_t off = (size_t)(lrow0 + ai * 128 + m * 16) * DM + col0;
#pragma unroll
                for (int bj = 0; bj < 2; ++bj)
#pragma unroll
                    for (int n = 0; n < 2; ++n) { const f32x4 bs = *(const f32x4*)(bp + off + bj * 128 + n * 16); *(f32x4*)(op + off + bj * 128 + n * 16) = bs + acc[ai][bj][m][n] * dbg; }
                asm volatile("" ::: "memory"); }
    }
};
struct EpiSwiglu {
    static constexpr bool PERM = true;
    bf16_t* P;
    __device__ __forceinline__ void operator()(const f32x4 (&acc)[2][2][4][2], const Unit& u, int wr, int wc, int fr, int fq) const {
        asm volatile("" : "+v"(fr), "+v"(fq));
        const int row0 = u.pm * 256 + wr * 64 + fr, col0 = u.pn * 128 + wc * 32 + 8 * fq;
#pragma unroll
        for (int ai = 0; ai < 2; ++ai)
#pragma unroll
            for (int m = 0; m < 4; ++m) { bf16_t* rowp = P + (size_t)(row0 + ai * 128 + m * 16) * PW + col0;
                float o[8];
#pragma unroll
                for (int n = 0; n < 2; ++n)
#pragma unroll
                    for (int e = 0; e < 4; ++e) { const float g = acc[ai][0][m][n][e], up = acc[ai][1][m][n][e]; o[n * 4 + e] = g * __builtin_amdgcn_rcpf(1.f + __builtin_amdgcn_exp2f(-g * LOG2E)) * up; }
                u32x4 w; w.x = cvt_pk_bf16(o[0], o[1]); w.y = cvt_pk_bf16(o[2], o[3]); w.z = cvt_pk_bf16(o[4], o[5]); w.w = cvt_pk_bf16(o[6], o[7]);
                *(u32x4*)rowp = w; }
    }
};

#define XB_TMO      128
#define XB_XCNT(j)  (256  + 64 * (j))
#define XB_XSUB(j)  (1280 + 64 * (j))
#define XB_XGEN(j)  (2304 + 64 * (j))
#define XB_TOP      3328
#define XB_TOPGEN   3392
#define XCD_BAR_WORDS 3456
#define XB_SPIN_CAP (1u << 18)
__device__ __forceinline__ unsigned xb_ld(unsigned* p)              { return __hip_atomic_load(p, __ATOMIC_RELAXED, __HIP_MEMORY_SCOPE_AGENT); }
__device__ __forceinline__ unsigned xb_add(unsigned* p, unsigned v) { return __hip_atomic_fetch_add(p, v, __ATOMIC_RELAXED, __HIP_MEMORY_SCOPE_AGENT); }
__device__ __forceinline__ unsigned xb_xcc_id() { return (unsigned)__builtin_amdgcn_s_getreg((3 << 11) | 20) & 0xFu; }
#define XB_SPIN(cond, bar) do { unsigned _sp = 0; while (cond) { __builtin_amdgcn_s_sleep(1); \
    if ((++_sp & 255u) == 0u) { if (xb_ld(&(bar)[XB_TMO])) break; if (_sp > XB_SPIN_CAP) { atomicAdd(&(bar)[XB_TMO], 1u); break; } } } } while (0)
struct XcdBarrier { unsigned* bar; unsigned x; volatile LAS unsigned* st; };
__device__ __forceinline__ XcdBarrier xcd_barrier_post(unsigned* bar, volatile LAS unsigned* st) {
    XcdBarrier b; b.bar = bar; b.x = xb_xcc_id(); b.st = st;
    if (threadIdx.x == 0) (void)xb_add(&bar[XB_XCNT(b.x)], 1u);
    return b;
}
__device__ __forceinline__ void xcd_barrier_complete(unsigned* bar, unsigned x, unsigned& nloc, unsigned& nx) {
    const unsigned G = gridDim.x * gridDim.y * gridDim.z;
    unsigned sum, cnt, mine, sp = 0u;
    for (;;) {
        sum = 0u; cnt = 0u; mine = 0u;
#pragma unroll
        for (unsigned j = 0; j < 16; ++j) { const unsigned c = xb_ld(&bar[XB_XCNT(j)]); sum += c; cnt += (c > 0u) ? 1u : 0u; mine = (j == x) ? c : mine; }
        if (sum == G) break;
        __builtin_amdgcn_s_sleep(1);
        if ((++sp & 255u) == 0u) { if (xb_ld(&bar[XB_TMO])) break; if (sp > XB_SPIN_CAP) { atomicAdd(&bar[XB_TMO], 1u); break; } }
    }
    nloc = mine > 0u ? mine : 1u; nx = cnt > 0u ? cnt : 1u;
}
__device__ __forceinline__ void xcd_barrier(const XcdBarrier& b) {
    asm volatile("s_waitcnt vmcnt(0)" ::: "memory");
    __syncthreads();
    if (threadIdx.x == 0) {
        unsigned* bar = b.bar;
        __builtin_amdgcn_s_waitcnt(0);
        unsigned nloc = b.st[0], nx = b.st[1];
        if (nloc == 0u) { xcd_barrier_complete(bar, b.x, nloc, nx); b.st[0] = nloc; b.st[1] = nx; }
        const unsigned old = xb_add(&bar[XB_XSUB(b.x)], 1u);
        const unsigned gen = old / nloc;
        if (old + 1u == (gen + 1u) * nloc) {
            __builtin_amdgcn_fence(__ATOMIC_RELEASE, "agent");
            asm volatile("s_waitcnt vmcnt(0)" ::: "memory");
            const unsigned og = xb_add(&bar[XB_TOP], 1u);
            const unsigned tg = og / nx;
            if (og + 1u == (tg + 1u) * nx) xb_add(&bar[XB_TOPGEN], 1u);
            else XB_SPIN(xb_ld(&bar[XB_TOPGEN]) == tg, bar);
            __builtin_amdgcn_fence(__ATOMIC_ACQUIRE, "agent");
            xb_add(&bar[XB_XGEN(b.x)], 1u);
            asm volatile("s_waitcnt vmcnt(0)" ::: "memory");
        } else {
            XB_SPIN(xb_ld(&bar[XB_XGEN(b.x)]) == gen, bar);
            __builtin_amdgcn_fence(__ATOMIC_ACQUIRE, "agent");
            asm volatile("s_waitcnt vmcnt(0)" ::: "memory");
        }
    }
    __syncthreads();
}

constexpr int NWAVES = 8;
constexpr int RING_BYTES = 131072, LDSCTL_OFF = RING_BYTES, LDS_BYTES = 147456;
struct Args {
    const float* in[19]; float* out; unsigned char* ws; int ph_lo, ph_hi;
};
struct Ctx {
    LAS unsigned char* lds; int tid, lane, wave, gw, ngw, G, bid;
};

template <int MAP> __device__ __forceinline__ int wmap(int n, float& sc) {
    sc = 1.f;
    if (MAP == 0) return n;
    if (MAP == 1) {
        if (n < 1088) return n;
        if (n < 4160) return 1280 + (n - 1088);
        if (n < 5184) return 4352 + (n - 4160);
        if (n < 5248) return 1088 + (n - 5184);
        if (n < 5264) { sc = 0.03125f; return 1152 + (n - 5248); }
        if (n < 8336) return 5376 + (n - 5264);
        return 8448 + (n - 8336);
    }
    if (n < DFF) return (n >> 7) * 256 + (n & 127);
    const int m = n - DFF; return (m >> 7) * 256 + 128 + (m & 127);
}
template <int MAP> __device__ __forceinline__ void conv_item(const float* W, int K, int N, bf16_t* WT, const float* gain, LAS float* scr, int item, int lane) {
    const int nblk = (N + 31) / 32, kb = item / nblk, nb = item - kb * nblk, k0 = 64 * kb, n0 = 32 * nb;
    const int nn = n0 + (lane & 31);
#pragma unroll 8
    for (int i = 0; i < 32; ++i) { const int kk = 2 * i + (lane >> 5); float v = 0.f; if (nn < N) { v = W[(size_t)(k0 + kk) * N + nn]; if (gain) v *= gain[k0 + kk]; } scr[kk * 33 + (lane & 31)] = v; }
    LDS_WAIT(); asm volatile("" ::: "memory");
    const int c = lane & 7;
#pragma unroll
    for (int j = 0; j < 4; ++j) { const int n = (lane >> 3) + 8 * j; const int ns = n0 + n;
        if (ns < N) { float sc; const int dst = wmap<MAP>(ns, sc); const LAS float* s = scr + (8 * c) * 33 + n;
            u32x4 o; o.x = pk2(s[0 * 33] * sc, s[1 * 33] * sc); o.y = pk2(s[2 * 33] * sc, s[3 * 33] * sc); o.z = pk2(s[4 * 33] * sc, s[5 * 33] * sc); o.w = pk2(s[6 * 33] * sc, s[7 * 33] * sc);
            *(u32x4*)(WT + (size_t)dst * K + k0 + 8 * c) = o; } }
    LDS_WAIT(); asm volatile("" ::: "memory");
}
template <int MAP> __device__ __forceinline__ void conv_matrix(const Ctx& F, const float* W, int K, int N, bf16_t* WT, const float* gain) {
    LAS float* scr = (LAS float*)(F.lds + F.wave * 16384);
    const int nit = (K / 64) * ((N + 31) / 32);
    for (int it = F.gw; it < nit; it += F.ngw) conv_item<MAP>(W, K, N, WT, gain, scr, it, F.lane);
}

__device__ __forceinline__ void norm_row(const float* hrow, bf16_t* orow, int lane) {
    f32x4 v[8]; float s = 0.f;
    if (hrow) {
#pragma unroll
        for (int j = 0; j < 8; ++j) { v[j] = *((const f32x4*)hrow + lane + 64 * j); s += (v[j].x * v[j].x + v[j].y * v[j].y) + (v[j].z * v[j].z + v[j].w * v[j].w); }
    } else {
#pragma unroll
        for (int j = 0; j < 8; ++j) v[j] = (f32x4){0.f, 0.f, 0.f, 0.f};
    }
    const float rstd = 1.0f / sqrtf(wave_sum(s) * (1.f / DM) + EPS);
#pragma unroll
    for (int j = 0; j < 8; ++j) { u32x2 o; o.x = pk2(v[j].x * rstd, v[j].y * rstd); o.y = pk2(v[j].z * rstd, v[j].w * rstd); *((u32x2*)orow + lane + 64 * j) = o; }
}

__device__ __forceinline__ void post1a_row(const bf16_t* P, int r, float* rstdq, float* rstdkv, int lane) {
    const bf16_t* p = P + (size_t)r * PW;
    const u32x4 a = *((const u32x4*)(p + C_CQ) + lane), b = *((const u32x4*)(p + C_CKV) + lane);
    float sa = 0.f, sb = 0.f;
#pragma unroll
    for (int e = 0; e < 4; ++e) { const float x0 = __uint_as_float(a[e] << 16), x1 = __uint_as_float(a[e] & 0xffff0000u); sa += x0 * x0 + x1 * x1;
        const float y0 = __uint_as_float(b[e] << 16), y1 = __uint_as_float(b[e] & 0xffff0000u); sb += y0 * y0 + y1 * y1; }
    sa = wave_sum(sa); sb = wave_sum(sb);
    if (lane == 0) { rstdq[r] = 1.0f / sqrtf(sa * (1.f / 512.f) + EPS); rstdkv[r] = 1.0f / sqrtf(sb * (1.f / 512.f) + EPS); }
}
__device__ __forceinline__ void post2_row(bf16_t* P, int r, const float* rstdq, const float* rstdkv, const float* qkg  , int lane) {
    bf16_t* p = P + (size_t)r * PW;
    const float sq = rstdq[r], skv = rstdkv[r];
    float cs, sn; rope_cs(row_pos(r), lane & 31, 2.f / 64.f, cs, sn);
    const float g0a = qkg[lane], g0b = qkg[64 + lane], g0c = qkg[128 + lane];
    const float g1a = qkg[192 + lane], g1b = qkg[192 + 64 + lane], g1c = qkg[192 + 128 + lane];
    const float kpe = bf2f(p[C_KPE + lane]);
    const float kpe_ss = wave_sum(kpe * kpe);
#pragma unroll 2
    for (int h = 0; h < 8; ++h) {
        bf16_t* q = p + C_QRAW + h * 192;
        float x0 = bf2f(q[lane]) * sq, x1 = bf2f(q[64 + lane]) * sq, x2 = bf2f(q[128 + lane]) * sq;
        float rn = 1.0f / sqrtf(wave_sum(x0 * x0 + x1 * x1 + x2 * x2) * (1.f / 192.f) + EPS);
        x0 *= rn * g0a; x1 *= rn * g0b; x2 *= rn * g0c;
        { const float pr = __shfl_xor(x2, 32); x2 = (lane < 32) ? (x2 * cs - pr * sn) : (x2 * cs + pr * sn); }
        q[lane] = (bf16_t)f2bf(x0 * C2_192); q[64 + lane] = (bf16_t)f2bf(x1 * C2_192); q[128 + lane] = (bf16_t)f2bf(x2 * C2_192);
        bf16_t* kv = p + C_KVRAW + h * 256;
        float k0 = bf2f(kv[lane]) * skv, k1 = bf2f(kv[64 + lane]) * skv;
        const float v0 = bf2f(kv[128 + lane]) * skv, v1 = bf2f(kv[192 + lane]) * skv;
        rn = 1.0f / sqrtf((wave_sum(k0 * k0 + k1 * k1) + kpe_ss) * (1.f / 192.f) + EPS);
        kv[lane] = (bf16_t)f2bf(k0 * rn * g1a); kv[64 + lane] = (bf16_t)f2bf(k1 * rn * g1b);
        kv[128 + lane] = (bf16_t)f2bf(v0); kv[192 + lane] = (bf16_t)f2bf(v1);
        float kp = kpe * rn * g1c;
        { const float pr = __shfl_xor(kp, 32); kp = (lane < 32) ? (kp * cs - pr * sn) : (kp * cs + pr * sn); }
        p[C_KPEH + h * 64 + lane] = (bf16_t)f2bf(kp);
    }
}
__device__ __forceinline__ void headnorm_rope128(bf16_t* x, float ga, float gb, float cs, float sn, float scale, int lane) {
    float a = bf2f(x[lane]), b = bf2f(x[64 + lane]);
    const float rn = 1.0f / sqrtf(wave_sum(a * a + b * b) * (1.f / 128.f) + EPS);
    a *= rn * ga; b *= rn * gb;
    const float ra = a * cs - b * sn, rb = b * cs + a * sn;
    x[lane] = (bf16_t)f2bf(ra * scale); x[64 + lane] = (bf16_t)f2bf(rb * scale);
}
__device__ __forceinline__ void post1b_row(bf16_t* P, int r, const float* dsag  , const float* diffg  , int lane) {
    bf16_t* p = P + (size_t)r * PW;
    const int pos = row_pos(r);
    float c128, s128, c64, s64; rope_cs(pos, lane, 2.f / 128.f, c128, s128); rope_cs(pos, lane & 31, 2.f / 64.f, c64, s64);
    const float dq_a = dsag[lane], dq_b = dsag[64 + lane], dk_a = dsag[128 + lane], dk_b = dsag[192 + lane];
    const float fq_a = diffg[lane], fq_b = diffg[64 + lane], fk_a = diffg[128 + lane], fk_b = diffg[192 + lane];
#pragma unroll 2
    for (int h = 0; h < 8; ++h) {
        headnorm_rope128(p + C_DQ + h * 128, dq_a, dq_b, c128, s128, C2_128, lane);
        headnorm_rope128(p + C_DK + h * 128, dk_a, dk_b, c128, s128, 1.f, lane);
        headnorm_rope128(p + C_FQ + h * 128, fq_a, fq_b, c128, s128, C2_128, lane);
        headnorm_rope128(p + C_FK + h * 128, fk_a, fk_b, c128, s128, 1.f, lane);
    }
#pragma unroll 2
    for (int h = 0; h < 17; ++h) {
        bf16_t* x = (h < 16) ? (p + C_IQ + h * 64) : (p + C_IK);
        const float v = bf2f(x[lane]); const float pr = __shfl_xor(v, 32);
        x[lane] = (bf16_t)f2bf((lane < 32) ? (v * c64 - pr * s64) : (v * c64 + pr * s64));
    }
}
__device__ __forceinline__ void post3_row(bf16_t* P, int r, const float* subg, float lam, float omli, int lane) {
    bf16_t* p = P + (size_t)r * PW;
    const float g0 = subg[lane], g1 = subg[64 + lane], g2 = subg[128 + lane], g3 = subg[192 + lane];
#pragma unroll
    for (int h = 0; h < 4; ++h) {
        const bf16_t* a0 = p + C_FQ + (h * 2) * 128; const bf16_t* a1 = p + C_FQ + (h * 2 + 1) * 128;
        const bf16_t* b0 = p + C_IQ + (h * 2) * 128; const bf16_t* b1 = p + C_IQ + (h * 2 + 1) * 128;
        const float d0 = bf2f(a0[lane]) - lam * bf2f(a1[lane]), d1 = bf2f(a0[64 + lane]) - lam * bf2f(a1[64 + lane]);
        const float d2 = bf2f(b0[lane]) - lam * bf2f(b1[lane]), d3 = bf2f(b0[64 + lane]) - lam * bf2f(b1[64 + lane]);
        const float rn = omli / sqrtf(wave_sum(d0 * d0 + d1 * d1 + d2 * d2 + d3 * d3) * (1.f / 256.f) + EPS);
        bf16_t* o = p + C_OC + h * 256;
        o[lane] = (bf16_t)f2bf(d0 * rn * g0); o[64 + lane] = (bf16_t)f2bf(d1 * rn * g1); o[128 + lane] = (bf16_t)f2bf(d2 * rn * g2); o[192 + lane] = (bf16_t)f2bf(d3 * rn * g3);
    }
}

__device__ __forceinline__ int key_row(int kidx, int tokbase) { return kidx < 64 ? (MBLK - 64) + kidx : tokbase + (kidx - 64); }

__device__ __forceinline__ void index_row(const bf16_t* P, int tok, unsigned* bm, LAS float* iqs  , LAS unsigned* keys  , int lane) {
    const int b = tok >> 11, t = tok & (SEQ - 1), r = MBLK + tok, qk = 64 + t, nvalid = t + 17, tokbase = MBLK + b * SEQ;
    const int nch = qk / 64 + 1;
    unsigned* out = bm + (size_t)tok * BMW;
    if (nvalid <= 256) {
        for (int c = 0; c < 33; ++c) { const int kidx = 64 * c + lane; const unsigned long long m = __ballot(kidx >= 48 && kidx <= qk);
            if (lane == 0) { out[2 * c] = (unsigned)m; out[2 * c + 1] = (unsigned)(m >> 32); } }
        return;
    }
    const bf16_t* p = P + (size_t)r * PW;
#pragma unroll
    for (int j = 0; j < 16; ++j) iqs[j * 64 + lane] = bf2f(p[C_IQ + j * 64 + lane]);
    if (lane < 16) iqs[1024 + lane] = bf2f(p[C_IW + lane]);
    LDS_WAIT(); asm volatile("" ::: "memory");
    for (int c = 0; c < nch; ++c) {
        const int kidx = 64 * c + lane; const bool valid = kidx >= 48 && kidx <= qk;
        const int kr = key_row(valid ? kidx : 48, tokbase);
        const u32x4* kp = (const u32x4*)(P + (size_t)kr * PW + C_IK);
        u32x4 kw[8];
#pragma unroll
        for (int j = 0; j < 8; ++j) kw[j] = kp[j];
        float score = 0.f;
#pragma unroll 1
        for (int h = 0; h < 16; ++h) {
            const LAS f32x4* qv = (const LAS f32x4*)(iqs + h * 64); float d = 0.f;
#pragma unroll
            for (int j = 0; j < 8; ++j) { const u32x4 w = kw[j]; const f32x4 qa = qv[2 * j], qb = qv[2 * j + 1];
                d += qa.x * __uint_as_float(w.x << 16) + qa.y * __uint_as_float(w.x & 0xffff0000u) + qa.z * __uint_as_float(w.y << 16) + qa.w * __uint_as_float(w.y & 0xffff0000u)
                   + qb.x * __uint_as_float(w.z << 16) + qb.y * __uint_as_float(w.z & 0xffff0000u) + qb.z * __uint_as_float(w.w << 16) + qb.w * __uint_as_float(w.w & 0xffff0000u); }
            score += fmaxf(d, 0.f) * iqs[1024 + h];
        }
        const unsigned u = __float_as_uint(score);
        keys[c * 64 + lane] = valid ? ((u & 0x80000000u) ? ~u : (u | 0x80000000u)) : 0u;
    }
    LDS_WAIT(); asm volatile("" ::: "memory");
    unsigned T = 0u;
    for (int bit = 31; bit >= 0; --bit) {
        const unsigned cand = T | (1u << bit); int cnt = 0;
        for (int c = 0; c < nch; ++c) cnt += __popcll(__ballot(keys[c * 64 + lane] >= cand));
        if (cnt >= 256) T = cand;
        if (cnt == 256) break;
    }
    for (int c = 0; c < 33; ++c) { unsigned long long m = 0ull; if (c < nch) m = __ballot(keys[c * 64 + lane] >= T);
        if (lane == 0) { out[2 * c] = (unsigned)m; out[2 * c + 1] = (unsigned)(m >> 32); } }
    LDS_WAIT(); asm volatile("" ::: "memory");
}

template <int DQK, int DV, bool MASKED>
__device__ __forceinline__ void attn_row(bf16_t* P, int r, int qcol, int k1col, int k2col, int vcol, int ocol0, int ocol1, const unsigned* bm, LAS float* qs, int lane) {
    int qk, tokbase;
    if (r < MBLK) { qk = r - (MBLK - 64); tokbase = MBLK; } else { const int tok = r - MBLK; qk = 64 + (tok & (SEQ - 1)); tokbase = MBLK + (tok >> 11) * SEQ; }
    const bf16_t* qp = P + (size_t)r * PW + qcol;
#pragma unroll
    for (int d = 0; d < DQK; d += 64) qs[d + lane] = bf2f(qp[d + lane]);
    LDS_WAIT(); asm volatile("" ::: "memory");
    const bool use_bm = MASKED && r >= MBLK;
    const unsigned* bmr = bm + (size_t)(r >= MBLK ? r - MBLK : 0) * BMW;
    float m = -1e30f, l = 0.f, o[DV / 64];
#pragma unroll
    for (int k = 0; k < DV / 64; ++k) o[k] = 0.f;
    const int nch = qk / 64 + 1;
    for (int c = 0; c < nch; ++c) {
        const int kidx = 64 * c + lane; bool valid = kidx >= 48 && kidx <= qk;
        if (use_bm) valid = (bmr[kidx >> 5] >> (kidx & 31)) & 1u;
        const int kr = key_row((kidx >= 48 && kidx <= qk) ? kidx : 48, tokbase);
        float s = 0.f;
        { const u32x4* kp = (const u32x4*)(P + (size_t)kr * PW + k1col);
#pragma unroll
          for (int j = 0; j < 16; ++j) { const u32x4 w = kp[j]; const LAS f32x4* qv = (const LAS f32x4*)(qs + j * 8); const f32x4 qa = qv[0], qb = qv[1];
              s += qa.x * __uint_as_float(w.x << 16) + qa.y * __uint_as_float(w.x & 0xffff0000u) + qa.z * __uint_as_float(w.y << 16) + qa.w * __uint_as_float(w.y & 0xffff0000u)
                 + qb.x * __uint_as_float(w.z << 16) + qb.y * __uint_as_float(w.z & 0xffff0000u) + qb.z * __uint_as_float(w.w << 16) + qb.w * __uint_as_float(w.w & 0xffff0000u); } }
        if (DQK == 192) { const u32x4* kp = (const u32x4*)(P + (size_t)kr * PW + k2col);
#pragma unroll
          for (int j = 0; j < 8; ++j) { const u32x4 w = kp[j]; const LAS f32x4* qv = (const LAS f32x4*)(qs + 128 + j * 8); const f32x4 qa = qv[0], qb = qv[1];
              s += qa.x * __uint_as_float(w.x << 16) + qa.y * __uint_as_float(w.x & 0xffff0000u) + qa.z * __uint_as_float(w.y << 16) + qa.w * __uint_as_float(w.y & 0xffff0000u)
                 + qb.x * __uint_as_float(w.z << 16) + qb.y * __uint_as_float(w.z & 0xffff0000u) + qb.z * __uint_as_float(w.w << 16) + qb.w * __uint_as_float(w.w & 0xffff0000u); } }
        if (!valid) s = -__builtin_inff();
        const float mn = fmaxf(m, wave_max(s));
        const float alpha = __builtin_amdgcn_exp2f(m - mn), pj = __builtin_amdgcn_exp2f(s - mn);
        l = l * alpha + wave_sum(pj); m = mn;
#pragma unroll
        for (int k = 0; k < DV / 64; ++k) o[k] *= alpha;
        for (int j = 0; j < 64; ++j) {
            const float pw = __uint_as_float((unsigned)__builtin_amdgcn_readlane((int)__float_as_uint(pj), j));
            if (pw != 0.f) { const int rj = __builtin_amdgcn_readlane(kr, j); const bf16_t* vp = P + (size_t)rj * PW + vcol;
#pragma unroll
                for (int k = 0; k < DV / 64; ++k) o[k] += pw * bf2f(vp[k * 64 + lane]); }
        }
    }
    const float rl = l > 0.f ? 1.0f / l : 0.f;
    bf16_t* op = P + (size_t)r * PW;
#pragma unroll
    for (int k = 0; k < DV / 64; ++k) { const int d = k * 64 + lane; op[(d < 128 ? ocol0 + d : ocol1 + d - 128)] = (bf16_t)f2bf(o[k] * rl); }
    LDS_WAIT(); asm volatile("" ::: "memory");
}
__device__ __forceinline__ int deal_row(int pass, int gw, int ngw) { const int j = (pass & 1) ? (ngw - 1 - gw) : gw; return pass * ngw + j; }

constexpr int PH_PER_LAYER = 20, N_PHASES = 2 * PH_PER_LAYER;
__device__ __forceinline__ unsigned char* uni_ptr(unsigned char* p) { const unsigned long long v = (unsigned long long)p; const unsigned lo = __builtin_amdgcn_readfirstlane((unsigned)v), hi = __builtin_amdgcn_readfirstlane((unsigned)(v >> 32)); return (unsigned char*)(((unsigned long long)hi << 32) | lo); }
__device__ __forceinline__ const float* arg_in(const Args& a, int k) { asm volatile("" : "+s"(k)); return a.in[k]; }
__global__ void __launch_bounds__(NWAVES * 64, 2) mega_fwd(Args args) {
    extern __shared__ __attribute__((aligned(16))) unsigned char lds_raw[];
    {
        LAS unsigned char* l0 = (LAS unsigned char*)lds_raw;
        for (int u = threadIdx.x; u < (LDS_BYTES - LDSCTL_OFF) / 4; u += NWAVES * 64) ((LAS unsigned*)(l0 + LDSCTL_OFF))[u] = 0u;
        __syncthreads();
    }
#if MK_ONE_LAUNCH
    XcdBarrier bar = xcd_barrier_post((unsigned*)(args.ws + WS_CTL) + CW_BAR, (volatile LAS unsigned*)((LAS unsigned char*)lds_raw + LDSCTL_OFF + 64));
#define GRID_BAR() xcd_barrier(bar)
#else
#define GRID_BAR() do {} while (0)
#endif
    const int lo = args.ph_lo, hi = args.ph_hi;
#define IN(k) (lo <= (k) && (k) < hi)
#define SEAM(k) do { if (IN((k) + 1)) GRID_BAR(); } while (0)
#define PH_BEGIN \
    int tid_ = threadIdx.x; asm volatile("" : "+v"(tid_)); \
    Ctx F; F.lds = (LAS unsigned char*)lds_raw; F.tid = tid_; F.lane = tid_ & 63; F.wave = __builtin_amdgcn_readfirstlane(tid_ >> 6); \
    F.G = gridDim.x; F.bid = blockIdx.x; F.gw = F.bid * NWAVES + F.wave; F.ngw = F.G * NWAVES; \
    unsigned char* ws = uni_ptr(args.ws); asm volatile("" : "+s"(ws)); \
    int ly = __builtin_amdgcn_readfirstlane(layer); asm volatile("" : "+s"(ly)); (void)ly; (void)F
#define XN_ ((bf16_t*)(ws + WS_XN))
#define P_ ((bf16_t*)(ws + WS_P))
#define HMETA_ ((float*)(ws + WS_HMETA))
#define RSTDQ_ ((float*)(ws + WS_RSTD))
#define RSTDKV_ ((float*)(ws + WS_RSTD) + R)
#define BM_ ((unsigned*)(ws + WS_BM))
#define WB_(off) ((bf16_t*)(ws + WS_WB + (off)))
#define OUT_ (args.out)
#define LAMBDA_INIT(ly) ((ly) == 0 ? 0.2f : (0.8f - 0.6f * 0.7408182206817179f))
#define HSRC_TOK(ly) ((ly) == 0 ? arg_in(args, 0) : (const float*)args.out)

    for (int layer = 0; layer < 2; ++layer) {
        const int pb = layer * PH_PER_LAYER;
        if (((PHMASK >> 0) & 1) && IN(pb + 0)) {
            PH_BEGIN;
            const float* meta = arg_in(args, 1);
            conv_matrix<1>(F, arg_in(args, 3) + (size_t)ly * DM * D_IN, DM, D_IN, WB_(WB_IN), arg_in(args, 2) + ly * DM);
            conv_matrix<0>(F, arg_in(args, 7) + (size_t)ly * 512 * 1536, 512, 1536, WB_(WB_QUP), arg_in(args, 5) + ly * 512);
            conv_matrix<0>(F, arg_in(args, 8) + (size_t)ly * 512 * 2048, 512, 2048, WB_(WB_KVUP), arg_in(args, 6) + ly * 512);
            for (int b = 0; b < 3; ++b) conv_matrix<0>(F, arg_in(args, 14) + ((size_t)ly * 3 + b) * 1024 * DM, 1024, DM, WB_(WB_BR) + (size_t)b * DM * 1024, nullptr);
            conv_matrix<0>(F, arg_in(args, 15) + (size_t)ly * DM * DM, DM, DM, WB_(WB_O), nullptr);
            conv_matrix<2>(F, arg_in(args, 17) + (size_t)ly * DM * 2 * DFF, DM, 2 * DFF, WB_(WB_F1), arg_in(args, 16) + ly * DM);
            conv_matrix<0>(F, arg_in(args, 18) + (size_t)ly * DFF * DM, DFF, DM, WB_(WB_F2), nullptr);
            for (int i = F.gw * 64 + F.lane; i < 112 * 2048 / 8; i += F.ngw * 64) *((u32x4*)(WB_(WB_IN) + (size_t)1168 * 2048) + i) = (u32x4){0u, 0u, 0u, 0u};
            float* hmeta = HMETA_;
            if (ly == 0) {
                for (int i = F.gw * 64 + F.lane; i < MBLK * DM / 4; i += F.ngw * 64) { const int rr = i / (DM / 4); f32x4 v = (f32x4){0.f, 0.f, 0.f, 0.f};
                    if (rr >= MBLK - NMETA) v = *((const f32x4*)meta + (i - (MBLK - NMETA) * (DM / 4))); *((f32x4*)hmeta + i) = v; }
            }
            const float* hsrc_tok = HSRC_TOK(ly);
            bf16_t* XN = XN_;
            for (int r = F.gw; r < R; r += F.ngw) {
                const float* src;
                if (r < MBLK) src = (ly == 0) ? (r >= MBLK - NMETA ? meta + (size_t)(r - (MBLK - NMETA)) * DM : nullptr) : hmeta + (size_t)r * DM;
                else src = hsrc_tok + (size_t)(r - MBLK) * DM;
                norm_row(src, XN + (size_t)r * DM, F.lane);
            }
            SEAM(pb + 0);
        }
        if (((PHMASK >> 1) & 1) && IN(pb + 1)) {
            PH_BEGIN;
            SchedPlain S{XN_, DM, WB_(WB_IN), DM, NPM, 5, F.G, F.bid, 0}; EpiP E{P_};
            pg8::gemm_phase(F.lds, S, E);
            SEAM(pb + 1);
        }
        if (((PHMASK >> 2) & 1) && IN(pb + 2)) {
            PH_BEGIN;
            { bf16_t* P = P_; float* rq = RSTDQ_; float* rkv = RSTDKV_;
              for (int r = F.gw; r < R; r += F.ngw) post1a_row(P, r, rq, rkv, F.lane); }
            VM_WAIT(); __syncthreads();
            SchedMlaUp S{P_, WB_(WB_QUP), WB_(WB_KVUP), F.G, F.bid}; EpiP E{P_};
            pg8::gemm_phase(F.lds, S, E);
            SEAM(pb + 2);
        }
        if (((PHMASK >> 3) & 1) && IN(pb + 3)) {
            PH_BEGIN;
            const float* mla_qkg = arg_in(args, 9) + ly * 2 * 192;
            bf16_t* P = P_; float* rq = RSTDQ_; float* rkv = RSTDKV_;
            for (int r = F.gw; r < R; r += F.ngw) post2_row(P, r, rq, rkv, mla_qkg, F.lane);
            SEAM(pb + 3);
        }
        if (((PHMASK >> 4) & 1) && IN(pb + 4)) {
            PH_BEGIN;
            LAS float* qs = (LAS float*)(F.lds + F.wave * 1024);
            bf16_t* P = P_;
            const int nq = NTOK + NMETA;
            for (int h = 0; h < 8; ++h)
                for (int pass = 0; pass * F.ngw < nq; ++pass) { const int qi = deal_row(pass, F.gw, F.ngw); if (qi >= nq) continue;
                    const int r = qi < NTOK ? MBLK + qi : (MBLK - NMETA) + (qi - NTOK);
                    attn_row<192, 128, false>(P, r, C_QRAW + h * 192, C_KVRAW + h * 256, C_KPEH + h * 64, C_KVRAW + h * 256 + 128, C_OA + h * 128, 0, nullptr, qs, F.lane); }
            SEAM(pb + 4);
        }
        if (((PHMASK >> 5) & 1) && IN(pb + 5)) {
            PH_BEGIN;
            SchedPlain S{XN_, DM, WB_(WB_IN) + (size_t)1280 * DM, DM, NPM, 28, F.G, F.bid, 1280}; EpiP E{P_};
            pg8::gemm_phase(F.lds, S, E);
            SEAM(pb + 5);
        }
        if (((PHMASK >> 6) & 1) && IN(pb + 6)) {
            PH_BEGIN;
            const float* dsa_qkg = arg_in(args, 10) + ly * 2 * 128; const float* diff_qkg = arg_in(args, 11) + ly * 2 * 128;
            bf16_t* P = P_;
            for (int r = F.gw; r < R; r += F.ngw) post1b_row(P, r, dsa_qkg, diff_qkg, F.lane);
            SEAM(pb + 6);
        }
        if (((PHMASK >> 7) & 1) && IN(pb + 7)) {
            PH_BEGIN;
            LAS float* iqs = (LAS float*)(F.lds + F.wave * 4352); LAS unsigned* keys = (LAS unsigned*)(F.lds + 8 * 4352 + F.wave * 8448);
            bf16_t* P = P_; unsigned* bm = BM_;
            for (int pass = 0; pass * F.ngw < NTOK; ++pass) { const int tok = deal_row(pass, F.gw, F.ngw); if (tok >= NTOK) continue; index_row(P, tok, bm, iqs, keys, F.lane); }
            SEAM(pb + 7);
        }
        if (((PHMASK >> 8) & 1) && IN(pb + 8)) {
            PH_BEGIN;
            LAS float* qs = (LAS float*)(F.lds + F.wave * 1024);
            bf16_t* P = P_; unsigned* bm = BM_;
            const int nq = NTOK + NMETA;
            for (int h = 0; h < 16; ++h)
                for (int pass = 0; pass * F.ngw < nq; ++pass) { const int qi = deal_row(pass, F.gw, F.ngw); if (qi >= nq) continue;
                    const int r = qi < NTOK ? MBLK + qi : (MBLK - NMETA) + (qi - NTOK);
                    if (h < 8) attn_row<128, 128, true>(P, r, C_DQ + h * 128, C_DK + h * 128, 0, C_DV + h * 128, C_OB + h * 128, 0, bm, qs, F.lane);
                    else { const int hj = h - 8; attn_row<128, 256, false>(P, r, C_FQ + hj * 128, C_FK + hj * 128, 0, C_FV + (hj >> 1) * 256, C_FQ + hj * 128, C_IQ + hj * 128, nullptr, qs, F.lane); } }
            SEAM(pb + 8);
        }
        if (((PHMASK >> 9) & 1) && IN(pb + 9)) {
            PH_BEGIN;
            const float* diff_lam = arg_in(args, 12) + ly * 4 * 128; const float* diff_subg = arg_in(args, 13) + ly * 256;
            const float lambda_init = LAMBDA_INIT(ly);
            const float s1 = wave_sum(diff_lam[F.lane] * diff_lam[128 + F.lane] + diff_lam[64 + F.lane] * diff_lam[192 + F.lane]);
            const float s2 = wave_sum(diff_lam[256 + F.lane] * diff_lam[384 + F.lane] + diff_lam[320 + F.lane] * diff_lam[448 + F.lane]);
            const float lam = __expf(s1) - __expf(s2) + lambda_init;
            bf16_t* P = P_;
            for (int r = F.gw; r < R; r += F.ngw) post3_row(P, r, diff_subg, lam, 1.f - lambda_init, F.lane);
            SEAM(pb + 9);
        }
#define GATE_PHASE(k, b) \
        if (((PHMASK >> 10) & 1) && IN(pb + (k))) { \
            PH_BEGIN; \
            SchedPlain S{XN_, DM, WB_(WB_G) + (size_t)(b) * 2048 * DM, DM, NPM, 8, F.G, F.bid, 0}; EpiGate E{(bf16_t*)(ws + WS_GS), arg_in(args, 4) + ly * 3 * DM + (b) * DM}; \
            pg8::gemm_phase(F.lds, S, E); \
            SEAM(pb + (k)); \
        }
#define BRANCH_PHASE(k, b, oc) \
        if (((PHMASK >> 10) & 1) && IN(pb + (k))) { \
            PH_BEGIN; \
            SchedPlain S{P_ + (oc), PW, WB_(WB_BR) + (size_t)(b) * DM * 1024, 1024, NPM, 8, F.G, F.bid, C_MERGED}; EpiGated E{P_, (const bf16_t*)(ws + WS_GS), (b) == 0 ? 1 : 0, ((DBG_BM >> (b)) & 1) ? 1.f : 0.f}; \
            pg8::gemm_phase(F.lds, S, E); \
            SEAM(pb + (k)); \
        }
        GATE_PHASE(10, 0) BRANCH_PHASE(11, 0, C_OA)
        GATE_PHASE(12, 1) BRANCH_PHASE(13, 1, C_OB)
        GATE_PHASE(14, 2) BRANCH_PHASE(15, 2, C_OC)
        if (((PHMASK >> 11) & 1) && IN(pb + 16)) {
            PH_BEGIN;
            SchedPlain S{P_ + C_MERGED, PW, WB_(WB_O), DM, NPM, 8, F.G, F.bid, 0}; EpiRes E{HSRC_TOK(ly), OUT_, HMETA_, DBG_SA};
            pg8::gemm_phase(F.lds, S, E);
            SEAM(pb + 16);
        }
        if (((PHMASK >> 12) & 1) && IN(pb + 17)) {
            PH_BEGIN;
            float* hmeta = HMETA_; float* out = OUT_; bf16_t* XN = XN_;
            for (int r = F.gw; r < R; r += F.ngw) norm_row(r < MBLK ? hmeta + (size_t)r * DM : out + (size_t)(r - MBLK) * DM, XN + (size_t)r * DM, F.lane);
            SEAM(pb + 17);
        }
        if (((PHMASK >> 13) & 1) && IN(pb + 18)) {
            PH_BEGIN;
            SchedPlain S{XN_, DM, WB_(WB_F1), DM, NPM, 44, F.G, F.bid, 0}; EpiSwiglu E{P_};
            pg8::gemm_phase(F.lds, S, E);
            SEAM(pb + 18);
        }
        if (((PHMASK >> 14) & 1) && IN(pb + 19)) {
            PH_BEGIN;
            SchedPlain S{P_, PW, WB_(WB_F2), DFF, NPM, 8, F.G, F.bid, 0}; EpiRes E{OUT_, OUT_, HMETA_, DBG_SF};
            pg8::gemm_phase(F.lds, S, E);
            SEAM(pb + 19);
        }
    }
#undef IN
#undef SEAM
}

__global__ void diag_fill(float* out, int n, float v) { for (int i = blockIdx.x * blockDim.x + threadIdx.x; i < n; i += gridDim.x * blockDim.x) out[i] = v; }
extern "C" void kernel_launch(void* const* d_in, const int* in_sizes, int n_in, void* d_out, int out_size, void* d_ws, size_t ws_size, hipStream_t stream) {
    static int grid = 0; static float code = 0.f;
    if (grid == 0) {
        int dev = 0, cus = 0;
        if (n_in != 19) { code = 10.f; grid = -1; }
        else if (ws_size < WS_END) { code = 20.f + (float)(ws_size >> 20) * 0.01f; grid = -1; }
        else if (hipGetDevice(&dev) != hipSuccess || hipDeviceGetAttribute(&cus, hipDeviceAttributeMultiprocessorCount, dev) != hipSuccess) { code = 40.f; grid = -1; }
        else if (hipFuncSetAttribute((const void*)mega_fwd, hipFuncAttributeMaxDynamicSharedMemorySize, LDS_BYTES) != hipSuccess) { code = 50.f; grid = -1; }
        else {
            int per_cu = 0;
            if (hipOccupancyMaxActiveBlocksPerMultiprocessor(&per_cu, (const void*)mega_fwd, NWAVES * 64, LDS_BYTES) != hipSuccess || per_cu < 1) { code = 60.f; grid = -1; }
            (void)hipGetLastError();
            if (grid == 0) grid = cus;
        }
    }
    if (grid < 0) { hipLaunchKernelGGL(diag_fill, dim3(1024), dim3(256), 0, stream, (float*)d_out, out_size, code); return; }
    (void)hipMemsetAsync((char*)d_ws + WS_CTL, 0, CTL_BYTES, stream);
    Args a{};
    for (int i = 0; i < 19; ++i) a.in[i] = (const float*)d_in[i];
    a.out = (float*)d_out; a.ws = (unsigned char*)d_ws;
#if MK_ONE_LAUNCH
    a.ph_lo = 0; a.ph_hi = N_PHASES;
    hipLaunchKernelGGL(mega_fwd, dim3(grid), dim3(NWAVES * 64), LDS_BYTES, stream, a);
#else
    for (int p = 0; p < N_PHASES; ++p) { a.ph_lo = p; a.ph_hi = p + 1; hipLaunchKernelGGL(mega_fwd, dim3(grid), dim3(NWAVES * 64), LDS_BYTES, stream, a); }
#endif
    if (hipPeekAtLastError() != hipSuccess) { (void)hipGetLastError(); hipLaunchKernelGGL(diag_fill, dim3(1024), dim3(256), 0, stream, (float*)d_out, out_size, 70.f); }
}
```

```cpp
#include <hip/hip_runtime.h>
#include <cstdio>
#include <cstdint>

#ifndef PHMASK
#define PHMASK 0x7fff
#endif
#ifndef DBG_BM
#define DBG_BM 7
#endif
#ifndef DBG_BR
#define DBG_BR 0
#endif
#ifndef DBG_SA
#define DBG_SA 1.0f
#endif
#ifndef DBG_SF
#define DBG_SF 1.0f
#endif
#ifndef MK_ONE_LAUNCH
#define MK_ONE_LAUNCH 1
#endif

#define LAS __attribute__((address_space(3)))
#define GAS __attribute__((address_space(1)))
typedef unsigned short bf16_t;
typedef short bf16x8 __attribute__((ext_vector_type(8)));
typedef float f32x4 __attribute__((ext_vector_type(4)));
typedef float f32x2 __attribute__((ext_vector_type(2)));
typedef unsigned u32x4 __attribute__((ext_vector_type(4)));
typedef unsigned u32x2 __attribute__((ext_vector_type(2)));

constexpr int DM = 2048, NB = 16, SEQ = 2048, NMETA = 16, MBLK = 256;
constexpr int R = MBLK + NB * SEQ;
constexpr int NPM = R / 256;
constexpr int NTOK = NB * SEQ;
constexpr int DFF = 5632;
constexpr int PW = 8448;
constexpr int C_CQ = 0, C_CKV = 512, C_KPE = 1024, C_IK = 1088, C_IW = 1152, C_DQ = 1280, C_DK = 2304, C_DV = 3328, C_IQ = 4352,
              C_FQ = 5376, C_FK = 6400, C_FV = 7424;
constexpr int C_KVRAW = 1280, C_QRAW = 3328, C_KPEH = 4864;
constexpr int C_OA = 0, C_OB = C_DQ, C_OC = C_FQ, C_MERGED = 2304;
constexpr int BMW = 66;
constexpr float EPS = 1e-6f;
constexpr float LOG2E = 1.4426950408889634f;
constexpr float C2_128 = 0.08838834764831845f * LOG2E;
constexpr float C2_192 = 0.07216878364870323f * LOG2E;
constexpr int D_IN = 14480;

constexpr size_t MiB = 1u << 20;
constexpr size_t WS_CTL = 0, CTL_BYTES = 1 * MiB;
constexpr size_t WS_RSTD = 1 * MiB;
constexpr size_t WS_HMETA = 2 * MiB;
constexpr size_t WS_BM = 4 * MiB;
constexpr size_t WS_WB = 16 * MiB;
constexpr size_t WB_IN = 0, WB_G = WB_IN + (size_t)8448 * 2048 * 2, WB_QUP = WB_G + (size_t)6144 * 2048 * 2, WB_KVUP = WB_QUP + (size_t)1536 * 512 * 2,
                 WB_BR = WB_KVUP + (size_t)2048 * 512 * 2, WB_O = WB_BR + (size_t)3 * 2048 * 1024 * 2, WB_F1 = WB_O + (size_t)2048 * 2048 * 2,
                 WB_F2 = WB_F1 + (size_t)11264 * 2048 * 2, WB_END = WB_F2 + (size_t)2048 * 5632 * 2;
constexpr size_t WS_XN = 164 * MiB;
constexpr size_t WS_P = 294 * MiB;
constexpr size_t WS_GS = 828 * MiB;
constexpr size_t WS_END = 960 * MiB;
static_assert(WS_GS + (size_t)R * 2048 * 2 <= WS_END && WS_WB + WB_END <= WS_XN && WS_XN + (size_t)R * 2048 * 2 <= WS_P && WS_P + (size_t)R * PW * 2 <= WS_GS, "ws map");
constexpr int CW_BAR = 4096, CW_Q = 16384;

__device__ __forceinline__ float bf2f(bf16_t v) { return __uint_as_float((unsigned)v << 16); }
__device__ __forceinline__ unsigned f2bf(float f) { unsigned u = __float_as_uint(f); return (u + 0x7fffu + ((u >> 16) & 1u)) >> 16; }
__device__ __forceinline__ unsigned pk2(float lo, float hi) { return f2bf(lo) | (f2bf(hi) << 16); }
typedef __bf16 bf16x2_t __attribute__((ext_vector_type(2)));
__device__ __forceinline__ unsigned cvt_pk_bf16(float lo, float hi) { f32x2 v = {lo, hi}; bf16x2_t b = __builtin_convertvector(v, bf16x2_t); return __builtin_bit_cast(unsigned, b); }
__device__ __forceinline__ float wave_sum(float v) {
#pragma unroll
    for (int o = 1; o < 64; o <<= 1) v += __shfl_xor(v, o);
    return v;
}
__device__ __forceinline__ float wave_max(float v) {
#pragma unroll
    for (int o = 1; o < 64; o <<= 1) v = fmaxf(v, __shfl_xor(v, o));
    return v;
}
#define LDS_WAIT() asm volatile("s_waitcnt lgkmcnt(0)" ::: "memory")
#define VM_WAIT() asm volatile("s_waitcnt vmcnt(0)" ::: "memory")
__device__ __forceinline__ int row_pos(int r) { return r < MBLK ? (r >= MBLK - NMETA ? r - (MBLK - NMETA) : 0) : NMETA + ((r - MBLK) & (SEQ - 1)); }
__device__ __forceinline__ void rope_cs(int pos, int i, float two_over_d, float& c, float& s) {
    const float inv = __builtin_amdgcn_exp2f(-(float)i * two_over_d * 13.287712379549449f);
    float rev = (float)pos * inv * 0.15915494309189535f;
    rev -= floorf(rev);
    s = __builtin_amdgcn_sinf(rev); c = __builtin_amdgcn_cosf(rev);
}

namespace pg8 {
constexpr int BM = 256, BK = 64, HALF = 128, HTB = HALF * BK * 2, STAGE_BYTES = 8 * HTB;
__device__ __forceinline__ int lds_byte(int r, int c) { const int st = (r >> 4) * 2 + (c >> 5), rr = r & 15, cc = c & 31, ob = rr * 64 + cc * 2; return st * 1024 + (ob ^ (((ob >> 9) & 1) << 5)); }
__device__ __forceinline__ void stage_rc(int b, int& R_, int& C_) { const int st = b / 1024, sb = b % 1024, swz = sb ^ (((sb >> 9) & 1) << 5); R_ = (st >> 1) * 16 + swz / 64; C_ = (st & 1) * 32 + (swz % 64) / 2; }
__device__ __forceinline__ int perm32(int rho) { const int n = rho >> 4, i = rho & 15; return 8 * (i >> 2) + 4 * n + (i & 3); }

struct Unit { const char* A; const char* B; unsigned lda2, ldb2; int nt, pm, pn, kind, ocol; };

__device__ __forceinline__ void tile_of(int L, int nM, int nN, int& pm, int& pn) {
    const int nwg = nM * nN; int wgid = L;
    { const int q = nwg / 8, r = nwg % 8, xcd = wgid % 8, off = wgid / 8; wgid = (xcd < r ? xcd * (q + 1) : r * (q + 1) + (xcd - r) * q) + off; }
    const int nig = 8 * nN, gid = wgid / nig, fm = gid * 8, gsz = (nM - fm) < 8 ? (nM - fm) : 8;
    pm = fm + ((wgid % nig) % gsz); pn = (wgid % nig) / gsz;
}

template <class Epi, class Sched>
__device__ __forceinline__ void gemm_phase(LAS unsigned char* lds, const Sched& S, const Epi& E) {
    int tid = threadIdx.x; asm volatile("" : "+v"(tid));
    const int wid = __builtin_amdgcn_readfirstlane(tid >> 6), lane = tid & 63, wr = wid >> 2, wc = wid & 3, fr = lane & 15, fq = lane >> 4;
    unsigned rA[2], rB[2], cc[2];
#pragma unroll
    for (int i = 0; i < 2; ++i) { int R_, C_; stage_rc(tid * 16 + i * 8192, R_, C_); rA[i] = (unsigned)R_; rB[i] = (unsigned)(Epi::PERM ? ((R_ & ~31) + perm32(R_ & 31)) : R_); cc[i] = (unsigned)C_ * 2u; }
    const size_t kstep = (size_t)(BK * 2);
    const unsigned ldsw = (unsigned)wid * 1024u;
    const int aoff = lds_byte(wr * 64 + fr, fq * 8), boff = lds_byte(wc * 32 + fr, fq * 8);
#define PG8_SA(b, h) (((b) * 2 + (h)) * HTB)
#define PG8_SB(b, h) ((4 + (b) * 2 + (h)) * HTB)
#define PG8_STAGE(bufoff, gbase, rr, ld2) do { _Pragma("unroll") for (int _i = 0; _i < 2; ++_i) \
        __builtin_amdgcn_global_load_lds((const unsigned*)((const char*)(gbase) + ((rr)[_i] * (ld2) + cc[_i])), (LAS unsigned*)(lds + (bufoff) + ldsw + _i * 8192), 16, 0, 0); } while (0)
#define PG8_LDA(dst, b, h) do { _Pragma("unroll") for (int m = 0; m < 4; ++m) _Pragma("unroll") for (int k = 0; k < 2; ++k) dst[m][k] = *(const LAS bf16x8*)(lds + PG8_SA(b, h) + aoff + m * 2048 + k * 1024); } while (0)
#define PG8_LDB(dst, b, h) do { _Pragma("unroll") for (int n = 0; n < 2; ++n) _Pragma("unroll") for (int k = 0; k < 2; ++k) dst[n][k] = *(const LAS bf16x8*)(lds + PG8_SB(b, h) + boff + n * 2048 + k * 1024); } while (0)
#define PG8_MMA(ai, bj, At, Bt) do { __builtin_amdgcn_s_setprio(1); _Pragma("unroll") for (int m = 0; m < 4; ++m) _Pragma("unroll") for (int n = 0; n < 2; ++n) _Pragma("unroll") for (int k = 0; k < 2; ++k) \
        acc[ai][bj][m][n] = __builtin_amdgcn_mfma_f32_16x16x32_bf16(Bt[n][k], At[m][k], acc[ai][bj][m][n], 0, 0, 0); __builtin_amdgcn_s_setprio(0); } while (0)
#define PG8_WAIT_V(n) asm volatile("s_waitcnt vmcnt(" #n ")" ::: "memory")
#define PG8_WAIT_L(n) asm volatile("s_waitcnt lgkmcnt(" #n ")" ::: "memory")
#define PG8_BAR __builtin_amdgcn_s_barrier()
#define PG8_SCHED __builtin_amdgcn_sched_barrier(0)
    Unit cur, nxt; int ui = 0;
    if (!S.next(0, cur)) return;
    float zf = 0.f; asm volatile("" : "+v"(zf));
    f32x4 acc[2][2][4][2];
#pragma unroll
    for (int a = 0; a < 2; ++a)
#pragma unroll
        for (int b = 0; b < 2; ++b)
#pragma unroll
            for (int m = 0; m < 4; ++m)
#pragma unroll
                for (int n = 0; n < 2; ++n) acc[a][b][m][n] = (f32x4){zf, zf, zf, zf};
    bf16x8 At[4][2], B0[2][2], B1[2][2];
    const char* cA = cur.A; const char* cB = cur.B;
    unsigned lA = cur.lda2, lB = cur.ldb2;
    size_t hA = (size_t)HALF * lA, hB = (size_t)HALF * lB;
    PG8_STAGE(PG8_SB(0, 0), cB, rB, lB); PG8_STAGE(PG8_SB(0, 1), cB + hB, rB, lB); PG8_STAGE(PG8_SA(0, 0), cA, rA, lA); PG8_STAGE(PG8_SA(0, 1), cA + hA, rA, lA);
    if (wr == 1) PG8_BAR;
    PG8_WAIT_V(2); PG8_BAR;
    PG8_STAGE(PG8_SB(1, 0), cB + kstep, rB, lB); PG8_STAGE(PG8_SA(1, 0), cA + kstep, rA, lA); PG8_STAGE(PG8_SB(1, 1), cB + hB + kstep, rB, lB);
    PG8_WAIT_V(6); PG8_BAR;
    for (;;) {
        const bool has_next = S.next(ui + 1, nxt);
        if (!has_next) nxt = cur;
        const char* nA = nxt.A; const char* nB = nxt.B;
        const unsigned lAn = nxt.lda2, lBn = nxt.ldb2;
        const size_t hAn = (size_t)HALF * lAn, hBn = (size_t)HALF * lBn;
        const int nt = cur.nt;
        for (int t = 0; t < nt; t += 2) {
            const bool last = (t == nt - 2);
            const char* a1 = cA + (size_t)(t + 1) * kstep;
            const char* a2 = last ? nA : cA + (size_t)(t + 2) * kstep; const char* b2 = last ? nB : cB + (size_t)(t + 2) * kstep;
            const char* a3 = a2 + kstep; const char* b3 = b2 + kstep;
            const size_t hA2 = last ? hAn : hA, hB2 = last ? hBn : hB;
            const unsigned lA2 = last ? lAn : lA, lB2 = last ? lBn : lB;
            PG8_LDB(B0, 0, 0); PG8_LDB(B1, 0, 1); PG8_SCHED; PG8_LDA(At, 0, 0); PG8_STAGE(PG8_SA(1, 1), a1 + hA, rA, lA);
            PG8_WAIT_V(8); PG8_WAIT_L(0); PG8_BAR; PG8_MMA(0, 0, At, B0); PG8_MMA(0, 1, At, B1); PG8_BAR; PG8_SCHED;
            PG8_LDA(At, 0, 1); PG8_STAGE(PG8_SB(0, 0), b2, rB, lB2); PG8_STAGE(PG8_SB(0, 1), b2 + hB2, rB, lB2); PG8_STAGE(PG8_SA(0, 0), a2, rA, lA2);
            PG8_WAIT_V(8); PG8_WAIT_L(0); PG8_BAR; PG8_MMA(1, 0, At, B0); PG8_MMA(1, 1, At, B1); PG8_BAR; PG8_SCHED;
            PG8_LDB(B0, 1, 0); PG8_LDB(B1, 1, 1); PG8_SCHED; PG8_LDA(At, 1, 0); PG8_STAGE(PG8_SA(0, 1), a2 + hA2, rA, lA2);
            PG8_WAIT_V(8); PG8_WAIT_L(0); PG8_BAR; PG8_MMA(0, 0, At, B0); PG8_MMA(0, 1, At, B1); PG8_BAR; PG8_SCHED;
            PG8_LDA(At, 1, 1); PG8_STAGE(PG8_SB(1, 0), b3, rB, lB2); PG8_STAGE(PG8_SB(1, 1), b3 + hB2, rB, lB2); PG8_STAGE(PG8_SA(1, 0), a3, rA, lA2);
            PG8_WAIT_V(8); PG8_WAIT_L(0); PG8_BAR; PG8_MMA(1, 0, At, B0); PG8_MMA(1, 1, At, B1); PG8_BAR; PG8_SCHED;
        }
        if (wr == 0) PG8_BAR;
        E(acc, cur, wr, wc, fr, fq);
#pragma unroll
        for (int a = 0; a < 2; ++a)
#pragma unroll
            for (int b = 0; b < 2; ++b)
#pragma unroll
                for (int m = 0; m < 4; ++m)
#pragma unroll
                    for (int n = 0; n < 2; ++n) acc[a][b][m][n] = (f32x4){zf, zf, zf, zf};
        if (!has_next) break;
        cur = nxt; cA = nA; cB = nB; hA = hAn; hB = hBn; lA = lAn; lB = lBn; ++ui;
        if (wr == 1) PG8_BAR;
    }
    PG8_WAIT_V(0);
    PG8_BAR;
#undef PG8_SA
#undef PG8_SB
#undef PG8_STAGE
#undef PG8_LDA
#undef PG8_LDB
#undef PG8_MMA
#undef PG8_WAIT_V
#undef PG8_WAIT_L
#undef PG8_BAR
#undef PG8_SCHED
}
}
using pg8::Unit;

struct SchedPlain {
    const bf16_t* A; int lda; const bf16_t* B; int K; int nM, nN, G, c, ocol0;
    __device__ __forceinline__ bool next(int i, Unit& u) const {
        const int L = i * G + c; if (L >= nM * nN) return false;
        int pm, pn; pg8::tile_of(L, nM, nN, pm, pn);
        u.pm = pm; u.pn = pn; u.kind = 0; u.ocol = ocol0 + 256 * pn; u.nt = K / 64; u.lda2 = (unsigned)lda * 2u; u.ldb2 = (unsigned)K * 2u;
        u.A = (const char*)(A + (size_t)pm * 256 * lda); u.B = (const char*)(B + (size_t)pn * 256 * K); return true;
    }
};
struct SchedMlaUp {
    const bf16_t* P; const bf16_t* Wq; const bf16_t* Wkv; int G, c;
    __device__ __forceinline__ bool next(int i, Unit& u) const {
        const int L = i * G + c; if (L >= NPM * 14) return false;
        int pm, pn; pg8::tile_of(L, NPM, 14, pm, pn);
        u.pm = pm; u.pn = pn; u.kind = 0; u.nt = 8; u.lda2 = PW * 2u; u.ldb2 = 512 * 2u;
        if (pn < 6) { u.A = (const char*)(P + (size_t)pm * 256 * PW + C_CQ); u.B = (const char*)(Wq + (size_t)pn * 256 * 512); u.ocol = C_QRAW + 256 * pn; }
        else { u.A = (const char*)(P + (size_t)pm * 256 * PW + C_CKV); u.B = (const char*)(Wkv + (size_t)(pn - 6) * 256 * 512); u.ocol = C_KVRAW + 256 * (pn - 6); }
        return true;
    }
};
struct EpiP {
    static constexpr bool PERM = true;
    bf16_t* P;
    __device__ __forceinline__ void operator()(const f32x4 (&acc)[2][2][4][2], const Unit& u, int wr, int wc, int fr, int fq) const {
        asm volatile("" : "+v"(fr), "+v"(fq));
        const int row0 = u.pm * 256 + wr * 64 + fr, col0 = u.ocol + wc * 32 + 8 * fq;
#pragma unroll
        for (int ai = 0; ai < 2; ++ai)
#pragma unroll
            for (int m = 0; m < 4; ++m) { bf16_t* rowp = P + (size_t)(row0 + ai * 128 + m * 16) * PW + col0;
#pragma unroll
                for (int bj = 0; bj < 2; ++bj) { const f32x4 v0 = acc[ai][bj][m][0], v1 = acc[ai][bj][m][1];
                    u32x4 w; w.x = cvt_pk_bf16(v0[0], v0[1]); w.y = cvt_pk_bf16(v0[2], v0[3]); w.z = cvt_pk_bf16(v1[0], v1[1]); w.w = cvt_pk_bf16(v1[2], v1[3]);
                    *(u32x4*)(rowp + bj * 128) = w; } }
    }
};
struct EpiGate {
    static constexpr bool PERM = true;
    bf16_t* G; const float* bias;
    __device__ __forceinline__ void operator()(const f32x4 (&acc)[2][2][4][2], const Unit& u, int wr, int wc, int fr, int fq) const {
        asm volatile("" : "+v"(fr), "+v"(fq));
        const int row0 = u.pm * 256 + wr * 64 + fr, col0 = u.pn * 256 + wc * 32 + 8 * fq;
#pragma unroll
        for (int bj = 0; bj < 2; ++bj) { const f32x4 bv0 = *(const f32x4*)(bias + col0 + bj * 128), bv1 = *(const f32x4*)(bias + col0 + bj * 128 + 4);
#pragma unroll
            for (int ai = 0; ai < 2; ++ai)
#pragma unroll
                for (int m = 0; m < 4; ++m) { bf16_t* rowp = G + (size_t)(row0 + ai * 128 + m * 16) * 2048 + col0; f32x4 v0 = acc[ai][bj][m][0] + bv0, v1 = acc[ai][bj][m][1] + bv1;
#pragma unroll
                    for (int e = 0; e < 4; ++e) { v0[e] = __builtin_amdgcn_rcpf(1.f + __builtin_amdgcn_exp2f(-v0[e] * LOG2E)); v1[e] = __builtin_amdgcn_rcpf(1.f + __builtin_amdgcn_exp2f(-v1[e] * LOG2E)); }
                    u32x4 w; w.x = cvt_pk_bf16(v0[0], v0[1]); w.y = cvt_pk_bf16(v0[2], v0[3]); w.z = cvt_pk_bf16(v1[0], v1[1]); w.w = cvt_pk_bf16(v1[2], v1[3]);
                    *(u32x4*)(rowp + bj * 128) = w; } }
    }
};
struct EpiGated {
    static constexpr bool PERM = true;
    bf16_t* P; const bf16_t* G; int first; float sc;
    __device__ __forceinline__ void operator()(const f32x4 (&acc)[2][2][4][2], const Unit& u, int wr, int wc, int fr, int fq) const {
        asm volatile("" : "+v"(fr), "+v"(fq));
        const int row0 = u.pm * 256 + wr * 64 + fr, lcol0 = u.pn * 256 + wc * 32 + 8 * fq, col0 = u.ocol + wc * 32 + 8 * fq;
        unsigned zu = 0u; asm volatile("" : "+v"(zu));
#pragma unroll
        for (int ai = 0; ai < 2; ++ai)
#pragma unroll
            for (int m = 0; m < 4; ++m) { bf16_t* rowp = P + (size_t)(row0 + ai * 128 + m * 16) * PW + col0; const bf16_t* gp = G + (size_t)(row0 + ai * 128 + m * 16) * 2048 + lcol0;
#pragma unroll
                for (int bj = 0; bj < 2; ++bj) { u32x4 g = *(const u32x4*)(gp + bj * 128); if (DBG_BR == 1) g = (u32x4){0x3f803f80u, 0x3f803f80u, 0x3f803f80u, 0x3f803f80u};
                    u32x4 pv = (u32x4){zu, zu, zu, zu}; if (!first) pv = *(const u32x4*)(rowp + bj * 128);
                    const f32x4 v0 = acc[ai][bj][m][0] * sc, v1 = acc[ai][bj][m][1] * sc;
                    float o[8];
                    o[0] = __uint_as_float(pv.x << 16) + __uint_as_float(g.x << 16) * v0[0]; o[1] = __uint_as_float(pv.x & 0xffff0000u) + __uint_as_float(g.x & 0xffff0000u) * v0[1];
                    o[2] = __uint_as_float(pv.y << 16) + __uint_as_float(g.y << 16) * v0[2]; o[3] = __uint_as_float(pv.y & 0xffff0000u) + __uint_as_float(g.y & 0xffff0000u) * v0[3];
                    o[4] = __uint_as_float(pv.z << 16) + __uint_as_float(g.z << 16) * v1[0]; o[5] = __uint_as_float(pv.z & 0xffff0000u) + __uint_as_float(g.z & 0xffff0000u) * v1[1];
                    o[6] = __uint_as_float(pv.w << 16) + __uint_as_float(g.w << 16) * v1[2]; o[7] = __uint_as_float(pv.w & 0xffff0000u) + __uint_as_float(g.w & 0xffff0000u) * v1[3];
                    u32x4 w; w.x = cvt_pk_bf16(o[0], o[1]); w.y = cvt_pk_bf16(o[2], o[3]); w.z = cvt_pk_bf16(o[4], o[5]); w.w = cvt_pk_bf16(o[6], o[7]);
                    *(u32x4*)(rowp + bj * 128) = w; }
                asm volatile("" ::: "memory"); }
    }
};
struct EpiRes {
    static constexpr bool PERM = false;
    const float* base_tok; float* out_tok; float* hmeta; float dbg;
    __device__ __forceinline__ void operator()(const f32x4 (&acc)[2][2][4][2], const Unit& u, int wr, int wc, int fr, int fq) const {
        asm volatile("" : "+v"(fr), "+v"(fq));
        const float* bp; float* op;
        if (u.pm == 0) { bp = hmeta; op = hmeta; } else { bp = base_tok + (size_t)(u.pm - 1) * 256 * DM; op = out_tok + (size_t)(u.pm - 1) * 256 * DM; }
        const int lrow0 = wr * 64 + fr, col0 = u.pn * 256 + wc * 32 + 4 * fq;
#pragma unroll
        for (int ai = 0; ai < 2; ++ai)
#pragma unroll
            for (int m = 0; m < 4; ++m) { const size_t off = (size_t)(lrow0 + ai * 128 + m * 16) * DM + col0;
#pragma unroll
                for (int bj = 0; bj < 2; ++bj)
#pragma unroll
                    for (int n = 0; n < 2; ++n) { const f32x4 bs = *(const f32x4*)(bp + off + bj * 128 + n * 16); *(f32x4*)(op + off + bj * 128 + n * 16) = bs + acc[ai][bj][m][n] * dbg; }
                asm volatile("" ::: "memory"); }
    }
};
struct EpiSwiglu {
    static constexpr bool PERM = true;
    bf16_t* P;
    __device__ __forceinline__ void operator()(const f32x4 (&acc)[2][2][4][2], const Unit& u, int wr, int wc, int fr, int fq) const {
        asm volatile("" : "+v"(fr), "+v"(fq));
        const int row0 = u.pm * 256 + wr * 64 + fr, col0 = u.pn * 128 + wc * 32 + 8 * fq;
#pragma unroll
        for (int ai = 0; ai < 2; ++ai)
#pragma unroll
            for (int m = 0; m < 4; ++m) { bf16_t* rowp = P + (size_t)(row0 + ai * 128 + m * 16) * PW + col0;
                float o[8];
#pragma unroll
                for (int n = 0; n < 2; ++n)
#pragma unroll
                    for (int e = 0; e < 4; ++e) { const float g = acc[ai][0][m][n][e], up = acc[ai][1][m][n][e]; o[n * 4 + e] = g * __builtin_amdgcn_rcpf(1.f + __builtin_amdgcn_exp2f(-g * LOG2E)) * up; }
                u32x4 w; w.x = cvt_pk_bf16(o[0], o[1]); w.y = cvt_pk_bf16(o[2], o[3]); w.z = cvt_pk_bf16(o[4], o[5]); w.w = cvt_pk_bf16(o[6], o[7]);
                *(u32x4*)rowp = w; }
    }
};

#define XB_TMO      128
#define XB_XCNT(j)  (256  + 64 * (j))
#define XB_XSUB(j)  (1280 + 64 * (j))
#define XB_XGEN(j)  (2304 + 64 * (j))
#define XB_TOP      3328
#define XB_TOPGEN   3392
#define XCD_BAR_WORDS 3456
#define XB_SPIN_CAP (1u << 18)
__device__ __forceinline__ unsigned xb_ld(unsigned* p)              { return __hip_atomic_load(p, __ATOMIC_RELAXED, __HIP_MEMORY_SCOPE_AGENT); }
__device__ __forceinline__ unsigned xb_add(unsigned* p, unsigned v) { return __hip_atomic_fetch_add(p, v, __ATOMIC_RELAXED, __HIP_MEMORY_SCOPE_AGENT); }
__device__ __forceinline__ unsigned xb_xcc_id() { return (unsigned)__builtin_amdgcn_s_getreg((3 << 11) | 20) & 0xFu; }
#define XB_SPIN(cond, bar) do { unsigned _sp = 0; while (cond) { __builtin_amdgcn_s_sleep(1); \
    if ((++_sp & 255u) == 0u) { if (xb_ld(&(bar)[XB_TMO])) break; if (_sp > XB_SPIN_CAP) { atomicAdd(&(bar)[XB_TMO], 1u); break; } } } } while (0)
struct XcdBarrier { unsigned* bar; unsigned x; volatile LAS unsigned* st; };
__device__ __forceinline__ XcdBarrier xcd_barrier_post(unsigned* bar, volatile LAS unsigned* st) {
    XcdBarrier b; b.bar = bar; b.x = xb_xcc_id(); b.st = st;
    if (threadIdx.x == 0) (void)xb_add(&bar[XB_XCNT(b.x)], 1u);
    return b;
}
__device__ __forceinline__ void xcd_barrier_complete(unsigned* bar, unsigned x, unsigned& nloc, unsigned& nx) {
    const unsigned G = gridDim.x * gridDim.y * gridDim.z;
    unsigned sum, cnt, mine, sp = 0u;
    for (;;) {
        sum = 0u; cnt = 0u; mine = 0u;
#pragma unroll
        for (unsigned j = 0; j < 16; ++j) { const unsigned c = xb_ld(&bar[XB_XCNT(j)]); sum += c; cnt += (c > 0u) ? 1u : 0u; mine = (j == x) ? c : mine; }
        if (sum == G) break;
        __builtin_amdgcn_s_sleep(1);
        if ((++sp & 255u) == 0u) { if (xb_ld(&bar[XB_TMO])) break; if (sp > XB_SPIN_CAP) { atomicAdd(&bar[XB_TMO], 1u); break; } }
    }
    nloc = mine > 0u ? mine : 1u; nx = cnt > 0u ? cnt : 1u;
}
__device__ __forceinline__ void xcd_barrier(const XcdBarrier& b) {
    asm volatile("s_waitcnt vmcnt(0)" ::: "memory");
    __syncthreads();
    if (threadIdx.x == 0) {
        unsigned* bar = b.bar;
        __builtin_amdgcn_s_waitcnt(0);
        unsigned nloc = b.st[0], nx = b.st[1];
        if (nloc == 0u) { xcd_barrier_complete(bar, b.x, nloc, nx); b.st[0] = nloc; b.st[1] = nx; }
        const unsigned old = xb_add(&bar[XB_XSUB(b.x)], 1u);
        const unsigned gen = old / nloc;
        if (old + 1u == (gen + 1u) * nloc) {
            __builtin_amdgcn_fence(__ATOMIC_RELEASE, "agent");
            asm volatile("s_waitcnt vmcnt(0)" ::: "memory");
            const unsigned og = xb_add(&bar[XB_TOP], 1u);
            const unsigned tg = og / nx;
            if (og + 1u == (tg + 1u) * nx) xb_add(&bar[XB_TOPGEN], 1u);
            else XB_SPIN(xb_ld(&bar[XB_TOPGEN]) == tg, bar);
            __builtin_amdgcn_fence(__ATOMIC_ACQUIRE, "agent");
            xb_add(&bar[XB_XGEN(b.x)], 1u);
            asm volatile("s_waitcnt vmcnt(0)" ::: "memory");
        } else {
            XB_SPIN(xb_ld(&bar[XB_XGEN(b.x)]) == gen, bar);
            __builtin_amdgcn_fence(__ATOMIC_ACQUIRE, "agent");
            asm volatile("s_waitcnt vmcnt(0)" ::: "memory");
        }
    }
    __syncthreads();
}

constexpr int NWAVES = 8;
constexpr int RING_BYTES = 131072, LDS_BYTES = 147456, LDSCTL_OFF = LDS_BYTES - 512;
struct Args {
    const float* in[19]; float* out; unsigned char* ws; int ph_lo, ph_hi;
};
struct Ctx {
    LAS unsigned char* lds; int tid, lane, wave, gw, ngw, G, bid;
};

template <int MAP> __device__ __forceinline__ int wmap(int n, float& sc) {
    sc = 1.f;
    if (MAP == 0) return n;
    if (MAP == 1) {
        if (n < 1088) return n;
        if (n < 4160) return 1280 + (n - 1088);
        if (n < 5184) return 4352 + (n - 4160);
        if (n < 5248) return 1088 + (n - 5184);
        if (n < 5264) { sc = 0.03125f; return 1152 + (n - 5248); }
        if (n < 8336) return 5376 + (n - 5264);
        return 8448 + (n - 8336);
    }
    if (n < DFF) return (n >> 7) * 256 + (n & 127);
    const int m = n - DFF; return (m >> 7) * 256 + 128 + (m & 127);
}
template <int MAP> __device__ __forceinline__ void conv_item(const float* W, int K, int N, bf16_t* WT, const float* gain, LAS float* scr, int item, int lane) {
    const int nblk = (N + 31) / 32, kb = item / nblk, nb = item - kb * nblk, k0 = 64 * kb, n0 = 32 * nb;
    const int nn = n0 + (lane & 31);
#pragma unroll 8
    for (int i = 0; i < 32; ++i) { const int kk = 2 * i + (lane >> 5); float v = 0.f; if (nn < N) { v = W[(size_t)(k0 + kk) * N + nn]; if (gain) v *= gain[k0 + kk]; } scr[kk * 33 + (lane & 31)] = v; }
    LDS_WAIT(); asm volatile("" ::: "memory");
    const int c = lane & 7;
#pragma unroll
    for (int j = 0; j < 4; ++j) { const int n = (lane >> 3) + 8 * j; const int ns = n0 + n;
        if (ns < N) { float sc; const int dst = wmap<MAP>(ns, sc); const LAS float* s = scr + (8 * c) * 33 + n;
            u32x4 o; o.x = pk2(s[0 * 33] * sc, s[1 * 33] * sc); o.y = pk2(s[2 * 33] * sc, s[3 * 33] * sc); o.z = pk2(s[4 * 33] * sc, s[5 * 33] * sc); o.w = pk2(s[6 * 33] * sc, s[7 * 33] * sc);
            *(u32x4*)(WT + (size_t)dst * K + k0 + 8 * c) = o; } }
    LDS_WAIT(); asm volatile("" ::: "memory");
}
template <int MAP> __device__ __forceinline__ void conv_matrix(const Ctx& F, const float* W, int K, int N, bf16_t* WT, const float* gain) {
    LAS float* scr = (LAS float*)(F.lds + F.wave * 16384);
    const int nit = (K / 64) * ((N + 31) / 32);
    for (int it = F.gw; it < nit; it += F.ngw) conv_item<MAP>(W, K, N, WT, gain, scr, it, F.lane);
}

__device__ __forceinline__ void norm_row(const float* hrow, bf16_t* orow, int lane) {
    f32x4 v[8]; float s = 0.f; float zf = 0.f; asm volatile("" : "+v"(zf));
    if (hrow) {
#pragma unroll
        for (int j = 0; j < 8; ++j) { v[j] = *((const f32x4*)hrow + lane + 64 * j); s += (v[j].x * v[j].x + v[j].y * v[j].y) + (v[j].z * v[j].z + v[j].w * v[j].w); }
    } else {
#pragma unroll
        for (int j = 0; j < 8; ++j) v[j] = (f32x4){zf, zf, zf, zf};
    }
    const float rstd = 1.0f / sqrtf(wave_sum(s) * (1.f / DM) + EPS);
#pragma unroll
    for (int j = 0; j < 8; ++j) { u32x2 o; o.x = pk2(v[j].x * rstd, v[j].y * rstd); o.y = pk2(v[j].z * rstd, v[j].w * rstd); *((u32x2*)orow + lane + 64 * j) = o; }
}

__device__ __forceinline__ void post1a_row(const bf16_t* P, int r, float* rstdq, float* rstdkv, int lane) {
    const bf16_t* p = P + (size_t)r * PW;
    const u32x4 a = *((const u32x4*)(p + C_CQ) + lane), b = *((const u32x4*)(p + C_CKV) + lane);
    float sa = 0.f, sb = 0.f;
#pragma unroll
    for (int e = 0; e < 4; ++e) { const float x0 = __uint_as_float(a[e] << 16), x1 = __uint_as_float(a[e] & 0xffff0000u); sa += x0 * x0 + x1 * x1;
        const float y0 = __uint_as_float(b[e] << 16), y1 = __uint_as_float(b[e] & 0xffff0000u); sb += y0 * y0 + y1 * y1; }
    sa = wave_sum(sa); sb = wave_sum(sb);
    if (lane == 0) { rstdq[r] = 1.0f / sqrtf(sa * (1.f / 512.f) + EPS); rstdkv[r] = 1.0f / sqrtf(sb * (1.f / 512.f) + EPS); }
}
__device__ __forceinline__ void post2_row(bf16_t* P, int r, const float* rstdq, const float* rstdkv, const float* qkg  , int lane) {
    bf16_t* p = P + (size_t)r * PW;
    const float sq = rstdq[r], skv = rstdkv[r];
    float cs, sn; rope_cs(row_pos(r), lane & 31, 2.f / 64.f, cs, sn);
    const float g0a = qkg[lane], g0b = qkg[64 + lane], g0c = qkg[128 + lane];
    const float g1a = qkg[192 + lane], g1b = qkg[192 + 64 + lane], g1c = qkg[192 + 128 + lane];
    const float kpe = bf2f(p[C_KPE + lane]);
    const float kpe_ss = wave_sum(kpe * kpe);
#pragma unroll 2
    for (int h = 0; h < 8; ++h) {
        bf16_t* q = p + C_QRAW + h * 192;
        float x0 = bf2f(q[lane]) * sq, x1 = bf2f(q[64 + lane]) * sq, x2 = bf2f(q[128 + lane]) * sq;
        float rn = 1.0f / sqrtf(wave_sum(x0 * x0 + x1 * x1 + x2 * x2) * (1.f / 192.f) + EPS);
        x0 *= rn * g0a; x1 *= rn * g0b; x2 *= rn * g0c;
        { const float pr = __shfl_xor(x2, 32); x2 = (lane < 32) ? (x2 * cs - pr * sn) : (x2 * cs + pr * sn); }
        q[lane] = (bf16_t)f2bf(x0 * C2_192); q[64 + lane] = (bf16_t)f2bf(x1 * C2_192); q[128 + lane] = (bf16_t)f2bf(x2 * C2_192);
        bf16_t* kv = p + C_KVRAW + h * 256;
        float k0 = bf2f(kv[lane]) * skv, k1 = bf2f(kv[64 + lane]) * skv;
        const float v0 = bf2f(kv[128 + lane]) * skv, v1 = bf2f(kv[192 + lane]) * skv;
        rn = 1.0f / sqrtf((wave_sum(k0 * k0 + k1 * k1) + kpe_ss) * (1.f / 192.f) + EPS);
        kv[lane] = (bf16_t)f2bf(k0 * rn * g1a); kv[64 + lane] = (bf16_t)f2bf(k1 * rn * g1b);
        kv[128 + lane] = (bf16_t)f2bf(v0); kv[192 + lane] = (bf16_t)f2bf(v1);
        float kp = kpe * rn * g1c;
        { const float pr = __shfl_xor(kp, 32); kp = (lane < 32) ? (kp * cs - pr * sn) : (kp * cs + pr * sn); }
        p[C_KPEH + h * 64 + lane] = (bf16_t)f2bf(kp);
    }
}
__device__ __forceinline__ void headnorm_rope128(bf16_t* x, float ga, float gb, float cs, float sn, float scale, int lane) {
    float a = bf2f(x[lane]), b = bf2f(x[64 + lane]);
    const float rn = 1.0f / sqrtf(wave_sum(a * a + b * b) * (1.f / 128.f) + EPS);
    a *= rn * ga; b *= rn * gb;
    const float ra = a * cs - b * sn, rb = b * cs + a * sn;
    x[lane] = (bf16_t)f2bf(ra * scale); x[64 + lane] = (bf16_t)f2bf(rb * scale);
}
__device__ __forceinline__ void post1b_row(bf16_t* P, int r, const float* dsag  , const float* diffg  , int lane) {
    bf16_t* p = P + (size_t)r * PW;
    const int pos = row_pos(r);
    float c128, s128, c64, s64; rope_cs(pos, lane, 2.f / 128.f, c128, s128); rope_cs(pos, lane & 31, 2.f / 64.f, c64, s64);
    const float dq_a = dsag[lane], dq_b = dsag[64 + lane], dk_a = dsag[128 + lane], dk_b = dsag[192 + lane];
    const float fq_a = diffg[lane], fq_b = diffg[64 + lane], fk_a = diffg[128 + lane], fk_b = diffg[192 + lane];
#pragma unroll 2
    for (int h = 0; h < 8; ++h) {
        headnorm_rope128(p + C_DQ + h * 128, dq_a, dq_b, c128, s128, C2_128, lane);
        headnorm_rope128(p + C_DK + h * 128, dk_a, dk_b, c128, s128, 1.f, lane);
        headnorm_rope128(p + C_FQ + h * 128, fq_a, fq_b, c128, s128, C2_128, lane);
        headnorm_rope128(p + C_FK + h * 128, fk_a, fk_b, c128, s128, 1.f, lane);
    }
#pragma unroll 2
    for (int h = 0; h < 17; ++h) {
        bf16_t* x = (h < 16) ? (p + C_IQ + h * 64) : (p + C_IK);
        const float v = bf2f(x[lane]); const float pr = __shfl_xor(v, 32);
        x[lane] = (bf16_t)f2bf((lane < 32) ? (v * c64 - pr * s64) : (v * c64 + pr * s64));
    }
}
__device__ __forceinline__ void post3_row(bf16_t* P, int r, const float* subg, float lam, float omli, int lane) {
    bf16_t* p = P + (size_t)r * PW;
    const float g0 = subg[lane], g1 = subg[64 + lane], g2 = subg[128 + lane], g3 = subg[192 + lane];
#pragma unroll
    for (int h = 0; h < 4; ++h) {
        const bf16_t* a0 = p + C_FQ + (h * 2) * 128; const bf16_t* a1 = p + C_FQ + (h * 2 + 1) * 128;
        const bf16_t* b0 = p + C_IQ + (h * 2) * 128; const bf16_t* b1 = p + C_IQ + (h * 2 + 1) * 128;
        const float d0 = bf2f(a0[lane]) - lam * bf2f(a1[lane]), d1 = bf2f(a0[64 + lane]) - lam * bf2f(a1[64 + lane]);
        const float d2 = bf2f(b0[lane]) - lam * bf2f(b1[lane]), d3 = bf2f(b0[64 + lane]) - lam * bf2f(b1[64 + lane]);
        const float rn = omli / sqrtf(wave_sum(d0 * d0 + d1 * d1 + d2 * d2 + d3 * d3) * (1.f / 256.f) + EPS);
        bf16_t* o = p + C_OC + h * 256;
        o[lane] = (bf16_t)f2bf(d0 * rn * g0); o[64 + lane] = (bf16_t)f2bf(d1 * rn * g1); o[128 + lane] = (bf16_t)f2bf(d2 * rn * g2); o[192 + lane] = (bf16_t)f2bf(d3 * rn * g3);
    }
}

__device__ __forceinline__ int key_row(int kidx, int tokbase) { return kidx < 64 ? (MBLK - 64) + kidx : tokbase + (kidx - 64); }

__device__ __forceinline__ void index_row(const bf16_t* P, int tok, unsigned* bm, LAS float* iqs  , LAS unsigned* keys  , int lane) {
    const int b = tok >> 11, t = tok & (SEQ - 1), r = MBLK + tok, qk = 64 + t, nvalid = t + 17, tokbase = MBLK + b * SEQ;
    const int nch = qk / 64 + 1;
    unsigned* out = bm + (size_t)tok * BMW;
    if (nvalid <= 256) {
        for (int c = 0; c < 33; ++c) { const int kidx = 64 * c + lane; const unsigned long long m = __ballot(kidx >= 48 && kidx <= qk);
            if (lane == 0) { out[2 * c] = (unsigned)m; out[2 * c + 1] = (unsigned)(m >> 32); } }
        return;
    }
    const bf16_t* p = P + (size_t)r * PW;
#pragma unroll
    for (int j = 0; j < 16; ++j) iqs[j * 64 + lane] = bf2f(p[C_IQ + j * 64 + lane]);
    if (lane < 16) iqs[1024 + lane] = bf2f(p[C_IW + lane]);
    LDS_WAIT(); asm volatile("" ::: "memory");
    for (int c = 0; c < nch; ++c) {
        const int kidx = 64 * c + lane; const bool valid = kidx >= 48 && kidx <= qk;
        const int kr = key_row(valid ? kidx : 48, tokbase);
        const u32x4* kp = (const u32x4*)(P + (size_t)kr * PW + C_IK);
        u32x4 kw[8];
#pragma unroll
        for (int j = 0; j < 8; ++j) kw[j] = kp[j];
        float score = 0.f;
#pragma unroll 1
        for (int h = 0; h < 16; ++h) {
            const LAS f32x4* qv = (const LAS f32x4*)(iqs + h * 64); float d = 0.f;
#pragma unroll
            for (int j = 0; j < 8; ++j) { const u32x4 w = kw[j]; const f32x4 qa = qv[2 * j], qb = qv[2 * j + 1];
                d += qa.x * __uint_as_float(w.x << 16) + qa.y * __uint_as_float(w.x & 0xffff0000u) + qa.z * __uint_as_float(w.y << 16) + qa.w * __uint_as_float(w.y & 0xffff0000u)
                   + qb.x * __uint_as_float(w.z << 16) + qb.y * __uint_as_float(w.z & 0xffff0000u) + qb.z * __uint_as_float(w.w << 16) + qb.w * __uint_as_float(w.w & 0xffff0000u); }
            score += fmaxf(d, 0.f) * iqs[1024 + h];
        }
        const unsigned u = __float_as_uint(score);
        keys[c * 64 + lane] = valid ? ((u & 0x80000000u) ? ~u : (u | 0x80000000u)) : 0u;
    }
    LDS_WAIT(); asm volatile("" ::: "memory");
    unsigned T = 0u;
    for (int bit = 31; bit >= 0; --bit) {
        const unsigned cand = T | (1u << bit); int cnt = 0;
        for (int c = 0; c < nch; ++c) cnt += __popcll(__ballot(keys[c * 64 + lane] >= cand));
        if (cnt >= 256) T = cand;
        if (cnt == 256) break;
    }
    for (int c = 0; c < 33; ++c) { unsigned long long m = 0ull; if (c < nch) m = __ballot(keys[c * 64 + lane] >= T);
        if (lane == 0) { out[2 * c] = (unsigned)m; out[2 * c + 1] = (unsigned)(m >> 32); } }
    LDS_WAIT(); asm volatile("" ::: "memory");
}

template <int DQK, int DV, bool MASKED>
__device__ __forceinline__ void attn_row(bf16_t* P, int r, int qcol, int k1col, int k2col, int vcol, int ocol0, int ocol1, const unsigned* bm, LAS float* qs, int lane) {
    int qk, tokbase;
    if (r < MBLK) { qk = r - (MBLK - 64); tokbase = MBLK; } else { const int tok = r - MBLK; qk = 64 + (tok & (SEQ - 1)); tokbase = MBLK + (tok >> 11) * SEQ; }
    const bf16_t* qp = P + (size_t)r * PW + qcol;
#pragma unroll
    for (int d = 0; d < DQK; d += 64) qs[d + lane] = bf2f(qp[d + lane]);
    LDS_WAIT(); asm volatile("" ::: "memory");
    const bool use_bm = MASKED && r >= MBLK;
    const unsigned* bmr = bm + (size_t)(r >= MBLK ? r - MBLK : 0) * BMW;
    float m = -1e30f, l = 0.f, o[DV / 64];
#pragma unroll
    for (int k = 0; k < DV / 64; ++k) o[k] = 0.f;
    const int nch = qk / 64 + 1;
    for (int c = 0; c < nch; ++c) {
        const int kidx = 64 * c + lane; bool valid = kidx >= 48 && kidx <= qk;
        if (use_bm) valid = (bmr[kidx >> 5] >> (kidx & 31)) & 1u;
        const int kr = key_row((kidx >= 48 && kidx <= qk) ? kidx : 48, tokbase);
        float s = 0.f;
        { const u32x4* kp = (const u32x4*)(P + (size_t)kr * PW + k1col);
#pragma unroll
          for (int j = 0; j < 16; ++j) { const u32x4 w = kp[j]; const LAS f32x4* qv = (const LAS f32x4*)(qs + j * 8); const f32x4 qa = qv[0], qb = qv[1];
              s += qa.x * __uint_as_float(w.x << 16) + qa.y * __uint_as_float(w.x & 0xffff0000u) + qa.z * __uint_as_float(w.y << 16) + qa.w * __uint_as_float(w.y & 0xffff0000u)
                 + qb.x * __uint_as_float(w.z << 16) + qb.y * __uint_as_float(w.z & 0xffff0000u) + qb.z * __uint_as_float(w.w << 16) + qb.w * __uint_as_float(w.w & 0xffff0000u); } }
        if (DQK == 192) { const u32x4* kp = (const u32x4*)(P + (size_t)kr * PW + k2col);
#pragma unroll
          for (int j = 0; j < 8; ++j) { const u32x4 w = kp[j]; const LAS f32x4* qv = (const LAS f32x4*)(qs + 128 + j * 8); const f32x4 qa = qv[0], qb = qv[1];
              s += qa.x * __uint_as_float(w.x << 16) + qa.y * __uint_as_float(w.x & 0xffff0000u) + qa.z * __uint_as_float(w.y << 16) + qa.w * __uint_as_float(w.y & 0xffff0000u)
                 + qb.x * __uint_as_float(w.z << 16) + qb.y * __uint_as_float(w.z & 0xffff0000u) + qb.z * __uint_as_float(w.w << 16) + qb.w * __uint_as_float(w.w & 0xffff0000u); } }
        if (!valid) s = -__builtin_inff();
        const float mn = fmaxf(m, wave_max(s));
        const float alpha = __builtin_amdgcn_exp2f(m - mn), pj = __builtin_amdgcn_exp2f(s - mn);
        l = l * alpha + wave_sum(pj); m = mn;
#pragma unroll
        for (int k = 0; k < DV / 64; ++k) o[k] *= alpha;
        for (int j = 0; j < 64; ++j) {
            const float pw = __uint_as_float((unsigned)__builtin_amdgcn_readlane((int)__float_as_uint(pj), j));
            if (pw != 0.f) { const int rj = __builtin_amdgcn_readlane(kr, j); const bf16_t* vp = P + (size_t)rj * PW + vcol;
#pragma unroll
                for (int k = 0; k < DV / 64; ++k) o[k] += pw * bf2f(vp[k * 64 + lane]); }
        }
    }
    const float rl = l > 0.f ? 1.0f / l : 0.f;
    bf16_t* op = P + (size_t)r * PW;
#pragma unroll
    for (int k = 0; k < DV / 64; ++k) { const int d = k * 64 + lane; op[(d < 128 ? ocol0 + d : ocol1 + d - 128)] = (bf16_t)f2bf(o[k] * rl); }
    LDS_WAIT(); asm volatile("" ::: "memory");
}
namespace fa {
typedef float f32x16 __attribute__((ext_vector_type(16)));
typedef short s16x4 __attribute__((ext_vector_type(4)));
__device__ __forceinline__ int crow(int r, int hi) { return (r & 3) + 8 * (r >> 2) + 4 * hi; }
__device__ __forceinline__ int v_st(int k, int c) { const int kk = (k & ~0xC) | ((k & 4) << 1) | ((k & 8) >> 1); return ((kk >> 3) * 4 + (c >> 5)) * 512 + ((kk & 7) * 32 + (c & 31)) * 2; }
__device__ __forceinline__ int v_rd_base(int lane) { return ((lane & 3) << 3) | (((lane >> 2) & 3) << 6) | (((lane >> 4) & 1) << 5) | (((lane >> 5) & 1) << 8); }
constexpr int v_rd_off(int d0, int ks, int half) { return d0 * 512 + ks * 4096 + half * 2048; }
constexpr int SHM_V = 16384;
template <int DQK> struct Geo { static constexpr int KP = DQK * 2, SHM_K = 64 * DQK * 2, LDS_K0 = 2 * SHM_V, LDS_WS = LDS_K0 + 2 * SHM_K, BYTES = LDS_WS + 8 * 256; };
#define FA_KSWZ(row, colB, pitch) ((row) * (pitch) + ((colB) ^ (((row) & 7) << 4)))
#define FA_SBAR() __builtin_amdgcn_sched_barrier(0)

struct Item { int qrow0, qk0, nt, tokbase; };

template <int DQK>
__device__ __forceinline__ void load_q(const bf16_t* P, const Item& it, int qcol, bf16x8 (&qr)[DQK / 16]) {
    int tid = threadIdx.x; asm volatile("" : "+v"(tid));
    const int wid = tid >> 6, lane = tid & 63, r32 = lane & 31, hi = lane >> 5;
    const bf16_t* qp = P + (size_t)(it.qrow0 + wid * 32 + r32) * PW + qcol + hi * 8;
#pragma unroll
    for (int d0 = 0; d0 < DQK / 16; ++d0) qr[d0] = *(const bf16x8*)(qp + d0 * 16);
}

template <int DQK, bool MASKED>
__device__ __forceinline__ void attn_core(bf16_t* P, const Item& it, const bf16x8 (&qr)[DQK / 16], int k1col, int k2col, int vcol, int ocol, const unsigned* bmq, LAS unsigned char* lds) {
    typedef Geo<DQK> G;
    int tid = threadIdx.x; asm volatile("" : "+v"(tid));
    const int wid = __builtin_amdgcn_readfirstlane(tid >> 6), lane = tid & 63, r32 = lane & 31, hi = lane >> 5;
    LAS unsigned char* V_lds = lds; LAS unsigned char* K_lds = lds + G::LDS_K0; LAS float* wsf = (LAS float*)(lds + G::LDS_WS) + wid * 64;
    const int sr = tid >> 4, sc = (tid & 15) * 8;
    const int vst0 = v_st(sr, sc), vst1 = v_st(32 + sr, sc), kws0 = FA_KSWZ(sr, sc * 2, G::KP), kws1 = FA_KSWZ(sr + 32, sc * 2, G::KP);
    const int xr = tid >> 3, xc = (tid & 7) * 8, kws2 = FA_KSWZ(xr, (128 + xc) * 2, G::KP);
    const unsigned loff0 = (unsigned)(sr * PW + sc) * 2u, loffx = (unsigned)(xr * PW + xc) * 2u;
    const int vb0 = (int)(unsigned)(size_t)V_lds + v_rd_base(lane);
    const int NT = it.nt;
    const int qk = it.qk0 + wid * 32 + r32;
    const bool use_bm = MASKED && (bmq != nullptr);
    const unsigned bmoff = (unsigned)((wid * 32 + r32) * BMW) * 4u;
    float m_reg = -1e30f, l_reg = 0.f; f32x16 o[4];
#pragma unroll
    for (int d = 0; d < 4; ++d) o[d] = (f32x16){0.f,0.f,0.f,0.f,0.f,0.f,0.f,0.f,0.f,0.f,0.f,0.f,0.f,0.f,0.f,0.f};
    bf16x8 sk0, sk1, sk2, sv0, sv1;
#define FA_KROW0(t) ((t) == 0 ? (MBLK - 64) : it.tokbase + 64 * ((t) - 1))
#define FA_LOAD(t) do { const int kr_ = FA_KROW0(t); const char* rb_ = (const char*)(P + (size_t)kr_ * PW); const char* rk_ = rb_ + (size_t)k1col * 2; const char* rv_ = rb_ + (size_t)vcol * 2; \
        sk0 = *(const bf16x8*)(rk_ + loff0); sk1 = *(const bf16x8*)(rk_ + (size_t)32 * PW * 2 + loff0); sv0 = *(const bf16x8*)(rv_ + loff0); sv1 = *(const bf16x8*)(rv_ + (size_t)32 * PW * 2 + loff0); \
        if (DQK == 192) sk2 = *(const bf16x8*)(rb_ + (size_t)k2col * 2 + loffx); } while (0)
#define FA_WRITE(bf) do { *(LAS bf16x8*)(K_lds + (bf) * G::SHM_K + kws0) = sk0; *(LAS bf16x8*)(K_lds + (bf) * G::SHM_K + kws1) = sk1; \
        *(LAS bf16x8*)(V_lds + (bf) * SHM_V + vst0) = sv0; *(LAS bf16x8*)(V_lds + (bf) * SHM_V + vst1) = sv1; \
        if (DQK == 192) *(LAS bf16x8*)(K_lds + (bf) * G::SHM_K + kws2) = sk2; } while (0)
    constexpr int QREG = (DQK == 192) ? 6 : DQK / 16;
    LAS unsigned char* qx = lds + G::BYTES + (wid * 384 + lane) * 16;
    if (DQK == 192) {
#pragma unroll
        for (int d0 = QREG; d0 < DQK / 16; ++d0) *(LAS bf16x8*)(qx + (d0 - QREG) * 1024) = qr[d0];
    }
    FA_LOAD(0); FA_WRITE(0);
    __syncthreads();
    for (int t = 0; t < NT; ++t) {
        const int cur = t & 1;
        unsigned zb = 0u; asm volatile("" : "+v"(zb)); u32x2 bw = (u32x2){zb, zb};
        if (use_bm) bw = *(const u32x2*)((const char*)(bmq + 2 * t) + bmoff);
        f32x16 p0 = (f32x16){0.f,0.f,0.f,0.f,0.f,0.f,0.f,0.f,0.f,0.f,0.f,0.f,0.f,0.f,0.f,0.f}, p1 = p0;
        { LAS unsigned char* kbase = K_lds + cur * G::SHM_K;
          LAS unsigned char* kb[4];
#pragma unroll
          for (int dd = 0; dd < 4; ++dd) kb[dd] = kbase + FA_KSWZ(r32, (dd * 16 + hi * 8) * 2, G::KP);
          constexpr int GS = (DQK == 192) ? 2 : 4;
#pragma unroll
          for (int g = 0; g < DQK / (16 * GS); ++g) {
              bf16x8 fb0[GS], fb1[GS];
#pragma unroll
              for (int dd = 0; dd < GS; ++dd) { const int d0 = g * GS + dd; LAS unsigned char* a = kb[d0 & 3] + (d0 >> 2) * 128; fb0[dd] = *(const LAS bf16x8*)a; fb1[dd] = *(const LAS bf16x8*)(a + 32 * G::KP); }
              FA_SBAR();
#pragma unroll
              for (int dd = 0; dd < GS; ++dd) { const int d0 = g * GS + dd; bf16x8 qf; if (d0 < QREG) qf = qr[d0 < QREG ? d0 : 0]; else qf = *(const LAS bf16x8*)(qx + (d0 - QREG) * 1024);
                  p0 = __builtin_amdgcn_mfma_f32_32x32x16_bf16(fb0[dd], qf, p0, 0, 0, 0); p1 = __builtin_amdgcn_mfma_f32_32x32x16_bf16(fb1[dd], qf, p1, 0, 0, 0); }
              FA_SBAR(); } }
        if (t + 1 < NT) FA_LOAD(t + 1);
        FA_SBAR();
        const float NEG = -__builtin_inff();
        if (use_bm) {
            const unsigned wx = bw.x >> (4 * hi), wy = bw.y >> (4 * hi);
#pragma unroll
            for (int r = 0; r < 16; ++r) { const unsigned bit = 1u << ((r & 3) + 8 * (r >> 2)); if (!(wx & bit)) p0[r] = NEG; if (!(wy & bit)) p1[r] = NEG; }
        } else if (t == 0 || 64 * t + 63 > it.qk0 + wid * 32) {
            const int kb_ = 64 * t + 4 * hi;
#pragma unroll
            for (int r = 0; r < 16; ++r) { const int k0 = kb_ + (r & 3) + 8 * (r >> 2), k1 = k0 + 32;
                if (k0 < 48 || k0 > qk) p0[r] = NEG; if (k1 < 48 || k1 > qk) p1[r] = NEG; }
        }
        float pmax = p0[0];
#pragma unroll
        for (int r = 1; r < 16; ++r) pmax = fmaxf(pmax, p0[r]);
#pragma unroll
        for (int r = 0; r < 16; ++r) pmax = fmaxf(pmax, p1[r]);
        { auto rr = __builtin_amdgcn_permlane32_swap(__float_as_uint(pmax), __float_as_uint(pmax), false, false); pmax = fmaxf(__uint_as_float(rr[0]), __uint_as_float(rr[1])); }
        const float mn = fmaxf(m_reg, pmax); const float alpha = __builtin_amdgcn_exp2f(m_reg - mn); m_reg = mn;
        float ps = 0.f;
#pragma unroll
        for (int r = 0; r < 16; ++r) { p0[r] = __builtin_amdgcn_exp2f(p0[r] - mn); p1[r] = __builtin_amdgcn_exp2f(p1[r] - mn); ps += p0[r] + p1[r]; }
        { auto rr = __builtin_amdgcn_permlane32_swap(__float_as_uint(ps), __float_as_uint(ps), false, false); ps = __uint_as_float(rr[0]) + __uint_as_float(rr[1]); }
        l_reg = l_reg * alpha + ps;
        if (__any(alpha < 1.f)) { if (hi == 0) wsf[r32] = alpha; LDS_WAIT();
#pragma unroll
            for (int d_ = 0; d_ < 4; ++d_)
#pragma unroll
                for (int r = 0; r < 16; ++r) o[d_][r] *= wsf[crow(r, hi)];
            LDS_WAIT(); }
        bf16x8 pa0, pa1, pa2, pa3;
#define FA_PK4(Pv, B_, OUT) do { const unsigned a0 = cvt_pk_bf16(Pv[B_ + 0], Pv[B_ + 1]), a1 = cvt_pk_bf16(Pv[B_ + 2], Pv[B_ + 3]), b0 = cvt_pk_bf16(Pv[B_ + 4], Pv[B_ + 5]), b1 = cvt_pk_bf16(Pv[B_ + 6], Pv[B_ + 7]); \
        auto r0 = __builtin_amdgcn_permlane32_swap(a0, b0, false, false); auto r1 = __builtin_amdgcn_permlane32_swap(a1, b1, false, false); \
        u32x4 w_ = {r0[0], r1[0], r0[1], r1[1]}; OUT = __builtin_bit_cast(bf16x8, w_); } while (0)
        FA_PK4(p0, 0, pa0); FA_PK4(p0, 8, pa1); FA_PK4(p1, 0, pa2); FA_PK4(p1, 8, pa3);
#define FA_TRRD(dst, off) asm volatile("ds_read_b64_tr_b16 %0, %1 offset:%2" : "=&v"(dst) : "v"(vb0), "i"(off) : "memory")
#define FA_PV(VB, d0) do { s16x4 l0, l1, l2, l3, h0, h1, h2, h3; constexpr int b_ = (VB) * SHM_V + v_rd_off(d0, 0, 0); \
        FA_TRRD(l0, b_); FA_TRRD(h0, b_ + 2048); FA_TRRD(l1, b_ + 4096); FA_TRRD(h1, b_ + 6144); FA_TRRD(l2, b_ + 8192); FA_TRRD(h2, b_ + 10240); FA_TRRD(l3, b_ + 12288); FA_TRRD(h3, b_ + 14336); \
        asm volatile("s_waitcnt lgkmcnt(0)" ::: "memory"); FA_SBAR(); \
        o[d0] = __builtin_amdgcn_mfma_f32_32x32x16_bf16(pa0, (bf16x8){l0[0], l0[1], l0[2], l0[3], h0[0], h0[1], h0[2], h0[3]}, o[d0], 0, 0, 0); \
        o[d0] = __builtin_amdgcn_mfma_f32_32x32x16_bf16(pa1, (bf16x8){l1[0], l1[1], l1[2], l1[3], h1[0], h1[1], h1[2], h1[3]}, o[d0], 0, 0, 0); \
        o[d0] = __builtin_amdgcn_mfma_f32_32x32x16_bf16(pa2, (bf16x8){l2[0], l2[1], l2[2], l2[3], h2[0], h2[1], h2[2], h2[3]}, o[d0], 0, 0, 0); \
        o[d0] = __builtin_amdgcn_mfma_f32_32x32x16_bf16(pa3, (bf16x8){l3[0], l3[1], l3[2], l3[3], h3[0], h3[1], h3[2], h3[3]}, o[d0], 0, 0, 0); } while (0)
        FA_SBAR();
        if (cur == 0) { FA_PV(0, 0); FA_PV(0, 1); FA_PV(0, 2); FA_PV(0, 3); } else { FA_PV(1, 0); FA_PV(1, 1); FA_PV(1, 2); FA_PV(1, 3); }
        FA_SBAR();
        if (t + 1 < NT) { if (cur == 0) FA_WRITE(1); else FA_WRITE(0); }
        __syncthreads();
    }
    if (hi == 0) wsf[r32] = l_reg; LDS_WAIT();
    float rli[16];
#pragma unroll
    for (int r = 0; r < 16; ++r) { const float lv = wsf[crow(r, hi)]; rli[r] = lv > 0.f ? __builtin_amdgcn_rcpf(lv) : 0.f; }
    { int l2 = lane; asm volatile("" : "+v"(l2));
      const int r32b = l2 & 31, hib = l2 >> 5;
      char* Ow = (char*)(P + (size_t)(it.qrow0 + wid * 32) * PW + ocol) + (unsigned)((4 * hib) * PW + r32b) * 2u;
#pragma unroll
      for (int r = 0; r < 16; ++r) { const unsigned ro = (unsigned)(((r & 3) + 8 * (r >> 2)) * PW) * 2u;
#pragma unroll
        for (int d0 = 0; d0 < 4; ++d0) { const float v = o[d0][r] * rli[r]; const float vn = __shfl_xor(v, 1);
            if ((r32b & 1) == 0) *(unsigned*)(Ow + ro + d0 * 64) = cvt_pk_bf16(v, vn); } } }
    LDS_WAIT();
    __syncthreads();
#undef FA_KROW0
#undef FA_LOAD
#undef FA_WRITE
#undef FA_PK4
#undef FA_TRRD
#undef FA_PV
}
__device__ __forceinline__ int next_item(unsigned* ctr, LAS int* slot) {
    __syncthreads();
    if (threadIdx.x == 0) *slot = (int)__hip_atomic_fetch_add(ctr, 1u, __ATOMIC_RELAXED, __HIP_MEMORY_SCOPE_AGENT);
    __syncthreads();
    return *slot;
}
__device__ __forceinline__ Item make_item(bool meta, int b, int qb) {
    Item it;
    if (meta) { it.qrow0 = 0; it.qk0 = -(MBLK - 64); it.nt = 1; it.tokbase = MBLK; }
    else { it.qrow0 = MBLK + b * SEQ + qb * 256; it.qk0 = 64 + qb * 256; it.nt = 4 * (qb + 1) + 1; it.tokbase = MBLK + b * SEQ; }
    return it;
}
}

__device__ __forceinline__ int deal_row(int pass, int gw, int ngw) { const int j = (pass & 1) ? (ngw - 1 - gw) : gw; return pass * ngw + j; }

constexpr int PH_PER_LAYER = 20, N_PHASES = 2 * PH_PER_LAYER;
__device__ __forceinline__ unsigned char* uni_ptr(unsigned char* p) { const unsigned long long v = (unsigned long long)p; const unsigned lo = __builtin_amdgcn_readfirstlane((unsigned)v), hi = __builtin_amdgcn_readfirstlane((unsigned)(v >> 32)); return (unsigned char*)(((unsigned long long)hi << 32) | lo); }
__device__ __forceinline__ const float* arg_in(const Args& a, int k) { asm volatile("" : "+s"(k)); return a.in[k]; }
__global__ void __launch_bounds__(NWAVES * 64, 2) mega_fwd(Args args) {
    extern __shared__ __attribute__((aligned(16))) unsigned char lds_raw[];
    {
        LAS unsigned char* l0 = (LAS unsigned char*)lds_raw;
        for (int u = threadIdx.x; u < (LDS_BYTES - LDSCTL_OFF) / 4; u += NWAVES * 64) ((LAS unsigned*)(l0 + LDSCTL_OFF))[u] = 0u;
        __syncthreads();
    }
#if MK_ONE_LAUNCH
    (void)xcd_barrier_post((unsigned*)(args.ws + WS_CTL) + CW_BAR, (volatile LAS unsigned*)((LAS unsigned char*)lds_raw + LDSCTL_OFF + 64));
#define GRID_BAR() do { XcdBarrier bar_; bar_.bar = (unsigned*)(uni_ptr(args.ws) + WS_CTL) + CW_BAR; bar_.x = xb_xcc_id(); bar_.st = (volatile LAS unsigned*)((LAS unsigned char*)lds_raw + LDSCTL_OFF + 64); xcd_barrier(bar_); } while (0)
#else
#define GRID_BAR() do {} while (0)
#endif
    const int lo = args.ph_lo, hi = args.ph_hi;
#define IN(k) (lo <= (k) && (k) < hi)
#define SEAM(k) do { if (IN((k) + 1)) GRID_BAR(); } while (0)
#define PH_BEGIN \
    int tid_ = threadIdx.x; asm volatile("" : "+v"(tid_)); \
    Ctx F; F.lds = (LAS unsigned char*)lds_raw; F.tid = tid_; F.lane = tid_ & 63; F.wave = __builtin_amdgcn_readfirstlane(tid_ >> 6); \
    F.G = gridDim.x; F.bid = blockIdx.x; F.gw = F.bid * NWAVES + F.wave; F.ngw = F.G * NWAVES; \
    unsigned char* ws = uni_ptr(args.ws); asm volatile("" : "+s"(ws)); \
    int ly = __builtin_amdgcn_readfirstlane(layer); asm volatile("" : "+s"(ly)); (void)ly; (void)F
#define XN_ ((bf16_t*)(ws + WS_XN))
#define P_ ((bf16_t*)(ws + WS_P))
#define HMETA_ ((float*)(ws + WS_HMETA))
#define RSTDQ_ ((float*)(ws + WS_RSTD))
#define RSTDKV_ ((float*)(ws + WS_RSTD) + R)
#define BM_ ((unsigned*)(ws + WS_BM))
#define WB_(off) ((bf16_t*)(ws + WS_WB + (off)))
#define OUT_ (args.out)
#define LAMBDA_INIT(ly) ((ly) == 0 ? 0.2f : (0.8f - 0.6f * 0.7408182206817179f))
#define HSRC_TOK(ly) ((ly) == 0 ? arg_in(args, 0) : (const float*)args.out)

#pragma unroll
    for (int layer = 0; layer < 2; ++layer) {
        const int pb = layer * PH_PER_LAYER;
        if (((PHMASK >> 0) & 1) && IN(pb + 0)) {
            PH_BEGIN;
            const float* meta = arg_in(args, 1);
            conv_matrix<1>(F, arg_in(args, 3) + (size_t)ly * DM * D_IN, DM, D_IN, WB_(WB_IN), arg_in(args, 2) + ly * DM);
            conv_matrix<0>(F, arg_in(args, 7) + (size_t)ly * 512 * 1536, 512, 1536, WB_(WB_QUP), arg_in(args, 5) + ly * 512);
            conv_matrix<0>(F, arg_in(args, 8) + (size_t)ly * 512 * 2048, 512, 2048, WB_(WB_KVUP), arg_in(args, 6) + ly * 512);
            for (int b = 0; b < 3; ++b) conv_matrix<0>(F, arg_in(args, 14) + ((size_t)ly * 3 + b) * 1024 * DM, 1024, DM, WB_(WB_BR) + (size_t)b * DM * 1024, nullptr);
            conv_matrix<0>(F, arg_in(args, 15) + (size_t)ly * DM * DM, DM, DM, WB_(WB_O), nullptr);
            conv_matrix<2>(F, arg_in(args, 17) + (size_t)ly * DM * 2 * DFF, DM, 2 * DFF, WB_(WB_F1), arg_in(args, 16) + ly * DM);
            conv_matrix<0>(F, arg_in(args, 18) + (size_t)ly * DFF * DM, DFF, DM, WB_(WB_F2), nullptr);
            unsigned zu = 0u; asm volatile("" : "+v"(zu)); const float zf = __uint_as_float(zu);
            for (int i = F.gw * 64 + F.lane; i < 112 * 2048 / 8; i += F.ngw * 64) *((u32x4*)(WB_(WB_IN) + (size_t)1168 * 2048) + i) = (u32x4){zu, zu, zu, zu};
            float* hmeta = HMETA_;
            if (ly == 0) {
                for (int i = F.gw * 64 + F.lane; i < MBLK * DM / 4; i += F.ngw * 64) { const int rr = i / (DM / 4); f32x4 v = (f32x4){zf, zf, zf, zf};
                    if (rr >= MBLK - NMETA) v = *((const f32x4*)meta + (i - (MBLK - NMETA) * (DM / 4))); *((f32x4*)hmeta + i) = v; }
            }
            const float* hsrc_tok = HSRC_TOK(ly);
            bf16_t* XN = XN_;
            for (int r = F.gw; r < R; r += F.ngw) {
                const float* src;
                if (r < MBLK) src = (ly == 0) ? (r >= MBLK - NMETA ? meta + (size_t)(r - (MBLK - NMETA)) * DM : nullptr) : hmeta + (size_t)r * DM;
                else src = hsrc_tok + (size_t)(r - MBLK) * DM;
                norm_row(src, XN + (size_t)r * DM, F.lane);
            }
            SEAM(pb + 0);
        }
        if (((PHMASK >> 1) & 1) && IN(pb + 1)) {
            PH_BEGIN;
            SchedPlain S{XN_, DM, WB_(WB_IN), DM, NPM, 5, F.G, F.bid, 0}; EpiP E{P_};
            pg8::gemm_phase(F.lds, S, E);
            SEAM(pb + 1);
        }
        if (((PHMASK >> 2) & 1) && IN(pb + 2)) {
            PH_BEGIN;
            { bf16_t* P = P_; float* rq = RSTDQ_; float* rkv = RSTDKV_;
              for (int r = F.gw; r < R; r += F.ngw) post1a_row(P, r, rq, rkv, F.lane); }
            VM_WAIT(); __syncthreads();
            SchedMlaUp S{P_, WB_(WB_QUP), WB_(WB_KVUP), F.G, F.bid}; EpiP E{P_};
            pg8::gemm_phase(F.lds, S, E);
            SEAM(pb + 2);
        }
        if (((PHMASK >> 3) & 1) && IN(pb + 3)) {
            PH_BEGIN;
            const float* mla_qkg = arg_in(args, 9) + ly * 2 * 192;
            bf16_t* P = P_; float* rq = RSTDQ_; float* rkv = RSTDKV_;
            for (int r = F.gw; r < R; r += F.ngw) post2_row(P, r, rq, rkv, mla_qkg, F.lane);
            SEAM(pb + 3);
        }
        if (((PHMASK >> 4) & 1) && IN(pb + 4)) {
            PH_BEGIN;
            bf16_t* P = P_;
            unsigned* ctr = (unsigned*)(ws + WS_CTL) + CW_Q + 64 * (ly * 4 + 0);
            LAS int* slot = (LAS int*)(F.lds + LDSCTL_OFF + 128);
            for (;;) {
                const int idx = fa::next_item(ctr, slot); if (idx >= 8 * 129) break;
                int h; fa::Item it;
                if (idx < 1024) { const int qb = 7 - (idx >> 7), rest = idx & 127; h = rest & 7; it = fa::make_item(false, rest >> 3, qb); } else { h = idx - 1024; it = fa::make_item(true, 0, 0); }
                bf16x8 qr[12]; fa::load_q<192>(P, it, C_QRAW + h * 192, qr);
                fa::attn_core<192, false>(P, it, qr, C_KVRAW + h * 256, C_KPEH + h * 64, C_KVRAW + h * 256 + 128, C_OA + h * 128, nullptr, F.lds);
            }
            SEAM(pb + 4);
        }
        if (((PHMASK >> 5) & 1) && IN(pb + 5)) {
            PH_BEGIN;
            SchedPlain S{XN_, DM, WB_(WB_IN) + (size_t)1280 * DM, DM, NPM, 28, F.G, F.bid, 1280}; EpiP E{P_};
            pg8::gemm_phase(F.lds, S, E);
            SEAM(pb + 5);
        }
        if (((PHMASK >> 6) & 1) && IN(pb + 6)) {
            PH_BEGIN;
            const float* dsa_qkg = arg_in(args, 10) + ly * 2 * 128; const float* diff_qkg = arg_in(args, 11) + ly * 2 * 128;
            bf16_t* P = P_;
            for (int r = F.gw; r < R; r += F.ngw) post1b_row(P, r, dsa_qkg, diff_qkg, F.lane);
            SEAM(pb + 6);
        }
        if (((PHMASK >> 7) & 1) && IN(pb + 7)) {
            PH_BEGIN;
            LAS float* iqs = (LAS float*)(F.lds + F.wave * 4352); LAS unsigned* keys = (LAS unsigned*)(F.lds + 8 * 4352 + F.wave * 8448);
            bf16_t* P = P_; unsigned* bm = BM_;
            for (int pass = 0; pass * F.ngw < NTOK; ++pass) { const int tok = deal_row(pass, F.gw, F.ngw); if (tok >= NTOK) continue; index_row(P, tok, bm, iqs, keys, F.lane); }
            SEAM(pb + 7);
        }
        if (((PHMASK >> 8) & 1) && IN(pb + 8)) {
            PH_BEGIN;
            bf16_t* P = P_; unsigned* bm = BM_;
            unsigned* ctr = (unsigned*)(ws + WS_CTL) + CW_Q + 64 * (ly * 4 + 1);
            LAS int* slot = (LAS int*)(F.lds + LDSCTL_OFF + 128);
            for (;;) {
                const int idx = fa::next_item(ctr, slot); if (idx >= 16 * 129) break;
                int hh; bool meta = false; fa::Item it; int b = 0, qb = 0;
                if (idx < 2048) { qb = 7 - (idx >> 8); const int rest = idx & 255; hh = (rest < 128) ? 8 + (rest & 7) : (rest & 7); b = (rest & 127) >> 3; it = fa::make_item(false, b, qb); }
                else { hh = idx - 2048; hh = hh < 8 ? 8 + hh : hh - 8; meta = true; it = fa::make_item(true, 0, 0); }
                if (hh < 8) {
                    bf16x8 qr[8]; fa::load_q<128>(P, it, C_DQ + hh * 128, qr);
                    fa::attn_core<128, true>(P, it, qr, C_DK + hh * 128, 0, C_DV + hh * 128, C_OB + hh * 128, meta ? nullptr : bm + (size_t)(b * SEQ + qb * 256) * BMW, F.lds);
                } else {
                    const int hj = hh - 8;
                    bf16x8 qr[8]; fa::load_q<128>(P, it, C_FQ + hj * 128, qr);
                    fa::attn_core<128, false>(P, it, qr, C_FK + hj * 128, 0, C_FV + (hj >> 1) * 256, C_FQ + hj * 128, nullptr, F.lds);
                    fa::attn_core<128, false>(P, it, qr, C_FK + hj * 128, 0, C_FV + (hj >> 1) * 256 + 128, C_IQ + hj * 128, nullptr, F.lds);
                }
            }
            SEAM(pb + 8);
        }
        if (((PHMASK >> 9) & 1) && IN(pb + 9)) {
            PH_BEGIN;
            const float* diff_lam = arg_in(args, 12) + ly * 4 * 128; const float* diff_subg = arg_in(args, 13) + ly * 256;
            const float lambda_init = LAMBDA_INIT(ly);
            const float s1 = wave_sum(diff_lam[F.lane] * diff_lam[128 + F.lane] + diff_lam[64 + F.lane] * diff_lam[192 + F.lane]);
            const float s2 = wave_sum(diff_lam[256 + F.lane] * diff_lam[384 + F.lane] + diff_lam[320 + F.lane] * diff_lam[448 + F.lane]);
            const float lam = __expf(s1) - __expf(s2) + lambda_init;
            bf16_t* P = P_;
            for (int r = F.gw; r < R; r += F.ngw) post3_row(P, r, diff_subg, lam, 1.f - lambda_init, F.lane);
            SEAM(pb + 9);
        }
#define GATE_PHASE(k, b) \
        if (((PHMASK >> 10) & 1) && IN(pb + (k))) { \
            PH_BEGIN; \
            SchedPlain S{XN_, DM, WB_(WB_G) + (size_t)(b) * 2048 * DM, DM, NPM, 8, F.G, F.bid, 0}; EpiGate E{(bf16_t*)(ws + WS_GS), arg_in(args, 4) + ly * 3 * DM + (b) * DM}; \
            pg8::gemm_phase(F.lds, S, E); \
            SEAM(pb + (k)); \
        }
#define BRANCH_PHASE(k, b, oc) \
        if (((PHMASK >> 10) & 1) && IN(pb + (k))) { \
            PH_BEGIN; \
            SchedPlain S{P_ + (oc), PW, WB_(WB_BR) + (size_t)(b) * DM * 1024, 1024, NPM, 8, F.G, F.bid, C_MERGED}; EpiGated E{P_, (const bf16_t*)(ws + WS_GS), (b) == 0 ? 1 : 0, ((DBG_BM >> (b)) & 1) ? 1.f : 0.f}; \
            pg8::gemm_phase(F.lds, S, E); \
            SEAM(pb + (k)); \
        }
        GATE_PHASE(10, 0) BRANCH_PHASE(11, 0, C_OA)
        GATE_PHASE(12, 1) BRANCH_PHASE(13, 1, C_OB)
        GATE_PHASE(14, 2) BRANCH_PHASE(15, 2, C_OC)
        if (((PHMASK >> 11) & 1) && IN(pb + 16)) {
            PH_BEGIN;
            SchedPlain S{P_ + C_MERGED, PW, WB_(WB_O), DM, NPM, 8, F.G, F.bid, 0}; EpiRes E{HSRC_TOK(ly), OUT_, HMETA_, DBG_SA};
            pg8::gemm_phase(F.lds, S, E);
            SEAM(pb + 16);
        }
        if (((PHMASK >> 12) & 1) && IN(pb + 17)) {
            PH_BEGIN;
            float* hmeta = HMETA_; float* out = OUT_; bf16_t* XN = XN_;
            for (int r = F.gw; r < R; r += F.ngw) norm_row(r < MBLK ? hmeta + (size_t)r * DM : out + (size_t)(r - MBLK) * DM, XN + (size_t)r * DM, F.lane);
            SEAM(pb + 17);
        }
        if (((PHMASK >> 13) & 1) && IN(pb + 18)) {
            PH_BEGIN;
            SchedPlain S{XN_, DM, WB_(WB_F1), DM, NPM, 44, F.G, F.bid, 0}; EpiSwiglu E{P_};
            pg8::gemm_phase(F.lds, S, E);
            SEAM(pb + 18);
        }
        if (((PHMASK >> 14) & 1) && IN(pb + 19)) {
            PH_BEGIN;
            SchedPlain S{P_, PW, WB_(WB_F2), DFF, NPM, 8, F.G, F.bid, 0}; EpiRes E{OUT_, OUT_, HMETA_, DBG_SF};
            pg8::gemm_phase(F.lds, S, E);
            SEAM(pb + 19);
        }
    }
#undef IN
#undef SEAM
}

__global__ void diag_fill(float* out, int n, float v) { for (int i = blockIdx.x * blockDim.x + threadIdx.x; i < n; i += gridDim.x * blockDim.x) out[i] = v; }
extern "C" void kernel_launch(void* const* d_in, const int* in_sizes, int n_in, void* d_out, int out_size, void* d_ws, size_t ws_size, hipStream_t stream) {
    static int grid = 0; static float code = 0.f;
    if (grid == 0) {
        int dev = 0, cus = 0;
        if (n_in != 19) { code = 10.f; grid = -1; }
        else if (ws_size < WS_END) { code = 20.f + (float)(ws_size >> 20) * 0.01f; grid = -1; }
        else if (hipGetDevice(&dev) != hipSuccess || hipDeviceGetAttribute(&cus, hipDeviceAttributeMultiprocessorCount, dev) != hipSuccess) { code = 40.f; grid = -1; }
        else if (hipFuncSetAttribute((const void*)mega_fwd, hipFuncAttributeMaxDynamicSharedMemorySize, LDS_BYTES) != hipSuccess) { code = 50.f; grid = -1; }
        else {
            int per_cu = 0;
            if (hipOccupancyMaxActiveBlocksPerMultiprocessor(&per_cu, (const void*)mega_fwd, NWAVES * 64, LDS_BYTES) != hipSuccess || per_cu < 1) { code = 60.f; grid = -1; }
            (void)hipGetLastError();
            if (grid == 0) grid = cus;
        }
    }
    if (grid < 0) { hipLaunchKernelGGL(diag_fill, dim3(1024), dim3(256), 0, stream, (float*)d_out, out_size, code); return; }
    (void)hipMemsetAsync((char*)d_ws + WS_CTL, 0, CTL_BYTES, stream);
    Args a{};
    for (int i = 0; i < 19; ++i) a.in[i] = (const float*)d_in[i];
    a.out = (float*)d_out; a.ws = (unsigned char*)d_ws;
#if MK_ONE_LAUNCH
    a.ph_lo = 0; a.ph_hi = N_PHASES;
    hipLaunchKernelGGL(mega_fwd, dim3(grid), dim3(NWAVES * 64), LDS_BYTES, stream, a);
#else
    for (int p = 0; p < N_PHASES; ++p) { a.ph_lo = p; a.ph_hi = p + 1; hipLaunchKernelGGL(mega_fwd, dim3(grid), dim3(NWAVES * 64), LDS_BYTES, stream, a); }
#endif
    if (hipPeekAtLastError() != hipSuccess) { (void)hipGetLastError(); hipLaunchKernelGGL(diag_fill, dim3(1024), dim3(256), 0, stream, (float*)d_out, out_size, 70.f); }
}
```

```cpp
#include <hip/hip_runtime.h>
#include <cstdio>
#include <cstdint>

#ifndef PHMASK
#define PHMASK 0x7fff
#endif
#ifndef DBG_BM
#define DBG_BM 7
#endif
#ifndef DBG_BR
#define DBG_BR 0
#endif
#ifndef DBG_SA
#define DBG_SA 1.0f
#endif
#ifndef DBG_SF
#define DBG_SF 1.0f
#endif
#ifndef MK_ONE_LAUNCH
#define MK_ONE_LAUNCH 1
#endif

#define LAS __attribute__((address_space(3)))
#define GAS __attribute__((address_space(1)))
typedef unsigned short bf16_t;
typedef short bf16x8 __attribute__((ext_vector_type(8)));
typedef float f32x4 __attribute__((ext_vector_type(4)));
typedef float f32x2 __attribute__((ext_vector_type(2)));
typedef unsigned u32x4 __attribute__((ext_vector_type(4)));
typedef unsigned u32x2 __attribute__((ext_vector_type(2)));

constexpr int DM = 2048, NB = 16, SEQ = 2048, NMETA = 16, MBLK = 256;
constexpr int R = MBLK + NB * SEQ;
constexpr int NPM = R / 256;
constexpr int NTOK = NB * SEQ;
constexpr int DFF = 5632;
constexpr int PW = 8448;
constexpr int C_CQ = 0, C_CKV = 512, C_KPE = 1024, C_IK = 1088, C_IW = 1152, C_DQ = 1280, C_DK = 2304, C_DV = 3328, C_IQ = 4352,
              C_FQ = 5376, C_FK = 6400, C_FV = 7424;
constexpr int C_KVRAW = 1280, C_QRAW = 3328, C_KPEH = 4864;
constexpr int C_OA = 0, C_OB = C_DQ, C_OC = C_FQ, C_MERGED = 2304;
constexpr int BMW = 66;
constexpr float EPS = 1e-6f;
constexpr float LOG2E = 1.4426950408889634f;
constexpr float C2_128 = 0.08838834764831845f * LOG2E;
constexpr float C2_192 = 0.07216878364870323f * LOG2E;
constexpr int D_IN = 14480;

constexpr size_t MiB = 1u << 20;
constexpr size_t WS_CTL = 0, CTL_BYTES = 1 * MiB;
constexpr size_t WS_RSTD = 1 * MiB;
constexpr size_t WS_HMETA = 2 * MiB;
constexpr size_t WS_BM = 4 * MiB;
constexpr size_t WS_WB = 16 * MiB;
constexpr size_t WB_IN = 0, WB_G = WB_IN + (size_t)8448 * 2048 * 2, WB_QUP = WB_G + (size_t)6144 * 2048 * 2, WB_KVUP = WB_QUP + (size_t)1536 * 512 * 2,
                 WB_BR = WB_KVUP + (size_t)2048 * 512 * 2, WB_O = WB_BR + (size_t)3 * 2048 * 1024 * 2, WB_F1 = WB_O + (size_t)2048 * 2048 * 2,
                 WB_F2 = WB_F1 + (size_t)11264 * 2048 * 2, WB_END = WB_F2 + (size_t)2048 * 5632 * 2;
constexpr size_t WS_XN = 164 * MiB;
constexpr size_t WS_P = 294 * MiB;
constexpr size_t WS_GS = 828 * MiB;
constexpr size_t WS_END = 960 * MiB;
static_assert(WS_GS + (size_t)R * 2048 * 2 <= WS_END && WS_WB + WB_END <= WS_XN && WS_XN + (size_t)R * 2048 * 2 <= WS_P && WS_P + (size_t)R * PW * 2 <= WS_GS, "ws map");
constexpr int CW_BAR = 4096, CW_Q = 16384;

__device__ __forceinline__ float bf2f(bf16_t v) { return __uint_as_float((unsigned)v << 16); }
__device__ __forceinline__ unsigned f2bf(float f) { unsigned u = __float_as_uint(f); return (u + 0x7fffu + ((u >> 16) & 1u)) >> 16; }
__device__ __forceinline__ unsigned pk2(float lo, float hi) { return f2bf(lo) | (f2bf(hi) << 16); }
typedef __bf16 bf16x2_t __attribute__((ext_vector_type(2)));
__device__ __forceinline__ unsigned cvt_pk_bf16(float lo, float hi) { f32x2 v = {lo, hi}; bf16x2_t b = __builtin_convertvector(v, bf16x2_t); return __builtin_bit_cast(unsigned, b); }
__device__ __forceinline__ float wave_sum(float v) {
#pragma unroll
    for (int o = 1; o < 64; o <<= 1) v += __shfl_xor(v, o);
    return v;
}
__device__ __forceinline__ float wave_max(float v) {
#pragma unroll
    for (int o = 1; o < 64; o <<= 1) v = fmaxf(v, __shfl_xor(v, o));
    return v;
}
#define LDS_WAIT() asm volatile("s_waitcnt lgkmcnt(0)" ::: "memory")
#define VM_WAIT() asm volatile("s_waitcnt vmcnt(0)" ::: "memory")
__device__ __forceinline__ int row_pos(int r) { return r < MBLK ? (r >= MBLK - NMETA ? r - (MBLK - NMETA) : 0) : NMETA + ((r - MBLK) & (SEQ - 1)); }
__device__ __forceinline__ void rope_cs(int pos, int i, float two_over_d, float& c, float& s) {
    const float inv = __builtin_amdgcn_exp2f(-(float)i * two_over_d * 13.287712379549449f);
    float rev = (float)pos * inv * 0.15915494309189535f;
    rev -= floorf(rev);
    s = __builtin_amdgcn_sinf(rev); c = __builtin_amdgcn_cosf(rev);
}

namespace pg8 {
constexpr int BM = 256, BK = 64, HALF = 128, HTB = HALF * BK * 2, STAGE_BYTES = 8 * HTB;
__device__ __forceinline__ int lds_byte(int r, int c) { const int st = (r >> 4) * 2 + (c >> 5), rr = r & 15, cc = c & 31, ob = rr * 64 + cc * 2; return st * 1024 + (ob ^ (((ob >> 9) & 1) << 5)); }
__device__ __forceinline__ void stage_rc(int b, int& R_, int& C_) { const int st = b / 1024, sb = b % 1024, swz = sb ^ (((sb >> 9) & 1) << 5); R_ = (st >> 1) * 16 + swz / 64; C_ = (st & 1) * 32 + (swz % 64) / 2; }
__device__ __forceinline__ int perm32(int rho) { const int n = rho >> 4, i = rho & 15; return 8 * (i >> 2) + 4 * n + (i & 3); }

struct Unit { const char* A; const char* B; unsigned lda2, ldb2; int nt, pm, pn, kind, ocol; };

__device__ __forceinline__ void tile_of(int L, int nM, int nN, int& pm, int& pn) {
    const int nwg = nM * nN; int wgid = L;
    { const int q = nwg / 8, r = nwg % 8, xcd = wgid % 8, off = wgid / 8; wgid = (xcd < r ? xcd * (q + 1) : r * (q + 1) + (xcd - r) * q) + off; }
    const int nig = 8 * nN, gid = wgid / nig, fm = gid * 8, gsz = (nM - fm) < 8 ? (nM - fm) : 8;
    pm = fm + ((wgid % nig) % gsz); pn = (wgid % nig) / gsz;
}

template <class Epi, class Sched>
__device__ __forceinline__ void gemm_phase(LAS unsigned char* lds, const Sched& S, const Epi& E) {
    int tid = threadIdx.x; asm volatile("" : "+v"(tid));
    const int wid = __builtin_amdgcn_readfirstlane(tid >> 6), lane = tid & 63, wr = wid >> 2, wc = wid & 3, fr = lane & 15, fq = lane >> 4;
    unsigned rA[2], rB[2], cc[2];
#pragma unroll
    for (int i = 0; i < 2; ++i) { int R_, C_; stage_rc(tid * 16 + i * 8192, R_, C_); rA[i] = (unsigned)R_; rB[i] = (unsigned)(Epi::PERM ? ((R_ & ~31) + perm32(R_ & 31)) : R_); cc[i] = (unsigned)C_ * 2u; }
    const size_t kstep = (size_t)(BK * 2);
    const unsigned ldsw = (unsigned)wid * 1024u;
    const int aoff = lds_byte(wr * 64 + fr, fq * 8), boff = lds_byte(wc * 32 + fr, fq * 8);
#define PG8_SA(b, h) (((b) * 2 + (h)) * HTB)
#define PG8_SB(b, h) ((4 + (b) * 2 + (h)) * HTB)
#define PG8_STAGE(bufoff, gbase, rr, ld2) do { _Pragma("unroll") for (int _i = 0; _i < 2; ++_i) \
        __builtin_amdgcn_global_load_lds((const unsigned*)((const char*)(gbase) + ((rr)[_i] * (ld2) + cc[_i])), (LAS unsigned*)(lds + (bufoff) + ldsw + _i * 8192), 16, 0, 0); } while (0)
#define PG8_LDA(dst, b, h) do { _Pragma("unroll") for (int m = 0; m < 4; ++m) _Pragma("unroll") for (int k = 0; k < 2; ++k) dst[m][k] = *(const LAS bf16x8*)(lds + PG8_SA(b, h) + aoff + m * 2048 + k * 1024); } while (0)
#define PG8_LDB(dst, b, h) do { _Pragma("unroll") for (int n = 0; n < 2; ++n) _Pragma("unroll") for (int k = 0; k < 2; ++k) dst[n][k] = *(const LAS bf16x8*)(lds + PG8_SB(b, h) + boff + n * 2048 + k * 1024); } while (0)
#define PG8_MMA(ai, bj, At, Bt) do { __builtin_amdgcn_s_setprio(1); _Pragma("unroll") for (int m = 0; m < 4; ++m) _Pragma("unroll") for (int n = 0; n < 2; ++n) _Pragma("unroll") for (int k = 0; k < 2; ++k) \
        acc[ai][bj][m][n] = __builtin_amdgcn_mfma_f32_16x16x32_bf16(Bt[n][k], At[m][k], acc[ai][bj][m][n], 0, 0, 0); __builtin_amdgcn_s_setprio(0); } while (0)
#define PG8_WAIT_V(n) asm volatile("s_waitcnt vmcnt(" #n ")" ::: "memory")
#define PG8_WAIT_L(n) asm volatile("s_waitcnt lgkmcnt(" #n ")" ::: "memory")
#define PG8_BAR __builtin_amdgcn_s_barrier()
#define PG8_SCHED __builtin_amdgcn_sched_barrier(0)
    Unit cur, nxt; int ui = 0;
    if (!S.next(0, cur)) return;
    float zf = 0.f; asm volatile("" : "+v"(zf));
    f32x4 acc[2][2][4][2];
#pragma unroll
    for (int a = 0; a < 2; ++a)
#pragma unroll
        for (int b = 0; b < 2; ++b)
#pragma unroll
            for (int m = 0; m < 4; ++m)
#pragma unroll
                for (int n = 0; n < 2; ++n) acc[a][b][m][n] = (f32x4){zf, zf, zf, zf};
    bf16x8 At[4][2], B0[2][2], B1[2][2];
    const char* cA = cur.A; const char* cB = cur.B;
    unsigned lA = cur.lda2, lB = cur.ldb2;
    size_t hA = (size_t)HALF * lA, hB = (size_t)HALF * lB;
    PG8_STAGE(PG8_SB(0, 0), cB, rB, lB); PG8_STAGE(PG8_SB(0, 1), cB + hB, rB, lB); PG8_STAGE(PG8_SA(0, 0), cA, rA, lA); PG8_STAGE(PG8_SA(0, 1), cA + hA, rA, lA);
    if (wr == 1) PG8_BAR;
    PG8_WAIT_V(2); PG8_BAR;
    PG8_STAGE(PG8_SB(1, 0), cB + kstep, rB, lB); PG8_STAGE(PG8_SA(1, 0), cA + kstep, rA, lA); PG8_STAGE(PG8_SB(1, 1), cB + hB + kstep, rB, lB);
    PG8_WAIT_V(6); PG8_BAR;
    for (;;) {
        const bool has_next = S.next(ui + 1, nxt);
        if (!has_next) nxt = cur;
        const char* nA = nxt.A; const char* nB = nxt.B;
        const unsigned lAn = nxt.lda2, lBn = nxt.ldb2;
        const size_t hAn = (size_t)HALF * lAn, hBn = (size_t)HALF * lBn;
        const int nt = cur.nt;
        for (int t = 0; t < nt; t += 2) {
            const bool last = (t == nt - 2);
            const char* a1 = cA + (size_t)(t + 1) * kstep;
            const char* a2 = last ? nA : cA + (size_t)(t + 2) * kstep; const char* b2 = last ? nB : cB + (size_t)(t + 2) * kstep;
            const char* a3 = a2 + kstep; const char* b3 = b2 + kstep;
            const size_t hA2 = last ? hAn : hA, hB2 = last ? hBn : hB;
            const unsigned lA2 = last ? lAn : lA, lB2 = last ? lBn : lB;
            PG8_LDB(B0, 0, 0); PG8_LDB(B1, 0, 1); PG8_SCHED; PG8_LDA(At, 0, 0); PG8_STAGE(PG8_SA(1, 1), a1 + hA, rA, lA);
            PG8_WAIT_V(8); PG8_WAIT_L(0); PG8_BAR; PG8_MMA(0, 0, At, B0); PG8_MMA(0, 1, At, B1); PG8_BAR; PG8_SCHED;
            PG8_LDA(At, 0, 1); PG8_STAGE(PG8_SB(0, 0), b2, rB, lB2); PG8_STAGE(PG8_SB(0, 1), b2 + hB2, rB, lB2); PG8_STAGE(PG8_SA(0, 0), a2, rA, lA2);
            PG8_WAIT_V(8); PG8_WAIT_L(0); PG8_BAR; PG8_MMA(1, 0, At, B0); PG8_MMA(1, 1, At, B1); PG8_BAR; PG8_SCHED;
            PG8_LDB(B0, 1, 0); PG8_LDB(B1, 1, 1); PG8_SCHED; PG8_LDA(At, 1, 0); PG8_STAGE(PG8_SA(0, 1), a2 + hA2, rA, lA2);
            PG8_WAIT_V(8); PG8_WAIT_L(0); PG8_BAR; PG8_MMA(0, 0, At, B0); PG8_MMA(0, 1, At, B1); PG8_BAR; PG8_SCHED;
            PG8_LDA(At, 1, 1); PG8_STAGE(PG8_SB(1, 0), b3, rB, lB2); PG8_STAGE(PG8_SB(1, 1), b3 + hB2, rB, lB2); PG8_STAGE(PG8_SA(1, 0), a3, rA, lA2);
            PG8_WAIT_V(8); PG8_WAIT_L(0); PG8_BAR; PG8_MMA(1, 0, At, B0); PG8_MMA(1, 1, At, B1); PG8_BAR; PG8_SCHED;
        }
        if (wr == 0) PG8_BAR;
        E(acc, cur, wr, wc, fr, fq);
#pragma unroll
        for (int a = 0; a < 2; ++a)
#pragma unroll
            for (int b = 0; b < 2; ++b)
#pragma unroll
                for (int m = 0; m < 4; ++m)
#pragma unroll
                    for (int n = 0; n < 2; ++n) acc[a][b][m][n] = (f32x4){zf, zf, zf, zf};
        if (!has_next) break;
        cur = nxt; cA = nA; cB = nB; hA = hAn; hB = hBn; lA = lAn; lB = lBn; ++ui;
        if (wr == 1) PG8_BAR;
    }
    PG8_WAIT_V(0);
    PG8_BAR;
#undef PG8_SA
#undef PG8_SB
#undef PG8_STAGE
#undef PG8_LDA
#undef PG8_LDB
#undef PG8_MMA
#undef PG8_WAIT_V
#undef PG8_WAIT_L
#undef PG8_BAR
#undef PG8_SCHED
}
}
using pg8::Unit;

struct SchedPlain {
    const bf16_t* A; int lda; const bf16_t* B; int K; int nM, nN, G, c, ocol0;
    __device__ __forceinline__ bool next(int i, Unit& u) const {
        const int L = i * G + c; if (L >= nM * nN) return false;
        int pm, pn; pg8::tile_of(L, nM, nN, pm, pn);
        u.pm = pm; u.pn = pn; u.kind = 0; u.ocol = ocol0 + 256 * pn; u.nt = K / 64; u.lda2 = (unsigned)lda * 2u; u.ldb2 = (unsigned)K * 2u;
        u.A = (const char*)(A + (size_t)pm * 256 * lda); u.B = (const char*)(B + (size_t)pn * 256 * K); return true;
    }
};
struct SchedMlaUp {
    const bf16_t* P; const bf16_t* Wq; const bf16_t* Wkv; int G, c;
    __device__ __forceinline__ bool next(int i, Unit& u) const {
        const int L = i * G + c; if (L >= NPM * 14) return false;
        int pm, pn; pg8::tile_of(L, NPM, 14, pm, pn);
        u.pm = pm; u.pn = pn; u.kind = 0; u.nt = 8; u.lda2 = PW * 2u; u.ldb2 = 512 * 2u;
        if (pn < 6) { u.A = (const char*)(P + (size_t)pm * 256 * PW + C_CQ); u.B = (const char*)(Wq + (size_t)pn * 256 * 512); u.ocol = C_QRAW + 256 * pn; }
        else { u.A = (const char*)(P + (size_t)pm * 256 * PW + C_CKV); u.B = (const char*)(Wkv + (size_t)(pn - 6) * 256 * 512); u.ocol = C_KVRAW + 256 * (pn - 6); }
        return true;
    }
};
struct EpiP {
    static constexpr bool PERM = true;
    bf16_t* P;
    __device__ __forceinline__ void operator()(const f32x4 (&acc)[2][2][4][2], const Unit& u, int wr, int wc, int fr, int fq) const {
        asm volatile("" : "+v"(fr), "+v"(fq));
        const int row0 = u.pm * 256 + wr * 64 + fr, col0 = u.ocol + wc * 32 + 8 * fq;
#pragma unroll
        for (int ai = 0; ai < 2; ++ai)
#pragma unroll
            for (int m = 0; m < 4; ++m) { bf16_t* rowp = P + (size_t)(row0 + ai * 128 + m * 16) * PW + col0;
#pragma unroll
                for (int bj = 0; bj < 2; ++bj) { const f32x4 v0 = acc[ai][bj][m][0], v1 = acc[ai][bj][m][1];
                    u32x4 w; w.x = cvt_pk_bf16(v0[0], v0[1]); w.y = cvt_pk_bf16(v0[2], v0[3]); w.z = cvt_pk_bf16(v1[0], v1[1]); w.w = cvt_pk_bf16(v1[2], v1[3]);
                    *(u32x4*)(rowp + bj * 128) = w; } }
    }
};
struct EpiGate {
    static constexpr bool PERM = true;
    bf16_t* G; const float* bias;
    __device__ __forceinline__ void operator()(const f32x4 (&acc)[2][2][4][2], const Unit& u, int wr, int wc, int fr, int fq) const {
        asm volatile("" : "+v"(fr), "+v"(fq));
        const int row0 = u.pm * 256 + wr * 64 + fr, col0 = u.pn * 256 + wc * 32 + 8 * fq;
#pragma unroll
        for (int bj = 0; bj < 2; ++bj) { const f32x4 bv0 = *(const f32x4*)(bias + col0 + bj * 128), bv1 = *(const f32x4*)(bias + col0 + bj * 128 + 4);
#pragma unroll
            for (int ai = 0; ai < 2; ++ai)
#pragma unroll
                for (int m = 0; m < 4; ++m) { bf16_t* rowp = G + (size_t)(row0 + ai * 128 + m * 16) * 2048 + col0; f32x4 v0 = acc[ai][bj][m][0] + bv0, v1 = acc[ai][bj][m][1] + bv1;
#pragma unroll
                    for (int e = 0; e < 4; ++e) { v0[e] = __builtin_amdgcn_rcpf(1.f + __builtin_amdgcn_exp2f(-v0[e] * LOG2E)); v1[e] = __builtin_amdgcn_rcpf(1.f + __builtin_amdgcn_exp2f(-v1[e] * LOG2E)); }
                    u32x4 w; w.x = cvt_pk_bf16(v0[0], v0[1]); w.y = cvt_pk_bf16(v0[2], v0[3]); w.z = cvt_pk_bf16(v1[0], v1[1]); w.w = cvt_pk_bf16(v1[2], v1[3]);
                    *(u32x4*)(rowp + bj * 128) = w; } }
    }
};
struct EpiGated {
    static constexpr bool PERM = true;
    bf16_t* P; const bf16_t* G; int first; float sc;
    __device__ __forceinline__ void operator()(const f32x4 (&acc)[2][2][4][2], const Unit& u, int wr, int wc, int fr, int fq) const {
        asm volatile("" : "+v"(fr), "+v"(fq));
        const int row0 = u.pm * 256 + wr * 64 + fr, lcol0 = u.pn * 256 + wc * 32 + 8 * fq, col0 = u.ocol + wc * 32 + 8 * fq;
        unsigned zu = 0u; asm volatile("" : "+v"(zu));
#pragma unroll
        for (int ai = 0; ai < 2; ++ai)
#pragma unroll
            for (int m = 0; m < 4; ++m) { bf16_t* rowp = P + (size_t)(row0 + ai * 128 + m * 16) * PW + col0; const bf16_t* gp = G + (size_t)(row0 + ai * 128 + m * 16) * 2048 + lcol0;
#pragma unroll
                for (int bj = 0; bj < 2; ++bj) { u32x4 g = *(const u32x4*)(gp + bj * 128); if (DBG_BR == 1) g = (u32x4){0x3f803f80u, 0x3f803f80u, 0x3f803f80u, 0x3f803f80u};
                    u32x4 pv = (u32x4){zu, zu, zu, zu}; if (!first) pv = *(const u32x4*)(rowp + bj * 128);
                    const f32x4 v0 = acc[ai][bj][m][0] * sc, v1 = acc[ai][bj][m][1] * sc;
                    float o[8];
                    o[0] = __uint_as_float(pv.x << 16) + __uint_as_float(g.x << 16) * v0[0]; o[1] = __uint_as_float(pv.x & 0xffff0000u) + __uint_as_float(g.x & 0xffff0000u) * v0[1];
                    o[2] = __uint_as_float(pv.y << 16) + __uint_as_float(g.y << 16) * v0[2]; o[3] = __uint_as_float(pv.y & 0xffff0000u) + __uint_as_float(g.y & 0xffff0000u) * v0[3];
                    o[4] = __uint_as_float(pv.z << 16) + __uint_as_float(g.z << 16) * v1[0]; o[5] = __uint_as_float(pv.z & 0xffff0000u) + __uint_as_float(g.z & 0xffff0000u) * v1[1];
                    o[6] = __uint_as_float(pv.w << 16) + __uint_as_float(g.w << 16) * v1[2]; o[7] = __uint_as_float(pv.w & 0xffff0000u) + __uint_as_float(g.w & 0xffff0000u) * v1[3];
                    u32x4 w; w.x = cvt_pk_bf16(o[0], o[1]); w.y = cvt_pk_bf16(o[2], o[3]); w.z = cvt_pk_bf16(o[4], o[5]); w.w = cvt_pk_bf16(o[6], o[7]);
                    *(u32x4*)(rowp + bj * 128) = w; }
                asm volatile("" ::: "memory"); }
    }
};
struct EpiRes {
    static constexpr bool PERM = false;
    const float* base_tok; float* out_tok; float* hmeta; float dbg;
    __device__ __forceinline__ void operator()(const f32x4 (&acc)[2][2][4][2], const Unit& u, int wr, int wc, int fr, int fq) const {
        asm volatile("" : "+v"(fr), "+v"(fq));
        const float* bp; float* op;
        if (u.pm == 0) { bp = hmeta; op = hmeta; } else { bp = base_tok + (size_t)(u.pm - 1) * 256 * DM; op = out_tok + (size_t)(u.pm - 1) * 256 * DM; }
        const int lrow0 = wr * 64 + fr, col0 = u.pn * 256 + wc * 32 + 4 * fq;
#pragma unroll
        for (int ai = 0; ai < 2; ++ai)
#pragma unroll
            for (int m = 0; m < 4; ++m) { const size_t off = (size_t)(lrow0 + ai * 128 + m * 16) * DM + col0;
#pragma unroll
                for (int bj = 0; bj < 2; ++bj)
#pragma unroll
                    for (int n = 0; n < 2; ++n) { const f32x4 bs = *(const f32x4*)(bp + off + bj * 128 + n * 16); *(f32x4*)(op + off + bj * 128 + n * 16) = bs + acc[ai][bj][m][n] * dbg; }
                asm volatile("" ::: "memory"); }
    }
};
struct EpiSwiglu {
    static constexpr bool PERM = true;
    bf16_t* P;
    __device__ __forceinline__ void operator()(const f32x4 (&acc)[2][2][4][2], const Unit& u, int wr, int wc, int fr, int fq) const {
        asm volatile("" : "+v"(fr), "+v"(fq));
        const int row0 = u.pm * 256 + wr * 64 + fr, col0 = u.pn * 128 + wc * 32 + 8 * fq;
#pragma unroll
        for (int ai = 0; ai < 2; ++ai)
#pragma unroll
            for (int m = 0; m < 4; ++m) { bf16_t* rowp = P + (size_t)(row0 + ai * 128 + m * 16) * PW + col0;
                float o[8];
#pragma unroll
                for (int n = 0; n < 2; ++n)
#pragma unroll
                    for (int e = 0; e < 4; ++e) { const float g = acc[ai][0][m][n][e], up = acc[ai][1][m][n][e]; o[n * 4 + e] = g * __builtin_amdgcn_rcpf(1.f + __builtin_amdgcn_exp2f(-g * LOG2E)) * up; }
                u32x4 w; w.x = cvt_pk_bf16(o[0], o[1]); w.y = cvt_pk_bf16(o[2], o[3]); w.z = cvt_pk_bf16(o[4], o[5]); w.w = cvt_pk_bf16(o[6], o[7]);
                *(u32x4*)rowp = w; }
    }
};

#define XB_TMO      128
#define XB_XCNT(j)  (256  + 64 * (j))
#define XB_XSUB(j)  (1280 + 64 * (j))
#define XB_XGEN(j)  (2304 + 64 * (j))
#define XB_TOP      3328
#define XB_TOPGEN   3392
#define XCD_BAR_WORDS 3456
#define XB_SPIN_CAP (1u << 18)
__device__ __forceinline__ unsigned xb_ld(unsigned* p)              { return __hip_atomic_load(p, __ATOMIC_RELAXED, __HIP_MEMORY_SCOPE_AGENT); }
__device__ __forceinline__ unsigned xb_add(unsigned* p, unsigned v) { return __hip_atomic_fetch_add(p, v, __ATOMIC_RELAXED, __HIP_MEMORY_SCOPE_AGENT); }
__device__ __forceinline__ unsigned xb_xcc_id() { return (unsigned)__builtin_amdgcn_s_getreg((3 << 11) | 20) & 0xFu; }
#define XB_SPIN(cond, bar) do { unsigned _sp = 0; while (cond) { __builtin_amdgcn_s_sleep(1); \
    if ((++_sp & 255u) == 0u) { if (xb_ld(&(bar)[XB_TMO])) break; if (_sp > XB_SPIN_CAP) { atomicAdd(&(bar)[XB_TMO], 1u); break; } } } } while (0)
struct XcdBarrier { unsigned* bar; unsigned x; volatile LAS unsigned* st; };
__device__ __forceinline__ XcdBarrier xcd_barrier_post(unsigned* bar, volatile LAS unsigned* st) {
    XcdBarrier b; b.bar = bar; b.x = xb_xcc_id(); b.st = st;
    if (threadIdx.x == 0) (void)xb_add(&bar[XB_XCNT(b.x)], 1u);
    return b;
}
__device__ __forceinline__ void xcd_barrier_complete(unsigned* bar, unsigned x, unsigned& nloc, unsigned& nx) {
    const unsigned G = gridDim.x * gridDim.y * gridDim.z;
    unsigned sum, cnt, mine, sp = 0u;
    for (;;) {
        sum = 0u; cnt = 0u; mine = 0u;
#pragma unroll
        for (unsigned j = 0; j < 16; ++j) { const unsigned c = xb_ld(&bar[XB_XCNT(j)]); sum += c; cnt += (c > 0u) ? 1u : 0u; mine = (j == x) ? c : mine; }
        if (sum == G) break;
        __builtin_amdgcn_s_sleep(1);
        if ((++sp & 255u) == 0u) { if (xb_ld(&bar[XB_TMO])) break; if (sp > XB_SPIN_CAP) { atomicAdd(&bar[XB_TMO], 1u); break; } }
    }
    nloc = mine > 0u ? mine : 1u; nx = cnt > 0u ? cnt : 1u;
}
__device__ __forceinline__ void xcd_barrier(const XcdBarrier& b) {
    asm volatile("s_waitcnt vmcnt(0)" ::: "memory");
    __syncthreads();
    if (threadIdx.x == 0) {
        unsigned* bar = b.bar;
        __builtin_amdgcn_s_waitcnt(0);
        unsigned nloc = b.st[0], nx = b.st[1];
        if (nloc == 0u) { xcd_barrier_complete(bar, b.x, nloc, nx); b.st[0] = nloc; b.st[1] = nx; }
        const unsigned old = xb_add(&bar[XB_XSUB(b.x)], 1u);
        const unsigned gen = old / nloc;
        if (old + 1u == (gen + 1u) * nloc) {
            __builtin_amdgcn_fence(__ATOMIC_RELEASE, "agent");
            asm volatile("s_waitcnt vmcnt(0)" ::: "memory");
            const unsigned og = xb_add(&bar[XB_TOP], 1u);
            const unsigned tg = og / nx;
            if (og + 1u == (tg + 1u) * nx) xb_add(&bar[XB_TOPGEN], 1u);
            else XB_SPIN(xb_ld(&bar[XB_TOPGEN]) == tg, bar);
            __builtin_amdgcn_fence(__ATOMIC_ACQUIRE, "agent");
            xb_add(&bar[XB_XGEN(b.x)], 1u);
            asm volatile("s_waitcnt vmcnt(0)" ::: "memory");
        } else {
            XB_SPIN(xb_ld(&bar[XB_XGEN(b.x)]) == gen, bar);
            __builtin_amdgcn_fence(__ATOMIC_ACQUIRE, "agent");
            asm volatile("s_waitcnt vmcnt(0)" ::: "memory");
        }
    }
    __syncthreads();
}

constexpr int NWAVES = 8;
constexpr int RING_BYTES = 131072, LDS_BYTES = 147456, LDSCTL_OFF = LDS_BYTES - 512;
struct Args {
    const float* in[19]; float* out; unsigned char* ws; int ph_lo, ph_hi;
};
struct Ctx {
    LAS unsigned char* lds; int tid, lane, wave, gw, ngw, G, bid;
};

template <int MAP> __device__ __forceinline__ int wmap(int n, float& sc) {
    sc = 1.f;
    if (MAP == 0) return n;
    if (MAP == 1) {
        if (n < 1088) return n;
        if (n < 4160) return 1280 + (n - 1088);
        if (n < 5184) return 4352 + (n - 4160);
        if (n < 5248) return 1088 + (n - 5184);
        if (n < 5264) { sc = 0.03125f; return 1152 + (n - 5248); }
        if (n < 8336) return 5376 + (n - 5264);
        return 8448 + (n - 8336);
    }
    if (n < DFF) return (n >> 7) * 256 + (n & 127);
    const int m = n - DFF; return (m >> 7) * 256 + 128 + (m & 127);
}
template <int MAP> __device__ __forceinline__ void conv_item(const float* W, int K, int N, bf16_t* WT, const float* gain, LAS float* scr, int item, int lane) {
    const int nblk = (N + 31) / 32, kb = item / nblk, nb = item - kb * nblk, k0 = 64 * kb, n0 = 32 * nb;
    const int nn = n0 + (lane & 31);
#pragma unroll 8
    for (int i = 0; i < 32; ++i) { const int kk = 2 * i + (lane >> 5); float v = 0.f; if (nn < N) { v = W[(size_t)(k0 + kk) * N + nn]; if (gain) v *= gain[k0 + kk]; } scr[kk * 33 + (lane & 31)] = v; }
    LDS_WAIT(); asm volatile("" ::: "memory");
    const int c = lane & 7;
#pragma unroll
    for (int j = 0; j < 4; ++j) { const int n = (lane >> 3) + 8 * j; const int ns = n0 + n;
        if (ns < N) { float sc; const int dst = wmap<MAP>(ns, sc); const LAS float* s = scr + (8 * c) * 33 + n;
            u32x4 o; o.x = pk2(s[0 * 33] * sc, s[1 * 33] * sc); o.y = pk2(s[2 * 33] * sc, s[3 * 33] * sc); o.z = pk2(s[4 * 33] * sc, s[5 * 33] * sc); o.w = pk2(s[6 * 33] * sc, s[7 * 33] * sc);
            *(u32x4*)(WT + (size_t)dst * K + k0 + 8 * c) = o; } }
    LDS_WAIT(); asm volatile("" ::: "memory");
}
template <int MAP> __device__ __forceinline__ void conv_matrix(const Ctx& F, const float* W, int K, int N, bf16_t* WT, const float* gain) {
    LAS float* scr = (LAS float*)(F.lds + F.wave * 16384);
    const int nit = (K / 64) * ((N + 31) / 32);
    for (int it = F.gw; it < nit; it += F.ngw) conv_item<MAP>(W, K, N, WT, gain, scr, it, F.lane);
}

__device__ __forceinline__ void norm_row(const float* hrow, bf16_t* orow, int lane) {
    f32x4 v[8]; float s = 0.f; float zf = 0.f; asm volatile("" : "+v"(zf));
    if (hrow) {
#pragma unroll
        for (int j = 0; j < 8; ++j) { v[j] = *((const f32x4*)hrow + lane + 64 * j); s += (v[j].x * v[j].x + v[j].y * v[j].y) + (v[j].z * v[j].z + v[j].w * v[j].w); }
    } else {
#pragma unroll
        for (int j = 0; j < 8; ++j) v[j] = (f32x4){zf, zf, zf, zf};
    }
    const float rstd = 1.0f / sqrtf(wave_sum(s) * (1.f / DM) + EPS);
#pragma unroll
    for (int j = 0; j < 8; ++j) { u32x2 o; o.x = pk2(v[j].x * rstd, v[j].y * rstd); o.y = pk2(v[j].z * rstd, v[j].w * rstd); *((u32x2*)orow + lane + 64 * j) = o; }
}

__device__ __forceinline__ void post1a_row(const bf16_t* P, int r, float* rstdq, float* rstdkv, int lane) {
    const bf16_t* p = P + (size_t)r * PW;
    const u32x4 a = *((const u32x4*)(p + C_CQ) + lane), b = *((const u32x4*)(p + C_CKV) + lane);
    float sa = 0.f, sb = 0.f;
#pragma unroll
    for (int e = 0; e < 4; ++e) { const float x0 = __uint_as_float(a[e] << 16), x1 = __uint_as_float(a[e] & 0xffff0000u); sa += x0 * x0 + x1 * x1;
        const float y0 = __uint_as_float(b[e] << 16), y1 = __uint_as_float(b[e] & 0xffff0000u); sb += y0 * y0 + y1 * y1; }
    sa = wave_sum(sa); sb = wave_sum(sb);
    if (lane == 0) { rstdq[r] = 1.0f / sqrtf(sa * (1.f / 512.f) + EPS); rstdkv[r] = 1.0f / sqrtf(sb * (1.f / 512.f) + EPS); }
}
__device__ __forceinline__ void post2_row(bf16_t* P, int r, const float* rstdq, const float* rstdkv, const float* qkg  , int lane) {
    bf16_t* p = P + (size_t)r * PW;
    const float sq = rstdq[r], skv = rstdkv[r];
    float cs, sn; rope_cs(row_pos(r), lane & 31, 2.f / 64.f, cs, sn);
    const float g0a = qkg[lane], g0b = qkg[64 + lane], g0c = qkg[128 + lane];
    const float g1a = qkg[192 + lane], g1b = qkg[192 + 64 + lane], g1c = qkg[192 + 128 + lane];
    const float kpe = bf2f(p[C_KPE + lane]);
    const float kpe_ss = wave_sum(kpe * kpe);
#pragma unroll 2
    for (int h = 0; h < 8; ++h) {
        bf16_t* q = p + C_QRAW + h * 192;
        float x0 = bf2f(q[lane]) * sq, x1 = bf2f(q[64 + lane]) * sq, x2 = bf2f(q[128 + lane]) * sq;
        float rn = 1.0f / sqrtf(wave_sum(x0 * x0 + x1 * x1 + x2 * x2) * (1.f / 192.f) + EPS);
        x0 *= rn * g0a; x1 *= rn * g0b; x2 *= rn * g0c;
        { const float pr = __shfl_xor(x2, 32); x2 = (lane < 32) ? (x2 * cs - pr * sn) : (x2 * cs + pr * sn); }
        q[lane] = (bf16_t)f2bf(x0 * C2_192); q[64 + lane] = (bf16_t)f2bf(x1 * C2_192); q[128 + lane] = (bf16_t)f2bf(x2 * C2_192);
        bf16_t* kv = p + C_KVRAW + h * 256;
        float k0 = bf2f(kv[lane]) * skv, k1 = bf2f(kv[64 + lane]) * skv;
        const float v0 = bf2f(kv[128 + lane]) * skv, v1 = bf2f(kv[192 + lane]) * skv;
        rn = 1.0f / sqrtf((wave_sum(k0 * k0 + k1 * k1) + kpe_ss) * (1.f / 192.f) + EPS);
        kv[lane] = (bf16_t)f2bf(k0 * rn * g1a); kv[64 + lane] = (bf16_t)f2bf(k1 * rn * g1b);
        kv[128 + lane] = (bf16_t)f2bf(v0); kv[192 + lane] = (bf16_t)f2bf(v1);
        float kp = kpe * rn * g1c;
        { const float pr = __shfl_xor(kp, 32); kp = (lane < 32) ? (kp * cs - pr * sn) : (kp * cs + pr * sn); }
        p[C_KPEH + h * 64 + lane] = (bf16_t)f2bf(kp);
    }
}
__device__ __forceinline__ void headnorm_rope128(bf16_t* x, float ga, float gb, float cs, float sn, float scale, int lane) {
    float a = bf2f(x[lane]), b = bf2f(x[64 + lane]);
    const float rn = 1.0f / sqrtf(wave_sum(a * a + b * b) * (1.f / 128.f) + EPS);
    a *= rn * ga; b *= rn * gb;
    const float ra = a * cs - b * sn, rb = b * cs + a * sn;
    x[lane] = (bf16_t)f2bf(ra * scale); x[64 + lane] = (bf16_t)f2bf(rb * scale);
}
__device__ __forceinline__ void post1b_row(bf16_t* P, int r, const float* dsag  , const float* diffg  , int lane) {
    bf16_t* p = P + (size_t)r * PW;
    const int pos = row_pos(r);
    float c128, s128, c64, s64; rope_cs(pos, lane, 2.f / 128.f, c128, s128); rope_cs(pos, lane & 31, 2.f / 64.f, c64, s64);
    const float dq_a = dsag[lane], dq_b = dsag[64 + lane], dk_a = dsag[128 + lane], dk_b = dsag[192 + lane];
    const float fq_a = diffg[lane], fq_b = diffg[64 + lane], fk_a = diffg[128 + lane], fk_b = diffg[192 + lane];
#pragma unroll 2
    for (int h = 0; h < 8; ++h) {
        headnorm_rope128(p + C_DQ + h * 128, dq_a, dq_b, c128, s128, C2_128, lane);
        headnorm_rope128(p + C_DK + h * 128, dk_a, dk_b, c128, s128, 1.f, lane);
        headnorm_rope128(p + C_FQ + h * 128, fq_a, fq_b, c128, s128, C2_128, lane);
        headnorm_rope128(p + C_FK + h * 128, fk_a, fk_b, c128, s128, 1.f, lane);
    }
#pragma unroll 2
    for (int h = 0; h < 17; ++h) {
        bf16_t* x = (h < 16) ? (p + C_IQ + h * 64) : (p + C_IK);
        const float v = bf2f(x[lane]); const float pr = __shfl_xor(v, 32);
        x[lane] = (bf16_t)f2bf((lane < 32) ? (v * c64 - pr * s64) : (v * c64 + pr * s64));
    }
}
__device__ __forceinline__ void post3_row(bf16_t* P, int r, const float* subg, float lam, float omli, int lane) {
    bf16_t* p = P + (size_t)r * PW;
    const float g0 = subg[lane], g1 = subg[64 + lane], g2 = subg[128 + lane], g3 = subg[192 + lane];
#pragma unroll
    for (int h = 0; h < 4; ++h) {
        const bf16_t* a0 = p + C_FQ + (h * 2) * 128; const bf16_t* a1 = p + C_FQ + (h * 2 + 1) * 128;
        const bf16_t* b0 = p + C_IQ + (h * 2) * 128; const bf16_t* b1 = p + C_IQ + (h * 2 + 1) * 128;
        const float d0 = bf2f(a0[lane]) - lam * bf2f(a1[lane]), d1 = bf2f(a0[64 + lane]) - lam * bf2f(a1[64 + lane]);
        const float d2 = bf2f(b0[lane]) - lam * bf2f(b1[lane]), d3 = bf2f(b0[64 + lane]) - lam * bf2f(b1[64 + lane]);
        const float rn = omli / sqrtf(wave_sum(d0 * d0 + d1 * d1 + d2 * d2 + d3 * d3) * (1.f / 256.f) + EPS);
        bf16_t* o = p + C_OC + h * 256;
        o[lane] = (bf16_t)f2bf(d0 * rn * g0); o[64 + lane] = (bf16_t)f2bf(d1 * rn * g1); o[128 + lane] = (bf16_t)f2bf(d2 * rn * g2); o[192 + lane] = (bf16_t)f2bf(d3 * rn * g3);
    }
}

__device__ __forceinline__ int key_row(int kidx, int tokbase) { return kidx < 64 ? (MBLK - 64) + kidx : tokbase + (kidx - 64); }

__device__ __forceinline__ void index_row(const bf16_t* P, int tok, unsigned* bm, LAS float* iqs  , LAS unsigned* keys  , int lane) {
    const int b = tok >> 11, t = tok & (SEQ - 1), r = MBLK + tok, qk = 64 + t, nvalid = t + 17, tokbase = MBLK + b * SEQ;
    const int nch = qk / 64 + 1;
    unsigned* out = bm + (size_t)tok * BMW;
    if (nvalid <= 256) {
        for (int c = 0; c < 33; ++c) { const int kidx = 64 * c + lane; const unsigned long long m = __ballot(kidx >= 48 && kidx <= qk);
            if (lane == 0) { out[2 * c] = (unsigned)m; out[2 * c + 1] = (unsigned)(m >> 32); } }
        return;
    }
    const bf16_t* p = P + (size_t)r * PW;
#pragma unroll
    for (int j = 0; j < 16; ++j) iqs[j * 64 + lane] = bf2f(p[C_IQ + j * 64 + lane]);
    if (lane < 16) iqs[1024 + lane] = bf2f(p[C_IW + lane]);
    LDS_WAIT(); asm volatile("" ::: "memory");
    for (int c = 0; c < nch; ++c) {
        const int kidx = 64 * c + lane; const bool valid = kidx >= 48 && kidx <= qk;
        const int kr = key_row(valid ? kidx : 48, tokbase);
        const u32x4* kp = (const u32x4*)(P + (size_t)kr * PW + C_IK);
        u32x4 kw[8];
#pragma unroll
        for (int j = 0; j < 8; ++j) kw[j] = kp[j];
        float score = 0.f;
#pragma unroll 1
        for (int h = 0; h < 16; ++h) {
            const LAS f32x4* qv = (const LAS f32x4*)(iqs + h * 64); float d = 0.f;
#pragma unroll
            for (int j = 0; j < 8; ++j) { const u32x4 w = kw[j]; const f32x4 qa = qv[2 * j], qb = qv[2 * j + 1];
                d += qa.x * __uint_as_float(w.x << 16) + qa.y * __uint_as_float(w.x & 0xffff0000u) + qa.z * __uint_as_float(w.y << 16) + qa.w * __uint_as_float(w.y & 0xffff0000u)
                   + qb.x * __uint_as_float(w.z << 16) + qb.y * __uint_as_float(w.z & 0xffff0000u) + qb.z * __uint_as_float(w.w << 16) + qb.w * __uint_as_float(w.w & 0xffff0000u); }
            score += fmaxf(d, 0.f) * iqs[1024 + h];
        }
        const unsigned u = __float_as_uint(score);
        keys[c * 64 + lane] = valid ? ((u & 0x80000000u) ? ~u : (u | 0x80000000u)) : 0u;
    }
    LDS_WAIT(); asm volatile("" ::: "memory");
    unsigned T = 0u;
    for (int bit = 31; bit >= 0; --bit) {
        const unsigned cand = T | (1u << bit); int cnt = 0;
        for (int c = 0; c < nch; ++c) cnt += __popcll(__ballot(keys[c * 64 + lane] >= cand));
        if (cnt >= 256) T = cand;
        if (cnt == 256) break;
    }
    for (int c = 0; c < 33; ++c) { unsigned long long m = 0ull; if (c < nch) m = __ballot(keys[c * 64 + lane] >= T);
        if (lane == 0) { out[2 * c] = (unsigned)m; out[2 * c + 1] = (unsigned)(m >> 32); } }
    LDS_WAIT(); asm volatile("" ::: "memory");
}

__device__ __forceinline__ void index_unit(const bf16_t* P, int unit, unsigned* bm) {
    typedef float f32x16 __attribute__((ext_vector_type(16)));
    int tid = threadIdx.x; asm volatile("" : "+v"(tid));
    const int wid = __builtin_amdgcn_readfirstlane(tid >> 6), lane = tid & 63, j = lane & 31, hi = lane >> 5;
    const int tb = 127 - (unit >> 4), b = unit & 15, t0 = tb * 16, tokbase = MBLK + b * SEQ;
    const int tq = t0 + 2 * wid + hi, qk = 64 + tq, qrow = tokbase + tq;
    const int wmax = (64 + t0 + 15) >> 5;
    bf16x8 af[4];
    { const int qa = (j >> 2) & 1, ha = (j & 3) + 4 * (j >> 3);
      const bf16_t* ap = P + (size_t)(tokbase + t0 + 2 * wid + qa) * PW + C_IQ + ha * 64 + hi * 8;
#pragma unroll
      for (int s = 0; s < 4; ++s) af[s] = *(const bf16x8*)(ap + s * 16); }
    float iw[16];
    { const bf16_t* wp = P + (size_t)qrow * PW + C_IW;
      const u32x4 w0 = *(const u32x4*)wp, w1 = *(const u32x4*)(wp + 8);
#pragma unroll
      for (int e = 0; e < 4; ++e) { iw[2 * e] = __uint_as_float(w0[e] << 16); iw[2 * e + 1] = __uint_as_float(w0[e] & 0xffff0000u); iw[8 + 2 * e] = __uint_as_float(w1[e] << 16); iw[8 + 2 * e + 1] = __uint_as_float(w1[e] & 0xffff0000u); } }
    unsigned key[66];
    bf16x8 bf[4];
#define IDX_LOADB(w) do { const int kr_ = (w) < 2 ? (MBLK - 64) + 32 * (w) : tokbase + 32 * ((w) - 2); const bf16_t* bp_ = P + (size_t)(kr_ + j) * PW + C_IK + hi * 8; \
        _Pragma("unroll") for (int s = 0; s < 4; ++s) bf[s] = *(const bf16x8*)(bp_ + s * 16); } while (0)
    IDX_LOADB(0);
#pragma unroll
    for (int w = 0; w < 66; ++w) {
        key[w] = 0u;
        if (w <= wmax) {
            bf16x8 bc[4];
#pragma unroll
            for (int s = 0; s < 4; ++s) bc[s] = bf[s];
            if (w + 1 <= wmax) IDX_LOADB(w + 1);
            f32x16 acc = (f32x16){0.f,0.f,0.f,0.f,0.f,0.f,0.f,0.f,0.f,0.f,0.f,0.f,0.f,0.f,0.f,0.f};
#pragma unroll
            for (int s = 0; s < 4; ++s) acc = __builtin_amdgcn_mfma_f32_32x32x16_bf16(af[s], bc[s], acc, 0, 0, 0);
            float score = 0.f;
#pragma unroll
            for (int r = 0; r < 16; ++r) score += fmaxf(acc[r], 0.f) * iw[r];
            const int kidx = 32 * w + j; const bool valid = kidx >= 48 && kidx <= qk;
            const unsigned u = __float_as_uint(score);
            key[w] = valid ? ((u & 0x80000000u) ? ~u : (u | 0x80000000u)) : 0u;
        }
    }
#undef IDX_LOADB
    unsigned T = 0u; bool done = false;
    if (tq + 17 <= 256) { T = 1u; done = true; }
    for (int bit = 31; bit >= 0; --bit) {
        if (__all(done)) break;
        const unsigned cand = T | (1u << bit);
        int c0 = 0, c1 = 0;
#pragma unroll
        for (int w = 0; w < 66; ++w) { if (w <= wmax) { const unsigned long long m = __ballot(key[w] >= cand); c0 += __popc((unsigned)m); c1 += __popc((unsigned)(m >> 32)); } }
        const int cnt = hi ? c1 : c0;
        if (!done && cnt >= 256) T = cand;
        if (cnt == 256) done = true;
    }
    unsigned* o0 = bm + (size_t)(b * SEQ + t0 + 2 * wid) * BMW; unsigned* o1 = o0 + BMW;
#pragma unroll
    for (int w = 0; w < 66; ++w) { unsigned long long m = 0ull; if (w <= wmax) m = __ballot(key[w] >= T && key[w] != 0u);
        if (lane == 0) { o0[w] = (unsigned)m; o1[w] = (unsigned)(m >> 32); } }
}

template <int DQK, int DV, bool MASKED>
__device__ __forceinline__ void attn_row(bf16_t* P, int r, int qcol, int k1col, int k2col, int vcol, int ocol0, int ocol1, const unsigned* bm, LAS float* qs, int lane) {
    int qk, tokbase;
    if (r < MBLK) { qk = r - (MBLK - 64); tokbase = MBLK; } else { const int tok = r - MBLK; qk = 64 + (tok & (SEQ - 1)); tokbase = MBLK + (tok >> 11) * SEQ; }
    const bf16_t* qp = P + (size_t)r * PW + qcol;
#pragma unroll
    for (int d = 0; d < DQK; d += 64) qs[d + lane] = bf2f(qp[d + lane]);
    LDS_WAIT(); asm volatile("" ::: "memory");
    const bool use_bm = MASKED && r >= MBLK;
    const unsigned* bmr = bm + (size_t)(r >= MBLK ? r - MBLK : 0) * BMW;
    float m = -1e30f, l = 0.f, o[DV / 64];
#pragma unroll
    for (int k = 0; k < DV / 64; ++k) o[k] = 0.f;
    const int nch = qk / 64 + 1;
    for (int c = 0; c < nch; ++c) {
        const int kidx = 64 * c + lane; bool valid = kidx >= 48 && kidx <= qk;
        if (use_bm) valid = (bmr[kidx >> 5] >> (kidx & 31)) & 1u;
        const int kr = key_row((kidx >= 48 && kidx <= qk) ? kidx : 48, tokbase);
        float s = 0.f;
        { const u32x4* kp = (const u32x4*)(P + (size_t)kr * PW + k1col);
#pragma unroll
          for (int j = 0; j < 16; ++j) { const u32x4 w = kp[j]; const LAS f32x4* qv = (const LAS f32x4*)(qs + j * 8); const f32x4 qa = qv[0], qb = qv[1];
              s += qa.x * __uint_as_float(w.x << 16) + qa.y * __uint_as_float(w.x & 0xffff0000u) + qa.z * __uint_as_float(w.y << 16) + qa.w * __uint_as_float(w.y & 0xffff0000u)
                 + qb.x * __uint_as_float(w.z << 16) + qb.y * __uint_as_float(w.z & 0xffff0000u) + qb.z * __uint_as_float(w.w << 16) + qb.w * __uint_as_float(w.w & 0xffff0000u); } }
        if (DQK == 192) { const u32x4* kp = (const u32x4*)(P + (size_t)kr * PW + k2col);
#pragma unroll
          for (int j = 0; j < 8; ++j) { const u32x4 w = kp[j]; const LAS f32x4* qv = (const LAS f32x4*)(qs + 128 + j * 8); const f32x4 qa = qv[0], qb = qv[1];
              s += qa.x * __uint_as_float(w.x << 16) + qa.y * __uint_as_float(w.x & 0xffff0000u) + qa.z * __uint_as_float(w.y << 16) + qa.w * __uint_as_float(w.y & 0xffff0000u)
                 + qb.x * __uint_as_float(w.z << 16) + qb.y * __uint_as_float(w.z & 0xffff0000u) + qb.z * __uint_as_float(w.w << 16) + qb.w * __uint_as_float(w.w & 0xffff0000u); } }
        if (!valid) s = -__builtin_inff();
        const float mn = fmaxf(m, wave_max(s));
        const float alpha = __builtin_amdgcn_exp2f(m - mn), pj = __builtin_amdgcn_exp2f(s - mn);
        l = l * alpha + wave_sum(pj); m = mn;
#pragma unroll
        for (int k = 0; k < DV / 64; ++k) o[k] *= alpha;
        for (int j = 0; j < 64; ++j) {
            const float pw = __uint_as_float((unsigned)__builtin_amdgcn_readlane((int)__float_as_uint(pj), j));
            if (pw != 0.f) { const int rj = __builtin_amdgcn_readlane(kr, j); const bf16_t* vp = P + (size_t)rj * PW + vcol;
#pragma unroll
                for (int k = 0; k < DV / 64; ++k) o[k] += pw * bf2f(vp[k * 64 + lane]); }
        }
    }
    const float rl = l > 0.f ? 1.0f / l : 0.f;
    bf16_t* op = P + (size_t)r * PW;
#pragma unroll
    for (int k = 0; k < DV / 64; ++k) { const int d = k * 64 + lane; op[(d < 128 ? ocol0 + d : ocol1 + d - 128)] = (bf16_t)f2bf(o[k] * rl); }
    LDS_WAIT(); asm volatile("" ::: "memory");
}
namespace fa {
typedef float f32x16 __attribute__((ext_vector_type(16)));
typedef short s16x4 __attribute__((ext_vector_type(4)));
__device__ __forceinline__ int crow(int r, int hi) { return (r & 3) + 8 * (r >> 2) + 4 * hi; }
__device__ __forceinline__ int v_st(int k, int c) { const int kk = (k & ~0xC) | ((k & 4) << 1) | ((k & 8) >> 1); return ((kk >> 3) * 4 + (c >> 5)) * 512 + ((kk & 7) * 32 + (c & 31)) * 2; }
__device__ __forceinline__ int v_rd_base(int lane) { return ((lane & 3) << 3) | (((lane >> 2) & 3) << 6) | (((lane >> 4) & 1) << 5) | (((lane >> 5) & 1) << 8); }
constexpr int v_rd_off(int d0, int ks, int half) { return d0 * 512 + ks * 4096 + half * 2048; }
constexpr int SHM_V = 16384;
template <int DQK> struct Geo { static constexpr int KP = DQK * 2, SHM_K = 64 * DQK * 2, LDS_K0 = 2 * SHM_V, LDS_WS = LDS_K0 + 2 * SHM_K, BYTES = LDS_WS + 8 * 256; };
#define FA_KSWZ(row, colB, pitch) ((row) * (pitch) + ((colB) ^ (((row) & 7) << 4)))
#define FA_SBAR() __builtin_amdgcn_sched_barrier(0)

struct Item { int qrow0, qk0, nt, tokbase; };

template <int DQK>
__device__ __forceinline__ void load_q(const bf16_t* P, const Item& it, int qcol, bf16x8 (&qr)[DQK / 16]) {
    int tid = threadIdx.x; asm volatile("" : "+v"(tid));
    const int wid = tid >> 6, lane = tid & 63, r32 = lane & 31, hi = lane >> 5;
    const bf16_t* qp = P + (size_t)(it.qrow0 + wid * 32 + r32) * PW + qcol + hi * 8;
#pragma unroll
    for (int d0 = 0; d0 < DQK / 16; ++d0) qr[d0] = *(const bf16x8*)(qp + d0 * 16);
}

template <int DQK, bool MASKED>
__device__ __forceinline__ void attn_core(bf16_t* P, const Item& it, const bf16x8 (&qr)[DQK / 16], int k1col, int k2col, int vcol, int ocol, const unsigned* bmq, LAS unsigned char* lds) {
    typedef Geo<DQK> G;
    int tid = threadIdx.x; asm volatile("" : "+v"(tid));
    const int wid = __builtin_amdgcn_readfirstlane(tid >> 6), lane = tid & 63, r32 = lane & 31, hi = lane >> 5;
    LAS unsigned char* V_lds = lds; LAS unsigned char* K_lds = lds + G::LDS_K0; LAS float* wsf = (LAS float*)(lds + G::LDS_WS) + wid * 64;
    const int sr = tid >> 4, sc = (tid & 15) * 8;
    const int vst0 = v_st(sr, sc), vst1 = v_st(32 + sr, sc), kws0 = FA_KSWZ(sr, sc * 2, G::KP), kws1 = FA_KSWZ(sr + 32, sc * 2, G::KP);
    const int xr = tid >> 3, xc = (tid & 7) * 8, kws2 = FA_KSWZ(xr, (128 + xc) * 2, G::KP);
    const unsigned loff0 = (unsigned)(sr * PW + sc) * 2u, loffx = (unsigned)(xr * PW + xc) * 2u;
    const int vb0 = (int)(unsigned)(size_t)V_lds + v_rd_base(lane);
    const int NT = it.nt;
    const int qk = it.qk0 + wid * 32 + r32;
    const bool use_bm = MASKED && (bmq != nullptr);
    const unsigned bmoff = (unsigned)((wid * 32 + r32) * BMW) * 4u;
    float m_reg = -1e30f, l_reg = 0.f; f32x16 o[4];
#pragma unroll
    for (int d = 0; d < 4; ++d) o[d] = (f32x16){0.f,0.f,0.f,0.f,0.f,0.f,0.f,0.f,0.f,0.f,0.f,0.f,0.f,0.f,0.f,0.f};
    bf16x8 sk0, sk1, sk2, sv0, sv1;
#define FA_KROW0(t) ((t) == 0 ? (MBLK - 64) : it.tokbase + 64 * ((t) - 1))
#define FA_LOAD(t) do { const int kr_ = FA_KROW0(t); const char* rb_ = (const char*)(P + (size_t)kr_ * PW); const char* rk_ = rb_ + (size_t)k1col * 2; const char* rv_ = rb_ + (size_t)vcol * 2; \
        sk0 = *(const bf16x8*)(rk_ + loff0); sk1 = *(const bf16x8*)(rk_ + (size_t)32 * PW * 2 + loff0); sv0 = *(const bf16x8*)(rv_ + loff0); sv1 = *(const bf16x8*)(rv_ + (size_t)32 * PW * 2 + loff0); \
        if (DQK == 192) sk2 = *(const bf16x8*)(rb_ + (size_t)k2col * 2 + loffx); } while (0)
#define FA_WRITE(bf) do { *(LAS bf16x8*)(K_lds + (bf) * G::SHM_K + kws0) = sk0; *(LAS bf16x8*)(K_lds + (bf) * G::SHM_K + kws1) = sk1; \
        *(LAS bf16x8*)(V_lds + (bf) * SHM_V + vst0) = sv0; *(LAS bf16x8*)(V_lds + (bf) * SHM_V + vst1) = sv1; \
        if (DQK == 192) *(LAS bf16x8*)(K_lds + (bf) * G::SHM_K + kws2) = sk2; } while (0)
    constexpr int QREG = (DQK == 192) ? 6 : DQK / 16;
    LAS unsigned char* qx = lds + G::BYTES + (wid * 384 + lane) * 16;
    if (DQK == 192) {
#pragma unroll
        for (int d0 = QREG; d0 < DQK / 16; ++d0) *(LAS bf16x8*)(qx + (d0 - QREG) * 1024) = qr[d0];
    }
    FA_LOAD(0); FA_WRITE(0);
    __syncthreads();
    for (int t = 0; t < NT; ++t) {
        const int cur = t & 1;
        unsigned zb = 0u; asm volatile("" : "+v"(zb)); u32x2 bw = (u32x2){zb, zb};
        if (use_bm) bw = *(const u32x2*)((const char*)(bmq + 2 * t) + bmoff);
        f32x16 p0 = (f32x16){0.f,0.f,0.f,0.f,0.f,0.f,0.f,0.f,0.f,0.f,0.f,0.f,0.f,0.f,0.f,0.f}, p1 = p0;
        { LAS unsigned char* kbase = K_lds + cur * G::SHM_K;
          LAS unsigned char* kb[4];
#pragma unroll
          for (int dd = 0; dd < 4; ++dd) kb[dd] = kbase + FA_KSWZ(r32, (dd * 16 + hi * 8) * 2, G::KP);
          constexpr int GS = (DQK == 192) ? 2 : 4;
#pragma unroll
          for (int g = 0; g < DQK / (16 * GS); ++g) {
              bf16x8 fb0[GS], fb1[GS];
#pragma unroll
              for (int dd = 0; dd < GS; ++dd) { const int d0 = g * GS + dd; LAS unsigned char* a = kb[d0 & 3] + (d0 >> 2) * 128; fb0[dd] = *(const LAS bf16x8*)a; fb1[dd] = *(const LAS bf16x8*)(a + 32 * G::KP); }
              FA_SBAR();
#pragma unroll
              for (int dd = 0; dd < GS; ++dd) { const int d0 = g * GS + dd; bf16x8 qf; if (d0 < QREG) qf = qr[d0 < QREG ? d0 : 0]; else qf = *(const LAS bf16x8*)(qx + (d0 - QREG) * 1024);
                  p0 = __builtin_amdgcn_mfma_f32_32x32x16_bf16(fb0[dd], qf, p0, 0, 0, 0); p1 = __builtin_amdgcn_mfma_f32_32x32x16_bf16(fb1[dd], qf, p1, 0, 0, 0); }
              FA_SBAR(); } }
        if (t + 1 < NT) FA_LOAD(t + 1);
        FA_SBAR();
        const float NEG = -__builtin_inff();
        if (use_bm) {
            const unsigned wx = bw.x >> (4 * hi), wy = bw.y >> (4 * hi);
#pragma unroll
            for (int r = 0; r < 16; ++r) { const unsigned bit = 1u << ((r & 3) + 8 * (r >> 2)); if (!(wx & bit)) p0[r] = NEG; if (!(wy & bit)) p1[r] = NEG; }
        } else if (t == 0 || 64 * t + 63 > it.qk0 + wid * 32) {
            const int kb_ = 64 * t + 4 * hi;
#pragma unroll
            for (int r = 0; r < 16; ++r) { const int k0 = kb_ + (r & 3) + 8 * (r >> 2), k1 = k0 + 32;
                if (k0 < 48 || k0 > qk) p0[r] = NEG; if (k1 < 48 || k1 > qk) p1[r] = NEG; }
        }
        float pmax = p0[0];
#pragma unroll
        for (int r = 1; r < 16; ++r) pmax = fmaxf(pmax, p0[r]);
#pragma unroll
        for (int r = 0; r < 16; ++r) pmax = fmaxf(pmax, p1[r]);
        { auto rr = __builtin_amdgcn_permlane32_swap(__float_as_uint(pmax), __float_as_uint(pmax), false, false); pmax = fmaxf(__uint_as_float(rr[0]), __uint_as_float(rr[1])); }
        const float mn = fmaxf(m_reg, pmax); const float alpha = __builtin_amdgcn_exp2f(m_reg - mn); m_reg = mn;
        float ps = 0.f;
#pragma unroll
        for (int r = 0; r < 16; ++r) { p0[r] = __builtin_amdgcn_exp2f(p0[r] - mn); p1[r] = __builtin_amdgcn_exp2f(p1[r] - mn); ps += p0[r] + p1[r]; }
        { auto rr = __builtin_amdgcn_permlane32_swap(__float_as_uint(ps), __float_as_uint(ps), false, false); ps = __uint_as_float(rr[0]) + __uint_as_float(rr[1]); }
        l_reg = l_reg * alpha + ps;
        if (__any(alpha < 1.f)) { if (hi == 0) wsf[r32] = alpha; LDS_WAIT();
#pragma unroll
            for (int d_ = 0; d_ < 4; ++d_)
#pragma unroll
                for (int r = 0; r < 16; ++r) o[d_][r] *= wsf[crow(r, hi)];
            LDS_WAIT(); }
        bf16x8 pa0, pa1, pa2, pa3;
#define FA_PK4(Pv, B_, OUT) do { const unsigned a0 = cvt_pk_bf16(Pv[B_ + 0], Pv[B_ + 1]), a1 = cvt_pk_bf16(Pv[B_ + 2], Pv[B_ + 3]), b0 = cvt_pk_bf16(Pv[B_ + 4], Pv[B_ + 5]), b1 = cvt_pk_bf16(Pv[B_ + 6], Pv[B_ + 7]); \
        auto r0 = __builtin_amdgcn_permlane32_swap(a0, b0, false, false); auto r1 = __builtin_amdgcn_permlane32_swap(a1, b1, false, false); \
        u32x4 w_ = {r0[0], r1[0], r0[1], r1[1]}; OUT = __builtin_bit_cast(bf16x8, w_); } while (0)
        FA_PK4(p0, 0, pa0); FA_PK4(p0, 8, pa1); FA_PK4(p1, 0, pa2); FA_PK4(p1, 8, pa3);
#define FA_TRRD(dst, off) asm volatile("ds_read_b64_tr_b16 %0, %1 offset:%2" : "=&v"(dst) : "v"(vb0), "i"(off) : "memory")
#define FA_PV(VB, d0) do { s16x4 l0, l1, l2, l3, h0, h1, h2, h3; constexpr int b_ = (VB) * SHM_V + v_rd_off(d0, 0, 0); \
        FA_TRRD(l0, b_); FA_TRRD(h0, b_ + 2048); FA_TRRD(l1, b_ + 4096); FA_TRRD(h1, b_ + 6144); FA_TRRD(l2, b_ + 8192); FA_TRRD(h2, b_ + 10240); FA_TRRD(l3, b_ + 12288); FA_TRRD(h3, b_ + 14336); \
        asm volatile("s_waitcnt lgkmcnt(0)" ::: "memory"); FA_SBAR(); \
        o[d0] = __builtin_amdgcn_mfma_f32_32x32x16_bf16(pa0, (bf16x8){l0[0], l0[1], l0[2], l0[3], h0[0], h0[1], h0[2], h0[3]}, o[d0], 0, 0, 0); \
        o[d0] = __builtin_amdgcn_mfma_f32_32x32x16_bf16(pa1, (bf16x8){l1[0], l1[1], l1[2], l1[3], h1[0], h1[1], h1[2], h1[3]}, o[d0], 0, 0, 0); \
        o[d0] = __builtin_amdgcn_mfma_f32_32x32x16_bf16(pa2, (bf16x8){l2[0], l2[1], l2[2], l2[3], h2[0], h2[1], h2[2], h2[3]}, o[d0], 0, 0, 0); \
        o[d0] = __builtin_amdgcn_mfma_f32_32x32x16_bf16(pa3, (bf16x8){l3[0], l3[1], l3[2], l3[3], h3[0], h3[1], h3[2], h3[3]}, o[d0], 0, 0, 0); } while (0)
        FA_SBAR();
        if (cur == 0) { FA_PV(0, 0); FA_PV(0, 1); FA_PV(0, 2); FA_PV(0, 3); } else { FA_PV(1, 0); FA_PV(1, 1); FA_PV(1, 2); FA_PV(1, 3); }
        FA_SBAR();
        if (t + 1 < NT) { if (cur == 0) FA_WRITE(1); else FA_WRITE(0); }
        __syncthreads();
    }
    if (hi == 0) wsf[r32] = l_reg; LDS_WAIT();
    float rli[16];
#pragma unroll
    for (int r = 0; r < 16; ++r) { const float lv = wsf[crow(r, hi)]; rli[r] = lv > 0.f ? __builtin_amdgcn_rcpf(lv) : 0.f; }
    { int l2 = lane; asm volatile("" : "+v"(l2));
      const int r32b = l2 & 31, hib = l2 >> 5;
      char* Ow = (char*)(P + (size_t)(it.qrow0 + wid * 32) * PW + ocol) + (unsigned)((4 * hib) * PW + r32b) * 2u;
#pragma unroll
      for (int r = 0; r < 16; ++r) { const unsigned ro = (unsigned)(((r & 3) + 8 * (r >> 2)) * PW) * 2u;
#pragma unroll
        for (int d0 = 0; d0 < 4; ++d0) { const float v = o[d0][r] * rli[r]; const float vn = __shfl_xor(v, 1);
            if ((r32b & 1) == 0) *(unsigned*)(Ow + ro + d0 * 64) = cvt_pk_bf16(v, vn); } } }
    LDS_WAIT();
    __syncthreads();
#undef FA_KROW0
#undef FA_LOAD
#undef FA_WRITE
#undef FA_PK4
#undef FA_TRRD
#undef FA_PV
}
__device__ __forceinline__ int next_item(unsigned* ctr, LAS int* slot) {
    __syncthreads();
    if (threadIdx.x == 0) *slot = (int)__hip_atomic_fetch_add(ctr, 1u, __ATOMIC_RELAXED, __HIP_MEMORY_SCOPE_AGENT);
    __syncthreads();
    return *slot;
}
__device__ __forceinline__ Item make_item(bool meta, int b, int qb) {
    Item it;
    if (meta) { it.qrow0 = 0; it.qk0 = -(MBLK - 64); it.nt = 1; it.tokbase = MBLK; }
    else { it.qrow0 = MBLK + b * SEQ + qb * 256; it.qk0 = 64 + qb * 256; it.nt = 4 * (qb + 1) + 1; it.tokbase = MBLK + b * SEQ; }
    return it;
}
}

__device__ __forceinline__ int deal_row(int pass, int gw, int ngw) { const int j = (pass & 1) ? (ngw - 1 - gw) : gw; return pass * ngw + j; }

constexpr int PH_PER_LAYER = 20, N_PHASES = 2 * PH_PER_LAYER;
__device__ __forceinline__ unsigned char* uni_ptr(unsigned char* p) { const unsigned long long v = (unsigned long long)p; const unsigned lo = __builtin_amdgcn_readfirstlane((unsigned)v), hi = __builtin_amdgcn_readfirstlane((unsigned)(v >> 32)); return (unsigned char*)(((unsigned long long)hi << 32) | lo); }
__device__ __forceinline__ const float* arg_in(const Args& a, int k) { asm volatile("" : "+s"(k)); return a.in[k]; }
__global__ void __launch_bounds__(NWAVES * 64, 2) mega_fwd(Args args) {
    extern __shared__ __attribute__((aligned(16))) unsigned char lds_raw[];
    {
        LAS unsigned char* l0 = (LAS unsigned char*)lds_raw;
        for (int u = threadIdx.x; u < (LDS_BYTES - LDSCTL_OFF) / 4; u += NWAVES * 64) ((LAS unsigned*)(l0 + LDSCTL_OFF))[u] = 0u;
        __syncthreads();
    }
#if MK_ONE_LAUNCH
    (void)xcd_barrier_post((unsigned*)(args.ws + WS_CTL) + CW_BAR, (volatile LAS unsigned*)((LAS unsigned char*)lds_raw + LDSCTL_OFF + 64));
#define GRID_BAR() do { XcdBarrier bar_; bar_.bar = (unsigned*)(uni_ptr(args.ws) + WS_CTL) + CW_BAR; bar_.x = xb_xcc_id(); bar_.st = (volatile LAS unsigned*)((LAS unsigned char*)lds_raw + LDSCTL_OFF + 64); xcd_barrier(bar_); } while (0)
#else
#define GRID_BAR() do {} while (0)
#endif
    const int lo = args.ph_lo, hi = args.ph_hi;
#define IN(k) (lo <= (k) && (k) < hi)
#define SEAM(k) do { if (IN((k) + 1)) GRID_BAR(); } while (0)
#define PH_BEGIN \
    int tid_ = threadIdx.x; asm volatile("" : "+v"(tid_)); \
    Ctx F; F.lds = (LAS unsigned char*)lds_raw; F.tid = tid_; F.lane = tid_ & 63; F.wave = __builtin_amdgcn_readfirstlane(tid_ >> 6); \
    F.G = gridDim.x; F.bid = blockIdx.x; F.gw = F.bid * NWAVES + F.wave; F.ngw = F.G * NWAVES; \
    unsigned char* ws = uni_ptr(args.ws); asm volatile("" : "+s"(ws)); \
    int ly = __builtin_amdgcn_readfirstlane(layer); asm volatile("" : "+s"(ly)); (void)ly; (void)F
#define XN_ ((bf16_t*)(ws + WS_XN))
#define P_ ((bf16_t*)(ws + WS_P))
#define HMETA_ ((float*)(ws + WS_HMETA))
#define RSTDQ_ ((float*)(ws + WS_RSTD))
#define RSTDKV_ ((float*)(ws + WS_RSTD) + R)
#define BM_ ((unsigned*)(ws + WS_BM))
#define WB_(off) ((bf16_t*)(ws + WS_WB + (off)))
#define OUT_ (args.out)
#define LAMBDA_INIT(ly) ((ly) == 0 ? 0.2f : (0.8f - 0.6f * 0.7408182206817179f))
#define HSRC_TOK(ly) ((ly) == 0 ? arg_in(args, 0) : (const float*)args.out)

#pragma unroll
    for (int layer = 0; layer < 2; ++layer) {
        const int pb = layer * PH_PER_LAYER;
        if (((PHMASK >> 0) & 1) && IN(pb + 0)) {
            PH_BEGIN;
            const float* meta = arg_in(args, 1);
            conv_matrix<1>(F, arg_in(args, 3) + (size_t)ly * DM * D_IN, DM, D_IN, WB_(WB_IN), arg_in(args, 2) + ly * DM);
            conv_matrix<0>(F, arg_in(args, 7) + (size_t)ly * 512 * 1536, 512, 1536, WB_(WB_QUP), arg_in(args, 5) + ly * 512);
            conv_matrix<0>(F, arg_in(args, 8) + (size_t)ly * 512 * 2048, 512, 2048, WB_(WB_KVUP), arg_in(args, 6) + ly * 512);
            for (int b = 0; b < 3; ++b) conv_matrix<0>(F, arg_in(args, 14) + ((size_t)ly * 3 + b) * 1024 * DM, 1024, DM, WB_(WB_BR) + (size_t)b * DM * 1024, nullptr);
            conv_matrix<0>(F, arg_in(args, 15) + (size_t)ly * DM * DM, DM, DM, WB_(WB_O), nullptr);
            conv_matrix<2>(F, arg_in(args, 17) + (size_t)ly * DM * 2 * DFF, DM, 2 * DFF, WB_(WB_F1), arg_in(args, 16) + ly * DM);
            conv_matrix<0>(F, arg_in(args, 18) + (size_t)ly * DFF * DM, DFF, DM, WB_(WB_F2), nullptr);
            unsigned zu = 0u; asm volatile("" : "+v"(zu)); const float zf = __uint_as_float(zu);
            for (int i = F.gw * 64 + F.lane; i < 112 * 2048 / 8; i += F.ngw * 64) *((u32x4*)(WB_(WB_IN) + (size_t)1168 * 2048) + i) = (u32x4){zu, zu, zu, zu};
            float* hmeta = HMETA_;
            if (ly == 0) {
                for (int i = F.gw * 64 + F.lane; i < MBLK * DM / 4; i += F.ngw * 64) { const int rr = i / (DM / 4); f32x4 v = (f32x4){zf, zf, zf, zf};
                    if (rr >= MBLK - NMETA) v = *((const f32x4*)meta + (i - (MBLK - NMETA) * (DM / 4))); *((f32x4*)hmeta + i) = v; }
            }
            const float* hsrc_tok = HSRC_TOK(ly);
            bf16_t* XN = XN_;
            for (int r = F.gw; r < R; r += F.ngw) {
                const float* src;
                if (r < MBLK) src = (ly == 0) ? (r >= MBLK - NMETA ? meta + (size_t)(r - (MBLK - NMETA)) * DM : nullptr) : hmeta + (size_t)r * DM;
                else src = hsrc_tok + (size_t)(r - MBLK) * DM;
                norm_row(src, XN + (size_t)r * DM, F.lane);
            }
            SEAM(pb + 0);
        }
        if (((PHMASK >> 1) & 1) && IN(pb + 1)) {
            PH_BEGIN;
            SchedPlain S{XN_, DM, WB_(WB_IN), DM, NPM, 5, F.G, F.bid, 0}; EpiP E{P_};
            pg8::gemm_phase(F.lds, S, E);
            SEAM(pb + 1);
        }
        if (((PHMASK >> 2) & 1) && IN(pb + 2)) {
            PH_BEGIN;
            { bf16_t* P = P_; float* rq = RSTDQ_; float* rkv = RSTDKV_;
              for (int r = F.gw; r < R; r += F.ngw) post1a_row(P, r, rq, rkv, F.lane); }
            VM_WAIT(); __syncthreads();
            SchedMlaUp S{P_, WB_(WB_QUP), WB_(WB_KVUP), F.G, F.bid}; EpiP E{P_};
            pg8::gemm_phase(F.lds, S, E);
            SEAM(pb + 2);
        }
        if (((PHMASK >> 3) & 1) && IN(pb + 3)) {
            PH_BEGIN;
            const float* mla_qkg = arg_in(args, 9) + ly * 2 * 192;
            bf16_t* P = P_; float* rq = RSTDQ_; float* rkv = RSTDKV_;
            for (int r = F.gw; r < R; r += F.ngw) post2_row(P, r, rq, rkv, mla_qkg, F.lane);
            SEAM(pb + 3);
        }
        if (((PHMASK >> 4) & 1) && IN(pb + 4)) {
            PH_BEGIN;
            bf16_t* P = P_;
            unsigned* ctr = (unsigned*)(ws + WS_CTL) + CW_Q + 64 * (ly * 4 + 0);
            LAS int* slot = (LAS int*)(F.lds + LDSCTL_OFF + 128);
            for (;;) {
                const int idx = fa::next_item(ctr, slot); if (idx >= 8 * 129) break;
                int h; fa::Item it;
                if (idx < 1024) { const int qb = 7 - (idx >> 7), rest = idx & 127; h = rest & 7; it = fa::make_item(false, rest >> 3, qb); } else { h = idx - 1024; it = fa::make_item(true, 0, 0); }
                bf16x8 qr[12]; fa::load_q<192>(P, it, C_QRAW + h * 192, qr);
                fa::attn_core<192, false>(P, it, qr, C_KVRAW + h * 256, C_KPEH + h * 64, C_KVRAW + h * 256 + 128, C_OA + h * 128, nullptr, F.lds);
            }
            SEAM(pb + 4);
        }
        if (((PHMASK >> 5) & 1) && IN(pb + 5)) {
            PH_BEGIN;
            SchedPlain S{XN_, DM, WB_(WB_IN) + (size_t)1280 * DM, DM, NPM, 28, F.G, F.bid, 1280}; EpiP E{P_};
            pg8::gemm_phase(F.lds, S, E);
            SEAM(pb + 5);
        }
        if (((PHMASK >> 6) & 1) && IN(pb + 6)) {
            PH_BEGIN;
            const float* dsa_qkg = arg_in(args, 10) + ly * 2 * 128; const float* diff_qkg = arg_in(args, 11) + ly * 2 * 128;
            bf16_t* P = P_;
            for (int r = F.gw; r < R; r += F.ngw) post1b_row(P, r, dsa_qkg, diff_qkg, F.lane);
            SEAM(pb + 6);
        }
        if (((PHMASK >> 7) & 1) && IN(pb + 7)) {
            PH_BEGIN;
            bf16_t* P = P_; unsigned* bm = BM_;
            unsigned* ctr = (unsigned*)(ws + WS_CTL) + CW_Q + 64 * (ly * 4 + 2);
            LAS int* slot = (LAS int*)(F.lds + LDSCTL_OFF + 128);
            for (;;) { const int idx = fa::next_item(ctr, slot); if (idx >= NTOK / 16) break; index_unit(P, idx, bm); }
            SEAM(pb + 7);
        }
        if (((PHMASK >> 8) & 1) && IN(pb + 8)) {
            PH_BEGIN;
            bf16_t* P = P_; unsigned* bm = BM_;
            unsigned* ctr = (unsigned*)(ws + WS_CTL) + CW_Q + 64 * (ly * 4 + 1);
            LAS int* slot = (LAS int*)(F.lds + LDSCTL_OFF + 128);
            for (;;) {
                const int idx = fa::next_item(ctr, slot); if (idx >= 16 * 129) break;
                int hh; bool meta = false; fa::Item it; int b = 0, qb = 0;
                if (idx < 2048) { qb = 7 - (idx >> 8); const int rest = idx & 255; hh = (rest < 128) ? 8 + (rest & 7) : (rest & 7); b = (rest & 127) >> 3; it = fa::make_item(false, b, qb); }
                else { hh = idx - 2048; hh = hh < 8 ? 8 + hh : hh - 8; meta = true; it = fa::make_item(true, 0, 0); }
                if (hh < 8) {
                    bf16x8 qr[8]; fa::load_q<128>(P, it, C_DQ + hh * 128, qr);
                    fa::attn_core<128, true>(P, it, qr, C_DK + hh * 128, 0, C_DV + hh * 128, C_OB + hh * 128, meta ? nullptr : bm + (size_t)(b * SEQ + qb * 256) * BMW, F.lds);
                } else {
                    const int hj = hh - 8;
                    bf16x8 qr[8]; fa::load_q<128>(P, it, C_FQ + hj * 128, qr);
                    fa::attn_core<128, false>(P, it, qr, C_FK + hj * 128, 0, C_FV + (hj >> 1) * 256, C_FQ + hj * 128, nullptr, F.lds);
                    fa::attn_core<128, false>(P, it, qr, C_FK + hj * 128, 0, C_FV + (hj >> 1) * 256 + 128, C_IQ + hj * 128, nullptr, F.lds);
                }
            }
            SEAM(pb + 8);
        }
        if (((PHMASK >> 9) & 1) && IN(pb + 9)) {
            PH_BEGIN;
            const float* diff_lam = arg_in(args, 12) + ly * 4 * 128; const float* diff_subg = arg_in(args, 13) + ly * 256;
            const float lambda_init = LAMBDA_INIT(ly);
            const float s1 = wave_sum(diff_lam[F.lane] * diff_lam[128 + F.lane] + diff_lam[64 + F.lane] * diff_lam[192 + F.lane]);
            const float s2 = wave_sum(diff_lam[256 + F.lane] * diff_lam[384 + F.lane] + diff_lam[320 + F.lane] * diff_lam[448 + F.lane]);
            const float lam = __expf(s1) - __expf(s2) + lambda_init;
            bf16_t* P = P_;
            for (int r = F.gw; r < R; r += F.ngw) post3_row(P, r, diff_subg, lam, 1.f - lambda_init, F.lane);
            SEAM(pb + 9);
        }
#define GATE_PHASE(k, b) \
        if (((PHMASK >> 10) & 1) && IN(pb + (k))) { \
            PH_BEGIN; \
            SchedPlain S{XN_, DM, WB_(WB_G) + (size_t)(b) * 2048 * DM, DM, NPM, 8, F.G, F.bid, 0}; EpiGate E{(bf16_t*)(ws + WS_GS), arg_in(args, 4) + ly * 3 * DM + (b) * DM}; \
            pg8::gemm_phase(F.lds, S, E); \
            SEAM(pb + (k)); \
        }
#define BRANCH_PHASE(k, b, oc) \
        if (((PHMASK >> 10) & 1) && IN(pb + (k))) { \
            PH_BEGIN; \
            SchedPlain S{P_ + (oc), PW, WB_(WB_BR) + (size_t)(b) * DM * 1024, 1024, NPM, 8, F.G, F.bid, C_MERGED}; EpiGated E{P_, (const bf16_t*)(ws + WS_GS), (b) == 0 ? 1 : 0, ((DBG_BM >> (b)) & 1) ? 1.f : 0.f}; \
            pg8::gemm_phase(F.lds, S, E); \
            SEAM(pb + (k)); \
        }
        GATE_PHASE(10, 0) BRANCH_PHASE(11, 0, C_OA)
        GATE_PHASE(12, 1) BRANCH_PHASE(13, 1, C_OB)
        GATE_PHASE(14, 2) BRANCH_PHASE(15, 2, C_OC)
        if (((PHMASK >> 11) & 1) && IN(pb + 16)) {
            PH_BEGIN;
            SchedPlain S{P_ + C_MERGED, PW, WB_(WB_O), DM, NPM, 8, F.G, F.bid, 0}; EpiRes E{HSRC_TOK(ly), OUT_, HMETA_, DBG_SA};
            pg8::gemm_phase(F.lds, S, E);
            SEAM(pb + 16);
        }
        if (((PHMASK >> 12) & 1) && IN(pb + 17)) {
            PH_BEGIN;
            float* hmeta = HMETA_; float* out = OUT_; bf16_t* XN = XN_;
            for (int r = F.gw; r < R; r += F.ngw) norm_row(r < MBLK ? hmeta + (size_t)r * DM : out + (size_t)(r - MBLK) * DM, XN + (size_t)r * DM, F.lane);
            SEAM(pb + 17);
        }
        if (((PHMASK >> 13) & 1) && IN(pb + 18)) {
            PH_BEGIN;
            SchedPlain S{XN_, DM, WB_(WB_F1), DM, NPM, 44, F.G, F.bid, 0}; EpiSwiglu E{P_};
            pg8::gemm_phase(F.lds, S, E);
            SEAM(pb + 18);
        }
        if (((PHMASK >> 14) & 1) && IN(pb + 19)) {
            PH_BEGIN;
            SchedPlain S{P_, PW, WB_(WB_F2), DFF, NPM, 8, F.G, F.bid, 0}; EpiRes E{OUT_, OUT_, HMETA_, DBG_SF};
            pg8::gemm_phase(F.lds, S, E);
            SEAM(pb + 19);
        }
    }
#undef IN
#undef SEAM
}

__global__ void diag_fill(float* out, int n, float v) { for (int i = blockIdx.x * blockDim.x + threadIdx.x; i < n; i += gridDim.x * blockDim.x) out[i] = v; }
extern "C" void kernel_launch(void* const* d_in, const int* in_sizes, int n_in, void* d_out, int out_size, void* d_ws, size_t ws_size, hipStream_t stream) {
    static int grid = 0; static float code = 0.f;
    if (grid == 0) {
        int dev = 0, cus = 0;
        if (n_in != 19) { code = 10.f; grid = -1; }
        else if (ws_size < WS_END) { code = 20.f + (float)(ws_size >> 20) * 0.01f; grid = -1; }
        else if (hipGetDevice(&dev) != hipSuccess || hipDeviceGetAttribute(&cus, hipDeviceAttributeMultiprocessorCount, dev) != hipSuccess) { code = 40.f; grid = -1; }
        else if (hipFuncSetAttribute((const void*)mega_fwd, hipFuncAttributeMaxDynamicSharedMemorySize, LDS_BYTES) != hipSuccess) { code = 50.f; grid = -1; }
        else {
            int per_cu = 0;
            if (hipOccupancyMaxActiveBlocksPerMultiprocessor(&per_cu, (const void*)mega_fwd, NWAVES * 64, LDS_BYTES) != hipSuccess || per_cu < 1) { code = 60.f; grid = -1; }
            (void)hipGetLastError();
            if (grid == 0) grid = cus;
        }
    }
    if (grid < 0) { hipLaunchKernelGGL(diag_fill, dim3(1024), dim3(256), 0, stream, (float*)d_out, out_size, code); return; }
    (void)hipMemsetAsync((char*)d_ws + WS_CTL, 0, CTL_BYTES, stream);
    Args a{};
    for (int i = 0; i < 19; ++i) a.in[i] = (const float*)d_in[i];
    a.out = (float*)d_out; a.ws = (unsigned char*)d_ws;
#if MK_ONE_LAUNCH
    a.ph_lo = 0; a.ph_hi = N_PHASES;
    hipLaunchKernelGGL(mega_fwd, dim3(grid), dim3(NWAVES * 64), LDS_BYTES, stream, a);
#else
    for (int p = 0; p < N_PHASES; ++p) { a.ph_lo = p; a.ph_hi = p + 1; hipLaunchKernelGGL(mega_fwd, dim3(grid), dim3(NWAVES * 64), LDS_BYTES, stream, a); }
#endif
    if (hipPeekAtLastError() != hipSuccess) { (void)hipGetLastError(); hipLaunchKernelGGL(diag_fill, dim3(1024), dim3(256), 0, stream, (float*)d_out, out_size, 70.f); }
}
```

```cpp
#include <hip/hip_runtime.h>
#include <cstdio>
#include <cstdint>

#ifndef PHMASK
#define PHMASK 0x7fff
#endif
#ifndef REPMASK
#define REPMASK 0
#endif
#define NREP(k) ((((REPMASK) >> (k)) & 1) ? 2 : 1)
#ifndef DBG_BM
#define DBG_BM 7
#endif
#ifndef DBG_BR
#define DBG_BR 0
#endif
#ifndef DBG_SA
#define DBG_SA 1.0f
#endif
#ifndef DBG_SF
#define DBG_SF 1.0f
#endif
#ifndef MK_ONE_LAUNCH
#define MK_ONE_LAUNCH 1
#endif

#define LAS __attribute__((address_space(3)))
#define GAS __attribute__((address_space(1)))
typedef unsigned short bf16_t;
typedef short bf16x8 __attribute__((ext_vector_type(8)));
typedef float f32x4 __attribute__((ext_vector_type(4)));
typedef float f32x2 __attribute__((ext_vector_type(2)));
typedef unsigned u32x4 __attribute__((ext_vector_type(4)));
typedef unsigned u32x2 __attribute__((ext_vector_type(2)));

constexpr int DM = 2048, NB = 16, SEQ = 2048, NMETA = 16, MBLK = 256;
constexpr int R = MBLK + NB * SEQ;
constexpr int NPM = R / 256;
constexpr int NPMM = NPM - 1;
constexpr int MROW0 = MBLK - NMETA;
constexpr int NTOK = NB * SEQ;
constexpr int DFF = 5632;
constexpr int PW = 8448;
constexpr int C_CQ = 0, C_CKV = 512, C_KPE = 1024, C_IK = 1088, C_IW = 1152, C_DQ = 1280, C_DK = 2304, C_DV = 3328, C_IQ = 4352,
              C_FQ = 5376, C_FK = 6400, C_FV = 7424;
constexpr int C_KVRAW = 1280, C_QRAW = 3328, C_KPEH = 4864;
constexpr int C_OA = 0, C_OB = C_DQ, C_OC = C_FQ, C_MERGED = 2304;
constexpr int BMW = 66;
constexpr float EPS = 1e-6f;
constexpr float LOG2E = 1.4426950408889634f;
constexpr float C2_128 = 0.08838834764831845f * LOG2E;
constexpr float C2_192 = 0.07216878364870323f * LOG2E;
constexpr int D_IN = 14480;

constexpr size_t MiB = 1u << 20;
constexpr size_t WS_CTL = 0, CTL_BYTES = 1 * MiB;
constexpr size_t WS_RSTD = 1 * MiB;
constexpr size_t WS_HMETA = 2 * MiB;
constexpr size_t WS_BM = 4 * MiB;
constexpr size_t WS_WB = 16 * MiB;
constexpr size_t WB_IN = 0, WB_G = WB_IN + (size_t)8448 * 2048 * 2, WB_QUP = WB_G + (size_t)6144 * 2048 * 2, WB_KVUP = WB_QUP + (size_t)1536 * 512 * 2,
                 WB_BR = WB_KVUP + (size_t)2048 * 512 * 2, WB_O = WB_BR + (size_t)3 * 2048 * 1024 * 2, WB_F1 = WB_O + (size_t)2048 * 2048 * 2,
                 WB_F2 = WB_F1 + (size_t)11264 * 2048 * 2, WB_END = WB_F2 + (size_t)2048 * 5632 * 2;
constexpr size_t WS_XN = 164 * MiB;
constexpr size_t WS_P = 294 * MiB;
constexpr size_t WS_GS = 828 * MiB;
constexpr size_t WS_END = 960 * MiB;
static_assert(WS_GS + (size_t)R * 2048 * 2 <= WS_END && WS_WB + WB_END <= WS_XN && WS_XN + (size_t)R * 2048 * 2 <= WS_P && WS_P + (size_t)R * PW * 2 <= WS_GS, "ws map");
constexpr int CW_BAR = 4096, CW_Q = 16384;

__device__ __forceinline__ float bf2f(bf16_t v) { return __uint_as_float((unsigned)v << 16); }
__device__ __forceinline__ unsigned f2bf(float f) { unsigned u = __float_as_uint(f); return (u + 0x7fffu + ((u >> 16) & 1u)) >> 16; }
__device__ __forceinline__ unsigned pk2(float lo, float hi) { return f2bf(lo) | (f2bf(hi) << 16); }
typedef __bf16 bf16x2_t __attribute__((ext_vector_type(2)));
__device__ __forceinline__ unsigned cvt_pk_bf16(float lo, float hi) { f32x2 v = {lo, hi}; bf16x2_t b = __builtin_convertvector(v, bf16x2_t); return __builtin_bit_cast(unsigned, b); }
__device__ __forceinline__ float wave_sum(float v) {
#pragma unroll
    for (int o = 1; o < 64; o <<= 1) v += __shfl_xor(v, o);
    return v;
}
__device__ __forceinline__ float wave_max(float v) {
#pragma unroll
    for (int o = 1; o < 64; o <<= 1) v = fmaxf(v, __shfl_xor(v, o));
    return v;
}
#define LDS_WAIT() asm volatile("s_waitcnt lgkmcnt(0)" ::: "memory")
#define VM_WAIT() asm volatile("s_waitcnt vmcnt(0)" ::: "memory")
__device__ __forceinline__ int row_pos(int r) { return r < MBLK ? (r >= MBLK - NMETA ? r - (MBLK - NMETA) : 0) : NMETA + ((r - MBLK) & (SEQ - 1)); }
__device__ __forceinline__ void rope_cs(int pos, int i, float two_over_d, float& c, float& s) {
    const float inv = __builtin_amdgcn_exp2f(-(float)i * two_over_d * 13.287712379549449f);
    float rev = (float)pos * inv * 0.15915494309189535f;
    rev -= floorf(rev);
    s = __builtin_amdgcn_sinf(rev); c = __builtin_amdgcn_cosf(rev);
}

namespace pg8 {
constexpr int BM = 256, BK = 64, HALF = 128, HTB = HALF * BK * 2, STAGE_BYTES = 8 * HTB;
__device__ __forceinline__ int lds_byte(int r, int c) { const int st = (r >> 4) * 2 + (c >> 5), rr = r & 15, cc = c & 31, ob = rr * 64 + cc * 2; return st * 1024 + (ob ^ (((ob >> 9) & 1) << 5)); }
__device__ __forceinline__ void stage_rc(int b, int& R_, int& C_) { const int st = b / 1024, sb = b % 1024, swz = sb ^ (((sb >> 9) & 1) << 5); R_ = (st >> 1) * 16 + swz / 64; C_ = (st & 1) * 32 + (swz % 64) / 2; }
__device__ __forceinline__ int perm32(int rho) { const int n = rho >> 4, i = rho & 15; return 8 * (i >> 2) + 4 * n + (i & 3); }

struct Unit { const char* A; const char* B; unsigned lda2, ldb2; int nt, pm, pn, kind, ocol; };

__device__ __forceinline__ void tile_of(int L, int nM, int nN, int& pm, int& pn) {
    const int nwg = nM * nN; int wgid = L;
    { const int q = nwg / 8, r = nwg % 8, xcd = wgid % 8, off = wgid / 8; wgid = (xcd < r ? xcd * (q + 1) : r * (q + 1) + (xcd - r) * q) + off; }
    const int nig = 8 * nN, gid = wgid / nig, fm = gid * 8, gsz = (nM - fm) < 8 ? (nM - fm) : 8;
    pm = fm + ((wgid % nig) % gsz); pn = (wgid % nig) / gsz;
}

template <class Epi, class Sched>
__device__ __forceinline__ void gemm_phase(LAS unsigned char* lds, const Sched& S, const Epi& E) {
    int tid = threadIdx.x; asm volatile("" : "+v"(tid));
    const int wid = __builtin_amdgcn_readfirstlane(tid >> 6), lane = tid & 63, wr = wid >> 2, wc = wid & 3, fr = lane & 15, fq = lane >> 4;
    unsigned rA[2], rB[2], cc[2];
#pragma unroll
    for (int i = 0; i < 2; ++i) { int R_, C_; stage_rc(tid * 16 + i * 8192, R_, C_); rA[i] = (unsigned)R_; rB[i] = (unsigned)(Epi::PERM ? ((R_ & ~31) + perm32(R_ & 31)) : R_); cc[i] = (unsigned)C_ * 2u; }
    const size_t kstep = (size_t)(BK * 2);
    const unsigned ldsw = (unsigned)wid * 1024u;
    const int aoff = lds_byte(wr * 64 + fr, fq * 8), boff = lds_byte(wc * 32 + fr, fq * 8);
#define PG8_SA(b, h) (((b) * 2 + (h)) * HTB)
#define PG8_SB(b, h) ((4 + (b) * 2 + (h)) * HTB)
#define PG8_STAGE(bufoff, gbase, rr, ld2) do { _Pragma("unroll") for (int _i = 0; _i < 2; ++_i) \
        __builtin_amdgcn_global_load_lds((const unsigned*)((const char*)(gbase) + ((rr)[_i] * (ld2) + cc[_i])), (LAS unsigned*)(lds + (bufoff) + ldsw + _i * 8192), 16, 0, 0); } while (0)
#define PG8_LDA(dst, b, h) do { _Pragma("unroll") for (int m = 0; m < 4; ++m) _Pragma("unroll") for (int k = 0; k < 2; ++k) dst[m][k] = *(const LAS bf16x8*)(lds + PG8_SA(b, h) + aoff + m * 2048 + k * 1024); } while (0)
#define PG8_LDB(dst, b, h) do { _Pragma("unroll") for (int n = 0; n < 2; ++n) _Pragma("unroll") for (int k = 0; k < 2; ++k) dst[n][k] = *(const LAS bf16x8*)(lds + PG8_SB(b, h) + boff + n * 2048 + k * 1024); } while (0)
#define PG8_MMA(ai, bj, At, Bt) do { __builtin_amdgcn_s_setprio(1); _Pragma("unroll") for (int m = 0; m < 4; ++m) _Pragma("unroll") for (int n = 0; n < 2; ++n) _Pragma("unroll") for (int k = 0; k < 2; ++k) \
        acc[ai][bj][m][n] = __builtin_amdgcn_mfma_f32_16x16x32_bf16(Bt[n][k], At[m][k], acc[ai][bj][m][n], 0, 0, 0); __builtin_amdgcn_s_setprio(0); } while (0)
#define PG8_WAIT_V(n) asm volatile("s_waitcnt vmcnt(" #n ")" ::: "memory")
#define PG8_WAIT_L(n) asm volatile("s_waitcnt lgkmcnt(" #n ")" ::: "memory")
#define PG8_BAR __builtin_amdgcn_s_barrier()
#define PG8_SCHED __builtin_amdgcn_sched_barrier(0)
    Unit cur, nxt; int ui = 0;
    if (!S.next(0, cur)) return;
    float zf = 0.f; asm volatile("" : "+v"(zf));
    f32x4 acc[2][2][4][2];
#pragma unroll
    for (int a = 0; a < 2; ++a)
#pragma unroll
        for (int b = 0; b < 2; ++b)
#pragma unroll
            for (int m = 0; m < 4; ++m)
#pragma unroll
                for (int n = 0; n < 2; ++n) acc[a][b][m][n] = (f32x4){zf, zf, zf, zf};
    bf16x8 At[4][2], B0[2][2], B1[2][2];
    const char* cA = cur.A; const char* cB = cur.B;
    unsigned lA = cur.lda2, lB = cur.ldb2;
    size_t hA = (size_t)HALF * lA, hB = (size_t)HALF * lB;
    PG8_STAGE(PG8_SB(0, 0), cB, rB, lB); PG8_STAGE(PG8_SB(0, 1), cB + hB, rB, lB); PG8_STAGE(PG8_SA(0, 0), cA, rA, lA); PG8_STAGE(PG8_SA(0, 1), cA + hA, rA, lA);
    if (wr == 1) PG8_BAR;
    PG8_WAIT_V(2); PG8_BAR;
    PG8_STAGE(PG8_SB(1, 0), cB + kstep, rB, lB); PG8_STAGE(PG8_SA(1, 0), cA + kstep, rA, lA); PG8_STAGE(PG8_SB(1, 1), cB + hB + kstep, rB, lB);
    PG8_WAIT_V(6); PG8_BAR;
    for (;;) {
        const bool has_next = S.next(ui + 1, nxt);
        if (!has_next) nxt = cur;
        const char* nA = nxt.A; const char* nB = nxt.B;
        const unsigned lAn = nxt.lda2, lBn = nxt.ldb2;
        const size_t hAn = (size_t)HALF * lAn, hBn = (size_t)HALF * lBn;
        const int nt = cur.nt;
        for (int t = 0; t < nt; t += 2) {
            const bool last = (t == nt - 2);
            const char* a1 = cA + (size_t)(t + 1) * kstep;
            const char* a2 = last ? nA : cA + (size_t)(t + 2) * kstep; const char* b2 = last ? nB : cB + (size_t)(t + 2) * kstep;
            const char* a3 = a2 + kstep; const char* b3 = b2 + kstep;
            const size_t hA2 = last ? hAn : hA, hB2 = last ? hBn : hB;
            const unsigned lA2 = last ? lAn : lA, lB2 = last ? lBn : lB;
            PG8_LDB(B0, 0, 0); PG8_LDB(B1, 0, 1); PG8_SCHED; PG8_LDA(At, 0, 0); PG8_STAGE(PG8_SA(1, 1), a1 + hA, rA, lA);
            PG8_WAIT_V(8); PG8_WAIT_L(0); PG8_BAR; PG8_MMA(0, 0, At, B0); PG8_MMA(0, 1, At, B1); PG8_BAR; PG8_SCHED;
            PG8_LDA(At, 0, 1); PG8_STAGE(PG8_SB(0, 0), b2, rB, lB2); PG8_STAGE(PG8_SB(0, 1), b2 + hB2, rB, lB2); PG8_STAGE(PG8_SA(0, 0), a2, rA, lA2);
            PG8_WAIT_V(8); PG8_WAIT_L(0); PG8_BAR; PG8_MMA(1, 0, At, B0); PG8_MMA(1, 1, At, B1); PG8_BAR; PG8_SCHED;
            PG8_LDB(B0, 1, 0); PG8_LDB(B1, 1, 1); PG8_SCHED; PG8_LDA(At, 1, 0); PG8_STAGE(PG8_SA(0, 1), a2 + hA2, rA, lA2);
            PG8_WAIT_V(8); PG8_WAIT_L(0); PG8_BAR; PG8_MMA(0, 0, At, B0); PG8_MMA(0, 1, At, B1); PG8_BAR; PG8_SCHED;
            PG8_LDA(At, 1, 1); PG8_STAGE(PG8_SB(1, 0), b3, rB, lB2); PG8_STAGE(PG8_SB(1, 1), b3 + hB2, rB, lB2); PG8_STAGE(PG8_SA(1, 0), a3, rA, lA2);
            PG8_WAIT_V(8); PG8_WAIT_L(0); PG8_BAR; PG8_MMA(1, 0, At, B0); PG8_MMA(1, 1, At, B1); PG8_BAR; PG8_SCHED;
        }
        if (wr == 0) PG8_BAR;
        E(acc, cur, wr, wc, fr, fq);
#pragma unroll
        for (int a = 0; a < 2; ++a)
#pragma unroll
            for (int b = 0; b < 2; ++b)
#pragma unroll
                for (int m = 0; m < 4; ++m)
#pragma unroll
                    for (int n = 0; n < 2; ++n) acc[a][b][m][n] = (f32x4){zf, zf, zf, zf};
        if (!has_next) break;
        cur = nxt; cA = nA; cB = nB; hA = hAn; hB = hBn; lA = lAn; lB = lBn; ++ui;
        if (wr == 1) PG8_BAR;
    }
    PG8_WAIT_V(0);
    PG8_BAR;
#undef PG8_SA
#undef PG8_SB
#undef PG8_STAGE
#undef PG8_LDA
#undef PG8_LDB
#undef PG8_MMA
#undef PG8_WAIT_V
#undef PG8_WAIT_L
#undef PG8_BAR
#undef PG8_SCHED
}
}
using pg8::Unit;

struct SchedPlain {
    const bf16_t* A; int lda; const bf16_t* B; int K; int nM, nN, G, c, ocol0;
    __device__ __forceinline__ bool next(int i, Unit& u) const {
        const int L = i * G + c; if (L >= nM * nN) return false;
        int pm, pn; pg8::tile_of(L, nM, nN, pm, pn); pm += 1;
        u.pm = pm; u.pn = pn; u.kind = 0; u.ocol = ocol0 + 256 * pn; u.nt = K / 64; u.lda2 = (unsigned)lda * 2u; u.ldb2 = (unsigned)K * 2u;
        u.A = (const char*)(A + (size_t)pm * 256 * lda); u.B = (const char*)(B + (size_t)pn * 256 * K); return true;
    }
};
struct SchedMlaUp {
    const bf16_t* P; const bf16_t* Wq; const bf16_t* Wkv; int G, c;
    __device__ __forceinline__ bool next(int i, Unit& u) const {
        const int L = i * G + c; if (L >= NPMM * 14) return false;
        int pm, pn; pg8::tile_of(L, NPMM, 14, pm, pn); pm += 1;
        u.pm = pm; u.pn = pn; u.kind = 0; u.nt = 8; u.lda2 = PW * 2u; u.ldb2 = 512 * 2u;
        if (pn < 6) { u.A = (const char*)(P + (size_t)pm * 256 * PW + C_CQ); u.B = (const char*)(Wq + (size_t)pn * 256 * 512); u.ocol = C_QRAW + 256 * pn; }
        else { u.A = (const char*)(P + (size_t)pm * 256 * PW + C_CKV); u.B = (const char*)(Wkv + (size_t)(pn - 6) * 256 * 512); u.ocol = C_KVRAW + 256 * (pn - 6); }
        return true;
    }
};
struct EpiP {
    static constexpr bool PERM = true;
    bf16_t* P;
    __device__ __forceinline__ void operator()(const f32x4 (&acc)[2][2][4][2], const Unit& u, int wr, int wc, int fr, int fq) const {
        asm volatile("" : "+v"(fr), "+v"(fq));
        const int row0 = u.pm * 256 + wr * 64 + fr, col0 = u.ocol + wc * 32 + 8 * fq;
#pragma unroll
        for (int ai = 0; ai < 2; ++ai)
#pragma unroll
            for (int m = 0; m < 4; ++m) { bf16_t* rowp = P + (size_t)(row0 + ai * 128 + m * 16) * PW + col0;
#pragma unroll
                for (int bj = 0; bj < 2; ++bj) { const f32x4 v0 = acc[ai][bj][m][0], v1 = acc[ai][bj][m][1];
                    u32x4 w; w.x = cvt_pk_bf16(v0[0], v0[1]); w.y = cvt_pk_bf16(v0[2], v0[3]); w.z = cvt_pk_bf16(v1[0], v1[1]); w.w = cvt_pk_bf16(v1[2], v1[3]);
                    *(u32x4*)(rowp + bj * 128) = w; } }
    }
};
struct EpiGate {
    static constexpr bool PERM = true;
    bf16_t* G; const float* bias;
    __device__ __forceinline__ void operator()(const f32x4 (&acc)[2][2][4][2], const Unit& u, int wr, int wc, int fr, int fq) const {
        asm volatile("" : "+v"(fr), "+v"(fq));
        const int row0 = u.pm * 256 + wr * 64 + fr, col0 = u.pn * 256 + wc * 32 + 8 * fq;
#pragma unroll
        for (int bj = 0; bj < 2; ++bj) { const f32x4 bv0 = *(const f32x4*)(bias + col0 + bj * 128), bv1 = *(const f32x4*)(bias + col0 + bj * 128 + 4);
#pragma unroll
            for (int ai = 0; ai < 2; ++ai)
#pragma unroll
                for (int m = 0; m < 4; ++m) { bf16_t* rowp = G + (size_t)(row0 + ai * 128 + m * 16) * 2048 + col0; f32x4 v0 = acc[ai][bj][m][0] + bv0, v1 = acc[ai][bj][m][1] + bv1;
#pragma unroll
                    for (int e = 0; e < 4; ++e) { v0[e] = __builtin_amdgcn_rcpf(1.f + __builtin_amdgcn_exp2f(-v0[e] * LOG2E)); v1[e] = __builtin_amdgcn_rcpf(1.f + __builtin_amdgcn_exp2f(-v1[e] * LOG2E)); }
                    u32x4 w; w.x = cvt_pk_bf16(v0[0], v0[1]); w.y = cvt_pk_bf16(v0[2], v0[3]); w.z = cvt_pk_bf16(v1[0], v1[1]); w.w = cvt_pk_bf16(v1[2], v1[3]);
                    *(u32x4*)(rowp + bj * 128) = w; } }
    }
};
struct EpiGated {
    static constexpr bool PERM = true;
    bf16_t* P; const bf16_t* G; int first; float sc;
    __device__ __forceinline__ void operator()(const f32x4 (&acc)[2][2][4][2], const Unit& u, int wr, int wc, int fr, int fq) const {
        asm volatile("" : "+v"(fr), "+v"(fq));
        const int row0 = u.pm * 256 + wr * 64 + fr, lcol0 = u.pn * 256 + wc * 32 + 8 * fq, col0 = u.ocol + wc * 32 + 8 * fq;
        unsigned zu = 0u; asm volatile("" : "+v"(zu));
#pragma unroll
        for (int ai = 0; ai < 2; ++ai)
#pragma unroll
            for (int m = 0; m < 4; ++m) { bf16_t* rowp = P + (size_t)(row0 + ai * 128 + m * 16) * PW + col0; const bf16_t* gp = G + (size_t)(row0 + ai * 128 + m * 16) * 2048 + lcol0;
#pragma unroll
                for (int bj = 0; bj < 2; ++bj) { u32x4 g = *(const u32x4*)(gp + bj * 128); if (DBG_BR == 1) g = (u32x4){0x3f803f80u, 0x3f803f80u, 0x3f803f80u, 0x3f803f80u};
                    u32x4 pv = (u32x4){zu, zu, zu, zu}; if (!first) pv = *(const u32x4*)(rowp + bj * 128);
                    const f32x4 v0 = acc[ai][bj][m][0] * sc, v1 = acc[ai][bj][m][1] * sc;
                    float o[8];
                    o[0] = __uint_as_float(pv.x << 16) + __uint_as_float(g.x << 16) * v0[0]; o[1] = __uint_as_float(pv.x & 0xffff0000u) + __uint_as_float(g.x & 0xffff0000u) * v0[1];
                    o[2] = __uint_as_float(pv.y << 16) + __uint_as_float(g.y << 16) * v0[2]; o[3] = __uint_as_float(pv.y & 0xffff0000u) + __uint_as_float(g.y & 0xffff0000u) * v0[3];
                    o[4] = __uint_as_float(pv.z << 16) + __uint_as_float(g.z << 16) * v1[0]; o[5] = __uint_as_float(pv.z & 0xffff0000u) + __uint_as_float(g.z & 0xffff0000u) * v1[1];
                    o[6] = __uint_as_float(pv.w << 16) + __uint_as_float(g.w << 16) * v1[2]; o[7] = __uint_as_float(pv.w & 0xffff0000u) + __uint_as_float(g.w & 0xffff0000u) * v1[3];
                    u32x4 w; w.x = cvt_pk_bf16(o[0], o[1]); w.y = cvt_pk_bf16(o[2], o[3]); w.z = cvt_pk_bf16(o[4], o[5]); w.w = cvt_pk_bf16(o[6], o[7]);
                    *(u32x4*)(rowp + bj * 128) = w; }
                asm volatile("" ::: "memory"); }
    }
};
struct EpiRes {
    static constexpr bool PERM = false;
    const float* base_tok; float* out_tok; float* hmeta; float dbg;
    __device__ __forceinline__ void operator()(const f32x4 (&acc)[2][2][4][2], const Unit& u, int wr, int wc, int fr, int fq) const {
        asm volatile("" : "+v"(fr), "+v"(fq));
        const float* bp; float* op;
        if (u.pm == 0) { bp = hmeta; op = hmeta; } else { bp = base_tok + (size_t)(u.pm - 1) * 256 * DM; op = out_tok + (size_t)(u.pm - 1) * 256 * DM; }
        const int lrow0 = wr * 64 + fr, col0 = u.pn * 256 + wc * 32 + 4 * fq;
#pragma unroll
        for (int ai = 0; ai < 2; ++ai)
#pragma unroll
            for (int m = 0; m < 4; ++m) { const size_t off = (size_t)(lrow0 + ai * 128 + m * 16) * DM + col0;
#pragma unroll
                for (int bj = 0; bj < 2; ++bj)
#pragma unroll
                    for (int n = 0; n < 2; ++n) { const f32x4 bs = *(const f32x4*)(bp + off + bj * 128 + n * 16); *(f32x4*)(op + off + bj * 128 + n * 16) = bs + acc[ai][bj][m][n] * dbg; }
                asm volatile("" ::: "memory"); }
    }
};
struct EpiSwiglu {
    static constexpr bool PERM = true;
    bf16_t* P;
    __device__ __forceinline__ void operator()(const f32x4 (&acc)[2][2][4][2], const Unit& u, int wr, int wc, int fr, int fq) const {
        asm volatile("" : "+v"(fr), "+v"(fq));
        const int row0 = u.pm * 256 + wr * 64 + fr, col0 = u.pn * 128 + wc * 32 + 8 * fq;
#pragma unroll
        for (int ai = 0; ai < 2; ++ai)
#pragma unroll
            for (int m = 0; m < 4; ++m) { bf16_t* rowp = P + (size_t)(row0 + ai * 128 + m * 16) * PW + col0;
                float o[8];
#pragma unroll
                for (int n = 0; n < 2; ++n)
#pragma unroll
                    for (int e = 0; e < 4; ++e) { const float g = acc[ai][0][m][n][e], up = acc[ai][1][m][n][e]; o[n * 4 + e] = g * __builtin_amdgcn_rcpf(1.f + __builtin_amdgcn_exp2f(-g * LOG2E)) * up; }
                u32x4 w; w.x = cvt_pk_bf16(o[0], o[1]); w.y = cvt_pk_bf16(o[2], o[3]); w.z = cvt_pk_bf16(o[4], o[5]); w.w = cvt_pk_bf16(o[6], o[7]);
                *(u32x4*)rowp = w; }
    }
};

struct SkP { bf16_t* P; int ocol; __device__ __forceinline__ void operator()(int r, int c, float v) const { P[(size_t)(MROW0 + r) * PW + ocol + c] = (bf16_t)f2bf(v); } };
struct SkGate { bf16_t* G; const float* bias; __device__ __forceinline__ void operator()(int r, int c, float v) const { G[(size_t)(MROW0 + r) * 2048 + c] = (bf16_t)f2bf(__builtin_amdgcn_rcpf(1.f + __builtin_amdgcn_exp2f(-(v + bias[c]) * LOG2E))); } };
struct SkGated { bf16_t* P; const bf16_t* G; int first; __device__ __forceinline__ void operator()(int r, int c, float v) const { bf16_t* p = P + (size_t)(MROW0 + r) * PW + C_MERGED + c; const float pv = first ? 0.f : bf2f(*p); *p = (bf16_t)f2bf(pv + bf2f(G[(size_t)(MROW0 + r) * 2048 + c]) * v); } };
struct SkRes { float* hmeta; __device__ __forceinline__ void operator()(int r, int c, float v) const { hmeta[(size_t)(MROW0 + r) * DM + c] += v; } };
template <class Fn>
__device__ __forceinline__ void skinny_gemm(LAS unsigned char* lds, const bf16_t* A, int lda, const bf16_t* Bt, int K, int ntask, int bid, int G, const Fn& f) {
    int tid = threadIdx.x; asm volatile("" : "+v"(tid));
    const int wid = __builtin_amdgcn_readfirstlane(tid >> 6), lane = tid & 63, l15 = lane & 15, kq = lane >> 4;
    LAS f32x4* red = (LAS f32x4*)lds;
    const int kw = K / 8;
    for (int task = bid; task < ntask; task += G) {
        const bf16_t* ap = A + (size_t)l15 * lda + wid * kw + kq * 8;
        const bf16_t* bp = Bt + (size_t)(task * 16 + l15) * K + wid * kw + kq * 8;
        float z = 0.f; asm volatile("" : "+v"(z));
        f32x4 acc = (f32x4){z, z, z, z};
        for (int k = 0; k < kw; k += 32) acc = __builtin_amdgcn_mfma_f32_16x16x32_bf16(*(const bf16x8*)(ap + k), *(const bf16x8*)(bp + k), acc, 0, 0, 0);
        red[wid * 64 + lane] = acc;
        LDS_WAIT(); __syncthreads();
        if (wid == 0) {
            f32x4 s = red[lane];
#pragma unroll
            for (int w = 1; w < 8; ++w) s += red[w * 64 + lane];
#pragma unroll
            for (int r = 0; r < 4; ++r) f(kq * 4 + r, task * 16 + l15, s[r]);
        }
        __syncthreads();
    }
}
__device__ __forceinline__ void skinny_swiglu(LAS unsigned char* lds, const bf16_t* A, int lda, const bf16_t* Bt, int K, bf16_t* P, int bid, int G) {
    int tid = threadIdx.x; asm volatile("" : "+v"(tid));
    const int wid = __builtin_amdgcn_readfirstlane(tid >> 6), lane = tid & 63, l15 = lane & 15, kq = lane >> 4;
    LAS f32x4* red = (LAS f32x4*)lds;
    const int kw = K / 8;
    for (int task = bid; task < DFF / 16; task += G) {
        const int c0 = task * 16, brow = (c0 >> 7) * 256 + (c0 & 127) + l15;
        const bf16_t* ap = A + (size_t)l15 * lda + wid * kw + kq * 8;
        const bf16_t* bg = Bt + (size_t)brow * K + wid * kw + kq * 8; const bf16_t* bu = bg + (size_t)128 * K;
        float z = 0.f; asm volatile("" : "+v"(z));
        f32x4 ag = (f32x4){z, z, z, z}, au = ag;
        for (int k = 0; k < kw; k += 32) { const bf16x8 a = *(const bf16x8*)(ap + k); ag = __builtin_amdgcn_mfma_f32_16x16x32_bf16(a, *(const bf16x8*)(bg + k), ag, 0, 0, 0); au = __builtin_amdgcn_mfma_f32_16x16x32_bf16(a, *(const bf16x8*)(bu + k), au, 0, 0, 0); }
        red[wid * 64 + lane] = ag; red[512 + wid * 64 + lane] = au;
        LDS_WAIT(); __syncthreads();
        if (wid == 0) {
            f32x4 sg = red[lane], su = red[512 + lane];
#pragma unroll
            for (int w = 1; w < 8; ++w) { sg += red[w * 64 + lane]; su += red[512 + w * 64 + lane]; }
#pragma unroll
            for (int r = 0; r < 4; ++r) { const float g = sg[r]; P[(size_t)(MROW0 + kq * 4 + r) * PW + c0 + l15] = (bf16_t)f2bf(g * __builtin_amdgcn_rcpf(1.f + __builtin_amdgcn_exp2f(-g * LOG2E)) * su[r]); }
        }
        __syncthreads();
    }
}

#define XB_TMO      128
#define XB_XCNT(j)  (256  + 64 * (j))
#define XB_XSUB(j)  (1280 + 64 * (j))
#define XB_XGEN(j)  (2304 + 64 * (j))
#define XB_TOP      3328
#define XB_TOPGEN   3392
#define XCD_BAR_WORDS 3456
#define XB_SPIN_CAP (1u << 18)
__device__ __forceinline__ unsigned xb_ld(unsigned* p)              { return __hip_atomic_load(p, __ATOMIC_RELAXED, __HIP_MEMORY_SCOPE_AGENT); }
__device__ __forceinline__ unsigned xb_add(unsigned* p, unsigned v) { return __hip_atomic_fetch_add(p, v, __ATOMIC_RELAXED, __HIP_MEMORY_SCOPE_AGENT); }
__device__ __forceinline__ unsigned xb_xcc_id() { return (unsigned)__builtin_amdgcn_s_getreg((3 << 11) | 20) & 0xFu; }
#define XB_SPIN(cond, bar) do { unsigned _sp = 0; while (cond) { __builtin_amdgcn_s_sleep(1); \
    if ((++_sp & 255u) == 0u) { if (xb_ld(&(bar)[XB_TMO])) break; if (_sp > XB_SPIN_CAP) { atomicAdd(&(bar)[XB_TMO], 1u); break; } } } } while (0)
struct XcdBarrier { unsigned* bar; unsigned x; volatile LAS unsigned* st; };
__device__ __forceinline__ XcdBarrier xcd_barrier_post(unsigned* bar, volatile LAS unsigned* st) {
    XcdBarrier b; b.bar = bar; b.x = xb_xcc_id(); b.st = st;
    if (threadIdx.x == 0) (void)xb_add(&bar[XB_XCNT(b.x)], 1u);
    return b;
}
__device__ __forceinline__ void xcd_barrier_complete(unsigned* bar, unsigned x, unsigned& nloc, unsigned& nx) {
    const unsigned G = gridDim.x * gridDim.y * gridDim.z;
    unsigned sum, cnt, mine, sp = 0u;
    for (;;) {
        sum = 0u; cnt = 0u; mine = 0u;
#pragma unroll
        for (unsigned j = 0; j < 16; ++j) { const unsigned c = xb_ld(&bar[XB_XCNT(j)]); sum += c; cnt += (c > 0u) ? 1u : 0u; mine = (j == x) ? c : mine; }
        if (sum == G) break;
        __builtin_amdgcn_s_sleep(1);
        if ((++sp & 255u) == 0u) { if (xb_ld(&bar[XB_TMO])) break; if (sp > XB_SPIN_CAP) { atomicAdd(&bar[XB_TMO], 1u); break; } }
    }
    nloc = mine > 0u ? mine : 1u; nx = cnt > 0u ? cnt : 1u;
}
__device__ __forceinline__ void xcd_barrier(const XcdBarrier& b) {
    asm volatile("s_waitcnt vmcnt(0)" ::: "memory");
    __syncthreads();
    if (threadIdx.x == 0) {
        unsigned* bar = b.bar;
        __builtin_amdgcn_s_waitcnt(0);
        unsigned nloc = b.st[0], nx = b.st[1];
        if (nloc == 0u) { xcd_barrier_complete(bar, b.x, nloc, nx); b.st[0] = nloc; b.st[1] = nx; }
        const unsigned old = xb_add(&bar[XB_XSUB(b.x)], 1u);
        const unsigned gen = old / nloc;
        if (old + 1u == (gen + 1u) * nloc) {
            __builtin_amdgcn_fence(__ATOMIC_RELEASE, "agent");
            asm volatile("s_waitcnt vmcnt(0)" ::: "memory");
            const unsigned og = xb_add(&bar[XB_TOP], 1u);
            const unsigned tg = og / nx;
            if (og + 1u == (tg + 1u) * nx) xb_add(&bar[XB_TOPGEN], 1u);
            else XB_SPIN(xb_ld(&bar[XB_TOPGEN]) == tg, bar);
            __builtin_amdgcn_fence(__ATOMIC_ACQUIRE, "agent");
            xb_add(&bar[XB_XGEN(b.x)], 1u);
            asm volatile("s_waitcnt vmcnt(0)" ::: "memory");
        } else {
            XB_SPIN(xb_ld(&bar[XB_XGEN(b.x)]) == gen, bar);
            __builtin_amdgcn_fence(__ATOMIC_ACQUIRE, "agent");
            asm volatile("s_waitcnt vmcnt(0)" ::: "memory");
        }
    }
    __syncthreads();
}

constexpr int NWAVES = 8;
constexpr int RING_BYTES = 131072, LDS_BYTES = 147456, LDSCTL_OFF = LDS_BYTES - 512;
struct Args {
    const float* in[19]; float* out; unsigned char* ws; int ph_lo, ph_hi;
};
struct Ctx {
    LAS unsigned char* lds; int tid, lane, wave, gw, ngw, G, bid;
};

template <int MAP> __device__ __forceinline__ int wmap(int n, float& sc) {
    sc = 1.f;
    if (MAP == 0) return n;
    if (MAP == 1) {
        if (n < 1088) return n;
        if (n < 4160) return 1280 + (n - 1088);
        if (n < 5184) return 4352 + (n - 4160);
        if (n < 5248) return 1088 + (n - 5184);
        if (n < 5264) { sc = 0.03125f; return 1152 + (n - 5248); }
        if (n < 8336) return 5376 + (n - 5264);
        return 8448 + (n - 8336);
    }
    if (n < DFF) return (n >> 7) * 256 + (n & 127);
    const int m = n - DFF; return (m >> 7) * 256 + 128 + (m & 127);
}
template <int MAP> __device__ __forceinline__ void conv_item(const float* W, int K, int N, bf16_t* WT, const float* gain, LAS float* scr, int item, int lane) {
    const int nblk = (N + 31) / 32, kb = item / nblk, nb = item - kb * nblk, k0 = 64 * kb, n0 = 32 * nb;
    const int nn = n0 + (lane & 31);
#pragma unroll 8
    for (int i = 0; i < 32; ++i) { const int kk = 2 * i + (lane >> 5); float v = 0.f; if (nn < N) { v = W[(size_t)(k0 + kk) * N + nn]; if (gain) v *= gain[k0 + kk]; } scr[kk * 33 + (lane & 31)] = v; }
    LDS_WAIT(); asm volatile("" ::: "memory");
    const int c = lane & 7;
#pragma unroll
    for (int j = 0; j < 4; ++j) { const int n = (lane >> 3) + 8 * j; const int ns = n0 + n;
        if (ns < N) { float sc; const int dst = wmap<MAP>(ns, sc); const LAS float* s = scr + (8 * c) * 33 + n;
            u32x4 o; o.x = pk2(s[0 * 33] * sc, s[1 * 33] * sc); o.y = pk2(s[2 * 33] * sc, s[3 * 33] * sc); o.z = pk2(s[4 * 33] * sc, s[5 * 33] * sc); o.w = pk2(s[6 * 33] * sc, s[7 * 33] * sc);
            *(u32x4*)(WT + (size_t)dst * K + k0 + 8 * c) = o; } }
    LDS_WAIT(); asm volatile("" ::: "memory");
}
template <int MAP> __device__ __forceinline__ void conv_matrix(const Ctx& F, const float* W, int K, int N, bf16_t* WT, const float* gain) {
    LAS float* scr = (LAS float*)(F.lds + F.wave * 16384);
    const int nit = (K / 64) * ((N + 31) / 32);
    for (int it = F.gw; it < nit; it += F.ngw) conv_item<MAP>(W, K, N, WT, gain, scr, it, F.lane);
}

__device__ __forceinline__ void norm_row(const float* hrow, bf16_t* orow, int lane) {
    f32x4 v[8]; float s = 0.f; float zf = 0.f; asm volatile("" : "+v"(zf));
    if (hrow) {
#pragma unroll
        for (int j = 0; j < 8; ++j) { v[j] = *((const f32x4*)hrow + lane + 64 * j); s += (v[j].x * v[j].x + v[j].y * v[j].y) + (v[j].z * v[j].z + v[j].w * v[j].w); }
    } else {
#pragma unroll
        for (int j = 0; j < 8; ++j) v[j] = (f32x4){zf, zf, zf, zf};
    }
    const float rstd = 1.0f / sqrtf(wave_sum(s) * (1.f / DM) + EPS);
#pragma unroll
    for (int j = 0; j < 8; ++j) { u32x2 o; o.x = pk2(v[j].x * rstd, v[j].y * rstd); o.y = pk2(v[j].z * rstd, v[j].w * rstd); *((u32x2*)orow + lane + 64 * j) = o; }
}

__device__ __forceinline__ void post1a_row(const bf16_t* P, int r, float* rstdq, float* rstdkv, int lane) {
    const bf16_t* p = P + (size_t)r * PW;
    const u32x4 a = *((const u32x4*)(p + C_CQ) + lane), b = *((const u32x4*)(p + C_CKV) + lane);
    float sa = 0.f, sb = 0.f;
#pragma unroll
    for (int e = 0; e < 4; ++e) { const float x0 = __uint_as_float(a[e] << 16), x1 = __uint_as_float(a[e] & 0xffff0000u); sa += x0 * x0 + x1 * x1;
        const float y0 = __uint_as_float(b[e] << 16), y1 = __uint_as_float(b[e] & 0xffff0000u); sb += y0 * y0 + y1 * y1; }
    sa = wave_sum(sa); sb = wave_sum(sb);
    if (lane == 0) { rstdq[r] = 1.0f / sqrtf(sa * (1.f / 512.f) + EPS); rstdkv[r] = 1.0f / sqrtf(sb * (1.f / 512.f) + EPS); }
}
__device__ __forceinline__ void post2_row(bf16_t* P, int r, const float* rstdq, const float* rstdkv, const float* qkg  , int lane) {
    bf16_t* p = P + (size_t)r * PW;
    const float sq = rstdq[r], skv = rstdkv[r];
    float cs, sn; rope_cs(row_pos(r), lane & 31, 2.f / 64.f, cs, sn);
    const float g0a = qkg[lane], g0b = qkg[64 + lane], g0c = qkg[128 + lane];
    const float g1a = qkg[192 + lane], g1b = qkg[192 + 64 + lane], g1c = qkg[192 + 128 + lane];
    const float kpe = bf2f(p[C_KPE + lane]);
    const float kpe_ss = wave_sum(kpe * kpe);
#pragma unroll 2
    for (int h = 0; h < 8; ++h) {
        bf16_t* q = p + C_QRAW + h * 192;
        float x0 = bf2f(q[lane]) * sq, x1 = bf2f(q[64 + lane]) * sq, x2 = bf2f(q[128 + lane]) * sq;
        float rn = 1.0f / sqrtf(wave_sum(x0 * x0 + x1 * x1 + x2 * x2) * (1.f / 192.f) + EPS);
        x0 *= rn * g0a; x1 *= rn * g0b; x2 *= rn * g0c;
        { const float pr = __shfl_xor(x2, 32); x2 = (lane < 32) ? (x2 * cs - pr * sn) : (x2 * cs + pr * sn); }
        q[lane] = (bf16_t)f2bf(x0 * C2_192); q[64 + lane] = (bf16_t)f2bf(x1 * C2_192); q[128 + lane] = (bf16_t)f2bf(x2 * C2_192);
        bf16_t* kv = p + C_KVRAW + h * 256;
        float k0 = bf2f(kv[lane]) * skv, k1 = bf2f(kv[64 + lane]) * skv;
        const float v0 = bf2f(kv[128 + lane]) * skv, v1 = bf2f(kv[192 + lane]) * skv;
        rn = 1.0f / sqrtf((wave_sum(k0 * k0 + k1 * k1) + kpe_ss) * (1.f / 192.f) + EPS);
        kv[lane] = (bf16_t)f2bf(k0 * rn * g1a); kv[64 + lane] = (bf16_t)f2bf(k1 * rn * g1b);
        kv[128 + lane] = (bf16_t)f2bf(v0); kv[192 + lane] = (bf16_t)f2bf(v1);
        float kp = kpe * rn * g1c;
        { const float pr = __shfl_xor(kp, 32); kp = (lane < 32) ? (kp * cs - pr * sn) : (kp * cs + pr * sn); }
        p[C_KPEH + h * 64 + lane] = (bf16_t)f2bf(kp);
    }
}
__device__ __forceinline__ void headnorm_rope128(bf16_t* x, float ga, float gb, float cs, float sn, float scale, int lane) {
    float a = bf2f(x[lane]), b = bf2f(x[64 + lane]);
    const float rn = 1.0f / sqrtf(wave_sum(a * a + b * b) * (1.f / 128.f) + EPS);
    a *= rn * ga; b *= rn * gb;
    const float ra = a * cs - b * sn, rb = b * cs + a * sn;
    x[lane] = (bf16_t)f2bf(ra * scale); x[64 + lane] = (bf16_t)f2bf(rb * scale);
}
__device__ __forceinline__ void post1b_row(bf16_t* P, int r, const float* dsag  , const float* diffg  , int lane) {
    bf16_t* p = P + (size_t)r * PW;
    const int pos = row_pos(r);
    float c128, s128, c64, s64; rope_cs(pos, lane, 2.f / 128.f, c128, s128); rope_cs(pos, lane & 31, 2.f / 64.f, c64, s64);
    const float dq_a = dsag[lane], dq_b = dsag[64 + lane], dk_a = dsag[128 + lane], dk_b = dsag[192 + lane];
    const float fq_a = diffg[lane], fq_b = diffg[64 + lane], fk_a = diffg[128 + lane], fk_b = diffg[192 + lane];
#pragma unroll 2
    for (int h = 0; h < 8; ++h) {
        headnorm_rope128(p + C_DQ + h * 128, dq_a, dq_b, c128, s128, C2_128, lane);
        headnorm_rope128(p + C_DK + h * 128, dk_a, dk_b, c128, s128, 1.f, lane);
        headnorm_rope128(p + C_FQ + h * 128, fq_a, fq_b, c128, s128, C2_128, lane);
        headnorm_rope128(p + C_FK + h * 128, fk_a, fk_b, c128, s128, 1.f, lane);
    }
#pragma unroll 2
    for (int h = 0; h < 17; ++h) {
        bf16_t* x = (h < 16) ? (p + C_IQ + h * 64) : (p + C_IK);
        const float v = bf2f(x[lane]); const float pr = __shfl_xor(v, 32);
        x[lane] = (bf16_t)f2bf((lane < 32) ? (v * c64 - pr * s64) : (v * c64 + pr * s64));
    }
}
__device__ __forceinline__ void post3_row(bf16_t* P, int r, const float* subg, float lam, float omli, int lane) {
    bf16_t* p = P + (size_t)r * PW;
    const float g0 = subg[lane], g1 = subg[64 + lane], g2 = subg[128 + lane], g3 = subg[192 + lane];
#pragma unroll
    for (int h = 0; h < 4; ++h) {
        const bf16_t* a0 = p + C_FQ + (h * 2) * 128; const bf16_t* a1 = p + C_FQ + (h * 2 + 1) * 128;
        const bf16_t* b0 = p + C_IQ + (h * 2) * 128; const bf16_t* b1 = p + C_IQ + (h * 2 + 1) * 128;
        const float d0 = bf2f(a0[lane]) - lam * bf2f(a1[lane]), d1 = bf2f(a0[64 + lane]) - lam * bf2f(a1[64 + lane]);
        const float d2 = bf2f(b0[lane]) - lam * bf2f(b1[lane]), d3 = bf2f(b0[64 + lane]) - lam * bf2f(b1[64 + lane]);
        const float rn = omli / sqrtf(wave_sum(d0 * d0 + d1 * d1 + d2 * d2 + d3 * d3) * (1.f / 256.f) + EPS);
        bf16_t* o = p + C_OC + h * 256;
        o[lane] = (bf16_t)f2bf(d0 * rn * g0); o[64 + lane] = (bf16_t)f2bf(d1 * rn * g1); o[128 + lane] = (bf16_t)f2bf(d2 * rn * g2); o[192 + lane] = (bf16_t)f2bf(d3 * rn * g3);
    }
}

__device__ __forceinline__ int key_row(int kidx, int tokbase) { return kidx < 64 ? (MBLK - 64) + kidx : tokbase + (kidx - 64); }

__device__ __forceinline__ void index_row(const bf16_t* P, int tok, unsigned* bm, LAS float* iqs  , LAS unsigned* keys  , int lane) {
    const int b = tok >> 11, t = tok & (SEQ - 1), r = MBLK + tok, qk = 64 + t, nvalid = t + 17, tokbase = MBLK + b * SEQ;
    const int nch = qk / 64 + 1;
    unsigned* out = bm + (size_t)tok * BMW;
    if (nvalid <= 256) {
        for (int c = 0; c < 33; ++c) { const int kidx = 64 * c + lane; const unsigned long long m = __ballot(kidx >= 48 && kidx <= qk);
            if (lane == 0) { out[2 * c] = (unsigned)m; out[2 * c + 1] = (unsigned)(m >> 32); } }
        return;
    }
    const bf16_t* p = P + (size_t)r * PW;
#pragma unroll
    for (int j = 0; j < 16; ++j) iqs[j * 64 + lane] = bf2f(p[C_IQ + j * 64 + lane]);
    if (lane < 16) iqs[1024 + lane] = bf2f(p[C_IW + lane]);
    LDS_WAIT(); asm volatile("" ::: "memory");
    for (int c = 0; c < nch; ++c) {
        const int kidx = 64 * c + lane; const bool valid = kidx >= 48 && kidx <= qk;
        const int kr = key_row(valid ? kidx : 48, tokbase);
        const u32x4* kp = (const u32x4*)(P + (size_t)kr * PW + C_IK);
        u32x4 kw[8];
#pragma unroll
        for (int j = 0; j < 8; ++j) kw[j] = kp[j];
        float score = 0.f;
#pragma unroll 1
        for (int h = 0; h < 16; ++h) {
            const LAS f32x4* qv = (const LAS f32x4*)(iqs + h * 64); float d = 0.f;
#pragma unroll
            for (int j = 0; j < 8; ++j) { const u32x4 w = kw[j]; const f32x4 qa = qv[2 * j], qb = qv[2 * j + 1];
                d += qa.x * __uint_as_float(w.x << 16) + qa.y * __uint_as_float(w.x & 0xffff0000u) + qa.z * __uint_as_float(w.y << 16) + qa.w * __uint_as_float(w.y & 0xffff0000u)
                   + qb.x * __uint_as_float(w.z << 16) + qb.y * __uint_as_float(w.z & 0xffff0000u) + qb.z * __uint_as_float(w.w << 16) + qb.w * __uint_as_float(w.w & 0xffff0000u); }
            score += fmaxf(d, 0.f) * iqs[1024 + h];
        }
        const unsigned u = __float_as_uint(score);
        keys[c * 64 + lane] = valid ? ((u & 0x80000000u) ? ~u : (u | 0x80000000u)) : 0u;
    }
    LDS_WAIT(); asm volatile("" ::: "memory");
    unsigned T = 0u;
    for (int bit = 31; bit >= 0; --bit) {
        const unsigned cand = T | (1u << bit); int cnt = 0;
        for (int c = 0; c < nch; ++c) cnt += __popcll(__ballot(keys[c * 64 + lane] >= cand));
        if (cnt >= 256) T = cand;
        if (cnt == 256) break;
    }
    for (int c = 0; c < 33; ++c) { unsigned long long m = 0ull; if (c < nch) m = __ballot(keys[c * 64 + lane] >= T);
        if (lane == 0) { out[2 * c] = (unsigned)m; out[2 * c + 1] = (unsigned)(m >> 32); } }
    LDS_WAIT(); asm volatile("" ::: "memory");
}

__device__ __forceinline__ void index_unit(const bf16_t* P, int unit, unsigned* bm) {
    typedef float f32x16 __attribute__((ext_vector_type(16)));
    int tid = threadIdx.x; asm volatile("" : "+v"(tid));
    const int wid = __builtin_amdgcn_readfirstlane(tid >> 6), lane = tid & 63, j = lane & 31, hi = lane >> 5;
    const int tb = 127 - (unit >> 4), b = unit & 15, t0 = tb * 16, tokbase = MBLK + b * SEQ;
    const int tq = t0 + 2 * wid + hi, qk = 64 + tq, qrow = tokbase + tq;
    const int wmax = (64 + t0 + 15) >> 5;
    bf16x8 af[4];
    { const int qa = (j >> 2) & 1, ha = (j & 3) + 4 * (j >> 3);
      const bf16_t* ap = P + (size_t)(tokbase + t0 + 2 * wid + qa) * PW + C_IQ + ha * 64 + hi * 8;
#pragma unroll
      for (int s = 0; s < 4; ++s) af[s] = *(const bf16x8*)(ap + s * 16); }
    float iw[16];
    { const bf16_t* wp = P + (size_t)qrow * PW + C_IW;
      const u32x4 w0 = *(const u32x4*)wp, w1 = *(const u32x4*)(wp + 8);
#pragma unroll
      for (int e = 0; e < 4; ++e) { iw[2 * e] = __uint_as_float(w0[e] << 16); iw[2 * e + 1] = __uint_as_float(w0[e] & 0xffff0000u); iw[8 + 2 * e] = __uint_as_float(w1[e] << 16); iw[8 + 2 * e + 1] = __uint_as_float(w1[e] & 0xffff0000u); } }
    unsigned key[66];
    bf16x8 bf[4];
#define IDX_LOADB(w) do { const int kr_ = (w) < 2 ? (MBLK - 64) + 32 * (w) : tokbase + 32 * ((w) - 2); const bf16_t* bp_ = P + (size_t)(kr_ + j) * PW + C_IK + hi * 8; \
        _Pragma("unroll") for (int s = 0; s < 4; ++s) bf[s] = *(const bf16x8*)(bp_ + s * 16); } while (0)
    IDX_LOADB(0);
#pragma unroll
    for (int w = 0; w < 66; ++w) {
        key[w] = 0u;
        if (w <= wmax) {
            bf16x8 bc[4];
#pragma unroll
            for (int s = 0; s < 4; ++s) bc[s] = bf[s];
            if (w + 1 <= wmax) IDX_LOADB(w + 1);
            f32x16 acc = (f32x16){0.f,0.f,0.f,0.f,0.f,0.f,0.f,0.f,0.f,0.f,0.f,0.f,0.f,0.f,0.f,0.f};
#pragma unroll
            for (int s = 0; s < 4; ++s) acc = __builtin_amdgcn_mfma_f32_32x32x16_bf16(af[s], bc[s], acc, 0, 0, 0);
            float score = 0.f;
#pragma unroll
            for (int r = 0; r < 16; ++r) score += fmaxf(acc[r], 0.f) * iw[r];
            const int kidx = 32 * w + j; const bool valid = kidx >= 48 && kidx <= qk;
            const unsigned u = __float_as_uint(score);
            key[w] = valid ? ((u & 0x80000000u) ? ~u : (u | 0x80000000u)) : 0u;
        }
    }
#undef IDX_LOADB
    unsigned T = 0u; bool done = false;
    if (tq + 17 <= 256) { T = 1u; done = true; }
    for (int bit = 31; bit >= 0; --bit) {
        if (__all(done)) break;
        const unsigned cand = T | (1u << bit);
        int c0 = 0, c1 = 0;
#pragma unroll
        for (int w = 0; w < 66; ++w) { if (w <= wmax) { const unsigned long long m = __ballot(key[w] >= cand); c0 += __popc((unsigned)m); c1 += __popc((unsigned)(m >> 32)); } }
        const int cnt = hi ? c1 : c0;
        if (!done && cnt >= 256) T = cand;
        if (cnt == 256) done = true;
    }
    unsigned* o0 = bm + (size_t)(b * SEQ + t0 + 2 * wid) * BMW; unsigned* o1 = o0 + BMW;
#pragma unroll
    for (int w = 0; w < 66; ++w) { unsigned long long m = 0ull; if (w <= wmax) m = __ballot(key[w] >= T && key[w] != 0u);
        if (lane == 0) { o0[w] = (unsigned)m; o1[w] = (unsigned)(m >> 32); } }
}

template <int DQK, int DV, bool MASKED>
__device__ __forceinline__ void attn_row(bf16_t* P, int r, int qcol, int k1col, int k2col, int vcol, int ocol0, int ocol1, const unsigned* bm, LAS float* qs, int lane) {
    int qk, tokbase;
    if (r < MBLK) { qk = r - (MBLK - 64); tokbase = MBLK; } else { const int tok = r - MBLK; qk = 64 + (tok & (SEQ - 1)); tokbase = MBLK + (tok >> 11) * SEQ; }
    const bf16_t* qp = P + (size_t)r * PW + qcol;
#pragma unroll
    for (int d = 0; d < DQK; d += 64) qs[d + lane] = bf2f(qp[d + lane]);
    LDS_WAIT(); asm volatile("" ::: "memory");
    const bool use_bm = MASKED && r >= MBLK;
    const unsigned* bmr = bm + (size_t)(r >= MBLK ? r - MBLK : 0) * BMW;
    float m = -1e30f, l = 0.f, o[DV / 64];
#pragma unroll
    for (int k = 0; k < DV / 64; ++k) o[k] = 0.f;
    const int nch = qk / 64 + 1;
    for (int c = 0; c < nch; ++c) {
        const int kidx = 64 * c + lane; bool valid = kidx >= 48 && kidx <= qk;
        if (use_bm) valid = (bmr[kidx >> 5] >> (kidx & 31)) & 1u;
        const int kr = key_row((kidx >= 48 && kidx <= qk) ? kidx : 48, tokbase);
        float s = 0.f;
        { const u32x4* kp = (const u32x4*)(P + (size_t)kr * PW + k1col);
#pragma unroll
          for (int j = 0; j < 16; ++j) { const u32x4 w = kp[j]; const LAS f32x4* qv = (const LAS f32x4*)(qs + j * 8); const f32x4 qa = qv[0], qb = qv[1];
              s += qa.x * __uint_as_float(w.x << 16) + qa.y * __uint_as_float(w.x & 0xffff0000u) + qa.z * __uint_as_float(w.y << 16) + qa.w * __uint_as_float(w.y & 0xffff0000u)
                 + qb.x * __uint_as_float(w.z << 16) + qb.y * __uint_as_float(w.z & 0xffff0000u) + qb.z * __uint_as_float(w.w << 16) + qb.w * __uint_as_float(w.w & 0xffff0000u); } }
        if (DQK == 192) { const u32x4* kp = (const u32x4*)(P + (size_t)kr * PW + k2col);
#pragma unroll
          for (int j = 0; j < 8; ++j) { const u32x4 w = kp[j]; const LAS f32x4* qv = (const LAS f32x4*)(qs + 128 + j * 8); const f32x4 qa = qv[0], qb = qv[1];
              s += qa.x * __uint_as_float(w.x << 16) + qa.y * __uint_as_float(w.x & 0xffff0000u) + qa.z * __uint_as_float(w.y << 16) + qa.w * __uint_as_float(w.y & 0xffff0000u)
                 + qb.x * __uint_as_float(w.z << 16) + qb.y * __uint_as_float(w.z & 0xffff0000u) + qb.z * __uint_as_float(w.w << 16) + qb.w * __uint_as_float(w.w & 0xffff0000u); } }
        if (!valid) s = -__builtin_inff();
        const float mn = fmaxf(m, wave_max(s));
        const float alpha = __builtin_amdgcn_exp2f(m - mn), pj = __builtin_amdgcn_exp2f(s - mn);
        l = l * alpha + wave_sum(pj); m = mn;
#pragma unroll
        for (int k = 0; k < DV / 64; ++k) o[k] *= alpha;
        for (int j = 0; j < 64; ++j) {
            const float pw = __uint_as_float((unsigned)__builtin_amdgcn_readlane((int)__float_as_uint(pj), j));
            if (pw != 0.f) { const int rj = __builtin_amdgcn_readlane(kr, j); const bf16_t* vp = P + (size_t)rj * PW + vcol;
#pragma unroll
                for (int k = 0; k < DV / 64; ++k) o[k] += pw * bf2f(vp[k * 64 + lane]); }
        }
    }
    const float rl = l > 0.f ? 1.0f / l : 0.f;
    bf16_t* op = P + (size_t)r * PW;
#pragma unroll
    for (int k = 0; k < DV / 64; ++k) { const int d = k * 64 + lane; op[(d < 128 ? ocol0 + d : ocol1 + d - 128)] = (bf16_t)f2bf(o[k] * rl); }
    LDS_WAIT(); asm volatile("" ::: "memory");
}
namespace fa {
typedef float f32x16 __attribute__((ext_vector_type(16)));
typedef short s16x4 __attribute__((ext_vector_type(4)));
__device__ __forceinline__ int crow(int r, int hi) { return (r & 3) + 8 * (r >> 2) + 4 * hi; }
__device__ __forceinline__ int v_st(int k, int c) { const int kk = (k & ~0xC) | ((k & 4) << 1) | ((k & 8) >> 1); return ((kk >> 3) * 4 + (c >> 5)) * 512 + ((kk & 7) * 32 + (c & 31)) * 2; }
__device__ __forceinline__ int v_rd_base(int lane) { return ((lane & 3) << 3) | (((lane >> 2) & 3) << 6) | (((lane >> 4) & 1) << 5) | (((lane >> 5) & 1) << 8); }
constexpr int v_rd_off(int d0, int ks, int half) { return d0 * 512 + ks * 4096 + half * 2048; }
constexpr int SHM_V = 16384;
template <int DQK> struct Geo { static constexpr int KP = DQK * 2, SHM_K = 64 * DQK * 2, LDS_K0 = 2 * SHM_V, LDS_WS = LDS_K0 + 2 * SHM_K, BYTES = LDS_WS + 8 * 256; };
#define FA_KSWZ(row, colB, pitch) ((row) * (pitch) + ((colB) ^ (((row) & 7) << 4)))
#define FA_SBAR() __builtin_amdgcn_sched_barrier(0)

struct Item { int qrow0, qk0, nt, tokbase; };

template <int DQK>
__device__ __forceinline__ void load_q(const bf16_t* P, const Item& it, int qcol, bf16x8 (&qr)[DQK / 16]) {
    int tid = threadIdx.x; asm volatile("" : "+v"(tid));
    const int wid = tid >> 6, lane = tid & 63, r32 = lane & 31, hi = lane >> 5;
    const bf16_t* qp = P + (size_t)(it.qrow0 + wid * 32 + r32) * PW + qcol + hi * 8;
#pragma unroll
    for (int d0 = 0; d0 < DQK / 16; ++d0) qr[d0] = *(const bf16x8*)(qp + d0 * 16);
}

template <int DQK, bool MASKED>
__device__ __forceinline__ void attn_core(bf16_t* P, const Item& it, const bf16x8 (&qr)[DQK / 16], int k1col, int k2col, int vcol, int ocol, const unsigned* bmq, LAS unsigned char* lds) {
    typedef Geo<DQK> G;
    int tid = threadIdx.x; asm volatile("" : "+v"(tid));
    const int wid = __builtin_amdgcn_readfirstlane(tid >> 6), lane = tid & 63, r32 = lane & 31, hi = lane >> 5;
    LAS unsigned char* V_lds = lds; LAS unsigned char* K_lds = lds + G::LDS_K0; LAS float* wsf = (LAS float*)(lds + G::LDS_WS) + wid * 64;
    const int sr = tid >> 4, sc = (tid & 15) * 8;
    const int vst0 = v_st(sr, sc), vst1 = v_st(32 + sr, sc), kws0 = FA_KSWZ(sr, sc * 2, G::KP), kws1 = FA_KSWZ(sr + 32, sc * 2, G::KP);
    const int xr = tid >> 3, xc = (tid & 7) * 8, kws2 = FA_KSWZ(xr, (128 + xc) * 2, G::KP);
    const unsigned loff0 = (unsigned)(sr * PW + sc) * 2u, loffx = (unsigned)(xr * PW + xc) * 2u;
    const int vb0 = (int)(unsigned)(size_t)V_lds + v_rd_base(lane);
    const int NT = it.nt;
    const int qk = it.qk0 + wid * 32 + r32;
    const bool use_bm = MASKED && (bmq != nullptr);
    const unsigned bmoff = (unsigned)((wid * 32 + r32) * BMW) * 4u;
    float m_reg = -1e30f, l_reg = 0.f; f32x16 o[4];
#pragma unroll
    for (int d = 0; d < 4; ++d) o[d] = (f32x16){0.f,0.f,0.f,0.f,0.f,0.f,0.f,0.f,0.f,0.f,0.f,0.f,0.f,0.f,0.f,0.f};
    bf16x8 sk0, sk1, sk2, sv0, sv1;
#define FA_KROW0(t) ((t) == 0 ? (MBLK - 64) : it.tokbase + 64 * ((t) - 1))
#define FA_LOAD(t) do { const int kr_ = FA_KROW0(t); const char* rb_ = (const char*)(P + (size_t)kr_ * PW); const char* rk_ = rb_ + (size_t)k1col * 2; const char* rv_ = rb_ + (size_t)vcol * 2; \
        sk0 = *(const bf16x8*)(rk_ + loff0); sk1 = *(const bf16x8*)(rk_ + (size_t)32 * PW * 2 + loff0); sv0 = *(const bf16x8*)(rv_ + loff0); sv1 = *(const bf16x8*)(rv_ + (size_t)32 * PW * 2 + loff0); \
        if (DQK == 192) sk2 = *(const bf16x8*)(rb_ + (size_t)k2col * 2 + loffx); } while (0)
#define FA_WRITE(bf) do { *(LAS bf16x8*)(K_lds + (bf) * G::SHM_K + kws0) = sk0; *(LAS bf16x8*)(K_lds + (bf) * G::SHM_K + kws1) = sk1; \
        *(LAS bf16x8*)(V_lds + (bf) * SHM_V + vst0) = sv0; *(LAS bf16x8*)(V_lds + (bf) * SHM_V + vst1) = sv1; \
        if (DQK == 192) *(LAS bf16x8*)(K_lds + (bf) * G::SHM_K + kws2) = sk2; } while (0)
    constexpr int QREG = (DQK == 192) ? 6 : DQK / 16;
    LAS unsigned char* qx = lds + G::BYTES + (wid * 384 + lane) * 16;
    if (DQK == 192) {
#pragma unroll
        for (int d0 = QREG; d0 < DQK / 16; ++d0) *(LAS bf16x8*)(qx + (d0 - QREG) * 1024) = qr[d0];
    }
    FA_LOAD(0); FA_WRITE(0);
    __syncthreads();
    for (int t = 0; t < NT; ++t) {
        const int cur = t & 1;
        unsigned zb = 0u; asm volatile("" : "+v"(zb)); u32x2 bw = (u32x2){zb, zb};
        if (use_bm) bw = *(const u32x2*)((const char*)(bmq + 2 * t) + bmoff);
        f32x16 p0 = (f32x16){0.f,0.f,0.f,0.f,0.f,0.f,0.f,0.f,0.f,0.f,0.f,0.f,0.f,0.f,0.f,0.f}, p1 = p0;
        { LAS unsigned char* kbase = K_lds + cur * G::SHM_K;
          LAS unsigned char* kb[4];
#pragma unroll
          for (int dd = 0; dd < 4; ++dd) kb[dd] = kbase + FA_KSWZ(r32, (dd * 16 + hi * 8) * 2, G::KP);
          constexpr int GS = (DQK == 192) ? 2 : 4;
#pragma unroll
          for (int g = 0; g < DQK / (16 * GS); ++g) {
              bf16x8 fb0[GS], fb1[GS];
#pragma unroll
              for (int dd = 0; dd < GS; ++dd) { const int d0 = g * GS + dd; LAS unsigned char* a = kb[d0 & 3] + (d0 >> 2) * 128; fb0[dd] = *(const LAS bf16x8*)a; fb1[dd] = *(const LAS bf16x8*)(a + 32 * G::KP); }
              FA_SBAR();
#pragma unroll
              for (int dd = 0; dd < GS; ++dd) { const int d0 = g * GS + dd; bf16x8 qf; if (d0 < QREG) qf = qr[d0 < QREG ? d0 : 0]; else qf = *(const LAS bf16x8*)(qx + (d0 - QREG) * 1024);
                  p0 = __builtin_amdgcn_mfma_f32_32x32x16_bf16(fb0[dd], qf, p0, 0, 0, 0); p1 = __builtin_amdgcn_mfma_f32_32x32x16_bf16(fb1[dd], qf, p1, 0, 0, 0); }
              FA_SBAR(); } }
        if (t + 1 < NT) FA_LOAD(t + 1);
        FA_SBAR();
        const float NEG = -__builtin_inff();
        if (use_bm) {
            const unsigned wx = bw.x >> (4 * hi), wy = bw.y >> (4 * hi);
#pragma unroll
            for (int r = 0; r < 16; ++r) { const unsigned bit = 1u << ((r & 3) + 8 * (r >> 2)); if (!(wx & bit)) p0[r] = NEG; if (!(wy & bit)) p1[r] = NEG; }
        } else if (t == 0 || 64 * t + 63 > it.qk0 + wid * 32) {
            const int kb_ = 64 * t + 4 * hi;
#pragma unroll
            for (int r = 0; r < 16; ++r) { const int k0 = kb_ + (r & 3) + 8 * (r >> 2), k1 = k0 + 32;
                if (k0 < 48 || k0 > qk) p0[r] = NEG; if (k1 < 48 || k1 > qk) p1[r] = NEG; }
        }
        float pmax = p0[0];
#pragma unroll
        for (int r = 1; r < 16; ++r) pmax = fmaxf(pmax, p0[r]);
#pragma unroll
        for (int r = 0; r < 16; ++r) pmax = fmaxf(pmax, p1[r]);
        { auto rr = __builtin_amdgcn_permlane32_swap(__float_as_uint(pmax), __float_as_uint(pmax), false, false); pmax = fmaxf(__uint_as_float(rr[0]), __uint_as_float(rr[1])); }
        const float mn = fmaxf(m_reg, pmax); const float alpha = __builtin_amdgcn_exp2f(m_reg - mn); m_reg = mn;
        float ps = 0.f;
#pragma unroll
        for (int r = 0; r < 16; ++r) { p0[r] = __builtin_amdgcn_exp2f(p0[r] - mn); p1[r] = __builtin_amdgcn_exp2f(p1[r] - mn); ps += p0[r] + p1[r]; }
        { auto rr = __builtin_amdgcn_permlane32_swap(__float_as_uint(ps), __float_as_uint(ps), false, false); ps = __uint_as_float(rr[0]) + __uint_as_float(rr[1]); }
        l_reg = l_reg * alpha + ps;
        if (__any(alpha < 1.f)) { if (hi == 0) wsf[r32] = alpha; LDS_WAIT();
#pragma unroll
            for (int d_ = 0; d_ < 4; ++d_)
#pragma unroll
                for (int r = 0; r < 16; ++r) o[d_][r] *= wsf[crow(r, hi)];
            LDS_WAIT(); }
        bf16x8 pa0, pa1, pa2, pa3;
#define FA_PK4(Pv, B_, OUT) do { const unsigned a0 = cvt_pk_bf16(Pv[B_ + 0], Pv[B_ + 1]), a1 = cvt_pk_bf16(Pv[B_ + 2], Pv[B_ + 3]), b0 = cvt_pk_bf16(Pv[B_ + 4], Pv[B_ + 5]), b1 = cvt_pk_bf16(Pv[B_ + 6], Pv[B_ + 7]); \
        auto r0 = __builtin_amdgcn_permlane32_swap(a0, b0, false, false); auto r1 = __builtin_amdgcn_permlane32_swap(a1, b1, false, false); \
        u32x4 w_ = {r0[0], r1[0], r0[1], r1[1]}; OUT = __builtin_bit_cast(bf16x8, w_); } while (0)
        FA_PK4(p0, 0, pa0); FA_PK4(p0, 8, pa1); FA_PK4(p1, 0, pa2); FA_PK4(p1, 8, pa3);
#define FA_TRRD(dst, off) asm volatile("ds_read_b64_tr_b16 %0, %1 offset:%2" : "=&v"(dst) : "v"(vb0), "i"(off) : "memory")
#define FA_PV(VB, d0) do { s16x4 l0, l1, l2, l3, h0, h1, h2, h3; constexpr int b_ = (VB) * SHM_V + v_rd_off(d0, 0, 0); \
        FA_TRRD(l0, b_); FA_TRRD(h0, b_ + 2048); FA_TRRD(l1, b_ + 4096); FA_TRRD(h1, b_ + 6144); FA_TRRD(l2, b_ + 8192); FA_TRRD(h2, b_ + 10240); FA_TRRD(l3, b_ + 12288); FA_TRRD(h3, b_ + 14336); \
        asm volatile("s_waitcnt lgkmcnt(0)" ::: "memory"); FA_SBAR(); \
        o[d0] = __builtin_amdgcn_mfma_f32_32x32x16_bf16(pa0, (bf16x8){l0[0], l0[1], l0[2], l0[3], h0[0], h0[1], h0[2], h0[3]}, o[d0], 0, 0, 0); \
        o[d0] = __builtin_amdgcn_mfma_f32_32x32x16_bf16(pa1, (bf16x8){l1[0], l1[1], l1[2], l1[3], h1[0], h1[1], h1[2], h1[3]}, o[d0], 0, 0, 0); \
        o[d0] = __builtin_amdgcn_mfma_f32_32x32x16_bf16(pa2, (bf16x8){l2[0], l2[1], l2[2], l2[3], h2[0], h2[1], h2[2], h2[3]}, o[d0], 0, 0, 0); \
        o[d0] = __builtin_amdgcn_mfma_f32_32x32x16_bf16(pa3, (bf16x8){l3[0], l3[1], l3[2], l3[3], h3[0], h3[1], h3[2], h3[3]}, o[d0], 0, 0, 0); } while (0)
        FA_SBAR();
        if (cur == 0) { FA_PV(0, 0); FA_PV(0, 1); FA_PV(0, 2); FA_PV(0, 3); } else { FA_PV(1, 0); FA_PV(1, 1); FA_PV(1, 2); FA_PV(1, 3); }
        FA_SBAR();
        if (t + 1 < NT) { if (cur == 0) FA_WRITE(1); else FA_WRITE(0); }
        __syncthreads();
    }
    if (hi == 0) wsf[r32] = l_reg; LDS_WAIT();
    float rli[16];
#pragma unroll
    for (int r = 0; r < 16; ++r) { const float lv = wsf[crow(r, hi)]; rli[r] = lv > 0.f ? __builtin_amdgcn_rcpf(lv) : 0.f; }
    { int l2 = lane; asm volatile("" : "+v"(l2));
      const int r32b = l2 & 31, hib = l2 >> 5;
      char* Ow = (char*)(P + (size_t)(it.qrow0 + wid * 32) * PW + ocol) + (unsigned)((4 * hib) * PW + r32b) * 2u;
#pragma unroll
      for (int r = 0; r < 16; ++r) { const unsigned ro = (unsigned)(((r & 3) + 8 * (r >> 2)) * PW) * 2u;
#pragma unroll
        for (int d0 = 0; d0 < 4; ++d0) { const float v = o[d0][r] * rli[r]; const float vn = __shfl_xor(v, 1);
            if ((r32b & 1) == 0) *(unsigned*)(Ow + ro + d0 * 64) = cvt_pk_bf16(v, vn); } } }
    LDS_WAIT();
    __syncthreads();
#undef FA_KROW0
#undef FA_LOAD
#undef FA_WRITE
#undef FA_PK4
#undef FA_TRRD
#undef FA_PV
}
__device__ __forceinline__ int next_item(unsigned* ctr, LAS int* slot) {
    __syncthreads();
    if (threadIdx.x == 0) *slot = (int)__hip_atomic_fetch_add(ctr, 1u, __ATOMIC_RELAXED, __HIP_MEMORY_SCOPE_AGENT);
    __syncthreads();
    return *slot;
}
__device__ __forceinline__ Item make_item(bool meta, int b, int qb) {
    Item it;
    if (meta) { it.qrow0 = 0; it.qk0 = -(MBLK - 64); it.nt = 1; it.tokbase = MBLK; }
    else { it.qrow0 = MBLK + b * SEQ + qb * 256; it.qk0 = 64 + qb * 256; it.nt = 4 * (qb + 1) + 1; it.tokbase = MBLK + b * SEQ; }
    return it;
}
}

__device__ __forceinline__ int deal_row(int pass, int gw, int ngw) { const int j = (pass & 1) ? (ngw - 1 - gw) : gw; return pass * ngw + j; }

constexpr int PH_PER_LAYER = 20, N_PHASES = 2 * PH_PER_LAYER;
__device__ __forceinline__ unsigned char* uni_ptr(unsigned char* p) { const unsigned long long v = (unsigned long long)p; const unsigned lo = __builtin_amdgcn_readfirstlane((unsigned)v), hi = __builtin_amdgcn_readfirstlane((unsigned)(v >> 32)); return (unsigned char*)(((unsigned long long)hi << 32) | lo); }
__device__ __forceinline__ const float* arg_in(const Args& a, int k) { asm volatile("" : "+s"(k)); return a.in[k]; }
__global__ void __launch_bounds__(NWAVES * 64, 2) mega_fwd(Args args) {
    extern __shared__ __attribute__((aligned(16))) unsigned char lds_raw[];
    {
        LAS unsigned char* l0 = (LAS unsigned char*)lds_raw;
        for (int u = threadIdx.x; u < (LDS_BYTES - LDSCTL_OFF) / 4; u += NWAVES * 64) ((LAS unsigned*)(l0 + LDSCTL_OFF))[u] = 0u;
        __syncthreads();
    }
#if MK_ONE_LAUNCH
    (void)xcd_barrier_post((unsigned*)(args.ws + WS_CTL) + CW_BAR, (volatile LAS unsigned*)((LAS unsigned char*)lds_raw + LDSCTL_OFF + 64));
#define GRID_BAR() do { XcdBarrier bar_; bar_.bar = (unsigned*)(uni_ptr(args.ws) + WS_CTL) + CW_BAR; bar_.x = xb_xcc_id(); bar_.st = (volatile LAS unsigned*)((LAS unsigned char*)lds_raw + LDSCTL_OFF + 64); xcd_barrier(bar_); } while (0)
#else
#define GRID_BAR() do {} while (0)
#endif
    const int lo = args.ph_lo, hi = args.ph_hi;
#define IN(k) (lo <= (k) && (k) < hi)
#define SEAM(k) do { if (IN((k) + 1)) GRID_BAR(); } while (0)
#define PH_BEGIN \
    int tid_ = threadIdx.x; asm volatile("" : "+v"(tid_)); \
    Ctx F; F.lds = (LAS unsigned char*)lds_raw; F.tid = tid_; F.lane = tid_ & 63; F.wave = __builtin_amdgcn_readfirstlane(tid_ >> 6); \
    F.G = gridDim.x; F.bid = blockIdx.x; F.gw = F.bid * NWAVES + F.wave; F.ngw = F.G * NWAVES; \
    unsigned char* ws = uni_ptr(args.ws); asm volatile("" : "+s"(ws)); \
    int ly = __builtin_amdgcn_readfirstlane(layer); asm volatile("" : "+s"(ly)); (void)ly; (void)F
#define XN_ ((bf16_t*)(ws + WS_XN))
#define P_ ((bf16_t*)(ws + WS_P))
#define HMETA_ ((float*)(ws + WS_HMETA))
#define RSTDQ_ ((float*)(ws + WS_RSTD))
#define RSTDKV_ ((float*)(ws + WS_RSTD) + R)
#define BM_ ((unsigned*)(ws + WS_BM))
#define WB_(off) ((bf16_t*)(ws + WS_WB + (off)))
#define OUT_ (args.out)
#define LAMBDA_INIT(ly) ((ly) == 0 ? 0.2f : (0.8f - 0.6f * 0.7408182206817179f))
#define HSRC_TOK(ly) ((ly) == 0 ? arg_in(args, 0) : (const float*)args.out)

#pragma unroll
    for (int layer = 0; layer < 2; ++layer) {
        const int pb = layer * PH_PER_LAYER;
        if (((PHMASK >> 0) & 1) && IN(pb + 0)) {
            PH_BEGIN;
            const float* meta = arg_in(args, 1);
            conv_matrix<1>(F, arg_in(args, 3) + (size_t)ly * DM * D_IN, DM, D_IN, WB_(WB_IN), arg_in(args, 2) + ly * DM);
            conv_matrix<0>(F, arg_in(args, 7) + (size_t)ly * 512 * 1536, 512, 1536, WB_(WB_QUP), arg_in(args, 5) + ly * 512);
            conv_matrix<0>(F, arg_in(args, 8) + (size_t)ly * 512 * 2048, 512, 2048, WB_(WB_KVUP), arg_in(args, 6) + ly * 512);
            for (int b = 0; b < 3; ++b) conv_matrix<0>(F, arg_in(args, 14) + ((size_t)ly * 3 + b) * 1024 * DM, 1024, DM, WB_(WB_BR) + (size_t)b * DM * 1024, nullptr);
            conv_matrix<0>(F, arg_in(args, 15) + (size_t)ly * DM * DM, DM, DM, WB_(WB_O), nullptr);
            conv_matrix<2>(F, arg_in(args, 17) + (size_t)ly * DM * 2 * DFF, DM, 2 * DFF, WB_(WB_F1), arg_in(args, 16) + ly * DM);
            conv_matrix<0>(F, arg_in(args, 18) + (size_t)ly * DFF * DM, DFF, DM, WB_(WB_F2), nullptr);
            unsigned zu = 0u; asm volatile("" : "+v"(zu)); const float zf = __uint_as_float(zu);
            for (int i = F.gw * 64 + F.lane; i < 112 * 2048 / 8; i += F.ngw * 64) *((u32x4*)(WB_(WB_IN) + (size_t)1168 * 2048) + i) = (u32x4){zu, zu, zu, zu};
            float* hmeta = HMETA_;
            if (ly == 0) {
                for (int i = F.gw * 64 + F.lane; i < MROW0 * PW / 8; i += F.ngw * 64) *((u32x4*)P_ + i) = (u32x4){zu, zu, zu, zu};
                for (int i = F.gw * 64 + F.lane; i < MBLK * DM / 4; i += F.ngw * 64) { const int rr = i / (DM / 4); f32x4 v = (f32x4){zf, zf, zf, zf};
                    if (rr >= MBLK - NMETA) v = *((const f32x4*)meta + (i - (MBLK - NMETA) * (DM / 4))); *((f32x4*)hmeta + i) = v; }
            }
            const float* hsrc_tok = HSRC_TOK(ly);
            bf16_t* XN = XN_;
            for (int r = MROW0 + F.gw; r < R; r += F.ngw) {
                const float* src;
                if (r < MBLK) src = (ly == 0) ? (r >= MBLK - NMETA ? meta + (size_t)(r - (MBLK - NMETA)) * DM : nullptr) : hmeta + (size_t)r * DM;
                else src = hsrc_tok + (size_t)(r - MBLK) * DM;
                norm_row(src, XN + (size_t)r * DM, F.lane);
            }
            SEAM(pb + 0);
        }
        if (((PHMASK >> 1) & 1) && IN(pb + 1)) {
            PH_BEGIN;
            { SkP f{P_, 0}; skinny_gemm(F.lds, XN_ + (size_t)MROW0 * DM, DM, WB_(WB_IN), DM, 1280 / 16, F.bid, F.G, f); }
            SchedPlain S{XN_, DM, WB_(WB_IN), DM, NPMM, 5, F.G, F.bid, 0}; EpiP E{P_};
            pg8::gemm_phase(F.lds, S, E);
            SEAM(pb + 1);
        }
        if (((PHMASK >> 2) & 1) && IN(pb + 2)) {
            PH_BEGIN;
            { bf16_t* P = P_; float* rq = RSTDQ_; float* rkv = RSTDKV_;
              for (int r = MROW0 + F.gw; r < R; r += F.ngw) post1a_row(P, r, rq, rkv, F.lane); }
            VM_WAIT(); __syncthreads();
            { SkP f{P_, C_QRAW}; skinny_gemm(F.lds, P_ + (size_t)MROW0 * PW + C_CQ, PW, WB_(WB_QUP), 512, 1536 / 16, F.bid, F.G, f); }
            { SkP f{P_, C_KVRAW}; skinny_gemm(F.lds, P_ + (size_t)MROW0 * PW + C_CKV, PW, WB_(WB_KVUP), 512, 2048 / 16, F.bid, F.G, f); }
            SchedMlaUp S{P_, WB_(WB_QUP), WB_(WB_KVUP), F.G, F.bid}; EpiP E{P_};
            pg8::gemm_phase(F.lds, S, E);
            SEAM(pb + 2);
        }
        if (((PHMASK >> 3) & 1) && IN(pb + 3)) {
            PH_BEGIN;
            const float* mla_qkg = arg_in(args, 9) + ly * 2 * 192;
            bf16_t* P = P_; float* rq = RSTDQ_; float* rkv = RSTDKV_;
            for (int r = MROW0 + F.gw; r < R; r += F.ngw) post2_row(P, r, rq, rkv, mla_qkg, F.lane);
            SEAM(pb + 3);
        }
        if (((PHMASK >> 4) & 1) && IN(pb + 4)) {
            PH_BEGIN;
            bf16_t* P = P_;
            LAS int* slot = (LAS int*)(F.lds + LDSCTL_OFF + 128);
            for (int rep_ = 0; rep_ < NREP(4); ++rep_) { if (rep_) GRID_BAR();
            unsigned* ctr = (unsigned*)(ws + WS_CTL) + CW_Q + 64 * (ly * 4 + 0) + 64 * 16 * rep_;
            for (;;) {
                const int idx = fa::next_item(ctr, slot); if (idx >= 8 * 129) break;
                int h; fa::Item it;
                if (idx < 1024) { const int qb = 7 - (idx >> 7), rest = idx & 127; h = rest & 7; it = fa::make_item(false, rest >> 3, qb); } else { h = idx - 1024; it = fa::make_item(true, 0, 0); }
                bf16x8 qr[12]; fa::load_q<192>(P, it, C_QRAW + h * 192, qr);
                fa::attn_core<192, false>(P, it, qr, C_KVRAW + h * 256, C_KPEH + h * 64, C_KVRAW + h * 256 + 128, C_OA + h * 128, nullptr, F.lds);
            } }
            SEAM(pb + 4);
        }
        if (((PHMASK >> 5) & 1) && IN(pb + 5)) {
            PH_BEGIN;
            { SkP f{P_, 1280}; skinny_gemm(F.lds, XN_ + (size_t)MROW0 * DM, DM, WB_(WB_IN) + (size_t)1280 * DM, DM, 7168 / 16, F.bid, F.G, f); }
            SchedPlain S{XN_, DM, WB_(WB_IN) + (size_t)1280 * DM, DM, NPMM, 28, F.G, F.bid, 1280}; EpiP E{P_};
            pg8::gemm_phase(F.lds, S, E);
            if (NREP(5) == 2) { GRID_BAR(); pg8::gemm_phase(F.lds, S, E); }
            SEAM(pb + 5);
        }
        if (((PHMASK >> 6) & 1) && IN(pb + 6)) {
            PH_BEGIN;
            const float* dsa_qkg = arg_in(args, 10) + ly * 2 * 128; const float* diff_qkg = arg_in(args, 11) + ly * 2 * 128;
            bf16_t* P = P_;
            for (int r = MROW0 + F.gw; r < R; r += F.ngw) post1b_row(P, r, dsa_qkg, diff_qkg, F.lane);
            SEAM(pb + 6);
        }
        if (((PHMASK >> 7) & 1) && IN(pb + 7)) {
            PH_BEGIN;
            bf16_t* P = P_; unsigned* bm = BM_;
            unsigned* ctr = (unsigned*)(ws + WS_CTL) + CW_Q + 64 * (ly * 4 + 2);
            LAS int* slot = (LAS int*)(F.lds + LDSCTL_OFF + 128);
            for (;;) { const int idx = fa::next_item(ctr, slot); if (idx >= NTOK / 16) break; index_unit(P, idx, bm); }
            SEAM(pb + 7);
        }
        if (((PHMASK >> 8) & 1) && IN(pb + 8)) {
            PH_BEGIN;
            bf16_t* P = P_; unsigned* bm = BM_;
            unsigned* ctr = (unsigned*)(ws + WS_CTL) + CW_Q + 64 * (ly * 4 + 1);
            LAS int* slot = (LAS int*)(F.lds + LDSCTL_OFF + 128);
            for (;;) {
                const int idx = fa::next_item(ctr, slot); if (idx >= 16 * 129) break;
                int hh; bool meta = false; fa::Item it; int b = 0, qb = 0;
                if (idx < 2048) { qb = 7 - (idx >> 8); const int rest = idx & 255; hh = (rest < 128) ? 8 + (rest & 7) : (rest & 7); b = (rest & 127) >> 3; it = fa::make_item(false, b, qb); }
                else { hh = idx - 2048; hh = hh < 8 ? 8 + hh : hh - 8; meta = true; it = fa::make_item(true, 0, 0); }
                if (hh < 8) {
                    bf16x8 qr[8]; fa::load_q<128>(P, it, C_DQ + hh * 128, qr);
                    fa::attn_core<128, true>(P, it, qr, C_DK + hh * 128, 0, C_DV + hh * 128, C_OB + hh * 128, meta ? nullptr : bm + (size_t)(b * SEQ + qb * 256) * BMW, F.lds);
                } else {
                    const int hj = hh - 8;
                    bf16x8 qr[8]; fa::load_q<128>(P, it, C_FQ + hj * 128, qr);
                    fa::attn_core<128, false>(P, it, qr, C_FK + hj * 128, 0, C_FV + (hj >> 1) * 256, C_FQ + hj * 128, nullptr, F.lds);
                    fa::attn_core<128, false>(P, it, qr, C_FK + hj * 128, 0, C_FV + (hj >> 1) * 256 + 128, C_IQ + hj * 128, nullptr, F.lds);
                }
            }
            SEAM(pb + 8);
        }
        if (((PHMASK >> 9) & 1) && IN(pb + 9)) {
            PH_BEGIN;
            const float* diff_lam = arg_in(args, 12) + ly * 4 * 128; const float* diff_subg = arg_in(args, 13) + ly * 256;
            const float lambda_init = LAMBDA_INIT(ly);
            const float s1 = wave_sum(diff_lam[F.lane] * diff_lam[128 + F.lane] + diff_lam[64 + F.lane] * diff_lam[192 + F.lane]);
            const float s2 = wave_sum(diff_lam[256 + F.lane] * diff_lam[384 + F.lane] + diff_lam[320 + F.lane] * diff_lam[448 + F.lane]);
            const float lam = __expf(s1) - __expf(s2) + lambda_init;
            bf16_t* P = P_;
            for (int r = MROW0 + F.gw; r < R; r += F.ngw) post3_row(P, r, diff_subg, lam, 1.f - lambda_init, F.lane);
            SEAM(pb + 9);
        }
#define GATE_PHASE(k, b) \
        if (((PHMASK >> 10) & 1) && IN(pb + (k))) { \
            PH_BEGIN; \
            { SkGate f{(bf16_t*)(ws + WS_GS), arg_in(args, 4) + ly * 3 * DM + (b) * DM}; skinny_gemm(F.lds, XN_ + (size_t)MROW0 * DM, DM, WB_(WB_G) + (size_t)(b) * 2048 * DM, DM, 2048 / 16, F.bid, F.G, f); } \
            SchedPlain S{XN_, DM, WB_(WB_G) + (size_t)(b) * 2048 * DM, DM, NPMM, 8, F.G, F.bid, 0}; EpiGate E{(bf16_t*)(ws + WS_GS), arg_in(args, 4) + ly * 3 * DM + (b) * DM}; \
            pg8::gemm_phase(F.lds, S, E); \
            SEAM(pb + (k)); \
        }
#define BRANCH_PHASE(k, b, oc) \
        if (((PHMASK >> 10) & 1) && IN(pb + (k))) { \
            PH_BEGIN; \
            { SkGated f{P_, (const bf16_t*)(ws + WS_GS), (b) == 0 ? 1 : 0}; skinny_gemm(F.lds, P_ + (size_t)MROW0 * PW + (oc), PW, WB_(WB_BR) + (size_t)(b) * DM * 1024, 1024, 2048 / 16, F.bid, F.G, f); } \
            SchedPlain S{P_ + (oc), PW, WB_(WB_BR) + (size_t)(b) * DM * 1024, 1024, NPMM, 8, F.G, F.bid, C_MERGED}; EpiGated E{P_, (const bf16_t*)(ws + WS_GS), (b) == 0 ? 1 : 0, ((DBG_BM >> (b)) & 1) ? 1.f : 0.f}; \
            pg8::gemm_phase(F.lds, S, E); \
            SEAM(pb + (k)); \
        }
        GATE_PHASE(10, 0) BRANCH_PHASE(11, 0, C_OA)
        GATE_PHASE(12, 1) BRANCH_PHASE(13, 1, C_OB)
        GATE_PHASE(14, 2) BRANCH_PHASE(15, 2, C_OC)
        if (((PHMASK >> 11) & 1) && IN(pb + 16)) {
            PH_BEGIN;
            { SkRes f{HMETA_}; skinny_gemm(F.lds, P_ + (size_t)MROW0 * PW + C_MERGED, PW, WB_(WB_O), DM, 2048 / 16, F.bid, F.G, f); }
            SchedPlain S{P_ + C_MERGED, PW, WB_(WB_O), DM, NPMM, 8, F.G, F.bid, 0}; EpiRes E{HSRC_TOK(ly), OUT_, HMETA_, DBG_SA};
            pg8::gemm_phase(F.lds, S, E);
            SEAM(pb + 16);
        }
        if (((PHMASK >> 12) & 1) && IN(pb + 17)) {
            PH_BEGIN;
            float* hmeta = HMETA_; float* out = OUT_; bf16_t* XN = XN_;
            for (int r = MROW0 + F.gw; r < R; r += F.ngw) norm_row(r < MBLK ? hmeta + (size_t)r * DM : out + (size_t)(r - MBLK) * DM, XN + (size_t)r * DM, F.lane);
            SEAM(pb + 17);
        }
        if (((PHMASK >> 13) & 1) && IN(pb + 18)) {
            PH_BEGIN;
            skinny_swiglu(F.lds, XN_ + (size_t)MROW0 * DM, DM, WB_(WB_F1), DM, P_, F.bid, F.G);
            SchedPlain S{XN_, DM, WB_(WB_F1), DM, NPMM, 44, F.G, F.bid, 0}; EpiSwiglu E{P_};
            pg8::gemm_phase(F.lds, S, E);
            SEAM(pb + 18);
        }
        if (((PHMASK >> 14) & 1) && IN(pb + 19)) {
            PH_BEGIN;
            { SkRes f{HMETA_}; skinny_gemm(F.lds, P_ + (size_t)MROW0 * PW, PW, WB_(WB_F2), DFF, 2048 / 16, F.bid, F.G, f); }
            SchedPlain S{P_, PW, WB_(WB_F2), DFF, NPMM, 8, F.G, F.bid, 0}; EpiRes E{OUT_, OUT_, HMETA_, DBG_SF};
            pg8::gemm_phase(F.lds, S, E);
            SEAM(pb + 19);
        }
    }
#undef IN
#undef SEAM
}

__global__ void diag_fill(float* out, int n, float v) { for (int i = blockIdx.x * blockDim.x + threadIdx.x; i < n; i += gridDim.x * blockDim.x) out[i] = v; }
extern "C" void kernel_launch(void* const* d_in, const int* in_sizes, int n_in, void* d_out, int out_size, void* d_ws, size_t ws_size, hipStream_t stream) {
    static int grid = 0; static float code = 0.f;
    if (grid == 0) {
        int dev = 0, cus = 0;
        if (n_in != 19) { code = 10.f; grid = -1; }
        else if (ws_size < WS_END) { code = 20.f + (float)(ws_size >> 20) * 0.01f; grid = -1; }
        else if (hipGetDevice(&dev) != hipSuccess || hipDeviceGetAttribute(&cus, hipDeviceAttributeMultiprocessorCount, dev) != hipSuccess) { code = 40.f; grid = -1; }
        else if (hipFuncSetAttribute((const void*)mega_fwd, hipFuncAttributeMaxDynamicSharedMemorySize, LDS_BYTES) != hipSuccess) { code = 50.f; grid = -1; }
        else {
            int per_cu = 0;
            if (hipOccupancyMaxActiveBlocksPerMultiprocessor(&per_cu, (const void*)mega_fwd, NWAVES * 64, LDS_BYTES) != hipSuccess || per_cu < 1) { code = 60.f; grid = -1; }
            (void)hipGetLastError();
            if (grid == 0) grid = cus;
        }
    }
    if (grid < 0) { hipLaunchKernelGGL(diag_fill, dim3(1024), dim3(256), 0, stream, (float*)d_out, out_size, code); return; }
    (void)hipMemsetAsync((char*)d_ws + WS_CTL, 0, CTL_BYTES, stream);
    Args a{};
    for (int i = 0; i < 19; ++i) a.in[i] = (const float*)d_in[i];
    a.out = (float*)d_out; a.ws = (unsigned char*)d_ws;
#if MK_ONE_LAUNCH
    a.ph_lo = 0; a.ph_hi = N_PHASES;
    hipLaunchKernelGGL(mega_fwd, dim3(grid), dim3(NWAVES * 64), LDS_BYTES, stream, a);
#else
    for (int p = 0; p < N_PHASES; ++p) { a.ph_lo = p; a.ph_hi = p + 1; hipLaunchKernelGGL(mega_fwd, dim3(grid), dim3(NWAVES * 64), LDS_BYTES, stream, a); }
#endif
    if (hipPeekAtLastError() != hipSuccess) { (void)hipGetLastError(); hipLaunchKernelGGL(diag_fill, dim3(1024), dim3(256), 0, stream, (float*)d_out, out_size, 70.f); }
}
```

```cpp
#include <hip/hip_runtime.h>
#include <cstdio>
#include <cstdint>

#ifndef PHMASK
#define PHMASK 0x7fff
#endif
#ifndef REPMASK
#define REPMASK 0
#endif
#define NREP(k) ((((REPMASK) >> (k)) & 1) ? 2 : 1)
#ifndef DBG_BM
#define DBG_BM 7
#endif
#ifndef DBG_BR
#define DBG_BR 0
#endif
#ifndef DBG_SA
#define DBG_SA 1.0f
#endif
#ifndef DBG_SF
#define DBG_SF 1.0f
#endif
#ifndef MK_ONE_LAUNCH
#define MK_ONE_LAUNCH 1
#endif

#define LAS __attribute__((address_space(3)))
#define GAS __attribute__((address_space(1)))
typedef unsigned short bf16_t;
typedef short bf16x8 __attribute__((ext_vector_type(8)));
typedef float f32x4 __attribute__((ext_vector_type(4)));
typedef float f32x2 __attribute__((ext_vector_type(2)));
typedef unsigned u32x4 __attribute__((ext_vector_type(4)));
typedef unsigned u32x2 __attribute__((ext_vector_type(2)));

constexpr int DM = 2048, NB = 16, SEQ = 2048, NMETA = 16, MBLK = 256;
constexpr int R = MBLK + NB * SEQ;
constexpr int NPM = R / 256;
constexpr int NPMM = NPM - 1;
constexpr int MROW0 = MBLK - NMETA;
constexpr int NTOK = NB * SEQ;
constexpr int DFF = 5632;
constexpr int PW = 8448;
constexpr int C_CQ = 0, C_CKV = 512, C_KPE = 1024, C_IK = 1088, C_IW = 1152, C_DQ = 1280, C_DK = 2304, C_DV = 3328, C_IQ = 4352,
              C_FQ = 5376, C_FK = 6400, C_FV = 7424;
constexpr int C_KVRAW = 1280, C_QRAW = 3328, C_KPEH = 4864;
constexpr int C_OA = 0, C_OB = C_DQ, C_OC = C_FQ, C_MERGED = 2304;
constexpr int BMW = 66;
constexpr float EPS = 1e-6f;
constexpr float LOG2E = 1.4426950408889634f;
constexpr float C2_128 = 0.08838834764831845f * LOG2E;
constexpr float C2_192 = 0.07216878364870323f * LOG2E;
constexpr int D_IN = 14480;

constexpr size_t MiB = 1u << 20;
constexpr size_t WS_CTL = 0, CTL_BYTES = 1 * MiB;
constexpr size_t WS_RSTD = 1 * MiB;
constexpr size_t WS_HMETA = 2 * MiB;
constexpr size_t WS_BM = 4 * MiB;
constexpr size_t WS_WB = 16 * MiB;
constexpr size_t WB_IN = 0, WB_G = WB_IN + (size_t)8448 * 2048 * 2, WB_QUP = WB_G + (size_t)6144 * 2048 * 2, WB_KVUP = WB_QUP + (size_t)1536 * 512 * 2,
                 WB_BR = WB_KVUP + (size_t)2048 * 512 * 2, WB_O = WB_BR + (size_t)3 * 2048 * 1024 * 2, WB_F1 = WB_O + (size_t)2048 * 2048 * 2,
                 WB_F2 = WB_F1 + (size_t)11264 * 2048 * 2, WB_END = WB_F2 + (size_t)2048 * 5632 * 2;
constexpr size_t WS_XN = 164 * MiB;
constexpr size_t WS_P = 294 * MiB;
constexpr size_t WS_GS = 828 * MiB;
constexpr size_t WS_END = 960 * MiB;
static_assert(WS_GS + (size_t)R * 2048 * 2 <= WS_END && WS_WB + WB_END <= WS_XN && WS_XN + (size_t)R * 2048 * 2 <= WS_P && WS_P + (size_t)R * PW * 2 <= WS_GS, "ws map");
constexpr int CW_BAR = 4096, CW_Q = 16384;

__device__ __forceinline__ float bf2f(bf16_t v) { return __uint_as_float((unsigned)v << 16); }
__device__ __forceinline__ unsigned f2bf(float f) { unsigned u = __float_as_uint(f); return (u + 0x7fffu + ((u >> 16) & 1u)) >> 16; }
__device__ __forceinline__ unsigned pk2(float lo, float hi) { return f2bf(lo) | (f2bf(hi) << 16); }
typedef __bf16 bf16x2_t __attribute__((ext_vector_type(2)));
__device__ __forceinline__ unsigned cvt_pk_bf16(float lo, float hi) { f32x2 v = {lo, hi}; bf16x2_t b = __builtin_convertvector(v, bf16x2_t); return __builtin_bit_cast(unsigned, b); }
__device__ __forceinline__ float wave_sum(float v) {
#pragma unroll
    for (int o = 1; o < 64; o <<= 1) v += __shfl_xor(v, o);
    return v;
}
__device__ __forceinline__ float wave_max(float v) {
#pragma unroll
    for (int o = 1; o < 64; o <<= 1) v = fmaxf(v, __shfl_xor(v, o));
    return v;
}
#define LDS_WAIT() asm volatile("s_waitcnt lgkmcnt(0)" ::: "memory")
#define VM_WAIT() asm volatile("s_waitcnt vmcnt(0)" ::: "memory")
__device__ __forceinline__ int row_pos(int r) { return r < MBLK ? (r >= MBLK - NMETA ? r - (MBLK - NMETA) : 0) : NMETA + ((r - MBLK) & (SEQ - 1)); }
__device__ __forceinline__ void rope_cs(int pos, int i, float two_over_d, float& c, float& s) {
    const float inv = __builtin_amdgcn_exp2f(-(float)i * two_over_d * 13.287712379549449f);
    float rev = (float)pos * inv * 0.15915494309189535f;
    rev -= floorf(rev);
    s = __builtin_amdgcn_sinf(rev); c = __builtin_amdgcn_cosf(rev);
}

namespace pg8 {
constexpr int BM = 256, BK = 64, HALF = 128, HTB = HALF * BK * 2, STAGE_BYTES = 8 * HTB;
__device__ __forceinline__ int lds_byte(int r, int c) { const int st = (r >> 4) * 2 + (c >> 5), rr = r & 15, cc = c & 31, ob = rr * 64 + cc * 2; return st * 1024 + (ob ^ (((ob >> 9) & 1) << 5)); }
__device__ __forceinline__ void stage_rc(int b, int& R_, int& C_) { const int st = b / 1024, sb = b % 1024, swz = sb ^ (((sb >> 9) & 1) << 5); R_ = (st >> 1) * 16 + swz / 64; C_ = (st & 1) * 32 + (swz % 64) / 2; }
__device__ __forceinline__ int perm32(int rho) { const int n = rho >> 4, i = rho & 15; return 8 * (i >> 2) + 4 * n + (i & 3); }

struct Unit { const char* A; const char* B; unsigned lda2, ldb2; int nt, pm, pn, kind, ocol; };

__device__ __forceinline__ void tile_of(int L, int nM, int nN, int& pm, int& pn) {
    const int nwg = nM * nN; int wgid = L;
    { const int q = nwg / 8, r = nwg % 8, xcd = wgid % 8, off = wgid / 8; wgid = (xcd < r ? xcd * (q + 1) : r * (q + 1) + (xcd - r) * q) + off; }
    const int nig = 8 * nN, gid = wgid / nig, fm = gid * 8, gsz = (nM - fm) < 8 ? (nM - fm) : 8;
    pm = fm + ((wgid % nig) % gsz); pn = (wgid % nig) / gsz;
}

template <class Epi, class Sched>
__device__ __forceinline__ void gemm_phase(LAS unsigned char* lds, const Sched& S, const Epi& E) {
    int tid = threadIdx.x; asm volatile("" : "+v"(tid));
    const int wid = __builtin_amdgcn_readfirstlane(tid >> 6), lane = tid & 63, wr = wid >> 2, wc = wid & 3, fr = lane & 15, fq = lane >> 4;
    unsigned rA[2], rB[2], cc[2];
#pragma unroll
    for (int i = 0; i < 2; ++i) { int R_, C_; stage_rc(tid * 16 + i * 8192, R_, C_); rA[i] = (unsigned)R_; rB[i] = (unsigned)(Epi::PERM ? ((R_ & ~31) + perm32(R_ & 31)) : R_); cc[i] = (unsigned)C_ * 2u; }
    const size_t kstep = (size_t)(BK * 2);
    const unsigned ldsw = (unsigned)wid * 1024u;
    const int aoff = lds_byte(wr * 64 + fr, fq * 8), boff = lds_byte(wc * 32 + fr, fq * 8);
#define PG8_SA(b, h) (((b) * 2 + (h)) * HTB)
#define PG8_SB(b, h) ((4 + (b) * 2 + (h)) * HTB)
#define PG8_STAGE(bufoff, gbase, rr, ld2) do { _Pragma("unroll") for (int _i = 0; _i < 2; ++_i) \
        __builtin_amdgcn_global_load_lds((const unsigned*)((const char*)(gbase) + ((rr)[_i] * (ld2) + cc[_i])), (LAS unsigned*)(lds + (bufoff) + ldsw + _i * 8192), 16, 0, 0); } while (0)
#define PG8_LDA(dst, b, h) do { _Pragma("unroll") for (int m = 0; m < 4; ++m) _Pragma("unroll") for (int k = 0; k < 2; ++k) dst[m][k] = *(const LAS bf16x8*)(lds + PG8_SA(b, h) + aoff + m * 2048 + k * 1024); } while (0)
#define PG8_LDB(dst, b, h) do { _Pragma("unroll") for (int n = 0; n < 2; ++n) _Pragma("unroll") for (int k = 0; k < 2; ++k) dst[n][k] = *(const LAS bf16x8*)(lds + PG8_SB(b, h) + boff + n * 2048 + k * 1024); } while (0)
#define PG8_MMA(ai, bj, At, Bt) do { __builtin_amdgcn_s_setprio(1); _Pragma("unroll") for (int m = 0; m < 4; ++m) _Pragma("unroll") for (int n = 0; n < 2; ++n) _Pragma("unroll") for (int k = 0; k < 2; ++k) \
        acc[ai][bj][m][n] = __builtin_amdgcn_mfma_f32_16x16x32_bf16(Bt[n][k], At[m][k], acc[ai][bj][m][n], 0, 0, 0); __builtin_amdgcn_s_setprio(0); } while (0)
#define PG8_WAIT_V(n) asm volatile("s_waitcnt vmcnt(" #n ")" ::: "memory")
#define PG8_WAIT_L(n) asm volatile("s_waitcnt lgkmcnt(" #n ")" ::: "memory")
#define PG8_BAR __builtin_amdgcn_s_barrier()
#define PG8_SCHED __builtin_amdgcn_sched_barrier(0)
    Unit cur, nxt; int ui = 0;
    if (!S.next(0, cur)) return;
    float zf = 0.f; asm volatile("" : "+v"(zf));
    f32x4 acc[2][2][4][2];
#pragma unroll
    for (int a = 0; a < 2; ++a)
#pragma unroll
        for (int b = 0; b < 2; ++b)
#pragma unroll
            for (int m = 0; m < 4; ++m)
#pragma unroll
                for (int n = 0; n < 2; ++n) acc[a][b][m][n] = (f32x4){zf, zf, zf, zf};
    bf16x8 At[4][2], B0[2][2], B1[2][2];
    const char* cA = cur.A; const char* cB = cur.B;
    unsigned lA = cur.lda2, lB = cur.ldb2;
    size_t hA = (size_t)HALF * lA, hB = (size_t)HALF * lB;
    PG8_STAGE(PG8_SB(0, 0), cB, rB, lB); PG8_STAGE(PG8_SB(0, 1), cB + hB, rB, lB); PG8_STAGE(PG8_SA(0, 0), cA, rA, lA); PG8_STAGE(PG8_SA(0, 1), cA + hA, rA, lA);
    if (wr == 1) PG8_BAR;
    PG8_WAIT_V(2); PG8_BAR;
    PG8_STAGE(PG8_SB(1, 0), cB + kstep, rB, lB); PG8_STAGE(PG8_SA(1, 0), cA + kstep, rA, lA); PG8_STAGE(PG8_SB(1, 1), cB + hB + kstep, rB, lB);
    PG8_WAIT_V(6); PG8_BAR;
    for (;;) {
        const bool has_next = S.next(ui + 1, nxt);
        if (!has_next) nxt = cur;
        const char* nA = nxt.A; const char* nB = nxt.B;
        const unsigned lAn = nxt.lda2, lBn = nxt.ldb2;
        const size_t hAn = (size_t)HALF * lAn, hBn = (size_t)HALF * lBn;
        const int nt = cur.nt;
        for (int t = 0; t < nt; t += 2) {
            const bool last = (t == nt - 2);
            const char* a1 = cA + (size_t)(t + 1) * kstep;
            const char* a2 = last ? nA : cA + (size_t)(t + 2) * kstep; const char* b2 = last ? nB : cB + (size_t)(t + 2) * kstep;
            const char* a3 = a2 + kstep; const char* b3 = b2 + kstep;
            const size_t hA2 = last ? hAn : hA, hB2 = last ? hBn : hB;
            const unsigned lA2 = last ? lAn : lA, lB2 = last ? lBn : lB;
            PG8_LDB(B0, 0, 0); PG8_LDB(B1, 0, 1); PG8_SCHED; PG8_LDA(At, 0, 0); PG8_STAGE(PG8_SA(1, 1), a1 + hA, rA, lA);
            PG8_WAIT_V(8); PG8_WAIT_L(0); PG8_BAR; PG8_MMA(0, 0, At, B0); PG8_MMA(0, 1, At, B1); PG8_BAR; PG8_SCHED;
            PG8_LDA(At, 0, 1); PG8_STAGE(PG8_SB(0, 0), b2, rB, lB2); PG8_STAGE(PG8_SB(0, 1), b2 + hB2, rB, lB2); PG8_STAGE(PG8_SA(0, 0), a2, rA, lA2);
            PG8_WAIT_V(8); PG8_WAIT_L(0); PG8_BAR; PG8_MMA(1, 0, At, B0); PG8_MMA(1, 1, At, B1); PG8_BAR; PG8_SCHED;
            PG8_LDB(B0, 1, 0); PG8_LDB(B1, 1, 1); PG8_SCHED; PG8_LDA(At, 1, 0); PG8_STAGE(PG8_SA(0, 1), a2 + hA2, rA, lA2);
            PG8_WAIT_V(8); PG8_WAIT_L(0); PG8_BAR; PG8_MMA(0, 0, At, B0); PG8_MMA(0, 1, At, B1); PG8_BAR; PG8_SCHED;
            PG8_LDA(At, 1, 1); PG8_STAGE(PG8_SB(1, 0), b3, rB, lB2); PG8_STAGE(PG8_SB(1, 1), b3 + hB2, rB, lB2); PG8_STAGE(PG8_SA(1, 0), a3, rA, lA2);
            PG8_WAIT_V(8); PG8_WAIT_L(0); PG8_BAR; PG8_MMA(1, 0, At, B0); PG8_MMA(1, 1, At, B1); PG8_BAR; PG8_SCHED;
        }
        if (wr == 0) PG8_BAR;
        E(acc, cur, wr, wc, fr, fq);
#pragma unroll
        for (int a = 0; a < 2; ++a)
#pragma unroll
            for (int b = 0; b < 2; ++b)
#pragma unroll
                for (int m = 0; m < 4; ++m)
#pragma unroll
                    for (int n = 0; n < 2; ++n) acc[a][b][m][n] = (f32x4){zf, zf, zf, zf};
        if (!has_next) break;
        cur = nxt; cA = nA; cB = nB; hA = hAn; hB = hBn; lA = lAn; lB = lBn; ++ui;
        if (wr == 1) PG8_BAR;
    }
    PG8_WAIT_V(0);
    PG8_BAR;
#undef PG8_SA
#undef PG8_SB
#undef PG8_STAGE
#undef PG8_LDA
#undef PG8_LDB
#undef PG8_MMA
#undef PG8_WAIT_V
#undef PG8_WAIT_L
#undef PG8_BAR
#undef PG8_SCHED
}
}
using pg8::Unit;

struct SchedPlain {
    const bf16_t* A; int lda; const bf16_t* B; int K; int nM, nN, G, c, ocol0;
    __device__ __forceinline__ bool next(int i, Unit& u) const {
        const int L = i * G + c; if (L >= nM * nN) return false;
        int pm, pn; pg8::tile_of(L, nM, nN, pm, pn); pm += 1;
        u.pm = pm; u.pn = pn; u.kind = 0; u.ocol = ocol0 + 256 * pn; u.nt = K / 64; u.lda2 = (unsigned)lda * 2u; u.ldb2 = (unsigned)K * 2u;
        u.A = (const char*)(A + (size_t)pm * 256 * lda); u.B = (const char*)(B + (size_t)pn * 256 * K); return true;
    }
};
struct SchedMlaUp {
    const bf16_t* P; const bf16_t* Wq; const bf16_t* Wkv; int G, c;
    __device__ __forceinline__ bool next(int i, Unit& u) const {
        const int L = i * G + c; if (L >= NPMM * 14) return false;
        int pm, pn; pg8::tile_of(L, NPMM, 14, pm, pn); pm += 1;
        u.pm = pm; u.pn = pn; u.kind = 0; u.nt = 8; u.lda2 = PW * 2u; u.ldb2 = 512 * 2u;
        if (pn < 6) { u.A = (const char*)(P + (size_t)pm * 256 * PW + C_CQ); u.B = (const char*)(Wq + (size_t)pn * 256 * 512); u.ocol = C_QRAW + 256 * pn; }
        else { u.A = (const char*)(P + (size_t)pm * 256 * PW + C_CKV); u.B = (const char*)(Wkv + (size_t)(pn - 6) * 256 * 512); u.ocol = C_KVRAW + 256 * (pn - 6); }
        return true;
    }
};
struct EpiP {
    static constexpr bool PERM = true;
    bf16_t* P;
    __device__ __forceinline__ void operator()(const f32x4 (&acc)[2][2][4][2], const Unit& u, int wr, int wc, int fr, int fq) const {
        asm volatile("" : "+v"(fr), "+v"(fq));
        const int row0 = u.pm * 256 + wr * 64 + fr, col0 = u.ocol + wc * 32 + 8 * fq;
#pragma unroll
        for (int ai = 0; ai < 2; ++ai)
#pragma unroll
            for (int m = 0; m < 4; ++m) { bf16_t* rowp = P + (size_t)(row0 + ai * 128 + m * 16) * PW + col0;
#pragma unroll
                for (int bj = 0; bj < 2; ++bj) { const f32x4 v0 = acc[ai][bj][m][0], v1 = acc[ai][bj][m][1];
                    u32x4 w; w.x = cvt_pk_bf16(v0[0], v0[1]); w.y = cvt_pk_bf16(v0[2], v0[3]); w.z = cvt_pk_bf16(v1[0], v1[1]); w.w = cvt_pk_bf16(v1[2], v1[3]);
                    *(u32x4*)(rowp + bj * 128) = w; } }
    }
};
struct EpiGate {
    static constexpr bool PERM = true;
    bf16_t* G; const float* bias;
    __device__ __forceinline__ void operator()(const f32x4 (&acc)[2][2][4][2], const Unit& u, int wr, int wc, int fr, int fq) const {
        asm volatile("" : "+v"(fr), "+v"(fq));
        const int row0 = u.pm * 256 + wr * 64 + fr, col0 = u.pn * 256 + wc * 32 + 8 * fq;
#pragma unroll
        for (int bj = 0; bj < 2; ++bj) { const f32x4 bv0 = *(const f32x4*)(bias + col0 + bj * 128), bv1 = *(const f32x4*)(bias + col0 + bj * 128 + 4);
#pragma unroll
            for (int ai = 0; ai < 2; ++ai)
#pragma unroll
                for (int m = 0; m < 4; ++m) { bf16_t* rowp = G + (size_t)(row0 + ai * 128 + m * 16) * 2048 + col0; f32x4 v0 = acc[ai][bj][m][0] + bv0, v1 = acc[ai][bj][m][1] + bv1;
#pragma unroll
                    for (int e = 0; e < 4; ++e) { v0[e] = __builtin_amdgcn_rcpf(1.f + __builtin_amdgcn_exp2f(-v0[e] * LOG2E)); v1[e] = __builtin_amdgcn_rcpf(1.f + __builtin_amdgcn_exp2f(-v1[e] * LOG2E)); }
                    u32x4 w; w.x = cvt_pk_bf16(v0[0], v0[1]); w.y = cvt_pk_bf16(v0[2], v0[3]); w.z = cvt_pk_bf16(v1[0], v1[1]); w.w = cvt_pk_bf16(v1[2], v1[3]);
                    *(u32x4*)(rowp + bj * 128) = w; } }
    }
};
struct EpiGated {
    static constexpr bool PERM = true;
    bf16_t* P; const bf16_t* G; int first; float sc;
    __device__ __forceinline__ void operator()(const f32x4 (&acc)[2][2][4][2], const Unit& u, int wr, int wc, int fr, int fq) const {
        asm volatile("" : "+v"(fr), "+v"(fq));
        const int row0 = u.pm * 256 + wr * 64 + fr, lcol0 = u.pn * 256 + wc * 32 + 8 * fq, col0 = u.ocol + wc * 32 + 8 * fq;
        unsigned zu = 0u; asm volatile("" : "+v"(zu));
#pragma unroll
        for (int ai = 0; ai < 2; ++ai)
#pragma unroll
            for (int m = 0; m < 4; ++m) { bf16_t* rowp = P + (size_t)(row0 + ai * 128 + m * 16) * PW + col0; const bf16_t* gp = G + (size_t)(row0 + ai * 128 + m * 16) * 2048 + lcol0;
#pragma unroll
                for (int bj = 0; bj < 2; ++bj) { u32x4 g = *(const u32x4*)(gp + bj * 128); if (DBG_BR == 1) g = (u32x4){0x3f803f80u, 0x3f803f80u, 0x3f803f80u, 0x3f803f80u};
                    u32x4 pv = (u32x4){zu, zu, zu, zu}; if (!first) pv = *(const u32x4*)(rowp + bj * 128);
                    const f32x4 v0 = acc[ai][bj][m][0] * sc, v1 = acc[ai][bj][m][1] * sc;
                    float o[8];
                    o[0] = __uint_as_float(pv.x << 16) + __uint_as_float(g.x << 16) * v0[0]; o[1] = __uint_as_float(pv.x & 0xffff0000u) + __uint_as_float(g.x & 0xffff0000u) * v0[1];
                    o[2] = __uint_as_float(pv.y << 16) + __uint_as_float(g.y << 16) * v0[2]; o[3] = __uint_as_float(pv.y & 0xffff0000u) + __uint_as_float(g.y & 0xffff0000u) * v0[3];
                    o[4] = __uint_as_float(pv.z << 16) + __uint_as_float(g.z << 16) * v1[0]; o[5] = __uint_as_float(pv.z & 0xffff0000u) + __uint_as_float(g.z & 0xffff0000u) * v1[1];
                    o[6] = __uint_as_float(pv.w << 16) + __uint_as_float(g.w << 16) * v1[2]; o[7] = __uint_as_float(pv.w & 0xffff0000u) + __uint_as_float(g.w & 0xffff0000u) * v1[3];
                    u32x4 w; w.x = cvt_pk_bf16(o[0], o[1]); w.y = cvt_pk_bf16(o[2], o[3]); w.z = cvt_pk_bf16(o[4], o[5]); w.w = cvt_pk_bf16(o[6], o[7]);
                    *(u32x4*)(rowp + bj * 128) = w; }
                asm volatile("" ::: "memory"); }
    }
};
struct EpiRes {
    static constexpr bool PERM = false;
    const float* base_tok; float* out_tok; float* hmeta; float dbg;
    __device__ __forceinline__ void operator()(const f32x4 (&acc)[2][2][4][2], const Unit& u, int wr, int wc, int fr, int fq) const {
        asm volatile("" : "+v"(fr), "+v"(fq));
        const float* bp; float* op;
        if (u.pm == 0) { bp = hmeta; op = hmeta; } else { bp = base_tok + (size_t)(u.pm - 1) * 256 * DM; op = out_tok + (size_t)(u.pm - 1) * 256 * DM; }
        const int lrow0 = wr * 64 + fr, col0 = u.pn * 256 + wc * 32 + 4 * fq;
#pragma unroll
        for (int ai = 0; ai < 2; ++ai)
#pragma unroll
            for (int m = 0; m < 4; ++m) { const size_t off = (size_t)(lrow0 + ai * 128 + m * 16) * DM + col0;
#pragma unroll
                for (int bj = 0; bj < 2; ++bj)
#pragma unroll
                    for (int n = 0; n < 2; ++n) { const f32x4 bs = *(const f32x4*)(bp + off + bj * 128 + n * 16); *(f32x4*)(op + off + bj * 128 + n * 16) = bs + acc[ai][bj][m][n] * dbg; }
                asm volatile("" ::: "memory"); }
    }
};
struct EpiSwiglu {
    static constexpr bool PERM = true;
    bf16_t* P;
    __device__ __forceinline__ void operator()(const f32x4 (&acc)[2][2][4][2], const Unit& u, int wr, int wc, int fr, int fq) const {
        asm volatile("" : "+v"(fr), "+v"(fq));
        const int row0 = u.pm * 256 + wr * 64 + fr, col0 = u.pn * 128 + wc * 32 + 8 * fq;
#pragma unroll
        for (int ai = 0; ai < 2; ++ai)
#pragma unroll
            for (int m = 0; m < 4; ++m) { bf16_t* rowp = P + (size_t)(row0 + ai * 128 + m * 16) * PW + col0;
                float o[8];
#pragma unroll
                for (int n = 0; n < 2; ++n)
#pragma unroll
                    for (int e = 0; e < 4; ++e) { const float g = acc[ai][0][m][n][e], up = acc[ai][1][m][n][e]; o[n * 4 + e] = g * __builtin_amdgcn_rcpf(1.f + __builtin_amdgcn_exp2f(-g * LOG2E)) * up; }
                u32x4 w; w.x = cvt_pk_bf16(o[0], o[1]); w.y = cvt_pk_bf16(o[2], o[3]); w.z = cvt_pk_bf16(o[4], o[5]); w.w = cvt_pk_bf16(o[6], o[7]);
                *(u32x4*)rowp = w; }
    }
};

struct SkP { bf16_t* P; int ocol; __device__ __forceinline__ void operator()(int r, int c, float v) const { P[(size_t)(MROW0 + r) * PW + ocol + c] = (bf16_t)f2bf(v); } };
struct SkGate { bf16_t* G; const float* bias; __device__ __forceinline__ void operator()(int r, int c, float v) const { G[(size_t)(MROW0 + r) * 2048 + c] = (bf16_t)f2bf(__builtin_amdgcn_rcpf(1.f + __builtin_amdgcn_exp2f(-(v + bias[c]) * LOG2E))); } };
struct SkGated { bf16_t* P; const bf16_t* G; int first; __device__ __forceinline__ void operator()(int r, int c, float v) const { bf16_t* p = P + (size_t)(MROW0 + r) * PW + C_MERGED + c; const float pv = first ? 0.f : bf2f(*p); *p = (bf16_t)f2bf(pv + bf2f(G[(size_t)(MROW0 + r) * 2048 + c]) * v); } };
struct SkRes { float* hmeta; __device__ __forceinline__ void operator()(int r, int c, float v) const { hmeta[(size_t)(MROW0 + r) * DM + c] += v; } };
template <class Fn>
__device__ __forceinline__ void skinny_gemm(LAS unsigned char* lds, const bf16_t* A, int lda, const bf16_t* Bt, int K, int ntask, int bid, int G, const Fn& f) {
    int tid = threadIdx.x; asm volatile("" : "+v"(tid));
    const int wid = __builtin_amdgcn_readfirstlane(tid >> 6), lane = tid & 63, l15 = lane & 15, kq = lane >> 4;
    LAS f32x4* red = (LAS f32x4*)lds;
    const int kw = K / 8;
    for (int task = bid; task < ntask; task += G) {
        const bf16_t* ap = A + (size_t)l15 * lda + wid * kw + kq * 8;
        const bf16_t* bp = Bt + (size_t)(task * 16 + l15) * K + wid * kw + kq * 8;
        float z = 0.f; asm volatile("" : "+v"(z));
        f32x4 acc = (f32x4){z, z, z, z};
        for (int k = 0; k < kw; k += 32) acc = __builtin_amdgcn_mfma_f32_16x16x32_bf16(*(const bf16x8*)(ap + k), *(const bf16x8*)(bp + k), acc, 0, 0, 0);
        red[wid * 64 + lane] = acc;
        LDS_WAIT(); __syncthreads();
        if (wid == 0) {
            f32x4 s = red[lane];
#pragma unroll
            for (int w = 1; w < 8; ++w) s += red[w * 64 + lane];
#pragma unroll
            for (int r = 0; r < 4; ++r) f(kq * 4 + r, task * 16 + l15, s[r]);
        }
        __syncthreads();
    }
}
__device__ __forceinline__ void skinny_swiglu(LAS unsigned char* lds, const bf16_t* A, int lda, const bf16_t* Bt, int K, bf16_t* P, int bid, int G) {
    int tid = threadIdx.x; asm volatile("" : "+v"(tid));
    const int wid = __builtin_amdgcn_readfirstlane(tid >> 6), lane = tid & 63, l15 = lane & 15, kq = lane >> 4;
    LAS f32x4* red = (LAS f32x4*)lds;
    const int kw = K / 8;
    for (int task = bid; task < DFF / 16; task += G) {
        const int c0 = task * 16, brow = (c0 >> 7) * 256 + (c0 & 127) + l15;
        const bf16_t* ap = A + (size_t)l15 * lda + wid * kw + kq * 8;
        const bf16_t* bg = Bt + (size_t)brow * K + wid * kw + kq * 8; const bf16_t* bu = bg + (size_t)128 * K;
        float z = 0.f; asm volatile("" : "+v"(z));
        f32x4 ag = (f32x4){z, z, z, z}, au = ag;
        for (int k = 0; k < kw; k += 32) { const bf16x8 a = *(const bf16x8*)(ap + k); ag = __builtin_amdgcn_mfma_f32_16x16x32_bf16(a, *(const bf16x8*)(bg + k), ag, 0, 0, 0); au = __builtin_amdgcn_mfma_f32_16x16x32_bf16(a, *(const bf16x8*)(bu + k), au, 0, 0, 0); }
        red[wid * 64 + lane] = ag; red[512 + wid * 64 + lane] = au;
        LDS_WAIT(); __syncthreads();
        if (wid == 0) {
            f32x4 sg = red[lane], su = red[512 + lane];
#pragma unroll
            for (int w = 1; w < 8; ++w) { sg += red[w * 64 + lane]; su += red[512 + w * 64 + lane]; }
#pragma unroll
            for (int r = 0; r < 4; ++r) { const float g = sg[r]; P[(size_t)(MROW0 + kq * 4 + r) * PW + c0 + l15] = (bf16_t)f2bf(g * __builtin_amdgcn_rcpf(1.f + __builtin_amdgcn_exp2f(-g * LOG2E)) * su[r]); }
        }
        __syncthreads();
    }
}

#define XB_TMO      128
#define XB_XCNT(j)  (256  + 64 * (j))
#define XB_XSUB(j)  (1280 + 64 * (j))
#define XB_XGEN(j)  (2304 + 64 * (j))
#define XB_TOP      3328
#define XB_TOPGEN   3392
#define XCD_BAR_WORDS 3456
#define XB_SPIN_CAP (1u << 18)
__device__ __forceinline__ unsigned xb_ld(unsigned* p)              { return __hip_atomic_load(p, __ATOMIC_RELAXED, __HIP_MEMORY_SCOPE_AGENT); }
__device__ __forceinline__ unsigned xb_add(unsigned* p, unsigned v) { return __hip_atomic_fetch_add(p, v, __ATOMIC_RELAXED, __HIP_MEMORY_SCOPE_AGENT); }
__device__ __forceinline__ unsigned xb_xcc_id() { return (unsigned)__builtin_amdgcn_s_getreg((3 << 11) | 20) & 0xFu; }
#define XB_SPIN(cond, bar) do { unsigned _sp = 0; while (cond) { __builtin_amdgcn_s_sleep(1); \
    if ((++_sp & 255u) == 0u) { if (xb_ld(&(bar)[XB_TMO])) break; if (_sp > XB_SPIN_CAP) { atomicAdd(&(bar)[XB_TMO], 1u); break; } } } } while (0)
struct XcdBarrier { unsigned* bar; unsigned x; volatile LAS unsigned* st; };
__device__ __forceinline__ XcdBarrier xcd_barrier_post(unsigned* bar, volatile LAS unsigned* st) {
    XcdBarrier b; b.bar = bar; b.x = xb_xcc_id(); b.st = st;
    if (threadIdx.x == 0) (void)xb_add(&bar[XB_XCNT(b.x)], 1u);
    return b;
}
__device__ __forceinline__ void xcd_barrier_complete(unsigned* bar, unsigned x, unsigned& nloc, unsigned& nx) {
    const unsigned G = gridDim.x * gridDim.y * gridDim.z;
    unsigned sum, cnt, mine, sp = 0u;
    for (;;) {
        sum = 0u; cnt = 0u; mine = 0u;
#pragma unroll
        for (unsigned j = 0; j < 16; ++j) { const unsigned c = xb_ld(&bar[XB_XCNT(j)]); sum += c; cnt += (c > 0u) ? 1u : 0u; mine = (j == x) ? c : mine; }
        if (sum == G) break;
        __builtin_amdgcn_s_sleep(1);
        if ((++sp & 255u) == 0u) { if (xb_ld(&bar[XB_TMO])) break; if (sp > XB_SPIN_CAP) { atomicAdd(&bar[XB_TMO], 1u); break; } }
    }
    nloc = mine > 0u ? mine : 1u; nx = cnt > 0u ? cnt : 1u;
}
__device__ __forceinline__ void xcd_barrier(const XcdBarrier& b) {
    asm volatile("s_waitcnt vmcnt(0)" ::: "memory");
    __syncthreads();
    if (threadIdx.x == 0) {
        unsigned* bar = b.bar;
        __builtin_amdgcn_s_waitcnt(0);
        unsigned nloc = b.st[0], nx = b.st[1];
        if (nloc == 0u) { xcd_barrier_complete(bar, b.x, nloc, nx); b.st[0] = nloc; b.st[1] = nx; }
        const unsigned old = xb_add(&bar[XB_XSUB(b.x)], 1u);
        const unsigned gen = old / nloc;
        if (old + 1u == (gen + 1u) * nloc) {
            __builtin_amdgcn_fence(__ATOMIC_RELEASE, "agent");
            asm volatile("s_waitcnt vmcnt(0)" ::: "memory");
            const unsigned og = xb_add(&bar[XB_TOP], 1u);
            const unsigned tg = og / nx;
            if (og + 1u == (tg + 1u) * nx) xb_add(&bar[XB_TOPGEN], 1u);
            else XB_SPIN(xb_ld(&bar[XB_TOPGEN]) == tg, bar);
            __builtin_amdgcn_fence(__ATOMIC_ACQUIRE, "agent");
            xb_add(&bar[XB_XGEN(b.x)], 1u);
            asm volatile("s_waitcnt vmcnt(0)" ::: "memory");
        } else {
            XB_SPIN(xb_ld(&bar[XB_XGEN(b.x)]) == gen, bar);
            __builtin_amdgcn_fence(__ATOMIC_ACQUIRE, "agent");
            asm volatile("s_waitcnt vmcnt(0)" ::: "memory");
        }
    }
    __syncthreads();
}

constexpr int NWAVES = 8;
constexpr int RING_BYTES = 131072, LDS_BYTES = 147456, LDSCTL_OFF = LDS_BYTES - 512;
struct Args {
    const float* in[19]; float* out; unsigned char* ws; int ph_lo, ph_hi;
};
struct Ctx {
    LAS unsigned char* lds; int tid, lane, wave, gw, ngw, G, bid;
};

template <int MAP> __device__ __forceinline__ int wmap(int n, float& sc) {
    sc = 1.f;
    if (MAP == 0) return n;
    if (MAP == 1) {
        if (n < 1088) return n;
        if (n < 4160) return 1280 + (n - 1088);
        if (n < 5184) return 4352 + (n - 4160);
        if (n < 5248) return 1088 + (n - 5184);
        if (n < 5264) { sc = 0.03125f; return 1152 + (n - 5248); }
        if (n < 8336) return 5376 + (n - 5264);
        return 8448 + (n - 8336);
    }
    if (n < DFF) return (n >> 7) * 256 + (n & 127);
    const int m = n - DFF; return (m >> 7) * 256 + 128 + (m & 127);
}
template <int MAP> __device__ __forceinline__ void conv_item(const float* W, int K, int N, bf16_t* WT, const float* gain, LAS float* scr, int item, int lane) {
    const int nblk = (N + 31) / 32, kb = item / nblk, nb = item - kb * nblk, k0 = 64 * kb, n0 = 32 * nb;
    const int nn = n0 + (lane & 31);
#pragma unroll 8
    for (int i = 0; i < 32; ++i) { const int kk = 2 * i + (lane >> 5); float v = 0.f; if (nn < N) { v = W[(size_t)(k0 + kk) * N + nn]; if (gain) v *= gain[k0 + kk]; } scr[kk * 33 + (lane & 31)] = v; }
    LDS_WAIT(); asm volatile("" ::: "memory");
    const int c = lane & 7;
#pragma unroll
    for (int j = 0; j < 4; ++j) { const int n = (lane >> 3) + 8 * j; const int ns = n0 + n;
        if (ns < N) { float sc; const int dst = wmap<MAP>(ns, sc); const LAS float* s = scr + (8 * c) * 33 + n;
            u32x4 o; o.x = pk2(s[0 * 33] * sc, s[1 * 33] * sc); o.y = pk2(s[2 * 33] * sc, s[3 * 33] * sc); o.z = pk2(s[4 * 33] * sc, s[5 * 33] * sc); o.w = pk2(s[6 * 33] * sc, s[7 * 33] * sc);
            *(u32x4*)(WT + (size_t)dst * K + k0 + 8 * c) = o; } }
    LDS_WAIT(); asm volatile("" ::: "memory");
}
template <int MAP> __device__ __forceinline__ void conv_matrix(const Ctx& F, const float* W, int K, int N, bf16_t* WT, const float* gain) {
    LAS float* scr = (LAS float*)(F.lds + F.wave * 16384);
    const int nit = (K / 64) * ((N + 31) / 32);
    for (int it = F.gw; it < nit; it += F.ngw) conv_item<MAP>(W, K, N, WT, gain, scr, it, F.lane);
}

__device__ __forceinline__ void norm_row(const float* hrow, bf16_t* orow, int lane) {
    f32x4 v[8]; float s = 0.f; float zf = 0.f; asm volatile("" : "+v"(zf));
    if (hrow) {
#pragma unroll
        for (int j = 0; j < 8; ++j) { v[j] = *((const f32x4*)hrow + lane + 64 * j); s += (v[j].x * v[j].x + v[j].y * v[j].y) + (v[j].z * v[j].z + v[j].w * v[j].w); }
    } else {
#pragma unroll
        for (int j = 0; j < 8; ++j) v[j] = (f32x4){zf, zf, zf, zf};
    }
    const float rstd = 1.0f / sqrtf(wave_sum(s) * (1.f / DM) + EPS);
#pragma unroll
    for (int j = 0; j < 8; ++j) { u32x2 o; o.x = pk2(v[j].x * rstd, v[j].y * rstd); o.y = pk2(v[j].z * rstd, v[j].w * rstd); *((u32x2*)orow + lane + 64 * j) = o; }
}

__device__ __forceinline__ void post1a_row(const bf16_t* P, int r, float* rstdq, float* rstdkv, int lane) {
    const bf16_t* p = P + (size_t)r * PW;
    const u32x4 a = *((const u32x4*)(p + C_CQ) + lane), b = *((const u32x4*)(p + C_CKV) + lane);
    float sa = 0.f, sb = 0.f;
#pragma unroll
    for (int e = 0; e < 4; ++e) { const float x0 = __uint_as_float(a[e] << 16), x1 = __uint_as_float(a[e] & 0xffff0000u); sa += x0 * x0 + x1 * x1;
        const float y0 = __uint_as_float(b[e] << 16), y1 = __uint_as_float(b[e] & 0xffff0000u); sb += y0 * y0 + y1 * y1; }
    sa = wave_sum(sa); sb = wave_sum(sb);
    if (lane == 0) { rstdq[r] = 1.0f / sqrtf(sa * (1.f / 512.f) + EPS); rstdkv[r] = 1.0f / sqrtf(sb * (1.f / 512.f) + EPS); }
}
__device__ __forceinline__ void unpack8(const u32x4& w, float (&x)[8]) {
#pragma unroll
    for (int e = 0; e < 4; ++e) { x[2 * e] = __uint_as_float(w[e] << 16); x[2 * e + 1] = __uint_as_float(w[e] & 0xffff0000u); }
}
__device__ __forceinline__ u32x4 pack8(const float (&x)[8]) { u32x4 w; w.x = cvt_pk_bf16(x[0], x[1]); w.y = cvt_pk_bf16(x[2], x[3]); w.z = cvt_pk_bf16(x[4], x[5]); w.w = cvt_pk_bf16(x[6], x[7]); return w; }
__device__ __forceinline__ u32x4 shfl_xor4(const u32x4& w, int m) { u32x4 r; r.x = __shfl_xor(w.x, m); r.y = __shfl_xor(w.y, m); r.z = __shfl_xor(w.z, m); r.w = __shfl_xor(w.w, m); return r; }
template <int HD, bool NORM>
__device__ __forceinline__ void rope_pass(bf16_t* p, const float* gain, float scale, const float (&cs)[8], const float (&sn)[8], int lane, bool active) {
    constexpr int LPH = HD / 8, HALF = LPH / 2;
    const int lh = lane & (LPH - 1);
    u32x4* ptr = (u32x4*)(p + (active ? lane : 0) * 8);
    const u32x4 raw = *ptr;
    float x[8]; unpack8(raw, x);
    float px[8]; { const u32x4 praw = shfl_xor4(raw, HALF); unpack8(praw, px); }
    if (NORM) {
        float ss = 0.f;
#pragma unroll
        for (int j = 0; j < 8; ++j) ss += x[j] * x[j];
#pragma unroll
        for (int o = 1; o < LPH; o <<= 1) ss += __shfl_xor(ss, o);
        const float rn = 1.0f / sqrtf(ss * (1.f / HD) + EPS);
        const f32x4 g0 = *(const f32x4*)(gain + lh * 8), g1 = *(const f32x4*)(gain + lh * 8 + 4);
        const f32x4 h0 = *(const f32x4*)(gain + (lh ^ HALF) * 8), h1 = *(const f32x4*)(gain + (lh ^ HALF) * 8 + 4);
#pragma unroll
        for (int j = 0; j < 4; ++j) { x[j] *= rn * g0[j]; x[4 + j] *= rn * g1[j]; px[j] *= rn * h0[j]; px[4 + j] *= rn * h1[j]; }
    }
    const bool first = lh < HALF;
    float o[8];
#pragma unroll
    for (int j = 0; j < 8; ++j) o[j] = (first ? (x[j] * cs[j] - px[j] * sn[j]) : (x[j] * cs[j] + px[j] * sn[j])) * scale;
    if (active) *ptr = pack8(o);
}
__device__ __forceinline__ void post1b_row(bf16_t* P, int r, const float* dsag  , const float* diffg  , int lane) {
    bf16_t* p = P + (size_t)r * PW;
    const int pos = row_pos(r);
    float c128[8], s128[8], c64[8], s64[8];
#pragma unroll
    for (int j = 0; j < 8; ++j) { rope_cs(pos, 8 * (lane & 7) + j, 2.f / 128.f, c128[j], s128[j]); rope_cs(pos, 8 * (lane & 3) + j, 2.f / 64.f, c64[j], s64[j]); }
#pragma unroll
    for (int k = 0; k < 2; ++k) {
        rope_pass<128, true>(p + C_DQ + 512 * k, dsag, C2_128, c128, s128, lane, true);
        rope_pass<128, true>(p + C_DK + 512 * k, dsag + 128, 1.f, c128, s128, lane, true);
        rope_pass<128, true>(p + C_FQ + 512 * k, diffg, C2_128, c128, s128, lane, true);
        rope_pass<128, true>(p + C_FK + 512 * k, diffg + 128, 1.f, c128, s128, lane, true);
        rope_pass<64, false>(p + C_IQ + 512 * k, nullptr, 1.f, c64, s64, lane, true);
    }
    rope_pass<64, false>(p + C_IK, nullptr, 1.f, c64, s64, lane, lane < 8);
}
__device__ __forceinline__ void post2_row(bf16_t* P, int r, const float* rstdq, const float* rstdkv, const float* qkg  , LAS float* rnl, int lane) {
    bf16_t* p = P + (size_t)r * PW;
    const float sq = rstdq[r], skv = rstdkv[r];
    const int pos = row_pos(r), hw = lane >> 5, l5 = lane & 31;
    float c64[8], s64[8];
#pragma unroll
    for (int j = 0; j < 8; ++j) rope_cs(pos, 8 * (lane & 3) + j, 2.f / 64.f, c64[j], s64[j]);
    float kp[8]; { const u32x4 w = *(const u32x4*)(p + C_KPE + (lane & 7) * 8); unpack8(w, kp); }
    float kpe_ss = 0.f;
#pragma unroll
    for (int j = 0; j < 8; ++j) kpe_ss += kp[j] * kp[j];
    kpe_ss += __shfl_xor(kpe_ss, 1); kpe_ss += __shfl_xor(kpe_ss, 2); kpe_ss += __shfl_xor(kpe_ss, 4);
#pragma unroll 1
    for (int it = 0; it < 4; ++it) {
        const int h = 2 * it + hw; const bool act = l5 < 24;
        u32x4* ptr = (u32x4*)(p + C_QRAW + h * 192 + (act ? l5 : 0) * 8);
        float x[8]; { const u32x4 w = *ptr; unpack8(w, x); }
        float ss = 0.f;
#pragma unroll
        for (int j = 0; j < 8; ++j) { x[j] *= sq; ss += x[j] * x[j]; }
        if (!act) ss = 0.f;
#pragma unroll
        for (int o = 1; o < 32; o <<= 1) ss += __shfl_xor(ss, o);
        const float rn = 1.0f / sqrtf(ss * (1.f / 192.f) + EPS);
        const int gi = (act ? l5 : 0) * 8;
        const f32x4 g0 = *(const f32x4*)(qkg + gi), g1 = *(const f32x4*)(qkg + gi + 4);
#pragma unroll
        for (int j = 0; j < 4; ++j) { x[j] *= rn * g0[j]; x[4 + j] *= rn * g1[j]; }
        float o[8];
#pragma unroll
        for (int j = 0; j < 8; ++j) { const float pr = __shfl_xor(x[j], 4); const float rot = (l5 & 4) ? (x[j] * c64[j] + pr * s64[j]) : (x[j] * c64[j] - pr * s64[j]); o[j] = (l5 >= 16 ? rot : x[j]) * C2_192; }
        if (act) *ptr = pack8(o);
    }
#pragma unroll 1
    for (int it = 0; it < 4; ++it) {
        const int h = 2 * it + hw; const bool isk = l5 < 16;
        u32x4* ptr = (u32x4*)(p + C_KVRAW + h * 256 + l5 * 8);
        float x[8]; { const u32x4 w = *ptr; unpack8(w, x); }
        float ss = 0.f;
#pragma unroll
        for (int j = 0; j < 8; ++j) { x[j] *= skv; ss += x[j] * x[j]; }
        if (!isk) ss = 0.f;
#pragma unroll
        for (int o = 1; o < 32; o <<= 1) ss += __shfl_xor(ss, o);
        const float rn = 1.0f / sqrtf((ss + kpe_ss) * (1.f / 192.f) + EPS);
        if (l5 == 0) rnl[h] = rn;
        const int gi = 192 + (isk ? l5 : 0) * 8;
        const f32x4 g0 = *(const f32x4*)(qkg + gi), g1 = *(const f32x4*)(qkg + gi + 4);
        float o[8];
#pragma unroll
        for (int j = 0; j < 4; ++j) { o[j] = isk ? x[j] * rn * g0[j] : x[j]; o[4 + j] = isk ? x[4 + j] * rn * g1[j] : x[4 + j]; }
        *ptr = pack8(o);
    }
    LDS_WAIT(); asm volatile("" ::: "memory");
    { const int hd = lane >> 3, c = lane & 7; const float rn = rnl[hd];
      const f32x4 g0 = *(const f32x4*)(qkg + 192 + 128 + c * 8), g1 = *(const f32x4*)(qkg + 192 + 128 + c * 8 + 4);
      float x[8], o[8];
#pragma unroll
      for (int j = 0; j < 4; ++j) { x[j] = kp[j] * rn * g0[j]; x[4 + j] = kp[4 + j] * rn * g1[j]; }
#pragma unroll
      for (int j = 0; j < 8; ++j) { const float pr = __shfl_xor(x[j], 4); o[j] = (c & 4) ? (x[j] * c64[j] + pr * s64[j]) : (x[j] * c64[j] - pr * s64[j]); }
      *(u32x4*)(p + C_KPEH + hd * 64 + c * 8) = pack8(o); }
    LDS_WAIT(); asm volatile("" ::: "memory");
}
__device__ __forceinline__ void post3_row(bf16_t* P, int r, const float* subg, float lam, float omli, int lane) {
    bf16_t* p = P + (size_t)r * PW;
    const int hw = lane >> 5, l5 = lane & 31;
#pragma unroll
    for (int h = 0; h < 4; ++h) {
        const u32x4 raw = *(const u32x4*)(p + (hw ? C_IQ : C_FQ) + h * 256 + l5 * 8);
        const u32x4 praw = shfl_xor4(raw, 16);
        float a[8], b[8]; unpack8(raw, a); unpack8(praw, b);
        float d[8], ss = 0.f;
#pragma unroll
        for (int j = 0; j < 8; ++j) { d[j] = a[j] - lam * b[j]; ss += d[j] * d[j]; }
        if (l5 >= 16) ss = 0.f;
#pragma unroll
        for (int o = 1; o < 64; o <<= 1) ss += __shfl_xor(ss, o);
        const float rn = omli / sqrtf(ss * (1.f / 256.f) + EPS);
        const int dim = hw * 128 + (l5 & 15) * 8;
        const f32x4 g0 = *(const f32x4*)(subg + dim), g1 = *(const f32x4*)(subg + dim + 4);
        float o[8];
#pragma unroll
        for (int j = 0; j < 4; ++j) { o[j] = d[j] * rn * g0[j]; o[4 + j] = d[4 + j] * rn * g1[j]; }
        if (l5 < 16) *(u32x4*)(p + C_OC + h * 256 + dim) = pack8(o);
    }
}

__device__ __forceinline__ int key_row(int kidx, int tokbase) { return kidx < 64 ? (MBLK - 64) + kidx : tokbase + (kidx - 64); }

__device__ __forceinline__ void index_row(const bf16_t* P, int tok, unsigned* bm, LAS float* iqs  , LAS unsigned* keys  , int lane) {
    const int b = tok >> 11, t = tok & (SEQ - 1), r = MBLK + tok, qk = 64 + t, nvalid = t + 17, tokbase = MBLK + b * SEQ;
    const int nch = qk / 64 + 1;
    unsigned* out = bm + (size_t)tok * BMW;
    if (nvalid <= 256) {
        for (int c = 0; c < 33; ++c) { const int kidx = 64 * c + lane; const unsigned long long m = __ballot(kidx >= 48 && kidx <= qk);
            if (lane == 0) { out[2 * c] = (unsigned)m; out[2 * c + 1] = (unsigned)(m >> 32); } }
        return;
    }
    const bf16_t* p = P + (size_t)r * PW;
#pragma unroll
    for (int j = 0; j < 16; ++j) iqs[j * 64 + lane] = bf2f(p[C_IQ + j * 64 + lane]);
    if (lane < 16) iqs[1024 + lane] = bf2f(p[C_IW + lane]);
    LDS_WAIT(); asm volatile("" ::: "memory");
    for (int c = 0; c < nch; ++c) {
        const int kidx = 64 * c + lane; const bool valid = kidx >= 48 && kidx <= qk;
        const int kr = key_row(valid ? kidx : 48, tokbase);
        const u32x4* kp = (const u32x4*)(P + (size_t)kr * PW + C_IK);
        u32x4 kw[8];
#pragma unroll
        for (int j = 0; j < 8; ++j) kw[j] = kp[j];
        float score = 0.f;
#pragma unroll 1
        for (int h = 0; h < 16; ++h) {
            const LAS f32x4* qv = (const LAS f32x4*)(iqs + h * 64); float d = 0.f;
#pragma unroll
            for (int j = 0; j < 8; ++j) { const u32x4 w = kw[j]; const f32x4 qa = qv[2 * j], qb = qv[2 * j + 1];
                d += qa.x * __uint_as_float(w.x << 16) + qa.y * __uint_as_float(w.x & 0xffff0000u) + qa.z * __uint_as_float(w.y << 16) + qa.w * __uint_as_float(w.y & 0xffff0000u)
                   + qb.x * __uint_as_float(w.z << 16) + qb.y * __uint_as_float(w.z & 0xffff0000u) + qb.z * __uint_as_float(w.w << 16) + qb.w * __uint_as_float(w.w & 0xffff0000u); }
            score += fmaxf(d, 0.f) * iqs[1024 + h];
        }
        const unsigned u = __float_as_uint(score);
        keys[c * 64 + lane] = valid ? ((u & 0x80000000u) ? ~u : (u | 0x80000000u)) : 0u;
    }
    LDS_WAIT(); asm volatile("" ::: "memory");
    unsigned T = 0u;
    for (int bit = 31; bit >= 0; --bit) {
        const unsigned cand = T | (1u << bit); int cnt = 0;
        for (int c = 0; c < nch; ++c) cnt += __popcll(__ballot(keys[c * 64 + lane] >= cand));
        if (cnt >= 256) T = cand;
        if (cnt == 256) break;
    }
    for (int c = 0; c < 33; ++c) { unsigned long long m = 0ull; if (c < nch) m = __ballot(keys[c * 64 + lane] >= T);
        if (lane == 0) { out[2 * c] = (unsigned)m; out[2 * c + 1] = (unsigned)(m >> 32); } }
    LDS_WAIT(); asm volatile("" ::: "memory");
}

__device__ __forceinline__ void index_unit(const bf16_t* P, int unit, unsigned* bm, LAS unsigned char* lds) {
    typedef float f32x16 __attribute__((ext_vector_type(16)));
    int tid = threadIdx.x; asm volatile("" : "+v"(tid));
    const int wid = __builtin_amdgcn_readfirstlane(tid >> 6), lane = tid & 63, j = lane & 31, hi = lane >> 5;
    const int tb = 255 - (unit >> 4), b = unit & 15, t0 = tb * 8, tokbase = MBLK + b * SEQ;
    const int wmax = (64 + t0 + 7) >> 5;
    LAS unsigned* keys = (LAS unsigned*)lds;
    LAS float* iwl = (LAS float*)(lds + 8 * 2112 * 4);
    if (t0 + 7 + 17 > 256) {
        if (tid < 128) iwl[tid] = bf2f(P[(size_t)(tokbase + t0 + (tid >> 4)) * PW + C_IW + (tid & 15)]);
        bf16x8 af[4][4];
        { const int qa = (j >> 2) & 1, ha = (j & 3) + 4 * (j >> 3);
#pragma unroll
          for (int blk = 0; blk < 4; ++blk) { const bf16_t* ap = P + (size_t)(tokbase + t0 + 2 * blk + qa) * PW + C_IQ + ha * 64 + hi * 8;
#pragma unroll
              for (int s = 0; s < 4; ++s) af[blk][s] = *(const bf16x8*)(ap + s * 16); } }
        LDS_WAIT(); __syncthreads();
        const unsigned boff = (unsigned)(j * PW + C_IK + hi * 8) * 2u;
        for (int w = wid; w <= wmax; w += 8) {
            const int kr_ = w < 2 ? (MBLK - 64) + 32 * w : tokbase + 32 * (w - 2); const char* bp_ = (const char*)(P + (size_t)kr_ * PW) + boff;
            bf16x8 bf[4];
#pragma unroll
            for (int s = 0; s < 4; ++s) bf[s] = *(const bf16x8*)(bp_ + s * 32);
            const int kidx = 32 * w + j;
#pragma unroll
            for (int blk = 0; blk < 4; ++blk) {
                f32x16 acc = (f32x16){0.f,0.f,0.f,0.f,0.f,0.f,0.f,0.f,0.f,0.f,0.f,0.f,0.f,0.f,0.f,0.f};
#pragma unroll
                for (int s = 0; s < 4; ++s) acc = __builtin_amdgcn_mfma_f32_32x32x16_bf16(af[blk][s], bf[s], acc, 0, 0, 0);
                const int q = 2 * blk + hi;
                const LAS f32x4* iwq = (const LAS f32x4*)(iwl + q * 16);
                float score = 0.f;
#pragma unroll
                for (int g = 0; g < 4; ++g) { const f32x4 wv = iwq[g]; score += fmaxf(acc[4 * g], 0.f) * wv.x + fmaxf(acc[4 * g + 1], 0.f) * wv.y + fmaxf(acc[4 * g + 2], 0.f) * wv.z + fmaxf(acc[4 * g + 3], 0.f) * wv.w; }
                const bool valid = kidx >= 48 && kidx <= 64 + t0 + q; const unsigned u_ = __float_as_uint(score);
                keys[q * 2112 + kidx] = valid ? ((u_ & 0x80000000u) ? ~u_ : (u_ | 0x80000000u)) : 0u;
            }
        }
        LDS_WAIT(); __syncthreads();
    }
    const int tq = t0 + wid, qk = 64 + tq, nch = qk / 64 + 1;
    unsigned* out = bm + (size_t)(b * SEQ + tq) * BMW;
    if (tq + 17 <= 256) {
        for (int c = 0; c < 33; ++c) { const int kidx = 64 * c + lane; const unsigned long long m = __ballot(kidx >= 48 && kidx <= qk);
            if (lane == 0) { out[2 * c] = (unsigned)m; out[2 * c + 1] = (unsigned)(m >> 32); } }
    } else {
        unsigned kreg[33];
#pragma unroll
        for (int c = 0; c < 33; ++c) kreg[c] = (c < nch && 64 * c + lane <= qk) ? keys[wid * 2112 + 64 * c + lane] : 0u;
        unsigned T = 0u;
        for (int bit = 31; bit >= 0; --bit) {
            const unsigned cand = T | (1u << bit); int cnt = 0;
#pragma unroll
            for (int c = 0; c < 33; ++c) cnt += __popcll(__ballot(kreg[c] >= cand));
            if (cnt >= 256) T = cand;
            if (cnt == 256) break;
        }
#pragma unroll
        for (int c = 0; c < 33; ++c) { const unsigned long long m = __ballot(kreg[c] >= T && kreg[c] != 0u);
            if (lane == 0) { out[2 * c] = (unsigned)m; out[2 * c + 1] = (unsigned)(m >> 32); } }
    }
    LDS_WAIT();
}

template <int DQK, int DV, bool MASKED>
__device__ __forceinline__ void attn_row(bf16_t* P, int r, int qcol, int k1col, int k2col, int vcol, int ocol0, int ocol1, const unsigned* bm, LAS float* qs, int lane) {
    int qk, tokbase;
    if (r < MBLK) { qk = r - (MBLK - 64); tokbase = MBLK; } else { const int tok = r - MBLK; qk = 64 + (tok & (SEQ - 1)); tokbase = MBLK + (tok >> 11) * SEQ; }
    const bf16_t* qp = P + (size_t)r * PW + qcol;
#pragma unroll
    for (int d = 0; d < DQK; d += 64) qs[d + lane] = bf2f(qp[d + lane]);
    LDS_WAIT(); asm volatile("" ::: "memory");
    const bool use_bm = MASKED && r >= MBLK;
    const unsigned* bmr = bm + (size_t)(r >= MBLK ? r - MBLK : 0) * BMW;
    float m = -1e30f, l = 0.f, o[DV / 64];
#pragma unroll
    for (int k = 0; k < DV / 64; ++k) o[k] = 0.f;
    const int nch = qk / 64 + 1;
    for (int c = 0; c < nch; ++c) {
        const int kidx = 64 * c + lane; bool valid = kidx >= 48 && kidx <= qk;
        if (use_bm) valid = (bmr[kidx >> 5] >> (kidx & 31)) & 1u;
        const int kr = key_row((kidx >= 48 && kidx <= qk) ? kidx : 48, tokbase);
        float s = 0.f;
        { const u32x4* kp = (const u32x4*)(P + (size_t)kr * PW + k1col);
#pragma unroll
          for (int j = 0; j < 16; ++j) { const u32x4 w = kp[j]; const LAS f32x4* qv = (const LAS f32x4*)(qs + j * 8); const f32x4 qa = qv[0], qb = qv[1];
              s += qa.x * __uint_as_float(w.x << 16) + qa.y * __uint_as_float(w.x & 0xffff0000u) + qa.z * __uint_as_float(w.y << 16) + qa.w * __uint_as_float(w.y & 0xffff0000u)
                 + qb.x * __uint_as_float(w.z << 16) + qb.y * __uint_as_float(w.z & 0xffff0000u) + qb.z * __uint_as_float(w.w << 16) + qb.w * __uint_as_float(w.w & 0xffff0000u); } }
        if (DQK == 192) { const u32x4* kp = (const u32x4*)(P + (size_t)kr * PW + k2col);
#pragma unroll
          for (int j = 0; j < 8; ++j) { const u32x4 w = kp[j]; const LAS f32x4* qv = (const LAS f32x4*)(qs + 128 + j * 8); const f32x4 qa = qv[0], qb = qv[1];
              s += qa.x * __uint_as_float(w.x << 16) + qa.y * __uint_as_float(w.x & 0xffff0000u) + qa.z * __uint_as_float(w.y << 16) + qa.w * __uint_as_float(w.y & 0xffff0000u)
                 + qb.x * __uint_as_float(w.z << 16) + qb.y * __uint_as_float(w.z & 0xffff0000u) + qb.z * __uint_as_float(w.w << 16) + qb.w * __uint_as_float(w.w & 0xffff0000u); } }
        if (!valid) s = -__builtin_inff();
        const float mn = fmaxf(m, wave_max(s));
        const float alpha = __builtin_amdgcn_exp2f(m - mn), pj = __builtin_amdgcn_exp2f(s - mn);
        l = l * alpha + wave_sum(pj); m = mn;
#pragma unroll
        for (int k = 0; k < DV / 64; ++k) o[k] *= alpha;
        for (int j = 0; j < 64; ++j) {
            const float pw = __uint_as_float((unsigned)__builtin_amdgcn_readlane((int)__float_as_uint(pj), j));
            if (pw != 0.f) { const int rj = __builtin_amdgcn_readlane(kr, j); const bf16_t* vp = P + (size_t)rj * PW + vcol;
#pragma unroll
                for (int k = 0; k < DV / 64; ++k) o[k] += pw * bf2f(vp[k * 64 + lane]); }
        }
    }
    const float rl = l > 0.f ? 1.0f / l : 0.f;
    bf16_t* op = P + (size_t)r * PW;
#pragma unroll
    for (int k = 0; k < DV / 64; ++k) { const int d = k * 64 + lane; op[(d < 128 ? ocol0 + d : ocol1 + d - 128)] = (bf16_t)f2bf(o[k] * rl); }
    LDS_WAIT(); asm volatile("" ::: "memory");
}
namespace fa {
typedef float f32x16 __attribute__((ext_vector_type(16)));
typedef short s16x4 __attribute__((ext_vector_type(4)));
__device__ __forceinline__ int crow(int r, int hi) { return (r & 3) + 8 * (r >> 2) + 4 * hi; }
__device__ __forceinline__ int v_st(int k, int c) { const int kk = (k & ~0xC) | ((k & 4) << 1) | ((k & 8) >> 1); return ((kk >> 3) * 4 + (c >> 5)) * 512 + ((kk & 7) * 32 + (c & 31)) * 2; }
__device__ __forceinline__ int v_rd_base(int lane) { return ((lane & 3) << 3) | (((lane >> 2) & 3) << 6) | (((lane >> 4) & 1) << 5) | (((lane >> 5) & 1) << 8); }
constexpr int v_rd_off(int d0, int ks, int half) { return d0 * 512 + ks * 4096 + half * 2048; }
constexpr int SHM_V = 16384;
template <int DQK> struct Geo { static constexpr int KP = DQK * 2, SHM_K = 64 * DQK * 2, LDS_K0 = 2 * SHM_V, LDS_WS = LDS_K0 + 2 * SHM_K, BYTES = LDS_WS + 8 * 256; };
#define FA_KSWZ(row, colB, pitch) ((row) * (pitch) + ((colB) ^ (((row) & 7) << 4)))
#define FA_SBAR() __builtin_amdgcn_sched_barrier(0)

struct Item { int qrow0, qk0, nt, tokbase; };

template <int DQK>
__device__ __forceinline__ void load_q(const bf16_t* P, const Item& it, int qcol, bf16x8 (&qr)[DQK / 16]) {
    int tid = threadIdx.x; asm volatile("" : "+v"(tid));
    const int wid = tid >> 6, lane = tid & 63, r32 = lane & 31, hi = lane >> 5;
    const bf16_t* qp = P + (size_t)(it.qrow0 + wid * 32 + r32) * PW + qcol + hi * 8;
#pragma unroll
    for (int d0 = 0; d0 < DQK / 16; ++d0) qr[d0] = *(const bf16x8*)(qp + d0 * 16);
}

template <int DQK, bool MASKED>
__device__ __forceinline__ void attn_core(bf16_t* P, const Item& it, const bf16x8 (&qr)[DQK / 16], int k1col, int k2col, int vcol, int ocol, const unsigned* bmq, LAS unsigned char* lds) {
    typedef Geo<DQK> G;
    int tid = threadIdx.x; asm volatile("" : "+v"(tid));
    const int wid = __builtin_amdgcn_readfirstlane(tid >> 6), lane = tid & 63, r32 = lane & 31, hi = lane >> 5;
    LAS unsigned char* V_lds = lds; LAS unsigned char* K_lds = lds + G::LDS_K0; LAS float* wsf = (LAS float*)(lds + G::LDS_WS) + wid * 64;
    const int sr = tid >> 4, sc = (tid & 15) * 8;
    const int vst0 = v_st(sr, sc), vst1 = v_st(32 + sr, sc), kws0 = FA_KSWZ(sr, sc * 2, G::KP), kws1 = FA_KSWZ(sr + 32, sc * 2, G::KP);
    const int xr = tid >> 3, xc = (tid & 7) * 8, kws2 = FA_KSWZ(xr, (128 + xc) * 2, G::KP);
    const unsigned loff0 = (unsigned)(sr * PW + sc) * 2u, loffx = (unsigned)(xr * PW + xc) * 2u;
    const int vb0 = (int)(unsigned)(size_t)V_lds + v_rd_base(lane);
    const int NT = it.nt;
    const int qk = it.qk0 + wid * 32 + r32;
    const bool use_bm = MASKED && (bmq != nullptr);
    const unsigned bmoff = (unsigned)((wid * 32 + r32) * BMW) * 4u;
    float m_reg = -1e30f, l_reg = 0.f; f32x16 o[4];
#pragma unroll
    for (int d = 0; d < 4; ++d) o[d] = (f32x16){0.f,0.f,0.f,0.f,0.f,0.f,0.f,0.f,0.f,0.f,0.f,0.f,0.f,0.f,0.f,0.f};
    bf16x8 sk0, sk1, sk2, sv0, sv1;
#define FA_KROW0(t) ((t) == 0 ? (MBLK - 64) : it.tokbase + 64 * ((t) - 1))
#define FA_LOAD(t) do { const int kr_ = FA_KROW0(t); const char* rb_ = (const char*)(P + (size_t)kr_ * PW); const char* rk_ = rb_ + (size_t)k1col * 2; const char* rv_ = rb_ + (size_t)vcol * 2; \
        sk0 = *(const bf16x8*)(rk_ + loff0); sk1 = *(const bf16x8*)(rk_ + (size_t)32 * PW * 2 + loff0); sv0 = *(const bf16x8*)(rv_ + loff0); sv1 = *(const bf16x8*)(rv_ + (size_t)32 * PW * 2 + loff0); \
        if (DQK == 192) sk2 = *(const bf16x8*)(rb_ + (size_t)k2col * 2 + loffx); } while (0)
#define FA_WRITE(bf) do { *(LAS bf16x8*)(K_lds + (bf) * G::SHM_K + kws0) = sk0; *(LAS bf16x8*)(K_lds + (bf) * G::SHM_K + kws1) = sk1; \
        *(LAS bf16x8*)(V_lds + (bf) * SHM_V + vst0) = sv0; *(LAS bf16x8*)(V_lds + (bf) * SHM_V + vst1) = sv1; \
        if (DQK == 192) *(LAS bf16x8*)(K_lds + (bf) * G::SHM_K + kws2) = sk2; } while (0)
    constexpr int QREG = (DQK == 192) ? 6 : DQK / 16;
    LAS unsigned char* qx = lds + G::BYTES + (wid * 384 + lane) * 16;
    if (DQK == 192) {
#pragma unroll
        for (int d0 = QREG; d0 < DQK / 16; ++d0) *(LAS bf16x8*)(qx + (d0 - QREG) * 1024) = qr[d0];
    }
    FA_LOAD(0); FA_WRITE(0);
    __syncthreads();
    for (int t = 0; t < NT; ++t) {
        const int cur = t & 1;
        unsigned zb = 0u; asm volatile("" : "+v"(zb)); u32x2 bw = (u32x2){zb, zb};
        if (use_bm) bw = *(const u32x2*)((const char*)(bmq + 2 * t) + bmoff);
        f32x16 p0 = (f32x16){0.f,0.f,0.f,0.f,0.f,0.f,0.f,0.f,0.f,0.f,0.f,0.f,0.f,0.f,0.f,0.f}, p1 = p0;
        { LAS unsigned char* kbase = K_lds + cur * G::SHM_K;
          LAS unsigned char* kb[4];
#pragma unroll
          for (int dd = 0; dd < 4; ++dd) kb[dd] = kbase + FA_KSWZ(r32, (dd * 16 + hi * 8) * 2, G::KP);
          constexpr int GS = (DQK == 192) ? 2 : 4;
#pragma unroll
          for (int g = 0; g < DQK / (16 * GS); ++g) {
              bf16x8 fb0[GS], fb1[GS];
#pragma unroll
              for (int dd = 0; dd < GS; ++dd) { const int d0 = g * GS + dd; LAS unsigned char* a = kb[d0 & 3] + (d0 >> 2) * 128; fb0[dd] = *(const LAS bf16x8*)a; fb1[dd] = *(const LAS bf16x8*)(a + 32 * G::KP); }
              FA_SBAR();
#pragma unroll
              for (int dd = 0; dd < GS; ++dd) { const int d0 = g * GS + dd; bf16x8 qf; if (d0 < QREG) qf = qr[d0 < QREG ? d0 : 0]; else qf = *(const LAS bf16x8*)(qx + (d0 - QREG) * 1024);
                  p0 = __builtin_amdgcn_mfma_f32_32x32x16_bf16(fb0[dd], qf, p0, 0, 0, 0); p1 = __builtin_amdgcn_mfma_f32_32x32x16_bf16(fb1[dd], qf, p1, 0, 0, 0); }
              FA_SBAR(); } }
        if (t + 1 < NT) FA_LOAD(t + 1);
        FA_SBAR();
        const float NEG = -__builtin_inff();
        if (use_bm) {
            const unsigned wx = bw.x >> (4 * hi), wy = bw.y >> (4 * hi);
#pragma unroll
            for (int r = 0; r < 16; ++r) { const unsigned bit = 1u << ((r & 3) + 8 * (r >> 2)); if (!(wx & bit)) p0[r] = NEG; if (!(wy & bit)) p1[r] = NEG; }
        } else if (t == 0 || 64 * t + 63 > it.qk0 + wid * 32) {
            const int kb_ = 64 * t + 4 * hi;
#pragma unroll
            for (int r = 0; r < 16; ++r) { const int k0 = kb_ + (r & 3) + 8 * (r >> 2), k1 = k0 + 32;
                if (k0 < 48 || k0 > qk) p0[r] = NEG; if (k1 < 48 || k1 > qk) p1[r] = NEG; }
        }
        float pmax = p0[0];
#pragma unroll
        for (int r = 1; r < 16; ++r) pmax = fmaxf(pmax, p0[r]);
#pragma unroll
        for (int r = 0; r < 16; ++r) pmax = fmaxf(pmax, p1[r]);
        { auto rr = __builtin_amdgcn_permlane32_swap(__float_as_uint(pmax), __float_as_uint(pmax), false, false); pmax = fmaxf(__uint_as_float(rr[0]), __uint_as_float(rr[1])); }
        const float mn = fmaxf(m_reg, pmax); const float alpha = __builtin_amdgcn_exp2f(m_reg - mn); m_reg = mn;
        float ps = 0.f;
#pragma unroll
        for (int r = 0; r < 16; ++r) { p0[r] = __builtin_amdgcn_exp2f(p0[r] - mn); p1[r] = __builtin_amdgcn_exp2f(p1[r] - mn); ps += p0[r] + p1[r]; }
        { auto rr = __builtin_amdgcn_permlane32_swap(__float_as_uint(ps), __float_as_uint(ps), false, false); ps = __uint_as_float(rr[0]) + __uint_as_float(rr[1]); }
        l_reg = l_reg * alpha + ps;
        if (__any(alpha < 1.f)) { if (hi == 0) wsf[r32] = alpha; LDS_WAIT();
#pragma unroll
            for (int d_ = 0; d_ < 4; ++d_)
#pragma unroll
                for (int r = 0; r < 16; ++r) o[d_][r] *= wsf[crow(r, hi)];
            LDS_WAIT(); }
        bf16x8 pa0, pa1, pa2, pa3;
#define FA_PK4(Pv, B_, OUT) do { const unsigned a0 = cvt_pk_bf16(Pv[B_ + 0], Pv[B_ + 1]), a1 = cvt_pk_bf16(Pv[B_ + 2], Pv[B_ + 3]), b0 = cvt_pk_bf16(Pv[B_ + 4], Pv[B_ + 5]), b1 = cvt_pk_bf16(Pv[B_ + 6], Pv[B_ + 7]); \
        auto r0 = __builtin_amdgcn_permlane32_swap(a0, b0, false, false); auto r1 = __builtin_amdgcn_permlane32_swap(a1, b1, false, false); \
        u32x4 w_ = {r0[0], r1[0], r0[1], r1[1]}; OUT = __builtin_bit_cast(bf16x8, w_); } while (0)
        FA_PK4(p0, 0, pa0); FA_PK4(p0, 8, pa1); FA_PK4(p1, 0, pa2); FA_PK4(p1, 8, pa3);
#define FA_TRRD(dst, off) asm volatile("ds_read_b64_tr_b16 %0, %1 offset:%2" : "=&v"(dst) : "v"(vb0), "i"(off) : "memory")
#define FA_PV(VB, d0) do { s16x4 l0, l1, l2, l3, h0, h1, h2, h3; constexpr int b_ = (VB) * SHM_V + v_rd_off(d0, 0, 0); \
        FA_TRRD(l0, b_); FA_TRRD(h0, b_ + 2048); FA_TRRD(l1, b_ + 4096); FA_TRRD(h1, b_ + 6144); FA_TRRD(l2, b_ + 8192); FA_TRRD(h2, b_ + 10240); FA_TRRD(l3, b_ + 12288); FA_TRRD(h3, b_ + 14336); \
        asm volatile("s_waitcnt lgkmcnt(0)" ::: "memory"); FA_SBAR(); \
        o[d0] = __builtin_amdgcn_mfma_f32_32x32x16_bf16(pa0, (bf16x8){l0[0], l0[1], l0[2], l0[3], h0[0], h0[1], h0[2], h0[3]}, o[d0], 0, 0, 0); \
        o[d0] = __builtin_amdgcn_mfma_f32_32x32x16_bf16(pa1, (bf16x8){l1[0], l1[1], l1[2], l1[3], h1[0], h1[1], h1[2], h1[3]}, o[d0], 0, 0, 0); \
        o[d0] = __builtin_amdgcn_mfma_f32_32x32x16_bf16(pa2, (bf16x8){l2[0], l2[1], l2[2], l2[3], h2[0], h2[1], h2[2], h2[3]}, o[d0], 0, 0, 0); \
        o[d0] = __builtin_amdgcn_mfma_f32_32x32x16_bf16(pa3, (bf16x8){l3[0], l3[1], l3[2], l3[3], h3[0], h3[1], h3[2], h3[3]}, o[d0], 0, 0, 0); } while (0)
        FA_SBAR();
        if (cur == 0) { FA_PV(0, 0); FA_PV(0, 1); FA_PV(0, 2); FA_PV(0, 3); } else { FA_PV(1, 0); FA_PV(1, 1); FA_PV(1, 2); FA_PV(1, 3); }
        FA_SBAR();
        if (t + 1 < NT) { if (cur == 0) FA_WRITE(1); else FA_WRITE(0); }
        __syncthreads();
    }
    if (hi == 0) wsf[r32] = l_reg; LDS_WAIT();
    float rli[16];
#pragma unroll
    for (int r = 0; r < 16; ++r) { const float lv = wsf[crow(r, hi)]; rli[r] = lv > 0.f ? __builtin_amdgcn_rcpf(lv) : 0.f; }
    { int l2 = lane; asm volatile("" : "+v"(l2));
      const int r32b = l2 & 31, hib = l2 >> 5;
      char* Ow = (char*)(P + (size_t)(it.qrow0 + wid * 32) * PW + ocol) + (unsigned)((4 * hib) * PW + r32b) * 2u;
#pragma unroll
      for (int r = 0; r < 16; ++r) { const unsigned ro = (unsigned)(((r & 3) + 8 * (r >> 2)) * PW) * 2u;
#pragma unroll
        for (int d0 = 0; d0 < 4; ++d0) { const float v = o[d0][r] * rli[r]; const float vn = __shfl_xor(v, 1);
            if ((r32b & 1) == 0) *(unsigned*)(Ow + ro + d0 * 64) = cvt_pk_bf16(v, vn); } } }
    LDS_WAIT();
    __syncthreads();
#undef FA_KROW0
#undef FA_LOAD
#undef FA_WRITE
#undef FA_PK4
#undef FA_TRRD
#undef FA_PV
}
__device__ __forceinline__ int next_item(unsigned* ctr, LAS int* slot) {
    __syncthreads();
    if (threadIdx.x == 0) *slot = (int)__hip_atomic_fetch_add(ctr, 1u, __ATOMIC_RELAXED, __HIP_MEMORY_SCOPE_AGENT);
    __syncthreads();
    return *slot;
}
__device__ __forceinline__ Item make_item(bool meta, int b, int qb) {
    Item it;
    if (meta) { it.qrow0 = 0; it.qk0 = -(MBLK - 64); it.nt = 1; it.tokbase = MBLK; }
    else { it.qrow0 = MBLK + b * SEQ + qb * 256; it.qk0 = 64 + qb * 256; it.nt = 4 * (qb + 1) + 1; it.tokbase = MBLK + b * SEQ; }
    return it;
}
}

__device__ __forceinline__ int deal_row(int pass, int gw, int ngw) { const int j = (pass & 1) ? (ngw - 1 - gw) : gw; return pass * ngw + j; }

constexpr int PH_PER_LAYER = 20, N_PHASES = 2 * PH_PER_LAYER;
__device__ __forceinline__ unsigned char* uni_ptr(unsigned char* p) { const unsigned long long v = (unsigned long long)p; const unsigned lo = __builtin_amdgcn_readfirstlane((unsigned)v), hi = __builtin_amdgcn_readfirstlane((unsigned)(v >> 32)); return (unsigned char*)(((unsigned long long)hi << 32) | lo); }
__device__ __forceinline__ const float* arg_in(const Args& a, int k) { asm volatile("" : "+s"(k)); return a.in[k]; }
__global__ void __launch_bounds__(NWAVES * 64, 2) mega_fwd(Args args) {
    extern __shared__ __attribute__((aligned(16))) unsigned char lds_raw[];
    {
        LAS unsigned char* l0 = (LAS unsigned char*)lds_raw;
        for (int u = threadIdx.x; u < (LDS_BYTES - LDSCTL_OFF) / 4; u += NWAVES * 64) ((LAS unsigned*)(l0 + LDSCTL_OFF))[u] = 0u;
        __syncthreads();
    }
#if MK_ONE_LAUNCH
    (void)xcd_barrier_post((unsigned*)(args.ws + WS_CTL) + CW_BAR, (volatile LAS unsigned*)((LAS unsigned char*)lds_raw + LDSCTL_OFF + 64));
#define GRID_BAR() do { XcdBarrier bar_; bar_.bar = (unsigned*)(uni_ptr(args.ws) + WS_CTL) + CW_BAR; bar_.x = xb_xcc_id(); bar_.st = (volatile LAS unsigned*)((LAS unsigned char*)lds_raw + LDSCTL_OFF + 64); xcd_barrier(bar_); } while (0)
#else
#define GRID_BAR() do {} while (0)
#endif
    const int lo = args.ph_lo, hi = args.ph_hi;
#define IN(k) (lo <= (k) && (k) < hi)
#define SEAM(k) do { if (IN((k) + 1)) GRID_BAR(); } while (0)
#define PH_BEGIN \
    int tid_ = threadIdx.x; asm volatile("" : "+v"(tid_)); \
    Ctx F; F.lds = (LAS unsigned char*)lds_raw; F.tid = tid_; F.lane = tid_ & 63; F.wave = __builtin_amdgcn_readfirstlane(tid_ >> 6); \
    F.G = gridDim.x; F.bid = blockIdx.x; F.gw = F.bid * NWAVES + F.wave; F.ngw = F.G * NWAVES; \
    unsigned char* ws = uni_ptr(args.ws); asm volatile("" : "+s"(ws)); \
    int ly = __builtin_amdgcn_readfirstlane(layer); asm volatile("" : "+s"(ly)); (void)ly; (void)F
#define XN_ ((bf16_t*)(ws + WS_XN))
#define P_ ((bf16_t*)(ws + WS_P))
#define HMETA_ ((float*)(ws + WS_HMETA))
#define RSTDQ_ ((float*)(ws + WS_RSTD))
#define RSTDKV_ ((float*)(ws + WS_RSTD) + R)
#define BM_ ((unsigned*)(ws + WS_BM))
#define WB_(off) ((bf16_t*)(ws + WS_WB + (off)))
#define OUT_ (args.out)
#define LAMBDA_INIT(ly) ((ly) == 0 ? 0.2f : (0.8f - 0.6f * 0.7408182206817179f))
#define HSRC_TOK(ly) ((ly) == 0 ? arg_in(args, 0) : (const float*)args.out)

#pragma unroll
    for (int layer = 0; layer < 2; ++layer) {
        const int pb = layer * PH_PER_LAYER;
        if (((PHMASK >> 0) & 1) && IN(pb + 0)) {
            PH_BEGIN;
            for (int rep_ = 0; rep_ < NREP(0); ++rep_) { if (rep_) GRID_BAR();
            const float* meta = arg_in(args, 1);
            conv_matrix<1>(F, arg_in(args, 3) + (size_t)ly * DM * D_IN, DM, D_IN, WB_(WB_IN), arg_in(args, 2) + ly * DM);
            conv_matrix<0>(F, arg_in(args, 7) + (size_t)ly * 512 * 1536, 512, 1536, WB_(WB_QUP), arg_in(args, 5) + ly * 512);
            conv_matrix<0>(F, arg_in(args, 8) + (size_t)ly * 512 * 2048, 512, 2048, WB_(WB_KVUP), arg_in(args, 6) + ly * 512);
            for (int b = 0; b < 3; ++b) conv_matrix<0>(F, arg_in(args, 14) + ((size_t)ly * 3 + b) * 1024 * DM, 1024, DM, WB_(WB_BR) + (size_t)b * DM * 1024, nullptr);
            conv_matrix<0>(F, arg_in(args, 15) + (size_t)ly * DM * DM, DM, DM, WB_(WB_O), nullptr);
            conv_matrix<2>(F, arg_in(args, 17) + (size_t)ly * DM * 2 * DFF, DM, 2 * DFF, WB_(WB_F1), arg_in(args, 16) + ly * DM);
            conv_matrix<0>(F, arg_in(args, 18) + (size_t)ly * DFF * DM, DFF, DM, WB_(WB_F2), nullptr);
            unsigned zu = 0u; asm volatile("" : "+v"(zu)); const float zf = __uint_as_float(zu);
            for (int i = F.gw * 64 + F.lane; i < 112 * 2048 / 8; i += F.ngw * 64) *((u32x4*)(WB_(WB_IN) + (size_t)1168 * 2048) + i) = (u32x4){zu, zu, zu, zu};
            float* hmeta = HMETA_;
            if (ly == 0) {
                for (int i = F.gw * 64 + F.lane; i < MROW0 * PW / 8; i += F.ngw * 64) *((u32x4*)P_ + i) = (u32x4){zu, zu, zu, zu};
                for (int i = F.gw * 64 + F.lane; i < MBLK * DM / 4; i += F.ngw * 64) { const int rr = i / (DM / 4); f32x4 v = (f32x4){zf, zf, zf, zf};
                    if (rr >= MBLK - NMETA) v = *((const f32x4*)meta + (i - (MBLK - NMETA) * (DM / 4))); *((f32x4*)hmeta + i) = v; }
            }
            const float* hsrc_tok = HSRC_TOK(ly);
            bf16_t* XN = XN_;
            for (int r = MROW0 + F.gw; r < R; r += F.ngw) {
                const float* src;
                if (r < MBLK) src = (ly == 0) ? (r >= MBLK - NMETA ? meta + (size_t)(r - (MBLK - NMETA)) * DM : nullptr) : hmeta + (size_t)r * DM;
                else src = hsrc_tok + (size_t)(r - MBLK) * DM;
                norm_row(src, XN + (size_t)r * DM, F.lane);
            }
            }
            SEAM(pb + 0);
        }
        if (((PHMASK >> 1) & 1) && IN(pb + 1)) {
            PH_BEGIN;
            { SkP f{P_, 0}; skinny_gemm(F.lds, XN_ + (size_t)MROW0 * DM, DM, WB_(WB_IN), DM, 1280 / 16, F.bid, F.G, f); }
            SchedPlain S{XN_, DM, WB_(WB_IN), DM, NPMM, 5, F.G, F.bid, 0}; EpiP E{P_};
            pg8::gemm_phase(F.lds, S, E);
            SEAM(pb + 1);
        }
        if (((PHMASK >> 2) & 1) && IN(pb + 2)) {
            PH_BEGIN;
            { bf16_t* P = P_; float* rq = RSTDQ_; float* rkv = RSTDKV_;
              for (int r = MROW0 + F.gw; r < R; r += F.ngw) post1a_row(P, r, rq, rkv, F.lane); }
            VM_WAIT(); __syncthreads();
            { SkP f{P_, C_QRAW}; skinny_gemm(F.lds, P_ + (size_t)MROW0 * PW + C_CQ, PW, WB_(WB_QUP), 512, 1536 / 16, F.bid, F.G, f); }
            { SkP f{P_, C_KVRAW}; skinny_gemm(F.lds, P_ + (size_t)MROW0 * PW + C_CKV, PW, WB_(WB_KVUP), 512, 2048 / 16, F.bid, F.G, f); }
            SchedMlaUp S{P_, WB_(WB_QUP), WB_(WB_KVUP), F.G, F.bid}; EpiP E{P_};
            pg8::gemm_phase(F.lds, S, E);
            SEAM(pb + 2);
        }
        if (((PHMASK >> 3) & 1) && IN(pb + 3)) {
            PH_BEGIN;
            const float* mla_qkg = arg_in(args, 9) + ly * 2 * 192;
            bf16_t* P = P_; float* rq = RSTDQ_; float* rkv = RSTDKV_;
            LAS float* rnl = (LAS float*)(F.lds + F.wave * 64);
            for (int r = MROW0 + F.gw; r < R; r += F.ngw) post2_row(P, r, rq, rkv, mla_qkg, rnl, F.lane);
            SEAM(pb + 3);
        }
        if (((PHMASK >> 4) & 1) && IN(pb + 4)) {
            PH_BEGIN;
            bf16_t* P = P_;
            LAS int* slot = (LAS int*)(F.lds + LDSCTL_OFF + 128);
            for (int rep_ = 0; rep_ < NREP(4); ++rep_) { if (rep_) GRID_BAR();
            unsigned* ctr = (unsigned*)(ws + WS_CTL) + CW_Q + 64 * (ly * 4 + 0) + 64 * 16 * rep_;
            for (;;) {
                const int idx = fa::next_item(ctr, slot); if (idx >= 8 * 129) break;
                int h; fa::Item it;
                if (idx < 1024) { const int qb = 7 - (idx >> 7), rest = idx & 127; h = rest & 7; it = fa::make_item(false, rest >> 3, qb); } else { h = idx - 1024; it = fa::make_item(true, 0, 0); }
                bf16x8 qr[12]; fa::load_q<192>(P, it, C_QRAW + h * 192, qr);
                fa::attn_core<192, false>(P, it, qr, C_KVRAW + h * 256, C_KPEH + h * 64, C_KVRAW + h * 256 + 128, C_OA + h * 128, nullptr, F.lds);
            } }
            SEAM(pb + 4);
        }
        if (((PHMASK >> 5) & 1) && IN(pb + 5)) {
            PH_BEGIN;
            { SkP f{P_, 1280}; skinny_gemm(F.lds, XN_ + (size_t)MROW0 * DM, DM, WB_(WB_IN) + (size_t)1280 * DM, DM, 7168 / 16, F.bid, F.G, f); }
            SchedPlain S{XN_, DM, WB_(WB_IN) + (size_t)1280 * DM, DM, NPMM, 28, F.G, F.bid, 1280}; EpiP E{P_};
            pg8::gemm_phase(F.lds, S, E);
            if (NREP(5) == 2) { GRID_BAR(); pg8::gemm_phase(F.lds, S, E); }
            SEAM(pb + 5);
        }
        if (((PHMASK >> 6) & 1) && IN(pb + 6)) {
            PH_BEGIN;
            const float* dsa_qkg = arg_in(args, 10) + ly * 2 * 128; const float* diff_qkg = arg_in(args, 11) + ly * 2 * 128;
            bf16_t* P = P_;
            for (int r = MROW0 + F.gw; r < R; r += F.ngw) post1b_row(P, r, dsa_qkg, diff_qkg, F.lane);
            SEAM(pb + 6);
        }
        if (((PHMASK >> 7) & 1) && IN(pb + 7)) {
            PH_BEGIN;
            bf16_t* P = P_; unsigned* bm = BM_;
            unsigned* ctr = (unsigned*)(ws + WS_CTL) + CW_Q + 64 * (ly * 4 + 2);
            LAS int* slot = (LAS int*)(F.lds + LDSCTL_OFF + 128);
            for (int rep_ = 0; rep_ < NREP(7); ++rep_) { if (rep_) GRID_BAR(); unsigned* c2 = ctr + 64 * 16 * rep_;
            for (;;) { const int idx = fa::next_item(c2, slot); if (idx >= NTOK / 8) break; index_unit(P, idx, bm, F.lds); } }
            SEAM(pb + 7);
        }
        if (((PHMASK >> 8) & 1) && IN(pb + 8)) {
            PH_BEGIN;
            bf16_t* P = P_; unsigned* bm = BM_;
            unsigned* ctr = (unsigned*)(ws + WS_CTL) + CW_Q + 64 * (ly * 4 + 1);
            LAS int* slot = (LAS int*)(F.lds + LDSCTL_OFF + 128);
            for (;;) {
                const int idx = fa::next_item(ctr, slot); if (idx >= 16 * 129) break;
                int hh; bool meta = false; fa::Item it; int b = 0, qb = 0;
                if (idx < 2048) { qb = 7 - (idx >> 8); const int rest = idx & 255; hh = (rest < 128) ? 8 + (rest & 7) : (rest & 7); b = (rest & 127) >> 3; it = fa::make_item(false, b, qb); }
                else { hh = idx - 2048; hh = hh < 8 ? 8 + hh : hh - 8; meta = true; it = fa::make_item(true, 0, 0); }
                if (hh < 8) {
                    bf16x8 qr[8]; fa::load_q<128>(P, it, C_DQ + hh * 128, qr);
                    fa::attn_core<128, true>(P, it, qr, C_DK + hh * 128, 0, C_DV + hh * 128, C_OB + hh * 128, meta ? nullptr : bm + (size_t)(b * SEQ + qb * 256) * BMW, F.lds);
                } else {
                    const int hj = hh - 8;
                    bf16x8 qr[8]; fa::load_q<128>(P, it, C_FQ + hj * 128, qr);
                    fa::attn_core<128, false>(P, it, qr, C_FK + hj * 128, 0, C_FV + (hj >> 1) * 256, C_FQ + hj * 128, nullptr, F.lds);
                    fa::attn_core<128, false>(P, it, qr, C_FK + hj * 128, 0, C_FV + (hj >> 1) * 256 + 128, C_IQ + hj * 128, nullptr, F.lds);
                }
            }
            SEAM(pb + 8);
        }
        if (((PHMASK >> 9) & 1) && IN(pb + 9)) {
            PH_BEGIN;
            const float* diff_lam = arg_in(args, 12) + ly * 4 * 128; const float* diff_subg = arg_in(args, 13) + ly * 256;
            const float lambda_init = LAMBDA_INIT(ly);
            const float s1 = wave_sum(diff_lam[F.lane] * diff_lam[128 + F.lane] + diff_lam[64 + F.lane] * diff_lam[192 + F.lane]);
            const float s2 = wave_sum(diff_lam[256 + F.lane] * diff_lam[384 + F.lane] + diff_lam[320 + F.lane] * diff_lam[448 + F.lane]);
            const float lam = __expf(s1) - __expf(s2) + lambda_init;
            bf16_t* P = P_;
            for (int r = MROW0 + F.gw; r < R; r += F.ngw) post3_row(P, r, diff_subg, lam, 1.f - lambda_init, F.lane);
            SEAM(pb + 9);
        }
#define GATE_PHASE(k, b) \
        if (((PHMASK >> 10) & 1) && IN(pb + (k))) { \
            PH_BEGIN; \
            { SkGate f{(bf16_t*)(ws + WS_GS), arg_in(args, 4) + ly * 3 * DM + (b) * DM}; skinny_gemm(F.lds, XN_ + (size_t)MROW0 * DM, DM, WB_(WB_G) + (size_t)(b) * 2048 * DM, DM, 2048 / 16, F.bid, F.G, f); } \
            SchedPlain S{XN_, DM, WB_(WB_G) + (size_t)(b) * 2048 * DM, DM, NPMM, 8, F.G, F.bid, 0}; EpiGate E{(bf16_t*)(ws + WS_GS), arg_in(args, 4) + ly * 3 * DM + (b) * DM}; \
            pg8::gemm_phase(F.lds, S, E); \
            SEAM(pb + (k)); \
        }
#define BRANCH_PHASE(k, b, oc) \
        if (((PHMASK >> 10) & 1) && IN(pb + (k))) { \
            PH_BEGIN; \
            { SkGated f{P_, (const bf16_t*)(ws + WS_GS), (b) == 0 ? 1 : 0}; skinny_gemm(F.lds, P_ + (size_t)MROW0 * PW + (oc), PW, WB_(WB_BR) + (size_t)(b) * DM * 1024, 1024, 2048 / 16, F.bid, F.G, f); } \
            SchedPlain S{P_ + (oc), PW, WB_(WB_BR) + (size_t)(b) * DM * 1024, 1024, NPMM, 8, F.G, F.bid, C_MERGED}; EpiGated E{P_, (const bf16_t*)(ws + WS_GS), (b) == 0 ? 1 : 0, ((DBG_BM >> (b)) & 1) ? 1.f : 0.f}; \
            pg8::gemm_phase(F.lds, S, E); \
            SEAM(pb + (k)); \
        }
        GATE_PHASE(10, 0) BRANCH_PHASE(11, 0, C_OA)
        GATE_PHASE(12, 1) BRANCH_PHASE(13, 1, C_OB)
        GATE_PHASE(14, 2) BRANCH_PHASE(15, 2, C_OC)
        if (((PHMASK >> 11) & 1) && IN(pb + 16)) {
            PH_BEGIN;
            { SkRes f{HMETA_}; skinny_gemm(F.lds, P_ + (size_t)MROW0 * PW + C_MERGED, PW, WB_(WB_O), DM, 2048 / 16, F.bid, F.G, f); }
            SchedPlain S{P_ + C_MERGED, PW, WB_(WB_O), DM, NPMM, 8, F.G, F.bid, 0}; EpiRes E{HSRC_TOK(ly), OUT_, HMETA_, DBG_SA};
            pg8::gemm_phase(F.lds, S, E);
            SEAM(pb + 16);
        }
        if (((PHMASK >> 12) & 1) && IN(pb + 17)) {
            PH_BEGIN;
            float* hmeta = HMETA_; float* out = OUT_; bf16_t* XN = XN_;
            for (int r = MROW0 + F.gw; r < R; r += F.ngw) norm_row(r < MBLK ? hmeta + (size_t)r * DM : out + (size_t)(r - MBLK) * DM, XN + (size_t)r * DM, F.lane);
            SEAM(pb + 17);
        }
        if (((PHMASK >> 13) & 1) && IN(pb + 18)) {
            PH_BEGIN;
            skinny_swiglu(F.lds, XN_ + (size_t)MROW0 * DM, DM, WB_(WB_F1), DM, P_, F.bid, F.G);
            SchedPlain S{XN_, DM, WB_(WB_F1), DM, NPMM, 44, F.G, F.bid, 0}; EpiSwiglu E{P_};
            pg8::gemm_phase(F.lds, S, E);
            SEAM(pb + 18);
        }
        if (((PHMASK >> 14) & 1) && IN(pb + 19)) {
            PH_BEGIN;
            { SkRes f{HMETA_}; skinny_gemm(F.lds, P_ + (size_t)MROW0 * PW, PW, WB_(WB_F2), DFF, 2048 / 16, F.bid, F.G, f); }
            SchedPlain S{P_, PW, WB_(WB_F2), DFF, NPMM, 8, F.G, F.bid, 0}; EpiRes E{OUT_, OUT_, HMETA_, DBG_SF};
            pg8::gemm_phase(F.lds, S, E);
            SEAM(pb + 19);
        }
    }
#undef IN
#undef SEAM
}

__global__ void diag_fill(float* out, int n, float v) { for (int i = blockIdx.x * blockDim.x + threadIdx.x; i < n; i += gridDim.x * blockDim.x) out[i] = v; }
extern "C" void kernel_launch(void* const* d_in, const int* in_sizes, int n_in, void* d_out, int out_size, void* d_ws, size_t ws_size, hipStream_t stream) {
    static int grid = 0; static float code = 0.f;
    if (grid == 0) {
        int dev = 0, cus = 0;
        if (n_in != 19) { code = 10.f; grid = -1; }
        else if (ws_size < WS_END) { code = 20.f + (float)(ws_size >> 20) * 0.01f; grid = -1; }
        else if (hipGetDevice(&dev) != hipSuccess || hipDeviceGetAttribute(&cus, hipDeviceAttributeMultiprocessorCount, dev) != hipSuccess) { code = 40.f; grid = -1; }
        else if (hipFuncSetAttribute((const void*)mega_fwd, hipFuncAttributeMaxDynamicSharedMemorySize, LDS_BYTES) != hipSuccess) { code = 50.f; grid = -1; }
        else {
            int per_cu = 0;
            if (hipOccupancyMaxActiveBlocksPerMultiprocessor(&per_cu, (const void*)mega_fwd, NWAVES * 64, LDS_BYTES) != hipSuccess || per_cu < 1) { code = 60.f; grid = -1; }
            (void)hipGetLastError();
            if (grid == 0) grid = cus;
        }
    }
    if (grid < 0) { hipLaunchKernelGGL(diag_fill, dim3(1024), dim3(256), 0, stream, (float*)d_out, out_size, code); return; }
    (void)hipMemsetAsync((char*)d_ws + WS_CTL, 0, CTL_BYTES, stream);
    Args a{};
    for (int i = 0; i < 19; ++i) a.in[i] = (const float*)d_in[i];
    a.out = (float*)d_out; a.ws = (unsigned char*)d_ws;
#if MK_ONE_LAUNCH
    a.ph_lo = 0; a.ph_hi = N_PHASES;
    hipLaunchKernelGGL(mega_fwd, dim3(grid), dim3(NWAVES * 64), LDS_BYTES, stream, a);
#else
    for (int p = 0; p < N_PHASES; ++p) { a.ph_lo = p; a.ph_hi = p + 1; hipLaunchKernelGGL(mega_fwd, dim3(grid), dim3(NWAVES * 64), LDS_BYTES, stream, a); }
#endif
    if (hipPeekAtLastError() != hipSuccess) { (void)hipGetLastError(); hipLaunchKernelGGL(diag_fill, dim3(1024), dim3(256), 0, stream, (float*)d_out, out_size, 70.f); }
}
```

```cpp
#include <hip/hip_runtime.h>
#include <cstdio>
#include <cstdint>

#ifndef PHMASK
#define PHMASK 0x7fff
#endif
#ifndef REPMASK
#define REPMASK 0
#endif
#define NREP(k) ((((REPMASK) >> (k)) & 1) ? 2 : 1)
#ifndef DBG_BM
#define DBG_BM 7
#endif
#ifndef DBG_BR
#define DBG_BR 0
#endif
#ifndef DBG_SA
#define DBG_SA 1.0f
#endif
#ifndef DBG_SF
#define DBG_SF 1.0f
#endif
#ifndef MK_ONE_LAUNCH
#define MK_ONE_LAUNCH 1
#endif

#define LAS __attribute__((address_space(3)))
#define GAS __attribute__((address_space(1)))
typedef unsigned short bf16_t;
typedef short bf16x8 __attribute__((ext_vector_type(8)));
typedef float f32x4 __attribute__((ext_vector_type(4)));
typedef float f32x2 __attribute__((ext_vector_type(2)));
typedef unsigned u32x4 __attribute__((ext_vector_type(4)));
typedef unsigned u32x2 __attribute__((ext_vector_type(2)));

constexpr int DM = 2048, NB = 16, SEQ = 2048, NMETA = 16, MBLK = 256;
constexpr int R = MBLK + NB * SEQ;
constexpr int NPM = R / 256;
constexpr int NPMM = NPM - 1;
constexpr int MROW0 = MBLK - NMETA;
constexpr int NTOK = NB * SEQ;
constexpr int DFF = 5632;
constexpr int PW = 8448;
constexpr int C_CQ = 0, C_CKV = 512, C_KPE = 1024, C_IK = 1088, C_IW = 1152, C_DQ = 1280, C_DK = 2304, C_DV = 3328, C_IQ = 4352,
              C_FQ = 5376, C_FK = 6400, C_FV = 7424;
constexpr int C_KVRAW = 1280, C_QRAW = 3328, C_KPEH = 4864;
constexpr int C_OA = 0, C_OB = C_DQ, C_OC = C_FQ, C_MERGED = 2304;
constexpr int BMW = 66;
constexpr float EPS = 1e-6f;
constexpr float LOG2E = 1.4426950408889634f;
constexpr float C2_128 = 0.08838834764831845f * LOG2E;
constexpr float C2_192 = 0.07216878364870323f * LOG2E;
constexpr int D_IN = 14480;

constexpr size_t MiB = 1u << 20;
constexpr size_t WS_CTL = 0, CTL_BYTES = 1 * MiB;
constexpr size_t WS_RSTD = 1 * MiB;
constexpr size_t WS_HMETA = 2 * MiB;
constexpr size_t WS_BM = 4 * MiB;
constexpr size_t WS_WB = 16 * MiB;
constexpr size_t WB_IN = 0, WB_G = WB_IN + (size_t)8448 * 2048 * 2, WB_QUP = WB_G + (size_t)6144 * 2048 * 2, WB_KVUP = WB_QUP + (size_t)1536 * 512 * 2,
                 WB_BR = WB_KVUP + (size_t)2048 * 512 * 2, WB_O = WB_BR + (size_t)3 * 2048 * 1024 * 2, WB_F1 = WB_O + (size_t)2048 * 2048 * 2,
                 WB_F2 = WB_F1 + (size_t)11264 * 2048 * 2, WB_END = WB_F2 + (size_t)2048 * 5632 * 2;
constexpr size_t WS_XN = 164 * MiB;
constexpr size_t WS_P = 294 * MiB;
constexpr size_t WS_GS = 828 * MiB;
constexpr size_t WS_END = 960 * MiB;
static_assert(WS_GS + (size_t)R * 2048 * 2 <= WS_END && WS_WB + WB_END <= WS_XN && WS_XN + (size_t)R * 2048 * 2 <= WS_P && WS_P + (size_t)R * PW * 2 <= WS_GS, "ws map");
constexpr int CW_BAR = 4096, CW_Q = 16384;
constexpr size_t WS_RS = 256 * 1024;

__device__ __forceinline__ float bf2f(bf16_t v) { return __uint_as_float((unsigned)v << 16); }
__device__ __forceinline__ unsigned f2bf(float f) { unsigned u = __float_as_uint(f); return (u + 0x7fffu + ((u >> 16) & 1u)) >> 16; }
__device__ __forceinline__ unsigned pk2(float lo, float hi) { return f2bf(lo) | (f2bf(hi) << 16); }
typedef __bf16 bf16x2_t __attribute__((ext_vector_type(2)));
__device__ __forceinline__ unsigned cvt_pk_bf16(float lo, float hi) { f32x2 v = {lo, hi}; bf16x2_t b = __builtin_convertvector(v, bf16x2_t); return __builtin_bit_cast(unsigned, b); }
__device__ __forceinline__ float wave_sum(float v) {
#pragma unroll
    for (int o = 1; o < 64; o <<= 1) v += __shfl_xor(v, o);
    return v;
}
__device__ __forceinline__ float wave_max(float v) {
#pragma unroll
    for (int o = 1; o < 64; o <<= 1) v = fmaxf(v, __shfl_xor(v, o));
    return v;
}
#define LDS_WAIT() asm volatile("s_waitcnt lgkmcnt(0)" ::: "memory")
#define VM_WAIT() asm volatile("s_waitcnt vmcnt(0)" ::: "memory")
__device__ __forceinline__ int row_pos(int r) { return r < MBLK ? (r >= MBLK - NMETA ? r - (MBLK - NMETA) : 0) : NMETA + ((r - MBLK) & (SEQ - 1)); }
__device__ __forceinline__ void rope_cs(int pos, int i, float two_over_d, float& c, float& s) {
    const float inv = __builtin_amdgcn_exp2f(-(float)i * two_over_d * 13.287712379549449f);
    float rev = (float)pos * inv * 0.15915494309189535f;
    rev -= floorf(rev);
    s = __builtin_amdgcn_sinf(rev); c = __builtin_amdgcn_cosf(rev);
}

namespace pg8 {
constexpr int BM = 256, BK = 64, HALF = 128, HTB = HALF * BK * 2, STAGE_BYTES = 8 * HTB;
__device__ __forceinline__ int lds_byte(int r, int c) { const int st = (r >> 4) * 2 + (c >> 5), rr = r & 15, cc = c & 31, ob = rr * 64 + cc * 2; return st * 1024 + (ob ^ (((ob >> 9) & 1) << 5)); }
__device__ __forceinline__ void stage_rc(int b, int& R_, int& C_) { const int st = b / 1024, sb = b % 1024, swz = sb ^ (((sb >> 9) & 1) << 5); R_ = (st >> 1) * 16 + swz / 64; C_ = (st & 1) * 32 + (swz % 64) / 2; }
__device__ __forceinline__ int perm32(int rho) { const int n = rho >> 4, i = rho & 15; return 8 * (i >> 2) + 4 * n + (i & 3); }

struct Unit { const char* A; const char* B; unsigned lda2, ldb2; int nt, pm, pn, kind, ocol; };

__device__ __forceinline__ void tile_of(int L, int nM, int nN, int& pm, int& pn) {
    const int nwg = nM * nN; int wgid = L;
    { const int q = nwg / 8, r = nwg % 8, xcd = wgid % 8, off = wgid / 8; wgid = (xcd < r ? xcd * (q + 1) : r * (q + 1) + (xcd - r) * q) + off; }
    const int nig = 8 * nN, gid = wgid / nig, fm = gid * 8, gsz = (nM - fm) < 8 ? (nM - fm) : 8;
    pm = fm + ((wgid % nig) % gsz); pn = (wgid % nig) / gsz;
}

template <class Epi, class Sched>
__device__ __forceinline__ void gemm_phase(LAS unsigned char* lds, const Sched& S, const Epi& E) {
    int tid = threadIdx.x; asm volatile("" : "+v"(tid));
    const int wid = __builtin_amdgcn_readfirstlane(tid >> 6), lane = tid & 63, wr = wid >> 2, wc = wid & 3, fr = lane & 15, fq = lane >> 4;
    unsigned rA[2], rB[2], cc[2];
#pragma unroll
    for (int i = 0; i < 2; ++i) { int R_, C_; stage_rc(tid * 16 + i * 8192, R_, C_); rA[i] = (unsigned)R_; rB[i] = (unsigned)(Epi::PERM ? ((R_ & ~31) + perm32(R_ & 31)) : R_); cc[i] = (unsigned)C_ * 2u; }
    const size_t kstep = (size_t)(BK * 2);
    const unsigned ldsw = (unsigned)wid * 1024u;
    const int aoff = lds_byte(wr * 64 + fr, fq * 8), boff = lds_byte(wc * 32 + fr, fq * 8);
#define PG8_SA(b, h) (((b) * 2 + (h)) * HTB)
#define PG8_SB(b, h) ((4 + (b) * 2 + (h)) * HTB)
#define PG8_STAGE(bufoff, gbase, rr, ld2) do { _Pragma("unroll") for (int _i = 0; _i < 2; ++_i) \
        __builtin_amdgcn_global_load_lds((const unsigned*)((const char*)(gbase) + ((rr)[_i] * (ld2) + cc[_i])), (LAS unsigned*)(lds + (bufoff) + ldsw + _i * 8192), 16, 0, 0); } while (0)
#define PG8_LDA(dst, b, h) do { _Pragma("unroll") for (int m = 0; m < 4; ++m) _Pragma("unroll") for (int k = 0; k < 2; ++k) dst[m][k] = *(const LAS bf16x8*)(lds + PG8_SA(b, h) + aoff + m * 2048 + k * 1024); } while (0)
#define PG8_LDB(dst, b, h) do { _Pragma("unroll") for (int n = 0; n < 2; ++n) _Pragma("unroll") for (int k = 0; k < 2; ++k) dst[n][k] = *(const LAS bf16x8*)(lds + PG8_SB(b, h) + boff + n * 2048 + k * 1024); } while (0)
#define PG8_MMA(ai, bj, At, Bt) do { __builtin_amdgcn_s_setprio(1); _Pragma("unroll") for (int m = 0; m < 4; ++m) _Pragma("unroll") for (int n = 0; n < 2; ++n) _Pragma("unroll") for (int k = 0; k < 2; ++k) \
        acc[ai][bj][m][n] = __builtin_amdgcn_mfma_f32_16x16x32_bf16(Bt[n][k], At[m][k], acc[ai][bj][m][n], 0, 0, 0); __builtin_amdgcn_s_setprio(0); } while (0)
#define PG8_WAIT_V(n) asm volatile("s_waitcnt vmcnt(" #n ")" ::: "memory")
#define PG8_WAIT_L(n) asm volatile("s_waitcnt lgkmcnt(" #n ")" ::: "memory")
#define PG8_BAR __builtin_amdgcn_s_barrier()
#define PG8_SCHED __builtin_amdgcn_sched_barrier(0)
    Unit cur, nxt; int ui = 0;
    if (!S.next(0, cur)) return;
    float zf = 0.f; asm volatile("" : "+v"(zf));
    f32x4 acc[2][2][4][2];
#pragma unroll
    for (int a = 0; a < 2; ++a)
#pragma unroll
        for (int b = 0; b < 2; ++b)
#pragma unroll
            for (int m = 0; m < 4; ++m)
#pragma unroll
                for (int n = 0; n < 2; ++n) acc[a][b][m][n] = (f32x4){zf, zf, zf, zf};
    bf16x8 At[4][2], B0[2][2], B1[2][2];
    const char* cA = cur.A; const char* cB = cur.B;
    unsigned lA = cur.lda2, lB = cur.ldb2;
    size_t hA = (size_t)HALF * lA, hB = (size_t)HALF * lB;
    PG8_STAGE(PG8_SB(0, 0), cB, rB, lB); PG8_STAGE(PG8_SB(0, 1), cB + hB, rB, lB); PG8_STAGE(PG8_SA(0, 0), cA, rA, lA); PG8_STAGE(PG8_SA(0, 1), cA + hA, rA, lA);
    if (wr == 1) PG8_BAR;
    PG8_WAIT_V(2); PG8_BAR;
    PG8_STAGE(PG8_SB(1, 0), cB + kstep, rB, lB); PG8_STAGE(PG8_SA(1, 0), cA + kstep, rA, lA); PG8_STAGE(PG8_SB(1, 1), cB + hB + kstep, rB, lB);
    PG8_WAIT_V(6); PG8_BAR;
    for (;;) {
        const bool has_next = S.next(ui + 1, nxt);
        if (!has_next) nxt = cur;
        const char* nA = nxt.A; const char* nB = nxt.B;
        const unsigned lAn = nxt.lda2, lBn = nxt.ldb2;
        const size_t hAn = (size_t)HALF * lAn, hBn = (size_t)HALF * lBn;
        const int nt = cur.nt;
        for (int t = 0; t < nt; t += 2) {
            const bool last = (t == nt - 2);
            const char* a1 = cA + (size_t)(t + 1) * kstep;
            const char* a2 = last ? nA : cA + (size_t)(t + 2) * kstep; const char* b2 = last ? nB : cB + (size_t)(t + 2) * kstep;
            const char* a3 = a2 + kstep; const char* b3 = b2 + kstep;
            const size_t hA2 = last ? hAn : hA, hB2 = last ? hBn : hB;
            const unsigned lA2 = last ? lAn : lA, lB2 = last ? lBn : lB;
            PG8_LDB(B0, 0, 0); PG8_LDB(B1, 0, 1); PG8_SCHED; PG8_LDA(At, 0, 0); PG8_STAGE(PG8_SA(1, 1), a1 + hA, rA, lA);
            PG8_WAIT_V(8); PG8_WAIT_L(0); PG8_BAR; PG8_MMA(0, 0, At, B0); PG8_MMA(0, 1, At, B1); PG8_BAR; PG8_SCHED;
            PG8_LDA(At, 0, 1); PG8_STAGE(PG8_SB(0, 0), b2, rB, lB2); PG8_STAGE(PG8_SB(0, 1), b2 + hB2, rB, lB2); PG8_STAGE(PG8_SA(0, 0), a2, rA, lA2);
            PG8_WAIT_V(8); PG8_WAIT_L(0); PG8_BAR; PG8_MMA(1, 0, At, B0); PG8_MMA(1, 1, At, B1); PG8_BAR; PG8_SCHED;
            PG8_LDB(B0, 1, 0); PG8_LDB(B1, 1, 1); PG8_SCHED; PG8_LDA(At, 1, 0); PG8_STAGE(PG8_SA(0, 1), a2 + hA2, rA, lA2);
            PG8_WAIT_V(8); PG8_WAIT_L(0); PG8_BAR; PG8_MMA(0, 0, At, B0); PG8_MMA(0, 1, At, B1); PG8_BAR; PG8_SCHED;
            PG8_LDA(At, 1, 1); PG8_STAGE(PG8_SB(1, 0), b3, rB, lB2); PG8_STAGE(PG8_SB(1, 1), b3 + hB2, rB, lB2); PG8_STAGE(PG8_SA(1, 0), a3, rA, lA2);
            PG8_WAIT_V(8); PG8_WAIT_L(0); PG8_BAR; PG8_MMA(1, 0, At, B0); PG8_MMA(1, 1, At, B1); PG8_BAR; PG8_SCHED;
        }
        if (wr == 0) PG8_BAR;
        E(acc, cur, wr, wc, fr, fq);
#pragma unroll
        for (int a = 0; a < 2; ++a)
#pragma unroll
            for (int b = 0; b < 2; ++b)
#pragma unroll
                for (int m = 0; m < 4; ++m)
#pragma unroll
                    for (int n = 0; n < 2; ++n) acc[a][b][m][n] = (f32x4){zf, zf, zf, zf};
        if (!has_next) break;
        cur = nxt; cA = nA; cB = nB; hA = hAn; hB = hBn; lA = lAn; lB = lBn; ++ui;
        if (wr == 1) PG8_BAR;
    }
    PG8_WAIT_V(0);
    PG8_BAR;
#undef PG8_SA
#undef PG8_SB
#undef PG8_STAGE
#undef PG8_LDA
#undef PG8_LDB
#undef PG8_MMA
#undef PG8_WAIT_V
#undef PG8_WAIT_L
#undef PG8_BAR
#undef PG8_SCHED
}
}
using pg8::Unit;

struct SchedPlain {
    const bf16_t* A; int lda; const bf16_t* B; int K; int nM, nN, G, c, ocol0;
    __device__ __forceinline__ bool next(int i, Unit& u) const {
        const int L = i * G + c; if (L >= nM * nN) return false;
        int pm, pn; pg8::tile_of(L, nM, nN, pm, pn); pm += 1;
        u.pm = pm; u.pn = pn; u.kind = 0; u.ocol = ocol0 + 256 * pn; u.nt = K / 64; u.lda2 = (unsigned)lda * 2u; u.ldb2 = (unsigned)K * 2u;
        u.A = (const char*)(A + (size_t)pm * 256 * lda); u.B = (const char*)(B + (size_t)pn * 256 * K); return true;
    }
};
struct SchedMlaUp {
    const bf16_t* P; const bf16_t* Wq; const bf16_t* Wkv; int G, c;
    __device__ __forceinline__ bool next(int i, Unit& u) const {
        const int L = i * G + c; if (L >= NPMM * 14) return false;
        int pm, pn; pg8::tile_of(L, NPMM, 14, pm, pn); pm += 1;
        u.pm = pm; u.pn = pn; u.kind = 0; u.nt = 8; u.lda2 = PW * 2u; u.ldb2 = 512 * 2u;
        if (pn < 6) { u.A = (const char*)(P + (size_t)pm * 256 * PW + C_CQ); u.B = (const char*)(Wq + (size_t)pn * 256 * 512); u.ocol = C_QRAW + 256 * pn; }
        else { u.A = (const char*)(P + (size_t)pm * 256 * PW + C_CKV); u.B = (const char*)(Wkv + (size_t)(pn - 6) * 256 * 512); u.ocol = C_KVRAW + 256 * (pn - 6); }
        return true;
    }
};
struct EpiP {
    static constexpr bool PERM = true;
    bf16_t* P; const float* rs;
    __device__ __forceinline__ void operator()(const f32x4 (&acc)[2][2][4][2], const Unit& u, int wr, int wc, int fr, int fq) const {
        asm volatile("" : "+v"(fr), "+v"(fq));
        const int row0 = u.pm * 256 + wr * 64 + fr, col0 = u.ocol + wc * 32 + 8 * fq;
#pragma unroll
        for (int ai = 0; ai < 2; ++ai)
#pragma unroll
            for (int m = 0; m < 4; ++m) { bf16_t* rowp = P + (size_t)(row0 + ai * 128 + m * 16) * PW + col0;
                const float sc = rs ? __builtin_amdgcn_rsqf(rs[row0 + ai * 128 + m * 16] * (1.f / DM) + EPS) : 1.f;
#pragma unroll
                for (int bj = 0; bj < 2; ++bj) { const f32x4 v0 = acc[ai][bj][m][0] * sc, v1 = acc[ai][bj][m][1] * sc;
                    u32x4 w; w.x = cvt_pk_bf16(v0[0], v0[1]); w.y = cvt_pk_bf16(v0[2], v0[3]); w.z = cvt_pk_bf16(v1[0], v1[1]); w.w = cvt_pk_bf16(v1[2], v1[3]);
                    *(u32x4*)(rowp + bj * 128) = w; } }
    }
};
struct EpiGate {
    static constexpr bool PERM = true;
    bf16_t* G; const float* bias; const float* rs;
    __device__ __forceinline__ void operator()(const f32x4 (&acc)[2][2][4][2], const Unit& u, int wr, int wc, int fr, int fq) const {
        asm volatile("" : "+v"(fr), "+v"(fq));
        const int row0 = u.pm * 256 + wr * 64 + fr, col0 = u.pn * 256 + wc * 32 + 8 * fq;
        float rsc[2][4];
#pragma unroll
        for (int ai = 0; ai < 2; ++ai)
#pragma unroll
            for (int m = 0; m < 4; ++m) rsc[ai][m] = __builtin_amdgcn_rsqf(rs[row0 + ai * 128 + m * 16] * (1.f / DM) + EPS);
#pragma unroll
        for (int bj = 0; bj < 2; ++bj) { const f32x4 bv0 = *(const f32x4*)(bias + col0 + bj * 128), bv1 = *(const f32x4*)(bias + col0 + bj * 128 + 4);
#pragma unroll
            for (int ai = 0; ai < 2; ++ai)
#pragma unroll
                for (int m = 0; m < 4; ++m) { bf16_t* rowp = G + (size_t)(row0 + ai * 128 + m * 16) * 2048 + col0; f32x4 v0 = acc[ai][bj][m][0] * rsc[ai][m] + bv0, v1 = acc[ai][bj][m][1] * rsc[ai][m] + bv1;
#pragma unroll
                    for (int e = 0; e < 4; ++e) { v0[e] = __builtin_amdgcn_rcpf(1.f + __builtin_amdgcn_exp2f(-v0[e] * LOG2E)); v1[e] = __builtin_amdgcn_rcpf(1.f + __builtin_amdgcn_exp2f(-v1[e] * LOG2E)); }
                    u32x4 w; w.x = cvt_pk_bf16(v0[0], v0[1]); w.y = cvt_pk_bf16(v0[2], v0[3]); w.z = cvt_pk_bf16(v1[0], v1[1]); w.w = cvt_pk_bf16(v1[2], v1[3]);
                    *(u32x4*)(rowp + bj * 128) = w; } }
    }
};
struct EpiGated {
    static constexpr bool PERM = true;
    bf16_t* P; const bf16_t* G; int first; float sc;
    __device__ __forceinline__ void operator()(const f32x4 (&acc)[2][2][4][2], const Unit& u, int wr, int wc, int fr, int fq) const {
        asm volatile("" : "+v"(fr), "+v"(fq));
        const int row0 = u.pm * 256 + wr * 64 + fr, lcol0 = u.pn * 256 + wc * 32 + 8 * fq, col0 = u.ocol + wc * 32 + 8 * fq;
        unsigned zu = 0u; asm volatile("" : "+v"(zu));
#pragma unroll
        for (int ai = 0; ai < 2; ++ai)
#pragma unroll
            for (int m = 0; m < 4; ++m) { bf16_t* rowp = P + (size_t)(row0 + ai * 128 + m * 16) * PW + col0; const bf16_t* gp = G + (size_t)(row0 + ai * 128 + m * 16) * 2048 + lcol0;
#pragma unroll
                for (int bj = 0; bj < 2; ++bj) { u32x4 g = *(const u32x4*)(gp + bj * 128); if (DBG_BR == 1) g = (u32x4){0x3f803f80u, 0x3f803f80u, 0x3f803f80u, 0x3f803f80u};
                    u32x4 pv = (u32x4){zu, zu, zu, zu}; if (!first) pv = *(const u32x4*)(rowp + bj * 128);
                    const f32x4 v0 = acc[ai][bj][m][0] * sc, v1 = acc[ai][bj][m][1] * sc;
                    float o[8];
                    o[0] = __uint_as_float(pv.x << 16) + __uint_as_float(g.x << 16) * v0[0]; o[1] = __uint_as_float(pv.x & 0xffff0000u) + __uint_as_float(g.x & 0xffff0000u) * v0[1];
                    o[2] = __uint_as_float(pv.y << 16) + __uint_as_float(g.y << 16) * v0[2]; o[3] = __uint_as_float(pv.y & 0xffff0000u) + __uint_as_float(g.y & 0xffff0000u) * v0[3];
                    o[4] = __uint_as_float(pv.z << 16) + __uint_as_float(g.z << 16) * v1[0]; o[5] = __uint_as_float(pv.z & 0xffff0000u) + __uint_as_float(g.z & 0xffff0000u) * v1[1];
                    o[6] = __uint_as_float(pv.w << 16) + __uint_as_float(g.w << 16) * v1[2]; o[7] = __uint_as_float(pv.w & 0xffff0000u) + __uint_as_float(g.w & 0xffff0000u) * v1[3];
                    u32x4 w; w.x = cvt_pk_bf16(o[0], o[1]); w.y = cvt_pk_bf16(o[2], o[3]); w.z = cvt_pk_bf16(o[4], o[5]); w.w = cvt_pk_bf16(o[6], o[7]);
                    *(u32x4*)(rowp + bj * 128) = w; }
                asm volatile("" ::: "memory"); }
    }
};
struct EpiRes {
    static constexpr bool PERM = false;
    const float* base_tok; float* out_tok; float* hmeta; float dbg; bf16_t* hb; float* rs;
    __device__ __forceinline__ void operator()(const f32x4 (&acc)[2][2][4][2], const Unit& u, int wr, int wc, int fr, int fq) const {
        asm volatile("" : "+v"(fr), "+v"(fq));
        const float* bp; float* op;
        if (u.pm == 0) { bp = hmeta; op = hmeta; } else { bp = base_tok + (size_t)(u.pm - 1) * 256 * DM; op = out_tok + (size_t)(u.pm - 1) * 256 * DM; }
        const int lrow0 = wr * 64 + fr, col0 = u.pn * 256 + wc * 32 + 4 * fq;
#pragma unroll
        for (int ai = 0; ai < 2; ++ai)
#pragma unroll
            for (int m = 0; m < 4; ++m) { const size_t off = (size_t)(lrow0 + ai * 128 + m * 16) * DM + col0;
                const int grow = u.pm * 256 + lrow0 + ai * 128 + m * 16; float ss = 0.f;
#pragma unroll
                for (int bj = 0; bj < 2; ++bj)
#pragma unroll
                    for (int n = 0; n < 2; ++n) { const f32x4 bs = *(const f32x4*)(bp + off + bj * 128 + n * 16); const f32x4 hv = bs + acc[ai][bj][m][n] * dbg; *(f32x4*)(op + off + bj * 128 + n * 16) = hv;
                        if (hb) { ss += (hv[0] * hv[0] + hv[1] * hv[1]) + (hv[2] * hv[2] + hv[3] * hv[3]); u32x2 w; w.x = cvt_pk_bf16(hv[0], hv[1]); w.y = cvt_pk_bf16(hv[2], hv[3]); *(u32x2*)(hb + (size_t)grow * DM + col0 + bj * 128 + n * 16) = w; } }
                if (hb) { ss += __shfl_xor(ss, 16); ss += __shfl_xor(ss, 32); if (fq == 0) (void)__hip_atomic_fetch_add(rs + grow, ss, __ATOMIC_RELAXED, __HIP_MEMORY_SCOPE_AGENT); }
                asm volatile("" ::: "memory"); }
    }
};
struct EpiSwiglu {
    static constexpr bool PERM = true;
    bf16_t* P; const float* rs;
    __device__ __forceinline__ void operator()(const f32x4 (&acc)[2][2][4][2], const Unit& u, int wr, int wc, int fr, int fq) const {
        asm volatile("" : "+v"(fr), "+v"(fq));
        const int row0 = u.pm * 256 + wr * 64 + fr, col0 = u.pn * 128 + wc * 32 + 8 * fq;
#pragma unroll
        for (int ai = 0; ai < 2; ++ai)
#pragma unroll
            for (int m = 0; m < 4; ++m) { bf16_t* rowp = P + (size_t)(row0 + ai * 128 + m * 16) * PW + col0;
                const float sc = __builtin_amdgcn_rsqf(rs[row0 + ai * 128 + m * 16] * (1.f / DM) + EPS);
                float o[8];
#pragma unroll
                for (int n = 0; n < 2; ++n)
#pragma unroll
                    for (int e = 0; e < 4; ++e) { const float g = acc[ai][0][m][n][e] * sc, up = acc[ai][1][m][n][e] * sc; o[n * 4 + e] = g * __builtin_amdgcn_rcpf(1.f + __builtin_amdgcn_exp2f(-g * LOG2E)) * up; }
                u32x4 w; w.x = cvt_pk_bf16(o[0], o[1]); w.y = cvt_pk_bf16(o[2], o[3]); w.z = cvt_pk_bf16(o[4], o[5]); w.w = cvt_pk_bf16(o[6], o[7]);
                *(u32x4*)rowp = w; }
    }
};

struct SkP { bf16_t* P; int ocol; const float* rs; __device__ __forceinline__ void operator()(int r, int c, float v) const { if (rs) v *= __builtin_amdgcn_rsqf(rs[MROW0 + r] * (1.f / DM) + EPS); P[(size_t)(MROW0 + r) * PW + ocol + c] = (bf16_t)f2bf(v); } };
struct SkGate { bf16_t* G; const float* bias; const float* rs; __device__ __forceinline__ void operator()(int r, int c, float v) const { v *= __builtin_amdgcn_rsqf(rs[MROW0 + r] * (1.f / DM) + EPS); G[(size_t)(MROW0 + r) * 2048 + c] = (bf16_t)f2bf(__builtin_amdgcn_rcpf(1.f + __builtin_amdgcn_exp2f(-(v + bias[c]) * LOG2E))); } };
struct SkGated { bf16_t* P; const bf16_t* G; int first; __device__ __forceinline__ void operator()(int r, int c, float v) const { bf16_t* p = P + (size_t)(MROW0 + r) * PW + C_MERGED + c; const float pv = first ? 0.f : bf2f(*p); *p = (bf16_t)f2bf(pv + bf2f(G[(size_t)(MROW0 + r) * 2048 + c]) * v); } };
struct SkRes { float* hmeta; bf16_t* hb; float* rs;
    __device__ __forceinline__ void operator()(int r, int c, float v) const { float* p = hmeta + (size_t)(MROW0 + r) * DM + c; const float hv = *p + v; *p = hv;
        if (hb) { hb[(size_t)(MROW0 + r) * DM + c] = (bf16_t)f2bf(hv); float ss = hv * hv; ss += __shfl_xor(ss, 1); ss += __shfl_xor(ss, 2); ss += __shfl_xor(ss, 4); ss += __shfl_xor(ss, 8);
            if ((threadIdx.x & 15) == 0) (void)__hip_atomic_fetch_add(rs + MROW0 + r, ss, __ATOMIC_RELAXED, __HIP_MEMORY_SCOPE_AGENT); } } };
template <class Fn>
__device__ __forceinline__ void skinny_gemm(LAS unsigned char* lds, const bf16_t* A, int lda, const bf16_t* Bt, int K, int ntask, int bid, int G, const Fn& f) {
    int tid = threadIdx.x; asm volatile("" : "+v"(tid));
    const int wid = __builtin_amdgcn_readfirstlane(tid >> 6), lane = tid & 63, l15 = lane & 15, kq = lane >> 4;
    LAS f32x4* red = (LAS f32x4*)lds;
    const int kw = K / 8;
    for (int task = bid; task < ntask; task += G) {
        const bf16_t* ap = A + (size_t)l15 * lda + wid * kw + kq * 8;
        const bf16_t* bp = Bt + (size_t)(task * 16 + l15) * K + wid * kw + kq * 8;
        float z = 0.f; asm volatile("" : "+v"(z));
        f32x4 acc = (f32x4){z, z, z, z};
        for (int k0 = 0; k0 < kw; k0 += 256) {
            bf16x8 fa[8], fb[8];
#pragma unroll
            for (int i = 0; i < 8; ++i) { const int k = (k0 + 32 * i < kw) ? k0 + 32 * i : 0; fa[i] = *(const bf16x8*)(ap + k); fb[i] = *(const bf16x8*)(bp + k); }
#pragma unroll
            for (int i = 0; i < 8; ++i) if (k0 + 32 * i < kw) acc = __builtin_amdgcn_mfma_f32_16x16x32_bf16(fa[i], fb[i], acc, 0, 0, 0);
        }
        red[wid * 64 + lane] = acc;
        LDS_WAIT(); __syncthreads();
        if (wid == 0) {
            f32x4 s = red[lane];
#pragma unroll
            for (int w = 1; w < 8; ++w) s += red[w * 64 + lane];
#pragma unroll
            for (int r = 0; r < 4; ++r) f(kq * 4 + r, task * 16 + l15, s[r]);
        }
        __syncthreads();
    }
}
__device__ __forceinline__ void skinny_swiglu(LAS unsigned char* lds, const bf16_t* A, int lda, const bf16_t* Bt, int K, bf16_t* P, const float* rs, int bid, int G) {
    int tid = threadIdx.x; asm volatile("" : "+v"(tid));
    const int wid = __builtin_amdgcn_readfirstlane(tid >> 6), lane = tid & 63, l15 = lane & 15, kq = lane >> 4;
    LAS f32x4* red = (LAS f32x4*)lds;
    const int kw = K / 8;
    for (int task = bid; task < DFF / 16; task += G) {
        const int c0 = task * 16, brow = (c0 >> 7) * 256 + (c0 & 127) + l15;
        const bf16_t* ap = A + (size_t)l15 * lda + wid * kw + kq * 8;
        const bf16_t* bg = Bt + (size_t)brow * K + wid * kw + kq * 8; const bf16_t* bu = bg + (size_t)128 * K;
        float z = 0.f; asm volatile("" : "+v"(z));
        f32x4 ag = (f32x4){z, z, z, z}, au = ag;
        {
            bf16x8 fa[8], fg[8], fu[8];
#pragma unroll
            for (int i = 0; i < 8; ++i) { fa[i] = *(const bf16x8*)(ap + 32 * i); fg[i] = *(const bf16x8*)(bg + 32 * i); fu[i] = *(const bf16x8*)(bu + 32 * i); }
#pragma unroll
            for (int i = 0; i < 8; ++i) { ag = __builtin_amdgcn_mfma_f32_16x16x32_bf16(fa[i], fg[i], ag, 0, 0, 0); au = __builtin_amdgcn_mfma_f32_16x16x32_bf16(fa[i], fu[i], au, 0, 0, 0); }
        }
        red[wid * 64 + lane] = ag; red[512 + wid * 64 + lane] = au;
        LDS_WAIT(); __syncthreads();
        if (wid == 0) {
            f32x4 sg = red[lane], su = red[512 + lane];
#pragma unroll
            for (int w = 1; w < 8; ++w) { sg += red[w * 64 + lane]; su += red[512 + w * 64 + lane]; }
#pragma unroll
            for (int r = 0; r < 4; ++r) { const float sc = __builtin_amdgcn_rsqf(rs[MROW0 + kq * 4 + r] * (1.f / DM) + EPS); const float g = sg[r] * sc; su[r] *= sc; P[(size_t)(MROW0 + kq * 4 + r) * PW + c0 + l15] = (bf16_t)f2bf(g * __builtin_amdgcn_rcpf(1.f + __builtin_amdgcn_exp2f(-g * LOG2E)) * su[r]); }
        }
        __syncthreads();
    }
}

#define XB_TMO      128
#define XB_XCNT(j)  (256  + 64 * (j))
#define XB_XSUB(j)  (1280 + 64 * (j))
#define XB_XGEN(j)  (2304 + 64 * (j))
#define XB_TOP      3328
#define XB_TOPGEN   3392
#define XCD_BAR_WORDS 3456
#define XB_SPIN_CAP (1u << 18)
__device__ __forceinline__ unsigned xb_ld(unsigned* p)              { return __hip_atomic_load(p, __ATOMIC_RELAXED, __HIP_MEMORY_SCOPE_AGENT); }
__device__ __forceinline__ unsigned xb_add(unsigned* p, unsigned v) { return __hip_atomic_fetch_add(p, v, __ATOMIC_RELAXED, __HIP_MEMORY_SCOPE_AGENT); }
__device__ __forceinline__ unsigned xb_xcc_id() { return (unsigned)__builtin_amdgcn_s_getreg((3 << 11) | 20) & 0xFu; }
#define XB_SPIN(cond, bar) do { unsigned _sp = 0; while (cond) { __builtin_amdgcn_s_sleep(1); \
    if ((++_sp & 255u) == 0u) { if (xb_ld(&(bar)[XB_TMO])) break; if (_sp > XB_SPIN_CAP) { atomicAdd(&(bar)[XB_TMO], 1u); break; } } } } while (0)
struct XcdBarrier { unsigned* bar; unsigned x; volatile LAS unsigned* st; };
__device__ __forceinline__ XcdBarrier xcd_barrier_post(unsigned* bar, volatile LAS unsigned* st) {
    XcdBarrier b; b.bar = bar; b.x = xb_xcc_id(); b.st = st;
    if (threadIdx.x == 0) (void)xb_add(&bar[XB_XCNT(b.x)], 1u);
    return b;
}
__device__ __forceinline__ void xcd_barrier_complete(unsigned* bar, unsigned x, unsigned& nloc, unsigned& nx) {
    const unsigned G = gridDim.x * gridDim.y * gridDim.z;
    unsigned sum, cnt, mine, sp = 0u;
    for (;;) {
        sum = 0u; cnt = 0u; mine = 0u;
#pragma unroll
        for (unsigned j = 0; j < 16; ++j) { const unsigned c = xb_ld(&bar[XB_XCNT(j)]); sum += c; cnt += (c > 0u) ? 1u : 0u; mine = (j == x) ? c : mine; }
        if (sum == G) break;
        __builtin_amdgcn_s_sleep(1);
        if ((++sp & 255u) == 0u) { if (xb_ld(&bar[XB_TMO])) break; if (sp > XB_SPIN_CAP) { atomicAdd(&bar[XB_TMO], 1u); break; } }
    }
    nloc = mine > 0u ? mine : 1u; nx = cnt > 0u ? cnt : 1u;
}
__device__ __forceinline__ void xcd_barrier(const XcdBarrier& b) {
    asm volatile("s_waitcnt vmcnt(0)" ::: "memory");
    __syncthreads();
    if (threadIdx.x == 0) {
        unsigned* bar = b.bar;
        __builtin_amdgcn_s_waitcnt(0);
        unsigned nloc = b.st[0], nx = b.st[1];
        if (nloc == 0u) { xcd_barrier_complete(bar, b.x, nloc, nx); b.st[0] = nloc; b.st[1] = nx; }
        const unsigned old = xb_add(&bar[XB_XSUB(b.x)], 1u);
        const unsigned gen = old / nloc;
        if (old + 1u == (gen + 1u) * nloc) {
            __builtin_amdgcn_fence(__ATOMIC_RELEASE, "agent");
            asm volatile("s_waitcnt vmcnt(0)" ::: "memory");
            const unsigned og = xb_add(&bar[XB_TOP], 1u);
            const unsigned tg = og / nx;
            if (og + 1u == (tg + 1u) * nx) xb_add(&bar[XB_TOPGEN], 1u);
            else XB_SPIN(xb_ld(&bar[XB_TOPGEN]) == tg, bar);
            __builtin_amdgcn_fence(__ATOMIC_ACQUIRE, "agent");
            xb_add(&bar[XB_XGEN(b.x)], 1u);
            asm volatile("s_waitcnt vmcnt(0)" ::: "memory");
        } else {
            XB_SPIN(xb_ld(&bar[XB_XGEN(b.x)]) == gen, bar);
            __builtin_amdgcn_fence(__ATOMIC_ACQUIRE, "agent");
            asm volatile("s_waitcnt vmcnt(0)" ::: "memory");
        }
    }
    __syncthreads();
}

constexpr int NWAVES = 8;
constexpr int RING_BYTES = 131072, LDS_BYTES = 147456, LDSCTL_OFF = LDS_BYTES - 512;
struct Args {
    const float* in[19]; float* out; unsigned char* ws; int ph_lo, ph_hi;
};
struct Ctx {
    LAS unsigned char* lds; int tid, lane, wave, gw, ngw, G, bid;
};

template <int MAP> __device__ __forceinline__ int wmap(int n, float& sc) {
    sc = 1.f;
    if (MAP == 0) return n;
    if (MAP == 1) {
        if (n < 1088) return n;
        if (n < 4160) return 1280 + (n - 1088);
        if (n < 5184) return 4352 + (n - 4160);
        if (n < 5248) return 1088 + (n - 5184);
        if (n < 5264) { sc = 0.03125f; return 1152 + (n - 5248); }
        if (n < 8336) return 5376 + (n - 5264);
        return 8448 + (n - 8336);
    }
    if (n < DFF) return (n >> 7) * 256 + (n & 127);
    const int m = n - DFF; return (m >> 7) * 256 + 128 + (m & 127);
}
template <int MAP> __device__ __forceinline__ void conv_item(const float* W, int K, int N, bf16_t* WT, const float* gain, LAS float* scr, int item, int lane) {
    const int nblk = (N + 31) / 32, kb = item / nblk, nb = item - kb * nblk, k0 = 64 * kb, n0 = 32 * nb;
    const int nn = n0 + (lane & 31);
    float wv[32];
#pragma unroll
    for (int i = 0; i < 32; ++i) { const int kk = 2 * i + (lane >> 5); wv[i] = (nn < N) ? W[(size_t)(k0 + kk) * N + nn] : 0.f; }
#pragma unroll
    for (int i = 0; i < 32; ++i) { const int kk = 2 * i + (lane >> 5); float v = wv[i]; if (gain) v *= gain[k0 + kk]; scr[kk * 33 + (lane & 31)] = v; }
    LDS_WAIT(); asm volatile("" ::: "memory");
    const int c = lane & 7;
#pragma unroll
    for (int j = 0; j < 4; ++j) { const int n = (lane >> 3) + 8 * j; const int ns = n0 + n;
        if (ns < N) { float sc; const int dst = wmap<MAP>(ns, sc); const LAS float* s = scr + (8 * c) * 33 + n;
            u32x4 o; o.x = pk2(s[0 * 33] * sc, s[1 * 33] * sc); o.y = pk2(s[2 * 33] * sc, s[3 * 33] * sc); o.z = pk2(s[4 * 33] * sc, s[5 * 33] * sc); o.w = pk2(s[6 * 33] * sc, s[7 * 33] * sc);
            *(u32x4*)(WT + (size_t)dst * K + k0 + 8 * c) = o; } }
    LDS_WAIT(); asm volatile("" ::: "memory");
}
template <int MAP> __device__ __forceinline__ void conv_matrix(const Ctx& F, const float* W, int K, int N, bf16_t* WT, const float* gain) {
    LAS float* scr = (LAS float*)(F.lds + F.wave * 16384);
    const int nit = (K / 64) * ((N + 31) / 32);
    for (int it = F.gw; it < nit; it += F.ngw) conv_item<MAP>(W, K, N, WT, gain, scr, it, F.lane);
}

__device__ __forceinline__ void norm_row(const float* hrow, bf16_t* orow, float* rs_row, int lane) {
    f32x4 v[8]; float s = 0.f;
#pragma unroll
    for (int j = 0; j < 8; ++j) { v[j] = *((const f32x4*)hrow + lane + 64 * j); s += (v[j].x * v[j].x + v[j].y * v[j].y) + (v[j].z * v[j].z + v[j].w * v[j].w); }
    s = wave_sum(s);
    if (lane == 0) *rs_row = s;
#pragma unroll
    for (int j = 0; j < 8; ++j) { u32x2 o; o.x = cvt_pk_bf16(v[j].x, v[j].y); o.y = cvt_pk_bf16(v[j].z, v[j].w); *((u32x2*)orow + lane + 64 * j) = o; }
}

__device__ __forceinline__ void post1a_row(const bf16_t* P, int r, float* rstdq, float* rstdkv, int lane) {
    const bf16_t* p = P + (size_t)r * PW;
    const u32x4 a = *((const u32x4*)(p + C_CQ) + lane), b = *((const u32x4*)(p + C_CKV) + lane);
    float sa = 0.f, sb = 0.f;
#pragma unroll
    for (int e = 0; e < 4; ++e) { const float x0 = __uint_as_float(a[e] << 16), x1 = __uint_as_float(a[e] & 0xffff0000u); sa += x0 * x0 + x1 * x1;
        const float y0 = __uint_as_float(b[e] << 16), y1 = __uint_as_float(b[e] & 0xffff0000u); sb += y0 * y0 + y1 * y1; }
    sa = wave_sum(sa); sb = wave_sum(sb);
    if (lane == 0) { rstdq[r] = 1.0f / sqrtf(sa * (1.f / 512.f) + EPS); rstdkv[r] = 1.0f / sqrtf(sb * (1.f / 512.f) + EPS); }
}
__device__ __forceinline__ void unpack8(const u32x4& w, float (&x)[8]) {
#pragma unroll
    for (int e = 0; e < 4; ++e) { x[2 * e] = __uint_as_float(w[e] << 16); x[2 * e + 1] = __uint_as_float(w[e] & 0xffff0000u); }
}
__device__ __forceinline__ u32x4 pack8(const float (&x)[8]) { u32x4 w; w.x = cvt_pk_bf16(x[0], x[1]); w.y = cvt_pk_bf16(x[2], x[3]); w.z = cvt_pk_bf16(x[4], x[5]); w.w = cvt_pk_bf16(x[6], x[7]); return w; }
__device__ __forceinline__ u32x4 shfl_xor4(const u32x4& w, int m) { u32x4 r; r.x = __shfl_xor(w.x, m); r.y = __shfl_xor(w.y, m); r.z = __shfl_xor(w.z, m); r.w = __shfl_xor(w.w, m); return r; }
template <int HD, bool NORM>
__device__ __forceinline__ void rope_pass(const u32x4& raw, u32x4* ptr, const float* gain, float scale, const float (&cs)[8], const float (&sn)[8], int lane, bool active) {
    constexpr int LPH = HD / 8, HALF = LPH / 2;
    const int lh = lane & (LPH - 1);
    float x[8]; unpack8(raw, x);
    float px[8]; { const u32x4 praw = shfl_xor4(raw, HALF); unpack8(praw, px); }
    if (NORM) {
        float ss = 0.f;
#pragma unroll
        for (int j = 0; j < 8; ++j) ss += x[j] * x[j];
#pragma unroll
        for (int o = 1; o < LPH; o <<= 1) ss += __shfl_xor(ss, o);
        const float rn = __builtin_amdgcn_rsqf(ss * (1.f / HD) + EPS);
        const f32x4 g0 = *(const f32x4*)(gain + lh * 8), g1 = *(const f32x4*)(gain + lh * 8 + 4);
        const f32x4 h0 = *(const f32x4*)(gain + (lh ^ HALF) * 8), h1 = *(const f32x4*)(gain + (lh ^ HALF) * 8 + 4);
#pragma unroll
        for (int j = 0; j < 4; ++j) { x[j] *= rn * g0[j]; x[4 + j] *= rn * g1[j]; px[j] *= rn * h0[j]; px[4 + j] *= rn * h1[j]; }
    }
    const bool first = lh < HALF;
    float o[8];
#pragma unroll
    for (int j = 0; j < 8; ++j) o[j] = (first ? (x[j] * cs[j] - px[j] * sn[j]) : (x[j] * cs[j] + px[j] * sn[j])) * scale;
    if (active) *ptr = pack8(o);
}
__device__ __forceinline__ void post1b_row(bf16_t* P, int r, const float* dsag  , const float* diffg  , int lane) {
    bf16_t* p = P + (size_t)r * PW;
    u32x4* pdq = (u32x4*)(p + C_DQ) + lane; u32x4* pdk = (u32x4*)(p + C_DK) + lane; u32x4* pfq = (u32x4*)(p + C_FQ) + lane; u32x4* pfk = (u32x4*)(p + C_FK) + lane; u32x4* piq = (u32x4*)(p + C_IQ) + lane;
    u32x4* pik = (u32x4*)(p + C_IK) + (lane < 8 ? lane : 0);
    u32x4 rdq[2], rdk[2], rfq[2], rfk[2], riq[2];
#pragma unroll
    for (int k = 0; k < 2; ++k) { rdq[k] = pdq[64 * k]; rdk[k] = pdk[64 * k]; rfq[k] = pfq[64 * k]; rfk[k] = pfk[64 * k]; riq[k] = piq[64 * k]; }
    const u32x4 rik = *pik;
    const int pos = row_pos(r);
    float c128[8], s128[8], c64[8], s64[8];
#pragma unroll
    for (int j = 0; j < 8; ++j) { rope_cs(pos, 8 * (lane & 7) + j, 2.f / 128.f, c128[j], s128[j]); rope_cs(pos, 8 * (lane & 3) + j, 2.f / 64.f, c64[j], s64[j]); }
#pragma unroll
    for (int k = 0; k < 2; ++k) {
        rope_pass<128, true>(rdq[k], pdq + 64 * k, dsag, C2_128, c128, s128, lane, true);
        rope_pass<128, true>(rdk[k], pdk + 64 * k, dsag + 128, 1.f, c128, s128, lane, true);
        rope_pass<128, true>(rfq[k], pfq + 64 * k, diffg, C2_128, c128, s128, lane, true);
        rope_pass<128, true>(rfk[k], pfk + 64 * k, diffg + 128, 1.f, c128, s128, lane, true);
        rope_pass<64, false>(riq[k], piq + 64 * k, nullptr, 1.f, c64, s64, lane, true);
    }
    rope_pass<64, false>(rik, pik, nullptr, 1.f, c64, s64, lane, lane < 8);
}
__device__ __forceinline__ void post2_row(bf16_t* P, int r, const float* rstdq, const float* rstdkv, const float* qkg  , LAS float* rnl, int lane) {
    bf16_t* p = P + (size_t)r * PW;
    const float sq = rstdq[r], skv = rstdkv[r];
    const int pos = row_pos(r), hw = lane >> 5, l5 = lane & 31;
    float c64[8], s64[8];
#pragma unroll
    for (int j = 0; j < 8; ++j) rope_cs(pos, 8 * (lane & 3) + j, 2.f / 64.f, c64[j], s64[j]);
    float kp[8]; { const u32x4 w = *(const u32x4*)(p + C_KPE + (lane & 7) * 8); unpack8(w, kp); }
    float kpe_ss = 0.f;
#pragma unroll
    for (int j = 0; j < 8; ++j) kpe_ss += kp[j] * kp[j];
    kpe_ss += __shfl_xor(kpe_ss, 1); kpe_ss += __shfl_xor(kpe_ss, 2); kpe_ss += __shfl_xor(kpe_ss, 4);
    u32x4 rq[4], rkv[4];
#pragma unroll
    for (int it = 0; it < 4; ++it) { const int h = 2 * it + hw; rq[it] = *(const u32x4*)(p + C_QRAW + h * 192 + (l5 < 24 ? l5 : 0) * 8); rkv[it] = *(const u32x4*)(p + C_KVRAW + h * 256 + l5 * 8); }
#pragma unroll
    for (int it = 0; it < 4; ++it) {
        const int h = 2 * it + hw; const bool act = l5 < 24;
        u32x4* ptr = (u32x4*)(p + C_QRAW + h * 192 + (act ? l5 : 0) * 8);
        float x[8]; unpack8(rq[it], x);
        float ss = 0.f;
#pragma unroll
        for (int j = 0; j < 8; ++j) { x[j] *= sq; ss += x[j] * x[j]; }
        if (!act) ss = 0.f;
#pragma unroll
        for (int o = 1; o < 32; o <<= 1) ss += __shfl_xor(ss, o);
        const float rn = 1.0f / sqrtf(ss * (1.f / 192.f) + EPS);
        const int gi = (act ? l5 : 0) * 8;
        const f32x4 g0 = *(const f32x4*)(qkg + gi), g1 = *(const f32x4*)(qkg + gi + 4);
#pragma unroll
        for (int j = 0; j < 4; ++j) { x[j] *= rn * g0[j]; x[4 + j] *= rn * g1[j]; }
        float o[8];
#pragma unroll
        for (int j = 0; j < 8; ++j) { const float pr = __shfl_xor(x[j], 4); const float rot = (l5 & 4) ? (x[j] * c64[j] + pr * s64[j]) : (x[j] * c64[j] - pr * s64[j]); o[j] = (l5 >= 16 ? rot : x[j]) * C2_192; }
        if (act) *ptr = pack8(o);
    }
#pragma unroll
    for (int it = 0; it < 4; ++it) {
        const int h = 2 * it + hw; const bool isk = l5 < 16;
        u32x4* ptr = (u32x4*)(p + C_KVRAW + h * 256 + l5 * 8);
        float x[8]; unpack8(rkv[it], x);
        float ss = 0.f;
#pragma unroll
        for (int j = 0; j < 8; ++j) { x[j] *= skv; ss += x[j] * x[j]; }
        if (!isk) ss = 0.f;
#pragma unroll
        for (int o = 1; o < 32; o <<= 1) ss += __shfl_xor(ss, o);
        const float rn = 1.0f / sqrtf((ss + kpe_ss) * (1.f / 192.f) + EPS);
        if (l5 == 0) rnl[h] = rn;
        const int gi = 192 + (isk ? l5 : 0) * 8;
        const f32x4 g0 = *(const f32x4*)(qkg + gi), g1 = *(const f32x4*)(qkg + gi + 4);
        float o[8];
#pragma unroll
        for (int j = 0; j < 4; ++j) { o[j] = isk ? x[j] * rn * g0[j] : x[j]; o[4 + j] = isk ? x[4 + j] * rn * g1[j] : x[4 + j]; }
        *ptr = pack8(o);
    }
    LDS_WAIT(); asm volatile("" ::: "memory");
    { const int hd = lane >> 3, c = lane & 7; const float rn = rnl[hd];
      const f32x4 g0 = *(const f32x4*)(qkg + 192 + 128 + c * 8), g1 = *(const f32x4*)(qkg + 192 + 128 + c * 8 + 4);
      float x[8], o[8];
#pragma unroll
      for (int j = 0; j < 4; ++j) { x[j] = kp[j] * rn * g0[j]; x[4 + j] = kp[4 + j] * rn * g1[j]; }
#pragma unroll
      for (int j = 0; j < 8; ++j) { const float pr = __shfl_xor(x[j], 4); o[j] = (c & 4) ? (x[j] * c64[j] + pr * s64[j]) : (x[j] * c64[j] - pr * s64[j]); }
      *(u32x4*)(p + C_KPEH + hd * 64 + c * 8) = pack8(o); }
    LDS_WAIT(); asm volatile("" ::: "memory");
}
__device__ __forceinline__ void post3_row(bf16_t* P, int r, const float* subg, float lam, float omli, int lane) {
    bf16_t* p = P + (size_t)r * PW;
    const int hw = lane >> 5, l5 = lane & 31;
    u32x4 rr[4];
#pragma unroll
    for (int h = 0; h < 4; ++h) rr[h] = *(const u32x4*)(p + (hw ? C_IQ : C_FQ) + h * 256 + l5 * 8);
#pragma unroll
    for (int h = 0; h < 4; ++h) {
        const u32x4 raw = rr[h];
        const u32x4 praw = shfl_xor4(raw, 16);
        float a[8], b[8]; unpack8(raw, a); unpack8(praw, b);
        float d[8], ss = 0.f;
#pragma unroll
        for (int j = 0; j < 8; ++j) { d[j] = a[j] - lam * b[j]; ss += d[j] * d[j]; }
        if (l5 >= 16) ss = 0.f;
#pragma unroll
        for (int o = 1; o < 64; o <<= 1) ss += __shfl_xor(ss, o);
        const float rn = omli / sqrtf(ss * (1.f / 256.f) + EPS);
        const int dim = hw * 128 + (l5 & 15) * 8;
        const f32x4 g0 = *(const f32x4*)(subg + dim), g1 = *(const f32x4*)(subg + dim + 4);
        float o[8];
#pragma unroll
        for (int j = 0; j < 4; ++j) { o[j] = d[j] * rn * g0[j]; o[4 + j] = d[4 + j] * rn * g1[j]; }
        if (l5 < 16) *(u32x4*)(p + C_OC + h * 256 + dim) = pack8(o);
    }
}

__device__ __forceinline__ int key_row(int kidx, int tokbase) { return kidx < 64 ? (MBLK - 64) + kidx : tokbase + (kidx - 64); }

__device__ __forceinline__ void index_row(const bf16_t* P, int tok, unsigned* bm, LAS float* iqs  , LAS unsigned* keys  , int lane) {
    const int b = tok >> 11, t = tok & (SEQ - 1), r = MBLK + tok, qk = 64 + t, nvalid = t + 17, tokbase = MBLK + b * SEQ;
    const int nch = qk / 64 + 1;
    unsigned* out = bm + (size_t)tok * BMW;
    if (nvalid <= 256) {
        for (int c = 0; c < 33; ++c) { const int kidx = 64 * c + lane; const unsigned long long m = __ballot(kidx >= 48 && kidx <= qk);
            if (lane == 0) { out[2 * c] = (unsigned)m; out[2 * c + 1] = (unsigned)(m >> 32); } }
        return;
    }
    const bf16_t* p = P + (size_t)r * PW;
#pragma unroll
    for (int j = 0; j < 16; ++j) iqs[j * 64 + lane] = bf2f(p[C_IQ + j * 64 + lane]);
    if (lane < 16) iqs[1024 + lane] = bf2f(p[C_IW + lane]);
    LDS_WAIT(); asm volatile("" ::: "memory");
    for (int c = 0; c < nch; ++c) {
        const int kidx = 64 * c + lane; const bool valid = kidx >= 48 && kidx <= qk;
        const int kr = key_row(valid ? kidx : 48, tokbase);
        const u32x4* kp = (const u32x4*)(P + (size_t)kr * PW + C_IK);
        u32x4 kw[8];
#pragma unroll
        for (int j = 0; j < 8; ++j) kw[j] = kp[j];
        float score = 0.f;
#pragma unroll 1
        for (int h = 0; h < 16; ++h) {
            const LAS f32x4* qv = (const LAS f32x4*)(iqs + h * 64); float d = 0.f;
#pragma unroll
            for (int j = 0; j < 8; ++j) { const u32x4 w = kw[j]; const f32x4 qa = qv[2 * j], qb = qv[2 * j + 1];
                d += qa.x * __uint_as_float(w.x << 16) + qa.y * __uint_as_float(w.x & 0xffff0000u) + qa.z * __uint_as_float(w.y << 16) + qa.w * __uint_as_float(w.y & 0xffff0000u)
                   + qb.x * __uint_as_float(w.z << 16) + qb.y * __uint_as_float(w.z & 0xffff0000u) + qb.z * __uint_as_float(w.w << 16) + qb.w * __uint_as_float(w.w & 0xffff0000u); }
            score += fmaxf(d, 0.f) * iqs[1024 + h];
        }
        const unsigned u = __float_as_uint(score);
        keys[c * 64 + lane] = valid ? ((u & 0x80000000u) ? ~u : (u | 0x80000000u)) : 0u;
    }
    LDS_WAIT(); asm volatile("" ::: "memory");
    unsigned T = 0u;
    for (int bit = 31; bit >= 0; --bit) {
        const unsigned cand = T | (1u << bit); int cnt = 0;
        for (int c = 0; c < nch; ++c) cnt += __popcll(__ballot(keys[c * 64 + lane] >= cand));
        if (cnt >= 256) T = cand;
        if (cnt == 256) break;
    }
    for (int c = 0; c < 33; ++c) { unsigned long long m = 0ull; if (c < nch) m = __ballot(keys[c * 64 + lane] >= T);
        if (lane == 0) { out[2 * c] = (unsigned)m; out[2 * c + 1] = (unsigned)(m >> 32); } }
    LDS_WAIT(); asm volatile("" ::: "memory");
}

__device__ __forceinline__ void index_unit(const bf16_t* P, int unit, unsigned* bm, LAS unsigned char* lds) {
    typedef float f32x16 __attribute__((ext_vector_type(16)));
    int tid = threadIdx.x; asm volatile("" : "+v"(tid));
    const int wid = __builtin_amdgcn_readfirstlane(tid >> 6), lane = tid & 63, j = lane & 31, hi = lane >> 5;
    const int tb = 255 - (unit >> 4), b = unit & 15, t0 = tb * 8, tokbase = MBLK + b * SEQ;
    const int wmax = (64 + t0 + 7) >> 5;
    LAS unsigned* keys = (LAS unsigned*)lds;
    LAS float* iwl = (LAS float*)(lds + 8 * 2112 * 4);
    if (t0 + 7 + 17 > 256) {
        if (tid < 128) iwl[tid] = bf2f(P[(size_t)(tokbase + t0 + (tid >> 4)) * PW + C_IW + (tid & 15)]);
        bf16x8 af[4][4];
        { const int qa = (j >> 2) & 1, ha = (j & 3) + 4 * (j >> 3);
#pragma unroll
          for (int blk = 0; blk < 4; ++blk) { const bf16_t* ap = P + (size_t)(tokbase + t0 + 2 * blk + qa) * PW + C_IQ + ha * 64 + hi * 8;
#pragma unroll
              for (int s = 0; s < 4; ++s) af[blk][s] = *(const bf16x8*)(ap + s * 16); } }
        LDS_WAIT(); __syncthreads();
        const unsigned boff = (unsigned)(j * PW + C_IK + hi * 8) * 2u;
        for (int w = wid; w <= wmax; w += 8) {
            const int kr_ = w < 2 ? (MBLK - 64) + 32 * w : tokbase + 32 * (w - 2); const char* bp_ = (const char*)(P + (size_t)kr_ * PW) + boff;
            bf16x8 bf[4];
#pragma unroll
            for (int s = 0; s < 4; ++s) bf[s] = *(const bf16x8*)(bp_ + s * 32);
            const int kidx = 32 * w + j;
#pragma unroll
            for (int blk = 0; blk < 4; ++blk) {
                f32x16 acc = (f32x16){0.f,0.f,0.f,0.f,0.f,0.f,0.f,0.f,0.f,0.f,0.f,0.f,0.f,0.f,0.f,0.f};
#pragma unroll
                for (int s = 0; s < 4; ++s) acc = __builtin_amdgcn_mfma_f32_32x32x16_bf16(af[blk][s], bf[s], acc, 0, 0, 0);
                const int q = 2 * blk + hi;
                const LAS f32x4* iwq = (const LAS f32x4*)(iwl + q * 16);
                float score = 0.f;
#pragma unroll
                for (int g = 0; g < 4; ++g) { const f32x4 wv = iwq[g]; score += fmaxf(acc[4 * g], 0.f) * wv.x + fmaxf(acc[4 * g + 1], 0.f) * wv.y + fmaxf(acc[4 * g + 2], 0.f) * wv.z + fmaxf(acc[4 * g + 3], 0.f) * wv.w; }
                const bool valid = kidx >= 48 && kidx <= 64 + t0 + q; const unsigned u_ = __float_as_uint(score);
                keys[q * 2112 + kidx] = valid ? ((u_ & 0x80000000u) ? ~u_ : (u_ | 0x80000000u)) : 0u;
            }
        }
        LDS_WAIT(); __syncthreads();
    }
    const int tq = t0 + wid, qk = 64 + tq, nch = qk / 64 + 1;
    unsigned* out = bm + (size_t)(b * SEQ + tq) * BMW;
    if (tq + 17 <= 256) {
        for (int c = 0; c < 33; ++c) { const int kidx = 64 * c + lane; const unsigned long long m = __ballot(kidx >= 48 && kidx <= qk);
            if (lane == 0) { out[2 * c] = (unsigned)m; out[2 * c + 1] = (unsigned)(m >> 32); } }
    } else {
        unsigned kreg[33];
#pragma unroll
        for (int c = 0; c < 33; ++c) kreg[c] = (c < nch && 64 * c + lane <= qk) ? keys[wid * 2112 + 64 * c + lane] : 0u;
        unsigned T = 0u;
        for (int bit = 31; bit >= 0; --bit) {
            const unsigned cand = T | (1u << bit); int cnt = 0;
#pragma unroll
            for (int c = 0; c < 33; ++c) cnt += __popcll(__ballot(kreg[c] >= cand));
            if (cnt >= 256) T = cand;
            if (cnt == 256) break;
        }
#pragma unroll
        for (int c = 0; c < 33; ++c) { const unsigned long long m = __ballot(kreg[c] >= T && kreg[c] != 0u);
            if (lane == 0) { out[2 * c] = (unsigned)m; out[2 * c + 1] = (unsigned)(m >> 32); } }
    }
    LDS_WAIT();
}

template <int DQK, int DV, bool MASKED>
__device__ __forceinline__ void attn_row(bf16_t* P, int r, int qcol, int k1col, int k2col, int vcol, int ocol0, int ocol1, const unsigned* bm, LAS float* qs, int lane) {
    int qk, tokbase;
    if (r < MBLK) { qk = r - (MBLK - 64); tokbase = MBLK; } else { const int tok = r - MBLK; qk = 64 + (tok & (SEQ - 1)); tokbase = MBLK + (tok >> 11) * SEQ; }
    const bf16_t* qp = P + (size_t)r * PW + qcol;
#pragma unroll
    for (int d = 0; d < DQK; d += 64) qs[d + lane] = bf2f(qp[d + lane]);
    LDS_WAIT(); asm volatile("" ::: "memory");
    const bool use_bm = MASKED && r >= MBLK;
    const unsigned* bmr = bm + (size_t)(r >= MBLK ? r - MBLK : 0) * BMW;
    float m = -1e30f, l = 0.f, o[DV / 64];
#pragma unroll
    for (int k = 0; k < DV / 64; ++k) o[k] = 0.f;
    const int nch = qk / 64 + 1;
    for (int c = 0; c < nch; ++c) {
        const int kidx = 64 * c + lane; bool valid = kidx >= 48 && kidx <= qk;
        if (use_bm) valid = (bmr[kidx >> 5] >> (kidx & 31)) & 1u;
        const int kr = key_row((kidx >= 48 && kidx <= qk) ? kidx : 48, tokbase);
        float s = 0.f;
        { const u32x4* kp = (const u32x4*)(P + (size_t)kr * PW + k1col);
#pragma unroll
          for (int j = 0; j < 16; ++j) { const u32x4 w = kp[j]; const LAS f32x4* qv = (const LAS f32x4*)(qs + j * 8); const f32x4 qa = qv[0], qb = qv[1];
              s += qa.x * __uint_as_float(w.x << 16) + qa.y * __uint_as_float(w.x & 0xffff0000u) + qa.z * __uint_as_float(w.y << 16) + qa.w * __uint_as_float(w.y & 0xffff0000u)
                 + qb.x * __uint_as_float(w.z << 16) + qb.y * __uint_as_float(w.z & 0xffff0000u) + qb.z * __uint_as_float(w.w << 16) + qb.w * __uint_as_float(w.w & 0xffff0000u); } }
        if (DQK == 192) { const u32x4* kp = (const u32x4*)(P + (size_t)kr * PW + k2col);
#pragma unroll
          for (int j = 0; j < 8; ++j) { const u32x4 w = kp[j]; const LAS f32x4* qv = (const LAS f32x4*)(qs + 128 + j * 8); const f32x4 qa = qv[0], qb = qv[1];
              s += qa.x * __uint_as_float(w.x << 16) + qa.y * __uint_as_float(w.x & 0xffff0000u) + qa.z * __uint_as_float(w.y << 16) + qa.w * __uint_as_float(w.y & 0xffff0000u)
                 + qb.x * __uint_as_float(w.z << 16) + qb.y * __uint_as_float(w.z & 0xffff0000u) + qb.z * __uint_as_float(w.w << 16) + qb.w * __uint_as_float(w.w & 0xffff0000u); } }
        if (!valid) s = -__builtin_inff();
        const float mn = fmaxf(m, wave_max(s));
        const float alpha = __builtin_amdgcn_exp2f(m - mn), pj = __builtin_amdgcn_exp2f(s - mn);
        l = l * alpha + wave_sum(pj); m = mn;
#pragma unroll
        for (int k = 0; k < DV / 64; ++k) o[k] *= alpha;
        for (int j = 0; j < 64; ++j) {
            const float pw = __uint_as_float((unsigned)__builtin_amdgcn_readlane((int)__float_as_uint(pj), j));
            if (pw != 0.f) { const int rj = __builtin_amdgcn_readlane(kr, j); const bf16_t* vp = P + (size_t)rj * PW + vcol;
#pragma unroll
                for (int k = 0; k < DV / 64; ++k) o[k] += pw * bf2f(vp[k * 64 + lane]); }
        }
    }
    const float rl = l > 0.f ? 1.0f / l : 0.f;
    bf16_t* op = P + (size_t)r * PW;
#pragma unroll
    for (int k = 0; k < DV / 64; ++k) { const int d = k * 64 + lane; op[(d < 128 ? ocol0 + d : ocol1 + d - 128)] = (bf16_t)f2bf(o[k] * rl); }
    LDS_WAIT(); asm volatile("" ::: "memory");
}
namespace fa {
typedef float f32x16 __attribute__((ext_vector_type(16)));
typedef short s16x4 __attribute__((ext_vector_type(4)));
__device__ __forceinline__ int crow(int r, int hi) { return (r & 3) + 8 * (r >> 2) + 4 * hi; }
__device__ __forceinline__ int v_st(int k, int c) { const int kk = (k & ~0xC) | ((k & 4) << 1) | ((k & 8) >> 1); return ((kk >> 3) * 4 + (c >> 5)) * 512 + ((kk & 7) * 32 + (c & 31)) * 2; }
__device__ __forceinline__ int v_rd_base(int lane) { return ((lane & 3) << 3) | (((lane >> 2) & 3) << 6) | (((lane >> 4) & 1) << 5) | (((lane >> 5) & 1) << 8); }
constexpr int v_rd_off(int d0, int ks, int half) { return d0 * 512 + ks * 4096 + half * 2048; }
constexpr int SHM_V = 16384;
template <int DQK> struct Geo { static constexpr int KP = DQK * 2, SHM_K = 64 * DQK * 2, LDS_K0 = 2 * SHM_V, LDS_WS = LDS_K0 + 2 * SHM_K, BYTES = LDS_WS + 8 * 256; };
#define FA_KSWZ(row, colB, pitch) ((row) * (pitch) + ((colB) ^ (((row) & 7) << 4)))
#define FA_SBAR() __builtin_amdgcn_sched_barrier(0)

struct Item { int qrow0, qk0, nt, tokbase; };

template <int DQK>
__device__ __forceinline__ void load_q(const bf16_t* P, const Item& it, int qcol, bf16x8 (&qr)[DQK / 16]) {
    int tid = threadIdx.x; asm volatile("" : "+v"(tid));
    const int wid = tid >> 6, lane = tid & 63, r32 = lane & 31, hi = lane >> 5;
    const bf16_t* qp = P + (size_t)(it.qrow0 + wid * 32 + r32) * PW + qcol + hi * 8;
#pragma unroll
    for (int d0 = 0; d0 < DQK / 16; ++d0) qr[d0] = *(const bf16x8*)(qp + d0 * 16);
}

template <int DQK, bool MASKED>
__device__ __forceinline__ void attn_core(bf16_t* P, const Item& it, const bf16x8 (&qr)[DQK / 16], int k1col, int k2col, int vcol, int ocol, const unsigned* bmq, LAS unsigned char* lds) {
    typedef Geo<DQK> G;
    int tid = threadIdx.x; asm volatile("" : "+v"(tid));
    const int wid = __builtin_amdgcn_readfirstlane(tid >> 6), lane = tid & 63, r32 = lane & 31, hi = lane >> 5;
    LAS unsigned char* V_lds = lds; LAS unsigned char* K_lds = lds + G::LDS_K0; LAS float* wsf = (LAS float*)(lds + G::LDS_WS) + wid * 64;
    const int sr = tid >> 4, sc = (tid & 15) * 8;
    const int vst0 = v_st(sr, sc), vst1 = v_st(32 + sr, sc), kws0 = FA_KSWZ(sr, sc * 2, G::KP), kws1 = FA_KSWZ(sr + 32, sc * 2, G::KP);
    const int xr = tid >> 3, xc = (tid & 7) * 8, kws2 = FA_KSWZ(xr, (128 + xc) * 2, G::KP);
    const unsigned loff0 = (unsigned)(sr * PW + sc) * 2u, loffx = (unsigned)(xr * PW + xc) * 2u;
    const int vb0 = (int)(unsigned)(size_t)V_lds + v_rd_base(lane);
    const int NT = it.nt;
    const int qk = it.qk0 + wid * 32 + r32;
    const bool use_bm = MASKED && (bmq != nullptr);
    const unsigned bmoff = (unsigned)((wid * 32 + r32) * BMW) * 4u;
    float m_reg = -1e30f, l_reg = 0.f; f32x16 o[4];
#pragma unroll
    for (int d = 0; d < 4; ++d) o[d] = (f32x16){0.f,0.f,0.f,0.f,0.f,0.f,0.f,0.f,0.f,0.f,0.f,0.f,0.f,0.f,0.f,0.f};
    bf16x8 sk0, sk1, sk2, sv0, sv1;
#define FA_KROW0(t) ((t) == 0 ? (MBLK - 64) : it.tokbase + 64 * ((t) - 1))
#define FA_LOAD(t) do { const int kr_ = FA_KROW0(t); const char* rb_ = (const char*)(P + (size_t)kr_ * PW); const char* rk_ = rb_ + (size_t)k1col * 2; const char* rv_ = rb_ + (size_t)vcol * 2; \
        sk0 = *(const bf16x8*)(rk_ + loff0); sk1 = *(const bf16x8*)(rk_ + (size_t)32 * PW * 2 + loff0); sv0 = *(const bf16x8*)(rv_ + loff0); sv1 = *(const bf16x8*)(rv_ + (size_t)32 * PW * 2 + loff0); \
        if (DQK == 192) sk2 = *(const bf16x8*)(rb_ + (size_t)k2col * 2 + loffx); } while (0)
#define FA_WRITE(bf) do { *(LAS bf16x8*)(K_lds + (bf) * G::SHM_K + kws0) = sk0; *(LAS bf16x8*)(K_lds + (bf) * G::SHM_K + kws1) = sk1; \
        *(LAS bf16x8*)(V_lds + (bf) * SHM_V + vst0) = sv0; *(LAS bf16x8*)(V_lds + (bf) * SHM_V + vst1) = sv1; \
        if (DQK == 192) *(LAS bf16x8*)(K_lds + (bf) * G::SHM_K + kws2) = sk2; } while (0)
    constexpr int QREG = (DQK == 192) ? 6 : DQK / 16;
    LAS unsigned char* qx = lds + G::BYTES + (wid * 384 + lane) * 16;
    if (DQK == 192) {
#pragma unroll
        for (int d0 = QREG; d0 < DQK / 16; ++d0) *(LAS bf16x8*)(qx + (d0 - QREG) * 1024) = qr[d0];
    }
    FA_LOAD(0); FA_WRITE(0);
    __syncthreads();
    for (int t = 0; t < NT; ++t) {
        const int cur = t & 1;
        unsigned zb = 0u; asm volatile("" : "+v"(zb)); u32x2 bw = (u32x2){zb, zb};
        if (use_bm) bw = *(const u32x2*)((const char*)(bmq + 2 * t) + bmoff);
        f32x16 p0 = (f32x16){0.f,0.f,0.f,0.f,0.f,0.f,0.f,0.f,0.f,0.f,0.f,0.f,0.f,0.f,0.f,0.f}, p1 = p0;
        { LAS unsigned char* kbase = K_lds + cur * G::SHM_K;
          LAS unsigned char* kb[4];
#pragma unroll
          for (int dd = 0; dd < 4; ++dd) kb[dd] = kbase + FA_KSWZ(r32, (dd * 16 + hi * 8) * 2, G::KP);
          constexpr int GS = (DQK == 192) ? 2 : 4;
#pragma unroll
          for (int g = 0; g < DQK / (16 * GS); ++g) {
              bf16x8 fb0[GS], fb1[GS];
#pragma unroll
              for (int dd = 0; dd < GS; ++dd) { const int d0 = g * GS + dd; LAS unsigned char* a = kb[d0 & 3] + (d0 >> 2) * 128; fb0[dd] = *(const LAS bf16x8*)a; fb1[dd] = *(const LAS bf16x8*)(a + 32 * G::KP); }
              FA_SBAR();
#pragma unroll
              for (int dd = 0; dd < GS; ++dd) { const int d0 = g * GS + dd; bf16x8 qf; if (d0 < QREG) qf = qr[d0 < QREG ? d0 : 0]; else qf = *(const LAS bf16x8*)(qx + (d0 - QREG) * 1024);
                  p0 = __builtin_amdgcn_mfma_f32_32x32x16_bf16(fb0[dd], qf, p0, 0, 0, 0); p1 = __builtin_amdgcn_mfma_f32_32x32x16_bf16(fb1[dd], qf, p1, 0, 0, 0); }
              FA_SBAR(); } }
        if (t + 1 < NT) FA_LOAD(t + 1);
        FA_SBAR();
        const float NEG = -__builtin_inff();
        if (use_bm) {
            const unsigned wx = bw.x >> (4 * hi), wy = bw.y >> (4 * hi);
#pragma unroll
            for (int r = 0; r < 16; ++r) { const unsigned bit = 1u << ((r & 3) + 8 * (r >> 2)); if (!(wx & bit)) p0[r] = NEG; if (!(wy & bit)) p1[r] = NEG; }
        } else if (t == 0 || 64 * t + 63 > it.qk0 + wid * 32) {
            const int kb_ = 64 * t + 4 * hi;
#pragma unroll
            for (int r = 0; r < 16; ++r) { const int k0 = kb_ + (r & 3) + 8 * (r >> 2), k1 = k0 + 32;
                if (k0 < 48 || k0 > qk) p0[r] = NEG; if (k1 < 48 || k1 > qk) p1[r] = NEG; }
        }
        float pmax = p0[0];
#pragma unroll
        for (int r = 1; r < 16; ++r) pmax = fmaxf(pmax, p0[r]);
#pragma unroll
        for (int r = 0; r < 16; ++r) pmax = fmaxf(pmax, p1[r]);
        { auto rr = __builtin_amdgcn_permlane32_swap(__float_as_uint(pmax), __float_as_uint(pmax), false, false); pmax = fmaxf(__uint_as_float(rr[0]), __uint_as_float(rr[1])); }
        const float mn = fmaxf(m_reg, pmax); const float alpha = __builtin_amdgcn_exp2f(m_reg - mn); m_reg = mn;
        float ps = 0.f;
#pragma unroll
        for (int r = 0; r < 16; ++r) { p0[r] = __builtin_amdgcn_exp2f(p0[r] - mn); p1[r] = __builtin_amdgcn_exp2f(p1[r] - mn); ps += p0[r] + p1[r]; }
        { auto rr = __builtin_amdgcn_permlane32_swap(__float_as_uint(ps), __float_as_uint(ps), false, false); ps = __uint_as_float(rr[0]) + __uint_as_float(rr[1]); }
        l_reg = l_reg * alpha + ps;
        if (__any(alpha < 1.f)) { if (hi == 0) wsf[r32] = alpha; LDS_WAIT();
#pragma unroll
            for (int d_ = 0; d_ < 4; ++d_)
#pragma unroll
                for (int r = 0; r < 16; ++r) o[d_][r] *= wsf[crow(r, hi)];
            LDS_WAIT(); }
        bf16x8 pa0, pa1, pa2, pa3;
#define FA_PK4(Pv, B_, OUT) do { const unsigned a0 = cvt_pk_bf16(Pv[B_ + 0], Pv[B_ + 1]), a1 = cvt_pk_bf16(Pv[B_ + 2], Pv[B_ + 3]), b0 = cvt_pk_bf16(Pv[B_ + 4], Pv[B_ + 5]), b1 = cvt_pk_bf16(Pv[B_ + 6], Pv[B_ + 7]); \
        auto r0 = __builtin_amdgcn_permlane32_swap(a0, b0, false, false); auto r1 = __builtin_amdgcn_permlane32_swap(a1, b1, false, false); \
        u32x4 w_ = {r0[0], r1[0], r0[1], r1[1]}; OUT = __builtin_bit_cast(bf16x8, w_); } while (0)
        FA_PK4(p0, 0, pa0); FA_PK4(p0, 8, pa1); FA_PK4(p1, 0, pa2); FA_PK4(p1, 8, pa3);
#define FA_TRRD(dst, off) asm volatile("ds_read_b64_tr_b16 %0, %1 offset:%2" : "=&v"(dst) : "v"(vb0), "i"(off) : "memory")
#define FA_PV(VB, d0) do { s16x4 l0, l1, l2, l3, h0, h1, h2, h3; constexpr int b_ = (VB) * SHM_V + v_rd_off(d0, 0, 0); \
        FA_TRRD(l0, b_); FA_TRRD(h0, b_ + 2048); FA_TRRD(l1, b_ + 4096); FA_TRRD(h1, b_ + 6144); FA_TRRD(l2, b_ + 8192); FA_TRRD(h2, b_ + 10240); FA_TRRD(l3, b_ + 12288); FA_TRRD(h3, b_ + 14336); \
        asm volatile("s_waitcnt lgkmcnt(0)" ::: "memory"); FA_SBAR(); \
        o[d0] = __builtin_amdgcn_mfma_f32_32x32x16_bf16(pa0, (bf16x8){l0[0], l0[1], l0[2], l0[3], h0[0], h0[1], h0[2], h0[3]}, o[d0], 0, 0, 0); \
        o[d0] = __builtin_amdgcn_mfma_f32_32x32x16_bf16(pa1, (bf16x8){l1[0], l1[1], l1[2], l1[3], h1[0], h1[1], h1[2], h1[3]}, o[d0], 0, 0, 0); \
        o[d0] = __builtin_amdgcn_mfma_f32_32x32x16_bf16(pa2, (bf16x8){l2[0], l2[1], l2[2], l2[3], h2[0], h2[1], h2[2], h2[3]}, o[d0], 0, 0, 0); \
        o[d0] = __builtin_amdgcn_mfma_f32_32x32x16_bf16(pa3, (bf16x8){l3[0], l3[1], l3[2], l3[3], h3[0], h3[1], h3[2], h3[3]}, o[d0], 0, 0, 0); } while (0)
        FA_SBAR();
        if (cur == 0) { FA_PV(0, 0); FA_PV(0, 1); FA_PV(0, 2); FA_PV(0, 3); } else { FA_PV(1, 0); FA_PV(1, 1); FA_PV(1, 2); FA_PV(1, 3); }
        FA_SBAR();
        if (t + 1 < NT) { if (cur == 0) FA_WRITE(1); else FA_WRITE(0); }
        __syncthreads();
    }
    if (hi == 0) wsf[r32] = l_reg; LDS_WAIT();
    float rli[16];
#pragma unroll
    for (int r = 0; r < 16; ++r) { const float lv = wsf[crow(r, hi)]; rli[r] = lv > 0.f ? __builtin_amdgcn_rcpf(lv) : 0.f; }
    { int l2 = lane; asm volatile("" : "+v"(l2));
      const int r32b = l2 & 31, hib = l2 >> 5;
      char* Ow = (char*)(P + (size_t)(it.qrow0 + wid * 32) * PW + ocol) + (unsigned)((4 * hib) * PW + r32b) * 2u;
#pragma unroll
      for (int r = 0; r < 16; ++r) { const unsigned ro = (unsigned)(((r & 3) + 8 * (r >> 2)) * PW) * 2u;
#pragma unroll
        for (int d0 = 0; d0 < 4; ++d0) { const float v = o[d0][r] * rli[r]; const float vn = __shfl_xor(v, 1);
            if ((r32b & 1) == 0) *(unsigned*)(Ow + ro + d0 * 64) = cvt_pk_bf16(v, vn); } } }
    LDS_WAIT();
    __syncthreads();
#undef FA_KROW0
#undef FA_LOAD
#undef FA_WRITE
#undef FA_PK4
#undef FA_TRRD
#undef FA_PV
}
__device__ __forceinline__ int next_item(unsigned* ctr, LAS int* slot) {
    __syncthreads();
    if (threadIdx.x == 0) *slot = (int)__hip_atomic_fetch_add(ctr, 1u, __ATOMIC_RELAXED, __HIP_MEMORY_SCOPE_AGENT);
    __syncthreads();
    return *slot;
}
__device__ __forceinline__ Item make_item(bool meta, int b, int qb) {
    Item it;
    if (meta) { it.qrow0 = 0; it.qk0 = -(MBLK - 64); it.nt = 1; it.tokbase = MBLK; }
    else { it.qrow0 = MBLK + b * SEQ + qb * 256; it.qk0 = 64 + qb * 256; it.nt = 4 * (qb + 1) + 1; it.tokbase = MBLK + b * SEQ; }
    return it;
}
}

__device__ __forceinline__ int deal_row(int pass, int gw, int ngw) { const int j = (pass & 1) ? (ngw - 1 - gw) : gw; return pass * ngw + j; }

constexpr int PH_PER_LAYER = 19, N_PHASES = 2 * PH_PER_LAYER;
__device__ __forceinline__ unsigned char* uni_ptr(unsigned char* p) { const unsigned long long v = (unsigned long long)p; const unsigned lo = __builtin_amdgcn_readfirstlane((unsigned)v), hi = __builtin_amdgcn_readfirstlane((unsigned)(v >> 32)); return (unsigned char*)(((unsigned long long)hi << 32) | lo); }
__device__ __forceinline__ const float* arg_in(const Args& a, int k) { asm volatile("" : "+s"(k)); return a.in[k]; }
__global__ void __launch_bounds__(NWAVES * 64, 2) mega_fwd(Args args) {
    extern __shared__ __attribute__((aligned(16))) unsigned char lds_raw[];
    {
        LAS unsigned char* l0 = (LAS unsigned char*)lds_raw;
        for (int u = threadIdx.x; u < (LDS_BYTES - LDSCTL_OFF) / 4; u += NWAVES * 64) ((LAS unsigned*)(l0 + LDSCTL_OFF))[u] = 0u;
        __syncthreads();
    }
#if MK_ONE_LAUNCH
    (void)xcd_barrier_post((unsigned*)(args.ws + WS_CTL) + CW_BAR, (volatile LAS unsigned*)((LAS unsigned char*)lds_raw + LDSCTL_OFF + 64));
#define GRID_BAR() do { XcdBarrier bar_; bar_.bar = (unsigned*)(uni_ptr(args.ws) + WS_CTL) + CW_BAR; bar_.x = xb_xcc_id(); bar_.st = (volatile LAS unsigned*)((LAS unsigned char*)lds_raw + LDSCTL_OFF + 64); xcd_barrier(bar_); } while (0)
#else
#define GRID_BAR() do {} while (0)
#endif
    const int lo = args.ph_lo, hi = args.ph_hi;
#define IN(k) (lo <= (k) && (k) < hi)
#define SEAM(k) do { if (IN((k) + 1)) GRID_BAR(); } while (0)
#define PH_BEGIN \
    int tid_ = threadIdx.x; asm volatile("" : "+v"(tid_)); \
    Ctx F; F.lds = (LAS unsigned char*)lds_raw; F.tid = tid_; F.lane = tid_ & 63; F.wave = __builtin_amdgcn_readfirstlane(tid_ >> 6); \
    F.G = gridDim.x; F.bid = blockIdx.x; F.gw = F.bid * NWAVES + F.wave; F.ngw = F.G * NWAVES; \
    unsigned char* ws = uni_ptr(args.ws); asm volatile("" : "+s"(ws)); \
    int ly = __builtin_amdgcn_readfirstlane(layer); asm volatile("" : "+s"(ly)); (void)ly; (void)F
#define XN_ ((bf16_t*)(ws + WS_XN))
#define P_ ((bf16_t*)(ws + WS_P))
#define HMETA_ ((float*)(ws + WS_HMETA))
#define RSTDQ_ ((float*)(ws + WS_RSTD))
#define RSTDKV_ ((float*)(ws + WS_RSTD) + R)
#define BM_ ((unsigned*)(ws + WS_BM))
#define RS_(i) ((float*)(ws + WS_CTL + WS_RS) + (size_t)(i) * R)
#define WB_(off) ((bf16_t*)(ws + WS_WB + (off)))
#define OUT_ (args.out)
#define LAMBDA_INIT(ly) ((ly) == 0 ? 0.2f : (0.8f - 0.6f * 0.7408182206817179f))
#define HSRC_TOK(ly) ((ly) == 0 ? arg_in(args, 0) : (const float*)args.out)

#pragma unroll
    for (int layer = 0; layer < 2; ++layer) {
        const int pb = layer * PH_PER_LAYER;
        if (((PHMASK >> 0) & 1) && IN(pb + 0)) {
            PH_BEGIN;
            for (int rep_ = 0; rep_ < NREP(0); ++rep_) { if (rep_) GRID_BAR();
            const float* meta = arg_in(args, 1);
            conv_matrix<1>(F, arg_in(args, 3) + (size_t)ly * DM * D_IN, DM, D_IN, WB_(WB_IN), arg_in(args, 2) + ly * DM);
            conv_matrix<0>(F, arg_in(args, 7) + (size_t)ly * 512 * 1536, 512, 1536, WB_(WB_QUP), arg_in(args, 5) + ly * 512);
            conv_matrix<0>(F, arg_in(args, 8) + (size_t)ly * 512 * 2048, 512, 2048, WB_(WB_KVUP), arg_in(args, 6) + ly * 512);
            for (int b = 0; b < 3; ++b) conv_matrix<0>(F, arg_in(args, 14) + ((size_t)ly * 3 + b) * 1024 * DM, 1024, DM, WB_(WB_BR) + (size_t)b * DM * 1024, nullptr);
            conv_matrix<0>(F, arg_in(args, 15) + (size_t)ly * DM * DM, DM, DM, WB_(WB_O), nullptr);
            conv_matrix<2>(F, arg_in(args, 17) + (size_t)ly * DM * 2 * DFF, DM, 2 * DFF, WB_(WB_F1), arg_in(args, 16) + ly * DM);
            conv_matrix<0>(F, arg_in(args, 18) + (size_t)ly * DFF * DM, DFF, DM, WB_(WB_F2), nullptr);
            unsigned zu = 0u; asm volatile("" : "+v"(zu)); const float zf = __uint_as_float(zu);
            for (int i = F.gw * 64 + F.lane; i < 112 * 2048 / 8; i += F.ngw * 64) *((u32x4*)(WB_(WB_IN) + (size_t)1168 * 2048) + i) = (u32x4){zu, zu, zu, zu};
            float* hmeta = HMETA_;
            if (ly == 0) {
                for (int i = F.gw * 64 + F.lane; i < MROW0 * PW / 8; i += F.ngw * 64) *((u32x4*)P_ + i) = (u32x4){zu, zu, zu, zu};
                for (int i = F.gw * 64 + F.lane; i < MBLK * DM / 4; i += F.ngw * 64) { const int rr = i / (DM / 4); f32x4 v = (f32x4){zf, zf, zf, zf};
                    if (rr >= MBLK - NMETA) v = *((const f32x4*)meta + (i - (MBLK - NMETA) * (DM / 4))); *((f32x4*)hmeta + i) = v; }
            }
            if (ly == 0) {
                const float* xin = arg_in(args, 0); bf16_t* XN = XN_; float* rs0 = RS_(0);
                for (int r = MROW0 + F.gw; r < R; r += F.ngw)
                    norm_row(r < MBLK ? meta + (size_t)(r - MROW0) * DM : xin + (size_t)(r - MBLK) * DM, XN + (size_t)r * DM, rs0 + r, F.lane);
            }
            }
            SEAM(pb + 0);
        }
        if (((PHMASK >> 1) & 1) && IN(pb + 1)) {
            PH_BEGIN;
            { SkP f{P_, 0, RS_(2 * ly)}; skinny_gemm(F.lds, XN_ + (size_t)MROW0 * DM, DM, WB_(WB_IN), DM, 1280 / 16, F.bid, F.G, f); }
            SchedPlain S{XN_, DM, WB_(WB_IN), DM, NPMM, 5, F.G, F.bid, 0}; EpiP E{P_, RS_(2 * ly)};
            pg8::gemm_phase(F.lds, S, E);
            if (NREP(1) == 2) { GRID_BAR(); pg8::gemm_phase(F.lds, S, E); }
            SEAM(pb + 1);
        }
        if (((PHMASK >> 2) & 1) && IN(pb + 2)) {
            PH_BEGIN;
            { bf16_t* P = P_; float* rq = RSTDQ_; float* rkv = RSTDKV_;
              for (int r = MROW0 + F.gw; r < R; r += F.ngw) post1a_row(P, r, rq, rkv, F.lane); }
            VM_WAIT(); __syncthreads();
            { SkP f{P_, C_QRAW, nullptr}; skinny_gemm(F.lds, P_ + (size_t)MROW0 * PW + C_CQ, PW, WB_(WB_QUP), 512, 1536 / 16, F.bid, F.G, f); }
            { SkP f{P_, C_KVRAW, nullptr}; skinny_gemm(F.lds, P_ + (size_t)MROW0 * PW + C_CKV, PW, WB_(WB_KVUP), 512, 2048 / 16, F.bid, F.G, f); }
            SchedMlaUp S{P_, WB_(WB_QUP), WB_(WB_KVUP), F.G, F.bid}; EpiP E{P_, nullptr};
            pg8::gemm_phase(F.lds, S, E);
            if (NREP(2) == 2) { GRID_BAR(); pg8::gemm_phase(F.lds, S, E); }
            SEAM(pb + 2);
        }
        if (((PHMASK >> 3) & 1) && IN(pb + 3)) {
            PH_BEGIN;
            const float* mla_qkg = arg_in(args, 9) + ly * 2 * 192;
            bf16_t* P = P_; float* rq = RSTDQ_; float* rkv = RSTDKV_;
            LAS float* rnl = (LAS float*)(F.lds + F.wave * 64);
            for (int r = MROW0 + F.gw; r < R; r += F.ngw) post2_row(P, r, rq, rkv, mla_qkg, rnl, F.lane);
            SEAM(pb + 3);
        }
        if (((PHMASK >> 4) & 1) && IN(pb + 4)) {
            PH_BEGIN;
            bf16_t* P = P_;
            LAS int* slot = (LAS int*)(F.lds + LDSCTL_OFF + 128);
            for (int rep_ = 0; rep_ < NREP(4); ++rep_) { if (rep_) GRID_BAR();
            unsigned* ctr = (unsigned*)(ws + WS_CTL) + CW_Q + 64 * (ly * 4 + 0) + 64 * 16 * rep_;
            for (;;) {
                const int idx = fa::next_item(ctr, slot); if (idx >= 8 * 129) break;
                int h; fa::Item it;
                if (idx < 1024) { const int qb = 7 - (idx >> 7), rest = idx & 127; h = rest & 7; it = fa::make_item(false, rest >> 3, qb); } else { h = idx - 1024; it = fa::make_item(true, 0, 0); }
                bf16x8 qr[12]; fa::load_q<192>(P, it, C_QRAW + h * 192, qr);
                fa::attn_core<192, false>(P, it, qr, C_KVRAW + h * 256, C_KPEH + h * 64, C_KVRAW + h * 256 + 128, C_OA + h * 128, nullptr, F.lds);
            } }
            SEAM(pb + 4);
        }
        if (((PHMASK >> 5) & 1) && IN(pb + 5)) {
            PH_BEGIN;
            { SkP f{P_, 1280, RS_(2 * ly)}; skinny_gemm(F.lds, XN_ + (size_t)MROW0 * DM, DM, WB_(WB_IN) + (size_t)1280 * DM, DM, 7168 / 16, F.bid, F.G, f); }
            SchedPlain S{XN_, DM, WB_(WB_IN) + (size_t)1280 * DM, DM, NPMM, 28, F.G, F.bid, 1280}; EpiP E{P_, RS_(2 * ly)};
            pg8::gemm_phase(F.lds, S, E);
            if (NREP(5) == 2) { GRID_BAR(); pg8::gemm_phase(F.lds, S, E); }
            SEAM(pb + 5);
        }
        if (((PHMASK >> 6) & 1) && IN(pb + 6)) {
            PH_BEGIN;
            const float* dsa_qkg = arg_in(args, 10) + ly * 2 * 128; const float* diff_qkg = arg_in(args, 11) + ly * 2 * 128;
            bf16_t* P = P_;
            for (int r = MROW0 + F.gw; r < R; r += F.ngw) post1b_row(P, r, dsa_qkg, diff_qkg, F.lane);
            SEAM(pb + 6);
        }
        if (((PHMASK >> 7) & 1) && IN(pb + 7)) {
            PH_BEGIN;
            bf16_t* P = P_; unsigned* bm = BM_;
            unsigned* ctr = (unsigned*)(ws + WS_CTL) + CW_Q + 64 * (ly * 4 + 2);
            LAS int* slot = (LAS int*)(F.lds + LDSCTL_OFF + 128);
            for (int rep_ = 0; rep_ < NREP(7); ++rep_) { if (rep_) GRID_BAR(); unsigned* c2 = ctr + 64 * 16 * rep_;
            for (;;) { const int idx = fa::next_item(c2, slot); if (idx >= NTOK / 8) break; index_unit(P, idx, bm, F.lds); } }
            SEAM(pb + 7);
        }
        if (((PHMASK >> 8) & 1) && IN(pb + 8)) {
            PH_BEGIN;
            bf16_t* P = P_; unsigned* bm = BM_;
            LAS int* slot = (LAS int*)(F.lds + LDSCTL_OFF + 128);
            for (int rep_ = 0; rep_ < NREP(8); ++rep_) { if (rep_) GRID_BAR();
            const bool dummy = (NREP(8) == 2) && rep_ == 0;
            unsigned* ctr = (unsigned*)(ws + WS_CTL) + CW_Q + 64 * (ly * 4 + 1) + 64 * 16 * rep_;
            for (;;) {
                const int idx = fa::next_item(ctr, slot); if (idx >= 16 * 129) break;
                int hh; bool meta = false; fa::Item it; int b = 0, qb = 0;
                if (idx < 2048) { qb = 7 - (idx >> 8); const int rest = idx & 255; hh = (rest < 128) ? 8 + (rest & 7) : (rest & 7); b = (rest & 127) >> 3; it = fa::make_item(false, b, qb); }
                else { hh = idx - 2048; hh = hh < 8 ? 8 + hh : hh - 8; meta = true; it = fa::make_item(true, 0, 0); }
                if (hh < 8) {
                    bf16x8 qr[8]; fa::load_q<128>(P, it, C_DQ + hh * 128, qr);
                    fa::attn_core<128, true>(P, it, qr, C_DK + hh * 128, 0, C_DV + hh * 128, dummy ? C_KPE : C_OB + hh * 128, meta ? nullptr : bm + (size_t)(b * SEQ + qb * 256) * BMW, F.lds);
                } else {
                    const int hj = hh - 8;
                    bf16x8 qr[8]; fa::load_q<128>(P, it, C_FQ + hj * 128, qr);
                    fa::attn_core<128, false>(P, it, qr, C_FK + hj * 128, 0, C_FV + (hj >> 1) * 256, dummy ? C_KPE : C_FQ + hj * 128, nullptr, F.lds);
                    fa::attn_core<128, false>(P, it, qr, C_FK + hj * 128, 0, C_FV + (hj >> 1) * 256 + 128, dummy ? C_KPE : C_IQ + hj * 128, nullptr, F.lds);
                }
            } }
            SEAM(pb + 8);
        }
        if (((PHMASK >> 9) & 1) && IN(pb + 9)) {
            PH_BEGIN;
            const float* diff_lam = arg_in(args, 12) + ly * 4 * 128; const float* diff_subg = arg_in(args, 13) + ly * 256;
            const float lambda_init = LAMBDA_INIT(ly);
            const float s1 = wave_sum(diff_lam[F.lane] * diff_lam[128 + F.lane] + diff_lam[64 + F.lane] * diff_lam[192 + F.lane]);
            const float s2 = wave_sum(diff_lam[256 + F.lane] * diff_lam[384 + F.lane] + diff_lam[320 + F.lane] * diff_lam[448 + F.lane]);
            const float lam = __expf(s1) - __expf(s2) + lambda_init;
            bf16_t* P = P_;
            for (int r = MROW0 + F.gw; r < R; r += F.ngw) post3_row(P, r, diff_subg, lam, 1.f - lambda_init, F.lane);
            SEAM(pb + 9);
        }
#define GATE_PHASE(k, b) \
        if (((PHMASK >> 10) & 1) && IN(pb + (k))) { \
            PH_BEGIN; \
            { SkGate f{(bf16_t*)(ws + WS_GS), arg_in(args, 4) + ly * 3 * DM + (b) * DM, RS_(2 * ly)}; skinny_gemm(F.lds, XN_ + (size_t)MROW0 * DM, DM, WB_(WB_G) + (size_t)(b) * 2048 * DM, DM, 2048 / 16, F.bid, F.G, f); } \
            SchedPlain S{XN_, DM, WB_(WB_G) + (size_t)(b) * 2048 * DM, DM, NPMM, 8, F.G, F.bid, 0}; EpiGate E{(bf16_t*)(ws + WS_GS), arg_in(args, 4) + ly * 3 * DM + (b) * DM, RS_(2 * ly)}; \
            pg8::gemm_phase(F.lds, S, E); \
            if (NREP(k) == 2) { GRID_BAR(); pg8::gemm_phase(F.lds, S, E); } \
            SEAM(pb + (k)); \
        }
#define BRANCH_PHASE(k, b, oc) \
        if (((PHMASK >> 10) & 1) && IN(pb + (k))) { \
            PH_BEGIN; \
            { SkGated f{P_, (const bf16_t*)(ws + WS_GS), (b) == 0 ? 1 : 0}; skinny_gemm(F.lds, P_ + (size_t)MROW0 * PW + (oc), PW, WB_(WB_BR) + (size_t)(b) * DM * 1024, 1024, 2048 / 16, F.bid, F.G, f); } \
            SchedPlain S{P_ + (oc), PW, WB_(WB_BR) + (size_t)(b) * DM * 1024, 1024, NPMM, 8, F.G, F.bid, C_MERGED}; EpiGated E{P_, (const bf16_t*)(ws + WS_GS), (b) == 0 ? 1 : 0, ((DBG_BM >> (b)) & 1) ? 1.f : 0.f}; \
            pg8::gemm_phase(F.lds, S, E); \
            if (NREP(k) == 2 && (b) == 0) { GRID_BAR(); pg8::gemm_phase(F.lds, S, E); } \
            SEAM(pb + (k)); \
        }
        GATE_PHASE(10, 0) BRANCH_PHASE(11, 0, C_OA)
        GATE_PHASE(12, 1) BRANCH_PHASE(13, 1, C_OB)
        GATE_PHASE(14, 2) BRANCH_PHASE(15, 2, C_OC)
        if (((PHMASK >> 11) & 1) && IN(pb + 16)) {
            PH_BEGIN;
            { SkRes f{HMETA_, XN_, RS_(2 * ly + 1)}; skinny_gemm(F.lds, P_ + (size_t)MROW0 * PW + C_MERGED, PW, WB_(WB_O), DM, 2048 / 16, F.bid, F.G, f); }
            SchedPlain S{P_ + C_MERGED, PW, WB_(WB_O), DM, NPMM, 8, F.G, F.bid, 0}; EpiRes E{HSRC_TOK(ly), OUT_, HMETA_, DBG_SA, XN_, RS_(2 * ly + 1)};
            pg8::gemm_phase(F.lds, S, E);
            SEAM(pb + 16);
        }
        if (((PHMASK >> 13) & 1) && IN(pb + 17)) {
            PH_BEGIN;
            skinny_swiglu(F.lds, XN_ + (size_t)MROW0 * DM, DM, WB_(WB_F1), DM, P_, RS_(2 * ly + 1), F.bid, F.G);
            SchedPlain S{XN_, DM, WB_(WB_F1), DM, NPMM, 44, F.G, F.bid, 0}; EpiSwiglu E{P_, RS_(2 * ly + 1)};
            pg8::gemm_phase(F.lds, S, E);
            if (NREP(17) == 2) { GRID_BAR(); pg8::gemm_phase(F.lds, S, E); }
            SEAM(pb + 17);
        }
        if (((PHMASK >> 14) & 1) && IN(pb + 18)) {
            PH_BEGIN;
            { SkRes f{HMETA_, ly == 0 ? XN_ : (bf16_t*)nullptr, RS_(2)}; skinny_gemm(F.lds, P_ + (size_t)MROW0 * PW, PW, WB_(WB_F2), DFF, 2048 / 16, F.bid, F.G, f); }
            SchedPlain S{P_, PW, WB_(WB_F2), DFF, NPMM, 8, F.G, F.bid, 0}; EpiRes E{OUT_, OUT_, HMETA_, DBG_SF, ly == 0 ? XN_ : (bf16_t*)nullptr, RS_(2)};
            pg8::gemm_phase(F.lds, S, E);
            SEAM(pb + 18);
        }
    }
#undef IN
#undef SEAM
}

__global__ void diag_fill(float* out, int n, float v) { for (int i = blockIdx.x * blockDim.x + threadIdx.x; i < n; i += gridDim.x * blockDim.x) out[i] = v; }
extern "C" void kernel_launch(void* const* d_in, const int* in_sizes, int n_in, void* d_out, int out_size, void* d_ws, size_t ws_size, hipStream_t stream) {
    static int grid = 0; static float code = 0.f;
    if (grid == 0) {
        int dev = 0, cus = 0;
        if (n_in != 19) { code = 10.f; grid = -1; }
        else if (ws_size < WS_END) { code = 20.f + (float)(ws_size >> 20) * 0.01f; grid = -1; }
        else if (hipGetDevice(&dev) != hipSuccess || hipDeviceGetAttribute(&cus, hipDeviceAttributeMultiprocessorCount, dev) != hipSuccess) { code = 40.f; grid = -1; }
        else if (hipFuncSetAttribute((const void*)mega_fwd, hipFuncAttributeMaxDynamicSharedMemorySize, LDS_BYTES) != hipSuccess) { code = 50.f; grid = -1; }
        else {
            int per_cu = 0;
            if (hipOccupancyMaxActiveBlocksPerMultiprocessor(&per_cu, (const void*)mega_fwd, NWAVES * 64, LDS_BYTES) != hipSuccess || per_cu < 1) { code = 60.f; grid = -1; }
            (void)hipGetLastError();
            if (grid == 0) grid = cus;
        }
    }
    if (grid < 0) { hipLaunchKernelGGL(diag_fill, dim3(1024), dim3(256), 0, stream, (float*)d_out, out_size, code); return; }
    (void)hipMemsetAsync((char*)d_ws + WS_CTL, 0, CTL_BYTES, stream);
    Args a{};
    for (int i = 0; i < 19; ++i) a.in[i] = (const float*)d_in[i];
    a.out = (float*)d_out; a.ws = (unsigned char*)d_ws;
#if MK_ONE_LAUNCH
    a.ph_lo = 0; a.ph_hi = N_PHASES;
    hipLaunchKernelGGL(mega_fwd, dim3(grid), dim3(NWAVES * 64), LDS_BYTES, stream, a);
#else
    for (int p = 0; p < N_PHASES; ++p) { a.ph_lo = p; a.ph_hi = p + 1; hipLaunchKernelGGL(mega_fwd, dim3(grid), dim3(NWAVES * 64), LDS_BYTES, stream, a); }
#endif
    if (hipPeekAtLastError() != hipSuccess) { (void)hipGetLastError(); hipLaunchKernelGGL(diag_fill, dim3(1024), dim3(256), 0, stream, (float*)d_out, out_size, 70.f); }
}
```

```cpp
#include <hip/hip_runtime.h>
#include <cstdio>
#include <cstdint>

#ifndef PHMASK
#define PHMASK 0x7fff
#endif
#ifndef REPMASK
#define REPMASK 0
#endif
#define NREP(k) ((((REPMASK) >> (k)) & 1) ? 2 : 1)
#ifndef DBG_BM
#define DBG_BM 7
#endif
#ifndef DBG_BR
#define DBG_BR 0
#endif
#ifndef DBG_SA
#define DBG_SA 1.0f
#endif
#ifndef DBG_SF
#define DBG_SF 1.0f
#endif
#ifndef MK_ONE_LAUNCH
#define MK_ONE_LAUNCH 1
#endif

#define LAS __attribute__((address_space(3)))
#define GAS __attribute__((address_space(1)))
typedef unsigned short bf16_t;
typedef short bf16x8 __attribute__((ext_vector_type(8)));
typedef float f32x4 __attribute__((ext_vector_type(4)));
typedef float f32x2 __attribute__((ext_vector_type(2)));
typedef unsigned u32x4 __attribute__((ext_vector_type(4)));
typedef unsigned u32x2 __attribute__((ext_vector_type(2)));

constexpr int DM = 2048, NB = 16, SEQ = 2048, NMETA = 16, MBLK = 256;
constexpr int R = MBLK + NB * SEQ;
constexpr int NPM = R / 256;
constexpr int NPMM = NPM - 1;
constexpr int MROW0 = MBLK - NMETA;
constexpr int NTOK = NB * SEQ;
constexpr int DFF = 5632;
constexpr int PW = 8448;
constexpr int C_CQ = 0, C_CKV = 512, C_KPE = 1024, C_IK = 1088, C_IW = 1152, C_DQ = 1280, C_DK = 2304, C_DV = 3328, C_IQ = 4352,
              C_FQ = 5376, C_FK = 6400, C_FV = 7424;
constexpr int C_KVRAW = 1280, C_QRAW = 3328, C_KPEH = 4864;
constexpr int C_OA = 0, C_OB = C_DQ, C_OC = C_FQ, C_MERGED = 2304;
constexpr int BMW = 66;
constexpr float EPS = 1e-6f;
constexpr float LOG2E = 1.4426950408889634f;
constexpr float C2_128 = 0.08838834764831845f * LOG2E;
constexpr float C2_192 = 0.07216878364870323f * LOG2E;
constexpr int D_IN = 14480;

constexpr size_t MiB = 1u << 20;
constexpr size_t WS_CTL = 0, CTL_BYTES = 1 * MiB;
constexpr size_t WS_RSTD = 1 * MiB;
constexpr size_t WS_HMETA = 2 * MiB;
constexpr size_t WS_BM = 4 * MiB;
constexpr size_t WS_WB = 16 * MiB;
constexpr size_t WB_IN = 0, WB_G = WB_IN + (size_t)8448 * 2048 * 2, WB_QUP = WB_G + (size_t)6144 * 2048 * 2, WB_KVUP = WB_QUP + (size_t)1536 * 512 * 2,
                 WB_BR = WB_KVUP + (size_t)2048 * 512 * 2, WB_O = WB_BR + (size_t)3 * 2048 * 1024 * 2, WB_F1 = WB_O + (size_t)2048 * 2048 * 2,
                 WB_F2 = WB_F1 + (size_t)11264 * 2048 * 2, WB_END = WB_F2 + (size_t)2048 * 5632 * 2;
constexpr size_t WS_XN = 164 * MiB;
constexpr size_t WS_P = 294 * MiB;
constexpr size_t WS_GS = 828 * MiB;
constexpr size_t WS_END = 960 * MiB;
static_assert(WS_GS + (size_t)R * 2048 * 2 <= WS_END && WS_WB + WB_END <= WS_XN && WS_XN + (size_t)R * 2048 * 2 <= WS_P && WS_P + (size_t)R * PW * 2 <= WS_GS, "ws map");
constexpr int CW_BAR = 4096, CW_Q = 16384;
constexpr size_t WS_RS = 256 * 1024;

__device__ __forceinline__ float bf2f(bf16_t v) { return __uint_as_float((unsigned)v << 16); }
__device__ __forceinline__ unsigned f2bf(float f) { unsigned u = __float_as_uint(f); return (u + 0x7fffu + ((u >> 16) & 1u)) >> 16; }
__device__ __forceinline__ unsigned pk2(float lo, float hi) { return f2bf(lo) | (f2bf(hi) << 16); }
typedef __bf16 bf16x2_t __attribute__((ext_vector_type(2)));
__device__ __forceinline__ unsigned cvt_pk_bf16(float lo, float hi) { f32x2 v = {lo, hi}; bf16x2_t b = __builtin_convertvector(v, bf16x2_t); return __builtin_bit_cast(unsigned, b); }
__device__ __forceinline__ float wave_sum(float v) {
#pragma unroll
    for (int o = 1; o < 64; o <<= 1) v += __shfl_xor(v, o);
    return v;
}
__device__ __forceinline__ float wave_max(float v) {
#pragma unroll
    for (int o = 1; o < 64; o <<= 1) v = fmaxf(v, __shfl_xor(v, o));
    return v;
}
#define LDS_WAIT() asm volatile("s_waitcnt lgkmcnt(0)" ::: "memory")
#define VM_WAIT() asm volatile("s_waitcnt vmcnt(0)" ::: "memory")
__device__ __forceinline__ int row_pos(int r) { return r < MBLK ? (r >= MBLK - NMETA ? r - (MBLK - NMETA) : 0) : NMETA + ((r - MBLK) & (SEQ - 1)); }
__device__ __forceinline__ void rope_cs(int pos, int i, float two_over_d, float& c, float& s) {
    const float inv = __builtin_amdgcn_exp2f(-(float)i * two_over_d * 13.287712379549449f);
    float rev = (float)pos * inv * 0.15915494309189535f;
    rev -= floorf(rev);
    s = __builtin_amdgcn_sinf(rev); c = __builtin_amdgcn_cosf(rev);
}

namespace pg8 {
constexpr int BM = 256, BK = 64, HALF = 128, HTB = HALF * BK * 2, STAGE_BYTES = 8 * HTB;
__device__ __forceinline__ int lds_byte(int r, int c) { const int st = (r >> 4) * 2 + (c >> 5), rr = r & 15, cc = c & 31, ob = rr * 64 + cc * 2; return st * 1024 + (ob ^ (((ob >> 9) & 1) << 5)); }
__device__ __forceinline__ void stage_rc(int b, int& R_, int& C_) { const int st = b / 1024, sb = b % 1024, swz = sb ^ (((sb >> 9) & 1) << 5); R_ = (st >> 1) * 16 + swz / 64; C_ = (st & 1) * 32 + (swz % 64) / 2; }
__device__ __forceinline__ int perm32(int rho) { const int n = rho >> 4, i = rho & 15; return 8 * (i >> 2) + 4 * n + (i & 3); }

struct Unit { const char* A; const char* B; unsigned lda2, ldb2; int nt, pm, pn, kind, ocol; };

__device__ __forceinline__ void tile_of(int L, int nM, int nN, int& pm, int& pn) {
    const int nwg = nM * nN; int wgid = L;
    { const int q = nwg / 8, r = nwg % 8, xcd = wgid % 8, off = wgid / 8; wgid = (xcd < r ? xcd * (q + 1) : r * (q + 1) + (xcd - r) * q) + off; }
    const int nig = 8 * nN, gid = wgid / nig, fm = gid * 8, gsz = (nM - fm) < 8 ? (nM - fm) : 8;
    pm = fm + ((wgid % nig) % gsz); pn = (wgid % nig) / gsz;
}

template <class Epi, class Sched>
__device__ __forceinline__ void gemm_phase(LAS unsigned char* lds, const Sched& S, const Epi& E) {
    int tid = threadIdx.x; asm volatile("" : "+v"(tid));
    const int wid = __builtin_amdgcn_readfirstlane(tid >> 6), lane = tid & 63, wr = wid >> 2, wc = wid & 3, fr = lane & 15, fq = lane >> 4;
    unsigned rA[2], rB[2], cc[2];
#pragma unroll
    for (int i = 0; i < 2; ++i) { int R_, C_; stage_rc(tid * 16 + i * 8192, R_, C_); rA[i] = (unsigned)R_; rB[i] = (unsigned)(Epi::PERM ? ((R_ & ~31) + perm32(R_ & 31)) : R_); cc[i] = (unsigned)C_ * 2u; }
    const size_t kstep = (size_t)(BK * 2);
    const unsigned ldsw = (unsigned)wid * 1024u;
    const int aoff = lds_byte(wr * 64 + fr, fq * 8), boff = lds_byte(wc * 32 + fr, fq * 8);
#define PG8_SA(b, h) (((b) * 2 + (h)) * HTB)
#define PG8_SB(b, h) ((4 + (b) * 2 + (h)) * HTB)
#define PG8_STAGE(bufoff, gbase, rr, ld2) do { _Pragma("unroll") for (int _i = 0; _i < 2; ++_i) \
        __builtin_amdgcn_global_load_lds((const unsigned*)((const char*)(gbase) + ((rr)[_i] * (ld2) + cc[_i])), (LAS unsigned*)(lds + (bufoff) + ldsw + _i * 8192), 16, 0, 0); } while (0)
#define PG8_LDA(dst, b, h) do { _Pragma("unroll") for (int m = 0; m < 4; ++m) _Pragma("unroll") for (int k = 0; k < 2; ++k) dst[m][k] = *(const LAS bf16x8*)(lds + PG8_SA(b, h) + aoff + m * 2048 + k * 1024); } while (0)
#define PG8_LDB(dst, b, h) do { _Pragma("unroll") for (int n = 0; n < 2; ++n) _Pragma("unroll") for (int k = 0; k < 2; ++k) dst[n][k] = *(const LAS bf16x8*)(lds + PG8_SB(b, h) + boff + n * 2048 + k * 1024); } while (0)
#define PG8_MMA(ai, bj, At, Bt) do { __builtin_amdgcn_s_setprio(1); _Pragma("unroll") for (int m = 0; m < 4; ++m) _Pragma("unroll") for (int n = 0; n < 2; ++n) _Pragma("unroll") for (int k = 0; k < 2; ++k) \
        acc[ai][bj][m][n] = __builtin_amdgcn_mfma_f32_16x16x32_bf16(Bt[n][k], At[m][k], acc[ai][bj][m][n], 0, 0, 0); __builtin_amdgcn_s_setprio(0); } while (0)
#define PG8_WAIT_V(n) asm volatile("s_waitcnt vmcnt(" #n ")" ::: "memory")
#define PG8_WAIT_L(n) asm volatile("s_waitcnt lgkmcnt(" #n ")" ::: "memory")
#define PG8_BAR __builtin_amdgcn_s_barrier()
#define PG8_SCHED __builtin_amdgcn_sched_barrier(0)
    Unit cur, nxt; int ui = 0;
    if (!S.next(0, cur)) return;
    float zf = 0.f; asm volatile("" : "+v"(zf));
    f32x4 acc[2][2][4][2];
#pragma unroll
    for (int a = 0; a < 2; ++a)
#pragma unroll
        for (int b = 0; b < 2; ++b)
#pragma unroll
            for (int m = 0; m < 4; ++m)
#pragma unroll
                for (int n = 0; n < 2; ++n) acc[a][b][m][n] = (f32x4){zf, zf, zf, zf};
    bf16x8 At[4][2], B0[2][2], B1[2][2];
    const char* cA = cur.A; const char* cB = cur.B;
    unsigned lA = cur.lda2, lB = cur.ldb2;
    size_t hA = (size_t)HALF * lA, hB = (size_t)HALF * lB;
    PG8_STAGE(PG8_SB(0, 0), cB, rB, lB); PG8_STAGE(PG8_SB(0, 1), cB + hB, rB, lB); PG8_STAGE(PG8_SA(0, 0), cA, rA, lA); PG8_STAGE(PG8_SA(0, 1), cA + hA, rA, lA);
    if (wr == 1) PG8_BAR;
    PG8_WAIT_V(2); PG8_BAR;
    PG8_STAGE(PG8_SB(1, 0), cB + kstep, rB, lB); PG8_STAGE(PG8_SA(1, 0), cA + kstep, rA, lA); PG8_STAGE(PG8_SB(1, 1), cB + hB + kstep, rB, lB);
    PG8_WAIT_V(6); PG8_BAR;
    for (;;) {
        const bool has_next = S.next(ui + 1, nxt);
        if (!has_next) nxt = cur;
        const char* nA = nxt.A; const char* nB = nxt.B;
        const unsigned lAn = nxt.lda2, lBn = nxt.ldb2;
        const size_t hAn = (size_t)HALF * lAn, hBn = (size_t)HALF * lBn;
        const int nt = cur.nt;
        for (int t = 0; t < nt; t += 2) {
            const bool last = (t == nt - 2);
            const char* a1 = cA + (size_t)(t + 1) * kstep;
            const char* a2 = last ? nA : cA + (size_t)(t + 2) * kstep; const char* b2 = last ? nB : cB + (size_t)(t + 2) * kstep;
            const char* a3 = a2 + kstep; const char* b3 = b2 + kstep;
            const size_t hA2 = last ? hAn : hA, hB2 = last ? hBn : hB;
            const unsigned lA2 = last ? lAn : lA, lB2 = last ? lBn : lB;
            PG8_LDB(B0, 0, 0); PG8_LDB(B1, 0, 1); PG8_SCHED; PG8_LDA(At, 0, 0); PG8_STAGE(PG8_SA(1, 1), a1 + hA, rA, lA);
            PG8_WAIT_V(8); PG8_WAIT_L(0); PG8_BAR; PG8_MMA(0, 0, At, B0); PG8_MMA(0, 1, At, B1); PG8_BAR; PG8_SCHED;
            PG8_LDA(At, 0, 1); PG8_STAGE(PG8_SB(0, 0), b2, rB, lB2); PG8_STAGE(PG8_SB(0, 1), b2 + hB2, rB, lB2); PG8_STAGE(PG8_SA(0, 0), a2, rA, lA2);
            PG8_WAIT_V(8); PG8_WAIT_L(0); PG8_BAR; PG8_MMA(1, 0, At, B0); PG8_MMA(1, 1, At, B1); PG8_BAR; PG8_SCHED;
            PG8_LDB(B0, 1, 0); PG8_LDB(B1, 1, 1); PG8_SCHED; PG8_LDA(At, 1, 0); PG8_STAGE(PG8_SA(0, 1), a2 + hA2, rA, lA2);
            PG8_WAIT_V(8); PG8_WAIT_L(0); PG8_BAR; PG8_MMA(0, 0, At, B0); PG8_MMA(0, 1, At, B1); PG8_BAR; PG8_SCHED;
            PG8_LDA(At, 1, 1); PG8_STAGE(PG8_SB(1, 0), b3, rB, lB2); PG8_STAGE(PG8_SB(1, 1), b3 + hB2, rB, lB2); PG8_STAGE(PG8_SA(1, 0), a3, rA, lA2);
            PG8_WAIT_V(8); PG8_WAIT_L(0); PG8_BAR; PG8_MMA(1, 0, At, B0); PG8_MMA(1, 1, At, B1); PG8_BAR; PG8_SCHED;
        }
        if (wr == 0) PG8_BAR;
        E(acc, cur, wr, wc, fr, fq);
#pragma unroll
        for (int a = 0; a < 2; ++a)
#pragma unroll
            for (int b = 0; b < 2; ++b)
#pragma unroll
                for (int m = 0; m < 4; ++m)
#pragma unroll
                    for (int n = 0; n < 2; ++n) acc[a][b][m][n] = (f32x4){zf, zf, zf, zf};
        if (!has_next) break;
        cur = nxt; cA = nA; cB = nB; hA = hAn; hB = hBn; lA = lAn; lB = lBn; ++ui;
        if (wr == 1) PG8_BAR;
    }
    PG8_WAIT_V(0);
    PG8_BAR;
#undef PG8_SA
#undef PG8_SB
#undef PG8_STAGE
#undef PG8_LDA
#undef PG8_LDB
#undef PG8_MMA
#undef PG8_WAIT_V
#undef PG8_WAIT_L
#undef PG8_BAR
#undef PG8_SCHED
}
}
using pg8::Unit;

struct SchedPlain {
    const bf16_t* A; int lda; const bf16_t* B; int K; int nM, nN, G, c, ocol0;
    __device__ __forceinline__ bool next(int i, Unit& u) const {
        const int L = i * G + c; if (L >= nM * nN) return false;
        int pm, pn; pg8::tile_of(L, nM, nN, pm, pn); pm += 1;
        u.pm = pm; u.pn = pn; u.kind = 0; u.ocol = ocol0 + 256 * pn; u.nt = K / 64; u.lda2 = (unsigned)lda * 2u; u.ldb2 = (unsigned)K * 2u;
        u.A = (const char*)(A + (size_t)pm * 256 * lda); u.B = (const char*)(B + (size_t)pn * 256 * K); return true;
    }
};
struct SchedMlaUp {
    const bf16_t* P; const bf16_t* Wq; const bf16_t* Wkv; int G, c;
    __device__ __forceinline__ bool next(int i, Unit& u) const {
        const int L = i * G + c; if (L >= NPMM * 14) return false;
        int pm, pn; pg8::tile_of(L, NPMM, 14, pm, pn); pm += 1;
        u.pm = pm; u.pn = pn; u.kind = 0; u.nt = 8; u.lda2 = PW * 2u; u.ldb2 = 512 * 2u;
        if (pn < 6) { u.A = (const char*)(P + (size_t)pm * 256 * PW + C_CQ); u.B = (const char*)(Wq + (size_t)pn * 256 * 512); u.ocol = C_QRAW + 256 * pn; }
        else { u.A = (const char*)(P + (size_t)pm * 256 * PW + C_CKV); u.B = (const char*)(Wkv + (size_t)(pn - 6) * 256 * 512); u.ocol = C_KVRAW + 256 * (pn - 6); }
        return true;
    }
};
struct EpiP {
    static constexpr bool PERM = true;
    bf16_t* P; const float* rs;
    __device__ __forceinline__ void operator()(const f32x4 (&acc)[2][2][4][2], const Unit& u, int wr, int wc, int fr, int fq) const {
        asm volatile("" : "+v"(fr), "+v"(fq));
        const int row0 = u.pm * 256 + wr * 64 + fr, col0 = u.ocol + wc * 32 + 8 * fq;
#pragma unroll
        for (int ai = 0; ai < 2; ++ai)
#pragma unroll
            for (int m = 0; m < 4; ++m) { bf16_t* rowp = P + (size_t)(row0 + ai * 128 + m * 16) * PW + col0;
                const float sc = rs ? __builtin_amdgcn_rsqf(rs[row0 + ai * 128 + m * 16] * (1.f / DM) + EPS) : 1.f;
#pragma unroll
                for (int bj = 0; bj < 2; ++bj) { const f32x4 v0 = acc[ai][bj][m][0] * sc, v1 = acc[ai][bj][m][1] * sc;
                    u32x4 w; w.x = cvt_pk_bf16(v0[0], v0[1]); w.y = cvt_pk_bf16(v0[2], v0[3]); w.z = cvt_pk_bf16(v1[0], v1[1]); w.w = cvt_pk_bf16(v1[2], v1[3]);
                    *(u32x4*)(rowp + bj * 128) = w; } }
    }
};
struct EpiGate {
    static constexpr bool PERM = true;
    bf16_t* G; const float* bias; const float* rs;
    __device__ __forceinline__ void operator()(const f32x4 (&acc)[2][2][4][2], const Unit& u, int wr, int wc, int fr, int fq) const {
        asm volatile("" : "+v"(fr), "+v"(fq));
        const int row0 = u.pm * 256 + wr * 64 + fr, col0 = u.pn * 256 + wc * 32 + 8 * fq;
        float rsc[2][4];
#pragma unroll
        for (int ai = 0; ai < 2; ++ai)
#pragma unroll
            for (int m = 0; m < 4; ++m) rsc[ai][m] = __builtin_amdgcn_rsqf(rs[row0 + ai * 128 + m * 16] * (1.f / DM) + EPS);
#pragma unroll
        for (int bj = 0; bj < 2; ++bj) { const f32x4 bv0 = *(const f32x4*)(bias + col0 + bj * 128), bv1 = *(const f32x4*)(bias + col0 + bj * 128 + 4);
#pragma unroll
            for (int ai = 0; ai < 2; ++ai)
#pragma unroll
                for (int m = 0; m < 4; ++m) { bf16_t* rowp = G + (size_t)(row0 + ai * 128 + m * 16) * 2048 + col0; f32x4 v0 = acc[ai][bj][m][0] * rsc[ai][m] + bv0, v1 = acc[ai][bj][m][1] * rsc[ai][m] + bv1;
#pragma unroll
                    for (int e = 0; e < 4; ++e) { v0[e] = __builtin_amdgcn_rcpf(1.f + __builtin_amdgcn_exp2f(-v0[e] * LOG2E)); v1[e] = __builtin_amdgcn_rcpf(1.f + __builtin_amdgcn_exp2f(-v1[e] * LOG2E)); }
                    u32x4 w; w.x = cvt_pk_bf16(v0[0], v0[1]); w.y = cvt_pk_bf16(v0[2], v0[3]); w.z = cvt_pk_bf16(v1[0], v1[1]); w.w = cvt_pk_bf16(v1[2], v1[3]);
                    *(u32x4*)(rowp + bj * 128) = w; } }
    }
};
struct EpiGated {
    static constexpr bool PERM = true;
    bf16_t* P; const bf16_t* G; int first; float sc;
    __device__ __forceinline__ void operator()(const f32x4 (&acc)[2][2][4][2], const Unit& u, int wr, int wc, int fr, int fq) const {
        asm volatile("" : "+v"(fr), "+v"(fq));
        const int row0 = u.pm * 256 + wr * 64 + fr, lcol0 = u.pn * 256 + wc * 32 + 8 * fq, col0 = u.ocol + wc * 32 + 8 * fq;
        unsigned zu = 0u; asm volatile("" : "+v"(zu));
#pragma unroll
        for (int ai = 0; ai < 2; ++ai)
#pragma unroll
            for (int m = 0; m < 4; ++m) { bf16_t* rowp = P + (size_t)(row0 + ai * 128 + m * 16) * PW + col0; const bf16_t* gp = G + (size_t)(row0 + ai * 128 + m * 16) * 2048 + lcol0;
#pragma unroll
                for (int bj = 0; bj < 2; ++bj) { u32x4 g = *(const u32x4*)(gp + bj * 128); if (DBG_BR == 1) g = (u32x4){0x3f803f80u, 0x3f803f80u, 0x3f803f80u, 0x3f803f80u};
                    u32x4 pv = (u32x4){zu, zu, zu, zu}; if (!first) pv = *(const u32x4*)(rowp + bj * 128);
                    const f32x4 v0 = acc[ai][bj][m][0] * sc, v1 = acc[ai][bj][m][1] * sc;
                    float o[8];
                    o[0] = __uint_as_float(pv.x << 16) + __uint_as_float(g.x << 16) * v0[0]; o[1] = __uint_as_float(pv.x & 0xffff0000u) + __uint_as_float(g.x & 0xffff0000u) * v0[1];
                    o[2] = __uint_as_float(pv.y << 16) + __uint_as_float(g.y << 16) * v0[2]; o[3] = __uint_as_float(pv.y & 0xffff0000u) + __uint_as_float(g.y & 0xffff0000u) * v0[3];
                    o[4] = __uint_as_float(pv.z << 16) + __uint_as_float(g.z << 16) * v1[0]; o[5] = __uint_as_float(pv.z & 0xffff0000u) + __uint_as_float(g.z & 0xffff0000u) * v1[1];
                    o[6] = __uint_as_float(pv.w << 16) + __uint_as_float(g.w << 16) * v1[2]; o[7] = __uint_as_float(pv.w & 0xffff0000u) + __uint_as_float(g.w & 0xffff0000u) * v1[3];
                    u32x4 w; w.x = cvt_pk_bf16(o[0], o[1]); w.y = cvt_pk_bf16(o[2], o[3]); w.z = cvt_pk_bf16(o[4], o[5]); w.w = cvt_pk_bf16(o[6], o[7]);
                    *(u32x4*)(rowp + bj * 128) = w; }
                asm volatile("" ::: "memory"); }
    }
};
struct EpiRes {
    static constexpr bool PERM = false;
    const float* base_tok; float* out_tok; float* hmeta; float dbg; bf16_t* hb; float* rs;
    __device__ __forceinline__ void operator()(const f32x4 (&acc)[2][2][4][2], const Unit& u, int wr, int wc, int fr, int fq) const {
        asm volatile("" : "+v"(fr), "+v"(fq));
        const float* bp; float* op;
        if (u.pm == 0) { bp = hmeta; op = hmeta; } else { bp = base_tok + (size_t)(u.pm - 1) * 256 * DM; op = out_tok + (size_t)(u.pm - 1) * 256 * DM; }
        const int lrow0 = wr * 64 + fr, col0 = u.pn * 256 + wc * 32 + 4 * fq;
#pragma unroll
        for (int ai = 0; ai < 2; ++ai)
#pragma unroll
            for (int m = 0; m < 4; ++m) { const size_t off = (size_t)(lrow0 + ai * 128 + m * 16) * DM + col0;
                const int grow = u.pm * 256 + lrow0 + ai * 128 + m * 16; float ss = 0.f;
#pragma unroll
                for (int bj = 0; bj < 2; ++bj)
#pragma unroll
                    for (int n = 0; n < 2; ++n) { const f32x4 bs = *(const f32x4*)(bp + off + bj * 128 + n * 16); const f32x4 hv = bs + acc[ai][bj][m][n] * dbg; *(f32x4*)(op + off + bj * 128 + n * 16) = hv;
                        if (hb) { ss += (hv[0] * hv[0] + hv[1] * hv[1]) + (hv[2] * hv[2] + hv[3] * hv[3]); u32x2 w; w.x = cvt_pk_bf16(hv[0], hv[1]); w.y = cvt_pk_bf16(hv[2], hv[3]); *(u32x2*)(hb + (size_t)grow * DM + col0 + bj * 128 + n * 16) = w; } }
                if (hb) { ss += __shfl_xor(ss, 16); ss += __shfl_xor(ss, 32); if (fq == 0) (void)__hip_atomic_fetch_add(rs + grow, ss, __ATOMIC_RELAXED, __HIP_MEMORY_SCOPE_AGENT); }
                asm volatile("" ::: "memory"); }
    }
};
struct EpiSwiglu {
    static constexpr bool PERM = true;
    bf16_t* P; const float* rs;
    __device__ __forceinline__ void operator()(const f32x4 (&acc)[2][2][4][2], const Unit& u, int wr, int wc, int fr, int fq) const {
        asm volatile("" : "+v"(fr), "+v"(fq));
        const int row0 = u.pm * 256 + wr * 64 + fr, col0 = u.pn * 128 + wc * 32 + 8 * fq;
#pragma unroll
        for (int ai = 0; ai < 2; ++ai)
#pragma unroll
            for (int m = 0; m < 4; ++m) { bf16_t* rowp = P + (size_t)(row0 + ai * 128 + m * 16) * PW + col0;
                const float sc = __builtin_amdgcn_rsqf(rs[row0 + ai * 128 + m * 16] * (1.f / DM) + EPS);
                float o[8];
#pragma unroll
                for (int n = 0; n < 2; ++n)
#pragma unroll
                    for (int e = 0; e < 4; ++e) { const float g = acc[ai][0][m][n][e] * sc, up = acc[ai][1][m][n][e] * sc; o[n * 4 + e] = g * __builtin_amdgcn_rcpf(1.f + __builtin_amdgcn_exp2f(-g * LOG2E)) * up; }
                u32x4 w; w.x = cvt_pk_bf16(o[0], o[1]); w.y = cvt_pk_bf16(o[2], o[3]); w.z = cvt_pk_bf16(o[4], o[5]); w.w = cvt_pk_bf16(o[6], o[7]);
                *(u32x4*)rowp = w; }
    }
};

struct SkP { bf16_t* P; int ocol; const float* rs; __device__ __forceinline__ void operator()(int r, int c, float v) const { if (rs) v *= __builtin_amdgcn_rsqf(rs[MROW0 + r] * (1.f / DM) + EPS); P[(size_t)(MROW0 + r) * PW + ocol + c] = (bf16_t)f2bf(v); } };
struct SkGate { bf16_t* G; const float* bias; const float* rs; __device__ __forceinline__ void operator()(int r, int c, float v) const { v *= __builtin_amdgcn_rsqf(rs[MROW0 + r] * (1.f / DM) + EPS); G[(size_t)(MROW0 + r) * 2048 + c] = (bf16_t)f2bf(__builtin_amdgcn_rcpf(1.f + __builtin_amdgcn_exp2f(-(v + bias[c]) * LOG2E))); } };
struct SkGated { bf16_t* P; const bf16_t* G; int first; __device__ __forceinline__ void operator()(int r, int c, float v) const { bf16_t* p = P + (size_t)(MROW0 + r) * PW + C_MERGED + c; const float pv = first ? 0.f : bf2f(*p); *p = (bf16_t)f2bf(pv + bf2f(G[(size_t)(MROW0 + r) * 2048 + c]) * v); } };
struct SkRes { float* hmeta; bf16_t* hb; float* rs;
    __device__ __forceinline__ void operator()(int r, int c, float v) const { float* p = hmeta + (size_t)(MROW0 + r) * DM + c; const float hv = *p + v; *p = hv;
        if (hb) { hb[(size_t)(MROW0 + r) * DM + c] = (bf16_t)f2bf(hv); float ss = hv * hv; ss += __shfl_xor(ss, 1); ss += __shfl_xor(ss, 2); ss += __shfl_xor(ss, 4); ss += __shfl_xor(ss, 8);
            if ((threadIdx.x & 15) == 0) (void)__hip_atomic_fetch_add(rs + MROW0 + r, ss, __ATOMIC_RELAXED, __HIP_MEMORY_SCOPE_AGENT); } } };
template <class Fn>
__device__ __forceinline__ void skinny_gemm(LAS unsigned char* lds, const bf16_t* A, int lda, const bf16_t* Bt, int K, int ntask, int bid, int G, const Fn& f) {
    int tid = threadIdx.x; asm volatile("" : "+v"(tid));
    const int wid = __builtin_amdgcn_readfirstlane(tid >> 6), lane = tid & 63, l15 = lane & 15, kq = lane >> 4;
    LAS f32x4* red = (LAS f32x4*)lds;
    const int kw = K / 8;
    for (int task = bid; task < ntask; task += G) {
        const bf16_t* ap = A + (size_t)l15 * lda + wid * kw + kq * 8;
        const bf16_t* bp = Bt + (size_t)(task * 16 + l15) * K + wid * kw + kq * 8;
        float z = 0.f; asm volatile("" : "+v"(z));
        f32x4 acc = (f32x4){z, z, z, z};
        for (int k0 = 0; k0 < kw; k0 += 256) {
            bf16x8 fa[8], fb[8];
#pragma unroll
            for (int i = 0; i < 8; ++i) { const int k = (k0 + 32 * i < kw) ? k0 + 32 * i : 0; fa[i] = *(const bf16x8*)(ap + k); fb[i] = *(const bf16x8*)(bp + k); }
#pragma unroll
            for (int i = 0; i < 8; ++i) if (k0 + 32 * i < kw) acc = __builtin_amdgcn_mfma_f32_16x16x32_bf16(fa[i], fb[i], acc, 0, 0, 0);
        }
        red[wid * 64 + lane] = acc;
        LDS_WAIT(); __syncthreads();
        if (wid == 0) {
            f32x4 s = red[lane];
#pragma unroll
            for (int w = 1; w < 8; ++w) s += red[w * 64 + lane];
#pragma unroll
            for (int r = 0; r < 4; ++r) f(kq * 4 + r, task * 16 + l15, s[r]);
        }
        __syncthreads();
    }
}
__device__ __forceinline__ void skinny_swiglu(LAS unsigned char* lds, const bf16_t* A, int lda, const bf16_t* Bt, int K, bf16_t* P, const float* rs, int bid, int G) {
    int tid = threadIdx.x; asm volatile("" : "+v"(tid));
    const int wid = __builtin_amdgcn_readfirstlane(tid >> 6), lane = tid & 63, l15 = lane & 15, kq = lane >> 4;
    LAS f32x4* red = (LAS f32x4*)lds;
    const int kw = K / 8;
    for (int task = bid; task < DFF / 16; task += G) {
        const int c0 = task * 16, brow = (c0 >> 7) * 256 + (c0 & 127) + l15;
        const bf16_t* ap = A + (size_t)l15 * lda + wid * kw + kq * 8;
        const bf16_t* bg = Bt + (size_t)brow * K + wid * kw + kq * 8; const bf16_t* bu = bg + (size_t)128 * K;
        float z = 0.f; asm volatile("" : "+v"(z));
        f32x4 ag = (f32x4){z, z, z, z}, au = ag;
        {
            bf16x8 fa[8], fg[8], fu[8];
#pragma unroll
            for (int i = 0; i < 8; ++i) { fa[i] = *(const bf16x8*)(ap + 32 * i); fg[i] = *(const bf16x8*)(bg + 32 * i); fu[i] = *(const bf16x8*)(bu + 32 * i); }
#pragma unroll
            for (int i = 0; i < 8; ++i) { ag = __builtin_amdgcn_mfma_f32_16x16x32_bf16(fa[i], fg[i], ag, 0, 0, 0); au = __builtin_amdgcn_mfma_f32_16x16x32_bf16(fa[i], fu[i], au, 0, 0, 0); }
        }
        red[wid * 64 + lane] = ag; red[512 + wid * 64 + lane] = au;
        LDS_WAIT(); __syncthreads();
        if (wid == 0) {
            f32x4 sg = red[lane], su = red[512 + lane];
#pragma unroll
            for (int w = 1; w < 8; ++w) { sg += red[w * 64 + lane]; su += red[512 + w * 64 + lane]; }
#pragma unroll
            for (int r = 0; r < 4; ++r) { const float sc = __builtin_amdgcn_rsqf(rs[MROW0 + kq * 4 + r] * (1.f / DM) + EPS); const float g = sg[r] * sc; su[r] *= sc; P[(size_t)(MROW0 + kq * 4 + r) * PW + c0 + l15] = (bf16_t)f2bf(g * __builtin_amdgcn_rcpf(1.f + __builtin_amdgcn_exp2f(-g * LOG2E)) * su[r]); }
        }
        __syncthreads();
    }
}

#define XB_TMO      128
#define XB_XCNT(j)  (256  + 64 * (j))
#define XB_XSUB(j)  (1280 + 64 * (j))
#define XB_XGEN(j)  (2304 + 64 * (j))
#define XB_TOP      3328
#define XB_TOPGEN   3392
#define XCD_BAR_WORDS 3456
#define XB_SPIN_CAP (1u << 18)
__device__ __forceinline__ unsigned xb_ld(unsigned* p)              { return __hip_atomic_load(p, __ATOMIC_RELAXED, __HIP_MEMORY_SCOPE_AGENT); }
__device__ __forceinline__ unsigned xb_add(unsigned* p, unsigned v) { return __hip_atomic_fetch_add(p, v, __ATOMIC_RELAXED, __HIP_MEMORY_SCOPE_AGENT); }
__device__ __forceinline__ unsigned xb_xcc_id() { return (unsigned)__builtin_amdgcn_s_getreg((3 << 11) | 20) & 0xFu; }
#define XB_SPIN(cond, bar) do { unsigned _sp = 0; while (cond) { __builtin_amdgcn_s_sleep(1); \
    if ((++_sp & 255u) == 0u) { if (xb_ld(&(bar)[XB_TMO])) break; if (_sp > XB_SPIN_CAP) { atomicAdd(&(bar)[XB_TMO], 1u); break; } } } } while (0)
struct XcdBarrier { unsigned* bar; unsigned x; volatile LAS unsigned* st; };
__device__ __forceinline__ XcdBarrier xcd_barrier_post(unsigned* bar, volatile LAS unsigned* st) {
    XcdBarrier b; b.bar = bar; b.x = xb_xcc_id(); b.st = st;
    if (threadIdx.x == 0) (void)xb_add(&bar[XB_XCNT(b.x)], 1u);
    return b;
}
__device__ __forceinline__ void xcd_barrier_complete(unsigned* bar, unsigned x, unsigned& nloc, unsigned& nx) {
    const unsigned G = gridDim.x * gridDim.y * gridDim.z;
    unsigned sum, cnt, mine, sp = 0u;
    for (;;) {
        sum = 0u; cnt = 0u; mine = 0u;
#pragma unroll
        for (unsigned j = 0; j < 16; ++j) { const unsigned c = xb_ld(&bar[XB_XCNT(j)]); sum += c; cnt += (c > 0u) ? 1u : 0u; mine = (j == x) ? c : mine; }
        if (sum == G) break;
        __builtin_amdgcn_s_sleep(1);
        if ((++sp & 255u) == 0u) { if (xb_ld(&bar[XB_TMO])) break; if (sp > XB_SPIN_CAP) { atomicAdd(&bar[XB_TMO], 1u); break; } }
    }
    nloc = mine > 0u ? mine : 1u; nx = cnt > 0u ? cnt : 1u;
}
__device__ __forceinline__ void xcd_barrier(const XcdBarrier& b) {
    asm volatile("s_waitcnt vmcnt(0)" ::: "memory");
    __syncthreads();
    if (threadIdx.x == 0) {
        unsigned* bar = b.bar;
        __builtin_amdgcn_s_waitcnt(0);
        unsigned nloc = b.st[0], nx = b.st[1];
        if (nloc == 0u) { xcd_barrier_complete(bar, b.x, nloc, nx); b.st[0] = nloc; b.st[1] = nx; }
        const unsigned old = xb_add(&bar[XB_XSUB(b.x)], 1u);
        const unsigned gen = old / nloc;
        if (old + 1u == (gen + 1u) * nloc) {
            __builtin_amdgcn_fence(__ATOMIC_RELEASE, "agent");
            asm volatile("s_waitcnt vmcnt(0)" ::: "memory");
            const unsigned og = xb_add(&bar[XB_TOP], 1u);
            const unsigned tg = og / nx;
            if (og + 1u == (tg + 1u) * nx) xb_add(&bar[XB_TOPGEN], 1u);
            else XB_SPIN(xb_ld(&bar[XB_TOPGEN]) == tg, bar);
            __builtin_amdgcn_fence(__ATOMIC_ACQUIRE, "agent");
            xb_add(&bar[XB_XGEN(b.x)], 1u);
            asm volatile("s_waitcnt vmcnt(0)" ::: "memory");
        } else {
            XB_SPIN(xb_ld(&bar[XB_XGEN(b.x)]) == gen, bar);
            __builtin_amdgcn_fence(__ATOMIC_ACQUIRE, "agent");
            asm volatile("s_waitcnt vmcnt(0)" ::: "memory");
        }
    }
    __syncthreads();
}

constexpr int NWAVES = 8;
constexpr int RING_BYTES = 131072, LDS_BYTES = 147456, LDSCTL_OFF = LDS_BYTES - 512;
struct Args {
    const float* in[19]; float* out; unsigned char* ws; int ph_lo, ph_hi;
};
struct Ctx {
    LAS unsigned char* lds; int tid, lane, wave, gw, ngw, G, bid;
};

template <int MAP> __device__ __forceinline__ int wmap(int n, float& sc) {
    sc = 1.f;
    if (MAP == 0) return n;
    if (MAP == 1) {
        if (n < 1088) return n;
        if (n < 4160) return 1280 + (n - 1088);
        if (n < 5184) return 4352 + (n - 4160);
        if (n < 5248) return 1088 + (n - 5184);
        if (n < 5264) { sc = 0.03125f; return 1152 + (n - 5248); }
        if (n < 8336) return 5376 + (n - 5264);
        return 8448 + (n - 8336);
    }
    if (n < DFF) return (n >> 7) * 256 + (n & 127);
    const int m = n - DFF; return (m >> 7) * 256 + 128 + (m & 127);
}
template <int MAP> __device__ __forceinline__ void conv_item(const float* W, int K, int N, bf16_t* WT, const float* gain, LAS float* scr, int item, int lane) {
    const int nblk = (N + 31) / 32, kb = item / nblk, nb = item - kb * nblk, k0 = 64 * kb, n0 = 32 * nb;
    const int nn = n0 + (lane & 31);
    float wv[32];
#pragma unroll
    for (int i = 0; i < 32; ++i) { const int kk = 2 * i + (lane >> 5); wv[i] = (nn < N) ? W[(size_t)(k0 + kk) * N + nn] : 0.f; }
#pragma unroll
    for (int i = 0; i < 32; ++i) { const int kk = 2 * i + (lane >> 5); float v = wv[i]; if (gain) v *= gain[k0 + kk]; scr[kk * 33 + (lane & 31)] = v; }
    LDS_WAIT(); asm volatile("" ::: "memory");
    const int c = lane & 7;
#pragma unroll
    for (int j = 0; j < 4; ++j) { const int n = (lane >> 3) + 8 * j; const int ns = n0 + n;
        if (ns < N) { float sc; const int dst = wmap<MAP>(ns, sc); const LAS float* s = scr + (8 * c) * 33 + n;
            u32x4 o; o.x = pk2(s[0 * 33] * sc, s[1 * 33] * sc); o.y = pk2(s[2 * 33] * sc, s[3 * 33] * sc); o.z = pk2(s[4 * 33] * sc, s[5 * 33] * sc); o.w = pk2(s[6 * 33] * sc, s[7 * 33] * sc);
            *(u32x4*)(WT + (size_t)dst * K + k0 + 8 * c) = o; } }
    LDS_WAIT(); asm volatile("" ::: "memory");
}
template <int MAP> __device__ __forceinline__ void conv_matrix(const Ctx& F, const float* W, int K, int N, bf16_t* WT, const float* gain) {
    LAS float* scr = (LAS float*)(F.lds + F.wave * 16384);
    const int nit = (K / 64) * ((N + 31) / 32);
    for (int it = F.gw; it < nit; it += F.ngw) conv_item<MAP>(W, K, N, WT, gain, scr, it, F.lane);
}

__device__ __forceinline__ void norm_row(const float* hrow, bf16_t* orow, float* rs_row, int lane) {
    f32x4 v[8]; float s = 0.f;
#pragma unroll
    for (int j = 0; j < 8; ++j) { v[j] = *((const f32x4*)hrow + lane + 64 * j); s += (v[j].x * v[j].x + v[j].y * v[j].y) + (v[j].z * v[j].z + v[j].w * v[j].w); }
    s = wave_sum(s);
    if (lane == 0) *rs_row = s;
#pragma unroll
    for (int j = 0; j < 8; ++j) { u32x2 o; o.x = cvt_pk_bf16(v[j].x, v[j].y); o.y = cvt_pk_bf16(v[j].z, v[j].w); *((u32x2*)orow + lane + 64 * j) = o; }
}

__device__ __forceinline__ void post1a_row(const bf16_t* P, int r, float* rstdq, float* rstdkv, int lane) {
    const bf16_t* p = P + (size_t)r * PW;
    const u32x4 a = *((const u32x4*)(p + C_CQ) + lane), b = *((const u32x4*)(p + C_CKV) + lane);
    float sa = 0.f, sb = 0.f;
#pragma unroll
    for (int e = 0; e < 4; ++e) { const float x0 = __uint_as_float(a[e] << 16), x1 = __uint_as_float(a[e] & 0xffff0000u); sa += x0 * x0 + x1 * x1;
        const float y0 = __uint_as_float(b[e] << 16), y1 = __uint_as_float(b[e] & 0xffff0000u); sb += y0 * y0 + y1 * y1; }
    sa = wave_sum(sa); sb = wave_sum(sb);
    if (lane == 0) { rstdq[r] = 1.0f / sqrtf(sa * (1.f / 512.f) + EPS); rstdkv[r] = 1.0f / sqrtf(sb * (1.f / 512.f) + EPS); }
}
__device__ __forceinline__ void unpack8(const u32x4& w, float (&x)[8]) {
#pragma unroll
    for (int e = 0; e < 4; ++e) { x[2 * e] = __uint_as_float(w[e] << 16); x[2 * e + 1] = __uint_as_float(w[e] & 0xffff0000u); }
}
__device__ __forceinline__ u32x4 pack8(const float (&x)[8]) { u32x4 w; w.x = cvt_pk_bf16(x[0], x[1]); w.y = cvt_pk_bf16(x[2], x[3]); w.z = cvt_pk_bf16(x[4], x[5]); w.w = cvt_pk_bf16(x[6], x[7]); return w; }
__device__ __forceinline__ u32x4 shfl_xor4(const u32x4& w, int m) { u32x4 r; r.x = __shfl_xor(w.x, m); r.y = __shfl_xor(w.y, m); r.z = __shfl_xor(w.z, m); r.w = __shfl_xor(w.w, m); return r; }
template <int HD, bool NORM>
__device__ __forceinline__ void rope_pass(const u32x4& raw, u32x4* ptr, const float* gain, float scale, const float (&cs)[8], const float (&sn)[8], int lane, bool active) {
    constexpr int LPH = HD / 8, HALF = LPH / 2;
    const int lh = lane & (LPH - 1);
    float x[8]; unpack8(raw, x);
    float px[8]; { const u32x4 praw = shfl_xor4(raw, HALF); unpack8(praw, px); }
    if (NORM) {
        float ss = 0.f;
#pragma unroll
        for (int j = 0; j < 8; ++j) ss += x[j] * x[j];
#pragma unroll
        for (int o = 1; o < LPH; o <<= 1) ss += __shfl_xor(ss, o);
        const float rn = __builtin_amdgcn_rsqf(ss * (1.f / HD) + EPS);
        const f32x4 g0 = *(const f32x4*)(gain + lh * 8), g1 = *(const f32x4*)(gain + lh * 8 + 4);
        const f32x4 h0 = *(const f32x4*)(gain + (lh ^ HALF) * 8), h1 = *(const f32x4*)(gain + (lh ^ HALF) * 8 + 4);
#pragma unroll
        for (int j = 0; j < 4; ++j) { x[j] *= rn * g0[j]; x[4 + j] *= rn * g1[j]; px[j] *= rn * h0[j]; px[4 + j] *= rn * h1[j]; }
    }
    const bool first = lh < HALF;
    float o[8];
#pragma unroll
    for (int j = 0; j < 8; ++j) o[j] = (first ? (x[j] * cs[j] - px[j] * sn[j]) : (x[j] * cs[j] + px[j] * sn[j])) * scale;
    if (active) *ptr = pack8(o);
}
__device__ __forceinline__ void post1b_row(bf16_t* P, int r, const float* dsag  , const float* diffg  , int lane) {
    bf16_t* p = P + (size_t)r * PW;
    u32x4* pdq = (u32x4*)(p + C_DQ) + lane; u32x4* pdk = (u32x4*)(p + C_DK) + lane; u32x4* pfq = (u32x4*)(p + C_FQ) + lane; u32x4* pfk = (u32x4*)(p + C_FK) + lane; u32x4* piq = (u32x4*)(p + C_IQ) + lane;
    u32x4* pik = (u32x4*)(p + C_IK) + (lane < 8 ? lane : 0);
    u32x4 rdq[2], rdk[2], rfq[2], rfk[2], riq[2];
#pragma unroll
    for (int k = 0; k < 2; ++k) { rdq[k] = pdq[64 * k]; rdk[k] = pdk[64 * k]; rfq[k] = pfq[64 * k]; rfk[k] = pfk[64 * k]; riq[k] = piq[64 * k]; }
    const u32x4 rik = *pik;
    const int pos = row_pos(r);
    float c128[8], s128[8], c64[8], s64[8];
#pragma unroll
    for (int j = 0; j < 8; ++j) { rope_cs(pos, 8 * (lane & 7) + j, 2.f / 128.f, c128[j], s128[j]); rope_cs(pos, 8 * (lane & 3) + j, 2.f / 64.f, c64[j], s64[j]); }
#pragma unroll
    for (int k = 0; k < 2; ++k) {
        rope_pass<128, true>(rdq[k], pdq + 64 * k, dsag, C2_128, c128, s128, lane, true);
        rope_pass<128, true>(rdk[k], pdk + 64 * k, dsag + 128, 1.f, c128, s128, lane, true);
        rope_pass<128, true>(rfq[k], pfq + 64 * k, diffg, C2_128, c128, s128, lane, true);
        rope_pass<128, true>(rfk[k], pfk + 64 * k, diffg + 128, 1.f, c128, s128, lane, true);
        rope_pass<64, false>(riq[k], piq + 64 * k, nullptr, 1.f, c64, s64, lane, true);
    }
    rope_pass<64, false>(rik, pik, nullptr, 1.f, c64, s64, lane, lane < 8);
}
__device__ __forceinline__ void post2_row(bf16_t* P, int r, const float* rstdq, const float* rstdkv, const float* qkg  , LAS float* rnl, int lane) {
    bf16_t* p = P + (size_t)r * PW;
    const float sq = rstdq[r], skv = rstdkv[r];
    const int pos = row_pos(r), hw = lane >> 5, l5 = lane & 31;
    float c64[8], s64[8];
#pragma unroll
    for (int j = 0; j < 8; ++j) rope_cs(pos, 8 * (lane & 3) + j, 2.f / 64.f, c64[j], s64[j]);
    float kp[8]; { const u32x4 w = *(const u32x4*)(p + C_KPE + (lane & 7) * 8); unpack8(w, kp); }
    float kpe_ss = 0.f;
#pragma unroll
    for (int j = 0; j < 8; ++j) kpe_ss += kp[j] * kp[j];
    kpe_ss += __shfl_xor(kpe_ss, 1); kpe_ss += __shfl_xor(kpe_ss, 2); kpe_ss += __shfl_xor(kpe_ss, 4);
    u32x4 rq[4], rkv[4];
#pragma unroll
    for (int it = 0; it < 4; ++it) { const int h = 2 * it + hw; rq[it] = *(const u32x4*)(p + C_QRAW + h * 192 + (l5 < 24 ? l5 : 0) * 8); rkv[it] = *(const u32x4*)(p + C_KVRAW + h * 256 + l5 * 8); }
#pragma unroll
    for (int it = 0; it < 4; ++it) {
        const int h = 2 * it + hw; const bool act = l5 < 24;
        u32x4* ptr = (u32x4*)(p + C_QRAW + h * 192 + (act ? l5 : 0) * 8);
        float x[8]; unpack8(rq[it], x);
        float ss = 0.f;
#pragma unroll
        for (int j = 0; j < 8; ++j) { x[j] *= sq; ss += x[j] * x[j]; }
        if (!act) ss = 0.f;
#pragma unroll
        for (int o = 1; o < 32; o <<= 1) ss += __shfl_xor(ss, o);
        const float rn = 1.0f / sqrtf(ss * (1.f / 192.f) + EPS);
        const int gi = (act ? l5 : 0) * 8;
        const f32x4 g0 = *(const f32x4*)(qkg + gi), g1 = *(const f32x4*)(qkg + gi + 4);
#pragma unroll
        for (int j = 0; j < 4; ++j) { x[j] *= rn * g0[j]; x[4 + j] *= rn * g1[j]; }
        float o[8];
#pragma unroll
        for (int j = 0; j < 8; ++j) { const float pr = __shfl_xor(x[j], 4); const float rot = (l5 & 4) ? (x[j] * c64[j] + pr * s64[j]) : (x[j] * c64[j] - pr * s64[j]); o[j] = (l5 >= 16 ? rot : x[j]) * C2_192; }
        if (act) *ptr = pack8(o);
    }
#pragma unroll
    for (int it = 0; it < 4; ++it) {
        const int h = 2 * it + hw; const bool isk = l5 < 16;
        u32x4* ptr = (u32x4*)(p + C_KVRAW + h * 256 + l5 * 8);
        float x[8]; unpack8(rkv[it], x);
        float ss = 0.f;
#pragma unroll
        for (int j = 0; j < 8; ++j) { x[j] *= skv; ss += x[j] * x[j]; }
        if (!isk) ss = 0.f;
#pragma unroll
        for (int o = 1; o < 32; o <<= 1) ss += __shfl_xor(ss, o);
        const float rn = 1.0f / sqrtf((ss + kpe_ss) * (1.f / 192.f) + EPS);
        if (l5 == 0) rnl[h] = rn;
        const int gi = 192 + (isk ? l5 : 0) * 8;
        const f32x4 g0 = *(const f32x4*)(qkg + gi), g1 = *(const f32x4*)(qkg + gi + 4);
        float o[8];
#pragma unroll
        for (int j = 0; j < 4; ++j) { o[j] = isk ? x[j] * rn * g0[j] : x[j]; o[4 + j] = isk ? x[4 + j] * rn * g1[j] : x[4 + j]; }
        *ptr = pack8(o);
    }
    LDS_WAIT(); asm volatile("" ::: "memory");
    { const int hd = lane >> 3, c = lane & 7; const float rn = rnl[hd];
      const f32x4 g0 = *(const f32x4*)(qkg + 192 + 128 + c * 8), g1 = *(const f32x4*)(qkg + 192 + 128 + c * 8 + 4);
      float x[8], o[8];
#pragma unroll
      for (int j = 0; j < 4; ++j) { x[j] = kp[j] * rn * g0[j]; x[4 + j] = kp[4 + j] * rn * g1[j]; }
#pragma unroll
      for (int j = 0; j < 8; ++j) { const float pr = __shfl_xor(x[j], 4); o[j] = (c & 4) ? (x[j] * c64[j] + pr * s64[j]) : (x[j] * c64[j] - pr * s64[j]); }
      *(u32x4*)(p + C_KPEH + hd * 64 + c * 8) = pack8(o); }
    LDS_WAIT(); asm volatile("" ::: "memory");
}
__device__ __forceinline__ void post3_row(bf16_t* P, int r, const float* subg, float lam, float omli, int lane) {
    bf16_t* p = P + (size_t)r * PW;
    const int hw = lane >> 5, l5 = lane & 31;
    u32x4 rr[4];
#pragma unroll
    for (int h = 0; h < 4; ++h) rr[h] = *(const u32x4*)(p + (hw ? C_IQ : C_FQ) + h * 256 + l5 * 8);
#pragma unroll
    for (int h = 0; h < 4; ++h) {
        const u32x4 raw = rr[h];
        const u32x4 praw = shfl_xor4(raw, 16);
        float a[8], b[8]; unpack8(raw, a); unpack8(praw, b);
        float d[8], ss = 0.f;
#pragma unroll
        for (int j = 0; j < 8; ++j) { d[j] = a[j] - lam * b[j]; ss += d[j] * d[j]; }
        if (l5 >= 16) ss = 0.f;
#pragma unroll
        for (int o = 1; o < 64; o <<= 1) ss += __shfl_xor(ss, o);
        const float rn = omli / sqrtf(ss * (1.f / 256.f) + EPS);
        const int dim = hw * 128 + (l5 & 15) * 8;
        const f32x4 g0 = *(const f32x4*)(subg + dim), g1 = *(const f32x4*)(subg + dim + 4);
        float o[8];
#pragma unroll
        for (int j = 0; j < 4; ++j) { o[j] = d[j] * rn * g0[j]; o[4 + j] = d[4 + j] * rn * g1[j]; }
        if (l5 < 16) *(u32x4*)(p + C_OC + h * 256 + dim) = pack8(o);
    }
}

__device__ __forceinline__ int key_row(int kidx, int tokbase) { return kidx < 64 ? (MBLK - 64) + kidx : tokbase + (kidx - 64); }

__device__ __forceinline__ void index_row(const bf16_t* P, int tok, unsigned* bm, LAS float* iqs  , LAS unsigned* keys  , int lane) {
    const int b = tok >> 11, t = tok & (SEQ - 1), r = MBLK + tok, qk = 64 + t, nvalid = t + 17, tokbase = MBLK + b * SEQ;
    const int nch = qk / 64 + 1;
    unsigned* out = bm + (size_t)tok * BMW;
    if (nvalid <= 256) {
        for (int c = 0; c < 33; ++c) { const int kidx = 64 * c + lane; const unsigned long long m = __ballot(kidx >= 48 && kidx <= qk);
            if (lane == 0) { out[2 * c] = (unsigned)m; out[2 * c + 1] = (unsigned)(m >> 32); } }
        return;
    }
    const bf16_t* p = P + (size_t)r * PW;
#pragma unroll
    for (int j = 0; j < 16; ++j) iqs[j * 64 + lane] = bf2f(p[C_IQ + j * 64 + lane]);
    if (lane < 16) iqs[1024 + lane] = bf2f(p[C_IW + lane]);
    LDS_WAIT(); asm volatile("" ::: "memory");
    for (int c = 0; c < nch; ++c) {
        const int kidx = 64 * c + lane; const bool valid = kidx >= 48 && kidx <= qk;
        const int kr = key_row(valid ? kidx : 48, tokbase);
        const u32x4* kp = (const u32x4*)(P + (size_t)kr * PW + C_IK);
        u32x4 kw[8];
#pragma unroll
        for (int j = 0; j < 8; ++j) kw[j] = kp[j];
        float score = 0.f;
#pragma unroll 1
        for (int h = 0; h < 16; ++h) {
            const LAS f32x4* qv = (const LAS f32x4*)(iqs + h * 64); float d = 0.f;
#pragma unroll
            for (int j = 0; j < 8; ++j) { const u32x4 w = kw[j]; const f32x4 qa = qv[2 * j], qb = qv[2 * j + 1];
                d += qa.x * __uint_as_float(w.x << 16) + qa.y * __uint_as_float(w.x & 0xffff0000u) + qa.z * __uint_as_float(w.y << 16) + qa.w * __uint_as_float(w.y & 0xffff0000u)
                   + qb.x * __uint_as_float(w.z << 16) + qb.y * __uint_as_float(w.z & 0xffff0000u) + qb.z * __uint_as_float(w.w << 16) + qb.w * __uint_as_float(w.w & 0xffff0000u); }
            score += fmaxf(d, 0.f) * iqs[1024 + h];
        }
        const unsigned u = __float_as_uint(score);
        keys[c * 64 + lane] = valid ? ((u & 0x80000000u) ? ~u : (u | 0x80000000u)) : 0u;
    }
    LDS_WAIT(); asm volatile("" ::: "memory");
    unsigned T = 0u;
    for (int bit = 31; bit >= 0; --bit) {
        const unsigned cand = T | (1u << bit); int cnt = 0;
        for (int c = 0; c < nch; ++c) cnt += __popcll(__ballot(keys[c * 64 + lane] >= cand));
        if (cnt >= 256) T = cand;
        if (cnt == 256) break;
    }
    for (int c = 0; c < 33; ++c) { unsigned long long m = 0ull; if (c < nch) m = __ballot(keys[c * 64 + lane] >= T);
        if (lane == 0) { out[2 * c] = (unsigned)m; out[2 * c + 1] = (unsigned)(m >> 32); } }
    LDS_WAIT(); asm volatile("" ::: "memory");
}

__device__ __forceinline__ void index_unit(const bf16_t* P, int unit, unsigned* bm, LAS unsigned char* lds) {
    typedef float f32x16 __attribute__((ext_vector_type(16)));
    int tid = threadIdx.x; asm volatile("" : "+v"(tid));
    const int wid = __builtin_amdgcn_readfirstlane(tid >> 6), lane = tid & 63, j = lane & 31, hi = lane >> 5;
    const int tb = 255 - (unit >> 4), b = unit & 15, t0 = tb * 8, tokbase = MBLK + b * SEQ;
    const int wmax = (64 + t0 + 7) >> 5;
    LAS unsigned* keys = (LAS unsigned*)lds;
    LAS float* iwl = (LAS float*)(lds + 8 * 2112 * 4);
    if (t0 + 7 + 17 > 256) {
        if (tid < 128) iwl[tid] = bf2f(P[(size_t)(tokbase + t0 + (tid >> 4)) * PW + C_IW + (tid & 15)]);
        bf16x8 af[4][4];
        { const int qa = (j >> 2) & 1, ha = (j & 3) + 4 * (j >> 3);
#pragma unroll
          for (int blk = 0; blk < 4; ++blk) { const bf16_t* ap = P + (size_t)(tokbase + t0 + 2 * blk + qa) * PW + C_IQ + ha * 64 + hi * 8;
#pragma unroll
              for (int s = 0; s < 4; ++s) af[blk][s] = *(const bf16x8*)(ap + s * 16); } }
        LDS_WAIT(); __syncthreads();
        const unsigned boff = (unsigned)(j * PW + C_IK + hi * 8) * 2u;
        for (int w = wid; w <= wmax; w += 8) {
            const int kr_ = w < 2 ? (MBLK - 64) + 32 * w : tokbase + 32 * (w - 2); const char* bp_ = (const char*)(P + (size_t)kr_ * PW) + boff;
            bf16x8 bf[4];
#pragma unroll
            for (int s = 0; s < 4; ++s) bf[s] = *(const bf16x8*)(bp_ + s * 32);
            const int kidx = 32 * w + j;
#pragma unroll
            for (int blk = 0; blk < 4; ++blk) {
                f32x16 acc = (f32x16){0.f,0.f,0.f,0.f,0.f,0.f,0.f,0.f,0.f,0.f,0.f,0.f,0.f,0.f,0.f,0.f};
#pragma unroll
                for (int s = 0; s < 4; ++s) acc = __builtin_amdgcn_mfma_f32_32x32x16_bf16(af[blk][s], bf[s], acc, 0, 0, 0);
                const int q = 2 * blk + hi;
                const LAS f32x4* iwq = (const LAS f32x4*)(iwl + q * 16);
                float score = 0.f;
#pragma unroll
                for (int g = 0; g < 4; ++g) { const f32x4 wv = iwq[g]; score += fmaxf(acc[4 * g], 0.f) * wv.x + fmaxf(acc[4 * g + 1], 0.f) * wv.y + fmaxf(acc[4 * g + 2], 0.f) * wv.z + fmaxf(acc[4 * g + 3], 0.f) * wv.w; }
                const bool valid = kidx >= 48 && kidx <= 64 + t0 + q; const unsigned u_ = __float_as_uint(score);
                keys[q * 2112 + kidx] = valid ? ((u_ & 0x80000000u) ? ~u_ : (u_ | 0x80000000u)) : 0u;
            }
        }
        LDS_WAIT(); __syncthreads();
    }
    const int tq = t0 + wid, qk = 64 + tq, nch = qk / 64 + 1;
    unsigned* out = bm + (size_t)(b * SEQ + tq) * BMW;
    if (tq + 17 <= 256) {
        for (int c = 0; c < 33; ++c) { const int kidx = 64 * c + lane; const unsigned long long m = __ballot(kidx >= 48 && kidx <= qk);
            if (lane == 0) { out[2 * c] = (unsigned)m; out[2 * c + 1] = (unsigned)(m >> 32); } }
    } else {
        unsigned kreg[33];
#pragma unroll
        for (int c = 0; c < 33; ++c) kreg[c] = (c < nch && 64 * c + lane <= qk) ? keys[wid * 2112 + 64 * c + lane] : 0u;
        unsigned T = 0u;
        for (int bit = 31; bit >= 0; --bit) {
            const unsigned cand = T | (1u << bit); int cnt = 0;
#pragma unroll
            for (int c = 0; c < 33; ++c) cnt += __popcll(__ballot(kreg[c] >= cand));
            if (cnt >= 256) T = cand;
            if (cnt == 256) break;
        }
#pragma unroll
        for (int c = 0; c < 33; ++c) { const unsigned long long m = __ballot(kreg[c] >= T && kreg[c] != 0u);
            if (lane == 0) { out[2 * c] = (unsigned)m; out[2 * c + 1] = (unsigned)(m >> 32); } }
    }
    LDS_WAIT();
}

template <int DQK, int DV, bool MASKED>
__device__ __forceinline__ void attn_row(bf16_t* P, int r, int qcol, int k1col, int k2col, int vcol, int ocol0, int ocol1, const unsigned* bm, LAS float* qs, int lane) {
    int qk, tokbase;
    if (r < MBLK) { qk = r - (MBLK - 64); tokbase = MBLK; } else { const int tok = r - MBLK; qk = 64 + (tok & (SEQ - 1)); tokbase = MBLK + (tok >> 11) * SEQ; }
    const bf16_t* qp = P + (size_t)r * PW + qcol;
#pragma unroll
    for (int d = 0; d < DQK; d += 64) qs[d + lane] = bf2f(qp[d + lane]);
    LDS_WAIT(); asm volatile("" ::: "memory");
    const bool use_bm = MASKED && r >= MBLK;
    const unsigned* bmr = bm + (size_t)(r >= MBLK ? r - MBLK : 0) * BMW;
    float m = -1e30f, l = 0.f, o[DV / 64];
#pragma unroll
    for (int k = 0; k < DV / 64; ++k) o[k] = 0.f;
    const int nch = qk / 64 + 1;
    for (int c = 0; c < nch; ++c) {
        const int kidx = 64 * c + lane; bool valid = kidx >= 48 && kidx <= qk;
        if (use_bm) valid = (bmr[kidx >> 5] >> (kidx & 31)) & 1u;
        const int kr = key_row((kidx >= 48 && kidx <= qk) ? kidx : 48, tokbase);
        float s = 0.f;
        { const u32x4* kp = (const u32x4*)(P + (size_t)kr * PW + k1col);
#pragma unroll
          for (int j = 0; j < 16; ++j) { const u32x4 w = kp[j]; const LAS f32x4* qv = (const LAS f32x4*)(qs + j * 8); const f32x4 qa = qv[0], qb = qv[1];
              s += qa.x * __uint_as_float(w.x << 16) + qa.y * __uint_as_float(w.x & 0xffff0000u) + qa.z * __uint_as_float(w.y << 16) + qa.w * __uint_as_float(w.y & 0xffff0000u)
                 + qb.x * __uint_as_float(w.z << 16) + qb.y * __uint_as_float(w.z & 0xffff0000u) + qb.z * __uint_as_float(w.w << 16) + qb.w * __uint_as_float(w.w & 0xffff0000u); } }
        if (DQK == 192) { const u32x4* kp = (const u32x4*)(P + (size_t)kr * PW + k2col);
#pragma unroll
          for (int j = 0; j < 8; ++j) { const u32x4 w = kp[j]; const LAS f32x4* qv = (const LAS f32x4*)(qs + 128 + j * 8); const f32x4 qa = qv[0], qb = qv[1];
              s += qa.x * __uint_as_float(w.x << 16) + qa.y * __uint_as_float(w.x & 0xffff0000u) + qa.z * __uint_as_float(w.y << 16) + qa.w * __uint_as_float(w.y & 0xffff0000u)
                 + qb.x * __uint_as_float(w.z << 16) + qb.y * __uint_as_float(w.z & 0xffff0000u) + qb.z * __uint_as_float(w.w << 16) + qb.w * __uint_as_float(w.w & 0xffff0000u); } }
        if (!valid) s = -__builtin_inff();
        const float mn = fmaxf(m, wave_max(s));
        const float alpha = __builtin_amdgcn_exp2f(m - mn), pj = __builtin_amdgcn_exp2f(s - mn);
        l = l * alpha + wave_sum(pj); m = mn;
#pragma unroll
        for (int k = 0; k < DV / 64; ++k) o[k] *= alpha;
        for (int j = 0; j < 64; ++j) {
            const float pw = __uint_as_float((unsigned)__builtin_amdgcn_readlane((int)__float_as_uint(pj), j));
            if (pw != 0.f) { const int rj = __builtin_amdgcn_readlane(kr, j); const bf16_t* vp = P + (size_t)rj * PW + vcol;
#pragma unroll
                for (int k = 0; k < DV / 64; ++k) o[k] += pw * bf2f(vp[k * 64 + lane]); }
        }
    }
    const float rl = l > 0.f ? 1.0f / l : 0.f;
    bf16_t* op = P + (size_t)r * PW;
#pragma unroll
    for (int k = 0; k < DV / 64; ++k) { const int d = k * 64 + lane; op[(d < 128 ? ocol0 + d : ocol1 + d - 128)] = (bf16_t)f2bf(o[k] * rl); }
    LDS_WAIT(); asm volatile("" ::: "memory");
}
namespace fa {
typedef float f32x16 __attribute__((ext_vector_type(16)));
typedef short s16x4 __attribute__((ext_vector_type(4)));
__device__ __forceinline__ int crow(int r, int hi) { return (r & 3) + 8 * (r >> 2) + 4 * hi; }
__device__ __forceinline__ int v_st(int k, int c) { const int kk = (k & ~0xC) | ((k & 4) << 1) | ((k & 8) >> 1); return ((kk >> 3) * 4 + (c >> 5)) * 512 + ((kk & 7) * 32 + (c & 31)) * 2; }
__device__ __forceinline__ int v_rd_base(int lane) { return ((lane & 3) << 3) | (((lane >> 2) & 3) << 6) | (((lane >> 4) & 1) << 5) | (((lane >> 5) & 1) << 8); }
constexpr int v_rd_off(int d0, int ks, int half) { return d0 * 512 + ks * 4096 + half * 2048; }
constexpr int SHM_V = 16384;
template <int DQK> struct Geo { static constexpr int KP = DQK * 2, SHM_K = 64 * DQK * 2, LDS_K0 = 2 * SHM_V, LDS_WS = LDS_K0 + 2 * SHM_K, BYTES = LDS_WS + 8 * 256; };
#define FA_KSWZ(row, colB, pitch) ((row) * (pitch) + ((colB) ^ (((row) & 7) << 4)))
#define FA_SBAR() __builtin_amdgcn_sched_barrier(0)

struct Item { int qrow0, qk0, nt, tokbase; };

template <int DQK>
__device__ __forceinline__ void load_q(const bf16_t* P, const Item& it, int qcol, bf16x8 (&qr)[DQK / 16]) {
    int tid = threadIdx.x; asm volatile("" : "+v"(tid));
    const int wid = tid >> 6, lane = tid & 63, r32 = lane & 31, hi = lane >> 5;
    const bf16_t* qp = P + (size_t)(it.qrow0 + wid * 32 + r32) * PW + qcol + hi * 8;
#pragma unroll
    for (int d0 = 0; d0 < DQK / 16; ++d0) qr[d0] = *(const bf16x8*)(qp + d0 * 16);
}

template <int DQK, bool MASKED>
__device__ __forceinline__ void attn_core(bf16_t* P, const Item& it, const bf16x8 (&qr)[DQK / 16], int k1col, int k2col, int vcol, int ocol, const unsigned* bmq, LAS unsigned char* lds) {
    typedef Geo<DQK> G;
    int tid = threadIdx.x; asm volatile("" : "+v"(tid));
    const int wid = __builtin_amdgcn_readfirstlane(tid >> 6), lane = tid & 63, r32 = lane & 31, hi = lane >> 5;
    LAS unsigned char* V_lds = lds; LAS unsigned char* K_lds = lds + G::LDS_K0; LAS float* wsf = (LAS float*)(lds + G::LDS_WS) + wid * 64;
    const int sr = tid >> 4, sc = (tid & 15) * 8;
    const int vst0 = v_st(sr, sc), vst1 = v_st(32 + sr, sc), kws0 = FA_KSWZ(sr, sc * 2, G::KP), kws1 = FA_KSWZ(sr + 32, sc * 2, G::KP);
    const int xr = tid >> 3, xc = (tid & 7) * 8, kws2 = FA_KSWZ(xr, (128 + xc) * 2, G::KP);
    const unsigned loff0 = (unsigned)(sr * PW + sc) * 2u, loffx = (unsigned)(xr * PW + xc) * 2u;
    const int vb0 = (int)(unsigned)(size_t)V_lds + v_rd_base(lane);
    const int NT = it.nt;
    const int qk = it.qk0 + wid * 32 + r32;
    const bool use_bm = MASKED && (bmq != nullptr);
    const unsigned bmoff = (unsigned)((wid * 32 + r32) * BMW) * 4u;
    float l_reg = 0.f; f32x16 o[4];
#pragma unroll
    for (int d = 0; d < 4; ++d) o[d] = (f32x16){0.f,0.f,0.f,0.f,0.f,0.f,0.f,0.f,0.f,0.f,0.f,0.f,0.f,0.f,0.f,0.f};
    bf16x8 sk0, sk1, sk2, sv0, sv1;
#define FA_KROW0(t) ((t) == 0 ? (MBLK - 64) : it.tokbase + 64 * ((t) - 1))
#define FA_LOAD(t) do { const int kr_ = FA_KROW0(t); const char* rb_ = (const char*)(P + (size_t)kr_ * PW); const char* rk_ = rb_ + (size_t)k1col * 2; const char* rv_ = rb_ + (size_t)vcol * 2; \
        sk0 = *(const bf16x8*)(rk_ + loff0); sk1 = *(const bf16x8*)(rk_ + (size_t)32 * PW * 2 + loff0); sv0 = *(const bf16x8*)(rv_ + loff0); sv1 = *(const bf16x8*)(rv_ + (size_t)32 * PW * 2 + loff0); \
        if (DQK == 192) sk2 = *(const bf16x8*)(rb_ + (size_t)k2col * 2 + loffx); } while (0)
#define FA_WRITE(bf) do { *(LAS bf16x8*)(K_lds + (bf) * G::SHM_K + kws0) = sk0; *(LAS bf16x8*)(K_lds + (bf) * G::SHM_K + kws1) = sk1; \
        *(LAS bf16x8*)(V_lds + (bf) * SHM_V + vst0) = sv0; *(LAS bf16x8*)(V_lds + (bf) * SHM_V + vst1) = sv1; \
        if (DQK == 192) *(LAS bf16x8*)(K_lds + (bf) * G::SHM_K + kws2) = sk2; } while (0)
    constexpr int QREG = (DQK == 192) ? 6 : DQK / 16;
    LAS unsigned char* qx = lds + G::BYTES + (wid * 384 + lane) * 16;
    if (DQK == 192) {
#pragma unroll
        for (int d0 = QREG; d0 < DQK / 16; ++d0) *(LAS bf16x8*)(qx + (d0 - QREG) * 1024) = qr[d0];
    }
    FA_LOAD(0); FA_WRITE(0);
    __syncthreads();
    for (int t = 0; t < NT; ++t) {
        const int cur = t & 1;
        unsigned zb = 0u; asm volatile("" : "+v"(zb)); u32x2 bw = (u32x2){zb, zb};
        if (use_bm) bw = *(const u32x2*)((const char*)(bmq + 2 * t) + bmoff);
        f32x16 p0 = (f32x16){0.f,0.f,0.f,0.f,0.f,0.f,0.f,0.f,0.f,0.f,0.f,0.f,0.f,0.f,0.f,0.f}, p1 = p0;
        { LAS unsigned char* kbase = K_lds + cur * G::SHM_K;
          LAS unsigned char* kb[4];
#pragma unroll
          for (int dd = 0; dd < 4; ++dd) kb[dd] = kbase + FA_KSWZ(r32, (dd * 16 + hi * 8) * 2, G::KP);
          constexpr int GS = (DQK == 192) ? 2 : 4;
#pragma unroll
          for (int g = 0; g < DQK / (16 * GS); ++g) {
              bf16x8 fb0[GS], fb1[GS];
#pragma unroll
              for (int dd = 0; dd < GS; ++dd) { const int d0 = g * GS + dd; LAS unsigned char* a = kb[d0 & 3] + (d0 >> 2) * 128; fb0[dd] = *(const LAS bf16x8*)a; fb1[dd] = *(const LAS bf16x8*)(a + 32 * G::KP); }
              FA_SBAR();
#pragma unroll
              for (int dd = 0; dd < GS; ++dd) { const int d0 = g * GS + dd; bf16x8 qf; if (d0 < QREG) qf = qr[d0 < QREG ? d0 : 0]; else qf = *(const LAS bf16x8*)(qx + (d0 - QREG) * 1024);
                  p0 = __builtin_amdgcn_mfma_f32_32x32x16_bf16(fb0[dd], qf, p0, 0, 0, 0); p1 = __builtin_amdgcn_mfma_f32_32x32x16_bf16(fb1[dd], qf, p1, 0, 0, 0); }
              FA_SBAR(); } }
        if (t + 1 < NT) FA_LOAD(t + 1);
        FA_SBAR();
        const float NEG = -__builtin_inff();
        if (use_bm) {
        } else if (t == 0 || 64 * t + 63 > it.qk0 + wid * 32) {
            const int kb_ = 64 * t + 4 * hi;
#pragma unroll
            for (int r = 0; r < 16; ++r) { const int k0 = kb_ + (r & 3) + 8 * (r >> 2), k1 = k0 + 32;
                if (k0 < 48 || k0 > qk) p0[r] = NEG; if (k1 < 48 || k1 > qk) p1[r] = NEG; }
        }
        float ps = 0.f;
#pragma unroll
        for (int r = 0; r < 16; ++r) { p0[r] = __builtin_amdgcn_exp2f(p0[r]); p1[r] = __builtin_amdgcn_exp2f(p1[r]); }
        if (use_bm) {
            const int wx = (int)(bw.x >> (4 * hi)), wy = (int)(bw.y >> (4 * hi));
#pragma unroll
            for (int r = 0; r < 16; ++r) { const int c = (r & 3) + 8 * (r >> 2);
                p0[r] = __uint_as_float(__float_as_uint(p0[r]) & (unsigned)__builtin_amdgcn_sbfe(wx, c, 1)); p1[r] = __uint_as_float(__float_as_uint(p1[r]) & (unsigned)__builtin_amdgcn_sbfe(wy, c, 1)); }
        }
        { f32x2 s2 = (f32x2){p0[0], p0[1]} + (f32x2){p1[0], p1[1]};
#pragma unroll
          for (int r = 2; r < 16; r += 2) s2 += (f32x2){p0[r], p0[r + 1]} + (f32x2){p1[r], p1[r + 1]};
          ps = s2.x + s2.y; }
        { auto rr = __builtin_amdgcn_permlane32_swap(__float_as_uint(ps), __float_as_uint(ps), false, false); ps = __uint_as_float(rr[0]) + __uint_as_float(rr[1]); }
        l_reg += ps;
        bf16x8 pa0, pa1, pa2, pa3;
#define FA_PK4(Pv, B_, OUT) do { const unsigned a0 = cvt_pk_bf16(Pv[B_ + 0], Pv[B_ + 1]), a1 = cvt_pk_bf16(Pv[B_ + 2], Pv[B_ + 3]), b0 = cvt_pk_bf16(Pv[B_ + 4], Pv[B_ + 5]), b1 = cvt_pk_bf16(Pv[B_ + 6], Pv[B_ + 7]); \
        auto r0 = __builtin_amdgcn_permlane32_swap(a0, b0, false, false); auto r1 = __builtin_amdgcn_permlane32_swap(a1, b1, false, false); \
        u32x4 w_ = {r0[0], r1[0], r0[1], r1[1]}; OUT = __builtin_bit_cast(bf16x8, w_); } while (0)
        FA_PK4(p0, 0, pa0); FA_PK4(p0, 8, pa1); FA_PK4(p1, 0, pa2); FA_PK4(p1, 8, pa3);
#define FA_TRRD(dst, off) asm volatile("ds_read_b64_tr_b16 %0, %1 offset:%2" : "=&v"(dst) : "v"(vb0), "i"(off) : "memory")
#define FA_PV(VB, d0) do { s16x4 l0, l1, l2, l3, h0, h1, h2, h3; constexpr int b_ = (VB) * SHM_V + v_rd_off(d0, 0, 0); \
        FA_TRRD(l0, b_); FA_TRRD(h0, b_ + 2048); FA_TRRD(l1, b_ + 4096); FA_TRRD(h1, b_ + 6144); FA_TRRD(l2, b_ + 8192); FA_TRRD(h2, b_ + 10240); FA_TRRD(l3, b_ + 12288); FA_TRRD(h3, b_ + 14336); \
        asm volatile("s_waitcnt lgkmcnt(0)" ::: "memory"); FA_SBAR(); \
        o[d0] = __builtin_amdgcn_mfma_f32_32x32x16_bf16(pa0, (bf16x8){l0[0], l0[1], l0[2], l0[3], h0[0], h0[1], h0[2], h0[3]}, o[d0], 0, 0, 0); \
        o[d0] = __builtin_amdgcn_mfma_f32_32x32x16_bf16(pa1, (bf16x8){l1[0], l1[1], l1[2], l1[3], h1[0], h1[1], h1[2], h1[3]}, o[d0], 0, 0, 0); \
        o[d0] = __builtin_amdgcn_mfma_f32_32x32x16_bf16(pa2, (bf16x8){l2[0], l2[1], l2[2], l2[3], h2[0], h2[1], h2[2], h2[3]}, o[d0], 0, 0, 0); \
        o[d0] = __builtin_amdgcn_mfma_f32_32x32x16_bf16(pa3, (bf16x8){l3[0], l3[1], l3[2], l3[3], h3[0], h3[1], h3[2], h3[3]}, o[d0], 0, 0, 0); } while (0)
        FA_SBAR();
        if (cur == 0) { FA_PV(0, 0); FA_PV(0, 1); FA_PV(0, 2); FA_PV(0, 3); } else { FA_PV(1, 0); FA_PV(1, 1); FA_PV(1, 2); FA_PV(1, 3); }
        FA_SBAR();
        if (t + 1 < NT) { if (cur == 0) FA_WRITE(1); else FA_WRITE(0); }
        __syncthreads();
    }
    if (hi == 0) wsf[r32] = l_reg; LDS_WAIT();
    float rli[16];
#pragma unroll
    for (int r = 0; r < 16; ++r) { const float lv = wsf[crow(r, hi)]; rli[r] = lv > 0.f ? __builtin_amdgcn_rcpf(lv) : 0.f; }
    { int l2 = lane; asm volatile("" : "+v"(l2));
      const int r32b = l2 & 31, hib = l2 >> 5;
      char* Ow = (char*)(P + (size_t)(it.qrow0 + wid * 32) * PW + ocol) + (unsigned)((4 * hib) * PW + r32b) * 2u;
#pragma unroll
      for (int r = 0; r < 16; ++r) { const unsigned ro = (unsigned)(((r & 3) + 8 * (r >> 2)) * PW) * 2u;
#pragma unroll
        for (int d0 = 0; d0 < 4; ++d0) { const float v = o[d0][r] * rli[r]; const float vn = __shfl_xor(v, 1);
            if ((r32b & 1) == 0) *(unsigned*)(Ow + ro + d0 * 64) = cvt_pk_bf16(v, vn); } } }
    LDS_WAIT();
    __syncthreads();
#undef FA_KROW0
#undef FA_LOAD
#undef FA_WRITE
#undef FA_PK4
#undef FA_TRRD
#undef FA_PV
}
__device__ __forceinline__ int next_item(unsigned* ctr, LAS int* slot) {
    __syncthreads();
    if (threadIdx.x == 0) *slot = (int)__hip_atomic_fetch_add(ctr, 1u, __ATOMIC_RELAXED, __HIP_MEMORY_SCOPE_AGENT);
    __syncthreads();
    return *slot;
}
__device__ __forceinline__ Item make_item(bool meta, int b, int qb) {
    Item it;
    if (meta) { it.qrow0 = 0; it.qk0 = -(MBLK - 64); it.nt = 1; it.tokbase = MBLK; }
    else { it.qrow0 = MBLK + b * SEQ + qb * 256; it.qk0 = 64 + qb * 256; it.nt = 4 * (qb + 1) + 1; it.tokbase = MBLK + b * SEQ; }
    return it;
}
}

__device__ __forceinline__ int deal_row(int pass, int gw, int ngw) { const int j = (pass & 1) ? (ngw - 1 - gw) : gw; return pass * ngw + j; }

constexpr int PH_PER_LAYER = 19, N_PHASES = 2 * PH_PER_LAYER;
__device__ __forceinline__ unsigned char* uni_ptr(unsigned char* p) { const unsigned long long v = (unsigned long long)p; const unsigned lo = __builtin_amdgcn_readfirstlane((unsigned)v), hi = __builtin_amdgcn_readfirstlane((unsigned)(v >> 32)); return (unsigned char*)(((unsigned long long)hi << 32) | lo); }
__device__ __forceinline__ const float* arg_in(const Args& a, int k) { asm volatile("" : "+s"(k)); return a.in[k]; }
__global__ void __launch_bounds__(NWAVES * 64, 2) mega_fwd(Args args) {
    extern __shared__ __attribute__((aligned(16))) unsigned char lds_raw[];
    {
        LAS unsigned char* l0 = (LAS unsigned char*)lds_raw;
        for (int u = threadIdx.x; u < (LDS_BYTES - LDSCTL_OFF) / 4; u += NWAVES * 64) ((LAS unsigned*)(l0 + LDSCTL_OFF))[u] = 0u;
        __syncthreads();
    }
#if MK_ONE_LAUNCH
    (void)xcd_barrier_post((unsigned*)(args.ws + WS_CTL) + CW_BAR, (volatile LAS unsigned*)((LAS unsigned char*)lds_raw + LDSCTL_OFF + 64));
#define GRID_BAR() do { XcdBarrier bar_; bar_.bar = (unsigned*)(uni_ptr(args.ws) + WS_CTL) + CW_BAR; bar_.x = xb_xcc_id(); bar_.st = (volatile LAS unsigned*)((LAS unsigned char*)lds_raw + LDSCTL_OFF + 64); xcd_barrier(bar_); } while (0)
#else
#define GRID_BAR() do {} while (0)
#endif
    const int lo = args.ph_lo, hi = args.ph_hi;
#define IN(k) (lo <= (k) && (k) < hi)
#define SEAM(k) do { if (IN((k) + 1)) GRID_BAR(); } while (0)
#define PH_BEGIN \
    int tid_ = threadIdx.x; asm volatile("" : "+v"(tid_)); \
    Ctx F; F.lds = (LAS unsigned char*)lds_raw; F.tid = tid_; F.lane = tid_ & 63; F.wave = __builtin_amdgcn_readfirstlane(tid_ >> 6); \
    F.G = gridDim.x; F.bid = blockIdx.x; F.gw = F.bid * NWAVES + F.wave; F.ngw = F.G * NWAVES; \
    unsigned char* ws = uni_ptr(args.ws); asm volatile("" : "+s"(ws)); \
    int ly = __builtin_amdgcn_readfirstlane(layer); asm volatile("" : "+s"(ly)); (void)ly; (void)F
#define XN_ ((bf16_t*)(ws + WS_XN))
#define P_ ((bf16_t*)(ws + WS_P))
#define HMETA_ ((float*)(ws + WS_HMETA))
#define RSTDQ_ ((float*)(ws + WS_RSTD))
#define RSTDKV_ ((float*)(ws + WS_RSTD) + R)
#define BM_ ((unsigned*)(ws + WS_BM))
#define RS_(i) ((float*)(ws + WS_CTL + WS_RS) + (size_t)(i) * R)
#define WB_(off) ((bf16_t*)(ws + WS_WB + (off)))
#define OUT_ (args.out)
#define LAMBDA_INIT(ly) ((ly) == 0 ? 0.2f : (0.8f - 0.6f * 0.7408182206817179f))
#define HSRC_TOK(ly) ((ly) == 0 ? arg_in(args, 0) : (const float*)args.out)

#pragma unroll
    for (int layer = 0; layer < 2; ++layer) {
        const int pb = layer * PH_PER_LAYER;
        if (((PHMASK >> 0) & 1) && IN(pb + 0)) {
            PH_BEGIN;
            for (int rep_ = 0; rep_ < NREP(0); ++rep_) { if (rep_) GRID_BAR();
            const float* meta = arg_in(args, 1);
            conv_matrix<1>(F, arg_in(args, 3) + (size_t)ly * DM * D_IN, DM, D_IN, WB_(WB_IN), arg_in(args, 2) + ly * DM);
            conv_matrix<0>(F, arg_in(args, 7) + (size_t)ly * 512 * 1536, 512, 1536, WB_(WB_QUP), arg_in(args, 5) + ly * 512);
            conv_matrix<0>(F, arg_in(args, 8) + (size_t)ly * 512 * 2048, 512, 2048, WB_(WB_KVUP), arg_in(args, 6) + ly * 512);
            for (int b = 0; b < 3; ++b) conv_matrix<0>(F, arg_in(args, 14) + ((size_t)ly * 3 + b) * 1024 * DM, 1024, DM, WB_(WB_BR) + (size_t)b * DM * 1024, nullptr);
            conv_matrix<0>(F, arg_in(args, 15) + (size_t)ly * DM * DM, DM, DM, WB_(WB_O), nullptr);
            conv_matrix<2>(F, arg_in(args, 17) + (size_t)ly * DM * 2 * DFF, DM, 2 * DFF, WB_(WB_F1), arg_in(args, 16) + ly * DM);
            conv_matrix<0>(F, arg_in(args, 18) + (size_t)ly * DFF * DM, DFF, DM, WB_(WB_F2), nullptr);
            unsigned zu = 0u; asm volatile("" : "+v"(zu)); const float zf = __uint_as_float(zu);
            for (int i = F.gw * 64 + F.lane; i < 112 * 2048 / 8; i += F.ngw * 64) *((u32x4*)(WB_(WB_IN) + (size_t)1168 * 2048) + i) = (u32x4){zu, zu, zu, zu};
            float* hmeta = HMETA_;
            if (ly == 0) {
                for (int i = F.gw * 64 + F.lane; i < MROW0 * PW / 8; i += F.ngw * 64) *((u32x4*)P_ + i) = (u32x4){zu, zu, zu, zu};
                for (int i = F.gw * 64 + F.lane; i < MBLK * DM / 4; i += F.ngw * 64) { const int rr = i / (DM / 4); f32x4 v = (f32x4){zf, zf, zf, zf};
                    if (rr >= MBLK - NMETA) v = *((const f32x4*)meta + (i - (MBLK - NMETA) * (DM / 4))); *((f32x4*)hmeta + i) = v; }
            }
            if (ly == 0) {
                const float* xin = arg_in(args, 0); bf16_t* XN = XN_; float* rs0 = RS_(0);
                for (int r = MROW0 + F.gw; r < R; r += F.ngw)
                    norm_row(r < MBLK ? meta + (size_t)(r - MROW0) * DM : xin + (size_t)(r - MBLK) * DM, XN + (size_t)r * DM, rs0 + r, F.lane);
            }
            }
            SEAM(pb + 0);
        }
        if (((PHMASK >> 1) & 1) && IN(pb + 1)) {
            PH_BEGIN;
            { SkP f{P_, 0, RS_(2 * ly)}; skinny_gemm(F.lds, XN_ + (size_t)MROW0 * DM, DM, WB_(WB_IN), DM, 1280 / 16, F.bid, F.G, f); }
            SchedPlain S{XN_, DM, WB_(WB_IN), DM, NPMM, 5, F.G, F.bid, 0}; EpiP E{P_, RS_(2 * ly)};
            pg8::gemm_phase(F.lds, S, E);
            if (NREP(1) == 2) { GRID_BAR(); pg8::gemm_phase(F.lds, S, E); }
            SEAM(pb + 1);
        }
        if (((PHMASK >> 2) & 1) && IN(pb + 2)) {
            PH_BEGIN;
            { bf16_t* P = P_; float* rq = RSTDQ_; float* rkv = RSTDKV_;
              for (int r = MROW0 + F.gw; r < R; r += F.ngw) post1a_row(P, r, rq, rkv, F.lane); }
            VM_WAIT(); __syncthreads();
            { SkP f{P_, C_QRAW, nullptr}; skinny_gemm(F.lds, P_ + (size_t)MROW0 * PW + C_CQ, PW, WB_(WB_QUP), 512, 1536 / 16, F.bid, F.G, f); }
            { SkP f{P_, C_KVRAW, nullptr}; skinny_gemm(F.lds, P_ + (size_t)MROW0 * PW + C_CKV, PW, WB_(WB_KVUP), 512, 2048 / 16, F.bid, F.G, f); }
            SchedMlaUp S{P_, WB_(WB_QUP), WB_(WB_KVUP), F.G, F.bid}; EpiP E{P_, nullptr};
            pg8::gemm_phase(F.lds, S, E);
            if (NREP(2) == 2) { GRID_BAR(); pg8::gemm_phase(F.lds, S, E); }
            SEAM(pb + 2);
        }
        if (((PHMASK >> 3) & 1) && IN(pb + 3)) {
            PH_BEGIN;
            const float* mla_qkg = arg_in(args, 9) + ly * 2 * 192;
            bf16_t* P = P_; float* rq = RSTDQ_; float* rkv = RSTDKV_;
            LAS float* rnl = (LAS float*)(F.lds + F.wave * 64);
            for (int r = MROW0 + F.gw; r < R; r += F.ngw) post2_row(P, r, rq, rkv, mla_qkg, rnl, F.lane);
            SEAM(pb + 3);
        }
        if (((PHMASK >> 4) & 1) && IN(pb + 4)) {
            PH_BEGIN;
            bf16_t* P = P_;
            LAS int* slot = (LAS int*)(F.lds + LDSCTL_OFF + 128);
            for (int rep_ = 0; rep_ < NREP(4); ++rep_) { if (rep_) GRID_BAR();
            unsigned* ctr = (unsigned*)(ws + WS_CTL) + CW_Q + 64 * (ly * 4 + 0) + 64 * 16 * rep_;
            for (;;) {
                const int idx = fa::next_item(ctr, slot); if (idx >= 8 * 129) break;
                int h; fa::Item it;
                if (idx < 1024) { const int qb = 7 - (idx >> 7), rest = idx & 127; h = rest & 7; it = fa::make_item(false, rest >> 3, qb); } else { h = idx - 1024; it = fa::make_item(true, 0, 0); }
                bf16x8 qr[12]; fa::load_q<192>(P, it, C_QRAW + h * 192, qr);
                fa::attn_core<192, false>(P, it, qr, C_KVRAW + h * 256, C_KPEH + h * 64, C_KVRAW + h * 256 + 128, C_OA + h * 128, nullptr, F.lds);
            } }
            SEAM(pb + 4);
        }
        if (((PHMASK >> 5) & 1) && IN(pb + 5)) {
            PH_BEGIN;
            { SkP f{P_, 1280, RS_(2 * ly)}; skinny_gemm(F.lds, XN_ + (size_t)MROW0 * DM, DM, WB_(WB_IN) + (size_t)1280 * DM, DM, 7168 / 16, F.bid, F.G, f); }
            SchedPlain S{XN_, DM, WB_(WB_IN) + (size_t)1280 * DM, DM, NPMM, 28, F.G, F.bid, 1280}; EpiP E{P_, RS_(2 * ly)};
            pg8::gemm_phase(F.lds, S, E);
            if (NREP(5) == 2) { GRID_BAR(); pg8::gemm_phase(F.lds, S, E); }
            SEAM(pb + 5);
        }
        if (((PHMASK >> 6) & 1) && IN(pb + 6)) {
            PH_BEGIN;
            const float* dsa_qkg = arg_in(args, 10) + ly * 2 * 128; const float* diff_qkg = arg_in(args, 11) + ly * 2 * 128;
            bf16_t* P = P_;
            for (int r = MROW0 + F.gw; r < R; r += F.ngw) post1b_row(P, r, dsa_qkg, diff_qkg, F.lane);
            SEAM(pb + 6);
        }
        if (((PHMASK >> 7) & 1) && IN(pb + 7)) {
            PH_BEGIN;
            bf16_t* P = P_; unsigned* bm = BM_;
            unsigned* ctr = (unsigned*)(ws + WS_CTL) + CW_Q + 64 * (ly * 4 + 2);
            LAS int* slot = (LAS int*)(F.lds + LDSCTL_OFF + 128);
            for (int rep_ = 0; rep_ < NREP(7); ++rep_) { if (rep_) GRID_BAR(); unsigned* c2 = ctr + 64 * 16 * rep_;
            for (;;) { const int idx = fa::next_item(c2, slot); if (idx >= NTOK / 8) break; index_unit(P, idx, bm, F.lds); } }
            SEAM(pb + 7);
        }
        if (((PHMASK >> 8) & 1) && IN(pb + 8)) {
            PH_BEGIN;
            bf16_t* P = P_; unsigned* bm = BM_;
            LAS int* slot = (LAS int*)(F.lds + LDSCTL_OFF + 128);
            for (int rep_ = 0; rep_ < NREP(8); ++rep_) { if (rep_) GRID_BAR();
            const bool dummy = (NREP(8) == 2) && rep_ == 0;
            unsigned* ctr = (unsigned*)(ws + WS_CTL) + CW_Q + 64 * (ly * 4 + 1) + 64 * 16 * rep_;
            for (;;) {
                const int idx = fa::next_item(ctr, slot); if (idx >= 16 * 129) break;
                int hh; bool meta = false; fa::Item it; int b = 0, qb = 0;
                if (idx < 2048) { qb = 7 - (idx >> 8); const int rest = idx & 255; hh = (rest < 128) ? 8 + (rest & 7) : (rest & 7); b = (rest & 127) >> 3; it = fa::make_item(false, b, qb); }
                else { hh = idx - 2048; hh = hh < 8 ? 8 + hh : hh - 8; meta = true; it = fa::make_item(true, 0, 0); }
                if (hh < 8) {
                    bf16x8 qr[8]; fa::load_q<128>(P, it, C_DQ + hh * 128, qr);
                    fa::attn_core<128, true>(P, it, qr, C_DK + hh * 128, 0, C_DV + hh * 128, dummy ? C_KPE : C_OB + hh * 128, meta ? nullptr : bm + (size_t)(b * SEQ + qb * 256) * BMW, F.lds);
                } else {
                    const int hj = hh - 8;
                    bf16x8 qr[8]; fa::load_q<128>(P, it, C_FQ + hj * 128, qr);
                    fa::attn_core<128, false>(P, it, qr, C_FK + hj * 128, 0, C_FV + (hj >> 1) * 256, dummy ? C_KPE : C_FQ + hj * 128, nullptr, F.lds);
                    fa::attn_core<128, false>(P, it, qr, C_FK + hj * 128, 0, C_FV + (hj >> 1) * 256 + 128, dummy ? C_KPE : C_IQ + hj * 128, nullptr, F.lds);
                }
            } }
            SEAM(pb + 8);
        }
        if (((PHMASK >> 9) & 1) && IN(pb + 9)) {
            PH_BEGIN;
            const float* diff_lam = arg_in(args, 12) + ly * 4 * 128; const float* diff_subg = arg_in(args, 13) + ly * 256;
            const float lambda_init = LAMBDA_INIT(ly);
            const float s1 = wave_sum(diff_lam[F.lane] * diff_lam[128 + F.lane] + diff_lam[64 + F.lane] * diff_lam[192 + F.lane]);
            const float s2 = wave_sum(diff_lam[256 + F.lane] * diff_lam[384 + F.lane] + diff_lam[320 + F.lane] * diff_lam[448 + F.lane]);
            const float lam = __expf(s1) - __expf(s2) + lambda_init;
            bf16_t* P = P_;
            for (int r = MROW0 + F.gw; r < R; r += F.ngw) post3_row(P, r, diff_subg, lam, 1.f - lambda_init, F.lane);
            SEAM(pb + 9);
        }
#define GATE_PHASE(k, b) \
        if (((PHMASK >> 10) & 1) && IN(pb + (k))) { \
            PH_BEGIN; \
            { SkGate f{(bf16_t*)(ws + WS_GS), arg_in(args, 4) + ly * 3 * DM + (b) * DM, RS_(2 * ly)}; skinny_gemm(F.lds, XN_ + (size_t)MROW0 * DM, DM, WB_(WB_G) + (size_t)(b) * 2048 * DM, DM, 2048 / 16, F.bid, F.G, f); } \
            SchedPlain S{XN_, DM, WB_(WB_G) + (size_t)(b) * 2048 * DM, DM, NPMM, 8, F.G, F.bid, 0}; EpiGate E{(bf16_t*)(ws + WS_GS), arg_in(args, 4) + ly * 3 * DM + (b) * DM, RS_(2 * ly)}; \
            pg8::gemm_phase(F.lds, S, E); \
            if (NREP(k) == 2) { GRID_BAR(); pg8::gemm_phase(F.lds, S, E); } \
            SEAM(pb + (k)); \
        }
#define BRANCH_PHASE(k, b, oc) \
        if (((PHMASK >> 10) & 1) && IN(pb + (k))) { \
            PH_BEGIN; \
            { SkGated f{P_, (const bf16_t*)(ws + WS_GS), (b) == 0 ? 1 : 0}; skinny_gemm(F.lds, P_ + (size_t)MROW0 * PW + (oc), PW, WB_(WB_BR) + (size_t)(b) * DM * 1024, 1024, 2048 / 16, F.bid, F.G, f); } \
            SchedPlain S{P_ + (oc), PW, WB_(WB_BR) + (size_t)(b) * DM * 1024, 1024, NPMM, 8, F.G, F.bid, C_MERGED}; EpiGated E{P_, (const bf16_t*)(ws + WS_GS), (b) == 0 ? 1 : 0, ((DBG_BM >> (b)) & 1) ? 1.f : 0.f}; \
            pg8::gemm_phase(F.lds, S, E); \
            if (NREP(k) == 2 && (b) == 0) { GRID_BAR(); pg8::gemm_phase(F.lds, S, E); } \
            SEAM(pb + (k)); \
        }
        GATE_PHASE(10, 0) BRANCH_PHASE(11, 0, C_OA)
        GATE_PHASE(12, 1) BRANCH_PHASE(13, 1, C_OB)
        GATE_PHASE(14, 2) BRANCH_PHASE(15, 2, C_OC)
        if (((PHMASK >> 11) & 1) && IN(pb + 16)) {
            PH_BEGIN;
            { SkRes f{HMETA_, XN_, RS_(2 * ly + 1)}; skinny_gemm(F.lds, P_ + (size_t)MROW0 * PW + C_MERGED, PW, WB_(WB_O), DM, 2048 / 16, F.bid, F.G, f); }
            SchedPlain S{P_ + C_MERGED, PW, WB_(WB_O), DM, NPMM, 8, F.G, F.bid, 0}; EpiRes E{HSRC_TOK(ly), OUT_, HMETA_, DBG_SA, XN_, RS_(2 * ly + 1)};
            pg8::gemm_phase(F.lds, S, E);
            SEAM(pb + 16);
        }
        if (((PHMASK >> 13) & 1) && IN(pb + 17)) {
            PH_BEGIN;
            skinny_swiglu(F.lds, XN_ + (size_t)MROW0 * DM, DM, WB_(WB_F1), DM, P_, RS_(2 * ly + 1), F.bid, F.G);
            SchedPlain S{XN_, DM, WB_(WB_F1), DM, NPMM, 44, F.G, F.bid, 0}; EpiSwiglu E{P_, RS_(2 * ly + 1)};
            pg8::gemm_phase(F.lds, S, E);
            if (NREP(17) == 2) { GRID_BAR(); pg8::gemm_phase(F.lds, S, E); }
            SEAM(pb + 17);
        }
        if (((PHMASK >> 14) & 1) && IN(pb + 18)) {
            PH_BEGIN;
            { SkRes f{HMETA_, ly == 0 ? XN_ : (bf16_t*)nullptr, RS_(2)}; skinny_gemm(F.lds, P_ + (size_t)MROW0 * PW, PW, WB_(WB_F2), DFF, 2048 / 16, F.bid, F.G, f); }
            SchedPlain S{P_, PW, WB_(WB_F2), DFF, NPMM, 8, F.G, F.bid, 0}; EpiRes E{OUT_, OUT_, HMETA_, DBG_SF, ly == 0 ? XN_ : (bf16_t*)nullptr, RS_(2)};
            pg8::gemm_phase(F.lds, S, E);
            SEAM(pb + 18);
        }
    }
#undef IN
#undef SEAM
}

__global__ void diag_fill(float* out, int n, float v) { for (int i = blockIdx.x * blockDim.x + threadIdx.x; i < n; i += gridDim.x * blockDim.x) out[i] = v; }
extern "C" void kernel_launch(void* const* d_in, const int* in_sizes, int n_in, void* d_out, int out_size, void* d_ws, size_t ws_size, hipStream_t stream) {
    static int grid = 0; static float code = 0.f;
    if (grid == 0) {
        int dev = 0, cus = 0;
        if (n_in != 19) { code = 10.f; grid = -1; }
        else if (ws_size < WS_END) { code = 20.f + (float)(ws_size >> 20) * 0.01f; grid = -1; }
        else if (hipGetDevice(&dev) != hipSuccess || hipDeviceGetAttribute(&cus, hipDeviceAttributeMultiprocessorCount, dev) != hipSuccess) { code = 40.f; grid = -1; }
        else if (hipFuncSetAttribute((const void*)mega_fwd, hipFuncAttributeMaxDynamicSharedMemorySize, LDS_BYTES) != hipSuccess) { code = 50.f; grid = -1; }
        else {
            int per_cu = 0;
            if (hipOccupancyMaxActiveBlocksPerMultiprocessor(&per_cu, (const void*)mega_fwd, NWAVES * 64, LDS_BYTES) != hipSuccess || per_cu < 1) { code = 60.f; grid = -1; }
            (void)hipGetLastError();
            if (grid == 0) grid = cus;
        }
    }
    if (grid < 0) { hipLaunchKernelGGL(diag_fill, dim3(1024), dim3(256), 0, stream, (float*)d_out, out_size, code); return; }
    (void)hipMemsetAsync((char*)d_ws + WS_CTL, 0, CTL_BYTES, stream);
    Args a{};
    for (int i = 0; i < 19; ++i) a.in[i] = (const float*)d_in[i];
    a.out = (float*)d_out; a.ws = (unsigned char*)d_ws;
#if MK_ONE_LAUNCH
    a.ph_lo = 0; a.ph_hi = N_PHASES;
    hipLaunchKernelGGL(mega_fwd, dim3(grid), dim3(NWAVES * 64), LDS_BYTES, stream, a);
#else
    for (int p = 0; p < N_PHASES; ++p) { a.ph_lo = p; a.ph_hi = p + 1; hipLaunchKernelGGL(mega_fwd, dim3(grid), dim3(NWAVES * 64), LDS_BYTES, stream, a); }
#endif
    if (hipPeekAtLastError() != hipSuccess) { (void)hipGetLastError(); hipLaunchKernelGGL(diag_fill, dim3(1024), dim3(256), 0, stream, (float*)d_out, out_size, 70.f); }
}
```

```cpp
#include <hip/hip_runtime.h>
#include <cstdio>
#include <cstdint>

#ifndef PHMASK
#define PHMASK 0x7fff
#endif
#ifndef REPMASK
#define REPMASK 0
#endif
#define NREP(k) ((((REPMASK) >> (k)) & 1) ? 2 : 1)
#ifndef DBG_BM
#define DBG_BM 7
#endif
#ifndef DBG_BR
#define DBG_BR 0
#endif
#ifndef DBG_SA
#define DBG_SA 1.0f
#endif
#ifndef DBG_SF
#define DBG_SF 1.0f
#endif
#ifndef MK_ONE_LAUNCH
#define MK_ONE_LAUNCH 1
#endif

#define LAS __attribute__((address_space(3)))
#define GAS __attribute__((address_space(1)))
typedef unsigned short bf16_t;
typedef short bf16x8 __attribute__((ext_vector_type(8)));
typedef float f32x4 __attribute__((ext_vector_type(4)));
typedef float f32x2 __attribute__((ext_vector_type(2)));
typedef unsigned u32x4 __attribute__((ext_vector_type(4)));
typedef unsigned u32x2 __attribute__((ext_vector_type(2)));

constexpr int DM = 2048, NB = 16, SEQ = 2048, NMETA = 16, MBLK = 256;
constexpr int R = MBLK + NB * SEQ;
constexpr int NPM = R / 256;
constexpr int NPMM = NPM - 1;
constexpr int MROW0 = MBLK - NMETA;
constexpr int NTOK = NB * SEQ;
constexpr int DFF = 5632;
constexpr int PW = 8448;
constexpr int C_CQ = 0, C_CKV = 512, C_KPE = 1024, C_IK = 1088, C_IW = 1152, C_DQ = 1280, C_DK = 2304, C_DV = 3328, C_IQ = 4352,
              C_FQ = 5376, C_FK = 6400, C_FV = 7424;
constexpr int C_KVRAW = 1280, C_QRAW = 3328, C_KPEH = 4864;
constexpr int C_OA = 0, C_OB = C_DQ, C_OC = C_FQ, C_MERGED = 2304;
constexpr int BMW = 66;
constexpr float EPS = 1e-6f;
constexpr float LOG2E = 1.4426950408889634f;
constexpr float C2_128 = 0.08838834764831845f * LOG2E;
constexpr float C2_192 = 0.07216878364870323f * LOG2E;
constexpr int D_IN = 14480;

constexpr size_t MiB = 1u << 20;
constexpr size_t WS_CTL = 0, CTL_BYTES = 1 * MiB;
constexpr size_t WS_RSTD = 1 * MiB;
constexpr size_t WS_HMETA = 2 * MiB;
constexpr size_t WS_BM = 4 * MiB;
constexpr size_t WS_WB = 16 * MiB;
constexpr size_t WB_IN = 0, WB_G = WB_IN + (size_t)8448 * 2048 * 2, WB_QUP = WB_G + (size_t)6144 * 2048 * 2, WB_KVUP = WB_QUP + (size_t)1536 * 512 * 2,
                 WB_BR = WB_KVUP + (size_t)2048 * 512 * 2, WB_O = WB_BR + (size_t)3 * 2048 * 1024 * 2, WB_F1 = WB_O + (size_t)2048 * 2048 * 2,
                 WB_F2 = WB_F1 + (size_t)11264 * 2048 * 2, WB_END = WB_F2 + (size_t)2048 * 5632 * 2;
constexpr size_t WS_XN = 164 * MiB;
constexpr size_t WS_P = 294 * MiB;
constexpr size_t WS_GS = 828 * MiB;
constexpr size_t WS_END = 960 * MiB;
static_assert(WS_GS + (size_t)R * 2048 * 2 <= WS_END && WS_WB + WB_END <= WS_XN && WS_XN + (size_t)R * 2048 * 2 <= WS_P && WS_P + (size_t)R * PW * 2 <= WS_GS, "ws map");
constexpr int CW_BAR = 4096, CW_Q = 16384;
constexpr size_t WS_RS = 256 * 1024;

__device__ __forceinline__ float bf2f(bf16_t v) { return __uint_as_float((unsigned)v << 16); }
__device__ __forceinline__ unsigned f2bf(float f) { unsigned u = __float_as_uint(f); return (u + 0x7fffu + ((u >> 16) & 1u)) >> 16; }
__device__ __forceinline__ unsigned pk2(float lo, float hi) { return f2bf(lo) | (f2bf(hi) << 16); }
typedef __bf16 bf16x2_t __attribute__((ext_vector_type(2)));
__device__ __forceinline__ unsigned cvt_pk_bf16(float lo, float hi) { f32x2 v = {lo, hi}; bf16x2_t b = __builtin_convertvector(v, bf16x2_t); return __builtin_bit_cast(unsigned, b); }
__device__ __forceinline__ float wave_sum(float v) {
#pragma unroll
    for (int o = 1; o < 64; o <<= 1) v += __shfl_xor(v, o);
    return v;
}
__device__ __forceinline__ float wave_max(float v) {
#pragma unroll
    for (int o = 1; o < 64; o <<= 1) v = fmaxf(v, __shfl_xor(v, o));
    return v;
}
#define LDS_WAIT() asm volatile("s_waitcnt lgkmcnt(0)" ::: "memory")
#define VM_WAIT() asm volatile("s_waitcnt vmcnt(0)" ::: "memory")
__device__ __forceinline__ int row_pos(int r) { return r < MBLK ? (r >= MBLK - NMETA ? r - (MBLK - NMETA) : 0) : NMETA + ((r - MBLK) & (SEQ - 1)); }
__device__ __forceinline__ void rope_cs(int pos, int i, float two_over_d, float& c, float& s) {
    const float inv = __builtin_amdgcn_exp2f(-(float)i * two_over_d * 13.287712379549449f);
    float rev = (float)pos * inv * 0.15915494309189535f;
    rev -= floorf(rev);
    s = __builtin_amdgcn_sinf(rev); c = __builtin_amdgcn_cosf(rev);
}

namespace pg8 {
constexpr int BM = 256, BK = 64, HALF = 128, HTB = HALF * BK * 2, STAGE_BYTES = 8 * HTB;
__device__ __forceinline__ int lds_byte(int r, int c) { const int st = (r >> 4) * 2 + (c >> 5), rr = r & 15, cc = c & 31, ob = rr * 64 + cc * 2; return st * 1024 + (ob ^ (((ob >> 9) & 1) << 5)); }
__device__ __forceinline__ void stage_rc(int b, int& R_, int& C_) { const int st = b / 1024, sb = b % 1024, swz = sb ^ (((sb >> 9) & 1) << 5); R_ = (st >> 1) * 16 + swz / 64; C_ = (st & 1) * 32 + (swz % 64) / 2; }
__device__ __forceinline__ int perm32(int rho) { const int n = rho >> 4, i = rho & 15; return 8 * (i >> 2) + 4 * n + (i & 3); }

struct Unit { const char* A; const char* B; unsigned lda2, ldb2; int nt, pm, pn, kind, ocol; };

__device__ __forceinline__ void tile_of(int L, int nM, int nN, int& pm, int& pn) {
    const int nwg = nM * nN; int wgid = L;
    { const int q = nwg / 8, r = nwg % 8, xcd = wgid % 8, off = wgid / 8; wgid = (xcd < r ? xcd * (q + 1) : r * (q + 1) + (xcd - r) * q) + off; }
    const int nig = 8 * nN, gid = wgid / nig, fm = gid * 8, gsz = (nM - fm) < 8 ? (nM - fm) : 8;
    pm = fm + ((wgid % nig) % gsz); pn = (wgid % nig) / gsz;
}

template <class Epi, class Sched>
__device__ __forceinline__ void gemm_phase(LAS unsigned char* lds, const Sched& S, const Epi& E) {
    int tid = threadIdx.x; asm volatile("" : "+v"(tid));
    const int wid = __builtin_amdgcn_readfirstlane(tid >> 6), lane = tid & 63, wr = wid >> 2, wc = wid & 3, fr = lane & 15, fq = lane >> 4;
    unsigned rA[2], rB[2], cc[2];
#pragma unroll
    for (int i = 0; i < 2; ++i) { int R_, C_; stage_rc(tid * 16 + i * 8192, R_, C_); rA[i] = (unsigned)R_; rB[i] = (unsigned)(Epi::PERM ? ((R_ & ~31) + perm32(R_ & 31)) : R_); cc[i] = (unsigned)C_ * 2u; }
    const size_t kstep = (size_t)(BK * 2);
    const unsigned ldsw = (unsigned)wid * 1024u;
    const int aoff = lds_byte(wr * 64 + fr, fq * 8), boff = lds_byte(wc * 32 + fr, fq * 8);
#define PG8_SA(b, h) (((b) * 2 + (h)) * HTB)
#define PG8_SB(b, h) ((4 + (b) * 2 + (h)) * HTB)
#define PG8_STAGE(bufoff, gbase, rr, ld2) do { _Pragma("unroll") for (int _i = 0; _i < 2; ++_i) \
        __builtin_amdgcn_global_load_lds((const unsigned*)((const char*)(gbase) + ((rr)[_i] * (ld2) + cc[_i])), (LAS unsigned*)(lds + (bufoff) + ldsw + _i * 8192), 16, 0, 0); } while (0)
#define PG8_LDA(dst, b, h) do { _Pragma("unroll") for (int m = 0; m < 4; ++m) _Pragma("unroll") for (int k = 0; k < 2; ++k) dst[m][k] = *(const LAS bf16x8*)(lds + PG8_SA(b, h) + aoff + m * 2048 + k * 1024); } while (0)
#define PG8_LDB(dst, b, h) do { _Pragma("unroll") for (int n = 0; n < 2; ++n) _Pragma("unroll") for (int k = 0; k < 2; ++k) dst[n][k] = *(const LAS bf16x8*)(lds + PG8_SB(b, h) + boff + n * 2048 + k * 1024); } while (0)
#define PG8_MMA(ai, bj, At, Bt) do { __builtin_amdgcn_s_setprio(1); _Pragma("unroll") for (int m = 0; m < 4; ++m) _Pragma("unroll") for (int n = 0; n < 2; ++n) _Pragma("unroll") for (int k = 0; k < 2; ++k) \
        acc[ai][bj][m][n] = __builtin_amdgcn_mfma_f32_16x16x32_bf16(Bt[n][k], At[m][k], acc[ai][bj][m][n], 0, 0, 0); __builtin_amdgcn_s_setprio(0); } while (0)
#define PG8_WAIT_V(n) asm volatile("s_waitcnt vmcnt(" #n ")" ::: "memory")
#define PG8_WAIT_L(n) asm volatile("s_waitcnt lgkmcnt(" #n ")" ::: "memory")
#define PG8_BAR __builtin_amdgcn_s_barrier()
#define PG8_SCHED __builtin_amdgcn_sched_barrier(0)
    Unit cur, nxt; int ui = 0;
    if (!S.next(0, cur)) return;
    float zf = 0.f; asm volatile("" : "+v"(zf));
    f32x4 acc[2][2][4][2];
#pragma unroll
    for (int a = 0; a < 2; ++a)
#pragma unroll
        for (int b = 0; b < 2; ++b)
#pragma unroll
            for (int m = 0; m < 4; ++m)
#pragma unroll
                for (int n = 0; n < 2; ++n) acc[a][b][m][n] = (f32x4){zf, zf, zf, zf};
    bf16x8 At[4][2], B0[2][2], B1[2][2];
    const char* cA = cur.A; const char* cB = cur.B;
    unsigned lA = cur.lda2, lB = cur.ldb2;
    size_t hA = (size_t)HALF * lA, hB = (size_t)HALF * lB;
    PG8_STAGE(PG8_SB(0, 0), cB, rB, lB); PG8_STAGE(PG8_SB(0, 1), cB + hB, rB, lB); PG8_STAGE(PG8_SA(0, 0), cA, rA, lA); PG8_STAGE(PG8_SA(0, 1), cA + hA, rA, lA);
    if (wr == 1) PG8_BAR;
    PG8_WAIT_V(2); PG8_BAR;
    PG8_STAGE(PG8_SB(1, 0), cB + kstep, rB, lB); PG8_STAGE(PG8_SA(1, 0), cA + kstep, rA, lA); PG8_STAGE(PG8_SB(1, 1), cB + hB + kstep, rB, lB);
    PG8_WAIT_V(6); PG8_BAR;
    for (;;) {
        const bool has_next = S.next(ui + 1, nxt);
        if (!has_next) nxt = cur;
        const char* nA = nxt.A; const char* nB = nxt.B;
        const unsigned lAn = nxt.lda2, lBn = nxt.ldb2;
        const size_t hAn = (size_t)HALF * lAn, hBn = (size_t)HALF * lBn;
        const int nt = cur.nt;
        for (int t = 0; t < nt; t += 2) {
            const bool last = (t == nt - 2);
            const char* a1 = cA + (size_t)(t + 1) * kstep;
            const char* a2 = last ? nA : cA + (size_t)(t + 2) * kstep; const char* b2 = last ? nB : cB + (size_t)(t + 2) * kstep;
            const char* a3 = a2 + kstep; const char* b3 = b2 + kstep;
            const size_t hA2 = last ? hAn : hA, hB2 = last ? hBn : hB;
            const unsigned lA2 = last ? lAn : lA, lB2 = last ? lBn : lB;
            PG8_LDB(B0, 0, 0); PG8_LDB(B1, 0, 1); PG8_SCHED; PG8_LDA(At, 0, 0); PG8_STAGE(PG8_SA(1, 1), a1 + hA, rA, lA);
            PG8_WAIT_V(8); PG8_WAIT_L(0); PG8_BAR; PG8_MMA(0, 0, At, B0); PG8_MMA(0, 1, At, B1); PG8_BAR; PG8_SCHED;
            PG8_LDA(At, 0, 1); PG8_STAGE(PG8_SB(0, 0), b2, rB, lB2); PG8_STAGE(PG8_SB(0, 1), b2 + hB2, rB, lB2); PG8_STAGE(PG8_SA(0, 0), a2, rA, lA2);
            PG8_WAIT_V(8); PG8_WAIT_L(0); PG8_BAR; PG8_MMA(1, 0, At, B0); PG8_MMA(1, 1, At, B1); PG8_BAR; PG8_SCHED;
            PG8_LDB(B0, 1, 0); PG8_LDB(B1, 1, 1); PG8_SCHED; PG8_LDA(At, 1, 0); PG8_STAGE(PG8_SA(0, 1), a2 + hA2, rA, lA2);
            PG8_WAIT_V(8); PG8_WAIT_L(0); PG8_BAR; PG8_MMA(0, 0, At, B0); PG8_MMA(0, 1, At, B1); PG8_BAR; PG8_SCHED;
            PG8_LDA(At, 1, 1); PG8_STAGE(PG8_SB(1, 0), b3, rB, lB2); PG8_STAGE(PG8_SB(1, 1), b3 + hB2, rB, lB2); PG8_STAGE(PG8_SA(1, 0), a3, rA, lA2);
            PG8_WAIT_V(8); PG8_WAIT_L(0); PG8_BAR; PG8_MMA(1, 0, At, B0); PG8_MMA(1, 1, At, B1); PG8_BAR; PG8_SCHED;
        }
        if (wr == 0) PG8_BAR;
        E(acc, cur, wr, wc, fr, fq);
#pragma unroll
        for (int a = 0; a < 2; ++a)
#pragma unroll
            for (int b = 0; b < 2; ++b)
#pragma unroll
                for (int m = 0; m < 4; ++m)
#pragma unroll
                    for (int n = 0; n < 2; ++n) acc[a][b][m][n] = (f32x4){zf, zf, zf, zf};
        if (!has_next) break;
        cur = nxt; cA = nA; cB = nB; hA = hAn; hB = hBn; lA = lAn; lB = lBn; ++ui;
        if (wr == 1) PG8_BAR;
    }
    PG8_WAIT_V(0);
    PG8_BAR;
#undef PG8_SA
#undef PG8_SB
#undef PG8_STAGE
#undef PG8_LDA
#undef PG8_LDB
#undef PG8_MMA
#undef PG8_WAIT_V
#undef PG8_WAIT_L
#undef PG8_BAR
#undef PG8_SCHED
}
}
using pg8::Unit;

struct SchedPlain {
    const bf16_t* A; int lda; const bf16_t* B; int K; int nM, nN, G, c, ocol0;
    __device__ __forceinline__ bool next(int i, Unit& u) const {
        const int L = i * G + c; if (L >= nM * nN) return false;
        int pm, pn; pg8::tile_of(L, nM, nN, pm, pn); pm += 1;
        u.pm = pm; u.pn = pn; u.kind = 0; u.ocol = ocol0 + 256 * pn; u.nt = K / 64; u.lda2 = (unsigned)lda * 2u; u.ldb2 = (unsigned)K * 2u;
        u.A = (const char*)(A + (size_t)pm * 256 * lda); u.B = (const char*)(B + (size_t)pn * 256 * K); return true;
    }
};
struct SchedMlaUp {
    const bf16_t* P; const bf16_t* Wq; const bf16_t* Wkv; int G, c;
    __device__ __forceinline__ bool next(int i, Unit& u) const {
        const int L = i * G + c; if (L >= NPMM * 14) return false;
        int pm, pn; pg8::tile_of(L, NPMM, 14, pm, pn); pm += 1;
        u.pm = pm; u.pn = pn; u.kind = 0; u.nt = 8; u.lda2 = PW * 2u; u.ldb2 = 512 * 2u;
        if (pn < 6) { u.A = (const char*)(P + (size_t)pm * 256 * PW + C_CQ); u.B = (const char*)(Wq + (size_t)pn * 256 * 512); u.ocol = C_QRAW + 256 * pn; }
        else { u.A = (const char*)(P + (size_t)pm * 256 * PW + C_CKV); u.B = (const char*)(Wkv + (size_t)(pn - 6) * 256 * 512); u.ocol = C_KVRAW + 256 * (pn - 6); }
        return true;
    }
};
struct EpiP {
    static constexpr bool PERM = true;
    bf16_t* P; const float* rs;
    __device__ __forceinline__ void operator()(const f32x4 (&acc)[2][2][4][2], const Unit& u, int wr, int wc, int fr, int fq) const {
        asm volatile("" : "+v"(fr), "+v"(fq));
        const int row0 = u.pm * 256 + wr * 64 + fr, col0 = u.ocol + wc * 32 + 8 * fq;
#pragma unroll
        for (int ai = 0; ai < 2; ++ai)
#pragma unroll
            for (int m = 0; m < 4; ++m) { bf16_t* rowp = P + (size_t)(row0 + ai * 128 + m * 16) * PW + col0;
                const float sc = rs ? __builtin_amdgcn_rsqf(rs[row0 + ai * 128 + m * 16] * (1.f / DM) + EPS) : 1.f;
#pragma unroll
                for (int bj = 0; bj < 2; ++bj) { const f32x4 v0 = acc[ai][bj][m][0] * sc, v1 = acc[ai][bj][m][1] * sc;
                    u32x4 w; w.x = cvt_pk_bf16(v0[0], v0[1]); w.y = cvt_pk_bf16(v0[2], v0[3]); w.z = cvt_pk_bf16(v1[0], v1[1]); w.w = cvt_pk_bf16(v1[2], v1[3]);
                    *(u32x4*)(rowp + bj * 128) = w; } }
    }
};
struct EpiG2 {
    static constexpr bool PERM = true;
    bf16_t* P; const float* rs; const float* gperm; LAS float* xl;
    __device__ __forceinline__ void operator()(const f32x4 (&acc)[2][2][4][2], const Unit& u, int wr, int wc, int fr, int fq) const {
        asm volatile("" : "+v"(fr), "+v"(fq));
        const int row0 = u.pm * 256 + wr * 64 + fr, lcol = wc * 32 + 8 * fq, col0 = u.ocol + lcol;
        const int pn = u.pn;
        const bool plain = (pn >= 8 && pn < 12) || pn >= 24, isidx = (pn >= 12 && pn < 16), nrm = !plain && !isidx;
        float rsc[2][4];
#pragma unroll
        for (int ai = 0; ai < 2; ++ai)
#pragma unroll
            for (int m = 0; m < 4; ++m) rsc[ai][m] = __builtin_amdgcn_rsqf(rs[row0 + ai * 128 + m * 16] * (1.f / DM) + EPS);
        if (nrm) {
#pragma unroll
            for (int ai = 0; ai < 2; ++ai)
#pragma unroll
                for (int m = 0; m < 4; ++m)
#pragma unroll
                    for (int bj = 0; bj < 2; ++bj) { const f32x4 a = acc[ai][bj][m][0], b = acc[ai][bj][m][1]; float ss = (a[0] * a[0] + a[1] * a[1]) + (a[2] * a[2] + a[3] * a[3]) + (b[0] * b[0] + b[1] * b[1]) + (b[2] * b[2] + b[3] * b[3]);
                        ss += __shfl_xor(ss, 16); ss += __shfl_xor(ss, 32);
                        if (fq == 0) xl[((wr * 64 + fr + ai * 128 + m * 16) * 2 + bj) * 4 + wc] = ss * rsc[ai][m] * rsc[ai][m]; }
            asm volatile("s_waitcnt lgkmcnt(0)" ::: "memory"); __builtin_amdgcn_s_barrier(); asm volatile("" ::: "memory");
        }
        const int i0 = isidx ? (16 * (wc & 1) + 4 * fq) : (16 * wc + 4 * fq);
        const float tod = isidx ? (2.f / 64.f) : (2.f / 128.f);
        float inv[4];
#pragma unroll
        for (int j = 0; j < 4; ++j) inv[j] = __builtin_amdgcn_exp2f(-(float)(i0 + j) * tod * 13.287712379549449f) * 0.15915494309189535f;
        const int gidx = pn < 4 ? 0 : (pn < 8 ? 1 : (pn < 20 ? 2 : 3));
        const float qscale = (pn < 4 || (pn >= 16 && pn < 20)) ? C2_128 : 1.f;
        f32x4 g0 = (f32x4){1.f, 1.f, 1.f, 1.f}, g1 = g0;
        if (nrm) { g0 = *(const f32x4*)(gperm + gidx * 128 + lcol); g1 = *(const f32x4*)(gperm + gidx * 128 + lcol + 4); }
#pragma unroll
        for (int ai = 0; ai < 2; ++ai)
#pragma unroll
            for (int m = 0; m < 4; ++m) { const int row = row0 + ai * 128 + m * 16; bf16_t* rowp = P + (size_t)row * PW + col0;
                float cs[4], sn[4];
                if (!plain) { const float pos = (float)(NMETA + ((row - MBLK) & (SEQ - 1)));
#pragma unroll
                    for (int j = 0; j < 4; ++j) { float rev = pos * inv[j]; rev -= floorf(rev); sn[j] = __builtin_amdgcn_sinf(rev); cs[j] = __builtin_amdgcn_cosf(rev); } }
#pragma unroll
                for (int bj = 0; bj < 2; ++bj) { f32x4 v0 = acc[ai][bj][m][0] * rsc[ai][m], v1 = acc[ai][bj][m][1] * rsc[ai][m];
                    if (!plain) {
                        if (nrm) { const LAS f32x4* xp = (const LAS f32x4*)(xl + ((wr * 64 + fr + ai * 128 + m * 16) * 2 + bj) * 4); const f32x4 pp = *xp;
                            const float rn = __builtin_amdgcn_rsqf(((pp[0] + pp[1]) + (pp[2] + pp[3])) * (1.f / 128.f) + EPS); v0 = v0 * (g0 * rn); v1 = v1 * (g1 * rn); }
                        f32x4 w0, w1;
                        w0[0] = v0[0] * cs[0] - v0[1] * sn[0]; w0[1] = v0[1] * cs[0] + v0[0] * sn[0]; w0[2] = v0[2] * cs[1] - v0[3] * sn[1]; w0[3] = v0[3] * cs[1] + v0[2] * sn[1];
                        w1[0] = v1[0] * cs[2] - v1[1] * sn[2]; w1[1] = v1[1] * cs[2] + v1[0] * sn[2]; w1[2] = v1[2] * cs[3] - v1[3] * sn[3]; w1[3] = v1[3] * cs[3] + v1[2] * sn[3];
                        v0 = w0 * qscale; v1 = w1 * qscale; }
                    u32x4 w; w.x = cvt_pk_bf16(v0[0], v0[1]); w.y = cvt_pk_bf16(v0[2], v0[3]); w.z = cvt_pk_bf16(v1[0], v1[1]); w.w = cvt_pk_bf16(v1[2], v1[3]);
                    *(u32x4*)(rowp + bj * 128) = w; } }
    }
};
struct EpiGate {
    static constexpr bool PERM = true;
    bf16_t* G; const float* bias; const float* rs;
    __device__ __forceinline__ void operator()(const f32x4 (&acc)[2][2][4][2], const Unit& u, int wr, int wc, int fr, int fq) const {
        asm volatile("" : "+v"(fr), "+v"(fq));
        const int row0 = u.pm * 256 + wr * 64 + fr, col0 = u.pn * 256 + wc * 32 + 8 * fq;
        float rsc[2][4];
#pragma unroll
        for (int ai = 0; ai < 2; ++ai)
#pragma unroll
            for (int m = 0; m < 4; ++m) rsc[ai][m] = __builtin_amdgcn_rsqf(rs[row0 + ai * 128 + m * 16] * (1.f / DM) + EPS);
#pragma unroll
        for (int bj = 0; bj < 2; ++bj) { const f32x4 bv0 = *(const f32x4*)(bias + col0 + bj * 128), bv1 = *(const f32x4*)(bias + col0 + bj * 128 + 4);
#pragma unroll
            for (int ai = 0; ai < 2; ++ai)
#pragma unroll
                for (int m = 0; m < 4; ++m) { bf16_t* rowp = G + (size_t)(row0 + ai * 128 + m * 16) * 2048 + col0; f32x4 v0 = acc[ai][bj][m][0] * rsc[ai][m] + bv0, v1 = acc[ai][bj][m][1] * rsc[ai][m] + bv1;
#pragma unroll
                    for (int e = 0; e < 4; ++e) { v0[e] = __builtin_amdgcn_rcpf(1.f + __builtin_amdgcn_exp2f(-v0[e] * LOG2E)); v1[e] = __builtin_amdgcn_rcpf(1.f + __builtin_amdgcn_exp2f(-v1[e] * LOG2E)); }
                    u32x4 w; w.x = cvt_pk_bf16(v0[0], v0[1]); w.y = cvt_pk_bf16(v0[2], v0[3]); w.z = cvt_pk_bf16(v1[0], v1[1]); w.w = cvt_pk_bf16(v1[2], v1[3]);
                    *(u32x4*)(rowp + bj * 128) = w; } }
    }
};
struct EpiGated {
    static constexpr bool PERM = true;
    bf16_t* P; const bf16_t* G; int first; float sc;
    __device__ __forceinline__ void operator()(const f32x4 (&acc)[2][2][4][2], const Unit& u, int wr, int wc, int fr, int fq) const {
        asm volatile("" : "+v"(fr), "+v"(fq));
        const int row0 = u.pm * 256 + wr * 64 + fr, lcol0 = u.pn * 256 + wc * 32 + 8 * fq, col0 = u.ocol + wc * 32 + 8 * fq;
        unsigned zu = 0u; asm volatile("" : "+v"(zu));
#pragma unroll
        for (int ai = 0; ai < 2; ++ai)
#pragma unroll
            for (int m = 0; m < 4; ++m) { bf16_t* rowp = P + (size_t)(row0 + ai * 128 + m * 16) * PW + col0; const bf16_t* gp = G + (size_t)(row0 + ai * 128 + m * 16) * 2048 + lcol0;
#pragma unroll
                for (int bj = 0; bj < 2; ++bj) { u32x4 g = *(const u32x4*)(gp + bj * 128); if (DBG_BR == 1) g = (u32x4){0x3f803f80u, 0x3f803f80u, 0x3f803f80u, 0x3f803f80u};
                    u32x4 pv = (u32x4){zu, zu, zu, zu}; if (!first) pv = *(const u32x4*)(rowp + bj * 128);
                    const f32x4 v0 = acc[ai][bj][m][0] * sc, v1 = acc[ai][bj][m][1] * sc;
                    float o[8];
                    o[0] = __uint_as_float(pv.x << 16) + __uint_as_float(g.x << 16) * v0[0]; o[1] = __uint_as_float(pv.x & 0xffff0000u) + __uint_as_float(g.x & 0xffff0000u) * v0[1];
                    o[2] = __uint_as_float(pv.y << 16) + __uint_as_float(g.y << 16) * v0[2]; o[3] = __uint_as_float(pv.y & 0xffff0000u) + __uint_as_float(g.y & 0xffff0000u) * v0[3];
                    o[4] = __uint_as_float(pv.z << 16) + __uint_as_float(g.z << 16) * v1[0]; o[5] = __uint_as_float(pv.z & 0xffff0000u) + __uint_as_float(g.z & 0xffff0000u) * v1[1];
                    o[6] = __uint_as_float(pv.w << 16) + __uint_as_float(g.w << 16) * v1[2]; o[7] = __uint_as_float(pv.w & 0xffff0000u) + __uint_as_float(g.w & 0xffff0000u) * v1[3];
                    u32x4 w; w.x = cvt_pk_bf16(o[0], o[1]); w.y = cvt_pk_bf16(o[2], o[3]); w.z = cvt_pk_bf16(o[4], o[5]); w.w = cvt_pk_bf16(o[6], o[7]);
                    *(u32x4*)(rowp + bj * 128) = w; }
                asm volatile("" ::: "memory"); }
    }
};
struct EpiRes {
    static constexpr bool PERM = false;
    const float* base_tok; float* out_tok; float* hmeta; float dbg; bf16_t* hb; float* rs;
    __device__ __forceinline__ void operator()(const f32x4 (&acc)[2][2][4][2], const Unit& u, int wr, int wc, int fr, int fq) const {
        asm volatile("" : "+v"(fr), "+v"(fq));
        const float* bp; float* op;
        if (u.pm == 0) { bp = hmeta; op = hmeta; } else { bp = base_tok + (size_t)(u.pm - 1) * 256 * DM; op = out_tok + (size_t)(u.pm - 1) * 256 * DM; }
        const int lrow0 = wr * 64 + fr, col0 = u.pn * 256 + wc * 32 + 4 * fq;
#pragma unroll
        for (int ai = 0; ai < 2; ++ai)
#pragma unroll
            for (int m = 0; m < 4; ++m) { const size_t off = (size_t)(lrow0 + ai * 128 + m * 16) * DM + col0;
                const int grow = u.pm * 256 + lrow0 + ai * 128 + m * 16; float ss = 0.f;
#pragma unroll
                for (int bj = 0; bj < 2; ++bj)
#pragma unroll
                    for (int n = 0; n < 2; ++n) { const f32x4 bs = *(const f32x4*)(bp + off + bj * 128 + n * 16); const f32x4 hv = bs + acc[ai][bj][m][n] * dbg; *(f32x4*)(op + off + bj * 128 + n * 16) = hv;
                        if (hb) { ss += (hv[0] * hv[0] + hv[1] * hv[1]) + (hv[2] * hv[2] + hv[3] * hv[3]); u32x2 w; w.x = cvt_pk_bf16(hv[0], hv[1]); w.y = cvt_pk_bf16(hv[2], hv[3]); *(u32x2*)(hb + (size_t)grow * DM + col0 + bj * 128 + n * 16) = w; } }
                if (hb) { ss += __shfl_xor(ss, 16); ss += __shfl_xor(ss, 32); if (fq == 0) (void)__hip_atomic_fetch_add(rs + grow, ss, __ATOMIC_RELAXED, __HIP_MEMORY_SCOPE_AGENT); }
                asm volatile("" ::: "memory"); }
    }
};
struct EpiSwiglu {
    static constexpr bool PERM = true;
    bf16_t* P; const float* rs;
    __device__ __forceinline__ void operator()(const f32x4 (&acc)[2][2][4][2], const Unit& u, int wr, int wc, int fr, int fq) const {
        asm volatile("" : "+v"(fr), "+v"(fq));
        const int row0 = u.pm * 256 + wr * 64 + fr, col0 = u.pn * 128 + wc * 32 + 8 * fq;
#pragma unroll
        for (int ai = 0; ai < 2; ++ai)
#pragma unroll
            for (int m = 0; m < 4; ++m) { bf16_t* rowp = P + (size_t)(row0 + ai * 128 + m * 16) * PW + col0;
                const float sc = __builtin_amdgcn_rsqf(rs[row0 + ai * 128 + m * 16] * (1.f / DM) + EPS);
                float o[8];
#pragma unroll
                for (int n = 0; n < 2; ++n)
#pragma unroll
                    for (int e = 0; e < 4; ++e) { const float g = acc[ai][0][m][n][e] * sc, up = acc[ai][1][m][n][e] * sc; o[n * 4 + e] = g * __builtin_amdgcn_rcpf(1.f + __builtin_amdgcn_exp2f(-g * LOG2E)) * up; }
                u32x4 w; w.x = cvt_pk_bf16(o[0], o[1]); w.y = cvt_pk_bf16(o[2], o[3]); w.z = cvt_pk_bf16(o[4], o[5]); w.w = cvt_pk_bf16(o[6], o[7]);
                *(u32x4*)rowp = w; }
    }
};

struct SkP { bf16_t* P; int ocol; const float* rs; __device__ __forceinline__ void operator()(int r, int c, float v) const { if (rs) v *= __builtin_amdgcn_rsqf(rs[MROW0 + r] * (1.f / DM) + EPS); P[(size_t)(MROW0 + r) * PW + ocol + c] = (bf16_t)f2bf(v); } };
struct SkGate { bf16_t* G; const float* bias; const float* rs; __device__ __forceinline__ void operator()(int r, int c, float v) const { v *= __builtin_amdgcn_rsqf(rs[MROW0 + r] * (1.f / DM) + EPS); G[(size_t)(MROW0 + r) * 2048 + c] = (bf16_t)f2bf(__builtin_amdgcn_rcpf(1.f + __builtin_amdgcn_exp2f(-(v + bias[c]) * LOG2E))); } };
struct SkGated { bf16_t* P; const bf16_t* G; int first; __device__ __forceinline__ void operator()(int r, int c, float v) const { bf16_t* p = P + (size_t)(MROW0 + r) * PW + C_MERGED + c; const float pv = first ? 0.f : bf2f(*p); *p = (bf16_t)f2bf(pv + bf2f(G[(size_t)(MROW0 + r) * 2048 + c]) * v); } };
struct SkRes { float* hmeta; bf16_t* hb; float* rs;
    __device__ __forceinline__ void operator()(int r, int c, float v) const { float* p = hmeta + (size_t)(MROW0 + r) * DM + c; const float hv = *p + v; *p = hv;
        if (hb) { hb[(size_t)(MROW0 + r) * DM + c] = (bf16_t)f2bf(hv); float ss = hv * hv; ss += __shfl_xor(ss, 1); ss += __shfl_xor(ss, 2); ss += __shfl_xor(ss, 4); ss += __shfl_xor(ss, 8);
            if ((threadIdx.x & 15) == 0) (void)__hip_atomic_fetch_add(rs + MROW0 + r, ss, __ATOMIC_RELAXED, __HIP_MEMORY_SCOPE_AGENT); } } };
template <class Fn>
__device__ __forceinline__ void skinny_gemm(LAS unsigned char* lds, const bf16_t* A, int lda, const bf16_t* Bt, int K, int ntask, int bid, int G, const Fn& f) {
    int tid = threadIdx.x; asm volatile("" : "+v"(tid));
    const int wid = __builtin_amdgcn_readfirstlane(tid >> 6), lane = tid & 63, l15 = lane & 15, kq = lane >> 4;
    LAS f32x4* red = (LAS f32x4*)lds;
    const int kw = K / 8;
    for (int task = bid; task < ntask; task += G) {
        const bf16_t* ap = A + (size_t)l15 * lda + wid * kw + kq * 8;
        const bf16_t* bp = Bt + (size_t)(task * 16 + l15) * K + wid * kw + kq * 8;
        float z = 0.f; asm volatile("" : "+v"(z));
        f32x4 acc = (f32x4){z, z, z, z};
        for (int k0 = 0; k0 < kw; k0 += 256) {
            bf16x8 fa[8], fb[8];
#pragma unroll
            for (int i = 0; i < 8; ++i) { const int k = (k0 + 32 * i < kw) ? k0 + 32 * i : 0; fa[i] = *(const bf16x8*)(ap + k); fb[i] = *(const bf16x8*)(bp + k); }
#pragma unroll
            for (int i = 0; i < 8; ++i) if (k0 + 32 * i < kw) acc = __builtin_amdgcn_mfma_f32_16x16x32_bf16(fa[i], fb[i], acc, 0, 0, 0);
        }
        red[wid * 64 + lane] = acc;
        LDS_WAIT(); __syncthreads();
        if (wid == 0) {
            f32x4 s = red[lane];
#pragma unroll
            for (int w = 1; w < 8; ++w) s += red[w * 64 + lane];
#pragma unroll
            for (int r = 0; r < 4; ++r) f(kq * 4 + r, task * 16 + l15, s[r]);
        }
        __syncthreads();
    }
}
__device__ __forceinline__ void skinny_swiglu(LAS unsigned char* lds, const bf16_t* A, int lda, const bf16_t* Bt, int K, bf16_t* P, const float* rs, int bid, int G) {
    int tid = threadIdx.x; asm volatile("" : "+v"(tid));
    const int wid = __builtin_amdgcn_readfirstlane(tid >> 6), lane = tid & 63, l15 = lane & 15, kq = lane >> 4;
    LAS f32x4* red = (LAS f32x4*)lds;
    const int kw = K / 8;
    for (int task = bid; task < DFF / 16; task += G) {
        const int c0 = task * 16, brow = (c0 >> 7) * 256 + (c0 & 127) + l15;
        const bf16_t* ap = A + (size_t)l15 * lda + wid * kw + kq * 8;
        const bf16_t* bg = Bt + (size_t)brow * K + wid * kw + kq * 8; const bf16_t* bu = bg + (size_t)128 * K;
        float z = 0.f; asm volatile("" : "+v"(z));
        f32x4 ag = (f32x4){z, z, z, z}, au = ag;
        {
            bf16x8 fa[8], fg[8], fu[8];
#pragma unroll
            for (int i = 0; i < 8; ++i) { fa[i] = *(const bf16x8*)(ap + 32 * i); fg[i] = *(const bf16x8*)(bg + 32 * i); fu[i] = *(const bf16x8*)(bu + 32 * i); }
#pragma unroll
            for (int i = 0; i < 8; ++i) { ag = __builtin_amdgcn_mfma_f32_16x16x32_bf16(fa[i], fg[i], ag, 0, 0, 0); au = __builtin_amdgcn_mfma_f32_16x16x32_bf16(fa[i], fu[i], au, 0, 0, 0); }
        }
        red[wid * 64 + lane] = ag; red[512 + wid * 64 + lane] = au;
        LDS_WAIT(); __syncthreads();
        if (wid == 0) {
            f32x4 sg = red[lane], su = red[512 + lane];
#pragma unroll
            for (int w = 1; w < 8; ++w) { sg += red[w * 64 + lane]; su += red[512 + w * 64 + lane]; }
#pragma unroll
            for (int r = 0; r < 4; ++r) { const float sc = __builtin_amdgcn_rsqf(rs[MROW0 + kq * 4 + r] * (1.f / DM) + EPS); const float g = sg[r] * sc; su[r] *= sc; P[(size_t)(MROW0 + kq * 4 + r) * PW + c0 + l15] = (bf16_t)f2bf(g * __builtin_amdgcn_rcpf(1.f + __builtin_amdgcn_exp2f(-g * LOG2E)) * su[r]); }
        }
        __syncthreads();
    }
}

#define XB_TMO      128
#define XB_XCNT(j)  (256  + 64 * (j))
#define XB_XSUB(j)  (1280 + 64 * (j))
#define XB_XGEN(j)  (2304 + 64 * (j))
#define XB_TOP      3328
#define XB_TOPGEN   3392
#define XCD_BAR_WORDS 3456
#define XB_SPIN_CAP (1u << 18)
__device__ __forceinline__ unsigned xb_ld(unsigned* p)              { return __hip_atomic_load(p, __ATOMIC_RELAXED, __HIP_MEMORY_SCOPE_AGENT); }
__device__ __forceinline__ unsigned xb_add(unsigned* p, unsigned v) { return __hip_atomic_fetch_add(p, v, __ATOMIC_RELAXED, __HIP_MEMORY_SCOPE_AGENT); }
__device__ __forceinline__ unsigned xb_xcc_id() { return (unsigned)__builtin_amdgcn_s_getreg((3 << 11) | 20) & 0xFu; }
#define XB_SPIN(cond, bar) do { unsigned _sp = 0; while (cond) { __builtin_amdgcn_s_sleep(1); \
    if ((++_sp & 255u) == 0u) { if (xb_ld(&(bar)[XB_TMO])) break; if (_sp > XB_SPIN_CAP) { atomicAdd(&(bar)[XB_TMO], 1u); break; } } } } while (0)
struct XcdBarrier { unsigned* bar; unsigned x; volatile LAS unsigned* st; };
__device__ __forceinline__ XcdBarrier xcd_barrier_post(unsigned* bar, volatile LAS unsigned* st) {
    XcdBarrier b; b.bar = bar; b.x = xb_xcc_id(); b.st = st;
    if (threadIdx.x == 0) (void)xb_add(&bar[XB_XCNT(b.x)], 1u);
    return b;
}
__device__ __forceinline__ void xcd_barrier_complete(unsigned* bar, unsigned x, unsigned& nloc, unsigned& nx) {
    const unsigned G = gridDim.x * gridDim.y * gridDim.z;
    unsigned sum, cnt, mine, sp = 0u;
    for (;;) {
        sum = 0u; cnt = 0u; mine = 0u;
#pragma unroll
        for (unsigned j = 0; j < 16; ++j) { const unsigned c = xb_ld(&bar[XB_XCNT(j)]); sum += c; cnt += (c > 0u) ? 1u : 0u; mine = (j == x) ? c : mine; }
        if (sum == G) break;
        __builtin_amdgcn_s_sleep(1);
        if ((++sp & 255u) == 0u) { if (xb_ld(&bar[XB_TMO])) break; if (sp > XB_SPIN_CAP) { atomicAdd(&bar[XB_TMO], 1u); break; } }
    }
    nloc = mine > 0u ? mine : 1u; nx = cnt > 0u ? cnt : 1u;
}
__device__ __forceinline__ void xcd_barrier(const XcdBarrier& b) {
    asm volatile("s_waitcnt vmcnt(0)" ::: "memory");
    __syncthreads();
    if (threadIdx.x == 0) {
        unsigned* bar = b.bar;
        __builtin_amdgcn_s_waitcnt(0);
        unsigned nloc = b.st[0], nx = b.st[1];
        if (nloc == 0u) { xcd_barrier_complete(bar, b.x, nloc, nx); b.st[0] = nloc; b.st[1] = nx; }
        const unsigned old = xb_add(&bar[XB_XSUB(b.x)], 1u);
        const unsigned gen = old / nloc;
        if (old + 1u == (gen + 1u) * nloc) {
            __builtin_amdgcn_fence(__ATOMIC_RELEASE, "agent");
            asm volatile("s_waitcnt vmcnt(0)" ::: "memory");
            const unsigned og = xb_add(&bar[XB_TOP], 1u);
            const unsigned tg = og / nx;
            if (og + 1u == (tg + 1u) * nx) xb_add(&bar[XB_TOPGEN], 1u);
            else XB_SPIN(xb_ld(&bar[XB_TOPGEN]) == tg, bar);
            __builtin_amdgcn_fence(__ATOMIC_ACQUIRE, "agent");
            xb_add(&bar[XB_XGEN(b.x)], 1u);
            asm volatile("s_waitcnt vmcnt(0)" ::: "memory");
        } else {
            XB_SPIN(xb_ld(&bar[XB_XGEN(b.x)]) == gen, bar);
            __builtin_amdgcn_fence(__ATOMIC_ACQUIRE, "agent");
            asm volatile("s_waitcnt vmcnt(0)" ::: "memory");
        }
    }
    __syncthreads();
}

constexpr int NWAVES = 8;
constexpr int RING_BYTES = 131072, LDS_BYTES = 147456, LDSCTL_OFF = LDS_BYTES - 512;
struct Args {
    const float* in[19]; float* out; unsigned char* ws; int ph_lo, ph_hi;
};
struct Ctx {
    LAS unsigned char* lds; int tid, lane, wave, gw, ngw, G, bid;
};

template <int MAP> __device__ __forceinline__ int wmap(int n, float& sc) {
    sc = 1.f;
    if (MAP == 0) return n;
    if (MAP == 1) {
        if (n < 1088) return n;
        if (n < 3136) { const int m = n - 1088, d = m & 127; return 1280 + (m - d) + (d < 64 ? 2 * d : 2 * (d - 64) + 1); }
        if (n < 4160) return 1280 + (n - 1088);
        if (n < 5184) { const int m = n - 4160, d = m & 63; return 4352 + (m - d) + (d < 32 ? 2 * d : 2 * (d - 32) + 1); }
        if (n < 5248) { const int d = n - 5184; return 1088 + (d < 32 ? 2 * d : 2 * (d - 32) + 1); }
        if (n < 5264) { sc = 0.03125f; return 1152 + (n - 5248); }
        if (n < 7312) { const int m = n - 5264, d = m & 127; return 5376 + (m - d) + (d < 64 ? 2 * d : 2 * (d - 64) + 1); }
        if (n < 8336) return 5376 + (n - 5264);
        return 8448 + (n - 8336);
    }
    if (n < DFF) return (n >> 7) * 256 + (n & 127);
    const int m = n - DFF; return (m >> 7) * 256 + 128 + (m & 127);
}
template <int MAP> __device__ __forceinline__ void conv_item(const float* W, int K, int N, bf16_t* WT, const float* gain, LAS float* scr, int item, int lane) {
    const int nblk = (N + 31) / 32, kb = item / nblk, nb = item - kb * nblk, k0 = 64 * kb, n0 = 32 * nb;
    const int nn = n0 + (lane & 31);
    float wv[32];
#pragma unroll
    for (int i = 0; i < 32; ++i) { const int kk = 2 * i + (lane >> 5); wv[i] = (nn < N) ? W[(size_t)(k0 + kk) * N + nn] : 0.f; }
#pragma unroll
    for (int i = 0; i < 32; ++i) { const int kk = 2 * i + (lane >> 5); float v = wv[i]; if (gain) v *= gain[k0 + kk]; scr[kk * 33 + (lane & 31)] = v; }
    LDS_WAIT(); asm volatile("" ::: "memory");
    const int c = lane & 7;
#pragma unroll
    for (int j = 0; j < 4; ++j) { const int n = (lane >> 3) + 8 * j; const int ns = n0 + n;
        if (ns < N) { float sc; const int dst = wmap<MAP>(ns, sc); const LAS float* s = scr + (8 * c) * 33 + n;
            u32x4 o; o.x = pk2(s[0 * 33] * sc, s[1 * 33] * sc); o.y = pk2(s[2 * 33] * sc, s[3 * 33] * sc); o.z = pk2(s[4 * 33] * sc, s[5 * 33] * sc); o.w = pk2(s[6 * 33] * sc, s[7 * 33] * sc);
            *(u32x4*)(WT + (size_t)dst * K + k0 + 8 * c) = o; } }
    LDS_WAIT(); asm volatile("" ::: "memory");
}
template <int MAP> __device__ __forceinline__ void conv_matrix(const Ctx& F, const float* W, int K, int N, bf16_t* WT, const float* gain) {
    LAS float* scr = (LAS float*)(F.lds + F.wave * 16384);
    const int nit = (K / 64) * ((N + 31) / 32);
    for (int it = F.gw; it < nit; it += F.ngw) conv_item<MAP>(W, K, N, WT, gain, scr, it, F.lane);
}

__device__ __forceinline__ void norm_row(const float* hrow, bf16_t* orow, float* rs_row, int lane) {
    f32x4 v[8]; float s = 0.f;
#pragma unroll
    for (int j = 0; j < 8; ++j) { v[j] = *((const f32x4*)hrow + lane + 64 * j); s += (v[j].x * v[j].x + v[j].y * v[j].y) + (v[j].z * v[j].z + v[j].w * v[j].w); }
    s = wave_sum(s);
    if (lane == 0) *rs_row = s;
#pragma unroll
    for (int j = 0; j < 8; ++j) { u32x2 o; o.x = cvt_pk_bf16(v[j].x, v[j].y); o.y = cvt_pk_bf16(v[j].z, v[j].w); *((u32x2*)orow + lane + 64 * j) = o; }
}

__device__ __forceinline__ void post1a_row(const bf16_t* P, int r, float* rstdq, float* rstdkv, int lane) {
    const bf16_t* p = P + (size_t)r * PW;
    const u32x4 a = *((const u32x4*)(p + C_CQ) + lane), b = *((const u32x4*)(p + C_CKV) + lane);
    float sa = 0.f, sb = 0.f;
#pragma unroll
    for (int e = 0; e < 4; ++e) { const float x0 = __uint_as_float(a[e] << 16), x1 = __uint_as_float(a[e] & 0xffff0000u); sa += x0 * x0 + x1 * x1;
        const float y0 = __uint_as_float(b[e] << 16), y1 = __uint_as_float(b[e] & 0xffff0000u); sb += y0 * y0 + y1 * y1; }
    sa = wave_sum(sa); sb = wave_sum(sb);
    if (lane == 0) { rstdq[r] = 1.0f / sqrtf(sa * (1.f / 512.f) + EPS); rstdkv[r] = 1.0f / sqrtf(sb * (1.f / 512.f) + EPS); }
    { unsigned* ikp = (unsigned*)(P + (size_t)r * PW + C_IK) + (lane & 31); const unsigned w = *ikp; const float x1 = __uint_as_float(w << 16), x2 = __uint_as_float(w & 0xffff0000u);
      float cs, sn; rope_cs(row_pos(r), lane & 31, 2.f / 64.f, cs, sn);
      if (lane < 32) *ikp = cvt_pk_bf16(x1 * cs - x2 * sn, x2 * cs + x1 * sn); }
}
__device__ __forceinline__ void meta_post_row(bf16_t* P, int r, const float* gperm, int lane) {
    bf16_t* p = P + (size_t)r * PW; const int pos = row_pos(r);
    float c128, s128, c64, s64; rope_cs(pos, lane, 2.f / 128.f, c128, s128); rope_cs(pos, lane & 31, 2.f / 64.f, c64, s64);
#pragma unroll 1
    for (int t = 0; t < 4; ++t) {
        const int cb = t == 0 ? C_DQ : (t == 1 ? C_DK : (t == 2 ? C_FQ : C_FK)); const float sc = (t == 0 || t == 2) ? C2_128 : 1.f;
        const float ga = gperm[t * 128 + 2 * lane], gb = gperm[t * 128 + 2 * lane + 1];
#pragma unroll 1
        for (int h = 0; h < 8; ++h) { unsigned* xp = (unsigned*)(p + cb + h * 128) + lane; const unsigned w = *xp; float x1 = __uint_as_float(w << 16), x2 = __uint_as_float(w & 0xffff0000u);
            const float rn = __builtin_amdgcn_rsqf(wave_sum(x1 * x1 + x2 * x2) * (1.f / 128.f) + EPS); x1 *= rn * ga; x2 *= rn * gb;
            *xp = cvt_pk_bf16((x1 * c128 - x2 * s128) * sc, (x2 * c128 + x1 * s128) * sc); }
    }
#pragma unroll 1
    for (int hh = 0; hh < 8; ++hh) { unsigned* xp = (unsigned*)(p + C_IQ + hh * 128) + lane; const unsigned w = *xp; const float x1 = __uint_as_float(w << 16), x2 = __uint_as_float(w & 0xffff0000u);
        *xp = cvt_pk_bf16(x1 * c64 - x2 * s64, x2 * c64 + x1 * s64); }
}
__device__ __forceinline__ void unpack8(const u32x4& w, float (&x)[8]) {
#pragma unroll
    for (int e = 0; e < 4; ++e) { x[2 * e] = __uint_as_float(w[e] << 16); x[2 * e + 1] = __uint_as_float(w[e] & 0xffff0000u); }
}
__device__ __forceinline__ u32x4 pack8(const float (&x)[8]) { u32x4 w; w.x = cvt_pk_bf16(x[0], x[1]); w.y = cvt_pk_bf16(x[2], x[3]); w.z = cvt_pk_bf16(x[4], x[5]); w.w = cvt_pk_bf16(x[6], x[7]); return w; }
__device__ __forceinline__ u32x4 shfl_xor4(const u32x4& w, int m) { u32x4 r; r.x = __shfl_xor(w.x, m); r.y = __shfl_xor(w.y, m); r.z = __shfl_xor(w.z, m); r.w = __shfl_xor(w.w, m); return r; }
template <int HD, bool NORM>
__device__ __forceinline__ void rope_pass(const u32x4& raw, u32x4* ptr, const float* gain, float scale, const float (&cs)[8], const float (&sn)[8], int lane, bool active) {
    constexpr int LPH = HD / 8, HALF = LPH / 2;
    const int lh = lane & (LPH - 1);
    float x[8]; unpack8(raw, x);
    float px[8]; { const u32x4 praw = shfl_xor4(raw, HALF); unpack8(praw, px); }
    if (NORM) {
        float ss = 0.f;
#pragma unroll
        for (int j = 0; j < 8; ++j) ss += x[j] * x[j];
#pragma unroll
        for (int o = 1; o < LPH; o <<= 1) ss += __shfl_xor(ss, o);
        const float rn = __builtin_amdgcn_rsqf(ss * (1.f / HD) + EPS);
        const f32x4 g0 = *(const f32x4*)(gain + lh * 8), g1 = *(const f32x4*)(gain + lh * 8 + 4);
        const f32x4 h0 = *(const f32x4*)(gain + (lh ^ HALF) * 8), h1 = *(const f32x4*)(gain + (lh ^ HALF) * 8 + 4);
#pragma unroll
        for (int j = 0; j < 4; ++j) { x[j] *= rn * g0[j]; x[4 + j] *= rn * g1[j]; px[j] *= rn * h0[j]; px[4 + j] *= rn * h1[j]; }
    }
    const bool first = lh < HALF;
    float o[8];
#pragma unroll
    for (int j = 0; j < 8; ++j) o[j] = (first ? (x[j] * cs[j] - px[j] * sn[j]) : (x[j] * cs[j] + px[j] * sn[j])) * scale;
    if (active) *ptr = pack8(o);
}
__device__ __forceinline__ void post1b_row(bf16_t* P, int r, const float* dsag  , const float* diffg  , int lane) {
    bf16_t* p = P + (size_t)r * PW;
    u32x4* pdq = (u32x4*)(p + C_DQ) + lane; u32x4* pdk = (u32x4*)(p + C_DK) + lane; u32x4* pfq = (u32x4*)(p + C_FQ) + lane; u32x4* pfk = (u32x4*)(p + C_FK) + lane; u32x4* piq = (u32x4*)(p + C_IQ) + lane;
    u32x4* pik = (u32x4*)(p + C_IK) + (lane < 8 ? lane : 0);
    u32x4 rdq[2], rdk[2], rfq[2], rfk[2], riq[2];
#pragma unroll
    for (int k = 0; k < 2; ++k) { rdq[k] = pdq[64 * k]; rdk[k] = pdk[64 * k]; rfq[k] = pfq[64 * k]; rfk[k] = pfk[64 * k]; riq[k] = piq[64 * k]; }
    const u32x4 rik = *pik;
    const int pos = row_pos(r);
    float c128[8], s128[8], c64[8], s64[8];
#pragma unroll
    for (int j = 0; j < 8; ++j) { rope_cs(pos, 8 * (lane & 7) + j, 2.f / 128.f, c128[j], s128[j]); rope_cs(pos, 8 * (lane & 3) + j, 2.f / 64.f, c64[j], s64[j]); }
#pragma unroll
    for (int k = 0; k < 2; ++k) {
        rope_pass<128, true>(rdq[k], pdq + 64 * k, dsag, C2_128, c128, s128, lane, true);
        rope_pass<128, true>(rdk[k], pdk + 64 * k, dsag + 128, 1.f, c128, s128, lane, true);
        rope_pass<128, true>(rfq[k], pfq + 64 * k, diffg, C2_128, c128, s128, lane, true);
        rope_pass<128, true>(rfk[k], pfk + 64 * k, diffg + 128, 1.f, c128, s128, lane, true);
        rope_pass<64, false>(riq[k], piq + 64 * k, nullptr, 1.f, c64, s64, lane, true);
    }
    rope_pass<64, false>(rik, pik, nullptr, 1.f, c64, s64, lane, lane < 8);
}
__device__ __forceinline__ void post2_row(bf16_t* P, int r, const float* rstdq, const float* rstdkv, const float* qkg  , LAS float* rnl, int lane) {
    bf16_t* p = P + (size_t)r * PW;
    const float sq = rstdq[r], skv = rstdkv[r];
    const int pos = row_pos(r), hw = lane >> 5, l5 = lane & 31;
    float c64[8], s64[8];
#pragma unroll
    for (int j = 0; j < 8; ++j) rope_cs(pos, 8 * (lane & 3) + j, 2.f / 64.f, c64[j], s64[j]);
    float kp[8]; { const u32x4 w = *(const u32x4*)(p + C_KPE + (lane & 7) * 8); unpack8(w, kp); }
    float kpe_ss = 0.f;
#pragma unroll
    for (int j = 0; j < 8; ++j) kpe_ss += kp[j] * kp[j];
    kpe_ss += __shfl_xor(kpe_ss, 1); kpe_ss += __shfl_xor(kpe_ss, 2); kpe_ss += __shfl_xor(kpe_ss, 4);
    u32x4 rq[4], rkv[4];
#pragma unroll
    for (int it = 0; it < 4; ++it) { const int h = 2 * it + hw; rq[it] = *(const u32x4*)(p + C_QRAW + h * 192 + (l5 < 24 ? l5 : 0) * 8); rkv[it] = *(const u32x4*)(p + C_KVRAW + h * 256 + l5 * 8); }
#pragma unroll
    for (int it = 0; it < 4; ++it) {
        const int h = 2 * it + hw; const bool act = l5 < 24;
        u32x4* ptr = (u32x4*)(p + C_QRAW + h * 192 + (act ? l5 : 0) * 8);
        float x[8]; unpack8(rq[it], x);
        float ss = 0.f;
#pragma unroll
        for (int j = 0; j < 8; ++j) { x[j] *= sq; ss += x[j] * x[j]; }
        if (!act) ss = 0.f;
#pragma unroll
        for (int o = 1; o < 32; o <<= 1) ss += __shfl_xor(ss, o);
        const float rn = 1.0f / sqrtf(ss * (1.f / 192.f) + EPS);
        const int gi = (act ? l5 : 0) * 8;
        const f32x4 g0 = *(const f32x4*)(qkg + gi), g1 = *(const f32x4*)(qkg + gi + 4);
#pragma unroll
        for (int j = 0; j < 4; ++j) { x[j] *= rn * g0[j]; x[4 + j] *= rn * g1[j]; }
        float o[8];
#pragma unroll
        for (int j = 0; j < 8; ++j) { const float pr = __shfl_xor(x[j], 4); const float rot = (l5 & 4) ? (x[j] * c64[j] + pr * s64[j]) : (x[j] * c64[j] - pr * s64[j]); o[j] = (l5 >= 16 ? rot : x[j]) * C2_192; }
        if (act) *ptr = pack8(o);
    }
#pragma unroll
    for (int it = 0; it < 4; ++it) {
        const int h = 2 * it + hw; const bool isk = l5 < 16;
        u32x4* ptr = (u32x4*)(p + C_KVRAW + h * 256 + l5 * 8);
        float x[8]; unpack8(rkv[it], x);
        float ss = 0.f;
#pragma unroll
        for (int j = 0; j < 8; ++j) { x[j] *= skv; ss += x[j] * x[j]; }
        if (!isk) ss = 0.f;
#pragma unroll
        for (int o = 1; o < 32; o <<= 1) ss += __shfl_xor(ss, o);
        const float rn = 1.0f / sqrtf((ss + kpe_ss) * (1.f / 192.f) + EPS);
        if (l5 == 0) rnl[h] = rn;
        const int gi = 192 + (isk ? l5 : 0) * 8;
        const f32x4 g0 = *(const f32x4*)(qkg + gi), g1 = *(const f32x4*)(qkg + gi + 4);
        float o[8];
#pragma unroll
        for (int j = 0; j < 4; ++j) { o[j] = isk ? x[j] * rn * g0[j] : x[j]; o[4 + j] = isk ? x[4 + j] * rn * g1[j] : x[4 + j]; }
        *ptr = pack8(o);
    }
    LDS_WAIT(); asm volatile("" ::: "memory");
    { const int hd = lane >> 3, c = lane & 7; const float rn = rnl[hd];
      const f32x4 g0 = *(const f32x4*)(qkg + 192 + 128 + c * 8), g1 = *(const f32x4*)(qkg + 192 + 128 + c * 8 + 4);
      float x[8], o[8];
#pragma unroll
      for (int j = 0; j < 4; ++j) { x[j] = kp[j] * rn * g0[j]; x[4 + j] = kp[4 + j] * rn * g1[j]; }
#pragma unroll
      for (int j = 0; j < 8; ++j) { const float pr = __shfl_xor(x[j], 4); o[j] = (c & 4) ? (x[j] * c64[j] + pr * s64[j]) : (x[j] * c64[j] - pr * s64[j]); }
      *(u32x4*)(p + C_KPEH + hd * 64 + c * 8) = pack8(o); }
    LDS_WAIT(); asm volatile("" ::: "memory");
}
__device__ __forceinline__ void post3_row(bf16_t* P, int r, const float* subg, float lam, float omli, int lane) {
    bf16_t* p = P + (size_t)r * PW;
    const int hw = lane >> 5, l5 = lane & 31;
    u32x4 rr[4];
#pragma unroll
    for (int h = 0; h < 4; ++h) rr[h] = *(const u32x4*)(p + (hw ? C_IQ : C_FQ) + h * 256 + l5 * 8);
#pragma unroll
    for (int h = 0; h < 4; ++h) {
        const u32x4 raw = rr[h];
        const u32x4 praw = shfl_xor4(raw, 16);
        float a[8], b[8]; unpack8(raw, a); unpack8(praw, b);
        float d[8], ss = 0.f;
#pragma unroll
        for (int j = 0; j < 8; ++j) { d[j] = a[j] - lam * b[j]; ss += d[j] * d[j]; }
        if (l5 >= 16) ss = 0.f;
#pragma unroll
        for (int o = 1; o < 64; o <<= 1) ss += __shfl_xor(ss, o);
        const float rn = omli / sqrtf(ss * (1.f / 256.f) + EPS);
        const int dim = hw * 128 + (l5 & 15) * 8;
        const f32x4 g0 = *(const f32x4*)(subg + dim), g1 = *(const f32x4*)(subg + dim + 4);
        float o[8];
#pragma unroll
        for (int j = 0; j < 4; ++j) { o[j] = d[j] * rn * g0[j]; o[4 + j] = d[4 + j] * rn * g1[j]; }
        if (l5 < 16) *(u32x4*)(p + C_OC + h * 256 + dim) = pack8(o);
    }
}

__device__ __forceinline__ int key_row(int kidx, int tokbase) { return kidx < 64 ? (MBLK - 64) + kidx : tokbase + (kidx - 64); }

__device__ __forceinline__ void index_row(const bf16_t* P, int tok, unsigned* bm, LAS float* iqs  , LAS unsigned* keys  , int lane) {
    const int b = tok >> 11, t = tok & (SEQ - 1), r = MBLK + tok, qk = 64 + t, nvalid = t + 17, tokbase = MBLK + b * SEQ;
    const int nch = qk / 64 + 1;
    unsigned* out = bm + (size_t)tok * BMW;
    if (nvalid <= 256) {
        for (int c = 0; c < 33; ++c) { const int kidx = 64 * c + lane; const unsigned long long m = __ballot(kidx >= 48 && kidx <= qk);
            if (lane == 0) { out[2 * c] = (unsigned)m; out[2 * c + 1] = (unsigned)(m >> 32); } }
        return;
    }
    const bf16_t* p = P + (size_t)r * PW;
#pragma unroll
    for (int j = 0; j < 16; ++j) iqs[j * 64 + lane] = bf2f(p[C_IQ + j * 64 + lane]);
    if (lane < 16) iqs[1024 + lane] = bf2f(p[C_IW + lane]);
    LDS_WAIT(); asm volatile("" ::: "memory");
    for (int c = 0; c < nch; ++c) {
        const int kidx = 64 * c + lane; const bool valid = kidx >= 48 && kidx <= qk;
        const int kr = key_row(valid ? kidx : 48, tokbase);
        const u32x4* kp = (const u32x4*)(P + (size_t)kr * PW + C_IK);
        u32x4 kw[8];
#pragma unroll
        for (int j = 0; j < 8; ++j) kw[j] = kp[j];
        float score = 0.f;
#pragma unroll 1
        for (int h = 0; h < 16; ++h) {
            const LAS f32x4* qv = (const LAS f32x4*)(iqs + h * 64); float d = 0.f;
#pragma unroll
            for (int j = 0; j < 8; ++j) { const u32x4 w = kw[j]; const f32x4 qa = qv[2 * j], qb = qv[2 * j + 1];
                d += qa.x * __uint_as_float(w.x << 16) + qa.y * __uint_as_float(w.x & 0xffff0000u) + qa.z * __uint_as_float(w.y << 16) + qa.w * __uint_as_float(w.y & 0xffff0000u)
                   + qb.x * __uint_as_float(w.z << 16) + qb.y * __uint_as_float(w.z & 0xffff0000u) + qb.z * __uint_as_float(w.w << 16) + qb.w * __uint_as_float(w.w & 0xffff0000u); }
            score += fmaxf(d, 0.f) * iqs[1024 + h];
        }
        const unsigned u = __float_as_uint(score);
        keys[c * 64 + lane] = valid ? ((u & 0x80000000u) ? ~u : (u | 0x80000000u)) : 0u;
    }
    LDS_WAIT(); asm volatile("" ::: "memory");
    unsigned T = 0u;
    for (int bit = 31; bit >= 0; --bit) {
        const unsigned cand = T | (1u << bit); int cnt = 0;
        for (int c = 0; c < nch; ++c) cnt += __popcll(__ballot(keys[c * 64 + lane] >= cand));
        if (cnt >= 256) T = cand;
        if (cnt == 256) break;
    }
    for (int c = 0; c < 33; ++c) { unsigned long long m = 0ull; if (c < nch) m = __ballot(keys[c * 64 + lane] >= T);
        if (lane == 0) { out[2 * c] = (unsigned)m; out[2 * c + 1] = (unsigned)(m >> 32); } }
    LDS_WAIT(); asm volatile("" ::: "memory");
}

__device__ __forceinline__ void index_unit(const bf16_t* P, int unit, unsigned* bm, LAS unsigned char* lds) {
    typedef float f32x16 __attribute__((ext_vector_type(16)));
    int tid = threadIdx.x; asm volatile("" : "+v"(tid));
    const int wid = __builtin_amdgcn_readfirstlane(tid >> 6), lane = tid & 63, j = lane & 31, hi = lane >> 5;
    const int tb = 255 - (unit >> 4), b = unit & 15, t0 = tb * 8, tokbase = MBLK + b * SEQ;
    const int wmax = (64 + t0 + 7) >> 5;
    LAS unsigned* keys = (LAS unsigned*)lds;
    LAS float* iwl = (LAS float*)(lds + 8 * 2112 * 4);
    if (t0 + 7 + 17 > 256) {
        if (tid < 128) iwl[tid] = bf2f(P[(size_t)(tokbase + t0 + (tid >> 4)) * PW + C_IW + (tid & 15)]);
        bf16x8 af[4][4];
        { const int qa = (j >> 2) & 1, ha = (j & 3) + 4 * (j >> 3);
#pragma unroll
          for (int blk = 0; blk < 4; ++blk) { const bf16_t* ap = P + (size_t)(tokbase + t0 + 2 * blk + qa) * PW + C_IQ + ha * 64 + hi * 8;
#pragma unroll
              for (int s = 0; s < 4; ++s) af[blk][s] = *(const bf16x8*)(ap + s * 16); } }
        LDS_WAIT(); __syncthreads();
        const unsigned boff = (unsigned)(j * PW + C_IK + hi * 8) * 2u;
        for (int w = wid; w <= wmax; w += 8) {
            const int kr_ = w < 2 ? (MBLK - 64) + 32 * w : tokbase + 32 * (w - 2); const char* bp_ = (const char*)(P + (size_t)kr_ * PW) + boff;
            bf16x8 bf[4];
#pragma unroll
            for (int s = 0; s < 4; ++s) bf[s] = *(const bf16x8*)(bp_ + s * 32);
            const int kidx = 32 * w + j;
#pragma unroll
            for (int blk = 0; blk < 4; ++blk) {
                f32x16 acc = (f32x16){0.f,0.f,0.f,0.f,0.f,0.f,0.f,0.f,0.f,0.f,0.f,0.f,0.f,0.f,0.f,0.f};
#pragma unroll
                for (int s = 0; s < 4; ++s) acc = __builtin_amdgcn_mfma_f32_32x32x16_bf16(af[blk][s], bf[s], acc, 0, 0, 0);
                const int q = 2 * blk + hi;
                const LAS f32x4* iwq = (const LAS f32x4*)(iwl + q * 16);
                float score = 0.f;
#pragma unroll
                for (int g = 0; g < 4; ++g) { const f32x4 wv = iwq[g]; score += fmaxf(acc[4 * g], 0.f) * wv.x + fmaxf(acc[4 * g + 1], 0.f) * wv.y + fmaxf(acc[4 * g + 2], 0.f) * wv.z + fmaxf(acc[4 * g + 3], 0.f) * wv.w; }
                const bool valid = kidx >= 48 && kidx <= 64 + t0 + q; const unsigned u_ = __float_as_uint(score);
                keys[q * 2112 + kidx] = valid ? ((u_ & 0x80000000u) ? ~u_ : (u_ | 0x80000000u)) : 0u;
            }
        }
        LDS_WAIT(); __syncthreads();
    }
    const int tq = t0 + wid, qk = 64 + tq, nch = qk / 64 + 1;
    unsigned* out = bm + (size_t)(b * SEQ + tq) * BMW;
    if (tq + 17 <= 256) {
        for (int c = 0; c < 33; ++c) { const int kidx = 64 * c + lane; const unsigned long long m = __ballot(kidx >= 48 && kidx <= qk);
            if (lane == 0) { out[2 * c] = (unsigned)m; out[2 * c + 1] = (unsigned)(m >> 32); } }
    } else {
        unsigned kreg[33];
#pragma unroll
        for (int c = 0; c < 33; ++c) kreg[c] = (c < nch && 64 * c + lane <= qk) ? keys[wid * 2112 + 64 * c + lane] : 0u;
        unsigned T = 0u;
        for (int bit = 31; bit >= 0; --bit) {
            const unsigned cand = T | (1u << bit); int cnt = 0;
#pragma unroll
            for (int c = 0; c < 33; ++c) cnt += __popcll(__ballot(kreg[c] >= cand));
            if (cnt >= 256) T = cand;
            if (cnt == 256) break;
        }
#pragma unroll
        for (int c = 0; c < 33; ++c) { const unsigned long long m = __ballot(kreg[c] >= T && kreg[c] != 0u);
            if (lane == 0) { out[2 * c] = (unsigned)m; out[2 * c + 1] = (unsigned)(m >> 32); } }
    }
    LDS_WAIT();
}

template <int DQK, int DV, bool MASKED>
__device__ __forceinline__ void attn_row(bf16_t* P, int r, int qcol, int k1col, int k2col, int vcol, int ocol0, int ocol1, const unsigned* bm, LAS float* qs, int lane) {
    int qk, tokbase;
    if (r < MBLK) { qk = r - (MBLK - 64); tokbase = MBLK; } else { const int tok = r - MBLK; qk = 64 + (tok & (SEQ - 1)); tokbase = MBLK + (tok >> 11) * SEQ; }
    const bf16_t* qp = P + (size_t)r * PW + qcol;
#pragma unroll
    for (int d = 0; d < DQK; d += 64) qs[d + lane] = bf2f(qp[d + lane]);
    LDS_WAIT(); asm volatile("" ::: "memory");
    const bool use_bm = MASKED && r >= MBLK;
    const unsigned* bmr = bm + (size_t)(r >= MBLK ? r - MBLK : 0) * BMW;
    float m = -1e30f, l = 0.f, o[DV / 64];
#pragma unroll
    for (int k = 0; k < DV / 64; ++k) o[k] = 0.f;
    const int nch = qk / 64 + 1;
    for (int c = 0; c < nch; ++c) {
        const int kidx = 64 * c + lane; bool valid = kidx >= 48 && kidx <= qk;
        if (use_bm) valid = (bmr[kidx >> 5] >> (kidx & 31)) & 1u;
        const int kr = key_row((kidx >= 48 && kidx <= qk) ? kidx : 48, tokbase);
        float s = 0.f;
        { const u32x4* kp = (const u32x4*)(P + (size_t)kr * PW + k1col);
#pragma unroll
          for (int j = 0; j < 16; ++j) { const u32x4 w = kp[j]; const LAS f32x4* qv = (const LAS f32x4*)(qs + j * 8); const f32x4 qa = qv[0], qb = qv[1];
              s += qa.x * __uint_as_float(w.x << 16) + qa.y * __uint_as_float(w.x & 0xffff0000u) + qa.z * __uint_as_float(w.y << 16) + qa.w * __uint_as_float(w.y & 0xffff0000u)
                 + qb.x * __uint_as_float(w.z << 16) + qb.y * __uint_as_float(w.z & 0xffff0000u) + qb.z * __uint_as_float(w.w << 16) + qb.w * __uint_as_float(w.w & 0xffff0000u); } }
        if (DQK == 192) { const u32x4* kp = (const u32x4*)(P + (size_t)kr * PW + k2col);
#pragma unroll
          for (int j = 0; j < 8; ++j) { const u32x4 w = kp[j]; const LAS f32x4* qv = (const LAS f32x4*)(qs + 128 + j * 8); const f32x4 qa = qv[0], qb = qv[1];
              s += qa.x * __uint_as_float(w.x << 16) + qa.y * __uint_as_float(w.x & 0xffff0000u) + qa.z * __uint_as_float(w.y << 16) + qa.w * __uint_as_float(w.y & 0xffff0000u)
                 + qb.x * __uint_as_float(w.z << 16) + qb.y * __uint_as_float(w.z & 0xffff0000u) + qb.z * __uint_as_float(w.w << 16) + qb.w * __uint_as_float(w.w & 0xffff0000u); } }
        if (!valid) s = -__builtin_inff();
        const float mn = fmaxf(m, wave_max(s));
        const float alpha = __builtin_amdgcn_exp2f(m - mn), pj = __builtin_amdgcn_exp2f(s - mn);
        l = l * alpha + wave_sum(pj); m = mn;
#pragma unroll
        for (int k = 0; k < DV / 64; ++k) o[k] *= alpha;
        for (int j = 0; j < 64; ++j) {
            const float pw = __uint_as_float((unsigned)__builtin_amdgcn_readlane((int)__float_as_uint(pj), j));
            if (pw != 0.f) { const int rj = __builtin_amdgcn_readlane(kr, j); const bf16_t* vp = P + (size_t)rj * PW + vcol;
#pragma unroll
                for (int k = 0; k < DV / 64; ++k) o[k] += pw * bf2f(vp[k * 64 + lane]); }
        }
    }
    const float rl = l > 0.f ? 1.0f / l : 0.f;
    bf16_t* op = P + (size_t)r * PW;
#pragma unroll
    for (int k = 0; k < DV / 64; ++k) { const int d = k * 64 + lane; op[(d < 128 ? ocol0 + d : ocol1 + d - 128)] = (bf16_t)f2bf(o[k] * rl); }
    LDS_WAIT(); asm volatile("" ::: "memory");
}
namespace fa {
typedef float f32x16 __attribute__((ext_vector_type(16)));
typedef short s16x4 __attribute__((ext_vector_type(4)));
__device__ __forceinline__ int crow(int r, int hi) { return (r & 3) + 8 * (r >> 2) + 4 * hi; }
__device__ __forceinline__ int v_st(int k, int c) { const int kk = (k & ~0xC) | ((k & 4) << 1) | ((k & 8) >> 1); return ((kk >> 3) * 4 + (c >> 5)) * 512 + ((kk & 7) * 32 + (c & 31)) * 2; }
__device__ __forceinline__ int v_rd_base(int lane) { return ((lane & 3) << 3) | (((lane >> 2) & 3) << 6) | (((lane >> 4) & 1) << 5) | (((lane >> 5) & 1) << 8); }
constexpr int v_rd_off(int d0, int ks, int half) { return d0 * 512 + ks * 4096 + half * 2048; }
constexpr int SHM_V = 16384;
template <int DQK> struct Geo { static constexpr int KP = DQK * 2, SHM_K = 64 * DQK * 2, LDS_K0 = 2 * SHM_V, LDS_WS = LDS_K0 + 2 * SHM_K, BYTES = LDS_WS + 8 * 256; };
#define FA_KSWZ(row, colB, pitch) ((row) * (pitch) + ((colB) ^ (((row) & 7) << 4)))
#define FA_SBAR() __builtin_amdgcn_sched_barrier(0)

struct Item { int qrow0, qk0, nt, tokbase; };

template <int DQK>
__device__ __forceinline__ void load_q(const bf16_t* P, const Item& it, int qcol, bf16x8 (&qr)[DQK / 16]) {
    int tid = threadIdx.x; asm volatile("" : "+v"(tid));
    const int wid = tid >> 6, lane = tid & 63, r32 = lane & 31, hi = lane >> 5;
    const bf16_t* qp = P + (size_t)(it.qrow0 + wid * 32 + r32) * PW + qcol + hi * 8;
#pragma unroll
    for (int d0 = 0; d0 < DQK / 16; ++d0) qr[d0] = *(const bf16x8*)(qp + d0 * 16);
}

template <int DQK, bool MASKED>
__device__ __forceinline__ void attn_core(bf16_t* P, const Item& it, const bf16x8 (&qr)[DQK / 16], int k1col, int k2col, int vcol, int ocol, const unsigned* bmq, LAS unsigned char* lds) {
    typedef Geo<DQK> G;
    int tid = threadIdx.x; asm volatile("" : "+v"(tid));
    const int wid = __builtin_amdgcn_readfirstlane(tid >> 6), lane = tid & 63, r32 = lane & 31, hi = lane >> 5;
    LAS unsigned char* V_lds = lds; LAS unsigned char* K_lds = lds + G::LDS_K0; LAS float* wsf = (LAS float*)(lds + G::LDS_WS) + wid * 64;
    const int sr = tid >> 4, sc = (tid & 15) * 8;
    const int vst0 = v_st(sr, sc), vst1 = v_st(32 + sr, sc), kws0 = FA_KSWZ(sr, sc * 2, G::KP), kws1 = FA_KSWZ(sr + 32, sc * 2, G::KP);
    const int xr = tid >> 3, xc = (tid & 7) * 8, kws2 = FA_KSWZ(xr, (128 + xc) * 2, G::KP);
    const unsigned loff0 = (unsigned)(sr * PW + sc) * 2u, loffx = (unsigned)(xr * PW + xc) * 2u;
    const int vb0 = (int)(unsigned)(size_t)V_lds + v_rd_base(lane);
    const int NT = it.nt;
    const int qk = it.qk0 + wid * 32 + r32;
    const bool use_bm = MASKED && (bmq != nullptr);
    const unsigned bmoff = (unsigned)((wid * 32 + r32) * BMW) * 4u;
    float l_reg = 0.f; f32x16 o[4];
#pragma unroll
    for (int d = 0; d < 4; ++d) o[d] = (f32x16){0.f,0.f,0.f,0.f,0.f,0.f,0.f,0.f,0.f,0.f,0.f,0.f,0.f,0.f,0.f,0.f};
    bf16x8 sk0, sk1, sk2, sv0, sv1;
#define FA_KROW0(t) ((t) == 0 ? (MBLK - 64) : it.tokbase + 64 * ((t) - 1))
#define FA_LOAD(t) do { const int kr_ = FA_KROW0(t); const char* rb_ = (const char*)(P + (size_t)kr_ * PW); const char* rk_ = rb_ + (size_t)k1col * 2; const char* rv_ = rb_ + (size_t)vcol * 2; \
        sk0 = *(const bf16x8*)(rk_ + loff0); sk1 = *(const bf16x8*)(rk_ + (size_t)32 * PW * 2 + loff0); sv0 = *(const bf16x8*)(rv_ + loff0); sv1 = *(const bf16x8*)(rv_ + (size_t)32 * PW * 2 + loff0); \
        if (DQK == 192) sk2 = *(const bf16x8*)(rb_ + (size_t)k2col * 2 + loffx); } while (0)
#define FA_WRITE(bf) do { *(LAS bf16x8*)(K_lds + (bf) * G::SHM_K + kws0) = sk0; *(LAS bf16x8*)(K_lds + (bf) * G::SHM_K + kws1) = sk1; \
        *(LAS bf16x8*)(V_lds + (bf) * SHM_V + vst0) = sv0; *(LAS bf16x8*)(V_lds + (bf) * SHM_V + vst1) = sv1; \
        if (DQK == 192) *(LAS bf16x8*)(K_lds + (bf) * G::SHM_K + kws2) = sk2; } while (0)
    constexpr int QREG = (DQK == 192) ? 6 : DQK / 16;
    LAS unsigned char* qx = lds + G::BYTES + (wid * 384 + lane) * 16;
    if (DQK == 192) {
#pragma unroll
        for (int d0 = QREG; d0 < DQK / 16; ++d0) *(LAS bf16x8*)(qx + (d0 - QREG) * 1024) = qr[d0];
    }
    FA_LOAD(0); FA_WRITE(0);
    __syncthreads();
    for (int t = 0; t < NT; ++t) {
        const int cur = t & 1;
        unsigned zb = 0u; asm volatile("" : "+v"(zb)); u32x2 bw = (u32x2){zb, zb};
        if (use_bm) bw = *(const u32x2*)((const char*)(bmq + 2 * t) + bmoff);
        f32x16 p0 = (f32x16){0.f,0.f,0.f,0.f,0.f,0.f,0.f,0.f,0.f,0.f,0.f,0.f,0.f,0.f,0.f,0.f}, p1 = p0;
        { LAS unsigned char* kbase = K_lds + cur * G::SHM_K;
          LAS unsigned char* kb[4];
#pragma unroll
          for (int dd = 0; dd < 4; ++dd) kb[dd] = kbase + FA_KSWZ(r32, (dd * 16 + hi * 8) * 2, G::KP);
          constexpr int GS = (DQK == 192) ? 2 : 4;
#pragma unroll
          for (int g = 0; g < DQK / (16 * GS); ++g) {
              bf16x8 fb0[GS], fb1[GS];
#pragma unroll
              for (int dd = 0; dd < GS; ++dd) { const int d0 = g * GS + dd; LAS unsigned char* a = kb[d0 & 3] + (d0 >> 2) * 128; fb0[dd] = *(const LAS bf16x8*)a; fb1[dd] = *(const LAS bf16x8*)(a + 32 * G::KP); }
              FA_SBAR();
#pragma unroll
              for (int dd = 0; dd < GS; ++dd) { const int d0 = g * GS + dd; bf16x8 qf; if (d0 < QREG) qf = qr[d0 < QREG ? d0 : 0]; else qf = *(const LAS bf16x8*)(qx + (d0 - QREG) * 1024);
                  p0 = __builtin_amdgcn_mfma_f32_32x32x16_bf16(fb0[dd], qf, p0, 0, 0, 0); p1 = __builtin_amdgcn_mfma_f32_32x32x16_bf16(fb1[dd], qf, p1, 0, 0, 0); }
              FA_SBAR(); } }
        if (t + 1 < NT) FA_LOAD(t + 1);
        FA_SBAR();
        const float NEG = -__builtin_inff();
        if (use_bm) {
        } else if (t == 0 || 64 * t + 63 > it.qk0 + wid * 32) {
            const int kb_ = 64 * t + 4 * hi;
#pragma unroll
            for (int r = 0; r < 16; ++r) { const int k0 = kb_ + (r & 3) + 8 * (r >> 2), k1 = k0 + 32;
                if (k0 < 48 || k0 > qk) p0[r] = NEG; if (k1 < 48 || k1 > qk) p1[r] = NEG; }
        }
        float ps = 0.f;
#pragma unroll
        for (int r = 0; r < 16; ++r) { p0[r] = __builtin_amdgcn_exp2f(p0[r]); p1[r] = __builtin_amdgcn_exp2f(p1[r]); }
        if (use_bm) {
            const int wx = (int)(bw.x >> (4 * hi)), wy = (int)(bw.y >> (4 * hi));
#pragma unroll
            for (int r = 0; r < 16; ++r) { const int c = (r & 3) + 8 * (r >> 2);
                p0[r] = __uint_as_float(__float_as_uint(p0[r]) & (unsigned)__builtin_amdgcn_sbfe(wx, c, 1)); p1[r] = __uint_as_float(__float_as_uint(p1[r]) & (unsigned)__builtin_amdgcn_sbfe(wy, c, 1)); }
        }
        { f32x2 s2 = (f32x2){p0[0], p0[1]} + (f32x2){p1[0], p1[1]};
#pragma unroll
          for (int r = 2; r < 16; r += 2) s2 += (f32x2){p0[r], p0[r + 1]} + (f32x2){p1[r], p1[r + 1]};
          ps = s2.x + s2.y; }
        { auto rr = __builtin_amdgcn_permlane32_swap(__float_as_uint(ps), __float_as_uint(ps), false, false); ps = __uint_as_float(rr[0]) + __uint_as_float(rr[1]); }
        l_reg += ps;
        bf16x8 pa0, pa1, pa2, pa3;
#define FA_PK4(Pv, B_, OUT) do { const unsigned a0 = cvt_pk_bf16(Pv[B_ + 0], Pv[B_ + 1]), a1 = cvt_pk_bf16(Pv[B_ + 2], Pv[B_ + 3]), b0 = cvt_pk_bf16(Pv[B_ + 4], Pv[B_ + 5]), b1 = cvt_pk_bf16(Pv[B_ + 6], Pv[B_ + 7]); \
        auto r0 = __builtin_amdgcn_permlane32_swap(a0, b0, false, false); auto r1 = __builtin_amdgcn_permlane32_swap(a1, b1, false, false); \
        u32x4 w_ = {r0[0], r1[0], r0[1], r1[1]}; OUT = __builtin_bit_cast(bf16x8, w_); } while (0)
        FA_PK4(p0, 0, pa0); FA_PK4(p0, 8, pa1); FA_PK4(p1, 0, pa2); FA_PK4(p1, 8, pa3);
#define FA_TRRD(dst, off) asm volatile("ds_read_b64_tr_b16 %0, %1 offset:%2" : "=&v"(dst) : "v"(vb0), "i"(off) : "memory")
#define FA_PV(VB, d0) do { s16x4 l0, l1, l2, l3, h0, h1, h2, h3; constexpr int b_ = (VB) * SHM_V + v_rd_off(d0, 0, 0); \
        FA_TRRD(l0, b_); FA_TRRD(h0, b_ + 2048); FA_TRRD(l1, b_ + 4096); FA_TRRD(h1, b_ + 6144); FA_TRRD(l2, b_ + 8192); FA_TRRD(h2, b_ + 10240); FA_TRRD(l3, b_ + 12288); FA_TRRD(h3, b_ + 14336); \
        asm volatile("s_waitcnt lgkmcnt(0)" ::: "memory"); FA_SBAR(); \
        o[d0] = __builtin_amdgcn_mfma_f32_32x32x16_bf16(pa0, (bf16x8){l0[0], l0[1], l0[2], l0[3], h0[0], h0[1], h0[2], h0[3]}, o[d0], 0, 0, 0); \
        o[d0] = __builtin_amdgcn_mfma_f32_32x32x16_bf16(pa1, (bf16x8){l1[0], l1[1], l1[2], l1[3], h1[0], h1[1], h1[2], h1[3]}, o[d0], 0, 0, 0); \
        o[d0] = __builtin_amdgcn_mfma_f32_32x32x16_bf16(pa2, (bf16x8){l2[0], l2[1], l2[2], l2[3], h2[0], h2[1], h2[2], h2[3]}, o[d0], 0, 0, 0); \
        o[d0] = __builtin_amdgcn_mfma_f32_32x32x16_bf16(pa3, (bf16x8){l3[0], l3[1], l3[2], l3[3], h3[0], h3[1], h3[2], h3[3]}, o[d0], 0, 0, 0); } while (0)
        FA_SBAR();
        if (cur == 0) { FA_PV(0, 0); FA_PV(0, 1); FA_PV(0, 2); FA_PV(0, 3); } else { FA_PV(1, 0); FA_PV(1, 1); FA_PV(1, 2); FA_PV(1, 3); }
        FA_SBAR();
        if (t + 1 < NT) { if (cur == 0) FA_WRITE(1); else FA_WRITE(0); }
        __syncthreads();
    }
    if (hi == 0) wsf[r32] = l_reg; LDS_WAIT();
    float rli[16];
#pragma unroll
    for (int r = 0; r < 16; ++r) { const float lv = wsf[crow(r, hi)]; rli[r] = lv > 0.f ? __builtin_amdgcn_rcpf(lv) : 0.f; }
    { int l2 = lane; asm volatile("" : "+v"(l2));
      const int r32b = l2 & 31, hib = l2 >> 5;
      char* Ow = (char*)(P + (size_t)(it.qrow0 + wid * 32) * PW + ocol) + (unsigned)((4 * hib) * PW + r32b) * 2u;
#pragma unroll
      for (int r = 0; r < 16; ++r) { const unsigned ro = (unsigned)(((r & 3) + 8 * (r >> 2)) * PW) * 2u;
#pragma unroll
        for (int d0 = 0; d0 < 4; ++d0) { const float v = o[d0][r] * rli[r]; const float vn = __shfl_xor(v, 1);
            if ((r32b & 1) == 0) *(unsigned*)(Ow + ro + d0 * 64) = cvt_pk_bf16(v, vn); } } }
    LDS_WAIT();
    __syncthreads();
#undef FA_KROW0
#undef FA_LOAD
#undef FA_WRITE
#undef FA_PK4
#undef FA_TRRD
#undef FA_PV
}
__device__ __forceinline__ int next_item(unsigned* ctr, LAS int* slot) {
    __syncthreads();
    if (threadIdx.x == 0) *slot = (int)__hip_atomic_fetch_add(ctr, 1u, __ATOMIC_RELAXED, __HIP_MEMORY_SCOPE_AGENT);
    __syncthreads();
    return *slot;
}
__device__ __forceinline__ void queue_prime(unsigned* ctr, LAS int* slot) {
    __syncthreads();
    if (threadIdx.x == 0) slot[0] = (int)__hip_atomic_fetch_add(ctr, 1u, __ATOMIC_RELAXED, __HIP_MEMORY_SCOPE_AGENT);
    __syncthreads();
}
__device__ __forceinline__ int queue_next(unsigned* ctr, LAS int* slot, int k) {
    const int idx = slot[k & 1];
    if (threadIdx.x == 0) slot[(k + 1) & 1] = (int)__hip_atomic_fetch_add(ctr, 1u, __ATOMIC_RELAXED, __HIP_MEMORY_SCOPE_AGENT);
    return idx;
}
__device__ __forceinline__ Item make_item(bool meta, int b, int qb) {
    Item it;
    if (meta) { it.qrow0 = 0; it.qk0 = -(MBLK - 64); it.nt = 1; it.tokbase = MBLK; }
    else { it.qrow0 = MBLK + b * SEQ + qb * 256; it.qk0 = 64 + qb * 256; it.nt = 4 * (qb + 1) + 1; it.tokbase = MBLK + b * SEQ; }
    return it;
}
}

__device__ __forceinline__ int deal_row(int pass, int gw, int ngw) { const int j = (pass & 1) ? (ngw - 1 - gw) : gw; return pass * ngw + j; }

constexpr int PH_PER_LAYER = 19, N_PHASES = 2 * PH_PER_LAYER;
__device__ __forceinline__ unsigned char* uni_ptr(unsigned char* p) { const unsigned long long v = (unsigned long long)p; const unsigned lo = __builtin_amdgcn_readfirstlane((unsigned)v), hi = __builtin_amdgcn_readfirstlane((unsigned)(v >> 32)); return (unsigned char*)(((unsigned long long)hi << 32) | lo); }
__device__ __forceinline__ const float* arg_in(const Args& a, int k) { asm volatile("" : "+s"(k)); return a.in[k]; }
__global__ void __launch_bounds__(NWAVES * 64, 2) mega_fwd(Args args) {
    extern __shared__ __attribute__((aligned(16))) unsigned char lds_raw[];
    {
        LAS unsigned char* l0 = (LAS unsigned char*)lds_raw;
        for (int u = threadIdx.x; u < (LDS_BYTES - LDSCTL_OFF) / 4; u += NWAVES * 64) ((LAS unsigned*)(l0 + LDSCTL_OFF))[u] = 0u;
        __syncthreads();
    }
#if MK_ONE_LAUNCH
    (void)xcd_barrier_post((unsigned*)(args.ws + WS_CTL) + CW_BAR, (volatile LAS unsigned*)((LAS unsigned char*)lds_raw + LDSCTL_OFF + 64));
#define GRID_BAR() do { XcdBarrier bar_; bar_.bar = (unsigned*)(uni_ptr(args.ws) + WS_CTL) + CW_BAR; bar_.x = xb_xcc_id(); bar_.st = (volatile LAS unsigned*)((LAS unsigned char*)lds_raw + LDSCTL_OFF + 64); xcd_barrier(bar_); } while (0)
#else
#define GRID_BAR() do {} while (0)
#endif
    const int lo = args.ph_lo, hi = args.ph_hi;
#define IN(k) (lo <= (k) && (k) < hi)
#define SEAM(k) do { if (IN((k) + 1)) GRID_BAR(); } while (0)
#define PH_BEGIN \
    int tid_ = threadIdx.x; asm volatile("" : "+v"(tid_)); \
    Ctx F; F.lds = (LAS unsigned char*)lds_raw; F.tid = tid_; F.lane = tid_ & 63; F.wave = __builtin_amdgcn_readfirstlane(tid_ >> 6); \
    F.G = gridDim.x; F.bid = blockIdx.x; F.gw = F.bid * NWAVES + F.wave; F.ngw = F.G * NWAVES; \
    unsigned char* ws = uni_ptr(args.ws); asm volatile("" : "+s"(ws)); \
    int ly = __builtin_amdgcn_readfirstlane(layer); asm volatile("" : "+s"(ly)); (void)ly; (void)F
#define XN_ ((bf16_t*)(ws + WS_XN))
#define P_ ((bf16_t*)(ws + WS_P))
#define HMETA_ ((float*)(ws + WS_HMETA))
#define RSTDQ_ ((float*)(ws + WS_RSTD))
#define RSTDKV_ ((float*)(ws + WS_RSTD) + R)
#define BM_ ((unsigned*)(ws + WS_BM))
#define RS_(i) ((float*)(ws + WS_CTL + WS_RS) + (size_t)(i) * R)
#define GPERM_ ((float*)(ws + WS_RSTD + 512 * 1024))
#define WB_(off) ((bf16_t*)(ws + WS_WB + (off)))
#define OUT_ (args.out)
#define LAMBDA_INIT(ly) ((ly) == 0 ? 0.2f : (0.8f - 0.6f * 0.7408182206817179f))
#define HSRC_TOK(ly) ((ly) == 0 ? arg_in(args, 0) : (const float*)args.out)

#pragma unroll
    for (int layer = 0; layer < 2; ++layer) {
        const int pb = layer * PH_PER_LAYER;
        if (((PHMASK >> 0) & 1) && IN(pb + 0)) {
            PH_BEGIN;
            for (int rep_ = 0; rep_ < NREP(0); ++rep_) { if (rep_) GRID_BAR();
            const float* meta = arg_in(args, 1);
            conv_matrix<1>(F, arg_in(args, 3) + (size_t)ly * DM * D_IN, DM, D_IN, WB_(WB_IN), arg_in(args, 2) + ly * DM);
            conv_matrix<0>(F, arg_in(args, 7) + (size_t)ly * 512 * 1536, 512, 1536, WB_(WB_QUP), arg_in(args, 5) + ly * 512);
            conv_matrix<0>(F, arg_in(args, 8) + (size_t)ly * 512 * 2048, 512, 2048, WB_(WB_KVUP), arg_in(args, 6) + ly * 512);
            for (int b = 0; b < 3; ++b) conv_matrix<0>(F, arg_in(args, 14) + ((size_t)ly * 3 + b) * 1024 * DM, 1024, DM, WB_(WB_BR) + (size_t)b * DM * 1024, nullptr);
            conv_matrix<0>(F, arg_in(args, 15) + (size_t)ly * DM * DM, DM, DM, WB_(WB_O), nullptr);
            conv_matrix<2>(F, arg_in(args, 17) + (size_t)ly * DM * 2 * DFF, DM, 2 * DFF, WB_(WB_F1), arg_in(args, 16) + ly * DM);
            conv_matrix<0>(F, arg_in(args, 18) + (size_t)ly * DFF * DM, DFF, DM, WB_(WB_F2), nullptr);
            unsigned zu = 0u; asm volatile("" : "+v"(zu)); const float zf = __uint_as_float(zu);
            for (int i = F.gw * 64 + F.lane; i < 112 * 2048 / 8; i += F.ngw * 64) *((u32x4*)(WB_(WB_IN) + (size_t)1168 * 2048) + i) = (u32x4){zu, zu, zu, zu};
            if (F.bid == 0) { const int i = F.tid; const int t = i >> 7, ps = i & 127, dim = (ps >> 1) + 64 * (ps & 1);
                const float* gsrc = (t < 2 ? arg_in(args, 10) : arg_in(args, 11)) + ly * 256 + (t & 1) * 128; GPERM_[i] = gsrc[dim]; }
            float* hmeta = HMETA_;
            if (ly == 0) {
                for (int i = F.gw * 64 + F.lane; i < MROW0 * PW / 8; i += F.ngw * 64) *((u32x4*)P_ + i) = (u32x4){zu, zu, zu, zu};
                for (int i = F.gw * 64 + F.lane; i < MBLK * DM / 4; i += F.ngw * 64) { const int rr = i / (DM / 4); f32x4 v = (f32x4){zf, zf, zf, zf};
                    if (rr >= MBLK - NMETA) v = *((const f32x4*)meta + (i - (MBLK - NMETA) * (DM / 4))); *((f32x4*)hmeta + i) = v; }
            }
            if (ly == 0) {
                const float* xin = arg_in(args, 0); bf16_t* XN = XN_; float* rs0 = RS_(0);
                for (int r = MROW0 + F.gw; r < R; r += F.ngw)
                    norm_row(r < MBLK ? meta + (size_t)(r - MROW0) * DM : xin + (size_t)(r - MBLK) * DM, XN + (size_t)r * DM, rs0 + r, F.lane);
            }
            }
            SEAM(pb + 0);
        }
        if (((PHMASK >> 1) & 1) && IN(pb + 1)) {
            PH_BEGIN;
            { SkP f{P_, 0, RS_(2 * ly)}; skinny_gemm(F.lds, XN_ + (size_t)MROW0 * DM, DM, WB_(WB_IN), DM, 1280 / 16, F.bid, F.G, f); }
            SchedPlain S{XN_, DM, WB_(WB_IN), DM, NPMM, 5, F.G, F.bid, 0}; EpiP E{P_, RS_(2 * ly)};
            pg8::gemm_phase(F.lds, S, E);
            if (NREP(1) == 2) { GRID_BAR(); pg8::gemm_phase(F.lds, S, E); }
            SEAM(pb + 1);
        }
        if (((PHMASK >> 2) & 1) && IN(pb + 2)) {
            PH_BEGIN;
            { bf16_t* P = P_; float* rq = RSTDQ_; float* rkv = RSTDKV_;
              for (int r = MROW0 + F.gw; r < R; r += F.ngw) post1a_row(P, r, rq, rkv, F.lane); }
            VM_WAIT(); __syncthreads();
            { SkP f{P_, C_QRAW, nullptr}; skinny_gemm(F.lds, P_ + (size_t)MROW0 * PW + C_CQ, PW, WB_(WB_QUP), 512, 1536 / 16, F.bid, F.G, f); }
            { SkP f{P_, C_KVRAW, nullptr}; skinny_gemm(F.lds, P_ + (size_t)MROW0 * PW + C_CKV, PW, WB_(WB_KVUP), 512, 2048 / 16, F.bid, F.G, f); }
            SchedMlaUp S{P_, WB_(WB_QUP), WB_(WB_KVUP), F.G, F.bid}; EpiP E{P_, nullptr};
            pg8::gemm_phase(F.lds, S, E);
            if (NREP(2) == 2) { GRID_BAR(); pg8::gemm_phase(F.lds, S, E); }
            SEAM(pb + 2);
        }
        if (((PHMASK >> 3) & 1) && IN(pb + 3)) {
            PH_BEGIN;
            const float* mla_qkg = arg_in(args, 9) + ly * 2 * 192;
            bf16_t* P = P_; float* rq = RSTDQ_; float* rkv = RSTDKV_;
            LAS float* rnl = (LAS float*)(F.lds + F.wave * 64);
            for (int r = MROW0 + F.gw; r < R; r += F.ngw) post2_row(P, r, rq, rkv, mla_qkg, rnl, F.lane);
            SEAM(pb + 3);
        }
        if (((PHMASK >> 4) & 1) && IN(pb + 4)) {
            PH_BEGIN;
            bf16_t* P = P_;
            LAS int* slot = (LAS int*)(F.lds + LDSCTL_OFF + 128);
            for (int rep_ = 0; rep_ < NREP(4); ++rep_) { if (rep_) GRID_BAR();
            unsigned* ctr = (unsigned*)(ws + WS_CTL) + CW_Q + 64 * (ly * 4 + 0) + 64 * 16 * rep_;
            fa::queue_prime(ctr, slot);
            for (int qk_ = 0;; ++qk_) {
                const int idx = fa::queue_next(ctr, slot, qk_); if (idx >= 8 * 129) break;
                int h; fa::Item it;
                if (idx < 1024) { const int qb = 7 - (idx >> 7), rest = idx & 127; h = rest & 7; it = fa::make_item(false, rest >> 3, qb); } else { h = idx - 1024; it = fa::make_item(true, 0, 0); }
                bf16x8 qr[12]; fa::load_q<192>(P, it, C_QRAW + h * 192, qr);
                fa::attn_core<192, false>(P, it, qr, C_KVRAW + h * 256, C_KPEH + h * 64, C_KVRAW + h * 256 + 128, C_OA + h * 128, nullptr, F.lds);
            } }
            SEAM(pb + 4);
        }
        if (((PHMASK >> 5) & 1) && IN(pb + 5)) {
            PH_BEGIN;
            { SkP f{P_, 1280, RS_(2 * ly)}; skinny_gemm(F.lds, XN_ + (size_t)MROW0 * DM, DM, WB_(WB_IN) + (size_t)1280 * DM, DM, 7168 / 16, F.bid, F.G, f); }
            SchedPlain S{XN_, DM, WB_(WB_IN) + (size_t)1280 * DM, DM, NPMM, 28, F.G, F.bid, 1280}; EpiG2 E{P_, RS_(2 * ly), GPERM_, (LAS float*)(F.lds + RING_BYTES)};
            pg8::gemm_phase(F.lds, S, E);
            if (NREP(5) == 2) { GRID_BAR(); pg8::gemm_phase(F.lds, S, E); }
            SEAM(pb + 5);
        }
        if (((PHMASK >> 6) & 1) && IN(pb + 6)) {
            PH_BEGIN;
            bf16_t* P = P_; const float* gp = GPERM_;
            if (F.gw < NMETA) meta_post_row(P, MROW0 + F.gw, gp, F.lane);
            SEAM(pb + 6);
        }
        if (((PHMASK >> 7) & 1) && IN(pb + 7)) {
            PH_BEGIN;
            bf16_t* P = P_; unsigned* bm = BM_;
            unsigned* ctr = (unsigned*)(ws + WS_CTL) + CW_Q + 64 * (ly * 4 + 2);
            LAS int* slot = (LAS int*)(F.lds + LDSCTL_OFF + 128);
            for (int rep_ = 0; rep_ < NREP(7); ++rep_) { if (rep_) GRID_BAR(); unsigned* c2 = ctr + 64 * 16 * rep_;
            for (;;) { const int idx = fa::next_item(c2, slot); if (idx >= NTOK / 8) break; index_unit(P, idx, bm, F.lds); } }
            SEAM(pb + 7);
        }
        if (((PHMASK >> 8) & 1) && IN(pb + 8)) {
            PH_BEGIN;
            bf16_t* P = P_; unsigned* bm = BM_;
            LAS int* slot = (LAS int*)(F.lds + LDSCTL_OFF + 128);
            for (int rep_ = 0; rep_ < NREP(8); ++rep_) { if (rep_) GRID_BAR();
            const bool dummy = (NREP(8) == 2) && rep_ == 0;
            unsigned* ctr = (unsigned*)(ws + WS_CTL) + CW_Q + 64 * (ly * 4 + 1) + 64 * 16 * rep_;
            fa::queue_prime(ctr, slot);
            for (int qk_ = 0;; ++qk_) {
                const int idx = fa::queue_next(ctr, slot, qk_); if (idx >= 16 * 129) break;
                int hh; bool meta = false; fa::Item it; int b = 0, qb = 0;
                if (idx < 2048) { qb = 7 - (idx >> 8); const int rest = idx & 255; hh = (rest < 128) ? 8 + (rest & 7) : (rest & 7); b = (rest & 127) >> 3; it = fa::make_item(false, b, qb); }
                else { hh = idx - 2048; hh = hh < 8 ? 8 + hh : hh - 8; meta = true; it = fa::make_item(true, 0, 0); }
                if (hh < 8) {
                    bf16x8 qr[8]; fa::load_q<128>(P, it, C_DQ + hh * 128, qr);
                    fa::attn_core<128, true>(P, it, qr, C_DK + hh * 128, 0, C_DV + hh * 128, dummy ? C_KPE : C_OB + hh * 128, meta ? nullptr : bm + (size_t)(b * SEQ + qb * 256) * BMW, F.lds);
                } else {
                    const int hj = hh - 8;
                    bf16x8 qr[8]; fa::load_q<128>(P, it, C_FQ + hj * 128, qr);
                    fa::attn_core<128, false>(P, it, qr, C_FK + hj * 128, 0, C_FV + (hj >> 1) * 256, dummy ? C_KPE : C_FQ + hj * 128, nullptr, F.lds);
                    fa::attn_core<128, false>(P, it, qr, C_FK + hj * 128, 0, C_FV + (hj >> 1) * 256 + 128, dummy ? C_KPE : C_IQ + hj * 128, nullptr, F.lds);
                }
            } }
            SEAM(pb + 8);
        }
        if (((PHMASK >> 9) & 1) && IN(pb + 9)) {
            PH_BEGIN;
            const float* diff_lam = arg_in(args, 12) + ly * 4 * 128; const float* diff_subg = arg_in(args, 13) + ly * 256;
            const float lambda_init = LAMBDA_INIT(ly);
            const float s1 = wave_sum(diff_lam[F.lane] * diff_lam[128 + F.lane] + diff_lam[64 + F.lane] * diff_lam[192 + F.lane]);
            const float s2 = wave_sum(diff_lam[256 + F.lane] * diff_lam[384 + F.lane] + diff_lam[320 + F.lane] * diff_lam[448 + F.lane]);
            const float lam = __expf(s1) - __expf(s2) + lambda_init;
            bf16_t* P = P_;
            for (int r = MROW0 + F.gw; r < R; r += F.ngw) post3_row(P, r, diff_subg, lam, 1.f - lambda_init, F.lane);
            SEAM(pb + 9);
        }
#define GATE_PHASE(k, b) \
        if (((PHMASK >> 10) & 1) && IN(pb + (k))) { \
            PH_BEGIN; \
            { SkGate f{(bf16_t*)(ws + WS_GS), arg_in(args, 4) + ly * 3 * DM + (b) * DM, RS_(2 * ly)}; skinny_gemm(F.lds, XN_ + (size_t)MROW0 * DM, DM, WB_(WB_G) + (size_t)(b) * 2048 * DM, DM, 2048 / 16, F.bid, F.G, f); } \
            SchedPlain S{XN_, DM, WB_(WB_G) + (size_t)(b) * 2048 * DM, DM, NPMM, 8, F.G, F.bid, 0}; EpiGate E{(bf16_t*)(ws + WS_GS), arg_in(args, 4) + ly * 3 * DM + (b) * DM, RS_(2 * ly)}; \
            pg8::gemm_phase(F.lds, S, E); \
            if (NREP(k) == 2) { GRID_BAR(); pg8::gemm_phase(F.lds, S, E); } \
            SEAM(pb + (k)); \
        }
#define BRANCH_PHASE(k, b, oc) \
        if (((PHMASK >> 10) & 1) && IN(pb + (k))) { \
            PH_BEGIN; \
            { SkGated f{P_, (const bf16_t*)(ws + WS_GS), (b) == 0 ? 1 : 0}; skinny_gemm(F.lds, P_ + (size_t)MROW0 * PW + (oc), PW, WB_(WB_BR) + (size_t)(b) * DM * 1024, 1024, 2048 / 16, F.bid, F.G, f); } \
            SchedPlain S{P_ + (oc), PW, WB_(WB_BR) + (size_t)(b) * DM * 1024, 1024, NPMM, 8, F.G, F.bid, C_MERGED}; EpiGated E{P_, (const bf16_t*)(ws + WS_GS), (b) == 0 ? 1 : 0, ((DBG_BM >> (b)) & 1) ? 1.f : 0.f}; \
            pg8::gemm_phase(F.lds, S, E); \
            if (NREP(k) == 2 && (b) == 0) { GRID_BAR(); pg8::gemm_phase(F.lds, S, E); } \
            SEAM(pb + (k)); \
        }
        GATE_PHASE(10, 0) BRANCH_PHASE(11, 0, C_OA)
        GATE_PHASE(12, 1) BRANCH_PHASE(13, 1, C_OB)
        GATE_PHASE(14, 2) BRANCH_PHASE(15, 2, C_OC)
        if (((PHMASK >> 11) & 1) && IN(pb + 16)) {
            PH_BEGIN;
            { SkRes f{HMETA_, XN_, RS_(2 * ly + 1)}; skinny_gemm(F.lds, P_ + (size_t)MROW0 * PW + C_MERGED, PW, WB_(WB_O), DM, 2048 / 16, F.bid, F.G, f); }
            SchedPlain S{P_ + C_MERGED, PW, WB_(WB_O), DM, NPMM, 8, F.G, F.bid, 0}; EpiRes E{HSRC_TOK(ly), OUT_, HMETA_, DBG_SA, XN_, RS_(2 * ly + 1)};
            pg8::gemm_phase(F.lds, S, E);
            SEAM(pb + 16);
        }
        if (((PHMASK >> 13) & 1) && IN(pb + 17)) {
            PH_BEGIN;
            skinny_swiglu(F.lds, XN_ + (size_t)MROW0 * DM, DM, WB_(WB_F1), DM, P_, RS_(2 * ly + 1), F.bid, F.G);
            SchedPlain S{XN_, DM, WB_(WB_F1), DM, NPMM, 44, F.G, F.bid, 0}; EpiSwiglu E{P_, RS_(2 * ly + 1)};
            pg8::gemm_phase(F.lds, S, E);
            if (NREP(17) == 2) { GRID_BAR(); pg8::gemm_phase(F.lds, S, E); }
            SEAM(pb + 17);
        }
        if (((PHMASK >> 14) & 1) && IN(pb + 18)) {
            PH_BEGIN;
            { SkRes f{HMETA_, ly == 0 ? XN_ : (bf16_t*)nullptr, RS_(2)}; skinny_gemm(F.lds, P_ + (size_t)MROW0 * PW, PW, WB_(WB_F2), DFF, 2048 / 16, F.bid, F.G, f); }
            SchedPlain S{P_, PW, WB_(WB_F2), DFF, NPMM, 8, F.G, F.bid, 0}; EpiRes E{OUT_, OUT_, HMETA_, DBG_SF, ly == 0 ? XN_ : (bf16_t*)nullptr, RS_(2)};
            pg8::gemm_phase(F.lds, S, E);
            SEAM(pb + 18);
        }
    }
#undef IN
#undef SEAM
}

__global__ void diag_fill(float* out, int n, float v) { for (int i = blockIdx.x * blockDim.x + threadIdx.x; i < n; i += gridDim.x * blockDim.x) out[i] = v; }
extern "C" void kernel_launch(void* const* d_in, const int* in_sizes, int n_in, void* d_out, int out_size, void* d_ws, size_t ws_size, hipStream_t stream) {
    static int grid = 0; static float code = 0.f;
    if (grid == 0) {
        int dev = 0, cus = 0;
        if (n_in != 19) { code = 10.f; grid = -1; }
        else if (ws_size < WS_END) { code = 20.f + (float)(ws_size >> 20) * 0.01f; grid = -1; }
        else if (hipGetDevice(&dev) != hipSuccess || hipDeviceGetAttribute(&cus, hipDeviceAttributeMultiprocessorCount, dev) != hipSuccess) { code = 40.f; grid = -1; }
        else if (hipFuncSetAttribute((const void*)mega_fwd, hipFuncAttributeMaxDynamicSharedMemorySize, LDS_BYTES) != hipSuccess) { code = 50.f; grid = -1; }
        else {
            int per_cu = 0;
            if (hipOccupancyMaxActiveBlocksPerMultiprocessor(&per_cu, (const void*)mega_fwd, NWAVES * 64, LDS_BYTES) != hipSuccess || per_cu < 1) { code = 60.f; grid = -1; }
            (void)hipGetLastError();
            if (grid == 0) grid = cus;
        }
    }
    if (grid < 0) { hipLaunchKernelGGL(diag_fill, dim3(1024), dim3(256), 0, stream, (float*)d_out, out_size, code); return; }
    (void)hipMemsetAsync((char*)d_ws + WS_CTL, 0, CTL_BYTES, stream);
    Args a{};
    for (int i = 0; i < 19; ++i) a.in[i] = (const float*)d_in[i];
    a.out = (float*)d_out; a.ws = (unsigned char*)d_ws;
#if MK_ONE_LAUNCH
    a.ph_lo = 0; a.ph_hi = N_PHASES;
    hipLaunchKernelGGL(mega_fwd, dim3(grid), dim3(NWAVES * 64), LDS_BYTES, stream, a);
#else
    for (int p = 0; p < N_PHASES; ++p) { a.ph_lo = p; a.ph_hi = p + 1; hipLaunchKernelGGL(mega_fwd, dim3(grid), dim3(NWAVES * 64), LDS_BYTES, stream, a); }
#endif
    if (hipPeekAtLastError() != hipSuccess) { (void)hipGetLastError(); hipLaunchKernelGGL(diag_fill, dim3(1024), dim3(256), 0, stream, (float*)d_out, out_size, 70.f); }
}
```

```cpp
#include <hip/hip_runtime.h>
#include <cstdio>
#include <cstdint>

#ifndef PHMASK
#define PHMASK 0x7fff
#endif
#ifndef REPMASK
#define REPMASK 0
#endif
#define NREP(k) ((((REPMASK) >> (k)) & 1) ? 2 : 1)
#ifndef DBG_BM
#define DBG_BM 7
#endif
#ifndef DBG_BR
#define DBG_BR 0
#endif
#ifndef DBG_SA
#define DBG_SA 1.0f
#endif
#ifndef DBG_SF
#define DBG_SF 1.0f
#endif
#ifndef MK_ONE_LAUNCH
#define MK_ONE_LAUNCH 1
#endif

#define LAS __attribute__((address_space(3)))
#define GAS __attribute__((address_space(1)))
typedef unsigned short bf16_t;
typedef short bf16x8 __attribute__((ext_vector_type(8)));
typedef float f32x4 __attribute__((ext_vector_type(4)));
typedef float f32x2 __attribute__((ext_vector_type(2)));
typedef unsigned u32x4 __attribute__((ext_vector_type(4)));
typedef unsigned u32x2 __attribute__((ext_vector_type(2)));

constexpr int DM = 2048, NB = 16, SEQ = 2048, NMETA = 16, MBLK = 256;
constexpr int R = MBLK + NB * SEQ;
constexpr int NPM = R / 256;
constexpr int NPMM = NPM - 1;
constexpr int MROW0 = MBLK - NMETA;
constexpr int NTOK = NB * SEQ;
constexpr int DFF = 5632;
constexpr int PW = 8448;
constexpr int C_CQ = 0, C_CKV = 512, C_KPE = 1024, C_IK = 1088, C_IW = 1152, C_DQ = 1280, C_DK = 2304, C_DV = 3328, C_IQ = 4352,
              C_FQ = 5376, C_FK = 6400, C_FV = 7424;
constexpr int C_KVRAW = 1280, C_QRAW = 3328, C_KPEH = 4864;
constexpr int C_OA = 0, C_OB = C_DQ, C_OC = C_FQ, C_MERGED = 2304;
constexpr int BMW = 66;
constexpr float EPS = 1e-6f;
constexpr float LOG2E = 1.4426950408889634f;
constexpr float C2_128 = 0.08838834764831845f * LOG2E;
constexpr float C2_192 = 0.07216878364870323f * LOG2E;
constexpr int D_IN = 14480;

constexpr size_t MiB = 1u << 20;
constexpr size_t WS_CTL = 0, CTL_BYTES = 1 * MiB;
constexpr size_t WS_RSTD = 1 * MiB;
constexpr size_t WS_HMETA = 2 * MiB;
constexpr size_t WS_BM = 4 * MiB;
constexpr size_t WS_WB = 16 * MiB;
constexpr size_t WB_IN = 0, WB_G = WB_IN + (size_t)8448 * 2048 * 2, WB_QUP = WB_G + (size_t)6144 * 2048 * 2, WB_KVUP = WB_QUP + (size_t)1536 * 512 * 2,
                 WB_BR = WB_KVUP + (size_t)2048 * 512 * 2, WB_O = WB_BR + (size_t)3 * 2048 * 1024 * 2, WB_F1 = WB_O + (size_t)2048 * 2048 * 2,
                 WB_F2 = WB_F1 + (size_t)11264 * 2048 * 2, WB_END = WB_F2 + (size_t)2048 * 5632 * 2;
constexpr size_t WS_XN = 164 * MiB;
constexpr size_t WS_P = 294 * MiB;
constexpr size_t WS_GS = 828 * MiB;
constexpr size_t WS_END = 960 * MiB;
static_assert(WS_GS + (size_t)R * 2048 * 2 <= WS_END && WS_WB + WB_END <= WS_XN && WS_XN + (size_t)R * 2048 * 2 <= WS_P && WS_P + (size_t)R * PW * 2 <= WS_GS, "ws map");
constexpr int CW_BAR = 4096, CW_Q = 16384;
constexpr size_t WS_RS = 256 * 1024;

__device__ __forceinline__ float bf2f(bf16_t v) { return __uint_as_float((unsigned)v << 16); }
__device__ __forceinline__ unsigned f2bf(float f) { unsigned u = __float_as_uint(f); return (u + 0x7fffu + ((u >> 16) & 1u)) >> 16; }
__device__ __forceinline__ unsigned pk2(float lo, float hi) { return f2bf(lo) | (f2bf(hi) << 16); }
typedef __bf16 bf16x2_t __attribute__((ext_vector_type(2)));
__device__ __forceinline__ unsigned cvt_pk_bf16(float lo, float hi) { f32x2 v = {lo, hi}; bf16x2_t b = __builtin_convertvector(v, bf16x2_t); return __builtin_bit_cast(unsigned, b); }
__device__ __forceinline__ float wave_sum(float v) {
#pragma unroll
    for (int o = 1; o < 64; o <<= 1) v += __shfl_xor(v, o);
    return v;
}
__device__ __forceinline__ float wave_max(float v) {
#pragma unroll
    for (int o = 1; o < 64; o <<= 1) v = fmaxf(v, __shfl_xor(v, o));
    return v;
}
#define LDS_WAIT() asm volatile("s_waitcnt lgkmcnt(0)" ::: "memory")
#define VM_WAIT() asm volatile("s_waitcnt vmcnt(0)" ::: "memory")
__device__ __forceinline__ int row_pos(int r) { return r < MBLK ? (r >= MBLK - NMETA ? r - (MBLK - NMETA) : 0) : NMETA + ((r - MBLK) & (SEQ - 1)); }
__device__ __forceinline__ void rope_cs(int pos, int i, float two_over_d, float& c, float& s) {
    const float inv = __builtin_amdgcn_exp2f(-(float)i * two_over_d * 13.287712379549449f);
    float rev = (float)pos * inv * 0.15915494309189535f;
    rev -= floorf(rev);
    s = __builtin_amdgcn_sinf(rev); c = __builtin_amdgcn_cosf(rev);
}

namespace pg8 {
constexpr int BM = 256, BK = 64, HALF = 128, HTB = HALF * BK * 2, STAGE_BYTES = 8 * HTB;
__device__ __forceinline__ int lds_byte(int r, int c) { const int st = (r >> 4) * 2 + (c >> 5), rr = r & 15, cc = c & 31, ob = rr * 64 + cc * 2; return st * 1024 + (ob ^ (((ob >> 9) & 1) << 5)); }
__device__ __forceinline__ void stage_rc(int b, int& R_, int& C_) { const int st = b / 1024, sb = b % 1024, swz = sb ^ (((sb >> 9) & 1) << 5); R_ = (st >> 1) * 16 + swz / 64; C_ = (st & 1) * 32 + (swz % 64) / 2; }
__device__ __forceinline__ int perm32(int rho) { const int n = rho >> 4, i = rho & 15; return 8 * (i >> 2) + 4 * n + (i & 3); }

struct Unit { const char* A; const char* B; unsigned lda2, ldb2; int nt, pm, pn, kind, ocol; };

__device__ __forceinline__ void tile_of(int L, int nM, int nN, int& pm, int& pn) {
    const int nwg = nM * nN; int wgid = L;
    { const int q = nwg / 8, r = nwg % 8, xcd = wgid % 8, off = wgid / 8; wgid = (xcd < r ? xcd * (q + 1) : r * (q + 1) + (xcd - r) * q) + off; }
    const int nig = 8 * nN, gid = wgid / nig, fm = gid * 8, gsz = (nM - fm) < 8 ? (nM - fm) : 8;
    pm = fm + ((wgid % nig) % gsz); pn = (wgid % nig) / gsz;
}

template <class Epi, class Sched>
__device__ __forceinline__ void gemm_phase(LAS unsigned char* lds, const Sched& S, const Epi& E) {
    int tid = threadIdx.x; asm volatile("" : "+v"(tid));
    const int wid = __builtin_amdgcn_readfirstlane(tid >> 6), lane = tid & 63, wr = wid >> 2, wc = wid & 3, fr = lane & 15, fq = lane >> 4;
    unsigned rA[2], rB[2], cc[2];
#pragma unroll
    for (int i = 0; i < 2; ++i) { int R_, C_; stage_rc(tid * 16 + i * 8192, R_, C_); rA[i] = (unsigned)R_; rB[i] = (unsigned)(Epi::PERM ? ((R_ & ~31) + perm32(R_ & 31)) : R_); cc[i] = (unsigned)C_ * 2u; }
    const size_t kstep = (size_t)(BK * 2);
    const unsigned ldsw = (unsigned)wid * 1024u;
    const int aoff = lds_byte(wr * 64 + fr, fq * 8), boff = lds_byte(wc * 32 + fr, fq * 8);
#define PG8_SA(b, h) (((b) * 2 + (h)) * HTB)
#define PG8_SB(b, h) ((4 + (b) * 2 + (h)) * HTB)
#define PG8_STAGE(bufoff, gbase, rr, ld2) do { _Pragma("unroll") for (int _i = 0; _i < 2; ++_i) \
        __builtin_amdgcn_global_load_lds((const unsigned*)((const char*)(gbase) + ((rr)[_i] * (ld2) + cc[_i])), (LAS unsigned*)(lds + (bufoff) + ldsw + _i * 8192), 16, 0, 0); } while (0)
#define PG8_LDA(dst, b, h) do { _Pragma("unroll") for (int m = 0; m < 4; ++m) _Pragma("unroll") for (int k = 0; k < 2; ++k) dst[m][k] = *(const LAS bf16x8*)(lds + PG8_SA(b, h) + aoff + m * 2048 + k * 1024); } while (0)
#define PG8_LDB(dst, b, h) do { _Pragma("unroll") for (int n = 0; n < 2; ++n) _Pragma("unroll") for (int k = 0; k < 2; ++k) dst[n][k] = *(const LAS bf16x8*)(lds + PG8_SB(b, h) + boff + n * 2048 + k * 1024); } while (0)
#define PG8_MMA(ai, bj, At, Bt) do { __builtin_amdgcn_s_setprio(1); _Pragma("unroll") for (int m = 0; m < 4; ++m) _Pragma("unroll") for (int n = 0; n < 2; ++n) _Pragma("unroll") for (int k = 0; k < 2; ++k) \
        acc[ai][bj][m][n] = __builtin_amdgcn_mfma_f32_16x16x32_bf16(Bt[n][k], At[m][k], acc[ai][bj][m][n], 0, 0, 0); __builtin_amdgcn_s_setprio(0); } while (0)
#define PG8_WAIT_V(n) asm volatile("s_waitcnt vmcnt(" #n ")" ::: "memory")
#define PG8_WAIT_L(n) asm volatile("s_waitcnt lgkmcnt(" #n ")" ::: "memory")
#define PG8_BAR __builtin_amdgcn_s_barrier()
#define PG8_SCHED __builtin_amdgcn_sched_barrier(0)
    Unit cur, nxt; int ui = 0;
    if (!S.next(0, cur)) return;
    float zf = 0.f; asm volatile("" : "+v"(zf));
    f32x4 acc[2][2][4][2];
#pragma unroll
    for (int a = 0; a < 2; ++a)
#pragma unroll
        for (int b = 0; b < 2; ++b)
#pragma unroll
            for (int m = 0; m < 4; ++m)
#pragma unroll
                for (int n = 0; n < 2; ++n) acc[a][b][m][n] = (f32x4){zf, zf, zf, zf};
    bf16x8 At[4][2], B0[2][2], B1[2][2];
    const char* cA = cur.A; const char* cB = cur.B;
    unsigned lA = cur.lda2, lB = cur.ldb2;
    size_t hA = (size_t)HALF * lA, hB = (size_t)HALF * lB;
    PG8_STAGE(PG8_SB(0, 0), cB, rB, lB); PG8_STAGE(PG8_SB(0, 1), cB + hB, rB, lB); PG8_STAGE(PG8_SA(0, 0), cA, rA, lA); PG8_STAGE(PG8_SA(0, 1), cA + hA, rA, lA);
    if (wr == 1) PG8_BAR;
    PG8_WAIT_V(2); PG8_BAR;
    PG8_STAGE(PG8_SB(1, 0), cB + kstep, rB, lB); PG8_STAGE(PG8_SA(1, 0), cA + kstep, rA, lA); PG8_STAGE(PG8_SB(1, 1), cB + hB + kstep, rB, lB);
    PG8_WAIT_V(6); PG8_BAR;
    for (;;) {
        const bool has_next = S.next(ui + 1, nxt);
        if (!has_next) nxt = cur;
        const char* nA = nxt.A; const char* nB = nxt.B;
        const unsigned lAn = nxt.lda2, lBn = nxt.ldb2;
        const size_t hAn = (size_t)HALF * lAn, hBn = (size_t)HALF * lBn;
        const int nt = cur.nt;
        for (int t = 0; t < nt; t += 2) {
            const bool last = (t == nt - 2);
            const char* a1 = cA + (size_t)(t + 1) * kstep;
            const char* a2 = last ? nA : cA + (size_t)(t + 2) * kstep; const char* b2 = last ? nB : cB + (size_t)(t + 2) * kstep;
            const char* a3 = a2 + kstep; const char* b3 = b2 + kstep;
            const size_t hA2 = last ? hAn : hA, hB2 = last ? hBn : hB;
            const unsigned lA2 = last ? lAn : lA, lB2 = last ? lBn : lB;
            PG8_LDB(B0, 0, 0); PG8_LDB(B1, 0, 1); PG8_SCHED; PG8_LDA(At, 0, 0); PG8_STAGE(PG8_SA(1, 1), a1 + hA, rA, lA);
            PG8_WAIT_V(8); PG8_WAIT_L(0); PG8_BAR; PG8_MMA(0, 0, At, B0); PG8_MMA(0, 1, At, B1); PG8_BAR; PG8_SCHED;
            PG8_LDA(At, 0, 1); PG8_STAGE(PG8_SB(0, 0), b2, rB, lB2); PG8_STAGE(PG8_SB(0, 1), b2 + hB2, rB, lB2); PG8_STAGE(PG8_SA(0, 0), a2, rA, lA2);
            PG8_WAIT_V(8); PG8_WAIT_L(0); PG8_BAR; PG8_MMA(1, 0, At, B0); PG8_MMA(1, 1, At, B1); PG8_BAR; PG8_SCHED;
            PG8_LDB(B0, 1, 0); PG8_LDB(B1, 1, 1); PG8_SCHED; PG8_LDA(At, 1, 0); PG8_STAGE(PG8_SA(0, 1), a2 + hA2, rA, lA2);
            PG8_WAIT_V(8); PG8_WAIT_L(0); PG8_BAR; PG8_MMA(0, 0, At, B0); PG8_MMA(0, 1, At, B1); PG8_BAR; PG8_SCHED;
            PG8_LDA(At, 1, 1); PG8_STAGE(PG8_SB(1, 0), b3, rB, lB2); PG8_STAGE(PG8_SB(1, 1), b3 + hB2, rB, lB2); PG8_STAGE(PG8_SA(1, 0), a3, rA, lA2);
            PG8_WAIT_V(8); PG8_WAIT_L(0); PG8_BAR; PG8_MMA(1, 0, At, B0); PG8_MMA(1, 1, At, B1); PG8_BAR; PG8_SCHED;
        }
        if (wr == 0) PG8_BAR;
        E(acc, cur, wr, wc, fr, fq);
#pragma unroll
        for (int a = 0; a < 2; ++a)
#pragma unroll
            for (int b = 0; b < 2; ++b)
#pragma unroll
                for (int m = 0; m < 4; ++m)
#pragma unroll
                    for (int n = 0; n < 2; ++n) acc[a][b][m][n] = (f32x4){zf, zf, zf, zf};
        if (!has_next) break;
        cur = nxt; cA = nA; cB = nB; hA = hAn; hB = hBn; lA = lAn; lB = lBn; ++ui;
        if (wr == 1) PG8_BAR;
    }
    PG8_WAIT_V(0);
    PG8_BAR;
#undef PG8_SA
#undef PG8_SB
#undef PG8_STAGE
#undef PG8_LDA
#undef PG8_LDB
#undef PG8_MMA
#undef PG8_WAIT_V
#undef PG8_WAIT_L
#undef PG8_BAR
#undef PG8_SCHED
}
}
using pg8::Unit;

struct SchedPlain {
    const bf16_t* A; int lda; const bf16_t* B; int K; int nM, nN, G, c, ocol0;
    __device__ __forceinline__ bool next(int i, Unit& u) const {
        const int L = i * G + c; if (L >= nM * nN) return false;
        int pm, pn; pg8::tile_of(L, nM, nN, pm, pn); pm += 1;
        u.pm = pm; u.pn = pn; u.kind = 0; u.ocol = ocol0 + 256 * pn; u.nt = K / 64; u.lda2 = (unsigned)lda * 2u; u.ldb2 = (unsigned)K * 2u;
        u.A = (const char*)(A + (size_t)pm * 256 * lda); u.B = (const char*)(B + (size_t)pn * 256 * K); return true;
    }
};
struct SchedMlaUp {
    const bf16_t* P; const bf16_t* Wq; const bf16_t* Wkv; int G, c;
    __device__ __forceinline__ bool next(int i, Unit& u) const {
        const int L = i * G + c; if (L >= NPMM * 14) return false;
        int pm, pn; pg8::tile_of(L, NPMM, 14, pm, pn); pm += 1;
        u.pm = pm; u.pn = pn; u.kind = 0; u.nt = 8; u.lda2 = PW * 2u; u.ldb2 = 512 * 2u;
        if (pn < 6) { u.A = (const char*)(P + (size_t)pm * 256 * PW + C_CQ); u.B = (const char*)(Wq + (size_t)pn * 256 * 512); u.ocol = C_QRAW + 256 * pn; }
        else { u.A = (const char*)(P + (size_t)pm * 256 * PW + C_CKV); u.B = (const char*)(Wkv + (size_t)(pn - 6) * 256 * 512); u.ocol = C_KVRAW + 256 * (pn - 6); }
        return true;
    }
};
struct EpiP {
    static constexpr bool PERM = true;
    bf16_t* P; const float* rs;
    __device__ __forceinline__ void operator()(const f32x4 (&acc)[2][2][4][2], const Unit& u, int wr, int wc, int fr, int fq) const {
        asm volatile("" : "+v"(fr), "+v"(fq));
        const int row0 = u.pm * 256 + wr * 64 + fr, col0 = u.ocol + wc * 32 + 8 * fq;
#pragma unroll
        for (int ai = 0; ai < 2; ++ai)
#pragma unroll
            for (int m = 0; m < 4; ++m) { bf16_t* rowp = P + (size_t)(row0 + ai * 128 + m * 16) * PW + col0;
                const float sc = rs ? __builtin_amdgcn_rsqf(rs[row0 + ai * 128 + m * 16] * (1.f / DM) + EPS) : 1.f;
#pragma unroll
                for (int bj = 0; bj < 2; ++bj) { const f32x4 v0 = acc[ai][bj][m][0] * sc, v1 = acc[ai][bj][m][1] * sc;
                    u32x4 w; w.x = cvt_pk_bf16(v0[0], v0[1]); w.y = cvt_pk_bf16(v0[2], v0[3]); w.z = cvt_pk_bf16(v1[0], v1[1]); w.w = cvt_pk_bf16(v1[2], v1[3]);
                    *(u32x4*)(rowp + bj * 128) = w; } }
    }
};
struct EpiG2 {
    static constexpr bool PERM = true;
    bf16_t* P; const float* rs; const float* gperm; LAS float* xl;
    __device__ __forceinline__ void operator()(const f32x4 (&acc)[2][2][4][2], const Unit& u, int wr, int wc, int fr, int fq) const {
        asm volatile("" : "+v"(fr), "+v"(fq));
        const int row0 = u.pm * 256 + wr * 64 + fr, lcol = wc * 32 + 8 * fq, col0 = u.ocol + lcol;
        const int pn = u.pn;
        const bool plain = (pn >= 8 && pn < 12) || pn >= 24, isidx = (pn >= 12 && pn < 16), nrm = !plain && !isidx;
        float rsc[2][4];
#pragma unroll
        for (int ai = 0; ai < 2; ++ai)
#pragma unroll
            for (int m = 0; m < 4; ++m) rsc[ai][m] = __builtin_amdgcn_rsqf(rs[row0 + ai * 128 + m * 16] * (1.f / DM) + EPS);
        if (nrm) {
#pragma unroll
            for (int ai = 0; ai < 2; ++ai)
#pragma unroll
                for (int m = 0; m < 4; ++m)
#pragma unroll
                    for (int bj = 0; bj < 2; ++bj) { const f32x4 a = acc[ai][bj][m][0], b = acc[ai][bj][m][1]; float ss = (a[0] * a[0] + a[1] * a[1]) + (a[2] * a[2] + a[3] * a[3]) + (b[0] * b[0] + b[1] * b[1]) + (b[2] * b[2] + b[3] * b[3]);
                        ss += __shfl_xor(ss, 16); ss += __shfl_xor(ss, 32);
                        if (fq == 0) xl[((wr * 64 + fr + ai * 128 + m * 16) * 2 + bj) * 4 + wc] = ss * rsc[ai][m] * rsc[ai][m]; }
            asm volatile("s_waitcnt lgkmcnt(0)" ::: "memory"); __builtin_amdgcn_s_barrier(); asm volatile("" ::: "memory");
        }
        const int i0 = isidx ? (16 * (wc & 1) + 4 * fq) : (16 * wc + 4 * fq);
        const float tod = isidx ? (2.f / 64.f) : (2.f / 128.f);
        float inv[4];
#pragma unroll
        for (int j = 0; j < 4; ++j) inv[j] = __builtin_amdgcn_exp2f(-(float)(i0 + j) * tod * 13.287712379549449f) * 0.15915494309189535f;
        const int gidx = pn < 4 ? 0 : (pn < 8 ? 1 : (pn < 20 ? 2 : 3));
        const float qscale = (pn < 4 || (pn >= 16 && pn < 20)) ? C2_128 : 1.f;
        f32x4 g0 = (f32x4){1.f, 1.f, 1.f, 1.f}, g1 = g0;
        if (nrm) { g0 = *(const f32x4*)(gperm + gidx * 128 + lcol); g1 = *(const f32x4*)(gperm + gidx * 128 + lcol + 4); }
#pragma unroll
        for (int ai = 0; ai < 2; ++ai)
#pragma unroll
            for (int m = 0; m < 4; ++m) { const int row = row0 + ai * 128 + m * 16; bf16_t* rowp = P + (size_t)row * PW + col0;
                float cs[4], sn[4];
                if (!plain) { const float pos = (float)(NMETA + ((row - MBLK) & (SEQ - 1)));
#pragma unroll
                    for (int j = 0; j < 4; ++j) { float rev = pos * inv[j]; rev -= floorf(rev); sn[j] = __builtin_amdgcn_sinf(rev); cs[j] = __builtin_amdgcn_cosf(rev); } }
#pragma unroll
                for (int bj = 0; bj < 2; ++bj) { f32x4 v0 = acc[ai][bj][m][0] * rsc[ai][m], v1 = acc[ai][bj][m][1] * rsc[ai][m];
                    if (!plain) {
                        if (nrm) { const LAS f32x4* xp = (const LAS f32x4*)(xl + ((wr * 64 + fr + ai * 128 + m * 16) * 2 + bj) * 4); const f32x4 pp = *xp;
                            const float rn = __builtin_amdgcn_rsqf(((pp[0] + pp[1]) + (pp[2] + pp[3])) * (1.f / 128.f) + EPS); v0 = v0 * (g0 * rn); v1 = v1 * (g1 * rn); }
                        f32x4 w0, w1;
                        w0[0] = v0[0] * cs[0] - v0[1] * sn[0]; w0[1] = v0[1] * cs[0] + v0[0] * sn[0]; w0[2] = v0[2] * cs[1] - v0[3] * sn[1]; w0[3] = v0[3] * cs[1] + v0[2] * sn[1];
                        w1[0] = v1[0] * cs[2] - v1[1] * sn[2]; w1[1] = v1[1] * cs[2] + v1[0] * sn[2]; w1[2] = v1[2] * cs[3] - v1[3] * sn[3]; w1[3] = v1[3] * cs[3] + v1[2] * sn[3];
                        v0 = w0 * qscale; v1 = w1 * qscale; }
                    u32x4 w; w.x = cvt_pk_bf16(v0[0], v0[1]); w.y = cvt_pk_bf16(v0[2], v0[3]); w.z = cvt_pk_bf16(v1[0], v1[1]); w.w = cvt_pk_bf16(v1[2], v1[3]);
                    *(u32x4*)(rowp + bj * 128) = w; } }
    }
};
struct EpiGate {
    static constexpr bool PERM = true;
    bf16_t* G; const float* bias; const float* rs;
    __device__ __forceinline__ void operator()(const f32x4 (&acc)[2][2][4][2], const Unit& u, int wr, int wc, int fr, int fq) const {
        asm volatile("" : "+v"(fr), "+v"(fq));
        const int row0 = u.pm * 256 + wr * 64 + fr, col0 = u.pn * 256 + wc * 32 + 8 * fq;
        float rsc[2][4];
#pragma unroll
        for (int ai = 0; ai < 2; ++ai)
#pragma unroll
            for (int m = 0; m < 4; ++m) rsc[ai][m] = __builtin_amdgcn_rsqf(rs[row0 + ai * 128 + m * 16] * (1.f / DM) + EPS);
#pragma unroll
        for (int bj = 0; bj < 2; ++bj) { const f32x4 bv0 = *(const f32x4*)(bias + col0 + bj * 128), bv1 = *(const f32x4*)(bias + col0 + bj * 128 + 4);
#pragma unroll
            for (int ai = 0; ai < 2; ++ai)
#pragma unroll
                for (int m = 0; m < 4; ++m) { bf16_t* rowp = G + (size_t)(row0 + ai * 128 + m * 16) * 2048 + col0; f32x4 v0 = acc[ai][bj][m][0] * rsc[ai][m] + bv0, v1 = acc[ai][bj][m][1] * rsc[ai][m] + bv1;
#pragma unroll
                    for (int e = 0; e < 4; ++e) { v0[e] = __builtin_amdgcn_rcpf(1.f + __builtin_amdgcn_exp2f(-v0[e] * LOG2E)); v1[e] = __builtin_amdgcn_rcpf(1.f + __builtin_amdgcn_exp2f(-v1[e] * LOG2E)); }
                    u32x4 w; w.x = cvt_pk_bf16(v0[0], v0[1]); w.y = cvt_pk_bf16(v0[2], v0[3]); w.z = cvt_pk_bf16(v1[0], v1[1]); w.w = cvt_pk_bf16(v1[2], v1[3]);
                    *(u32x4*)(rowp + bj * 128) = w; } }
    }
};
struct EpiGated {
    static constexpr bool PERM = true;
    bf16_t* P; const bf16_t* G; int first; float sc;
    __device__ __forceinline__ void operator()(const f32x4 (&acc)[2][2][4][2], const Unit& u, int wr, int wc, int fr, int fq) const {
        asm volatile("" : "+v"(fr), "+v"(fq));
        const int row0 = u.pm * 256 + wr * 64 + fr, lcol0 = u.pn * 256 + wc * 32 + 8 * fq, col0 = u.ocol + wc * 32 + 8 * fq;
        unsigned zu = 0u; asm volatile("" : "+v"(zu));
#pragma unroll
        for (int ai = 0; ai < 2; ++ai)
#pragma unroll
            for (int m = 0; m < 4; ++m) { bf16_t* rowp = P + (size_t)(row0 + ai * 128 + m * 16) * PW + col0; const bf16_t* gp = G + (size_t)(row0 + ai * 128 + m * 16) * 2048 + lcol0;
#pragma unroll
                for (int bj = 0; bj < 2; ++bj) { u32x4 g = *(const u32x4*)(gp + bj * 128); if (DBG_BR == 1) g = (u32x4){0x3f803f80u, 0x3f803f80u, 0x3f803f80u, 0x3f803f80u};
                    u32x4 pv = (u32x4){zu, zu, zu, zu}; if (!first) pv = *(const u32x4*)(rowp + bj * 128);
                    const f32x4 v0 = acc[ai][bj][m][0] * sc, v1 = acc[ai][bj][m][1] * sc;
                    float o[8];
                    o[0] = __uint_as_float(pv.x << 16) + __uint_as_float(g.x << 16) * v0[0]; o[1] = __uint_as_float(pv.x & 0xffff0000u) + __uint_as_float(g.x & 0xffff0000u) * v0[1];
                    o[2] = __uint_as_float(pv.y << 16) + __uint_as_float(g.y << 16) * v0[2]; o[3] = __uint_as_float(pv.y & 0xffff0000u) + __uint_as_float(g.y & 0xffff0000u) * v0[3];
                    o[4] = __uint_as_float(pv.z << 16) + __uint_as_float(g.z << 16) * v1[0]; o[5] = __uint_as_float(pv.z & 0xffff0000u) + __uint_as_float(g.z & 0xffff0000u) * v1[1];
                    o[6] = __uint_as_float(pv.w << 16) + __uint_as_float(g.w << 16) * v1[2]; o[7] = __uint_as_float(pv.w & 0xffff0000u) + __uint_as_float(g.w & 0xffff0000u) * v1[3];
                    u32x4 w; w.x = cvt_pk_bf16(o[0], o[1]); w.y = cvt_pk_bf16(o[2], o[3]); w.z = cvt_pk_bf16(o[4], o[5]); w.w = cvt_pk_bf16(o[6], o[7]);
                    *(u32x4*)(rowp + bj * 128) = w; }
                asm volatile("" ::: "memory"); }
    }
};
struct EpiRes {
    static constexpr bool PERM = false;
    const float* base_tok; float* out_tok; float* hmeta; float dbg; bf16_t* hb; float* rs;
    __device__ __forceinline__ void operator()(const f32x4 (&acc)[2][2][4][2], const Unit& u, int wr, int wc, int fr, int fq) const {
        asm volatile("" : "+v"(fr), "+v"(fq));
        const float* bp; float* op;
        if (u.pm == 0) { bp = hmeta; op = hmeta; } else { bp = base_tok + (size_t)(u.pm - 1) * 256 * DM; op = out_tok + (size_t)(u.pm - 1) * 256 * DM; }
        const int lrow0 = wr * 64 + fr, col0 = u.pn * 256 + wc * 32 + 4 * fq;
#pragma unroll
        for (int ai = 0; ai < 2; ++ai)
#pragma unroll
            for (int m = 0; m < 4; ++m) { const size_t off = (size_t)(lrow0 + ai * 128 + m * 16) * DM + col0;
                const int grow = u.pm * 256 + lrow0 + ai * 128 + m * 16; float ss = 0.f;
#pragma unroll
                for (int bj = 0; bj < 2; ++bj)
#pragma unroll
                    for (int n = 0; n < 2; ++n) { const f32x4 bs = *(const f32x4*)(bp + off + bj * 128 + n * 16); const f32x4 hv = bs + acc[ai][bj][m][n] * dbg; *(f32x4*)(op + off + bj * 128 + n * 16) = hv;
                        if (hb) { ss += (hv[0] * hv[0] + hv[1] * hv[1]) + (hv[2] * hv[2] + hv[3] * hv[3]); u32x2 w; w.x = cvt_pk_bf16(hv[0], hv[1]); w.y = cvt_pk_bf16(hv[2], hv[3]); *(u32x2*)(hb + (size_t)grow * DM + col0 + bj * 128 + n * 16) = w; } }
                if (hb) { ss += __shfl_xor(ss, 16); ss += __shfl_xor(ss, 32); if (fq == 0) (void)__hip_atomic_fetch_add(rs + grow, ss, __ATOMIC_RELAXED, __HIP_MEMORY_SCOPE_AGENT); }
                asm volatile("" ::: "memory"); }
    }
};
struct EpiSwiglu {
    static constexpr bool PERM = true;
    bf16_t* P; const float* rs;
    __device__ __forceinline__ void operator()(const f32x4 (&acc)[2][2][4][2], const Unit& u, int wr, int wc, int fr, int fq) const {
        asm volatile("" : "+v"(fr), "+v"(fq));
        const int row0 = u.pm * 256 + wr * 64 + fr, col0 = u.pn * 128 + wc * 32 + 8 * fq;
#pragma unroll
        for (int ai = 0; ai < 2; ++ai)
#pragma unroll
            for (int m = 0; m < 4; ++m) { bf16_t* rowp = P + (size_t)(row0 + ai * 128 + m * 16) * PW + col0;
                const float sc = __builtin_amdgcn_rsqf(rs[row0 + ai * 128 + m * 16] * (1.f / DM) + EPS);
                float o[8];
#pragma unroll
                for (int n = 0; n < 2; ++n)
#pragma unroll
                    for (int e = 0; e < 4; ++e) { const float g = acc[ai][0][m][n][e] * sc, up = acc[ai][1][m][n][e] * sc; o[n * 4 + e] = g * __builtin_amdgcn_rcpf(1.f + __builtin_amdgcn_exp2f(-g * LOG2E)) * up; }
                u32x4 w; w.x = cvt_pk_bf16(o[0], o[1]); w.y = cvt_pk_bf16(o[2], o[3]); w.z = cvt_pk_bf16(o[4], o[5]); w.w = cvt_pk_bf16(o[6], o[7]);
                *(u32x4*)rowp = w; }
    }
};

struct SkP { bf16_t* P; int ocol; const float* rs; __device__ __forceinline__ void operator()(int r, int c, float v) const { if (rs) v *= __builtin_amdgcn_rsqf(rs[MROW0 + r] * (1.f / DM) + EPS); P[(size_t)(MROW0 + r) * PW + ocol + c] = (bf16_t)f2bf(v); } };
struct SkGate { bf16_t* G; const float* bias; const float* rs; __device__ __forceinline__ void operator()(int r, int c, float v) const { v *= __builtin_amdgcn_rsqf(rs[MROW0 + r] * (1.f / DM) + EPS); G[(size_t)(MROW0 + r) * 2048 + c] = (bf16_t)f2bf(__builtin_amdgcn_rcpf(1.f + __builtin_amdgcn_exp2f(-(v + bias[c]) * LOG2E))); } };
struct SkGated { bf16_t* P; const bf16_t* G; int first; __device__ __forceinline__ void operator()(int r, int c, float v) const { bf16_t* p = P + (size_t)(MROW0 + r) * PW + C_MERGED + c; const float pv = first ? 0.f : bf2f(*p); *p = (bf16_t)f2bf(pv + bf2f(G[(size_t)(MROW0 + r) * 2048 + c]) * v); } };
struct SkRes { float* hmeta; bf16_t* hb; float* rs;
    __device__ __forceinline__ void operator()(int r, int c, float v) const { float* p = hmeta + (size_t)(MROW0 + r) * DM + c; const float hv = *p + v; *p = hv;
        if (hb) { hb[(size_t)(MROW0 + r) * DM + c] = (bf16_t)f2bf(hv); float ss = hv * hv; ss += __shfl_xor(ss, 1); ss += __shfl_xor(ss, 2); ss += __shfl_xor(ss, 4); ss += __shfl_xor(ss, 8);
            if ((threadIdx.x & 15) == 0) (void)__hip_atomic_fetch_add(rs + MROW0 + r, ss, __ATOMIC_RELAXED, __HIP_MEMORY_SCOPE_AGENT); } } };
template <class Fn>
__device__ __forceinline__ void skinny_gemm(LAS unsigned char* lds, const bf16_t* A, int lda, const bf16_t* Bt, int K, int ntask, int bid, int G, const Fn& f) {
    int tid = threadIdx.x; asm volatile("" : "+v"(tid));
    const int wid = __builtin_amdgcn_readfirstlane(tid >> 6), lane = tid & 63, l15 = lane & 15, kq = lane >> 4;
    LAS f32x4* red = (LAS f32x4*)lds;
    const int kw = K / 8;
    for (int task = bid; task < ntask; task += G) {
        const bf16_t* ap = A + (size_t)l15 * lda + wid * kw + kq * 8;
        const bf16_t* bp = Bt + (size_t)(task * 16 + l15) * K + wid * kw + kq * 8;
        float z = 0.f; asm volatile("" : "+v"(z));
        f32x4 acc = (f32x4){z, z, z, z};
        for (int k0 = 0; k0 < kw; k0 += 256) {
            bf16x8 fa[8], fb[8];
#pragma unroll
            for (int i = 0; i < 8; ++i) { const int k = (k0 + 32 * i < kw) ? k0 + 32 * i : 0; fa[i] = *(const bf16x8*)(ap + k); fb[i] = *(const bf16x8*)(bp + k); }
#pragma unroll
            for (int i = 0; i < 8; ++i) if (k0 + 32 * i < kw) acc = __builtin_amdgcn_mfma_f32_16x16x32_bf16(fa[i], fb[i], acc, 0, 0, 0);
        }
        red[wid * 64 + lane] = acc;
        LDS_WAIT(); __syncthreads();
        if (wid == 0) {
            f32x4 s = red[lane];
#pragma unroll
            for (int w = 1; w < 8; ++w) s += red[w * 64 + lane];
#pragma unroll
            for (int r = 0; r < 4; ++r) f(kq * 4 + r, task * 16 + l15, s[r]);
        }
        __syncthreads();
    }
}
__device__ __forceinline__ void skinny_swiglu(LAS unsigned char* lds, const bf16_t* A, int lda, const bf16_t* Bt, int K, bf16_t* P, const float* rs, int bid, int G) {
    int tid = threadIdx.x; asm volatile("" : "+v"(tid));
    const int wid = __builtin_amdgcn_readfirstlane(tid >> 6), lane = tid & 63, l15 = lane & 15, kq = lane >> 4;
    LAS f32x4* red = (LAS f32x4*)lds;
    const int kw = K / 8;
    for (int task = bid; task < DFF / 16; task += G) {
        const int c0 = task * 16, brow = (c0 >> 7) * 256 + (c0 & 127) + l15;
        const bf16_t* ap = A + (size_t)l15 * lda + wid * kw + kq * 8;
        const bf16_t* bg = Bt + (size_t)brow * K + wid * kw + kq * 8; const bf16_t* bu = bg + (size_t)128 * K;
        float z = 0.f; asm volatile("" : "+v"(z));
        f32x4 ag = (f32x4){z, z, z, z}, au = ag;
        {
            bf16x8 fa[8], fg[8], fu[8];
#pragma unroll
            for (int i = 0; i < 8; ++i) { fa[i] = *(const bf16x8*)(ap + 32 * i); fg[i] = *(const bf16x8*)(bg + 32 * i); fu[i] = *(const bf16x8*)(bu + 32 * i); }
#pragma unroll
            for (int i = 0; i < 8; ++i) { ag = __builtin_amdgcn_mfma_f32_16x16x32_bf16(fa[i], fg[i], ag, 0, 0, 0); au = __builtin_amdgcn_mfma_f32_16x16x32_bf16(fa[i], fu[i], au, 0, 0, 0); }
        }
        red[wid * 64 + lane] = ag; red[512 + wid * 64 + lane] = au;
        LDS_WAIT(); __syncthreads();
        if (wid == 0) {
            f32x4 sg = red[lane], su = red[512 + lane];
#pragma unroll
            for (int w = 1; w < 8; ++w) { sg += red[w * 64 + lane]; su += red[512 + w * 64 + lane]; }
#pragma unroll
            for (int r = 0; r < 4; ++r) { const float sc = __builtin_amdgcn_rsqf(rs[MROW0 + kq * 4 + r] * (1.f / DM) + EPS); const float g = sg[r] * sc; su[r] *= sc; P[(size_t)(MROW0 + kq * 4 + r) * PW + c0 + l15] = (bf16_t)f2bf(g * __builtin_amdgcn_rcpf(1.f + __builtin_amdgcn_exp2f(-g * LOG2E)) * su[r]); }
        }
        __syncthreads();
    }
}

#define XB_TMO      128
#define XB_XCNT(j)  (256  + 64 * (j))
#define XB_XSUB(j)  (1280 + 64 * (j))
#define XB_XGEN(j)  (2304 + 64 * (j))
#define XB_TOP      3328
#define XB_TOPGEN   3392
#define XCD_BAR_WORDS 3456
#define XB_SPIN_CAP (1u << 18)
__device__ __forceinline__ unsigned xb_ld(unsigned* p)              { return __hip_atomic_load(p, __ATOMIC_RELAXED, __HIP_MEMORY_SCOPE_AGENT); }
__device__ __forceinline__ unsigned xb_add(unsigned* p, unsigned v) { return __hip_atomic_fetch_add(p, v, __ATOMIC_RELAXED, __HIP_MEMORY_SCOPE_AGENT); }
__device__ __forceinline__ unsigned xb_xcc_id() { return (unsigned)__builtin_amdgcn_s_getreg((3 << 11) | 20) & 0xFu; }
#define XB_SPIN(cond, bar) do { unsigned _sp = 0; while (cond) { __builtin_amdgcn_s_sleep(1); \
    if ((++_sp & 255u) == 0u) { if (xb_ld(&(bar)[XB_TMO])) break; if (_sp > XB_SPIN_CAP) { atomicAdd(&(bar)[XB_TMO], 1u); break; } } } } while (0)
struct XcdBarrier { unsigned* bar; unsigned x; volatile LAS unsigned* st; };
__device__ __forceinline__ XcdBarrier xcd_barrier_post(unsigned* bar, volatile LAS unsigned* st) {
    XcdBarrier b; b.bar = bar; b.x = xb_xcc_id(); b.st = st;
    if (threadIdx.x == 0) (void)xb_add(&bar[XB_XCNT(b.x)], 1u);
    return b;
}
__device__ __forceinline__ void xcd_barrier_complete(unsigned* bar, unsigned x, unsigned& nloc, unsigned& nx) {
    const unsigned G = gridDim.x * gridDim.y * gridDim.z;
    unsigned sum, cnt, mine, sp = 0u;
    for (;;) {
        sum = 0u; cnt = 0u; mine = 0u;
#pragma unroll
        for (unsigned j = 0; j < 16; ++j) { const unsigned c = xb_ld(&bar[XB_XCNT(j)]); sum += c; cnt += (c > 0u) ? 1u : 0u; mine = (j == x) ? c : mine; }
        if (sum == G) break;
        __builtin_amdgcn_s_sleep(1);
        if ((++sp & 255u) == 0u) { if (xb_ld(&bar[XB_TMO])) break; if (sp > XB_SPIN_CAP) { atomicAdd(&bar[XB_TMO], 1u); break; } }
    }
    nloc = mine > 0u ? mine : 1u; nx = cnt > 0u ? cnt : 1u;
}
__device__ __forceinline__ void xcd_barrier(const XcdBarrier& b) {
    asm volatile("s_waitcnt vmcnt(0)" ::: "memory");
    __syncthreads();
    if (threadIdx.x == 0) {
        unsigned* bar = b.bar;
        __builtin_amdgcn_s_waitcnt(0);
        unsigned nloc = b.st[0], nx = b.st[1];
        if (nloc == 0u) { xcd_barrier_complete(bar, b.x, nloc, nx); b.st[0] = nloc; b.st[1] = nx; }
        const unsigned old = xb_add(&bar[XB_XSUB(b.x)], 1u);
        const unsigned gen = old / nloc;
        if (old + 1u == (gen + 1u) * nloc) {
            __builtin_amdgcn_fence(__ATOMIC_RELEASE, "agent");
            asm volatile("s_waitcnt vmcnt(0)" ::: "memory");
            const unsigned og = xb_add(&bar[XB_TOP], 1u);
            const unsigned tg = og / nx;
            if (og + 1u == (tg + 1u) * nx) xb_add(&bar[XB_TOPGEN], 1u);
            else XB_SPIN(xb_ld(&bar[XB_TOPGEN]) == tg, bar);
            __builtin_amdgcn_fence(__ATOMIC_ACQUIRE, "agent");
            xb_add(&bar[XB_XGEN(b.x)], 1u);
            asm volatile("s_waitcnt vmcnt(0)" ::: "memory");
        } else {
            XB_SPIN(xb_ld(&bar[XB_XGEN(b.x)]) == gen, bar);
            __builtin_amdgcn_fence(__ATOMIC_ACQUIRE, "agent");
            asm volatile("s_waitcnt vmcnt(0)" ::: "memory");
        }
    }
    __syncthreads();
}

constexpr int NWAVES = 8;
constexpr int RING_BYTES = 131072, LDS_BYTES = 147456, LDSCTL_OFF = LDS_BYTES - 512;
struct Args {
    const float* in[19]; float* out; unsigned char* ws; int ph_lo, ph_hi;
};
struct Ctx {
    LAS unsigned char* lds; int tid, lane, wave, gw, ngw, G, bid;
};

template <int MAP> __device__ __forceinline__ int wmap(int n, float& sc) {
    sc = 1.f;
    if (MAP == 0) return n;
    if (MAP == 1) {
        if (n < 1088) return n;
        if (n < 3136) { const int m = n - 1088, d = m & 127; return 1280 + (m - d) + (d < 64 ? 2 * d : 2 * (d - 64) + 1); }
        if (n < 4160) return 1280 + (n - 1088);
        if (n < 5184) { const int m = n - 4160, d = m & 63; return 4352 + (m - d) + (d < 32 ? 2 * d : 2 * (d - 32) + 1); }
        if (n < 5248) { const int d = n - 5184; return 1088 + (d < 32 ? 2 * d : 2 * (d - 32) + 1); }
        if (n < 5264) { sc = 0.03125f; return 1152 + (n - 5248); }
        if (n < 7312) { const int m = n - 5264, d = m & 127; return 5376 + (m - d) + (d < 64 ? 2 * d : 2 * (d - 64) + 1); }
        if (n < 8336) return 5376 + (n - 5264);
        return 8448 + (n - 8336);
    }
    if (n < DFF) return (n >> 7) * 256 + (n & 127);
    const int m = n - DFF; return (m >> 7) * 256 + 128 + (m & 127);
}
template <int MAP> __device__ __forceinline__ void conv_item(const float* W, int K, int N, bf16_t* WT, const float* gain, LAS float* scr, int item, int lane) {
    const int nblk = (N + 31) / 32, kb = item / nblk, nb = item - kb * nblk, k0 = 64 * kb, n0 = 32 * nb;
    const int nn = n0 + (lane & 31);
    float wv[32];
#pragma unroll
    for (int i = 0; i < 32; ++i) { const int kk = 2 * i + (lane >> 5); wv[i] = (nn < N) ? W[(size_t)(k0 + kk) * N + nn] : 0.f; }
#pragma unroll
    for (int i = 0; i < 32; ++i) { const int kk = 2 * i + (lane >> 5); float v = wv[i]; if (gain) v *= gain[k0 + kk]; scr[kk * 33 + (lane & 31)] = v; }
    LDS_WAIT(); asm volatile("" ::: "memory");
    const int c = lane & 7;
#pragma unroll
    for (int j = 0; j < 4; ++j) { const int n = (lane >> 3) + 8 * j; const int ns = n0 + n;
        if (ns < N) { float sc; const int dst = wmap<MAP>(ns, sc); const LAS float* s = scr + (8 * c) * 33 + n;
            u32x4 o; o.x = pk2(s[0 * 33] * sc, s[1 * 33] * sc); o.y = pk2(s[2 * 33] * sc, s[3 * 33] * sc); o.z = pk2(s[4 * 33] * sc, s[5 * 33] * sc); o.w = pk2(s[6 * 33] * sc, s[7 * 33] * sc);
            *(u32x4*)(WT + (size_t)dst * K + k0 + 8 * c) = o; } }
    LDS_WAIT(); asm volatile("" ::: "memory");
}
template <int MAP> __device__ __forceinline__ void conv_matrix(const Ctx& F, const float* W, int K, int N, bf16_t* WT, const float* gain) {
    LAS float* scr = (LAS float*)(F.lds + F.wave * 16384);
    const int nit = (K / 64) * ((N + 31) / 32);
    for (int it = F.gw; it < nit; it += F.ngw) conv_item<MAP>(W, K, N, WT, gain, scr, it, F.lane);
}

__device__ __forceinline__ void norm_row(const float* hrow, bf16_t* orow, float* rs_row, int lane) {
    f32x4 v[8]; float s = 0.f;
#pragma unroll
    for (int j = 0; j < 8; ++j) { v[j] = *((const f32x4*)hrow + lane + 64 * j); s += (v[j].x * v[j].x + v[j].y * v[j].y) + (v[j].z * v[j].z + v[j].w * v[j].w); }
    s = wave_sum(s);
    if (lane == 0) *rs_row = s;
#pragma unroll
    for (int j = 0; j < 8; ++j) { u32x2 o; o.x = cvt_pk_bf16(v[j].x, v[j].y); o.y = cvt_pk_bf16(v[j].z, v[j].w); *((u32x2*)orow + lane + 64 * j) = o; }
}

__device__ __forceinline__ void post1a_row(const bf16_t* P, int r, float* rstdq, float* rstdkv, int lane) {
    const bf16_t* p = P + (size_t)r * PW;
    const u32x4 a = *((const u32x4*)(p + C_CQ) + lane), b = *((const u32x4*)(p + C_CKV) + lane);
    float sa = 0.f, sb = 0.f;
#pragma unroll
    for (int e = 0; e < 4; ++e) { const float x0 = __uint_as_float(a[e] << 16), x1 = __uint_as_float(a[e] & 0xffff0000u); sa += x0 * x0 + x1 * x1;
        const float y0 = __uint_as_float(b[e] << 16), y1 = __uint_as_float(b[e] & 0xffff0000u); sb += y0 * y0 + y1 * y1; }
    sa = wave_sum(sa); sb = wave_sum(sb);
    if (lane == 0) { rstdq[r] = 1.0f / sqrtf(sa * (1.f / 512.f) + EPS); rstdkv[r] = 1.0f / sqrtf(sb * (1.f / 512.f) + EPS); }
    { unsigned* ikp = (unsigned*)(P + (size_t)r * PW + C_IK) + (lane & 31); const unsigned w = *ikp; const float x1 = __uint_as_float(w << 16), x2 = __uint_as_float(w & 0xffff0000u);
      float cs, sn; rope_cs(row_pos(r), lane & 31, 2.f / 64.f, cs, sn);
      if (lane < 32) *ikp = cvt_pk_bf16(x1 * cs - x2 * sn, x2 * cs + x1 * sn); }
}
__device__ __forceinline__ void meta_post_row(bf16_t* P, int r, const float* gperm, int lane) {
    bf16_t* p = P + (size_t)r * PW; const int pos = row_pos(r);
    float c128, s128, c64, s64; rope_cs(pos, lane, 2.f / 128.f, c128, s128); rope_cs(pos, lane & 31, 2.f / 64.f, c64, s64);
#pragma unroll 1
    for (int t = 0; t < 4; ++t) {
        const int cb = t == 0 ? C_DQ : (t == 1 ? C_DK : (t == 2 ? C_FQ : C_FK)); const float sc = (t == 0 || t == 2) ? C2_128 : 1.f;
        const float ga = gperm[t * 128 + 2 * lane], gb = gperm[t * 128 + 2 * lane + 1];
#pragma unroll 1
        for (int h = 0; h < 8; ++h) { unsigned* xp = (unsigned*)(p + cb + h * 128) + lane; const unsigned w = *xp; float x1 = __uint_as_float(w << 16), x2 = __uint_as_float(w & 0xffff0000u);
            const float rn = __builtin_amdgcn_rsqf(wave_sum(x1 * x1 + x2 * x2) * (1.f / 128.f) + EPS); x1 *= rn * ga; x2 *= rn * gb;
            *xp = cvt_pk_bf16((x1 * c128 - x2 * s128) * sc, (x2 * c128 + x1 * s128) * sc); }
    }
#pragma unroll 1
    for (int hh = 0; hh < 8; ++hh) { unsigned* xp = (unsigned*)(p + C_IQ + hh * 128) + lane; const unsigned w = *xp; const float x1 = __uint_as_float(w << 16), x2 = __uint_as_float(w & 0xffff0000u);
        *xp = cvt_pk_bf16(x1 * c64 - x2 * s64, x2 * c64 + x1 * s64); }
}
__device__ __forceinline__ void unpack8(const u32x4& w, float (&x)[8]) {
#pragma unroll
    for (int e = 0; e < 4; ++e) { x[2 * e] = __uint_as_float(w[e] << 16); x[2 * e + 1] = __uint_as_float(w[e] & 0xffff0000u); }
}
__device__ __forceinline__ u32x4 pack8(const float (&x)[8]) { u32x4 w; w.x = cvt_pk_bf16(x[0], x[1]); w.y = cvt_pk_bf16(x[2], x[3]); w.z = cvt_pk_bf16(x[4], x[5]); w.w = cvt_pk_bf16(x[6], x[7]); return w; }
__device__ __forceinline__ u32x4 shfl_xor4(const u32x4& w, int m) { u32x4 r; r.x = __shfl_xor(w.x, m); r.y = __shfl_xor(w.y, m); r.z = __shfl_xor(w.z, m); r.w = __shfl_xor(w.w, m); return r; }
__device__ __forceinline__ void post2_row(bf16_t* P, int r, const float* rstdq, const float* rstdkv, const float* qkg  , LAS float* rnl, int lane) {
    bf16_t* p = P + (size_t)r * PW;
    const float sq = rstdq[r], skv = rstdkv[r];
    const int pos = row_pos(r), hw = lane >> 5, l5 = lane & 31;
    float c64[8], s64[8];
#pragma unroll
    for (int j = 0; j < 8; ++j) rope_cs(pos, 8 * (lane & 3) + j, 2.f / 64.f, c64[j], s64[j]);
    float kp[8]; { const u32x4 w = *(const u32x4*)(p + C_KPE + (lane & 7) * 8); unpack8(w, kp); }
    float kpe_ss = 0.f;
#pragma unroll
    for (int j = 0; j < 8; ++j) kpe_ss += kp[j] * kp[j];
    kpe_ss += __shfl_xor(kpe_ss, 1); kpe_ss += __shfl_xor(kpe_ss, 2); kpe_ss += __shfl_xor(kpe_ss, 4);
    u32x4 rq[4], rkv[4];
#pragma unroll
    for (int it = 0; it < 4; ++it) { const int h = 2 * it + hw; rq[it] = *(const u32x4*)(p + C_QRAW + h * 192 + (l5 < 24 ? l5 : 0) * 8); rkv[it] = *(const u32x4*)(p + C_KVRAW + h * 256 + l5 * 8); }
#pragma unroll
    for (int it = 0; it < 4; ++it) {
        const int h = 2 * it + hw; const bool act = l5 < 24;
        u32x4* ptr = (u32x4*)(p + C_QRAW + h * 192 + (act ? l5 : 0) * 8);
        float x[8]; unpack8(rq[it], x);
        float ss = 0.f;
#pragma unroll
        for (int j = 0; j < 8; ++j) { x[j] *= sq; ss += x[j] * x[j]; }
        if (!act) ss = 0.f;
#pragma unroll
        for (int o = 1; o < 32; o <<= 1) ss += __shfl_xor(ss, o);
        const float rn = 1.0f / sqrtf(ss * (1.f / 192.f) + EPS);
        const int gi = (act ? l5 : 0) * 8;
        const f32x4 g0 = *(const f32x4*)(qkg + gi), g1 = *(const f32x4*)(qkg + gi + 4);
#pragma unroll
        for (int j = 0; j < 4; ++j) { x[j] *= rn * g0[j]; x[4 + j] *= rn * g1[j]; }
        float o[8];
#pragma unroll
        for (int j = 0; j < 8; ++j) { const float pr = __shfl_xor(x[j], 4); const float rot = (l5 & 4) ? (x[j] * c64[j] + pr * s64[j]) : (x[j] * c64[j] - pr * s64[j]); o[j] = (l5 >= 16 ? rot : x[j]) * C2_192; }
        if (act) *ptr = pack8(o);
    }
#pragma unroll
    for (int it = 0; it < 4; ++it) {
        const int h = 2 * it + hw; const bool isk = l5 < 16;
        u32x4* ptr = (u32x4*)(p + C_KVRAW + h * 256 + l5 * 8);
        float x[8]; unpack8(rkv[it], x);
        float ss = 0.f;
#pragma unroll
        for (int j = 0; j < 8; ++j) { x[j] *= skv; ss += x[j] * x[j]; }
        if (!isk) ss = 0.f;
#pragma unroll
        for (int o = 1; o < 32; o <<= 1) ss += __shfl_xor(ss, o);
        const float rn = 1.0f / sqrtf((ss + kpe_ss) * (1.f / 192.f) + EPS);
        if (l5 == 0) rnl[h] = rn;
        const int gi = 192 + (isk ? l5 : 0) * 8;
        const f32x4 g0 = *(const f32x4*)(qkg + gi), g1 = *(const f32x4*)(qkg + gi + 4);
        float o[8];
#pragma unroll
        for (int j = 0; j < 4; ++j) { o[j] = isk ? x[j] * rn * g0[j] : x[j]; o[4 + j] = isk ? x[4 + j] * rn * g1[j] : x[4 + j]; }
        *ptr = pack8(o);
    }
    LDS_WAIT(); asm volatile("" ::: "memory");
    { const int hd = lane >> 3, c = lane & 7; const float rn = rnl[hd];
      const f32x4 g0 = *(const f32x4*)(qkg + 192 + 128 + c * 8), g1 = *(const f32x4*)(qkg + 192 + 128 + c * 8 + 4);
      float x[8], o[8];
#pragma unroll
      for (int j = 0; j < 4; ++j) { x[j] = kp[j] * rn * g0[j]; x[4 + j] = kp[4 + j] * rn * g1[j]; }
#pragma unroll
      for (int j = 0; j < 8; ++j) { const float pr = __shfl_xor(x[j], 4); o[j] = (c & 4) ? (x[j] * c64[j] + pr * s64[j]) : (x[j] * c64[j] - pr * s64[j]); }
      *(u32x4*)(p + C_KPEH + hd * 64 + c * 8) = pack8(o); }
    LDS_WAIT(); asm volatile("" ::: "memory");
}
__device__ __forceinline__ void post3_row(bf16_t* P, int r, const float* subg, float lam, float omli, int lane) {
    bf16_t* p = P + (size_t)r * PW;
    const int hw = lane >> 5, l5 = lane & 31;
    u32x4 rr[4];
#pragma unroll
    for (int h = 0; h < 4; ++h) rr[h] = *(const u32x4*)(p + (hw ? C_IQ : C_FQ) + h * 256 + l5 * 8);
#pragma unroll
    for (int h = 0; h < 4; ++h) {
        const u32x4 raw = rr[h];
        const u32x4 praw = shfl_xor4(raw, 16);
        float a[8], b[8]; unpack8(raw, a); unpack8(praw, b);
        float d[8], ss = 0.f;
#pragma unroll
        for (int j = 0; j < 8; ++j) { d[j] = a[j] - lam * b[j]; ss += d[j] * d[j]; }
        if (l5 >= 16) ss = 0.f;
#pragma unroll
        for (int o = 1; o < 64; o <<= 1) ss += __shfl_xor(ss, o);
        const float rn = omli / sqrtf(ss * (1.f / 256.f) + EPS);
        const int dim = hw * 128 + (l5 & 15) * 8;
        const f32x4 g0 = *(const f32x4*)(subg + dim), g1 = *(const f32x4*)(subg + dim + 4);
        float o[8];
#pragma unroll
        for (int j = 0; j < 4; ++j) { o[j] = d[j] * rn * g0[j]; o[4 + j] = d[4 + j] * rn * g1[j]; }
        if (l5 < 16) *(u32x4*)(p + C_OC + h * 256 + dim) = pack8(o);
    }
}

__device__ __forceinline__ void index_unit(const bf16_t* P, int unit, unsigned* bm, LAS unsigned char* lds) {
    typedef float f32x16 __attribute__((ext_vector_type(16)));
    int tid = threadIdx.x; asm volatile("" : "+v"(tid));
    const int wid = __builtin_amdgcn_readfirstlane(tid >> 6), lane = tid & 63, j = lane & 31, hi = lane >> 5;
    const int tb = 255 - (unit >> 4), b = unit & 15, t0 = tb * 8, tokbase = MBLK + b * SEQ;
    const int wmax = (64 + t0 + 7) >> 5;
    LAS unsigned* keys = (LAS unsigned*)lds;
    LAS float* iwl = (LAS float*)(lds + 8 * 2112 * 4);
    if (t0 + 7 + 17 > 256) {
        if (tid < 128) iwl[tid] = bf2f(P[(size_t)(tokbase + t0 + (tid >> 4)) * PW + C_IW + (tid & 15)]);
        LAS unsigned char* al = lds + 8 * 2112 * 4 + 512;
        { const int id0 = tid * 2;
#pragma unroll
          for (int e = 0; e < 2; ++e) { const int id = id0 + e, rw = id >> 3, c = id & 7;
              *(LAS bf16x8*)(al + rw * 144 + c * 16) = *(const bf16x8*)(P + (size_t)(tokbase + t0 + (rw >> 4)) * PW + C_IQ + (rw & 15) * 64 + c * 8); } }
        LDS_WAIT(); __syncthreads();
        bf16x8 af[4][4];
        { const int qa = (j >> 2) & 1, ha = (j & 3) + 4 * (j >> 3);
#pragma unroll
          for (int blk = 0; blk < 4; ++blk)
#pragma unroll
              for (int s = 0; s < 4; ++s) af[blk][s] = *(const LAS bf16x8*)(al + ((2 * blk + qa) * 16 + ha) * 144 + s * 32 + hi * 16); }
        const unsigned boff = (unsigned)(j * PW + C_IK + hi * 8) * 2u;
        for (int w = wid; w <= wmax; w += 8) {
            const int kr_ = w < 2 ? (MBLK - 64) + 32 * w : tokbase + 32 * (w - 2); const char* bp_ = (const char*)(P + (size_t)kr_ * PW) + boff;
            bf16x8 bf[4];
#pragma unroll
            for (int s = 0; s < 4; ++s) bf[s] = *(const bf16x8*)(bp_ + s * 32);
            const int kidx = 32 * w + j;
#pragma unroll
            for (int blk = 0; blk < 4; ++blk) {
                f32x16 acc = (f32x16){0.f,0.f,0.f,0.f,0.f,0.f,0.f,0.f,0.f,0.f,0.f,0.f,0.f,0.f,0.f,0.f};
#pragma unroll
                for (int s = 0; s < 4; ++s) acc = __builtin_amdgcn_mfma_f32_32x32x16_bf16(af[blk][s], bf[s], acc, 0, 0, 0);
                const int q = 2 * blk + hi;
                const LAS f32x4* iwq = (const LAS f32x4*)(iwl + q * 16);
                float score = 0.f;
#pragma unroll
                for (int g = 0; g < 4; ++g) { const f32x4 wv = iwq[g]; score += fmaxf(acc[4 * g], 0.f) * wv.x + fmaxf(acc[4 * g + 1], 0.f) * wv.y + fmaxf(acc[4 * g + 2], 0.f) * wv.z + fmaxf(acc[4 * g + 3], 0.f) * wv.w; }
                const bool valid = kidx >= 48 && kidx <= 64 + t0 + q; const unsigned u_ = __float_as_uint(score);
                keys[q * 2112 + kidx] = valid ? ((u_ & 0x80000000u) ? ~u_ : (u_ | 0x80000000u)) : 0u;
            }
        }
        LDS_WAIT(); __syncthreads();
    }
    const int tq = t0 + wid, qk = 64 + tq, nch = qk / 64 + 1;
    unsigned* out = bm + (size_t)(b * SEQ + tq) * BMW;
    if (tq + 17 <= 256) {
        for (int c = 0; c < 33; ++c) { const int kidx = 64 * c + lane; const unsigned long long m = __ballot(kidx >= 48 && kidx <= qk);
            if (lane == 0) { out[2 * c] = (unsigned)m; out[2 * c + 1] = (unsigned)(m >> 32); } }
    } else {
        unsigned kreg[33];
#pragma unroll
        for (int c = 0; c < 33; ++c) kreg[c] = (c < nch && 64 * c + lane <= qk) ? keys[wid * 2112 + 64 * c + lane] : 0u;
        unsigned T = 0u;
        for (int bit = 31; bit >= 0; --bit) {
            const unsigned cand = T | (1u << bit); int cnt = 0;
#pragma unroll
            for (int c = 0; c < 33; ++c) cnt += __popcll(__ballot(kreg[c] >= cand));
            if (cnt >= 256) T = cand;
            if (cnt == 256) break;
        }
#pragma unroll
        for (int c = 0; c < 33; ++c) { const unsigned long long m = __ballot(kreg[c] >= T && kreg[c] != 0u);
            if (lane == 0) { out[2 * c] = (unsigned)m; out[2 * c + 1] = (unsigned)(m >> 32); } }
    }
    LDS_WAIT();
}

namespace fa {
typedef float f32x16 __attribute__((ext_vector_type(16)));
typedef short s16x4 __attribute__((ext_vector_type(4)));
__device__ __forceinline__ int crow(int r, int hi) { return (r & 3) + 8 * (r >> 2) + 4 * hi; }
__device__ __forceinline__ int v_st(int k, int c) { const int kk = (k & ~0xC) | ((k & 4) << 1) | ((k & 8) >> 1); return ((kk >> 3) * 4 + (c >> 5)) * 512 + ((kk & 7) * 32 + (c & 31)) * 2; }
__device__ __forceinline__ int v_rd_base(int lane) { return ((lane & 3) << 3) | (((lane >> 2) & 3) << 6) | (((lane >> 4) & 1) << 5) | (((lane >> 5) & 1) << 8); }
constexpr int v_rd_off(int d0, int ks, int half) { return d0 * 512 + ks * 4096 + half * 2048; }
constexpr int SHM_V = 16384;
template <int DQK> struct Geo { static constexpr int KP = DQK * 2, SHM_K = 64 * DQK * 2, LDS_K0 = 2 * SHM_V, LDS_WS = LDS_K0 + 2 * SHM_K, BYTES = LDS_WS + 8 * 256; };
#define FA_KSWZ(row, colB, pitch) ((row) * (pitch) + ((colB) ^ (((row) & 7) << 4)))
#define FA_SBAR() __builtin_amdgcn_sched_barrier(0)

struct Item { int qrow0, qk0, nt, tokbase; };

template <int DQK>
__device__ __forceinline__ void load_q(const bf16_t* P, const Item& it, int qcol, bf16x8 (&qr)[DQK / 16]) {
    int tid = threadIdx.x; asm volatile("" : "+v"(tid));
    const int wid = tid >> 6, lane = tid & 63, r32 = lane & 31, hi = lane >> 5;
    const bf16_t* qp = P + (size_t)(it.qrow0 + wid * 32 + r32) * PW + qcol + hi * 8;
#pragma unroll
    for (int d0 = 0; d0 < DQK / 16; ++d0) qr[d0] = *(const bf16x8*)(qp + d0 * 16);
}

template <int DQK, bool MASKED>
__device__ __forceinline__ void attn_core(bf16_t* P, const Item& it, const bf16x8 (&qr)[DQK / 16], int k1col, int k2col, int vcol, int ocol, const unsigned* bmq, LAS unsigned char* lds) {
    typedef Geo<DQK> G;
    int tid = threadIdx.x; asm volatile("" : "+v"(tid));
    const int wid = __builtin_amdgcn_readfirstlane(tid >> 6), lane = tid & 63, r32 = lane & 31, hi = lane >> 5;
    LAS unsigned char* V_lds = lds; LAS unsigned char* K_lds = lds + G::LDS_K0; LAS float* wsf = (LAS float*)(lds + G::LDS_WS) + wid * 64;
    const int sr = tid >> 4, sc = (tid & 15) * 8;
    const int vst0 = v_st(sr, sc), vst1 = v_st(32 + sr, sc), kws0 = FA_KSWZ(sr, sc * 2, G::KP), kws1 = FA_KSWZ(sr + 32, sc * 2, G::KP);
    const int xr = tid >> 3, xc = (tid & 7) * 8, kws2 = FA_KSWZ(xr, (128 + xc) * 2, G::KP);
    const unsigned loff0 = (unsigned)(sr * PW + sc) * 2u, loffx = (unsigned)(xr * PW + xc) * 2u;
    const int vb0 = (int)(unsigned)(size_t)V_lds + v_rd_base(lane);
    const int NT = it.nt;
    const int qk = it.qk0 + wid * 32 + r32;
    const bool use_bm = MASKED && (bmq != nullptr);
    const unsigned bmoff = (unsigned)((wid * 32 + r32) * BMW) * 4u;
    float l_reg = 0.f; f32x16 o[4];
#pragma unroll
    for (int d = 0; d < 4; ++d) o[d] = (f32x16){0.f,0.f,0.f,0.f,0.f,0.f,0.f,0.f,0.f,0.f,0.f,0.f,0.f,0.f,0.f,0.f};
    bf16x8 sk0, sk1, sk2, sv0, sv1;
#define FA_KROW0(t) ((t) == 0 ? (MBLK - 64) : it.tokbase + 64 * ((t) - 1))
#define FA_LOAD(t) do { const int kr_ = FA_KROW0(t); const char* rb_ = (const char*)(P + (size_t)kr_ * PW); const char* rk_ = rb_ + (size_t)k1col * 2; const char* rv_ = rb_ + (size_t)vcol * 2; \
        sk0 = *(const bf16x8*)(rk_ + loff0); sk1 = *(const bf16x8*)(rk_ + (size_t)32 * PW * 2 + loff0); sv0 = *(const bf16x8*)(rv_ + loff0); sv1 = *(const bf16x8*)(rv_ + (size_t)32 * PW * 2 + loff0); \
        if (DQK == 192) sk2 = *(const bf16x8*)(rb_ + (size_t)k2col * 2 + loffx); } while (0)
#define FA_WRITE(bf) do { *(LAS bf16x8*)(K_lds + (bf) * G::SHM_K + kws0) = sk0; *(LAS bf16x8*)(K_lds + (bf) * G::SHM_K + kws1) = sk1; \
        *(LAS bf16x8*)(V_lds + (bf) * SHM_V + vst0) = sv0; *(LAS bf16x8*)(V_lds + (bf) * SHM_V + vst1) = sv1; \
        if (DQK == 192) *(LAS bf16x8*)(K_lds + (bf) * G::SHM_K + kws2) = sk2; } while (0)
    constexpr int QREG = (DQK == 192) ? 8 : DQK / 16;
    LAS unsigned char* qx = lds + G::BYTES + (wid * 384 + lane) * 16;
    if (DQK == 192) {
#pragma unroll
        for (int d0 = QREG; d0 < DQK / 16; ++d0) *(LAS bf16x8*)(qx + (d0 - QREG) * 1024) = qr[d0];
    }
    FA_LOAD(0); FA_WRITE(0);
    __syncthreads();
    for (int t = 0; t < NT; ++t) {
        const int cur = t & 1;
        unsigned zb = 0u; asm volatile("" : "+v"(zb)); u32x2 bw = (u32x2){zb, zb};
        if (use_bm) bw = *(const u32x2*)((const char*)(bmq + 2 * t) + bmoff);
        f32x16 p0 = (f32x16){0.f,0.f,0.f,0.f,0.f,0.f,0.f,0.f,0.f,0.f,0.f,0.f,0.f,0.f,0.f,0.f}, p1 = p0;
        { LAS unsigned char* kbase = K_lds + cur * G::SHM_K;
          LAS unsigned char* kb[4];
#pragma unroll
          for (int dd = 0; dd < 4; ++dd) kb[dd] = kbase + FA_KSWZ(r32, (dd * 16 + hi * 8) * 2, G::KP);
          constexpr int GS = (DQK == 192) ? 2 : 4;
#pragma unroll
          for (int g = 0; g < DQK / (16 * GS); ++g) {
              bf16x8 fb0[GS], fb1[GS];
#pragma unroll
              for (int dd = 0; dd < GS; ++dd) { const int d0 = g * GS + dd; LAS unsigned char* a = kb[d0 & 3] + (d0 >> 2) * 128; fb0[dd] = *(const LAS bf16x8*)a; fb1[dd] = *(const LAS bf16x8*)(a + 32 * G::KP); }
              FA_SBAR();
#pragma unroll
              for (int dd = 0; dd < GS; ++dd) { const int d0 = g * GS + dd; bf16x8 qf; if (d0 < QREG) qf = qr[d0 < QREG ? d0 : 0]; else qf = *(const LAS bf16x8*)(qx + (d0 - QREG) * 1024);
                  p0 = __builtin_amdgcn_mfma_f32_32x32x16_bf16(fb0[dd], qf, p0, 0, 0, 0); p1 = __builtin_amdgcn_mfma_f32_32x32x16_bf16(fb1[dd], qf, p1, 0, 0, 0); }
              FA_SBAR(); } }
        if (t + 1 < NT) FA_LOAD(t + 1);
        FA_SBAR();
        const float NEG = -__builtin_inff();
        if (use_bm) {
        } else if (t == 0 || 64 * t + 63 > it.qk0 + wid * 32) {
            const int kb_ = 64 * t + 4 * hi;
#pragma unroll
            for (int r = 0; r < 16; ++r) { const int k0 = kb_ + (r & 3) + 8 * (r >> 2), k1 = k0 + 32;
                if (k0 < 48 || k0 > qk) p0[r] = NEG; if (k1 < 48 || k1 > qk) p1[r] = NEG; }
        }
        float ps = 0.f;
#pragma unroll
        for (int r = 0; r < 16; ++r) { p0[r] = __builtin_amdgcn_exp2f(p0[r]); p1[r] = __builtin_amdgcn_exp2f(p1[r]); }
        if (use_bm) {
            const int wx = (int)(bw.x >> (4 * hi)), wy = (int)(bw.y >> (4 * hi));
#pragma unroll
            for (int r = 0; r < 16; ++r) { const int c = (r & 3) + 8 * (r >> 2);
                p0[r] = __uint_as_float(__float_as_uint(p0[r]) & (unsigned)__builtin_amdgcn_sbfe(wx, c, 1)); p1[r] = __uint_as_float(__float_as_uint(p1[r]) & (unsigned)__builtin_amdgcn_sbfe(wy, c, 1)); }
        }
        { f32x2 s2 = (f32x2){p0[0], p0[1]} + (f32x2){p1[0], p1[1]};
#pragma unroll
          for (int r = 2; r < 16; r += 2) s2 += (f32x2){p0[r], p0[r + 1]} + (f32x2){p1[r], p1[r + 1]};
          ps = s2.x + s2.y; }
        { auto rr = __builtin_amdgcn_permlane32_swap(__float_as_uint(ps), __float_as_uint(ps), false, false); ps = __uint_as_float(rr[0]) + __uint_as_float(rr[1]); }
        l_reg += ps;
        bf16x8 pa0, pa1, pa2, pa3;
#define FA_PK4(Pv, B_, OUT) do { const unsigned a0 = cvt_pk_bf16(Pv[B_ + 0], Pv[B_ + 1]), a1 = cvt_pk_bf16(Pv[B_ + 2], Pv[B_ + 3]), b0 = cvt_pk_bf16(Pv[B_ + 4], Pv[B_ + 5]), b1 = cvt_pk_bf16(Pv[B_ + 6], Pv[B_ + 7]); \
        auto r0 = __builtin_amdgcn_permlane32_swap(a0, b0, false, false); auto r1 = __builtin_amdgcn_permlane32_swap(a1, b1, false, false); \
        u32x4 w_ = {r0[0], r1[0], r0[1], r1[1]}; OUT = __builtin_bit_cast(bf16x8, w_); } while (0)
        FA_PK4(p0, 0, pa0); FA_PK4(p0, 8, pa1); FA_PK4(p1, 0, pa2); FA_PK4(p1, 8, pa3);
#define FA_TRRD(dst, off) asm volatile("ds_read_b64_tr_b16 %0, %1 offset:%2" : "=&v"(dst) : "v"(vb0), "i"(off) : "memory")
#define FA_PV(VB, d0) do { s16x4 l0, l1, l2, l3, h0, h1, h2, h3; constexpr int b_ = (VB) * SHM_V + v_rd_off(d0, 0, 0); \
        FA_TRRD(l0, b_); FA_TRRD(h0, b_ + 2048); FA_TRRD(l1, b_ + 4096); FA_TRRD(h1, b_ + 6144); FA_TRRD(l2, b_ + 8192); FA_TRRD(h2, b_ + 10240); FA_TRRD(l3, b_ + 12288); FA_TRRD(h3, b_ + 14336); \
        asm volatile("s_waitcnt lgkmcnt(0)" ::: "memory"); FA_SBAR(); \
        o[d0] = __builtin_amdgcn_mfma_f32_32x32x16_bf16(pa0, (bf16x8){l0[0], l0[1], l0[2], l0[3], h0[0], h0[1], h0[2], h0[3]}, o[d0], 0, 0, 0); \
        o[d0] = __builtin_amdgcn_mfma_f32_32x32x16_bf16(pa1, (bf16x8){l1[0], l1[1], l1[2], l1[3], h1[0], h1[1], h1[2], h1[3]}, o[d0], 0, 0, 0); \
        o[d0] = __builtin_amdgcn_mfma_f32_32x32x16_bf16(pa2, (bf16x8){l2[0], l2[1], l2[2], l2[3], h2[0], h2[1], h2[2], h2[3]}, o[d0], 0, 0, 0); \
        o[d0] = __builtin_amdgcn_mfma_f32_32x32x16_bf16(pa3, (bf16x8){l3[0], l3[1], l3[2], l3[3], h3[0], h3[1], h3[2], h3[3]}, o[d0], 0, 0, 0); } while (0)
        FA_SBAR();
        if (cur == 0) { FA_PV(0, 0); FA_PV(0, 1); FA_PV(0, 2); FA_PV(0, 3); } else { FA_PV(1, 0); FA_PV(1, 1); FA_PV(1, 2); FA_PV(1, 3); }
        FA_SBAR();
        if (t + 1 < NT) { if (cur == 0) FA_WRITE(1); else FA_WRITE(0); }
        __syncthreads();
    }
    if (hi == 0) wsf[r32] = l_reg; LDS_WAIT();
    float rli[16];
#pragma unroll
    for (int r = 0; r < 16; ++r) { const float lv = wsf[crow(r, hi)]; rli[r] = lv > 0.f ? __builtin_amdgcn_rcpf(lv) : 0.f; }
    { int l2 = lane; asm volatile("" : "+v"(l2));
      const int r32b = l2 & 31, hib = l2 >> 5;
      char* Ow = (char*)(P + (size_t)(it.qrow0 + wid * 32) * PW + ocol) + (unsigned)((4 * hib) * PW + r32b) * 2u;
#pragma unroll
      for (int r = 0; r < 16; ++r) { const unsigned ro = (unsigned)(((r & 3) + 8 * (r >> 2)) * PW) * 2u;
#pragma unroll
        for (int d0 = 0; d0 < 4; ++d0) { const float v = o[d0][r] * rli[r]; const float vn = __shfl_xor(v, 1);
            if ((r32b & 1) == 0) *(unsigned*)(Ow + ro + d0 * 64) = cvt_pk_bf16(v, vn); } } }
    LDS_WAIT();
    __syncthreads();
#undef FA_KROW0
#undef FA_LOAD
#undef FA_WRITE
#undef FA_PK4
#undef FA_TRRD
#undef FA_PV
}
__device__ __forceinline__ int next_item(unsigned* ctr, LAS int* slot) {
    __syncthreads();
    if (threadIdx.x == 0) *slot = (int)__hip_atomic_fetch_add(ctr, 1u, __ATOMIC_RELAXED, __HIP_MEMORY_SCOPE_AGENT);
    __syncthreads();
    return *slot;
}
__device__ __forceinline__ void queue_prime(unsigned* ctr, LAS int* slot) {
    __syncthreads();
    if (threadIdx.x == 0) slot[0] = (int)__hip_atomic_fetch_add(ctr, 1u, __ATOMIC_RELAXED, __HIP_MEMORY_SCOPE_AGENT);
    __syncthreads();
}
__device__ __forceinline__ int queue_next(unsigned* ctr, LAS int* slot, int k) {
    const int idx = slot[k & 1];
    if (threadIdx.x == 0) slot[(k + 1) & 1] = (int)__hip_atomic_fetch_add(ctr, 1u, __ATOMIC_RELAXED, __HIP_MEMORY_SCOPE_AGENT);
    return idx;
}
__device__ __forceinline__ Item make_item(bool meta, int b, int qb) {
    Item it;
    if (meta) { it.qrow0 = 0; it.qk0 = -(MBLK - 64); it.nt = 1; it.tokbase = MBLK; }
    else { it.qrow0 = MBLK + b * SEQ + qb * 256; it.qk0 = 64 + qb * 256; it.nt = 4 * (qb + 1) + 1; it.tokbase = MBLK + b * SEQ; }
    return it;
}
}


constexpr int PH_PER_LAYER = 19, N_PHASES = 2 * PH_PER_LAYER;
__device__ __forceinline__ unsigned char* uni_ptr(unsigned char* p) { const unsigned long long v = (unsigned long long)p; const unsigned lo = __builtin_amdgcn_readfirstlane((unsigned)v), hi = __builtin_amdgcn_readfirstlane((unsigned)(v >> 32)); return (unsigned char*)(((unsigned long long)hi << 32) | lo); }
__device__ __forceinline__ const float* arg_in(const Args& a, int k) { asm volatile("" : "+s"(k)); return a.in[k]; }
__global__ void __launch_bounds__(NWAVES * 64, 2) mega_fwd(Args args) {
    extern __shared__ __attribute__((aligned(16))) unsigned char lds_raw[];
    {
        LAS unsigned char* l0 = (LAS unsigned char*)lds_raw;
        for (int u = threadIdx.x; u < (LDS_BYTES - LDSCTL_OFF) / 4; u += NWAVES * 64) ((LAS unsigned*)(l0 + LDSCTL_OFF))[u] = 0u;
        __syncthreads();
    }
#if MK_ONE_LAUNCH
    (void)xcd_barrier_post((unsigned*)(args.ws + WS_CTL) + CW_BAR, (volatile LAS unsigned*)((LAS unsigned char*)lds_raw + LDSCTL_OFF + 64));
#define GRID_BAR() do { XcdBarrier bar_; bar_.bar = (unsigned*)(uni_ptr(args.ws) + WS_CTL) + CW_BAR; bar_.x = xb_xcc_id(); bar_.st = (volatile LAS unsigned*)((LAS unsigned char*)lds_raw + LDSCTL_OFF + 64); xcd_barrier(bar_); } while (0)
#else
#define GRID_BAR() do {} while (0)
#endif
    const int lo = args.ph_lo, hi = args.ph_hi;
#define IN(k) (lo <= (k) && (k) < hi)
#define SEAM(k) do { if (IN((k) + 1)) GRID_BAR(); } while (0)
#define PH_BEGIN \
    int tid_ = threadIdx.x; asm volatile("" : "+v"(tid_)); \
    Ctx F; F.lds = (LAS unsigned char*)lds_raw; F.tid = tid_; F.lane = tid_ & 63; F.wave = __builtin_amdgcn_readfirstlane(tid_ >> 6); \
    F.G = gridDim.x; F.bid = blockIdx.x; F.gw = F.bid * NWAVES + F.wave; F.ngw = F.G * NWAVES; \
    unsigned char* ws = uni_ptr(args.ws); asm volatile("" : "+s"(ws)); \
    int ly = __builtin_amdgcn_readfirstlane(layer); asm volatile("" : "+s"(ly)); (void)ly; (void)F
#define XN_ ((bf16_t*)(ws + WS_XN))
#define P_ ((bf16_t*)(ws + WS_P))
#define HMETA_ ((float*)(ws + WS_HMETA))
#define RSTDQ_ ((float*)(ws + WS_RSTD))
#define RSTDKV_ ((float*)(ws + WS_RSTD) + R)
#define BM_ ((unsigned*)(ws + WS_BM))
#define RS_(i) ((float*)(ws + WS_CTL + WS_RS) + (size_t)(i) * R)
#define GPERM_ ((float*)(ws + WS_RSTD + 512 * 1024))
#define WB_(off) ((bf16_t*)(ws + WS_WB + (off)))
#define OUT_ (args.out)
#define LAMBDA_INIT(ly) ((ly) == 0 ? 0.2f : (0.8f - 0.6f * 0.7408182206817179f))
#define HSRC_TOK(ly) ((ly) == 0 ? arg_in(args, 0) : (const float*)args.out)

#pragma unroll
    for (int layer = 0; layer < 2; ++layer) {
        const int pb = layer * PH_PER_LAYER;
        if (((PHMASK >> 0) & 1) && IN(pb + 0)) {
            PH_BEGIN;
            for (int rep_ = 0; rep_ < NREP(0); ++rep_) { if (rep_) GRID_BAR();
            const float* meta = arg_in(args, 1);
            conv_matrix<1>(F, arg_in(args, 3) + (size_t)ly * DM * D_IN, DM, D_IN, WB_(WB_IN), arg_in(args, 2) + ly * DM);
            conv_matrix<0>(F, arg_in(args, 7) + (size_t)ly * 512 * 1536, 512, 1536, WB_(WB_QUP), arg_in(args, 5) + ly * 512);
            conv_matrix<0>(F, arg_in(args, 8) + (size_t)ly * 512 * 2048, 512, 2048, WB_(WB_KVUP), arg_in(args, 6) + ly * 512);
            for (int b = 0; b < 3; ++b) conv_matrix<0>(F, arg_in(args, 14) + ((size_t)ly * 3 + b) * 1024 * DM, 1024, DM, WB_(WB_BR) + (size_t)b * DM * 1024, nullptr);
            conv_matrix<0>(F, arg_in(args, 15) + (size_t)ly * DM * DM, DM, DM, WB_(WB_O), nullptr);
            conv_matrix<2>(F, arg_in(args, 17) + (size_t)ly * DM * 2 * DFF, DM, 2 * DFF, WB_(WB_F1), arg_in(args, 16) + ly * DM);
            conv_matrix<0>(F, arg_in(args, 18) + (size_t)ly * DFF * DM, DFF, DM, WB_(WB_F2), nullptr);
            unsigned zu = 0u; asm volatile("" : "+v"(zu)); const float zf = __uint_as_float(zu);
            for (int i = F.gw * 64 + F.lane; i < 112 * 2048 / 8; i += F.ngw * 64) *((u32x4*)(WB_(WB_IN) + (size_t)1168 * 2048) + i) = (u32x4){zu, zu, zu, zu};
            if (F.bid == 0) { const int i = F.tid; const int t = i >> 7, ps = i & 127, dim = (ps >> 1) + 64 * (ps & 1);
                const float* gsrc = (t < 2 ? arg_in(args, 10) : arg_in(args, 11)) + ly * 256 + (t & 1) * 128; GPERM_[i] = gsrc[dim]; }
            float* hmeta = HMETA_;
            if (ly == 0) {
                for (int i = F.gw * 64 + F.lane; i < MROW0 * PW / 8; i += F.ngw * 64) *((u32x4*)P_ + i) = (u32x4){zu, zu, zu, zu};
                for (int i = F.gw * 64 + F.lane; i < MBLK * DM / 4; i += F.ngw * 64) { const int rr = i / (DM / 4); f32x4 v = (f32x4){zf, zf, zf, zf};
                    if (rr >= MBLK - NMETA) v = *((const f32x4*)meta + (i - (MBLK - NMETA) * (DM / 4))); *((f32x4*)hmeta + i) = v; }
            }
            if (ly == 0) {
                const float* xin = arg_in(args, 0); bf16_t* XN = XN_; float* rs0 = RS_(0);
                for (int r = MROW0 + F.gw; r < R; r += F.ngw)
                    norm_row(r < MBLK ? meta + (size_t)(r - MROW0) * DM : xin + (size_t)(r - MBLK) * DM, XN + (size_t)r * DM, rs0 + r, F.lane);
            }
            }
            SEAM(pb + 0);
        }
        if (((PHMASK >> 1) & 1) && IN(pb + 1)) {
            PH_BEGIN;
            { SkP f{P_, 0, RS_(2 * ly)}; skinny_gemm(F.lds, XN_ + (size_t)MROW0 * DM, DM, WB_(WB_IN), DM, 1280 / 16, F.bid, F.G, f); }
            SchedPlain S{XN_, DM, WB_(WB_IN), DM, NPMM, 5, F.G, F.bid, 0}; EpiP E{P_, RS_(2 * ly)};
            pg8::gemm_phase(F.lds, S, E);
            if (NREP(1) == 2) { GRID_BAR(); pg8::gemm_phase(F.lds, S, E); }
            SEAM(pb + 1);
        }
        if (((PHMASK >> 2) & 1) && IN(pb + 2)) {
            PH_BEGIN;
            { bf16_t* P = P_; float* rq = RSTDQ_; float* rkv = RSTDKV_;
              for (int r = MROW0 + F.gw; r < R; r += F.ngw) post1a_row(P, r, rq, rkv, F.lane); }
            VM_WAIT(); __syncthreads();
            { SkP f{P_, C_QRAW, nullptr}; skinny_gemm(F.lds, P_ + (size_t)MROW0 * PW + C_CQ, PW, WB_(WB_QUP), 512, 1536 / 16, F.bid, F.G, f); }
            { SkP f{P_, C_KVRAW, nullptr}; skinny_gemm(F.lds, P_ + (size_t)MROW0 * PW + C_CKV, PW, WB_(WB_KVUP), 512, 2048 / 16, F.bid, F.G, f); }
            SchedMlaUp S{P_, WB_(WB_QUP), WB_(WB_KVUP), F.G, F.bid}; EpiP E{P_, nullptr};
            pg8::gemm_phase(F.lds, S, E);
            if (NREP(2) == 2) { GRID_BAR(); pg8::gemm_phase(F.lds, S, E); }
            SEAM(pb + 2);
        }
        if (((PHMASK >> 3) & 1) && IN(pb + 3)) {
            PH_BEGIN;
            const float* mla_qkg = arg_in(args, 9) + ly * 2 * 192;
            bf16_t* P = P_; float* rq = RSTDQ_; float* rkv = RSTDKV_;
            LAS float* rnl = (LAS float*)(F.lds + F.wave * 64);
            for (int r = MROW0 + F.gw; r < R; r += F.ngw) post2_row(P, r, rq, rkv, mla_qkg, rnl, F.lane);
            SEAM(pb + 3);
        }
        if (((PHMASK >> 4) & 1) && IN(pb + 4)) {
            PH_BEGIN;
            bf16_t* P = P_;
            LAS int* slot = (LAS int*)(F.lds + LDSCTL_OFF + 128);
            for (int rep_ = 0; rep_ < NREP(4); ++rep_) { if (rep_) GRID_BAR();
            unsigned* ctr = (unsigned*)(ws + WS_CTL) + CW_Q + 64 * (ly * 4 + 0) + 64 * 16 * rep_;
            fa::queue_prime(ctr, slot);
            for (int qk_ = 0;; ++qk_) {
                const int idx = fa::queue_next(ctr, slot, qk_); if (idx >= 8 * 129) break;
                int h; fa::Item it;
                if (idx < 1024) { const int qb = 7 - (idx >> 7), rest = idx & 127; h = rest & 7; it = fa::make_item(false, rest >> 3, qb); } else { h = idx - 1024; it = fa::make_item(true, 0, 0); }
                bf16x8 qr[12]; fa::load_q<192>(P, it, C_QRAW + h * 192, qr);
                fa::attn_core<192, false>(P, it, qr, C_KVRAW + h * 256, C_KPEH + h * 64, C_KVRAW + h * 256 + 128, C_OA + h * 128, nullptr, F.lds);
            } }
            SEAM(pb + 4);
        }
        if (((PHMASK >> 5) & 1) && IN(pb + 5)) {
            PH_BEGIN;
            { SkP f{P_, 1280, RS_(2 * ly)}; skinny_gemm(F.lds, XN_ + (size_t)MROW0 * DM, DM, WB_(WB_IN) + (size_t)1280 * DM, DM, 7168 / 16, F.bid, F.G, f); }
            SchedPlain S{XN_, DM, WB_(WB_IN) + (size_t)1280 * DM, DM, NPMM, 28, F.G, F.bid, 1280}; EpiG2 E{P_, RS_(2 * ly), GPERM_, (LAS float*)(F.lds + RING_BYTES)};
            pg8::gemm_phase(F.lds, S, E);
            if (NREP(5) == 2) { GRID_BAR(); pg8::gemm_phase(F.lds, S, E); }
            SEAM(pb + 5);
        }
        if (((PHMASK >> 6) & 1) && IN(pb + 6)) {
            PH_BEGIN;
            bf16_t* P = P_; const float* gp = GPERM_;
            if (F.gw < NMETA) meta_post_row(P, MROW0 + F.gw, gp, F.lane);
            SEAM(pb + 6);
        }
        if (((PHMASK >> 7) & 1) && IN(pb + 7)) {
            PH_BEGIN;
            bf16_t* P = P_; unsigned* bm = BM_;
            unsigned* ctr = (unsigned*)(ws + WS_CTL) + CW_Q + 64 * (ly * 4 + 2);
            LAS int* slot = (LAS int*)(F.lds + LDSCTL_OFF + 128);
            for (int rep_ = 0; rep_ < NREP(7); ++rep_) { if (rep_) GRID_BAR(); unsigned* c2 = ctr + 64 * 16 * rep_;
            for (;;) { const int idx = fa::next_item(c2, slot); if (idx >= NTOK / 8) break; index_unit(P, idx, bm, F.lds); } }
            SEAM(pb + 7);
        }
        if (((PHMASK >> 8) & 1) && IN(pb + 8)) {
            PH_BEGIN;
            bf16_t* P = P_; unsigned* bm = BM_;
            LAS int* slot = (LAS int*)(F.lds + LDSCTL_OFF + 128);
            for (int rep_ = 0; rep_ < NREP(8); ++rep_) { if (rep_) GRID_BAR();
            const bool dummy = (NREP(8) == 2) && rep_ == 0;
            unsigned* ctr = (unsigned*)(ws + WS_CTL) + CW_Q + 64 * (ly * 4 + 1) + 64 * 16 * rep_;
            fa::queue_prime(ctr, slot);
            for (int qk_ = 0;; ++qk_) {
                const int idx = fa::queue_next(ctr, slot, qk_); if (idx >= 16 * 129) break;
                int hh; bool meta = false; fa::Item it; int b = 0, qb = 0;
                if (idx < 2048) { qb = 7 - (idx >> 8); const int rest = idx & 255; hh = (rest < 128) ? 8 + (rest & 7) : (rest & 7); b = (rest & 127) >> 3; it = fa::make_item(false, b, qb); }
                else { hh = idx - 2048; hh = hh < 8 ? 8 + hh : hh - 8; meta = true; it = fa::make_item(true, 0, 0); }
                if (hh < 8) {
                    bf16x8 qr[8]; fa::load_q<128>(P, it, C_DQ + hh * 128, qr);
                    fa::attn_core<128, true>(P, it, qr, C_DK + hh * 128, 0, C_DV + hh * 128, dummy ? C_KPE : C_OB + hh * 128, meta ? nullptr : bm + (size_t)(b * SEQ + qb * 256) * BMW, F.lds);
                } else {
                    const int hj = hh - 8;
                    bf16x8 qr[8]; fa::load_q<128>(P, it, C_FQ + hj * 128, qr);
                    fa::attn_core<128, false>(P, it, qr, C_FK + hj * 128, 0, C_FV + (hj >> 1) * 256, dummy ? C_KPE : C_FQ + hj * 128, nullptr, F.lds);
                    fa::attn_core<128, false>(P, it, qr, C_FK + hj * 128, 0, C_FV + (hj >> 1) * 256 + 128, dummy ? C_KPE : C_IQ + hj * 128, nullptr, F.lds);
                }
            } }
            SEAM(pb + 8);
        }
        if (((PHMASK >> 9) & 1) && IN(pb + 9)) {
            PH_BEGIN;
            const float* diff_lam = arg_in(args, 12) + ly * 4 * 128; const float* diff_subg = arg_in(args, 13) + ly * 256;
            const float lambda_init = LAMBDA_INIT(ly);
            const float s1 = wave_sum(diff_lam[F.lane] * diff_lam[128 + F.lane] + diff_lam[64 + F.lane] * diff_lam[192 + F.lane]);
            const float s2 = wave_sum(diff_lam[256 + F.lane] * diff_lam[384 + F.lane] + diff_lam[320 + F.lane] * diff_lam[448 + F.lane]);
            const float lam = __expf(s1) - __expf(s2) + lambda_init;
            bf16_t* P = P_;
            for (int r = MROW0 + F.gw; r < R; r += F.ngw) post3_row(P, r, diff_subg, lam, 1.f - lambda_init, F.lane);
        }
#define GATE_PHASE(k, b) \
        if (((PHMASK >> 10) & 1) && IN(pb + (k))) { \
            PH_BEGIN; \
            { SkGate f{(bf16_t*)(ws + WS_GS), arg_in(args, 4) + ly * 3 * DM + (b) * DM, RS_(2 * ly)}; skinny_gemm(F.lds, XN_ + (size_t)MROW0 * DM, DM, WB_(WB_G) + (size_t)(b) * 2048 * DM, DM, 2048 / 16, F.bid, F.G, f); } \
            SchedPlain S{XN_, DM, WB_(WB_G) + (size_t)(b) * 2048 * DM, DM, NPMM, 8, F.G, F.bid, 0}; EpiGate E{(bf16_t*)(ws + WS_GS), arg_in(args, 4) + ly * 3 * DM + (b) * DM, RS_(2 * ly)}; \
            pg8::gemm_phase(F.lds, S, E); \
            if (NREP(k) == 2) { GRID_BAR(); pg8::gemm_phase(F.lds, S, E); } \
            SEAM(pb + (k)); \
        }
#define BRANCH_PHASE(k, b, oc) \
        if (((PHMASK >> 10) & 1) && IN(pb + (k))) { \
            PH_BEGIN; \
            { SkGated f{P_, (const bf16_t*)(ws + WS_GS), (b) == 0 ? 1 : 0}; skinny_gemm(F.lds, P_ + (size_t)MROW0 * PW + (oc), PW, WB_(WB_BR) + (size_t)(b) * DM * 1024, 1024, 2048 / 16, F.bid, F.G, f); } \
            SchedPlain S{P_ + (oc), PW, WB_(WB_BR) + (size_t)(b) * DM * 1024, 1024, NPMM, 8, F.G, F.bid, C_MERGED}; EpiGated E{P_, (const bf16_t*)(ws + WS_GS), (b) == 0 ? 1 : 0, ((DBG_BM >> (b)) & 1) ? 1.f : 0.f}; \
            pg8::gemm_phase(F.lds, S, E); \
            if (NREP(k) == 2 && (b) == 0) { GRID_BAR(); pg8::gemm_phase(F.lds, S, E); } \
            SEAM(pb + (k)); \
        }
        GATE_PHASE(10, 0) BRANCH_PHASE(11, 0, C_OA)
        GATE_PHASE(12, 1) BRANCH_PHASE(13, 1, C_OB)
        GATE_PHASE(14, 2) BRANCH_PHASE(15, 2, C_OC)
        if (((PHMASK >> 11) & 1) && IN(pb + 16)) {
            PH_BEGIN;
            { SkRes f{HMETA_, XN_, RS_(2 * ly + 1)}; skinny_gemm(F.lds, P_ + (size_t)MROW0 * PW + C_MERGED, PW, WB_(WB_O), DM, 2048 / 16, F.bid, F.G, f); }
            SchedPlain S{P_ + C_MERGED, PW, WB_(WB_O), DM, NPMM, 8, F.G, F.bid, 0}; EpiRes E{HSRC_TOK(ly), OUT_, HMETA_, DBG_SA, XN_, RS_(2 * ly + 1)};
            pg8::gemm_phase(F.lds, S, E);
            SEAM(pb + 16);
        }
        if (((PHMASK >> 13) & 1) && IN(pb + 17)) {
            PH_BEGIN;
            skinny_swiglu(F.lds, XN_ + (size_t)MROW0 * DM, DM, WB_(WB_F1), DM, P_, RS_(2 * ly + 1), F.bid, F.G);
            SchedPlain S{XN_, DM, WB_(WB_F1), DM, NPMM, 44, F.G, F.bid, 0}; EpiSwiglu E{P_, RS_(2 * ly + 1)};
            pg8::gemm_phase(F.lds, S, E);
            if (NREP(17) == 2) { GRID_BAR(); pg8::gemm_phase(F.lds, S, E); }
            SEAM(pb + 17);
        }
        if (((PHMASK >> 14) & 1) && IN(pb + 18)) {
            PH_BEGIN;
            { SkRes f{HMETA_, ly == 0 ? XN_ : (bf16_t*)nullptr, RS_(2)}; skinny_gemm(F.lds, P_ + (size_t)MROW0 * PW, PW, WB_(WB_F2), DFF, 2048 / 16, F.bid, F.G, f); }
            SchedPlain S{P_, PW, WB_(WB_F2), DFF, NPMM, 8, F.G, F.bid, 0}; EpiRes E{OUT_, OUT_, HMETA_, DBG_SF, ly == 0 ? XN_ : (bf16_t*)nullptr, RS_(2)};
            pg8::gemm_phase(F.lds, S, E);
            SEAM(pb + 18);
        }
    }
#undef IN
#undef SEAM
}

__global__ void diag_fill(float* out, int n, float v) { for (int i = blockIdx.x * blockDim.x + threadIdx.x; i < n; i += gridDim.x * blockDim.x) out[i] = v; }
extern "C" void kernel_launch(void* const* d_in, const int* in_sizes, int n_in, void* d_out, int out_size, void* d_ws, size_t ws_size, hipStream_t stream) {
    static int grid = 0; static float code = 0.f;
    if (grid == 0) {
        int dev = 0, cus = 0;
        if (n_in != 19) { code = 10.f; grid = -1; }
        else if (ws_size < WS_END) { code = 20.f + (float)(ws_size >> 20) * 0.01f; grid = -1; }
        else if (hipGetDevice(&dev) != hipSuccess || hipDeviceGetAttribute(&cus, hipDeviceAttributeMultiprocessorCount, dev) != hipSuccess) { code = 40.f; grid = -1; }
        else if (hipFuncSetAttribute((const void*)mega_fwd, hipFuncAttributeMaxDynamicSharedMemorySize, LDS_BYTES) != hipSuccess) { code = 50.f; grid = -1; }
        else {
            int per_cu = 0;
            if (hipOccupancyMaxActiveBlocksPerMultiprocessor(&per_cu, (const void*)mega_fwd, NWAVES * 64, LDS_BYTES) != hipSuccess || per_cu < 1) { code = 60.f; grid = -1; }
            (void)hipGetLastError();
            if (grid == 0) grid = cus;
        }
    }
    if (grid < 0) { hipLaunchKernelGGL(diag_fill, dim3(1024), dim3(256), 0, stream, (float*)d_out, out_size, code); return; }
    (void)hipMemsetAsync((char*)d_ws + WS_CTL, 0, CTL_BYTES, stream);
    Args a{};
    for (int i = 0; i < 19; ++i) a.in[i] = (const float*)d_in[i];
    a.out = (float*)d_out; a.ws = (unsigned char*)d_ws;
#if MK_ONE_LAUNCH
    a.ph_lo = 0; a.ph_hi = N_PHASES;
    hipLaunchKernelGGL(mega_fwd, dim3(grid), dim3(NWAVES * 64), LDS_BYTES, stream, a);
#else
    for (int p = 0; p < N_PHASES; ++p) { a.ph_lo = p; a.ph_hi = p + 1; hipLaunchKernelGGL(mega_fwd, dim3(grid), dim3(NWAVES * 64), LDS_BYTES, stream, a); }
#endif
    if (hipPeekAtLastError() != hipSuccess) { (void)hipGetLastError(); hipLaunchKernelGGL(diag_fill, dim3(1024), dim3(256), 0, stream, (float*)d_out, out_size, 70.f); }
}
```

```cpp
#include <hip/hip_runtime.h>
#include <cstdio>
#include <cstdint>

#ifndef PHMASK
#define PHMASK 0x7fff
#endif
#ifndef REPMASK
#define REPMASK 0
#endif
#define NREP(k) ((((REPMASK) >> (k)) & 1) ? 2 : 1)
#ifndef DBG_BM
#define DBG_BM 7
#endif
#ifndef DBG_BR
#define DBG_BR 0
#endif
#ifndef DBG_SA
#define DBG_SA 1.0f
#endif
#ifndef DBG_SF
#define DBG_SF 1.0f
#endif
#ifndef MK_ONE_LAUNCH
#define MK_ONE_LAUNCH 1
#endif

#define LAS __attribute__((address_space(3)))
#define GAS __attribute__((address_space(1)))
typedef unsigned short bf16_t;
typedef short bf16x8 __attribute__((ext_vector_type(8)));
typedef float f32x4 __attribute__((ext_vector_type(4)));
typedef float f32x2 __attribute__((ext_vector_type(2)));
typedef unsigned u32x4 __attribute__((ext_vector_type(4)));
typedef unsigned u32x2 __attribute__((ext_vector_type(2)));

constexpr int DM = 2048, NB = 16, SEQ = 2048, NMETA = 16, MBLK = 256;
constexpr int R = MBLK + NB * SEQ;
constexpr int NPM = R / 256;
constexpr int NPMM = NPM - 1;
constexpr int MROW0 = MBLK - NMETA;
constexpr int NTOK = NB * SEQ;
constexpr int DFF = 5632;
constexpr int PW = 8448;
constexpr int C_CQ = 0, C_CKV = 512, C_KPE = 1024, C_IK = 1088, C_IW = 1152, C_DQ = 1280, C_DK = 2304, C_DV = 3328, C_IQ = 4352,
              C_FQ = 5376, C_FK = 6400, C_FV = 7424;
constexpr int C_KVRAW = 1280, C_QRAW = 3328, C_KPEH = 4864;
constexpr int C_OA = 0, C_OB = C_DQ, C_OC = C_FQ, C_MERGED = 2304;
constexpr int BMW = 66;
constexpr float EPS = 1e-6f;
constexpr float LOG2E = 1.4426950408889634f;
constexpr float C2_128 = 0.08838834764831845f * LOG2E;
constexpr float C2_192 = 0.07216878364870323f * LOG2E;
constexpr int D_IN = 14480;

constexpr size_t MiB = 1u << 20;
constexpr size_t WS_CTL = 0, CTL_BYTES = 1 * MiB;
constexpr size_t WS_RSTD = 1 * MiB;
constexpr size_t WS_HMETA = 2 * MiB;
constexpr size_t WS_BM = 4 * MiB;
constexpr size_t WS_WB = 16 * MiB;
constexpr size_t WB_IN = 0, WB_G = WB_IN + (size_t)8448 * 2048 * 2, WB_QUP = WB_G + (size_t)6144 * 2048 * 2, WB_KVUP = WB_QUP + (size_t)1536 * 512 * 2,
                 WB_BR = WB_KVUP + (size_t)2048 * 512 * 2, WB_O = WB_BR + (size_t)3 * 2048 * 1024 * 2, WB_F1 = WB_O + (size_t)2048 * 2048 * 2,
                 WB_F2 = WB_F1 + (size_t)11264 * 2048 * 2, WB_END = WB_F2 + (size_t)2048 * 5632 * 2;
constexpr size_t WS_XN = 164 * MiB;
constexpr size_t WS_P = 294 * MiB;
constexpr size_t WS_GS = 828 * MiB;
constexpr size_t WS_END = 960 * MiB;
static_assert(WS_GS + (size_t)R * 2048 * 2 <= WS_END && WS_WB + WB_END <= WS_XN && WS_XN + (size_t)R * 2048 * 2 <= WS_P && WS_P + (size_t)R * PW * 2 <= WS_GS, "ws map");
constexpr int CW_BAR = 4096, CW_Q = 16384;
constexpr size_t WS_RS = 256 * 1024;

__device__ __forceinline__ float bf2f(bf16_t v) { return __uint_as_float((unsigned)v << 16); }
__device__ __forceinline__ unsigned f2bf(float f) { unsigned u = __float_as_uint(f); return (u + 0x7fffu + ((u >> 16) & 1u)) >> 16; }
__device__ __forceinline__ unsigned pk2(float lo, float hi) { return f2bf(lo) | (f2bf(hi) << 16); }
typedef __bf16 bf16x2_t __attribute__((ext_vector_type(2)));
__device__ __forceinline__ unsigned cvt_pk_bf16(float lo, float hi) { f32x2 v = {lo, hi}; bf16x2_t b = __builtin_convertvector(v, bf16x2_t); return __builtin_bit_cast(unsigned, b); }
__device__ __forceinline__ float wave_sum(float v) {
#pragma unroll
    for (int o = 1; o < 64; o <<= 1) v += __shfl_xor(v, o);
    return v;
}
__device__ __forceinline__ float wave_max(float v) {
#pragma unroll
    for (int o = 1; o < 64; o <<= 1) v = fmaxf(v, __shfl_xor(v, o));
    return v;
}
#define LDS_WAIT() asm volatile("s_waitcnt lgkmcnt(0)" ::: "memory")
#define VM_WAIT() asm volatile("s_waitcnt vmcnt(0)" ::: "memory")
__device__ __forceinline__ int row_pos(int r) { return r < MBLK ? (r >= MBLK - NMETA ? r - (MBLK - NMETA) : 0) : NMETA + ((r - MBLK) & (SEQ - 1)); }
__device__ __forceinline__ void rope_cs(int pos, int i, float two_over_d, float& c, float& s) {
    const float inv = __builtin_amdgcn_exp2f(-(float)i * two_over_d * 13.287712379549449f);
    float rev = (float)pos * inv * 0.15915494309189535f;
    rev -= floorf(rev);
    s = __builtin_amdgcn_sinf(rev); c = __builtin_amdgcn_cosf(rev);
}

namespace pg8 {
constexpr int BM = 256, BK = 64, HALF = 128, HTB = HALF * BK * 2, STAGE_BYTES = 8 * HTB;
__device__ __forceinline__ int lds_byte(int r, int c) { const int st = (r >> 4) * 2 + (c >> 5), rr = r & 15, cc = c & 31, ob = rr * 64 + cc * 2; return st * 1024 + (ob ^ (((ob >> 9) & 1) << 5)); }
__device__ __forceinline__ void stage_rc(int b, int& R_, int& C_) { const int st = b / 1024, sb = b % 1024, swz = sb ^ (((sb >> 9) & 1) << 5); R_ = (st >> 1) * 16 + swz / 64; C_ = (st & 1) * 32 + (swz % 64) / 2; }
__device__ __forceinline__ int perm32(int rho) { const int n = rho >> 4, i = rho & 15; return 8 * (i >> 2) + 4 * n + (i & 3); }

struct Unit { const char* A; const char* B; unsigned lda2, ldb2; int nt, pm, pn, kind, ocol; };

#ifndef WGM
#define WGM 4
#endif
__device__ __forceinline__ void tile_of(int L, int nM, int nN, int& pm, int& pn) {
    const int nwg = nM * nN; int wgid = L;
    { const int q = nwg / 8, r = nwg % 8, xcd = wgid % 8, off = wgid / 8; wgid = (xcd < r ? xcd * (q + 1) : r * (q + 1) + (xcd - r) * q) + off; }
    const int nig = WGM * nN, gid = wgid / nig, fm = gid * WGM, gsz = (nM - fm) < WGM ? (nM - fm) : WGM;
    pm = fm + ((wgid % nig) % gsz); pn = (wgid % nig) / gsz;
}

template <class Epi, class Sched>
__device__ __forceinline__ void gemm_phase(LAS unsigned char* lds, const Sched& S, const Epi& E) {
    int tid = threadIdx.x; asm volatile("" : "+v"(tid));
    const int wid = __builtin_amdgcn_readfirstlane(tid >> 6), lane = tid & 63, wr = wid >> 2, wc = wid & 3, fr = lane & 15, fq = lane >> 4;
    unsigned rA[2], rB[2], cc[2];
#pragma unroll
    for (int i = 0; i < 2; ++i) { int R_, C_; stage_rc(tid * 16 + i * 8192, R_, C_); rA[i] = (unsigned)R_; rB[i] = (unsigned)(Epi::PERM ? ((R_ & ~31) + perm32(R_ & 31)) : R_); cc[i] = (unsigned)C_ * 2u; }
    const size_t kstep = (size_t)(BK * 2);
    const unsigned ldsw = (unsigned)wid * 1024u;
    const int aoff = lds_byte(wr * 64 + fr, fq * 8), boff = lds_byte(wc * 32 + fr, fq * 8);
#define PG8_SA(b, h) (((b) * 2 + (h)) * HTB)
#define PG8_SB(b, h) ((4 + (b) * 2 + (h)) * HTB)
#define PG8_STAGE(bufoff, gbase, rr, ld2) do { _Pragma("unroll") for (int _i = 0; _i < 2; ++_i) \
        __builtin_amdgcn_global_load_lds((const unsigned*)((const char*)(gbase) + ((rr)[_i] * (ld2) + cc[_i])), (LAS unsigned*)(lds + (bufoff) + ldsw + _i * 8192), 16, 0, 0); } while (0)
#define PG8_LDA(dst, b, h) do { _Pragma("unroll") for (int m = 0; m < 4; ++m) _Pragma("unroll") for (int k = 0; k < 2; ++k) dst[m][k] = *(const LAS bf16x8*)(lds + PG8_SA(b, h) + aoff + m * 2048 + k * 1024); } while (0)
#define PG8_LDB(dst, b, h) do { _Pragma("unroll") for (int n = 0; n < 2; ++n) _Pragma("unroll") for (int k = 0; k < 2; ++k) dst[n][k] = *(const LAS bf16x8*)(lds + PG8_SB(b, h) + boff + n * 2048 + k * 1024); } while (0)
#define PG8_MMA(ai, bj, At, Bt) do { __builtin_amdgcn_s_setprio(1); _Pragma("unroll") for (int m = 0; m < 4; ++m) _Pragma("unroll") for (int n = 0; n < 2; ++n) _Pragma("unroll") for (int k = 0; k < 2; ++k) \
        acc[ai][bj][m][n] = __builtin_amdgcn_mfma_f32_16x16x32_bf16(Bt[n][k], At[m][k], acc[ai][bj][m][n], 0, 0, 0); __builtin_amdgcn_s_setprio(0); } while (0)
#define PG8_WAIT_V(n) asm volatile("s_waitcnt vmcnt(" #n ")" ::: "memory")
#define PG8_WAIT_L(n) asm volatile("s_waitcnt lgkmcnt(" #n ")" ::: "memory")
#define PG8_BAR __builtin_amdgcn_s_barrier()
#define PG8_SCHED __builtin_amdgcn_sched_barrier(0)
    Unit cur, nxt; int ui = 0;
    if (!S.next(0, cur)) return;
    float zf = 0.f; asm volatile("" : "+v"(zf));
    f32x4 acc[2][2][4][2];
#pragma unroll
    for (int a = 0; a < 2; ++a)
#pragma unroll
        for (int b = 0; b < 2; ++b)
#pragma unroll
            for (int m = 0; m < 4; ++m)
#pragma unroll
                for (int n = 0; n < 2; ++n) acc[a][b][m][n] = (f32x4){zf, zf, zf, zf};
    bf16x8 At[4][2], B0[2][2], B1[2][2];
    const char* cA = cur.A; const char* cB = cur.B;
    unsigned lA = cur.lda2, lB = cur.ldb2;
    size_t hA = (size_t)HALF * lA, hB = (size_t)HALF * lB;
    PG8_STAGE(PG8_SB(0, 0), cB, rB, lB); PG8_STAGE(PG8_SB(0, 1), cB + hB, rB, lB); PG8_STAGE(PG8_SA(0, 0), cA, rA, lA); PG8_STAGE(PG8_SA(0, 1), cA + hA, rA, lA);
    if (wr == 1) PG8_BAR;
    PG8_WAIT_V(2); PG8_BAR;
    PG8_STAGE(PG8_SB(1, 0), cB + kstep, rB, lB); PG8_STAGE(PG8_SA(1, 0), cA + kstep, rA, lA); PG8_STAGE(PG8_SB(1, 1), cB + hB + kstep, rB, lB);
    PG8_WAIT_V(6); PG8_BAR;
    for (;;) {
        const bool has_next = S.next(ui + 1, nxt);
        if (!has_next) nxt = cur;
        const char* nA = nxt.A; const char* nB = nxt.B;
        const unsigned lAn = nxt.lda2, lBn = nxt.ldb2;
        const size_t hAn = (size_t)HALF * lAn, hBn = (size_t)HALF * lBn;
        const int nt = cur.nt;
        for (int t = 0; t < nt; t += 2) {
            const bool last = (t == nt - 2);
            const char* a1 = cA + (size_t)(t + 1) * kstep;
            const char* a2 = last ? nA : cA + (size_t)(t + 2) * kstep; const char* b2 = last ? nB : cB + (size_t)(t + 2) * kstep;
            const char* a3 = a2 + kstep; const char* b3 = b2 + kstep;
            const size_t hA2 = last ? hAn : hA, hB2 = last ? hBn : hB;
            const unsigned lA2 = last ? lAn : lA, lB2 = last ? lBn : lB;
            PG8_LDB(B0, 0, 0); PG8_LDB(B1, 0, 1); PG8_SCHED; PG8_LDA(At, 0, 0); PG8_STAGE(PG8_SA(1, 1), a1 + hA, rA, lA);
            PG8_WAIT_V(8); PG8_WAIT_L(0); PG8_BAR; PG8_MMA(0, 0, At, B0); PG8_MMA(0, 1, At, B1); PG8_BAR; PG8_SCHED;
            PG8_LDA(At, 0, 1); PG8_STAGE(PG8_SB(0, 0), b2, rB, lB2); PG8_STAGE(PG8_SB(0, 1), b2 + hB2, rB, lB2); PG8_STAGE(PG8_SA(0, 0), a2, rA, lA2);
            PG8_WAIT_V(8); PG8_WAIT_L(0); PG8_BAR; PG8_MMA(1, 0, At, B0); PG8_MMA(1, 1, At, B1); PG8_BAR; PG8_SCHED;
            PG8_LDB(B0, 1, 0); PG8_LDB(B1, 1, 1); PG8_SCHED; PG8_LDA(At, 1, 0); PG8_STAGE(PG8_SA(0, 1), a2 + hA2, rA, lA2);
            PG8_WAIT_V(8); PG8_WAIT_L(0); PG8_BAR; PG8_MMA(0, 0, At, B0); PG8_MMA(0, 1, At, B1); PG8_BAR; PG8_SCHED;
            PG8_LDA(At, 1, 1); PG8_STAGE(PG8_SB(1, 0), b3, rB, lB2); PG8_STAGE(PG8_SB(1, 1), b3 + hB2, rB, lB2); PG8_STAGE(PG8_SA(1, 0), a3, rA, lA2);
            PG8_WAIT_V(8); PG8_WAIT_L(0); PG8_BAR; PG8_MMA(1, 0, At, B0); PG8_MMA(1, 1, At, B1); PG8_BAR; PG8_SCHED;
        }
        if (wr == 0) PG8_BAR;
        E(acc, cur, wr, wc, fr, fq);
#pragma unroll
        for (int a = 0; a < 2; ++a)
#pragma unroll
            for (int b = 0; b < 2; ++b)
#pragma unroll
                for (int m = 0; m < 4; ++m)
#pragma unroll
                    for (int n = 0; n < 2; ++n) acc[a][b][m][n] = (f32x4){zf, zf, zf, zf};
        if (!has_next) break;
        cur = nxt; cA = nA; cB = nB; hA = hAn; hB = hBn; lA = lAn; lB = lBn; ++ui;
        if (wr == 1) PG8_BAR;
    }
    PG8_WAIT_V(0);
    PG8_BAR;
#undef PG8_SA
#undef PG8_SB
#undef PG8_STAGE
#undef PG8_LDA
#undef PG8_LDB
#undef PG8_MMA
#undef PG8_WAIT_V
#undef PG8_WAIT_L
#undef PG8_BAR
#undef PG8_SCHED
}
}
using pg8::Unit;

struct SchedPlain {
    const bf16_t* A; int lda; const bf16_t* B; int K; int nM, nN, G, c, ocol0;
    __device__ __forceinline__ bool next(int i, Unit& u) const {
        const int L = i * G + c; if (L >= nM * nN) return false;
        int pm, pn; pg8::tile_of(L, nM, nN, pm, pn); pm += 1;
        u.pm = pm; u.pn = pn; u.kind = 0; u.ocol = ocol0 + 256 * pn; u.nt = K / 64; u.lda2 = (unsigned)lda * 2u; u.ldb2 = (unsigned)K * 2u;
        u.A = (const char*)(A + (size_t)pm * 256 * lda); u.B = (const char*)(B + (size_t)pn * 256 * K); return true;
    }
};
struct SchedMlaUp {
    const bf16_t* P; const bf16_t* Wq; const bf16_t* Wkv; int G, c;
    __device__ __forceinline__ bool next(int i, Unit& u) const {
        const int L = i * G + c; if (L >= NPMM * 14) return false;
        int pm, pn; pg8::tile_of(L, NPMM, 14, pm, pn); pm += 1;
        u.pm = pm; u.pn = pn; u.kind = 0; u.nt = 8; u.lda2 = PW * 2u; u.ldb2 = 512 * 2u;
        if (pn < 6) { u.A = (const char*)(P + (size_t)pm * 256 * PW + C_CQ); u.B = (const char*)(Wq + (size_t)pn * 256 * 512); u.ocol = C_QRAW + 256 * pn; }
        else { u.A = (const char*)(P + (size_t)pm * 256 * PW + C_CKV); u.B = (const char*)(Wkv + (size_t)(pn - 6) * 256 * 512); u.ocol = C_KVRAW + 256 * (pn - 6); }
        return true;
    }
};
struct EpiP {
    static constexpr bool PERM = true;
    bf16_t* P; const float* rs;
    __device__ __forceinline__ void operator()(const f32x4 (&acc)[2][2][4][2], const Unit& u, int wr, int wc, int fr, int fq) const {
        asm volatile("" : "+v"(fr), "+v"(fq));
        const int row0 = u.pm * 256 + wr * 64 + fr, col0 = u.ocol + wc * 32 + 8 * fq;
#pragma unroll
        for (int ai = 0; ai < 2; ++ai)
#pragma unroll
            for (int m = 0; m < 4; ++m) { bf16_t* rowp = P + (size_t)(row0 + ai * 128 + m * 16) * PW + col0;
                const float sc = rs ? __builtin_amdgcn_rsqf(rs[row0 + ai * 128 + m * 16] * (1.f / DM) + EPS) : 1.f;
#pragma unroll
                for (int bj = 0; bj < 2; ++bj) { const f32x4 v0 = acc[ai][bj][m][0] * sc, v1 = acc[ai][bj][m][1] * sc;
                    u32x4 w; w.x = cvt_pk_bf16(v0[0], v0[1]); w.y = cvt_pk_bf16(v0[2], v0[3]); w.z = cvt_pk_bf16(v1[0], v1[1]); w.w = cvt_pk_bf16(v1[2], v1[3]);
                    *(u32x4*)(rowp + bj * 128) = w; } }
    }
};
struct EpiG2 {
    static constexpr bool PERM = true;
    bf16_t* P; const float* rs; const float* gperm; LAS float* xl;
    __device__ __forceinline__ void operator()(const f32x4 (&acc)[2][2][4][2], const Unit& u, int wr, int wc, int fr, int fq) const {
        asm volatile("" : "+v"(fr), "+v"(fq));
        const int row0 = u.pm * 256 + wr * 64 + fr, lcol = wc * 32 + 8 * fq, col0 = u.ocol + lcol;
        const int pn = u.pn;
        const bool plain = (pn >= 8 && pn < 12) || pn >= 24, isidx = (pn >= 12 && pn < 16), nrm = !plain && !isidx;
        float rsc[2][4];
#pragma unroll
        for (int ai = 0; ai < 2; ++ai)
#pragma unroll
            for (int m = 0; m < 4; ++m) rsc[ai][m] = __builtin_amdgcn_rsqf(rs[row0 + ai * 128 + m * 16] * (1.f / DM) + EPS);
        if (nrm) {
#pragma unroll
            for (int ai = 0; ai < 2; ++ai)
#pragma unroll
                for (int m = 0; m < 4; ++m)
#pragma unroll
                    for (int bj = 0; bj < 2; ++bj) { const f32x4 a = acc[ai][bj][m][0], b = acc[ai][bj][m][1]; float ss = (a[0] * a[0] + a[1] * a[1]) + (a[2] * a[2] + a[3] * a[3]) + (b[0] * b[0] + b[1] * b[1]) + (b[2] * b[2] + b[3] * b[3]);
                        ss += __shfl_xor(ss, 16); ss += __shfl_xor(ss, 32);
                        if (fq == 0) xl[((wr * 64 + fr + ai * 128 + m * 16) * 2 + bj) * 4 + wc] = ss * rsc[ai][m] * rsc[ai][m]; }
            asm volatile("s_waitcnt lgkmcnt(0)" ::: "memory"); __builtin_amdgcn_s_barrier(); asm volatile("" ::: "memory");
        }
        const int i0 = isidx ? (16 * (wc & 1) + 4 * fq) : (16 * wc + 4 * fq);
        const float tod = isidx ? (2.f / 64.f) : (2.f / 128.f);
        float inv[4];
#pragma unroll
        for (int j = 0; j < 4; ++j) inv[j] = __builtin_amdgcn_exp2f(-(float)(i0 + j) * tod * 13.287712379549449f) * 0.15915494309189535f;
        const int gidx = pn < 4 ? 0 : (pn < 8 ? 1 : (pn < 20 ? 2 : 3));
        const float qscale = (pn < 4 || (pn >= 16 && pn < 20)) ? C2_128 : 1.f;
        f32x4 g0 = (f32x4){1.f, 1.f, 1.f, 1.f}, g1 = g0;
        if (nrm) { g0 = *(const f32x4*)(gperm + gidx * 128 + lcol); g1 = *(const f32x4*)(gperm + gidx * 128 + lcol + 4); }
#pragma unroll
        for (int ai = 0; ai < 2; ++ai)
#pragma unroll
            for (int m = 0; m < 4; ++m) { const int row = row0 + ai * 128 + m * 16; bf16_t* rowp = P + (size_t)row * PW + col0;
                float cs[4], sn[4];
                if (!plain) { const float pos = (float)(NMETA + ((row - MBLK) & (SEQ - 1)));
#pragma unroll
                    for (int j = 0; j < 4; ++j) { float rev = pos * inv[j]; rev -= floorf(rev); sn[j] = __builtin_amdgcn_sinf(rev); cs[j] = __builtin_amdgcn_cosf(rev); } }
#pragma unroll
                for (int bj = 0; bj < 2; ++bj) { f32x4 v0 = acc[ai][bj][m][0] * rsc[ai][m], v1 = acc[ai][bj][m][1] * rsc[ai][m];
                    if (!plain) {
                        if (nrm) { const LAS f32x4* xp = (const LAS f32x4*)(xl + ((wr * 64 + fr + ai * 128 + m * 16) * 2 + bj) * 4); const f32x4 pp = *xp;
                            const float rn = __builtin_amdgcn_rsqf(((pp[0] + pp[1]) + (pp[2] + pp[3])) * (1.f / 128.f) + EPS); v0 = v0 * (g0 * rn); v1 = v1 * (g1 * rn); }
                        f32x4 w0, w1;
                        w0[0] = v0[0] * cs[0] - v0[1] * sn[0]; w0[1] = v0[1] * cs[0] + v0[0] * sn[0]; w0[2] = v0[2] * cs[1] - v0[3] * sn[1]; w0[3] = v0[3] * cs[1] + v0[2] * sn[1];
                        w1[0] = v1[0] * cs[2] - v1[1] * sn[2]; w1[1] = v1[1] * cs[2] + v1[0] * sn[2]; w1[2] = v1[2] * cs[3] - v1[3] * sn[3]; w1[3] = v1[3] * cs[3] + v1[2] * sn[3];
                        v0 = w0 * qscale; v1 = w1 * qscale; }
                    u32x4 w; w.x = cvt_pk_bf16(v0[0], v0[1]); w.y = cvt_pk_bf16(v0[2], v0[3]); w.z = cvt_pk_bf16(v1[0], v1[1]); w.w = cvt_pk_bf16(v1[2], v1[3]);
                    *(u32x4*)(rowp + bj * 128) = w; } }
    }
};
struct EpiGate {
    static constexpr bool PERM = true;
    bf16_t* G; const float* bias; const float* rs;
    __device__ __forceinline__ void operator()(const f32x4 (&acc)[2][2][4][2], const Unit& u, int wr, int wc, int fr, int fq) const {
        asm volatile("" : "+v"(fr), "+v"(fq));
        const int row0 = u.pm * 256 + wr * 64 + fr, col0 = u.pn * 256 + wc * 32 + 8 * fq;
        float rsc[2][4];
#pragma unroll
        for (int ai = 0; ai < 2; ++ai)
#pragma unroll
            for (int m = 0; m < 4; ++m) rsc[ai][m] = __builtin_amdgcn_rsqf(rs[row0 + ai * 128 + m * 16] * (1.f / DM) + EPS);
#pragma unroll
        for (int bj = 0; bj < 2; ++bj) { const f32x4 bv0 = *(const f32x4*)(bias + col0 + bj * 128), bv1 = *(const f32x4*)(bias + col0 + bj * 128 + 4);
#pragma unroll
            for (int ai = 0; ai < 2; ++ai)
#pragma unroll
                for (int m = 0; m < 4; ++m) { bf16_t* rowp = G + (size_t)(row0 + ai * 128 + m * 16) * 2048 + col0; f32x4 v0 = acc[ai][bj][m][0] * rsc[ai][m] + bv0, v1 = acc[ai][bj][m][1] * rsc[ai][m] + bv1;
#pragma unroll
                    for (int e = 0; e < 4; ++e) { v0[e] = __builtin_amdgcn_rcpf(1.f + __builtin_amdgcn_exp2f(-v0[e] * LOG2E)); v1[e] = __builtin_amdgcn_rcpf(1.f + __builtin_amdgcn_exp2f(-v1[e] * LOG2E)); }
                    u32x4 w; w.x = cvt_pk_bf16(v0[0], v0[1]); w.y = cvt_pk_bf16(v0[2], v0[3]); w.z = cvt_pk_bf16(v1[0], v1[1]); w.w = cvt_pk_bf16(v1[2], v1[3]);
                    *(u32x4*)(rowp + bj * 128) = w; } }
    }
};
struct EpiGated {
    static constexpr bool PERM = true;
    bf16_t* P; const bf16_t* G; int first; float sc;
    __device__ __forceinline__ void operator()(const f32x4 (&acc)[2][2][4][2], const Unit& u, int wr, int wc, int fr, int fq) const {
        asm volatile("" : "+v"(fr), "+v"(fq));
        const int row0 = u.pm * 256 + wr * 64 + fr, lcol0 = u.pn * 256 + wc * 32 + 8 * fq, col0 = u.ocol + wc * 32 + 8 * fq;
        unsigned zu = 0u; asm volatile("" : "+v"(zu));
#pragma unroll
        for (int ai = 0; ai < 2; ++ai)
#pragma unroll
            for (int m = 0; m < 4; ++m) { bf16_t* rowp = P + (size_t)(row0 + ai * 128 + m * 16) * PW + col0; const bf16_t* gp = G + (size_t)(row0 + ai * 128 + m * 16) * 2048 + lcol0;
#pragma unroll
                for (int bj = 0; bj < 2; ++bj) { u32x4 g = *(const u32x4*)(gp + bj * 128); if (DBG_BR == 1) g = (u32x4){0x3f803f80u, 0x3f803f80u, 0x3f803f80u, 0x3f803f80u};
                    u32x4 pv = (u32x4){zu, zu, zu, zu}; if (!first) pv = *(const u32x4*)(rowp + bj * 128);
                    const f32x4 v0 = acc[ai][bj][m][0] * sc, v1 = acc[ai][bj][m][1] * sc;
                    float o[8];
                    o[0] = __uint_as_float(pv.x << 16) + __uint_as_float(g.x << 16) * v0[0]; o[1] = __uint_as_float(pv.x & 0xffff0000u) + __uint_as_float(g.x & 0xffff0000u) * v0[1];
                    o[2] = __uint_as_float(pv.y << 16) + __uint_as_float(g.y << 16) * v0[2]; o[3] = __uint_as_float(pv.y & 0xffff0000u) + __uint_as_float(g.y & 0xffff0000u) * v0[3];
                    o[4] = __uint_as_float(pv.z << 16) + __uint_as_float(g.z << 16) * v1[0]; o[5] = __uint_as_float(pv.z & 0xffff0000u) + __uint_as_float(g.z & 0xffff0000u) * v1[1];
                    o[6] = __uint_as_float(pv.w << 16) + __uint_as_float(g.w << 16) * v1[2]; o[7] = __uint_as_float(pv.w & 0xffff0000u) + __uint_as_float(g.w & 0xffff0000u) * v1[3];
                    u32x4 w; w.x = cvt_pk_bf16(o[0], o[1]); w.y = cvt_pk_bf16(o[2], o[3]); w.z = cvt_pk_bf16(o[4], o[5]); w.w = cvt_pk_bf16(o[6], o[7]);
                    *(u32x4*)(rowp + bj * 128) = w; }
                asm volatile("" ::: "memory"); }
    }
};
struct EpiRes {
    static constexpr bool PERM = false;
    const float* base_tok; float* out_tok; float* hmeta; float dbg; bf16_t* hb; float* rs;
    __device__ __forceinline__ void operator()(const f32x4 (&acc)[2][2][4][2], const Unit& u, int wr, int wc, int fr, int fq) const {
        asm volatile("" : "+v"(fr), "+v"(fq));
        const float* bp; float* op;
        if (u.pm == 0) { bp = hmeta; op = hmeta; } else { bp = base_tok + (size_t)(u.pm - 1) * 256 * DM; op = out_tok + (size_t)(u.pm - 1) * 256 * DM; }
        const int lrow0 = wr * 64 + fr, col0 = u.pn * 256 + wc * 32 + 4 * fq;
#pragma unroll
        for (int ai = 0; ai < 2; ++ai)
#pragma unroll
            for (int m = 0; m < 4; ++m) { const size_t off = (size_t)(lrow0 + ai * 128 + m * 16) * DM + col0;
                const int grow = u.pm * 256 + lrow0 + ai * 128 + m * 16; float ss = 0.f;
#pragma unroll
                for (int bj = 0; bj < 2; ++bj)
#pragma unroll
                    for (int n = 0; n < 2; ++n) { const f32x4 bs = *(const f32x4*)(bp + off + bj * 128 + n * 16); const f32x4 hv = bs + acc[ai][bj][m][n] * dbg; *(f32x4*)(op + off + bj * 128 + n * 16) = hv;
                        if (hb) { ss += (hv[0] * hv[0] + hv[1] * hv[1]) + (hv[2] * hv[2] + hv[3] * hv[3]); u32x2 w; w.x = cvt_pk_bf16(hv[0], hv[1]); w.y = cvt_pk_bf16(hv[2], hv[3]); *(u32x2*)(hb + (size_t)grow * DM + col0 + bj * 128 + n * 16) = w; } }
                if (hb) { ss += __shfl_xor(ss, 16); ss += __shfl_xor(ss, 32); if (fq == 0) (void)__hip_atomic_fetch_add(rs + grow, ss, __ATOMIC_RELAXED, __HIP_MEMORY_SCOPE_AGENT); }
                asm volatile("" ::: "memory"); }
    }
};
struct EpiSwiglu {
    static constexpr bool PERM = true;
    bf16_t* P; const float* rs;
    __device__ __forceinline__ void operator()(const f32x4 (&acc)[2][2][4][2], const Unit& u, int wr, int wc, int fr, int fq) const {
        asm volatile("" : "+v"(fr), "+v"(fq));
        const int row0 = u.pm * 256 + wr * 64 + fr, col0 = u.pn * 128 + wc * 32 + 8 * fq;
#pragma unroll
        for (int ai = 0; ai < 2; ++ai)
#pragma unroll
            for (int m = 0; m < 4; ++m) { bf16_t* rowp = P + (size_t)(row0 + ai * 128 + m * 16) * PW + col0;
                const float sc = __builtin_amdgcn_rsqf(rs[row0 + ai * 128 + m * 16] * (1.f / DM) + EPS);
                float o[8];
#pragma unroll
                for (int n = 0; n < 2; ++n)
#pragma unroll
                    for (int e = 0; e < 4; ++e) { const float g = acc[ai][0][m][n][e] * sc, up = acc[ai][1][m][n][e] * sc; o[n * 4 + e] = g * __builtin_amdgcn_rcpf(1.f + __builtin_amdgcn_exp2f(-g * LOG2E)) * up; }
                u32x4 w; w.x = cvt_pk_bf16(o[0], o[1]); w.y = cvt_pk_bf16(o[2], o[3]); w.z = cvt_pk_bf16(o[4], o[5]); w.w = cvt_pk_bf16(o[6], o[7]);
                *(u32x4*)rowp = w; }
    }
};

struct SkP { bf16_t* P; int ocol; const float* rs; __device__ __forceinline__ void operator()(int r, int c, float v) const { if (rs) v *= __builtin_amdgcn_rsqf(rs[MROW0 + r] * (1.f / DM) + EPS); P[(size_t)(MROW0 + r) * PW + ocol + c] = (bf16_t)f2bf(v); } };
struct SkGate { bf16_t* G; const float* bias; const float* rs; __device__ __forceinline__ void operator()(int r, int c, float v) const { v *= __builtin_amdgcn_rsqf(rs[MROW0 + r] * (1.f / DM) + EPS); G[(size_t)(MROW0 + r) * 2048 + c] = (bf16_t)f2bf(__builtin_amdgcn_rcpf(1.f + __builtin_amdgcn_exp2f(-(v + bias[c]) * LOG2E))); } };
struct SkGated { bf16_t* P; const bf16_t* G; int first; __device__ __forceinline__ void operator()(int r, int c, float v) const { bf16_t* p = P + (size_t)(MROW0 + r) * PW + C_MERGED + c; const float pv = first ? 0.f : bf2f(*p); *p = (bf16_t)f2bf(pv + bf2f(G[(size_t)(MROW0 + r) * 2048 + c]) * v); } };
struct SkRes { float* hmeta; bf16_t* hb; float* rs;
    __device__ __forceinline__ void operator()(int r, int c, float v) const { float* p = hmeta + (size_t)(MROW0 + r) * DM + c; const float hv = *p + v; *p = hv;
        if (hb) { hb[(size_t)(MROW0 + r) * DM + c] = (bf16_t)f2bf(hv); float ss = hv * hv; ss += __shfl_xor(ss, 1); ss += __shfl_xor(ss, 2); ss += __shfl_xor(ss, 4); ss += __shfl_xor(ss, 8);
            if ((threadIdx.x & 15) == 0) (void)__hip_atomic_fetch_add(rs + MROW0 + r, ss, __ATOMIC_RELAXED, __HIP_MEMORY_SCOPE_AGENT); } } };
template <class Fn>
__device__ __forceinline__ void skinny_gemm(LAS unsigned char* lds, const bf16_t* A, int lda, const bf16_t* Bt, int K, int ntask, int bid, int G, const Fn& f) {
    int tid = threadIdx.x; asm volatile("" : "+v"(tid));
    const int wid = __builtin_amdgcn_readfirstlane(tid >> 6), lane = tid & 63, l15 = lane & 15, kq = lane >> 4;
    LAS f32x4* red = (LAS f32x4*)lds;
    const int kw = K / 8;
    for (int task = bid; task < ntask; task += G) {
        const bf16_t* ap = A + (size_t)l15 * lda + wid * kw + kq * 8;
        const bf16_t* bp = Bt + (size_t)(task * 16 + l15) * K + wid * kw + kq * 8;
        float z = 0.f; asm volatile("" : "+v"(z));
        f32x4 acc = (f32x4){z, z, z, z};
        for (int k0 = 0; k0 < kw; k0 += 256) {
            bf16x8 fa[8], fb[8];
#pragma unroll
            for (int i = 0; i < 8; ++i) { const int k = (k0 + 32 * i < kw) ? k0 + 32 * i : 0; fa[i] = *(const bf16x8*)(ap + k); fb[i] = *(const bf16x8*)(bp + k); }
#pragma unroll
            for (int i = 0; i < 8; ++i) if (k0 + 32 * i < kw) acc = __builtin_amdgcn_mfma_f32_16x16x32_bf16(fa[i], fb[i], acc, 0, 0, 0);
        }
        red[wid * 64 + lane] = acc;
        LDS_WAIT(); __syncthreads();
        if (wid == 0) {
            f32x4 s = red[lane];
#pragma unroll
            for (int w = 1; w < 8; ++w) s += red[w * 64 + lane];
#pragma unroll
            for (int r = 0; r < 4; ++r) f(kq * 4 + r, task * 16 + l15, s[r]);
        }
        __syncthreads();
    }
}
__device__ __forceinline__ void skinny_swiglu(LAS unsigned char* lds, const bf16_t* A, int lda, const bf16_t* Bt, int K, bf16_t* P, const float* rs, int bid, int G) {
    int tid = threadIdx.x; asm volatile("" : "+v"(tid));
    const int wid = __builtin_amdgcn_readfirstlane(tid >> 6), lane = tid & 63, l15 = lane & 15, kq = lane >> 4;
    LAS f32x4* red = (LAS f32x4*)lds;
    const int kw = K / 8;
    for (int task = bid; task < DFF / 16; task += G) {
        const int c0 = task * 16, brow = (c0 >> 7) * 256 + (c0 & 127) + l15;
        const bf16_t* ap = A + (size_t)l15 * lda + wid * kw + kq * 8;
        const bf16_t* bg = Bt + (size_t)brow * K + wid * kw + kq * 8; const bf16_t* bu = bg + (size_t)128 * K;
        float z = 0.f; asm volatile("" : "+v"(z));
        f32x4 ag = (f32x4){z, z, z, z}, au = ag;
        {
            bf16x8 fa[8], fg[8], fu[8];
#pragma unroll
            for (int i = 0; i < 8; ++i) { fa[i] = *(const bf16x8*)(ap + 32 * i); fg[i] = *(const bf16x8*)(bg + 32 * i); fu[i] = *(const bf16x8*)(bu + 32 * i); }
#pragma unroll
            for (int i = 0; i < 8; ++i) { ag = __builtin_amdgcn_mfma_f32_16x16x32_bf16(fa[i], fg[i], ag, 0, 0, 0); au = __builtin_amdgcn_mfma_f32_16x16x32_bf16(fa[i], fu[i], au, 0, 0, 0); }
        }
        red[wid * 64 + lane] = ag; red[512 + wid * 64 + lane] = au;
        LDS_WAIT(); __syncthreads();
        if (wid == 0) {
            f32x4 sg = red[lane], su = red[512 + lane];
#pragma unroll
            for (int w = 1; w < 8; ++w) { sg += red[w * 64 + lane]; su += red[512 + w * 64 + lane]; }
#pragma unroll
            for (int r = 0; r < 4; ++r) { const float sc = __builtin_amdgcn_rsqf(rs[MROW0 + kq * 4 + r] * (1.f / DM) + EPS); const float g = sg[r] * sc; su[r] *= sc; P[(size_t)(MROW0 + kq * 4 + r) * PW + c0 + l15] = (bf16_t)f2bf(g * __builtin_amdgcn_rcpf(1.f + __builtin_amdgcn_exp2f(-g * LOG2E)) * su[r]); }
        }
        __syncthreads();
    }
}

#define XB_TMO      128
#define XB_XCNT(j)  (256  + 64 * (j))
#define XB_XSUB(j)  (1280 + 64 * (j))
#define XB_XGEN(j)  (2304 + 64 * (j))
#define XB_TOP      3328
#define XB_TOPGEN   3392
#define XCD_BAR_WORDS 3456
#define XB_SPIN_CAP (1u << 18)
__device__ __forceinline__ unsigned xb_ld(unsigned* p)              { return __hip_atomic_load(p, __ATOMIC_RELAXED, __HIP_MEMORY_SCOPE_AGENT); }
__device__ __forceinline__ unsigned xb_add(unsigned* p, unsigned v) { return __hip_atomic_fetch_add(p, v, __ATOMIC_RELAXED, __HIP_MEMORY_SCOPE_AGENT); }
__device__ __forceinline__ unsigned xb_xcc_id() { return (unsigned)__builtin_amdgcn_s_getreg((3 << 11) | 20) & 0xFu; }
#define XB_SPIN(cond, bar) do { unsigned _sp = 0; while (cond) { __builtin_amdgcn_s_sleep(1); \
    if ((++_sp & 255u) == 0u) { if (xb_ld(&(bar)[XB_TMO])) break; if (_sp > XB_SPIN_CAP) { atomicAdd(&(bar)[XB_TMO], 1u); break; } } } } while (0)
struct XcdBarrier { unsigned* bar; unsigned x; volatile LAS unsigned* st; };
__device__ __forceinline__ XcdBarrier xcd_barrier_post(unsigned* bar, volatile LAS unsigned* st) {
    XcdBarrier b; b.bar = bar; b.x = xb_xcc_id(); b.st = st;
    if (threadIdx.x == 0) (void)xb_add(&bar[XB_XCNT(b.x)], 1u);
    return b;
}
__device__ __forceinline__ void xcd_barrier_complete(unsigned* bar, unsigned x, unsigned& nloc, unsigned& nx) {
    const unsigned G = gridDim.x * gridDim.y * gridDim.z;
    unsigned sum, cnt, mine, sp = 0u;
    for (;;) {
        sum = 0u; cnt = 0u; mine = 0u;
#pragma unroll
        for (unsigned j = 0; j < 16; ++j) { const unsigned c = xb_ld(&bar[XB_XCNT(j)]); sum += c; cnt += (c > 0u) ? 1u : 0u; mine = (j == x) ? c : mine; }
        if (sum == G) break;
        __builtin_amdgcn_s_sleep(1);
        if ((++sp & 255u) == 0u) { if (xb_ld(&bar[XB_TMO])) break; if (sp > XB_SPIN_CAP) { atomicAdd(&bar[XB_TMO], 1u); break; } }
    }
    nloc = mine > 0u ? mine : 1u; nx = cnt > 0u ? cnt : 1u;
}
__device__ __forceinline__ void xcd_barrier(const XcdBarrier& b) {
    asm volatile("s_waitcnt vmcnt(0)" ::: "memory");
    __syncthreads();
    if (threadIdx.x == 0) {
        unsigned* bar = b.bar;
        __builtin_amdgcn_s_waitcnt(0);
        unsigned nloc = b.st[0], nx = b.st[1];
        if (nloc == 0u) { xcd_barrier_complete(bar, b.x, nloc, nx); b.st[0] = nloc; b.st[1] = nx; }
        const unsigned old = xb_add(&bar[XB_XSUB(b.x)], 1u);
        const unsigned gen = old / nloc;
        if (old + 1u == (gen + 1u) * nloc) {
            __builtin_amdgcn_fence(__ATOMIC_RELEASE, "agent");
            asm volatile("s_waitcnt vmcnt(0)" ::: "memory");
            const unsigned og = xb_add(&bar[XB_TOP], 1u);
            const unsigned tg = og / nx;
            if (og + 1u == (tg + 1u) * nx) xb_add(&bar[XB_TOPGEN], 1u);
            else XB_SPIN(xb_ld(&bar[XB_TOPGEN]) == tg, bar);
            __builtin_amdgcn_fence(__ATOMIC_ACQUIRE, "agent");
            xb_add(&bar[XB_XGEN(b.x)], 1u);
            asm volatile("s_waitcnt vmcnt(0)" ::: "memory");
        } else {
            XB_SPIN(xb_ld(&bar[XB_XGEN(b.x)]) == gen, bar);
            __builtin_amdgcn_fence(__ATOMIC_ACQUIRE, "agent");
            asm volatile("s_waitcnt vmcnt(0)" ::: "memory");
        }
    }
    __syncthreads();
}

constexpr int NWAVES = 8;
constexpr int RING_BYTES = 131072, LDS_BYTES = 147456, LDSCTL_OFF = LDS_BYTES - 512;
struct Args {
    const float* in[19]; float* out; unsigned char* ws; int ph_lo, ph_hi;
};
struct Ctx {
    LAS unsigned char* lds; int tid, lane, wave, gw, ngw, G, bid;
};

template <int MAP> __device__ __forceinline__ int wmap(int n, float& sc) {
    sc = 1.f;
    if (MAP == 0) return n;
    if (MAP == 1) {
        if (n < 1088) return n;
        if (n < 3136) { const int m = n - 1088, d = m & 127; return 1280 + (m - d) + (d < 64 ? 2 * d : 2 * (d - 64) + 1); }
        if (n < 4160) return 1280 + (n - 1088);
        if (n < 5184) { const int m = n - 4160, d = m & 63; return 4352 + (m - d) + (d < 32 ? 2 * d : 2 * (d - 32) + 1); }
        if (n < 5248) { const int d = n - 5184; return 1088 + (d < 32 ? 2 * d : 2 * (d - 32) + 1); }
        if (n < 5264) { sc = 0.03125f; return 1152 + (n - 5248); }
        if (n < 7312) { const int m = n - 5264, d = m & 127; return 5376 + (m - d) + (d < 64 ? 2 * d : 2 * (d - 64) + 1); }
        if (n < 8336) return 5376 + (n - 5264);
        return 8448 + (n - 8336);
    }
    if (n < DFF) return (n >> 7) * 256 + (n & 127);
    const int m = n - DFF; return (m >> 7) * 256 + 128 + (m & 127);
}
template <int MAP> __device__ __forceinline__ void conv_item(const float* W, int K, int N, bf16_t* WT, const float* gain, LAS float* scr, int item, int lane) {
    const int nblk = (N + 31) / 32, kb = item / nblk, nb = item - kb * nblk, k0 = 64 * kb, n0 = 32 * nb;
    const int nn = n0 + (lane & 31);
    float wv[32];
#pragma unroll
    for (int i = 0; i < 32; ++i) { const int kk = 2 * i + (lane >> 5); wv[i] = (nn < N) ? W[(size_t)(k0 + kk) * N + nn] : 0.f; }
#pragma unroll
    for (int i = 0; i < 32; ++i) { const int kk = 2 * i + (lane >> 5); float v = wv[i]; if (gain) v *= gain[k0 + kk]; scr[kk * 33 + (lane & 31)] = v; }
    LDS_WAIT(); asm volatile("" ::: "memory");
    const int c = lane & 7;
#pragma unroll
    for (int j = 0; j < 4; ++j) { const int n = (lane >> 3) + 8 * j; const int ns = n0 + n;
        if (ns < N) { float sc; const int dst = wmap<MAP>(ns, sc); const LAS float* s = scr + (8 * c) * 33 + n;
            u32x4 o; o.x = pk2(s[0 * 33] * sc, s[1 * 33] * sc); o.y = pk2(s[2 * 33] * sc, s[3 * 33] * sc); o.z = pk2(s[4 * 33] * sc, s[5 * 33] * sc); o.w = pk2(s[6 * 33] * sc, s[7 * 33] * sc);
            *(u32x4*)(WT + (size_t)dst * K + k0 + 8 * c) = o; } }
    LDS_WAIT(); asm volatile("" ::: "memory");
}
template <int MAP> __device__ __forceinline__ void conv_matrix(const Ctx& F, const float* W, int K, int N, bf16_t* WT, const float* gain) {
    LAS float* scr = (LAS float*)(F.lds + F.wave * 16384);
    const int nit = (K / 64) * ((N + 31) / 32);
    for (int it = F.gw; it < nit; it += F.ngw) conv_item<MAP>(W, K, N, WT, gain, scr, it, F.lane);
}

__device__ __forceinline__ void norm_row(const float* hrow, bf16_t* orow, float* rs_row, int lane) {
    f32x4 v[8]; float s = 0.f;
#pragma unroll
    for (int j = 0; j < 8; ++j) { v[j] = *((const f32x4*)hrow + lane + 64 * j); s += (v[j].x * v[j].x + v[j].y * v[j].y) + (v[j].z * v[j].z + v[j].w * v[j].w); }
    s = wave_sum(s);
    if (lane == 0) *rs_row = s;
#pragma unroll
    for (int j = 0; j < 8; ++j) { u32x2 o; o.x = cvt_pk_bf16(v[j].x, v[j].y); o.y = cvt_pk_bf16(v[j].z, v[j].w); *((u32x2*)orow + lane + 64 * j) = o; }
}

__device__ __forceinline__ void post1a_row(const bf16_t* P, int r, float* rstdq, float* rstdkv, int lane) {
    const bf16_t* p = P + (size_t)r * PW;
    const u32x4 a = *((const u32x4*)(p + C_CQ) + lane), b = *((const u32x4*)(p + C_CKV) + lane);
    float sa = 0.f, sb = 0.f;
#pragma unroll
    for (int e = 0; e < 4; ++e) { const float x0 = __uint_as_float(a[e] << 16), x1 = __uint_as_float(a[e] & 0xffff0000u); sa += x0 * x0 + x1 * x1;
        const float y0 = __uint_as_float(b[e] << 16), y1 = __uint_as_float(b[e] & 0xffff0000u); sb += y0 * y0 + y1 * y1; }
    sa = wave_sum(sa); sb = wave_sum(sb);
    if (lane == 0) { rstdq[r] = 1.0f / sqrtf(sa * (1.f / 512.f) + EPS); rstdkv[r] = 1.0f / sqrtf(sb * (1.f / 512.f) + EPS); }
    { unsigned* ikp = (unsigned*)(P + (size_t)r * PW + C_IK) + (lane & 31); const unsigned w = *ikp; const float x1 = __uint_as_float(w << 16), x2 = __uint_as_float(w & 0xffff0000u);
      float cs, sn; rope_cs(row_pos(r), lane & 31, 2.f / 64.f, cs, sn);
      if (lane < 32) *ikp = cvt_pk_bf16(x1 * cs - x2 * sn, x2 * cs + x1 * sn); }
}
__device__ __forceinline__ void meta_post_row(bf16_t* P, int r, const float* gperm, int lane) {
    bf16_t* p = P + (size_t)r * PW; const int pos = row_pos(r);
    float c128, s128, c64, s64; rope_cs(pos, lane, 2.f / 128.f, c128, s128); rope_cs(pos, lane & 31, 2.f / 64.f, c64, s64);
#pragma unroll 1
    for (int t = 0; t < 4; ++t) {
        const int cb = t == 0 ? C_DQ : (t == 1 ? C_DK : (t == 2 ? C_FQ : C_FK)); const float sc = (t == 0 || t == 2) ? C2_128 : 1.f;
        const float ga = gperm[t * 128 + 2 * lane], gb = gperm[t * 128 + 2 * lane + 1];
#pragma unroll 1
        for (int h = 0; h < 8; ++h) { unsigned* xp = (unsigned*)(p + cb + h * 128) + lane; const unsigned w = *xp; float x1 = __uint_as_float(w << 16), x2 = __uint_as_float(w & 0xffff0000u);
            const float rn = __builtin_amdgcn_rsqf(wave_sum(x1 * x1 + x2 * x2) * (1.f / 128.f) + EPS); x1 *= rn * ga; x2 *= rn * gb;
            *xp = cvt_pk_bf16((x1 * c128 - x2 * s128) * sc, (x2 * c128 + x1 * s128) * sc); }
    }
#pragma unroll 1
    for (int hh = 0; hh < 8; ++hh) { unsigned* xp = (unsigned*)(p + C_IQ + hh * 128) + lane; const unsigned w = *xp; const float x1 = __uint_as_float(w << 16), x2 = __uint_as_float(w & 0xffff0000u);
        *xp = cvt_pk_bf16(x1 * c64 - x2 * s64, x2 * c64 + x1 * s64); }
}
__device__ __forceinline__ void unpack8(const u32x4& w, float (&x)[8]) {
#pragma unroll
    for (int e = 0; e < 4; ++e) { x[2 * e] = __uint_as_float(w[e] << 16); x[2 * e + 1] = __uint_as_float(w[e] & 0xffff0000u); }
}
__device__ __forceinline__ u32x4 pack8(const float (&x)[8]) { u32x4 w; w.x = cvt_pk_bf16(x[0], x[1]); w.y = cvt_pk_bf16(x[2], x[3]); w.z = cvt_pk_bf16(x[4], x[5]); w.w = cvt_pk_bf16(x[6], x[7]); return w; }
__device__ __forceinline__ u32x4 shfl_xor4(const u32x4& w, int m) { u32x4 r; r.x = __shfl_xor(w.x, m); r.y = __shfl_xor(w.y, m); r.z = __shfl_xor(w.z, m); r.w = __shfl_xor(w.w, m); return r; }
__device__ __forceinline__ void post2_row(bf16_t* P, int r, const float* rstdq, const float* rstdkv, const float* qkg  , LAS float* rnl, int lane) {
    bf16_t* p = P + (size_t)r * PW;
    const float sq = rstdq[r], skv = rstdkv[r];
    const int pos = row_pos(r), hw = lane >> 5, l5 = lane & 31;
    float c64[8], s64[8];
#pragma unroll
    for (int j = 0; j < 8; ++j) rope_cs(pos, 8 * (lane & 3) + j, 2.f / 64.f, c64[j], s64[j]);
    float kp[8]; { const u32x4 w = *(const u32x4*)(p + C_KPE + (lane & 7) * 8); unpack8(w, kp); }
    float kpe_ss = 0.f;
#pragma unroll
    for (int j = 0; j < 8; ++j) kpe_ss += kp[j] * kp[j];
    kpe_ss += __shfl_xor(kpe_ss, 1); kpe_ss += __shfl_xor(kpe_ss, 2); kpe_ss += __shfl_xor(kpe_ss, 4);
    u32x4 rq[4], rkv[4];
#pragma unroll
    for (int it = 0; it < 4; ++it) { const int h = 2 * it + hw; rq[it] = *(const u32x4*)(p + C_QRAW + h * 192 + (l5 < 24 ? l5 : 0) * 8); rkv[it] = *(const u32x4*)(p + C_KVRAW + h * 256 + l5 * 8); }
#pragma unroll
    for (int it = 0; it < 4; ++it) {
        const int h = 2 * it + hw; const bool act = l5 < 24;
        u32x4* ptr = (u32x4*)(p + C_QRAW + h * 192 + (act ? l5 : 0) * 8);
        float x[8]; unpack8(rq[it], x);
        float ss = 0.f;
#pragma unroll
        for (int j = 0; j < 8; ++j) { x[j] *= sq; ss += x[j] * x[j]; }
        if (!act) ss = 0.f;
#pragma unroll
        for (int o = 1; o < 32; o <<= 1) ss += __shfl_xor(ss, o);
        const float rn = 1.0f / sqrtf(ss * (1.f / 192.f) + EPS);
        const int gi = (act ? l5 : 0) * 8;
        const f32x4 g0 = *(const f32x4*)(qkg + gi), g1 = *(const f32x4*)(qkg + gi + 4);
#pragma unroll
        for (int j = 0; j < 4; ++j) { x[j] *= rn * g0[j]; x[4 + j] *= rn * g1[j]; }
        float o[8];
#pragma unroll
        for (int j = 0; j < 8; ++j) { const float pr = __shfl_xor(x[j], 4); const float rot = (l5 & 4) ? (x[j] * c64[j] + pr * s64[j]) : (x[j] * c64[j] - pr * s64[j]); o[j] = (l5 >= 16 ? rot : x[j]) * C2_192; }
        if (act) *ptr = pack8(o);
    }
#pragma unroll
    for (int it = 0; it < 4; ++it) {
        const int h = 2 * it + hw; const bool isk = l5 < 16;
        u32x4* ptr = (u32x4*)(p + C_KVRAW + h * 256 + l5 * 8);
        float x[8]; unpack8(rkv[it], x);
        float ss = 0.f;
#pragma unroll
        for (int j = 0; j < 8; ++j) { x[j] *= skv; ss += x[j] * x[j]; }
        if (!isk) ss = 0.f;
#pragma unroll
        for (int o = 1; o < 32; o <<= 1) ss += __shfl_xor(ss, o);
        const float rn = 1.0f / sqrtf((ss + kpe_ss) * (1.f / 192.f) + EPS);
        if (l5 == 0) rnl[h] = rn;
        const int gi = 192 + (isk ? l5 : 0) * 8;
        const f32x4 g0 = *(const f32x4*)(qkg + gi), g1 = *(const f32x4*)(qkg + gi + 4);
        float o[8];
#pragma unroll
        for (int j = 0; j < 4; ++j) { o[j] = isk ? x[j] * rn * g0[j] : x[j]; o[4 + j] = isk ? x[4 + j] * rn * g1[j] : x[4 + j]; }
        *ptr = pack8(o);
    }
    LDS_WAIT(); asm volatile("" ::: "memory");
    { const int hd = lane >> 3, c = lane & 7; const float rn = rnl[hd];
      const f32x4 g0 = *(const f32x4*)(qkg + 192 + 128 + c * 8), g1 = *(const f32x4*)(qkg + 192 + 128 + c * 8 + 4);
      float x[8], o[8];
#pragma unroll
      for (int j = 0; j < 4; ++j) { x[j] = kp[j] * rn * g0[j]; x[4 + j] = kp[4 + j] * rn * g1[j]; }
#pragma unroll
      for (int j = 0; j < 8; ++j) { const float pr = __shfl_xor(x[j], 4); o[j] = (c & 4) ? (x[j] * c64[j] + pr * s64[j]) : (x[j] * c64[j] - pr * s64[j]); }
      *(u32x4*)(p + C_KPEH + hd * 64 + c * 8) = pack8(o); }
    LDS_WAIT(); asm volatile("" ::: "memory");
}
__device__ __forceinline__ void post3_row(bf16_t* P, int r, const float* subg, float lam, float omli, int lane) {
    bf16_t* p = P + (size_t)r * PW;
    const int hw = lane >> 5, l5 = lane & 31;
    u32x4 rr[4];
#pragma unroll
    for (int h = 0; h < 4; ++h) rr[h] = *(const u32x4*)(p + (hw ? C_IQ : C_FQ) + h * 256 + l5 * 8);
#pragma unroll
    for (int h = 0; h < 4; ++h) {
        const u32x4 raw = rr[h];
        const u32x4 praw = shfl_xor4(raw, 16);
        float a[8], b[8]; unpack8(raw, a); unpack8(praw, b);
        float d[8], ss = 0.f;
#pragma unroll
        for (int j = 0; j < 8; ++j) { d[j] = a[j] - lam * b[j]; ss += d[j] * d[j]; }
        if (l5 >= 16) ss = 0.f;
#pragma unroll
        for (int o = 1; o < 64; o <<= 1) ss += __shfl_xor(ss, o);
        const float rn = omli / sqrtf(ss * (1.f / 256.f) + EPS);
        const int dim = hw * 128 + (l5 & 15) * 8;
        const f32x4 g0 = *(const f32x4*)(subg + dim), g1 = *(const f32x4*)(subg + dim + 4);
        float o[8];
#pragma unroll
        for (int j = 0; j < 4; ++j) { o[j] = d[j] * rn * g0[j]; o[4 + j] = d[4 + j] * rn * g1[j]; }
        if (l5 < 16) *(u32x4*)(p + C_OC + h * 256 + dim) = pack8(o);
    }
}

__device__ __forceinline__ void index_unit(const bf16_t* P, int unit, unsigned* bm, LAS unsigned char* lds) {
    typedef float f32x16 __attribute__((ext_vector_type(16)));
    int tid = threadIdx.x; asm volatile("" : "+v"(tid));
    const int wid = __builtin_amdgcn_readfirstlane(tid >> 6), lane = tid & 63, j = lane & 31, hi = lane >> 5;
    const int tb = 255 - (unit >> 4), b = unit & 15, t0 = tb * 8, tokbase = MBLK + b * SEQ;
    const int wmax = (64 + t0 + 7) >> 5;
    LAS unsigned* keys = (LAS unsigned*)lds;
    LAS float* iwl = (LAS float*)(lds + 8 * 2112 * 4);
    if (t0 + 7 + 17 > 256) {
        if (tid < 128) iwl[tid] = bf2f(P[(size_t)(tokbase + t0 + (tid >> 4)) * PW + C_IW + (tid & 15)]);
        LAS unsigned char* al = lds + 8 * 2112 * 4 + 512;
        { const int id0 = tid * 2;
#pragma unroll
          for (int e = 0; e < 2; ++e) { const int id = id0 + e, rw = id >> 3, c = id & 7;
              *(LAS bf16x8*)(al + rw * 144 + c * 16) = *(const bf16x8*)(P + (size_t)(tokbase + t0 + (rw >> 4)) * PW + C_IQ + (rw & 15) * 64 + c * 8); } }
        LDS_WAIT(); __syncthreads();
        bf16x8 af[4][4];
        { const int qa = (j >> 2) & 1, ha = (j & 3) + 4 * (j >> 3);
#pragma unroll
          for (int blk = 0; blk < 4; ++blk)
#pragma unroll
              for (int s = 0; s < 4; ++s) af[blk][s] = *(const LAS bf16x8*)(al + ((2 * blk + qa) * 16 + ha) * 144 + s * 32 + hi * 16); }
        const unsigned boff = (unsigned)(j * PW + C_IK + hi * 8) * 2u;
        for (int w = wid; w <= wmax; w += 8) {
            const int kr_ = w < 2 ? (MBLK - 64) + 32 * w : tokbase + 32 * (w - 2); const char* bp_ = (const char*)(P + (size_t)kr_ * PW) + boff;
            bf16x8 bf[4];
#pragma unroll
            for (int s = 0; s < 4; ++s) bf[s] = *(const bf16x8*)(bp_ + s * 32);
            const int kidx = 32 * w + j;
#pragma unroll
            for (int blk = 0; blk < 4; ++blk) {
                f32x16 acc = (f32x16){0.f,0.f,0.f,0.f,0.f,0.f,0.f,0.f,0.f,0.f,0.f,0.f,0.f,0.f,0.f,0.f};
#pragma unroll
                for (int s = 0; s < 4; ++s) acc = __builtin_amdgcn_mfma_f32_32x32x16_bf16(af[blk][s], bf[s], acc, 0, 0, 0);
                const int q = 2 * blk + hi;
                const LAS f32x4* iwq = (const LAS f32x4*)(iwl + q * 16);
                float score = 0.f;
#pragma unroll
                for (int g = 0; g < 4; ++g) { const f32x4 wv = iwq[g]; score += fmaxf(acc[4 * g], 0.f) * wv.x + fmaxf(acc[4 * g + 1], 0.f) * wv.y + fmaxf(acc[4 * g + 2], 0.f) * wv.z + fmaxf(acc[4 * g + 3], 0.f) * wv.w; }
                const bool valid = kidx >= 48 && kidx <= 64 + t0 + q; const unsigned u_ = __float_as_uint(score);
                keys[q * 2112 + kidx] = valid ? ((u_ & 0x80000000u) ? ~u_ : (u_ | 0x80000000u)) : 0u;
            }
        }
        LDS_WAIT(); __syncthreads();
    }
    const int tq = t0 + wid, qk = 64 + tq, nch = qk / 64 + 1;
    unsigned* out = bm + (size_t)(b * SEQ + tq) * BMW;
    if (tq + 17 <= 256) {
        for (int c = 0; c < 33; ++c) { const int kidx = 64 * c + lane; const unsigned long long m = __ballot(kidx >= 48 && kidx <= qk);
            if (lane == 0) { out[2 * c] = (unsigned)m; out[2 * c + 1] = (unsigned)(m >> 32); } }
    } else {
        unsigned kreg[33];
#pragma unroll
        for (int c = 0; c < 33; ++c) kreg[c] = (c < nch && 64 * c + lane <= qk) ? keys[wid * 2112 + 64 * c + lane] : 0u;
        unsigned T = 0u;
        for (int bit = 31; bit >= 0; --bit) {
            const unsigned cand = T | (1u << bit); int cnt = 0;
#pragma unroll
            for (int c = 0; c < 33; ++c) cnt += __popcll(__ballot(kreg[c] >= cand));
            if (cnt >= 256) T = cand;
            if (cnt == 256) break;
        }
#pragma unroll
        for (int c = 0; c < 33; ++c) { const unsigned long long m = __ballot(kreg[c] >= T && kreg[c] != 0u);
            if (lane == 0) { out[2 * c] = (unsigned)m; out[2 * c + 1] = (unsigned)(m >> 32); } }
    }
    LDS_WAIT();
}

namespace fa {
typedef float f32x16 __attribute__((ext_vector_type(16)));
typedef short s16x4 __attribute__((ext_vector_type(4)));
__device__ __forceinline__ int crow(int r, int hi) { return (r & 3) + 8 * (r >> 2) + 4 * hi; }
__device__ __forceinline__ int v_st(int k, int c) { const int kk = (k & ~0xC) | ((k & 4) << 1) | ((k & 8) >> 1); return ((kk >> 3) * 4 + (c >> 5)) * 512 + ((kk & 7) * 32 + (c & 31)) * 2; }
__device__ __forceinline__ int v_rd_base(int lane) { return ((lane & 3) << 3) | (((lane >> 2) & 3) << 6) | (((lane >> 4) & 1) << 5) | (((lane >> 5) & 1) << 8); }
constexpr int v_rd_off(int d0, int ks, int half) { return d0 * 512 + ks * 4096 + half * 2048; }
constexpr int SHM_V = 16384;
template <int DQK> struct Geo { static constexpr int KP = DQK * 2, SHM_K = 64 * DQK * 2, LDS_K0 = 2 * SHM_V, LDS_WS = LDS_K0 + 2 * SHM_K, BYTES = LDS_WS + 8 * 256; };
#define FA_KSWZ(row, colB, pitch) ((row) * (pitch) + ((colB) ^ (((row) & 7) << 4)))
#define FA_SBAR() __builtin_amdgcn_sched_barrier(0)

struct Item { int qrow0, qk0, nt, tokbase; };

template <int DQK>
__device__ __forceinline__ void load_q(const bf16_t* P, const Item& it, int qcol, bf16x8 (&qr)[DQK / 16]) {
    int tid = threadIdx.x; asm volatile("" : "+v"(tid));
    const int wid = tid >> 6, lane = tid & 63, r32 = lane & 31, hi = lane >> 5;
    const bf16_t* qp = P + (size_t)(it.qrow0 + wid * 32 + r32) * PW + qcol + hi * 8;
#pragma unroll
    for (int d0 = 0; d0 < DQK / 16; ++d0) qr[d0] = *(const bf16x8*)(qp + d0 * 16);
}

template <int DQK, bool MASKED>
__device__ __forceinline__ void attn_core(bf16_t* P, const Item& it, const bf16x8 (&qr)[DQK / 16], int k1col, int k2col, int vcol, int ocol, const unsigned* bmq, LAS unsigned char* lds) {
    typedef Geo<DQK> G;
    int tid = threadIdx.x; asm volatile("" : "+v"(tid));
    const int wid = __builtin_amdgcn_readfirstlane(tid >> 6), lane = tid & 63, r32 = lane & 31, hi = lane >> 5;
    LAS unsigned char* V_lds = lds; LAS unsigned char* K_lds = lds + G::LDS_K0; LAS float* wsf = (LAS float*)(lds + G::LDS_WS) + wid * 64;
    const int sr = tid >> 4, sc = (tid & 15) * 8;
    const int vst0 = v_st(sr, sc), vst1 = v_st(32 + sr, sc), kws0 = FA_KSWZ(sr, sc * 2, G::KP), kws1 = FA_KSWZ(sr + 32, sc * 2, G::KP);
    const int xr = tid >> 3, xc = (tid & 7) * 8, kws2 = FA_KSWZ(xr, (128 + xc) * 2, G::KP);
    const unsigned loff0 = (unsigned)(sr * PW + sc) * 2u, loffx = (unsigned)(xr * PW + xc) * 2u;
    const int vb0 = (int)(unsigned)(size_t)V_lds + v_rd_base(lane);
    const int NT = it.nt;
    const int qk = it.qk0 + wid * 32 + r32;
    const bool use_bm = MASKED && (bmq != nullptr);
    const unsigned bmoff = (unsigned)((wid * 32 + r32) * BMW) * 4u;
    float l_reg = 0.f; f32x16 o[4];
#pragma unroll
    for (int d = 0; d < 4; ++d) o[d] = (f32x16){0.f,0.f,0.f,0.f,0.f,0.f,0.f,0.f,0.f,0.f,0.f,0.f,0.f,0.f,0.f,0.f};
    bf16x8 sk0, sk1, sk2, sv0, sv1;
#define FA_KROW0(t) ((t) == 0 ? (MBLK - 64) : it.tokbase + 64 * ((t) - 1))
#define FA_LOAD(t) do { const int kr_ = FA_KROW0(t); const char* rb_ = (const char*)(P + (size_t)kr_ * PW); const char* rk_ = rb_ + (size_t)k1col * 2; const char* rv_ = rb_ + (size_t)vcol * 2; \
        sk0 = *(const bf16x8*)(rk_ + loff0); sk1 = *(const bf16x8*)(rk_ + (size_t)32 * PW * 2 + loff0); sv0 = *(const bf16x8*)(rv_ + loff0); sv1 = *(const bf16x8*)(rv_ + (size_t)32 * PW * 2 + loff0); \
        if (DQK == 192) sk2 = *(const bf16x8*)(rb_ + (size_t)k2col * 2 + loffx); } while (0)
#define FA_WRITE(bf) do { *(LAS bf16x8*)(K_lds + (bf) * G::SHM_K + kws0) = sk0; *(LAS bf16x8*)(K_lds + (bf) * G::SHM_K + kws1) = sk1; \
        *(LAS bf16x8*)(V_lds + (bf) * SHM_V + vst0) = sv0; *(LAS bf16x8*)(V_lds + (bf) * SHM_V + vst1) = sv1; \
        if (DQK == 192) *(LAS bf16x8*)(K_lds + (bf) * G::SHM_K + kws2) = sk2; } while (0)
    constexpr int QREG = (DQK == 192) ? 8 : DQK / 16;
    LAS unsigned char* qx = lds + G::BYTES + (wid * 384 + lane) * 16;
    if (DQK == 192) {
#pragma unroll
        for (int d0 = QREG; d0 < DQK / 16; ++d0) *(LAS bf16x8*)(qx + (d0 - QREG) * 1024) = qr[d0];
    }
    FA_LOAD(0); FA_WRITE(0);
    __syncthreads();
    for (int t = 0; t < NT; ++t) {
        const int cur = t & 1;
        unsigned zb = 0u; asm volatile("" : "+v"(zb)); u32x2 bw = (u32x2){zb, zb};
        if (use_bm) bw = *(const u32x2*)((const char*)(bmq + 2 * t) + bmoff);
        f32x16 p0 = (f32x16){0.f,0.f,0.f,0.f,0.f,0.f,0.f,0.f,0.f,0.f,0.f,0.f,0.f,0.f,0.f,0.f}, p1 = p0;
        { LAS unsigned char* kbase = K_lds + cur * G::SHM_K;
          LAS unsigned char* kb[4];
#pragma unroll
          for (int dd = 0; dd < 4; ++dd) kb[dd] = kbase + FA_KSWZ(r32, (dd * 16 + hi * 8) * 2, G::KP);
          constexpr int GS = (DQK == 192) ? 2 : 4;
#pragma unroll
          for (int g = 0; g < DQK / (16 * GS); ++g) {
              bf16x8 fb0[GS], fb1[GS];
#pragma unroll
              for (int dd = 0; dd < GS; ++dd) { const int d0 = g * GS + dd; LAS unsigned char* a = kb[d0 & 3] + (d0 >> 2) * 128; fb0[dd] = *(const LAS bf16x8*)a; fb1[dd] = *(const LAS bf16x8*)(a + 32 * G::KP); }
              FA_SBAR();
#pragma unroll
              for (int dd = 0; dd < GS; ++dd) { const int d0 = g * GS + dd; bf16x8 qf; if (d0 < QREG) qf = qr[d0 < QREG ? d0 : 0]; else qf = *(const LAS bf16x8*)(qx + (d0 - QREG) * 1024);
                  p0 = __builtin_amdgcn_mfma_f32_32x32x16_bf16(fb0[dd], qf, p0, 0, 0, 0); p1 = __builtin_amdgcn_mfma_f32_32x32x16_bf16(fb1[dd], qf, p1, 0, 0, 0); }
              FA_SBAR(); } }
        if (t + 1 < NT) FA_LOAD(t + 1);
        FA_SBAR();
        const float NEG = -__builtin_inff();
        if (use_bm) {
        } else if (t == 0 || 64 * t + 63 > it.qk0 + wid * 32) {
            const int kb_ = 64 * t + 4 * hi;
#pragma unroll
            for (int r = 0; r < 16; ++r) { const int k0 = kb_ + (r & 3) + 8 * (r >> 2), k1 = k0 + 32;
                if (k0 < 48 || k0 > qk) p0[r] = NEG; if (k1 < 48 || k1 > qk) p1[r] = NEG; }
        }
        float ps = 0.f;
#pragma unroll
        for (int r = 0; r < 16; ++r) { p0[r] = __builtin_amdgcn_exp2f(p0[r]); p1[r] = __builtin_amdgcn_exp2f(p1[r]); }
        if (use_bm) {
            const int wx = (int)(bw.x >> (4 * hi)), wy = (int)(bw.y >> (4 * hi));
#pragma unroll
            for (int r = 0; r < 16; ++r) { const int c = (r & 3) + 8 * (r >> 2);
                p0[r] = __uint_as_float(__float_as_uint(p0[r]) & (unsigned)__builtin_amdgcn_sbfe(wx, c, 1)); p1[r] = __uint_as_float(__float_as_uint(p1[r]) & (unsigned)__builtin_amdgcn_sbfe(wy, c, 1)); }
        }
        { f32x2 s2 = (f32x2){p0[0], p0[1]} + (f32x2){p1[0], p1[1]};
#pragma unroll
          for (int r = 2; r < 16; r += 2) s2 += (f32x2){p0[r], p0[r + 1]} + (f32x2){p1[r], p1[r + 1]};
          ps = s2.x + s2.y; }
        { auto rr = __builtin_amdgcn_permlane32_swap(__float_as_uint(ps), __float_as_uint(ps), false, false); ps = __uint_as_float(rr[0]) + __uint_as_float(rr[1]); }
        l_reg += ps;
        bf16x8 pa0, pa1, pa2, pa3;
#define FA_PK4(Pv, B_, OUT) do { const unsigned a0 = cvt_pk_bf16(Pv[B_ + 0], Pv[B_ + 1]), a1 = cvt_pk_bf16(Pv[B_ + 2], Pv[B_ + 3]), b0 = cvt_pk_bf16(Pv[B_ + 4], Pv[B_ + 5]), b1 = cvt_pk_bf16(Pv[B_ + 6], Pv[B_ + 7]); \
        auto r0 = __builtin_amdgcn_permlane32_swap(a0, b0, false, false); auto r1 = __builtin_amdgcn_permlane32_swap(a1, b1, false, false); \
        u32x4 w_ = {r0[0], r1[0], r0[1], r1[1]}; OUT = __builtin_bit_cast(bf16x8, w_); } while (0)
        FA_PK4(p0, 0, pa0); FA_PK4(p0, 8, pa1); FA_PK4(p1, 0, pa2); FA_PK4(p1, 8, pa3);
#define FA_TRRD(dst, off) asm volatile("ds_read_b64_tr_b16 %0, %1 offset:%2" : "=&v"(dst) : "v"(vb0), "i"(off) : "memory")
#define FA_PV(VB, d0) do { s16x4 l0, l1, l2, l3, h0, h1, h2, h3; constexpr int b_ = (VB) * SHM_V + v_rd_off(d0, 0, 0); \
        FA_TRRD(l0, b_); FA_TRRD(h0, b_ + 2048); FA_TRRD(l1, b_ + 4096); FA_TRRD(h1, b_ + 6144); FA_TRRD(l2, b_ + 8192); FA_TRRD(h2, b_ + 10240); FA_TRRD(l3, b_ + 12288); FA_TRRD(h3, b_ + 14336); \
        asm volatile("s_waitcnt lgkmcnt(0)" ::: "memory"); FA_SBAR(); \
        o[d0] = __builtin_amdgcn_mfma_f32_32x32x16_bf16(pa0, (bf16x8){l0[0], l0[1], l0[2], l0[3], h0[0], h0[1], h0[2], h0[3]}, o[d0], 0, 0, 0); \
        o[d0] = __builtin_amdgcn_mfma_f32_32x32x16_bf16(pa1, (bf16x8){l1[0], l1[1], l1[2], l1[3], h1[0], h1[1], h1[2], h1[3]}, o[d0], 0, 0, 0); \
        o[d0] = __builtin_amdgcn_mfma_f32_32x32x16_bf16(pa2, (bf16x8){l2[0], l2[1], l2[2], l2[3], h2[0], h2[1], h2[2], h2[3]}, o[d0], 0, 0, 0); \
        o[d0] = __builtin_amdgcn_mfma_f32_32x32x16_bf16(pa3, (bf16x8){l3[0], l3[1], l3[2], l3[3], h3[0], h3[1], h3[2], h3[3]}, o[d0], 0, 0, 0); } while (0)
        FA_SBAR();
        if (cur == 0) { FA_PV(0, 0); FA_PV(0, 1); FA_PV(0, 2); FA_PV(0, 3); } else { FA_PV(1, 0); FA_PV(1, 1); FA_PV(1, 2); FA_PV(1, 3); }
        FA_SBAR();
        if (t + 1 < NT) { if (cur == 0) FA_WRITE(1); else FA_WRITE(0); }
        __syncthreads();
    }
    if (hi == 0) wsf[r32] = l_reg; LDS_WAIT();
    float rli[16];
#pragma unroll
    for (int r = 0; r < 16; ++r) { const float lv = wsf[crow(r, hi)]; rli[r] = lv > 0.f ? __builtin_amdgcn_rcpf(lv) : 0.f; }
    { int l2 = lane; asm volatile("" : "+v"(l2));
      const int r32b = l2 & 31, hib = l2 >> 5;
      char* Ow = (char*)(P + (size_t)(it.qrow0 + wid * 32) * PW + ocol) + (unsigned)((4 * hib) * PW + r32b) * 2u;
#pragma unroll
      for (int r = 0; r < 16; ++r) { const unsigned ro = (unsigned)(((r & 3) + 8 * (r >> 2)) * PW) * 2u;
#pragma unroll
        for (int d0 = 0; d0 < 4; ++d0) { const float v = o[d0][r] * rli[r]; const float vn = __shfl_xor(v, 1);
            if ((r32b & 1) == 0) *(unsigned*)(Ow + ro + d0 * 64) = cvt_pk_bf16(v, vn); } } }
    LDS_WAIT();
    __syncthreads();
#undef FA_KROW0
#undef FA_LOAD
#undef FA_WRITE
#undef FA_PK4
#undef FA_TRRD
#undef FA_PV
}
__device__ __forceinline__ int next_item(unsigned* ctr, LAS int* slot) {
    __syncthreads();
    if (threadIdx.x == 0) *slot = (int)__hip_atomic_fetch_add(ctr, 1u, __ATOMIC_RELAXED, __HIP_MEMORY_SCOPE_AGENT);
    __syncthreads();
    return *slot;
}
__device__ __forceinline__ void queue_prime(unsigned* ctr, LAS int* slot) {
    __syncthreads();
    if (threadIdx.x == 0) slot[0] = (int)__hip_atomic_fetch_add(ctr, 1u, __ATOMIC_RELAXED, __HIP_MEMORY_SCOPE_AGENT);
    __syncthreads();
}
__device__ __forceinline__ int queue_next(unsigned* ctr, LAS int* slot, int k) {
    const int idx = slot[k & 1];
    if (threadIdx.x == 0) slot[(k + 1) & 1] = (int)__hip_atomic_fetch_add(ctr, 1u, __ATOMIC_RELAXED, __HIP_MEMORY_SCOPE_AGENT);
    return idx;
}
__device__ __forceinline__ Item make_item(bool meta, int b, int qb) {
    Item it;
    if (meta) { it.qrow0 = 0; it.qk0 = -(MBLK - 64); it.nt = 1; it.tokbase = MBLK; }
    else { it.qrow0 = MBLK + b * SEQ + qb * 256; it.qk0 = 64 + qb * 256; it.nt = 4 * (qb + 1) + 1; it.tokbase = MBLK + b * SEQ; }
    return it;
}
}


constexpr int PH_PER_LAYER = 19, N_PHASES = 2 * PH_PER_LAYER;
__device__ __forceinline__ unsigned char* uni_ptr(unsigned char* p) { const unsigned long long v = (unsigned long long)p; const unsigned lo = __builtin_amdgcn_readfirstlane((unsigned)v), hi = __builtin_amdgcn_readfirstlane((unsigned)(v >> 32)); return (unsigned char*)(((unsigned long long)hi << 32) | lo); }
__device__ __forceinline__ const float* arg_in(const Args& a, int k) { asm volatile("" : "+s"(k)); return a.in[k]; }
__global__ void __launch_bounds__(NWAVES * 64, 2) mega_fwd(Args args) {
    extern __shared__ __attribute__((aligned(16))) unsigned char lds_raw[];
    {
        LAS unsigned char* l0 = (LAS unsigned char*)lds_raw;
        for (int u = threadIdx.x; u < (LDS_BYTES - LDSCTL_OFF) / 4; u += NWAVES * 64) ((LAS unsigned*)(l0 + LDSCTL_OFF))[u] = 0u;
        __syncthreads();
    }
#if MK_ONE_LAUNCH
    (void)xcd_barrier_post((unsigned*)(args.ws + WS_CTL) + CW_BAR, (volatile LAS unsigned*)((LAS unsigned char*)lds_raw + LDSCTL_OFF + 64));
#define GRID_BAR() do { XcdBarrier bar_; bar_.bar = (unsigned*)(uni_ptr(args.ws) + WS_CTL) + CW_BAR; bar_.x = xb_xcc_id(); bar_.st = (volatile LAS unsigned*)((LAS unsigned char*)lds_raw + LDSCTL_OFF + 64); xcd_barrier(bar_); } while (0)
#else
#define GRID_BAR() do {} while (0)
#endif
    const int lo = args.ph_lo, hi = args.ph_hi;
#define IN(k) (lo <= (k) && (k) < hi)
#define SEAM(k) do { if (IN((k) + 1)) GRID_BAR(); } while (0)
#define PH_BEGIN \
    int tid_ = threadIdx.x; asm volatile("" : "+v"(tid_)); \
    Ctx F; F.lds = (LAS unsigned char*)lds_raw; F.tid = tid_; F.lane = tid_ & 63; F.wave = __builtin_amdgcn_readfirstlane(tid_ >> 6); \
    F.G = gridDim.x; F.bid = blockIdx.x; F.gw = F.bid * NWAVES + F.wave; F.ngw = F.G * NWAVES; \
    unsigned char* ws = uni_ptr(args.ws); asm volatile("" : "+s"(ws)); \
    int ly = __builtin_amdgcn_readfirstlane(layer); asm volatile("" : "+s"(ly)); (void)ly; (void)F
#define XN_ ((bf16_t*)(ws + WS_XN))
#define P_ ((bf16_t*)(ws + WS_P))
#define HMETA_ ((float*)(ws + WS_HMETA))
#define RSTDQ_ ((float*)(ws + WS_RSTD))
#define RSTDKV_ ((float*)(ws + WS_RSTD) + R)
#define BM_ ((unsigned*)(ws + WS_BM))
#define RS_(i) ((float*)(ws + WS_CTL + WS_RS) + (size_t)(i) * R)
#define GPERM_ ((float*)(ws + WS_RSTD + 512 * 1024))
#define WB_(off) ((bf16_t*)(ws + WS_WB + (off)))
#define OUT_ (args.out)
#define LAMBDA_INIT(ly) ((ly) == 0 ? 0.2f : (0.8f - 0.6f * 0.7408182206817179f))
#define HSRC_TOK(ly) ((ly) == 0 ? arg_in(args, 0) : (const float*)args.out)

#pragma unroll
    for (int layer = 0; layer < 2; ++layer) {
        const int pb = layer * PH_PER_LAYER;
        if (((PHMASK >> 0) & 1) && IN(pb + 0)) {
            PH_BEGIN;
            for (int rep_ = 0; rep_ < NREP(0); ++rep_) { if (rep_) GRID_BAR();
            const float* meta = arg_in(args, 1);
            conv_matrix<1>(F, arg_in(args, 3) + (size_t)ly * DM * D_IN, DM, D_IN, WB_(WB_IN), arg_in(args, 2) + ly * DM);
            conv_matrix<0>(F, arg_in(args, 7) + (size_t)ly * 512 * 1536, 512, 1536, WB_(WB_QUP), arg_in(args, 5) + ly * 512);
            conv_matrix<0>(F, arg_in(args, 8) + (size_t)ly * 512 * 2048, 512, 2048, WB_(WB_KVUP), arg_in(args, 6) + ly * 512);
            for (int b = 0; b < 3; ++b) conv_matrix<0>(F, arg_in(args, 14) + ((size_t)ly * 3 + b) * 1024 * DM, 1024, DM, WB_(WB_BR) + (size_t)b * DM * 1024, nullptr);
            conv_matrix<0>(F, arg_in(args, 15) + (size_t)ly * DM * DM, DM, DM, WB_(WB_O), nullptr);
            conv_matrix<2>(F, arg_in(args, 17) + (size_t)ly * DM * 2 * DFF, DM, 2 * DFF, WB_(WB_F1), arg_in(args, 16) + ly * DM);
            conv_matrix<0>(F, arg_in(args, 18) + (size_t)ly * DFF * DM, DFF, DM, WB_(WB_F2), nullptr);
            unsigned zu = 0u; asm volatile("" : "+v"(zu)); const float zf = __uint_as_float(zu);
            for (int i = F.gw * 64 + F.lane; i < 112 * 2048 / 8; i += F.ngw * 64) *((u32x4*)(WB_(WB_IN) + (size_t)1168 * 2048) + i) = (u32x4){zu, zu, zu, zu};
            if (F.bid == 0) { const int i = F.tid; const int t = i >> 7, ps = i & 127, dim = (ps >> 1) + 64 * (ps & 1);
                const float* gsrc = (t < 2 ? arg_in(args, 10) : arg_in(args, 11)) + ly * 256 + (t & 1) * 128; GPERM_[i] = gsrc[dim]; }
            float* hmeta = HMETA_;
            if (ly == 0) {
                for (int i = F.gw * 64 + F.lane; i < MROW0 * PW / 8; i += F.ngw * 64) *((u32x4*)P_ + i) = (u32x4){zu, zu, zu, zu};
                for (int i = F.gw * 64 + F.lane; i < MBLK * DM / 4; i += F.ngw * 64) { const int rr = i / (DM / 4); f32x4 v = (f32x4){zf, zf, zf, zf};
                    if (rr >= MBLK - NMETA) v = *((const f32x4*)meta + (i - (MBLK - NMETA) * (DM / 4))); *((f32x4*)hmeta + i) = v; }
            }
            if (ly == 0) {
                const float* xin = arg_in(args, 0); bf16_t* XN = XN_; float* rs0 = RS_(0);
                for (int r = MROW0 + F.gw; r < R; r += F.ngw)
                    norm_row(r < MBLK ? meta + (size_t)(r - MROW0) * DM : xin + (size_t)(r - MBLK) * DM, XN + (size_t)r * DM, rs0 + r, F.lane);
            }
            }
            SEAM(pb + 0);
        }
        if (((PHMASK >> 1) & 1) && IN(pb + 1)) {
            PH_BEGIN;
            { SkP f{P_, 0, RS_(2 * ly)}; skinny_gemm(F.lds, XN_ + (size_t)MROW0 * DM, DM, WB_(WB_IN), DM, 1280 / 16, F.bid, F.G, f); }
            SchedPlain S{XN_, DM, WB_(WB_IN), DM, NPMM, 5, F.G, F.bid, 0}; EpiP E{P_, RS_(2 * ly)};
            pg8::gemm_phase(F.lds, S, E);
            if (NREP(1) == 2) { GRID_BAR(); pg8::gemm_phase(F.lds, S, E); }
            SEAM(pb + 1);
        }
        if (((PHMASK >> 2) & 1) && IN(pb + 2)) {
            PH_BEGIN;
            { bf16_t* P = P_; float* rq = RSTDQ_; float* rkv = RSTDKV_;
              for (int r = MROW0 + F.gw; r < R; r += F.ngw) post1a_row(P, r, rq, rkv, F.lane); }
            VM_WAIT(); __syncthreads();
            { SkP f{P_, C_QRAW, nullptr}; skinny_gemm(F.lds, P_ + (size_t)MROW0 * PW + C_CQ, PW, WB_(WB_QUP), 512, 1536 / 16, F.bid, F.G, f); }
            { SkP f{P_, C_KVRAW, nullptr}; skinny_gemm(F.lds, P_ + (size_t)MROW0 * PW + C_CKV, PW, WB_(WB_KVUP), 512, 2048 / 16, F.bid, F.G, f); }
            SchedMlaUp S{P_, WB_(WB_QUP), WB_(WB_KVUP), F.G, F.bid}; EpiP E{P_, nullptr};
            pg8::gemm_phase(F.lds, S, E);
            if (NREP(2) == 2) { GRID_BAR(); pg8::gemm_phase(F.lds, S, E); }
            SEAM(pb + 2);
        }
        if (((PHMASK >> 3) & 1) && IN(pb + 3)) {
            PH_BEGIN;
            const float* mla_qkg = arg_in(args, 9) + ly * 2 * 192;
            bf16_t* P = P_; float* rq = RSTDQ_; float* rkv = RSTDKV_;
            LAS float* rnl = (LAS float*)(F.lds + F.wave * 64);
            for (int r = MROW0 + F.gw; r < R; r += F.ngw) post2_row(P, r, rq, rkv, mla_qkg, rnl, F.lane);
            SEAM(pb + 3);
        }
        if (((PHMASK >> 4) & 1) && IN(pb + 4)) {
            PH_BEGIN;
            bf16_t* P = P_;
            LAS int* slot = (LAS int*)(F.lds + LDSCTL_OFF + 128);
            for (int rep_ = 0; rep_ < NREP(4); ++rep_) { if (rep_) GRID_BAR();
            unsigned* ctr = (unsigned*)(ws + WS_CTL) + CW_Q + 64 * (ly * 4 + 0) + 64 * 16 * rep_;
            fa::queue_prime(ctr, slot);
            for (int qk_ = 0;; ++qk_) {
                const int idx = fa::queue_next(ctr, slot, qk_); if (idx >= 8 * 129) break;
                int h; fa::Item it;
                if (idx < 1024) { const int qb = 7 - (idx >> 7), rest = idx & 127; h = rest & 7; it = fa::make_item(false, rest >> 3, qb); } else { h = idx - 1024; it = fa::make_item(true, 0, 0); }
                bf16x8 qr[12]; fa::load_q<192>(P, it, C_QRAW + h * 192, qr);
                fa::attn_core<192, false>(P, it, qr, C_KVRAW + h * 256, C_KPEH + h * 64, C_KVRAW + h * 256 + 128, C_OA + h * 128, nullptr, F.lds);
            } }
            SEAM(pb + 4);
        }
        if (((PHMASK >> 5) & 1) && IN(pb + 5)) {
            PH_BEGIN;
            { SkP f{P_, 1280, RS_(2 * ly)}; skinny_gemm(F.lds, XN_ + (size_t)MROW0 * DM, DM, WB_(WB_IN) + (size_t)1280 * DM, DM, 7168 / 16, F.bid, F.G, f); }
            SchedPlain S{XN_, DM, WB_(WB_IN) + (size_t)1280 * DM, DM, NPMM, 28, F.G, F.bid, 1280}; EpiG2 E{P_, RS_(2 * ly), GPERM_, (LAS float*)(F.lds + RING_BYTES)};
            pg8::gemm_phase(F.lds, S, E);
            if (NREP(5) == 2) { GRID_BAR(); pg8::gemm_phase(F.lds, S, E); }
            SEAM(pb + 5);
        }
        if (((PHMASK >> 6) & 1) && IN(pb + 6)) {
            PH_BEGIN;
            bf16_t* P = P_; const float* gp = GPERM_;
            if (F.gw < NMETA) meta_post_row(P, MROW0 + F.gw, gp, F.lane);
            SEAM(pb + 6);
        }
        if (((PHMASK >> 7) & 1) && IN(pb + 7)) {
            PH_BEGIN;
            bf16_t* P = P_; unsigned* bm = BM_;
            unsigned* ctr = (unsigned*)(ws + WS_CTL) + CW_Q + 64 * (ly * 4 + 2);
            LAS int* slot = (LAS int*)(F.lds + LDSCTL_OFF + 128);
            for (int rep_ = 0; rep_ < NREP(7); ++rep_) { if (rep_) GRID_BAR(); unsigned* c2 = ctr + 64 * 16 * rep_;
            for (;;) { const int idx = fa::next_item(c2, slot); if (idx >= NTOK / 8) break; index_unit(P, idx, bm, F.lds); } }
            SEAM(pb + 7);
        }
        if (((PHMASK >> 8) & 1) && IN(pb + 8)) {
            PH_BEGIN;
            bf16_t* P = P_; unsigned* bm = BM_;
            LAS int* slot = (LAS int*)(F.lds + LDSCTL_OFF + 128);
            for (int rep_ = 0; rep_ < NREP(8); ++rep_) { if (rep_) GRID_BAR();
            const bool dummy = (NREP(8) == 2) && rep_ == 0;
            unsigned* ctr = (unsigned*)(ws + WS_CTL) + CW_Q + 64 * (ly * 4 + 1) + 64 * 16 * rep_;
            fa::queue_prime(ctr, slot);
            for (int qk_ = 0;; ++qk_) {
                const int idx = fa::queue_next(ctr, slot, qk_); if (idx >= 16 * 129) break;
                int hh; bool meta = false; fa::Item it; int b = 0, qb = 0;
                if (idx < 2048) { qb = 7 - (idx >> 8); const int rest = idx & 255; hh = (rest < 128) ? 8 + (rest & 7) : (rest & 7); b = (rest & 127) >> 3; it = fa::make_item(false, b, qb); }
                else { hh = idx - 2048; hh = hh < 8 ? 8 + hh : hh - 8; meta = true; it = fa::make_item(true, 0, 0); }
                if (hh < 8) {
                    bf16x8 qr[8]; fa::load_q<128>(P, it, C_DQ + hh * 128, qr);
                    fa::attn_core<128, true>(P, it, qr, C_DK + hh * 128, 0, C_DV + hh * 128, dummy ? C_KPE : C_OB + hh * 128, meta ? nullptr : bm + (size_t)(b * SEQ + qb * 256) * BMW, F.lds);
                } else {
                    const int hj = hh - 8;
                    bf16x8 qr[8]; fa::load_q<128>(P, it, C_FQ + hj * 128, qr);
                    fa::attn_core<128, false>(P, it, qr, C_FK + hj * 128, 0, C_FV + (hj >> 1) * 256, dummy ? C_KPE : C_FQ + hj * 128, nullptr, F.lds);
                    fa::attn_core<128, false>(P, it, qr, C_FK + hj * 128, 0, C_FV + (hj >> 1) * 256 + 128, dummy ? C_KPE : C_IQ + hj * 128, nullptr, F.lds);
                }
            } }
            SEAM(pb + 8);
        }
        if (((PHMASK >> 9) & 1) && IN(pb + 9)) {
            PH_BEGIN;
            const float* diff_lam = arg_in(args, 12) + ly * 4 * 128; const float* diff_subg = arg_in(args, 13) + ly * 256;
            const float lambda_init = LAMBDA_INIT(ly);
            const float s1 = wave_sum(diff_lam[F.lane] * diff_lam[128 + F.lane] + diff_lam[64 + F.lane] * diff_lam[192 + F.lane]);
            const float s2 = wave_sum(diff_lam[256 + F.lane] * diff_lam[384 + F.lane] + diff_lam[320 + F.lane] * diff_lam[448 + F.lane]);
            const float lam = __expf(s1) - __expf(s2) + lambda_init;
            bf16_t* P = P_;
            for (int r = MROW0 + F.gw; r < R; r += F.ngw) post3_row(P, r, diff_subg, lam, 1.f - lambda_init, F.lane);
        }
#define GATE_PHASE(k, b) \
        if (((PHMASK >> 10) & 1) && IN(pb + (k))) { \
            PH_BEGIN; \
            { SkGate f{(bf16_t*)(ws + WS_GS), arg_in(args, 4) + ly * 3 * DM + (b) * DM, RS_(2 * ly)}; skinny_gemm(F.lds, XN_ + (size_t)MROW0 * DM, DM, WB_(WB_G) + (size_t)(b) * 2048 * DM, DM, 2048 / 16, F.bid, F.G, f); } \
            SchedPlain S{XN_, DM, WB_(WB_G) + (size_t)(b) * 2048 * DM, DM, NPMM, 8, F.G, F.bid, 0}; EpiGate E{(bf16_t*)(ws + WS_GS), arg_in(args, 4) + ly * 3 * DM + (b) * DM, RS_(2 * ly)}; \
            pg8::gemm_phase(F.lds, S, E); \
            if (NREP(k) == 2) { GRID_BAR(); pg8::gemm_phase(F.lds, S, E); } \
            SEAM(pb + (k)); \
        }
#define BRANCH_PHASE(k, b, oc) \
        if (((PHMASK >> 10) & 1) && IN(pb + (k))) { \
            PH_BEGIN; \
            { SkGated f{P_, (const bf16_t*)(ws + WS_GS), (b) == 0 ? 1 : 0}; skinny_gemm(F.lds, P_ + (size_t)MROW0 * PW + (oc), PW, WB_(WB_BR) + (size_t)(b) * DM * 1024, 1024, 2048 / 16, F.bid, F.G, f); } \
            SchedPlain S{P_ + (oc), PW, WB_(WB_BR) + (size_t)(b) * DM * 1024, 1024, NPMM, 8, F.G, F.bid, C_MERGED}; EpiGated E{P_, (const bf16_t*)(ws + WS_GS), (b) == 0 ? 1 : 0, ((DBG_BM >> (b)) & 1) ? 1.f : 0.f}; \
            pg8::gemm_phase(F.lds, S, E); \
            if (NREP(k) == 2 && (b) == 0) { GRID_BAR(); pg8::gemm_phase(F.lds, S, E); } \
            SEAM(pb + (k)); \
        }
        GATE_PHASE(10, 0) BRANCH_PHASE(11, 0, C_OA)
        GATE_PHASE(12, 1) BRANCH_PHASE(13, 1, C_OB)
        GATE_PHASE(14, 2) BRANCH_PHASE(15, 2, C_OC)
        if (((PHMASK >> 11) & 1) && IN(pb + 16)) {
            PH_BEGIN;
            { SkRes f{HMETA_, XN_, RS_(2 * ly + 1)}; skinny_gemm(F.lds, P_ + (size_t)MROW0 * PW + C_MERGED, PW, WB_(WB_O), DM, 2048 / 16, F.bid, F.G, f); }
            SchedPlain S{P_ + C_MERGED, PW, WB_(WB_O), DM, NPMM, 8, F.G, F.bid, 0}; EpiRes E{HSRC_TOK(ly), OUT_, HMETA_, DBG_SA, XN_, RS_(2 * ly + 1)};
            pg8::gemm_phase(F.lds, S, E);
            SEAM(pb + 16);
        }
        if (((PHMASK >> 13) & 1) && IN(pb + 17)) {
            PH_BEGIN;
            skinny_swiglu(F.lds, XN_ + (size_t)MROW0 * DM, DM, WB_(WB_F1), DM, P_, RS_(2 * ly + 1), F.bid, F.G);
            SchedPlain S{XN_, DM, WB_(WB_F1), DM, NPMM, 44, F.G, F.bid, 0}; EpiSwiglu E{P_, RS_(2 * ly + 1)};
            pg8::gemm_phase(F.lds, S, E);
            if (NREP(17) == 2) { GRID_BAR(); pg8::gemm_phase(F.lds, S, E); }
            SEAM(pb + 17);
        }
        if (((PHMASK >> 14) & 1) && IN(pb + 18)) {
            PH_BEGIN;
            { SkRes f{HMETA_, ly == 0 ? XN_ : (bf16_t*)nullptr, RS_(2)}; skinny_gemm(F.lds, P_ + (size_t)MROW0 * PW, PW, WB_(WB_F2), DFF, 2048 / 16, F.bid, F.G, f); }
            SchedPlain S{P_, PW, WB_(WB_F2), DFF, NPMM, 8, F.G, F.bid, 0}; EpiRes E{OUT_, OUT_, HMETA_, DBG_SF, ly == 0 ? XN_ : (bf16_t*)nullptr, RS_(2)};
            pg8::gemm_phase(F.lds, S, E);
            SEAM(pb + 18);
        }
    }
#undef IN
#undef SEAM
}

__global__ void diag_fill(float* out, int n, float v) { for (int i = blockIdx.x * blockDim.x + threadIdx.x; i < n; i += gridDim.x * blockDim.x) out[i] = v; }
extern "C" void kernel_launch(void* const* d_in, const int* in_sizes, int n_in, void* d_out, int out_size, void* d_ws, size_t ws_size, hipStream_t stream) {
    static int grid = 0; static float code = 0.f;
    if (grid == 0) {
        int dev = 0, cus = 0;
        if (n_in != 19) { code = 10.f; grid = -1; }
        else if (ws_size < WS_END) { code = 20.f + (float)(ws_size >> 20) * 0.01f; grid = -1; }
        else if (hipGetDevice(&dev) != hipSuccess || hipDeviceGetAttribute(&cus, hipDeviceAttributeMultiprocessorCount, dev) != hipSuccess) { code = 40.f; grid = -1; }
        else if (hipFuncSetAttribute((const void*)mega_fwd, hipFuncAttributeMaxDynamicSharedMemorySize, LDS_BYTES) != hipSuccess) { code = 50.f; grid = -1; }
        else {
            int per_cu = 0;
            if (hipOccupancyMaxActiveBlocksPerMultiprocessor(&per_cu, (const void*)mega_fwd, NWAVES * 64, LDS_BYTES) != hipSuccess || per_cu < 1) { code = 60.f; grid = -1; }
            (void)hipGetLastError();
            if (grid == 0) grid = cus;
        }
    }
    if (grid < 0) { hipLaunchKernelGGL(diag_fill, dim3(1024), dim3(256), 0, stream, (float*)d_out, out_size, code); return; }
    (void)hipMemsetAsync((char*)d_ws + WS_CTL, 0, CTL_BYTES, stream);
    Args a{};
    for (int i = 0; i < 19; ++i) a.in[i] = (const float*)d_in[i];
    a.out = (float*)d_out; a.ws = (unsigned char*)d_ws;
#if MK_ONE_LAUNCH
    a.ph_lo = 0; a.ph_hi = N_PHASES;
    hipLaunchKernelGGL(mega_fwd, dim3(grid), dim3(NWAVES * 64), LDS_BYTES, stream, a);
#else
    for (int p = 0; p < N_PHASES; ++p) { a.ph_lo = p; a.ph_hi = p + 1; hipLaunchKernelGGL(mega_fwd, dim3(grid), dim3(NWAVES * 64), LDS_BYTES, stream, a); }
#endif
    if (hipPeekAtLastError() != hipSuccess) { (void)hipGetLastError(); hipLaunchKernelGGL(diag_fill, dim3(1024), dim3(256), 0, stream, (float*)d_out, out_size, 70.f); }
}
```

```cpp
#include <hip/hip_runtime.h>
#include <cstdio>
#include <cstdint>

#ifndef PHMASK
#define PHMASK 0x7fff
#endif
#ifndef REPMASK
#define REPMASK 0
#endif
#define NREP(k) ((((REPMASK) >> (k)) & 1) ? 2 : 1)
#ifndef DBG_BM
#define DBG_BM 7
#endif
#ifndef DBG_BR
#define DBG_BR 0
#endif
#ifndef DBG_SA
#define DBG_SA 1.0f
#endif
#ifndef DBG_SF
#define DBG_SF 1.0f
#endif
#ifndef MK_ONE_LAUNCH
#define MK_ONE_LAUNCH 1
#endif

#define LAS __attribute__((address_space(3)))
#define GAS __attribute__((address_space(1)))
typedef unsigned short bf16_t;
typedef short bf16x8 __attribute__((ext_vector_type(8)));
typedef float f32x4 __attribute__((ext_vector_type(4)));
typedef float f32x2 __attribute__((ext_vector_type(2)));
typedef unsigned u32x4 __attribute__((ext_vector_type(4)));
typedef unsigned u32x2 __attribute__((ext_vector_type(2)));

constexpr int DM = 2048, NB = 16, SEQ = 2048, NMETA = 16, MBLK = 256;
constexpr int R = MBLK + NB * SEQ;
constexpr int NPM = R / 256;
constexpr int NPMM = NPM - 1;
constexpr int MROW0 = MBLK - NMETA;
constexpr int NTOK = NB * SEQ;
constexpr int DFF = 5632;
constexpr int PW = 8448;
constexpr int C_CQ = 0, C_CKV = 512, C_KPE = 1024, C_IK = 1088, C_IW = 1152, C_DQ = 1280, C_DK = 2304, C_DV = 3328, C_IQ = 4352,
              C_FQ = 5376, C_FK = 6400, C_FV = 7424;
constexpr int C_KVRAW = 1280, C_QRAW = 3328, C_KPEH = 4864;
constexpr int C_OA = 0, C_OB = C_DQ, C_OC = C_FQ, C_MERGED = 2304;
constexpr int BMW = 66;
constexpr float EPS = 1e-6f;
constexpr float LOG2E = 1.4426950408889634f;
constexpr float C2_128 = 0.08838834764831845f * LOG2E;
constexpr float C2_192 = 0.07216878364870323f * LOG2E;
constexpr int D_IN = 14480;

constexpr size_t MiB = 1u << 20;
constexpr size_t WS_CTL = 0, CTL_BYTES = 1 * MiB;
constexpr size_t WS_RSTD = 1 * MiB;
constexpr size_t WS_HMETA = 2 * MiB;
constexpr size_t WS_BM = 4 * MiB;
constexpr size_t WS_WB = 16 * MiB;
constexpr size_t WB_IN = 0, WB_G = WB_IN + (size_t)8448 * 2048 * 2, WB_QUP = WB_G + (size_t)6144 * 2048 * 2, WB_KVUP = WB_QUP + (size_t)1536 * 512 * 2,
                 WB_BR = WB_KVUP + (size_t)2048 * 512 * 2, WB_O = WB_BR + (size_t)3 * 2048 * 1024 * 2, WB_F1 = WB_O + (size_t)2048 * 2048 * 2,
                 WB_F2 = WB_F1 + (size_t)11264 * 2048 * 2, WB_END = WB_F2 + (size_t)2048 * 5632 * 2;
constexpr size_t WS_XN = 164 * MiB;
constexpr size_t WS_P = 294 * MiB;
constexpr size_t WS_GS = 828 * MiB;
constexpr size_t WS_END = 960 * MiB;
static_assert(WS_GS + (size_t)R * 2048 * 2 <= WS_END && WS_WB + WB_END <= WS_XN && WS_XN + (size_t)R * 2048 * 2 <= WS_P && WS_P + (size_t)R * PW * 2 <= WS_GS, "ws map");
constexpr int CW_BAR = 4096, CW_Q = 16384;
constexpr size_t WS_RS = 256 * 1024;

__device__ __forceinline__ float bf2f(bf16_t v) { return __uint_as_float((unsigned)v << 16); }
__device__ __forceinline__ unsigned f2bf(float f) { unsigned u = __float_as_uint(f); return (u + 0x7fffu + ((u >> 16) & 1u)) >> 16; }
__device__ __forceinline__ unsigned pk2(float lo, float hi) { return f2bf(lo) | (f2bf(hi) << 16); }
typedef __bf16 bf16x2_t __attribute__((ext_vector_type(2)));
__device__ __forceinline__ unsigned cvt_pk_bf16(float lo, float hi) { f32x2 v = {lo, hi}; bf16x2_t b = __builtin_convertvector(v, bf16x2_t); return __builtin_bit_cast(unsigned, b); }
__device__ __forceinline__ float wave_sum(float v) {
#pragma unroll
    for (int o = 1; o < 64; o <<= 1) v += __shfl_xor(v, o);
    return v;
}
__device__ __forceinline__ float wave_max(float v) {
#pragma unroll
    for (int o = 1; o < 64; o <<= 1) v = fmaxf(v, __shfl_xor(v, o));
    return v;
}
#define LDS_WAIT() asm volatile("s_waitcnt lgkmcnt(0)" ::: "memory")
#define VM_WAIT() asm volatile("s_waitcnt vmcnt(0)" ::: "memory")
__device__ __forceinline__ int row_pos(int r) { return r < MBLK ? (r >= MBLK - NMETA ? r - (MBLK - NMETA) : 0) : NMETA + ((r - MBLK) & (SEQ - 1)); }
__device__ __forceinline__ void rope_cs(int pos, int i, float two_over_d, float& c, float& s) {
    const float inv = __builtin_amdgcn_exp2f(-(float)i * two_over_d * 13.287712379549449f);
    float rev = (float)pos * inv * 0.15915494309189535f;
    rev -= floorf(rev);
    s = __builtin_amdgcn_sinf(rev); c = __builtin_amdgcn_cosf(rev);
}

namespace pg8 {
constexpr int BM = 256, BK = 64, HALF = 128, HTB = HALF * BK * 2, STAGE_BYTES = 8 * HTB;
__device__ __forceinline__ int lds_byte(int r, int c) { const int st = (r >> 4) * 2 + (c >> 5), rr = r & 15, cc = c & 31, ob = rr * 64 + cc * 2; return st * 1024 + (ob ^ (((ob >> 9) & 1) << 5)); }
__device__ __forceinline__ void stage_rc(int b, int& R_, int& C_) { const int st = b / 1024, sb = b % 1024, swz = sb ^ (((sb >> 9) & 1) << 5); R_ = (st >> 1) * 16 + swz / 64; C_ = (st & 1) * 32 + (swz % 64) / 2; }
__device__ __forceinline__ int perm32(int rho) { const int n = rho >> 4, i = rho & 15; return 8 * (i >> 2) + 4 * n + (i & 3); }

struct Unit { const char* A; const char* B; unsigned lda2, ldb2; int nt, pm, pn, kind, ocol; };

#ifndef WGM
#define WGM 4
#endif
__device__ __forceinline__ void tile_of(int L, int nM, int nN, int& pm, int& pn) {
    const int nwg = nM * nN; int wgid = L;
    { const int q = nwg / 8, r = nwg % 8, xcd = wgid % 8, off = wgid / 8; wgid = (xcd < r ? xcd * (q + 1) : r * (q + 1) + (xcd - r) * q) + off; }
    const int nig = WGM * nN, gid = wgid / nig, fm = gid * WGM, gsz = (nM - fm) < WGM ? (nM - fm) : WGM;
    pm = fm + ((wgid % nig) % gsz); pn = (wgid % nig) / gsz;
}

template <class Epi, class Sched>
__device__ __forceinline__ void gemm_phase(LAS unsigned char* lds, const Sched& S, const Epi& E) {
    int tid = threadIdx.x; asm volatile("" : "+v"(tid));
    const int wid = __builtin_amdgcn_readfirstlane(tid >> 6), lane = tid & 63, wr = wid >> 2, wc = wid & 3, fr = lane & 15, fq = lane >> 4;
    unsigned rA[2], rB[2], cc[2];
#pragma unroll
    for (int i = 0; i < 2; ++i) { int R_, C_; stage_rc(tid * 16 + i * 8192, R_, C_); rA[i] = (unsigned)R_; rB[i] = (unsigned)(Epi::PERM ? ((R_ & ~31) + perm32(R_ & 31)) : R_); cc[i] = (unsigned)C_ * 2u; }
    const size_t kstep = (size_t)(BK * 2);
    const unsigned ldsw = (unsigned)wid * 1024u;
    const int aoff = lds_byte(wr * 64 + fr, fq * 8), boff = lds_byte(wc * 32 + fr, fq * 8);
#define PG8_SA(b, h) (((b) * 2 + (h)) * HTB)
#define PG8_SB(b, h) ((4 + (b) * 2 + (h)) * HTB)
#define PG8_STAGE(bufoff, gbase, rr, ld2) do { _Pragma("unroll") for (int _i = 0; _i < 2; ++_i) \
        __builtin_amdgcn_global_load_lds((const unsigned*)((const char*)(gbase) + ((rr)[_i] * (ld2) + cc[_i])), (LAS unsigned*)(lds + (bufoff) + ldsw + _i * 8192), 16, 0, 0); } while (0)
#define PG8_LDA(dst, b, h) do { _Pragma("unroll") for (int m = 0; m < 4; ++m) _Pragma("unroll") for (int k = 0; k < 2; ++k) dst[m][k] = *(const LAS bf16x8*)(lds + PG8_SA(b, h) + aoff + m * 2048 + k * 1024); } while (0)
#define PG8_LDB(dst, b, h) do { _Pragma("unroll") for (int n = 0; n < 2; ++n) _Pragma("unroll") for (int k = 0; k < 2; ++k) dst[n][k] = *(const LAS bf16x8*)(lds + PG8_SB(b, h) + boff + n * 2048 + k * 1024); } while (0)
#define PG8_MMA(ai, bj, At, Bt) do { __builtin_amdgcn_s_setprio(1); _Pragma("unroll") for (int m = 0; m < 4; ++m) _Pragma("unroll") for (int n = 0; n < 2; ++n) _Pragma("unroll") for (int k = 0; k < 2; ++k) \
        acc[ai][bj][m][n] = __builtin_amdgcn_mfma_f32_16x16x32_bf16(Bt[n][k], At[m][k], acc[ai][bj][m][n], 0, 0, 0); __builtin_amdgcn_s_setprio(0); } while (0)
#define PG8_WAIT_V(n) asm volatile("s_waitcnt vmcnt(" #n ")" ::: "memory")
#define PG8_WAIT_L(n) asm volatile("s_waitcnt lgkmcnt(" #n ")" ::: "memory")
#define PG8_BAR __builtin_amdgcn_s_barrier()
#define PG8_SCHED __builtin_amdgcn_sched_barrier(0)
    Unit cur, nxt; int ui = 0;
    if (!S.next(0, cur)) return;
    float zf = 0.f; asm volatile("" : "+v"(zf));
    f32x4 acc[2][2][4][2];
#pragma unroll
    for (int a = 0; a < 2; ++a)
#pragma unroll
        for (int b = 0; b < 2; ++b)
#pragma unroll
            for (int m = 0; m < 4; ++m)
#pragma unroll
                for (int n = 0; n < 2; ++n) acc[a][b][m][n] = (f32x4){zf, zf, zf, zf};
    bf16x8 At[4][2], B0[2][2], B1[2][2];
    const char* cA = cur.A; const char* cB = cur.B;
    unsigned lA = cur.lda2, lB = cur.ldb2;
    size_t hA = (size_t)HALF * lA, hB = (size_t)HALF * lB;
    PG8_STAGE(PG8_SB(0, 0), cB, rB, lB); PG8_STAGE(PG8_SB(0, 1), cB + hB, rB, lB); PG8_STAGE(PG8_SA(0, 0), cA, rA, lA); PG8_STAGE(PG8_SA(0, 1), cA + hA, rA, lA);
    if (wr == 1) PG8_BAR;
    PG8_WAIT_V(2); PG8_BAR;
    PG8_STAGE(PG8_SB(1, 0), cB + kstep, rB, lB); PG8_STAGE(PG8_SA(1, 0), cA + kstep, rA, lA); PG8_STAGE(PG8_SB(1, 1), cB + hB + kstep, rB, lB);
    PG8_WAIT_V(6); PG8_BAR;
    for (;;) {
        const bool has_next = S.next(ui + 1, nxt);
        if (!has_next) nxt = cur;
        const char* nA = nxt.A; const char* nB = nxt.B;
        const unsigned lAn = nxt.lda2, lBn = nxt.ldb2;
        const size_t hAn = (size_t)HALF * lAn, hBn = (size_t)HALF * lBn;
        const int nt = cur.nt;
        for (int t = 0; t < nt; t += 2) {
            const bool last = (t == nt - 2);
            const char* a1 = cA + (size_t)(t + 1) * kstep;
            const char* a2 = last ? nA : cA + (size_t)(t + 2) * kstep; const char* b2 = last ? nB : cB + (size_t)(t + 2) * kstep;
            const char* a3 = a2 + kstep; const char* b3 = b2 + kstep;
            const size_t hA2 = last ? hAn : hA, hB2 = last ? hBn : hB;
            const unsigned lA2 = last ? lAn : lA, lB2 = last ? lBn : lB;
            PG8_LDB(B0, 0, 0); PG8_LDB(B1, 0, 1); PG8_SCHED; PG8_LDA(At, 0, 0); PG8_STAGE(PG8_SA(1, 1), a1 + hA, rA, lA);
            PG8_WAIT_V(8); PG8_WAIT_L(0); PG8_BAR; PG8_MMA(0, 0, At, B0); PG8_MMA(0, 1, At, B1); PG8_BAR; PG8_SCHED;
            PG8_LDA(At, 0, 1); PG8_STAGE(PG8_SB(0, 0), b2, rB, lB2); PG8_STAGE(PG8_SB(0, 1), b2 + hB2, rB, lB2); PG8_STAGE(PG8_SA(0, 0), a2, rA, lA2);
            PG8_WAIT_V(8); PG8_WAIT_L(0); PG8_BAR; PG8_MMA(1, 0, At, B0); PG8_MMA(1, 1, At, B1); PG8_BAR; PG8_SCHED;
            PG8_LDB(B0, 1, 0); PG8_LDB(B1, 1, 1); PG8_SCHED; PG8_LDA(At, 1, 0); PG8_STAGE(PG8_SA(0, 1), a2 + hA2, rA, lA2);
            PG8_WAIT_V(8); PG8_WAIT_L(0); PG8_BAR; PG8_MMA(0, 0, At, B0); PG8_MMA(0, 1, At, B1); PG8_BAR; PG8_SCHED;
            PG8_LDA(At, 1, 1); PG8_STAGE(PG8_SB(1, 0), b3, rB, lB2); PG8_STAGE(PG8_SB(1, 1), b3 + hB2, rB, lB2); PG8_STAGE(PG8_SA(1, 0), a3, rA, lA2);
            PG8_WAIT_V(8); PG8_WAIT_L(0); PG8_BAR; PG8_MMA(1, 0, At, B0); PG8_MMA(1, 1, At, B1); PG8_BAR; PG8_SCHED;
        }
        if (wr == 0) PG8_BAR;
        E(acc, cur, wr, wc, fr, fq);
#pragma unroll
        for (int a = 0; a < 2; ++a)
#pragma unroll
            for (int b = 0; b < 2; ++b)
#pragma unroll
                for (int m = 0; m < 4; ++m)
#pragma unroll
                    for (int n = 0; n < 2; ++n) acc[a][b][m][n] = (f32x4){zf, zf, zf, zf};
        if (!has_next) break;
        cur = nxt; cA = nA; cB = nB; hA = hAn; hB = hBn; lA = lAn; lB = lBn; ++ui;
        if (wr == 1) PG8_BAR;
    }
    PG8_WAIT_V(0);
    PG8_BAR;
#undef PG8_SA
#undef PG8_SB
#undef PG8_STAGE
#undef PG8_LDA
#undef PG8_LDB
#undef PG8_MMA
#undef PG8_WAIT_V
#undef PG8_WAIT_L
#undef PG8_BAR
#undef PG8_SCHED
}
}
using pg8::Unit;

struct SchedPlain {
    const bf16_t* A; int lda; const bf16_t* B; int K; int nM, nN, G, c, ocol0;
    __device__ __forceinline__ bool next(int i, Unit& u) const {
        const int L = i * G + c; if (L >= nM * nN) return false;
        int pm, pn; pg8::tile_of(L, nM, nN, pm, pn); pm += 1;
        u.pm = pm; u.pn = pn; u.kind = 0; u.ocol = ocol0 + 256 * pn; u.nt = K / 64; u.lda2 = (unsigned)lda * 2u; u.ldb2 = (unsigned)K * 2u;
        u.A = (const char*)(A + (size_t)pm * 256 * lda); u.B = (const char*)(B + (size_t)pn * 256 * K); return true;
    }
};
struct SchedMlaUp {
    const bf16_t* P; const bf16_t* Wq; const bf16_t* Wkv; int G, c;
    __device__ __forceinline__ bool next(int i, Unit& u) const {
        const int L = i * G + c; if (L >= NPMM * 14) return false;
        int pm, pn; pg8::tile_of(L, NPMM, 14, pm, pn); pm += 1;
        u.pm = pm; u.pn = pn; u.kind = 0; u.nt = 8; u.lda2 = PW * 2u; u.ldb2 = 512 * 2u;
        if (pn < 6) { u.A = (const char*)(P + (size_t)pm * 256 * PW + C_CQ); u.B = (const char*)(Wq + (size_t)pn * 256 * 512); u.ocol = C_QRAW + 256 * pn; }
        else { u.A = (const char*)(P + (size_t)pm * 256 * PW + C_CKV); u.B = (const char*)(Wkv + (size_t)(pn - 6) * 256 * 512); u.ocol = C_KVRAW + 256 * (pn - 6); }
        return true;
    }
};
struct EpiP {
    static constexpr bool PERM = true;
    bf16_t* P; const float* rs;
    __device__ __forceinline__ void operator()(const f32x4 (&acc)[2][2][4][2], const Unit& u, int wr, int wc, int fr, int fq) const {
        asm volatile("" : "+v"(fr), "+v"(fq));
        const int row0 = u.pm * 256 + wr * 64 + fr, col0 = u.ocol + wc * 32 + 8 * fq;
#pragma unroll
        for (int ai = 0; ai < 2; ++ai)
#pragma unroll
            for (int m = 0; m < 4; ++m) { bf16_t* rowp = P + (size_t)(row0 + ai * 128 + m * 16) * PW + col0;
                const float sc = rs ? __builtin_amdgcn_rsqf(rs[row0 + ai * 128 + m * 16] * (1.f / DM) + EPS) : 1.f;
#pragma unroll
                for (int bj = 0; bj < 2; ++bj) { const f32x4 v0 = acc[ai][bj][m][0] * sc, v1 = acc[ai][bj][m][1] * sc;
                    u32x4 w; w.x = cvt_pk_bf16(v0[0], v0[1]); w.y = cvt_pk_bf16(v0[2], v0[3]); w.z = cvt_pk_bf16(v1[0], v1[1]); w.w = cvt_pk_bf16(v1[2], v1[3]);
                    *(u32x4*)(rowp + bj * 128) = w; } }
    }
};
struct EpiG2 {
    static constexpr bool PERM = true;
    bf16_t* P; const float* rs; const float* gperm; LAS float* xl;
    __device__ __forceinline__ void operator()(const f32x4 (&acc)[2][2][4][2], const Unit& u, int wr, int wc, int fr, int fq) const {
        asm volatile("" : "+v"(fr), "+v"(fq));
        const int row0 = u.pm * 256 + wr * 64 + fr, lcol = wc * 32 + 8 * fq, col0 = u.ocol + lcol;
        const int pn = u.pn;
        const bool plain = (pn >= 8 && pn < 12) || pn >= 24, isidx = (pn >= 12 && pn < 16), nrm = !plain && !isidx;
        float rsc[2][4];
#pragma unroll
        for (int ai = 0; ai < 2; ++ai)
#pragma unroll
            for (int m = 0; m < 4; ++m) rsc[ai][m] = __builtin_amdgcn_rsqf(rs[row0 + ai * 128 + m * 16] * (1.f / DM) + EPS);
        if (nrm) {
#pragma unroll
            for (int ai = 0; ai < 2; ++ai)
#pragma unroll
                for (int m = 0; m < 4; ++m)
#pragma unroll
                    for (int bj = 0; bj < 2; ++bj) { const f32x4 a = acc[ai][bj][m][0], b = acc[ai][bj][m][1]; float ss = (a[0] * a[0] + a[1] * a[1]) + (a[2] * a[2] + a[3] * a[3]) + (b[0] * b[0] + b[1] * b[1]) + (b[2] * b[2] + b[3] * b[3]);
                        ss += __shfl_xor(ss, 16); ss += __shfl_xor(ss, 32);
                        if (fq == 0) xl[((wr * 64 + fr + ai * 128 + m * 16) * 2 + bj) * 4 + wc] = ss * rsc[ai][m] * rsc[ai][m]; }
            asm volatile("s_waitcnt lgkmcnt(0)" ::: "memory"); __builtin_amdgcn_s_barrier(); asm volatile("" ::: "memory");
        }
        const int i0 = isidx ? (16 * (wc & 1) + 4 * fq) : (16 * wc + 4 * fq);
        const float tod = isidx ? (2.f / 64.f) : (2.f / 128.f);
        float inv[4];
#pragma unroll
        for (int j = 0; j < 4; ++j) inv[j] = __builtin_amdgcn_exp2f(-(float)(i0 + j) * tod * 13.287712379549449f) * 0.15915494309189535f;
        const int gidx = pn < 4 ? 0 : (pn < 8 ? 1 : (pn < 20 ? 2 : 3));
        const float qscale = (pn < 4 || (pn >= 16 && pn < 20)) ? C2_128 : 1.f;
        f32x4 g0 = (f32x4){1.f, 1.f, 1.f, 1.f}, g1 = g0;
        if (nrm) { g0 = *(const f32x4*)(gperm + gidx * 128 + lcol); g1 = *(const f32x4*)(gperm + gidx * 128 + lcol + 4); }
#pragma unroll
        for (int ai = 0; ai < 2; ++ai)
#pragma unroll
            for (int m = 0; m < 4; ++m) { const int row = row0 + ai * 128 + m * 16; bf16_t* rowp = P + (size_t)row * PW + col0;
                float cs[4], sn[4];
                if (!plain) { const float pos = (float)(NMETA + ((row - MBLK) & (SEQ - 1)));
#pragma unroll
                    for (int j = 0; j < 4; ++j) { float rev = pos * inv[j]; rev -= floorf(rev); sn[j] = __builtin_amdgcn_sinf(rev); cs[j] = __builtin_amdgcn_cosf(rev); } }
#pragma unroll
                for (int bj = 0; bj < 2; ++bj) { f32x4 v0 = acc[ai][bj][m][0] * rsc[ai][m], v1 = acc[ai][bj][m][1] * rsc[ai][m];
                    if (!plain) {
                        if (nrm) { const LAS f32x4* xp = (const LAS f32x4*)(xl + ((wr * 64 + fr + ai * 128 + m * 16) * 2 + bj) * 4); const f32x4 pp = *xp;
                            const float rn = __builtin_amdgcn_rsqf(((pp[0] + pp[1]) + (pp[2] + pp[3])) * (1.f / 128.f) + EPS); v0 = v0 * (g0 * rn); v1 = v1 * (g1 * rn); }
                        f32x4 w0, w1;
                        w0[0] = v0[0] * cs[0] - v0[1] * sn[0]; w0[1] = v0[1] * cs[0] + v0[0] * sn[0]; w0[2] = v0[2] * cs[1] - v0[3] * sn[1]; w0[3] = v0[3] * cs[1] + v0[2] * sn[1];
                        w1[0] = v1[0] * cs[2] - v1[1] * sn[2]; w1[1] = v1[1] * cs[2] + v1[0] * sn[2]; w1[2] = v1[2] * cs[3] - v1[3] * sn[3]; w1[3] = v1[3] * cs[3] + v1[2] * sn[3];
                        v0 = w0 * qscale; v1 = w1 * qscale; }
                    u32x4 w; w.x = cvt_pk_bf16(v0[0], v0[1]); w.y = cvt_pk_bf16(v0[2], v0[3]); w.z = cvt_pk_bf16(v1[0], v1[1]); w.w = cvt_pk_bf16(v1[2], v1[3]);
                    *(u32x4*)(rowp + bj * 128) = w; } }
    }
};
struct EpiGate {
    static constexpr bool PERM = true;
    bf16_t* G; const float* bias; const float* rs;
    __device__ __forceinline__ void operator()(const f32x4 (&acc)[2][2][4][2], const Unit& u, int wr, int wc, int fr, int fq) const {
        asm volatile("" : "+v"(fr), "+v"(fq));
        const int row0 = u.pm * 256 + wr * 64 + fr, col0 = u.pn * 256 + wc * 32 + 8 * fq;
        float rsc[2][4];
#pragma unroll
        for (int ai = 0; ai < 2; ++ai)
#pragma unroll
            for (int m = 0; m < 4; ++m) rsc[ai][m] = __builtin_amdgcn_rsqf(rs[row0 + ai * 128 + m * 16] * (1.f / DM) + EPS);
#pragma unroll
        for (int bj = 0; bj < 2; ++bj) { const f32x4 bv0 = *(const f32x4*)(bias + col0 + bj * 128), bv1 = *(const f32x4*)(bias + col0 + bj * 128 + 4);
#pragma unroll
            for (int ai = 0; ai < 2; ++ai)
#pragma unroll
                for (int m = 0; m < 4; ++m) { bf16_t* rowp = G + (size_t)(row0 + ai * 128 + m * 16) * 2048 + col0; f32x4 v0 = acc[ai][bj][m][0] * rsc[ai][m] + bv0, v1 = acc[ai][bj][m][1] * rsc[ai][m] + bv1;
#pragma unroll
                    for (int e = 0; e < 4; ++e) { v0[e] = __builtin_amdgcn_rcpf(1.f + __builtin_amdgcn_exp2f(-v0[e] * LOG2E)); v1[e] = __builtin_amdgcn_rcpf(1.f + __builtin_amdgcn_exp2f(-v1[e] * LOG2E)); }
                    u32x4 w; w.x = cvt_pk_bf16(v0[0], v0[1]); w.y = cvt_pk_bf16(v0[2], v0[3]); w.z = cvt_pk_bf16(v1[0], v1[1]); w.w = cvt_pk_bf16(v1[2], v1[3]);
                    *(u32x4*)(rowp + bj * 128) = w; } }
    }
};
struct EpiGated {
    static constexpr bool PERM = true;
    bf16_t* P; const bf16_t* G; int first; float sc;
    __device__ __forceinline__ void operator()(const f32x4 (&acc)[2][2][4][2], const Unit& u, int wr, int wc, int fr, int fq) const {
        asm volatile("" : "+v"(fr), "+v"(fq));
        const int row0 = u.pm * 256 + wr * 64 + fr, lcol0 = u.pn * 256 + wc * 32 + 8 * fq, col0 = u.ocol + wc * 32 + 8 * fq;
        unsigned zu = 0u; asm volatile("" : "+v"(zu));
#pragma unroll
        for (int ai = 0; ai < 2; ++ai)
#pragma unroll
            for (int m = 0; m < 4; ++m) { bf16_t* rowp = P + (size_t)(row0 + ai * 128 + m * 16) * PW + col0; const bf16_t* gp = G + (size_t)(row0 + ai * 128 + m * 16) * 2048 + lcol0;
#pragma unroll
                for (int bj = 0; bj < 2; ++bj) { u32x4 g = *(const u32x4*)(gp + bj * 128); if (DBG_BR == 1) g = (u32x4){0x3f803f80u, 0x3f803f80u, 0x3f803f80u, 0x3f803f80u};
                    u32x4 pv = (u32x4){zu, zu, zu, zu}; if (!first) pv = *(const u32x4*)(rowp + bj * 128);
                    const f32x4 v0 = acc[ai][bj][m][0] * sc, v1 = acc[ai][bj][m][1] * sc;
                    float o[8];
                    o[0] = __uint_as_float(pv.x << 16) + __uint_as_float(g.x << 16) * v0[0]; o[1] = __uint_as_float(pv.x & 0xffff0000u) + __uint_as_float(g.x & 0xffff0000u) * v0[1];
                    o[2] = __uint_as_float(pv.y << 16) + __uint_as_float(g.y << 16) * v0[2]; o[3] = __uint_as_float(pv.y & 0xffff0000u) + __uint_as_float(g.y & 0xffff0000u) * v0[3];
                    o[4] = __uint_as_float(pv.z << 16) + __uint_as_float(g.z << 16) * v1[0]; o[5] = __uint_as_float(pv.z & 0xffff0000u) + __uint_as_float(g.z & 0xffff0000u) * v1[1];
                    o[6] = __uint_as_float(pv.w << 16) + __uint_as_float(g.w << 16) * v1[2]; o[7] = __uint_as_float(pv.w & 0xffff0000u) + __uint_as_float(g.w & 0xffff0000u) * v1[3];
                    u32x4 w; w.x = cvt_pk_bf16(o[0], o[1]); w.y = cvt_pk_bf16(o[2], o[3]); w.z = cvt_pk_bf16(o[4], o[5]); w.w = cvt_pk_bf16(o[6], o[7]);
                    *(u32x4*)(rowp + bj * 128) = w; }
                asm volatile("" ::: "memory"); }
    }
};
struct EpiRes {
    static constexpr bool PERM = false;
    const float* base_tok; float* out_tok; float* hmeta; float dbg; bf16_t* hb; float* rs;
    __device__ __forceinline__ void operator()(const f32x4 (&acc)[2][2][4][2], const Unit& u, int wr, int wc, int fr, int fq) const {
        asm volatile("" : "+v"(fr), "+v"(fq));
        const float* bp; float* op;
        if (u.pm == 0) { bp = hmeta; op = hmeta; } else { bp = base_tok + (size_t)(u.pm - 1) * 256 * DM; op = out_tok + (size_t)(u.pm - 1) * 256 * DM; }
        const int lrow0 = wr * 64 + fr, col0 = u.pn * 256 + wc * 32 + 4 * fq;
#pragma unroll
        for (int ai = 0; ai < 2; ++ai)
#pragma unroll
            for (int m = 0; m < 4; ++m) { const size_t off = (size_t)(lrow0 + ai * 128 + m * 16) * DM + col0;
                const int grow = u.pm * 256 + lrow0 + ai * 128 + m * 16; float ss = 0.f;
#pragma unroll
                for (int bj = 0; bj < 2; ++bj)
#pragma unroll
                    for (int n = 0; n < 2; ++n) { const f32x4 bs = *(const f32x4*)(bp + off + bj * 128 + n * 16); const f32x4 hv = bs + acc[ai][bj][m][n] * dbg; *(f32x4*)(op + off + bj * 128 + n * 16) = hv;
                        if (hb) { ss += (hv[0] * hv[0] + hv[1] * hv[1]) + (hv[2] * hv[2] + hv[3] * hv[3]); u32x2 w; w.x = cvt_pk_bf16(hv[0], hv[1]); w.y = cvt_pk_bf16(hv[2], hv[3]); *(u32x2*)(hb + (size_t)grow * DM + col0 + bj * 128 + n * 16) = w; } }
                if (hb) { ss += __shfl_xor(ss, 16); ss += __shfl_xor(ss, 32); if (fq == 0) (void)__hip_atomic_fetch_add(rs + grow, ss, __ATOMIC_RELAXED, __HIP_MEMORY_SCOPE_AGENT); }
                asm volatile("" ::: "memory"); }
    }
};
struct EpiSwiglu {
    static constexpr bool PERM = true;
    bf16_t* P; const float* rs;
    __device__ __forceinline__ void operator()(const f32x4 (&acc)[2][2][4][2], const Unit& u, int wr, int wc, int fr, int fq) const {
        asm volatile("" : "+v"(fr), "+v"(fq));
        const int row0 = u.pm * 256 + wr * 64 + fr, col0 = u.pn * 128 + wc * 32 + 8 * fq;
#pragma unroll
        for (int ai = 0; ai < 2; ++ai)
#pragma unroll
            for (int m = 0; m < 4; ++m) { bf16_t* rowp = P + (size_t)(row0 + ai * 128 + m * 16) * PW + col0;
                const float sc = __builtin_amdgcn_rsqf(rs[row0 + ai * 128 + m * 16] * (1.f / DM) + EPS);
                float o[8];
#pragma unroll
                for (int n = 0; n < 2; ++n)
#pragma unroll
                    for (int e = 0; e < 4; ++e) { const float g = acc[ai][0][m][n][e] * sc, up = acc[ai][1][m][n][e] * sc; o[n * 4 + e] = g * __builtin_amdgcn_rcpf(1.f + __builtin_amdgcn_exp2f(-g * LOG2E)) * up; }
                u32x4 w; w.x = cvt_pk_bf16(o[0], o[1]); w.y = cvt_pk_bf16(o[2], o[3]); w.z = cvt_pk_bf16(o[4], o[5]); w.w = cvt_pk_bf16(o[6], o[7]);
                *(u32x4*)rowp = w; }
    }
};

struct SkP { bf16_t* P; int ocol; const float* rs; __device__ __forceinline__ void operator()(int r, int c, float v) const { if (rs) v *= __builtin_amdgcn_rsqf(rs[MROW0 + r] * (1.f / DM) + EPS); P[(size_t)(MROW0 + r) * PW + ocol + c] = (bf16_t)f2bf(v); } };
struct SkGate { bf16_t* G; const float* bias; const float* rs; __device__ __forceinline__ void operator()(int r, int c, float v) const { v *= __builtin_amdgcn_rsqf(rs[MROW0 + r] * (1.f / DM) + EPS); G[(size_t)(MROW0 + r) * 2048 + c] = (bf16_t)f2bf(__builtin_amdgcn_rcpf(1.f + __builtin_amdgcn_exp2f(-(v + bias[c]) * LOG2E))); } };
struct SkGated { bf16_t* P; const bf16_t* G; int first; __device__ __forceinline__ void operator()(int r, int c, float v) const { bf16_t* p = P + (size_t)(MROW0 + r) * PW + C_MERGED + c; const float pv = first ? 0.f : bf2f(*p); *p = (bf16_t)f2bf(pv + bf2f(G[(size_t)(MROW0 + r) * 2048 + c]) * v); } };
struct SkRes { float* hmeta; bf16_t* hb; float* rs;
    __device__ __forceinline__ void operator()(int r, int c, float v) const { float* p = hmeta + (size_t)(MROW0 + r) * DM + c; const float hv = *p + v; *p = hv;
        if (hb) { hb[(size_t)(MROW0 + r) * DM + c] = (bf16_t)f2bf(hv); float ss = hv * hv; ss += __shfl_xor(ss, 1); ss += __shfl_xor(ss, 2); ss += __shfl_xor(ss, 4); ss += __shfl_xor(ss, 8);
            if ((threadIdx.x & 15) == 0) (void)__hip_atomic_fetch_add(rs + MROW0 + r, ss, __ATOMIC_RELAXED, __HIP_MEMORY_SCOPE_AGENT); } } };
template <class Fn>
__device__ __forceinline__ void skinny_gemm(LAS unsigned char* lds, const bf16_t* A, int lda, const bf16_t* Bt, int K, int ntask, int bid, int G, const Fn& f) {
    int tid = threadIdx.x; asm volatile("" : "+v"(tid));
    const int wid = __builtin_amdgcn_readfirstlane(tid >> 6), lane = tid & 63, l15 = lane & 15, kq = lane >> 4;
    LAS f32x4* red = (LAS f32x4*)lds;
    const int kw = K / 8;
    for (int task = bid; task < ntask; task += G) {
        const bf16_t* ap = A + (size_t)l15 * lda + wid * kw + kq * 8;
        const bf16_t* bp = Bt + (size_t)(task * 16 + l15) * K + wid * kw + kq * 8;
        float z = 0.f; asm volatile("" : "+v"(z));
        f32x4 acc = (f32x4){z, z, z, z};
        for (int k0 = 0; k0 < kw; k0 += 256) {
            bf16x8 fa[8], fb[8];
#pragma unroll
            for (int i = 0; i < 8; ++i) { const int k = (k0 + 32 * i < kw) ? k0 + 32 * i : 0; fa[i] = *(const bf16x8*)(ap + k); fb[i] = *(const bf16x8*)(bp + k); }
#pragma unroll
            for (int i = 0; i < 8; ++i) if (k0 + 32 * i < kw) acc = __builtin_amdgcn_mfma_f32_16x16x32_bf16(fa[i], fb[i], acc, 0, 0, 0);
        }
        red[wid * 64 + lane] = acc;
        LDS_WAIT(); __syncthreads();
        if (wid == 0) {
            f32x4 s = red[lane];
#pragma unroll
            for (int w = 1; w < 8; ++w) s += red[w * 64 + lane];
#pragma unroll
            for (int r = 0; r < 4; ++r) f(kq * 4 + r, task * 16 + l15, s[r]);
        }
        __syncthreads();
    }
}
__device__ __forceinline__ void skinny_swiglu(LAS unsigned char* lds, const bf16_t* A, int lda, const bf16_t* Bt, int K, bf16_t* P, const float* rs, int bid, int G) {
    int tid = threadIdx.x; asm volatile("" : "+v"(tid));
    const int wid = __builtin_amdgcn_readfirstlane(tid >> 6), lane = tid & 63, l15 = lane & 15, kq = lane >> 4;
    LAS f32x4* red = (LAS f32x4*)lds;
    const int kw = K / 8;
    for (int task = bid; task < DFF / 16; task += G) {
        const int c0 = task * 16, brow = (c0 >> 7) * 256 + (c0 & 127) + l15;
        const bf16_t* ap = A + (size_t)l15 * lda + wid * kw + kq * 8;
        const bf16_t* bg = Bt + (size_t)brow * K + wid * kw + kq * 8; const bf16_t* bu = bg + (size_t)128 * K;
        float z = 0.f; asm volatile("" : "+v"(z));
        f32x4 ag = (f32x4){z, z, z, z}, au = ag;
        {
            bf16x8 fa[8], fg[8], fu[8];
#pragma unroll
            for (int i = 0; i < 8; ++i) { fa[i] = *(const bf16x8*)(ap + 32 * i); fg[i] = *(const bf16x8*)(bg + 32 * i); fu[i] = *(const bf16x8*)(bu + 32 * i); }
#pragma unroll
            for (int i = 0; i < 8; ++i) { ag = __builtin_amdgcn_mfma_f32_16x16x32_bf16(fa[i], fg[i], ag, 0, 0, 0); au = __builtin_amdgcn_mfma_f32_16x16x32_bf16(fa[i], fu[i], au, 0, 0, 0); }
        }
        red[wid * 64 + lane] = ag; red[512 + wid * 64 + lane] = au;
        LDS_WAIT(); __syncthreads();
        if (wid == 0) {
            f32x4 sg = red[lane], su = red[512 + lane];
#pragma unroll
            for (int w = 1; w < 8; ++w) { sg += red[w * 64 + lane]; su += red[512 + w * 64 + lane]; }
#pragma unroll
            for (int r = 0; r < 4; ++r) { const float sc = __builtin_amdgcn_rsqf(rs[MROW0 + kq * 4 + r] * (1.f / DM) + EPS); const float g = sg[r] * sc; su[r] *= sc; P[(size_t)(MROW0 + kq * 4 + r) * PW + c0 + l15] = (bf16_t)f2bf(g * __builtin_amdgcn_rcpf(1.f + __builtin_amdgcn_exp2f(-g * LOG2E)) * su[r]); }
        }
        __syncthreads();
    }
}

#define XB_TMO      128
#define XB_XCNT(j)  (256  + 64 * (j))
#define XB_XSUB(j)  (1280 + 64 * (j))
#define XB_XGEN(j)  (2304 + 64 * (j))
#define XB_TOP      3328
#define XB_TOPGEN   3392
#define XCD_BAR_WORDS 3456
#define XB_SPIN_CAP (1u << 18)
__device__ __forceinline__ unsigned xb_ld(unsigned* p)              { return __hip_atomic_load(p, __ATOMIC_RELAXED, __HIP_MEMORY_SCOPE_AGENT); }
__device__ __forceinline__ unsigned xb_add(unsigned* p, unsigned v) { return __hip_atomic_fetch_add(p, v, __ATOMIC_RELAXED, __HIP_MEMORY_SCOPE_AGENT); }
__device__ __forceinline__ unsigned xb_xcc_id() { return (unsigned)__builtin_amdgcn_s_getreg((3 << 11) | 20) & 0xFu; }
#define XB_SPIN(cond, bar) do { unsigned _sp = 0; while (cond) { __builtin_amdgcn_s_sleep(1); \
    if ((++_sp & 255u) == 0u) { if (xb_ld(&(bar)[XB_TMO])) break; if (_sp > XB_SPIN_CAP) { atomicAdd(&(bar)[XB_TMO], 1u); break; } } } } while (0)
struct XcdBarrier { unsigned* bar; unsigned x; volatile LAS unsigned* st; };
__device__ __forceinline__ XcdBarrier xcd_barrier_post(unsigned* bar, volatile LAS unsigned* st) {
    XcdBarrier b; b.bar = bar; b.x = xb_xcc_id(); b.st = st;
    if (threadIdx.x == 0) (void)xb_add(&bar[XB_XCNT(b.x)], 1u);
    return b;
}
__device__ __forceinline__ void xcd_barrier_complete(unsigned* bar, unsigned x, unsigned& nloc, unsigned& nx) {
    const unsigned G = gridDim.x * gridDim.y * gridDim.z;
    unsigned sum, cnt, mine, sp = 0u;
    for (;;) {
        sum = 0u; cnt = 0u; mine = 0u;
#pragma unroll
        for (unsigned j = 0; j < 16; ++j) { const unsigned c = xb_ld(&bar[XB_XCNT(j)]); sum += c; cnt += (c > 0u) ? 1u : 0u; mine = (j == x) ? c : mine; }
        if (sum == G) break;
        __builtin_amdgcn_s_sleep(1);
        if ((++sp & 255u) == 0u) { if (xb_ld(&bar[XB_TMO])) break; if (sp > XB_SPIN_CAP) { atomicAdd(&bar[XB_TMO], 1u); break; } }
    }
    nloc = mine > 0u ? mine : 1u; nx = cnt > 0u ? cnt : 1u;
}
__device__ __forceinline__ void xcd_barrier(const XcdBarrier& b) {
    asm volatile("s_waitcnt vmcnt(0)" ::: "memory");
    __syncthreads();
    if (threadIdx.x == 0) {
        unsigned* bar = b.bar;
        __builtin_amdgcn_s_waitcnt(0);
        unsigned nloc = b.st[0], nx = b.st[1];
        if (nloc == 0u) { xcd_barrier_complete(bar, b.x, nloc, nx); b.st[0] = nloc; b.st[1] = nx; }
        const unsigned old = xb_add(&bar[XB_XSUB(b.x)], 1u);
        const unsigned gen = old / nloc;
        if (old + 1u == (gen + 1u) * nloc) {
            __builtin_amdgcn_fence(__ATOMIC_RELEASE, "agent");
            asm volatile("s_waitcnt vmcnt(0)" ::: "memory");
            const unsigned og = xb_add(&bar[XB_TOP], 1u);
            const unsigned tg = og / nx;
            if (og + 1u == (tg + 1u) * nx) xb_add(&bar[XB_TOPGEN], 1u);
            else XB_SPIN(xb_ld(&bar[XB_TOPGEN]) == tg, bar);
            __builtin_amdgcn_fence(__ATOMIC_ACQUIRE, "agent");
            xb_add(&bar[XB_XGEN(b.x)], 1u);
            asm volatile("s_waitcnt vmcnt(0)" ::: "memory");
        } else {
            XB_SPIN(xb_ld(&bar[XB_XGEN(b.x)]) == gen, bar);
            __builtin_amdgcn_fence(__ATOMIC_ACQUIRE, "agent");
            asm volatile("s_waitcnt vmcnt(0)" ::: "memory");
        }
    }
    __syncthreads();
}

constexpr int NWAVES = 8;
constexpr int RING_BYTES = 131072, LDS_BYTES = 147456, LDSCTL_OFF = LDS_BYTES - 512;
struct Args {
    const float* in[19]; float* out; unsigned char* ws; int ph_lo, ph_hi;
};
struct Ctx {
    LAS unsigned char* lds; int tid, lane, wave, gw, ngw, G, bid;
};

template <int MAP> __device__ __forceinline__ int wmap(int n, float& sc) {
    sc = 1.f;
    if (MAP == 0) return n;
    if (MAP == 1) {
        if (n < 1088) return n;
        if (n < 3136) { const int m = n - 1088, d = m & 127; return 1280 + (m - d) + (d < 64 ? 2 * d : 2 * (d - 64) + 1); }
        if (n < 4160) return 1280 + (n - 1088);
        if (n < 5184) { const int m = n - 4160, d = m & 63; return 4352 + (m - d) + (d < 32 ? 2 * d : 2 * (d - 32) + 1); }
        if (n < 5248) { const int d = n - 5184; return 1088 + (d < 32 ? 2 * d : 2 * (d - 32) + 1); }
        if (n < 5264) { sc = 0.03125f; return 1152 + (n - 5248); }
        if (n < 7312) { const int m = n - 5264, d = m & 127; return 5376 + (m - d) + (d < 64 ? 2 * d : 2 * (d - 64) + 1); }
        if (n < 8336) return 5376 + (n - 5264);
        return 8448 + (n - 8336);
    }
    if (n < DFF) return (n >> 7) * 256 + (n & 127);
    const int m = n - DFF; return (m >> 7) * 256 + 128 + (m & 127);
}
template <int MAP> __device__ __forceinline__ void conv_item(const float* W, int K, int N, bf16_t* WT, const float* gain, LAS float* scr, int item, int lane) {
    const int nblk = (N + 31) / 32, kb = item / nblk, nb = item - kb * nblk, k0 = 64 * kb, n0 = 32 * nb;
    const int nn = n0 + (lane & 31);
    float wv[32];
#pragma unroll
    for (int i = 0; i < 32; ++i) { const int kk = 2 * i + (lane >> 5); wv[i] = (nn < N) ? W[(size_t)(k0 + kk) * N + nn] : 0.f; }
#pragma unroll
    for (int i = 0; i < 32; ++i) { const int kk = 2 * i + (lane >> 5); float v = wv[i]; if (gain) v *= gain[k0 + kk]; scr[kk * 33 + (lane & 31)] = v; }
    LDS_WAIT(); asm volatile("" ::: "memory");
    const int c = lane & 7;
#pragma unroll
    for (int j = 0; j < 4; ++j) { const int n = (lane >> 3) + 8 * j; const int ns = n0 + n;
        if (ns < N) { float sc; const int dst = wmap<MAP>(ns, sc); const LAS float* s = scr + (8 * c) * 33 + n;
            u32x4 o; o.x = pk2(s[0 * 33] * sc, s[1 * 33] * sc); o.y = pk2(s[2 * 33] * sc, s[3 * 33] * sc); o.z = pk2(s[4 * 33] * sc, s[5 * 33] * sc); o.w = pk2(s[6 * 33] * sc, s[7 * 33] * sc);
            *(u32x4*)(WT + (size_t)dst * K + k0 + 8 * c) = o; } }
    LDS_WAIT(); asm volatile("" ::: "memory");
}
template <int MAP> __device__ __forceinline__ void conv_matrix(const Ctx& F, const float* W, int K, int N, bf16_t* WT, const float* gain) {
    LAS float* scr = (LAS float*)(F.lds + F.wave * 16384);
    const int nit = (K / 64) * ((N + 31) / 32);
    for (int it = F.gw; it < nit; it += F.ngw) conv_item<MAP>(W, K, N, WT, gain, scr, it, F.lane);
}

__device__ __forceinline__ void norm_row(const float* hrow, bf16_t* orow, float* rs_row, int lane) {
    f32x4 v[8]; float s = 0.f;
#pragma unroll
    for (int j = 0; j < 8; ++j) { v[j] = *((const f32x4*)hrow + lane + 64 * j); s += (v[j].x * v[j].x + v[j].y * v[j].y) + (v[j].z * v[j].z + v[j].w * v[j].w); }
    s = wave_sum(s);
    if (lane == 0) *rs_row = s;
#pragma unroll
    for (int j = 0; j < 8; ++j) { u32x2 o; o.x = cvt_pk_bf16(v[j].x, v[j].y); o.y = cvt_pk_bf16(v[j].z, v[j].w); *((u32x2*)orow + lane + 64 * j) = o; }
}

__device__ __forceinline__ void post1a_row(const bf16_t* P, int r, float* rstdq, float* rstdkv, int lane) {
    const bf16_t* p = P + (size_t)r * PW;
    const u32x4 a = *((const u32x4*)(p + C_CQ) + lane), b = *((const u32x4*)(p + C_CKV) + lane);
    float sa = 0.f, sb = 0.f;
#pragma unroll
    for (int e = 0; e < 4; ++e) { const float x0 = __uint_as_float(a[e] << 16), x1 = __uint_as_float(a[e] & 0xffff0000u); sa += x0 * x0 + x1 * x1;
        const float y0 = __uint_as_float(b[e] << 16), y1 = __uint_as_float(b[e] & 0xffff0000u); sb += y0 * y0 + y1 * y1; }
    sa = wave_sum(sa); sb = wave_sum(sb);
    if (lane == 0) { rstdq[r] = 1.0f / sqrtf(sa * (1.f / 512.f) + EPS); rstdkv[r] = 1.0f / sqrtf(sb * (1.f / 512.f) + EPS); }
    { unsigned* ikp = (unsigned*)(P + (size_t)r * PW + C_IK) + (lane & 31); const unsigned w = *ikp; const float x1 = __uint_as_float(w << 16), x2 = __uint_as_float(w & 0xffff0000u);
      float cs, sn; rope_cs(row_pos(r), lane & 31, 2.f / 64.f, cs, sn);
      if (lane < 32) *ikp = cvt_pk_bf16(x1 * cs - x2 * sn, x2 * cs + x1 * sn); }
}
__device__ __forceinline__ void meta_post_row(bf16_t* P, int r, const float* gperm, int lane) {
    bf16_t* p = P + (size_t)r * PW; const int pos = row_pos(r);
    float c128, s128, c64, s64; rope_cs(pos, lane, 2.f / 128.f, c128, s128); rope_cs(pos, lane & 31, 2.f / 64.f, c64, s64);
#pragma unroll 1
    for (int t = 0; t < 4; ++t) {
        const int cb = t == 0 ? C_DQ : (t == 1 ? C_DK : (t == 2 ? C_FQ : C_FK)); const float sc = (t == 0 || t == 2) ? C2_128 : 1.f;
        const float ga = gperm[t * 128 + 2 * lane], gb = gperm[t * 128 + 2 * lane + 1];
#pragma unroll 1
        for (int h = 0; h < 8; ++h) { unsigned* xp = (unsigned*)(p + cb + h * 128) + lane; const unsigned w = *xp; float x1 = __uint_as_float(w << 16), x2 = __uint_as_float(w & 0xffff0000u);
            const float rn = __builtin_amdgcn_rsqf(wave_sum(x1 * x1 + x2 * x2) * (1.f / 128.f) + EPS); x1 *= rn * ga; x2 *= rn * gb;
            *xp = cvt_pk_bf16((x1 * c128 - x2 * s128) * sc, (x2 * c128 + x1 * s128) * sc); }
    }
#pragma unroll 1
    for (int hh = 0; hh < 8; ++hh) { unsigned* xp = (unsigned*)(p + C_IQ + hh * 128) + lane; const unsigned w = *xp; const float x1 = __uint_as_float(w << 16), x2 = __uint_as_float(w & 0xffff0000u);
        *xp = cvt_pk_bf16(x1 * c64 - x2 * s64, x2 * c64 + x1 * s64); }
}
__device__ __forceinline__ void unpack8(const u32x4& w, float (&x)[8]) {
#pragma unroll
    for (int e = 0; e < 4; ++e) { x[2 * e] = __uint_as_float(w[e] << 16); x[2 * e + 1] = __uint_as_float(w[e] & 0xffff0000u); }
}
__device__ __forceinline__ u32x4 pack8(const float (&x)[8]) { u32x4 w; w.x = cvt_pk_bf16(x[0], x[1]); w.y = cvt_pk_bf16(x[2], x[3]); w.z = cvt_pk_bf16(x[4], x[5]); w.w = cvt_pk_bf16(x[6], x[7]); return w; }
__device__ __forceinline__ u32x4 shfl_xor4(const u32x4& w, int m) { u32x4 r; r.x = __shfl_xor(w.x, m); r.y = __shfl_xor(w.y, m); r.z = __shfl_xor(w.z, m); r.w = __shfl_xor(w.w, m); return r; }
__device__ __forceinline__ void post2_row(bf16_t* P, int r, const float* rstdq, const float* rstdkv, const float* qkg  , LAS float* rnl, int lane) {
    bf16_t* p = P + (size_t)r * PW;
    const float sq = rstdq[r], skv = rstdkv[r];
    const int pos = row_pos(r), hw = lane >> 5, l5 = lane & 31;
    float c64[8], s64[8];
#pragma unroll
    for (int j = 0; j < 8; ++j) rope_cs(pos, 8 * (lane & 3) + j, 2.f / 64.f, c64[j], s64[j]);
    float kp[8]; { const u32x4 w = *(const u32x4*)(p + C_KPE + (lane & 7) * 8); unpack8(w, kp); }
    float kpe_ss = 0.f;
#pragma unroll
    for (int j = 0; j < 8; ++j) kpe_ss += kp[j] * kp[j];
    kpe_ss += __shfl_xor(kpe_ss, 1); kpe_ss += __shfl_xor(kpe_ss, 2); kpe_ss += __shfl_xor(kpe_ss, 4);
    u32x4 rq[4], rkv[4];
#pragma unroll
    for (int it = 0; it < 4; ++it) { const int h = 2 * it + hw; rq[it] = *(const u32x4*)(p + C_QRAW + h * 192 + (l5 < 24 ? l5 : 0) * 8); rkv[it] = *(const u32x4*)(p + C_KVRAW + h * 256 + l5 * 8); }
#pragma unroll
    for (int it = 0; it < 4; ++it) {
        const int h = 2 * it + hw; const bool act = l5 < 24;
        u32x4* ptr = (u32x4*)(p + C_QRAW + h * 192 + (act ? l5 : 0) * 8);
        float x[8]; unpack8(rq[it], x);
        float ss = 0.f;
#pragma unroll
        for (int j = 0; j < 8; ++j) { x[j] *= sq; ss += x[j] * x[j]; }
        if (!act) ss = 0.f;
#pragma unroll
        for (int o = 1; o < 32; o <<= 1) ss += __shfl_xor(ss, o);
        const float rn = 1.0f / sqrtf(ss * (1.f / 192.f) + EPS);
        const int gi = (act ? l5 : 0) * 8;
        const f32x4 g0 = *(const f32x4*)(qkg + gi), g1 = *(const f32x4*)(qkg + gi + 4);
#pragma unroll
        for (int j = 0; j < 4; ++j) { x[j] *= rn * g0[j]; x[4 + j] *= rn * g1[j]; }
        float o[8];
#pragma unroll
        for (int j = 0; j < 8; ++j) { const float pr = __shfl_xor(x[j], 4); const float rot = (l5 & 4) ? (x[j] * c64[j] + pr * s64[j]) : (x[j] * c64[j] - pr * s64[j]); o[j] = (l5 >= 16 ? rot : x[j]) * C2_192; }
        if (act) *ptr = pack8(o);
    }
#pragma unroll
    for (int it = 0; it < 4; ++it) {
        const int h = 2 * it + hw; const bool isk = l5 < 16;
        u32x4* ptr = (u32x4*)(p + C_KVRAW + h * 256 + l5 * 8);
        float x[8]; unpack8(rkv[it], x);
        float ss = 0.f;
#pragma unroll
        for (int j = 0; j < 8; ++j) { x[j] *= skv; ss += x[j] * x[j]; }
        if (!isk) ss = 0.f;
#pragma unroll
        for (int o = 1; o < 32; o <<= 1) ss += __shfl_xor(ss, o);
        const float rn = 1.0f / sqrtf((ss + kpe_ss) * (1.f / 192.f) + EPS);
        if (l5 == 0) rnl[h] = rn;
        const int gi = 192 + (isk ? l5 : 0) * 8;
        const f32x4 g0 = *(const f32x4*)(qkg + gi), g1 = *(const f32x4*)(qkg + gi + 4);
        float o[8];
#pragma unroll
        for (int j = 0; j < 4; ++j) { o[j] = isk ? x[j] * rn * g0[j] : x[j]; o[4 + j] = isk ? x[4 + j] * rn * g1[j] : x[4 + j]; }
        *ptr = pack8(o);
    }
    LDS_WAIT(); asm volatile("" ::: "memory");
    { const int hd = lane >> 3, c = lane & 7; const float rn = rnl[hd];
      const f32x4 g0 = *(const f32x4*)(qkg + 192 + 128 + c * 8), g1 = *(const f32x4*)(qkg + 192 + 128 + c * 8 + 4);
      float x[8], o[8];
#pragma unroll
      for (int j = 0; j < 4; ++j) { x[j] = kp[j] * rn * g0[j]; x[4 + j] = kp[4 + j] * rn * g1[j]; }
#pragma unroll
      for (int j = 0; j < 8; ++j) { const float pr = __shfl_xor(x[j], 4); o[j] = (c & 4) ? (x[j] * c64[j] + pr * s64[j]) : (x[j] * c64[j] - pr * s64[j]); }
      *(u32x4*)(p + C_KPEH + hd * 64 + c * 8) = pack8(o); }
    LDS_WAIT(); asm volatile("" ::: "memory");
}
__device__ __forceinline__ void post3_row(bf16_t* P, int r, const float* subg, float lam, float omli, int lane) {
    bf16_t* p = P + (size_t)r * PW;
    const int hw = lane >> 5, l5 = lane & 31;
    u32x4 rr[4];
#pragma unroll
    for (int h = 0; h < 4; ++h) rr[h] = *(const u32x4*)(p + (hw ? C_IQ : C_FQ) + h * 256 + l5 * 8);
#pragma unroll
    for (int h = 0; h < 4; ++h) {
        const u32x4 raw = rr[h];
        const u32x4 praw = shfl_xor4(raw, 16);
        float a[8], b[8]; unpack8(raw, a); unpack8(praw, b);
        float d[8], ss = 0.f;
#pragma unroll
        for (int j = 0; j < 8; ++j) { d[j] = a[j] - lam * b[j]; ss += d[j] * d[j]; }
        if (l5 >= 16) ss = 0.f;
#pragma unroll
        for (int o = 1; o < 64; o <<= 1) ss += __shfl_xor(ss, o);
        const float rn = omli / sqrtf(ss * (1.f / 256.f) + EPS);
        const int dim = hw * 128 + (l5 & 15) * 8;
        const f32x4 g0 = *(const f32x4*)(subg + dim), g1 = *(const f32x4*)(subg + dim + 4);
        float o[8];
#pragma unroll
        for (int j = 0; j < 4; ++j) { o[j] = d[j] * rn * g0[j]; o[4 + j] = d[4 + j] * rn * g1[j]; }
        if (l5 < 16) *(u32x4*)(p + C_OC + h * 256 + dim) = pack8(o);
    }
}

__device__ __forceinline__ void index_unit(const bf16_t* P, int unit, unsigned* bm, LAS unsigned char* lds) {
    typedef float f32x16 __attribute__((ext_vector_type(16)));
    int tid = threadIdx.x; asm volatile("" : "+v"(tid));
    const int wid = __builtin_amdgcn_readfirstlane(tid >> 6), lane = tid & 63, j = lane & 31, hi = lane >> 5;
    const int tb = 255 - (unit >> 4), b = unit & 15, t0 = tb * 8, tokbase = MBLK + b * SEQ;
    const int wmax = (64 + t0 + 7) >> 5;
    LAS unsigned* keys = (LAS unsigned*)lds;
    LAS float* iwl = (LAS float*)(lds + 8 * 2112 * 4);
    if (t0 + 7 + 17 > 256) {
        if (tid < 128) iwl[tid] = bf2f(P[(size_t)(tokbase + t0 + (tid >> 4)) * PW + C_IW + (tid & 15)]);
        LAS unsigned char* al = lds + 8 * 2112 * 4 + 512;
        { const int id0 = tid * 2;
#pragma unroll
          for (int e = 0; e < 2; ++e) { const int id = id0 + e, rw = id >> 3, c = id & 7;
              *(LAS bf16x8*)(al + rw * 144 + c * 16) = *(const bf16x8*)(P + (size_t)(tokbase + t0 + (rw >> 4)) * PW + C_IQ + (rw & 15) * 64 + c * 8); } }
        LDS_WAIT(); __syncthreads();
        bf16x8 af[4][4];
        { const int qa = (j >> 2) & 1, ha = (j & 3) + 4 * (j >> 3);
#pragma unroll
          for (int blk = 0; blk < 4; ++blk)
#pragma unroll
              for (int s = 0; s < 4; ++s) af[blk][s] = *(const LAS bf16x8*)(al + ((2 * blk + qa) * 16 + ha) * 144 + s * 32 + hi * 16); }
        const unsigned boff = (unsigned)(j * PW + C_IK + hi * 8) * 2u;
        for (int w = wid; w <= wmax; w += 8) {
            const int kr_ = w < 2 ? (MBLK - 64) + 32 * w : tokbase + 32 * (w - 2); const char* bp_ = (const char*)(P + (size_t)kr_ * PW) + boff;
            bf16x8 bf[4];
#pragma unroll
            for (int s = 0; s < 4; ++s) bf[s] = *(const bf16x8*)(bp_ + s * 32);
            const int kidx = 32 * w + j;
#pragma unroll
            for (int blk = 0; blk < 4; ++blk) {
                f32x16 acc = (f32x16){0.f,0.f,0.f,0.f,0.f,0.f,0.f,0.f,0.f,0.f,0.f,0.f,0.f,0.f,0.f,0.f};
#pragma unroll
                for (int s = 0; s < 4; ++s) acc = __builtin_amdgcn_mfma_f32_32x32x16_bf16(af[blk][s], bf[s], acc, 0, 0, 0);
                const int q = 2 * blk + hi;
                const LAS f32x4* iwq = (const LAS f32x4*)(iwl + q * 16);
                float score = 0.f;
#pragma unroll
                for (int g = 0; g < 4; ++g) { const f32x4 wv = iwq[g]; score += fmaxf(acc[4 * g], 0.f) * wv.x + fmaxf(acc[4 * g + 1], 0.f) * wv.y + fmaxf(acc[4 * g + 2], 0.f) * wv.z + fmaxf(acc[4 * g + 3], 0.f) * wv.w; }
                const bool valid = kidx >= 48 && kidx <= 64 + t0 + q; const unsigned u_ = __float_as_uint(score);
                keys[q * 2112 + kidx] = valid ? ((u_ & 0x80000000u) ? ~u_ : (u_ | 0x80000000u)) : 0u;
            }
        }
        LDS_WAIT(); __syncthreads();
    }
    const int tq = t0 + wid, qk = 64 + tq, nch = qk / 64 + 1;
    unsigned* out = bm + (size_t)(b * SEQ + tq) * BMW;
    if (tq + 17 <= 256) {
        for (int c = 0; c < 33; ++c) { const int kidx = 64 * c + lane; const unsigned long long m = __ballot(kidx >= 48 && kidx <= qk);
            if (lane == 0) { out[2 * c] = (unsigned)m; out[2 * c + 1] = (unsigned)(m >> 32); } }
    } else {
        unsigned kreg[33];
#pragma unroll
        for (int c = 0; c < 33; ++c) kreg[c] = (c < nch && 64 * c + lane <= qk) ? keys[wid * 2112 + 64 * c + lane] : 0u;
        unsigned T = 0u;
        for (int bit = 31; bit >= 0; --bit) {
            const unsigned cand = T | (1u << bit); int cnt = 0;
#pragma unroll
            for (int c = 0; c < 33; ++c) cnt += __popcll(__ballot(kreg[c] >= cand));
            if (cnt >= 256) T = cand;
            if (cnt == 256) break;
        }
#pragma unroll
        for (int c = 0; c < 33; ++c) { const unsigned long long m = __ballot(kreg[c] >= T && kreg[c] != 0u);
            if (lane == 0) { out[2 * c] = (unsigned)m; out[2 * c + 1] = (unsigned)(m >> 32); } }
    }
    LDS_WAIT();
}

namespace fa {
typedef float f32x16 __attribute__((ext_vector_type(16)));
typedef short s16x4 __attribute__((ext_vector_type(4)));
__device__ __forceinline__ int crow(int r, int hi) { return (r & 3) + 8 * (r >> 2) + 4 * hi; }
__device__ __forceinline__ int v_st(int k, int c) { const int kk = (k & ~0xC) | ((k & 4) << 1) | ((k & 8) >> 1); return ((kk >> 3) * 4 + (c >> 5)) * 512 + ((kk & 7) * 32 + (c & 31)) * 2; }
__device__ __forceinline__ int v_rd_base(int lane) { return ((lane & 3) << 3) | (((lane >> 2) & 3) << 6) | (((lane >> 4) & 1) << 5) | (((lane >> 5) & 1) << 8); }
constexpr int v_rd_off(int d0, int ks, int half) { return d0 * 512 + ks * 4096 + half * 2048; }
constexpr int SHM_V = 16384;
template <int DQK> struct Geo { static constexpr int KP = DQK * 2, SHM_K = 64 * DQK * 2, LDS_K0 = 2 * SHM_V, LDS_WS = LDS_K0 + 2 * SHM_K, BYTES = LDS_WS + 8 * 256; };
#define FA_KSWZ(row, colB, pitch) ((row) * (pitch) + ((colB) ^ (((row) & 7) << 4)))
#define FA_SBAR() __builtin_amdgcn_sched_barrier(0)

struct Item { int qrow0, qk0, nt, tokbase; };

template <int DQK>
__device__ __forceinline__ void load_q(const bf16_t* P, const Item& it, int qcol, bf16x8 (&qr)[DQK / 16]) {
    int tid = threadIdx.x; asm volatile("" : "+v"(tid));
    const int wid = tid >> 6, lane = tid & 63, r32 = lane & 31, hi = lane >> 5;
    const bf16_t* qp = P + (size_t)(it.qrow0 + wid * 32 + r32) * PW + qcol + hi * 8;
#pragma unroll
    for (int d0 = 0; d0 < DQK / 16; ++d0) qr[d0] = *(const bf16x8*)(qp + d0 * 16);
}

template <int DQK, bool MASKED>
__device__ __forceinline__ void attn_core(bf16_t* P, const Item& it, const bf16x8 (&qr)[DQK / 16], int k1col, int k2col, int vcol, int ocol, const unsigned* bmq, LAS unsigned char* lds) {
    typedef Geo<DQK> G;
    int tid = threadIdx.x; asm volatile("" : "+v"(tid));
    const int wid = __builtin_amdgcn_readfirstlane(tid >> 6), lane = tid & 63, r32 = lane & 31, hi = lane >> 5;
    LAS unsigned char* V_lds = lds; LAS unsigned char* K_lds = lds + G::LDS_K0; LAS float* wsf = (LAS float*)(lds + G::LDS_WS) + wid * 64;
    const int sr = tid >> 4, sc = (tid & 15) * 8;
    const int vst0 = v_st(sr, sc), vst1 = v_st(32 + sr, sc), kws0 = FA_KSWZ(sr, sc * 2, G::KP), kws1 = FA_KSWZ(sr + 32, sc * 2, G::KP);
    const int xr = tid >> 3, xc = (tid & 7) * 8, kws2 = FA_KSWZ(xr, (128 + xc) * 2, G::KP);
    const unsigned loff0 = (unsigned)(sr * PW + sc) * 2u, loffx = (unsigned)(xr * PW + xc) * 2u;
    const int vb0 = (int)(unsigned)(size_t)V_lds + v_rd_base(lane);
    const int NT = it.nt;
    const int qk = it.qk0 + wid * 32 + r32;
    const bool use_bm = MASKED && (bmq != nullptr);
    const unsigned bmoff = (unsigned)((wid * 32 + r32) * BMW) * 4u;
    float l_reg = 0.f; f32x16 o[4];
#pragma unroll
    for (int d = 0; d < 4; ++d) o[d] = (f32x16){0.f,0.f,0.f,0.f,0.f,0.f,0.f,0.f,0.f,0.f,0.f,0.f,0.f,0.f,0.f,0.f};
    bf16x8 sk0, sk1, sk2, sv0, sv1;
#define FA_KROW0(t) ((t) == 0 ? (MBLK - 64) : it.tokbase + 64 * ((t) - 1))
#define FA_LOAD(t) do { const int kr_ = FA_KROW0(t); const char* rb_ = (const char*)(P + (size_t)kr_ * PW); const char* rk_ = rb_ + (size_t)k1col * 2; const char* rv_ = rb_ + (size_t)vcol * 2; \
        sk0 = *(const bf16x8*)(rk_ + loff0); sk1 = *(const bf16x8*)(rk_ + (size_t)32 * PW * 2 + loff0); sv0 = *(const bf16x8*)(rv_ + loff0); sv1 = *(const bf16x8*)(rv_ + (size_t)32 * PW * 2 + loff0); \
        if (DQK == 192) sk2 = *(const bf16x8*)(rb_ + (size_t)k2col * 2 + loffx); } while (0)
#define FA_WRITE(bf) do { *(LAS bf16x8*)(K_lds + (bf) * G::SHM_K + kws0) = sk0; *(LAS bf16x8*)(K_lds + (bf) * G::SHM_K + kws1) = sk1; \
        *(LAS bf16x8*)(V_lds + (bf) * SHM_V + vst0) = sv0; *(LAS bf16x8*)(V_lds + (bf) * SHM_V + vst1) = sv1; \
        if (DQK == 192) *(LAS bf16x8*)(K_lds + (bf) * G::SHM_K + kws2) = sk2; } while (0)
    constexpr int QREG = (DQK == 192) ? 8 : DQK / 16;
    LAS unsigned char* qx = lds + G::BYTES + (wid * 384 + lane) * 16;
    if (DQK == 192) {
#pragma unroll
        for (int d0 = QREG; d0 < DQK / 16; ++d0) *(LAS bf16x8*)(qx + (d0 - QREG) * 1024) = qr[d0];
    }
    FA_LOAD(0); FA_WRITE(0);
    __syncthreads();
    for (int t = 0; t < NT; ++t) {
        const int cur = t & 1;
        unsigned zb = 0u; asm volatile("" : "+v"(zb)); u32x2 bw = (u32x2){zb, zb};
        if (use_bm) bw = *(const u32x2*)((const char*)(bmq + 2 * t) + bmoff);
        f32x16 p0 = (f32x16){0.f,0.f,0.f,0.f,0.f,0.f,0.f,0.f,0.f,0.f,0.f,0.f,0.f,0.f,0.f,0.f}, p1 = p0;
        { LAS unsigned char* kbase = K_lds + cur * G::SHM_K;
          LAS unsigned char* kb[4];
#pragma unroll
          for (int dd = 0; dd < 4; ++dd) kb[dd] = kbase + FA_KSWZ(r32, (dd * 16 + hi * 8) * 2, G::KP);
          constexpr int GS = (DQK == 192) ? 2 : 4;
#pragma unroll
          for (int g = 0; g < DQK / (16 * GS); ++g) {
              bf16x8 fb0[GS], fb1[GS];
#pragma unroll
              for (int dd = 0; dd < GS; ++dd) { const int d0 = g * GS + dd; LAS unsigned char* a = kb[d0 & 3] + (d0 >> 2) * 128; fb0[dd] = *(const LAS bf16x8*)a; fb1[dd] = *(const LAS bf16x8*)(a + 32 * G::KP); }
              FA_SBAR();
#pragma unroll
              for (int dd = 0; dd < GS; ++dd) { const int d0 = g * GS + dd; bf16x8 qf; if (d0 < QREG) qf = qr[d0 < QREG ? d0 : 0]; else qf = *(const LAS bf16x8*)(qx + (d0 - QREG) * 1024);
                  p0 = __builtin_amdgcn_mfma_f32_32x32x16_bf16(fb0[dd], qf, p0, 0, 0, 0); p1 = __builtin_amdgcn_mfma_f32_32x32x16_bf16(fb1[dd], qf, p1, 0, 0, 0); }
              FA_SBAR(); } }
        if (t + 1 < NT) FA_LOAD(t + 1);
        FA_SBAR();
        const float NEG = -__builtin_inff();
        if (use_bm) {
        } else if (t == 0 || 64 * t + 63 > it.qk0 + wid * 32) {
            const int kb_ = 64 * t + 4 * hi;
#pragma unroll
            for (int r = 0; r < 16; ++r) { const int k0 = kb_ + (r & 3) + 8 * (r >> 2), k1 = k0 + 32;
                if (k0 < 48 || k0 > qk) p0[r] = NEG; if (k1 < 48 || k1 > qk) p1[r] = NEG; }
        }
        float ps = 0.f;
#pragma unroll
        for (int r = 0; r < 16; ++r) { p0[r] = __builtin_amdgcn_exp2f(p0[r]); p1[r] = __builtin_amdgcn_exp2f(p1[r]); }
        if (use_bm) {
            const int wx = (int)(bw.x >> (4 * hi)), wy = (int)(bw.y >> (4 * hi));
#pragma unroll
            for (int r = 0; r < 16; ++r) { const int c = (r & 3) + 8 * (r >> 2);
                p0[r] = __uint_as_float(__float_as_uint(p0[r]) & (unsigned)__builtin_amdgcn_sbfe(wx, c, 1)); p1[r] = __uint_as_float(__float_as_uint(p1[r]) & (unsigned)__builtin_amdgcn_sbfe(wy, c, 1)); }
        }
        { f32x2 s2 = (f32x2){p0[0], p0[1]} + (f32x2){p1[0], p1[1]};
#pragma unroll
          for (int r = 2; r < 16; r += 2) s2 += (f32x2){p0[r], p0[r + 1]} + (f32x2){p1[r], p1[r + 1]};
          ps = s2.x + s2.y; }
        { auto rr = __builtin_amdgcn_permlane32_swap(__float_as_uint(ps), __float_as_uint(ps), false, false); ps = __uint_as_float(rr[0]) + __uint_as_float(rr[1]); }
        l_reg += ps;
        bf16x8 pa0, pa1, pa2, pa3;
#define FA_PK4(Pv, B_, OUT) do { const unsigned a0 = cvt_pk_bf16(Pv[B_ + 0], Pv[B_ + 1]), a1 = cvt_pk_bf16(Pv[B_ + 2], Pv[B_ + 3]), b0 = cvt_pk_bf16(Pv[B_ + 4], Pv[B_ + 5]), b1 = cvt_pk_bf16(Pv[B_ + 6], Pv[B_ + 7]); \
        auto r0 = __builtin_amdgcn_permlane32_swap(a0, b0, false, false); auto r1 = __builtin_amdgcn_permlane32_swap(a1, b1, false, false); \
        u32x4 w_ = {r0[0], r1[0], r0[1], r1[1]}; OUT = __builtin_bit_cast(bf16x8, w_); } while (0)
        FA_PK4(p0, 0, pa0); FA_PK4(p0, 8, pa1); FA_PK4(p1, 0, pa2); FA_PK4(p1, 8, pa3);
#define FA_TRRD(dst, off) asm volatile("ds_read_b64_tr_b16 %0, %1 offset:%2" : "=&v"(dst) : "v"(vb0), "i"(off) : "memory")
#define FA_PV(VB, d0) do { s16x4 l0, l1, l2, l3, h0, h1, h2, h3; constexpr int b_ = (VB) * SHM_V + v_rd_off(d0, 0, 0); \
        FA_TRRD(l0, b_); FA_TRRD(h0, b_ + 2048); FA_TRRD(l1, b_ + 4096); FA_TRRD(h1, b_ + 6144); FA_TRRD(l2, b_ + 8192); FA_TRRD(h2, b_ + 10240); FA_TRRD(l3, b_ + 12288); FA_TRRD(h3, b_ + 14336); \
        asm volatile("s_waitcnt lgkmcnt(0)" ::: "memory"); FA_SBAR(); \
        o[d0] = __builtin_amdgcn_mfma_f32_32x32x16_bf16(pa0, (bf16x8){l0[0], l0[1], l0[2], l0[3], h0[0], h0[1], h0[2], h0[3]}, o[d0], 0, 0, 0); \
        o[d0] = __builtin_amdgcn_mfma_f32_32x32x16_bf16(pa1, (bf16x8){l1[0], l1[1], l1[2], l1[3], h1[0], h1[1], h1[2], h1[3]}, o[d0], 0, 0, 0); \
        o[d0] = __builtin_amdgcn_mfma_f32_32x32x16_bf16(pa2, (bf16x8){l2[0], l2[1], l2[2], l2[3], h2[0], h2[1], h2[2], h2[3]}, o[d0], 0, 0, 0); \
        o[d0] = __builtin_amdgcn_mfma_f32_32x32x16_bf16(pa3, (bf16x8){l3[0], l3[1], l3[2], l3[3], h3[0], h3[1], h3[2], h3[3]}, o[d0], 0, 0, 0); } while (0)
        FA_SBAR();
        if (cur == 0) { FA_PV(0, 0); FA_PV(0, 1); FA_PV(0, 2); FA_PV(0, 3); } else { FA_PV(1, 0); FA_PV(1, 1); FA_PV(1, 2); FA_PV(1, 3); }
        FA_SBAR();
        if (t + 1 < NT) { if (cur == 0) FA_WRITE(1); else FA_WRITE(0); }
        __syncthreads();
    }
    if (hi == 0) wsf[r32] = l_reg; LDS_WAIT();
    float rli[16];
#pragma unroll
    for (int r = 0; r < 16; ++r) { const float lv = wsf[crow(r, hi)]; rli[r] = lv > 0.f ? __builtin_amdgcn_rcpf(lv) : 0.f; }
    { int l2 = lane; asm volatile("" : "+v"(l2));
      const int r32b = l2 & 31, hib = l2 >> 5;
      char* Ow = (char*)(P + (size_t)(it.qrow0 + wid * 32) * PW + ocol) + (unsigned)((4 * hib) * PW + r32b) * 2u;
#pragma unroll
      for (int r = 0; r < 16; ++r) { const unsigned ro = (unsigned)(((r & 3) + 8 * (r >> 2)) * PW) * 2u;
#pragma unroll
        for (int d0 = 0; d0 < 4; ++d0) { const float v = o[d0][r] * rli[r]; const float vn = __shfl_xor(v, 1);
            if ((r32b & 1) == 0) *(unsigned*)(Ow + ro + d0 * 64) = cvt_pk_bf16(v, vn); } } }
    LDS_WAIT();
    __syncthreads();
#undef FA_KROW0
#undef FA_LOAD
#undef FA_WRITE
#undef FA_PK4
#undef FA_TRRD
#undef FA_PV
}
__device__ __forceinline__ int next_item(unsigned* ctr, LAS int* slot) {
    __syncthreads();
    if (threadIdx.x == 0) *slot = (int)__hip_atomic_fetch_add(ctr, 1u, __ATOMIC_RELAXED, __HIP_MEMORY_SCOPE_AGENT);
    __syncthreads();
    return *slot;
}
__device__ __forceinline__ void queue_prime(unsigned* ctr, LAS int* slot) {
    __syncthreads();
    if (threadIdx.x == 0) slot[0] = (int)__hip_atomic_fetch_add(ctr, 1u, __ATOMIC_RELAXED, __HIP_MEMORY_SCOPE_AGENT);
    __syncthreads();
}
__device__ __forceinline__ int queue_next(unsigned* ctr, LAS int* slot, int k) {
    const int idx = slot[k & 1];
    if (threadIdx.x == 0) slot[(k + 1) & 1] = (int)__hip_atomic_fetch_add(ctr, 1u, __ATOMIC_RELAXED, __HIP_MEMORY_SCOPE_AGENT);
    return idx;
}
__device__ __forceinline__ Item make_item(bool meta, int b, int qb) {
    Item it;
    if (meta) { it.qrow0 = 0; it.qk0 = -(MBLK - 64); it.nt = 1; it.tokbase = MBLK; }
    else { it.qrow0 = MBLK + b * SEQ + qb * 256; it.qk0 = 64 + qb * 256; it.nt = 4 * (qb + 1) + 1; it.tokbase = MBLK + b * SEQ; }
    return it;
}
}


constexpr int PH_PER_LAYER = 19, N_PHASES = 2 * PH_PER_LAYER;
__device__ __forceinline__ unsigned char* uni_ptr(unsigned char* p) { const unsigned long long v = (unsigned long long)p; const unsigned lo = __builtin_amdgcn_readfirstlane((unsigned)v), hi = __builtin_amdgcn_readfirstlane((unsigned)(v >> 32)); return (unsigned char*)(((unsigned long long)hi << 32) | lo); }
__device__ __forceinline__ const float* arg_in(const Args& a, int k) { asm volatile("" : "+s"(k)); return a.in[k]; }
__global__ void __launch_bounds__(NWAVES * 64, 2) mega_fwd(Args args) {
    extern __shared__ __attribute__((aligned(16))) unsigned char lds_raw[];
    {
        LAS unsigned char* l0 = (LAS unsigned char*)lds_raw;
        for (int u = threadIdx.x; u < (LDS_BYTES - LDSCTL_OFF) / 4; u += NWAVES * 64) ((LAS unsigned*)(l0 + LDSCTL_OFF))[u] = 0u;
        __syncthreads();
    }
#if MK_ONE_LAUNCH
    (void)xcd_barrier_post((unsigned*)(args.ws + WS_CTL) + CW_BAR, (volatile LAS unsigned*)((LAS unsigned char*)lds_raw + LDSCTL_OFF + 64));
#define GRID_BAR() do { XcdBarrier bar_; bar_.bar = (unsigned*)(uni_ptr(args.ws) + WS_CTL) + CW_BAR; bar_.x = xb_xcc_id(); bar_.st = (volatile LAS unsigned*)((LAS unsigned char*)lds_raw + LDSCTL_OFF + 64); xcd_barrier(bar_); } while (0)
#else
#define GRID_BAR() do {} while (0)
#endif
    const int lo = args.ph_lo, hi = args.ph_hi;
#define IN(k) (lo <= (k) && (k) < hi)
#define SEAM(k) do { if (IN((k) + 1)) GRID_BAR(); } while (0)
#define PH_BEGIN \
    int tid_ = threadIdx.x; asm volatile("" : "+v"(tid_)); \
    Ctx F; F.lds = (LAS unsigned char*)lds_raw; F.tid = tid_; F.lane = tid_ & 63; F.wave = __builtin_amdgcn_readfirstlane(tid_ >> 6); \
    F.G = gridDim.x; F.bid = blockIdx.x; F.gw = F.bid * NWAVES + F.wave; F.ngw = F.G * NWAVES; \
    unsigned char* ws = uni_ptr(args.ws); asm volatile("" : "+s"(ws)); \
    int ly = __builtin_amdgcn_readfirstlane(layer); asm volatile("" : "+s"(ly)); (void)ly; (void)F
#define XN_ ((bf16_t*)(ws + WS_XN))
#define P_ ((bf16_t*)(ws + WS_P))
#define HMETA_ ((float*)(ws + WS_HMETA))
#define RSTDQ_ ((float*)(ws + WS_RSTD))
#define RSTDKV_ ((float*)(ws + WS_RSTD) + R)
#define BM_ ((unsigned*)(ws + WS_BM))
#define RS_(i) ((float*)(ws + WS_CTL + WS_RS) + (size_t)(i) * R)
#define GPERM_ ((float*)(ws + WS_RSTD + 512 * 1024))
#define WB_(off) ((bf16_t*)(ws + WS_WB + (off)))
#define OUT_ (args.out)
#define LAMBDA_INIT(ly) ((ly) == 0 ? 0.2f : (0.8f - 0.6f * 0.7408182206817179f))
#define HSRC_TOK(ly) ((ly) == 0 ? arg_in(args, 0) : (const float*)args.out)

#pragma unroll
    for (int layer = 0; layer < 2; ++layer) {
        const int pb = layer * PH_PER_LAYER;
        if (((PHMASK >> 0) & 1) && IN(pb + 0)) {
            PH_BEGIN;
            for (int rep_ = 0; rep_ < NREP(0); ++rep_) { if (rep_) GRID_BAR();
            const float* meta = arg_in(args, 1);
            conv_matrix<1>(F, arg_in(args, 3) + (size_t)ly * DM * D_IN, DM, D_IN, WB_(WB_IN), arg_in(args, 2) + ly * DM);
            conv_matrix<0>(F, arg_in(args, 7) + (size_t)ly * 512 * 1536, 512, 1536, WB_(WB_QUP), arg_in(args, 5) + ly * 512);
            conv_matrix<0>(F, arg_in(args, 8) + (size_t)ly * 512 * 2048, 512, 2048, WB_(WB_KVUP), arg_in(args, 6) + ly * 512);
            for (int b = 0; b < 3; ++b) conv_matrix<0>(F, arg_in(args, 14) + ((size_t)ly * 3 + b) * 1024 * DM, 1024, DM, WB_(WB_BR) + (size_t)b * DM * 1024, nullptr);
            conv_matrix<0>(F, arg_in(args, 15) + (size_t)ly * DM * DM, DM, DM, WB_(WB_O), nullptr);
            conv_matrix<2>(F, arg_in(args, 17) + (size_t)ly * DM * 2 * DFF, DM, 2 * DFF, WB_(WB_F1), arg_in(args, 16) + ly * DM);
            conv_matrix<0>(F, arg_in(args, 18) + (size_t)ly * DFF * DM, DFF, DM, WB_(WB_F2), nullptr);
            unsigned zu = 0u; asm volatile("" : "+v"(zu)); const float zf = __uint_as_float(zu);
            for (int i = F.gw * 64 + F.lane; i < 112 * 2048 / 8; i += F.ngw * 64) *((u32x4*)(WB_(WB_IN) + (size_t)1168 * 2048) + i) = (u32x4){zu, zu, zu, zu};
            if (F.bid == 0) { const int i = F.tid; const int t = i >> 7, ps = i & 127, dim = (ps >> 1) + 64 * (ps & 1);
                const float* gsrc = (t < 2 ? arg_in(args, 10) : arg_in(args, 11)) + ly * 256 + (t & 1) * 128; GPERM_[i] = gsrc[dim]; }
            float* hmeta = HMETA_;
            if (ly == 0) {
                for (int i = F.gw * 64 + F.lane; i < MROW0 * PW / 8; i += F.ngw * 64) *((u32x4*)P_ + i) = (u32x4){zu, zu, zu, zu};
                for (int i = F.gw * 64 + F.lane; i < MBLK * DM / 4; i += F.ngw * 64) { const int rr = i / (DM / 4); f32x4 v = (f32x4){zf, zf, zf, zf};
                    if (rr >= MBLK - NMETA) v = *((const f32x4*)meta + (i - (MBLK - NMETA) * (DM / 4))); *((f32x4*)hmeta + i) = v; }
            }
            if (ly == 0) {
                const float* xin = arg_in(args, 0); bf16_t* XN = XN_; float* rs0 = RS_(0);
                for (int r = MROW0 + F.gw; r < R; r += F.ngw)
                    norm_row(r < MBLK ? meta + (size_t)(r - MROW0) * DM : xin + (size_t)(r - MBLK) * DM, XN + (size_t)r * DM, rs0 + r, F.lane);
            }
            }
            SEAM(pb + 0);
        }
        if (((PHMASK >> 1) & 1) && IN(pb + 1)) {
            PH_BEGIN;
            { SkP f{P_, 0, RS_(2 * ly)}; skinny_gemm(F.lds, XN_ + (size_t)MROW0 * DM, DM, WB_(WB_IN), DM, 1280 / 16, F.bid, F.G, f); }
            SchedPlain S{XN_, DM, WB_(WB_IN), DM, NPMM, 5, F.G, F.bid, 0}; EpiP E{P_, RS_(2 * ly)};
            pg8::gemm_phase(F.lds, S, E);
            if (NREP(1) == 2) { GRID_BAR(); pg8::gemm_phase(F.lds, S, E); }
            SEAM(pb + 1);
        }
        if (((PHMASK >> 2) & 1) && IN(pb + 2)) {
            PH_BEGIN;
            { bf16_t* P = P_; float* rq = RSTDQ_; float* rkv = RSTDKV_;
              for (int r = MROW0 + F.gw; r < R; r += F.ngw) post1a_row(P, r, rq, rkv, F.lane); }
            VM_WAIT(); __syncthreads();
            { SkP f{P_, C_QRAW, nullptr}; skinny_gemm(F.lds, P_ + (size_t)MROW0 * PW + C_CQ, PW, WB_(WB_QUP), 512, 1536 / 16, F.bid, F.G, f); }
            { SkP f{P_, C_KVRAW, nullptr}; skinny_gemm(F.lds, P_ + (size_t)MROW0 * PW + C_CKV, PW, WB_(WB_KVUP), 512, 2048 / 16, F.bid, F.G, f); }
            SchedMlaUp S{P_, WB_(WB_QUP), WB_(WB_KVUP), F.G, F.bid}; EpiP E{P_, nullptr};
            pg8::gemm_phase(F.lds, S, E);
            if (NREP(2) == 2) { GRID_BAR(); pg8::gemm_phase(F.lds, S, E); }
            SEAM(pb + 2);
        }
        if (((PHMASK >> 3) & 1) && IN(pb + 3)) {
            PH_BEGIN;
            const float* mla_qkg = arg_in(args, 9) + ly * 2 * 192;
            bf16_t* P = P_; float* rq = RSTDQ_; float* rkv = RSTDKV_;
            LAS float* rnl = (LAS float*)(F.lds + F.wave * 64);
            for (int r = MROW0 + F.gw; r < R; r += F.ngw) post2_row(P, r, rq, rkv, mla_qkg, rnl, F.lane);
            SEAM(pb + 3);
        }
        if (((PHMASK >> 4) & 1) && IN(pb + 4)) {
            PH_BEGIN;
            bf16_t* P = P_;
            LAS int* slot = (LAS int*)(F.lds + LDSCTL_OFF + 128);
            for (int rep_ = 0; rep_ < NREP(4); ++rep_) { if (rep_) GRID_BAR();
            unsigned* ctr = (unsigned*)(ws + WS_CTL) + CW_Q + 64 * (ly * 4 + 0) + 64 * 16 * rep_;
            const bool stat = (F.G == 256); const int sx = F.bid & 7, spl = (F.bid >> 3) >> 2, sj = (F.bid >> 3) & 3;
            if (!stat) fa::queue_prime(ctr, slot);
            for (int qk_ = 0;; ++qk_) {
                int idx;
                if (stat) { if (qk_ < 4) { const int pr = sx + 8 * (spl + 8 * (qk_ >> 1)), qb = (qk_ & 1) ? sj : 7 - sj; idx = (7 - qb) * 128 + pr; } else idx = (qk_ == 4 && F.bid < 8) ? 1024 + F.bid : 1 << 30; }
                else idx = fa::queue_next(ctr, slot, qk_);
                if (idx >= 8 * 129) break;
                int h; fa::Item it;
                if (idx < 1024) { const int qb = 7 - (idx >> 7), rest = idx & 127; h = rest & 7; it = fa::make_item(false, rest >> 3, qb); } else { h = idx - 1024; it = fa::make_item(true, 0, 0); }
                bf16x8 qr[12]; fa::load_q<192>(P, it, C_QRAW + h * 192, qr);
                fa::attn_core<192, false>(P, it, qr, C_KVRAW + h * 256, C_KPEH + h * 64, C_KVRAW + h * 256 + 128, C_OA + h * 128, nullptr, F.lds);
            } }
            SEAM(pb + 4);
        }
        if (((PHMASK >> 5) & 1) && IN(pb + 5)) {
            PH_BEGIN;
            { SkP f{P_, 1280, RS_(2 * ly)}; skinny_gemm(F.lds, XN_ + (size_t)MROW0 * DM, DM, WB_(WB_IN) + (size_t)1280 * DM, DM, 7168 / 16, F.bid, F.G, f); }
            SchedPlain S{XN_, DM, WB_(WB_IN) + (size_t)1280 * DM, DM, NPMM, 28, F.G, F.bid, 1280}; EpiG2 E{P_, RS_(2 * ly), GPERM_, (LAS float*)(F.lds + RING_BYTES)};
            pg8::gemm_phase(F.lds, S, E);
            if (NREP(5) == 2) { GRID_BAR(); pg8::gemm_phase(F.lds, S, E); }
            SEAM(pb + 5);
        }
        if (((PHMASK >> 6) & 1) && IN(pb + 6)) {
            PH_BEGIN;
            bf16_t* P = P_; const float* gp = GPERM_;
            if (F.gw < NMETA) meta_post_row(P, MROW0 + F.gw, gp, F.lane);
            SEAM(pb + 6);
        }
        if (((PHMASK >> 7) & 1) && IN(pb + 7)) {
            PH_BEGIN;
            bf16_t* P = P_; unsigned* bm = BM_;
            unsigned* ctr = (unsigned*)(ws + WS_CTL) + CW_Q + 64 * (ly * 4 + 2);
            LAS int* slot = (LAS int*)(F.lds + LDSCTL_OFF + 128);
            for (int rep_ = 0; rep_ < NREP(7); ++rep_) { if (rep_) GRID_BAR(); unsigned* c2 = ctr + 64 * 16 * rep_;
            for (;;) { const int idx = fa::next_item(c2, slot); if (idx >= NTOK / 8) break; index_unit(P, idx, bm, F.lds); } }
            SEAM(pb + 7);
        }
        if (((PHMASK >> 8) & 1) && IN(pb + 8)) {
            PH_BEGIN;
            bf16_t* P = P_; unsigned* bm = BM_;
            LAS int* slot = (LAS int*)(F.lds + LDSCTL_OFF + 128);
            for (int rep_ = 0; rep_ < NREP(8); ++rep_) { if (rep_) GRID_BAR();
            const bool dummy = (NREP(8) == 2) && rep_ == 0;
            unsigned* ctr = (unsigned*)(ws + WS_CTL) + CW_Q + 64 * (ly * 4 + 1) + 64 * 16 * rep_;
            const bool stat = (F.G == 256); const int sx = F.bid & 7, spl = (F.bid >> 3) >> 2, sj = (F.bid >> 3) & 3;
            if (!stat) fa::queue_prime(ctr, slot);
            for (int qk_ = 0;; ++qk_) {
                int idx;
                if (stat) { if (qk_ < 8) { const int pr = sx + 8 * (spl + 8 * ((qk_ >> 1) & 1)), qb = (qk_ & 1) ? sj : 7 - sj; idx = (7 - qb) * 256 + ((qk_ >> 2) ? 128 : 0) + pr; } else idx = (qk_ == 8 && F.bid < 16) ? 2048 + F.bid : 1 << 30; }
                else idx = fa::queue_next(ctr, slot, qk_);
                if (idx >= 16 * 129) break;
                int hh; bool meta = false; fa::Item it; int b = 0, qb = 0;
                if (idx < 2048) { qb = 7 - (idx >> 8); const int rest = idx & 255; hh = (rest < 128) ? 8 + (rest & 7) : (rest & 7); b = (rest & 127) >> 3; it = fa::make_item(false, b, qb); }
                else { hh = idx - 2048; hh = hh < 8 ? 8 + hh : hh - 8; meta = true; it = fa::make_item(true, 0, 0); }
                if (hh < 8) {
                    bf16x8 qr[8]; fa::load_q<128>(P, it, C_DQ + hh * 128, qr);
                    fa::attn_core<128, true>(P, it, qr, C_DK + hh * 128, 0, C_DV + hh * 128, dummy ? C_KPE : C_OB + hh * 128, meta ? nullptr : bm + (size_t)(b * SEQ + qb * 256) * BMW, F.lds);
                } else {
                    const int hj = hh - 8;
                    bf16x8 qr[8]; fa::load_q<128>(P, it, C_FQ + hj * 128, qr);
                    fa::attn_core<128, false>(P, it, qr, C_FK + hj * 128, 0, C_FV + (hj >> 1) * 256, dummy ? C_KPE : C_FQ + hj * 128, nullptr, F.lds);
                    fa::attn_core<128, false>(P, it, qr, C_FK + hj * 128, 0, C_FV + (hj >> 1) * 256 + 128, dummy ? C_KPE : C_IQ + hj * 128, nullptr, F.lds);
                }
            } }
            SEAM(pb + 8);
        }
        if (((PHMASK >> 9) & 1) && IN(pb + 9)) {
            PH_BEGIN;
            const float* diff_lam = arg_in(args, 12) + ly * 4 * 128; const float* diff_subg = arg_in(args, 13) + ly * 256;
            const float lambda_init = LAMBDA_INIT(ly);
            const float s1 = wave_sum(diff_lam[F.lane] * diff_lam[128 + F.lane] + diff_lam[64 + F.lane] * diff_lam[192 + F.lane]);
            const float s2 = wave_sum(diff_lam[256 + F.lane] * diff_lam[384 + F.lane] + diff_lam[320 + F.lane] * diff_lam[448 + F.lane]);
            const float lam = __expf(s1) - __expf(s2) + lambda_init;
            bf16_t* P = P_;
            for (int r = MROW0 + F.gw; r < R; r += F.ngw) post3_row(P, r, diff_subg, lam, 1.f - lambda_init, F.lane);
        }
#define GATE_PHASE(k, b) \
        if (((PHMASK >> 10) & 1) && IN(pb + (k))) { \
            PH_BEGIN; \
            { SkGate f{(bf16_t*)(ws + WS_GS), arg_in(args, 4) + ly * 3 * DM + (b) * DM, RS_(2 * ly)}; skinny_gemm(F.lds, XN_ + (size_t)MROW0 * DM, DM, WB_(WB_G) + (size_t)(b) * 2048 * DM, DM, 2048 / 16, F.bid, F.G, f); } \
            SchedPlain S{XN_, DM, WB_(WB_G) + (size_t)(b) * 2048 * DM, DM, NPMM, 8, F.G, F.bid, 0}; EpiGate E{(bf16_t*)(ws + WS_GS), arg_in(args, 4) + ly * 3 * DM + (b) * DM, RS_(2 * ly)}; \
            pg8::gemm_phase(F.lds, S, E); \
            if (NREP(k) == 2) { GRID_BAR(); pg8::gemm_phase(F.lds, S, E); } \
            SEAM(pb + (k)); \
        }
#define BRANCH_PHASE(k, b, oc) \
        if (((PHMASK >> 10) & 1) && IN(pb + (k))) { \
            PH_BEGIN; \
            { SkGated f{P_, (const bf16_t*)(ws + WS_GS), (b) == 0 ? 1 : 0}; skinny_gemm(F.lds, P_ + (size_t)MROW0 * PW + (oc), PW, WB_(WB_BR) + (size_t)(b) * DM * 1024, 1024, 2048 / 16, F.bid, F.G, f); } \
            SchedPlain S{P_ + (oc), PW, WB_(WB_BR) + (size_t)(b) * DM * 1024, 1024, NPMM, 8, F.G, F.bid, C_MERGED}; EpiGated E{P_, (const bf16_t*)(ws + WS_GS), (b) == 0 ? 1 : 0, ((DBG_BM >> (b)) & 1) ? 1.f : 0.f}; \
            pg8::gemm_phase(F.lds, S, E); \
            if (NREP(k) == 2 && (b) == 0) { GRID_BAR(); pg8::gemm_phase(F.lds, S, E); } \
            SEAM(pb + (k)); \
        }
        GATE_PHASE(10, 0) BRANCH_PHASE(11, 0, C_OA)
        GATE_PHASE(12, 1) BRANCH_PHASE(13, 1, C_OB)
        GATE_PHASE(14, 2) BRANCH_PHASE(15, 2, C_OC)
        if (((PHMASK >> 11) & 1) && IN(pb + 16)) {
            PH_BEGIN;
            { SkRes f{HMETA_, XN_, RS_(2 * ly + 1)}; skinny_gemm(F.lds, P_ + (size_t)MROW0 * PW + C_MERGED, PW, WB_(WB_O), DM, 2048 / 16, F.bid, F.G, f); }
            SchedPlain S{P_ + C_MERGED, PW, WB_(WB_O), DM, NPMM, 8, F.G, F.bid, 0}; EpiRes E{HSRC_TOK(ly), OUT_, HMETA_, DBG_SA, XN_, RS_(2 * ly + 1)};
            pg8::gemm_phase(F.lds, S, E);
            SEAM(pb + 16);
        }
        if (((PHMASK >> 13) & 1) && IN(pb + 17)) {
            PH_BEGIN;
            skinny_swiglu(F.lds, XN_ + (size_t)MROW0 * DM, DM, WB_(WB_F1), DM, P_, RS_(2 * ly + 1), F.bid, F.G);
            SchedPlain S{XN_, DM, WB_(WB_F1), DM, NPMM, 44, F.G, F.bid, 0}; EpiSwiglu E{P_, RS_(2 * ly + 1)};
            pg8::gemm_phase(F.lds, S, E);
            if (NREP(17) == 2) { GRID_BAR(); pg8::gemm_phase(F.lds, S, E); }
            SEAM(pb + 17);
        }
        if (((PHMASK >> 14) & 1) && IN(pb + 18)) {
            PH_BEGIN;
            { SkRes f{HMETA_, ly == 0 ? XN_ : (bf16_t*)nullptr, RS_(2)}; skinny_gemm(F.lds, P_ + (size_t)MROW0 * PW, PW, WB_(WB_F2), DFF, 2048 / 16, F.bid, F.G, f); }
            SchedPlain S{P_, PW, WB_(WB_F2), DFF, NPMM, 8, F.G, F.bid, 0}; EpiRes E{OUT_, OUT_, HMETA_, DBG_SF, ly == 0 ? XN_ : (bf16_t*)nullptr, RS_(2)};
            pg8::gemm_phase(F.lds, S, E);
            SEAM(pb + 18);
        }
    }
#undef IN
#undef SEAM
}

__global__ void diag_fill(float* out, int n, float v) { for (int i = blockIdx.x * blockDim.x + threadIdx.x; i < n; i += gridDim.x * blockDim.x) out[i] = v; }
extern "C" void kernel_launch(void* const* d_in, const int* in_sizes, int n_in, void* d_out, int out_size, void* d_ws, size_t ws_size, hipStream_t stream) {
    static int grid = 0; static float code = 0.f;
    if (grid == 0) {
        int dev = 0, cus = 0;
        if (n_in != 19) { code = 10.f; grid = -1; }
        else if (ws_size < WS_END) { code = 20.f + (float)(ws_size >> 20) * 0.01f; grid = -1; }
        else if (hipGetDevice(&dev) != hipSuccess || hipDeviceGetAttribute(&cus, hipDeviceAttributeMultiprocessorCount, dev) != hipSuccess) { code = 40.f; grid = -1; }
        else if (hipFuncSetAttribute((const void*)mega_fwd, hipFuncAttributeMaxDynamicSharedMemorySize, LDS_BYTES) != hipSuccess) { code = 50.f; grid = -1; }
        else {
            int per_cu = 0;
            if (hipOccupancyMaxActiveBlocksPerMultiprocessor(&per_cu, (const void*)mega_fwd, NWAVES * 64, LDS_BYTES) != hipSuccess || per_cu < 1) { code = 60.f; grid = -1; }
            (void)hipGetLastError();
            if (grid == 0) grid = cus;
        }
    }
    if (grid < 0) { hipLaunchKernelGGL(diag_fill, dim3(1024), dim3(256), 0, stream, (float*)d_out, out_size, code); return; }
    (void)hipMemsetAsync((char*)d_ws + WS_CTL, 0, CTL_BYTES, stream);
    Args a{};
    for (int i = 0; i < 19; ++i) a.in[i] = (const float*)d_in[i];
    a.out = (float*)d_out; a.ws = (unsigned char*)d_ws;
#if MK_ONE_LAUNCH
    a.ph_lo = 0; a.ph_hi = N_PHASES;
    hipLaunchKernelGGL(mega_fwd, dim3(grid), dim3(NWAVES * 64), LDS_BYTES, stream, a);
#else
    for (int p = 0; p < N_PHASES; ++p) { a.ph_lo = p; a.ph_hi = p + 1; hipLaunchKernelGGL(mega_fwd, dim3(grid), dim3(NWAVES * 64), LDS_BYTES, stream, a); }
#endif
    if (hipPeekAtLastError() != hipSuccess) { (void)hipGetLastError(); hipLaunchKernelGGL(diag_fill, dim3(1024), dim3(256), 0, stream, (float*)d_out, out_size, 70.f); }
}
```

```cpp
#include <hip/hip_runtime.h>
#include <cstdio>
#include <cstdint>

#ifndef PHMASK
#define PHMASK 0x7fff
#endif
#ifndef REPMASK
#define REPMASK 0
#endif
#define NREP(k) ((((REPMASK) >> (k)) & 1) ? 2 : 1)
#ifndef DBG_BM
#define DBG_BM 7
#endif
#ifndef DBG_BR
#define DBG_BR 0
#endif
#ifndef DBG_SA
#define DBG_SA 1.0f
#endif
#ifndef DBG_SF
#define DBG_SF 1.0f
#endif
#ifndef MK_ONE_LAUNCH
#define MK_ONE_LAUNCH 1
#endif

#define LAS __attribute__((address_space(3)))
#define GAS __attribute__((address_space(1)))
typedef unsigned short bf16_t;
typedef short bf16x8 __attribute__((ext_vector_type(8)));
typedef float f32x4 __attribute__((ext_vector_type(4)));
typedef float f32x2 __attribute__((ext_vector_type(2)));
typedef unsigned u32x4 __attribute__((ext_vector_type(4)));
typedef unsigned u32x2 __attribute__((ext_vector_type(2)));

constexpr int DM = 2048, NB = 16, SEQ = 2048, NMETA = 16, MBLK = 256;
constexpr int R = MBLK + NB * SEQ;
constexpr int NPM = R / 256;
constexpr int NPMM = NPM - 1;
constexpr int MROW0 = MBLK - NMETA;
constexpr int NTOK = NB * SEQ;
constexpr int DFF = 5632;
constexpr int PW = 8448;
constexpr int C_CQ = 0, C_CKV = 512, C_KPE = 1024, C_IK = 1088, C_IW = 1152, C_DQ = 1280, C_DK = 2304, C_DV = 3328, C_IQ = 4352,
              C_FQ = 5376, C_FK = 6400, C_FV = 7424;
constexpr int C_KVRAW = 1280, C_QRAW = 3328, C_KPEH = 4864;
constexpr int C_OA = 0, C_OB = C_DQ, C_OC = C_FQ, C_MERGED = 2304;
constexpr int BMW = 66;
constexpr float EPS = 1e-6f;
constexpr float LOG2E = 1.4426950408889634f;
constexpr float C2_128 = 0.08838834764831845f * LOG2E;
constexpr float C2_192 = 0.07216878364870323f * LOG2E;
constexpr int D_IN = 14480;

constexpr size_t MiB = 1u << 20;
constexpr size_t WS_CTL = 0, CTL_BYTES = 1 * MiB;
constexpr size_t WS_RSTD = 1 * MiB;
constexpr size_t WS_HMETA = 2 * MiB;
constexpr size_t WS_BM = 4 * MiB;
constexpr size_t WS_WB = 16 * MiB;
constexpr size_t WB_IN = 0, WB_G = WB_IN + (size_t)8448 * 2048 * 2, WB_QUP = WB_G + (size_t)6144 * 2048 * 2, WB_KVUP = WB_QUP + (size_t)1536 * 512 * 2,
                 WB_BR = WB_KVUP + (size_t)2048 * 512 * 2, WB_O = WB_BR + (size_t)3 * 2048 * 1024 * 2, WB_F1 = WB_O + (size_t)2048 * 2048 * 2,
                 WB_F2 = WB_F1 + (size_t)11264 * 2048 * 2, WB_END = WB_F2 + (size_t)2048 * 5632 * 2;
constexpr size_t WS_XN = 164 * MiB;
constexpr size_t WS_P = 294 * MiB;
constexpr size_t WS_GS = 828 * MiB;
constexpr size_t WS_END = 960 * MiB;
static_assert(WS_GS + (size_t)R * 2048 * 2 <= WS_END && WS_WB + WB_END <= WS_XN && WS_XN + (size_t)R * 2048 * 2 <= WS_P && WS_P + (size_t)R * PW * 2 <= WS_GS, "ws map");
constexpr int CW_BAR = 4096, CW_Q = 16384;
constexpr size_t WS_RS = 256 * 1024;

__device__ __forceinline__ float bf2f(bf16_t v) { return __uint_as_float((unsigned)v << 16); }
__device__ __forceinline__ unsigned f2bf(float f) { unsigned u = __float_as_uint(f); return (u + 0x7fffu + ((u >> 16) & 1u)) >> 16; }
__device__ __forceinline__ unsigned pk2(float lo, float hi) { return f2bf(lo) | (f2bf(hi) << 16); }
typedef __bf16 bf16x2_t __attribute__((ext_vector_type(2)));
__device__ __forceinline__ unsigned cvt_pk_bf16(float lo, float hi) { f32x2 v = {lo, hi}; bf16x2_t b = __builtin_convertvector(v, bf16x2_t); return __builtin_bit_cast(unsigned, b); }
__device__ __forceinline__ float wave_sum(float v) {
#pragma unroll
    for (int o = 1; o < 64; o <<= 1) v += __shfl_xor(v, o);
    return v;
}
__device__ __forceinline__ float wave_max(float v) {
#pragma unroll
    for (int o = 1; o < 64; o <<= 1) v = fmaxf(v, __shfl_xor(v, o));
    return v;
}
#define LDS_WAIT() asm volatile("s_waitcnt lgkmcnt(0)" ::: "memory")
#define VM_WAIT() asm volatile("s_waitcnt vmcnt(0)" ::: "memory")
__device__ __forceinline__ int row_pos(int r) { return r < MBLK ? (r >= MBLK - NMETA ? r - (MBLK - NMETA) : 0) : NMETA + ((r - MBLK) & (SEQ - 1)); }
__device__ __forceinline__ void rope_cs(int pos, int i, float two_over_d, float& c, float& s) {
    const float inv = __builtin_amdgcn_exp2f(-(float)i * two_over_d * 13.287712379549449f);
    float rev = (float)pos * inv * 0.15915494309189535f;
    rev -= floorf(rev);
    s = __builtin_amdgcn_sinf(rev); c = __builtin_amdgcn_cosf(rev);
}

namespace pg8 {
constexpr int BM = 256, BK = 64, HALF = 128, HTB = HALF * BK * 2, STAGE_BYTES = 8 * HTB;
__device__ __forceinline__ int lds_byte(int r, int c) { const int st = (r >> 4) * 2 + (c >> 5), rr = r & 15, cc = c & 31, ob = rr * 64 + cc * 2; return st * 1024 + (ob ^ (((ob >> 9) & 1) << 5)); }
__device__ __forceinline__ void stage_rc(int b, int& R_, int& C_) { const int st = b / 1024, sb = b % 1024, swz = sb ^ (((sb >> 9) & 1) << 5); R_ = (st >> 1) * 16 + swz / 64; C_ = (st & 1) * 32 + (swz % 64) / 2; }
__device__ __forceinline__ int perm32(int rho) { const int n = rho >> 4, i = rho & 15; return 8 * (i >> 2) + 4 * n + (i & 3); }

struct Unit { const char* A; const char* B; unsigned lda2, ldb2; int nt, pm, pn, kind, ocol; };

#ifndef WGM
#define WGM 4
#endif
__device__ __forceinline__ void tile_of(int L, int nM, int nN, int& pm, int& pn) {
    const int nwg = nM * nN; int wgid = L;
    { const int q = nwg / 8, r = nwg % 8, xcd = wgid % 8, off = wgid / 8; wgid = (xcd < r ? xcd * (q + 1) : r * (q + 1) + (xcd - r) * q) + off; }
    const int nig = WGM * nN, gid = wgid / nig, fm = gid * WGM, gsz = (nM - fm) < WGM ? (nM - fm) : WGM;
    pm = fm + ((wgid % nig) % gsz); pn = (wgid % nig) / gsz;
}

template <class Epi, class Sched>
__device__ __forceinline__ void gemm_phase(LAS unsigned char* lds, const Sched& S, const Epi& E) {
    int tid = threadIdx.x; asm volatile("" : "+v"(tid));
    const int wid = __builtin_amdgcn_readfirstlane(tid >> 6), lane = tid & 63, wr = wid >> 2, wc = wid & 3, fr = lane & 15, fq = lane >> 4;
    unsigned rA[2], rB[2], cc[2];
#pragma unroll
    for (int i = 0; i < 2; ++i) { int R_, C_; stage_rc(tid * 16 + i * 8192, R_, C_); rA[i] = (unsigned)R_; rB[i] = (unsigned)(Epi::PERM ? ((R_ & ~31) + perm32(R_ & 31)) : R_); cc[i] = (unsigned)C_ * 2u; }
    const size_t kstep = (size_t)(BK * 2);
    const unsigned ldsw = (unsigned)wid * 1024u;
    const int aoff = lds_byte(wr * 64 + fr, fq * 8), boff = lds_byte(wc * 32 + fr, fq * 8);
#define PG8_SA(b, h) (((b) * 2 + (h)) * HTB)
#define PG8_SB(b, h) ((4 + (b) * 2 + (h)) * HTB)
#define PG8_STAGE(bufoff, gbase, rr, ld2) do { _Pragma("unroll") for (int _i = 0; _i < 2; ++_i) \
        __builtin_amdgcn_global_load_lds((const unsigned*)((const char*)(gbase) + ((rr)[_i] * (ld2) + cc[_i])), (LAS unsigned*)(lds + (bufoff) + ldsw + _i * 8192), 16, 0, 0); } while (0)
#define PG8_LDA(dst, b, h) do { _Pragma("unroll") for (int m = 0; m < 4; ++m) _Pragma("unroll") for (int k = 0; k < 2; ++k) dst[m][k] = *(const LAS bf16x8*)(lds + PG8_SA(b, h) + aoff + m * 2048 + k * 1024); } while (0)
#define PG8_LDB(dst, b, h) do { _Pragma("unroll") for (int n = 0; n < 2; ++n) _Pragma("unroll") for (int k = 0; k < 2; ++k) dst[n][k] = *(const LAS bf16x8*)(lds + PG8_SB(b, h) + boff + n * 2048 + k * 1024); } while (0)
#define PG8_MMA(ai, bj, At, Bt) do { __builtin_amdgcn_s_setprio(1); _Pragma("unroll") for (int m = 0; m < 4; ++m) _Pragma("unroll") for (int n = 0; n < 2; ++n) _Pragma("unroll") for (int k = 0; k < 2; ++k) \
        acc[ai][bj][m][n] = __builtin_amdgcn_mfma_f32_16x16x32_bf16(Bt[n][k], At[m][k], acc[ai][bj][m][n], 0, 0, 0); __builtin_amdgcn_s_setprio(0); } while (0)
#define PG8_WAIT_V(n) asm volatile("s_waitcnt vmcnt(" #n ")" ::: "memory")
#define PG8_WAIT_L(n) asm volatile("s_waitcnt lgkmcnt(" #n ")" ::: "memory")
#define PG8_BAR __builtin_amdgcn_s_barrier()
#define PG8_SCHED __builtin_amdgcn_sched_barrier(0)
    Unit cur, nxt; int ui = 0;
    if (!S.next(0, cur)) return;
    float zf = 0.f; asm volatile("" : "+v"(zf));
    f32x4 acc[2][2][4][2];
#pragma unroll
    for (int a = 0; a < 2; ++a)
#pragma unroll
        for (int b = 0; b < 2; ++b)
#pragma unroll
            for (int m = 0; m < 4; ++m)
#pragma unroll
                for (int n = 0; n < 2; ++n) acc[a][b][m][n] = (f32x4){zf, zf, zf, zf};
    bf16x8 At[4][2], B0[2][2], B1[2][2];
    const char* cA = cur.A; const char* cB = cur.B;
    unsigned lA = cur.lda2, lB = cur.ldb2;
    size_t hA = (size_t)HALF * lA, hB = (size_t)HALF * lB;
    PG8_STAGE(PG8_SB(0, 0), cB, rB, lB); PG8_STAGE(PG8_SB(0, 1), cB + hB, rB, lB); PG8_STAGE(PG8_SA(0, 0), cA, rA, lA); PG8_STAGE(PG8_SA(0, 1), cA + hA, rA, lA);
    if (wr == 1) PG8_BAR;
    PG8_WAIT_V(2); PG8_BAR;
    PG8_STAGE(PG8_SB(1, 0), cB + kstep, rB, lB); PG8_STAGE(PG8_SA(1, 0), cA + kstep, rA, lA); PG8_STAGE(PG8_SB(1, 1), cB + hB + kstep, rB, lB);
    PG8_WAIT_V(6); PG8_BAR;
    for (;;) {
        const bool has_next = S.next(ui + 1, nxt);
        if (!has_next) nxt = cur;
        const char* nA = nxt.A; const char* nB = nxt.B;
        const unsigned lAn = nxt.lda2, lBn = nxt.ldb2;
        const size_t hAn = (size_t)HALF * lAn, hBn = (size_t)HALF * lBn;
        const int nt = cur.nt;
        for (int t = 0; t < nt; t += 2) {
            const bool last = (t == nt - 2);
            const char* a1 = cA + (size_t)(t + 1) * kstep;
            const char* a2 = last ? nA : cA + (size_t)(t + 2) * kstep; const char* b2 = last ? nB : cB + (size_t)(t + 2) * kstep;
            const char* a3 = a2 + kstep; const char* b3 = b2 + kstep;
            const size_t hA2 = last ? hAn : hA, hB2 = last ? hBn : hB;
            const unsigned lA2 = last ? lAn : lA, lB2 = last ? lBn : lB;
            PG8_LDB(B0, 0, 0); PG8_LDB(B1, 0, 1); PG8_SCHED; PG8_LDA(At, 0, 0); PG8_STAGE(PG8_SA(1, 1), a1 + hA, rA, lA);
            PG8_WAIT_V(8); PG8_WAIT_L(0); PG8_BAR; PG8_MMA(0, 0, At, B0); PG8_MMA(0, 1, At, B1); PG8_BAR; PG8_SCHED;
            PG8_LDA(At, 0, 1); PG8_STAGE(PG8_SB(0, 0), b2, rB, lB2); PG8_STAGE(PG8_SB(0, 1), b2 + hB2, rB, lB2); PG8_STAGE(PG8_SA(0, 0), a2, rA, lA2);
            PG8_WAIT_V(8); PG8_WAIT_L(0); PG8_BAR; PG8_MMA(1, 0, At, B0); PG8_MMA(1, 1, At, B1); PG8_BAR; PG8_SCHED;
            PG8_LDB(B0, 1, 0); PG8_LDB(B1, 1, 1); PG8_SCHED; PG8_LDA(At, 1, 0); PG8_STAGE(PG8_SA(0, 1), a2 + hA2, rA, lA2);
            PG8_WAIT_V(8); PG8_WAIT_L(0); PG8_BAR; PG8_MMA(0, 0, At, B0); PG8_MMA(0, 1, At, B1); PG8_BAR; PG8_SCHED;
            PG8_LDA(At, 1, 1); PG8_STAGE(PG8_SB(1, 0), b3, rB, lB2); PG8_STAGE(PG8_SB(1, 1), b3 + hB2, rB, lB2); PG8_STAGE(PG8_SA(1, 0), a3, rA, lA2);
            PG8_WAIT_V(8); PG8_WAIT_L(0); PG8_BAR; PG8_MMA(1, 0, At, B0); PG8_MMA(1, 1, At, B1); PG8_BAR; PG8_SCHED;
        }
        if (wr == 0) PG8_BAR;
        E(acc, cur, wr, wc, fr, fq);
#pragma unroll
        for (int a = 0; a < 2; ++a)
#pragma unroll
            for (int b = 0; b < 2; ++b)
#pragma unroll
                for (int m = 0; m < 4; ++m)
#pragma unroll
                    for (int n = 0; n < 2; ++n) acc[a][b][m][n] = (f32x4){zf, zf, zf, zf};
        if (!has_next) break;
        cur = nxt; cA = nA; cB = nB; hA = hAn; hB = hBn; lA = lAn; lB = lBn; ++ui;
        if (wr == 1) PG8_BAR;
    }
    PG8_WAIT_V(0);
    PG8_BAR;
#undef PG8_SA
#undef PG8_SB
#undef PG8_STAGE
#undef PG8_LDA
#undef PG8_LDB
#undef PG8_MMA
#undef PG8_WAIT_V
#undef PG8_WAIT_L
#undef PG8_BAR
#undef PG8_SCHED
}
}
using pg8::Unit;

struct SchedPlain {
    const bf16_t* A; int lda; const bf16_t* B; int K; int nM, nN, G, c, ocol0;
    __device__ __forceinline__ bool next(int i, Unit& u) const {
        const int L = i * G + c; if (L >= nM * nN) return false;
        int pm, pn; pg8::tile_of(L, nM, nN, pm, pn); pm += 1;
        u.pm = pm; u.pn = pn; u.kind = 0; u.ocol = ocol0 + 256 * pn; u.nt = K / 64; u.lda2 = (unsigned)lda * 2u; u.ldb2 = (unsigned)K * 2u;
        u.A = (const char*)(A + (size_t)pm * 256 * lda); u.B = (const char*)(B + (size_t)pn * 256 * K); return true;
    }
};
struct SchedMlaUp {
    const bf16_t* P; const bf16_t* Wq; const bf16_t* Wkv; int G, c;
    __device__ __forceinline__ bool next(int i, Unit& u) const {
        const int L = i * G + c; if (L >= NPMM * 14) return false;
        int pm, pn; pg8::tile_of(L, NPMM, 14, pm, pn); pm += 1;
        u.pm = pm; u.pn = pn; u.kind = 0; u.nt = 8; u.lda2 = PW * 2u; u.ldb2 = 512 * 2u;
        if (pn < 6) { u.A = (const char*)(P + (size_t)pm * 256 * PW + C_CQ); u.B = (const char*)(Wq + (size_t)pn * 256 * 512); u.ocol = C_QRAW + 256 * pn; }
        else { u.A = (const char*)(P + (size_t)pm * 256 * PW + C_CKV); u.B = (const char*)(Wkv + (size_t)(pn - 6) * 256 * 512); u.ocol = C_KVRAW + 256 * (pn - 6); }
        return true;
    }
};
struct EpiP {
    static constexpr bool PERM = true;
    bf16_t* P; const float* rs;
    __device__ __forceinline__ void operator()(const f32x4 (&acc)[2][2][4][2], const Unit& u, int wr, int wc, int fr, int fq) const {
        asm volatile("" : "+v"(fr), "+v"(fq));
        const int row0 = u.pm * 256 + wr * 64 + fr, col0 = u.ocol + wc * 32 + 8 * fq;
#pragma unroll
        for (int ai = 0; ai < 2; ++ai)
#pragma unroll
            for (int m = 0; m < 4; ++m) { bf16_t* rowp = P + (size_t)(row0 + ai * 128 + m * 16) * PW + col0;
                const float sc = rs ? __builtin_amdgcn_rsqf(rs[row0 + ai * 128 + m * 16] * (1.f / DM) + EPS) : 1.f;
#pragma unroll
                for (int bj = 0; bj < 2; ++bj) { const f32x4 v0 = acc[ai][bj][m][0] * sc, v1 = acc[ai][bj][m][1] * sc;
                    u32x4 w; w.x = cvt_pk_bf16(v0[0], v0[1]); w.y = cvt_pk_bf16(v0[2], v0[3]); w.z = cvt_pk_bf16(v1[0], v1[1]); w.w = cvt_pk_bf16(v1[2], v1[3]);
                    *(u32x4*)(rowp + bj * 128) = w; } }
    }
};
struct EpiG2 {
    static constexpr bool PERM = true;
    bf16_t* P; const float* rs; const float* gperm; LAS float* xl;
    __device__ __forceinline__ void operator()(const f32x4 (&acc)[2][2][4][2], const Unit& u, int wr, int wc, int fr, int fq) const {
        asm volatile("" : "+v"(fr), "+v"(fq));
        const int row0 = u.pm * 256 + wr * 64 + fr, lcol = wc * 32 + 8 * fq, col0 = u.ocol + lcol;
        const int pn = u.pn;
        const bool plain = (pn >= 8 && pn < 12) || pn >= 24, isidx = (pn >= 12 && pn < 16), nrm = !plain && !isidx;
        float rsc[2][4];
#pragma unroll
        for (int ai = 0; ai < 2; ++ai)
#pragma unroll
            for (int m = 0; m < 4; ++m) rsc[ai][m] = __builtin_amdgcn_rsqf(rs[row0 + ai * 128 + m * 16] * (1.f / DM) + EPS);
        if (nrm) {
#pragma unroll
            for (int ai = 0; ai < 2; ++ai)
#pragma unroll
                for (int m = 0; m < 4; ++m)
#pragma unroll
                    for (int bj = 0; bj < 2; ++bj) { const f32x4 a = acc[ai][bj][m][0], b = acc[ai][bj][m][1]; float ss = (a[0] * a[0] + a[1] * a[1]) + (a[2] * a[2] + a[3] * a[3]) + (b[0] * b[0] + b[1] * b[1]) + (b[2] * b[2] + b[3] * b[3]);
                        ss += __shfl_xor(ss, 16); ss += __shfl_xor(ss, 32);
                        if (fq == 0) xl[((wr * 64 + fr + ai * 128 + m * 16) * 2 + bj) * 4 + wc] = ss * rsc[ai][m] * rsc[ai][m]; }
            asm volatile("s_waitcnt lgkmcnt(0)" ::: "memory"); __builtin_amdgcn_s_barrier(); asm volatile("" ::: "memory");
        }
        const int i0 = isidx ? (16 * (wc & 1) + 4 * fq) : (16 * wc + 4 * fq);
        const float tod = isidx ? (2.f / 64.f) : (2.f / 128.f);
        float inv[4];
#pragma unroll
        for (int j = 0; j < 4; ++j) inv[j] = __builtin_amdgcn_exp2f(-(float)(i0 + j) * tod * 13.287712379549449f) * 0.15915494309189535f;
        const int gidx = pn < 4 ? 0 : (pn < 8 ? 1 : (pn < 20 ? 2 : 3));
        const float qscale = (pn < 4 || (pn >= 16 && pn < 20)) ? C2_128 : 1.f;
        f32x4 g0 = (f32x4){1.f, 1.f, 1.f, 1.f}, g1 = g0;
        if (nrm) { g0 = *(const f32x4*)(gperm + gidx * 128 + lcol); g1 = *(const f32x4*)(gperm + gidx * 128 + lcol + 4); }
#pragma unroll
        for (int ai = 0; ai < 2; ++ai)
#pragma unroll
            for (int m = 0; m < 4; ++m) { const int row = row0 + ai * 128 + m * 16; bf16_t* rowp = P + (size_t)row * PW + col0;
                float cs[4], sn[4];
                if (!plain) { const float pos = (float)(NMETA + ((row - MBLK) & (SEQ - 1)));
#pragma unroll
                    for (int j = 0; j < 4; ++j) { float rev = pos * inv[j]; rev -= floorf(rev); sn[j] = __builtin_amdgcn_sinf(rev); cs[j] = __builtin_amdgcn_cosf(rev); } }
#pragma unroll
                for (int bj = 0; bj < 2; ++bj) { f32x4 v0 = acc[ai][bj][m][0] * rsc[ai][m], v1 = acc[ai][bj][m][1] * rsc[ai][m];
                    if (!plain) {
                        if (nrm) { const LAS f32x4* xp = (const LAS f32x4*)(xl + ((wr * 64 + fr + ai * 128 + m * 16) * 2 + bj) * 4); const f32x4 pp = *xp;
                            const float rn = __builtin_amdgcn_rsqf(((pp[0] + pp[1]) + (pp[2] + pp[3])) * (1.f / 128.f) + EPS); v0 = v0 * (g0 * rn); v1 = v1 * (g1 * rn); }
                        f32x4 w0, w1;
                        w0[0] = v0[0] * cs[0] - v0[1] * sn[0]; w0[1] = v0[1] * cs[0] + v0[0] * sn[0]; w0[2] = v0[2] * cs[1] - v0[3] * sn[1]; w0[3] = v0[3] * cs[1] + v0[2] * sn[1];
                        w1[0] = v1[0] * cs[2] - v1[1] * sn[2]; w1[1] = v1[1] * cs[2] + v1[0] * sn[2]; w1[2] = v1[2] * cs[3] - v1[3] * sn[3]; w1[3] = v1[3] * cs[3] + v1[2] * sn[3];
                        v0 = w0 * qscale; v1 = w1 * qscale; }
                    u32x4 w; w.x = cvt_pk_bf16(v0[0], v0[1]); w.y = cvt_pk_bf16(v0[2], v0[3]); w.z = cvt_pk_bf16(v1[0], v1[1]); w.w = cvt_pk_bf16(v1[2], v1[3]);
                    *(u32x4*)(rowp + bj * 128) = w; } }
    }
};
struct EpiGate {
    static constexpr bool PERM = true;
    bf16_t* G; const float* bias; const float* rs;
    __device__ __forceinline__ void operator()(const f32x4 (&acc)[2][2][4][2], const Unit& u, int wr, int wc, int fr, int fq) const {
        asm volatile("" : "+v"(fr), "+v"(fq));
        const int row0 = u.pm * 256 + wr * 64 + fr, col0 = u.pn * 256 + wc * 32 + 8 * fq;
        float rsc[2][4];
#pragma unroll
        for (int ai = 0; ai < 2; ++ai)
#pragma unroll
            for (int m = 0; m < 4; ++m) rsc[ai][m] = __builtin_amdgcn_rsqf(rs[row0 + ai * 128 + m * 16] * (1.f / DM) + EPS);
#pragma unroll
        for (int bj = 0; bj < 2; ++bj) { const f32x4 bv0 = *(const f32x4*)(bias + col0 + bj * 128), bv1 = *(const f32x4*)(bias + col0 + bj * 128 + 4);
#pragma unroll
            for (int ai = 0; ai < 2; ++ai)
#pragma unroll
                for (int m = 0; m < 4; ++m) { bf16_t* rowp = G + (size_t)(row0 + ai * 128 + m * 16) * 2048 + col0; f32x4 v0 = acc[ai][bj][m][0] * rsc[ai][m] + bv0, v1 = acc[ai][bj][m][1] * rsc[ai][m] + bv1;
#pragma unroll
                    for (int e = 0; e < 4; ++e) { v0[e] = __builtin_amdgcn_rcpf(1.f + __builtin_amdgcn_exp2f(-v0[e] * LOG2E)); v1[e] = __builtin_amdgcn_rcpf(1.f + __builtin_amdgcn_exp2f(-v1[e] * LOG2E)); }
                    u32x4 w; w.x = cvt_pk_bf16(v0[0], v0[1]); w.y = cvt_pk_bf16(v0[2], v0[3]); w.z = cvt_pk_bf16(v1[0], v1[1]); w.w = cvt_pk_bf16(v1[2], v1[3]);
                    *(u32x4*)(rowp + bj * 128) = w; } }
    }
};
struct EpiGated {
    static constexpr bool PERM = true;
    bf16_t* P; const bf16_t* G; int first; float sc;
    __device__ __forceinline__ void operator()(const f32x4 (&acc)[2][2][4][2], const Unit& u, int wr, int wc, int fr, int fq) const {
        asm volatile("" : "+v"(fr), "+v"(fq));
        const int row0 = u.pm * 256 + wr * 64 + fr, lcol0 = u.pn * 256 + wc * 32 + 8 * fq, col0 = u.ocol + wc * 32 + 8 * fq;
        unsigned zu = 0u; asm volatile("" : "+v"(zu));
#pragma unroll
        for (int ai = 0; ai < 2; ++ai)
#pragma unroll
            for (int m = 0; m < 4; ++m) { bf16_t* rowp = P + (size_t)(row0 + ai * 128 + m * 16) * PW + col0; const bf16_t* gp = G + (size_t)(row0 + ai * 128 + m * 16) * 2048 + lcol0;
#pragma unroll
                for (int bj = 0; bj < 2; ++bj) { u32x4 g = *(const u32x4*)(gp + bj * 128); if (DBG_BR == 1) g = (u32x4){0x3f803f80u, 0x3f803f80u, 0x3f803f80u, 0x3f803f80u};
                    u32x4 pv = (u32x4){zu, zu, zu, zu}; if (!first) pv = *(const u32x4*)(rowp + bj * 128);
                    const f32x4 v0 = acc[ai][bj][m][0] * sc, v1 = acc[ai][bj][m][1] * sc;
                    float o[8];
                    o[0] = __uint_as_float(pv.x << 16) + __uint_as_float(g.x << 16) * v0[0]; o[1] = __uint_as_float(pv.x & 0xffff0000u) + __uint_as_float(g.x & 0xffff0000u) * v0[1];
                    o[2] = __uint_as_float(pv.y << 16) + __uint_as_float(g.y << 16) * v0[2]; o[3] = __uint_as_float(pv.y & 0xffff0000u) + __uint_as_float(g.y & 0xffff0000u) * v0[3];
                    o[4] = __uint_as_float(pv.z << 16) + __uint_as_float(g.z << 16) * v1[0]; o[5] = __uint_as_float(pv.z & 0xffff0000u) + __uint_as_float(g.z & 0xffff0000u) * v1[1];
                    o[6] = __uint_as_float(pv.w << 16) + __uint_as_float(g.w << 16) * v1[2]; o[7] = __uint_as_float(pv.w & 0xffff0000u) + __uint_as_float(g.w & 0xffff0000u) * v1[3];
                    u32x4 w; w.x = cvt_pk_bf16(o[0], o[1]); w.y = cvt_pk_bf16(o[2], o[3]); w.z = cvt_pk_bf16(o[4], o[5]); w.w = cvt_pk_bf16(o[6], o[7]);
                    *(u32x4*)(rowp + bj * 128) = w; }
                asm volatile("" ::: "memory"); }
    }
};
struct EpiRes {
    static constexpr bool PERM = false;
    const float* base_tok; float* out_tok; float* hmeta; float dbg; bf16_t* hb; float* rs;
    __device__ __forceinline__ void operator()(const f32x4 (&acc)[2][2][4][2], const Unit& u, int wr, int wc, int fr, int fq) const {
        asm volatile("" : "+v"(fr), "+v"(fq));
        const float* bp; float* op;
        if (u.pm == 0) { bp = hmeta; op = hmeta; } else { bp = base_tok + (size_t)(u.pm - 1) * 256 * DM; op = out_tok + (size_t)(u.pm - 1) * 256 * DM; }
        const int lrow0 = wr * 64 + fr, col0 = u.pn * 256 + wc * 32 + 4 * fq;
#pragma unroll
        for (int ai = 0; ai < 2; ++ai)
#pragma unroll
            for (int m = 0; m < 4; ++m) { const size_t off = (size_t)(lrow0 + ai * 128 + m * 16) * DM + col0;
                const int grow = u.pm * 256 + lrow0 + ai * 128 + m * 16; float ss = 0.f;
#pragma unroll
                for (int bj = 0; bj < 2; ++bj)
#pragma unroll
                    for (int n = 0; n < 2; ++n) { const f32x4 bs = *(const f32x4*)(bp + off + bj * 128 + n * 16); const f32x4 hv = bs + acc[ai][bj][m][n] * dbg; *(f32x4*)(op + off + bj * 128 + n * 16) = hv;
                        if (hb) { ss += (hv[0] * hv[0] + hv[1] * hv[1]) + (hv[2] * hv[2] + hv[3] * hv[3]); u32x2 w; w.x = cvt_pk_bf16(hv[0], hv[1]); w.y = cvt_pk_bf16(hv[2], hv[3]); *(u32x2*)(hb + (size_t)grow * DM + col0 + bj * 128 + n * 16) = w; } }
                if (hb) { ss += __shfl_xor(ss, 16); ss += __shfl_xor(ss, 32); if (fq == 0) (void)__hip_atomic_fetch_add(rs + grow, ss, __ATOMIC_RELAXED, __HIP_MEMORY_SCOPE_AGENT); }
                asm volatile("" ::: "memory"); }
    }
};
struct EpiSwiglu {
    static constexpr bool PERM = true;
    bf16_t* P; const float* rs;
    __device__ __forceinline__ void operator()(const f32x4 (&acc)[2][2][4][2], const Unit& u, int wr, int wc, int fr, int fq) const {
        asm volatile("" : "+v"(fr), "+v"(fq));
        const int row0 = u.pm * 256 + wr * 64 + fr, col0 = u.pn * 128 + wc * 32 + 8 * fq;
#pragma unroll
        for (int ai = 0; ai < 2; ++ai)
#pragma unroll
            for (int m = 0; m < 4; ++m) { bf16_t* rowp = P + (size_t)(row0 + ai * 128 + m * 16) * PW + col0;
                const float sc = __builtin_amdgcn_rsqf(rs[row0 + ai * 128 + m * 16] * (1.f / DM) + EPS);
                float o[8];
#pragma unroll
                for (int n = 0; n < 2; ++n)
#pragma unroll
                    for (int e = 0; e < 4; ++e) { const float g = acc[ai][0][m][n][e] * sc, up = acc[ai][1][m][n][e] * sc; o[n * 4 + e] = g * __builtin_amdgcn_rcpf(1.f + __builtin_amdgcn_exp2f(-g * LOG2E)) * up; }
                u32x4 w; w.x = cvt_pk_bf16(o[0], o[1]); w.y = cvt_pk_bf16(o[2], o[3]); w.z = cvt_pk_bf16(o[4], o[5]); w.w = cvt_pk_bf16(o[6], o[7]);
                *(u32x4*)rowp = w; }
    }
};

struct SkP { bf16_t* P; int ocol; const float* rs; __device__ __forceinline__ void operator()(int r, int c, float v) const { if (rs) v *= __builtin_amdgcn_rsqf(rs[MROW0 + r] * (1.f / DM) + EPS); P[(size_t)(MROW0 + r) * PW + ocol + c] = (bf16_t)f2bf(v); } };
struct SkGate { bf16_t* G; const float* bias; const float* rs; __device__ __forceinline__ void operator()(int r, int c, float v) const { v *= __builtin_amdgcn_rsqf(rs[MROW0 + r] * (1.f / DM) + EPS); G[(size_t)(MROW0 + r) * 2048 + c] = (bf16_t)f2bf(__builtin_amdgcn_rcpf(1.f + __builtin_amdgcn_exp2f(-(v + bias[c]) * LOG2E))); } };
struct SkGated { bf16_t* P; const bf16_t* G; int first; __device__ __forceinline__ void operator()(int r, int c, float v) const { bf16_t* p = P + (size_t)(MROW0 + r) * PW + C_MERGED + c; const float pv = first ? 0.f : bf2f(*p); *p = (bf16_t)f2bf(pv + bf2f(G[(size_t)(MROW0 + r) * 2048 + c]) * v); } };
struct SkRes { float* hmeta; bf16_t* hb; float* rs;
    __device__ __forceinline__ void operator()(int r, int c, float v) const { float* p = hmeta + (size_t)(MROW0 + r) * DM + c; const float hv = *p + v; *p = hv;
        if (hb) { hb[(size_t)(MROW0 + r) * DM + c] = (bf16_t)f2bf(hv); float ss = hv * hv; ss += __shfl_xor(ss, 1); ss += __shfl_xor(ss, 2); ss += __shfl_xor(ss, 4); ss += __shfl_xor(ss, 8);
            if ((threadIdx.x & 15) == 0) (void)__hip_atomic_fetch_add(rs + MROW0 + r, ss, __ATOMIC_RELAXED, __HIP_MEMORY_SCOPE_AGENT); } } };
template <class Fn>
__device__ __forceinline__ void skinny_gemm(LAS unsigned char* lds, const bf16_t* A, int lda, const bf16_t* Bt, int K, int ntask, int bid, int G, const Fn& f) {
    int tid = threadIdx.x; asm volatile("" : "+v"(tid));
    const int wid = __builtin_amdgcn_readfirstlane(tid >> 6), lane = tid & 63, l15 = lane & 15, kq = lane >> 4;
    LAS f32x4* red = (LAS f32x4*)lds;
    const int kw = K / 8;
    for (int task = bid; task < ntask; task += G) {
        const bf16_t* ap = A + (size_t)l15 * lda + wid * kw + kq * 8;
        const bf16_t* bp = Bt + (size_t)(task * 16 + l15) * K + wid * kw + kq * 8;
        float z = 0.f; asm volatile("" : "+v"(z));
        f32x4 acc = (f32x4){z, z, z, z};
        for (int k0 = 0; k0 < kw; k0 += 256) {
            bf16x8 fa[8], fb[8];
#pragma unroll
            for (int i = 0; i < 8; ++i) { const int k = (k0 + 32 * i < kw) ? k0 + 32 * i : 0; fa[i] = *(const bf16x8*)(ap + k); fb[i] = *(const bf16x8*)(bp + k); }
#pragma unroll
            for (int i = 0; i < 8; ++i) if (k0 + 32 * i < kw) acc = __builtin_amdgcn_mfma_f32_16x16x32_bf16(fa[i], fb[i], acc, 0, 0, 0);
        }
        red[wid * 64 + lane] = acc;
        LDS_WAIT(); __syncthreads();
        if (wid == 0) {
            f32x4 s = red[lane];
#pragma unroll
            for (int w = 1; w < 8; ++w) s += red[w * 64 + lane];
#pragma unroll
            for (int r = 0; r < 4; ++r) f(kq * 4 + r, task * 16 + l15, s[r]);
        }
        __syncthreads();
    }
}
__device__ __forceinline__ void skinny_swiglu(LAS unsigned char* lds, const bf16_t* A, int lda, const bf16_t* Bt, int K, bf16_t* P, const float* rs, int bid, int G) {
    int tid = threadIdx.x; asm volatile("" : "+v"(tid));
    const int wid = __builtin_amdgcn_readfirstlane(tid >> 6), lane = tid & 63, l15 = lane & 15, kq = lane >> 4;
    LAS f32x4* red = (LAS f32x4*)lds;
    const int kw = K / 8;
    for (int task = bid; task < DFF / 16; task += G) {
        const int c0 = task * 16, brow = (c0 >> 7) * 256 + (c0 & 127) + l15;
        const bf16_t* ap = A + (size_t)l15 * lda + wid * kw + kq * 8;
        const bf16_t* bg = Bt + (size_t)brow * K + wid * kw + kq * 8; const bf16_t* bu = bg + (size_t)128 * K;
        float z = 0.f; asm volatile("" : "+v"(z));
        f32x4 ag = (f32x4){z, z, z, z}, au = ag;
        {
            bf16x8 fa[8], fg[8], fu[8];
#pragma unroll
            for (int i = 0; i < 8; ++i) { fa[i] = *(const bf16x8*)(ap + 32 * i); fg[i] = *(const bf16x8*)(bg + 32 * i); fu[i] = *(const bf16x8*)(bu + 32 * i); }
#pragma unroll
            for (int i = 0; i < 8; ++i) { ag = __builtin_amdgcn_mfma_f32_16x16x32_bf16(fa[i], fg[i], ag, 0, 0, 0); au = __builtin_amdgcn_mfma_f32_16x16x32_bf16(fa[i], fu[i], au, 0, 0, 0); }
        }
        red[wid * 64 + lane] = ag; red[512 + wid * 64 + lane] = au;
        LDS_WAIT(); __syncthreads();
        if (wid == 0) {
            f32x4 sg = red[lane], su = red[512 + lane];
#pragma unroll
            for (int w = 1; w < 8; ++w) { sg += red[w * 64 + lane]; su += red[512 + w * 64 + lane]; }
#pragma unroll
            for (int r = 0; r < 4; ++r) { const float sc = __builtin_amdgcn_rsqf(rs[MROW0 + kq * 4 + r] * (1.f / DM) + EPS); const float g = sg[r] * sc; su[r] *= sc; P[(size_t)(MROW0 + kq * 4 + r) * PW + c0 + l15] = (bf16_t)f2bf(g * __builtin_amdgcn_rcpf(1.f + __builtin_amdgcn_exp2f(-g * LOG2E)) * su[r]); }
        }
        __syncthreads();
    }
}

#define XB_TMO      128
#define XB_XCNT(j)  (256  + 64 * (j))
#define XB_XSUB(j)  (1280 + 64 * (j))
#define XB_XGEN(j)  (2304 + 64 * (j))
#define XB_TOP      3328
#define XB_TOPGEN   3392
#define XCD_BAR_WORDS 3456
#define XB_SPIN_CAP (1u << 18)
__device__ __forceinline__ unsigned xb_ld(unsigned* p)              { return __hip_atomic_load(p, __ATOMIC_RELAXED, __HIP_MEMORY_SCOPE_AGENT); }
__device__ __forceinline__ unsigned xb_add(unsigned* p, unsigned v) { return __hip_atomic_fetch_add(p, v, __ATOMIC_RELAXED, __HIP_MEMORY_SCOPE_AGENT); }
__device__ __forceinline__ unsigned xb_xcc_id() { return (unsigned)__builtin_amdgcn_s_getreg((3 << 11) | 20) & 0xFu; }
#define XB_SPIN(cond, bar) do { unsigned _sp = 0; while (cond) { __builtin_amdgcn_s_sleep(1); \
    if ((++_sp & 255u) == 0u) { if (xb_ld(&(bar)[XB_TMO])) break; if (_sp > XB_SPIN_CAP) { atomicAdd(&(bar)[XB_TMO], 1u); break; } } } } while (0)
struct XcdBarrier { unsigned* bar; unsigned x; volatile LAS unsigned* st; };
__device__ __forceinline__ XcdBarrier xcd_barrier_post(unsigned* bar, volatile LAS unsigned* st) {
    XcdBarrier b; b.bar = bar; b.x = xb_xcc_id(); b.st = st;
    if (threadIdx.x == 0) (void)xb_add(&bar[XB_XCNT(b.x)], 1u);
    return b;
}
__device__ __forceinline__ void xcd_barrier_complete(unsigned* bar, unsigned x, unsigned& nloc, unsigned& nx) {
    const unsigned G = gridDim.x * gridDim.y * gridDim.z;
    unsigned sum, cnt, mine, sp = 0u;
    for (;;) {
        sum = 0u; cnt = 0u; mine = 0u;
#pragma unroll
        for (unsigned j = 0; j < 16; ++j) { const unsigned c = xb_ld(&bar[XB_XCNT(j)]); sum += c; cnt += (c > 0u) ? 1u : 0u; mine = (j == x) ? c : mine; }
        if (sum == G) break;
        __builtin_amdgcn_s_sleep(1);
        if ((++sp & 255u) == 0u) { if (xb_ld(&bar[XB_TMO])) break; if (sp > XB_SPIN_CAP) { atomicAdd(&bar[XB_TMO], 1u); break; } }
    }
    nloc = mine > 0u ? mine : 1u; nx = cnt > 0u ? cnt : 1u;
}
__device__ __forceinline__ void xcd_barrier(const XcdBarrier& b) {
    asm volatile("s_waitcnt vmcnt(0)" ::: "memory");
    __syncthreads();
    if (threadIdx.x == 0) {
        unsigned* bar = b.bar;
        __builtin_amdgcn_s_waitcnt(0);
        unsigned nloc = b.st[0], nx = b.st[1];
        if (nloc == 0u) { xcd_barrier_complete(bar, b.x, nloc, nx); b.st[0] = nloc; b.st[1] = nx; }
        const unsigned old = xb_add(&bar[XB_XSUB(b.x)], 1u);
        const unsigned gen = old / nloc;
        if (old + 1u == (gen + 1u) * nloc) {
            __builtin_amdgcn_fence(__ATOMIC_RELEASE, "agent");
            asm volatile("s_waitcnt vmcnt(0)" ::: "memory");
            const unsigned og = xb_add(&bar[XB_TOP], 1u);
            const unsigned tg = og / nx;
            if (og + 1u == (tg + 1u) * nx) xb_add(&bar[XB_TOPGEN], 1u);
            else XB_SPIN(xb_ld(&bar[XB_TOPGEN]) == tg, bar);
            __builtin_amdgcn_fence(__ATOMIC_ACQUIRE, "agent");
            xb_add(&bar[XB_XGEN(b.x)], 1u);
            asm volatile("s_waitcnt vmcnt(0)" ::: "memory");
        } else {
            XB_SPIN(xb_ld(&bar[XB_XGEN(b.x)]) == gen, bar);
            __builtin_amdgcn_fence(__ATOMIC_ACQUIRE, "agent");
            asm volatile("s_waitcnt vmcnt(0)" ::: "memory");
        }
    }
    __syncthreads();
}

constexpr int NWAVES = 8;
constexpr int RING_BYTES = 131072, LDS_BYTES = 147456, LDSCTL_OFF = LDS_BYTES - 512;
struct Args {
    const float* in[19]; float* out; unsigned char* ws; int ph_lo, ph_hi;
};
struct Ctx {
    LAS unsigned char* lds; int tid, lane, wave, gw, ngw, G, bid;
};

template <int MAP> __device__ __forceinline__ int wmap(int n, float& sc) {
    sc = 1.f;
    if (MAP == 0) return n;
    if (MAP == 1) {
        if (n < 1088) return n;
        if (n < 3136) { const int m = n - 1088, d = m & 127; return 1280 + (m - d) + (d < 64 ? 2 * d : 2 * (d - 64) + 1); }
        if (n < 4160) return 1280 + (n - 1088);
        if (n < 5184) { const int m = n - 4160, d = m & 63; return 4352 + (m - d) + (d < 32 ? 2 * d : 2 * (d - 32) + 1); }
        if (n < 5248) { const int d = n - 5184; return 1088 + (d < 32 ? 2 * d : 2 * (d - 32) + 1); }
        if (n < 5264) { sc = 0.03125f; return 1152 + (n - 5248); }
        if (n < 7312) { const int m = n - 5264, d = m & 127; return 5376 + (m - d) + (d < 64 ? 2 * d : 2 * (d - 64) + 1); }
        if (n < 8336) return 5376 + (n - 5264);
        return 8448 + (n - 8336);
    }
    if (n < DFF) return (n >> 7) * 256 + (n & 127);
    const int m = n - DFF; return (m >> 7) * 256 + 128 + (m & 127);
}
template <int MAP> __device__ __forceinline__ void conv_item(const float* W, int K, int N, bf16_t* WT, const float* gain, LAS float* scr, int item, int lane) {
    const int nblk = (N + 31) / 32, kb = item / nblk, nb = item - kb * nblk, k0 = 64 * kb, n0 = 32 * nb;
    const int nn = n0 + (lane & 31);
    float wv[32];
#pragma unroll
    for (int i = 0; i < 32; ++i) { const int kk = 2 * i + (lane >> 5); wv[i] = (nn < N) ? W[(size_t)(k0 + kk) * N + nn] : 0.f; }
#pragma unroll
    for (int i = 0; i < 32; ++i) { const int kk = 2 * i + (lane >> 5); float v = wv[i]; if (gain) v *= gain[k0 + kk]; scr[kk * 33 + (lane & 31)] = v; }
    LDS_WAIT(); asm volatile("" ::: "memory");
    const int c = lane & 7;
#pragma unroll
    for (int j = 0; j < 4; ++j) { const int n = (lane >> 3) + 8 * j; const int ns = n0 + n;
        if (ns < N) { float sc; const int dst = wmap<MAP>(ns, sc); const LAS float* s = scr + (8 * c) * 33 + n;
            u32x4 o; o.x = pk2(s[0 * 33] * sc, s[1 * 33] * sc); o.y = pk2(s[2 * 33] * sc, s[3 * 33] * sc); o.z = pk2(s[4 * 33] * sc, s[5 * 33] * sc); o.w = pk2(s[6 * 33] * sc, s[7 * 33] * sc);
            *(u32x4*)(WT + (size_t)dst * K + k0 + 8 * c) = o; } }
    LDS_WAIT(); asm volatile("" ::: "memory");
}
template <int MAP> __device__ __forceinline__ void conv_matrix(const Ctx& F, const float* W, int K, int N, bf16_t* WT, const float* gain) {
    LAS float* scr = (LAS float*)(F.lds + F.wave * 16384);
    const int nit = (K / 64) * ((N + 31) / 32);
    for (int it = F.gw; it < nit; it += F.ngw) conv_item<MAP>(W, K, N, WT, gain, scr, it, F.lane);
}

__device__ __forceinline__ void norm_row(const float* hrow, bf16_t* orow, float* rs_row, int lane) {
    f32x4 v[8]; float s = 0.f;
#pragma unroll
    for (int j = 0; j < 8; ++j) { v[j] = *((const f32x4*)hrow + lane + 64 * j); s += (v[j].x * v[j].x + v[j].y * v[j].y) + (v[j].z * v[j].z + v[j].w * v[j].w); }
    s = wave_sum(s);
    if (lane == 0) *rs_row = s;
#pragma unroll
    for (int j = 0; j < 8; ++j) { u32x2 o; o.x = cvt_pk_bf16(v[j].x, v[j].y); o.y = cvt_pk_bf16(v[j].z, v[j].w); *((u32x2*)orow + lane + 64 * j) = o; }
}

__device__ __forceinline__ void post1a_row(const bf16_t* P, int r, float* rstdq, float* rstdkv, int lane) {
    const bf16_t* p = P + (size_t)r * PW;
    const u32x4 a = *((const u32x4*)(p + C_CQ) + lane), b = *((const u32x4*)(p + C_CKV) + lane);
    float sa = 0.f, sb = 0.f;
#pragma unroll
    for (int e = 0; e < 4; ++e) { const float x0 = __uint_as_float(a[e] << 16), x1 = __uint_as_float(a[e] & 0xffff0000u); sa += x0 * x0 + x1 * x1;
        const float y0 = __uint_as_float(b[e] << 16), y1 = __uint_as_float(b[e] & 0xffff0000u); sb += y0 * y0 + y1 * y1; }
    sa = wave_sum(sa); sb = wave_sum(sb);
    if (lane == 0) { rstdq[r] = 1.0f / sqrtf(sa * (1.f / 512.f) + EPS); rstdkv[r] = 1.0f / sqrtf(sb * (1.f / 512.f) + EPS); }
    { unsigned* ikp = (unsigned*)(P + (size_t)r * PW + C_IK) + (lane & 31); const unsigned w = *ikp; const float x1 = __uint_as_float(w << 16), x2 = __uint_as_float(w & 0xffff0000u);
      float cs, sn; rope_cs(row_pos(r), lane & 31, 2.f / 64.f, cs, sn);
      if (lane < 32) *ikp = cvt_pk_bf16(x1 * cs - x2 * sn, x2 * cs + x1 * sn); }
}
__device__ __forceinline__ void meta_post_row(bf16_t* P, int r, const float* gperm, int lane) {
    bf16_t* p = P + (size_t)r * PW; const int pos = row_pos(r);
    float c128, s128, c64, s64; rope_cs(pos, lane, 2.f / 128.f, c128, s128); rope_cs(pos, lane & 31, 2.f / 64.f, c64, s64);
#pragma unroll 1
    for (int t = 0; t < 4; ++t) {
        const int cb = t == 0 ? C_DQ : (t == 1 ? C_DK : (t == 2 ? C_FQ : C_FK)); const float sc = (t == 0 || t == 2) ? C2_128 : 1.f;
        const float ga = gperm[t * 128 + 2 * lane], gb = gperm[t * 128 + 2 * lane + 1];
#pragma unroll 1
        for (int h = 0; h < 8; ++h) { unsigned* xp = (unsigned*)(p + cb + h * 128) + lane; const unsigned w = *xp; float x1 = __uint_as_float(w << 16), x2 = __uint_as_float(w & 0xffff0000u);
            const float rn = __builtin_amdgcn_rsqf(wave_sum(x1 * x1 + x2 * x2) * (1.f / 128.f) + EPS); x1 *= rn * ga; x2 *= rn * gb;
            *xp = cvt_pk_bf16((x1 * c128 - x2 * s128) * sc, (x2 * c128 + x1 * s128) * sc); }
    }
#pragma unroll 1
    for (int hh = 0; hh < 8; ++hh) { unsigned* xp = (unsigned*)(p + C_IQ + hh * 128) + lane; const unsigned w = *xp; const float x1 = __uint_as_float(w << 16), x2 = __uint_as_float(w & 0xffff0000u);
        *xp = cvt_pk_bf16(x1 * c64 - x2 * s64, x2 * c64 + x1 * s64); }
}
__device__ __forceinline__ void unpack8(const u32x4& w, float (&x)[8]) {
#pragma unroll
    for (int e = 0; e < 4; ++e) { x[2 * e] = __uint_as_float(w[e] << 16); x[2 * e + 1] = __uint_as_float(w[e] & 0xffff0000u); }
}
__device__ __forceinline__ u32x4 pack8(const float (&x)[8]) { u32x4 w; w.x = cvt_pk_bf16(x[0], x[1]); w.y = cvt_pk_bf16(x[2], x[3]); w.z = cvt_pk_bf16(x[4], x[5]); w.w = cvt_pk_bf16(x[6], x[7]); return w; }
__device__ __forceinline__ u32x4 shfl_xor4(const u32x4& w, int m) { u32x4 r; r.x = __shfl_xor(w.x, m); r.y = __shfl_xor(w.y, m); r.z = __shfl_xor(w.z, m); r.w = __shfl_xor(w.w, m); return r; }
__device__ __forceinline__ void post2_row(bf16_t* P, int r, const float* rstdq, const float* rstdkv, const float* qkg  , LAS float* rnl, int lane) {
    bf16_t* p = P + (size_t)r * PW;
    const float sq = rstdq[r], skv = rstdkv[r];
    const int pos = row_pos(r), hw = lane >> 5, l5 = lane & 31;
    float c64[8], s64[8];
#pragma unroll
    for (int j = 0; j < 8; ++j) rope_cs(pos, 8 * (lane & 3) + j, 2.f / 64.f, c64[j], s64[j]);
    float kp[8]; { const u32x4 w = *(const u32x4*)(p + C_KPE + (lane & 7) * 8); unpack8(w, kp); }
    float kpe_ss = 0.f;
#pragma unroll
    for (int j = 0; j < 8; ++j) kpe_ss += kp[j] * kp[j];
    kpe_ss += __shfl_xor(kpe_ss, 1); kpe_ss += __shfl_xor(kpe_ss, 2); kpe_ss += __shfl_xor(kpe_ss, 4);
    u32x4 rq[4], rkv[4];
#pragma unroll
    for (int it = 0; it < 4; ++it) { const int h = 2 * it + hw; rq[it] = *(const u32x4*)(p + C_QRAW + h * 192 + (l5 < 24 ? l5 : 0) * 8); rkv[it] = *(const u32x4*)(p + C_KVRAW + h * 256 + l5 * 8); }
#pragma unroll
    for (int it = 0; it < 4; ++it) {
        const int h = 2 * it + hw; const bool act = l5 < 24;
        u32x4* ptr = (u32x4*)(p + C_QRAW + h * 192 + (act ? l5 : 0) * 8);
        float x[8]; unpack8(rq[it], x);
        float ss = 0.f;
#pragma unroll
        for (int j = 0; j < 8; ++j) { x[j] *= sq; ss += x[j] * x[j]; }
        if (!act) ss = 0.f;
#pragma unroll
        for (int o = 1; o < 32; o <<= 1) ss += __shfl_xor(ss, o);
        const float rn = 1.0f / sqrtf(ss * (1.f / 192.f) + EPS);
        const int gi = (act ? l5 : 0) * 8;
        const f32x4 g0 = *(const f32x4*)(qkg + gi), g1 = *(const f32x4*)(qkg + gi + 4);
#pragma unroll
        for (int j = 0; j < 4; ++j) { x[j] *= rn * g0[j]; x[4 + j] *= rn * g1[j]; }
        float o[8];
#pragma unroll
        for (int j = 0; j < 8; ++j) { const float pr = __shfl_xor(x[j], 4); const float rot = (l5 & 4) ? (x[j] * c64[j] + pr * s64[j]) : (x[j] * c64[j] - pr * s64[j]); o[j] = (l5 >= 16 ? rot : x[j]) * C2_192; }
        if (act) *ptr = pack8(o);
    }
#pragma unroll
    for (int it = 0; it < 4; ++it) {
        const int h = 2 * it + hw; const bool isk = l5 < 16;
        u32x4* ptr = (u32x4*)(p + C_KVRAW + h * 256 + l5 * 8);
        float x[8]; unpack8(rkv[it], x);
        float ss = 0.f;
#pragma unroll
        for (int j = 0; j < 8; ++j) { x[j] *= skv; ss += x[j] * x[j]; }
        if (!isk) ss = 0.f;
#pragma unroll
        for (int o = 1; o < 32; o <<= 1) ss += __shfl_xor(ss, o);
        const float rn = 1.0f / sqrtf((ss + kpe_ss) * (1.f / 192.f) + EPS);
        if (l5 == 0) rnl[h] = rn;
        const int gi = 192 + (isk ? l5 : 0) * 8;
        const f32x4 g0 = *(const f32x4*)(qkg + gi), g1 = *(const f32x4*)(qkg + gi + 4);
        float o[8];
#pragma unroll
        for (int j = 0; j < 4; ++j) { o[j] = isk ? x[j] * rn * g0[j] : x[j]; o[4 + j] = isk ? x[4 + j] * rn * g1[j] : x[4 + j]; }
        *ptr = pack8(o);
    }
    LDS_WAIT(); asm volatile("" ::: "memory");
    { const int hd = lane >> 3, c = lane & 7; const float rn = rnl[hd];
      const f32x4 g0 = *(const f32x4*)(qkg + 192 + 128 + c * 8), g1 = *(const f32x4*)(qkg + 192 + 128 + c * 8 + 4);
      float x[8], o[8];
#pragma unroll
      for (int j = 0; j < 4; ++j) { x[j] = kp[j] * rn * g0[j]; x[4 + j] = kp[4 + j] * rn * g1[j]; }
#pragma unroll
      for (int j = 0; j < 8; ++j) { const float pr = __shfl_xor(x[j], 4); o[j] = (c & 4) ? (x[j] * c64[j] + pr * s64[j]) : (x[j] * c64[j] - pr * s64[j]); }
      *(u32x4*)(p + C_KPEH + hd * 64 + c * 8) = pack8(o); }
    LDS_WAIT(); asm volatile("" ::: "memory");
}
__device__ __forceinline__ void post3_row(bf16_t* P, int r, const float* subg, float lam, float omli, int lane) {
    bf16_t* p = P + (size_t)r * PW;
    const int hw = lane >> 5, l5 = lane & 31;
    u32x4 rr[4];
#pragma unroll
    for (int h = 0; h < 4; ++h) rr[h] = *(const u32x4*)(p + (hw ? C_IQ : C_FQ) + h * 256 + l5 * 8);
#pragma unroll
    for (int h = 0; h < 4; ++h) {
        const u32x4 raw = rr[h];
        const u32x4 praw = shfl_xor4(raw, 16);
        float a[8], b[8]; unpack8(raw, a); unpack8(praw, b);
        float d[8], ss = 0.f;
#pragma unroll
        for (int j = 0; j < 8; ++j) { d[j] = a[j] - lam * b[j]; ss += d[j] * d[j]; }
        if (l5 >= 16) ss = 0.f;
#pragma unroll
        for (int o = 1; o < 64; o <<= 1) ss += __shfl_xor(ss, o);
        const float rn = omli / sqrtf(ss * (1.f / 256.f) + EPS);
        const int dim = hw * 128 + (l5 & 15) * 8;
        const f32x4 g0 = *(const f32x4*)(subg + dim), g1 = *(const f32x4*)(subg + dim + 4);
        float o[8];
#pragma unroll
        for (int j = 0; j < 4; ++j) { o[j] = d[j] * rn * g0[j]; o[4 + j] = d[4 + j] * rn * g1[j]; }
        if (l5 < 16) *(u32x4*)(p + C_OC + h * 256 + dim) = pack8(o);
    }
}

__device__ __forceinline__ void index_unit(const bf16_t* P, int unit, unsigned* bm, LAS unsigned char* lds) {
    typedef float f32x16 __attribute__((ext_vector_type(16)));
    int tid = threadIdx.x; asm volatile("" : "+v"(tid));
    const int wid = __builtin_amdgcn_readfirstlane(tid >> 6), lane = tid & 63, j = lane & 31, hi = lane >> 5;
    const int tb = 255 - (unit >> 4), b = unit & 15, t0 = tb * 8, tokbase = MBLK + b * SEQ;
    const int wmax = (64 + t0 + 7) >> 5;
    LAS unsigned* keys = (LAS unsigned*)lds;
    LAS float* iwl = (LAS float*)(lds + 8 * 2112 * 4);
    if (t0 + 7 + 17 > 256) {
        if (tid < 128) iwl[tid] = bf2f(P[(size_t)(tokbase + t0 + (tid >> 4)) * PW + C_IW + (tid & 15)]);
        LAS unsigned char* al = lds + 8 * 2112 * 4 + 512;
        { const int id0 = tid * 2;
#pragma unroll
          for (int e = 0; e < 2; ++e) { const int id = id0 + e, rw = id >> 3, c = id & 7;
              *(LAS bf16x8*)(al + rw * 144 + c * 16) = *(const bf16x8*)(P + (size_t)(tokbase + t0 + (rw >> 4)) * PW + C_IQ + (rw & 15) * 64 + c * 8); } }
        LDS_WAIT(); __syncthreads();
        bf16x8 af[4][4];
        { const int qa = (j >> 2) & 1, ha = (j & 3) + 4 * (j >> 3);
#pragma unroll
          for (int blk = 0; blk < 4; ++blk)
#pragma unroll
              for (int s = 0; s < 4; ++s) af[blk][s] = *(const LAS bf16x8*)(al + ((2 * blk + qa) * 16 + ha) * 144 + s * 32 + hi * 16); }
        const unsigned boff = (unsigned)(j * PW + C_IK + hi * 8) * 2u;
        for (int w = wid; w <= wmax; w += 8) {
            const int kr_ = w < 2 ? (MBLK - 64) + 32 * w : tokbase + 32 * (w - 2); const char* bp_ = (const char*)(P + (size_t)kr_ * PW) + boff;
            bf16x8 bf[4];
#pragma unroll
            for (int s = 0; s < 4; ++s) bf[s] = *(const bf16x8*)(bp_ + s * 32);
            const int kidx = 32 * w + j;
#pragma unroll
            for (int blk = 0; blk < 4; ++blk) {
                f32x16 acc = (f32x16){0.f,0.f,0.f,0.f,0.f,0.f,0.f,0.f,0.f,0.f,0.f,0.f,0.f,0.f,0.f,0.f};
#pragma unroll
                for (int s = 0; s < 4; ++s) acc = __builtin_amdgcn_mfma_f32_32x32x16_bf16(af[blk][s], bf[s], acc, 0, 0, 0);
                const int q = 2 * blk + hi;
                const LAS f32x4* iwq = (const LAS f32x4*)(iwl + q * 16);
                float score = 0.f;
#pragma unroll
                for (int g = 0; g < 4; ++g) { const f32x4 wv = iwq[g]; score += fmaxf(acc[4 * g], 0.f) * wv.x + fmaxf(acc[4 * g + 1], 0.f) * wv.y + fmaxf(acc[4 * g + 2], 0.f) * wv.z + fmaxf(acc[4 * g + 3], 0.f) * wv.w; }
                const bool valid = kidx >= 48 && kidx <= 64 + t0 + q; const unsigned u_ = __float_as_uint(score);
                keys[q * 2112 + kidx] = valid ? ((u_ & 0x80000000u) ? ~u_ : (u_ | 0x80000000u)) : 0u;
            }
        }
        LDS_WAIT(); __syncthreads();
    }
    const int tq = t0 + wid, qk = 64 + tq, nch = qk / 64 + 1;
    unsigned* out = bm + (size_t)(b * SEQ + tq) * BMW;
    if (tq + 17 <= 256) {
        for (int c = 0; c < 33; ++c) { const int kidx = 64 * c + lane; const unsigned long long m = __ballot(kidx >= 48 && kidx <= qk);
            if (lane == 0) { out[2 * c] = (unsigned)m; out[2 * c + 1] = (unsigned)(m >> 32); } }
    } else {
        unsigned kreg[33];
#pragma unroll
        for (int c = 0; c < 33; ++c) kreg[c] = (c < nch && 64 * c + lane <= qk) ? keys[wid * 2112 + 64 * c + lane] : 0u;
        unsigned T = 0u;
        for (int bit = 31; bit >= 0; --bit) {
            const unsigned cand = T | (1u << bit); int cnt = 0;
#pragma unroll
            for (int c = 0; c < 33; ++c) cnt += __popcll(__ballot(kreg[c] >= cand));
            if (cnt >= 256) T = cand;
            if (cnt == 256) break;
        }
#pragma unroll
        for (int c = 0; c < 33; ++c) { const unsigned long long m = __ballot(kreg[c] >= T && kreg[c] != 0u);
            if (lane == 0) { out[2 * c] = (unsigned)m; out[2 * c + 1] = (unsigned)(m >> 32); } }
    }
    LDS_WAIT();
}

namespace fa {
typedef float f32x16 __attribute__((ext_vector_type(16)));
typedef short s16x4 __attribute__((ext_vector_type(4)));
__device__ __forceinline__ int crow(int r, int hi) { return (r & 3) + 8 * (r >> 2) + 4 * hi; }
__device__ __forceinline__ int v_st(int k, int c) { const int kk = (k & ~0xC) | ((k & 4) << 1) | ((k & 8) >> 1); return ((kk >> 3) * 4 + (c >> 5)) * 512 + ((kk & 7) * 32 + (c & 31)) * 2; }
__device__ __forceinline__ int v_rd_base(int lane) { return ((lane & 3) << 3) | (((lane >> 2) & 3) << 6) | (((lane >> 4) & 1) << 5) | (((lane >> 5) & 1) << 8); }
constexpr int v_rd_off(int d0, int ks, int half) { return d0 * 512 + ks * 4096 + half * 2048; }
constexpr int SHM_V = 16384;
template <int DQK, int DV> struct Geo { static constexpr int KP = DQK * 2, SHM_K = 64 * DQK * 2, LDS_K0 = 2 * 64 * DV * 2, LDS_WS = LDS_K0 + 2 * SHM_K, BYTES = LDS_WS + 8 * 256; };
#define FA_KSWZ(row, colB, pitch) ((row) * (pitch) + ((colB) ^ (((row) & 7) << 4)))
#define FA_SBAR() __builtin_amdgcn_sched_barrier(0)

struct Item { int qrow0, qk0, nt, tokbase; };

template <int DQK>
__device__ __forceinline__ void load_q(const bf16_t* P, const Item& it, int qcol, bf16x8 (&qr)[DQK / 16]) {
    int tid = threadIdx.x; asm volatile("" : "+v"(tid));
    const int wid = tid >> 6, lane = tid & 63, r32 = lane & 31, hi = lane >> 5;
    const bf16_t* qp = P + (size_t)(it.qrow0 + wid * 32 + r32) * PW + qcol + hi * 8;
#pragma unroll
    for (int d0 = 0; d0 < DQK / 16; ++d0) qr[d0] = *(const bf16x8*)(qp + d0 * 16);
}

template <int DQK, int DV, bool MASKED>
__device__ __forceinline__ void attn_core(bf16_t* P, const Item& it, const bf16x8 (&qr)[DQK / 16], int k1col, int k2col, int vcol, int ocol, int ocol1, const unsigned* bmq, LAS unsigned char* lds) {
    typedef Geo<DQK, DV> G; constexpr int SHMV = 64 * DV * 2, NDB = DV / 32;
    int tid = threadIdx.x; asm volatile("" : "+v"(tid));
    const int wid = __builtin_amdgcn_readfirstlane(tid >> 6), lane = tid & 63, r32 = lane & 31, hi = lane >> 5;
    LAS unsigned char* V_lds = lds; LAS unsigned char* K_lds = lds + G::LDS_K0; LAS float* wsf = (LAS float*)(lds + G::LDS_WS) + wid * 64;
    const int sr = tid >> 4, sc = (tid & 15) * 8;
    const int vst0 = v_st(sr, sc), vst1 = v_st(32 + sr, sc), kws0 = FA_KSWZ(sr, sc * 2, G::KP), kws1 = FA_KSWZ(sr + 32, sc * 2, G::KP);
    const int xr = tid >> 3, xc = (tid & 7) * 8, kws2 = FA_KSWZ(xr, (128 + xc) * 2, G::KP);
    const unsigned loff0 = (unsigned)(sr * PW + sc) * 2u, loffx = (unsigned)(xr * PW + xc) * 2u;
    const int vb0 = (int)(unsigned)(size_t)V_lds + v_rd_base(lane);
    const int NT = it.nt;
    const int qk = it.qk0 + wid * 32 + r32;
    const bool use_bm = MASKED && (bmq != nullptr);
    const unsigned bmoff = (unsigned)((wid * 32 + r32) * BMW) * 4u;
    float l_reg = 0.f; f32x16 o[NDB];
#pragma unroll
    for (int d = 0; d < NDB; ++d) o[d] = (f32x16){0.f,0.f,0.f,0.f,0.f,0.f,0.f,0.f,0.f,0.f,0.f,0.f,0.f,0.f,0.f,0.f};
    bf16x8 sk0, sk1, sk2, sv0, sv1, sv2, sv3;
#define FA_KROW0(t) ((t) == 0 ? (MBLK - 64) : it.tokbase + 64 * ((t) - 1))
#define FA_LOADK(t) do { const int kr_ = FA_KROW0(t); const char* rb_ = (const char*)(P + (size_t)kr_ * PW); const char* rk_ = rb_ + (size_t)k1col * 2; \
        sk0 = *(const bf16x8*)(rk_ + loff0); sk1 = *(const bf16x8*)(rk_ + (size_t)32 * PW * 2 + loff0); if (DQK == 192) sk2 = *(const bf16x8*)(rb_ + (size_t)k2col * 2 + loffx); } while (0)
#define FA_LOADV(t) do { const char* rv_ = (const char*)(P + (size_t)FA_KROW0(t) * PW) + (size_t)vcol * 2; \
        sv0 = *(const bf16x8*)(rv_ + loff0); sv1 = *(const bf16x8*)(rv_ + (size_t)32 * PW * 2 + loff0); if (DV == 256) { sv2 = *(const bf16x8*)(rv_ + 256 + loff0); sv3 = *(const bf16x8*)(rv_ + 256 + (size_t)32 * PW * 2 + loff0); } } while (0)
#define FA_LOAD(t) do { FA_LOADK(t); FA_LOADV(t); } while (0)
#define FA_WRITE(bf) do { *(LAS bf16x8*)(K_lds + (bf) * G::SHM_K + kws0) = sk0; *(LAS bf16x8*)(K_lds + (bf) * G::SHM_K + kws1) = sk1; \
        *(LAS bf16x8*)(V_lds + (bf) * SHMV + vst0) = sv0; *(LAS bf16x8*)(V_lds + (bf) * SHMV + vst1) = sv1; if (DV == 256) { *(LAS bf16x8*)(V_lds + (bf) * SHMV + 16384 + vst0) = sv2; *(LAS bf16x8*)(V_lds + (bf) * SHMV + 16384 + vst1) = sv3; } \
        if (DQK == 192) *(LAS bf16x8*)(K_lds + (bf) * G::SHM_K + kws2) = sk2; } while (0)
    constexpr int QREG = (DV == 256) ? 3 : DQK / 16;
    constexpr int NQL = DQK / 16 - QREG;
    static_assert(G::BYTES + 8 * NQL * 64 * 16 <= LDSCTL_OFF, "attention LDS budget");
    LAS unsigned char* qx = lds + G::BYTES + (wid * (NQL * 64) + lane) * 16;
    if (QREG < DQK / 16) {
#pragma unroll
        for (int d0 = QREG; d0 < DQK / 16; ++d0) *(LAS bf16x8*)(qx + (d0 - QREG) * 1024) = qr[d0];
    }
    FA_LOAD(0); FA_WRITE(0);
    __syncthreads();
    for (int t = 0; t < NT; ++t) {
        const int cur = t & 1;
        unsigned zb = 0u; asm volatile("" : "+v"(zb)); u32x2 bw = (u32x2){zb, zb};
        if (use_bm) bw = *(const u32x2*)((const char*)(bmq + 2 * t) + bmoff);
        f32x16 p0 = (f32x16){0.f,0.f,0.f,0.f,0.f,0.f,0.f,0.f,0.f,0.f,0.f,0.f,0.f,0.f,0.f,0.f}, p1 = p0;
        { LAS unsigned char* kbase = K_lds + cur * G::SHM_K;
          LAS unsigned char* kb[4];
#pragma unroll
          for (int dd = 0; dd < 4; ++dd) kb[dd] = kbase + FA_KSWZ(r32, (dd * 16 + hi * 8) * 2, G::KP);
          constexpr int GS = (DQK == 192 || DV == 256) ? 2 : 4;
#pragma unroll
          for (int g = 0; g < DQK / (16 * GS); ++g) {
              bf16x8 fb0[GS], fb1[GS];
#pragma unroll
              for (int dd = 0; dd < GS; ++dd) { const int d0 = g * GS + dd; LAS unsigned char* a = kb[d0 & 3] + (d0 >> 2) * 128; fb0[dd] = *(const LAS bf16x8*)a; fb1[dd] = *(const LAS bf16x8*)(a + 32 * G::KP); }
              FA_SBAR();
#pragma unroll
              for (int dd = 0; dd < GS; ++dd) { const int d0 = g * GS + dd; bf16x8 qf; if (d0 < QREG) qf = qr[d0 < QREG ? d0 : 0]; else qf = *(const LAS bf16x8*)(qx + (d0 - QREG) * 1024);
                  p0 = __builtin_amdgcn_mfma_f32_32x32x16_bf16(fb0[dd], qf, p0, 0, 0, 0); p1 = __builtin_amdgcn_mfma_f32_32x32x16_bf16(fb1[dd], qf, p1, 0, 0, 0); }
              FA_SBAR(); } }
        if (t + 1 < NT) { FA_LOADK(t + 1); if (DV != 256) FA_LOADV(t + 1); }
        FA_SBAR();
        const float NEG = -__builtin_inff();
        if (use_bm) {
        } else if (t == 0 || 64 * t + 63 > it.qk0 + wid * 32) {
            const int kb_ = 64 * t + 4 * hi;
#pragma unroll
            for (int r = 0; r < 16; ++r) { const int k0 = kb_ + (r & 3) + 8 * (r >> 2), k1 = k0 + 32;
                if (k0 < 48 || k0 > qk) p0[r] = NEG; if (k1 < 48 || k1 > qk) p1[r] = NEG; }
        }
        float ps = 0.f;
#pragma unroll
        for (int r = 0; r < 16; ++r) { p0[r] = __builtin_amdgcn_exp2f(p0[r]); p1[r] = __builtin_amdgcn_exp2f(p1[r]); }
        if (use_bm) {
            const int wx = (int)(bw.x >> (4 * hi)), wy = (int)(bw.y >> (4 * hi));
#pragma unroll
            for (int r = 0; r < 16; ++r) { const int c = (r & 3) + 8 * (r >> 2);
                p0[r] = __uint_as_float(__float_as_uint(p0[r]) & (unsigned)__builtin_amdgcn_sbfe(wx, c, 1)); p1[r] = __uint_as_float(__float_as_uint(p1[r]) & (unsigned)__builtin_amdgcn_sbfe(wy, c, 1)); }
        }
        { f32x2 s2 = (f32x2){p0[0], p0[1]} + (f32x2){p1[0], p1[1]};
#pragma unroll
          for (int r = 2; r < 16; r += 2) s2 += (f32x2){p0[r], p0[r + 1]} + (f32x2){p1[r], p1[r + 1]};
          ps = s2.x + s2.y; }
        { auto rr = __builtin_amdgcn_permlane32_swap(__float_as_uint(ps), __float_as_uint(ps), false, false); ps = __uint_as_float(rr[0]) + __uint_as_float(rr[1]); }
        l_reg += ps;
        if (DV == 256 && t + 1 < NT) { FA_SBAR(); FA_LOADV(t + 1); FA_SBAR(); }
        bf16x8 pa0, pa1, pa2, pa3;
#define FA_PK4(Pv, B_, OUT) do { const unsigned a0 = cvt_pk_bf16(Pv[B_ + 0], Pv[B_ + 1]), a1 = cvt_pk_bf16(Pv[B_ + 2], Pv[B_ + 3]), b0 = cvt_pk_bf16(Pv[B_ + 4], Pv[B_ + 5]), b1 = cvt_pk_bf16(Pv[B_ + 6], Pv[B_ + 7]); \
        auto r0 = __builtin_amdgcn_permlane32_swap(a0, b0, false, false); auto r1 = __builtin_amdgcn_permlane32_swap(a1, b1, false, false); \
        u32x4 w_ = {r0[0], r1[0], r0[1], r1[1]}; OUT = __builtin_bit_cast(bf16x8, w_); } while (0)
        FA_PK4(p0, 0, pa0); FA_PK4(p0, 8, pa1); FA_PK4(p1, 0, pa2); FA_PK4(p1, 8, pa3);
#define FA_TRRD(dst, off) asm volatile("ds_read_b64_tr_b16 %0, %1 offset:%2" : "=&v"(dst) : "v"(vbc), "i"(off) : "memory")
#define FA_PV(VB, d0) do { s16x4 l0, l1, l2, l3, h0, h1, h2, h3; constexpr int b_ = ((d0) >> 2) * 16384 + v_rd_off((d0) & 3, 0, 0); \
        FA_TRRD(l0, b_); FA_TRRD(h0, b_ + 2048); FA_TRRD(l1, b_ + 4096); FA_TRRD(h1, b_ + 6144); FA_TRRD(l2, b_ + 8192); FA_TRRD(h2, b_ + 10240); FA_TRRD(l3, b_ + 12288); FA_TRRD(h3, b_ + 14336); \
        asm volatile("s_waitcnt lgkmcnt(0)" ::: "memory"); FA_SBAR(); \
        o[d0] = __builtin_amdgcn_mfma_f32_32x32x16_bf16(pa0, (bf16x8){l0[0], l0[1], l0[2], l0[3], h0[0], h0[1], h0[2], h0[3]}, o[d0], 0, 0, 0); \
        o[d0] = __builtin_amdgcn_mfma_f32_32x32x16_bf16(pa1, (bf16x8){l1[0], l1[1], l1[2], l1[3], h1[0], h1[1], h1[2], h1[3]}, o[d0], 0, 0, 0); \
        o[d0] = __builtin_amdgcn_mfma_f32_32x32x16_bf16(pa2, (bf16x8){l2[0], l2[1], l2[2], l2[3], h2[0], h2[1], h2[2], h2[3]}, o[d0], 0, 0, 0); \
        o[d0] = __builtin_amdgcn_mfma_f32_32x32x16_bf16(pa3, (bf16x8){l3[0], l3[1], l3[2], l3[3], h3[0], h3[1], h3[2], h3[3]}, o[d0], 0, 0, 0); } while (0)
        FA_SBAR();
        { const int vbc = vb0 + cur * SHMV;
          FA_PV(0, 0); FA_PV(0, 1); FA_PV(0, 2); FA_PV(0, 3); if (DV == 256) { FA_PV(0, 4); FA_PV(0, 5); FA_PV(0, 6); FA_PV(0, 7); } }
        FA_SBAR();
        if (t + 1 < NT) { const int nb_ = cur ^ 1; FA_WRITE(nb_); }
        __syncthreads();
    }
    if (hi == 0) wsf[r32] = l_reg; LDS_WAIT();
    float rli[16];
#pragma unroll
    for (int r = 0; r < 16; ++r) { const float lv = wsf[crow(r, hi)]; rli[r] = lv > 0.f ? __builtin_amdgcn_rcpf(lv) : 0.f; }
    { int l2 = lane; asm volatile("" : "+v"(l2));
      const int r32b = l2 & 31, hib = l2 >> 5;
      char* Ow = (char*)(P + (size_t)(it.qrow0 + wid * 32) * PW + ocol) + (unsigned)((4 * hib) * PW + r32b) * 2u;
      char* Ow1 = (char*)(P + (size_t)(it.qrow0 + wid * 32) * PW + ocol1) + (unsigned)((4 * hib) * PW + r32b) * 2u;
#pragma unroll
      for (int r = 0; r < 16; ++r) { const unsigned ro = (unsigned)(((r & 3) + 8 * (r >> 2)) * PW) * 2u;
#pragma unroll
        for (int d0 = 0; d0 < NDB; ++d0) { const float v = o[d0][r] * rli[r]; const float vn = __shfl_xor(v, 1);
            if ((r32b & 1) == 0) *(unsigned*)((d0 < 4 ? Ow : Ow1) + ro + (d0 & 3) * 64) = cvt_pk_bf16(v, vn); } } }
    LDS_WAIT();
    __syncthreads();
#undef FA_KROW0
#undef FA_LOAD
#undef FA_LOADK
#undef FA_LOADV
#undef FA_WRITE
#undef FA_PK4
#undef FA_TRRD
#undef FA_PV
}
__device__ __forceinline__ int next_item(unsigned* ctr, LAS int* slot) {
    __syncthreads();
    if (threadIdx.x == 0) *slot = (int)__hip_atomic_fetch_add(ctr, 1u, __ATOMIC_RELAXED, __HIP_MEMORY_SCOPE_AGENT);
    __syncthreads();
    return *slot;
}
__device__ __forceinline__ void queue_prime(unsigned* ctr, LAS int* slot) {
    __syncthreads();
    if (threadIdx.x == 0) slot[0] = (int)__hip_atomic_fetch_add(ctr, 1u, __ATOMIC_RELAXED, __HIP_MEMORY_SCOPE_AGENT);
    __syncthreads();
}
__device__ __forceinline__ int queue_next(unsigned* ctr, LAS int* slot, int k) {
    const int idx = slot[k & 1];
    if (threadIdx.x == 0) slot[(k + 1) & 1] = (int)__hip_atomic_fetch_add(ctr, 1u, __ATOMIC_RELAXED, __HIP_MEMORY_SCOPE_AGENT);
    return idx;
}
__device__ __forceinline__ Item make_item(bool meta, int b, int qb) {
    Item it;
    if (meta) { it.qrow0 = 0; it.qk0 = -(MBLK - 64); it.nt = 1; it.tokbase = MBLK; }
    else { it.qrow0 = MBLK + b * SEQ + qb * 256; it.qk0 = 64 + qb * 256; it.nt = 4 * (qb + 1) + 1; it.tokbase = MBLK + b * SEQ; }
    return it;
}
}


constexpr int PH_PER_LAYER = 19, N_PHASES = 2 * PH_PER_LAYER;
__device__ __forceinline__ unsigned char* uni_ptr(unsigned char* p) { const unsigned long long v = (unsigned long long)p; const unsigned lo = __builtin_amdgcn_readfirstlane((unsigned)v), hi = __builtin_amdgcn_readfirstlane((unsigned)(v >> 32)); return (unsigned char*)(((unsigned long long)hi << 32) | lo); }
__device__ __forceinline__ const float* arg_in(const Args& a, int k) { asm volatile("" : "+s"(k)); return a.in[k]; }
__global__ void __launch_bounds__(NWAVES * 64, 2) mega_fwd(Args args) {
    extern __shared__ __attribute__((aligned(16))) unsigned char lds_raw[];
    {
        LAS unsigned char* l0 = (LAS unsigned char*)lds_raw;
        for (int u = threadIdx.x; u < (LDS_BYTES - LDSCTL_OFF) / 4; u += NWAVES * 64) ((LAS unsigned*)(l0 + LDSCTL_OFF))[u] = 0u;
        __syncthreads();
    }
#if MK_ONE_LAUNCH
    (void)xcd_barrier_post((unsigned*)(args.ws + WS_CTL) + CW_BAR, (volatile LAS unsigned*)((LAS unsigned char*)lds_raw + LDSCTL_OFF + 64));
#define GRID_BAR() do { XcdBarrier bar_; bar_.bar = (unsigned*)(uni_ptr(args.ws) + WS_CTL) + CW_BAR; bar_.x = xb_xcc_id(); bar_.st = (volatile LAS unsigned*)((LAS unsigned char*)lds_raw + LDSCTL_OFF + 64); xcd_barrier(bar_); } while (0)
#else
#define GRID_BAR() do {} while (0)
#endif
    const int lo = args.ph_lo, hi = args.ph_hi;
#define IN(k) (lo <= (k) && (k) < hi)
#define SEAM(k) do { if (IN((k) + 1)) GRID_BAR(); } while (0)
#define PH_BEGIN \
    int tid_ = threadIdx.x; asm volatile("" : "+v"(tid_)); \
    Ctx F; F.lds = (LAS unsigned char*)lds_raw; F.tid = tid_; F.lane = tid_ & 63; F.wave = __builtin_amdgcn_readfirstlane(tid_ >> 6); \
    F.G = gridDim.x; F.bid = blockIdx.x; F.gw = F.bid * NWAVES + F.wave; F.ngw = F.G * NWAVES; \
    unsigned char* ws = uni_ptr(args.ws); asm volatile("" : "+s"(ws)); \
    int ly = __builtin_amdgcn_readfirstlane(layer); asm volatile("" : "+s"(ly)); (void)ly; (void)F
#define XN_ ((bf16_t*)(ws + WS_XN))
#define P_ ((bf16_t*)(ws + WS_P))
#define HMETA_ ((float*)(ws + WS_HMETA))
#define RSTDQ_ ((float*)(ws + WS_RSTD))
#define RSTDKV_ ((float*)(ws + WS_RSTD) + R)
#define BM_ ((unsigned*)(ws + WS_BM))
#define RS_(i) ((float*)(ws + WS_CTL + WS_RS) + (size_t)(i) * R)
#define GPERM_ ((float*)(ws + WS_RSTD + 512 * 1024))
#define WB_(off) ((bf16_t*)(ws + WS_WB + (off)))
#define OUT_ (args.out)
#define LAMBDA_INIT(ly) ((ly) == 0 ? 0.2f : (0.8f - 0.6f * 0.7408182206817179f))
#define HSRC_TOK(ly) ((ly) == 0 ? arg_in(args, 0) : (const float*)args.out)

#pragma unroll
    for (int layer = 0; layer < 2; ++layer) {
        const int pb = layer * PH_PER_LAYER;
        if (((PHMASK >> 0) & 1) && IN(pb + 0)) {
            PH_BEGIN;
            for (int rep_ = 0; rep_ < NREP(0); ++rep_) { if (rep_) GRID_BAR();
            const float* meta = arg_in(args, 1);
            conv_matrix<1>(F, arg_in(args, 3) + (size_t)ly * DM * D_IN, DM, D_IN, WB_(WB_IN), arg_in(args, 2) + ly * DM);
            conv_matrix<0>(F, arg_in(args, 7) + (size_t)ly * 512 * 1536, 512, 1536, WB_(WB_QUP), arg_in(args, 5) + ly * 512);
            conv_matrix<0>(F, arg_in(args, 8) + (size_t)ly * 512 * 2048, 512, 2048, WB_(WB_KVUP), arg_in(args, 6) + ly * 512);
            for (int b = 0; b < 3; ++b) conv_matrix<0>(F, arg_in(args, 14) + ((size_t)ly * 3 + b) * 1024 * DM, 1024, DM, WB_(WB_BR) + (size_t)b * DM * 1024, nullptr);
            conv_matrix<0>(F, arg_in(args, 15) + (size_t)ly * DM * DM, DM, DM, WB_(WB_O), nullptr);
            conv_matrix<2>(F, arg_in(args, 17) + (size_t)ly * DM * 2 * DFF, DM, 2 * DFF, WB_(WB_F1), arg_in(args, 16) + ly * DM);
            conv_matrix<0>(F, arg_in(args, 18) + (size_t)ly * DFF * DM, DFF, DM, WB_(WB_F2), nullptr);
            unsigned zu = 0u; asm volatile("" : "+v"(zu)); const float zf = __uint_as_float(zu);
            for (int i = F.gw * 64 + F.lane; i < 112 * 2048 / 8; i += F.ngw * 64) *((u32x4*)(WB_(WB_IN) + (size_t)1168 * 2048) + i) = (u32x4){zu, zu, zu, zu};
            if (F.bid == 0) { const int i = F.tid; const int t = i >> 7, ps = i & 127, dim = (ps >> 1) + 64 * (ps & 1);
                const float* gsrc = (t < 2 ? arg_in(args, 10) : arg_in(args, 11)) + ly * 256 + (t & 1) * 128; GPERM_[i] = gsrc[dim]; }
            float* hmeta = HMETA_;
            if (ly == 0) {
                for (int i = F.gw * 64 + F.lane; i < MROW0 * PW / 8; i += F.ngw * 64) *((u32x4*)P_ + i) = (u32x4){zu, zu, zu, zu};
                for (int i = F.gw * 64 + F.lane; i < MBLK * DM / 4; i += F.ngw * 64) { const int rr = i / (DM / 4); f32x4 v = (f32x4){zf, zf, zf, zf};
                    if (rr >= MBLK - NMETA) v = *((const f32x4*)meta + (i - (MBLK - NMETA) * (DM / 4))); *((f32x4*)hmeta + i) = v; }
            }
            if (ly == 0) {
                const float* xin = arg_in(args, 0); bf16_t* XN = XN_; float* rs0 = RS_(0);
                for (int r = MROW0 + F.gw; r < R; r += F.ngw)
                    norm_row(r < MBLK ? meta + (size_t)(r - MROW0) * DM : xin + (size_t)(r - MBLK) * DM, XN + (size_t)r * DM, rs0 + r, F.lane);
            }
            }
            SEAM(pb + 0);
        }
        if (((PHMASK >> 1) & 1) && IN(pb + 1)) {
            PH_BEGIN;
            { SkP f{P_, 0, RS_(2 * ly)}; skinny_gemm(F.lds, XN_ + (size_t)MROW0 * DM, DM, WB_(WB_IN), DM, 1280 / 16, F.bid, F.G, f); }
            SchedPlain S{XN_, DM, WB_(WB_IN), DM, NPMM, 5, F.G, F.bid, 0}; EpiP E{P_, RS_(2 * ly)};
            pg8::gemm_phase(F.lds, S, E);
            if (NREP(1) == 2) { GRID_BAR(); pg8::gemm_phase(F.lds, S, E); }
            SEAM(pb + 1);
        }
        if (((PHMASK >> 2) & 1) && IN(pb + 2)) {
            PH_BEGIN;
            { bf16_t* P = P_; float* rq = RSTDQ_; float* rkv = RSTDKV_;
              for (int r = MROW0 + F.gw; r < R; r += F.ngw) post1a_row(P, r, rq, rkv, F.lane); }
            VM_WAIT(); __syncthreads();
            { SkP f{P_, C_QRAW, nullptr}; skinny_gemm(F.lds, P_ + (size_t)MROW0 * PW + C_CQ, PW, WB_(WB_QUP), 512, 1536 / 16, F.bid, F.G, f); }
            { SkP f{P_, C_KVRAW, nullptr}; skinny_gemm(F.lds, P_ + (size_t)MROW0 * PW + C_CKV, PW, WB_(WB_KVUP), 512, 2048 / 16, F.bid, F.G, f); }
            SchedMlaUp S{P_, WB_(WB_QUP), WB_(WB_KVUP), F.G, F.bid}; EpiP E{P_, nullptr};
            pg8::gemm_phase(F.lds, S, E);
            if (NREP(2) == 2) { GRID_BAR(); pg8::gemm_phase(F.lds, S, E); }
            SEAM(pb + 2);
        }
        if (((PHMASK >> 3) & 1) && IN(pb + 3)) {
            PH_BEGIN;
            const float* mla_qkg = arg_in(args, 9) + ly * 2 * 192;
            bf16_t* P = P_; float* rq = RSTDQ_; float* rkv = RSTDKV_;
            LAS float* rnl = (LAS float*)(F.lds + F.wave * 64);
            for (int r = MROW0 + F.gw; r < R; r += F.ngw) post2_row(P, r, rq, rkv, mla_qkg, rnl, F.lane);
            SEAM(pb + 3);
        }
        if (((PHMASK >> 4) & 1) && IN(pb + 4)) {
            PH_BEGIN;
            bf16_t* P = P_;
            LAS int* slot = (LAS int*)(F.lds + LDSCTL_OFF + 128);
            for (int rep_ = 0; rep_ < NREP(4); ++rep_) { if (rep_) GRID_BAR();
            unsigned* ctr = (unsigned*)(ws + WS_CTL) + CW_Q + 64 * (ly * 4 + 0) + 64 * 16 * rep_;
            const bool stat = (F.G == 256); const int sx = F.bid & 7, spl = (F.bid >> 3) >> 2, sj = (F.bid >> 3) & 3;
            if (!stat) fa::queue_prime(ctr, slot);
            for (int qk_ = 0;; ++qk_) {
                int idx;
                if (stat) { if (qk_ < 4) { const int pr = sx + 8 * (spl + 8 * (qk_ >> 1)), qb = (qk_ & 1) ? sj : 7 - sj; idx = (7 - qb) * 128 + pr; } else idx = (qk_ == 4 && F.bid < 8) ? 1024 + F.bid : 1 << 30; }
                else idx = fa::queue_next(ctr, slot, qk_);
                if (idx >= 8 * 129) break;
                int h; fa::Item it;
                if (idx < 1024) { const int qb = 7 - (idx >> 7), rest = idx & 127; h = rest & 7; it = fa::make_item(false, rest >> 3, qb); } else { h = idx - 1024; it = fa::make_item(true, 0, 0); }
                bf16x8 qr[12]; fa::load_q<192>(P, it, C_QRAW + h * 192, qr);
                fa::attn_core<192, 128, false>(P, it, qr, C_KVRAW + h * 256, C_KPEH + h * 64, C_KVRAW + h * 256 + 128, C_OA + h * 128, 0, nullptr, F.lds);
            } }
            SEAM(pb + 4);
        }
        if (((PHMASK >> 5) & 1) && IN(pb + 5)) {
            PH_BEGIN;
            { SkP f{P_, 1280, RS_(2 * ly)}; skinny_gemm(F.lds, XN_ + (size_t)MROW0 * DM, DM, WB_(WB_IN) + (size_t)1280 * DM, DM, 7168 / 16, F.bid, F.G, f); }
            SchedPlain S{XN_, DM, WB_(WB_IN) + (size_t)1280 * DM, DM, NPMM, 28, F.G, F.bid, 1280}; EpiG2 E{P_, RS_(2 * ly), GPERM_, (LAS float*)(F.lds + RING_BYTES)};
            pg8::gemm_phase(F.lds, S, E);
            if (NREP(5) == 2) { GRID_BAR(); pg8::gemm_phase(F.lds, S, E); }
            SEAM(pb + 5);
        }
        if (((PHMASK >> 6) & 1) && IN(pb + 6)) {
            PH_BEGIN;
            bf16_t* P = P_; const float* gp = GPERM_;
            if (F.gw < NMETA) meta_post_row(P, MROW0 + F.gw, gp, F.lane);
            SEAM(pb + 6);
        }
        if (((PHMASK >> 7) & 1) && IN(pb + 7)) {
            PH_BEGIN;
            bf16_t* P = P_; unsigned* bm = BM_;
            unsigned* ctr = (unsigned*)(ws + WS_CTL) + CW_Q + 64 * (ly * 4 + 2);
            LAS int* slot = (LAS int*)(F.lds + LDSCTL_OFF + 128);
            for (int rep_ = 0; rep_ < NREP(7); ++rep_) { if (rep_) GRID_BAR(); unsigned* c2 = ctr + 64 * 16 * rep_;
            for (;;) { const int idx = fa::next_item(c2, slot); if (idx >= NTOK / 8) break; index_unit(P, idx, bm, F.lds); } }
            SEAM(pb + 7);
        }
        if (((PHMASK >> 8) & 1) && IN(pb + 8)) {
            PH_BEGIN;
            bf16_t* P = P_; unsigned* bm = BM_;
            LAS int* slot = (LAS int*)(F.lds + LDSCTL_OFF + 128);
            for (int rep_ = 0; rep_ < NREP(8); ++rep_) { if (rep_) GRID_BAR();
            const bool dummy = (NREP(8) == 2) && rep_ == 0;
            unsigned* ctr = (unsigned*)(ws + WS_CTL) + CW_Q + 64 * (ly * 4 + 1) + 64 * 16 * rep_;
            const bool stat = (F.G == 256); const int sx = F.bid & 7, spl = (F.bid >> 3) >> 2, sj = (F.bid >> 3) & 3;
            if (!stat) fa::queue_prime(ctr, slot);
            for (int qk_ = 0;; ++qk_) {
                int idx;
                if (stat) { if (qk_ < 8) { const int pr = sx + 8 * (spl + 8 * ((qk_ >> 1) & 1)), qb = (qk_ & 1) ? sj : 7 - sj; idx = (7 - qb) * 256 + ((qk_ >> 2) ? 128 : 0) + pr; } else idx = (qk_ == 8 && F.bid < 16) ? 2048 + F.bid : 1 << 30; }
                else idx = fa::queue_next(ctr, slot, qk_);
                if (idx >= 16 * 129) break;
                int hh; bool meta = false; fa::Item it; int b = 0, qb = 0;
                if (idx < 2048) { qb = 7 - (idx >> 8); const int rest = idx & 255; hh = (rest < 128) ? 8 + (rest & 7) : (rest & 7); b = (rest & 127) >> 3; it = fa::make_item(false, b, qb); }
                else { hh = idx - 2048; hh = hh < 8 ? 8 + hh : hh - 8; meta = true; it = fa::make_item(true, 0, 0); }
                if (hh < 8) {
                    bf16x8 qr[8]; fa::load_q<128>(P, it, C_DQ + hh * 128, qr);
                    fa::attn_core<128, 128, true>(P, it, qr, C_DK + hh * 128, 0, C_DV + hh * 128, dummy ? C_KPE : C_OB + hh * 128, 0, meta ? nullptr : bm + (size_t)(b * SEQ + qb * 256) * BMW, F.lds);
                } else {
                    const int hj = hh - 8;
                    bf16x8 qr[8]; fa::load_q<128>(P, it, C_FQ + hj * 128, qr);
                    fa::attn_core<128, 256, false>(P, it, qr, C_FK + hj * 128, 0, C_FV + (hj >> 1) * 256, dummy ? C_KPE : C_FQ + hj * 128, dummy ? C_KPE : C_IQ + hj * 128, nullptr, F.lds);
                }
            } }
            SEAM(pb + 8);
        }
        if (((PHMASK >> 9) & 1) && IN(pb + 9)) {
            PH_BEGIN;
            const float* diff_lam = arg_in(args, 12) + ly * 4 * 128; const float* diff_subg = arg_in(args, 13) + ly * 256;
            const float lambda_init = LAMBDA_INIT(ly);
            const float s1 = wave_sum(diff_lam[F.lane] * diff_lam[128 + F.lane] + diff_lam[64 + F.lane] * diff_lam[192 + F.lane]);
            const float s2 = wave_sum(diff_lam[256 + F.lane] * diff_lam[384 + F.lane] + diff_lam[320 + F.lane] * diff_lam[448 + F.lane]);
            const float lam = __expf(s1) - __expf(s2) + lambda_init;
            bf16_t* P = P_;
            for (int r = MROW0 + F.gw; r < R; r += F.ngw) post3_row(P, r, diff_subg, lam, 1.f - lambda_init, F.lane);
        }
#define GATE_PHASE(k, b) \
        if (((PHMASK >> 10) & 1) && IN(pb + (k))) { \
            PH_BEGIN; \
            { SkGate f{(bf16_t*)(ws + WS_GS), arg_in(args, 4) + ly * 3 * DM + (b) * DM, RS_(2 * ly)}; skinny_gemm(F.lds, XN_ + (size_t)MROW0 * DM, DM, WB_(WB_G) + (size_t)(b) * 2048 * DM, DM, 2048 / 16, F.bid, F.G, f); } \
            SchedPlain S{XN_, DM, WB_(WB_G) + (size_t)(b) * 2048 * DM, DM, NPMM, 8, F.G, F.bid, 0}; EpiGate E{(bf16_t*)(ws + WS_GS), arg_in(args, 4) + ly * 3 * DM + (b) * DM, RS_(2 * ly)}; \
            pg8::gemm_phase(F.lds, S, E); \
            if (NREP(k) == 2) { GRID_BAR(); pg8::gemm_phase(F.lds, S, E); } \
            SEAM(pb + (k)); \
        }
#define BRANCH_PHASE(k, b, oc) \
        if (((PHMASK >> 10) & 1) && IN(pb + (k))) { \
            PH_BEGIN; \
            { SkGated f{P_, (const bf16_t*)(ws + WS_GS), (b) == 0 ? 1 : 0}; skinny_gemm(F.lds, P_ + (size_t)MROW0 * PW + (oc), PW, WB_(WB_BR) + (size_t)(b) * DM * 1024, 1024, 2048 / 16, F.bid, F.G, f); } \
            SchedPlain S{P_ + (oc), PW, WB_(WB_BR) + (size_t)(b) * DM * 1024, 1024, NPMM, 8, F.G, F.bid, C_MERGED}; EpiGated E{P_, (const bf16_t*)(ws + WS_GS), (b) == 0 ? 1 : 0, ((DBG_BM >> (b)) & 1) ? 1.f : 0.f}; \
            pg8::gemm_phase(F.lds, S, E); \
            if (NREP(k) == 2 && (b) == 0) { GRID_BAR(); pg8::gemm_phase(F.lds, S, E); } \
            SEAM(pb + (k)); \
        }
        GATE_PHASE(10, 0) BRANCH_PHASE(11, 0, C_OA)
        GATE_PHASE(12, 1) BRANCH_PHASE(13, 1, C_OB)
        GATE_PHASE(14, 2) BRANCH_PHASE(15, 2, C_OC)
        if (((PHMASK >> 11) & 1) && IN(pb + 16)) {
            PH_BEGIN;
            { SkRes f{HMETA_, XN_, RS_(2 * ly + 1)}; skinny_gemm(F.lds, P_ + (size_t)MROW0 * PW + C_MERGED, PW, WB_(WB_O), DM, 2048 / 16, F.bid, F.G, f); }
            SchedPlain S{P_ + C_MERGED, PW, WB_(WB_O), DM, NPMM, 8, F.G, F.bid, 0}; EpiRes E{HSRC_TOK(ly), OUT_, HMETA_, DBG_SA, XN_, RS_(2 * ly + 1)};
            pg8::gemm_phase(F.lds, S, E);
            SEAM(pb + 16);
        }
        if (((PHMASK >> 13) & 1) && IN(pb + 17)) {
            PH_BEGIN;
            skinny_swiglu(F.lds, XN_ + (size_t)MROW0 * DM, DM, WB_(WB_F1), DM, P_, RS_(2 * ly + 1), F.bid, F.G);
            SchedPlain S{XN_, DM, WB_(WB_F1), DM, NPMM, 44, F.G, F.bid, 0}; EpiSwiglu E{P_, RS_(2 * ly + 1)};
            pg8::gemm_phase(F.lds, S, E);
            if (NREP(17) == 2) { GRID_BAR(); pg8::gemm_phase(F.lds, S, E); }
            SEAM(pb + 17);
        }
        if (((PHMASK >> 14) & 1) && IN(pb + 18)) {
            PH_BEGIN;
            { SkRes f{HMETA_, ly == 0 ? XN_ : (bf16_t*)nullptr, RS_(2)}; skinny_gemm(F.lds, P_ + (size_t)MROW0 * PW, PW, WB_(WB_F2), DFF, 2048 / 16, F.bid, F.G, f); }
            SchedPlain S{P_, PW, WB_(WB_F2), DFF, NPMM, 8, F.G, F.bid, 0}; EpiRes E{OUT_, OUT_, HMETA_, DBG_SF, ly == 0 ? XN_ : (bf16_t*)nullptr, RS_(2)};
            pg8::gemm_phase(F.lds, S, E);
            SEAM(pb + 18);
        }
    }
#undef IN
#undef SEAM
}

__global__ void diag_fill(float* out, int n, float v) { for (int i = blockIdx.x * blockDim.x + threadIdx.x; i < n; i += gridDim.x * blockDim.x) out[i] = v; }
extern "C" void kernel_launch(void* const* d_in, const int* in_sizes, int n_in, void* d_out, int out_size, void* d_ws, size_t ws_size, hipStream_t stream) {
    static int grid = 0; static float code = 0.f;
    if (grid == 0) {
        int dev = 0, cus = 0;
        if (n_in != 19) { code = 10.f; grid = -1; }
        else if (ws_size < WS_END) { code = 20.f + (float)(ws_size >> 20) * 0.01f; grid = -1; }
        else if (hipGetDevice(&dev) != hipSuccess || hipDeviceGetAttribute(&cus, hipDeviceAttributeMultiprocessorCount, dev) != hipSuccess) { code = 40.f; grid = -1; }
        else if (hipFuncSetAttribute((const void*)mega_fwd, hipFuncAttributeMaxDynamicSharedMemorySize, LDS_BYTES) != hipSuccess) { code = 50.f; grid = -1; }
        else {
            int per_cu = 0;
            if (hipOccupancyMaxActiveBlocksPerMultiprocessor(&per_cu, (const void*)mega_fwd, NWAVES * 64, LDS_BYTES) != hipSuccess || per_cu < 1) { code = 60.f; grid = -1; }
            (void)hipGetLastError();
            if (grid == 0) grid = cus;
        }
    }
    if (grid < 0) { hipLaunchKernelGGL(diag_fill, dim3(1024), dim3(256), 0, stream, (float*)d_out, out_size, code); return; }
    (void)hipMemsetAsync((char*)d_ws + WS_CTL, 0, CTL_BYTES, stream);
    Args a{};
    for (int i = 0; i < 19; ++i) a.in[i] = (const float*)d_in[i];
    a.out = (float*)d_out; a.ws = (unsigned char*)d_ws;
#if MK_ONE_LAUNCH
    a.ph_lo = 0; a.ph_hi = N_PHASES;
    hipLaunchKernelGGL(mega_fwd, dim3(grid), dim3(NWAVES * 64), LDS_BYTES, stream, a);
#else
    for (int p = 0; p < N_PHASES; ++p) { a.ph_lo = p; a.ph_hi = p + 1; hipLaunchKernelGGL(mega_fwd, dim3(grid), dim3(NWAVES * 64), LDS_BYTES, stream, a); }
#endif
    if (hipPeekAtLastError() != hipSuccess) { (void)hipGetLastError(); hipLaunchKernelGGL(diag_fill, dim3(1024), dim3(256), 0, stream, (float*)d_out, out_size, 70.f); }
}
```

```cpp
#include <hip/hip_runtime.h>
#include <cstdio>
#include <cstdint>

#ifndef PHMASK
#define PHMASK 0x7fff
#endif
#ifndef REPMASK
#define REPMASK 0
#endif
#define NREP(k) ((((REPMASK) >> (k)) & 1) ? 2 : 1)
#ifndef DBG_BM
#define DBG_BM 7
#endif
#ifndef DBG_BR
#define DBG_BR 0
#endif
#ifndef DBG_SA
#define DBG_SA 1.0f
#endif
#ifndef DBG_SF
#define DBG_SF 1.0f
#endif
#ifndef MK_ONE_LAUNCH
#define MK_ONE_LAUNCH 1
#endif

#define LAS __attribute__((address_space(3)))
#define GAS __attribute__((address_space(1)))
typedef unsigned short bf16_t;
typedef short bf16x8 __attribute__((ext_vector_type(8)));
typedef float f32x4 __attribute__((ext_vector_type(4)));
typedef float f32x2 __attribute__((ext_vector_type(2)));
typedef unsigned u32x4 __attribute__((ext_vector_type(4)));
typedef unsigned u32x2 __attribute__((ext_vector_type(2)));

constexpr int DM = 2048, NB = 16, SEQ = 2048, NMETA = 16, MBLK = 256;
constexpr int R = MBLK + NB * SEQ;
constexpr int NPM = R / 256;
constexpr int NPMM = NPM - 1;
constexpr int MROW0 = MBLK - NMETA;
constexpr int NTOK = NB * SEQ;
constexpr int DFF = 5632;
constexpr int PW = 8448;
constexpr int C_CQ = 0, C_CKV = 512, C_KPE = 1024, C_IK = 1088, C_IW = 1152, C_DQ = 1280, C_DK = 2304, C_DV = 3328, C_IQ = 4352,
              C_FQ = 5376, C_FK = 6400, C_FV = 7424;
constexpr int C_KVRAW = 1280, C_QRAW = 3328, C_KPEH = 4864;
constexpr int C_OA = 0, C_OB = C_DQ, C_OC = C_FQ, C_MERGED = 2304;
constexpr int BMW = 66;
constexpr float EPS = 1e-6f;
constexpr float LOG2E = 1.4426950408889634f;
constexpr float C2_128 = 0.08838834764831845f * LOG2E;
constexpr float C2_192 = 0.07216878364870323f * LOG2E;
constexpr int D_IN = 14480;

constexpr size_t MiB = 1u << 20;
constexpr size_t WS_CTL = 0, CTL_BYTES = 1 * MiB;
constexpr size_t WS_RSTD = 1 * MiB;
constexpr size_t WS_HMETA = 2 * MiB;
constexpr size_t WS_BM = 4 * MiB;
constexpr size_t WS_WB = 16 * MiB;
constexpr size_t WB_IN = 0, WB_G = WB_IN + (size_t)8448 * 2048 * 2, WB_QUP = WB_G + (size_t)6144 * 2048 * 2, WB_KVUP = WB_QUP + (size_t)1536 * 512 * 2,
                 WB_BR = WB_KVUP + (size_t)2048 * 512 * 2, WB_O = WB_BR + (size_t)3 * 2048 * 1024 * 2, WB_F1 = WB_O + (size_t)2048 * 2048 * 2,
                 WB_F2 = WB_F1 + (size_t)11264 * 2048 * 2, WB_END = WB_F2 + (size_t)2048 * 5632 * 2;
constexpr size_t WS_XN = 164 * MiB;
constexpr size_t WS_P = 294 * MiB;
constexpr size_t WS_GS = 828 * MiB;
constexpr size_t WS_END = 960 * MiB;
static_assert(WS_GS + (size_t)R * 2048 * 2 <= WS_END && WS_WB + WB_END <= WS_XN && WS_XN + (size_t)R * 2048 * 2 <= WS_P && WS_P + (size_t)R * PW * 2 <= WS_GS, "ws map");
constexpr int CW_BAR = 4096, CW_Q = 16384;
constexpr size_t WS_RS = 256 * 1024;

__device__ __forceinline__ float bf2f(bf16_t v) { return __uint_as_float((unsigned)v << 16); }
__device__ __forceinline__ unsigned f2bf(float f) { unsigned u = __float_as_uint(f); return (u + 0x7fffu + ((u >> 16) & 1u)) >> 16; }
__device__ __forceinline__ unsigned pk2(float lo, float hi) { return f2bf(lo) | (f2bf(hi) << 16); }
typedef __bf16 bf16x2_t __attribute__((ext_vector_type(2)));
__device__ __forceinline__ unsigned cvt_pk_bf16(float lo, float hi) { f32x2 v = {lo, hi}; bf16x2_t b = __builtin_convertvector(v, bf16x2_t); return __builtin_bit_cast(unsigned, b); }
__device__ __forceinline__ float wave_sum(float v) {
#pragma unroll
    for (int o = 1; o < 64; o <<= 1) v += __shfl_xor(v, o);
    return v;
}
__device__ __forceinline__ float wave_max(float v) {
#pragma unroll
    for (int o = 1; o < 64; o <<= 1) v = fmaxf(v, __shfl_xor(v, o));
    return v;
}
#define LDS_WAIT() asm volatile("s_waitcnt lgkmcnt(0)" ::: "memory")
#define VM_WAIT() asm volatile("s_waitcnt vmcnt(0)" ::: "memory")
__device__ __forceinline__ int row_pos(int r) { return r < MBLK ? (r >= MBLK - NMETA ? r - (MBLK - NMETA) : 0) : NMETA + ((r - MBLK) & (SEQ - 1)); }
__device__ __forceinline__ void rope_cs(int pos, int i, float two_over_d, float& c, float& s) {
    const float inv = __builtin_amdgcn_exp2f(-(float)i * two_over_d * 13.287712379549449f);
    float rev = (float)pos * inv * 0.15915494309189535f;
    rev -= floorf(rev);
    s = __builtin_amdgcn_sinf(rev); c = __builtin_amdgcn_cosf(rev);
}

namespace pg8 {
constexpr int BM = 256, BK = 64, HALF = 128, HTB = HALF * BK * 2, STAGE_BYTES = 8 * HTB;
__device__ __forceinline__ int lds_byte(int r, int c) { const int st = (r >> 4) * 2 + (c >> 5), rr = r & 15, cc = c & 31, ob = rr * 64 + cc * 2; return st * 1024 + (ob ^ (((ob >> 9) & 1) << 5)); }
__device__ __forceinline__ void stage_rc(int b, int& R_, int& C_) { const int st = b / 1024, sb = b % 1024, swz = sb ^ (((sb >> 9) & 1) << 5); R_ = (st >> 1) * 16 + swz / 64; C_ = (st & 1) * 32 + (swz % 64) / 2; }
__device__ __forceinline__ int perm32(int rho) { const int n = rho >> 4, i = rho & 15; return 8 * (i >> 2) + 4 * n + (i & 3); }

struct Unit { const char* A; const char* B; unsigned lda2, ldb2; int nt, pm, pn, kind, ocol; };

#ifndef WGM
#define WGM 4
#endif
__device__ __forceinline__ void tile_of(int L, int nM, int nN, int& pm, int& pn) {
    const int nwg = nM * nN; int wgid = L;
    { const int q = nwg / 8, r = nwg % 8, xcd = wgid % 8, off = wgid / 8; wgid = (xcd < r ? xcd * (q + 1) : r * (q + 1) + (xcd - r) * q) + off; }
    const int nig = WGM * nN, gid = wgid / nig, fm = gid * WGM, gsz = (nM - fm) < WGM ? (nM - fm) : WGM;
    pm = fm + ((wgid % nig) % gsz); pn = (wgid % nig) / gsz;
}

template <class Epi, class Sched>
__device__ __forceinline__ void gemm_phase(LAS unsigned char* lds, const Sched& S, const Epi& E) {
    int tid = threadIdx.x; asm volatile("" : "+v"(tid));
    const int wid = __builtin_amdgcn_readfirstlane(tid >> 6), lane = tid & 63, wr = wid >> 2, wc = wid & 3, fr = lane & 15, fq = lane >> 4;
    unsigned rA[2], rB[2], cc[2];
#pragma unroll
    for (int i = 0; i < 2; ++i) { int R_, C_; stage_rc(tid * 16 + i * 8192, R_, C_); rA[i] = (unsigned)R_; rB[i] = (unsigned)(Epi::PERM ? ((R_ & ~31) + perm32(R_ & 31)) : R_); cc[i] = (unsigned)C_ * 2u; }
    const size_t kstep = (size_t)(BK * 2);
    const unsigned ldsw = (unsigned)wid * 1024u;
    const int aoff = lds_byte(wr * 64 + fr, fq * 8), boff = lds_byte(wc * 32 + fr, fq * 8);
#define PG8_SA(b, h) (((b) * 2 + (h)) * HTB)
#define PG8_SB(b, h) ((4 + (b) * 2 + (h)) * HTB)
#define PG8_STAGE(bufoff, gbase, rr, ld2) do { _Pragma("unroll") for (int _i = 0; _i < 2; ++_i) \
        __builtin_amdgcn_global_load_lds((const unsigned*)((const char*)(gbase) + ((rr)[_i] * (ld2) + cc[_i])), (LAS unsigned*)(lds + (bufoff) + ldsw + _i * 8192), 16, 0, 0); } while (0)
#define PG8_LDA(dst, b, h) do { _Pragma("unroll") for (int m = 0; m < 4; ++m) _Pragma("unroll") for (int k = 0; k < 2; ++k) dst[m][k] = *(const LAS bf16x8*)(lds + PG8_SA(b, h) + aoff + m * 2048 + k * 1024); } while (0)
#define PG8_LDB(dst, b, h) do { _Pragma("unroll") for (int n = 0; n < 2; ++n) _Pragma("unroll") for (int k = 0; k < 2; ++k) dst[n][k] = *(const LAS bf16x8*)(lds + PG8_SB(b, h) + boff + n * 2048 + k * 1024); } while (0)
#define PG8_MMA(ai, bj, At, Bt) do { __builtin_amdgcn_s_setprio(1); _Pragma("unroll") for (int m = 0; m < 4; ++m) _Pragma("unroll") for (int n = 0; n < 2; ++n) _Pragma("unroll") for (int k = 0; k < 2; ++k) \
        acc[ai][bj][m][n] = __builtin_amdgcn_mfma_f32_16x16x32_bf16(Bt[n][k], At[m][k], acc[ai][bj][m][n], 0, 0, 0); __builtin_amdgcn_s_setprio(0); } while (0)
#define PG8_WAIT_V(n) asm volatile("s_waitcnt vmcnt(" #n ")" ::: "memory")
#define PG8_WAIT_L(n) asm volatile("s_waitcnt lgkmcnt(" #n ")" ::: "memory")
#define PG8_BAR __builtin_amdgcn_s_barrier()
#define PG8_SCHED __builtin_amdgcn_sched_barrier(0)
    Unit cur, nxt; int ui = 0;
    if (!S.next(0, cur)) return;
    float zf = 0.f; asm volatile("" : "+v"(zf));
    f32x4 acc[2][2][4][2];
#pragma unroll
    for (int a = 0; a < 2; ++a)
#pragma unroll
        for (int b = 0; b < 2; ++b)
#pragma unroll
            for (int m = 0; m < 4; ++m)
#pragma unroll
                for (int n = 0; n < 2; ++n) acc[a][b][m][n] = (f32x4){zf, zf, zf, zf};
    bf16x8 At[4][2], B0[2][2], B1[2][2];
    const char* cA = cur.A; const char* cB = cur.B;
    unsigned lA = cur.lda2, lB = cur.ldb2;
    size_t hA = (size_t)HALF * lA, hB = (size_t)HALF * lB;
    PG8_STAGE(PG8_SB(0, 0), cB, rB, lB); PG8_STAGE(PG8_SB(0, 1), cB + hB, rB, lB); PG8_STAGE(PG8_SA(0, 0), cA, rA, lA); PG8_STAGE(PG8_SA(0, 1), cA + hA, rA, lA);
    if (wr == 1) PG8_BAR;
    PG8_WAIT_V(2); PG8_BAR;
    PG8_STAGE(PG8_SB(1, 0), cB + kstep, rB, lB); PG8_STAGE(PG8_SA(1, 0), cA + kstep, rA, lA); PG8_STAGE(PG8_SB(1, 1), cB + hB + kstep, rB, lB);
    PG8_WAIT_V(6); PG8_BAR;
    for (;;) {
        const bool has_next = S.next(ui + 1, nxt);
        if (!has_next) nxt = cur;
        const char* nA = nxt.A; const char* nB = nxt.B;
        const unsigned lAn = nxt.lda2, lBn = nxt.ldb2;
        const size_t hAn = (size_t)HALF * lAn, hBn = (size_t)HALF * lBn;
        const int nt = cur.nt;
        for (int t = 0; t < nt; t += 2) {
            const bool last = (t == nt - 2);
            const char* a1 = cA + (size_t)(t + 1) * kstep;
            const char* a2 = last ? nA : cA + (size_t)(t + 2) * kstep; const char* b2 = last ? nB : cB + (size_t)(t + 2) * kstep;
            const char* a3 = a2 + kstep; const char* b3 = b2 + kstep;
            const size_t hA2 = last ? hAn : hA, hB2 = last ? hBn : hB;
            const unsigned lA2 = last ? lAn : lA, lB2 = last ? lBn : lB;
            PG8_LDB(B0, 0, 0); PG8_LDB(B1, 0, 1); PG8_SCHED; PG8_LDA(At, 0, 0); PG8_STAGE(PG8_SA(1, 1), a1 + hA, rA, lA);
            PG8_WAIT_V(8); PG8_WAIT_L(0); PG8_BAR; PG8_MMA(0, 0, At, B0); PG8_MMA(0, 1, At, B1); PG8_BAR; PG8_SCHED;
            PG8_LDA(At, 0, 1); PG8_STAGE(PG8_SB(0, 0), b2, rB, lB2); PG8_STAGE(PG8_SB(0, 1), b2 + hB2, rB, lB2); PG8_STAGE(PG8_SA(0, 0), a2, rA, lA2);
            PG8_WAIT_V(8); PG8_WAIT_L(0); PG8_BAR; PG8_MMA(1, 0, At, B0); PG8_MMA(1, 1, At, B1); PG8_BAR; PG8_SCHED;
            PG8_LDB(B0, 1, 0); PG8_LDB(B1, 1, 1); PG8_SCHED; PG8_LDA(At, 1, 0); PG8_STAGE(PG8_SA(0, 1), a2 + hA2, rA, lA2);
            PG8_WAIT_V(8); PG8_WAIT_L(0); PG8_BAR; PG8_MMA(0, 0, At, B0); PG8_MMA(0, 1, At, B1); PG8_BAR; PG8_SCHED;
            PG8_LDA(At, 1, 1); PG8_STAGE(PG8_SB(1, 0), b3, rB, lB2); PG8_STAGE(PG8_SB(1, 1), b3 + hB2, rB, lB2); PG8_STAGE(PG8_SA(1, 0), a3, rA, lA2);
            PG8_WAIT_V(8); PG8_WAIT_L(0); PG8_BAR; PG8_MMA(1, 0, At, B0); PG8_MMA(1, 1, At, B1); PG8_BAR; PG8_SCHED;
        }
        if (wr == 0) PG8_BAR;
        E(acc, cur, wr, wc, fr, fq);
#pragma unroll
        for (int a = 0; a < 2; ++a)
#pragma unroll
            for (int b = 0; b < 2; ++b)
#pragma unroll
                for (int m = 0; m < 4; ++m)
#pragma unroll
                    for (int n = 0; n < 2; ++n) acc[a][b][m][n] = (f32x4){zf, zf, zf, zf};
        if (!has_next) break;
        cur = nxt; cA = nA; cB = nB; hA = hAn; hB = hBn; lA = lAn; lB = lBn; ++ui;
        if (wr == 1) PG8_BAR;
    }
    PG8_WAIT_V(0);
    PG8_BAR;
#undef PG8_SA
#undef PG8_SB
#undef PG8_STAGE
#undef PG8_LDA
#undef PG8_LDB
#undef PG8_MMA
#undef PG8_WAIT_V
#undef PG8_WAIT_L
#undef PG8_BAR
#undef PG8_SCHED
}
}
using pg8::Unit;

struct SchedPlain {
    const bf16_t* A; int lda; const bf16_t* B; int K; int nM, nN, G, c, ocol0;
    __device__ __forceinline__ bool next(int i, Unit& u) const {
        const int L = i * G + c; if (L >= nM * nN) return false;
        int pm, pn; pg8::tile_of(L, nM, nN, pm, pn); pm += 1;
        u.pm = pm; u.pn = pn; u.kind = 0; u.ocol = ocol0 + 256 * pn; u.nt = K / 64; u.lda2 = (unsigned)lda * 2u; u.ldb2 = (unsigned)K * 2u;
        u.A = (const char*)(A + (size_t)pm * 256 * lda); u.B = (const char*)(B + (size_t)pn * 256 * K); return true;
    }
};
struct SchedMlaUp {
    const bf16_t* P; const bf16_t* Wq; const bf16_t* Wkv; int G, c;
    __device__ __forceinline__ bool next(int i, Unit& u) const {
        const int L = i * G + c; if (L >= NPMM * 14) return false;
        int pm, pn; pg8::tile_of(L, NPMM, 14, pm, pn); pm += 1;
        u.pm = pm; u.pn = pn; u.kind = 0; u.nt = 8; u.lda2 = PW * 2u; u.ldb2 = 512 * 2u;
        if (pn < 6) { u.A = (const char*)(P + (size_t)pm * 256 * PW + C_CQ); u.B = (const char*)(Wq + (size_t)pn * 256 * 512); u.ocol = C_QRAW + 256 * pn; }
        else { u.A = (const char*)(P + (size_t)pm * 256 * PW + C_CKV); u.B = (const char*)(Wkv + (size_t)(pn - 6) * 256 * 512); u.ocol = C_KVRAW + 256 * (pn - 6); }
        return true;
    }
};
struct EpiP {
    static constexpr bool PERM = true;
    bf16_t* P; const float* rs;
    __device__ __forceinline__ void operator()(const f32x4 (&acc)[2][2][4][2], const Unit& u, int wr, int wc, int fr, int fq) const {
        asm volatile("" : "+v"(fr), "+v"(fq));
        const int row0 = u.pm * 256 + wr * 64 + fr, col0 = u.ocol + wc * 32 + 8 * fq;
#pragma unroll
        for (int ai = 0; ai < 2; ++ai)
#pragma unroll
            for (int m = 0; m < 4; ++m) { bf16_t* rowp = P + (size_t)(row0 + ai * 128 + m * 16) * PW + col0;
                const float sc = rs ? __builtin_amdgcn_rsqf(rs[row0 + ai * 128 + m * 16] * (1.f / DM) + EPS) : 1.f;
#pragma unroll
                for (int bj = 0; bj < 2; ++bj) { const f32x4 v0 = acc[ai][bj][m][0] * sc, v1 = acc[ai][bj][m][1] * sc;
                    u32x4 w; w.x = cvt_pk_bf16(v0[0], v0[1]); w.y = cvt_pk_bf16(v0[2], v0[3]); w.z = cvt_pk_bf16(v1[0], v1[1]); w.w = cvt_pk_bf16(v1[2], v1[3]);
                    *(u32x4*)(rowp + bj * 128) = w; } }
    }
};
struct EpiG2 {
    static constexpr bool PERM = true;
    bf16_t* P; const float* rs; const float* gperm; LAS float* xl;
    __device__ __forceinline__ void operator()(const f32x4 (&acc)[2][2][4][2], const Unit& u, int wr, int wc, int fr, int fq) const {
        asm volatile("" : "+v"(fr), "+v"(fq));
        const int row0 = u.pm * 256 + wr * 64 + fr, lcol = wc * 32 + 8 * fq, col0 = u.ocol + lcol;
        const int pn = u.pn;
        const bool plain = (pn >= 8 && pn < 12) || pn >= 24, isidx = (pn >= 12 && pn < 16), nrm = !plain && !isidx;
        float rsc[2][4];
#pragma unroll
        for (int ai = 0; ai < 2; ++ai)
#pragma unroll
            for (int m = 0; m < 4; ++m) rsc[ai][m] = __builtin_amdgcn_rsqf(rs[row0 + ai * 128 + m * 16] * (1.f / DM) + EPS);
        if (nrm) {
#pragma unroll
            for (int ai = 0; ai < 2; ++ai)
#pragma unroll
                for (int m = 0; m < 4; ++m)
#pragma unroll
                    for (int bj = 0; bj < 2; ++bj) { const f32x4 a = acc[ai][bj][m][0], b = acc[ai][bj][m][1]; float ss = (a[0] * a[0] + a[1] * a[1]) + (a[2] * a[2] + a[3] * a[3]) + (b[0] * b[0] + b[1] * b[1]) + (b[2] * b[2] + b[3] * b[3]);
                        ss += __shfl_xor(ss, 16); ss += __shfl_xor(ss, 32);
                        if (fq == 0) xl[((wr * 64 + fr + ai * 128 + m * 16) * 2 + bj) * 4 + wc] = ss * rsc[ai][m] * rsc[ai][m]; }
            asm volatile("s_waitcnt lgkmcnt(0)" ::: "memory"); __builtin_amdgcn_s_barrier(); asm volatile("" ::: "memory");
        }
        const int i0 = isidx ? (16 * (wc & 1) + 4 * fq) : (16 * wc + 4 * fq);
        const float tod = isidx ? (2.f / 64.f) : (2.f / 128.f);
        float inv[4];
#pragma unroll
        for (int j = 0; j < 4; ++j) inv[j] = __builtin_amdgcn_exp2f(-(float)(i0 + j) * tod * 13.287712379549449f) * 0.15915494309189535f;
        const int gidx = pn < 4 ? 0 : (pn < 8 ? 1 : (pn < 20 ? 2 : 3));
        const float qscale = (pn < 4 || (pn >= 16 && pn < 20)) ? C2_128 : 1.f;
        f32x4 g0 = (f32x4){1.f, 1.f, 1.f, 1.f}, g1 = g0;
        if (nrm) { g0 = *(const f32x4*)(gperm + gidx * 128 + lcol); g1 = *(const f32x4*)(gperm + gidx * 128 + lcol + 4); }
#pragma unroll
        for (int ai = 0; ai < 2; ++ai)
#pragma unroll
            for (int m = 0; m < 4; ++m) { const int row = row0 + ai * 128 + m * 16; bf16_t* rowp = P + (size_t)row * PW + col0;
                float cs[4], sn[4];
                if (!plain) { const float pos = (float)(NMETA + ((row - MBLK) & (SEQ - 1)));
#pragma unroll
                    for (int j = 0; j < 4; ++j) { float rev = pos * inv[j]; rev -= floorf(rev); sn[j] = __builtin_amdgcn_sinf(rev); cs[j] = __builtin_amdgcn_cosf(rev); } }
#pragma unroll
                for (int bj = 0; bj < 2; ++bj) { f32x4 v0 = acc[ai][bj][m][0] * rsc[ai][m], v1 = acc[ai][bj][m][1] * rsc[ai][m];
                    if (!plain) {
                        if (nrm) { const LAS f32x4* xp = (const LAS f32x4*)(xl + ((wr * 64 + fr + ai * 128 + m * 16) * 2 + bj) * 4); const f32x4 pp = *xp;
                            const float rn = __builtin_amdgcn_rsqf(((pp[0] + pp[1]) + (pp[2] + pp[3])) * (1.f / 128.f) + EPS); v0 = v0 * (g0 * rn); v1 = v1 * (g1 * rn); }
                        f32x4 w0, w1;
                        w0[0] = v0[0] * cs[0] - v0[1] * sn[0]; w0[1] = v0[1] * cs[0] + v0[0] * sn[0]; w0[2] = v0[2] * cs[1] - v0[3] * sn[1]; w0[3] = v0[3] * cs[1] + v0[2] * sn[1];
                        w1[0] = v1[0] * cs[2] - v1[1] * sn[2]; w1[1] = v1[1] * cs[2] + v1[0] * sn[2]; w1[2] = v1[2] * cs[3] - v1[3] * sn[3]; w1[3] = v1[3] * cs[3] + v1[2] * sn[3];
                        v0 = w0 * qscale; v1 = w1 * qscale; }
                    u32x4 w; w.x = cvt_pk_bf16(v0[0], v0[1]); w.y = cvt_pk_bf16(v0[2], v0[3]); w.z = cvt_pk_bf16(v1[0], v1[1]); w.w = cvt_pk_bf16(v1[2], v1[3]);
                    *(u32x4*)(rowp + bj * 128) = w; } }
    }
};
struct EpiGate {
    static constexpr bool PERM = true;
    bf16_t* G; const float* bias; const float* rs;
    __device__ __forceinline__ void operator()(const f32x4 (&acc)[2][2][4][2], const Unit& u, int wr, int wc, int fr, int fq) const {
        asm volatile("" : "+v"(fr), "+v"(fq));
        const int row0 = u.pm * 256 + wr * 64 + fr, col0 = u.pn * 256 + wc * 32 + 8 * fq;
        float rsc[2][4];
#pragma unroll
        for (int ai = 0; ai < 2; ++ai)
#pragma unroll
            for (int m = 0; m < 4; ++m) rsc[ai][m] = __builtin_amdgcn_rsqf(rs[row0 + ai * 128 + m * 16] * (1.f / DM) + EPS);
#pragma unroll
        for (int bj = 0; bj < 2; ++bj) { const f32x4 bv0 = *(const f32x4*)(bias + col0 + bj * 128), bv1 = *(const f32x4*)(bias + col0 + bj * 128 + 4);
#pragma unroll
            for (int ai = 0; ai < 2; ++ai)
#pragma unroll
                for (int m = 0; m < 4; ++m) { bf16_t* rowp = G + (size_t)(row0 + ai * 128 + m * 16) * 2048 + col0; f32x4 v0 = acc[ai][bj][m][0] * rsc[ai][m] + bv0, v1 = acc[ai][bj][m][1] * rsc[ai][m] + bv1;
#pragma unroll
                    for (int e = 0; e < 4; ++e) { v0[e] = __builtin_amdgcn_rcpf(1.f + __builtin_amdgcn_exp2f(-v0[e] * LOG2E)); v1[e] = __builtin_amdgcn_rcpf(1.f + __builtin_amdgcn_exp2f(-v1[e] * LOG2E)); }
                    u32x4 w; w.x = cvt_pk_bf16(v0[0], v0[1]); w.y = cvt_pk_bf16(v0[2], v0[3]); w.z = cvt_pk_bf16(v1[0], v1[1]); w.w = cvt_pk_bf16(v1[2], v1[3]);
                    *(u32x4*)(rowp + bj * 128) = w; } }
    }
};
struct EpiGated {
    static constexpr bool PERM = true;
    bf16_t* P; const bf16_t* G; int first; float sc;
    __device__ __forceinline__ void operator()(const f32x4 (&acc)[2][2][4][2], const Unit& u, int wr, int wc, int fr, int fq) const {
        asm volatile("" : "+v"(fr), "+v"(fq));
        const int row0 = u.pm * 256 + wr * 64 + fr, lcol0 = u.pn * 256 + wc * 32 + 8 * fq, col0 = u.ocol + wc * 32 + 8 * fq;
        unsigned zu = 0u; asm volatile("" : "+v"(zu));
#pragma unroll
        for (int ai = 0; ai < 2; ++ai)
#pragma unroll
            for (int m = 0; m < 4; ++m) { bf16_t* rowp = P + (size_t)(row0 + ai * 128 + m * 16) * PW + col0; const bf16_t* gp = G + (size_t)(row0 + ai * 128 + m * 16) * 2048 + lcol0;
#pragma unroll
                for (int bj = 0; bj < 2; ++bj) { u32x4 g = *(const u32x4*)(gp + bj * 128); if (DBG_BR == 1) g = (u32x4){0x3f803f80u, 0x3f803f80u, 0x3f803f80u, 0x3f803f80u};
                    u32x4 pv = (u32x4){zu, zu, zu, zu}; if (!first) pv = *(const u32x4*)(rowp + bj * 128);
                    const f32x4 v0 = acc[ai][bj][m][0] * sc, v1 = acc[ai][bj][m][1] * sc;
                    float o[8];
                    o[0] = __uint_as_float(pv.x << 16) + __uint_as_float(g.x << 16) * v0[0]; o[1] = __uint_as_float(pv.x & 0xffff0000u) + __uint_as_float(g.x & 0xffff0000u) * v0[1];
                    o[2] = __uint_as_float(pv.y << 16) + __uint_as_float(g.y << 16) * v0[2]; o[3] = __uint_as_float(pv.y & 0xffff0000u) + __uint_as_float(g.y & 0xffff0000u) * v0[3];
                    o[4] = __uint_as_float(pv.z << 16) + __uint_as_float(g.z << 16) * v1[0]; o[5] = __uint_as_float(pv.z & 0xffff0000u) + __uint_as_float(g.z & 0xffff0000u) * v1[1];
                    o[6] = __uint_as_float(pv.w << 16) + __uint_as_float(g.w << 16) * v1[2]; o[7] = __uint_as_float(pv.w & 0xffff0000u) + __uint_as_float(g.w & 0xffff0000u) * v1[3];
                    u32x4 w; w.x = cvt_pk_bf16(o[0], o[1]); w.y = cvt_pk_bf16(o[2], o[3]); w.z = cvt_pk_bf16(o[4], o[5]); w.w = cvt_pk_bf16(o[6], o[7]);
                    *(u32x4*)(rowp + bj * 128) = w; }
                asm volatile("" ::: "memory"); }
    }
};
struct EpiRes {
    static constexpr bool PERM = false;
    const float* base_tok; float* out_tok; float* hmeta; float dbg; bf16_t* hb; float* rs;
    __device__ __forceinline__ void operator()(const f32x4 (&acc)[2][2][4][2], const Unit& u, int wr, int wc, int fr, int fq) const {
        asm volatile("" : "+v"(fr), "+v"(fq));
        const float* bp; float* op;
        if (u.pm == 0) { bp = hmeta; op = hmeta; } else { bp = base_tok + (size_t)(u.pm - 1) * 256 * DM; op = out_tok + (size_t)(u.pm - 1) * 256 * DM; }
        const int lrow0 = wr * 64 + fr, col0 = u.pn * 256 + wc * 32 + 4 * fq;
#pragma unroll
        for (int ai = 0; ai < 2; ++ai)
#pragma unroll
            for (int m = 0; m < 4; ++m) { const size_t off = (size_t)(lrow0 + ai * 128 + m * 16) * DM + col0;
                const int grow = u.pm * 256 + lrow0 + ai * 128 + m * 16; float ss = 0.f;
#pragma unroll
                for (int bj = 0; bj < 2; ++bj)
#pragma unroll
                    for (int n = 0; n < 2; ++n) { const f32x4 bs = *(const f32x4*)(bp + off + bj * 128 + n * 16); const f32x4 hv = bs + acc[ai][bj][m][n] * dbg; *(f32x4*)(op + off + bj * 128 + n * 16) = hv;
                        if (hb) { ss += (hv[0] * hv[0] + hv[1] * hv[1]) + (hv[2] * hv[2] + hv[3] * hv[3]); u32x2 w; w.x = cvt_pk_bf16(hv[0], hv[1]); w.y = cvt_pk_bf16(hv[2], hv[3]); *(u32x2*)(hb + (size_t)grow * DM + col0 + bj * 128 + n * 16) = w; } }
                if (hb) { ss += __shfl_xor(ss, 16); ss += __shfl_xor(ss, 32); if (fq == 0) (void)__hip_atomic_fetch_add(rs + grow, ss, __ATOMIC_RELAXED, __HIP_MEMORY_SCOPE_AGENT); }
                asm volatile("" ::: "memory"); }
    }
};
struct EpiSwiglu {
    static constexpr bool PERM = true;
    bf16_t* P; const float* rs;
    __device__ __forceinline__ void operator()(const f32x4 (&acc)[2][2][4][2], const Unit& u, int wr, int wc, int fr, int fq) const {
        asm volatile("" : "+v"(fr), "+v"(fq));
        const int row0 = u.pm * 256 + wr * 64 + fr, col0 = u.pn * 128 + wc * 32 + 8 * fq;
#pragma unroll
        for (int ai = 0; ai < 2; ++ai)
#pragma unroll
            for (int m = 0; m < 4; ++m) { bf16_t* rowp = P + (size_t)(row0 + ai * 128 + m * 16) * PW + col0;
                const float sc = __builtin_amdgcn_rsqf(rs[row0 + ai * 128 + m * 16] * (1.f / DM) + EPS);
                float o[8];
#pragma unroll
                for (int n = 0; n < 2; ++n)
#pragma unroll
                    for (int e = 0; e < 4; ++e) { const float g = acc[ai][0][m][n][e] * sc, up = acc[ai][1][m][n][e] * sc; o[n * 4 + e] = g * __builtin_amdgcn_rcpf(1.f + __builtin_amdgcn_exp2f(-g * LOG2E)) * up; }
                u32x4 w; w.x = cvt_pk_bf16(o[0], o[1]); w.y = cvt_pk_bf16(o[2], o[3]); w.z = cvt_pk_bf16(o[4], o[5]); w.w = cvt_pk_bf16(o[6], o[7]);
                *(u32x4*)rowp = w; }
    }
};

struct SkP { bf16_t* P; int ocol; const float* rs; __device__ __forceinline__ void operator()(int r, int c, float v) const { if (rs) v *= __builtin_amdgcn_rsqf(rs[MROW0 + r] * (1.f / DM) + EPS); P[(size_t)(MROW0 + r) * PW + ocol + c] = (bf16_t)f2bf(v); } };
struct SkGate { bf16_t* G; const float* bias; const float* rs; __device__ __forceinline__ void operator()(int r, int c, float v) const { v *= __builtin_amdgcn_rsqf(rs[MROW0 + r] * (1.f / DM) + EPS); G[(size_t)(MROW0 + r) * 2048 + c] = (bf16_t)f2bf(__builtin_amdgcn_rcpf(1.f + __builtin_amdgcn_exp2f(-(v + bias[c]) * LOG2E))); } };
struct SkGated { bf16_t* P; const bf16_t* G; int first; __device__ __forceinline__ void operator()(int r, int c, float v) const { bf16_t* p = P + (size_t)(MROW0 + r) * PW + C_MERGED + c; const float pv = first ? 0.f : bf2f(*p); *p = (bf16_t)f2bf(pv + bf2f(G[(size_t)(MROW0 + r) * 2048 + c]) * v); } };
struct SkRes { float* hmeta; bf16_t* hb; float* rs;
    __device__ __forceinline__ void operator()(int r, int c, float v) const { float* p = hmeta + (size_t)(MROW0 + r) * DM + c; const float hv = *p + v; *p = hv;
        if (hb) { hb[(size_t)(MROW0 + r) * DM + c] = (bf16_t)f2bf(hv); float ss = hv * hv; ss += __shfl_xor(ss, 1); ss += __shfl_xor(ss, 2); ss += __shfl_xor(ss, 4); ss += __shfl_xor(ss, 8);
            if ((threadIdx.x & 15) == 0) (void)__hip_atomic_fetch_add(rs + MROW0 + r, ss, __ATOMIC_RELAXED, __HIP_MEMORY_SCOPE_AGENT); } } };
template <class Fn>
__device__ __forceinline__ void skinny_gemm(LAS unsigned char* lds, const bf16_t* A, int lda, const bf16_t* Bt, int K, int ntask, int bid, int G, const Fn& f) {
    int tid = threadIdx.x; asm volatile("" : "+v"(tid));
    const int wid = __builtin_amdgcn_readfirstlane(tid >> 6), lane = tid & 63, l15 = lane & 15, kq = lane >> 4;
    LAS f32x4* red = (LAS f32x4*)lds;
    const int kw = K / 8;
    for (int task = bid; task < ntask; task += G) {
        const bf16_t* ap = A + (size_t)l15 * lda + wid * kw + kq * 8;
        const bf16_t* bp = Bt + (size_t)(task * 16 + l15) * K + wid * kw + kq * 8;
        float z = 0.f; asm volatile("" : "+v"(z));
        f32x4 acc = (f32x4){z, z, z, z};
        for (int k0 = 0; k0 < kw; k0 += 256) {
            bf16x8 fa[8], fb[8];
#pragma unroll
            for (int i = 0; i < 8; ++i) { const int k = (k0 + 32 * i < kw) ? k0 + 32 * i : 0; fa[i] = *(const bf16x8*)(ap + k); fb[i] = *(const bf16x8*)(bp + k); }
#pragma unroll
            for (int i = 0; i < 8; ++i) if (k0 + 32 * i < kw) acc = __builtin_amdgcn_mfma_f32_16x16x32_bf16(fa[i], fb[i], acc, 0, 0, 0);
        }
        red[wid * 64 + lane] = acc;
        LDS_WAIT(); __syncthreads();
        if (wid == 0) {
            f32x4 s = red[lane];
#pragma unroll
            for (int w = 1; w < 8; ++w) s += red[w * 64 + lane];
#pragma unroll
            for (int r = 0; r < 4; ++r) f(kq * 4 + r, task * 16 + l15, s[r]);
        }
        __syncthreads();
    }
}
__device__ __forceinline__ void skinny_swiglu(LAS unsigned char* lds, const bf16_t* A, int lda, const bf16_t* Bt, int K, bf16_t* P, const float* rs, int bid, int G) {
    int tid = threadIdx.x; asm volatile("" : "+v"(tid));
    const int wid = __builtin_amdgcn_readfirstlane(tid >> 6), lane = tid & 63, l15 = lane & 15, kq = lane >> 4;
    LAS f32x4* red = (LAS f32x4*)lds;
    const int kw = K / 8;
    for (int task = bid; task < DFF / 16; task += G) {
        const int c0 = task * 16, brow = (c0 >> 7) * 256 + (c0 & 127) + l15;
        const bf16_t* ap = A + (size_t)l15 * lda + wid * kw + kq * 8;
        const bf16_t* bg = Bt + (size_t)brow * K + wid * kw + kq * 8; const bf16_t* bu = bg + (size_t)128 * K;
        float z = 0.f; asm volatile("" : "+v"(z));
        f32x4 ag = (f32x4){z, z, z, z}, au = ag;
        {
            bf16x8 fa[8], fg[8], fu[8];
#pragma unroll
            for (int i = 0; i < 8; ++i) { fa[i] = *(const bf16x8*)(ap + 32 * i); fg[i] = *(const bf16x8*)(bg + 32 * i); fu[i] = *(const bf16x8*)(bu + 32 * i); }
#pragma unroll
            for (int i = 0; i < 8; ++i) { ag = __builtin_amdgcn_mfma_f32_16x16x32_bf16(fa[i], fg[i], ag, 0, 0, 0); au = __builtin_amdgcn_mfma_f32_16x16x32_bf16(fa[i], fu[i], au, 0, 0, 0); }
        }
        red[wid * 64 + lane] = ag; red[512 + wid * 64 + lane] = au;
        LDS_WAIT(); __syncthreads();
        if (wid == 0) {
            f32x4 sg = red[lane], su = red[512 + lane];
#pragma unroll
            for (int w = 1; w < 8; ++w) { sg += red[w * 64 + lane]; su += red[512 + w * 64 + lane]; }
#pragma unroll
            for (int r = 0; r < 4; ++r) { const float sc = __builtin_amdgcn_rsqf(rs[MROW0 + kq * 4 + r] * (1.f / DM) + EPS); const float g = sg[r] * sc; su[r] *= sc; P[(size_t)(MROW0 + kq * 4 + r) * PW + c0 + l15] = (bf16_t)f2bf(g * __builtin_amdgcn_rcpf(1.f + __builtin_amdgcn_exp2f(-g * LOG2E)) * su[r]); }
        }
        __syncthreads();
    }
}

#define XB_TMO      128
#define XB_XCNT(j)  (256  + 64 * (j))
#define XB_XSUB(j)  (1280 + 64 * (j))
#define XB_XGEN(j)  (2304 + 64 * (j))
#define XB_TOP      3328
#define XB_TOPGEN   3392
#define XCD_BAR_WORDS 3456
#define XB_SPIN_CAP (1u << 18)
__device__ __forceinline__ unsigned xb_ld(unsigned* p)              { return __hip_atomic_load(p, __ATOMIC_RELAXED, __HIP_MEMORY_SCOPE_AGENT); }
__device__ __forceinline__ unsigned xb_add(unsigned* p, unsigned v) { return __hip_atomic_fetch_add(p, v, __ATOMIC_RELAXED, __HIP_MEMORY_SCOPE_AGENT); }
__device__ __forceinline__ unsigned xb_xcc_id() { return (unsigned)__builtin_amdgcn_s_getreg((3 << 11) | 20) & 0xFu; }
#define XB_SPIN(cond, bar) do { unsigned _sp = 0; while (cond) { __builtin_amdgcn_s_sleep(1); \
    if ((++_sp & 255u) == 0u) { if (xb_ld(&(bar)[XB_TMO])) break; if (_sp > XB_SPIN_CAP) { atomicAdd(&(bar)[XB_TMO], 1u); break; } } } } while (0)
struct XcdBarrier { unsigned* bar; unsigned x; volatile LAS unsigned* st; };
__device__ __forceinline__ XcdBarrier xcd_barrier_post(unsigned* bar, volatile LAS unsigned* st) {
    XcdBarrier b; b.bar = bar; b.x = xb_xcc_id(); b.st = st;
    if (threadIdx.x == 0) (void)xb_add(&bar[XB_XCNT(b.x)], 1u);
    return b;
}
__device__ __forceinline__ void xcd_barrier_complete(unsigned* bar, unsigned x, unsigned& nloc, unsigned& nx) {
    const unsigned G = gridDim.x * gridDim.y * gridDim.z;
    unsigned sum, cnt, mine, sp = 0u;
    for (;;) {
        sum = 0u; cnt = 0u; mine = 0u;
#pragma unroll
        for (unsigned j = 0; j < 16; ++j) { const unsigned c = xb_ld(&bar[XB_XCNT(j)]); sum += c; cnt += (c > 0u) ? 1u : 0u; mine = (j == x) ? c : mine; }
        if (sum == G) break;
        __builtin_amdgcn_s_sleep(1);
        if ((++sp & 255u) == 0u) { if (xb_ld(&bar[XB_TMO])) break; if (sp > XB_SPIN_CAP) { atomicAdd(&bar[XB_TMO], 1u); break; } }
    }
    nloc = mine > 0u ? mine : 1u; nx = cnt > 0u ? cnt : 1u;
}
__device__ __forceinline__ void xcd_barrier(const XcdBarrier& b) {
    asm volatile("s_waitcnt vmcnt(0)" ::: "memory");
    __syncthreads();
    if (threadIdx.x == 0) {
        unsigned* bar = b.bar;
        __builtin_amdgcn_s_waitcnt(0);
        unsigned nloc = b.st[0], nx = b.st[1];
        if (nloc == 0u) { xcd_barrier_complete(bar, b.x, nloc, nx); b.st[0] = nloc; b.st[1] = nx; }
        const unsigned old = xb_add(&bar[XB_XSUB(b.x)], 1u);
        const unsigned gen = old / nloc;
        if (old + 1u == (gen + 1u) * nloc) {
            __builtin_amdgcn_fence(__ATOMIC_RELEASE, "agent");
            asm volatile("s_waitcnt vmcnt(0)" ::: "memory");
            const unsigned og = xb_add(&bar[XB_TOP], 1u);
            const unsigned tg = og / nx;
            if (og + 1u == (tg + 1u) * nx) xb_add(&bar[XB_TOPGEN], 1u);
            else XB_SPIN(xb_ld(&bar[XB_TOPGEN]) == tg, bar);
            __builtin_amdgcn_fence(__ATOMIC_ACQUIRE, "agent");
            xb_add(&bar[XB_XGEN(b.x)], 1u);
            asm volatile("s_waitcnt vmcnt(0)" ::: "memory");
        } else {
            XB_SPIN(xb_ld(&bar[XB_XGEN(b.x)]) == gen, bar);
            __builtin_amdgcn_fence(__ATOMIC_ACQUIRE, "agent");
            asm volatile("s_waitcnt vmcnt(0)" ::: "memory");
        }
    }
    __syncthreads();
}

constexpr int NWAVES = 8;
constexpr int RING_BYTES = 131072, LDS_BYTES = 147456, LDSCTL_OFF = LDS_BYTES - 512;
struct Args {
    const float* in[19]; float* out; unsigned char* ws; int ph_lo, ph_hi;
};
struct Ctx {
    LAS unsigned char* lds; int tid, lane, wave, gw, ngw, G, bid;
};

template <int MAP> __device__ __forceinline__ int wmap(int n, float& sc) {
    sc = 1.f;
    if (MAP == 0) return n;
    if (MAP == 1) {
        if (n < 1088) return n;
        if (n < 3136) { const int m = n - 1088, d = m & 127; return 1280 + (m - d) + (d < 64 ? 2 * d : 2 * (d - 64) + 1); }
        if (n < 4160) return 1280 + (n - 1088);
        if (n < 5184) { const int m = n - 4160, d = m & 63; return 4352 + (m - d) + (d < 32 ? 2 * d : 2 * (d - 32) + 1); }
        if (n < 5248) { const int d = n - 5184; return 1088 + (d < 32 ? 2 * d : 2 * (d - 32) + 1); }
        if (n < 5264) { sc = 0.03125f; return 1152 + (n - 5248); }
        if (n < 7312) { const int m = n - 5264, d = m & 127; return 5376 + (m - d) + (d < 64 ? 2 * d : 2 * (d - 64) + 1); }
        if (n < 8336) return 5376 + (n - 5264);
        return 8448 + (n - 8336);
    }
    if (n < DFF) return (n >> 7) * 256 + (n & 127);
    const int m = n - DFF; return (m >> 7) * 256 + 128 + (m & 127);
}
template <int MAP> __device__ __forceinline__ void conv_matrix(const Ctx& F, const float* W, int K, int N, bf16_t* WT, const float* gain) {
    LAS float* scr = (LAS float*)(F.lds + F.wave * 18432);
    const int lane = F.lane;
    const int nblk = (N + 63) / 64, nit = (K / 64) * nblk;
    const int l31 = lane & 31, lh = lane >> 5, c = lane & 7, nsub = lane >> 3;
    f32x2 wv[32]; f32x4 g0 = (f32x4){1.f, 1.f, 1.f, 1.f}, g1 = g0;
#define CONV_LOAD(item) do { const int kb_ = (item) / nblk, nb_ = (item) - kb_ * nblk, k0_ = 64 * kb_, nn_ = 64 * nb_ + 2 * l31; \
        const float* src_ = W + (size_t)(k0_ + lh) * N + nn_; const bool ok_ = nn_ < N; \
        _Pragma("unroll") for (int i = 0; i < 32; ++i) wv[i] = ok_ ? *(const f32x2*)(src_ + (size_t)(2 * i) * N) : (f32x2){0.f, 0.f}; \
        if (gain) { g0 = *(const f32x4*)(gain + k0_ + 8 * c); g1 = *(const f32x4*)(gain + k0_ + 8 * c + 4); } } while (0)
    int it = F.gw;
    if (it < nit) CONV_LOAD(it);
    while (it < nit) {
        const int kb = it / nblk, nb = it - kb * nblk, k0 = 64 * kb, n0 = 64 * nb;
#pragma unroll
        for (int i = 0; i < 32; ++i) { LAS float* d = scr + (2 * i + lh) * 65 + l31; d[0] = wv[i].x; d[32] = wv[i].y; }
        const f32x4 gc0 = g0, gc1 = g1;
        const int nx = it + F.ngw;
        if (nx < nit) CONV_LOAD(nx);
        LDS_WAIT(); asm volatile("" ::: "memory");
#pragma unroll
        for (int j = 0; j < 8; ++j) { const int n = nsub + 8 * j, ns = n0 + n;
            if (ns < N) { float sc; const int dst = wmap<MAP>(ns, sc); const LAS float* s = scr + (8 * c) * 65 + (n & 1) * 32 + (n >> 1);
                u32x4 o; o.x = pk2(s[0 * 65] * (sc * gc0.x), s[1 * 65] * (sc * gc0.y)); o.y = pk2(s[2 * 65] * (sc * gc0.z), s[3 * 65] * (sc * gc0.w));
                o.z = pk2(s[4 * 65] * (sc * gc1.x), s[5 * 65] * (sc * gc1.y)); o.w = pk2(s[6 * 65] * (sc * gc1.z), s[7 * 65] * (sc * gc1.w));
                *(u32x4*)(WT + (size_t)dst * K + k0 + 8 * c) = o; } }
        LDS_WAIT(); asm volatile("" ::: "memory");
        it = nx;
    }
#undef CONV_LOAD
}

__device__ __forceinline__ void norm_row(const float* hrow, bf16_t* orow, float* rs_row, int lane) {
    f32x4 v[8]; float s = 0.f;
#pragma unroll
    for (int j = 0; j < 8; ++j) { v[j] = *((const f32x4*)hrow + lane + 64 * j); s += (v[j].x * v[j].x + v[j].y * v[j].y) + (v[j].z * v[j].z + v[j].w * v[j].w); }
    s = wave_sum(s);
    if (lane == 0) *rs_row = s;
#pragma unroll
    for (int j = 0; j < 8; ++j) { u32x2 o; o.x = cvt_pk_bf16(v[j].x, v[j].y); o.y = cvt_pk_bf16(v[j].z, v[j].w); *((u32x2*)orow + lane + 64 * j) = o; }
}

__device__ __forceinline__ void post1a_row(const bf16_t* P, int r, float* rstdq, float* rstdkv, int lane) {
    const bf16_t* p = P + (size_t)r * PW;
    const u32x4 a = *((const u32x4*)(p + C_CQ) + lane), b = *((const u32x4*)(p + C_CKV) + lane);
    float sa = 0.f, sb = 0.f;
#pragma unroll
    for (int e = 0; e < 4; ++e) { const float x0 = __uint_as_float(a[e] << 16), x1 = __uint_as_float(a[e] & 0xffff0000u); sa += x0 * x0 + x1 * x1;
        const float y0 = __uint_as_float(b[e] << 16), y1 = __uint_as_float(b[e] & 0xffff0000u); sb += y0 * y0 + y1 * y1; }
    sa = wave_sum(sa); sb = wave_sum(sb);
    if (lane == 0) { rstdq[r] = 1.0f / sqrtf(sa * (1.f / 512.f) + EPS); rstdkv[r] = 1.0f / sqrtf(sb * (1.f / 512.f) + EPS); }
    { unsigned* ikp = (unsigned*)(P + (size_t)r * PW + C_IK) + (lane & 31); const unsigned w = *ikp; const float x1 = __uint_as_float(w << 16), x2 = __uint_as_float(w & 0xffff0000u);
      float cs, sn; rope_cs(row_pos(r), lane & 31, 2.f / 64.f, cs, sn);
      if (lane < 32) *ikp = cvt_pk_bf16(x1 * cs - x2 * sn, x2 * cs + x1 * sn); }
}
__device__ __forceinline__ void meta_post_row(bf16_t* P, int r, const float* gperm, int lane) {
    bf16_t* p = P + (size_t)r * PW; const int pos = row_pos(r);
    float c128, s128, c64, s64; rope_cs(pos, lane, 2.f / 128.f, c128, s128); rope_cs(pos, lane & 31, 2.f / 64.f, c64, s64);
#pragma unroll 1
    for (int t = 0; t < 4; ++t) {
        const int cb = t == 0 ? C_DQ : (t == 1 ? C_DK : (t == 2 ? C_FQ : C_FK)); const float sc = (t == 0 || t == 2) ? C2_128 : 1.f;
        const float ga = gperm[t * 128 + 2 * lane], gb = gperm[t * 128 + 2 * lane + 1];
#pragma unroll 1
        for (int h = 0; h < 8; ++h) { unsigned* xp = (unsigned*)(p + cb + h * 128) + lane; const unsigned w = *xp; float x1 = __uint_as_float(w << 16), x2 = __uint_as_float(w & 0xffff0000u);
            const float rn = __builtin_amdgcn_rsqf(wave_sum(x1 * x1 + x2 * x2) * (1.f / 128.f) + EPS); x1 *= rn * ga; x2 *= rn * gb;
            *xp = cvt_pk_bf16((x1 * c128 - x2 * s128) * sc, (x2 * c128 + x1 * s128) * sc); }
    }
#pragma unroll 1
    for (int hh = 0; hh < 8; ++hh) { unsigned* xp = (unsigned*)(p + C_IQ + hh * 128) + lane; const unsigned w = *xp; const float x1 = __uint_as_float(w << 16), x2 = __uint_as_float(w & 0xffff0000u);
        *xp = cvt_pk_bf16(x1 * c64 - x2 * s64, x2 * c64 + x1 * s64); }
}
__device__ __forceinline__ void unpack8(const u32x4& w, float (&x)[8]) {
#pragma unroll
    for (int e = 0; e < 4; ++e) { x[2 * e] = __uint_as_float(w[e] << 16); x[2 * e + 1] = __uint_as_float(w[e] & 0xffff0000u); }
}
__device__ __forceinline__ u32x4 pack8(const float (&x)[8]) { u32x4 w; w.x = cvt_pk_bf16(x[0], x[1]); w.y = cvt_pk_bf16(x[2], x[3]); w.z = cvt_pk_bf16(x[4], x[5]); w.w = cvt_pk_bf16(x[6], x[7]); return w; }
__device__ __forceinline__ u32x4 shfl_xor4(const u32x4& w, int m) { u32x4 r; r.x = __shfl_xor(w.x, m); r.y = __shfl_xor(w.y, m); r.z = __shfl_xor(w.z, m); r.w = __shfl_xor(w.w, m); return r; }
__device__ __forceinline__ void post2_row(bf16_t* P, int r, const float* rstdq, const float* rstdkv, const float* qkg  , LAS float* rnl, int lane) {
    bf16_t* p = P + (size_t)r * PW;
    const float sq = rstdq[r], skv = rstdkv[r];
    const int pos = row_pos(r), hw = lane >> 5, l5 = lane & 31;
    float c64[8], s64[8];
#pragma unroll
    for (int j = 0; j < 8; ++j) rope_cs(pos, 8 * (lane & 3) + j, 2.f / 64.f, c64[j], s64[j]);
    float kp[8]; { const u32x4 w = *(const u32x4*)(p + C_KPE + (lane & 7) * 8); unpack8(w, kp); }
    float kpe_ss = 0.f;
#pragma unroll
    for (int j = 0; j < 8; ++j) kpe_ss += kp[j] * kp[j];
    kpe_ss += __shfl_xor(kpe_ss, 1); kpe_ss += __shfl_xor(kpe_ss, 2); kpe_ss += __shfl_xor(kpe_ss, 4);
    u32x4 rq[4], rkv[4];
#pragma unroll
    for (int it = 0; it < 4; ++it) { const int h = 2 * it + hw; rq[it] = *(const u32x4*)(p + C_QRAW + h * 192 + (l5 < 24 ? l5 : 0) * 8); rkv[it] = *(const u32x4*)(p + C_KVRAW + h * 256 + l5 * 8); }
#pragma unroll
    for (int it = 0; it < 4; ++it) {
        const int h = 2 * it + hw; const bool act = l5 < 24;
        u32x4* ptr = (u32x4*)(p + C_QRAW + h * 192 + (act ? l5 : 0) * 8);
        float x[8]; unpack8(rq[it], x);
        float ss = 0.f;
#pragma unroll
        for (int j = 0; j < 8; ++j) { x[j] *= sq; ss += x[j] * x[j]; }
        if (!act) ss = 0.f;
#pragma unroll
        for (int o = 1; o < 32; o <<= 1) ss += __shfl_xor(ss, o);
        const float rn = 1.0f / sqrtf(ss * (1.f / 192.f) + EPS);
        const int gi = (act ? l5 : 0) * 8;
        const f32x4 g0 = *(const f32x4*)(qkg + gi), g1 = *(const f32x4*)(qkg + gi + 4);
#pragma unroll
        for (int j = 0; j < 4; ++j) { x[j] *= rn * g0[j]; x[4 + j] *= rn * g1[j]; }
        float o[8];
#pragma unroll
        for (int j = 0; j < 8; ++j) { const float pr = __shfl_xor(x[j], 4); const float rot = (l5 & 4) ? (x[j] * c64[j] + pr * s64[j]) : (x[j] * c64[j] - pr * s64[j]); o[j] = (l5 >= 16 ? rot : x[j]) * C2_192; }
        if (act) *ptr = pack8(o);
    }
#pragma unroll
    for (int it = 0; it < 4; ++it) {
        const int h = 2 * it + hw; const bool isk = l5 < 16;
        u32x4* ptr = (u32x4*)(p + C_KVRAW + h * 256 + l5 * 8);
        float x[8]; unpack8(rkv[it], x);
        float ss = 0.f;
#pragma unroll
        for (int j = 0; j < 8; ++j) { x[j] *= skv; ss += x[j] * x[j]; }
        if (!isk) ss = 0.f;
#pragma unroll
        for (int o = 1; o < 32; o <<= 1) ss += __shfl_xor(ss, o);
        const float rn = 1.0f / sqrtf((ss + kpe_ss) * (1.f / 192.f) + EPS);
        if (l5 == 0) rnl[h] = rn;
        const int gi = 192 + (isk ? l5 : 0) * 8;
        const f32x4 g0 = *(const f32x4*)(qkg + gi), g1 = *(const f32x4*)(qkg + gi + 4);
        float o[8];
#pragma unroll
        for (int j = 0; j < 4; ++j) { o[j] = isk ? x[j] * rn * g0[j] : x[j]; o[4 + j] = isk ? x[4 + j] * rn * g1[j] : x[4 + j]; }
        *ptr = pack8(o);
    }
    LDS_WAIT(); asm volatile("" ::: "memory");
    { const int hd = lane >> 3, c = lane & 7; const float rn = rnl[hd];
      const f32x4 g0 = *(const f32x4*)(qkg + 192 + 128 + c * 8), g1 = *(const f32x4*)(qkg + 192 + 128 + c * 8 + 4);
      float x[8], o[8];
#pragma unroll
      for (int j = 0; j < 4; ++j) { x[j] = kp[j] * rn * g0[j]; x[4 + j] = kp[4 + j] * rn * g1[j]; }
#pragma unroll
      for (int j = 0; j < 8; ++j) { const float pr = __shfl_xor(x[j], 4); o[j] = (c & 4) ? (x[j] * c64[j] + pr * s64[j]) : (x[j] * c64[j] - pr * s64[j]); }
      *(u32x4*)(p + C_KPEH + hd * 64 + c * 8) = pack8(o); }
    LDS_WAIT(); asm volatile("" ::: "memory");
}
__device__ __forceinline__ void post3_row(bf16_t* P, int r, const float* subg, float lam, float omli, int lane) {
    bf16_t* p = P + (size_t)r * PW;
    const int hw = lane >> 5, l5 = lane & 31;
    u32x4 rr[4];
#pragma unroll
    for (int h = 0; h < 4; ++h) rr[h] = *(const u32x4*)(p + (hw ? C_IQ : C_FQ) + h * 256 + l5 * 8);
#pragma unroll
    for (int h = 0; h < 4; ++h) {
        const u32x4 raw = rr[h];
        const u32x4 praw = shfl_xor4(raw, 16);
        float a[8], b[8]; unpack8(raw, a); unpack8(praw, b);
        float d[8], ss = 0.f;
#pragma unroll
        for (int j = 0; j < 8; ++j) { d[j] = a[j] - lam * b[j]; ss += d[j] * d[j]; }
        if (l5 >= 16) ss = 0.f;
#pragma unroll
        for (int o = 1; o < 64; o <<= 1) ss += __shfl_xor(ss, o);
        const float rn = omli / sqrtf(ss * (1.f / 256.f) + EPS);
        const int dim = hw * 128 + (l5 & 15) * 8;
        const f32x4 g0 = *(const f32x4*)(subg + dim), g1 = *(const f32x4*)(subg + dim + 4);
        float o[8];
#pragma unroll
        for (int j = 0; j < 4; ++j) { o[j] = d[j] * rn * g0[j]; o[4 + j] = d[4 + j] * rn * g1[j]; }
        if (l5 < 16) *(u32x4*)(p + C_OC + h * 256 + dim) = pack8(o);
    }
}

__device__ __forceinline__ void index_unit(const bf16_t* P, int unit, unsigned* bm, LAS unsigned char* lds) {
    typedef float f32x16 __attribute__((ext_vector_type(16)));
    int tid = threadIdx.x; asm volatile("" : "+v"(tid));
    const int wid = __builtin_amdgcn_readfirstlane(tid >> 6), lane = tid & 63, j = lane & 31, hi = lane >> 5;
    const int tb = 255 - (unit >> 4), b = unit & 15, t0 = tb * 8, tokbase = MBLK + b * SEQ;
    const int wmax = (64 + t0 + 7) >> 5;
    LAS unsigned* keys = (LAS unsigned*)lds;
    LAS float* iwl = (LAS float*)(lds + 8 * 2112 * 4);
    if (t0 + 7 + 17 > 256) {
        if (tid < 128) iwl[tid] = bf2f(P[(size_t)(tokbase + t0 + (tid >> 4)) * PW + C_IW + (tid & 15)]);
        LAS unsigned char* al = lds + 8 * 2112 * 4 + 512;
        { const int id0 = tid * 2;
#pragma unroll
          for (int e = 0; e < 2; ++e) { const int id = id0 + e, rw = id >> 3, c = id & 7;
              *(LAS bf16x8*)(al + rw * 144 + c * 16) = *(const bf16x8*)(P + (size_t)(tokbase + t0 + (rw >> 4)) * PW + C_IQ + (rw & 15) * 64 + c * 8); } }
        LDS_WAIT(); __syncthreads();
        bf16x8 af[4][4];
        { const int qa = (j >> 2) & 1, ha = (j & 3) + 4 * (j >> 3);
#pragma unroll
          for (int blk = 0; blk < 4; ++blk)
#pragma unroll
              for (int s = 0; s < 4; ++s) af[blk][s] = *(const LAS bf16x8*)(al + ((2 * blk + qa) * 16 + ha) * 144 + s * 32 + hi * 16); }
        const unsigned boff = (unsigned)(j * PW + C_IK + hi * 8) * 2u;
        for (int w = wid; w <= wmax; w += 8) {
            const int kr_ = w < 2 ? (MBLK - 64) + 32 * w : tokbase + 32 * (w - 2); const char* bp_ = (const char*)(P + (size_t)kr_ * PW) + boff;
            bf16x8 bf[4];
#pragma unroll
            for (int s = 0; s < 4; ++s) bf[s] = *(const bf16x8*)(bp_ + s * 32);
            const int kidx = 32 * w + j;
#pragma unroll
            for (int blk = 0; blk < 4; ++blk) {
                f32x16 acc = (f32x16){0.f,0.f,0.f,0.f,0.f,0.f,0.f,0.f,0.f,0.f,0.f,0.f,0.f,0.f,0.f,0.f};
#pragma unroll
                for (int s = 0; s < 4; ++s) acc = __builtin_amdgcn_mfma_f32_32x32x16_bf16(af[blk][s], bf[s], acc, 0, 0, 0);
                const int q = 2 * blk + hi;
                const LAS f32x4* iwq = (const LAS f32x4*)(iwl + q * 16);
                float score = 0.f;
#pragma unroll
                for (int g = 0; g < 4; ++g) { const f32x4 wv = iwq[g]; score += fmaxf(acc[4 * g], 0.f) * wv.x + fmaxf(acc[4 * g + 1], 0.f) * wv.y + fmaxf(acc[4 * g + 2], 0.f) * wv.z + fmaxf(acc[4 * g + 3], 0.f) * wv.w; }
                const bool valid = kidx >= 48 && kidx <= 64 + t0 + q; const unsigned u_ = __float_as_uint(score);
                keys[q * 2112 + kidx] = valid ? ((u_ & 0x80000000u) ? ~u_ : (u_ | 0x80000000u)) : 0u;
            }
        }
        LDS_WAIT(); __syncthreads();
    }
    const int tq = t0 + wid, qk = 64 + tq, nch = qk / 64 + 1;
    unsigned* out = bm + (size_t)(b * SEQ + tq) * BMW;
    if (tq + 17 <= 256) {
        for (int c = 0; c < 33; ++c) { const int kidx = 64 * c + lane; const unsigned long long m = __ballot(kidx >= 48 && kidx <= qk);
            if (lane == 0) { out[2 * c] = (unsigned)m; out[2 * c + 1] = (unsigned)(m >> 32); } }
    } else {
        unsigned kreg[33];
#pragma unroll
        for (int c = 0; c < 33; ++c) kreg[c] = (c < nch && 64 * c + lane <= qk) ? keys[wid * 2112 + 64 * c + lane] : 0u;
        unsigned T = 0u;
        for (int bit = 31; bit >= 0; --bit) {
            const unsigned cand = T | (1u << bit); int cnt = 0;
#pragma unroll
            for (int c = 0; c < 33; ++c) cnt += __popcll(__ballot(kreg[c] >= cand));
            if (cnt >= 256) T = cand;
            if (cnt == 256) break;
        }
#pragma unroll
        for (int c = 0; c < 33; ++c) { const unsigned long long m = __ballot(kreg[c] >= T && kreg[c] != 0u);
            if (lane == 0) { out[2 * c] = (unsigned)m; out[2 * c + 1] = (unsigned)(m >> 32); } }
    }
    LDS_WAIT();
}

namespace fa {
typedef float f32x16 __attribute__((ext_vector_type(16)));
typedef short s16x4 __attribute__((ext_vector_type(4)));
__device__ __forceinline__ int crow(int r, int hi) { return (r & 3) + 8 * (r >> 2) + 4 * hi; }
__device__ __forceinline__ int v_st(int k, int c) { const int kk = (k & ~0xC) | ((k & 4) << 1) | ((k & 8) >> 1); return ((kk >> 3) * 4 + (c >> 5)) * 512 + ((kk & 7) * 32 + (c & 31)) * 2; }
__device__ __forceinline__ int v_rd_base(int lane) { return ((lane & 3) << 3) | (((lane >> 2) & 3) << 6) | (((lane >> 4) & 1) << 5) | (((lane >> 5) & 1) << 8); }
constexpr int v_rd_off(int d0, int ks, int half) { return d0 * 512 + ks * 4096 + half * 2048; }
constexpr int SHM_V = 16384;
template <int DQK, int DV> struct Geo { static constexpr int KP = DQK * 2, SHM_K = 64 * DQK * 2, LDS_K0 = 2 * 64 * DV * 2, LDS_WS = LDS_K0 + 2 * SHM_K, BYTES = LDS_WS + 8 * 256; };
#define FA_KSWZ(row, colB, pitch) ((row) * (pitch) + ((colB) ^ (((row) & 7) << 4)))
#define FA_SBAR() __builtin_amdgcn_sched_barrier(0)

struct Item { int qrow0, qk0, nt, tokbase; };

template <int DQK>
__device__ __forceinline__ void load_q(const bf16_t* P, const Item& it, int qcol, bf16x8 (&qr)[DQK / 16]) {
    int tid = threadIdx.x; asm volatile("" : "+v"(tid));
    const int wid = tid >> 6, lane = tid & 63, r32 = lane & 31, hi = lane >> 5;
    const bf16_t* qp = P + (size_t)(it.qrow0 + wid * 32 + r32) * PW + qcol + hi * 8;
#pragma unroll
    for (int d0 = 0; d0 < DQK / 16; ++d0) qr[d0] = *(const bf16x8*)(qp + d0 * 16);
}

template <int DQK, int DV, bool MASKED>
__device__ __forceinline__ void attn_core(bf16_t* P, const Item& it, const bf16x8 (&qr)[DQK / 16], int k1col, int k2col, int vcol, int ocol, int ocol1, const unsigned* bmq, LAS unsigned char* lds) {
    typedef Geo<DQK, DV> G; constexpr int SHMV = 64 * DV * 2, NDB = DV / 32;
    int tid = threadIdx.x; asm volatile("" : "+v"(tid));
    const int wid = __builtin_amdgcn_readfirstlane(tid >> 6), lane = tid & 63, r32 = lane & 31, hi = lane >> 5;
    LAS unsigned char* V_lds = lds; LAS unsigned char* K_lds = lds + G::LDS_K0; LAS float* wsf = (LAS float*)(lds + G::LDS_WS) + wid * 64;
    const int sr = tid >> 4, sc = (tid & 15) * 8;
    const int vst0 = v_st(sr, sc), vst1 = v_st(32 + sr, sc), kws0 = FA_KSWZ(sr, sc * 2, G::KP), kws1 = FA_KSWZ(sr + 32, sc * 2, G::KP);
    const int xr = tid >> 3, xc = (tid & 7) * 8, kws2 = FA_KSWZ(xr, (128 + xc) * 2, G::KP);
    const unsigned loff0 = (unsigned)(sr * PW + sc) * 2u, loffx = (unsigned)(xr * PW + xc) * 2u;
    const int vb0 = (int)(unsigned)(size_t)V_lds + v_rd_base(lane);
    const int NT = it.nt;
    const int qk = it.qk0 + wid * 32 + r32;
    const bool use_bm = MASKED && (bmq != nullptr);
    const unsigned bmoff = (unsigned)((wid * 32 + r32) * BMW) * 4u;
    float l_reg = 0.f; f32x16 o[NDB];
#pragma unroll
    for (int d = 0; d < NDB; ++d) o[d] = (f32x16){0.f,0.f,0.f,0.f,0.f,0.f,0.f,0.f,0.f,0.f,0.f,0.f,0.f,0.f,0.f,0.f};
    bf16x8 sk0, sk1, sk2, sv0, sv1, sv2, sv3;
#define FA_KROW0(t) ((t) == 0 ? (MBLK - 64) : it.tokbase + 64 * ((t) - 1))
#define FA_LOADK(t) do { const int kr_ = FA_KROW0(t); const char* rb_ = (const char*)(P + (size_t)kr_ * PW); const char* rk_ = rb_ + (size_t)k1col * 2; \
        sk0 = *(const bf16x8*)(rk_ + loff0); sk1 = *(const bf16x8*)(rk_ + (size_t)32 * PW * 2 + loff0); if (DQK == 192) sk2 = *(const bf16x8*)(rb_ + (size_t)k2col * 2 + loffx); } while (0)
#define FA_LOADV(t) do { const char* rv_ = (const char*)(P + (size_t)FA_KROW0(t) * PW) + (size_t)vcol * 2; \
        sv0 = *(const bf16x8*)(rv_ + loff0); sv1 = *(const bf16x8*)(rv_ + (size_t)32 * PW * 2 + loff0); if (DV == 256) { sv2 = *(const bf16x8*)(rv_ + 256 + loff0); sv3 = *(const bf16x8*)(rv_ + 256 + (size_t)32 * PW * 2 + loff0); } } while (0)
#define FA_LOAD(t) do { FA_LOADK(t); FA_LOADV(t); } while (0)
#define FA_WRITE(bf) do { *(LAS bf16x8*)(K_lds + (bf) * G::SHM_K + kws0) = sk0; *(LAS bf16x8*)(K_lds + (bf) * G::SHM_K + kws1) = sk1; \
        *(LAS bf16x8*)(V_lds + (bf) * SHMV + vst0) = sv0; *(LAS bf16x8*)(V_lds + (bf) * SHMV + vst1) = sv1; if (DV == 256) { *(LAS bf16x8*)(V_lds + (bf) * SHMV + 16384 + vst0) = sv2; *(LAS bf16x8*)(V_lds + (bf) * SHMV + 16384 + vst1) = sv3; } \
        if (DQK == 192) *(LAS bf16x8*)(K_lds + (bf) * G::SHM_K + kws2) = sk2; } while (0)
    constexpr int QREG = (DV == 256) ? 3 : DQK / 16;
    constexpr int NQL = DQK / 16 - QREG;
    static_assert(G::BYTES + 8 * NQL * 64 * 16 <= LDSCTL_OFF, "attention LDS budget");
    LAS unsigned char* qx = lds + G::BYTES + (wid * (NQL * 64) + lane) * 16;
    if (QREG < DQK / 16) {
#pragma unroll
        for (int d0 = QREG; d0 < DQK / 16; ++d0) *(LAS bf16x8*)(qx + (d0 - QREG) * 1024) = qr[d0];
    }
    FA_LOAD(0); FA_WRITE(0);
    __syncthreads();
    for (int t = 0; t < NT; ++t) {
        const int cur = t & 1;
        unsigned zb = 0u; asm volatile("" : "+v"(zb)); u32x2 bw = (u32x2){zb, zb};
        if (use_bm) bw = *(const u32x2*)((const char*)(bmq + 2 * t) + bmoff);
        f32x16 p0 = (f32x16){0.f,0.f,0.f,0.f,0.f,0.f,0.f,0.f,0.f,0.f,0.f,0.f,0.f,0.f,0.f,0.f}, p1 = p0;
        { LAS unsigned char* kbase = K_lds + cur * G::SHM_K;
          LAS unsigned char* kb[4];
#pragma unroll
          for (int dd = 0; dd < 4; ++dd) kb[dd] = kbase + FA_KSWZ(r32, (dd * 16 + hi * 8) * 2, G::KP);
          constexpr int GS = (DQK == 192 || DV == 256) ? 2 : 4;
#pragma unroll
          for (int g = 0; g < DQK / (16 * GS); ++g) {
              bf16x8 fb0[GS], fb1[GS];
#pragma unroll
              for (int dd = 0; dd < GS; ++dd) { const int d0 = g * GS + dd; LAS unsigned char* a = kb[d0 & 3] + (d0 >> 2) * 128; fb0[dd] = *(const LAS bf16x8*)a; fb1[dd] = *(const LAS bf16x8*)(a + 32 * G::KP); }
              FA_SBAR();
#pragma unroll
              for (int dd = 0; dd < GS; ++dd) { const int d0 = g * GS + dd; bf16x8 qf; if (d0 < QREG) qf = qr[d0 < QREG ? d0 : 0]; else qf = *(const LAS bf16x8*)(qx + (d0 - QREG) * 1024);
                  p0 = __builtin_amdgcn_mfma_f32_32x32x16_bf16(fb0[dd], qf, p0, 0, 0, 0); p1 = __builtin_amdgcn_mfma_f32_32x32x16_bf16(fb1[dd], qf, p1, 0, 0, 0); }
              FA_SBAR(); } }
        if (t + 1 < NT) { FA_LOADK(t + 1); if (DV != 256) FA_LOADV(t + 1); }
        FA_SBAR();
        const float NEG = -__builtin_inff();
        if (use_bm) {
        } else if (t == 0 || 64 * t + 63 > it.qk0 + wid * 32) {
            const int kb_ = 64 * t + 4 * hi;
#pragma unroll
            for (int r = 0; r < 16; ++r) { const int k0 = kb_ + (r & 3) + 8 * (r >> 2), k1 = k0 + 32;
                if (k0 < 48 || k0 > qk) p0[r] = NEG; if (k1 < 48 || k1 > qk) p1[r] = NEG; }
        }
        float ps = 0.f;
#pragma unroll
        for (int r = 0; r < 16; ++r) { p0[r] = __builtin_amdgcn_exp2f(p0[r]); p1[r] = __builtin_amdgcn_exp2f(p1[r]); }
        if (use_bm) {
            const int wx = (int)(bw.x >> (4 * hi)), wy = (int)(bw.y >> (4 * hi));
#pragma unroll
            for (int r = 0; r < 16; ++r) { const int c = (r & 3) + 8 * (r >> 2);
                p0[r] = __uint_as_float(__float_as_uint(p0[r]) & (unsigned)__builtin_amdgcn_sbfe(wx, c, 1)); p1[r] = __uint_as_float(__float_as_uint(p1[r]) & (unsigned)__builtin_amdgcn_sbfe(wy, c, 1)); }
        }
        { f32x2 s2 = (f32x2){p0[0], p0[1]} + (f32x2){p1[0], p1[1]};
#pragma unroll
          for (int r = 2; r < 16; r += 2) s2 += (f32x2){p0[r], p0[r + 1]} + (f32x2){p1[r], p1[r + 1]};
          ps = s2.x + s2.y; }
        { auto rr = __builtin_amdgcn_permlane32_swap(__float_as_uint(ps), __float_as_uint(ps), false, false); ps = __uint_as_float(rr[0]) + __uint_as_float(rr[1]); }
        l_reg += ps;
        if (DV == 256 && t + 1 < NT) { FA_SBAR(); FA_LOADV(t + 1); FA_SBAR(); }
        bf16x8 pa0, pa1, pa2, pa3;
#define FA_PK4(Pv, B_, OUT) do { const unsigned a0 = cvt_pk_bf16(Pv[B_ + 0], Pv[B_ + 1]), a1 = cvt_pk_bf16(Pv[B_ + 2], Pv[B_ + 3]), b0 = cvt_pk_bf16(Pv[B_ + 4], Pv[B_ + 5]), b1 = cvt_pk_bf16(Pv[B_ + 6], Pv[B_ + 7]); \
        auto r0 = __builtin_amdgcn_permlane32_swap(a0, b0, false, false); auto r1 = __builtin_amdgcn_permlane32_swap(a1, b1, false, false); \
        u32x4 w_ = {r0[0], r1[0], r0[1], r1[1]}; OUT = __builtin_bit_cast(bf16x8, w_); } while (0)
        FA_PK4(p0, 0, pa0); FA_PK4(p0, 8, pa1); FA_PK4(p1, 0, pa2); FA_PK4(p1, 8, pa3);
#define FA_TRRD(dst, off) asm volatile("ds_read_b64_tr_b16 %0, %1 offset:%2" : "=&v"(dst) : "v"(vbc), "i"(off) : "memory")
#define FA_PV(VB, d0) do { s16x4 l0, l1, l2, l3, h0, h1, h2, h3; constexpr int b_ = ((d0) >> 2) * 16384 + v_rd_off((d0) & 3, 0, 0); \
        FA_TRRD(l0, b_); FA_TRRD(h0, b_ + 2048); FA_TRRD(l1, b_ + 4096); FA_TRRD(h1, b_ + 6144); FA_TRRD(l2, b_ + 8192); FA_TRRD(h2, b_ + 10240); FA_TRRD(l3, b_ + 12288); FA_TRRD(h3, b_ + 14336); \
        asm volatile("s_waitcnt lgkmcnt(0)" ::: "memory"); FA_SBAR(); \
        o[d0] = __builtin_amdgcn_mfma_f32_32x32x16_bf16(pa0, (bf16x8){l0[0], l0[1], l0[2], l0[3], h0[0], h0[1], h0[2], h0[3]}, o[d0], 0, 0, 0); \
        o[d0] = __builtin_amdgcn_mfma_f32_32x32x16_bf16(pa1, (bf16x8){l1[0], l1[1], l1[2], l1[3], h1[0], h1[1], h1[2], h1[3]}, o[d0], 0, 0, 0); \
        o[d0] = __builtin_amdgcn_mfma_f32_32x32x16_bf16(pa2, (bf16x8){l2[0], l2[1], l2[2], l2[3], h2[0], h2[1], h2[2], h2[3]}, o[d0], 0, 0, 0); \
        o[d0] = __builtin_amdgcn_mfma_f32_32x32x16_bf16(pa3, (bf16x8){l3[0], l3[1], l3[2], l3[3], h3[0], h3[1], h3[2], h3[3]}, o[d0], 0, 0, 0); } while (0)
        FA_SBAR();
        { const int vbc = vb0 + cur * SHMV;
          FA_PV(0, 0); FA_PV(0, 1); FA_PV(0, 2); FA_PV(0, 3); if (DV == 256) { FA_PV(0, 4); FA_PV(0, 5); FA_PV(0, 6); FA_PV(0, 7); } }
        FA_SBAR();
        if (t + 1 < NT) { const int nb_ = cur ^ 1; FA_WRITE(nb_); }
        __syncthreads();
    }
    if (hi == 0) wsf[r32] = l_reg; LDS_WAIT();
    float rli[16];
#pragma unroll
    for (int r = 0; r < 16; ++r) { const float lv = wsf[crow(r, hi)]; rli[r] = lv > 0.f ? __builtin_amdgcn_rcpf(lv) : 0.f; }
    { int l2 = lane; asm volatile("" : "+v"(l2));
      const int r32b = l2 & 31, hib = l2 >> 5;
      char* Ow = (char*)(P + (size_t)(it.qrow0 + wid * 32) * PW + ocol) + (unsigned)((4 * hib) * PW + r32b) * 2u;
      char* Ow1 = (char*)(P + (size_t)(it.qrow0 + wid * 32) * PW + ocol1) + (unsigned)((4 * hib) * PW + r32b) * 2u;
#pragma unroll
      for (int r = 0; r < 16; ++r) { const unsigned ro = (unsigned)(((r & 3) + 8 * (r >> 2)) * PW) * 2u;
#pragma unroll
        for (int d0 = 0; d0 < NDB; ++d0) { const float v = o[d0][r] * rli[r]; const float vn = __shfl_xor(v, 1);
            if ((r32b & 1) == 0) *(unsigned*)((d0 < 4 ? Ow : Ow1) + ro + (d0 & 3) * 64) = cvt_pk_bf16(v, vn); } } }
    LDS_WAIT();
    __syncthreads();
#undef FA_KROW0
#undef FA_LOAD
#undef FA_LOADK
#undef FA_LOADV
#undef FA_WRITE
#undef FA_PK4
#undef FA_TRRD
#undef FA_PV
}
__device__ __forceinline__ int next_item(unsigned* ctr, LAS int* slot) {
    __syncthreads();
    if (threadIdx.x == 0) *slot = (int)__hip_atomic_fetch_add(ctr, 1u, __ATOMIC_RELAXED, __HIP_MEMORY_SCOPE_AGENT);
    __syncthreads();
    return *slot;
}
__device__ __forceinline__ void queue_prime(unsigned* ctr, LAS int* slot) {
    __syncthreads();
    if (threadIdx.x == 0) slot[0] = (int)__hip_atomic_fetch_add(ctr, 1u, __ATOMIC_RELAXED, __HIP_MEMORY_SCOPE_AGENT);
    __syncthreads();
}
__device__ __forceinline__ int queue_next(unsigned* ctr, LAS int* slot, int k) {
    const int idx = slot[k & 1];
    if (threadIdx.x == 0) slot[(k + 1) & 1] = (int)__hip_atomic_fetch_add(ctr, 1u, __ATOMIC_RELAXED, __HIP_MEMORY_SCOPE_AGENT);
    return idx;
}
__device__ __forceinline__ Item make_item(bool meta, int b, int qb) {
    Item it;
    if (meta) { it.qrow0 = 0; it.qk0 = -(MBLK - 64); it.nt = 1; it.tokbase = MBLK; }
    else { it.qrow0 = MBLK + b * SEQ + qb * 256; it.qk0 = 64 + qb * 256; it.nt = 4 * (qb + 1) + 1; it.tokbase = MBLK + b * SEQ; }
    return it;
}
}


constexpr int PH_PER_LAYER = 19, N_PHASES = 2 * PH_PER_LAYER;
__device__ __forceinline__ unsigned char* uni_ptr(unsigned char* p) { const unsigned long long v = (unsigned long long)p; const unsigned lo = __builtin_amdgcn_readfirstlane((unsigned)v), hi = __builtin_amdgcn_readfirstlane((unsigned)(v >> 32)); return (unsigned char*)(((unsigned long long)hi << 32) | lo); }
__device__ __forceinline__ const float* arg_in(const Args& a, int k) { asm volatile("" : "+s"(k)); return a.in[k]; }
__global__ void __launch_bounds__(NWAVES * 64, 2) mega_fwd(Args args) {
    extern __shared__ __attribute__((aligned(16))) unsigned char lds_raw[];
    {
        LAS unsigned char* l0 = (LAS unsigned char*)lds_raw;
        for (int u = threadIdx.x; u < (LDS_BYTES - LDSCTL_OFF) / 4; u += NWAVES * 64) ((LAS unsigned*)(l0 + LDSCTL_OFF))[u] = 0u;
        __syncthreads();
    }
#if MK_ONE_LAUNCH
    (void)xcd_barrier_post((unsigned*)(args.ws + WS_CTL) + CW_BAR, (volatile LAS unsigned*)((LAS unsigned char*)lds_raw + LDSCTL_OFF + 64));
#define GRID_BAR() do { XcdBarrier bar_; bar_.bar = (unsigned*)(uni_ptr(args.ws) + WS_CTL) + CW_BAR; bar_.x = xb_xcc_id(); bar_.st = (volatile LAS unsigned*)((LAS unsigned char*)lds_raw + LDSCTL_OFF + 64); xcd_barrier(bar_); } while (0)
#else
#define GRID_BAR() do {} while (0)
#endif
    const int lo = args.ph_lo, hi = args.ph_hi;
#define IN(k) (lo <= (k) && (k) < hi)
#define SEAM(k) do { if (IN((k) + 1)) GRID_BAR(); } while (0)
#define PH_BEGIN \
    int tid_ = threadIdx.x; asm volatile("" : "+v"(tid_)); \
    Ctx F; F.lds = (LAS unsigned char*)lds_raw; F.tid = tid_; F.lane = tid_ & 63; F.wave = __builtin_amdgcn_readfirstlane(tid_ >> 6); \
    F.G = gridDim.x; F.bid = blockIdx.x; F.gw = F.bid * NWAVES + F.wave; F.ngw = F.G * NWAVES; \
    unsigned char* ws = uni_ptr(args.ws); asm volatile("" : "+s"(ws)); \
    int ly = __builtin_amdgcn_readfirstlane(layer); asm volatile("" : "+s"(ly)); (void)ly; (void)F
#define XN_ ((bf16_t*)(ws + WS_XN))
#define P_ ((bf16_t*)(ws + WS_P))
#define HMETA_ ((float*)(ws + WS_HMETA))
#define RSTDQ_ ((float*)(ws + WS_RSTD))
#define RSTDKV_ ((float*)(ws + WS_RSTD) + R)
#define BM_ ((unsigned*)(ws + WS_BM))
#define RS_(i) ((float*)(ws + WS_CTL + WS_RS) + (size_t)(i) * R)
#define GPERM_ ((float*)(ws + WS_RSTD + 512 * 1024))
#define WB_(off) ((bf16_t*)(ws + WS_WB + (off)))
#define OUT_ (args.out)
#define LAMBDA_INIT(ly) ((ly) == 0 ? 0.2f : (0.8f - 0.6f * 0.7408182206817179f))
#define HSRC_TOK(ly) ((ly) == 0 ? arg_in(args, 0) : (const float*)args.out)

#pragma unroll
    for (int layer = 0; layer < 2; ++layer) {
        const int pb = layer * PH_PER_LAYER;
        if (((PHMASK >> 0) & 1) && IN(pb + 0)) {
            PH_BEGIN;
            for (int rep_ = 0; rep_ < NREP(0); ++rep_) { if (rep_) GRID_BAR();
            const float* meta = arg_in(args, 1);
            conv_matrix<1>(F, arg_in(args, 3) + (size_t)ly * DM * D_IN, DM, D_IN, WB_(WB_IN), arg_in(args, 2) + ly * DM);
            conv_matrix<0>(F, arg_in(args, 7) + (size_t)ly * 512 * 1536, 512, 1536, WB_(WB_QUP), arg_in(args, 5) + ly * 512);
            conv_matrix<0>(F, arg_in(args, 8) + (size_t)ly * 512 * 2048, 512, 2048, WB_(WB_KVUP), arg_in(args, 6) + ly * 512);
            for (int b = 0; b < 3; ++b) conv_matrix<0>(F, arg_in(args, 14) + ((size_t)ly * 3 + b) * 1024 * DM, 1024, DM, WB_(WB_BR) + (size_t)b * DM * 1024, nullptr);
            conv_matrix<0>(F, arg_in(args, 15) + (size_t)ly * DM * DM, DM, DM, WB_(WB_O), nullptr);
            conv_matrix<2>(F, arg_in(args, 17) + (size_t)ly * DM * 2 * DFF, DM, 2 * DFF, WB_(WB_F1), arg_in(args, 16) + ly * DM);
            conv_matrix<0>(F, arg_in(args, 18) + (size_t)ly * DFF * DM, DFF, DM, WB_(WB_F2), nullptr);
            unsigned zu = 0u; asm volatile("" : "+v"(zu)); const float zf = __uint_as_float(zu);
            for (int i = F.gw * 64 + F.lane; i < 112 * 2048 / 8; i += F.ngw * 64) *((u32x4*)(WB_(WB_IN) + (size_t)1168 * 2048) + i) = (u32x4){zu, zu, zu, zu};
            if (F.bid == 0) { const int i = F.tid; const int t = i >> 7, ps = i & 127, dim = (ps >> 1) + 64 * (ps & 1);
                const float* gsrc = (t < 2 ? arg_in(args, 10) : arg_in(args, 11)) + ly * 256 + (t & 1) * 128; GPERM_[i] = gsrc[dim]; }
            float* hmeta = HMETA_;
            if (ly == 0) {
                for (int i = F.gw * 64 + F.lane; i < MROW0 * PW / 8; i += F.ngw * 64) *((u32x4*)P_ + i) = (u32x4){zu, zu, zu, zu};
                for (int i = F.gw * 64 + F.lane; i < MBLK * DM / 4; i += F.ngw * 64) { const int rr = i / (DM / 4); f32x4 v = (f32x4){zf, zf, zf, zf};
                    if (rr >= MBLK - NMETA) v = *((const f32x4*)meta + (i - (MBLK - NMETA) * (DM / 4))); *((f32x4*)hmeta + i) = v; }
            }
            if (ly == 0) {
                const float* xin = arg_in(args, 0); bf16_t* XN = XN_; float* rs0 = RS_(0);
                for (int r = MROW0 + F.gw; r < R; r += F.ngw)
                    norm_row(r < MBLK ? meta + (size_t)(r - MROW0) * DM : xin + (size_t)(r - MBLK) * DM, XN + (size_t)r * DM, rs0 + r, F.lane);
            }
            }
            SEAM(pb + 0);
        }
        if (((PHMASK >> 1) & 1) && IN(pb + 1)) {
            PH_BEGIN;
            { SkP f{P_, 0, RS_(2 * ly)}; skinny_gemm(F.lds, XN_ + (size_t)MROW0 * DM, DM, WB_(WB_IN), DM, 1280 / 16, F.bid, F.G, f); }
            SchedPlain S{XN_, DM, WB_(WB_IN), DM, NPMM, 5, F.G, F.bid, 0}; EpiP E{P_, RS_(2 * ly)};
            pg8::gemm_phase(F.lds, S, E);
            if (NREP(1) == 2) { GRID_BAR(); pg8::gemm_phase(F.lds, S, E); }
            SEAM(pb + 1);
        }
        if (((PHMASK >> 2) & 1) && IN(pb + 2)) {
            PH_BEGIN;
            { bf16_t* P = P_; float* rq = RSTDQ_; float* rkv = RSTDKV_;
              for (int r = MROW0 + F.gw; r < R; r += F.ngw) post1a_row(P, r, rq, rkv, F.lane); }
            VM_WAIT(); __syncthreads();
            { SkP f{P_, C_QRAW, nullptr}; skinny_gemm(F.lds, P_ + (size_t)MROW0 * PW + C_CQ, PW, WB_(WB_QUP), 512, 1536 / 16, F.bid, F.G, f); }
            { SkP f{P_, C_KVRAW, nullptr}; skinny_gemm(F.lds, P_ + (size_t)MROW0 * PW + C_CKV, PW, WB_(WB_KVUP), 512, 2048 / 16, F.bid, F.G, f); }
            SchedMlaUp S{P_, WB_(WB_QUP), WB_(WB_KVUP), F.G, F.bid}; EpiP E{P_, nullptr};
            pg8::gemm_phase(F.lds, S, E);
            if (NREP(2) == 2) { GRID_BAR(); pg8::gemm_phase(F.lds, S, E); }
            SEAM(pb + 2);
        }
        if (((PHMASK >> 3) & 1) && IN(pb + 3)) {
            PH_BEGIN;
            const float* mla_qkg = arg_in(args, 9) + ly * 2 * 192;
            bf16_t* P = P_; float* rq = RSTDQ_; float* rkv = RSTDKV_;
            LAS float* rnl = (LAS float*)(F.lds + F.wave * 64);
            for (int r = MROW0 + F.gw; r < R; r += F.ngw) post2_row(P, r, rq, rkv, mla_qkg, rnl, F.lane);
            SEAM(pb + 3);
        }
        if (((PHMASK >> 4) & 1) && IN(pb + 4)) {
            PH_BEGIN;
            bf16_t* P = P_;
            LAS int* slot = (LAS int*)(F.lds + LDSCTL_OFF + 128);
            for (int rep_ = 0; rep_ < NREP(4); ++rep_) { if (rep_) GRID_BAR();
            unsigned* ctr = (unsigned*)(ws + WS_CTL) + CW_Q + 64 * (ly * 4 + 0) + 64 * 16 * rep_;
            const bool stat = (F.G == 256); const int sx = F.bid & 7, spl = (F.bid >> 3) >> 2, sj = (F.bid >> 3) & 3;
            if (!stat) fa::queue_prime(ctr, slot);
            for (int qk_ = 0;; ++qk_) {
                int idx;
                if (stat) { if (qk_ < 4) { const int pr = sx + 8 * (spl + 8 * (qk_ >> 1)), qb = (qk_ & 1) ? sj : 7 - sj; idx = (7 - qb) * 128 + pr; } else idx = (qk_ == 4 && F.bid < 8) ? 1024 + F.bid : 1 << 30; }
                else idx = fa::queue_next(ctr, slot, qk_);
                if (idx >= 8 * 129) break;
                int h; fa::Item it;
                if (idx < 1024) { const int qb = 7 - (idx >> 7), rest = idx & 127; h = rest & 7; it = fa::make_item(false, rest >> 3, qb); } else { h = idx - 1024; it = fa::make_item(true, 0, 0); }
                bf16x8 qr[12]; fa::load_q<192>(P, it, C_QRAW + h * 192, qr);
                fa::attn_core<192, 128, false>(P, it, qr, C_KVRAW + h * 256, C_KPEH + h * 64, C_KVRAW + h * 256 + 128, C_OA + h * 128, 0, nullptr, F.lds);
            } }
            SEAM(pb + 4);
        }
        if (((PHMASK >> 5) & 1) && IN(pb + 5)) {
            PH_BEGIN;
            { SkP f{P_, 1280, RS_(2 * ly)}; skinny_gemm(F.lds, XN_ + (size_t)MROW0 * DM, DM, WB_(WB_IN) + (size_t)1280 * DM, DM, 7168 / 16, F.bid, F.G, f); }
            SchedPlain S{XN_, DM, WB_(WB_IN) + (size_t)1280 * DM, DM, NPMM, 28, F.G, F.bid, 1280}; EpiG2 E{P_, RS_(2 * ly), GPERM_, (LAS float*)(F.lds + RING_BYTES)};
            pg8::gemm_phase(F.lds, S, E);
            if (NREP(5) == 2) { GRID_BAR(); pg8::gemm_phase(F.lds, S, E); }
            SEAM(pb + 5);
        }
        if (((PHMASK >> 6) & 1) && IN(pb + 6)) {
            PH_BEGIN;
            bf16_t* P = P_; const float* gp = GPERM_;
            if (F.gw < NMETA) meta_post_row(P, MROW0 + F.gw, gp, F.lane);
            SEAM(pb + 6);
        }
        if (((PHMASK >> 7) & 1) && IN(pb + 7)) {
            PH_BEGIN;
            bf16_t* P = P_; unsigned* bm = BM_;
            unsigned* ctr = (unsigned*)(ws + WS_CTL) + CW_Q + 64 * (ly * 4 + 2);
            LAS int* slot = (LAS int*)(F.lds + LDSCTL_OFF + 128);
            for (int rep_ = 0; rep_ < NREP(7); ++rep_) { if (rep_) GRID_BAR(); unsigned* c2 = ctr + 64 * 16 * rep_;
            for (;;) { const int idx = fa::next_item(c2, slot); if (idx >= NTOK / 8) break; index_unit(P, idx, bm, F.lds); } }
            SEAM(pb + 7);
        }
        if (((PHMASK >> 8) & 1) && IN(pb + 8)) {
            PH_BEGIN;
            bf16_t* P = P_; unsigned* bm = BM_;
            LAS int* slot = (LAS int*)(F.lds + LDSCTL_OFF + 128);
            for (int rep_ = 0; rep_ < NREP(8); ++rep_) { if (rep_) GRID_BAR();
            const bool dummy = (NREP(8) == 2) && rep_ == 0;
            unsigned* ctr = (unsigned*)(ws + WS_CTL) + CW_Q + 64 * (ly * 4 + 1) + 64 * 16 * rep_;
            const bool stat = (F.G == 256); const int sx = F.bid & 7, spl = (F.bid >> 3) >> 2, sj = (F.bid >> 3) & 3;
            if (!stat) fa::queue_prime(ctr, slot);
            for (int qk_ = 0;; ++qk_) {
                int idx;
                if (stat) { if (qk_ < 8) { const int pr = sx + 8 * (spl + 8 * ((qk_ >> 1) & 1)), qb = (qk_ & 1) ? sj : 7 - sj; idx = (7 - qb) * 256 + ((qk_ >> 2) ? 128 : 0) + pr; } else idx = (qk_ == 8 && F.bid < 16) ? 2048 + F.bid : 1 << 30; }
                else idx = fa::queue_next(ctr, slot, qk_);
                if (idx >= 16 * 129) break;
                int hh; bool meta = false; fa::Item it; int b = 0, qb = 0;
                if (idx < 2048) { qb = 7 - (idx >> 8); const int rest = idx & 255; hh = (rest < 128) ? 8 + (rest & 7) : (rest & 7); b = (rest & 127) >> 3; it = fa::make_item(false, b, qb); }
                else { hh = idx - 2048; hh = hh < 8 ? 8 + hh : hh - 8; meta = true; it = fa::make_item(true, 0, 0); }
                if (hh < 8) {
                    bf16x8 qr[8]; fa::load_q<128>(P, it, C_DQ + hh * 128, qr);
                    fa::attn_core<128, 128, true>(P, it, qr, C_DK + hh * 128, 0, C_DV + hh * 128, dummy ? C_KPE : C_OB + hh * 128, 0, meta ? nullptr : bm + (size_t)(b * SEQ + qb * 256) * BMW, F.lds);
                } else {
                    const int hj = hh - 8;
                    bf16x8 qr[8]; fa::load_q<128>(P, it, C_FQ + hj * 128, qr);
                    fa::attn_core<128, 256, false>(P, it, qr, C_FK + hj * 128, 0, C_FV + (hj >> 1) * 256, dummy ? C_KPE : C_FQ + hj * 128, dummy ? C_KPE : C_IQ + hj * 128, nullptr, F.lds);
                }
            } }
            SEAM(pb + 8);
        }
        if (((PHMASK >> 9) & 1) && IN(pb + 9)) {
            PH_BEGIN;
            const float* diff_lam = arg_in(args, 12) + ly * 4 * 128; const float* diff_subg = arg_in(args, 13) + ly * 256;
            const float lambda_init = LAMBDA_INIT(ly);
            const float s1 = wave_sum(diff_lam[F.lane] * diff_lam[128 + F.lane] + diff_lam[64 + F.lane] * diff_lam[192 + F.lane]);
            const float s2 = wave_sum(diff_lam[256 + F.lane] * diff_lam[384 + F.lane] + diff_lam[320 + F.lane] * diff_lam[448 + F.lane]);
            const float lam = __expf(s1) - __expf(s2) + lambda_init;
            bf16_t* P = P_;
            for (int r = MROW0 + F.gw; r < R; r += F.ngw) post3_row(P, r, diff_subg, lam, 1.f - lambda_init, F.lane);
        }
#define GATE_PHASE(k, b) \
        if (((PHMASK >> 10) & 1) && IN(pb + (k))) { \
            PH_BEGIN; \
            { SkGate f{(bf16_t*)(ws + WS_GS), arg_in(args, 4) + ly * 3 * DM + (b) * DM, RS_(2 * ly)}; skinny_gemm(F.lds, XN_ + (size_t)MROW0 * DM, DM, WB_(WB_G) + (size_t)(b) * 2048 * DM, DM, 2048 / 16, F.bid, F.G, f); } \
            SchedPlain S{XN_, DM, WB_(WB_G) + (size_t)(b) * 2048 * DM, DM, NPMM, 8, F.G, F.bid, 0}; EpiGate E{(bf16_t*)(ws + WS_GS), arg_in(args, 4) + ly * 3 * DM + (b) * DM, RS_(2 * ly)}; \
            pg8::gemm_phase(F.lds, S, E); \
            if (NREP(k) == 2) { GRID_BAR(); pg8::gemm_phase(F.lds, S, E); } \
            SEAM(pb + (k)); \
        }
#define BRANCH_PHASE(k, b, oc) \
        if (((PHMASK >> 10) & 1) && IN(pb + (k))) { \
            PH_BEGIN; \
            { SkGated f{P_, (const bf16_t*)(ws + WS_GS), (b) == 0 ? 1 : 0}; skinny_gemm(F.lds, P_ + (size_t)MROW0 * PW + (oc), PW, WB_(WB_BR) + (size_t)(b) * DM * 1024, 1024, 2048 / 16, F.bid, F.G, f); } \
            SchedPlain S{P_ + (oc), PW, WB_(WB_BR) + (size_t)(b) * DM * 1024, 1024, NPMM, 8, F.G, F.bid, C_MERGED}; EpiGated E{P_, (const bf16_t*)(ws + WS_GS), (b) == 0 ? 1 : 0, ((DBG_BM >> (b)) & 1) ? 1.f : 0.f}; \
            pg8::gemm_phase(F.lds, S, E); \
            if (NREP(k) == 2 && (b) == 0) { GRID_BAR(); pg8::gemm_phase(F.lds, S, E); } \
            SEAM(pb + (k)); \
        }
        GATE_PHASE(10, 0) BRANCH_PHASE(11, 0, C_OA)
        GATE_PHASE(12, 1) BRANCH_PHASE(13, 1, C_OB)
        GATE_PHASE(14, 2) BRANCH_PHASE(15, 2, C_OC)
        if (((PHMASK >> 11) & 1) && IN(pb + 16)) {
            PH_BEGIN;
            { SkRes f{HMETA_, XN_, RS_(2 * ly + 1)}; skinny_gemm(F.lds, P_ + (size_t)MROW0 * PW + C_MERGED, PW, WB_(WB_O), DM, 2048 / 16, F.bid, F.G, f); }
            SchedPlain S{P_ + C_MERGED, PW, WB_(WB_O), DM, NPMM, 8, F.G, F.bid, 0}; EpiRes E{HSRC_TOK(ly), OUT_, HMETA_, DBG_SA, XN_, RS_(2 * ly + 1)};
            pg8::gemm_phase(F.lds, S, E);
            SEAM(pb + 16);
        }
        if (((PHMASK >> 13) & 1) && IN(pb + 17)) {
            PH_BEGIN;
            skinny_swiglu(F.lds, XN_ + (size_t)MROW0 * DM, DM, WB_(WB_F1), DM, P_, RS_(2 * ly + 1), F.bid, F.G);
            SchedPlain S{XN_, DM, WB_(WB_F1), DM, NPMM, 44, F.G, F.bid, 0}; EpiSwiglu E{P_, RS_(2 * ly + 1)};
            pg8::gemm_phase(F.lds, S, E);
            if (NREP(17) == 2) { GRID_BAR(); pg8::gemm_phase(F.lds, S, E); }
            SEAM(pb + 17);
        }
        if (((PHMASK >> 14) & 1) && IN(pb + 18)) {
            PH_BEGIN;
            { SkRes f{HMETA_, ly == 0 ? XN_ : (bf16_t*)nullptr, RS_(2)}; skinny_gemm(F.lds, P_ + (size_t)MROW0 * PW, PW, WB_(WB_F2), DFF, 2048 / 16, F.bid, F.G, f); }
            SchedPlain S{P_, PW, WB_(WB_F2), DFF, NPMM, 8, F.G, F.bid, 0}; EpiRes E{OUT_, OUT_, HMETA_, DBG_SF, ly == 0 ? XN_ : (bf16_t*)nullptr, RS_(2)};
            pg8::gemm_phase(F.lds, S, E);
            SEAM(pb + 18);
        }
    }
#undef IN
#undef SEAM
}

__global__ void diag_fill(float* out, int n, float v) { for (int i = blockIdx.x * blockDim.x + threadIdx.x; i < n; i += gridDim.x * blockDim.x) out[i] = v; }
extern "C" void kernel_launch(void* const* d_in, const int* in_sizes, int n_in, void* d_out, int out_size, void* d_ws, size_t ws_size, hipStream_t stream) {
    static int grid = 0; static float code = 0.f;
    if (grid == 0) {
        int dev = 0, cus = 0;
        if (n_in != 19) { code = 10.f; grid = -1; }
        else if (ws_size < WS_END) { code = 20.f + (float)(ws_size >> 20) * 0.01f; grid = -1; }
        else if (hipGetDevice(&dev) != hipSuccess || hipDeviceGetAttribute(&cus, hipDeviceAttributeMultiprocessorCount, dev) != hipSuccess) { code = 40.f; grid = -1; }
        else if (hipFuncSetAttribute((const void*)mega_fwd, hipFuncAttributeMaxDynamicSharedMemorySize, LDS_BYTES) != hipSuccess) { code = 50.f; grid = -1; }
        else {
            int per_cu = 0;
            if (hipOccupancyMaxActiveBlocksPerMultiprocessor(&per_cu, (const void*)mega_fwd, NWAVES * 64, LDS_BYTES) != hipSuccess || per_cu < 1) { code = 60.f; grid = -1; }
            (void)hipGetLastError();
            if (grid == 0) grid = cus;
        }
    }
    if (grid < 0) { hipLaunchKernelGGL(diag_fill, dim3(1024), dim3(256), 0, stream, (float*)d_out, out_size, code); return; }
    (void)hipMemsetAsync((char*)d_ws + WS_CTL, 0, CTL_BYTES, stream);
    Args a{};
    for (int i = 0; i < 19; ++i) a.in[i] = (const float*)d_in[i];
    a.out = (float*)d_out; a.ws = (unsigned char*)d_ws;
#if MK_ONE_LAUNCH
    a.ph_lo = 0; a.ph_hi = N_PHASES;
    hipLaunchKernelGGL(mega_fwd, dim3(grid), dim3(NWAVES * 64), LDS_BYTES, stream, a);
#else
    for (int p = 0; p < N_PHASES; ++p) { a.ph_lo = p; a.ph_hi = p + 1; hipLaunchKernelGGL(mega_fwd, dim3(grid), dim3(NWAVES * 64), LDS_BYTES, stream, a); }
#endif
    if (hipPeekAtLastError() != hipSuccess) { (void)hipGetLastError(); hipLaunchKernelGGL(diag_fill, dim3(1024), dim3(256), 0, stream, (float*)d_out, out_size, 70.f); }
}
```

```cpp
#include <hip/hip_runtime.h>
#include <cstdio>
#include <cstdint>

#ifndef PHMASK
#define PHMASK 0x7fff
#endif
#ifndef REPMASK
#define REPMASK 0
#endif
#define NREP(k) ((((REPMASK) >> (k)) & 1) ? 2 : 1)
#ifndef DBG_BM
#define DBG_BM 7
#endif
#ifndef DBG_BR
#define DBG_BR 0
#endif
#ifndef DBG_SA
#define DBG_SA 1.0f
#endif
#ifndef DBG_SF
#define DBG_SF 1.0f
#endif
#ifndef MK_ONE_LAUNCH
#define MK_ONE_LAUNCH 1
#endif

#define LAS __attribute__((address_space(3)))
#define GAS __attribute__((address_space(1)))
typedef unsigned short bf16_t;
typedef short bf16x8 __attribute__((ext_vector_type(8)));
typedef float f32x4 __attribute__((ext_vector_type(4)));
typedef float f32x2 __attribute__((ext_vector_type(2)));
typedef unsigned u32x4 __attribute__((ext_vector_type(4)));
typedef unsigned u32x2 __attribute__((ext_vector_type(2)));

constexpr int DM = 2048, NB = 16, SEQ = 2048, NMETA = 16, MBLK = 256;
constexpr int R = MBLK + NB * SEQ;
constexpr int NPM = R / 256;
constexpr int NPMM = NPM - 1;
constexpr int MROW0 = MBLK - NMETA;
constexpr int NTOK = NB * SEQ;
constexpr int DFF = 5632;
constexpr int PW = 8448;
constexpr int C_CQ = 0, C_CKV = 512, C_KPE = 1024, C_IK = 1088, C_IW = 1152, C_DQ = 1280, C_DK = 2304, C_DV = 3328, C_IQ = 4352,
              C_FQ = 5376, C_FK = 6400, C_FV = 7424;
constexpr int C_KVRAW = 1280, C_QRAW = 3328, C_KPEH = 4864;
constexpr int C_OA = 0, C_OB = C_DQ, C_OC = C_FQ, C_MERGED = 2304;
constexpr int BMW = 66;
constexpr float EPS = 1e-6f;
constexpr float LOG2E = 1.4426950408889634f;
constexpr float C2_128 = 0.08838834764831845f * LOG2E;
constexpr float C2_192 = 0.07216878364870323f * LOG2E;
constexpr int D_IN = 14480;

constexpr size_t MiB = 1u << 20;
constexpr size_t WS_CTL = 0, CTL_BYTES = 1 * MiB;
constexpr size_t WS_RSTD = 1 * MiB;
constexpr size_t WS_HMETA = 2 * MiB;
constexpr size_t WS_BM = 4 * MiB;
constexpr size_t WS_WB = 16 * MiB;
constexpr size_t WB_IN = 0, WB_G = WB_IN + (size_t)8448 * 2048 * 2, WB_QUP = WB_G + (size_t)6144 * 2048 * 2, WB_KVUP = WB_QUP + (size_t)1536 * 512 * 2,
                 WB_BR = WB_KVUP + (size_t)2048 * 512 * 2, WB_O = WB_BR + (size_t)3 * 2048 * 1024 * 2, WB_F1 = WB_O + (size_t)2048 * 2048 * 2,
                 WB_F2 = WB_F1 + (size_t)11264 * 2048 * 2, WB_END = WB_F2 + (size_t)2048 * 5632 * 2;
constexpr size_t WS_XN = 164 * MiB;
constexpr size_t WS_P = 294 * MiB;
constexpr size_t WS_GS = 828 * MiB;
constexpr size_t WS_END = 960 * MiB;
static_assert(WS_GS + (size_t)R * 2048 * 2 <= WS_END && WS_WB + WB_END <= WS_XN && WS_XN + (size_t)R * 2048 * 2 <= WS_P && WS_P + (size_t)R * PW * 2 <= WS_GS, "ws map");
constexpr int CW_BAR = 4096, CW_Q = 16384;
constexpr size_t WS_RS = 256 * 1024;

__device__ __forceinline__ float bf2f(bf16_t v) { return __uint_as_float((unsigned)v << 16); }
__device__ __forceinline__ unsigned f2bf(float f) { unsigned u = __float_as_uint(f); return (u + 0x7fffu + ((u >> 16) & 1u)) >> 16; }
__device__ __forceinline__ unsigned pk2(float lo, float hi) { return f2bf(lo) | (f2bf(hi) << 16); }
typedef __bf16 bf16x2_t __attribute__((ext_vector_type(2)));
__device__ __forceinline__ unsigned cvt_pk_bf16(float lo, float hi) { f32x2 v = {lo, hi}; bf16x2_t b = __builtin_convertvector(v, bf16x2_t); return __builtin_bit_cast(unsigned, b); }
__device__ __forceinline__ float wave_sum(float v) {
#pragma unroll
    for (int o = 1; o < 64; o <<= 1) v += __shfl_xor(v, o);
    return v;
}
__device__ __forceinline__ float wave_max(float v) {
#pragma unroll
    for (int o = 1; o < 64; o <<= 1) v = fmaxf(v, __shfl_xor(v, o));
    return v;
}
#define LDS_WAIT() asm volatile("s_waitcnt lgkmcnt(0)" ::: "memory")
#define VM_WAIT() asm volatile("s_waitcnt vmcnt(0)" ::: "memory")
__device__ __forceinline__ int row_pos(int r) { return r < MBLK ? (r >= MBLK - NMETA ? r - (MBLK - NMETA) : 0) : NMETA + ((r - MBLK) & (SEQ - 1)); }
__device__ __forceinline__ void rope_cs(int pos, int i, float two_over_d, float& c, float& s) {
    const float inv = __builtin_amdgcn_exp2f(-(float)i * two_over_d * 13.287712379549449f);
    float rev = (float)pos * inv * 0.15915494309189535f;
    rev -= floorf(rev);
    s = __builtin_amdgcn_sinf(rev); c = __builtin_amdgcn_cosf(rev);
}

namespace pg8 {
constexpr int BM = 256, BK = 64, HALF = 128, HTB = HALF * BK * 2, STAGE_BYTES = 8 * HTB;
__device__ __forceinline__ int lds_byte(int r, int c) { const int st = (r >> 4) * 2 + (c >> 5), rr = r & 15, cc = c & 31, ob = rr * 64 + cc * 2; return st * 1024 + (ob ^ (((ob >> 9) & 1) << 5)); }
__device__ __forceinline__ void stage_rc(int b, int& R_, int& C_) { const int st = b / 1024, sb = b % 1024, swz = sb ^ (((sb >> 9) & 1) << 5); R_ = (st >> 1) * 16 + swz / 64; C_ = (st & 1) * 32 + (swz % 64) / 2; }
__device__ __forceinline__ int perm32(int rho) { const int n = rho >> 4, i = rho & 15; return 8 * (i >> 2) + 4 * n + (i & 3); }

struct Unit { const char* A; const char* B; unsigned lda2, ldb2; int nt, pm, pn, kind, ocol; };

#ifndef WGM
#define WGM 4
#endif
__device__ __forceinline__ void tile_of(int L, int nM, int nN, int& pm, int& pn) {
    const int nwg = nM * nN; int wgid = L;
    { const int q = nwg / 8, r = nwg % 8, xcd = wgid % 8, off = wgid / 8; wgid = (xcd < r ? xcd * (q + 1) : r * (q + 1) + (xcd - r) * q) + off; }
    const int nig = WGM * nN, gid = wgid / nig, fm = gid * WGM, gsz = (nM - fm) < WGM ? (nM - fm) : WGM;
    pm = fm + ((wgid % nig) % gsz); pn = (wgid % nig) / gsz;
}

template <class Epi, class Sched>
__device__ __forceinline__ void gemm_phase(LAS unsigned char* lds, const Sched& S, const Epi& E) {
    int tid = threadIdx.x; asm volatile("" : "+v"(tid));
    const int wid = __builtin_amdgcn_readfirstlane(tid >> 6), lane = tid & 63, wr = wid >> 2, wc = wid & 3, fr = lane & 15, fq = lane >> 4;
    unsigned rA[2], rB[2], cc[2];
#pragma unroll
    for (int i = 0; i < 2; ++i) { int R_, C_; stage_rc(tid * 16 + i * 8192, R_, C_); rA[i] = (unsigned)R_; rB[i] = (unsigned)(Epi::PERM ? ((R_ & ~31) + perm32(R_ & 31)) : R_); cc[i] = (unsigned)C_ * 2u; }
    const size_t kstep = (size_t)(BK * 2);
    const unsigned ldsw = (unsigned)wid * 1024u;
    const int aoff = lds_byte(wr * 64 + fr, fq * 8), boff = lds_byte(wc * 32 + fr, fq * 8);
#define PG8_SA(b, h) (((b) * 2 + (h)) * HTB)
#define PG8_SB(b, h) ((4 + (b) * 2 + (h)) * HTB)
#define PG8_STAGE(bufoff, gbase, rr, ld2) do { _Pragma("unroll") for (int _i = 0; _i < 2; ++_i) \
        __builtin_amdgcn_global_load_lds((const unsigned*)((const char*)(gbase) + ((rr)[_i] * (ld2) + cc[_i])), (LAS unsigned*)(lds + (bufoff) + ldsw + _i * 8192), 16, 0, 0); } while (0)
#define PG8_LDA(dst, b, h) do { _Pragma("unroll") for (int m = 0; m < 4; ++m) _Pragma("unroll") for (int k = 0; k < 2; ++k) dst[m][k] = *(const LAS bf16x8*)(lds + PG8_SA(b, h) + aoff + m * 2048 + k * 1024); } while (0)
#define PG8_LDB(dst, b, h) do { _Pragma("unroll") for (int n = 0; n < 2; ++n) _Pragma("unroll") for (int k = 0; k < 2; ++k) dst[n][k] = *(const LAS bf16x8*)(lds + PG8_SB(b, h) + boff + n * 2048 + k * 1024); } while (0)
#define PG8_MMA(ai, bj, At, Bt) do { __builtin_amdgcn_s_setprio(1); _Pragma("unroll") for (int m = 0; m < 4; ++m) _Pragma("unroll") for (int n = 0; n < 2; ++n) _Pragma("unroll") for (int k = 0; k < 2; ++k) \
        acc[ai][bj][m][n] = __builtin_amdgcn_mfma_f32_16x16x32_bf16(Bt[n][k], At[m][k], acc[ai][bj][m][n], 0, 0, 0); __builtin_amdgcn_s_setprio(0); } while (0)
#define PG8_WAIT_V(n) asm volatile("s_waitcnt vmcnt(" #n ")" ::: "memory")
#define PG8_WAIT_L(n) asm volatile("s_waitcnt lgkmcnt(" #n ")" ::: "memory")
#define PG8_BAR __builtin_amdgcn_s_barrier()
#define PG8_SCHED __builtin_amdgcn_sched_barrier(0)
    Unit cur, nxt; int ui = 0;
    if (!S.next(0, cur)) return;
    float zf = 0.f; asm volatile("" : "+v"(zf));
    f32x4 acc[2][2][4][2];
#pragma unroll
    for (int a = 0; a < 2; ++a)
#pragma unroll
        for (int b = 0; b < 2; ++b)
#pragma unroll
            for (int m = 0; m < 4; ++m)
#pragma unroll
                for (int n = 0; n < 2; ++n) acc[a][b][m][n] = (f32x4){zf, zf, zf, zf};
    bf16x8 At[4][2], B0[2][2], B1[2][2];
    const char* cA = cur.A; const char* cB = cur.B;
    unsigned lA = cur.lda2, lB = cur.ldb2;
    size_t hA = (size_t)HALF * lA, hB = (size_t)HALF * lB;
    PG8_STAGE(PG8_SB(0, 0), cB, rB, lB); PG8_STAGE(PG8_SB(0, 1), cB + hB, rB, lB); PG8_STAGE(PG8_SA(0, 0), cA, rA, lA); PG8_STAGE(PG8_SA(0, 1), cA + hA, rA, lA);
    if (wr == 1) PG8_BAR;
    PG8_WAIT_V(2); PG8_BAR;
    PG8_STAGE(PG8_SB(1, 0), cB + kstep, rB, lB); PG8_STAGE(PG8_SA(1, 0), cA + kstep, rA, lA); PG8_STAGE(PG8_SB(1, 1), cB + hB + kstep, rB, lB);
    PG8_WAIT_V(6); PG8_BAR;
    for (;;) {
        const bool has_next = S.next(ui + 1, nxt);
        if (!has_next) nxt = cur;
        const char* nA = nxt.A; const char* nB = nxt.B;
        const unsigned lAn = nxt.lda2, lBn = nxt.ldb2;
        const size_t hAn = (size_t)HALF * lAn, hBn = (size_t)HALF * lBn;
        const int nt = cur.nt;
        for (int t = 0; t < nt; t += 2) {
            const bool last = (t == nt - 2);
            const char* a1 = cA + (size_t)(t + 1) * kstep;
            const char* a2 = last ? nA : cA + (size_t)(t + 2) * kstep; const char* b2 = last ? nB : cB + (size_t)(t + 2) * kstep;
            const char* a3 = a2 + kstep; const char* b3 = b2 + kstep;
            const size_t hA2 = last ? hAn : hA, hB2 = last ? hBn : hB;
            const unsigned lA2 = last ? lAn : lA, lB2 = last ? lBn : lB;
            PG8_LDB(B0, 0, 0); PG8_LDB(B1, 0, 1); PG8_SCHED; PG8_LDA(At, 0, 0); PG8_STAGE(PG8_SA(1, 1), a1 + hA, rA, lA);
            PG8_WAIT_V(8); PG8_WAIT_L(0); PG8_BAR; PG8_MMA(0, 0, At, B0); PG8_MMA(0, 1, At, B1); PG8_BAR; PG8_SCHED;
            PG8_LDA(At, 0, 1); PG8_STAGE(PG8_SB(0, 0), b2, rB, lB2); PG8_STAGE(PG8_SB(0, 1), b2 + hB2, rB, lB2); PG8_STAGE(PG8_SA(0, 0), a2, rA, lA2);
            PG8_WAIT_V(8); PG8_WAIT_L(0); PG8_BAR; PG8_MMA(1, 0, At, B0); PG8_MMA(1, 1, At, B1); PG8_BAR; PG8_SCHED;
            PG8_LDB(B0, 1, 0); PG8_LDB(B1, 1, 1); PG8_SCHED; PG8_LDA(At, 1, 0); PG8_STAGE(PG8_SA(0, 1), a2 + hA2, rA, lA2);
            PG8_WAIT_V(8); PG8_WAIT_L(0); PG8_BAR; PG8_MMA(0, 0, At, B0); PG8_MMA(0, 1, At, B1); PG8_BAR; PG8_SCHED;
            PG8_LDA(At, 1, 1); PG8_STAGE(PG8_SB(1, 0), b3, rB, lB2); PG8_STAGE(PG8_SB(1, 1), b3 + hB2, rB, lB2); PG8_STAGE(PG8_SA(1, 0), a3, rA, lA2);
            PG8_WAIT_V(8); PG8_WAIT_L(0); PG8_BAR; PG8_MMA(1, 0, At, B0); PG8_MMA(1, 1, At, B1); PG8_BAR; PG8_SCHED;
        }
        if (wr == 0) PG8_BAR;
        E(acc, cur, wr, wc, fr, fq);
#pragma unroll
        for (int a = 0; a < 2; ++a)
#pragma unroll
            for (int b = 0; b < 2; ++b)
#pragma unroll
                for (int m = 0; m < 4; ++m)
#pragma unroll
                    for (int n = 0; n < 2; ++n) acc[a][b][m][n] = (f32x4){zf, zf, zf, zf};
        if (!has_next) break;
        cur = nxt; cA = nA; cB = nB; hA = hAn; hB = hBn; lA = lAn; lB = lBn; ++ui;
        if (wr == 1) PG8_BAR;
    }
    PG8_WAIT_V(0);
    PG8_BAR;
#undef PG8_SA
#undef PG8_SB
#undef PG8_STAGE
#undef PG8_LDA
#undef PG8_LDB
#undef PG8_MMA
#undef PG8_WAIT_V
#undef PG8_WAIT_L
#undef PG8_BAR
#undef PG8_SCHED
}
}
using pg8::Unit;

struct SchedPlain {
    const bf16_t* A; int lda; const bf16_t* B; int K; int nM, nN, G, c, ocol0;
    __device__ __forceinline__ bool next(int i, Unit& u) const {
        const int L = i * G + c; if (L >= nM * nN) return false;
        int pm, pn; pg8::tile_of(L, nM, nN, pm, pn); pm += 1;
        u.pm = pm; u.pn = pn; u.kind = 0; u.ocol = ocol0 + 256 * pn; u.nt = K / 64; u.lda2 = (unsigned)lda * 2u; u.ldb2 = (unsigned)K * 2u;
        u.A = (const char*)(A + (size_t)pm * 256 * lda); u.B = (const char*)(B + (size_t)pn * 256 * K); return true;
    }
};
struct SchedMlaUp {
    const bf16_t* P; const bf16_t* Wq; const bf16_t* Wkv; int G, c;
    __device__ __forceinline__ bool next(int i, Unit& u) const {
        const int L = i * G + c; if (L >= NPMM * 14) return false;
        int pm, pn; pg8::tile_of(L, NPMM, 14, pm, pn); pm += 1;
        u.pm = pm; u.pn = pn; u.kind = 0; u.nt = 8; u.lda2 = PW * 2u; u.ldb2 = 512 * 2u;
        if (pn < 6) { u.A = (const char*)(P + (size_t)pm * 256 * PW + C_CQ); u.B = (const char*)(Wq + (size_t)pn * 256 * 512); u.ocol = C_QRAW + 256 * pn; }
        else { u.A = (const char*)(P + (size_t)pm * 256 * PW + C_CKV); u.B = (const char*)(Wkv + (size_t)(pn - 6) * 256 * 512); u.ocol = C_KVRAW + 256 * (pn - 6); }
        return true;
    }
};
struct EpiP {
    static constexpr bool PERM = true;
    bf16_t* P; const float* rs;
    __device__ __forceinline__ void operator()(const f32x4 (&acc)[2][2][4][2], const Unit& u, int wr, int wc, int fr, int fq) const {
        asm volatile("" : "+v"(fr), "+v"(fq));
        const int row0 = u.pm * 256 + wr * 64 + fr, col0 = u.ocol + wc * 32 + 8 * fq;
#pragma unroll
        for (int ai = 0; ai < 2; ++ai)
#pragma unroll
            for (int m = 0; m < 4; ++m) { bf16_t* rowp = P + (size_t)(row0 + ai * 128 + m * 16) * PW + col0;
                const float sc = rs ? __builtin_amdgcn_rsqf(rs[row0 + ai * 128 + m * 16] * (1.f / DM) + EPS) : 1.f;
#pragma unroll
                for (int bj = 0; bj < 2; ++bj) { const f32x4 v0 = acc[ai][bj][m][0] * sc, v1 = acc[ai][bj][m][1] * sc;
                    u32x4 w; w.x = cvt_pk_bf16(v0[0], v0[1]); w.y = cvt_pk_bf16(v0[2], v0[3]); w.z = cvt_pk_bf16(v1[0], v1[1]); w.w = cvt_pk_bf16(v1[2], v1[3]);
                    *(u32x4*)(rowp + bj * 128) = w; } }
    }
};
struct EpiG2 {
    static constexpr bool PERM = true;
    bf16_t* P; const float* rs; const float* gperm; LAS float* xl;
    __device__ __forceinline__ void operator()(const f32x4 (&acc)[2][2][4][2], const Unit& u, int wr, int wc, int fr, int fq) const {
        asm volatile("" : "+v"(fr), "+v"(fq));
        const int row0 = u.pm * 256 + wr * 64 + fr, lcol = wc * 32 + 8 * fq, col0 = u.ocol + lcol;
        const int pn = u.pn;
        const bool plain = (pn >= 8 && pn < 12) || pn >= 24, isidx = (pn >= 12 && pn < 16), nrm = !plain && !isidx;
        float rsc[2][4];
#pragma unroll
        for (int ai = 0; ai < 2; ++ai)
#pragma unroll
            for (int m = 0; m < 4; ++m) rsc[ai][m] = __builtin_amdgcn_rsqf(rs[row0 + ai * 128 + m * 16] * (1.f / DM) + EPS);
        if (nrm) {
#pragma unroll
            for (int ai = 0; ai < 2; ++ai)
#pragma unroll
                for (int m = 0; m < 4; ++m)
#pragma unroll
                    for (int bj = 0; bj < 2; ++bj) { const f32x4 a = acc[ai][bj][m][0], b = acc[ai][bj][m][1]; float ss = (a[0] * a[0] + a[1] * a[1]) + (a[2] * a[2] + a[3] * a[3]) + (b[0] * b[0] + b[1] * b[1]) + (b[2] * b[2] + b[3] * b[3]);
                        ss += __shfl_xor(ss, 16); ss += __shfl_xor(ss, 32);
                        if (fq == 0) xl[((wr * 64 + fr + ai * 128 + m * 16) * 2 + bj) * 4 + wc] = ss * rsc[ai][m] * rsc[ai][m]; }
            asm volatile("s_waitcnt lgkmcnt(0)" ::: "memory"); __builtin_amdgcn_s_barrier(); asm volatile("" ::: "memory");
        }
        const int i0 = isidx ? (16 * (wc & 1) + 4 * fq) : (16 * wc + 4 * fq);
        const float tod = isidx ? (2.f / 64.f) : (2.f / 128.f);
        float inv[4];
#pragma unroll
        for (int j = 0; j < 4; ++j) inv[j] = __builtin_amdgcn_exp2f(-(float)(i0 + j) * tod * 13.287712379549449f) * 0.15915494309189535f;
        const int gidx = pn < 4 ? 0 : (pn < 8 ? 1 : (pn < 20 ? 2 : 3));
        const float qscale = (pn < 4 || (pn >= 16 && pn < 20)) ? C2_128 : 1.f;
        f32x4 g0 = (f32x4){1.f, 1.f, 1.f, 1.f}, g1 = g0;
        if (nrm) { g0 = *(const f32x4*)(gperm + gidx * 128 + lcol); g1 = *(const f32x4*)(gperm + gidx * 128 + lcol + 4); }
#pragma unroll
        for (int ai = 0; ai < 2; ++ai)
#pragma unroll
            for (int m = 0; m < 4; ++m) { const int row = row0 + ai * 128 + m * 16; bf16_t* rowp = P + (size_t)row * PW + col0;
                float cs[4], sn[4];
                if (!plain) { const float pos = (float)(NMETA + ((row - MBLK) & (SEQ - 1)));
#pragma unroll
                    for (int j = 0; j < 4; ++j) { float rev = pos * inv[j]; rev -= floorf(rev); sn[j] = __builtin_amdgcn_sinf(rev); cs[j] = __builtin_amdgcn_cosf(rev); } }
#pragma unroll
                for (int bj = 0; bj < 2; ++bj) { f32x4 v0 = acc[ai][bj][m][0] * rsc[ai][m], v1 = acc[ai][bj][m][1] * rsc[ai][m];
                    if (!plain) {
                        if (nrm) { const LAS f32x4* xp = (const LAS f32x4*)(xl + ((wr * 64 + fr + ai * 128 + m * 16) * 2 + bj) * 4); const f32x4 pp = *xp;
                            const float rn = __builtin_amdgcn_rsqf(((pp[0] + pp[1]) + (pp[2] + pp[3])) * (1.f / 128.f) + EPS); v0 = v0 * (g0 * rn); v1 = v1 * (g1 * rn); }
                        f32x4 w0, w1;
                        w0[0] = v0[0] * cs[0] - v0[1] * sn[0]; w0[1] = v0[1] * cs[0] + v0[0] * sn[0]; w0[2] = v0[2] * cs[1] - v0[3] * sn[1]; w0[3] = v0[3] * cs[1] + v0[2] * sn[1];
                        w1[0] = v1[0] * cs[2] - v1[1] * sn[2]; w1[1] = v1[1] * cs[2] + v1[0] * sn[2]; w1[2] = v1[2] * cs[3] - v1[3] * sn[3]; w1[3] = v1[3] * cs[3] + v1[2] * sn[3];
                        v0 = w0 * qscale; v1 = w1 * qscale; }
                    u32x4 w; w.x = cvt_pk_bf16(v0[0], v0[1]); w.y = cvt_pk_bf16(v0[2], v0[3]); w.z = cvt_pk_bf16(v1[0], v1[1]); w.w = cvt_pk_bf16(v1[2], v1[3]);
                    *(u32x4*)(rowp + bj * 128) = w; } }
    }
};
struct EpiGate {
    static constexpr bool PERM = true;
    bf16_t* G; const float* bias; const float* rs;
    __device__ __forceinline__ void operator()(const f32x4 (&acc)[2][2][4][2], const Unit& u, int wr, int wc, int fr, int fq) const {
        asm volatile("" : "+v"(fr), "+v"(fq));
        const int row0 = u.pm * 256 + wr * 64 + fr, col0 = u.pn * 256 + wc * 32 + 8 * fq;
        float rsc[2][4];
#pragma unroll
        for (int ai = 0; ai < 2; ++ai)
#pragma unroll
            for (int m = 0; m < 4; ++m) rsc[ai][m] = __builtin_amdgcn_rsqf(rs[row0 + ai * 128 + m * 16] * (1.f / DM) + EPS);
#pragma unroll
        for (int bj = 0; bj < 2; ++bj) { const f32x4 bv0 = *(const f32x4*)(bias + col0 + bj * 128), bv1 = *(const f32x4*)(bias + col0 + bj * 128 + 4);
#pragma unroll
            for (int ai = 0; ai < 2; ++ai)
#pragma unroll
                for (int m = 0; m < 4; ++m) { bf16_t* rowp = G + (size_t)(row0 + ai * 128 + m * 16) * 2048 + col0; f32x4 v0 = acc[ai][bj][m][0] * rsc[ai][m] + bv0, v1 = acc[ai][bj][m][1] * rsc[ai][m] + bv1;
#pragma unroll
                    for (int e = 0; e < 4; ++e) { v0[e] = __builtin_amdgcn_rcpf(1.f + __builtin_amdgcn_exp2f(-v0[e] * LOG2E)); v1[e] = __builtin_amdgcn_rcpf(1.f + __builtin_amdgcn_exp2f(-v1[e] * LOG2E)); }
                    u32x4 w; w.x = cvt_pk_bf16(v0[0], v0[1]); w.y = cvt_pk_bf16(v0[2], v0[3]); w.z = cvt_pk_bf16(v1[0], v1[1]); w.w = cvt_pk_bf16(v1[2], v1[3]);
                    *(u32x4*)(rowp + bj * 128) = w; } }
    }
};
struct EpiGated {
    static constexpr bool PERM = true;
    bf16_t* P; const bf16_t* G; int first; float sc;
    __device__ __forceinline__ void operator()(const f32x4 (&acc)[2][2][4][2], const Unit& u, int wr, int wc, int fr, int fq) const {
        asm volatile("" : "+v"(fr), "+v"(fq));
        const int row0 = u.pm * 256 + wr * 64 + fr, lcol0 = u.pn * 256 + wc * 32 + 8 * fq, col0 = u.ocol + wc * 32 + 8 * fq;
        unsigned zu = 0u; asm volatile("" : "+v"(zu));
#pragma unroll
        for (int ai = 0; ai < 2; ++ai)
#pragma unroll
            for (int m = 0; m < 4; ++m) { bf16_t* rowp = P + (size_t)(row0 + ai * 128 + m * 16) * PW + col0; const bf16_t* gp = G + (size_t)(row0 + ai * 128 + m * 16) * 2048 + lcol0;
#pragma unroll
                for (int bj = 0; bj < 2; ++bj) { u32x4 g = *(const u32x4*)(gp + bj * 128); if (DBG_BR == 1) g = (u32x4){0x3f803f80u, 0x3f803f80u, 0x3f803f80u, 0x3f803f80u};
                    u32x4 pv = (u32x4){zu, zu, zu, zu}; if (!first) pv = *(const u32x4*)(rowp + bj * 128);
                    const f32x4 v0 = acc[ai][bj][m][0] * sc, v1 = acc[ai][bj][m][1] * sc;
                    float o[8];
                    o[0] = __uint_as_float(pv.x << 16) + __uint_as_float(g.x << 16) * v0[0]; o[1] = __uint_as_float(pv.x & 0xffff0000u) + __uint_as_float(g.x & 0xffff0000u) * v0[1];
                    o[2] = __uint_as_float(pv.y << 16) + __uint_as_float(g.y << 16) * v0[2]; o[3] = __uint_as_float(pv.y & 0xffff0000u) + __uint_as_float(g.y & 0xffff0000u) * v0[3];
                    o[4] = __uint_as_float(pv.z << 16) + __uint_as_float(g.z << 16) * v1[0]; o[5] = __uint_as_float(pv.z & 0xffff0000u) + __uint_as_float(g.z & 0xffff0000u) * v1[1];
                    o[6] = __uint_as_float(pv.w << 16) + __uint_as_float(g.w << 16) * v1[2]; o[7] = __uint_as_float(pv.w & 0xffff0000u) + __uint_as_float(g.w & 0xffff0000u) * v1[3];
                    u32x4 w; w.x = cvt_pk_bf16(o[0], o[1]); w.y = cvt_pk_bf16(o[2], o[3]); w.z = cvt_pk_bf16(o[4], o[5]); w.w = cvt_pk_bf16(o[6], o[7]);
                    *(u32x4*)(rowp + bj * 128) = w; }
                asm volatile("" ::: "memory"); }
    }
};
struct EpiRes {
    static constexpr bool PERM = false;
    const float* base_tok; float* out_tok; float* hmeta; float dbg; bf16_t* hb; float* rs;
    __device__ __forceinline__ void operator()(const f32x4 (&acc)[2][2][4][2], const Unit& u, int wr, int wc, int fr, int fq) const {
        asm volatile("" : "+v"(fr), "+v"(fq));
        const float* bp; float* op;
        if (u.pm == 0) { bp = hmeta; op = hmeta; } else { bp = base_tok + (size_t)(u.pm - 1) * 256 * DM; op = out_tok + (size_t)(u.pm - 1) * 256 * DM; }
        const int lrow0 = wr * 64 + fr, col0 = u.pn * 256 + wc * 32 + 4 * fq;
#pragma unroll
        for (int ai = 0; ai < 2; ++ai)
#pragma unroll
            for (int m = 0; m < 4; ++m) { const size_t off = (size_t)(lrow0 + ai * 128 + m * 16) * DM + col0;
                const int grow = u.pm * 256 + lrow0 + ai * 128 + m * 16; float ss = 0.f;
#pragma unroll
                for (int bj = 0; bj < 2; ++bj)
#pragma unroll
                    for (int n = 0; n < 2; ++n) { const f32x4 bs = *(const f32x4*)(bp + off + bj * 128 + n * 16); const f32x4 hv = bs + acc[ai][bj][m][n] * dbg; *(f32x4*)(op + off + bj * 128 + n * 16) = hv;
                        if (hb) { ss += (hv[0] * hv[0] + hv[1] * hv[1]) + (hv[2] * hv[2] + hv[3] * hv[3]); u32x2 w; w.x = cvt_pk_bf16(hv[0], hv[1]); w.y = cvt_pk_bf16(hv[2], hv[3]); *(u32x2*)(hb + (size_t)grow * DM + col0 + bj * 128 + n * 16) = w; } }
                if (hb) { ss += __shfl_xor(ss, 16); ss += __shfl_xor(ss, 32); if (fq == 0) (void)__hip_atomic_fetch_add(rs + grow, ss, __ATOMIC_RELAXED, __HIP_MEMORY_SCOPE_AGENT); }
                asm volatile("" ::: "memory"); }
    }
};
struct EpiSwiglu {
    static constexpr bool PERM = true;
    bf16_t* P; const float* rs;
    __device__ __forceinline__ void operator()(const f32x4 (&acc)[2][2][4][2], const Unit& u, int wr, int wc, int fr, int fq) const {
        asm volatile("" : "+v"(fr), "+v"(fq));
        const int row0 = u.pm * 256 + wr * 64 + fr, col0 = u.pn * 128 + wc * 32 + 8 * fq;
#pragma unroll
        for (int ai = 0; ai < 2; ++ai)
#pragma unroll
            for (int m = 0; m < 4; ++m) { bf16_t* rowp = P + (size_t)(row0 + ai * 128 + m * 16) * PW + col0;
                const float sc = __builtin_amdgcn_rsqf(rs[row0 + ai * 128 + m * 16] * (1.f / DM) + EPS);
                float o[8];
#pragma unroll
                for (int n = 0; n < 2; ++n)
#pragma unroll
                    for (int e = 0; e < 4; ++e) { const float g = acc[ai][0][m][n][e] * sc, up = acc[ai][1][m][n][e] * sc; o[n * 4 + e] = g * __builtin_amdgcn_rcpf(1.f + __builtin_amdgcn_exp2f(-g * LOG2E)) * up; }
                u32x4 w; w.x = cvt_pk_bf16(o[0], o[1]); w.y = cvt_pk_bf16(o[2], o[3]); w.z = cvt_pk_bf16(o[4], o[5]); w.w = cvt_pk_bf16(o[6], o[7]);
                *(u32x4*)rowp = w; }
    }
};

struct SkP { bf16_t* P; int ocol; const float* rs; __device__ __forceinline__ void operator()(int r, int c, float v) const { if (rs) v *= __builtin_amdgcn_rsqf(rs[MROW0 + r] * (1.f / DM) + EPS); P[(size_t)(MROW0 + r) * PW + ocol + c] = (bf16_t)f2bf(v); } };
struct SkGate { bf16_t* G; const float* bias; const float* rs; __device__ __forceinline__ void operator()(int r, int c, float v) const { v *= __builtin_amdgcn_rsqf(rs[MROW0 + r] * (1.f / DM) + EPS); G[(size_t)(MROW0 + r) * 2048 + c] = (bf16_t)f2bf(__builtin_amdgcn_rcpf(1.f + __builtin_amdgcn_exp2f(-(v + bias[c]) * LOG2E))); } };
struct SkGated { bf16_t* P; const bf16_t* G; int first; __device__ __forceinline__ void operator()(int r, int c, float v) const { bf16_t* p = P + (size_t)(MROW0 + r) * PW + C_MERGED + c; const float pv = first ? 0.f : bf2f(*p); *p = (bf16_t)f2bf(pv + bf2f(G[(size_t)(MROW0 + r) * 2048 + c]) * v); } };
struct SkRes { float* hmeta; bf16_t* hb; float* rs;
    __device__ __forceinline__ void operator()(int r, int c, float v) const { float* p = hmeta + (size_t)(MROW0 + r) * DM + c; const float hv = *p + v; *p = hv;
        if (hb) { hb[(size_t)(MROW0 + r) * DM + c] = (bf16_t)f2bf(hv); float ss = hv * hv; ss += __shfl_xor(ss, 1); ss += __shfl_xor(ss, 2); ss += __shfl_xor(ss, 4); ss += __shfl_xor(ss, 8);
            if ((threadIdx.x & 15) == 0) (void)__hip_atomic_fetch_add(rs + MROW0 + r, ss, __ATOMIC_RELAXED, __HIP_MEMORY_SCOPE_AGENT); } } };
template <class Fn>
__device__ __forceinline__ void skinny_gemm(LAS unsigned char* lds, const bf16_t* A, int lda, const bf16_t* Bt, int K, int ntask, int bid, int G, const Fn& f) {
    int tid = threadIdx.x; asm volatile("" : "+v"(tid));
    const int wid = __builtin_amdgcn_readfirstlane(tid >> 6), lane = tid & 63, l15 = lane & 15, kq = lane >> 4;
    LAS f32x4* red = (LAS f32x4*)lds;
    const int kw = K / 8;
    for (int task = bid; task < ntask; task += G) {
        const bf16_t* ap = A + (size_t)l15 * lda + wid * kw + kq * 8;
        const bf16_t* bp = Bt + (size_t)(task * 16 + l15) * K + wid * kw + kq * 8;
        float z = 0.f; asm volatile("" : "+v"(z));
        f32x4 acc = (f32x4){z, z, z, z};
        for (int k0 = 0; k0 < kw; k0 += 256) {
            bf16x8 fa[8], fb[8];
#pragma unroll
            for (int i = 0; i < 8; ++i) { const int k = (k0 + 32 * i < kw) ? k0 + 32 * i : 0; fa[i] = *(const bf16x8*)(ap + k); fb[i] = *(const bf16x8*)(bp + k); }
#pragma unroll
            for (int i = 0; i < 8; ++i) if (k0 + 32 * i < kw) acc = __builtin_amdgcn_mfma_f32_16x16x32_bf16(fa[i], fb[i], acc, 0, 0, 0);
        }
        red[wid * 64 + lane] = acc;
        LDS_WAIT(); __syncthreads();
        if (wid == 0) {
            f32x4 s = red[lane];
#pragma unroll
            for (int w = 1; w < 8; ++w) s += red[w * 64 + lane];
#pragma unroll
            for (int r = 0; r < 4; ++r) f(kq * 4 + r, task * 16 + l15, s[r]);
        }
        __syncthreads();
    }
}
__device__ __forceinline__ void skinny_swiglu(LAS unsigned char* lds, const bf16_t* A, int lda, const bf16_t* Bt, int K, bf16_t* P, const float* rs, int bid, int G) {
    int tid = threadIdx.x; asm volatile("" : "+v"(tid));
    const int wid = __builtin_amdgcn_readfirstlane(tid >> 6), lane = tid & 63, l15 = lane & 15, kq = lane >> 4;
    LAS f32x4* red = (LAS f32x4*)lds;
    const int kw = K / 8;
    for (int task = bid; task < DFF / 16; task += G) {
        const int c0 = task * 16, brow = (c0 >> 7) * 256 + (c0 & 127) + l15;
        const bf16_t* ap = A + (size_t)l15 * lda + wid * kw + kq * 8;
        const bf16_t* bg = Bt + (size_t)brow * K + wid * kw + kq * 8; const bf16_t* bu = bg + (size_t)128 * K;
        float z = 0.f; asm volatile("" : "+v"(z));
        f32x4 ag = (f32x4){z, z, z, z}, au = ag;
        {
            bf16x8 fa[8], fg[8], fu[8];
#pragma unroll
            for (int i = 0; i < 8; ++i) { fa[i] = *(const bf16x8*)(ap + 32 * i); fg[i] = *(const bf16x8*)(bg + 32 * i); fu[i] = *(const bf16x8*)(bu + 32 * i); }
#pragma unroll
            for (int i = 0; i < 8; ++i) { ag = __builtin_amdgcn_mfma_f32_16x16x32_bf16(fa[i], fg[i], ag, 0, 0, 0); au = __builtin_amdgcn_mfma_f32_16x16x32_bf16(fa[i], fu[i], au, 0, 0, 0); }
        }
        red[wid * 64 + lane] = ag; red[512 + wid * 64 + lane] = au;
        LDS_WAIT(); __syncthreads();
        if (wid == 0) {
            f32x4 sg = red[lane], su = red[512 + lane];
#pragma unroll
            for (int w = 1; w < 8; ++w) { sg += red[w * 64 + lane]; su += red[512 + w * 64 + lane]; }
#pragma unroll
            for (int r = 0; r < 4; ++r) { const float sc = __builtin_amdgcn_rsqf(rs[MROW0 + kq * 4 + r] * (1.f / DM) + EPS); const float g = sg[r] * sc; su[r] *= sc; P[(size_t)(MROW0 + kq * 4 + r) * PW + c0 + l15] = (bf16_t)f2bf(g * __builtin_amdgcn_rcpf(1.f + __builtin_amdgcn_exp2f(-g * LOG2E)) * su[r]); }
        }
        __syncthreads();
    }
}

#define XB_TMO      128
#define XB_XCNT(j)  (256  + 64 * (j))
#define XB_XSUB(j)  (1280 + 64 * (j))
#define XB_XGEN(j)  (2304 + 64 * (j))
#define XB_TOP      3328
#define XB_TOPGEN   3392
#define XCD_BAR_WORDS 3456
#define XB_SPIN_CAP (1u << 18)
__device__ __forceinline__ unsigned xb_ld(unsigned* p)              { return __hip_atomic_load(p, __ATOMIC_RELAXED, __HIP_MEMORY_SCOPE_AGENT); }
__device__ __forceinline__ unsigned xb_add(unsigned* p, unsigned v) { return __hip_atomic_fetch_add(p, v, __ATOMIC_RELAXED, __HIP_MEMORY_SCOPE_AGENT); }
__device__ __forceinline__ unsigned xb_xcc_id() { return (unsigned)__builtin_amdgcn_s_getreg((3 << 11) | 20) & 0xFu; }
#define XB_SPIN(cond, bar) do { unsigned _sp = 0; while (cond) { __builtin_amdgcn_s_sleep(1); \
    if ((++_sp & 255u) == 0u) { if (xb_ld(&(bar)[XB_TMO])) break; if (_sp > XB_SPIN_CAP) { atomicAdd(&(bar)[XB_TMO], 1u); break; } } } } while (0)
struct XcdBarrier { unsigned* bar; unsigned x; volatile LAS unsigned* st; };
__device__ __forceinline__ XcdBarrier xcd_barrier_post(unsigned* bar, volatile LAS unsigned* st) {
    XcdBarrier b; b.bar = bar; b.x = xb_xcc_id(); b.st = st;
    if (threadIdx.x == 0) (void)xb_add(&bar[XB_XCNT(b.x)], 1u);
    return b;
}
__device__ __forceinline__ void xcd_barrier_complete(unsigned* bar, unsigned x, unsigned& nloc, unsigned& nx) {
    const unsigned G = gridDim.x * gridDim.y * gridDim.z;
    unsigned sum, cnt, mine, sp = 0u;
    for (;;) {
        sum = 0u; cnt = 0u; mine = 0u;
#pragma unroll
        for (unsigned j = 0; j < 16; ++j) { const unsigned c = xb_ld(&bar[XB_XCNT(j)]); sum += c; cnt += (c > 0u) ? 1u : 0u; mine = (j == x) ? c : mine; }
        if (sum == G) break;
        __builtin_amdgcn_s_sleep(1);
        if ((++sp & 255u) == 0u) { if (xb_ld(&bar[XB_TMO])) break; if (sp > XB_SPIN_CAP) { atomicAdd(&bar[XB_TMO], 1u); break; } }
    }
    nloc = mine > 0u ? mine : 1u; nx = cnt > 0u ? cnt : 1u;
}
__device__ __forceinline__ void xcd_barrier(const XcdBarrier& b) {
    asm volatile("s_waitcnt vmcnt(0)" ::: "memory");
    __syncthreads();
    if (threadIdx.x == 0) {
        unsigned* bar = b.bar;
        __builtin_amdgcn_s_waitcnt(0);
        unsigned nloc = b.st[0], nx = b.st[1];
        if (nloc == 0u) { xcd_barrier_complete(bar, b.x, nloc, nx); b.st[0] = nloc; b.st[1] = nx; }
        const unsigned old = xb_add(&bar[XB_XSUB(b.x)], 1u);
        const unsigned gen = old / nloc;
        if (old + 1u == (gen + 1u) * nloc) {
            __builtin_amdgcn_fence(__ATOMIC_RELEASE, "agent");
            asm volatile("s_waitcnt vmcnt(0)" ::: "memory");
            const unsigned og = xb_add(&bar[XB_TOP], 1u);
            const unsigned tg = og / nx;
            if (og + 1u == (tg + 1u) * nx) xb_add(&bar[XB_TOPGEN], 1u);
            else XB_SPIN(xb_ld(&bar[XB_TOPGEN]) == tg, bar);
            __builtin_amdgcn_fence(__ATOMIC_ACQUIRE, "agent");
            xb_add(&bar[XB_XGEN(b.x)], 1u);
            asm volatile("s_waitcnt vmcnt(0)" ::: "memory");
        } else {
            XB_SPIN(xb_ld(&bar[XB_XGEN(b.x)]) == gen, bar);
            __builtin_amdgcn_fence(__ATOMIC_ACQUIRE, "agent");
            asm volatile("s_waitcnt vmcnt(0)" ::: "memory");
        }
    }
    __syncthreads();
}

constexpr int NWAVES = 8;
constexpr int RING_BYTES = 131072, LDS_BYTES = 147456, LDSCTL_OFF = LDS_BYTES - 512;
struct Args {
    const float* in[19]; float* out; unsigned char* ws; int ph_lo, ph_hi;
};
struct Ctx {
    LAS unsigned char* lds; int tid, lane, wave, gw, ngw, G, bid;
};

template <int MAP> __device__ __forceinline__ int wmap(int n, float& sc) {
    sc = 1.f;
    if (MAP == 0) return n;
    if (MAP == 1) {
        if (n < 1088) return n;
        if (n < 3136) { const int m = n - 1088, d = m & 127; return 1280 + (m - d) + (d < 64 ? 2 * d : 2 * (d - 64) + 1); }
        if (n < 4160) return 1280 + (n - 1088);
        if (n < 5184) { const int m = n - 4160, d = m & 63; return 4352 + (m - d) + (d < 32 ? 2 * d : 2 * (d - 32) + 1); }
        if (n < 5248) { const int d = n - 5184; return 1088 + (d < 32 ? 2 * d : 2 * (d - 32) + 1); }
        if (n < 5264) { sc = 0.03125f; return 1152 + (n - 5248); }
        if (n < 7312) { const int m = n - 5264, d = m & 127; return 5376 + (m - d) + (d < 64 ? 2 * d : 2 * (d - 64) + 1); }
        if (n < 8336) return 5376 + (n - 5264);
        return 8448 + (n - 8336);
    }
    if (n < DFF) return (n >> 7) * 256 + (n & 127);
    const int m = n - DFF; return (m >> 7) * 256 + 128 + (m & 127);
}
template <int MAP> __device__ __forceinline__ void conv_matrix(const Ctx& F, const float* W, int K, int N, bf16_t* WT, const float* gain) {
    LAS float* scr = (LAS float*)(F.lds + F.wave * 18432);
    const int lane = F.lane;
    const int nblk = (N + 63) / 64, nit = (K / 64) * nblk;
    const int l31 = lane & 31, lh = lane >> 5, c = lane & 7, nsub = lane >> 3;
    f32x2 wv[32]; f32x4 g0 = (f32x4){1.f, 1.f, 1.f, 1.f}, g1 = g0;
#define CONV_LOAD(item) do { const int kb_ = (item) / nblk, nb_ = (item) - kb_ * nblk, k0_ = 64 * kb_, nn_ = 64 * nb_ + 2 * l31; \
        const float* src_ = W + (size_t)(k0_ + lh) * N + nn_; const bool ok_ = nn_ < N; \
        _Pragma("unroll") for (int i = 0; i < 32; ++i) wv[i] = ok_ ? *(const f32x2*)(src_ + (size_t)(2 * i) * N) : (f32x2){0.f, 0.f}; \
        if (gain) { g0 = *(const f32x4*)(gain + k0_ + 8 * c); g1 = *(const f32x4*)(gain + k0_ + 8 * c + 4); } } while (0)
    int it = F.gw;
    if (it < nit) CONV_LOAD(it);
    while (it < nit) {
        const int kb = it / nblk, nb = it - kb * nblk, k0 = 64 * kb, n0 = 64 * nb;
#pragma unroll
        for (int i = 0; i < 32; ++i) { LAS float* d = scr + (2 * i + lh) * 65 + l31; d[0] = wv[i].x; d[32] = wv[i].y; }
        const f32x4 gc0 = g0, gc1 = g1;
        const int nx = it + F.ngw;
        if (nx < nit) CONV_LOAD(nx);
        LDS_WAIT(); asm volatile("" ::: "memory");
#pragma unroll
        for (int j = 0; j < 8; ++j) { const int n = nsub + 8 * j, ns = n0 + n;
            if (ns < N) { float sc; const int dst = wmap<MAP>(ns, sc); const LAS float* s = scr + (8 * c) * 65 + (n & 1) * 32 + (n >> 1);
                u32x4 o; o.x = pk2(s[0 * 65] * (sc * gc0.x), s[1 * 65] * (sc * gc0.y)); o.y = pk2(s[2 * 65] * (sc * gc0.z), s[3 * 65] * (sc * gc0.w));
                o.z = pk2(s[4 * 65] * (sc * gc1.x), s[5 * 65] * (sc * gc1.y)); o.w = pk2(s[6 * 65] * (sc * gc1.z), s[7 * 65] * (sc * gc1.w));
                *(u32x4*)(WT + (size_t)dst * K + k0 + 8 * c) = o; } }
        LDS_WAIT(); asm volatile("" ::: "memory");
        it = nx;
    }
#undef CONV_LOAD
}

__device__ __forceinline__ void norm_row(const float* hrow, bf16_t* orow, float* rs_row, int lane) {
    f32x4 v[8]; float s = 0.f;
#pragma unroll
    for (int j = 0; j < 8; ++j) { v[j] = *((const f32x4*)hrow + lane + 64 * j); s += (v[j].x * v[j].x + v[j].y * v[j].y) + (v[j].z * v[j].z + v[j].w * v[j].w); }
    s = wave_sum(s);
    if (lane == 0) *rs_row = s;
#pragma unroll
    for (int j = 0; j < 8; ++j) { u32x2 o; o.x = cvt_pk_bf16(v[j].x, v[j].y); o.y = cvt_pk_bf16(v[j].z, v[j].w); *((u32x2*)orow + lane + 64 * j) = o; }
}

__device__ __forceinline__ void post1a_row(const bf16_t* P, int r, float* rstdq, float* rstdkv, int lane) {
    const bf16_t* p = P + (size_t)r * PW;
    const u32x4 a = *((const u32x4*)(p + C_CQ) + lane), b = *((const u32x4*)(p + C_CKV) + lane);
    float sa = 0.f, sb = 0.f;
#pragma unroll
    for (int e = 0; e < 4; ++e) { const float x0 = __uint_as_float(a[e] << 16), x1 = __uint_as_float(a[e] & 0xffff0000u); sa += x0 * x0 + x1 * x1;
        const float y0 = __uint_as_float(b[e] << 16), y1 = __uint_as_float(b[e] & 0xffff0000u); sb += y0 * y0 + y1 * y1; }
    sa = wave_sum(sa); sb = wave_sum(sb);
    if (lane == 0) { rstdq[r] = 1.0f / sqrtf(sa * (1.f / 512.f) + EPS); rstdkv[r] = 1.0f / sqrtf(sb * (1.f / 512.f) + EPS); }
    { unsigned* ikp = (unsigned*)(P + (size_t)r * PW + C_IK) + (lane & 31); const unsigned w = *ikp; const float x1 = __uint_as_float(w << 16), x2 = __uint_as_float(w & 0xffff0000u);
      float cs, sn; rope_cs(row_pos(r), lane & 31, 2.f / 64.f, cs, sn);
      if (lane < 32) *ikp = cvt_pk_bf16(x1 * cs - x2 * sn, x2 * cs + x1 * sn); }
}
__device__ __forceinline__ void meta_post_row(bf16_t* P, int r, const float* gperm, int lane) {
    bf16_t* p = P + (size_t)r * PW; const int pos = row_pos(r);
    float c128, s128, c64, s64; rope_cs(pos, lane, 2.f / 128.f, c128, s128); rope_cs(pos, lane & 31, 2.f / 64.f, c64, s64);
#pragma unroll 1
    for (int t = 0; t < 4; ++t) {
        const int cb = t == 0 ? C_DQ : (t == 1 ? C_DK : (t == 2 ? C_FQ : C_FK)); const float sc = (t == 0 || t == 2) ? C2_128 : 1.f;
        const float ga = gperm[t * 128 + 2 * lane], gb = gperm[t * 128 + 2 * lane + 1];
#pragma unroll 1
        for (int h = 0; h < 8; ++h) { unsigned* xp = (unsigned*)(p + cb + h * 128) + lane; const unsigned w = *xp; float x1 = __uint_as_float(w << 16), x2 = __uint_as_float(w & 0xffff0000u);
            const float rn = __builtin_amdgcn_rsqf(wave_sum(x1 * x1 + x2 * x2) * (1.f / 128.f) + EPS); x1 *= rn * ga; x2 *= rn * gb;
            *xp = cvt_pk_bf16((x1 * c128 - x2 * s128) * sc, (x2 * c128 + x1 * s128) * sc); }
    }
#pragma unroll 1
    for (int hh = 0; hh < 8; ++hh) { unsigned* xp = (unsigned*)(p + C_IQ + hh * 128) + lane; const unsigned w = *xp; const float x1 = __uint_as_float(w << 16), x2 = __uint_as_float(w & 0xffff0000u);
        *xp = cvt_pk_bf16(x1 * c64 - x2 * s64, x2 * c64 + x1 * s64); }
}
__device__ __forceinline__ void unpack8(const u32x4& w, float (&x)[8]) {
#pragma unroll
    for (int e = 0; e < 4; ++e) { x[2 * e] = __uint_as_float(w[e] << 16); x[2 * e + 1] = __uint_as_float(w[e] & 0xffff0000u); }
}
__device__ __forceinline__ u32x4 pack8(const float (&x)[8]) { u32x4 w; w.x = cvt_pk_bf16(x[0], x[1]); w.y = cvt_pk_bf16(x[2], x[3]); w.z = cvt_pk_bf16(x[4], x[5]); w.w = cvt_pk_bf16(x[6], x[7]); return w; }
__device__ __forceinline__ u32x4 shfl_xor4(const u32x4& w, int m) { u32x4 r; r.x = __shfl_xor(w.x, m); r.y = __shfl_xor(w.y, m); r.z = __shfl_xor(w.z, m); r.w = __shfl_xor(w.w, m); return r; }
__device__ __forceinline__ void post2_row(bf16_t* P, int r, const float* rstdq, const float* rstdkv, const float* qkg  , LAS float* rnl, int lane) {
    bf16_t* p = P + (size_t)r * PW;
    const float sq = rstdq[r], skv = rstdkv[r];
    const int pos = row_pos(r), hw = lane >> 5, l5 = lane & 31;
    float c64[8], s64[8];
#pragma unroll
    for (int j = 0; j < 8; ++j) rope_cs(pos, 8 * (lane & 3) + j, 2.f / 64.f, c64[j], s64[j]);
    float kp[8]; { const u32x4 w = *(const u32x4*)(p + C_KPE + (lane & 7) * 8); unpack8(w, kp); }
    float kpe_ss = 0.f;
#pragma unroll
    for (int j = 0; j < 8; ++j) kpe_ss += kp[j] * kp[j];
    kpe_ss += __shfl_xor(kpe_ss, 1); kpe_ss += __shfl_xor(kpe_ss, 2); kpe_ss += __shfl_xor(kpe_ss, 4);
    u32x4 rq[4], rkv[4];
#pragma unroll
    for (int it = 0; it < 4; ++it) { const int h = 2 * it + hw; rq[it] = *(const u32x4*)(p + C_QRAW + h * 192 + (l5 < 24 ? l5 : 0) * 8); rkv[it] = *(const u32x4*)(p + C_KVRAW + h * 256 + l5 * 8); }
#pragma unroll
    for (int it = 0; it < 4; ++it) {
        const int h = 2 * it + hw; const bool act = l5 < 24;
        u32x4* ptr = (u32x4*)(p + C_QRAW + h * 192 + (act ? l5 : 0) * 8);
        float x[8]; unpack8(rq[it], x);
        float ss = 0.f;
#pragma unroll
        for (int j = 0; j < 8; ++j) { x[j] *= sq; ss += x[j] * x[j]; }
        if (!act) ss = 0.f;
#pragma unroll
        for (int o = 1; o < 32; o <<= 1) ss += __shfl_xor(ss, o);
        const float rn = 1.0f / sqrtf(ss * (1.f / 192.f) + EPS);
        const int gi = (act ? l5 : 0) * 8;
        const f32x4 g0 = *(const f32x4*)(qkg + gi), g1 = *(const f32x4*)(qkg + gi + 4);
#pragma unroll
        for (int j = 0; j < 4; ++j) { x[j] *= rn * g0[j]; x[4 + j] *= rn * g1[j]; }
        float o[8];
#pragma unroll
        for (int j = 0; j < 8; ++j) { const float pr = __shfl_xor(x[j], 4); const float rot = (l5 & 4) ? (x[j] * c64[j] + pr * s64[j]) : (x[j] * c64[j] - pr * s64[j]); o[j] = (l5 >= 16 ? rot : x[j]) * C2_192; }
        if (act) *ptr = pack8(o);
    }
#pragma unroll
    for (int it = 0; it < 4; ++it) {
        const int h = 2 * it + hw; const bool isk = l5 < 16;
        u32x4* ptr = (u32x4*)(p + C_KVRAW + h * 256 + l5 * 8);
        float x[8]; unpack8(rkv[it], x);
        float ss = 0.f;
#pragma unroll
        for (int j = 0; j < 8; ++j) { x[j] *= skv; ss += x[j] * x[j]; }
        if (!isk) ss = 0.f;
#pragma unroll
        for (int o = 1; o < 32; o <<= 1) ss += __shfl_xor(ss, o);
        const float rn = 1.0f / sqrtf((ss + kpe_ss) * (1.f / 192.f) + EPS);
        if (l5 == 0) rnl[h] = rn;
        const int gi = 192 + (isk ? l5 : 0) * 8;
        const f32x4 g0 = *(const f32x4*)(qkg + gi), g1 = *(const f32x4*)(qkg + gi + 4);
        float o[8];
#pragma unroll
        for (int j = 0; j < 4; ++j) { o[j] = isk ? x[j] * rn * g0[j] : x[j]; o[4 + j] = isk ? x[4 + j] * rn * g1[j] : x[4 + j]; }
        *ptr = pack8(o);
    }
    LDS_WAIT(); asm volatile("" ::: "memory");
    { const int hd = lane >> 3, c = lane & 7; const float rn = rnl[hd];
      const f32x4 g0 = *(const f32x4*)(qkg + 192 + 128 + c * 8), g1 = *(const f32x4*)(qkg + 192 + 128 + c * 8 + 4);
      float x[8], o[8];
#pragma unroll
      for (int j = 0; j < 4; ++j) { x[j] = kp[j] * rn * g0[j]; x[4 + j] = kp[4 + j] * rn * g1[j]; }
#pragma unroll
      for (int j = 0; j < 8; ++j) { const float pr = __shfl_xor(x[j], 4); o[j] = (c & 4) ? (x[j] * c64[j] + pr * s64[j]) : (x[j] * c64[j] - pr * s64[j]); }
      *(u32x4*)(p + C_KPEH + hd * 64 + c * 8) = pack8(o); }
    LDS_WAIT(); asm volatile("" ::: "memory");
}
__device__ __forceinline__ void post3_row(bf16_t* P, int r, const float* subg, float lam, float omli, int lane) {
    bf16_t* p = P + (size_t)r * PW;
    const int hw = lane >> 5, l5 = lane & 31;
    u32x4 rr[4];
#pragma unroll
    for (int h = 0; h < 4; ++h) rr[h] = *(const u32x4*)(p + (hw ? C_IQ : C_FQ) + h * 256 + l5 * 8);
#pragma unroll
    for (int h = 0; h < 4; ++h) {
        const u32x4 raw = rr[h];
        const u32x4 praw = shfl_xor4(raw, 16);
        float a[8], b[8]; unpack8(raw, a); unpack8(praw, b);
        float d[8], ss = 0.f;
#pragma unroll
        for (int j = 0; j < 8; ++j) { d[j] = a[j] - lam * b[j]; ss += d[j] * d[j]; }
        if (l5 >= 16) ss = 0.f;
#pragma unroll
        for (int o = 1; o < 64; o <<= 1) ss += __shfl_xor(ss, o);
        const float rn = omli / sqrtf(ss * (1.f / 256.f) + EPS);
        const int dim = hw * 128 + (l5 & 15) * 8;
        const f32x4 g0 = *(const f32x4*)(subg + dim), g1 = *(const f32x4*)(subg + dim + 4);
        float o[8];
#pragma unroll
        for (int j = 0; j < 4; ++j) { o[j] = d[j] * rn * g0[j]; o[4 + j] = d[4 + j] * rn * g1[j]; }
        if (l5 < 16) *(u32x4*)(p + C_OC + h * 256 + dim) = pack8(o);
    }
}

__device__ __forceinline__ void index_unit(const bf16_t* P, int unit, unsigned* bm, LAS unsigned char* lds) {
    typedef float f32x16 __attribute__((ext_vector_type(16)));
    int tid = threadIdx.x; asm volatile("" : "+v"(tid));
    const int wid = __builtin_amdgcn_readfirstlane(tid >> 6), lane = tid & 63, j = lane & 31, hi = lane >> 5;
    const int tb = 255 - (unit >> 4), b = unit & 15, t0 = tb * 8, tokbase = MBLK + b * SEQ;
    const int wmax = (64 + t0 + 7) >> 5;
    LAS unsigned* keys = (LAS unsigned*)lds;
    LAS float* iwl = (LAS float*)(lds + 8 * 2112 * 4);
    if (t0 + 7 + 17 > 256) {
        if (tid < 128) iwl[tid] = bf2f(P[(size_t)(tokbase + t0 + (tid >> 4)) * PW + C_IW + (tid & 15)]);
        LAS unsigned char* al = lds + 8 * 2112 * 4 + 512;
        { const int id0 = tid * 2;
#pragma unroll
          for (int e = 0; e < 2; ++e) { const int id = id0 + e, rw = id >> 3, c = id & 7;
              *(LAS bf16x8*)(al + rw * 144 + c * 16) = *(const bf16x8*)(P + (size_t)(tokbase + t0 + (rw >> 4)) * PW + C_IQ + (rw & 15) * 64 + c * 8); } }
        LDS_WAIT(); __syncthreads();
        bf16x8 af[4][4];
        { const int qa = (j >> 2) & 1, ha = (j & 3) + 4 * (j >> 3);
#pragma unroll
          for (int blk = 0; blk < 4; ++blk)
#pragma unroll
              for (int s = 0; s < 4; ++s) af[blk][s] = *(const LAS bf16x8*)(al + ((2 * blk + qa) * 16 + ha) * 144 + s * 32 + hi * 16); }
        const unsigned boff = (unsigned)(j * PW + C_IK + hi * 8) * 2u;
        for (int w = wid; w <= wmax; w += 8) {
            const int kr_ = w < 2 ? (MBLK - 64) + 32 * w : tokbase + 32 * (w - 2); const char* bp_ = (const char*)(P + (size_t)kr_ * PW) + boff;
            bf16x8 bf[4];
#pragma unroll
            for (int s = 0; s < 4; ++s) bf[s] = *(const bf16x8*)(bp_ + s * 32);
            const int kidx = 32 * w + j;
#pragma unroll
            for (int blk = 0; blk < 4; ++blk) {
                f32x16 acc = (f32x16){0.f,0.f,0.f,0.f,0.f,0.f,0.f,0.f,0.f,0.f,0.f,0.f,0.f,0.f,0.f,0.f};
#pragma unroll
                for (int s = 0; s < 4; ++s) acc = __builtin_amdgcn_mfma_f32_32x32x16_bf16(af[blk][s], bf[s], acc, 0, 0, 0);
                const int q = 2 * blk + hi;
                const LAS f32x4* iwq = (const LAS f32x4*)(iwl + q * 16);
                float score = 0.f;
#pragma unroll
                for (int g = 0; g < 4; ++g) { const f32x4 wv = iwq[g]; score += fmaxf(acc[4 * g], 0.f) * wv.x + fmaxf(acc[4 * g + 1], 0.f) * wv.y + fmaxf(acc[4 * g + 2], 0.f) * wv.z + fmaxf(acc[4 * g + 3], 0.f) * wv.w; }
                const bool valid = kidx >= 48 && kidx <= 64 + t0 + q; const unsigned u_ = __float_as_uint(score);
                keys[q * 2112 + kidx] = valid ? ((u_ & 0x80000000u) ? ~u_ : (u_ | 0x80000000u)) : 0u;
            }
        }
        LDS_WAIT(); __syncthreads();
    }
    const int tq = t0 + wid, qk = 64 + tq, nch = qk / 64 + 1;
    unsigned* out = bm + (size_t)(b * SEQ + tq) * BMW;
    if (tq + 17 <= 256) {
        for (int c = 0; c < 33; ++c) { const int kidx = 64 * c + lane; const unsigned long long m = __ballot(kidx >= 48 && kidx <= qk);
            if (lane == 0) { out[2 * c] = (unsigned)m; out[2 * c + 1] = (unsigned)(m >> 32); } }
    } else {
        unsigned kreg[33];
#pragma unroll
        for (int c = 0; c < 33; ++c) kreg[c] = (c < nch && 64 * c + lane <= qk) ? keys[wid * 2112 + 64 * c + lane] : 0u;
        unsigned T = 0u;
        for (int bit = 31; bit >= 0; --bit) {
            const unsigned cand = T | (1u << bit); int cnt = 0;
#pragma unroll
            for (int c = 0; c < 33; ++c) cnt += __popcll(__ballot(kreg[c] >= cand));
            if (cnt >= 256) T = cand;
            if (cnt == 256) break;
        }
#pragma unroll
        for (int c = 0; c < 33; ++c) { const unsigned long long m = __ballot(kreg[c] >= T && kreg[c] != 0u);
            if (lane == 0) { out[2 * c] = (unsigned)m; out[2 * c + 1] = (unsigned)(m >> 32); } }
    }
    LDS_WAIT();
}

namespace fa {
typedef float f32x16 __attribute__((ext_vector_type(16)));
typedef short s16x4 __attribute__((ext_vector_type(4)));
__device__ __forceinline__ int crow(int r, int hi) { return (r & 3) + 8 * (r >> 2) + 4 * hi; }
__device__ __forceinline__ int v_st(int k, int c) { const int kk = (k & ~0xC) | ((k & 4) << 1) | ((k & 8) >> 1); return ((kk >> 3) * 4 + (c >> 5)) * 512 + ((kk & 7) * 32 + (c & 31)) * 2; }
__device__ __forceinline__ int v_rd_base(int lane) { return ((lane & 3) << 3) | (((lane >> 2) & 3) << 6) | (((lane >> 4) & 1) << 5) | (((lane >> 5) & 1) << 8); }
constexpr int v_rd_off(int d0, int ks, int half) { return d0 * 512 + ks * 4096 + half * 2048; }
constexpr int SHM_V = 16384;
template <int DQK, int DV> struct Geo { static constexpr int KP = DQK * 2, SHM_K = 64 * DQK * 2, LDS_K0 = 2 * 64 * DV * 2, LDS_WS = LDS_K0 + 2 * SHM_K, BYTES = LDS_WS + 8 * 256; };
#define FA_KSWZ(row, colB, pitch) ((row) * (pitch) + ((colB) ^ (((row) & 7) << 4)))
#define FA_SBAR() __builtin_amdgcn_sched_barrier(0)

struct Item { int qrow0, qk0, nt, tokbase; };

template <int DQK>
__device__ __forceinline__ void load_q(const bf16_t* P, const Item& it, int qcol, bf16x8 (&qr)[DQK / 16]) {
    int tid = threadIdx.x; asm volatile("" : "+v"(tid));
    const int wid = tid >> 6, lane = tid & 63, r32 = lane & 31, hi = lane >> 5;
    const bf16_t* qp = P + (size_t)(it.qrow0 + wid * 32 + r32) * PW + qcol + hi * 8;
#pragma unroll
    for (int d0 = 0; d0 < DQK / 16; ++d0) qr[d0] = *(const bf16x8*)(qp + d0 * 16);
}

template <int DQK, int DV, bool MASKED>
__device__ __forceinline__ void attn_core(bf16_t* P, const Item& it, const bf16x8 (&qr)[DQK / 16], int k1col, int k2col, int vcol, int ocol, int ocol1, const unsigned* bmq, LAS unsigned char* lds) {
    typedef Geo<DQK, DV> G; constexpr int SHMV = 64 * DV * 2, NDB = DV / 32;
    int tid = threadIdx.x; asm volatile("" : "+v"(tid));
    const int wid = __builtin_amdgcn_readfirstlane(tid >> 6), lane = tid & 63, r32 = lane & 31, hi = lane >> 5;
    LAS unsigned char* V_lds = lds; LAS unsigned char* K_lds = lds + G::LDS_K0; LAS float* wsf = (LAS float*)(lds + G::LDS_WS) + wid * 64;
    const int sr = tid >> 4, sc = (tid & 15) * 8;
    const int vst0 = v_st(sr, sc), vst1 = v_st(32 + sr, sc), kws0 = FA_KSWZ(sr, sc * 2, G::KP), kws1 = FA_KSWZ(sr + 32, sc * 2, G::KP);
    const int xr = tid >> 3, xc = (tid & 7) * 8, kws2 = FA_KSWZ(xr, (128 + xc) * 2, G::KP);
    const unsigned loff0 = (unsigned)(sr * PW + sc) * 2u, loffx = (unsigned)(xr * PW + xc) * 2u;
    const int vb0 = (int)(unsigned)(size_t)V_lds + v_rd_base(lane);
    const int NT = it.nt;
    const int qk = it.qk0 + wid * 32 + r32;
    const bool use_bm = MASKED && (bmq != nullptr);
    const unsigned bmoff = (unsigned)((wid * 32 + r32) * BMW) * 4u;
    float l_reg = 0.f; f32x16 o[NDB];
#pragma unroll
    for (int d = 0; d < NDB; ++d) o[d] = (f32x16){0.f,0.f,0.f,0.f,0.f,0.f,0.f,0.f,0.f,0.f,0.f,0.f,0.f,0.f,0.f,0.f};
    bf16x8 sk0, sk1, sk2, sv0, sv1, sv2, sv3;
#define FA_KROW0(t) ((t) == 0 ? (MBLK - 64) : it.tokbase + 64 * ((t) - 1))
#define FA_LOADK(t) do { const int kr_ = FA_KROW0(t); const char* rb_ = (const char*)(P + (size_t)kr_ * PW); const char* rk_ = rb_ + (size_t)k1col * 2; \
        sk0 = *(const bf16x8*)(rk_ + loff0); sk1 = *(const bf16x8*)(rk_ + (size_t)32 * PW * 2 + loff0); if (DQK == 192) sk2 = *(const bf16x8*)(rb_ + (size_t)k2col * 2 + loffx); } while (0)
#define FA_LOADV(t) do { const char* rv_ = (const char*)(P + (size_t)FA_KROW0(t) * PW) + (size_t)vcol * 2; \
        sv0 = *(const bf16x8*)(rv_ + loff0); sv1 = *(const bf16x8*)(rv_ + (size_t)32 * PW * 2 + loff0); if (DV == 256) { sv2 = *(const bf16x8*)(rv_ + 256 + loff0); sv3 = *(const bf16x8*)(rv_ + 256 + (size_t)32 * PW * 2 + loff0); } } while (0)
#define FA_LOAD(t) do { FA_LOADK(t); FA_LOADV(t); } while (0)
#define FA_WRITE(bf) do { *(LAS bf16x8*)(K_lds + (bf) * G::SHM_K + kws0) = sk0; *(LAS bf16x8*)(K_lds + (bf) * G::SHM_K + kws1) = sk1; \
        *(LAS bf16x8*)(V_lds + (bf) * SHMV + vst0) = sv0; *(LAS bf16x8*)(V_lds + (bf) * SHMV + vst1) = sv1; if (DV == 256) { *(LAS bf16x8*)(V_lds + (bf) * SHMV + 16384 + vst0) = sv2; *(LAS bf16x8*)(V_lds + (bf) * SHMV + 16384 + vst1) = sv3; } \
        if (DQK == 192) *(LAS bf16x8*)(K_lds + (bf) * G::SHM_K + kws2) = sk2; } while (0)
    constexpr int QREG = (DV == 256) ? 3 : DQK / 16;
    constexpr int NQL = DQK / 16 - QREG;
    static_assert(G::BYTES + 8 * NQL * 64 * 16 <= LDSCTL_OFF, "attention LDS budget");
    LAS unsigned char* qx = lds + G::BYTES + (wid * (NQL * 64) + lane) * 16;
    if (QREG < DQK / 16) {
#pragma unroll
        for (int d0 = QREG; d0 < DQK / 16; ++d0) *(LAS bf16x8*)(qx + (d0 - QREG) * 1024) = qr[d0];
    }
    FA_LOAD(0); FA_WRITE(0);
    __syncthreads();
    for (int t = 0; t < NT; ++t) {
        const int cur = t & 1;
        unsigned zb = 0u; asm volatile("" : "+v"(zb)); u32x2 bw = (u32x2){zb, zb};
        if (use_bm) bw = *(const u32x2*)((const char*)(bmq + 2 * t) + bmoff);
        f32x16 p0 = (f32x16){0.f,0.f,0.f,0.f,0.f,0.f,0.f,0.f,0.f,0.f,0.f,0.f,0.f,0.f,0.f,0.f}, p1 = p0;
        { LAS unsigned char* kbase = K_lds + cur * G::SHM_K;
          LAS unsigned char* kb[4];
#pragma unroll
          for (int dd = 0; dd < 4; ++dd) kb[dd] = kbase + FA_KSWZ(r32, (dd * 16 + hi * 8) * 2, G::KP);
          constexpr int GS = (DQK == 192 || DV == 256) ? 2 : 4;
#pragma unroll
          for (int g = 0; g < DQK / (16 * GS); ++g) {
              bf16x8 fb0[GS], fb1[GS];
#pragma unroll
              for (int dd = 0; dd < GS; ++dd) { const int d0 = g * GS + dd; LAS unsigned char* a = kb[d0 & 3] + (d0 >> 2) * 128; fb0[dd] = *(const LAS bf16x8*)a; fb1[dd] = *(const LAS bf16x8*)(a + 32 * G::KP); }
              FA_SBAR();
#pragma unroll
              for (int dd = 0; dd < GS; ++dd) { const int d0 = g * GS + dd; bf16x8 qf; if (d0 < QREG) qf = qr[d0 < QREG ? d0 : 0]; else qf = *(const LAS bf16x8*)(qx + (d0 - QREG) * 1024);
                  p0 = __builtin_amdgcn_mfma_f32_32x32x16_bf16(fb0[dd], qf, p0, 0, 0, 0); p1 = __builtin_amdgcn_mfma_f32_32x32x16_bf16(fb1[dd], qf, p1, 0, 0, 0); }
              FA_SBAR(); } }
        if (t + 1 < NT) { FA_LOADK(t + 1); if (DV != 256) FA_LOADV(t + 1); }
        FA_SBAR();
        const float NEG = -__builtin_inff();
        if (use_bm) {
        } else if (t == 0 || 64 * t + 63 > it.qk0 + wid * 32) {
            const int kb_ = 64 * t + 4 * hi;
#pragma unroll
            for (int r = 0; r < 16; ++r) { const int k0 = kb_ + (r & 3) + 8 * (r >> 2), k1 = k0 + 32;
                if (k0 < 48 || k0 > qk) p0[r] = NEG; if (k1 < 48 || k1 > qk) p1[r] = NEG; }
        }
        float ps = 0.f;
#pragma unroll
        for (int r = 0; r < 16; ++r) { p0[r] = __builtin_amdgcn_exp2f(p0[r]); p1[r] = __builtin_amdgcn_exp2f(p1[r]); }
        if (use_bm) {
            const int wx = (int)(bw.x >> (4 * hi)), wy = (int)(bw.y >> (4 * hi));
#pragma unroll
            for (int r = 0; r < 16; ++r) { const int c = (r & 3) + 8 * (r >> 2);
                p0[r] = __uint_as_float(__float_as_uint(p0[r]) & (unsigned)__builtin_amdgcn_sbfe(wx, c, 1)); p1[r] = __uint_as_float(__float_as_uint(p1[r]) & (unsigned)__builtin_amdgcn_sbfe(wy, c, 1)); }
        }
        { f32x2 s2 = (f32x2){p0[0], p0[1]} + (f32x2){p1[0], p1[1]};
#pragma unroll
          for (int r = 2; r < 16; r += 2) s2 += (f32x2){p0[r], p0[r + 1]} + (f32x2){p1[r], p1[r + 1]};
          ps = s2.x + s2.y; }
        { auto rr = __builtin_amdgcn_permlane32_swap(__float_as_uint(ps), __float_as_uint(ps), false, false); ps = __uint_as_float(rr[0]) + __uint_as_float(rr[1]); }
        l_reg += ps;
        if (DV == 256 && t + 1 < NT) { FA_SBAR(); FA_LOADV(t + 1); FA_SBAR(); }
        bf16x8 pa0, pa1, pa2, pa3;
#define FA_PK4(Pv, B_, OUT) do { const unsigned a0 = cvt_pk_bf16(Pv[B_ + 0], Pv[B_ + 1]), a1 = cvt_pk_bf16(Pv[B_ + 2], Pv[B_ + 3]), b0 = cvt_pk_bf16(Pv[B_ + 4], Pv[B_ + 5]), b1 = cvt_pk_bf16(Pv[B_ + 6], Pv[B_ + 7]); \
        auto r0 = __builtin_amdgcn_permlane32_swap(a0, b0, false, false); auto r1 = __builtin_amdgcn_permlane32_swap(a1, b1, false, false); \
        u32x4 w_ = {r0[0], r1[0], r0[1], r1[1]}; OUT = __builtin_bit_cast(bf16x8, w_); } while (0)
        FA_PK4(p0, 0, pa0); FA_PK4(p0, 8, pa1); FA_PK4(p1, 0, pa2); FA_PK4(p1, 8, pa3);
#define FA_TRRD(dst, off) asm volatile("ds_read_b64_tr_b16 %0, %1 offset:%2" : "=&v"(dst) : "v"(vbc), "i"(off) : "memory")
#define FA_PV(VB, d0) do { s16x4 l0, l1, l2, l3, h0, h1, h2, h3; constexpr int b_ = ((d0) >> 2) * 16384 + v_rd_off((d0) & 3, 0, 0); \
        FA_TRRD(l0, b_); FA_TRRD(h0, b_ + 2048); FA_TRRD(l1, b_ + 4096); FA_TRRD(h1, b_ + 6144); FA_TRRD(l2, b_ + 8192); FA_TRRD(h2, b_ + 10240); FA_TRRD(l3, b_ + 12288); FA_TRRD(h3, b_ + 14336); \
        asm volatile("s_waitcnt lgkmcnt(0)" ::: "memory"); FA_SBAR(); \
        o[d0] = __builtin_amdgcn_mfma_f32_32x32x16_bf16(pa0, (bf16x8){l0[0], l0[1], l0[2], l0[3], h0[0], h0[1], h0[2], h0[3]}, o[d0], 0, 0, 0); \
        o[d0] = __builtin_amdgcn_mfma_f32_32x32x16_bf16(pa1, (bf16x8){l1[0], l1[1], l1[2], l1[3], h1[0], h1[1], h1[2], h1[3]}, o[d0], 0, 0, 0); \
        o[d0] = __builtin_amdgcn_mfma_f32_32x32x16_bf16(pa2, (bf16x8){l2[0], l2[1], l2[2], l2[3], h2[0], h2[1], h2[2], h2[3]}, o[d0], 0, 0, 0); \
        o[d0] = __builtin_amdgcn_mfma_f32_32x32x16_bf16(pa3, (bf16x8){l3[0], l3[1], l3[2], l3[3], h3[0], h3[1], h3[2], h3[3]}, o[d0], 0, 0, 0); } while (0)
        FA_SBAR();
        { const int vbc = vb0 + cur * SHMV;
          FA_PV(0, 0); FA_PV(0, 1); FA_PV(0, 2); FA_PV(0, 3); if (DV == 256) { FA_PV(0, 4); FA_PV(0, 5); FA_PV(0, 6); FA_PV(0, 7); } }
        FA_SBAR();
        if (t + 1 < NT) { const int nb_ = cur ^ 1; FA_WRITE(nb_); }
        __syncthreads();
    }
    if (hi == 0) wsf[r32] = l_reg; LDS_WAIT();
    float rli[16];
#pragma unroll
    for (int r = 0; r < 16; ++r) { const float lv = wsf[crow(r, hi)]; rli[r] = lv > 0.f ? __builtin_amdgcn_rcpf(lv) : 0.f; }
    { int l2 = lane; asm volatile("" : "+v"(l2));
      const int r32b = l2 & 31, hib = l2 >> 5;
      char* Ow = (char*)(P + (size_t)(it.qrow0 + wid * 32) * PW + ocol) + (unsigned)((4 * hib) * PW + r32b) * 2u;
      char* Ow1 = (char*)(P + (size_t)(it.qrow0 + wid * 32) * PW + ocol1) + (unsigned)((4 * hib) * PW + r32b) * 2u;
#pragma unroll
      for (int r = 0; r < 16; ++r) { const unsigned ro = (unsigned)(((r & 3) + 8 * (r >> 2)) * PW) * 2u;
#pragma unroll
        for (int d0 = 0; d0 < NDB; ++d0) { const float v = o[d0][r] * rli[r]; const float vn = __shfl_xor(v, 1);
            if ((r32b & 1) == 0) *(unsigned*)((d0 < 4 ? Ow : Ow1) + ro + (d0 & 3) * 64) = cvt_pk_bf16(v, vn); } } }
    LDS_WAIT();
    __syncthreads();
#undef FA_KROW0
#undef FA_LOAD
#undef FA_LOADK
#undef FA_LOADV
#undef FA_WRITE
#undef FA_PK4
#undef FA_TRRD
#undef FA_PV
}
__device__ __forceinline__ int next_item(unsigned* ctr, LAS int* slot) {
    __syncthreads();
    if (threadIdx.x == 0) *slot = (int)__hip_atomic_fetch_add(ctr, 1u, __ATOMIC_RELAXED, __HIP_MEMORY_SCOPE_AGENT);
    __syncthreads();
    return *slot;
}
__device__ __forceinline__ void queue_prime(unsigned* ctr, LAS int* slot) {
    __syncthreads();
    if (threadIdx.x == 0) slot[0] = (int)__hip_atomic_fetch_add(ctr, 1u, __ATOMIC_RELAXED, __HIP_MEMORY_SCOPE_AGENT);
    __syncthreads();
}
__device__ __forceinline__ int queue_next(unsigned* ctr, LAS int* slot, int k) {
    const int idx = slot[k & 1];
    if (threadIdx.x == 0) slot[(k + 1) & 1] = (int)__hip_atomic_fetch_add(ctr, 1u, __ATOMIC_RELAXED, __HIP_MEMORY_SCOPE_AGENT);
    return idx;
}
__device__ __forceinline__ Item make_item(bool meta, int b, int qb) {
    Item it;
    if (meta) { it.qrow0 = 0; it.qk0 = -(MBLK - 64); it.nt = 1; it.tokbase = MBLK; }
    else { it.qrow0 = MBLK + b * SEQ + qb * 256; it.qk0 = 64 + qb * 256; it.nt = 4 * (qb + 1) + 1; it.tokbase = MBLK + b * SEQ; }
    return it;
}
}


constexpr int PH_PER_LAYER = 19, N_PHASES = 2 * PH_PER_LAYER;
__device__ __forceinline__ unsigned char* uni_ptr(unsigned char* p) { const unsigned long long v = (unsigned long long)p; const unsigned lo = __builtin_amdgcn_readfirstlane((unsigned)v), hi = __builtin_amdgcn_readfirstlane((unsigned)(v >> 32)); return (unsigned char*)(((unsigned long long)hi << 32) | lo); }
__device__ __forceinline__ const float* arg_in(const Args& a, int k) { asm volatile("" : "+s"(k)); return a.in[k]; }
__global__ void __launch_bounds__(NWAVES * 64, 2) mega_fwd(Args args) {
    extern __shared__ __attribute__((aligned(16))) unsigned char lds_raw[];
    {
        LAS unsigned char* l0 = (LAS unsigned char*)lds_raw;
        for (int u = threadIdx.x; u < (LDS_BYTES - LDSCTL_OFF) / 4; u += NWAVES * 64) ((LAS unsigned*)(l0 + LDSCTL_OFF))[u] = 0u;
        __syncthreads();
    }
#if MK_ONE_LAUNCH
    (void)xcd_barrier_post((unsigned*)(args.ws + WS_CTL) + CW_BAR, (volatile LAS unsigned*)((LAS unsigned char*)lds_raw + LDSCTL_OFF + 64));
#define GRID_BAR() do { XcdBarrier bar_; bar_.bar = (unsigned*)(uni_ptr(args.ws) + WS_CTL) + CW_BAR; bar_.x = xb_xcc_id(); bar_.st = (volatile LAS unsigned*)((LAS unsigned char*)lds_raw + LDSCTL_OFF + 64); xcd_barrier(bar_); } while (0)
#else
#define GRID_BAR() do {} while (0)
#endif
    const int lo = args.ph_lo, hi = args.ph_hi;
#define IN(k) (lo <= (k) && (k) < hi)
#define SEAM(k) do { if (IN((k) + 1)) GRID_BAR(); } while (0)
#define PH_BEGIN \
    int tid_ = threadIdx.x; asm volatile("" : "+v"(tid_)); \
    Ctx F; F.lds = (LAS unsigned char*)lds_raw; F.tid = tid_; F.lane = tid_ & 63; F.wave = __builtin_amdgcn_readfirstlane(tid_ >> 6); \
    F.G = gridDim.x; F.bid = blockIdx.x; F.gw = F.bid * NWAVES + F.wave; F.ngw = F.G * NWAVES; \
    unsigned char* ws = uni_ptr(args.ws); asm volatile("" : "+s"(ws)); \
    int ly = __builtin_amdgcn_readfirstlane(layer); asm volatile("" : "+s"(ly)); (void)ly; (void)F
#define XN_ ((bf16_t*)(ws + WS_XN))
#define P_ ((bf16_t*)(ws + WS_P))
#define HMETA_ ((float*)(ws + WS_HMETA))
#define RSTDQ_ ((float*)(ws + WS_RSTD))
#define RSTDKV_ ((float*)(ws + WS_RSTD) + R)
#define BM_ ((unsigned*)(ws + WS_BM))
#define RS_(i) ((float*)(ws + WS_CTL + WS_RS) + (size_t)(i) * R)
#define GPERM_ ((float*)(ws + WS_RSTD + 512 * 1024))
#define WB_(off) ((bf16_t*)(ws + WS_WB + (off)))
#define OUT_ (args.out)
#define LAMBDA_INIT(ly) ((ly) == 0 ? 0.2f : (0.8f - 0.6f * 0.7408182206817179f))
#define HSRC_TOK(ly) ((ly) == 0 ? arg_in(args, 0) : (const float*)args.out)

#pragma unroll
    for (int layer = 0; layer < 2; ++layer) {
        const int pb = layer * PH_PER_LAYER;
        if (((PHMASK >> 0) & 1) && IN(pb + 0)) {
            PH_BEGIN;
            for (int rep_ = 0; rep_ < NREP(0); ++rep_) { if (rep_) GRID_BAR();
            const float* meta = arg_in(args, 1);
            conv_matrix<1>(F, arg_in(args, 3) + (size_t)ly * DM * D_IN, DM, D_IN, WB_(WB_IN), arg_in(args, 2) + ly * DM);
            conv_matrix<0>(F, arg_in(args, 7) + (size_t)ly * 512 * 1536, 512, 1536, WB_(WB_QUP), arg_in(args, 5) + ly * 512);
            conv_matrix<0>(F, arg_in(args, 8) + (size_t)ly * 512 * 2048, 512, 2048, WB_(WB_KVUP), arg_in(args, 6) + ly * 512);
            for (int b = 0; b < 3; ++b) conv_matrix<0>(F, arg_in(args, 14) + ((size_t)ly * 3 + b) * 1024 * DM, 1024, DM, WB_(WB_BR) + (size_t)b * DM * 1024, nullptr);
            conv_matrix<0>(F, arg_in(args, 15) + (size_t)ly * DM * DM, DM, DM, WB_(WB_O), nullptr);
            conv_matrix<2>(F, arg_in(args, 17) + (size_t)ly * DM * 2 * DFF, DM, 2 * DFF, WB_(WB_F1), arg_in(args, 16) + ly * DM);
            conv_matrix<0>(F, arg_in(args, 18) + (size_t)ly * DFF * DM, DFF, DM, WB_(WB_F2), nullptr);
            unsigned zu = 0u; asm volatile("" : "+v"(zu)); const float zf = __uint_as_float(zu);
            for (int i = F.gw * 64 + F.lane; i < 112 * 2048 / 8; i += F.ngw * 64) *((u32x4*)(WB_(WB_IN) + (size_t)1168 * 2048) + i) = (u32x4){zu, zu, zu, zu};
            if (F.bid == 0) { const int i = F.tid; const int t = i >> 7, ps = i & 127, dim = (ps >> 1) + 64 * (ps & 1);
                const float* gsrc = (t < 2 ? arg_in(args, 10) : arg_in(args, 11)) + ly * 256 + (t & 1) * 128; GPERM_[i] = gsrc[dim]; }
            float* hmeta = HMETA_;
            if (ly == 0) {
                for (int i = F.gw * 64 + F.lane; i < MROW0 * PW / 8; i += F.ngw * 64) *((u32x4*)P_ + i) = (u32x4){zu, zu, zu, zu};
                for (int i = F.gw * 64 + F.lane; i < MBLK * DM / 4; i += F.ngw * 64) { const int rr = i / (DM / 4); f32x4 v = (f32x4){zf, zf, zf, zf};
                    if (rr >= MBLK - NMETA) v = *((const f32x4*)meta + (i - (MBLK - NMETA) * (DM / 4))); *((f32x4*)hmeta + i) = v; }
            }
            if (ly == 0) {
                const float* xin = arg_in(args, 0); bf16_t* XN = XN_; float* rs0 = RS_(0);
                for (int r = MROW0 + F.gw; r < R; r += F.ngw)
                    norm_row(r < MBLK ? meta + (size_t)(r - MROW0) * DM : xin + (size_t)(r - MBLK) * DM, XN + (size_t)r * DM, rs0 + r, F.lane);
            }
            }
            SEAM(pb + 0);
        }
        if (((PHMASK >> 1) & 1) && IN(pb + 1)) {
            PH_BEGIN;
            { SkP f{P_, 0, RS_(2 * ly)}; skinny_gemm(F.lds, XN_ + (size_t)MROW0 * DM, DM, WB_(WB_IN), DM, 1280 / 16, F.bid, F.G, f); }
            SchedPlain S{XN_, DM, WB_(WB_IN), DM, NPMM, 5, F.G, F.bid, 0}; EpiP E{P_, RS_(2 * ly)};
            pg8::gemm_phase(F.lds, S, E);
            if (NREP(1) == 2) { GRID_BAR(); pg8::gemm_phase(F.lds, S, E); }
            SEAM(pb + 1);
        }
        if (((PHMASK >> 2) & 1) && IN(pb + 2)) {
            PH_BEGIN;
            { bf16_t* P = P_; float* rq = RSTDQ_; float* rkv = RSTDKV_;
              for (int r = MROW0 + F.gw; r < R; r += F.ngw) post1a_row(P, r, rq, rkv, F.lane); }
            VM_WAIT(); __syncthreads();
            { SkP f{P_, C_QRAW, nullptr}; skinny_gemm(F.lds, P_ + (size_t)MROW0 * PW + C_CQ, PW, WB_(WB_QUP), 512, 1536 / 16, F.bid, F.G, f); }
            { SkP f{P_, C_KVRAW, nullptr}; skinny_gemm(F.lds, P_ + (size_t)MROW0 * PW + C_CKV, PW, WB_(WB_KVUP), 512, 2048 / 16, F.bid, F.G, f); }
            SchedMlaUp S{P_, WB_(WB_QUP), WB_(WB_KVUP), F.G, F.bid}; EpiP E{P_, nullptr};
            pg8::gemm_phase(F.lds, S, E);
            if (NREP(2) == 2) { GRID_BAR(); pg8::gemm_phase(F.lds, S, E); }
            SEAM(pb + 2);
        }
        if (((PHMASK >> 3) & 1) && IN(pb + 3)) {
            PH_BEGIN;
            const float* mla_qkg = arg_in(args, 9) + ly * 2 * 192;
            bf16_t* P = P_; float* rq = RSTDQ_; float* rkv = RSTDKV_;
            LAS float* rnl = (LAS float*)(F.lds + F.wave * 64);
            for (int r = MROW0 + F.gw; r < R; r += F.ngw) post2_row(P, r, rq, rkv, mla_qkg, rnl, F.lane);
            SEAM(pb + 3);
        }
        if (((PHMASK >> 4) & 1) && IN(pb + 4)) {
            PH_BEGIN;
            bf16_t* P = P_;
            LAS int* slot = (LAS int*)(F.lds + LDSCTL_OFF + 128);
            for (int rep_ = 0; rep_ < NREP(4); ++rep_) { if (rep_) GRID_BAR();
            unsigned* ctr = (unsigned*)(ws + WS_CTL) + CW_Q + 64 * (ly * 4 + 0) + 64 * 16 * rep_;
            const bool stat = (F.G == 256); const int sx = F.bid & 7, spl = (F.bid >> 3) >> 2, sj = (F.bid >> 3) & 3;
            if (!stat) fa::queue_prime(ctr, slot);
            for (int qk_ = 0;; ++qk_) {
                int idx;
                if (stat) { if (qk_ < 4) { const int pr = sx + 8 * (spl + 8 * (qk_ >> 1)), qb = (qk_ & 1) ? sj : 7 - sj; idx = (7 - qb) * 128 + pr; } else idx = (qk_ == 4 && F.bid < 8) ? 1024 + F.bid : 1 << 30; }
                else idx = fa::queue_next(ctr, slot, qk_);
                if (idx >= 8 * 129) break;
                int h; fa::Item it;
                if (idx < 1024) { const int qb = 7 - (idx >> 7), rest = idx & 127; h = rest & 7; it = fa::make_item(false, rest >> 3, qb); } else { h = idx - 1024; it = fa::make_item(true, 0, 0); }
                bf16x8 qr[12]; fa::load_q<192>(P, it, C_QRAW + h * 192, qr);
                fa::attn_core<192, 128, false>(P, it, qr, C_KVRAW + h * 256, C_KPEH + h * 64, C_KVRAW + h * 256 + 128, C_OA + h * 128, 0, nullptr, F.lds);
            } }
            SEAM(pb + 4);
        }
        if (((PHMASK >> 5) & 1) && IN(pb + 5)) {
            PH_BEGIN;
            { SkP f{P_, 1280, RS_(2 * ly)}; skinny_gemm(F.lds, XN_ + (size_t)MROW0 * DM, DM, WB_(WB_IN) + (size_t)1280 * DM, DM, 7168 / 16, F.bid, F.G, f); }
            SchedPlain S{XN_, DM, WB_(WB_IN) + (size_t)1280 * DM, DM, NPMM, 28, F.G, F.bid, 1280}; EpiG2 E{P_, RS_(2 * ly), GPERM_, (LAS float*)(F.lds + RING_BYTES)};
            pg8::gemm_phase(F.lds, S, E);
            if (NREP(5) == 2) { GRID_BAR(); pg8::gemm_phase(F.lds, S, E); }
            SEAM(pb + 5);
        }
        if (((PHMASK >> 6) & 1) && IN(pb + 6)) {
            PH_BEGIN;
            bf16_t* P = P_; const float* gp = GPERM_;
            if (F.gw < NMETA) meta_post_row(P, MROW0 + F.gw, gp, F.lane);
        }
        if (((PHMASK >> 7) & 1) && IN(pb + 7)) {
            PH_BEGIN;
            bf16_t* P = P_; unsigned* bm = BM_;
            unsigned* ctr = (unsigned*)(ws + WS_CTL) + CW_Q + 64 * (ly * 4 + 2);
            LAS int* slot = (LAS int*)(F.lds + LDSCTL_OFF + 128);
            for (int rep_ = 0; rep_ < NREP(7); ++rep_) { if (rep_) GRID_BAR(); unsigned* c2 = ctr + 64 * 16 * rep_;
            for (;;) { const int idx = fa::next_item(c2, slot); if (idx >= NTOK / 8) break; index_unit(P, idx, bm, F.lds); } }
            SEAM(pb + 7);
        }
        if (((PHMASK >> 8) & 1) && IN(pb + 8)) {
            PH_BEGIN;
            bf16_t* P = P_; unsigned* bm = BM_;
            LAS int* slot = (LAS int*)(F.lds + LDSCTL_OFF + 128);
            for (int rep_ = 0; rep_ < NREP(8); ++rep_) { if (rep_) GRID_BAR();
            const bool dummy = (NREP(8) == 2) && rep_ == 0;
            unsigned* ctr = (unsigned*)(ws + WS_CTL) + CW_Q + 64 * (ly * 4 + 1) + 64 * 16 * rep_;
            const bool stat = (F.G == 256); const int sx = F.bid & 7, spl = (F.bid >> 3) >> 2, sj = (F.bid >> 3) & 3;
            if (!stat) fa::queue_prime(ctr, slot);
            for (int qk_ = 0;; ++qk_) {
                int idx;
                if (stat) { if (qk_ < 8) { const int pr = sx + 8 * (spl + 8 * ((qk_ >> 1) & 1)), qb = (qk_ & 1) ? sj : 7 - sj; idx = (7 - qb) * 256 + ((qk_ >> 2) ? 128 : 0) + pr; } else idx = (qk_ == 8 && F.bid < 16) ? 2048 + F.bid : 1 << 30; }
                else idx = fa::queue_next(ctr, slot, qk_);
                if (idx >= 16 * 129) break;
                int hh; bool meta = false; fa::Item it; int b = 0, qb = 0;
                if (idx < 2048) { qb = 7 - (idx >> 8); const int rest = idx & 255; hh = (rest < 128) ? 8 + (rest & 7) : (rest & 7); b = (rest & 127) >> 3; it = fa::make_item(false, b, qb); }
                else { hh = idx - 2048; hh = hh < 8 ? 8 + hh : hh - 8; meta = true; it = fa::make_item(true, 0, 0); }
                if (hh < 8) {
                    bf16x8 qr[8]; fa::load_q<128>(P, it, C_DQ + hh * 128, qr);
                    fa::attn_core<128, 128, true>(P, it, qr, C_DK + hh * 128, 0, C_DV + hh * 128, dummy ? C_KPE : C_OB + hh * 128, 0, meta ? nullptr : bm + (size_t)(b * SEQ + qb * 256) * BMW, F.lds);
                } else {
                    const int hj = hh - 8;
                    bf16x8 qr[8]; fa::load_q<128>(P, it, C_FQ + hj * 128, qr);
                    fa::attn_core<128, 256, false>(P, it, qr, C_FK + hj * 128, 0, C_FV + (hj >> 1) * 256, dummy ? C_KPE : C_FQ + hj * 128, dummy ? C_KPE : C_IQ + hj * 128, nullptr, F.lds);
                }
            } }
            SEAM(pb + 8);
        }
        if (((PHMASK >> 9) & 1) && IN(pb + 9)) {
            PH_BEGIN;
            const float* diff_lam = arg_in(args, 12) + ly * 4 * 128; const float* diff_subg = arg_in(args, 13) + ly * 256;
            const float lambda_init = LAMBDA_INIT(ly);
            const float s1 = wave_sum(diff_lam[F.lane] * diff_lam[128 + F.lane] + diff_lam[64 + F.lane] * diff_lam[192 + F.lane]);
            const float s2 = wave_sum(diff_lam[256 + F.lane] * diff_lam[384 + F.lane] + diff_lam[320 + F.lane] * diff_lam[448 + F.lane]);
            const float lam = __expf(s1) - __expf(s2) + lambda_init;
            bf16_t* P = P_;
            for (int r = MROW0 + F.gw; r < R; r += F.ngw) post3_row(P, r, diff_subg, lam, 1.f - lambda_init, F.lane);
        }
#define GATE_PHASE(k, b, sk, seam) \
        if (((PHMASK >> 10) & 1) && IN(pb + (k))) { \
            PH_BEGIN; \
            { SkGate f{(bf16_t*)(ws + WS_GS), arg_in(args, 4) + ly * 3 * DM + (b) * DM, RS_(2 * ly)}; skinny_gemm(F.lds, XN_ + (size_t)MROW0 * DM, DM, WB_(WB_G) + (size_t)(b) * 2048 * DM, DM, 2048 / 16, (F.bid + (sk)) % F.G, F.G, f); } \
            SchedPlain S{XN_, DM, WB_(WB_G) + (size_t)(b) * 2048 * DM, DM, NPMM, 8, F.G, F.bid, 0}; EpiGate E{(bf16_t*)(ws + WS_GS), arg_in(args, 4) + ly * 3 * DM + (b) * DM, RS_(2 * ly)}; \
            pg8::gemm_phase(F.lds, S, E); \
            if (NREP(k) == 2) { GRID_BAR(); pg8::gemm_phase(F.lds, S, E); } \
            if (seam) SEAM(pb + (k)); \
        }
#define BRANCH_PHASE(k, b, oc, sk, seam) \
        if (((PHMASK >> 10) & 1) && IN(pb + (k))) { \
            PH_BEGIN; \
            { SkGated f{P_, (const bf16_t*)(ws + WS_GS), (b) == 0 ? 1 : 0}; skinny_gemm(F.lds, P_ + (size_t)MROW0 * PW + (oc), PW, WB_(WB_BR) + (size_t)(b) * DM * 1024, 1024, 2048 / 16, (F.bid + (sk)) % F.G, F.G, f); } \
            SchedPlain S{P_ + (oc), PW, WB_(WB_BR) + (size_t)(b) * DM * 1024, 1024, NPMM, 8, F.G, F.bid, C_MERGED}; EpiGated E{P_, (const bf16_t*)(ws + WS_GS), (b) == 0 ? 1 : 0, ((DBG_BM >> (b)) & 1) ? 1.f : 0.f}; \
            pg8::gemm_phase(F.lds, S, E); \
            if (NREP(k) == 2 && (b) == 0) { GRID_BAR(); pg8::gemm_phase(F.lds, S, E); } \
            if (seam) SEAM(pb + (k)); \
        }
        GATE_PHASE(10, 0, 0, 0) BRANCH_PHASE(11, 0, C_OA, 0, 0)
        GATE_PHASE(12, 1, 0, 0) BRANCH_PHASE(13, 1, C_OB, 0, 0)
        GATE_PHASE(14, 2, 0, 1) BRANCH_PHASE(15, 2, C_OC, 128, 1)
        if (((PHMASK >> 11) & 1) && IN(pb + 16)) {
            PH_BEGIN;
            { SkRes f{HMETA_, XN_, RS_(2 * ly + 1)}; skinny_gemm(F.lds, P_ + (size_t)MROW0 * PW + C_MERGED, PW, WB_(WB_O), DM, 2048 / 16, F.bid, F.G, f); }
            SchedPlain S{P_ + C_MERGED, PW, WB_(WB_O), DM, NPMM, 8, F.G, F.bid, 0}; EpiRes E{HSRC_TOK(ly), OUT_, HMETA_, DBG_SA, XN_, RS_(2 * ly + 1)};
            pg8::gemm_phase(F.lds, S, E);
            SEAM(pb + 16);
        }
        if (((PHMASK >> 13) & 1) && IN(pb + 17)) {
            PH_BEGIN;
            skinny_swiglu(F.lds, XN_ + (size_t)MROW0 * DM, DM, WB_(WB_F1), DM, P_, RS_(2 * ly + 1), F.bid, F.G);
            SchedPlain S{XN_, DM, WB_(WB_F1), DM, NPMM, 44, F.G, F.bid, 0}; EpiSwiglu E{P_, RS_(2 * ly + 1)};
            pg8::gemm_phase(F.lds, S, E);
            if (NREP(17) == 2) { GRID_BAR(); pg8::gemm_phase(F.lds, S, E); }
            SEAM(pb + 17);
        }
        if (((PHMASK >> 14) & 1) && IN(pb + 18)) {
            PH_BEGIN;
            { SkRes f{HMETA_, ly == 0 ? XN_ : (bf16_t*)nullptr, RS_(2)}; skinny_gemm(F.lds, P_ + (size_t)MROW0 * PW, PW, WB_(WB_F2), DFF, 2048 / 16, F.bid, F.G, f); }
            SchedPlain S{P_, PW, WB_(WB_F2), DFF, NPMM, 8, F.G, F.bid, 0}; EpiRes E{OUT_, OUT_, HMETA_, DBG_SF, ly == 0 ? XN_ : (bf16_t*)nullptr, RS_(2)};
            pg8::gemm_phase(F.lds, S, E);
            SEAM(pb + 18);
        }
    }
#undef IN
#undef SEAM
}

__global__ void diag_fill(float* out, int n, float v) { for (int i = blockIdx.x * blockDim.x + threadIdx.x; i < n; i += gridDim.x * blockDim.x) out[i] = v; }
extern "C" void kernel_launch(void* const* d_in, const int* in_sizes, int n_in, void* d_out, int out_size, void* d_ws, size_t ws_size, hipStream_t stream) {
    static int grid = 0; static float code = 0.f;
    if (grid == 0) {
        int dev = 0, cus = 0;
        if (n_in != 19) { code = 10.f; grid = -1; }
        else if (ws_size < WS_END) { code = 20.f + (float)(ws_size >> 20) * 0.01f; grid = -1; }
        else if (hipGetDevice(&dev) != hipSuccess || hipDeviceGetAttribute(&cus, hipDeviceAttributeMultiprocessorCount, dev) != hipSuccess) { code = 40.f; grid = -1; }
        else if (hipFuncSetAttribute((const void*)mega_fwd, hipFuncAttributeMaxDynamicSharedMemorySize, LDS_BYTES) != hipSuccess) { code = 50.f; grid = -1; }
        else {
            int per_cu = 0;
            if (hipOccupancyMaxActiveBlocksPerMultiprocessor(&per_cu, (const void*)mega_fwd, NWAVES * 64, LDS_BYTES) != hipSuccess || per_cu < 1) { code = 60.f; grid = -1; }
            (void)hipGetLastError();
            if (grid == 0) grid = cus;
        }
    }
    if (grid < 0) { hipLaunchKernelGGL(diag_fill, dim3(1024), dim3(256), 0, stream, (float*)d_out, out_size, code); return; }
    (void)hipMemsetAsync((char*)d_ws + WS_CTL, 0, CTL_BYTES, stream);
    Args a{};
    for (int i = 0; i < 19; ++i) a.in[i] = (const float*)d_in[i];
    a.out = (float*)d_out; a.ws = (unsigned char*)d_ws;
#if MK_ONE_LAUNCH
    a.ph_lo = 0; a.ph_hi = N_PHASES;
    hipLaunchKernelGGL(mega_fwd, dim3(grid), dim3(NWAVES * 64), LDS_BYTES, stream, a);
#else
    for (int p = 0; p < N_PHASES; ++p) { a.ph_lo = p; a.ph_hi = p + 1; hipLaunchKernelGGL(mega_fwd, dim3(grid), dim3(NWAVES * 64), LDS_BYTES, stream, a); }
#endif
    if (hipPeekAtLastError() != hipSuccess) { (void)hipGetLastError(); hipLaunchKernelGGL(diag_fill, dim3(1024), dim3(256), 0, stream, (float*)d_out, out_size, 70.f); }
}
```

```cpp
#include <hip/hip_runtime.h>
#include <cstdio>
#include <cstdint>

#ifndef PHMASK
#define PHMASK 0x7fff
#endif
#ifndef REPMASK
#define REPMASK 0
#endif
#define NREP(k) ((((REPMASK) >> (k)) & 1) ? 2 : 1)
#ifndef DBG_BM
#define DBG_BM 7
#endif
#ifndef DBG_BR
#define DBG_BR 0
#endif
#ifndef DBG_SA
#define DBG_SA 1.0f
#endif
#ifndef DBG_SF
#define DBG_SF 1.0f
#endif
#ifndef MK_ONE_LAUNCH
#define MK_ONE_LAUNCH 1
#endif

#define LAS __attribute__((address_space(3)))
#define GAS __attribute__((address_space(1)))
typedef unsigned short bf16_t;
typedef short bf16x8 __attribute__((ext_vector_type(8)));
typedef float f32x4 __attribute__((ext_vector_type(4)));
typedef float f32x2 __attribute__((ext_vector_type(2)));
typedef unsigned u32x4 __attribute__((ext_vector_type(4)));
typedef unsigned u32x2 __attribute__((ext_vector_type(2)));
typedef unsigned long long rs_t;
__device__ __forceinline__ float rs_val(rs_t v) { return (float)((double)v * (1.0 / 4294967296.0)); }
__device__ __forceinline__ rs_t rs_fix(float ss) { return (rs_t)((double)ss * 4294967296.0); }

constexpr int DM = 2048, NB = 16, SEQ = 2048, NMETA = 16, MBLK = 256;
constexpr int R = MBLK + NB * SEQ;
constexpr int NPM = R / 256;
constexpr int NPMM = NPM - 1;
constexpr int MROW0 = MBLK - NMETA;
constexpr int NTOK = NB * SEQ;
constexpr int DFF = 5632;
constexpr int PW = 8448;
constexpr int C_CQ = 0, C_CKV = 512, C_KPE = 1024, C_IK = 1088, C_IW = 1152, C_DQ = 1280, C_DK = 2304, C_DV = 3328, C_IQ = 4352,
              C_FQ = 5376, C_FK = 6400, C_FV = 7424;
constexpr int C_KVRAW = 1280, C_QRAW = 3328, C_KPEH = 4864;
constexpr int C_OA = 0, C_OB = C_DQ, C_OC = C_FQ, C_MERGED = 2304;
constexpr int BMW = 66;
constexpr float EPS = 1e-6f;
constexpr float LOG2E = 1.4426950408889634f;
constexpr float C2_128 = 0.08838834764831845f * LOG2E;
constexpr float C2_192 = 0.07216878364870323f * LOG2E;
constexpr int D_IN = 14480;

constexpr size_t MiB = 1u << 20;
constexpr size_t WS_CTL = 0, CTL_BYTES = 1536 * 1024;
constexpr size_t WS_RSTD = 13 * MiB;
constexpr size_t WS_HMETA = 2 * MiB;
constexpr size_t WS_BM = 4 * MiB;
constexpr size_t WS_WB = 16 * MiB;
constexpr size_t WB_IN = 0, WB_G = WB_IN + (size_t)8448 * 2048 * 2, WB_QUP = WB_G + (size_t)6144 * 2048 * 2, WB_KVUP = WB_QUP + (size_t)1536 * 512 * 2,
                 WB_BR = WB_KVUP + (size_t)2048 * 512 * 2, WB_O = WB_BR + (size_t)3 * 2048 * 1024 * 2, WB_F1 = WB_O + (size_t)2048 * 2048 * 2,
                 WB_F2 = WB_F1 + (size_t)11264 * 2048 * 2, WB_END = WB_F2 + (size_t)2048 * 5632 * 2;
constexpr size_t WS_XN = 164 * MiB;
constexpr size_t WS_P = 294 * MiB;
constexpr size_t WS_GS = 828 * MiB;
constexpr size_t WS_END = 960 * MiB;
static_assert(WS_GS + (size_t)R * 2048 * 2 <= WS_END && WS_WB + WB_END <= WS_XN && WS_XN + (size_t)R * 2048 * 2 <= WS_P && WS_P + (size_t)R * PW * 2 <= WS_GS, "ws map");
constexpr int CW_BAR = 4096, CW_Q = 16384;
constexpr size_t WS_RS = 256 * 1024;
static_assert(WS_RS + (size_t)4 * R * 8 <= CTL_BYTES && CTL_BYTES <= WS_HMETA && WS_BM + (size_t)32768 * BMW * 4 <= WS_RSTD && WS_RSTD + 1 * MiB <= WS_WB, "ctl map");

__device__ __forceinline__ float bf2f(bf16_t v) { return __uint_as_float((unsigned)v << 16); }
__device__ __forceinline__ unsigned f2bf(float f) { unsigned u = __float_as_uint(f); return (u + 0x7fffu + ((u >> 16) & 1u)) >> 16; }
__device__ __forceinline__ unsigned pk2(float lo, float hi) { return f2bf(lo) | (f2bf(hi) << 16); }
typedef __bf16 bf16x2_t __attribute__((ext_vector_type(2)));
__device__ __forceinline__ unsigned cvt_pk_bf16(float lo, float hi) { f32x2 v = {lo, hi}; bf16x2_t b = __builtin_convertvector(v, bf16x2_t); return __builtin_bit_cast(unsigned, b); }
__device__ __forceinline__ float wave_sum(float v) {
#pragma unroll
    for (int o = 1; o < 64; o <<= 1) v += __shfl_xor(v, o);
    return v;
}
__device__ __forceinline__ float wave_max(float v) {
#pragma unroll
    for (int o = 1; o < 64; o <<= 1) v = fmaxf(v, __shfl_xor(v, o));
    return v;
}
#define LDS_WAIT() asm volatile("s_waitcnt lgkmcnt(0)" ::: "memory")
#define VM_WAIT() asm volatile("s_waitcnt vmcnt(0)" ::: "memory")
__device__ __forceinline__ int row_pos(int r) { return r < MBLK ? (r >= MBLK - NMETA ? r - (MBLK - NMETA) : 0) : NMETA + ((r - MBLK) & (SEQ - 1)); }
__device__ __forceinline__ void rope_cs(int pos, int i, float two_over_d, float& c, float& s) {
    const float inv = __builtin_amdgcn_exp2f(-(float)i * two_over_d * 13.287712379549449f);
    float rev = (float)pos * inv * 0.15915494309189535f;
    rev -= floorf(rev);
    s = __builtin_amdgcn_sinf(rev); c = __builtin_amdgcn_cosf(rev);
}

namespace pg8 {
constexpr int BM = 256, BK = 64, HALF = 128, HTB = HALF * BK * 2, STAGE_BYTES = 8 * HTB;
__device__ __forceinline__ int lds_byte(int r, int c) { const int st = (r >> 4) * 2 + (c >> 5), rr = r & 15, cc = c & 31, ob = rr * 64 + cc * 2; return st * 1024 + (ob ^ (((ob >> 9) & 1) << 5)); }
__device__ __forceinline__ void stage_rc(int b, int& R_, int& C_) { const int st = b / 1024, sb = b % 1024, swz = sb ^ (((sb >> 9) & 1) << 5); R_ = (st >> 1) * 16 + swz / 64; C_ = (st & 1) * 32 + (swz % 64) / 2; }
__device__ __forceinline__ int perm32(int rho) { const int n = rho >> 4, i = rho & 15; return 8 * (i >> 2) + 4 * n + (i & 3); }

struct Unit { const char* A; const char* B; unsigned lda2, ldb2; int nt, pm, pn, kind, ocol; };

#ifndef WGM
#define WGM 4
#endif
__device__ __forceinline__ void tile_of(int L, int nM, int nN, int& pm, int& pn) {
    const int nwg = nM * nN; int wgid = L;
    { const int q = nwg / 8, r = nwg % 8, xcd = wgid % 8, off = wgid / 8; wgid = (xcd < r ? xcd * (q + 1) : r * (q + 1) + (xcd - r) * q) + off; }
    const int nig = WGM * nN, gid = wgid / nig, fm = gid * WGM, gsz = (nM - fm) < WGM ? (nM - fm) : WGM;
    pm = fm + ((wgid % nig) % gsz); pn = (wgid % nig) / gsz;
}

template <class Epi, class Sched>
__device__ __forceinline__ void gemm_phase(LAS unsigned char* lds, const Sched& S, const Epi& E) {
    int tid = threadIdx.x; asm volatile("" : "+v"(tid));
    const int wid = __builtin_amdgcn_readfirstlane(tid >> 6), lane = tid & 63, wr = wid >> 2, wc = wid & 3, fr = lane & 15, fq = lane >> 4;
    unsigned rA[2], rB[2], cc[2];
#pragma unroll
    for (int i = 0; i < 2; ++i) { int R_, C_; stage_rc(tid * 16 + i * 8192, R_, C_); rA[i] = (unsigned)R_; rB[i] = (unsigned)(Epi::PERM ? ((R_ & ~31) + perm32(R_ & 31)) : R_); cc[i] = (unsigned)C_ * 2u; }
    const size_t kstep = (size_t)(BK * 2);
    const unsigned ldsw = (unsigned)wid * 1024u;
    const int aoff = lds_byte(wr * 64 + fr, fq * 8), boff = lds_byte(wc * 32 + fr, fq * 8);
#define PG8_SA(b, h) (((b) * 2 + (h)) * HTB)
#define PG8_SB(b, h) ((4 + (b) * 2 + (h)) * HTB)
#define PG8_STAGE(bufoff, gbase, rr, ld2) do { _Pragma("unroll") for (int _i = 0; _i < 2; ++_i) \
        __builtin_amdgcn_global_load_lds((const unsigned*)((const char*)(gbase) + ((rr)[_i] * (ld2) + cc[_i])), (LAS unsigned*)(lds + (bufoff) + ldsw + _i * 8192), 16, 0, 0); } while (0)
#define PG8_LDA(dst, b, h) do { _Pragma("unroll") for (int m = 0; m < 4; ++m) _Pragma("unroll") for (int k = 0; k < 2; ++k) dst[m][k] = *(const LAS bf16x8*)(lds + PG8_SA(b, h) + aoff + m * 2048 + k * 1024); } while (0)
#define PG8_LDB(dst, b, h) do { _Pragma("unroll") for (int n = 0; n < 2; ++n) _Pragma("unroll") for (int k = 0; k < 2; ++k) dst[n][k] = *(const LAS bf16x8*)(lds + PG8_SB(b, h) + boff + n * 2048 + k * 1024); } while (0)
#define PG8_MMA(ai, bj, At, Bt) do { __builtin_amdgcn_s_setprio(1); _Pragma("unroll") for (int m = 0; m < 4; ++m) _Pragma("unroll") for (int n = 0; n < 2; ++n) _Pragma("unroll") for (int k = 0; k < 2; ++k) \
        acc[ai][bj][m][n] = __builtin_amdgcn_mfma_f32_16x16x32_bf16(Bt[n][k], At[m][k], acc[ai][bj][m][n], 0, 0, 0); __builtin_amdgcn_s_setprio(0); } while (0)
#define PG8_WAIT_V(n) asm volatile("s_waitcnt vmcnt(" #n ")" ::: "memory")
#define PG8_WAIT_L(n) asm volatile("s_waitcnt lgkmcnt(" #n ")" ::: "memory")
#define PG8_BAR __builtin_amdgcn_s_barrier()
#define PG8_SCHED __builtin_amdgcn_sched_barrier(0)
    Unit cur, nxt; int ui = 0;
    if (!S.next(0, cur)) return;
    float zf = 0.f; asm volatile("" : "+v"(zf));
    f32x4 acc[2][2][4][2];
#pragma unroll
    for (int a = 0; a < 2; ++a)
#pragma unroll
        for (int b = 0; b < 2; ++b)
#pragma unroll
            for (int m = 0; m < 4; ++m)
#pragma unroll
                for (int n = 0; n < 2; ++n) acc[a][b][m][n] = (f32x4){zf, zf, zf, zf};
    bf16x8 At[4][2], B0[2][2], B1[2][2];
    const char* cA = cur.A; const char* cB = cur.B;
    unsigned lA = cur.lda2, lB = cur.ldb2;
    size_t hA = (size_t)HALF * lA, hB = (size_t)HALF * lB;
    PG8_STAGE(PG8_SB(0, 0), cB, rB, lB); PG8_STAGE(PG8_SB(0, 1), cB + hB, rB, lB); PG8_STAGE(PG8_SA(0, 0), cA, rA, lA); PG8_STAGE(PG8_SA(0, 1), cA + hA, rA, lA);
    if (wr == 1) PG8_BAR;
    PG8_WAIT_V(2); PG8_BAR;
    PG8_STAGE(PG8_SB(1, 0), cB + kstep, rB, lB); PG8_STAGE(PG8_SA(1, 0), cA + kstep, rA, lA); PG8_STAGE(PG8_SB(1, 1), cB + hB + kstep, rB, lB);
    PG8_WAIT_V(6); PG8_BAR;
    for (;;) {
        const bool has_next = S.next(ui + 1, nxt);
        if (!has_next) nxt = cur;
        const char* nA = nxt.A; const char* nB = nxt.B;
        const unsigned lAn = nxt.lda2, lBn = nxt.ldb2;
        const size_t hAn = (size_t)HALF * lAn, hBn = (size_t)HALF * lBn;
        const int nt = cur.nt;
        for (int t = 0; t < nt; t += 2) {
            const bool last = (t == nt - 2);
            const char* a1 = cA + (size_t)(t + 1) * kstep;
            const char* a2 = last ? nA : cA + (size_t)(t + 2) * kstep; const char* b2 = last ? nB : cB + (size_t)(t + 2) * kstep;
            const char* a3 = a2 + kstep; const char* b3 = b2 + kstep;
            const size_t hA2 = last ? hAn : hA, hB2 = last ? hBn : hB;
            const unsigned lA2 = last ? lAn : lA, lB2 = last ? lBn : lB;
            PG8_LDB(B0, 0, 0); PG8_LDB(B1, 0, 1); PG8_SCHED; PG8_LDA(At, 0, 0); PG8_STAGE(PG8_SA(1, 1), a1 + hA, rA, lA);
            PG8_WAIT_V(8); PG8_WAIT_L(0); PG8_BAR; PG8_MMA(0, 0, At, B0); PG8_MMA(0, 1, At, B1); PG8_BAR; PG8_SCHED;
            PG8_LDA(At, 0, 1); PG8_STAGE(PG8_SB(0, 0), b2, rB, lB2); PG8_STAGE(PG8_SB(0, 1), b2 + hB2, rB, lB2); PG8_STAGE(PG8_SA(0, 0), a2, rA, lA2);
            PG8_WAIT_V(8); PG8_WAIT_L(0); PG8_BAR; PG8_MMA(1, 0, At, B0); PG8_MMA(1, 1, At, B1); PG8_BAR; PG8_SCHED;
            PG8_LDB(B0, 1, 0); PG8_LDB(B1, 1, 1); PG8_SCHED; PG8_LDA(At, 1, 0); PG8_STAGE(PG8_SA(0, 1), a2 + hA2, rA, lA2);
            PG8_WAIT_V(8); PG8_WAIT_L(0); PG8_BAR; PG8_MMA(0, 0, At, B0); PG8_MMA(0, 1, At, B1); PG8_BAR; PG8_SCHED;
            PG8_LDA(At, 1, 1); PG8_STAGE(PG8_SB(1, 0), b3, rB, lB2); PG8_STAGE(PG8_SB(1, 1), b3 + hB2, rB, lB2); PG8_STAGE(PG8_SA(1, 0), a3, rA, lA2);
            PG8_WAIT_V(8); PG8_WAIT_L(0); PG8_BAR; PG8_MMA(1, 0, At, B0); PG8_MMA(1, 1, At, B1); PG8_BAR; PG8_SCHED;
        }
        if (wr == 0) PG8_BAR;
        E(acc, cur, wr, wc, fr, fq);
#pragma unroll
        for (int a = 0; a < 2; ++a)
#pragma unroll
            for (int b = 0; b < 2; ++b)
#pragma unroll
                for (int m = 0; m < 4; ++m)
#pragma unroll
                    for (int n = 0; n < 2; ++n) acc[a][b][m][n] = (f32x4){zf, zf, zf, zf};
        if (!has_next) break;
        cur = nxt; cA = nA; cB = nB; hA = hAn; hB = hBn; lA = lAn; lB = lBn; ++ui;
        if (wr == 1) PG8_BAR;
    }
    PG8_WAIT_V(0);
    PG8_BAR;
#undef PG8_SA
#undef PG8_SB
#undef PG8_STAGE
#undef PG8_LDA
#undef PG8_LDB
#undef PG8_MMA
#undef PG8_WAIT_V
#undef PG8_WAIT_L
#undef PG8_BAR
#undef PG8_SCHED
}
}
using pg8::Unit;

struct SchedPlain {
    const bf16_t* A; int lda; const bf16_t* B; int K; int nM, nN, G, c, ocol0;
    __device__ __forceinline__ bool next(int i, Unit& u) const {
        const int L = i * G + c; if (L >= nM * nN) return false;
        int pm, pn; pg8::tile_of(L, nM, nN, pm, pn); pm += 1;
        u.pm = pm; u.pn = pn; u.kind = 0; u.ocol = ocol0 + 256 * pn; u.nt = K / 64; u.lda2 = (unsigned)lda * 2u; u.ldb2 = (unsigned)K * 2u;
        u.A = (const char*)(A + (size_t)pm * 256 * lda); u.B = (const char*)(B + (size_t)pn * 256 * K); return true;
    }
};
struct SchedMlaUp {
    const bf16_t* P; const bf16_t* Wq; const bf16_t* Wkv; int G, c;
    __device__ __forceinline__ bool next(int i, Unit& u) const {
        const int L = i * G + c; if (L >= NPMM * 14) return false;
        int pm, pn; pg8::tile_of(L, NPMM, 14, pm, pn); pm += 1;
        u.pm = pm; u.pn = pn; u.kind = 0; u.nt = 8; u.lda2 = PW * 2u; u.ldb2 = 512 * 2u;
        if (pn < 6) { u.A = (const char*)(P + (size_t)pm * 256 * PW + C_CQ); u.B = (const char*)(Wq + (size_t)pn * 256 * 512); u.ocol = C_QRAW + 256 * pn; }
        else { u.A = (const char*)(P + (size_t)pm * 256 * PW + C_CKV); u.B = (const char*)(Wkv + (size_t)(pn - 6) * 256 * 512); u.ocol = C_KVRAW + 256 * (pn - 6); }
        return true;
    }
};
struct EpiP {
    static constexpr bool PERM = true;
    bf16_t* P; const rs_t* rs;
    __device__ __forceinline__ void operator()(const f32x4 (&acc)[2][2][4][2], const Unit& u, int wr, int wc, int fr, int fq) const {
        asm volatile("" : "+v"(fr), "+v"(fq));
        const int row0 = u.pm * 256 + wr * 64 + fr, col0 = u.ocol + wc * 32 + 8 * fq;
#pragma unroll
        for (int ai = 0; ai < 2; ++ai)
#pragma unroll
            for (int m = 0; m < 4; ++m) { bf16_t* rowp = P + (size_t)(row0 + ai * 128 + m * 16) * PW + col0;
                const float sc = rs ? __builtin_amdgcn_rsqf(rs_val(rs[row0 + ai * 128 + m * 16]) * (1.f / DM) + EPS) : 1.f;
#pragma unroll
                for (int bj = 0; bj < 2; ++bj) { const f32x4 v0 = acc[ai][bj][m][0] * sc, v1 = acc[ai][bj][m][1] * sc;
                    u32x4 w; w.x = cvt_pk_bf16(v0[0], v0[1]); w.y = cvt_pk_bf16(v0[2], v0[3]); w.z = cvt_pk_bf16(v1[0], v1[1]); w.w = cvt_pk_bf16(v1[2], v1[3]);
                    *(u32x4*)(rowp + bj * 128) = w; } }
    }
};
struct EpiG2 {
    static constexpr bool PERM = true;
    bf16_t* P; const rs_t* rs; const float* gperm; LAS float* xl;
    __device__ __forceinline__ void operator()(const f32x4 (&acc)[2][2][4][2], const Unit& u, int wr, int wc, int fr, int fq) const {
        asm volatile("" : "+v"(fr), "+v"(fq));
        const int row0 = u.pm * 256 + wr * 64 + fr, lcol = wc * 32 + 8 * fq, col0 = u.ocol + lcol;
        const int pn = u.pn;
        const bool plain = (pn >= 8 && pn < 12) || pn >= 24, isidx = (pn >= 12 && pn < 16), nrm = !plain && !isidx;
        float rsc[2][4];
#pragma unroll
        for (int ai = 0; ai < 2; ++ai)
#pragma unroll
            for (int m = 0; m < 4; ++m) rsc[ai][m] = __builtin_amdgcn_rsqf(rs_val(rs[row0 + ai * 128 + m * 16]) * (1.f / DM) + EPS);
        if (nrm) {
#pragma unroll
            for (int ai = 0; ai < 2; ++ai)
#pragma unroll
                for (int m = 0; m < 4; ++m)
#pragma unroll
                    for (int bj = 0; bj < 2; ++bj) { const f32x4 a = acc[ai][bj][m][0], b = acc[ai][bj][m][1]; float ss = (a[0] * a[0] + a[1] * a[1]) + (a[2] * a[2] + a[3] * a[3]) + (b[0] * b[0] + b[1] * b[1]) + (b[2] * b[2] + b[3] * b[3]);
                        ss += __shfl_xor(ss, 16); ss += __shfl_xor(ss, 32);
                        if (fq == 0) xl[((wr * 64 + fr + ai * 128 + m * 16) * 2 + bj) * 4 + wc] = ss * rsc[ai][m] * rsc[ai][m]; }
            asm volatile("s_waitcnt lgkmcnt(0)" ::: "memory"); __builtin_amdgcn_s_barrier(); asm volatile("" ::: "memory");
        }
        const int i0 = isidx ? (16 * (wc & 1) + 4 * fq) : (16 * wc + 4 * fq);
        const float tod = isidx ? (2.f / 64.f) : (2.f / 128.f);
        float inv[4];
#pragma unroll
        for (int j = 0; j < 4; ++j) inv[j] = __builtin_amdgcn_exp2f(-(float)(i0 + j) * tod * 13.287712379549449f) * 0.15915494309189535f;
        const int gidx = pn < 4 ? 0 : (pn < 8 ? 1 : (pn < 20 ? 2 : 3));
        const float qscale = (pn < 4 || (pn >= 16 && pn < 20)) ? C2_128 : 1.f;
        f32x4 g0 = (f32x4){1.f, 1.f, 1.f, 1.f}, g1 = g0;
        if (nrm) { g0 = *(const f32x4*)(gperm + gidx * 128 + lcol); g1 = *(const f32x4*)(gperm + gidx * 128 + lcol + 4); }
#pragma unroll
        for (int ai = 0; ai < 2; ++ai)
#pragma unroll
            for (int m = 0; m < 4; ++m) { const int row = row0 + ai * 128 + m * 16; bf16_t* rowp = P + (size_t)row * PW + col0;
                float cs[4], sn[4];
                if (!plain) { const float pos = (float)(NMETA + ((row - MBLK) & (SEQ - 1)));
#pragma unroll
                    for (int j = 0; j < 4; ++j) { float rev = pos * inv[j]; rev -= floorf(rev); sn[j] = __builtin_amdgcn_sinf(rev); cs[j] = __builtin_amdgcn_cosf(rev); } }
#pragma unroll
                for (int bj = 0; bj < 2; ++bj) { f32x4 v0 = acc[ai][bj][m][0] * rsc[ai][m], v1 = acc[ai][bj][m][1] * rsc[ai][m];
                    if (!plain) {
                        if (nrm) { const LAS f32x4* xp = (const LAS f32x4*)(xl + ((wr * 64 + fr + ai * 128 + m * 16) * 2 + bj) * 4); const f32x4 pp = *xp;
                            const float rn = __builtin_amdgcn_rsqf(((pp[0] + pp[1]) + (pp[2] + pp[3])) * (1.f / 128.f) + EPS); v0 = v0 * (g0 * rn); v1 = v1 * (g1 * rn); }
                        f32x4 w0, w1;
                        w0[0] = v0[0] * cs[0] - v0[1] * sn[0]; w0[1] = v0[1] * cs[0] + v0[0] * sn[0]; w0[2] = v0[2] * cs[1] - v0[3] * sn[1]; w0[3] = v0[3] * cs[1] + v0[2] * sn[1];
                        w1[0] = v1[0] * cs[2] - v1[1] * sn[2]; w1[1] = v1[1] * cs[2] + v1[0] * sn[2]; w1[2] = v1[2] * cs[3] - v1[3] * sn[3]; w1[3] = v1[3] * cs[3] + v1[2] * sn[3];
                        v0 = w0 * qscale; v1 = w1 * qscale; }
                    u32x4 w; w.x = cvt_pk_bf16(v0[0], v0[1]); w.y = cvt_pk_bf16(v0[2], v0[3]); w.z = cvt_pk_bf16(v1[0], v1[1]); w.w = cvt_pk_bf16(v1[2], v1[3]);
                    *(u32x4*)(rowp + bj * 128) = w; } }
    }
};
struct EpiGate {
    static constexpr bool PERM = true;
    bf16_t* G; const float* bias; const rs_t* rs;
    __device__ __forceinline__ void operator()(const f32x4 (&acc)[2][2][4][2], const Unit& u, int wr, int wc, int fr, int fq) const {
        asm volatile("" : "+v"(fr), "+v"(fq));
        const int row0 = u.pm * 256 + wr * 64 + fr, col0 = u.pn * 256 + wc * 32 + 8 * fq;
        float rsc[2][4];
#pragma unroll
        for (int ai = 0; ai < 2; ++ai)
#pragma unroll
            for (int m = 0; m < 4; ++m) rsc[ai][m] = __builtin_amdgcn_rsqf(rs_val(rs[row0 + ai * 128 + m * 16]) * (1.f / DM) + EPS);
#pragma unroll
        for (int bj = 0; bj < 2; ++bj) { const f32x4 bv0 = *(const f32x4*)(bias + col0 + bj * 128), bv1 = *(const f32x4*)(bias + col0 + bj * 128 + 4);
#pragma unroll
            for (int ai = 0; ai < 2; ++ai)
#pragma unroll
                for (int m = 0; m < 4; ++m) { bf16_t* rowp = G + (size_t)(row0 + ai * 128 + m * 16) * 2048 + col0; f32x4 v0 = acc[ai][bj][m][0] * rsc[ai][m] + bv0, v1 = acc[ai][bj][m][1] * rsc[ai][m] + bv1;
#pragma unroll
                    for (int e = 0; e < 4; ++e) { v0[e] = __builtin_amdgcn_rcpf(1.f + __builtin_amdgcn_exp2f(-v0[e] * LOG2E)); v1[e] = __builtin_amdgcn_rcpf(1.f + __builtin_amdgcn_exp2f(-v1[e] * LOG2E)); }
                    u32x4 w; w.x = cvt_pk_bf16(v0[0], v0[1]); w.y = cvt_pk_bf16(v0[2], v0[3]); w.z = cvt_pk_bf16(v1[0], v1[1]); w.w = cvt_pk_bf16(v1[2], v1[3]);
                    *(u32x4*)(rowp + bj * 128) = w; } }
    }
};
struct EpiGated {
    static constexpr bool PERM = true;
    bf16_t* P; const bf16_t* G; int first; float sc;
    __device__ __forceinline__ void operator()(const f32x4 (&acc)[2][2][4][2], const Unit& u, int wr, int wc, int fr, int fq) const {
        asm volatile("" : "+v"(fr), "+v"(fq));
        const int row0 = u.pm * 256 + wr * 64 + fr, lcol0 = u.pn * 256 + wc * 32 + 8 * fq, col0 = u.ocol + wc * 32 + 8 * fq;
        unsigned zu = 0u; asm volatile("" : "+v"(zu));
#pragma unroll
        for (int ai = 0; ai < 2; ++ai)
#pragma unroll
            for (int m = 0; m < 4; ++m) { bf16_t* rowp = P + (size_t)(row0 + ai * 128 + m * 16) * PW + col0; const bf16_t* gp = G + (size_t)(row0 + ai * 128 + m * 16) * 2048 + lcol0;
#pragma unroll
                for (int bj = 0; bj < 2; ++bj) { u32x4 g = *(const u32x4*)(gp + bj * 128); if (DBG_BR == 1) g = (u32x4){0x3f803f80u, 0x3f803f80u, 0x3f803f80u, 0x3f803f80u};
                    u32x4 pv = (u32x4){zu, zu, zu, zu}; if (!first) pv = *(const u32x4*)(rowp + bj * 128);
                    const f32x4 v0 = acc[ai][bj][m][0] * sc, v1 = acc[ai][bj][m][1] * sc;
                    float o[8];
                    o[0] = __uint_as_float(pv.x << 16) + __uint_as_float(g.x << 16) * v0[0]; o[1] = __uint_as_float(pv.x & 0xffff0000u) + __uint_as_float(g.x & 0xffff0000u) * v0[1];
                    o[2] = __uint_as_float(pv.y << 16) + __uint_as_float(g.y << 16) * v0[2]; o[3] = __uint_as_float(pv.y & 0xffff0000u) + __uint_as_float(g.y & 0xffff0000u) * v0[3];
                    o[4] = __uint_as_float(pv.z << 16) + __uint_as_float(g.z << 16) * v1[0]; o[5] = __uint_as_float(pv.z & 0xffff0000u) + __uint_as_float(g.z & 0xffff0000u) * v1[1];
                    o[6] = __uint_as_float(pv.w << 16) + __uint_as_float(g.w << 16) * v1[2]; o[7] = __uint_as_float(pv.w & 0xffff0000u) + __uint_as_float(g.w & 0xffff0000u) * v1[3];
                    u32x4 w; w.x = cvt_pk_bf16(o[0], o[1]); w.y = cvt_pk_bf16(o[2], o[3]); w.z = cvt_pk_bf16(o[4], o[5]); w.w = cvt_pk_bf16(o[6], o[7]);
                    *(u32x4*)(rowp + bj * 128) = w; }
                asm volatile("" ::: "memory"); }
    }
};
struct EpiRes {
    static constexpr bool PERM = true;
    const float* base_f; float* out_f; float dbg; bf16_t* hb; rs_t* rs;
    __device__ __forceinline__ void operator()(const f32x4 (&acc)[2][2][4][2], const Unit& u, int wr, int wc, int fr, int fq) const {
        asm volatile("" : "+v"(fr), "+v"(fq));
        const int lrow0 = wr * 64 + fr, col0 = u.pn * 256 + wc * 32 + 8 * fq;
#pragma unroll
        for (int ai = 0; ai < 2; ++ai)
#pragma unroll
            for (int m = 0; m < 4; ++m) { const int lrow = lrow0 + ai * 128 + m * 16, grow = u.pm * 256 + lrow;
                const size_t foff = ((size_t)(u.pm - 1) * 256 + lrow) * DM + col0; bf16_t* hp = hb + (size_t)grow * DM + col0; float ss = 0.f;
#pragma unroll
                for (int bj = 0; bj < 2; ++bj) { f32x4 b0, b1;
                    if (base_f) { b0 = *(const f32x4*)(base_f + foff + bj * 128); b1 = *(const f32x4*)(base_f + foff + bj * 128 + 4); }
                    else { const u32x4 w = *(const u32x4*)(hp + bj * 128);
                        b0 = (f32x4){__uint_as_float(w.x << 16), __uint_as_float(w.x & 0xffff0000u), __uint_as_float(w.y << 16), __uint_as_float(w.y & 0xffff0000u)};
                        b1 = (f32x4){__uint_as_float(w.z << 16), __uint_as_float(w.z & 0xffff0000u), __uint_as_float(w.w << 16), __uint_as_float(w.w & 0xffff0000u)}; }
                    const f32x4 h0 = b0 + acc[ai][bj][m][0] * dbg, h1 = b1 + acc[ai][bj][m][1] * dbg;
                    if (out_f) { *(f32x4*)(out_f + foff + bj * 128) = h0; *(f32x4*)(out_f + foff + bj * 128 + 4) = h1; }
                    else { ss += ((h0[0] * h0[0] + h0[1] * h0[1]) + (h0[2] * h0[2] + h0[3] * h0[3])) + ((h1[0] * h1[0] + h1[1] * h1[1]) + (h1[2] * h1[2] + h1[3] * h1[3]));
                        u32x4 w; w.x = cvt_pk_bf16(h0[0], h0[1]); w.y = cvt_pk_bf16(h0[2], h0[3]); w.z = cvt_pk_bf16(h1[0], h1[1]); w.w = cvt_pk_bf16(h1[2], h1[3]); *(u32x4*)(hp + bj * 128) = w; } }
                if (!out_f) { ss += __shfl_xor(ss, 16); ss += __shfl_xor(ss, 32); if (fq == 0) (void)__hip_atomic_fetch_add(rs + grow, rs_fix(ss), __ATOMIC_RELAXED, __HIP_MEMORY_SCOPE_AGENT); }
                asm volatile("" ::: "memory"); }
    }
};
struct EpiSwiglu {
    static constexpr bool PERM = true;
    bf16_t* P; const rs_t* rs;
    __device__ __forceinline__ void operator()(const f32x4 (&acc)[2][2][4][2], const Unit& u, int wr, int wc, int fr, int fq) const {
        asm volatile("" : "+v"(fr), "+v"(fq));
        const int row0 = u.pm * 256 + wr * 64 + fr, col0 = u.pn * 128 + wc * 32 + 8 * fq;
#pragma unroll
        for (int ai = 0; ai < 2; ++ai)
#pragma unroll
            for (int m = 0; m < 4; ++m) { bf16_t* rowp = P + (size_t)(row0 + ai * 128 + m * 16) * PW + col0;
                const float sc = __builtin_amdgcn_rsqf(rs_val(rs[row0 + ai * 128 + m * 16]) * (1.f / DM) + EPS);
                float o[8];
#pragma unroll
                for (int n = 0; n < 2; ++n)
#pragma unroll
                    for (int e = 0; e < 4; ++e) { const float g = acc[ai][0][m][n][e] * sc, up = acc[ai][1][m][n][e] * sc; o[n * 4 + e] = g * __builtin_amdgcn_rcpf(1.f + __builtin_amdgcn_exp2f(-g * LOG2E)) * up; }
                u32x4 w; w.x = cvt_pk_bf16(o[0], o[1]); w.y = cvt_pk_bf16(o[2], o[3]); w.z = cvt_pk_bf16(o[4], o[5]); w.w = cvt_pk_bf16(o[6], o[7]);
                *(u32x4*)rowp = w; }
    }
};

struct SkP { bf16_t* P; int ocol; const rs_t* rs; __device__ __forceinline__ void operator()(int r, int c, float v) const { if (rs) v *= __builtin_amdgcn_rsqf(rs_val(rs[MROW0 + r]) * (1.f / DM) + EPS); P[(size_t)(MROW0 + r) * PW + ocol + c] = (bf16_t)f2bf(v); } };
struct SkGate { bf16_t* G; const float* bias; const rs_t* rs; __device__ __forceinline__ void operator()(int r, int c, float v) const { v *= __builtin_amdgcn_rsqf(rs_val(rs[MROW0 + r]) * (1.f / DM) + EPS); G[(size_t)(MROW0 + r) * 2048 + c] = (bf16_t)f2bf(__builtin_amdgcn_rcpf(1.f + __builtin_amdgcn_exp2f(-(v + bias[c]) * LOG2E))); } };
struct SkGated { bf16_t* P; const bf16_t* G; int first; __device__ __forceinline__ void operator()(int r, int c, float v) const { bf16_t* p = P + (size_t)(MROW0 + r) * PW + C_MERGED + c; const float pv = first ? 0.f : bf2f(*p); *p = (bf16_t)f2bf(pv + bf2f(G[(size_t)(MROW0 + r) * 2048 + c]) * v); } };
struct SkRes { float* hmeta; bf16_t* hb; rs_t* rs;
    __device__ __forceinline__ void operator()(int r, int c, float v) const { float* p = hmeta + (size_t)(MROW0 + r) * DM + c; const float hv = *p + v; *p = hv;
        if (hb) { hb[(size_t)(MROW0 + r) * DM + c] = (bf16_t)f2bf(hv); float ss = hv * hv; ss += __shfl_xor(ss, 1); ss += __shfl_xor(ss, 2); ss += __shfl_xor(ss, 4); ss += __shfl_xor(ss, 8);
            if ((threadIdx.x & 15) == 0) (void)__hip_atomic_fetch_add(rs + MROW0 + r, rs_fix(ss), __ATOMIC_RELAXED, __HIP_MEMORY_SCOPE_AGENT); } } };
template <class Fn>
__device__ __forceinline__ void skinny_gemm(LAS unsigned char* lds, const bf16_t* A, int lda, const bf16_t* Bt, int K, int ntask, int bid, int G, const Fn& f) {
    int tid = threadIdx.x; asm volatile("" : "+v"(tid));
    const int wid = __builtin_amdgcn_readfirstlane(tid >> 6), lane = tid & 63, l15 = lane & 15, kq = lane >> 4;
    LAS f32x4* red = (LAS f32x4*)lds;
    const int kw = K / 8;
    for (int task = bid; task < ntask; task += G) {
        const bf16_t* ap = A + (size_t)l15 * lda + wid * kw + kq * 8;
        const bf16_t* bp = Bt + (size_t)(task * 16 + l15) * K + wid * kw + kq * 8;
        float z = 0.f; asm volatile("" : "+v"(z));
        f32x4 acc = (f32x4){z, z, z, z};
        for (int k0 = 0; k0 < kw; k0 += 256) {
            bf16x8 fa[8], fb[8];
#pragma unroll
            for (int i = 0; i < 8; ++i) { const int k = (k0 + 32 * i < kw) ? k0 + 32 * i : 0; fa[i] = *(const bf16x8*)(ap + k); fb[i] = *(const bf16x8*)(bp + k); }
#pragma unroll
            for (int i = 0; i < 8; ++i) if (k0 + 32 * i < kw) acc = __builtin_amdgcn_mfma_f32_16x16x32_bf16(fa[i], fb[i], acc, 0, 0, 0);
        }
        red[wid * 64 + lane] = acc;
        LDS_WAIT(); __syncthreads();
        if (wid == 0) {
            f32x4 s = red[lane];
#pragma unroll
            for (int w = 1; w < 8; ++w) s += red[w * 64 + lane];
#pragma unroll
            for (int r = 0; r < 4; ++r) f(kq * 4 + r, task * 16 + l15, s[r]);
        }
        __syncthreads();
    }
}
__device__ __forceinline__ void skinny_swiglu(LAS unsigned char* lds, const bf16_t* A, int lda, const bf16_t* Bt, int K, bf16_t* P, const rs_t* rs, int bid, int G) {
    int tid = threadIdx.x; asm volatile("" : "+v"(tid));
    const int wid = __builtin_amdgcn_readfirstlane(tid >> 6), lane = tid & 63, l15 = lane & 15, kq = lane >> 4;
    LAS f32x4* red = (LAS f32x4*)lds;
    const int kw = K / 8;
    for (int task = bid; task < DFF / 16; task += G) {
        const int c0 = task * 16, brow = (c0 >> 7) * 256 + (c0 & 127) + l15;
        const bf16_t* ap = A + (size_t)l15 * lda + wid * kw + kq * 8;
        const bf16_t* bg = Bt + (size_t)brow * K + wid * kw + kq * 8; const bf16_t* bu = bg + (size_t)128 * K;
        float z = 0.f; asm volatile("" : "+v"(z));
        f32x4 ag = (f32x4){z, z, z, z}, au = ag;
        {
            bf16x8 fa[8], fg[8], fu[8];
#pragma unroll
            for (int i = 0; i < 8; ++i) { fa[i] = *(const bf16x8*)(ap + 32 * i); fg[i] = *(const bf16x8*)(bg + 32 * i); fu[i] = *(const bf16x8*)(bu + 32 * i); }
#pragma unroll
            for (int i = 0; i < 8; ++i) { ag = __builtin_amdgcn_mfma_f32_16x16x32_bf16(fa[i], fg[i], ag, 0, 0, 0); au = __builtin_amdgcn_mfma_f32_16x16x32_bf16(fa[i], fu[i], au, 0, 0, 0); }
        }
        red[wid * 64 + lane] = ag; red[512 + wid * 64 + lane] = au;
        LDS_WAIT(); __syncthreads();
        if (wid == 0) {
            f32x4 sg = red[lane], su = red[512 + lane];
#pragma unroll
            for (int w = 1; w < 8; ++w) { sg += red[w * 64 + lane]; su += red[512 + w * 64 + lane]; }
#pragma unroll
            for (int r = 0; r < 4; ++r) { const float sc = __builtin_amdgcn_rsqf(rs_val(rs[MROW0 + kq * 4 + r]) * (1.f / DM) + EPS); const float g = sg[r] * sc; su[r] *= sc; P[(size_t)(MROW0 + kq * 4 + r) * PW + c0 + l15] = (bf16_t)f2bf(g * __builtin_amdgcn_rcpf(1.f + __builtin_amdgcn_exp2f(-g * LOG2E)) * su[r]); }
        }
        __syncthreads();
    }
}

#define XB_TMO      128
#define XB_XCNT(j)  (256  + 64 * (j))
#define XB_XSUB(j)  (1280 + 64 * (j))
#define XB_XGEN(j)  (2304 + 64 * (j))
#define XB_TOP      3328
#define XB_TOPGEN   3392
#define XCD_BAR_WORDS 3456
#define XB_SPIN_CAP (1u << 18)
__device__ __forceinline__ unsigned xb_ld(unsigned* p)              { return __hip_atomic_load(p, __ATOMIC_RELAXED, __HIP_MEMORY_SCOPE_AGENT); }
__device__ __forceinline__ unsigned xb_add(unsigned* p, unsigned v) { return __hip_atomic_fetch_add(p, v, __ATOMIC_RELAXED, __HIP_MEMORY_SCOPE_AGENT); }
__device__ __forceinline__ unsigned xb_xcc_id() { return (unsigned)__builtin_amdgcn_s_getreg((3 << 11) | 20) & 0xFu; }
#define XB_SPIN(cond, bar) do { unsigned _sp = 0; while (cond) { __builtin_amdgcn_s_sleep(1); \
    if ((++_sp & 255u) == 0u) { if (xb_ld(&(bar)[XB_TMO])) break; if (_sp > XB_SPIN_CAP) { atomicAdd(&(bar)[XB_TMO], 1u); break; } } } } while (0)
struct XcdBarrier { unsigned* bar; unsigned x; volatile LAS unsigned* st; };
__device__ __forceinline__ XcdBarrier xcd_barrier_post(unsigned* bar, volatile LAS unsigned* st) {
    XcdBarrier b; b.bar = bar; b.x = xb_xcc_id(); b.st = st;
    if (threadIdx.x == 0) (void)xb_add(&bar[XB_XCNT(b.x)], 1u);
    return b;
}
__device__ __forceinline__ void xcd_barrier_complete(unsigned* bar, unsigned x, unsigned& nloc, unsigned& nx) {
    const unsigned G = gridDim.x * gridDim.y * gridDim.z;
    unsigned sum, cnt, mine, sp = 0u;
    for (;;) {
        sum = 0u; cnt = 0u; mine = 0u;
#pragma unroll
        for (unsigned j = 0; j < 16; ++j) { const unsigned c = xb_ld(&bar[XB_XCNT(j)]); sum += c; cnt += (c > 0u) ? 1u : 0u; mine = (j == x) ? c : mine; }
        if (sum == G) break;
        __builtin_amdgcn_s_sleep(1);
        if ((++sp & 255u) == 0u) { if (xb_ld(&bar[XB_TMO])) break; if (sp > XB_SPIN_CAP) { atomicAdd(&bar[XB_TMO], 1u); break; } }
    }
    nloc = mine > 0u ? mine : 1u; nx = cnt > 0u ? cnt : 1u;
}
__device__ __forceinline__ void xcd_barrier(const XcdBarrier& b) {
    asm volatile("s_waitcnt vmcnt(0)" ::: "memory");
    __syncthreads();
    if (threadIdx.x == 0) {
        unsigned* bar = b.bar;
        __builtin_amdgcn_s_waitcnt(0);
        unsigned nloc = b.st[0], nx = b.st[1];
        if (nloc == 0u) { xcd_barrier_complete(bar, b.x, nloc, nx); b.st[0] = nloc; b.st[1] = nx; }
        const unsigned old = xb_add(&bar[XB_XSUB(b.x)], 1u);
        const unsigned gen = old / nloc;
        if (old + 1u == (gen + 1u) * nloc) {
            __builtin_amdgcn_fence(__ATOMIC_RELEASE, "agent");
            asm volatile("s_waitcnt vmcnt(0)" ::: "memory");
            const unsigned og = xb_add(&bar[XB_TOP], 1u);
            const unsigned tg = og / nx;
            if (og + 1u == (tg + 1u) * nx) xb_add(&bar[XB_TOPGEN], 1u);
            else XB_SPIN(xb_ld(&bar[XB_TOPGEN]) == tg, bar);
            __builtin_amdgcn_fence(__ATOMIC_ACQUIRE, "agent");
            xb_add(&bar[XB_XGEN(b.x)], 1u);
            asm volatile("s_waitcnt vmcnt(0)" ::: "memory");
        } else {
            XB_SPIN(xb_ld(&bar[XB_XGEN(b.x)]) == gen, bar);
            __builtin_amdgcn_fence(__ATOMIC_ACQUIRE, "agent");
            asm volatile("s_waitcnt vmcnt(0)" ::: "memory");
        }
    }
    __syncthreads();
}

constexpr int NWAVES = 8;
constexpr int RING_BYTES = 131072, LDS_BYTES = 147456, LDSCTL_OFF = LDS_BYTES - 512;
struct Args {
    const float* in[19]; float* out; unsigned char* ws; int ph_lo, ph_hi;
};
struct Ctx {
    LAS unsigned char* lds; int tid, lane, wave, gw, ngw, G, bid;
};

template <int MAP> __device__ __forceinline__ int wmap(int n, float& sc) {
    sc = 1.f;
    if (MAP == 0) return n;
    if (MAP == 1) {
        if (n < 1088) return n;
        if (n < 3136) { const int m = n - 1088, d = m & 127; return 1280 + (m - d) + (d < 64 ? 2 * d : 2 * (d - 64) + 1); }
        if (n < 4160) return 1280 + (n - 1088);
        if (n < 5184) { const int m = n - 4160, d = m & 63; return 4352 + (m - d) + (d < 32 ? 2 * d : 2 * (d - 32) + 1); }
        if (n < 5248) { const int d = n - 5184; return 1088 + (d < 32 ? 2 * d : 2 * (d - 32) + 1); }
        if (n < 5264) { sc = 0.03125f; return 1152 + (n - 5248); }
        if (n < 7312) { const int m = n - 5264, d = m & 127; return 5376 + (m - d) + (d < 64 ? 2 * d : 2 * (d - 64) + 1); }
        if (n < 8336) return 5376 + (n - 5264);
        return 8448 + (n - 8336);
    }
    if (n < DFF) return (n >> 7) * 256 + (n & 127);
    const int m = n - DFF; return (m >> 7) * 256 + 128 + (m & 127);
}
template <int MAP> __device__ __forceinline__ void conv_matrix(const Ctx& F, const float* W, int K, int N, bf16_t* WT, const float* gain) {
    LAS float* scr = (LAS float*)(F.lds + F.wave * 18432);
    const int lane = F.lane;
    const int nblk = (N + 63) / 64, nit = (K / 64) * nblk;
    const int l31 = lane & 31, lh = lane >> 5, c = lane & 7, nsub = lane >> 3;
    f32x2 wv[32]; f32x4 g0 = (f32x4){1.f, 1.f, 1.f, 1.f}, g1 = g0;
#define CONV_LOAD(item) do { const int kb_ = (item) / nblk, nb_ = (item) - kb_ * nblk, k0_ = 64 * kb_, nn_ = 64 * nb_ + 2 * l31; \
        const float* src_ = W + (size_t)(k0_ + lh) * N + nn_; const bool ok_ = nn_ < N; \
        _Pragma("unroll") for (int i = 0; i < 32; ++i) wv[i] = ok_ ? *(const f32x2*)(src_ + (size_t)(2 * i) * N) : (f32x2){0.f, 0.f}; \
        if (gain) { g0 = *(const f32x4*)(gain + k0_ + 8 * c); g1 = *(const f32x4*)(gain + k0_ + 8 * c + 4); } } while (0)
    int it = F.gw;
    if (it < nit) CONV_LOAD(it);
    while (it < nit) {
        const int kb = it / nblk, nb = it - kb * nblk, k0 = 64 * kb, n0 = 64 * nb;
#pragma unroll
        for (int i = 0; i < 32; ++i) { LAS float* d = scr + (2 * i + lh) * 65 + l31; d[0] = wv[i].x; d[32] = wv[i].y; }
        const f32x4 gc0 = g0, gc1 = g1;
        const int nx = it + F.ngw;
        if (nx < nit) CONV_LOAD(nx);
        LDS_WAIT(); asm volatile("" ::: "memory");
#pragma unroll
        for (int j = 0; j < 8; ++j) { const int n = nsub + 8 * j, ns = n0 + n;
            if (ns < N) { float sc; const int dst = wmap<MAP>(ns, sc); const LAS float* s = scr + (8 * c) * 65 + (n & 1) * 32 + (n >> 1);
                u32x4 o; o.x = pk2(s[0 * 65] * (sc * gc0.x), s[1 * 65] * (sc * gc0.y)); o.y = pk2(s[2 * 65] * (sc * gc0.z), s[3 * 65] * (sc * gc0.w));
                o.z = pk2(s[4 * 65] * (sc * gc1.x), s[5 * 65] * (sc * gc1.y)); o.w = pk2(s[6 * 65] * (sc * gc1.z), s[7 * 65] * (sc * gc1.w));
                *(u32x4*)(WT + (size_t)dst * K + k0 + 8 * c) = o; } }
        LDS_WAIT(); asm volatile("" ::: "memory");
        it = nx;
    }
#undef CONV_LOAD
}

__device__ __forceinline__ void norm_row(const float* hrow, bf16_t* orow, rs_t* rs_row, int lane) {
    f32x4 v[8]; float s = 0.f;
#pragma unroll
    for (int j = 0; j < 8; ++j) { v[j] = *((const f32x4*)hrow + lane + 64 * j); s += (v[j].x * v[j].x + v[j].y * v[j].y) + (v[j].z * v[j].z + v[j].w * v[j].w); }
    s = wave_sum(s);
    if (lane == 0) *rs_row = rs_fix(s);
#pragma unroll
    for (int j = 0; j < 8; ++j) { u32x2 o; o.x = cvt_pk_bf16(v[j].x, v[j].y); o.y = cvt_pk_bf16(v[j].z, v[j].w); *((u32x2*)orow + lane + 64 * j) = o; }
}

__device__ __forceinline__ void post1a_row(const bf16_t* P, int r, float* rstdq, float* rstdkv, int lane) {
    const bf16_t* p = P + (size_t)r * PW;
    const u32x4 a = *((const u32x4*)(p + C_CQ) + lane), b = *((const u32x4*)(p + C_CKV) + lane);
    float sa = 0.f, sb = 0.f;
#pragma unroll
    for (int e = 0; e < 4; ++e) { const float x0 = __uint_as_float(a[e] << 16), x1 = __uint_as_float(a[e] & 0xffff0000u); sa += x0 * x0 + x1 * x1;
        const float y0 = __uint_as_float(b[e] << 16), y1 = __uint_as_float(b[e] & 0xffff0000u); sb += y0 * y0 + y1 * y1; }
    sa = wave_sum(sa); sb = wave_sum(sb);
    if (lane == 0) { rstdq[r] = 1.0f / sqrtf(sa * (1.f / 512.f) + EPS); rstdkv[r] = 1.0f / sqrtf(sb * (1.f / 512.f) + EPS); }
    { unsigned* ikp = (unsigned*)(P + (size_t)r * PW + C_IK) + (lane & 31); const unsigned w = *ikp; const float x1 = __uint_as_float(w << 16), x2 = __uint_as_float(w & 0xffff0000u);
      float cs, sn; rope_cs(row_pos(r), lane & 31, 2.f / 64.f, cs, sn);
      if (lane < 32) *ikp = cvt_pk_bf16(x1 * cs - x2 * sn, x2 * cs + x1 * sn); }
}
__device__ __forceinline__ void meta_post_row(bf16_t* P, int r, const float* gperm, int lane) {
    bf16_t* p = P + (size_t)r * PW; const int pos = row_pos(r);
    float c128, s128, c64, s64; rope_cs(pos, lane, 2.f / 128.f, c128, s128); rope_cs(pos, lane & 31, 2.f / 64.f, c64, s64);
#pragma unroll 1
    for (int t = 0; t < 4; ++t) {
        const int cb = t == 0 ? C_DQ : (t == 1 ? C_DK : (t == 2 ? C_FQ : C_FK)); const float sc = (t == 0 || t == 2) ? C2_128 : 1.f;
        const float ga = gperm[t * 128 + 2 * lane], gb = gperm[t * 128 + 2 * lane + 1];
#pragma unroll 1
        for (int h = 0; h < 8; ++h) { unsigned* xp = (unsigned*)(p + cb + h * 128) + lane; const unsigned w = *xp; float x1 = __uint_as_float(w << 16), x2 = __uint_as_float(w & 0xffff0000u);
            const float rn = __builtin_amdgcn_rsqf(wave_sum(x1 * x1 + x2 * x2) * (1.f / 128.f) + EPS); x1 *= rn * ga; x2 *= rn * gb;
            *xp = cvt_pk_bf16((x1 * c128 - x2 * s128) * sc, (x2 * c128 + x1 * s128) * sc); }
    }
#pragma unroll 1
    for (int hh = 0; hh < 8; ++hh) { unsigned* xp = (unsigned*)(p + C_IQ + hh * 128) + lane; const unsigned w = *xp; const float x1 = __uint_as_float(w << 16), x2 = __uint_as_float(w & 0xffff0000u);
        *xp = cvt_pk_bf16(x1 * c64 - x2 * s64, x2 * c64 + x1 * s64); }
}
__device__ __forceinline__ void unpack8(const u32x4& w, float (&x)[8]) {
#pragma unroll
    for (int e = 0; e < 4; ++e) { x[2 * e] = __uint_as_float(w[e] << 16); x[2 * e + 1] = __uint_as_float(w[e] & 0xffff0000u); }
}
__device__ __forceinline__ u32x4 pack8(const float (&x)[8]) { u32x4 w; w.x = cvt_pk_bf16(x[0], x[1]); w.y = cvt_pk_bf16(x[2], x[3]); w.z = cvt_pk_bf16(x[4], x[5]); w.w = cvt_pk_bf16(x[6], x[7]); return w; }
__device__ __forceinline__ u32x4 shfl_xor4(const u32x4& w, int m) { u32x4 r; r.x = __shfl_xor(w.x, m); r.y = __shfl_xor(w.y, m); r.z = __shfl_xor(w.z, m); r.w = __shfl_xor(w.w, m); return r; }
__device__ __forceinline__ void post2_row(bf16_t* P, int r, const float* rstdq, const float* rstdkv, const float* qkg  , LAS float* rnl, int lane) {
    bf16_t* p = P + (size_t)r * PW;
    const float sq = rstdq[r], skv = rstdkv[r];
    const int pos = row_pos(r), hw = lane >> 5, l5 = lane & 31;
    float c64[8], s64[8];
#pragma unroll
    for (int j = 0; j < 8; ++j) rope_cs(pos, 8 * (lane & 3) + j, 2.f / 64.f, c64[j], s64[j]);
    float kp[8]; { const u32x4 w = *(const u32x4*)(p + C_KPE + (lane & 7) * 8); unpack8(w, kp); }
    float kpe_ss = 0.f;
#pragma unroll
    for (int j = 0; j < 8; ++j) kpe_ss += kp[j] * kp[j];
    kpe_ss += __shfl_xor(kpe_ss, 1); kpe_ss += __shfl_xor(kpe_ss, 2); kpe_ss += __shfl_xor(kpe_ss, 4);
    u32x4 rq[4], rkv[4];
#pragma unroll
    for (int it = 0; it < 4; ++it) { const int h = 2 * it + hw; rq[it] = *(const u32x4*)(p + C_QRAW + h * 192 + (l5 < 24 ? l5 : 0) * 8); rkv[it] = *(const u32x4*)(p + C_KVRAW + h * 256 + l5 * 8); }
#pragma unroll
    for (int it = 0; it < 4; ++it) {
        const int h = 2 * it + hw; const bool act = l5 < 24;
        u32x4* ptr = (u32x4*)(p + C_QRAW + h * 192 + (act ? l5 : 0) * 8);
        float x[8]; unpack8(rq[it], x);
        float ss = 0.f;
#pragma unroll
        for (int j = 0; j < 8; ++j) { x[j] *= sq; ss += x[j] * x[j]; }
        if (!act) ss = 0.f;
#pragma unroll
        for (int o = 1; o < 32; o <<= 1) ss += __shfl_xor(ss, o);
        const float rn = 1.0f / sqrtf(ss * (1.f / 192.f) + EPS);
        const int gi = (act ? l5 : 0) * 8;
        const f32x4 g0 = *(const f32x4*)(qkg + gi), g1 = *(const f32x4*)(qkg + gi + 4);
#pragma unroll
        for (int j = 0; j < 4; ++j) { x[j] *= rn * g0[j]; x[4 + j] *= rn * g1[j]; }
        float o[8];
#pragma unroll
        for (int j = 0; j < 8; ++j) { const float pr = __shfl_xor(x[j], 4); const float rot = (l5 & 4) ? (x[j] * c64[j] + pr * s64[j]) : (x[j] * c64[j] - pr * s64[j]); o[j] = (l5 >= 16 ? rot : x[j]) * C2_192; }
        if (act) *ptr = pack8(o);
    }
#pragma unroll
    for (int it = 0; it < 4; ++it) {
        const int h = 2 * it + hw; const bool isk = l5 < 16;
        u32x4* ptr = (u32x4*)(p + C_KVRAW + h * 256 + l5 * 8);
        float x[8]; unpack8(rkv[it], x);
        float ss = 0.f;
#pragma unroll
        for (int j = 0; j < 8; ++j) { x[j] *= skv; ss += x[j] * x[j]; }
        if (!isk) ss = 0.f;
#pragma unroll
        for (int o = 1; o < 32; o <<= 1) ss += __shfl_xor(ss, o);
        const float rn = 1.0f / sqrtf((ss + kpe_ss) * (1.f / 192.f) + EPS);
        if (l5 == 0) rnl[h] = rn;
        const int gi = 192 + (isk ? l5 : 0) * 8;
        const f32x4 g0 = *(const f32x4*)(qkg + gi), g1 = *(const f32x4*)(qkg + gi + 4);
        float o[8];
#pragma unroll
        for (int j = 0; j < 4; ++j) { o[j] = isk ? x[j] * rn * g0[j] : x[j]; o[4 + j] = isk ? x[4 + j] * rn * g1[j] : x[4 + j]; }
        *ptr = pack8(o);
    }
    LDS_WAIT(); asm volatile("" ::: "memory");
    { const int hd = lane >> 3, c = lane & 7; const float rn = rnl[hd];
      const f32x4 g0 = *(const f32x4*)(qkg + 192 + 128 + c * 8), g1 = *(const f32x4*)(qkg + 192 + 128 + c * 8 + 4);
      float x[8], o[8];
#pragma unroll
      for (int j = 0; j < 4; ++j) { x[j] = kp[j] * rn * g0[j]; x[4 + j] = kp[4 + j] * rn * g1[j]; }
#pragma unroll
      for (int j = 0; j < 8; ++j) { const float pr = __shfl_xor(x[j], 4); o[j] = (c & 4) ? (x[j] * c64[j] + pr * s64[j]) : (x[j] * c64[j] - pr * s64[j]); }
      *(u32x4*)(p + C_KPEH + hd * 64 + c * 8) = pack8(o); }
    LDS_WAIT(); asm volatile("" ::: "memory");
}
__device__ __forceinline__ void post3_row(bf16_t* P, int r, const float* subg, float lam, float omli, int lane) {
    bf16_t* p = P + (size_t)r * PW;
    const int hw = lane >> 5, l5 = lane & 31;
    u32x4 rr[4];
#pragma unroll
    for (int h = 0; h < 4; ++h) rr[h] = *(const u32x4*)(p + (hw ? C_IQ : C_FQ) + h * 256 + l5 * 8);
#pragma unroll
    for (int h = 0; h < 4; ++h) {
        const u32x4 raw = rr[h];
        const u32x4 praw = shfl_xor4(raw, 16);
        float a[8], b[8]; unpack8(raw, a); unpack8(praw, b);
        float d[8], ss = 0.f;
#pragma unroll
        for (int j = 0; j < 8; ++j) { d[j] = a[j] - lam * b[j]; ss += d[j] * d[j]; }
        if (l5 >= 16) ss = 0.f;
#pragma unroll
        for (int o = 1; o < 64; o <<= 1) ss += __shfl_xor(ss, o);
        const float rn = omli / sqrtf(ss * (1.f / 256.f) + EPS);
        const int dim = hw * 128 + (l5 & 15) * 8;
        const f32x4 g0 = *(const f32x4*)(subg + dim), g1 = *(const f32x4*)(subg + dim + 4);
        float o[8];
#pragma unroll
        for (int j = 0; j < 4; ++j) { o[j] = d[j] * rn * g0[j]; o[4 + j] = d[4 + j] * rn * g1[j]; }
        if (l5 < 16) *(u32x4*)(p + C_OC + h * 256 + dim) = pack8(o);
    }
}

__device__ __forceinline__ void index_unit(const bf16_t* P, int unit, unsigned* bm, LAS unsigned char* lds) {
    typedef float f32x16 __attribute__((ext_vector_type(16)));
    int tid = threadIdx.x; asm volatile("" : "+v"(tid));
    const int wid = __builtin_amdgcn_readfirstlane(tid >> 6), lane = tid & 63, j = lane & 31, hi = lane >> 5;
    const int tb = 255 - (unit >> 4), b = unit & 15, t0 = tb * 8, tokbase = MBLK + b * SEQ;
    const int wmax = (64 + t0 + 7) >> 5;
    LAS unsigned* keys = (LAS unsigned*)lds;
    LAS float* iwl = (LAS float*)(lds + 8 * 2112 * 4);
    if (t0 + 7 + 17 > 256) {
        if (tid < 128) iwl[tid] = bf2f(P[(size_t)(tokbase + t0 + (tid >> 4)) * PW + C_IW + (tid & 15)]);
        LAS unsigned char* al = lds + 8 * 2112 * 4 + 512;
        { const int id0 = tid * 2;
#pragma unroll
          for (int e = 0; e < 2; ++e) { const int id = id0 + e, rw = id >> 3, c = id & 7;
              *(LAS bf16x8*)(al + rw * 144 + c * 16) = *(const bf16x8*)(P + (size_t)(tokbase + t0 + (rw >> 4)) * PW + C_IQ + (rw & 15) * 64 + c * 8); } }
        LDS_WAIT(); __syncthreads();
        bf16x8 af[4][4];
        { const int qa = (j >> 2) & 1, ha = (j & 3) + 4 * (j >> 3);
#pragma unroll
          for (int blk = 0; blk < 4; ++blk)
#pragma unroll
              for (int s = 0; s < 4; ++s) af[blk][s] = *(const LAS bf16x8*)(al + ((2 * blk + qa) * 16 + ha) * 144 + s * 32 + hi * 16); }
        const unsigned boff = (unsigned)(j * PW + C_IK + hi * 8) * 2u;
        for (int w = wid; w <= wmax; w += 8) {
            const int kr_ = w < 2 ? (MBLK - 64) + 32 * w : tokbase + 32 * (w - 2); const char* bp_ = (const char*)(P + (size_t)kr_ * PW) + boff;
            bf16x8 bf[4];
#pragma unroll
            for (int s = 0; s < 4; ++s) bf[s] = *(const bf16x8*)(bp_ + s * 32);
            const int kidx = 32 * w + j;
#pragma unroll
            for (int blk = 0; blk < 4; ++blk) {
                f32x16 acc = (f32x16){0.f,0.f,0.f,0.f,0.f,0.f,0.f,0.f,0.f,0.f,0.f,0.f,0.f,0.f,0.f,0.f};
#pragma unroll
                for (int s = 0; s < 4; ++s) acc = __builtin_amdgcn_mfma_f32_32x32x16_bf16(af[blk][s], bf[s], acc, 0, 0, 0);
                const int q = 2 * blk + hi;
                const LAS f32x4* iwq = (const LAS f32x4*)(iwl + q * 16);
                float score = 0.f;
#pragma unroll
                for (int g = 0; g < 4; ++g) { const f32x4 wv = iwq[g]; score += fmaxf(acc[4 * g], 0.f) * wv.x + fmaxf(acc[4 * g + 1], 0.f) * wv.y + fmaxf(acc[4 * g + 2], 0.f) * wv.z + fmaxf(acc[4 * g + 3], 0.f) * wv.w; }
                const bool valid = kidx >= 48 && kidx <= 64 + t0 + q; const unsigned u_ = __float_as_uint(score);
                keys[q * 2112 + kidx] = valid ? ((u_ & 0x80000000u) ? ~u_ : (u_ | 0x80000000u)) : 0u;
            }
        }
        LDS_WAIT(); __syncthreads();
    }
    const int tq = t0 + wid, qk = 64 + tq, nch = qk / 64 + 1;
    unsigned* out = bm + (size_t)(b * SEQ + tq) * BMW;
    if (tq + 17 <= 256) {
        for (int c = 0; c < 33; ++c) { const int kidx = 64 * c + lane; const unsigned long long m = __ballot(kidx >= 48 && kidx <= qk);
            if (lane == 0) { out[2 * c] = (unsigned)m; out[2 * c + 1] = (unsigned)(m >> 32); } }
    } else {
        unsigned kreg[33];
#pragma unroll
        for (int c = 0; c < 33; ++c) kreg[c] = (c < nch && 64 * c + lane <= qk) ? keys[wid * 2112 + 64 * c + lane] : 0u;
        unsigned T = 0u;
        for (int bit = 31; bit >= 0; --bit) {
            const unsigned cand = T | (1u << bit); int cnt = 0;
#pragma unroll
            for (int c = 0; c < 33; ++c) cnt += __popcll(__ballot(kreg[c] >= cand));
            if (cnt >= 256) T = cand;
            if (cnt == 256) break;
        }
#pragma unroll
        for (int c = 0; c < 33; ++c) { const unsigned long long m = __ballot(kreg[c] >= T && kreg[c] != 0u);
            if (lane == 0) { out[2 * c] = (unsigned)m; out[2 * c + 1] = (unsigned)(m >> 32); } }
    }
    LDS_WAIT();
}

namespace fa {
typedef float f32x16 __attribute__((ext_vector_type(16)));
typedef short s16x4 __attribute__((ext_vector_type(4)));
__device__ __forceinline__ int crow(int r, int hi) { return (r & 3) + 8 * (r >> 2) + 4 * hi; }
__device__ __forceinline__ int v_st(int k, int c) { const int kk = (k & ~0xC) | ((k & 4) << 1) | ((k & 8) >> 1); return ((kk >> 3) * 4 + (c >> 5)) * 512 + ((kk & 7) * 32 + (c & 31)) * 2; }
__device__ __forceinline__ int v_rd_base(int lane) { return ((lane & 3) << 3) | (((lane >> 2) & 3) << 6) | (((lane >> 4) & 1) << 5) | (((lane >> 5) & 1) << 8); }
constexpr int v_rd_off(int d0, int ks, int half) { return d0 * 512 + ks * 4096 + half * 2048; }
constexpr int SHM_V = 16384;
template <int DQK, int DV> struct Geo { static constexpr int KP = DQK * 2, SHM_K = 64 * DQK * 2, LDS_K0 = 2 * 64 * DV * 2, LDS_WS = LDS_K0 + 2 * SHM_K, BYTES = LDS_WS + 8 * 256; };
#define FA_KSWZ(row, colB, pitch) ((row) * (pitch) + ((colB) ^ (((row) & 7) << 4)))
#define FA_SBAR() __builtin_amdgcn_sched_barrier(0)

struct Item { int qrow0, qk0, nt, tokbase; };

template <int DQK>
__device__ __forceinline__ void load_q(const bf16_t* P, const Item& it, int qcol, bf16x8 (&qr)[DQK / 16]) {
    int tid = threadIdx.x; asm volatile("" : "+v"(tid));
    const int wid = tid >> 6, lane = tid & 63, r32 = lane & 31, hi = lane >> 5;
    const bf16_t* qp = P + (size_t)(it.qrow0 + wid * 32 + r32) * PW + qcol + hi * 8;
#pragma unroll
    for (int d0 = 0; d0 < DQK / 16; ++d0) qr[d0] = *(const bf16x8*)(qp + d0 * 16);
}

template <int DQK, int DV, bool MASKED>
__device__ __forceinline__ void attn_core(bf16_t* P, const Item& it, const bf16x8 (&qr)[DQK / 16], int k1col, int k2col, int vcol, int ocol, int ocol1, const unsigned* bmq, LAS unsigned char* lds) {
    typedef Geo<DQK, DV> G; constexpr int SHMV = 64 * DV * 2, NDB = DV / 32;
    int tid = threadIdx.x; asm volatile("" : "+v"(tid));
    const int wid = __builtin_amdgcn_readfirstlane(tid >> 6), lane = tid & 63, r32 = lane & 31, hi = lane >> 5;
    LAS unsigned char* V_lds = lds; LAS unsigned char* K_lds = lds + G::LDS_K0; LAS float* wsf = (LAS float*)(lds + G::LDS_WS) + wid * 64;
    const int sr = tid >> 4, sc = (tid & 15) * 8;
    const int vst0 = v_st(sr, sc), vst1 = v_st(32 + sr, sc), kws0 = FA_KSWZ(sr, sc * 2, G::KP), kws1 = FA_KSWZ(sr + 32, sc * 2, G::KP);
    const int xr = tid >> 3, xc = (tid & 7) * 8, kws2 = FA_KSWZ(xr, (128 + xc) * 2, G::KP);
    const unsigned loff0 = (unsigned)(sr * PW + sc) * 2u, loffx = (unsigned)(xr * PW + xc) * 2u;
    const int vb0 = (int)(unsigned)(size_t)V_lds + v_rd_base(lane);
    const int NT = it.nt;
    const int qk = it.qk0 + wid * 32 + r32;
    const bool use_bm = MASKED && (bmq != nullptr);
    const unsigned bmoff = (unsigned)((wid * 32 + r32) * BMW) * 4u;
    float l_reg = 0.f; f32x16 o[NDB];
#pragma unroll
    for (int d = 0; d < NDB; ++d) o[d] = (f32x16){0.f,0.f,0.f,0.f,0.f,0.f,0.f,0.f,0.f,0.f,0.f,0.f,0.f,0.f,0.f,0.f};
    bf16x8 sk0, sk1, sk2, sv0, sv1, sv2, sv3;
#define FA_KROW0(t) ((t) == 0 ? (MBLK - 64) : it.tokbase + 64 * ((t) - 1))
#define FA_LOADK(t) do { const int kr_ = FA_KROW0(t); const char* rb_ = (const char*)(P + (size_t)kr_ * PW); const char* rk_ = rb_ + (size_t)k1col * 2; \
        sk0 = *(const bf16x8*)(rk_ + loff0); sk1 = *(const bf16x8*)(rk_ + (size_t)32 * PW * 2 + loff0); if (DQK == 192) sk2 = *(const bf16x8*)(rb_ + (size_t)k2col * 2 + loffx); } while (0)
#define FA_LOADV(t) do { const char* rv_ = (const char*)(P + (size_t)FA_KROW0(t) * PW) + (size_t)vcol * 2; \
        sv0 = *(const bf16x8*)(rv_ + loff0); sv1 = *(const bf16x8*)(rv_ + (size_t)32 * PW * 2 + loff0); if (DV == 256) { sv2 = *(const bf16x8*)(rv_ + 256 + loff0); sv3 = *(const bf16x8*)(rv_ + 256 + (size_t)32 * PW * 2 + loff0); } } while (0)
#define FA_LOAD(t) do { FA_LOADK(t); FA_LOADV(t); } while (0)
#define FA_WRITE(bf) do { *(LAS bf16x8*)(K_lds + (bf) * G::SHM_K + kws0) = sk0; *(LAS bf16x8*)(K_lds + (bf) * G::SHM_K + kws1) = sk1; \
        *(LAS bf16x8*)(V_lds + (bf) * SHMV + vst0) = sv0; *(LAS bf16x8*)(V_lds + (bf) * SHMV + vst1) = sv1; if (DV == 256) { *(LAS bf16x8*)(V_lds + (bf) * SHMV + 16384 + vst0) = sv2; *(LAS bf16x8*)(V_lds + (bf) * SHMV + 16384 + vst1) = sv3; } \
        if (DQK == 192) *(LAS bf16x8*)(K_lds + (bf) * G::SHM_K + kws2) = sk2; } while (0)
    constexpr int QREG = (DV == 256) ? 3 : DQK / 16;
    constexpr int NQL = DQK / 16 - QREG;
    static_assert(G::BYTES + 8 * NQL * 64 * 16 <= LDSCTL_OFF, "attention LDS budget");
    LAS unsigned char* qx = lds + G::BYTES + (wid * (NQL * 64) + lane) * 16;
    if (QREG < DQK / 16) {
#pragma unroll
        for (int d0 = QREG; d0 < DQK / 16; ++d0) *(LAS bf16x8*)(qx + (d0 - QREG) * 1024) = qr[d0];
    }
    FA_LOAD(0); FA_WRITE(0);
    __syncthreads();
    for (int t = 0; t < NT; ++t) {
        const int cur = t & 1;
        unsigned zb = 0u; asm volatile("" : "+v"(zb)); u32x2 bw = (u32x2){zb, zb};
        if (use_bm) bw = *(const u32x2*)((const char*)(bmq + 2 * t) + bmoff);
        f32x16 p0 = (f32x16){0.f,0.f,0.f,0.f,0.f,0.f,0.f,0.f,0.f,0.f,0.f,0.f,0.f,0.f,0.f,0.f}, p1 = p0;
        { LAS unsigned char* kbase = K_lds + cur * G::SHM_K;
          LAS unsigned char* kb[4];
#pragma unroll
          for (int dd = 0; dd < 4; ++dd) kb[dd] = kbase + FA_KSWZ(r32, (dd * 16 + hi * 8) * 2, G::KP);
          constexpr int GS = (DQK == 192 || DV == 256) ? 2 : 4;
#pragma unroll
          for (int g = 0; g < DQK / (16 * GS); ++g) {
              bf16x8 fb0[GS], fb1[GS];
#pragma unroll
              for (int dd = 0; dd < GS; ++dd) { const int d0 = g * GS + dd; LAS unsigned char* a = kb[d0 & 3] + (d0 >> 2) * 128; fb0[dd] = *(const LAS bf16x8*)a; fb1[dd] = *(const LAS bf16x8*)(a + 32 * G::KP); }
              FA_SBAR();
#pragma unroll
              for (int dd = 0; dd < GS; ++dd) { const int d0 = g * GS + dd; bf16x8 qf; if (d0 < QREG) qf = qr[d0 < QREG ? d0 : 0]; else qf = *(const LAS bf16x8*)(qx + (d0 - QREG) * 1024);
                  p0 = __builtin_amdgcn_mfma_f32_32x32x16_bf16(fb0[dd], qf, p0, 0, 0, 0); p1 = __builtin_amdgcn_mfma_f32_32x32x16_bf16(fb1[dd], qf, p1, 0, 0, 0); }
              FA_SBAR(); } }
        if (t + 1 < NT) { FA_LOADK(t + 1); if (DV != 256) FA_LOADV(t + 1); }
        FA_SBAR();
        const float NEG = -__builtin_inff();
        if (use_bm) {
        } else if (t == 0 || 64 * t + 63 > it.qk0 + wid * 32) {
            const int kb_ = 64 * t + 4 * hi;
#pragma unroll
            for (int r = 0; r < 16; ++r) { const int k0 = kb_ + (r & 3) + 8 * (r >> 2), k1 = k0 + 32;
                if (k0 < 48 || k0 > qk) p0[r] = NEG; if (k1 < 48 || k1 > qk) p1[r] = NEG; }
        }
        float ps = 0.f;
#pragma unroll
        for (int r = 0; r < 16; ++r) { p0[r] = __builtin_amdgcn_exp2f(p0[r]); p1[r] = __builtin_amdgcn_exp2f(p1[r]); }
        if (use_bm) {
            const int wx = (int)(bw.x >> (4 * hi)), wy = (int)(bw.y >> (4 * hi));
#pragma unroll
            for (int r = 0; r < 16; ++r) { const int c = (r & 3) + 8 * (r >> 2);
                p0[r] = __uint_as_float(__float_as_uint(p0[r]) & (unsigned)__builtin_amdgcn_sbfe(wx, c, 1)); p1[r] = __uint_as_float(__float_as_uint(p1[r]) & (unsigned)__builtin_amdgcn_sbfe(wy, c, 1)); }
        }
        { f32x2 s2 = (f32x2){p0[0], p0[1]} + (f32x2){p1[0], p1[1]};
#pragma unroll
          for (int r = 2; r < 16; r += 2) s2 += (f32x2){p0[r], p0[r + 1]} + (f32x2){p1[r], p1[r + 1]};
          ps = s2.x + s2.y; }
        { auto rr = __builtin_amdgcn_permlane32_swap(__float_as_uint(ps), __float_as_uint(ps), false, false); ps = __uint_as_float(rr[0]) + __uint_as_float(rr[1]); }
        l_reg += ps;
        if (DV == 256 && t + 1 < NT) { FA_SBAR(); FA_LOADV(t + 1); FA_SBAR(); }
        bf16x8 pa0, pa1, pa2, pa3;
#define FA_PK4(Pv, B_, OUT) do { const unsigned a0 = cvt_pk_bf16(Pv[B_ + 0], Pv[B_ + 1]), a1 = cvt_pk_bf16(Pv[B_ + 2], Pv[B_ + 3]), b0 = cvt_pk_bf16(Pv[B_ + 4], Pv[B_ + 5]), b1 = cvt_pk_bf16(Pv[B_ + 6], Pv[B_ + 7]); \
        auto r0 = __builtin_amdgcn_permlane32_swap(a0, b0, false, false); auto r1 = __builtin_amdgcn_permlane32_swap(a1, b1, false, false); \
        u32x4 w_ = {r0[0], r1[0], r0[1], r1[1]}; OUT = __builtin_bit_cast(bf16x8, w_); } while (0)
        FA_PK4(p0, 0, pa0); FA_PK4(p0, 8, pa1); FA_PK4(p1, 0, pa2); FA_PK4(p1, 8, pa3);
#define FA_TRRD(dst, off) asm volatile("ds_read_b64_tr_b16 %0, %1 offset:%2" : "=&v"(dst) : "v"(vbc), "i"(off) : "memory")
#define FA_PV(VB, d0) do { s16x4 l0, l1, l2, l3, h0, h1, h2, h3; constexpr int b_ = ((d0) >> 2) * 16384 + v_rd_off((d0) & 3, 0, 0); \
        FA_TRRD(l0, b_); FA_TRRD(h0, b_ + 2048); FA_TRRD(l1, b_ + 4096); FA_TRRD(h1, b_ + 6144); FA_TRRD(l2, b_ + 8192); FA_TRRD(h2, b_ + 10240); FA_TRRD(l3, b_ + 12288); FA_TRRD(h3, b_ + 14336); \
        asm volatile("s_waitcnt lgkmcnt(0)" ::: "memory"); FA_SBAR(); \
        o[d0] = __builtin_amdgcn_mfma_f32_32x32x16_bf16(pa0, (bf16x8){l0[0], l0[1], l0[2], l0[3], h0[0], h0[1], h0[2], h0[3]}, o[d0], 0, 0, 0); \
        o[d0] = __builtin_amdgcn_mfma_f32_32x32x16_bf16(pa1, (bf16x8){l1[0], l1[1], l1[2], l1[3], h1[0], h1[1], h1[2], h1[3]}, o[d0], 0, 0, 0); \
        o[d0] = __builtin_amdgcn_mfma_f32_32x32x16_bf16(pa2, (bf16x8){l2[0], l2[1], l2[2], l2[3], h2[0], h2[1], h2[2], h2[3]}, o[d0], 0, 0, 0); \
        o[d0] = __builtin_amdgcn_mfma_f32_32x32x16_bf16(pa3, (bf16x8){l3[0], l3[1], l3[2], l3[3], h3[0], h3[1], h3[2], h3[3]}, o[d0], 0, 0, 0); } while (0)
        FA_SBAR();
        { const int vbc = vb0 + cur * SHMV;
          FA_PV(0, 0); FA_PV(0, 1); FA_PV(0, 2); FA_PV(0, 3); if (DV == 256) { FA_PV(0, 4); FA_PV(0, 5); FA_PV(0, 6); FA_PV(0, 7); } }
        FA_SBAR();
        if (t + 1 < NT) { const int nb_ = cur ^ 1; FA_WRITE(nb_); }
        __syncthreads();
    }
    if (hi == 0) wsf[r32] = l_reg; LDS_WAIT();
    float rli[16];
#pragma unroll
    for (int r = 0; r < 16; ++r) { const float lv = wsf[crow(r, hi)]; rli[r] = lv > 0.f ? __builtin_amdgcn_rcpf(lv) : 0.f; }
    { int l2 = lane; asm volatile("" : "+v"(l2));
      const int r32b = l2 & 31, hib = l2 >> 5;
      char* Ow = (char*)(P + (size_t)(it.qrow0 + wid * 32) * PW + ocol) + (unsigned)((4 * hib) * PW + r32b) * 2u;
      char* Ow1 = (char*)(P + (size_t)(it.qrow0 + wid * 32) * PW + ocol1) + (unsigned)((4 * hib) * PW + r32b) * 2u;
#pragma unroll
      for (int r = 0; r < 16; ++r) { const unsigned ro = (unsigned)(((r & 3) + 8 * (r >> 2)) * PW) * 2u;
#pragma unroll
        for (int d0 = 0; d0 < NDB; ++d0) { const float v = o[d0][r] * rli[r]; const float vn = __shfl_xor(v, 1);
            if ((r32b & 1) == 0) *(unsigned*)((d0 < 4 ? Ow : Ow1) + ro + (d0 & 3) * 64) = cvt_pk_bf16(v, vn); } } }
    LDS_WAIT();
    __syncthreads();
#undef FA_KROW0
#undef FA_LOAD
#undef FA_LOADK
#undef FA_LOADV
#undef FA_WRITE
#undef FA_PK4
#undef FA_TRRD
#undef FA_PV
}
__device__ __forceinline__ int next_item(unsigned* ctr, LAS int* slot) {
    __syncthreads();
    if (threadIdx.x == 0) *slot = (int)__hip_atomic_fetch_add(ctr, 1u, __ATOMIC_RELAXED, __HIP_MEMORY_SCOPE_AGENT);
    __syncthreads();
    return *slot;
}
__device__ __forceinline__ void queue_prime(unsigned* ctr, LAS int* slot) {
    __syncthreads();
    if (threadIdx.x == 0) slot[0] = (int)__hip_atomic_fetch_add(ctr, 1u, __ATOMIC_RELAXED, __HIP_MEMORY_SCOPE_AGENT);
    __syncthreads();
}
__device__ __forceinline__ int queue_next(unsigned* ctr, LAS int* slot, int k) {
    const int idx = slot[k & 1];
    if (threadIdx.x == 0) slot[(k + 1) & 1] = (int)__hip_atomic_fetch_add(ctr, 1u, __ATOMIC_RELAXED, __HIP_MEMORY_SCOPE_AGENT);
    return idx;
}
__device__ __forceinline__ Item make_item(bool meta, int b, int qb) {
    Item it;
    if (meta) { it.qrow0 = 0; it.qk0 = -(MBLK - 64); it.nt = 1; it.tokbase = MBLK; }
    else { it.qrow0 = MBLK + b * SEQ + qb * 256; it.qk0 = 64 + qb * 256; it.nt = 4 * (qb + 1) + 1; it.tokbase = MBLK + b * SEQ; }
    return it;
}
}


constexpr int PH_PER_LAYER = 19, N_PHASES = 2 * PH_PER_LAYER;
__device__ __forceinline__ unsigned char* uni_ptr(unsigned char* p) { const unsigned long long v = (unsigned long long)p; const unsigned lo = __builtin_amdgcn_readfirstlane((unsigned)v), hi = __builtin_amdgcn_readfirstlane((unsigned)(v >> 32)); return (unsigned char*)(((unsigned long long)hi << 32) | lo); }
__device__ __forceinline__ const float* arg_in(const Args& a, int k) { asm volatile("" : "+s"(k)); return a.in[k]; }
__global__ void __launch_bounds__(NWAVES * 64, 2) mega_fwd(Args args) {
    extern __shared__ __attribute__((aligned(16))) unsigned char lds_raw[];
    {
        LAS unsigned char* l0 = (LAS unsigned char*)lds_raw;
        for (int u = threadIdx.x; u < (LDS_BYTES - LDSCTL_OFF) / 4; u += NWAVES * 64) ((LAS unsigned*)(l0 + LDSCTL_OFF))[u] = 0u;
        __syncthreads();
    }
#if MK_ONE_LAUNCH
    (void)xcd_barrier_post((unsigned*)(args.ws + WS_CTL) + CW_BAR, (volatile LAS unsigned*)((LAS unsigned char*)lds_raw + LDSCTL_OFF + 64));
#define GRID_BAR() do { XcdBarrier bar_; bar_.bar = (unsigned*)(uni_ptr(args.ws) + WS_CTL) + CW_BAR; bar_.x = xb_xcc_id(); bar_.st = (volatile LAS unsigned*)((LAS unsigned char*)lds_raw + LDSCTL_OFF + 64); xcd_barrier(bar_); } while (0)
#else
#define GRID_BAR() do {} while (0)
#endif
    const int lo = args.ph_lo, hi = args.ph_hi;
#define IN(k) (lo <= (k) && (k) < hi)
#define SEAM(k) do { if (IN((k) + 1)) GRID_BAR(); } while (0)
#define PH_BEGIN \
    int tid_ = threadIdx.x; asm volatile("" : "+v"(tid_)); \
    Ctx F; F.lds = (LAS unsigned char*)lds_raw; F.tid = tid_; F.lane = tid_ & 63; F.wave = __builtin_amdgcn_readfirstlane(tid_ >> 6); \
    F.G = gridDim.x; F.bid = blockIdx.x; F.gw = F.bid * NWAVES + F.wave; F.ngw = F.G * NWAVES; \
    unsigned char* ws = uni_ptr(args.ws); asm volatile("" : "+s"(ws)); \
    int ly = __builtin_amdgcn_readfirstlane(layer); asm volatile("" : "+s"(ly)); (void)ly; (void)F
#define XN_ ((bf16_t*)(ws + WS_XN))
#define P_ ((bf16_t*)(ws + WS_P))
#define HMETA_ ((float*)(ws + WS_HMETA))
#define RSTDQ_ ((float*)(ws + WS_RSTD))
#define RSTDKV_ ((float*)(ws + WS_RSTD) + R)
#define BM_ ((unsigned*)(ws + WS_BM))
#define RS_(i) ((rs_t*)(ws + WS_CTL + WS_RS) + (size_t)(i) * R)
#define GPERM_ ((float*)(ws + WS_RSTD + 512 * 1024))
#define WB_(off) ((bf16_t*)(ws + WS_WB + (off)))
#define OUT_ (args.out)
#define LAMBDA_INIT(ly) ((ly) == 0 ? 0.2f : (0.8f - 0.6f * 0.7408182206817179f))

#pragma unroll
    for (int layer = 0; layer < 2; ++layer) {
        const int pb = layer * PH_PER_LAYER;
        if (((PHMASK >> 0) & 1) && IN(pb + 0)) {
            PH_BEGIN;
            for (int rep_ = 0; rep_ < NREP(0); ++rep_) { if (rep_) GRID_BAR();
            const float* meta = arg_in(args, 1);
            conv_matrix<1>(F, arg_in(args, 3) + (size_t)ly * DM * D_IN, DM, D_IN, WB_(WB_IN), arg_in(args, 2) + ly * DM);
            conv_matrix<0>(F, arg_in(args, 7) + (size_t)ly * 512 * 1536, 512, 1536, WB_(WB_QUP), arg_in(args, 5) + ly * 512);
            conv_matrix<0>(F, arg_in(args, 8) + (size_t)ly * 512 * 2048, 512, 2048, WB_(WB_KVUP), arg_in(args, 6) + ly * 512);
            for (int b = 0; b < 3; ++b) conv_matrix<0>(F, arg_in(args, 14) + ((size_t)ly * 3 + b) * 1024 * DM, 1024, DM, WB_(WB_BR) + (size_t)b * DM * 1024, nullptr);
            conv_matrix<0>(F, arg_in(args, 15) + (size_t)ly * DM * DM, DM, DM, WB_(WB_O), nullptr);
            conv_matrix<2>(F, arg_in(args, 17) + (size_t)ly * DM * 2 * DFF, DM, 2 * DFF, WB_(WB_F1), arg_in(args, 16) + ly * DM);
            conv_matrix<0>(F, arg_in(args, 18) + (size_t)ly * DFF * DM, DFF, DM, WB_(WB_F2), nullptr);
            unsigned zu = 0u; asm volatile("" : "+v"(zu)); const float zf = __uint_as_float(zu);
            for (int i = F.gw * 64 + F.lane; i < 112 * 2048 / 8; i += F.ngw * 64) *((u32x4*)(WB_(WB_IN) + (size_t)1168 * 2048) + i) = (u32x4){zu, zu, zu, zu};
            if (F.bid == 0) { const int i = F.tid; const int t = i >> 7, ps = i & 127, dim = (ps >> 1) + 64 * (ps & 1);
                const float* gsrc = (t < 2 ? arg_in(args, 10) : arg_in(args, 11)) + ly * 256 + (t & 1) * 128; GPERM_[i] = gsrc[dim]; }
            float* hmeta = HMETA_;
            if (ly == 0) {
                for (int i = F.gw * 64 + F.lane; i < MROW0 * PW / 8; i += F.ngw * 64) *((u32x4*)P_ + i) = (u32x4){zu, zu, zu, zu};
                for (int i = F.gw * 64 + F.lane; i < MBLK * DM / 4; i += F.ngw * 64) { const int rr = i / (DM / 4); f32x4 v = (f32x4){zf, zf, zf, zf};
                    if (rr >= MBLK - NMETA) v = *((const f32x4*)meta + (i - (MBLK - NMETA) * (DM / 4))); *((f32x4*)hmeta + i) = v; }
            }
            if (ly == 0) {
                const float* xin = arg_in(args, 0); bf16_t* XN = XN_; rs_t* rs0 = RS_(0);
                for (int r = MROW0 + F.gw; r < R; r += F.ngw)
                    norm_row(r < MBLK ? meta + (size_t)(r - MROW0) * DM : xin + (size_t)(r - MBLK) * DM, XN + (size_t)r * DM, rs0 + r, F.lane);
            }
            }
            SEAM(pb + 0);
        }
        if (((PHMASK >> 1) & 1) && IN(pb + 1)) {
            PH_BEGIN;
            { SkP f{P_, 0, RS_(2 * ly)}; skinny_gemm(F.lds, XN_ + (size_t)MROW0 * DM, DM, WB_(WB_IN), DM, 1280 / 16, F.bid, F.G, f); }
            SchedPlain S{XN_, DM, WB_(WB_IN), DM, NPMM, 5, F.G, F.bid, 0}; EpiP E{P_, RS_(2 * ly)};
            pg8::gemm_phase(F.lds, S, E);
            if (NREP(1) == 2) { GRID_BAR(); pg8::gemm_phase(F.lds, S, E); }
            SEAM(pb + 1);
        }
        if (((PHMASK >> 2) & 1) && IN(pb + 2)) {
            PH_BEGIN;
            { bf16_t* P = P_; float* rq = RSTDQ_; float* rkv = RSTDKV_;
              for (int r = MROW0 + F.gw; r < R; r += F.ngw) post1a_row(P, r, rq, rkv, F.lane); }
            VM_WAIT(); __syncthreads();
            { SkP f{P_, C_QRAW, nullptr}; skinny_gemm(F.lds, P_ + (size_t)MROW0 * PW + C_CQ, PW, WB_(WB_QUP), 512, 1536 / 16, F.bid, F.G, f); }
            { SkP f{P_, C_KVRAW, nullptr}; skinny_gemm(F.lds, P_ + (size_t)MROW0 * PW + C_CKV, PW, WB_(WB_KVUP), 512, 2048 / 16, F.bid, F.G, f); }
            SchedMlaUp S{P_, WB_(WB_QUP), WB_(WB_KVUP), F.G, F.bid}; EpiP E{P_, nullptr};
            pg8::gemm_phase(F.lds, S, E);
            if (NREP(2) == 2) { GRID_BAR(); pg8::gemm_phase(F.lds, S, E); }
            SEAM(pb + 2);
        }
        if (((PHMASK >> 3) & 1) && IN(pb + 3)) {
            PH_BEGIN;
            const float* mla_qkg = arg_in(args, 9) + ly * 2 * 192;
            bf16_t* P = P_; float* rq = RSTDQ_; float* rkv = RSTDKV_;
            LAS float* rnl = (LAS float*)(F.lds + F.wave * 64);
            for (int r = MROW0 + F.gw; r < R; r += F.ngw) post2_row(P, r, rq, rkv, mla_qkg, rnl, F.lane);
            SEAM(pb + 3);
        }
        if (((PHMASK >> 4) & 1) && IN(pb + 4)) {
            PH_BEGIN;
            bf16_t* P = P_;
            LAS int* slot = (LAS int*)(F.lds + LDSCTL_OFF + 128);
            for (int rep_ = 0; rep_ < NREP(4); ++rep_) { if (rep_) GRID_BAR();
            unsigned* ctr = (unsigned*)(ws + WS_CTL) + CW_Q + 64 * (ly * 4 + 0) + 64 * 16 * rep_;
            const bool stat = (F.G == 256); const int sx = F.bid & 7, spl = (F.bid >> 3) >> 2, sj = (F.bid >> 3) & 3;
            if (!stat) fa::queue_prime(ctr, slot);
            for (int qk_ = 0;; ++qk_) {
                int idx;
                if (stat) { if (qk_ < 4) { const int pr = sx + 8 * (spl + 8 * (qk_ >> 1)), qb = (qk_ & 1) ? sj : 7 - sj; idx = (7 - qb) * 128 + pr; } else idx = (qk_ == 4 && F.bid < 8) ? 1024 + F.bid : 1 << 30; }
                else idx = fa::queue_next(ctr, slot, qk_);
                if (idx >= 8 * 129) break;
                int h; fa::Item it;
                if (idx < 1024) { const int qb = 7 - (idx >> 7), rest = idx & 127; h = rest & 7; it = fa::make_item(false, rest >> 3, qb); } else { h = idx - 1024; it = fa::make_item(true, 0, 0); }
                bf16x8 qr[12]; fa::load_q<192>(P, it, C_QRAW + h * 192, qr);
                fa::attn_core<192, 128, false>(P, it, qr, C_KVRAW + h * 256, C_KPEH + h * 64, C_KVRAW + h * 256 + 128, C_OA + h * 128, 0, nullptr, F.lds);
            } }
            SEAM(pb + 4);
        }
        if (((PHMASK >> 5) & 1) && IN(pb + 5)) {
            PH_BEGIN;
            { SkP f{P_, 1280, RS_(2 * ly)}; skinny_gemm(F.lds, XN_ + (size_t)MROW0 * DM, DM, WB_(WB_IN) + (size_t)1280 * DM, DM, 7168 / 16, F.bid, F.G, f); }
            SchedPlain S{XN_, DM, WB_(WB_IN) + (size_t)1280 * DM, DM, NPMM, 28, F.G, F.bid, 1280}; EpiG2 E{P_, RS_(2 * ly), GPERM_, (LAS float*)(F.lds + RING_BYTES)};
            pg8::gemm_phase(F.lds, S, E);
            if (NREP(5) == 2) { GRID_BAR(); pg8::gemm_phase(F.lds, S, E); }
            SEAM(pb + 5);
        }
        if (((PHMASK >> 6) & 1) && IN(pb + 6)) {
            PH_BEGIN;
            bf16_t* P = P_; const float* gp = GPERM_;
            if (F.gw < NMETA) meta_post_row(P, MROW0 + F.gw, gp, F.lane);
        }
        if (((PHMASK >> 7) & 1) && IN(pb + 7)) {
            PH_BEGIN;
            bf16_t* P = P_; unsigned* bm = BM_;
            unsigned* ctr = (unsigned*)(ws + WS_CTL) + CW_Q + 64 * (ly * 4 + 2);
            LAS int* slot = (LAS int*)(F.lds + LDSCTL_OFF + 128);
            for (int rep_ = 0; rep_ < NREP(7); ++rep_) { if (rep_) GRID_BAR(); unsigned* c2 = ctr + 64 * 16 * rep_;
            for (;;) { const int idx = fa::next_item(c2, slot); if (idx >= NTOK / 8) break; index_unit(P, idx, bm, F.lds); } }
            SEAM(pb + 7);
        }
        if (((PHMASK >> 8) & 1) && IN(pb + 8)) {
            PH_BEGIN;
            bf16_t* P = P_; unsigned* bm = BM_;
            LAS int* slot = (LAS int*)(F.lds + LDSCTL_OFF + 128);
            for (int rep_ = 0; rep_ < NREP(8); ++rep_) { if (rep_) GRID_BAR();
            const bool dummy = (NREP(8) == 2) && rep_ == 0;
            unsigned* ctr = (unsigned*)(ws + WS_CTL) + CW_Q + 64 * (ly * 4 + 1) + 64 * 16 * rep_;
            const bool stat = (F.G == 256); const int sx = F.bid & 7, spl = (F.bid >> 3) >> 2, sj = (F.bid >> 3) & 3;
            if (!stat) fa::queue_prime(ctr, slot);
            for (int qk_ = 0;; ++qk_) {
                int idx;
                if (stat) { if (qk_ < 8) { const int pr = sx + 8 * (spl + 8 * ((qk_ >> 1) & 1)), qb = (qk_ & 1) ? sj : 7 - sj; idx = (7 - qb) * 256 + ((qk_ >> 2) ? 128 : 0) + pr; } else idx = (qk_ == 8 && F.bid < 16) ? 2048 + F.bid : 1 << 30; }
                else idx = fa::queue_next(ctr, slot, qk_);
                if (idx >= 16 * 129) break;
                int hh; bool meta = false; fa::Item it; int b = 0, qb = 0;
                if (idx < 2048) { qb = 7 - (idx >> 8); const int rest = idx & 255; hh = (rest < 128) ? 8 + (rest & 7) : (rest & 7); b = (rest & 127) >> 3; it = fa::make_item(false, b, qb); }
                else { hh = idx - 2048; hh = hh < 8 ? 8 + hh : hh - 8; meta = true; it = fa::make_item(true, 0, 0); }
                if (hh < 8) {
                    bf16x8 qr[8]; fa::load_q<128>(P, it, C_DQ + hh * 128, qr);
                    fa::attn_core<128, 128, true>(P, it, qr, C_DK + hh * 128, 0, C_DV + hh * 128, dummy ? C_KPE : C_OB + hh * 128, 0, meta ? nullptr : bm + (size_t)(b * SEQ + qb * 256) * BMW, F.lds);
                } else {
                    const int hj = hh - 8;
                    bf16x8 qr[8]; fa::load_q<128>(P, it, C_FQ + hj * 128, qr);
                    fa::attn_core<128, 256, false>(P, it, qr, C_FK + hj * 128, 0, C_FV + (hj >> 1) * 256, dummy ? C_KPE : C_FQ + hj * 128, dummy ? C_KPE : C_IQ + hj * 128, nullptr, F.lds);
                }
            } }
            SEAM(pb + 8);
        }
        if (((PHMASK >> 9) & 1) && IN(pb + 9)) {
            PH_BEGIN;
            const float* diff_lam = arg_in(args, 12) + ly * 4 * 128; const float* diff_subg = arg_in(args, 13) + ly * 256;
            const float lambda_init = LAMBDA_INIT(ly);
            const float s1 = wave_sum(diff_lam[F.lane] * diff_lam[128 + F.lane] + diff_lam[64 + F.lane] * diff_lam[192 + F.lane]);
            const float s2 = wave_sum(diff_lam[256 + F.lane] * diff_lam[384 + F.lane] + diff_lam[320 + F.lane] * diff_lam[448 + F.lane]);
            const float lam = __expf(s1) - __expf(s2) + lambda_init;
            bf16_t* P = P_;
            for (int r = MROW0 + F.gw; r < R; r += F.ngw) post3_row(P, r, diff_subg, lam, 1.f - lambda_init, F.lane);
        }
#define GATE_PHASE(k, b, sk, seam) \
        if (((PHMASK >> 10) & 1) && IN(pb + (k))) { \
            PH_BEGIN; \
            { SkGate f{(bf16_t*)(ws + WS_GS), arg_in(args, 4) + ly * 3 * DM + (b) * DM, RS_(2 * ly)}; skinny_gemm(F.lds, XN_ + (size_t)MROW0 * DM, DM, WB_(WB_G) + (size_t)(b) * 2048 * DM, DM, 2048 / 16, (F.bid + (sk)) % F.G, F.G, f); } \
            SchedPlain S{XN_, DM, WB_(WB_G) + (size_t)(b) * 2048 * DM, DM, NPMM, 8, F.G, F.bid, 0}; EpiGate E{(bf16_t*)(ws + WS_GS), arg_in(args, 4) + ly * 3 * DM + (b) * DM, RS_(2 * ly)}; \
            pg8::gemm_phase(F.lds, S, E); \
            if (NREP(k) == 2) { GRID_BAR(); pg8::gemm_phase(F.lds, S, E); } \
            if (seam) SEAM(pb + (k)); \
        }
#define BRANCH_PHASE(k, b, oc, sk, seam) \
        if (((PHMASK >> 10) & 1) && IN(pb + (k))) { \
            PH_BEGIN; \
            { SkGated f{P_, (const bf16_t*)(ws + WS_GS), (b) == 0 ? 1 : 0}; skinny_gemm(F.lds, P_ + (size_t)MROW0 * PW + (oc), PW, WB_(WB_BR) + (size_t)(b) * DM * 1024, 1024, 2048 / 16, (F.bid + (sk)) % F.G, F.G, f); } \
            SchedPlain S{P_ + (oc), PW, WB_(WB_BR) + (size_t)(b) * DM * 1024, 1024, NPMM, 8, F.G, F.bid, C_MERGED}; EpiGated E{P_, (const bf16_t*)(ws + WS_GS), (b) == 0 ? 1 : 0, ((DBG_BM >> (b)) & 1) ? 1.f : 0.f}; \
            pg8::gemm_phase(F.lds, S, E); \
            if (NREP(k) == 2 && (b) == 0) { GRID_BAR(); pg8::gemm_phase(F.lds, S, E); } \
            if (seam) SEAM(pb + (k)); \
        }
        GATE_PHASE(10, 0, 0, 0) BRANCH_PHASE(11, 0, C_OA, 0, 0)
        GATE_PHASE(12, 1, 0, 0) BRANCH_PHASE(13, 1, C_OB, 0, 0)
        GATE_PHASE(14, 2, 0, 1) BRANCH_PHASE(15, 2, C_OC, 128, 1)
        if (((PHMASK >> 11) & 1) && IN(pb + 16)) {
            PH_BEGIN;
            { SkRes f{HMETA_, XN_, RS_(2 * ly + 1)}; skinny_gemm(F.lds, P_ + (size_t)MROW0 * PW + C_MERGED, PW, WB_(WB_O), DM, 2048 / 16, F.bid, F.G, f); }
            SchedPlain S{P_ + C_MERGED, PW, WB_(WB_O), DM, NPMM, 8, F.G, F.bid, 0}; EpiRes E{ly == 0 ? arg_in(args, 0) : (const float*)nullptr, (float*)nullptr, DBG_SA, XN_, RS_(2 * ly + 1)};
            pg8::gemm_phase(F.lds, S, E);
            SEAM(pb + 16);
        }
        if (((PHMASK >> 13) & 1) && IN(pb + 17)) {
            PH_BEGIN;
            skinny_swiglu(F.lds, XN_ + (size_t)MROW0 * DM, DM, WB_(WB_F1), DM, P_, RS_(2 * ly + 1), F.bid, F.G);
            SchedPlain S{XN_, DM, WB_(WB_F1), DM, NPMM, 44, F.G, F.bid, 0}; EpiSwiglu E{P_, RS_(2 * ly + 1)};
            pg8::gemm_phase(F.lds, S, E);
            if (NREP(17) == 2) { GRID_BAR(); pg8::gemm_phase(F.lds, S, E); }
            SEAM(pb + 17);
        }
        if (((PHMASK >> 14) & 1) && IN(pb + 18)) {
            PH_BEGIN;
            { SkRes f{HMETA_, ly == 0 ? XN_ : (bf16_t*)nullptr, RS_(2)}; skinny_gemm(F.lds, P_ + (size_t)MROW0 * PW, PW, WB_(WB_F2), DFF, 2048 / 16, F.bid, F.G, f); }
            SchedPlain S{P_, PW, WB_(WB_F2), DFF, NPMM, 8, F.G, F.bid, 0}; EpiRes E{(const float*)nullptr, ly == 0 ? (float*)nullptr : OUT_, DBG_SF, XN_, RS_(2)};
            pg8::gemm_phase(F.lds, S, E);
            SEAM(pb + 18);
        }
    }
#undef IN
#undef SEAM
}

__global__ void diag_fill(float* out, int n, float v) { for (int i = blockIdx.x * blockDim.x + threadIdx.x; i < n; i += gridDim.x * blockDim.x) out[i] = v; }
extern "C" void kernel_launch(void* const* d_in, const int* in_sizes, int n_in, void* d_out, int out_size, void* d_ws, size_t ws_size, hipStream_t stream) {
    static int grid = 0; static float code = 0.f;
    if (grid == 0) {
        int dev = 0, cus = 0;
        if (n_in != 19) { code = 10.f; grid = -1; }
        else if (ws_size < WS_END) { code = 20.f + (float)(ws_size >> 20) * 0.01f; grid = -1; }
        else if (hipGetDevice(&dev) != hipSuccess || hipDeviceGetAttribute(&cus, hipDeviceAttributeMultiprocessorCount, dev) != hipSuccess) { code = 40.f; grid = -1; }
        else if (hipFuncSetAttribute((const void*)mega_fwd, hipFuncAttributeMaxDynamicSharedMemorySize, LDS_BYTES) != hipSuccess) { code = 50.f; grid = -1; }
        else {
            int per_cu = 0;
            if (hipOccupancyMaxActiveBlocksPerMultiprocessor(&per_cu, (const void*)mega_fwd, NWAVES * 64, LDS_BYTES) != hipSuccess || per_cu < 1) { code = 60.f; grid = -1; }
            (void)hipGetLastError();
            if (grid == 0) grid = cus;
        }
    }
    if (grid < 0) { hipLaunchKernelGGL(diag_fill, dim3(1024), dim3(256), 0, stream, (float*)d_out, out_size, code); return; }
    (void)hipMemsetAsync((char*)d_ws + WS_CTL, 0, CTL_BYTES, stream);
    Args a{};
    for (int i = 0; i < 19; ++i) a.in[i] = (const float*)d_in[i];
    a.out = (float*)d_out; a.ws = (unsigned char*)d_ws;
#if MK_ONE_LAUNCH
    a.ph_lo = 0; a.ph_hi = N_PHASES;
    hipLaunchKernelGGL(mega_fwd, dim3(grid), dim3(NWAVES * 64), LDS_BYTES, stream, a);
#else
    for (int p = 0; p < N_PHASES; ++p) { a.ph_lo = p; a.ph_hi = p + 1; hipLaunchKernelGGL(mega_fwd, dim3(grid), dim3(NWAVES * 64), LDS_BYTES, stream, a); }
#endif
    if (hipPeekAtLastError() != hipSuccess) { (void)hipGetLastError(); hipLaunchKernelGGL(diag_fill, dim3(1024), dim3(256), 0, stream, (float*)d_out, out_size, 70.f); }
}
```

```cpp
#include <hip/hip_runtime.h>
#include <cstdio>
#include <cstdint>

#ifndef PHMASK
#define PHMASK 0x7fff
#endif
#ifndef REPMASK
#define REPMASK 0
#endif
#define NREP(k) ((((REPMASK) >> (k)) & 1) ? 2 : 1)
#ifndef DBG_BM
#define DBG_BM 7
#endif
#ifndef DBG_BR
#define DBG_BR 0
#endif
#ifndef DBG_SA
#define DBG_SA 1.0f
#endif
#ifndef DBG_SF
#define DBG_SF 1.0f
#endif
#ifndef MK_ONE_LAUNCH
#define MK_ONE_LAUNCH 1
#endif

#define LAS __attribute__((address_space(3)))
#define GAS __attribute__((address_space(1)))
typedef unsigned short bf16_t;
typedef short bf16x8 __attribute__((ext_vector_type(8)));
typedef float f32x4 __attribute__((ext_vector_type(4)));
typedef float f32x2 __attribute__((ext_vector_type(2)));
typedef unsigned u32x4 __attribute__((ext_vector_type(4)));
typedef unsigned u32x2 __attribute__((ext_vector_type(2)));
typedef unsigned long long rs_t;
__device__ __forceinline__ float rs_val(rs_t v) { return (float)((double)v * (1.0 / 4294967296.0)); }
__device__ __forceinline__ rs_t rs_fix(float ss) { return (rs_t)((double)ss * 4294967296.0); }

constexpr int DM = 2048, NB = 16, SEQ = 2048, NMETA = 16, MBLK = 256;
constexpr int R = MBLK + NB * SEQ;
constexpr int NPM = R / 256;
constexpr int NPMM = NPM - 1;
constexpr int MROW0 = MBLK - NMETA;
constexpr int NTOK = NB * SEQ;
constexpr int DFF = 5632;
constexpr int PW = 8448;
constexpr int C_CQ = 0, C_CKV = 512, C_KPE = 1024, C_IK = 1088, C_IW = 1152, C_DQ = 1280, C_DK = 2304, C_DV = 3328, C_IQ = 4352,
              C_FQ = 5376, C_FK = 6400, C_FV = 7424;
constexpr int C_KVRAW = 1280, C_QRAW = 3328, C_KPEH = 4864;
constexpr int C_OA = 0, C_OB = C_DQ, C_OC = C_FQ, C_MERGED = 2304;
constexpr int BMW = 66;
constexpr float EPS = 1e-6f;
constexpr float LOG2E = 1.4426950408889634f;
constexpr float C2_128 = 0.08838834764831845f * LOG2E;
constexpr float C2_192 = 0.07216878364870323f * LOG2E;
constexpr int D_IN = 14480;

constexpr size_t MiB = 1u << 20;
constexpr size_t WS_CTL = 0, CTL_BYTES = 1536 * 1024;
constexpr size_t WS_RSTD = 13 * MiB;
constexpr size_t WS_HMETA = 2 * MiB;
constexpr size_t WS_BM = 4 * MiB;
constexpr size_t WS_WB = 16 * MiB;
constexpr size_t WB_IN = 0, WB_G = WB_IN + (size_t)8448 * 2048 * 2, WB_QUP = WB_G + (size_t)6144 * 2048 * 2, WB_KVUP = WB_QUP + (size_t)1536 * 512 * 2,
                 WB_BR = WB_KVUP + (size_t)2048 * 512 * 2, WB_O = WB_BR + (size_t)3 * 2048 * 1024 * 2, WB_F1 = WB_O + (size_t)2048 * 2048 * 2,
                 WB_F2 = WB_F1 + (size_t)11264 * 2048 * 2, WB_END = WB_F2 + (size_t)2048 * 5632 * 2;
constexpr size_t WS_XN = 164 * MiB;
constexpr size_t WS_P = 294 * MiB;
constexpr size_t WS_GS = 828 * MiB;
constexpr size_t WS_END = 960 * MiB;
static_assert(WS_GS + (size_t)R * 2048 * 2 <= WS_END && WS_WB + WB_END <= WS_XN && WS_XN + (size_t)R * 2048 * 2 <= WS_P && WS_P + (size_t)R * PW * 2 <= WS_GS, "ws map");
constexpr int CW_BAR = 4096, CW_Q = 16384;
constexpr size_t WS_RS = 256 * 1024;
static_assert(WS_RS + (size_t)4 * R * 8 <= CTL_BYTES && CTL_BYTES <= WS_HMETA && WS_BM + (size_t)32768 * BMW * 4 <= WS_RSTD && WS_RSTD + 1 * MiB <= WS_WB, "ctl map");

__device__ __forceinline__ float bf2f(bf16_t v) { return __uint_as_float((unsigned)v << 16); }
__device__ __forceinline__ unsigned f2bf(float f) { unsigned u = __float_as_uint(f); return (u + 0x7fffu + ((u >> 16) & 1u)) >> 16; }
__device__ __forceinline__ unsigned pk2(float lo, float hi) { return f2bf(lo) | (f2bf(hi) << 16); }
typedef __bf16 bf16x2_t __attribute__((ext_vector_type(2)));
__device__ __forceinline__ unsigned cvt_pk_bf16(float lo, float hi) { f32x2 v = {lo, hi}; bf16x2_t b = __builtin_convertvector(v, bf16x2_t); return __builtin_bit_cast(unsigned, b); }
__device__ __forceinline__ float wave_sum(float v) {
#pragma unroll
    for (int o = 1; o < 64; o <<= 1) v += __shfl_xor(v, o);
    return v;
}
__device__ __forceinline__ float wave_max(float v) {
#pragma unroll
    for (int o = 1; o < 64; o <<= 1) v = fmaxf(v, __shfl_xor(v, o));
    return v;
}
#define LDS_WAIT() asm volatile("s_waitcnt lgkmcnt(0)" ::: "memory")
#define VM_WAIT() asm volatile("s_waitcnt vmcnt(0)" ::: "memory")
__device__ __forceinline__ int row_pos(int r) { return r < MBLK ? (r >= MBLK - NMETA ? r - (MBLK - NMETA) : 0) : NMETA + ((r - MBLK) & (SEQ - 1)); }
__device__ __forceinline__ void rope_cs(int pos, int i, float two_over_d, float& c, float& s) {
    const float inv = __builtin_amdgcn_exp2f(-(float)i * two_over_d * 13.287712379549449f);
    float rev = (float)pos * inv * 0.15915494309189535f;
    rev -= floorf(rev);
    s = __builtin_amdgcn_sinf(rev); c = __builtin_amdgcn_cosf(rev);
}

namespace pg8 {
constexpr int BM = 256, BK = 64, HALF = 128, HTB = HALF * BK * 2, STAGE_BYTES = 8 * HTB;
__device__ __forceinline__ int lds_byte(int r, int c) { const int st = (r >> 4) * 2 + (c >> 5), rr = r & 15, cc = c & 31, ob = rr * 64 + cc * 2; return st * 1024 + (ob ^ (((ob >> 9) & 1) << 5)); }
__device__ __forceinline__ void stage_rc(int b, int& R_, int& C_) { const int st = b / 1024, sb = b % 1024, swz = sb ^ (((sb >> 9) & 1) << 5); R_ = (st >> 1) * 16 + swz / 64; C_ = (st & 1) * 32 + (swz % 64) / 2; }
__device__ __forceinline__ int perm32(int rho) { const int n = rho >> 4, i = rho & 15; return 8 * (i >> 2) + 4 * n + (i & 3); }

struct Unit { const char* A; const char* B; unsigned lda2, ldb2; int nt, pm, pn, kind, ocol; };

#ifndef WGM
#define WGM 4
#endif
__device__ __forceinline__ void tile_of(int L, int nM, int nN, int& pm, int& pn) {
    const int nwg = nM * nN; int wgid = L;
    { const int q = nwg / 8, r = nwg % 8, xcd = wgid % 8, off = wgid / 8; wgid = (xcd < r ? xcd * (q + 1) : r * (q + 1) + (xcd - r) * q) + off; }
    const int nig = WGM * nN, gid = wgid / nig, fm = gid * WGM, gsz = (nM - fm) < WGM ? (nM - fm) : WGM;
    pm = fm + ((wgid % nig) % gsz); pn = (wgid % nig) / gsz;
}

template <class Epi, class Sched>
__device__ __forceinline__ void gemm_phase(LAS unsigned char* lds, const Sched& S, const Epi& E) {
    int tid = threadIdx.x; asm volatile("" : "+v"(tid));
    const int wid = __builtin_amdgcn_readfirstlane(tid >> 6), lane = tid & 63, wr = wid >> 2, wc = wid & 3, fr = lane & 15, fq = lane >> 4;
    unsigned rA[2], rB[2], cc[2];
#pragma unroll
    for (int i = 0; i < 2; ++i) { int R_, C_; stage_rc(tid * 16 + i * 8192, R_, C_); rA[i] = (unsigned)R_; rB[i] = (unsigned)(Epi::PERM ? ((R_ & ~31) + perm32(R_ & 31)) : R_); cc[i] = (unsigned)C_ * 2u; }
    const size_t kstep = (size_t)(BK * 2);
    const unsigned ldsw = (unsigned)wid * 1024u;
    const int aoff = lds_byte(wr * 64 + fr, fq * 8), boff = lds_byte(wc * 32 + fr, fq * 8);
#define PG8_SA(b, h) (((b) * 2 + (h)) * HTB)
#define PG8_SB(b, h) ((4 + (b) * 2 + (h)) * HTB)
#define PG8_STAGE(bufoff, gbase, rr, ld2) do { _Pragma("unroll") for (int _i = 0; _i < 2; ++_i) \
        __builtin_amdgcn_global_load_lds((const unsigned*)((const char*)(gbase) + ((rr)[_i] * (ld2) + cc[_i])), (LAS unsigned*)(lds + (bufoff) + ldsw + _i * 8192), 16, 0, 0); } while (0)
#define PG8_LDA(dst, b, h) do { _Pragma("unroll") for (int m = 0; m < 4; ++m) _Pragma("unroll") for (int k = 0; k < 2; ++k) dst[m][k] = *(const LAS bf16x8*)(lds + PG8_SA(b, h) + aoff + m * 2048 + k * 1024); } while (0)
#define PG8_LDB(dst, b, h) do { _Pragma("unroll") for (int n = 0; n < 2; ++n) _Pragma("unroll") for (int k = 0; k < 2; ++k) dst[n][k] = *(const LAS bf16x8*)(lds + PG8_SB(b, h) + boff + n * 2048 + k * 1024); } while (0)
#define PG8_MMA(ai, bj, At, Bt) do { __builtin_amdgcn_s_setprio(1); _Pragma("unroll") for (int m = 0; m < 4; ++m) _Pragma("unroll") for (int n = 0; n < 2; ++n) _Pragma("unroll") for (int k = 0; k < 2; ++k) \
        acc[ai][bj][m][n] = __builtin_amdgcn_mfma_f32_16x16x32_bf16(Bt[n][k], At[m][k], acc[ai][bj][m][n], 0, 0, 0); __builtin_amdgcn_s_setprio(0); } while (0)
#define PG8_WAIT_V(n) asm volatile("s_waitcnt vmcnt(" #n ")" ::: "memory")
#define PG8_WAIT_L(n) asm volatile("s_waitcnt lgkmcnt(" #n ")" ::: "memory")
#define PG8_BAR __builtin_amdgcn_s_barrier()
#define PG8_SCHED __builtin_amdgcn_sched_barrier(0)
    Unit cur, nxt; int ui = 0;
    if (!S.next(0, cur)) return;
    float zf = 0.f; asm volatile("" : "+v"(zf));
    f32x4 acc[2][2][4][2];
#pragma unroll
    for (int a = 0; a < 2; ++a)
#pragma unroll
        for (int b = 0; b < 2; ++b)
#pragma unroll
            for (int m = 0; m < 4; ++m)
#pragma unroll
                for (int n = 0; n < 2; ++n) acc[a][b][m][n] = (f32x4){zf, zf, zf, zf};
    bf16x8 At[4][2], B0[2][2], B1[2][2];
    const char* cA = cur.A; const char* cB = cur.B;
    unsigned lA = cur.lda2, lB = cur.ldb2;
    size_t hA = (size_t)HALF * lA, hB = (size_t)HALF * lB;
    PG8_STAGE(PG8_SB(0, 0), cB, rB, lB); PG8_STAGE(PG8_SB(0, 1), cB + hB, rB, lB); PG8_STAGE(PG8_SA(0, 0), cA, rA, lA); PG8_STAGE(PG8_SA(0, 1), cA + hA, rA, lA);
    if (wr == 1) PG8_BAR;
    PG8_WAIT_V(2); PG8_BAR;
    PG8_STAGE(PG8_SB(1, 0), cB + kstep, rB, lB); PG8_STAGE(PG8_SA(1, 0), cA + kstep, rA, lA); PG8_STAGE(PG8_SB(1, 1), cB + hB + kstep, rB, lB);
    PG8_WAIT_V(6); PG8_BAR;
    for (;;) {
        const bool has_next = S.next(ui + 1, nxt);
        if (!has_next) nxt = cur;
        const char* nA = nxt.A; const char* nB = nxt.B;
        const unsigned lAn = nxt.lda2, lBn = nxt.ldb2;
        const size_t hAn = (size_t)HALF * lAn, hBn = (size_t)HALF * lBn;
        const int nt = cur.nt;
        for (int t = 0; t < nt; t += 2) {
            const bool last = (t == nt - 2);
            const char* a1 = cA + (size_t)(t + 1) * kstep;
            const char* a2 = last ? nA : cA + (size_t)(t + 2) * kstep; const char* b2 = last ? nB : cB + (size_t)(t + 2) * kstep;
            const char* a3 = a2 + kstep; const char* b3 = b2 + kstep;
            const size_t hA2 = last ? hAn : hA, hB2 = last ? hBn : hB;
            const unsigned lA2 = last ? lAn : lA, lB2 = last ? lBn : lB;
            PG8_LDB(B0, 0, 0); PG8_LDB(B1, 0, 1); PG8_SCHED; PG8_LDA(At, 0, 0); PG8_STAGE(PG8_SA(1, 1), a1 + hA, rA, lA);
            PG8_WAIT_V(8); PG8_WAIT_L(0); PG8_BAR; PG8_MMA(0, 0, At, B0); PG8_MMA(0, 1, At, B1); PG8_BAR; PG8_SCHED;
            PG8_LDA(At, 0, 1); PG8_STAGE(PG8_SB(0, 0), b2, rB, lB2); PG8_STAGE(PG8_SB(0, 1), b2 + hB2, rB, lB2); PG8_STAGE(PG8_SA(0, 0), a2, rA, lA2);
            PG8_WAIT_V(8); PG8_WAIT_L(0); PG8_BAR; PG8_MMA(1, 0, At, B0); PG8_MMA(1, 1, At, B1); PG8_BAR; PG8_SCHED;
            PG8_LDB(B0, 1, 0); PG8_LDB(B1, 1, 1); PG8_SCHED; PG8_LDA(At, 1, 0); PG8_STAGE(PG8_SA(0, 1), a2 + hA2, rA, lA2);
            PG8_WAIT_V(8); PG8_WAIT_L(0); PG8_BAR; PG8_MMA(0, 0, At, B0); PG8_MMA(0, 1, At, B1); PG8_BAR; PG8_SCHED;
            PG8_LDA(At, 1, 1); PG8_STAGE(PG8_SB(1, 0), b3, rB, lB2); PG8_STAGE(PG8_SB(1, 1), b3 + hB2, rB, lB2); PG8_STAGE(PG8_SA(1, 0), a3, rA, lA2);
            PG8_WAIT_V(8); PG8_WAIT_L(0); PG8_BAR; PG8_MMA(1, 0, At, B0); PG8_MMA(1, 1, At, B1); PG8_BAR; PG8_SCHED;
        }
        if (wr == 0) PG8_BAR;
        E(acc, cur, wr, wc, fr, fq);
#pragma unroll
        for (int a = 0; a < 2; ++a)
#pragma unroll
            for (int b = 0; b < 2; ++b)
#pragma unroll
                for (int m = 0; m < 4; ++m)
#pragma unroll
                    for (int n = 0; n < 2; ++n) acc[a][b][m][n] = (f32x4){zf, zf, zf, zf};
        if (!has_next) break;
        cur = nxt; cA = nA; cB = nB; hA = hAn; hB = hBn; lA = lAn; lB = lBn; ++ui;
        if (wr == 1) PG8_BAR;
    }
    PG8_WAIT_V(0);
    PG8_BAR;
#undef PG8_SA
#undef PG8_SB
#undef PG8_STAGE
#undef PG8_LDA
#undef PG8_LDB
#undef PG8_MMA
#undef PG8_WAIT_V
#undef PG8_WAIT_L
#undef PG8_BAR
#undef PG8_SCHED
}
}
using pg8::Unit;

struct SchedPlain {
    const bf16_t* A; int lda; const bf16_t* B; int K; int nM, nN, G, c, ocol0;
    __device__ __forceinline__ bool next(int i, Unit& u) const {
        const int L = i * G + c; if (L >= nM * nN) return false;
        int pm, pn; pg8::tile_of(L, nM, nN, pm, pn); pm += 1;
        u.pm = pm; u.pn = pn; u.kind = 0; u.ocol = ocol0 + 256 * pn; u.nt = K / 64; u.lda2 = (unsigned)lda * 2u; u.ldb2 = (unsigned)K * 2u;
        u.A = (const char*)(A + (size_t)pm * 256 * lda); u.B = (const char*)(B + (size_t)pn * 256 * K); return true;
    }
};
struct SchedMlaUp {
    const bf16_t* P; const bf16_t* Wq; const bf16_t* Wkv; int G, c;
    __device__ __forceinline__ bool next(int i, Unit& u) const {
        const int L = i * G + c; if (L >= NPMM * 14) return false;
        int pm, pn; pg8::tile_of(L, NPMM, 14, pm, pn); pm += 1;
        u.pm = pm; u.pn = pn; u.kind = 0; u.nt = 8; u.lda2 = PW * 2u; u.ldb2 = 512 * 2u;
        if (pn < 6) { u.A = (const char*)(P + (size_t)pm * 256 * PW + C_CQ); u.B = (const char*)(Wq + (size_t)pn * 256 * 512); u.ocol = C_QRAW + 256 * pn; }
        else { u.A = (const char*)(P + (size_t)pm * 256 * PW + C_CKV); u.B = (const char*)(Wkv + (size_t)(pn - 6) * 256 * 512); u.ocol = C_KVRAW + 256 * (pn - 6); }
        return true;
    }
};
struct EpiP {
    static constexpr bool PERM = true;
    bf16_t* P; const rs_t* rs;
    __device__ __forceinline__ void operator()(const f32x4 (&acc)[2][2][4][2], const Unit& u, int wr, int wc, int fr, int fq) const {
        asm volatile("" : "+v"(fr), "+v"(fq));
        const int row0 = u.pm * 256 + wr * 64 + fr, col0 = u.ocol + wc * 32 + 8 * fq;
#pragma unroll
        for (int ai = 0; ai < 2; ++ai)
#pragma unroll
            for (int m = 0; m < 4; ++m) { bf16_t* rowp = P + (size_t)(row0 + ai * 128 + m * 16) * PW + col0;
                const float sc = rs ? __builtin_amdgcn_rsqf(rs_val(rs[row0 + ai * 128 + m * 16]) * (1.f / DM) + EPS) : 1.f;
#pragma unroll
                for (int bj = 0; bj < 2; ++bj) { const f32x4 v0 = acc[ai][bj][m][0] * sc, v1 = acc[ai][bj][m][1] * sc;
                    u32x4 w; w.x = cvt_pk_bf16(v0[0], v0[1]); w.y = cvt_pk_bf16(v0[2], v0[3]); w.z = cvt_pk_bf16(v1[0], v1[1]); w.w = cvt_pk_bf16(v1[2], v1[3]);
                    *(u32x4*)(rowp + bj * 128) = w; } }
    }
};
struct EpiG2 {
    static constexpr bool PERM = true;
    bf16_t* P; const rs_t* rs; const float* gperm; LAS float* xl;
    __device__ __forceinline__ void operator()(const f32x4 (&acc)[2][2][4][2], const Unit& u, int wr, int wc, int fr, int fq) const {
        asm volatile("" : "+v"(fr), "+v"(fq));
        const int row0 = u.pm * 256 + wr * 64 + fr, lcol = wc * 32 + 8 * fq, col0 = u.ocol + lcol;
        const int pn = u.pn;
        const bool plain = (pn >= 8 && pn < 12) || pn >= 24, isidx = (pn >= 12 && pn < 16), nrm = !plain && !isidx;
        float rsc[2][4];
#pragma unroll
        for (int ai = 0; ai < 2; ++ai)
#pragma unroll
            for (int m = 0; m < 4; ++m) rsc[ai][m] = __builtin_amdgcn_rsqf(rs_val(rs[row0 + ai * 128 + m * 16]) * (1.f / DM) + EPS);
        if (nrm) {
#pragma unroll
            for (int ai = 0; ai < 2; ++ai)
#pragma unroll
                for (int m = 0; m < 4; ++m)
#pragma unroll
                    for (int bj = 0; bj < 2; ++bj) { const f32x4 a = acc[ai][bj][m][0], b = acc[ai][bj][m][1]; float ss = (a[0] * a[0] + a[1] * a[1]) + (a[2] * a[2] + a[3] * a[3]) + (b[0] * b[0] + b[1] * b[1]) + (b[2] * b[2] + b[3] * b[3]);
                        ss += __shfl_xor(ss, 16); ss += __shfl_xor(ss, 32);
                        if (fq == 0) xl[((wr * 64 + fr + ai * 128 + m * 16) * 2 + bj) * 4 + wc] = ss * rsc[ai][m] * rsc[ai][m]; }
            asm volatile("s_waitcnt lgkmcnt(0)" ::: "memory"); __builtin_amdgcn_s_barrier(); asm volatile("" ::: "memory");
        }
        const int i0 = isidx ? (16 * (wc & 1) + 4 * fq) : (16 * wc + 4 * fq);
        const float tod = isidx ? (2.f / 64.f) : (2.f / 128.f);
        float inv[4];
#pragma unroll
        for (int j = 0; j < 4; ++j) inv[j] = __builtin_amdgcn_exp2f(-(float)(i0 + j) * tod * 13.287712379549449f) * 0.15915494309189535f;
        const int gidx = pn < 4 ? 0 : (pn < 8 ? 1 : (pn < 20 ? 2 : 3));
        const float qscale = (pn < 4 || (pn >= 16 && pn < 20)) ? C2_128 : 1.f;
        f32x4 g0 = (f32x4){1.f, 1.f, 1.f, 1.f}, g1 = g0;
        if (nrm) { g0 = *(const f32x4*)(gperm + gidx * 128 + lcol); g1 = *(const f32x4*)(gperm + gidx * 128 + lcol + 4); }
#pragma unroll
        for (int ai = 0; ai < 2; ++ai)
#pragma unroll
            for (int m = 0; m < 4; ++m) { const int row = row0 + ai * 128 + m * 16; bf16_t* rowp = P + (size_t)row * PW + col0;
                float cs[4], sn[4];
                if (!plain) { const float pos = (float)(NMETA + ((row - MBLK) & (SEQ - 1)));
#pragma unroll
                    for (int j = 0; j < 4; ++j) { float rev = pos * inv[j]; rev -= floorf(rev); sn[j] = __builtin_amdgcn_sinf(rev); cs[j] = __builtin_amdgcn_cosf(rev); } }
#pragma unroll
                for (int bj = 0; bj < 2; ++bj) { f32x4 v0 = acc[ai][bj][m][0] * rsc[ai][m], v1 = acc[ai][bj][m][1] * rsc[ai][m];
                    if (!plain) {
                        if (nrm) { const LAS f32x4* xp = (const LAS f32x4*)(xl + ((wr * 64 + fr + ai * 128 + m * 16) * 2 + bj) * 4); const f32x4 pp = *xp;
                            const float rn = __builtin_amdgcn_rsqf(((pp[0] + pp[1]) + (pp[2] + pp[3])) * (1.f / 128.f) + EPS); v0 = v0 * (g0 * rn); v1 = v1 * (g1 * rn); }
                        f32x4 w0, w1;
                        w0[0] = v0[0] * cs[0] - v0[1] * sn[0]; w0[1] = v0[1] * cs[0] + v0[0] * sn[0]; w0[2] = v0[2] * cs[1] - v0[3] * sn[1]; w0[3] = v0[3] * cs[1] + v0[2] * sn[1];
                        w1[0] = v1[0] * cs[2] - v1[1] * sn[2]; w1[1] = v1[1] * cs[2] + v1[0] * sn[2]; w1[2] = v1[2] * cs[3] - v1[3] * sn[3]; w1[3] = v1[3] * cs[3] + v1[2] * sn[3];
                        v0 = w0 * qscale; v1 = w1 * qscale; }
                    u32x4 w; w.x = cvt_pk_bf16(v0[0], v0[1]); w.y = cvt_pk_bf16(v0[2], v0[3]); w.z = cvt_pk_bf16(v1[0], v1[1]); w.w = cvt_pk_bf16(v1[2], v1[3]);
                    *(u32x4*)(rowp + bj * 128) = w; } }
    }
};
struct EpiGate {
    static constexpr bool PERM = true;
    bf16_t* G; const float* bias; const rs_t* rs;
    __device__ __forceinline__ void operator()(const f32x4 (&acc)[2][2][4][2], const Unit& u, int wr, int wc, int fr, int fq) const {
        asm volatile("" : "+v"(fr), "+v"(fq));
        const int row0 = u.pm * 256 + wr * 64 + fr, col0 = u.pn * 256 + wc * 32 + 8 * fq;
        float rsc[2][4];
#pragma unroll
        for (int ai = 0; ai < 2; ++ai)
#pragma unroll
            for (int m = 0; m < 4; ++m) rsc[ai][m] = __builtin_amdgcn_rsqf(rs_val(rs[row0 + ai * 128 + m * 16]) * (1.f / DM) + EPS);
#pragma unroll
        for (int bj = 0; bj < 2; ++bj) { const f32x4 bv0 = *(const f32x4*)(bias + col0 + bj * 128), bv1 = *(const f32x4*)(bias + col0 + bj * 128 + 4);
#pragma unroll
            for (int ai = 0; ai < 2; ++ai)
#pragma unroll
                for (int m = 0; m < 4; ++m) { bf16_t* rowp = G + (size_t)(row0 + ai * 128 + m * 16) * 2048 + col0; f32x4 v0 = acc[ai][bj][m][0] * rsc[ai][m] + bv0, v1 = acc[ai][bj][m][1] * rsc[ai][m] + bv1;
#pragma unroll
                    for (int e = 0; e < 4; ++e) { v0[e] = __builtin_amdgcn_rcpf(1.f + __builtin_amdgcn_exp2f(-v0[e] * LOG2E)); v1[e] = __builtin_amdgcn_rcpf(1.f + __builtin_amdgcn_exp2f(-v1[e] * LOG2E)); }
                    u32x4 w; w.x = cvt_pk_bf16(v0[0], v0[1]); w.y = cvt_pk_bf16(v0[2], v0[3]); w.z = cvt_pk_bf16(v1[0], v1[1]); w.w = cvt_pk_bf16(v1[2], v1[3]);
                    *(u32x4*)(rowp + bj * 128) = w; } }
    }
};
struct EpiGated {
    static constexpr bool PERM = true;
    bf16_t* P; const bf16_t* G; int first; float sc;
    __device__ __forceinline__ void operator()(const f32x4 (&acc)[2][2][4][2], const Unit& u, int wr, int wc, int fr, int fq) const {
        asm volatile("" : "+v"(fr), "+v"(fq));
        const int row0 = u.pm * 256 + wr * 64 + fr, lcol0 = u.pn * 256 + wc * 32 + 8 * fq, col0 = u.ocol + wc * 32 + 8 * fq;
        unsigned zu = 0u; asm volatile("" : "+v"(zu));
#pragma unroll
        for (int ai = 0; ai < 2; ++ai) {
            u32x4 gq[4][2], pq[4][2];
#pragma unroll
            for (int m = 0; m < 4; ++m)
#pragma unroll
                for (int bj = 0; bj < 2; ++bj) { gq[m][bj] = *(const u32x4*)(G + (size_t)(row0 + ai * 128 + m * 16) * 2048 + lcol0 + bj * 128); if (DBG_BR == 1) gq[m][bj] = (u32x4){0x3f803f80u, 0x3f803f80u, 0x3f803f80u, 0x3f803f80u};
                    pq[m][bj] = (u32x4){zu, zu, zu, zu}; if (!first) pq[m][bj] = *(const u32x4*)(P + (size_t)(row0 + ai * 128 + m * 16) * PW + col0 + bj * 128); }
#pragma unroll
            for (int m = 0; m < 4; ++m) { bf16_t* rowp = P + (size_t)(row0 + ai * 128 + m * 16) * PW + col0;
#pragma unroll
                for (int bj = 0; bj < 2; ++bj) { const u32x4 g = gq[m][bj], pv = pq[m][bj];
                    const f32x4 v0 = acc[ai][bj][m][0] * sc, v1 = acc[ai][bj][m][1] * sc;
                    float o[8];
                    o[0] = __uint_as_float(pv.x << 16) + __uint_as_float(g.x << 16) * v0[0]; o[1] = __uint_as_float(pv.x & 0xffff0000u) + __uint_as_float(g.x & 0xffff0000u) * v0[1];
                    o[2] = __uint_as_float(pv.y << 16) + __uint_as_float(g.y << 16) * v0[2]; o[3] = __uint_as_float(pv.y & 0xffff0000u) + __uint_as_float(g.y & 0xffff0000u) * v0[3];
                    o[4] = __uint_as_float(pv.z << 16) + __uint_as_float(g.z << 16) * v1[0]; o[5] = __uint_as_float(pv.z & 0xffff0000u) + __uint_as_float(g.z & 0xffff0000u) * v1[1];
                    o[6] = __uint_as_float(pv.w << 16) + __uint_as_float(g.w << 16) * v1[2]; o[7] = __uint_as_float(pv.w & 0xffff0000u) + __uint_as_float(g.w & 0xffff0000u) * v1[3];
                    u32x4 w; w.x = cvt_pk_bf16(o[0], o[1]); w.y = cvt_pk_bf16(o[2], o[3]); w.z = cvt_pk_bf16(o[4], o[5]); w.w = cvt_pk_bf16(o[6], o[7]);
                    *(u32x4*)(rowp + bj * 128) = w; } }
            asm volatile("" ::: "memory"); }
    }
};
struct EpiRes {
    static constexpr bool PERM = true;
    float* out_f; float dbg; bf16_t* hb; rs_t* rs;
    __device__ __forceinline__ void operator()(const f32x4 (&acc)[2][2][4][2], const Unit& u, int wr, int wc, int fr, int fq) const {
        asm volatile("" : "+v"(fr), "+v"(fq));
        const int lrow0 = wr * 64 + fr, col0 = u.pn * 256 + wc * 32 + 8 * fq;
        bf16_t* hp0 = hb + (size_t)(u.pm * 256 + lrow0) * DM + col0;
        u32x4 bw[2][4][2];
#pragma unroll
        for (int ai = 0; ai < 2; ++ai)
#pragma unroll
            for (int m = 0; m < 4; ++m)
#pragma unroll
                for (int bj = 0; bj < 2; ++bj) bw[ai][m][bj] = *(const u32x4*)(hp0 + (size_t)(ai * 128 + m * 16) * DM + bj * 128);
#pragma unroll
        for (int ai = 0; ai < 2; ++ai)
#pragma unroll
            for (int m = 0; m < 4; ++m) { const int lrow = lrow0 + ai * 128 + m * 16, grow = u.pm * 256 + lrow;
                const size_t foff = ((size_t)(u.pm - 1) * 256 + lrow) * DM + col0; bf16_t* hp = hp0 + (size_t)(ai * 128 + m * 16) * DM; float ss = 0.f;
#pragma unroll
                for (int bj = 0; bj < 2; ++bj) { const u32x4 w = bw[ai][m][bj];
                    const f32x4 b0 = (f32x4){__uint_as_float(w.x << 16), __uint_as_float(w.x & 0xffff0000u), __uint_as_float(w.y << 16), __uint_as_float(w.y & 0xffff0000u)};
                    const f32x4 b1 = (f32x4){__uint_as_float(w.z << 16), __uint_as_float(w.z & 0xffff0000u), __uint_as_float(w.w << 16), __uint_as_float(w.w & 0xffff0000u)};
                    const f32x4 h0 = b0 + acc[ai][bj][m][0] * dbg, h1 = b1 + acc[ai][bj][m][1] * dbg;
                    if (out_f) { *(f32x4*)(out_f + foff + bj * 128) = h0; *(f32x4*)(out_f + foff + bj * 128 + 4) = h1; }
                    else { ss += ((h0[0] * h0[0] + h0[1] * h0[1]) + (h0[2] * h0[2] + h0[3] * h0[3])) + ((h1[0] * h1[0] + h1[1] * h1[1]) + (h1[2] * h1[2] + h1[3] * h1[3]));
                        u32x4 o; o.x = cvt_pk_bf16(h0[0], h0[1]); o.y = cvt_pk_bf16(h0[2], h0[3]); o.z = cvt_pk_bf16(h1[0], h1[1]); o.w = cvt_pk_bf16(h1[2], h1[3]); *(u32x4*)(hp + bj * 128) = o; } }
                if (!out_f) { ss += __shfl_xor(ss, 16); ss += __shfl_xor(ss, 32); if (fq == 0) (void)__hip_atomic_fetch_add(rs + grow, rs_fix(ss), __ATOMIC_RELAXED, __HIP_MEMORY_SCOPE_AGENT); } }
    }
};
struct EpiSwiglu {
    static constexpr bool PERM = true;
    bf16_t* P; const rs_t* rs;
    __device__ __forceinline__ void operator()(const f32x4 (&acc)[2][2][4][2], const Unit& u, int wr, int wc, int fr, int fq) const {
        asm volatile("" : "+v"(fr), "+v"(fq));
        const int row0 = u.pm * 256 + wr * 64 + fr, col0 = u.pn * 128 + wc * 32 + 8 * fq;
#pragma unroll
        for (int ai = 0; ai < 2; ++ai)
#pragma unroll
            for (int m = 0; m < 4; ++m) { bf16_t* rowp = P + (size_t)(row0 + ai * 128 + m * 16) * PW + col0;
                const float sc = __builtin_amdgcn_rsqf(rs_val(rs[row0 + ai * 128 + m * 16]) * (1.f / DM) + EPS);
                float o[8];
#pragma unroll
                for (int n = 0; n < 2; ++n)
#pragma unroll
                    for (int e = 0; e < 4; ++e) { const float g = acc[ai][0][m][n][e] * sc, up = acc[ai][1][m][n][e] * sc; o[n * 4 + e] = g * __builtin_amdgcn_rcpf(1.f + __builtin_amdgcn_exp2f(-g * LOG2E)) * up; }
                u32x4 w; w.x = cvt_pk_bf16(o[0], o[1]); w.y = cvt_pk_bf16(o[2], o[3]); w.z = cvt_pk_bf16(o[4], o[5]); w.w = cvt_pk_bf16(o[6], o[7]);
                *(u32x4*)rowp = w; }
    }
};

struct SkP { bf16_t* P; int ocol; const rs_t* rs; __device__ __forceinline__ void operator()(int r, int c, float v) const { if (rs) v *= __builtin_amdgcn_rsqf(rs_val(rs[MROW0 + r]) * (1.f / DM) + EPS); P[(size_t)(MROW0 + r) * PW + ocol + c] = (bf16_t)f2bf(v); } };
struct SkGate { bf16_t* G; const float* bias; const rs_t* rs; __device__ __forceinline__ void operator()(int r, int c, float v) const { v *= __builtin_amdgcn_rsqf(rs_val(rs[MROW0 + r]) * (1.f / DM) + EPS); G[(size_t)(MROW0 + r) * 2048 + c] = (bf16_t)f2bf(__builtin_amdgcn_rcpf(1.f + __builtin_amdgcn_exp2f(-(v + bias[c]) * LOG2E))); } };
struct SkGated { bf16_t* P; const bf16_t* G; int first; __device__ __forceinline__ void operator()(int r, int c, float v) const { bf16_t* p = P + (size_t)(MROW0 + r) * PW + C_MERGED + c; const float pv = first ? 0.f : bf2f(*p); *p = (bf16_t)f2bf(pv + bf2f(G[(size_t)(MROW0 + r) * 2048 + c]) * v); } };
struct SkRes { float* hmeta; bf16_t* hb; rs_t* rs;
    __device__ __forceinline__ void operator()(int r, int c, float v) const { float* p = hmeta + (size_t)(MROW0 + r) * DM + c; const float hv = *p + v; *p = hv;
        if (hb) { hb[(size_t)(MROW0 + r) * DM + c] = (bf16_t)f2bf(hv); float ss = hv * hv; ss += __shfl_xor(ss, 1); ss += __shfl_xor(ss, 2); ss += __shfl_xor(ss, 4); ss += __shfl_xor(ss, 8);
            if ((threadIdx.x & 15) == 0) (void)__hip_atomic_fetch_add(rs + MROW0 + r, rs_fix(ss), __ATOMIC_RELAXED, __HIP_MEMORY_SCOPE_AGENT); } } };
template <class Fn>
__device__ __forceinline__ void skinny_gemm(LAS unsigned char* lds, const bf16_t* A, int lda, const bf16_t* Bt, int K, int ntask, int bid, int G, const Fn& f) {
    int tid = threadIdx.x; asm volatile("" : "+v"(tid));
    const int wid = __builtin_amdgcn_readfirstlane(tid >> 6), lane = tid & 63, l15 = lane & 15, kq = lane >> 4;
    LAS f32x4* red = (LAS f32x4*)lds;
    const int kw = K / 8;
    for (int task = bid; task < ntask; task += G) {
        const bf16_t* ap = A + (size_t)l15 * lda + wid * kw + kq * 8;
        const bf16_t* bp = Bt + (size_t)(task * 16 + l15) * K + wid * kw + kq * 8;
        float z = 0.f; asm volatile("" : "+v"(z));
        f32x4 acc = (f32x4){z, z, z, z};
        for (int k0 = 0; k0 < kw; k0 += 256) {
            bf16x8 fa[8], fb[8];
#pragma unroll
            for (int i = 0; i < 8; ++i) { const int k = (k0 + 32 * i < kw) ? k0 + 32 * i : 0; fa[i] = *(const bf16x8*)(ap + k); fb[i] = *(const bf16x8*)(bp + k); }
#pragma unroll
            for (int i = 0; i < 8; ++i) if (k0 + 32 * i < kw) acc = __builtin_amdgcn_mfma_f32_16x16x32_bf16(fa[i], fb[i], acc, 0, 0, 0);
        }
        red[wid * 64 + lane] = acc;
        LDS_WAIT(); __syncthreads();
        if (wid == 0) {
            f32x4 s = red[lane];
#pragma unroll
            for (int w = 1; w < 8; ++w) s += red[w * 64 + lane];
#pragma unroll
            for (int r = 0; r < 4; ++r) f(kq * 4 + r, task * 16 + l15, s[r]);
        }
        __syncthreads();
    }
}
__device__ __forceinline__ void skinny_swiglu(LAS unsigned char* lds, const bf16_t* A, int lda, const bf16_t* Bt, int K, bf16_t* P, const rs_t* rs, int bid, int G) {
    int tid = threadIdx.x; asm volatile("" : "+v"(tid));
    const int wid = __builtin_amdgcn_readfirstlane(tid >> 6), lane = tid & 63, l15 = lane & 15, kq = lane >> 4;
    LAS f32x4* red = (LAS f32x4*)lds;
    const int kw = K / 8;
    for (int task = bid; task < DFF / 16; task += G) {
        const int c0 = task * 16, brow = (c0 >> 7) * 256 + (c0 & 127) + l15;
        const bf16_t* ap = A + (size_t)l15 * lda + wid * kw + kq * 8;
        const bf16_t* bg = Bt + (size_t)brow * K + wid * kw + kq * 8; const bf16_t* bu = bg + (size_t)128 * K;
        float z = 0.f; asm volatile("" : "+v"(z));
        f32x4 ag = (f32x4){z, z, z, z}, au = ag;
        {
            bf16x8 fa[8], fg[8], fu[8];
#pragma unroll
            for (int i = 0; i < 8; ++i) { fa[i] = *(const bf16x8*)(ap + 32 * i); fg[i] = *(const bf16x8*)(bg + 32 * i); fu[i] = *(const bf16x8*)(bu + 32 * i); }
#pragma unroll
            for (int i = 0; i < 8; ++i) { ag = __builtin_amdgcn_mfma_f32_16x16x32_bf16(fa[i], fg[i], ag, 0, 0, 0); au = __builtin_amdgcn_mfma_f32_16x16x32_bf16(fa[i], fu[i], au, 0, 0, 0); }
        }
        red[wid * 64 + lane] = ag; red[512 + wid * 64 + lane] = au;
        LDS_WAIT(); __syncthreads();
        if (wid == 0) {
            f32x4 sg = red[lane], su = red[512 + lane];
#pragma unroll
            for (int w = 1; w < 8; ++w) { sg += red[w * 64 + lane]; su += red[512 + w * 64 + lane]; }
#pragma unroll
            for (int r = 0; r < 4; ++r) { const float sc = __builtin_amdgcn_rsqf(rs_val(rs[MROW0 + kq * 4 + r]) * (1.f / DM) + EPS); const float g = sg[r] * sc; su[r] *= sc; P[(size_t)(MROW0 + kq * 4 + r) * PW + c0 + l15] = (bf16_t)f2bf(g * __builtin_amdgcn_rcpf(1.f + __builtin_amdgcn_exp2f(-g * LOG2E)) * su[r]); }
        }
        __syncthreads();
    }
}

#define XB_TMO      128
#define XB_XCNT(j)  (256  + 64 * (j))
#define XB_XSUB(j)  (1280 + 64 * (j))
#define XB_XGEN(j)  (2304 + 64 * (j))
#define XB_TOP      3328
#define XB_TOPGEN   3392
#define XCD_BAR_WORDS 3456
#define XB_SPIN_CAP (1u << 18)
__device__ __forceinline__ unsigned xb_ld(unsigned* p)              { return __hip_atomic_load(p, __ATOMIC_RELAXED, __HIP_MEMORY_SCOPE_AGENT); }
__device__ __forceinline__ unsigned xb_add(unsigned* p, unsigned v) { return __hip_atomic_fetch_add(p, v, __ATOMIC_RELAXED, __HIP_MEMORY_SCOPE_AGENT); }
__device__ __forceinline__ unsigned xb_xcc_id() { return (unsigned)__builtin_amdgcn_s_getreg((3 << 11) | 20) & 0xFu; }
#define XB_SPIN(cond, bar) do { unsigned _sp = 0; while (cond) { __builtin_amdgcn_s_sleep(1); \
    if ((++_sp & 255u) == 0u) { if (xb_ld(&(bar)[XB_TMO])) break; if (_sp > XB_SPIN_CAP) { atomicAdd(&(bar)[XB_TMO], 1u); break; } } } } while (0)
struct XcdBarrier { unsigned* bar; unsigned x; volatile LAS unsigned* st; };
__device__ __forceinline__ XcdBarrier xcd_barrier_post(unsigned* bar, volatile LAS unsigned* st) {
    XcdBarrier b; b.bar = bar; b.x = xb_xcc_id(); b.st = st;
    if (threadIdx.x == 0) (void)xb_add(&bar[XB_XCNT(b.x)], 1u);
    return b;
}
__device__ __forceinline__ void xcd_barrier_complete(unsigned* bar, unsigned x, unsigned& nloc, unsigned& nx) {
    const unsigned G = gridDim.x * gridDim.y * gridDim.z;
    unsigned sum, cnt, mine, sp = 0u;
    for (;;) {
        sum = 0u; cnt = 0u; mine = 0u;
#pragma unroll
        for (unsigned j = 0; j < 16; ++j) { const unsigned c = xb_ld(&bar[XB_XCNT(j)]); sum += c; cnt += (c > 0u) ? 1u : 0u; mine = (j == x) ? c : mine; }
        if (sum == G) break;
        __builtin_amdgcn_s_sleep(1);
        if ((++sp & 255u) == 0u) { if (xb_ld(&bar[XB_TMO])) break; if (sp > XB_SPIN_CAP) { atomicAdd(&bar[XB_TMO], 1u); break; } }
    }
    nloc = mine > 0u ? mine : 1u; nx = cnt > 0u ? cnt : 1u;
}
__device__ __forceinline__ void xcd_barrier(const XcdBarrier& b) {
    asm volatile("s_waitcnt vmcnt(0)" ::: "memory");
    __syncthreads();
    if (threadIdx.x == 0) {
        unsigned* bar = b.bar;
        __builtin_amdgcn_s_waitcnt(0);
        unsigned nloc = b.st[0], nx = b.st[1];
        if (nloc == 0u) { xcd_barrier_complete(bar, b.x, nloc, nx); b.st[0] = nloc; b.st[1] = nx; }
        const unsigned old = xb_add(&bar[XB_XSUB(b.x)], 1u);
        const unsigned gen = old / nloc;
        if (old + 1u == (gen + 1u) * nloc) {
            __builtin_amdgcn_fence(__ATOMIC_RELEASE, "agent");
            asm volatile("s_waitcnt vmcnt(0)" ::: "memory");
            const unsigned og = xb_add(&bar[XB_TOP], 1u);
            const unsigned tg = og / nx;
            if (og + 1u == (tg + 1u) * nx) xb_add(&bar[XB_TOPGEN], 1u);
            else XB_SPIN(xb_ld(&bar[XB_TOPGEN]) == tg, bar);
            __builtin_amdgcn_fence(__ATOMIC_ACQUIRE, "agent");
            xb_add(&bar[XB_XGEN(b.x)], 1u);
            asm volatile("s_waitcnt vmcnt(0)" ::: "memory");
        } else {
            XB_SPIN(xb_ld(&bar[XB_XGEN(b.x)]) == gen, bar);
            __builtin_amdgcn_fence(__ATOMIC_ACQUIRE, "agent");
            asm volatile("s_waitcnt vmcnt(0)" ::: "memory");
        }
    }
    __syncthreads();
}

constexpr int NWAVES = 8;
constexpr int RING_BYTES = 131072, LDS_BYTES = 147456, LDSCTL_OFF = LDS_BYTES - 512;
struct Args {
    const float* in[19]; float* out; unsigned char* ws; int ph_lo, ph_hi;
};
struct Ctx {
    LAS unsigned char* lds; int tid, lane, wave, gw, ngw, G, bid;
};

template <int MAP> __device__ __forceinline__ int wmap(int n, float& sc) {
    sc = 1.f;
    if (MAP == 0) return n;
    if (MAP == 1) {
        if (n < 1088) return n;
        if (n < 3136) { const int m = n - 1088, d = m & 127; return 1280 + (m - d) + (d < 64 ? 2 * d : 2 * (d - 64) + 1); }
        if (n < 4160) return 1280 + (n - 1088);
        if (n < 5184) { const int m = n - 4160, d = m & 63; return 4352 + (m - d) + (d < 32 ? 2 * d : 2 * (d - 32) + 1); }
        if (n < 5248) { const int d = n - 5184; return 1088 + (d < 32 ? 2 * d : 2 * (d - 32) + 1); }
        if (n < 5264) { sc = 0.03125f; return 1152 + (n - 5248); }
        if (n < 7312) { const int m = n - 5264, d = m & 127; return 5376 + (m - d) + (d < 64 ? 2 * d : 2 * (d - 64) + 1); }
        if (n < 8336) return 5376 + (n - 5264);
        return 8448 + (n - 8336);
    }
    if (n < DFF) return (n >> 7) * 256 + (n & 127);
    const int m = n - DFF; return (m >> 7) * 256 + 128 + (m & 127);
}
template <int MAP> __device__ __forceinline__ void conv_matrix(const Ctx& F, const float* W, int K, int N, bf16_t* WT, const float* gain) {
    LAS float* scr = (LAS float*)(F.lds + F.wave * 18432);
    const int lane = F.lane;
    const int nblk = (N + 63) / 64, nit = (K / 64) * nblk;
    const int l31 = lane & 31, lh = lane >> 5, c = lane & 7, nsub = lane >> 3;
    f32x2 wv[32]; f32x4 g0 = (f32x4){1.f, 1.f, 1.f, 1.f}, g1 = g0;
#define CONV_LOAD(item) do { const int kb_ = (item) / nblk, nb_ = (item) - kb_ * nblk, k0_ = 64 * kb_, nn_ = 64 * nb_ + 2 * l31; \
        const float* src_ = W + (size_t)(k0_ + lh) * N + nn_; const bool ok_ = nn_ < N; \
        _Pragma("unroll") for (int i = 0; i < 32; ++i) wv[i] = ok_ ? *(const f32x2*)(src_ + (size_t)(2 * i) * N) : (f32x2){0.f, 0.f}; \
        if (gain) { g0 = *(const f32x4*)(gain + k0_ + 8 * c); g1 = *(const f32x4*)(gain + k0_ + 8 * c + 4); } } while (0)
    int it = F.gw;
    if (it < nit) CONV_LOAD(it);
    while (it < nit) {
        const int kb = it / nblk, nb = it - kb * nblk, k0 = 64 * kb, n0 = 64 * nb;
#pragma unroll
        for (int i = 0; i < 32; ++i) { LAS float* d = scr + (2 * i + lh) * 65 + l31; d[0] = wv[i].x; d[32] = wv[i].y; }
        const f32x4 gc0 = g0, gc1 = g1;
        const int nx = it + F.ngw;
        if (nx < nit) CONV_LOAD(nx);
        LDS_WAIT(); asm volatile("" ::: "memory");
#pragma unroll
        for (int j = 0; j < 8; ++j) { const int n = nsub + 8 * j, ns = n0 + n;
            if (ns < N) { float sc; const int dst = wmap<MAP>(ns, sc); const LAS float* s = scr + (8 * c) * 65 + (n & 1) * 32 + (n >> 1);
                u32x4 o; o.x = pk2(s[0 * 65] * (sc * gc0.x), s[1 * 65] * (sc * gc0.y)); o.y = pk2(s[2 * 65] * (sc * gc0.z), s[3 * 65] * (sc * gc0.w));
                o.z = pk2(s[4 * 65] * (sc * gc1.x), s[5 * 65] * (sc * gc1.y)); o.w = pk2(s[6 * 65] * (sc * gc1.z), s[7 * 65] * (sc * gc1.w));
                *(u32x4*)(WT + (size_t)dst * K + k0 + 8 * c) = o; } }
        LDS_WAIT(); asm volatile("" ::: "memory");
        it = nx;
    }
#undef CONV_LOAD
}

__device__ __forceinline__ void norm_row(const float* hrow, bf16_t* orow, rs_t* rs_row, int lane) {
    f32x4 v[8]; float s = 0.f;
#pragma unroll
    for (int j = 0; j < 8; ++j) { v[j] = *((const f32x4*)hrow + lane + 64 * j); s += (v[j].x * v[j].x + v[j].y * v[j].y) + (v[j].z * v[j].z + v[j].w * v[j].w); }
    s = wave_sum(s);
    if (lane == 0) *rs_row = rs_fix(s);
#pragma unroll
    for (int j = 0; j < 8; ++j) { u32x2 o; o.x = cvt_pk_bf16(v[j].x, v[j].y); o.y = cvt_pk_bf16(v[j].z, v[j].w); *((u32x2*)orow + lane + 64 * j) = o; }
}

__device__ __forceinline__ void post1a_row(const bf16_t* P, int r, float* rstdq, float* rstdkv, int lane) {
    const bf16_t* p = P + (size_t)r * PW;
    const u32x4 a = *((const u32x4*)(p + C_CQ) + lane), b = *((const u32x4*)(p + C_CKV) + lane);
    float sa = 0.f, sb = 0.f;
#pragma unroll
    for (int e = 0; e < 4; ++e) { const float x0 = __uint_as_float(a[e] << 16), x1 = __uint_as_float(a[e] & 0xffff0000u); sa += x0 * x0 + x1 * x1;
        const float y0 = __uint_as_float(b[e] << 16), y1 = __uint_as_float(b[e] & 0xffff0000u); sb += y0 * y0 + y1 * y1; }
    sa = wave_sum(sa); sb = wave_sum(sb);
    if (lane == 0) { rstdq[r] = 1.0f / sqrtf(sa * (1.f / 512.f) + EPS); rstdkv[r] = 1.0f / sqrtf(sb * (1.f / 512.f) + EPS); }
    { unsigned* ikp = (unsigned*)(P + (size_t)r * PW + C_IK) + (lane & 31); const unsigned w = *ikp; const float x1 = __uint_as_float(w << 16), x2 = __uint_as_float(w & 0xffff0000u);
      float cs, sn; rope_cs(row_pos(r), lane & 31, 2.f / 64.f, cs, sn);
      if (lane < 32) *ikp = cvt_pk_bf16(x1 * cs - x2 * sn, x2 * cs + x1 * sn); }
}
__device__ __forceinline__ void meta_post_row(bf16_t* P, int r, const float* gperm, int lane) {
    bf16_t* p = P + (size_t)r * PW; const int pos = row_pos(r);
    float c128, s128, c64, s64; rope_cs(pos, lane, 2.f / 128.f, c128, s128); rope_cs(pos, lane & 31, 2.f / 64.f, c64, s64);
#pragma unroll 1
    for (int t = 0; t < 4; ++t) {
        const int cb = t == 0 ? C_DQ : (t == 1 ? C_DK : (t == 2 ? C_FQ : C_FK)); const float sc = (t == 0 || t == 2) ? C2_128 : 1.f;
        const float ga = gperm[t * 128 + 2 * lane], gb = gperm[t * 128 + 2 * lane + 1];
#pragma unroll 1
        for (int h = 0; h < 8; ++h) { unsigned* xp = (unsigned*)(p + cb + h * 128) + lane; const unsigned w = *xp; float x1 = __uint_as_float(w << 16), x2 = __uint_as_float(w & 0xffff0000u);
            const float rn = __builtin_amdgcn_rsqf(wave_sum(x1 * x1 + x2 * x2) * (1.f / 128.f) + EPS); x1 *= rn * ga; x2 *= rn * gb;
            *xp = cvt_pk_bf16((x1 * c128 - x2 * s128) * sc, (x2 * c128 + x1 * s128) * sc); }
    }
#pragma unroll 1
    for (int hh = 0; hh < 8; ++hh) { unsigned* xp = (unsigned*)(p + C_IQ + hh * 128) + lane; const unsigned w = *xp; const float x1 = __uint_as_float(w << 16), x2 = __uint_as_float(w & 0xffff0000u);
        *xp = cvt_pk_bf16(x1 * c64 - x2 * s64, x2 * c64 + x1 * s64); }
}
__device__ __forceinline__ void unpack8(const u32x4& w, float (&x)[8]) {
#pragma unroll
    for (int e = 0; e < 4; ++e) { x[2 * e] = __uint_as_float(w[e] << 16); x[2 * e + 1] = __uint_as_float(w[e] & 0xffff0000u); }
}
__device__ __forceinline__ u32x4 pack8(const float (&x)[8]) { u32x4 w; w.x = cvt_pk_bf16(x[0], x[1]); w.y = cvt_pk_bf16(x[2], x[3]); w.z = cvt_pk_bf16(x[4], x[5]); w.w = cvt_pk_bf16(x[6], x[7]); return w; }
__device__ __forceinline__ u32x4 shfl_xor4(const u32x4& w, int m) { u32x4 r; r.x = __shfl_xor(w.x, m); r.y = __shfl_xor(w.y, m); r.z = __shfl_xor(w.z, m); r.w = __shfl_xor(w.w, m); return r; }
__device__ __forceinline__ void post2_row(bf16_t* P, int r, const float* rstdq, const float* rstdkv, const float* qkg  , LAS float* rnl, int lane) {
    bf16_t* p = P + (size_t)r * PW;
    const float sq = rstdq[r], skv = rstdkv[r];
    const int pos = row_pos(r), hw = lane >> 5, l5 = lane & 31;
    float c64[8], s64[8];
#pragma unroll
    for (int j = 0; j < 8; ++j) rope_cs(pos, 8 * (lane & 3) + j, 2.f / 64.f, c64[j], s64[j]);
    float kp[8]; { const u32x4 w = *(const u32x4*)(p + C_KPE + (lane & 7) * 8); unpack8(w, kp); }
    float kpe_ss = 0.f;
#pragma unroll
    for (int j = 0; j < 8; ++j) kpe_ss += kp[j] * kp[j];
    kpe_ss += __shfl_xor(kpe_ss, 1); kpe_ss += __shfl_xor(kpe_ss, 2); kpe_ss += __shfl_xor(kpe_ss, 4);
    u32x4 rq[4], rkv[4];
#pragma unroll
    for (int it = 0; it < 4; ++it) { const int h = 2 * it + hw; rq[it] = *(const u32x4*)(p + C_QRAW + h * 192 + (l5 < 24 ? l5 : 0) * 8); rkv[it] = *(const u32x4*)(p + C_KVRAW + h * 256 + l5 * 8); }
#pragma unroll
    for (int it = 0; it < 4; ++it) {
        const int h = 2 * it + hw; const bool act = l5 < 24;
        u32x4* ptr = (u32x4*)(p + C_QRAW + h * 192 + (act ? l5 : 0) * 8);
        float x[8]; unpack8(rq[it], x);
        float ss = 0.f;
#pragma unroll
        for (int j = 0; j < 8; ++j) { x[j] *= sq; ss += x[j] * x[j]; }
        if (!act) ss = 0.f;
#pragma unroll
        for (int o = 1; o < 32; o <<= 1) ss += __shfl_xor(ss, o);
        const float rn = 1.0f / sqrtf(ss * (1.f / 192.f) + EPS);
        const int gi = (act ? l5 : 0) * 8;
        const f32x4 g0 = *(const f32x4*)(qkg + gi), g1 = *(const f32x4*)(qkg + gi + 4);
#pragma unroll
        for (int j = 0; j < 4; ++j) { x[j] *= rn * g0[j]; x[4 + j] *= rn * g1[j]; }
        float o[8];
#pragma unroll
        for (int j = 0; j < 8; ++j) { const float pr = __shfl_xor(x[j], 4); const float rot = (l5 & 4) ? (x[j] * c64[j] + pr * s64[j]) : (x[j] * c64[j] - pr * s64[j]); o[j] = (l5 >= 16 ? rot : x[j]) * C2_192; }
        if (act) *ptr = pack8(o);
    }
#pragma unroll
    for (int it = 0; it < 4; ++it) {
        const int h = 2 * it + hw; const bool isk = l5 < 16;
        u32x4* ptr = (u32x4*)(p + C_KVRAW + h * 256 + l5 * 8);
        float x[8]; unpack8(rkv[it], x);
        float ss = 0.f;
#pragma unroll
        for (int j = 0; j < 8; ++j) { x[j] *= skv; ss += x[j] * x[j]; }
        if (!isk) ss = 0.f;
#pragma unroll
        for (int o = 1; o < 32; o <<= 1) ss += __shfl_xor(ss, o);
        const float rn = 1.0f / sqrtf((ss + kpe_ss) * (1.f / 192.f) + EPS);
        if (l5 == 0) rnl[h] = rn;
        const int gi = 192 + (isk ? l5 : 0) * 8;
        const f32x4 g0 = *(const f32x4*)(qkg + gi), g1 = *(const f32x4*)(qkg + gi + 4);
        float o[8];
#pragma unroll
        for (int j = 0; j < 4; ++j) { o[j] = isk ? x[j] * rn * g0[j] : x[j]; o[4 + j] = isk ? x[4 + j] * rn * g1[j] : x[4 + j]; }
        *ptr = pack8(o);
    }
    LDS_WAIT(); asm volatile("" ::: "memory");
    { const int hd = lane >> 3, c = lane & 7; const float rn = rnl[hd];
      const f32x4 g0 = *(const f32x4*)(qkg + 192 + 128 + c * 8), g1 = *(const f32x4*)(qkg + 192 + 128 + c * 8 + 4);
      float x[8], o[8];
#pragma unroll
      for (int j = 0; j < 4; ++j) { x[j] = kp[j] * rn * g0[j]; x[4 + j] = kp[4 + j] * rn * g1[j]; }
#pragma unroll
      for (int j = 0; j < 8; ++j) { const float pr = __shfl_xor(x[j], 4); o[j] = (c & 4) ? (x[j] * c64[j] + pr * s64[j]) : (x[j] * c64[j] - pr * s64[j]); }
      *(u32x4*)(p + C_KPEH + hd * 64 + c * 8) = pack8(o); }
    LDS_WAIT(); asm volatile("" ::: "memory");
}
__device__ __forceinline__ void post3_row(bf16_t* P, int r, const float* subg, float lam, float omli, int lane) {
    bf16_t* p = P + (size_t)r * PW;
    const int hw = lane >> 5, l5 = lane & 31;
    u32x4 rr[4];
#pragma unroll
    for (int h = 0; h < 4; ++h) rr[h] = *(const u32x4*)(p + (hw ? C_IQ : C_FQ) + h * 256 + l5 * 8);
#pragma unroll
    for (int h = 0; h < 4; ++h) {
        const u32x4 raw = rr[h];
        const u32x4 praw = shfl_xor4(raw, 16);
        float a[8], b[8]; unpack8(raw, a); unpack8(praw, b);
        float d[8], ss = 0.f;
#pragma unroll
        for (int j = 0; j < 8; ++j) { d[j] = a[j] - lam * b[j]; ss += d[j] * d[j]; }
        if (l5 >= 16) ss = 0.f;
#pragma unroll
        for (int o = 1; o < 64; o <<= 1) ss += __shfl_xor(ss, o);
        const float rn = omli / sqrtf(ss * (1.f / 256.f) + EPS);
        const int dim = hw * 128 + (l5 & 15) * 8;
        const f32x4 g0 = *(const f32x4*)(subg + dim), g1 = *(const f32x4*)(subg + dim + 4);
        float o[8];
#pragma unroll
        for (int j = 0; j < 4; ++j) { o[j] = d[j] * rn * g0[j]; o[4 + j] = d[4 + j] * rn * g1[j]; }
        if (l5 < 16) *(u32x4*)(p + C_OC + h * 256 + dim) = pack8(o);
    }
}

__device__ __forceinline__ void index_unit(const bf16_t* P, int unit, unsigned* bm, LAS unsigned char* lds) {
    typedef float f32x16 __attribute__((ext_vector_type(16)));
    int tid = threadIdx.x; asm volatile("" : "+v"(tid));
    const int wid = __builtin_amdgcn_readfirstlane(tid >> 6), lane = tid & 63, j = lane & 31, hi = lane >> 5;
    const int tb = 255 - (unit >> 4), b = unit & 15, t0 = tb * 8, tokbase = MBLK + b * SEQ;
    const int wmax = (64 + t0 + 7) >> 5;
    LAS unsigned* keys = (LAS unsigned*)lds;
    LAS float* iwl = (LAS float*)(lds + 8 * 2112 * 4);
    if (t0 + 7 + 17 > 256) {
        if (tid < 128) iwl[tid] = bf2f(P[(size_t)(tokbase + t0 + (tid >> 4)) * PW + C_IW + (tid & 15)]);
        LAS unsigned char* al = lds + 8 * 2112 * 4 + 512;
        { const int id0 = tid * 2;
#pragma unroll
          for (int e = 0; e < 2; ++e) { const int id = id0 + e, rw = id >> 3, c = id & 7;
              *(LAS bf16x8*)(al + rw * 144 + c * 16) = *(const bf16x8*)(P + (size_t)(tokbase + t0 + (rw >> 4)) * PW + C_IQ + (rw & 15) * 64 + c * 8); } }
        LDS_WAIT(); __syncthreads();
        bf16x8 af[4][4];
        { const int qa = (j >> 2) & 1, ha = (j & 3) + 4 * (j >> 3);
#pragma unroll
          for (int blk = 0; blk < 4; ++blk)
#pragma unroll
              for (int s = 0; s < 4; ++s) af[blk][s] = *(const LAS bf16x8*)(al + ((2 * blk + qa) * 16 + ha) * 144 + s * 32 + hi * 16); }
        const unsigned boff = (unsigned)(j * PW + C_IK + hi * 8) * 2u;
        for (int w = wid; w <= wmax; w += 8) {
            const int kr_ = w < 2 ? (MBLK - 64) + 32 * w : tokbase + 32 * (w - 2); const char* bp_ = (const char*)(P + (size_t)kr_ * PW) + boff;
            bf16x8 bf[4];
#pragma unroll
            for (int s = 0; s < 4; ++s) bf[s] = *(const bf16x8*)(bp_ + s * 32);
            const int kidx = 32 * w + j;
#pragma unroll
            for (int blk = 0; blk < 4; ++blk) {
                f32x16 acc = (f32x16){0.f,0.f,0.f,0.f,0.f,0.f,0.f,0.f,0.f,0.f,0.f,0.f,0.f,0.f,0.f,0.f};
#pragma unroll
                for (int s = 0; s < 4; ++s) acc = __builtin_amdgcn_mfma_f32_32x32x16_bf16(af[blk][s], bf[s], acc, 0, 0, 0);
                const int q = 2 * blk + hi;
                const LAS f32x4* iwq = (const LAS f32x4*)(iwl + q * 16);
                float score = 0.f;
#pragma unroll
                for (int g = 0; g < 4; ++g) { const f32x4 wv = iwq[g]; score += fmaxf(acc[4 * g], 0.f) * wv.x + fmaxf(acc[4 * g + 1], 0.f) * wv.y + fmaxf(acc[4 * g + 2], 0.f) * wv.z + fmaxf(acc[4 * g + 3], 0.f) * wv.w; }
                const bool valid = kidx >= 48 && kidx <= 64 + t0 + q; const unsigned u_ = __float_as_uint(score);
                keys[q * 2112 + kidx] = valid ? ((u_ & 0x80000000u) ? ~u_ : (u_ | 0x80000000u)) : 0u;
            }
        }
        LDS_WAIT(); __syncthreads();
    }
    const int tq = t0 + wid, qk = 64 + tq, nch = qk / 64 + 1;
    unsigned* out = bm + (size_t)(b * SEQ + tq) * BMW;
    if (tq + 17 <= 256) {
        for (int c = 0; c < 33; ++c) { const int kidx = 64 * c + lane; const unsigned long long m = __ballot(kidx >= 48 && kidx <= qk);
            if (lane == 0) { out[2 * c] = (unsigned)m; out[2 * c + 1] = (unsigned)(m >> 32); } }
    } else {
        unsigned kreg[33];
#pragma unroll
        for (int c = 0; c < 33; ++c) kreg[c] = (c < nch && 64 * c + lane <= qk) ? keys[wid * 2112 + 64 * c + lane] : 0u;
        unsigned T = 0u;
        for (int bit = 31; bit >= 0; --bit) {
            const unsigned cand = T | (1u << bit); int cnt = 0;
#pragma unroll
            for (int c = 0; c < 33; ++c) cnt += __popcll(__ballot(kreg[c] >= cand));
            if (cnt >= 256) T = cand;
            if (cnt == 256) break;
        }
#pragma unroll
        for (int c = 0; c < 33; ++c) { const unsigned long long m = __ballot(kreg[c] >= T && kreg[c] != 0u);
            if (lane == 0) { out[2 * c] = (unsigned)m; out[2 * c + 1] = (unsigned)(m >> 32); } }
    }
    LDS_WAIT();
}

namespace fa {
typedef float f32x16 __attribute__((ext_vector_type(16)));
typedef short s16x4 __attribute__((ext_vector_type(4)));
__device__ __forceinline__ int crow(int r, int hi) { return (r & 3) + 8 * (r >> 2) + 4 * hi; }
__device__ __forceinline__ int v_st(int k, int c) { const int kk = (k & ~0xC) | ((k & 4) << 1) | ((k & 8) >> 1); return ((kk >> 3) * 4 + (c >> 5)) * 512 + ((kk & 7) * 32 + (c & 31)) * 2; }
__device__ __forceinline__ int v_rd_base(int lane) { return ((lane & 3) << 3) | (((lane >> 2) & 3) << 6) | (((lane >> 4) & 1) << 5) | (((lane >> 5) & 1) << 8); }
constexpr int v_rd_off(int d0, int ks, int half) { return d0 * 512 + ks * 4096 + half * 2048; }
constexpr int SHM_V = 16384;
template <int DQK, int DV> struct Geo { static constexpr int KP = DQK * 2, SHM_K = 64 * DQK * 2, LDS_K0 = 2 * 64 * DV * 2, LDS_WS = LDS_K0 + 2 * SHM_K, BYTES = LDS_WS + 8 * 256; };
#define FA_KSWZ(row, colB, pitch) ((row) * (pitch) + ((colB) ^ (((row) & 7) << 4)))
#define FA_SBAR() __builtin_amdgcn_sched_barrier(0)

struct Item { int qrow0, qk0, nt, tokbase; };

template <int DQK>
__device__ __forceinline__ void load_q(const bf16_t* P, const Item& it, int qcol, bf16x8 (&qr)[DQK / 16]) {
    int tid = threadIdx.x; asm volatile("" : "+v"(tid));
    const int wid = tid >> 6, lane = tid & 63, r32 = lane & 31, hi = lane >> 5;
    const bf16_t* qp = P + (size_t)(it.qrow0 + wid * 32 + r32) * PW + qcol + hi * 8;
#pragma unroll
    for (int d0 = 0; d0 < DQK / 16; ++d0) qr[d0] = *(const bf16x8*)(qp + d0 * 16);
}

template <int DQK, int DV, bool MASKED>
__device__ __forceinline__ void attn_core(bf16_t* P, const Item& it, const bf16x8 (&qr)[DQK / 16], int k1col, int k2col, int vcol, int ocol, int ocol1, const unsigned* bmq, LAS unsigned char* lds) {
    typedef Geo<DQK, DV> G; constexpr int SHMV = 64 * DV * 2, NDB = DV / 32;
    int tid = threadIdx.x; asm volatile("" : "+v"(tid));
    const int wid = __builtin_amdgcn_readfirstlane(tid >> 6), lane = tid & 63, r32 = lane & 31, hi = lane >> 5;
    LAS unsigned char* V_lds = lds; LAS unsigned char* K_lds = lds + G::LDS_K0; LAS float* wsf = (LAS float*)(lds + G::LDS_WS) + wid * 64;
    const int sr = tid >> 4, sc = (tid & 15) * 8;
    const int vst0 = v_st(sr, sc), vst1 = v_st(32 + sr, sc), kws0 = FA_KSWZ(sr, sc * 2, G::KP), kws1 = FA_KSWZ(sr + 32, sc * 2, G::KP);
    const int xr = tid >> 3, xc = (tid & 7) * 8, kws2 = FA_KSWZ(xr, (128 + xc) * 2, G::KP);
    const unsigned loff0 = (unsigned)(sr * PW + sc) * 2u, loffx = (unsigned)(xr * PW + xc) * 2u;
    const int vb0 = (int)(unsigned)(size_t)V_lds + v_rd_base(lane);
    const int NT = it.nt;
    const int qk = it.qk0 + wid * 32 + r32;
    const bool use_bm = MASKED && (bmq != nullptr);
    const unsigned bmoff = (unsigned)((wid * 32 + r32) * BMW) * 4u;
    float l_reg = 0.f; f32x16 o[NDB];
#pragma unroll
    for (int d = 0; d < NDB; ++d) o[d] = (f32x16){0.f,0.f,0.f,0.f,0.f,0.f,0.f,0.f,0.f,0.f,0.f,0.f,0.f,0.f,0.f,0.f};
    bf16x8 sk0, sk1, sk2, sv0, sv1, sv2, sv3;
#define FA_KROW0(t) ((t) == 0 ? (MBLK - 64) : it.tokbase + 64 * ((t) - 1))
#define FA_LOADK(t) do { const int kr_ = FA_KROW0(t); const char* rb_ = (const char*)(P + (size_t)kr_ * PW); const char* rk_ = rb_ + (size_t)k1col * 2; \
        sk0 = *(const bf16x8*)(rk_ + loff0); sk1 = *(const bf16x8*)(rk_ + (size_t)32 * PW * 2 + loff0); if (DQK == 192) sk2 = *(const bf16x8*)(rb_ + (size_t)k2col * 2 + loffx); } while (0)
#define FA_LOADV(t) do { const char* rv_ = (const char*)(P + (size_t)FA_KROW0(t) * PW) + (size_t)vcol * 2; \
        sv0 = *(const bf16x8*)(rv_ + loff0); sv1 = *(const bf16x8*)(rv_ + (size_t)32 * PW * 2 + loff0); if (DV == 256) { sv2 = *(const bf16x8*)(rv_ + 256 + loff0); sv3 = *(const bf16x8*)(rv_ + 256 + (size_t)32 * PW * 2 + loff0); } } while (0)
#define FA_LOAD(t) do { FA_LOADK(t); FA_LOADV(t); } while (0)
#define FA_WRITE(bf) do { *(LAS bf16x8*)(K_lds + (bf) * G::SHM_K + kws0) = sk0; *(LAS bf16x8*)(K_lds + (bf) * G::SHM_K + kws1) = sk1; \
        *(LAS bf16x8*)(V_lds + (bf) * SHMV + vst0) = sv0; *(LAS bf16x8*)(V_lds + (bf) * SHMV + vst1) = sv1; if (DV == 256) { *(LAS bf16x8*)(V_lds + (bf) * SHMV + 16384 + vst0) = sv2; *(LAS bf16x8*)(V_lds + (bf) * SHMV + 16384 + vst1) = sv3; } \
        if (DQK == 192) *(LAS bf16x8*)(K_lds + (bf) * G::SHM_K + kws2) = sk2; } while (0)
    constexpr int QREG = (DV == 256) ? 3 : DQK / 16;
    constexpr int NQL = DQK / 16 - QREG;
    static_assert(G::BYTES + 8 * NQL * 64 * 16 <= LDSCTL_OFF, "attention LDS budget");
    LAS unsigned char* qx = lds + G::BYTES + (wid * (NQL * 64) + lane) * 16;
    if (QREG < DQK / 16) {
#pragma unroll
        for (int d0 = QREG; d0 < DQK / 16; ++d0) *(LAS bf16x8*)(qx + (d0 - QREG) * 1024) = qr[d0];
    }
    FA_LOAD(0); FA_WRITE(0);
    __syncthreads();
    for (int t = 0; t < NT; ++t) {
        const int cur = t & 1;
        unsigned zb = 0u; asm volatile("" : "+v"(zb)); u32x2 bw = (u32x2){zb, zb};
        if (use_bm) bw = *(const u32x2*)((const char*)(bmq + 2 * t) + bmoff);
        f32x16 p0 = (f32x16){0.f,0.f,0.f,0.f,0.f,0.f,0.f,0.f,0.f,0.f,0.f,0.f,0.f,0.f,0.f,0.f}, p1 = p0;
        { LAS unsigned char* kbase = K_lds + cur * G::SHM_K;
          LAS unsigned char* kb[4];
#pragma unroll
          for (int dd = 0; dd < 4; ++dd) kb[dd] = kbase + FA_KSWZ(r32, (dd * 16 + hi * 8) * 2, G::KP);
          constexpr int GS = (DQK == 192 || DV == 256) ? 2 : 4;
#pragma unroll
          for (int g = 0; g < DQK / (16 * GS); ++g) {
              bf16x8 fb0[GS], fb1[GS];
#pragma unroll
              for (int dd = 0; dd < GS; ++dd) { const int d0 = g * GS + dd; LAS unsigned char* a = kb[d0 & 3] + (d0 >> 2) * 128; fb0[dd] = *(const LAS bf16x8*)a; fb1[dd] = *(const LAS bf16x8*)(a + 32 * G::KP); }
              FA_SBAR();
#pragma unroll
              for (int dd = 0; dd < GS; ++dd) { const int d0 = g * GS + dd; bf16x8 qf; if (d0 < QREG) qf = qr[d0 < QREG ? d0 : 0]; else qf = *(const LAS bf16x8*)(qx + (d0 - QREG) * 1024);
                  p0 = __builtin_amdgcn_mfma_f32_32x32x16_bf16(fb0[dd], qf, p0, 0, 0, 0); p1 = __builtin_amdgcn_mfma_f32_32x32x16_bf16(fb1[dd], qf, p1, 0, 0, 0); }
              FA_SBAR(); } }
        if (t + 1 < NT) { FA_LOADK(t + 1); if (DV != 256) FA_LOADV(t + 1); }
        FA_SBAR();
        const float NEG = -__builtin_inff();
        if (use_bm) {
        } else if (t == 0 || 64 * t + 63 > it.qk0 + wid * 32) {
            const int kb_ = 64 * t + 4 * hi;
#pragma unroll
            for (int r = 0; r < 16; ++r) { const int k0 = kb_ + (r & 3) + 8 * (r >> 2), k1 = k0 + 32;
                if (k0 < 48 || k0 > qk) p0[r] = NEG; if (k1 < 48 || k1 > qk) p1[r] = NEG; }
        }
        float ps = 0.f;
#pragma unroll
        for (int r = 0; r < 16; ++r) { p0[r] = __builtin_amdgcn_exp2f(p0[r]); p1[r] = __builtin_amdgcn_exp2f(p1[r]); }
        if (use_bm) {
            const int wx = (int)(bw.x >> (4 * hi)), wy = (int)(bw.y >> (4 * hi));
#pragma unroll
            for (int r = 0; r < 16; ++r) { const int c = (r & 3) + 8 * (r >> 2);
                p0[r] = __uint_as_float(__float_as_uint(p0[r]) & (unsigned)__builtin_amdgcn_sbfe(wx, c, 1)); p1[r] = __uint_as_float(__float_as_uint(p1[r]) & (unsigned)__builtin_amdgcn_sbfe(wy, c, 1)); }
        }
        { f32x2 s2 = (f32x2){p0[0], p0[1]} + (f32x2){p1[0], p1[1]};
#pragma unroll
          for (int r = 2; r < 16; r += 2) s2 += (f32x2){p0[r], p0[r + 1]} + (f32x2){p1[r], p1[r + 1]};
          ps = s2.x + s2.y; }
        { auto rr = __builtin_amdgcn_permlane32_swap(__float_as_uint(ps), __float_as_uint(ps), false, false); ps = __uint_as_float(rr[0]) + __uint_as_float(rr[1]); }
        l_reg += ps;
        if (DV == 256 && t + 1 < NT) { FA_SBAR(); FA_LOADV(t + 1); FA_SBAR(); }
        bf16x8 pa0, pa1, pa2, pa3;
#define FA_PK4(Pv, B_, OUT) do { const unsigned a0 = cvt_pk_bf16(Pv[B_ + 0], Pv[B_ + 1]), a1 = cvt_pk_bf16(Pv[B_ + 2], Pv[B_ + 3]), b0 = cvt_pk_bf16(Pv[B_ + 4], Pv[B_ + 5]), b1 = cvt_pk_bf16(Pv[B_ + 6], Pv[B_ + 7]); \
        auto r0 = __builtin_amdgcn_permlane32_swap(a0, b0, false, false); auto r1 = __builtin_amdgcn_permlane32_swap(a1, b1, false, false); \
        u32x4 w_ = {r0[0], r1[0], r0[1], r1[1]}; OUT = __builtin_bit_cast(bf16x8, w_); } while (0)
        FA_PK4(p0, 0, pa0); FA_PK4(p0, 8, pa1); FA_PK4(p1, 0, pa2); FA_PK4(p1, 8, pa3);
#define FA_TRRD(dst, off) asm volatile("ds_read_b64_tr_b16 %0, %1 offset:%2" : "=&v"(dst) : "v"(vbc), "i"(off) : "memory")
#define FA_PV(VB, d0) do { s16x4 l0, l1, l2, l3, h0, h1, h2, h3; constexpr int b_ = ((d0) >> 2) * 16384 + v_rd_off((d0) & 3, 0, 0); \
        FA_TRRD(l0, b_); FA_TRRD(h0, b_ + 2048); FA_TRRD(l1, b_ + 4096); FA_TRRD(h1, b_ + 6144); FA_TRRD(l2, b_ + 8192); FA_TRRD(h2, b_ + 10240); FA_TRRD(l3, b_ + 12288); FA_TRRD(h3, b_ + 14336); \
        asm volatile("s_waitcnt lgkmcnt(0)" ::: "memory"); FA_SBAR(); \
        o[d0] = __builtin_amdgcn_mfma_f32_32x32x16_bf16(pa0, (bf16x8){l0[0], l0[1], l0[2], l0[3], h0[0], h0[1], h0[2], h0[3]}, o[d0], 0, 0, 0); \
        o[d0] = __builtin_amdgcn_mfma_f32_32x32x16_bf16(pa1, (bf16x8){l1[0], l1[1], l1[2], l1[3], h1[0], h1[1], h1[2], h1[3]}, o[d0], 0, 0, 0); \
        o[d0] = __builtin_amdgcn_mfma_f32_32x32x16_bf16(pa2, (bf16x8){l2[0], l2[1], l2[2], l2[3], h2[0], h2[1], h2[2], h2[3]}, o[d0], 0, 0, 0); \
        o[d0] = __builtin_amdgcn_mfma_f32_32x32x16_bf16(pa3, (bf16x8){l3[0], l3[1], l3[2], l3[3], h3[0], h3[1], h3[2], h3[3]}, o[d0], 0, 0, 0); } while (0)
        FA_SBAR();
        { const int vbc = vb0 + cur * SHMV;
          FA_PV(0, 0); FA_PV(0, 1); FA_PV(0, 2); FA_PV(0, 3); if (DV == 256) { FA_PV(0, 4); FA_PV(0, 5); FA_PV(0, 6); FA_PV(0, 7); } }
        FA_SBAR();
        if (t + 1 < NT) { const int nb_ = cur ^ 1; FA_WRITE(nb_); }
        __syncthreads();
    }
    if (hi == 0) wsf[r32] = l_reg; LDS_WAIT();
    float rli[16];
#pragma unroll
    for (int r = 0; r < 16; ++r) { const float lv = wsf[crow(r, hi)]; rli[r] = lv > 0.f ? __builtin_amdgcn_rcpf(lv) : 0.f; }
    { int l2 = lane; asm volatile("" : "+v"(l2));
      const int r32b = l2 & 31, hib = l2 >> 5;
      char* Ow = (char*)(P + (size_t)(it.qrow0 + wid * 32) * PW + ocol) + (unsigned)((4 * hib) * PW + r32b) * 2u;
      char* Ow1 = (char*)(P + (size_t)(it.qrow0 + wid * 32) * PW + ocol1) + (unsigned)((4 * hib) * PW + r32b) * 2u;
#pragma unroll
      for (int r = 0; r < 16; ++r) { const unsigned ro = (unsigned)(((r & 3) + 8 * (r >> 2)) * PW) * 2u;
#pragma unroll
        for (int d0 = 0; d0 < NDB; ++d0) { const float v = o[d0][r] * rli[r]; const float vn = __shfl_xor(v, 1);
            if ((r32b & 1) == 0) *(unsigned*)((d0 < 4 ? Ow : Ow1) + ro + (d0 & 3) * 64) = cvt_pk_bf16(v, vn); } } }
    LDS_WAIT();
    __syncthreads();
#undef FA_KROW0
#undef FA_LOAD
#undef FA_LOADK
#undef FA_LOADV
#undef FA_WRITE
#undef FA_PK4
#undef FA_TRRD
#undef FA_PV
}
__device__ __forceinline__ int next_item(unsigned* ctr, LAS int* slot) {
    __syncthreads();
    if (threadIdx.x == 0) *slot = (int)__hip_atomic_fetch_add(ctr, 1u, __ATOMIC_RELAXED, __HIP_MEMORY_SCOPE_AGENT);
    __syncthreads();
    return *slot;
}
__device__ __forceinline__ void queue_prime(unsigned* ctr, LAS int* slot) {
    __syncthreads();
    if (threadIdx.x == 0) slot[0] = (int)__hip_atomic_fetch_add(ctr, 1u, __ATOMIC_RELAXED, __HIP_MEMORY_SCOPE_AGENT);
    __syncthreads();
}
__device__ __forceinline__ int queue_next(unsigned* ctr, LAS int* slot, int k) {
    const int idx = slot[k & 1];
    if (threadIdx.x == 0) slot[(k + 1) & 1] = (int)__hip_atomic_fetch_add(ctr, 1u, __ATOMIC_RELAXED, __HIP_MEMORY_SCOPE_AGENT);
    return idx;
}
__device__ __forceinline__ Item make_item(bool meta, int b, int qb) {
    Item it;
    if (meta) { it.qrow0 = 0; it.qk0 = -(MBLK - 64); it.nt = 1; it.tokbase = MBLK; }
    else { it.qrow0 = MBLK + b * SEQ + qb * 256; it.qk0 = 64 + qb * 256; it.nt = 4 * (qb + 1) + 1; it.tokbase = MBLK + b * SEQ; }
    return it;
}
}


constexpr int PH_PER_LAYER = 19, N_PHASES = 2 * PH_PER_LAYER;
__device__ __forceinline__ unsigned char* uni_ptr(unsigned char* p) { const unsigned long long v = (unsigned long long)p; const unsigned lo = __builtin_amdgcn_readfirstlane((unsigned)v), hi = __builtin_amdgcn_readfirstlane((unsigned)(v >> 32)); return (unsigned char*)(((unsigned long long)hi << 32) | lo); }
__device__ __forceinline__ const float* arg_in(const Args& a, int k) { asm volatile("" : "+s"(k)); return a.in[k]; }
__global__ void __launch_bounds__(NWAVES * 64, 2) mega_fwd(Args args) {
    extern __shared__ __attribute__((aligned(16))) unsigned char lds_raw[];
    {
        LAS unsigned char* l0 = (LAS unsigned char*)lds_raw;
        for (int u = threadIdx.x; u < (LDS_BYTES - LDSCTL_OFF) / 4; u += NWAVES * 64) ((LAS unsigned*)(l0 + LDSCTL_OFF))[u] = 0u;
        __syncthreads();
    }
#if MK_ONE_LAUNCH
    (void)xcd_barrier_post((unsigned*)(args.ws + WS_CTL) + CW_BAR, (volatile LAS unsigned*)((LAS unsigned char*)lds_raw + LDSCTL_OFF + 64));
#define GRID_BAR() do { XcdBarrier bar_; bar_.bar = (unsigned*)(uni_ptr(args.ws) + WS_CTL) + CW_BAR; bar_.x = xb_xcc_id(); bar_.st = (volatile LAS unsigned*)((LAS unsigned char*)lds_raw + LDSCTL_OFF + 64); xcd_barrier(bar_); } while (0)
#else
#define GRID_BAR() do {} while (0)
#endif
    const int lo = args.ph_lo, hi = args.ph_hi;
#define IN(k) (lo <= (k) && (k) < hi)
#define SEAM(k) do { if (IN((k) + 1)) GRID_BAR(); } while (0)
#define PH_BEGIN \
    int tid_ = threadIdx.x; asm volatile("" : "+v"(tid_)); \
    Ctx F; F.lds = (LAS unsigned char*)lds_raw; F.tid = tid_; F.lane = tid_ & 63; F.wave = __builtin_amdgcn_readfirstlane(tid_ >> 6); \
    F.G = gridDim.x; F.bid = blockIdx.x; F.gw = F.bid * NWAVES + F.wave; F.ngw = F.G * NWAVES; \
    unsigned char* ws = uni_ptr(args.ws); asm volatile("" : "+s"(ws)); \
    int ly = __builtin_amdgcn_readfirstlane(layer); asm volatile("" : "+s"(ly)); (void)ly; (void)F
#define XN_ ((bf16_t*)(ws + WS_XN))
#define P_ ((bf16_t*)(ws + WS_P))
#define HMETA_ ((float*)(ws + WS_HMETA))
#define RSTDQ_ ((float*)(ws + WS_RSTD))
#define RSTDKV_ ((float*)(ws + WS_RSTD) + R)
#define BM_ ((unsigned*)(ws + WS_BM))
#define RS_(i) ((rs_t*)(ws + WS_CTL + WS_RS) + (size_t)(i) * R)
#define GPERM_ ((float*)(ws + WS_RSTD + 512 * 1024))
#define WB_(off) ((bf16_t*)(ws + WS_WB + (off)))
#define OUT_ (args.out)
#define LAMBDA_INIT(ly) ((ly) == 0 ? 0.2f : (0.8f - 0.6f * 0.7408182206817179f))

#pragma unroll
    for (int layer = 0; layer < 2; ++layer) {
        const int pb = layer * PH_PER_LAYER;
        if (((PHMASK >> 0) & 1) && IN(pb + 0)) {
            PH_BEGIN;
            for (int rep_ = 0; rep_ < NREP(0); ++rep_) { if (rep_) GRID_BAR();
            const float* meta = arg_in(args, 1);
            conv_matrix<1>(F, arg_in(args, 3) + (size_t)ly * DM * D_IN, DM, D_IN, WB_(WB_IN), arg_in(args, 2) + ly * DM);
            conv_matrix<0>(F, arg_in(args, 7) + (size_t)ly * 512 * 1536, 512, 1536, WB_(WB_QUP), arg_in(args, 5) + ly * 512);
            conv_matrix<0>(F, arg_in(args, 8) + (size_t)ly * 512 * 2048, 512, 2048, WB_(WB_KVUP), arg_in(args, 6) + ly * 512);
            for (int b = 0; b < 3; ++b) conv_matrix<0>(F, arg_in(args, 14) + ((size_t)ly * 3 + b) * 1024 * DM, 1024, DM, WB_(WB_BR) + (size_t)b * DM * 1024, nullptr);
            conv_matrix<0>(F, arg_in(args, 15) + (size_t)ly * DM * DM, DM, DM, WB_(WB_O), nullptr);
            conv_matrix<2>(F, arg_in(args, 17) + (size_t)ly * DM * 2 * DFF, DM, 2 * DFF, WB_(WB_F1), arg_in(args, 16) + ly * DM);
            conv_matrix<0>(F, arg_in(args, 18) + (size_t)ly * DFF * DM, DFF, DM, WB_(WB_F2), nullptr);
            unsigned zu = 0u; asm volatile("" : "+v"(zu)); const float zf = __uint_as_float(zu);
            for (int i = F.gw * 64 + F.lane; i < 112 * 2048 / 8; i += F.ngw * 64) *((u32x4*)(WB_(WB_IN) + (size_t)1168 * 2048) + i) = (u32x4){zu, zu, zu, zu};
            if (F.bid == 0) { const int i = F.tid; const int t = i >> 7, ps = i & 127, dim = (ps >> 1) + 64 * (ps & 1);
                const float* gsrc = (t < 2 ? arg_in(args, 10) : arg_in(args, 11)) + ly * 256 + (t & 1) * 128; GPERM_[i] = gsrc[dim]; }
            float* hmeta = HMETA_;
            if (ly == 0) {
                for (int i = F.gw * 64 + F.lane; i < MROW0 * PW / 8; i += F.ngw * 64) *((u32x4*)P_ + i) = (u32x4){zu, zu, zu, zu};
                for (int i = F.gw * 64 + F.lane; i < MBLK * DM / 4; i += F.ngw * 64) { const int rr = i / (DM / 4); f32x4 v = (f32x4){zf, zf, zf, zf};
                    if (rr >= MBLK - NMETA) v = *((const f32x4*)meta + (i - (MBLK - NMETA) * (DM / 4))); *((f32x4*)hmeta + i) = v; }
            }
            if (ly == 0) {
                const float* xin = arg_in(args, 0); bf16_t* XN = XN_; rs_t* rs0 = RS_(0);
                for (int r = MROW0 + F.gw; r < R; r += F.ngw)
                    norm_row(r < MBLK ? meta + (size_t)(r - MROW0) * DM : xin + (size_t)(r - MBLK) * DM, XN + (size_t)r * DM, rs0 + r, F.lane);
            }
            }
            SEAM(pb + 0);
        }
        if (((PHMASK >> 1) & 1) && IN(pb + 1)) {
            PH_BEGIN;
            { SkP f{P_, 0, RS_(2 * ly)}; skinny_gemm(F.lds, XN_ + (size_t)MROW0 * DM, DM, WB_(WB_IN), DM, 1280 / 16, F.bid, F.G, f); }
            SchedPlain S{XN_, DM, WB_(WB_IN), DM, NPMM, 5, F.G, F.bid, 0}; EpiP E{P_, RS_(2 * ly)};
            pg8::gemm_phase(F.lds, S, E);
            if (NREP(1) == 2) { GRID_BAR(); pg8::gemm_phase(F.lds, S, E); }
            SEAM(pb + 1);
        }
        if (((PHMASK >> 2) & 1) && IN(pb + 2)) {
            PH_BEGIN;
            { bf16_t* P = P_; float* rq = RSTDQ_; float* rkv = RSTDKV_;
              for (int r = MROW0 + F.gw; r < R; r += F.ngw) post1a_row(P, r, rq, rkv, F.lane); }
            VM_WAIT(); __syncthreads();
            { SkP f{P_, C_QRAW, nullptr}; skinny_gemm(F.lds, P_ + (size_t)MROW0 * PW + C_CQ, PW, WB_(WB_QUP), 512, 1536 / 16, F.bid, F.G, f); }
            { SkP f{P_, C_KVRAW, nullptr}; skinny_gemm(F.lds, P_ + (size_t)MROW0 * PW + C_CKV, PW, WB_(WB_KVUP), 512, 2048 / 16, F.bid, F.G, f); }
            SchedMlaUp S{P_, WB_(WB_QUP), WB_(WB_KVUP), F.G, F.bid}; EpiP E{P_, nullptr};
            pg8::gemm_phase(F.lds, S, E);
            if (NREP(2) == 2) { GRID_BAR(); pg8::gemm_phase(F.lds, S, E); }
            SEAM(pb + 2);
        }
        if (((PHMASK >> 3) & 1) && IN(pb + 3)) {
            PH_BEGIN;
            const float* mla_qkg = arg_in(args, 9) + ly * 2 * 192;
            bf16_t* P = P_; float* rq = RSTDQ_; float* rkv = RSTDKV_;
            LAS float* rnl = (LAS float*)(F.lds + F.wave * 64);
            for (int r = MROW0 + F.gw; r < R; r += F.ngw) post2_row(P, r, rq, rkv, mla_qkg, rnl, F.lane);
            SEAM(pb + 3);
        }
        if (((PHMASK >> 4) & 1) && IN(pb + 4)) {
            PH_BEGIN;
            bf16_t* P = P_;
            LAS int* slot = (LAS int*)(F.lds + LDSCTL_OFF + 128);
            for (int rep_ = 0; rep_ < NREP(4); ++rep_) { if (rep_) GRID_BAR();
            unsigned* ctr = (unsigned*)(ws + WS_CTL) + CW_Q + 64 * (ly * 4 + 0) + 64 * 16 * rep_;
            const bool stat = (F.G == 256); const int sx = F.bid & 7, spl = (F.bid >> 3) >> 2, sj = (F.bid >> 3) & 3;
            if (!stat) fa::queue_prime(ctr, slot);
            for (int qk_ = 0;; ++qk_) {
                int idx;
                if (stat) { if (qk_ < 4) { const int pr = sx + 8 * (spl + 8 * (qk_ >> 1)), qb = (qk_ & 1) ? sj : 7 - sj; idx = (7 - qb) * 128 + pr; } else idx = (qk_ == 4 && F.bid < 8) ? 1024 + F.bid : 1 << 30; }
                else idx = fa::queue_next(ctr, slot, qk_);
                if (idx >= 8 * 129) break;
                int h; fa::Item it;
                if (idx < 1024) { const int qb = 7 - (idx >> 7), rest = idx & 127; h = rest & 7; it = fa::make_item(false, rest >> 3, qb); } else { h = idx - 1024; it = fa::make_item(true, 0, 0); }
                bf16x8 qr[12]; fa::load_q<192>(P, it, C_QRAW + h * 192, qr);
                fa::attn_core<192, 128, false>(P, it, qr, C_KVRAW + h * 256, C_KPEH + h * 64, C_KVRAW + h * 256 + 128, C_OA + h * 128, 0, nullptr, F.lds);
            } }
            SEAM(pb + 4);
        }
        if (((PHMASK >> 5) & 1) && IN(pb + 5)) {
            PH_BEGIN;
            { SkP f{P_, 1280, RS_(2 * ly)}; skinny_gemm(F.lds, XN_ + (size_t)MROW0 * DM, DM, WB_(WB_IN) + (size_t)1280 * DM, DM, 7168 / 16, F.bid, F.G, f); }
            SchedPlain S{XN_, DM, WB_(WB_IN) + (size_t)1280 * DM, DM, NPMM, 28, F.G, F.bid, 1280}; EpiG2 E{P_, RS_(2 * ly), GPERM_, (LAS float*)(F.lds + RING_BYTES)};
            pg8::gemm_phase(F.lds, S, E);
            if (NREP(5) == 2) { GRID_BAR(); pg8::gemm_phase(F.lds, S, E); }
            SEAM(pb + 5);
        }
        if (((PHMASK >> 6) & 1) && IN(pb + 6)) {
            PH_BEGIN;
            bf16_t* P = P_; const float* gp = GPERM_;
            if (F.gw < NMETA) meta_post_row(P, MROW0 + F.gw, gp, F.lane);
        }
        if (((PHMASK >> 7) & 1) && IN(pb + 7)) {
            PH_BEGIN;
            bf16_t* P = P_; unsigned* bm = BM_;
            unsigned* ctr = (unsigned*)(ws + WS_CTL) + CW_Q + 64 * (ly * 4 + 2);
            LAS int* slot = (LAS int*)(F.lds + LDSCTL_OFF + 128);
            for (int rep_ = 0; rep_ < NREP(7); ++rep_) { if (rep_) GRID_BAR(); unsigned* c2 = ctr + 64 * 16 * rep_;
            for (;;) { const int idx = fa::next_item(c2, slot); if (idx >= NTOK / 8) break; index_unit(P, idx, bm, F.lds); } }
            SEAM(pb + 7);
        }
        if (((PHMASK >> 8) & 1) && IN(pb + 8)) {
            PH_BEGIN;
            bf16_t* P = P_; unsigned* bm = BM_;
            LAS int* slot = (LAS int*)(F.lds + LDSCTL_OFF + 128);
            for (int rep_ = 0; rep_ < NREP(8); ++rep_) { if (rep_) GRID_BAR();
            const bool dummy = (NREP(8) == 2) && rep_ == 0;
            unsigned* ctr = (unsigned*)(ws + WS_CTL) + CW_Q + 64 * (ly * 4 + 1) + 64 * 16 * rep_;
            const bool stat = (F.G == 256); const int sx = F.bid & 7, spl = (F.bid >> 3) >> 2, sj = (F.bid >> 3) & 3;
            if (!stat) fa::queue_prime(ctr, slot);
            for (int qk_ = 0;; ++qk_) {
                int idx;
                if (stat) { if (qk_ < 8) { const int pr = sx + 8 * (spl + 8 * ((qk_ >> 1) & 1)), qb = (qk_ & 1) ? sj : 7 - sj; idx = (7 - qb) * 256 + ((qk_ >> 2) ? 128 : 0) + pr; } else idx = (qk_ == 8 && F.bid < 16) ? 2048 + F.bid : 1 << 30; }
                else idx = fa::queue_next(ctr, slot, qk_);
                if (idx >= 16 * 129) break;
                int hh; bool meta = false; fa::Item it; int b = 0, qb = 0;
                if (idx < 2048) { qb = 7 - (idx >> 8); const int rest = idx & 255; hh = (rest < 128) ? 8 + (rest & 7) : (rest & 7); b = (rest & 127) >> 3; it = fa::make_item(false, b, qb); }
                else { hh = idx - 2048; hh = hh < 8 ? 8 + hh : hh - 8; meta = true; it = fa::make_item(true, 0, 0); }
                if (hh < 8) {
                    bf16x8 qr[8]; fa::load_q<128>(P, it, C_DQ + hh * 128, qr);
                    fa::attn_core<128, 128, true>(P, it, qr, C_DK + hh * 128, 0, C_DV + hh * 128, dummy ? C_KPE : C_OB + hh * 128, 0, meta ? nullptr : bm + (size_t)(b * SEQ + qb * 256) * BMW, F.lds);
                } else {
                    const int hj = hh - 8;
                    bf16x8 qr[8]; fa::load_q<128>(P, it, C_FQ + hj * 128, qr);
                    fa::attn_core<128, 256, false>(P, it, qr, C_FK + hj * 128, 0, C_FV + (hj >> 1) * 256, dummy ? C_KPE : C_FQ + hj * 128, dummy ? C_KPE : C_IQ + hj * 128, nullptr, F.lds);
                }
            } }
            SEAM(pb + 8);
        }
        if (((PHMASK >> 9) & 1) && IN(pb + 9)) {
            PH_BEGIN;
            const float* diff_lam = arg_in(args, 12) + ly * 4 * 128; const float* diff_subg = arg_in(args, 13) + ly * 256;
            const float lambda_init = LAMBDA_INIT(ly);
            const float s1 = wave_sum(diff_lam[F.lane] * diff_lam[128 + F.lane] + diff_lam[64 + F.lane] * diff_lam[192 + F.lane]);
            const float s2 = wave_sum(diff_lam[256 + F.lane] * diff_lam[384 + F.lane] + diff_lam[320 + F.lane] * diff_lam[448 + F.lane]);
            const float lam = __expf(s1) - __expf(s2) + lambda_init;
            bf16_t* P = P_;
            for (int r = MROW0 + F.gw; r < R; r += F.ngw) post3_row(P, r, diff_subg, lam, 1.f - lambda_init, F.lane);
        }
#define GATE_PHASE(k, b, sk, seam) \
        if (((PHMASK >> 10) & 1) && IN(pb + (k))) { \
            PH_BEGIN; \
            { SkGate f{(bf16_t*)(ws + WS_GS), arg_in(args, 4) + ly * 3 * DM + (b) * DM, RS_(2 * ly)}; skinny_gemm(F.lds, XN_ + (size_t)MROW0 * DM, DM, WB_(WB_G) + (size_t)(b) * 2048 * DM, DM, 2048 / 16, (F.bid + (sk)) % F.G, F.G, f); } \
            SchedPlain S{XN_, DM, WB_(WB_G) + (size_t)(b) * 2048 * DM, DM, NPMM, 8, F.G, F.bid, 0}; EpiGate E{(bf16_t*)(ws + WS_GS), arg_in(args, 4) + ly * 3 * DM + (b) * DM, RS_(2 * ly)}; \
            pg8::gemm_phase(F.lds, S, E); \
            if (NREP(k) == 2) { GRID_BAR(); pg8::gemm_phase(F.lds, S, E); } \
            if (seam) SEAM(pb + (k)); \
        }
#define BRANCH_PHASE(k, b, oc, sk, seam) \
        if (((PHMASK >> 10) & 1) && IN(pb + (k))) { \
            PH_BEGIN; \
            { SkGated f{P_, (const bf16_t*)(ws + WS_GS), (b) == 0 ? 1 : 0}; skinny_gemm(F.lds, P_ + (size_t)MROW0 * PW + (oc), PW, WB_(WB_BR) + (size_t)(b) * DM * 1024, 1024, 2048 / 16, (F.bid + (sk)) % F.G, F.G, f); } \
            SchedPlain S{P_ + (oc), PW, WB_(WB_BR) + (size_t)(b) * DM * 1024, 1024, NPMM, 8, F.G, F.bid, C_MERGED}; EpiGated E{P_, (const bf16_t*)(ws + WS_GS), (b) == 0 ? 1 : 0, ((DBG_BM >> (b)) & 1) ? 1.f : 0.f}; \
            pg8::gemm_phase(F.lds, S, E); \
            if (NREP(k) == 2 && (b) == 0) { GRID_BAR(); pg8::gemm_phase(F.lds, S, E); } \
            if (seam) SEAM(pb + (k)); \
        }
        GATE_PHASE(10, 0, 0, 0) BRANCH_PHASE(11, 0, C_OA, 0, 0)
        GATE_PHASE(12, 1, 0, 0) BRANCH_PHASE(13, 1, C_OB, 0, 0)
        GATE_PHASE(14, 2, 0, 1) BRANCH_PHASE(15, 2, C_OC, 128, 1)
        if (((PHMASK >> 11) & 1) && IN(pb + 16)) {
            PH_BEGIN;
            { SkRes f{HMETA_, XN_, RS_(2 * ly + 1)}; skinny_gemm(F.lds, P_ + (size_t)MROW0 * PW + C_MERGED, PW, WB_(WB_O), DM, 2048 / 16, F.bid, F.G, f); }
            SchedPlain S{P_ + C_MERGED, PW, WB_(WB_O), DM, NPMM, 8, F.G, F.bid, 0}; EpiRes E{(float*)nullptr, DBG_SA, XN_, RS_(2 * ly + 1)};
            pg8::gemm_phase(F.lds, S, E);
            SEAM(pb + 16);
        }
        if (((PHMASK >> 13) & 1) && IN(pb + 17)) {
            PH_BEGIN;
            skinny_swiglu(F.lds, XN_ + (size_t)MROW0 * DM, DM, WB_(WB_F1), DM, P_, RS_(2 * ly + 1), F.bid, F.G);
            SchedPlain S{XN_, DM, WB_(WB_F1), DM, NPMM, 44, F.G, F.bid, 0}; EpiSwiglu E{P_, RS_(2 * ly + 1)};
            pg8::gemm_phase(F.lds, S, E);
            if (NREP(17) == 2) { GRID_BAR(); pg8::gemm_phase(F.lds, S, E); }
            SEAM(pb + 17);
        }
        if (((PHMASK >> 14) & 1) && IN(pb + 18)) {
            PH_BEGIN;
            { SkRes f{HMETA_, ly == 0 ? XN_ : (bf16_t*)nullptr, RS_(2)}; skinny_gemm(F.lds, P_ + (size_t)MROW0 * PW, PW, WB_(WB_F2), DFF, 2048 / 16, F.bid, F.G, f); }
            SchedPlain S{P_, PW, WB_(WB_F2), DFF, NPMM, 8, F.G, F.bid, 0}; EpiRes E{ly == 0 ? (float*)nullptr : OUT_, DBG_SF, XN_, RS_(2)};
            pg8::gemm_phase(F.lds, S, E);
            SEAM(pb + 18);
        }
    }
#undef IN
#undef SEAM
}

__global__ void diag_fill(float* out, int n, float v) { for (int i = blockIdx.x * blockDim.x + threadIdx.x; i < n; i += gridDim.x * blockDim.x) out[i] = v; }
extern "C" void kernel_launch(void* const* d_in, const int* in_sizes, int n_in, void* d_out, int out_size, void* d_ws, size_t ws_size, hipStream_t stream) {
    static int grid = 0; static float code = 0.f;
    if (grid == 0) {
        int dev = 0, cus = 0;
        if (n_in != 19) { code = 10.f; grid = -1; }
        else if (ws_size < WS_END) { code = 20.f + (float)(ws_size >> 20) * 0.01f; grid = -1; }
        else if (hipGetDevice(&dev) != hipSuccess || hipDeviceGetAttribute(&cus, hipDeviceAttributeMultiprocessorCount, dev) != hipSuccess) { code = 40.f; grid = -1; }
        else if (hipFuncSetAttribute((const void*)mega_fwd, hipFuncAttributeMaxDynamicSharedMemorySize, LDS_BYTES) != hipSuccess) { code = 50.f; grid = -1; }
        else {
            int per_cu = 0;
            if (hipOccupancyMaxActiveBlocksPerMultiprocessor(&per_cu, (const void*)mega_fwd, NWAVES * 64, LDS_BYTES) != hipSuccess || per_cu < 1) { code = 60.f; grid = -1; }
            (void)hipGetLastError();
            if (grid == 0) grid = cus;
        }
    }
    if (grid < 0) { hipLaunchKernelGGL(diag_fill, dim3(1024), dim3(256), 0, stream, (float*)d_out, out_size, code); return; }
    (void)hipMemsetAsync((char*)d_ws + WS_CTL, 0, CTL_BYTES, stream);
    Args a{};
    for (int i = 0; i < 19; ++i) a.in[i] = (const float*)d_in[i];
    a.out = (float*)d_out; a.ws = (unsigned char*)d_ws;
#if MK_ONE_LAUNCH
    a.ph_lo = 0; a.ph_hi = N_PHASES;
    hipLaunchKernelGGL(mega_fwd, dim3(grid), dim3(NWAVES * 64), LDS_BYTES, stream, a);
#else
    for (int p = 0; p < N_PHASES; ++p) { a.ph_lo = p; a.ph_hi = p + 1; hipLaunchKernelGGL(mega_fwd, dim3(grid), dim3(NWAVES * 64), LDS_BYTES, stream, a); }
#endif
    if (hipPeekAtLastError() != hipSuccess) { (void)hipGetLastError(); hipLaunchKernelGGL(diag_fill, dim3(1024), dim3(256), 0, stream, (float*)d_out, out_size, 70.f); }
}
```

```cpp
#include <hip/hip_runtime.h>
#include <cstdio>
#include <cstdint>

#ifndef PHMASK
#define PHMASK 0x7fff
#endif
#ifndef REPMASK
#define REPMASK 0
#endif
#define NREP(k) ((((REPMASK) >> (k)) & 1) ? 2 : 1)
#ifndef DBG_BM
#define DBG_BM 7
#endif
#ifndef DBG_BR
#define DBG_BR 0
#endif
#ifndef DBG_SA
#define DBG_SA 1.0f
#endif
#ifndef DBG_SF
#define DBG_SF 1.0f
#endif
#ifndef MK_ONE_LAUNCH
#define MK_ONE_LAUNCH 1
#endif

#define LAS __attribute__((address_space(3)))
#define GAS __attribute__((address_space(1)))
typedef unsigned short bf16_t;
typedef short bf16x8 __attribute__((ext_vector_type(8)));
typedef float f32x4 __attribute__((ext_vector_type(4)));
typedef float f32x2 __attribute__((ext_vector_type(2)));
typedef unsigned u32x4 __attribute__((ext_vector_type(4)));
typedef unsigned u32x2 __attribute__((ext_vector_type(2)));
typedef unsigned long long rs_t;
__device__ __forceinline__ float rs_val(rs_t v) { return (float)((double)v * (1.0 / 4294967296.0)); }
__device__ __forceinline__ rs_t rs_fix(float ss) { return (rs_t)((double)ss * 4294967296.0); }
__device__ __forceinline__ void st_wt(void* p, u32x4 v) { typedef __attribute__((address_space(1))) u32x4 gv; *(gv*)(unsigned long long)p = v; }
__device__ __forceinline__ void st_wt(void* p, f32x4 v) { typedef __attribute__((address_space(1))) f32x4 gv; *(gv*)(unsigned long long)p = v; }

constexpr int DM = 2048, NB = 16, SEQ = 2048, NMETA = 16, MBLK = 256;
constexpr int R = MBLK + NB * SEQ;
constexpr int NPM = R / 256;
constexpr int NPMM = NPM - 1;
constexpr int MROW0 = MBLK - NMETA;
constexpr int NTOK = NB * SEQ;
constexpr int DFF = 5632;
constexpr int PW = 8448;
constexpr int C_CQ = 0, C_CKV = 512, C_KPE = 1024, C_IK = 1088, C_IW = 1152, C_DQ = 1280, C_DK = 2304, C_DV = 3328, C_IQ = 4352,
              C_FQ = 5376, C_FK = 6400, C_FV = 7424;
constexpr int C_KVRAW = 1280, C_QRAW = 3328, C_KPEH = 4864;
constexpr int C_OA = 0, C_OB = C_DQ, C_OC = C_FQ, C_MERGED = 2304;
constexpr int BMW = 66;
constexpr float EPS = 1e-6f;
constexpr float LOG2E = 1.4426950408889634f;
constexpr float C2_128 = 0.08838834764831845f * LOG2E;
constexpr float C2_192 = 0.07216878364870323f * LOG2E;
constexpr int D_IN = 14480;

constexpr size_t MiB = 1u << 20;
constexpr size_t WS_CTL = 0, CTL_BYTES = 1536 * 1024;
constexpr size_t WS_RSTD = 13 * MiB;
constexpr size_t WS_HMETA = 2 * MiB;
constexpr size_t WS_BM = 4 * MiB;
constexpr size_t WS_WB = 16 * MiB;
constexpr size_t WB_IN = 0, WB_G = WB_IN + (size_t)8448 * 2048 * 2, WB_QUP = WB_G + (size_t)6144 * 2048 * 2, WB_KVUP = WB_QUP + (size_t)1536 * 512 * 2,
                 WB_BR = WB_KVUP + (size_t)2048 * 512 * 2, WB_O = WB_BR + (size_t)3 * 2048 * 1024 * 2, WB_F1 = WB_O + (size_t)2048 * 2048 * 2,
                 WB_F2 = WB_F1 + (size_t)11264 * 2048 * 2, WB_END = WB_F2 + (size_t)2048 * 5632 * 2;
constexpr size_t WS_XN = 164 * MiB;
constexpr size_t WS_P = 294 * MiB;
constexpr size_t WS_GS = 828 * MiB;
constexpr size_t WS_END = 960 * MiB;
static_assert(WS_GS + (size_t)R * 2048 * 2 <= WS_END && WS_WB + WB_END <= WS_XN && WS_XN + (size_t)R * 2048 * 2 <= WS_P && WS_P + (size_t)R * PW * 2 <= WS_GS, "ws map");
constexpr int CW_BAR = 4096, CW_Q = 16384;
constexpr size_t WS_RS = 256 * 1024;
static_assert(WS_RS + (size_t)4 * R * 8 <= CTL_BYTES && CTL_BYTES <= WS_HMETA && WS_BM + (size_t)32768 * BMW * 4 <= WS_RSTD && WS_RSTD + 1 * MiB <= WS_WB, "ctl map");

__device__ __forceinline__ float bf2f(bf16_t v) { return __uint_as_float((unsigned)v << 16); }
__device__ __forceinline__ unsigned f2bf(float f) { unsigned u = __float_as_uint(f); return (u + 0x7fffu + ((u >> 16) & 1u)) >> 16; }
__device__ __forceinline__ unsigned pk2(float lo, float hi) { return f2bf(lo) | (f2bf(hi) << 16); }
typedef __bf16 bf16x2_t __attribute__((ext_vector_type(2)));
__device__ __forceinline__ unsigned cvt_pk_bf16(float lo, float hi) { f32x2 v = {lo, hi}; bf16x2_t b = __builtin_convertvector(v, bf16x2_t); return __builtin_bit_cast(unsigned, b); }
__device__ __forceinline__ float wave_sum(float v) {
#pragma unroll
    for (int o = 1; o < 64; o <<= 1) v += __shfl_xor(v, o);
    return v;
}
__device__ __forceinline__ float wave_max(float v) {
#pragma unroll
    for (int o = 1; o < 64; o <<= 1) v = fmaxf(v, __shfl_xor(v, o));
    return v;
}
#define LDS_WAIT() asm volatile("s_waitcnt lgkmcnt(0)" ::: "memory")
#define VM_WAIT() asm volatile("s_waitcnt vmcnt(0)" ::: "memory")
__device__ __forceinline__ int row_pos(int r) { return r < MBLK ? (r >= MBLK - NMETA ? r - (MBLK - NMETA) : 0) : NMETA + ((r - MBLK) & (SEQ - 1)); }
__device__ __forceinline__ void rope_cs(int pos, int i, float two_over_d, float& c, float& s) {
    const float inv = __builtin_amdgcn_exp2f(-(float)i * two_over_d * 13.287712379549449f);
    float rev = (float)pos * inv * 0.15915494309189535f;
    rev -= floorf(rev);
    s = __builtin_amdgcn_sinf(rev); c = __builtin_amdgcn_cosf(rev);
}

namespace pg8 {
constexpr int BM = 256, BK = 64, HALF = 128, HTB = HALF * BK * 2, STAGE_BYTES = 8 * HTB;
__device__ __forceinline__ int lds_byte(int r, int c) { const int st = (r >> 4) * 2 + (c >> 5), rr = r & 15, cc = c & 31, ob = rr * 64 + cc * 2; return st * 1024 + (ob ^ (((ob >> 9) & 1) << 5)); }
__device__ __forceinline__ void stage_rc(int b, int& R_, int& C_) { const int st = b / 1024, sb = b % 1024, swz = sb ^ (((sb >> 9) & 1) << 5); R_ = (st >> 1) * 16 + swz / 64; C_ = (st & 1) * 32 + (swz % 64) / 2; }
__device__ __forceinline__ int perm32(int rho) { const int n = rho >> 4, i = rho & 15; return 8 * (i >> 2) + 4 * n + (i & 3); }

struct Unit { const char* A; const char* B; unsigned lda2, ldb2; int nt, pm, pn, kind, ocol; };

#ifndef WGM
#define WGM 4
#endif
__device__ __forceinline__ void tile_of(int L, int nM, int nN, int& pm, int& pn) {
    const int nwg = nM * nN; int wgid = L;
    { const int q = nwg / 8, r = nwg % 8, xcd = wgid % 8, off = wgid / 8; wgid = (xcd < r ? xcd * (q + 1) : r * (q + 1) + (xcd - r) * q) + off; }
    const int nig = WGM * nN, gid = wgid / nig, fm = gid * WGM, gsz = (nM - fm) < WGM ? (nM - fm) : WGM;
    pm = fm + ((wgid % nig) % gsz); pn = (wgid % nig) / gsz;
}

template <class Epi, class Sched>
__device__ __forceinline__ void gemm_phase(LAS unsigned char* lds, const Sched& S, const Epi& E) {
    int tid = threadIdx.x; asm volatile("" : "+v"(tid));
    const int wid = __builtin_amdgcn_readfirstlane(tid >> 6), lane = tid & 63, wr = wid >> 2, wc = wid & 3, fr = lane & 15, fq = lane >> 4;
    unsigned rA[2], rB[2], cc[2];
#pragma unroll
    for (int i = 0; i < 2; ++i) { int R_, C_; stage_rc(tid * 16 + i * 8192, R_, C_); rA[i] = (unsigned)R_; rB[i] = (unsigned)(Epi::PERM ? ((R_ & ~31) + perm32(R_ & 31)) : R_); cc[i] = (unsigned)C_ * 2u; }
    const size_t kstep = (size_t)(BK * 2);
    const unsigned ldsw = (unsigned)wid * 1024u;
    const int aoff = lds_byte(wr * 64 + fr, fq * 8), boff = lds_byte(wc * 32 + fr, fq * 8);
#define PG8_SA(b, h) (((b) * 2 + (h)) * HTB)
#define PG8_SB(b, h) ((4 + (b) * 2 + (h)) * HTB)
#define PG8_STAGE(bufoff, gbase, rr, ld2) do { _Pragma("unroll") for (int _i = 0; _i < 2; ++_i) \
        __builtin_amdgcn_global_load_lds((const unsigned*)((const char*)(gbase) + ((rr)[_i] * (ld2) + cc[_i])), (LAS unsigned*)(lds + (bufoff) + ldsw + _i * 8192), 16, 0, 0); } while (0)
#define PG8_LDA(dst, b, h) do { _Pragma("unroll") for (int m = 0; m < 4; ++m) _Pragma("unroll") for (int k = 0; k < 2; ++k) dst[m][k] = *(const LAS bf16x8*)(lds + PG8_SA(b, h) + aoff + m * 2048 + k * 1024); } while (0)
#define PG8_LDB(dst, b, h) do { _Pragma("unroll") for (int n = 0; n < 2; ++n) _Pragma("unroll") for (int k = 0; k < 2; ++k) dst[n][k] = *(const LAS bf16x8*)(lds + PG8_SB(b, h) + boff + n * 2048 + k * 1024); } while (0)
#define PG8_MMA(ai, bj, At, Bt) do { __builtin_amdgcn_s_setprio(1); _Pragma("unroll") for (int m = 0; m < 4; ++m) _Pragma("unroll") for (int n = 0; n < 2; ++n) _Pragma("unroll") for (int k = 0; k < 2; ++k) \
        acc[ai][bj][m][n] = __builtin_amdgcn_mfma_f32_16x16x32_bf16(Bt[n][k], At[m][k], acc[ai][bj][m][n], 0, 0, 0); __builtin_amdgcn_s_setprio(0); } while (0)
#define PG8_WAIT_V(n) asm volatile("s_waitcnt vmcnt(" #n ")" ::: "memory")
#define PG8_WAIT_L(n) asm volatile("s_waitcnt lgkmcnt(" #n ")" ::: "memory")
#define PG8_BAR __builtin_amdgcn_s_barrier()
#define PG8_SCHED __builtin_amdgcn_sched_barrier(0)
    Unit cur, nxt; int ui = 0;
    if (!S.next(0, cur)) return;
    float zf = 0.f; asm volatile("" : "+v"(zf));
    f32x4 acc[2][2][4][2];
#pragma unroll
    for (int a = 0; a < 2; ++a)
#pragma unroll
        for (int b = 0; b < 2; ++b)
#pragma unroll
            for (int m = 0; m < 4; ++m)
#pragma unroll
                for (int n = 0; n < 2; ++n) acc[a][b][m][n] = (f32x4){zf, zf, zf, zf};
    bf16x8 At[4][2], B0[2][2], B1[2][2];
    const char* cA = cur.A; const char* cB = cur.B;
    unsigned lA = cur.lda2, lB = cur.ldb2;
    size_t hA = (size_t)HALF * lA, hB = (size_t)HALF * lB;
    PG8_STAGE(PG8_SB(0, 0), cB, rB, lB); PG8_STAGE(PG8_SB(0, 1), cB + hB, rB, lB); PG8_STAGE(PG8_SA(0, 0), cA, rA, lA); PG8_STAGE(PG8_SA(0, 1), cA + hA, rA, lA);
    if (wr == 1) PG8_BAR;
    PG8_WAIT_V(2); PG8_BAR;
    PG8_STAGE(PG8_SB(1, 0), cB + kstep, rB, lB); PG8_STAGE(PG8_SA(1, 0), cA + kstep, rA, lA); PG8_STAGE(PG8_SB(1, 1), cB + hB + kstep, rB, lB);
    PG8_WAIT_V(6); PG8_BAR;
    for (;;) {
        const bool has_next = S.next(ui + 1, nxt);
        if (!has_next) nxt = cur;
        const char* nA = nxt.A; const char* nB = nxt.B;
        const unsigned lAn = nxt.lda2, lBn = nxt.ldb2;
        const size_t hAn = (size_t)HALF * lAn, hBn = (size_t)HALF * lBn;
        const int nt = cur.nt;
        for (int t = 0; t < nt; t += 2) {
            const bool last = (t == nt - 2);
            const char* a1 = cA + (size_t)(t + 1) * kstep;
            const char* a2 = last ? nA : cA + (size_t)(t + 2) * kstep; const char* b2 = last ? nB : cB + (size_t)(t + 2) * kstep;
            const char* a3 = a2 + kstep; const char* b3 = b2 + kstep;
            const size_t hA2 = last ? hAn : hA, hB2 = last ? hBn : hB;
            const unsigned lA2 = last ? lAn : lA, lB2 = last ? lBn : lB;
            PG8_LDB(B0, 0, 0); PG8_LDB(B1, 0, 1); PG8_SCHED; PG8_LDA(At, 0, 0); PG8_STAGE(PG8_SA(1, 1), a1 + hA, rA, lA);
            PG8_WAIT_V(8); PG8_WAIT_L(0); PG8_BAR; PG8_MMA(0, 0, At, B0); PG8_MMA(0, 1, At, B1); PG8_BAR; PG8_SCHED;
            PG8_LDA(At, 0, 1); PG8_STAGE(PG8_SB(0, 0), b2, rB, lB2); PG8_STAGE(PG8_SB(0, 1), b2 + hB2, rB, lB2); PG8_STAGE(PG8_SA(0, 0), a2, rA, lA2);
            PG8_WAIT_V(8); PG8_WAIT_L(0); PG8_BAR; PG8_MMA(1, 0, At, B0); PG8_MMA(1, 1, At, B1); PG8_BAR; PG8_SCHED;
            PG8_LDB(B0, 1, 0); PG8_LDB(B1, 1, 1); PG8_SCHED; PG8_LDA(At, 1, 0); PG8_STAGE(PG8_SA(0, 1), a2 + hA2, rA, lA2);
            PG8_WAIT_V(8); PG8_WAIT_L(0); PG8_BAR; PG8_MMA(0, 0, At, B0); PG8_MMA(0, 1, At, B1); PG8_BAR; PG8_SCHED;
            PG8_LDA(At, 1, 1); PG8_STAGE(PG8_SB(1, 0), b3, rB, lB2); PG8_STAGE(PG8_SB(1, 1), b3 + hB2, rB, lB2); PG8_STAGE(PG8_SA(1, 0), a3, rA, lA2);
            PG8_WAIT_V(8); PG8_WAIT_L(0); PG8_BAR; PG8_MMA(1, 0, At, B0); PG8_MMA(1, 1, At, B1); PG8_BAR; PG8_SCHED;
        }
        if (wr == 0) PG8_BAR;
        E(acc, cur, wr, wc, fr, fq);
#pragma unroll
        for (int a = 0; a < 2; ++a)
#pragma unroll
            for (int b = 0; b < 2; ++b)
#pragma unroll
                for (int m = 0; m < 4; ++m)
#pragma unroll
                    for (int n = 0; n < 2; ++n) acc[a][b][m][n] = (f32x4){zf, zf, zf, zf};
        if (!has_next) break;
        cur = nxt; cA = nA; cB = nB; hA = hAn; hB = hBn; lA = lAn; lB = lBn; ++ui;
        if (wr == 1) PG8_BAR;
    }
    PG8_WAIT_V(0);
    PG8_BAR;
#undef PG8_SA
#undef PG8_SB
#undef PG8_STAGE
#undef PG8_LDA
#undef PG8_LDB
#undef PG8_MMA
#undef PG8_WAIT_V
#undef PG8_WAIT_L
#undef PG8_BAR
#undef PG8_SCHED
}
}
using pg8::Unit;

struct SchedPlain {
    const bf16_t* A; int lda; const bf16_t* B; int K; int nM, nN, G, c, ocol0;
    __device__ __forceinline__ bool next(int i, Unit& u) const {
        const int L = i * G + c; if (L >= nM * nN) return false;
        int pm, pn; pg8::tile_of(L, nM, nN, pm, pn); pm += 1;
        u.pm = pm; u.pn = pn; u.kind = 0; u.ocol = ocol0 + 256 * pn; u.nt = K / 64; u.lda2 = (unsigned)lda * 2u; u.ldb2 = (unsigned)K * 2u;
        u.A = (const char*)(A + (size_t)pm * 256 * lda); u.B = (const char*)(B + (size_t)pn * 256 * K); return true;
    }
};
struct SchedMlaUp {
    const bf16_t* P; const bf16_t* Wq; const bf16_t* Wkv; int G, c;
    __device__ __forceinline__ bool next(int i, Unit& u) const {
        const int L = i * G + c; if (L >= NPMM * 14) return false;
        int pm, pn; pg8::tile_of(L, NPMM, 14, pm, pn); pm += 1;
        u.pm = pm; u.pn = pn; u.kind = 0; u.nt = 8; u.lda2 = PW * 2u; u.ldb2 = 512 * 2u;
        if (pn < 6) { u.A = (const char*)(P + (size_t)pm * 256 * PW + C_CQ); u.B = (const char*)(Wq + (size_t)pn * 256 * 512); u.ocol = C_QRAW + 256 * pn; }
        else { u.A = (const char*)(P + (size_t)pm * 256 * PW + C_CKV); u.B = (const char*)(Wkv + (size_t)(pn - 6) * 256 * 512); u.ocol = C_KVRAW + 256 * (pn - 6); }
        return true;
    }
};
struct EpiP {
    static constexpr bool PERM = true;
    bf16_t* P; const rs_t* rs;
    __device__ __forceinline__ void operator()(const f32x4 (&acc)[2][2][4][2], const Unit& u, int wr, int wc, int fr, int fq) const {
        asm volatile("" : "+v"(fr), "+v"(fq));
        const int row0 = u.pm * 256 + wr * 64 + fr, col0 = u.ocol + wc * 32 + 8 * fq;
#pragma unroll
        for (int ai = 0; ai < 2; ++ai)
#pragma unroll
            for (int m = 0; m < 4; ++m) { bf16_t* rowp = P + (size_t)(row0 + ai * 128 + m * 16) * PW + col0;
                const float sc = rs ? __builtin_amdgcn_rsqf(rs_val(rs[row0 + ai * 128 + m * 16]) * (1.f / DM) + EPS) : 1.f;
#pragma unroll
                for (int bj = 0; bj < 2; ++bj) { const f32x4 v0 = acc[ai][bj][m][0] * sc, v1 = acc[ai][bj][m][1] * sc;
                    u32x4 w; w.x = cvt_pk_bf16(v0[0], v0[1]); w.y = cvt_pk_bf16(v0[2], v0[3]); w.z = cvt_pk_bf16(v1[0], v1[1]); w.w = cvt_pk_bf16(v1[2], v1[3]);
                    st_wt(rowp + bj * 128, w); } }
    }
};
struct EpiG2 {
    static constexpr bool PERM = true;
    bf16_t* P; const rs_t* rs; const float* gperm; LAS float* xl;
    __device__ __forceinline__ void operator()(const f32x4 (&acc)[2][2][4][2], const Unit& u, int wr, int wc, int fr, int fq) const {
        asm volatile("" : "+v"(fr), "+v"(fq));
        const int row0 = u.pm * 256 + wr * 64 + fr, lcol = wc * 32 + 8 * fq, col0 = u.ocol + lcol;
        const int pn = u.pn;
        const bool plain = (pn >= 8 && pn < 12) || pn >= 24, isidx = (pn >= 12 && pn < 16), nrm = !plain && !isidx;
        const int gidx = pn < 4 ? 0 : (pn < 8 ? 1 : (pn < 20 ? 2 : 3));
        f32x4 g0 = (f32x4){1.f, 1.f, 1.f, 1.f}, g1 = g0;
        if (nrm) { g0 = *(const f32x4*)(gperm + gidx * 128 + lcol); g1 = *(const f32x4*)(gperm + gidx * 128 + lcol + 4); }
        float rsc[2][4];
#pragma unroll
        for (int ai = 0; ai < 2; ++ai)
#pragma unroll
            for (int m = 0; m < 4; ++m) rsc[ai][m] = __builtin_amdgcn_rsqf(rs_val(rs[row0 + ai * 128 + m * 16]) * (1.f / DM) + EPS);
        if (nrm) {
#pragma unroll
            for (int ai = 0; ai < 2; ++ai)
#pragma unroll
                for (int m = 0; m < 4; ++m)
#pragma unroll
                    for (int bj = 0; bj < 2; ++bj) { const f32x4 a = acc[ai][bj][m][0], b = acc[ai][bj][m][1]; float ss = (a[0] * a[0] + a[1] * a[1]) + (a[2] * a[2] + a[3] * a[3]) + (b[0] * b[0] + b[1] * b[1]) + (b[2] * b[2] + b[3] * b[3]);
                        ss += __shfl_xor(ss, 16); ss += __shfl_xor(ss, 32);
                        if (fq == 0) xl[((wr * 64 + fr + ai * 128 + m * 16) * 2 + bj) * 4 + wc] = ss * rsc[ai][m] * rsc[ai][m]; }
            asm volatile("s_waitcnt lgkmcnt(0)" ::: "memory"); __builtin_amdgcn_s_barrier(); asm volatile("" ::: "memory");
        }
        const int i0 = isidx ? (16 * (wc & 1) + 4 * fq) : (16 * wc + 4 * fq);
        const float tod = isidx ? (2.f / 64.f) : (2.f / 128.f);
        float inv[4];
#pragma unroll
        for (int j = 0; j < 4; ++j) inv[j] = __builtin_amdgcn_exp2f(-(float)(i0 + j) * tod * 13.287712379549449f) * 0.15915494309189535f;
        const float qscale = (pn < 4 || (pn >= 16 && pn < 20)) ? C2_128 : 1.f;
#pragma unroll
        for (int ai = 0; ai < 2; ++ai)
#pragma unroll
            for (int m = 0; m < 4; ++m) { const int row = row0 + ai * 128 + m * 16; bf16_t* rowp = P + (size_t)row * PW + col0;
                float cs[4], sn[4];
                if (!plain) { const float pos = (float)(NMETA + ((row - MBLK) & (SEQ - 1)));
#pragma unroll
                    for (int j = 0; j < 4; ++j) { float rev = pos * inv[j]; rev -= floorf(rev); sn[j] = __builtin_amdgcn_sinf(rev); cs[j] = __builtin_amdgcn_cosf(rev); } }
#pragma unroll
                for (int bj = 0; bj < 2; ++bj) { f32x4 v0 = acc[ai][bj][m][0] * rsc[ai][m], v1 = acc[ai][bj][m][1] * rsc[ai][m];
                    if (!plain) {
                        if (nrm) { const LAS f32x4* xp = (const LAS f32x4*)(xl + ((wr * 64 + fr + ai * 128 + m * 16) * 2 + bj) * 4); const f32x4 pp = *xp;
                            const float rn = __builtin_amdgcn_rsqf(((pp[0] + pp[1]) + (pp[2] + pp[3])) * (1.f / 128.f) + EPS); v0 = v0 * (g0 * rn); v1 = v1 * (g1 * rn); }
                        f32x4 w0, w1;
                        w0[0] = v0[0] * cs[0] - v0[1] * sn[0]; w0[1] = v0[1] * cs[0] + v0[0] * sn[0]; w0[2] = v0[2] * cs[1] - v0[3] * sn[1]; w0[3] = v0[3] * cs[1] + v0[2] * sn[1];
                        w1[0] = v1[0] * cs[2] - v1[1] * sn[2]; w1[1] = v1[1] * cs[2] + v1[0] * sn[2]; w1[2] = v1[2] * cs[3] - v1[3] * sn[3]; w1[3] = v1[3] * cs[3] + v1[2] * sn[3];
                        v0 = w0 * qscale; v1 = w1 * qscale; }
                    u32x4 w; w.x = cvt_pk_bf16(v0[0], v0[1]); w.y = cvt_pk_bf16(v0[2], v0[3]); w.z = cvt_pk_bf16(v1[0], v1[1]); w.w = cvt_pk_bf16(v1[2], v1[3]);
                    st_wt(rowp + bj * 128, w); } }
    }
};
struct EpiGate {
    static constexpr bool PERM = true;
    bf16_t* G; const float* bias; const rs_t* rs;
    __device__ __forceinline__ void operator()(const f32x4 (&acc)[2][2][4][2], const Unit& u, int wr, int wc, int fr, int fq) const {
        asm volatile("" : "+v"(fr), "+v"(fq));
        const int row0 = u.pm * 256 + wr * 64 + fr, col0 = u.pn * 256 + wc * 32 + 8 * fq;
        f32x4 bq[2][2];
#pragma unroll
        for (int bj = 0; bj < 2; ++bj) { bq[bj][0] = *(const f32x4*)(bias + col0 + bj * 128); bq[bj][1] = *(const f32x4*)(bias + col0 + bj * 128 + 4); }
        float rsc[2][4];
#pragma unroll
        for (int ai = 0; ai < 2; ++ai)
#pragma unroll
            for (int m = 0; m < 4; ++m) rsc[ai][m] = __builtin_amdgcn_rsqf(rs_val(rs[row0 + ai * 128 + m * 16]) * (1.f / DM) + EPS);
#pragma unroll
        for (int bj = 0; bj < 2; ++bj) { const f32x4 bv0 = bq[bj][0], bv1 = bq[bj][1];
#pragma unroll
            for (int ai = 0; ai < 2; ++ai)
#pragma unroll
                for (int m = 0; m < 4; ++m) { bf16_t* rowp = G + (size_t)(row0 + ai * 128 + m * 16) * 2048 + col0; f32x4 v0 = acc[ai][bj][m][0] * rsc[ai][m] + bv0, v1 = acc[ai][bj][m][1] * rsc[ai][m] + bv1;
#pragma unroll
                    for (int e = 0; e < 4; ++e) { v0[e] = __builtin_amdgcn_rcpf(1.f + __builtin_amdgcn_exp2f(-v0[e] * LOG2E)); v1[e] = __builtin_amdgcn_rcpf(1.f + __builtin_amdgcn_exp2f(-v1[e] * LOG2E)); }
                    u32x4 w; w.x = cvt_pk_bf16(v0[0], v0[1]); w.y = cvt_pk_bf16(v0[2], v0[3]); w.z = cvt_pk_bf16(v1[0], v1[1]); w.w = cvt_pk_bf16(v1[2], v1[3]);
                    st_wt(rowp + bj * 128, w); } }
    }
};
struct EpiGated {
    static constexpr bool PERM = true;
    bf16_t* P; const bf16_t* G; int first; float sc;
    __device__ __forceinline__ void operator()(const f32x4 (&acc)[2][2][4][2], const Unit& u, int wr, int wc, int fr, int fq) const {
        asm volatile("" : "+v"(fr), "+v"(fq));
        const int row0 = u.pm * 256 + wr * 64 + fr, lcol0 = u.pn * 256 + wc * 32 + 8 * fq, col0 = u.ocol + wc * 32 + 8 * fq;
        unsigned zu = 0u; asm volatile("" : "+v"(zu));
#pragma unroll
        for (int ai = 0; ai < 2; ++ai) {
            u32x4 gq[4][2], pq[4][2];
#pragma unroll
            for (int m = 0; m < 4; ++m)
#pragma unroll
                for (int bj = 0; bj < 2; ++bj) { gq[m][bj] = *(const u32x4*)(G + (size_t)(row0 + ai * 128 + m * 16) * 2048 + lcol0 + bj * 128); if (DBG_BR == 1) gq[m][bj] = (u32x4){0x3f803f80u, 0x3f803f80u, 0x3f803f80u, 0x3f803f80u};
                    pq[m][bj] = (u32x4){zu, zu, zu, zu}; if (!first) pq[m][bj] = *(const u32x4*)(P + (size_t)(row0 + ai * 128 + m * 16) * PW + col0 + bj * 128); }
#pragma unroll
            for (int m = 0; m < 4; ++m) { bf16_t* rowp = P + (size_t)(row0 + ai * 128 + m * 16) * PW + col0;
#pragma unroll
                for (int bj = 0; bj < 2; ++bj) { const u32x4 g = gq[m][bj], pv = pq[m][bj];
                    const f32x4 v0 = acc[ai][bj][m][0] * sc, v1 = acc[ai][bj][m][1] * sc;
                    float o[8];
                    o[0] = __uint_as_float(pv.x << 16) + __uint_as_float(g.x << 16) * v0[0]; o[1] = __uint_as_float(pv.x & 0xffff0000u) + __uint_as_float(g.x & 0xffff0000u) * v0[1];
                    o[2] = __uint_as_float(pv.y << 16) + __uint_as_float(g.y << 16) * v0[2]; o[3] = __uint_as_float(pv.y & 0xffff0000u) + __uint_as_float(g.y & 0xffff0000u) * v0[3];
                    o[4] = __uint_as_float(pv.z << 16) + __uint_as_float(g.z << 16) * v1[0]; o[5] = __uint_as_float(pv.z & 0xffff0000u) + __uint_as_float(g.z & 0xffff0000u) * v1[1];
                    o[6] = __uint_as_float(pv.w << 16) + __uint_as_float(g.w << 16) * v1[2]; o[7] = __uint_as_float(pv.w & 0xffff0000u) + __uint_as_float(g.w & 0xffff0000u) * v1[3];
                    u32x4 w; w.x = cvt_pk_bf16(o[0], o[1]); w.y = cvt_pk_bf16(o[2], o[3]); w.z = cvt_pk_bf16(o[4], o[5]); w.w = cvt_pk_bf16(o[6], o[7]);
                    st_wt(rowp + bj * 128, w); } }
            asm volatile("" ::: "memory"); }
    }
};
struct EpiRes {
    static constexpr bool PERM = true;
    float* out_f; float dbg; bf16_t* hb; rs_t* rs;
    __device__ __forceinline__ void operator()(const f32x4 (&acc)[2][2][4][2], const Unit& u, int wr, int wc, int fr, int fq) const {
        asm volatile("" : "+v"(fr), "+v"(fq));
        const int lrow0 = wr * 64 + fr, col0 = u.pn * 256 + wc * 32 + 8 * fq;
        bf16_t* hp0 = hb + (size_t)(u.pm * 256 + lrow0) * DM + col0;
        u32x4 bw[2][4][2];
#pragma unroll
        for (int ai = 0; ai < 2; ++ai)
#pragma unroll
            for (int m = 0; m < 4; ++m)
#pragma unroll
                for (int bj = 0; bj < 2; ++bj) bw[ai][m][bj] = *(const u32x4*)(hp0 + (size_t)(ai * 128 + m * 16) * DM + bj * 128);
#pragma unroll
        for (int ai = 0; ai < 2; ++ai)
#pragma unroll
            for (int m = 0; m < 4; ++m) { const int lrow = lrow0 + ai * 128 + m * 16, grow = u.pm * 256 + lrow;
                const size_t foff = ((size_t)(u.pm - 1) * 256 + lrow) * DM + col0; bf16_t* hp = hp0 + (size_t)(ai * 128 + m * 16) * DM; float ss = 0.f;
#pragma unroll
                for (int bj = 0; bj < 2; ++bj) { const u32x4 w = bw[ai][m][bj];
                    const f32x4 b0 = (f32x4){__uint_as_float(w.x << 16), __uint_as_float(w.x & 0xffff0000u), __uint_as_float(w.y << 16), __uint_as_float(w.y & 0xffff0000u)};
                    const f32x4 b1 = (f32x4){__uint_as_float(w.z << 16), __uint_as_float(w.z & 0xffff0000u), __uint_as_float(w.w << 16), __uint_as_float(w.w & 0xffff0000u)};
                    const f32x4 h0 = b0 + acc[ai][bj][m][0] * dbg, h1 = b1 + acc[ai][bj][m][1] * dbg;
                    if (out_f) { st_wt(out_f + foff + bj * 128, h0); st_wt(out_f + foff + bj * 128 + 4, h1); }
                    else { ss += ((h0[0] * h0[0] + h0[1] * h0[1]) + (h0[2] * h0[2] + h0[3] * h0[3])) + ((h1[0] * h1[0] + h1[1] * h1[1]) + (h1[2] * h1[2] + h1[3] * h1[3]));
                        u32x4 o; o.x = cvt_pk_bf16(h0[0], h0[1]); o.y = cvt_pk_bf16(h0[2], h0[3]); o.z = cvt_pk_bf16(h1[0], h1[1]); o.w = cvt_pk_bf16(h1[2], h1[3]); st_wt(hp + bj * 128, o); } }
                if (!out_f) { ss += __shfl_xor(ss, 16); ss += __shfl_xor(ss, 32); if (fq == 0) (void)__hip_atomic_fetch_add(rs + grow, rs_fix(ss), __ATOMIC_RELAXED, __HIP_MEMORY_SCOPE_AGENT); } }
    }
};
struct EpiSwiglu {
    static constexpr bool PERM = true;
    bf16_t* P; const rs_t* rs;
    __device__ __forceinline__ void operator()(const f32x4 (&acc)[2][2][4][2], const Unit& u, int wr, int wc, int fr, int fq) const {
        asm volatile("" : "+v"(fr), "+v"(fq));
        const int row0 = u.pm * 256 + wr * 64 + fr, col0 = u.pn * 128 + wc * 32 + 8 * fq;
#pragma unroll
        for (int ai = 0; ai < 2; ++ai)
#pragma unroll
            for (int m = 0; m < 4; ++m) { bf16_t* rowp = P + (size_t)(row0 + ai * 128 + m * 16) * PW + col0;
                const float sc = __builtin_amdgcn_rsqf(rs_val(rs[row0 + ai * 128 + m * 16]) * (1.f / DM) + EPS);
                float o[8];
#pragma unroll
                for (int n = 0; n < 2; ++n)
#pragma unroll
                    for (int e = 0; e < 4; ++e) { const float g = acc[ai][0][m][n][e] * sc, up = acc[ai][1][m][n][e] * sc; o[n * 4 + e] = g * __builtin_amdgcn_rcpf(1.f + __builtin_amdgcn_exp2f(-g * LOG2E)) * up; }
                u32x4 w; w.x = cvt_pk_bf16(o[0], o[1]); w.y = cvt_pk_bf16(o[2], o[3]); w.z = cvt_pk_bf16(o[4], o[5]); w.w = cvt_pk_bf16(o[6], o[7]);
                st_wt(rowp, w); }
    }
};

struct SkP { bf16_t* P; int ocol; const rs_t* rs; struct Pre { rs_t q[4]; };
    __device__ __forceinline__ void load(int r0, int, Pre& p) const { if (rs) {
#pragma unroll
        for (int r = 0; r < 4; ++r) p.q[r] = rs[MROW0 + r0 + r]; } }
    __device__ __forceinline__ void apply(int r0, int c, f32x4 v, const Pre& p) const {
#pragma unroll
        for (int r = 0; r < 4; ++r) { float x = v[r]; if (rs) x *= __builtin_amdgcn_rsqf(rs_val(p.q[r]) * (1.f / DM) + EPS); P[(size_t)(MROW0 + r0 + r) * PW + ocol + c] = (bf16_t)f2bf(x); } } };
struct SkGate { bf16_t* G; const float* bias; const rs_t* rs; struct Pre { rs_t q[4]; float b; };
    __device__ __forceinline__ void load(int r0, int c, Pre& p) const { p.b = bias[c];
#pragma unroll
        for (int r = 0; r < 4; ++r) p.q[r] = rs[MROW0 + r0 + r]; }
    __device__ __forceinline__ void apply(int r0, int c, f32x4 v, const Pre& p) const {
#pragma unroll
        for (int r = 0; r < 4; ++r) { const float x = v[r] * __builtin_amdgcn_rsqf(rs_val(p.q[r]) * (1.f / DM) + EPS); G[(size_t)(MROW0 + r0 + r) * 2048 + c] = (bf16_t)f2bf(__builtin_amdgcn_rcpf(1.f + __builtin_amdgcn_exp2f(-(x + p.b) * LOG2E))); } } };
struct SkGated { bf16_t* P; const bf16_t* G; int first; struct Pre { bf16_t pv[4], g[4]; };
    __device__ __forceinline__ void load(int r0, int c, Pre& p) const {
#pragma unroll
        for (int r = 0; r < 4; ++r) { p.g[r] = G[(size_t)(MROW0 + r0 + r) * 2048 + c]; p.pv[r] = first ? (bf16_t)0 : P[(size_t)(MROW0 + r0 + r) * PW + C_MERGED + c]; } }
    __device__ __forceinline__ void apply(int r0, int c, f32x4 v, const Pre& p) const {
#pragma unroll
        for (int r = 0; r < 4; ++r) P[(size_t)(MROW0 + r0 + r) * PW + C_MERGED + c] = (bf16_t)f2bf(bf2f(p.pv[r]) + bf2f(p.g[r]) * v[r]); } };
struct SkRes { float* hmeta; bf16_t* hb; rs_t* rs; struct Pre { float hm[4]; };
    __device__ __forceinline__ void load(int r0, int c, Pre& p) const {
#pragma unroll
        for (int r = 0; r < 4; ++r) p.hm[r] = hmeta[(size_t)(MROW0 + r0 + r) * DM + c]; }
    __device__ __forceinline__ void apply(int r0, int c, f32x4 v, const Pre& p) const {
#pragma unroll
        for (int r = 0; r < 4; ++r) { const float hv = p.hm[r] + v[r]; hmeta[(size_t)(MROW0 + r0 + r) * DM + c] = hv;
            if (hb) { hb[(size_t)(MROW0 + r0 + r) * DM + c] = (bf16_t)f2bf(hv); float ss = hv * hv; ss += __shfl_xor(ss, 1); ss += __shfl_xor(ss, 2); ss += __shfl_xor(ss, 4); ss += __shfl_xor(ss, 8);
                if ((threadIdx.x & 15) == 0) (void)__hip_atomic_fetch_add(rs + MROW0 + r0 + r, rs_fix(ss), __ATOMIC_RELAXED, __HIP_MEMORY_SCOPE_AGENT); } } } };
template <class Fn>
__device__ __forceinline__ void skinny_gemm(LAS unsigned char* lds, const bf16_t* A, int lda, const bf16_t* Bt, int K, int ntask, int bid, int G, const Fn& f) {
    int tid = threadIdx.x; asm volatile("" : "+v"(tid));
    const int wid = __builtin_amdgcn_readfirstlane(tid >> 6), lane = tid & 63, l15 = lane & 15, kq = lane >> 4;
    LAS f32x4* red = (LAS f32x4*)lds;
    const int kw = K / 8;
    for (int task = bid; task < ntask; task += G) {
        const bf16_t* ap = A + (size_t)l15 * lda + wid * kw + kq * 8;
        const bf16_t* bp = Bt + (size_t)(task * 16 + l15) * K + wid * kw + kq * 8;
        float z = 0.f; asm volatile("" : "+v"(z));
        f32x4 acc = (f32x4){z, z, z, z};
        typename Fn::Pre pre{}; if (wid == 0) f.load(kq * 4, task * 16 + l15, pre);
        for (int k0 = 0; k0 < kw; k0 += 256) {
            bf16x8 fa[8], fb[8];
#pragma unroll
            for (int i = 0; i < 8; ++i) { const int k = (k0 + 32 * i < kw) ? k0 + 32 * i : 0; fa[i] = *(const bf16x8*)(ap + k); fb[i] = *(const bf16x8*)(bp + k); }
#pragma unroll
            for (int i = 0; i < 8; ++i) if (k0 + 32 * i < kw) acc = __builtin_amdgcn_mfma_f32_16x16x32_bf16(fa[i], fb[i], acc, 0, 0, 0);
        }
        red[wid * 64 + lane] = acc;
        LDS_WAIT(); __syncthreads();
        if (wid == 0) {
            f32x4 s = red[lane];
#pragma unroll
            for (int w = 1; w < 8; ++w) s += red[w * 64 + lane];
            f.apply(kq * 4, task * 16 + l15, s, pre);
        }
        __syncthreads();
    }
}
__device__ __forceinline__ void skinny_swiglu(LAS unsigned char* lds, const bf16_t* A, int lda, const bf16_t* Bt, int K, bf16_t* P, const rs_t* rs, int bid, int G) {
    int tid = threadIdx.x; asm volatile("" : "+v"(tid));
    const int wid = __builtin_amdgcn_readfirstlane(tid >> 6), lane = tid & 63, l15 = lane & 15, kq = lane >> 4;
    LAS f32x4* red = (LAS f32x4*)lds;
    const int kw = K / 8;
    for (int task = bid; task < DFF / 16; task += G) {
        const int c0 = task * 16, brow = (c0 >> 7) * 256 + (c0 & 127) + l15;
        const bf16_t* ap = A + (size_t)l15 * lda + wid * kw + kq * 8;
        const bf16_t* bg = Bt + (size_t)brow * K + wid * kw + kq * 8; const bf16_t* bu = bg + (size_t)128 * K;
        float z = 0.f; asm volatile("" : "+v"(z));
        f32x4 ag = (f32x4){z, z, z, z}, au = ag;
        rs_t rq[4] = {0, 0, 0, 0}; if (wid == 0) {
#pragma unroll
            for (int r = 0; r < 4; ++r) rq[r] = rs[MROW0 + kq * 4 + r]; }
        {
            bf16x8 fa[8], fg[8], fu[8];
#pragma unroll
            for (int i = 0; i < 8; ++i) { fa[i] = *(const bf16x8*)(ap + 32 * i); fg[i] = *(const bf16x8*)(bg + 32 * i); fu[i] = *(const bf16x8*)(bu + 32 * i); }
#pragma unroll
            for (int i = 0; i < 8; ++i) { ag = __builtin_amdgcn_mfma_f32_16x16x32_bf16(fa[i], fg[i], ag, 0, 0, 0); au = __builtin_amdgcn_mfma_f32_16x16x32_bf16(fa[i], fu[i], au, 0, 0, 0); }
        }
        red[wid * 64 + lane] = ag; red[512 + wid * 64 + lane] = au;
        LDS_WAIT(); __syncthreads();
        if (wid == 0) {
            f32x4 sg = red[lane], su = red[512 + lane];
#pragma unroll
            for (int w = 1; w < 8; ++w) { sg += red[w * 64 + lane]; su += red[512 + w * 64 + lane]; }
#pragma unroll
            for (int r = 0; r < 4; ++r) { const float sc = __builtin_amdgcn_rsqf(rs_val(rq[r]) * (1.f / DM) + EPS); const float g = sg[r] * sc; su[r] *= sc; P[(size_t)(MROW0 + kq * 4 + r) * PW + c0 + l15] = (bf16_t)f2bf(g * __builtin_amdgcn_rcpf(1.f + __builtin_amdgcn_exp2f(-g * LOG2E)) * su[r]); }
        }
        __syncthreads();
    }
}

#define XB_TMO      128
#define XB_XCNT(j)  (256  + 64 * (j))
#define XB_XSUB(j)  (1280 + 64 * (j))
#define XB_XGEN(j)  (2304 + 64 * (j))
#define XB_TOP      3328
#define XB_TOPGEN   3392
#define XCD_BAR_WORDS 3456
#define XB_SPIN_CAP (1u << 18)
__device__ __forceinline__ unsigned xb_ld(unsigned* p)              { return __hip_atomic_load(p, __ATOMIC_RELAXED, __HIP_MEMORY_SCOPE_AGENT); }
__device__ __forceinline__ unsigned xb_add(unsigned* p, unsigned v) { return __hip_atomic_fetch_add(p, v, __ATOMIC_RELAXED, __HIP_MEMORY_SCOPE_AGENT); }
__device__ __forceinline__ unsigned xb_xcc_id() { return (unsigned)__builtin_amdgcn_s_getreg((3 << 11) | 20) & 0xFu; }
#define XB_SPIN(cond, bar) do { unsigned _sp = 0; while (cond) { __builtin_amdgcn_s_sleep(1); \
    if ((++_sp & 255u) == 0u) { if (xb_ld(&(bar)[XB_TMO])) break; if (_sp > XB_SPIN_CAP) { atomicAdd(&(bar)[XB_TMO], 1u); break; } } } } while (0)
struct XcdBarrier { unsigned* bar; unsigned x; volatile LAS unsigned* st; };
__device__ __forceinline__ XcdBarrier xcd_barrier_post(unsigned* bar, volatile LAS unsigned* st) {
    XcdBarrier b; b.bar = bar; b.x = xb_xcc_id(); b.st = st;
    if (threadIdx.x == 0) (void)xb_add(&bar[XB_XCNT(b.x)], 1u);
    return b;
}
__device__ __forceinline__ void xcd_barrier_complete(unsigned* bar, unsigned x, unsigned& nloc, unsigned& nx) {
    const unsigned G = gridDim.x * gridDim.y * gridDim.z;
    unsigned sum, cnt, mine, sp = 0u;
    for (;;) {
        sum = 0u; cnt = 0u; mine = 0u;
#pragma unroll
        for (unsigned j = 0; j < 16; ++j) { const unsigned c = xb_ld(&bar[XB_XCNT(j)]); sum += c; cnt += (c > 0u) ? 1u : 0u; mine = (j == x) ? c : mine; }
        if (sum == G) break;
        __builtin_amdgcn_s_sleep(1);
        if ((++sp & 255u) == 0u) { if (xb_ld(&bar[XB_TMO])) break; if (sp > XB_SPIN_CAP) { atomicAdd(&bar[XB_TMO], 1u); break; } }
    }
    nloc = mine > 0u ? mine : 1u; nx = cnt > 0u ? cnt : 1u;
}
__device__ __forceinline__ void xcd_barrier(const XcdBarrier& b) {
    asm volatile("s_waitcnt vmcnt(0)" ::: "memory");
    __syncthreads();
    if (threadIdx.x == 0) {
        unsigned* bar = b.bar;
        __builtin_amdgcn_s_waitcnt(0);
        unsigned nloc = b.st[0], nx = b.st[1];
        if (nloc == 0u) { xcd_barrier_complete(bar, b.x, nloc, nx); b.st[0] = nloc; b.st[1] = nx; }
        const unsigned old = xb_add(&bar[XB_XSUB(b.x)], 1u);
        const unsigned gen = old / nloc;
        if (old + 1u == (gen + 1u) * nloc) {
            __builtin_amdgcn_fence(__ATOMIC_RELEASE, "agent");
            asm volatile("s_waitcnt vmcnt(0)" ::: "memory");
            const unsigned og = xb_add(&bar[XB_TOP], 1u);
            const unsigned tg = og / nx;
            if (og + 1u == (tg + 1u) * nx) xb_add(&bar[XB_TOPGEN], 1u);
            else XB_SPIN(xb_ld(&bar[XB_TOPGEN]) == tg, bar);
            __builtin_amdgcn_fence(__ATOMIC_ACQUIRE, "agent");
            xb_add(&bar[XB_XGEN(b.x)], 1u);
            asm volatile("s_waitcnt vmcnt(0)" ::: "memory");
        } else {
            XB_SPIN(xb_ld(&bar[XB_XGEN(b.x)]) == gen, bar);
            __builtin_amdgcn_fence(__ATOMIC_ACQUIRE, "agent");
            asm volatile("s_waitcnt vmcnt(0)" ::: "memory");
        }
    }
    __syncthreads();
}

constexpr int NWAVES = 8;
constexpr int RING_BYTES = 131072, LDS_BYTES = 147456, LDSCTL_OFF = LDS_BYTES - 512;
struct Args {
    const float* in[19]; float* out; unsigned char* ws; int ph_lo, ph_hi;
};
struct Ctx {
    LAS unsigned char* lds; int tid, lane, wave, gw, ngw, G, bid;
};

template <int MAP> __device__ __forceinline__ int wmap(int n, float& sc) {
    sc = 1.f;
    if (MAP == 0) return n;
    if (MAP == 1) {
        if (n < 1088) return n;
        if (n < 3136) { const int m = n - 1088, d = m & 127; return 1280 + (m - d) + (d < 64 ? 2 * d : 2 * (d - 64) + 1); }
        if (n < 4160) return 1280 + (n - 1088);
        if (n < 5184) { const int m = n - 4160, d = m & 63; return 4352 + (m - d) + (d < 32 ? 2 * d : 2 * (d - 32) + 1); }
        if (n < 5248) { const int d = n - 5184; return 1088 + (d < 32 ? 2 * d : 2 * (d - 32) + 1); }
        if (n < 5264) { sc = 0.03125f; return 1152 + (n - 5248); }
        if (n < 7312) { const int m = n - 5264, d = m & 127; return 5376 + (m - d) + (d < 64 ? 2 * d : 2 * (d - 64) + 1); }
        if (n < 8336) return 5376 + (n - 5264);
        return 8448 + (n - 8336);
    }
    if (n < DFF) return (n >> 7) * 256 + (n & 127);
    const int m = n - DFF; return (m >> 7) * 256 + 128 + (m & 127);
}
template <int MAP> __device__ __forceinline__ void conv_matrix(const Ctx& F, const float* W, int K, int N, bf16_t* WT, const float* gain) {
    LAS float* scr = (LAS float*)(F.lds + F.wave * 18432);
    const int lane = F.lane;
    const int nblk = (N + 63) / 64, nit = (K / 64) * nblk;
    const int l31 = lane & 31, lh = lane >> 5, c = lane & 7, nsub = lane >> 3;
    f32x2 wv[32]; f32x4 g0 = (f32x4){1.f, 1.f, 1.f, 1.f}, g1 = g0;
#define CONV_LOAD(item) do { const int kb_ = (item) / nblk, nb_ = (item) - kb_ * nblk, k0_ = 64 * kb_, nn_ = 64 * nb_ + 2 * l31; \
        const float* src_ = W + (size_t)(k0_ + lh) * N + nn_; const bool ok_ = nn_ < N; \
        _Pragma("unroll") for (int i = 0; i < 32; ++i) wv[i] = ok_ ? *(const f32x2*)(src_ + (size_t)(2 * i) * N) : (f32x2){0.f, 0.f}; \
        if (gain) { g0 = *(const f32x4*)(gain + k0_ + 8 * c); g1 = *(const f32x4*)(gain + k0_ + 8 * c + 4); } } while (0)
    int it = F.gw;
    if (it < nit) CONV_LOAD(it);
    while (it < nit) {
        const int kb = it / nblk, nb = it - kb * nblk, k0 = 64 * kb, n0 = 64 * nb;
#pragma unroll
        for (int i = 0; i < 32; ++i) { LAS float* d = scr + (2 * i + lh) * 65 + l31; d[0] = wv[i].x; d[32] = wv[i].y; }
        const f32x4 gc0 = g0, gc1 = g1;
        const int nx = it + F.ngw;
        if (nx < nit) CONV_LOAD(nx);
        LDS_WAIT(); asm volatile("" ::: "memory");
#pragma unroll
        for (int j = 0; j < 8; ++j) { const int n = nsub + 8 * j, ns = n0 + n;
            if (ns < N) { float sc; const int dst = wmap<MAP>(ns, sc); const LAS float* s = scr + (8 * c) * 65 + (n & 1) * 32 + (n >> 1);
                u32x4 o; o.x = pk2(s[0 * 65] * (sc * gc0.x), s[1 * 65] * (sc * gc0.y)); o.y = pk2(s[2 * 65] * (sc * gc0.z), s[3 * 65] * (sc * gc0.w));
                o.z = pk2(s[4 * 65] * (sc * gc1.x), s[5 * 65] * (sc * gc1.y)); o.w = pk2(s[6 * 65] * (sc * gc1.z), s[7 * 65] * (sc * gc1.w));
                *(u32x4*)(WT + (size_t)dst * K + k0 + 8 * c) = o; } }
        LDS_WAIT(); asm volatile("" ::: "memory");
        it = nx;
    }
#undef CONV_LOAD
}

__device__ __forceinline__ void norm_row(const float* hrow, bf16_t* orow, rs_t* rs_row, int lane) {
    f32x4 v[8]; float s = 0.f;
#pragma unroll
    for (int j = 0; j < 8; ++j) { v[j] = *((const f32x4*)hrow + lane + 64 * j); s += (v[j].x * v[j].x + v[j].y * v[j].y) + (v[j].z * v[j].z + v[j].w * v[j].w); }
    s = wave_sum(s);
    if (lane == 0) *rs_row = rs_fix(s);
#pragma unroll
    for (int j = 0; j < 8; ++j) { u32x2 o; o.x = cvt_pk_bf16(v[j].x, v[j].y); o.y = cvt_pk_bf16(v[j].z, v[j].w); *((u32x2*)orow + lane + 64 * j) = o; }
}

__device__ __forceinline__ void post1a_row(const bf16_t* P, int r, float* rstdq, float* rstdkv, int lane) {
    const bf16_t* p = P + (size_t)r * PW;
    const u32x4 a = *((const u32x4*)(p + C_CQ) + lane), b = *((const u32x4*)(p + C_CKV) + lane);
    float sa = 0.f, sb = 0.f;
#pragma unroll
    for (int e = 0; e < 4; ++e) { const float x0 = __uint_as_float(a[e] << 16), x1 = __uint_as_float(a[e] & 0xffff0000u); sa += x0 * x0 + x1 * x1;
        const float y0 = __uint_as_float(b[e] << 16), y1 = __uint_as_float(b[e] & 0xffff0000u); sb += y0 * y0 + y1 * y1; }
    sa = wave_sum(sa); sb = wave_sum(sb);
    if (lane == 0) { rstdq[r] = 1.0f / sqrtf(sa * (1.f / 512.f) + EPS); rstdkv[r] = 1.0f / sqrtf(sb * (1.f / 512.f) + EPS); }
    { unsigned* ikp = (unsigned*)(P + (size_t)r * PW + C_IK) + (lane & 31); const unsigned w = *ikp; const float x1 = __uint_as_float(w << 16), x2 = __uint_as_float(w & 0xffff0000u);
      float cs, sn; rope_cs(row_pos(r), lane & 31, 2.f / 64.f, cs, sn);
      if (lane < 32) *ikp = cvt_pk_bf16(x1 * cs - x2 * sn, x2 * cs + x1 * sn); }
}
__device__ __forceinline__ void meta_post_row(bf16_t* P, int r, const float* gperm, int lane) {
    bf16_t* p = P + (size_t)r * PW; const int pos = row_pos(r);
    float c128, s128, c64, s64; rope_cs(pos, lane, 2.f / 128.f, c128, s128); rope_cs(pos, lane & 31, 2.f / 64.f, c64, s64);
#pragma unroll 1
    for (int t = 0; t < 4; ++t) {
        const int cb = t == 0 ? C_DQ : (t == 1 ? C_DK : (t == 2 ? C_FQ : C_FK)); const float sc = (t == 0 || t == 2) ? C2_128 : 1.f;
        const float ga = gperm[t * 128 + 2 * lane], gb = gperm[t * 128 + 2 * lane + 1];
#pragma unroll 1
        for (int h = 0; h < 8; ++h) { unsigned* xp = (unsigned*)(p + cb + h * 128) + lane; const unsigned w = *xp; float x1 = __uint_as_float(w << 16), x2 = __uint_as_float(w & 0xffff0000u);
            const float rn = __builtin_amdgcn_rsqf(wave_sum(x1 * x1 + x2 * x2) * (1.f / 128.f) + EPS); x1 *= rn * ga; x2 *= rn * gb;
            *xp = cvt_pk_bf16((x1 * c128 - x2 * s128) * sc, (x2 * c128 + x1 * s128) * sc); }
    }
#pragma unroll 1
    for (int hh = 0; hh < 8; ++hh) { unsigned* xp = (unsigned*)(p + C_IQ + hh * 128) + lane; const unsigned w = *xp; const float x1 = __uint_as_float(w << 16), x2 = __uint_as_float(w & 0xffff0000u);
        *xp = cvt_pk_bf16(x1 * c64 - x2 * s64, x2 * c64 + x1 * s64); }
}
__device__ __forceinline__ void unpack8(const u32x4& w, float (&x)[8]) {
#pragma unroll
    for (int e = 0; e < 4; ++e) { x[2 * e] = __uint_as_float(w[e] << 16); x[2 * e + 1] = __uint_as_float(w[e] & 0xffff0000u); }
}
__device__ __forceinline__ u32x4 pack8(const float (&x)[8]) { u32x4 w; w.x = cvt_pk_bf16(x[0], x[1]); w.y = cvt_pk_bf16(x[2], x[3]); w.z = cvt_pk_bf16(x[4], x[5]); w.w = cvt_pk_bf16(x[6], x[7]); return w; }
__device__ __forceinline__ u32x4 shfl_xor4(const u32x4& w, int m) { u32x4 r; r.x = __shfl_xor(w.x, m); r.y = __shfl_xor(w.y, m); r.z = __shfl_xor(w.z, m); r.w = __shfl_xor(w.w, m); return r; }
__device__ __forceinline__ void post2_row(bf16_t* P, int r, const float* rstdq, const float* rstdkv, const float* qkg  , LAS float* rnl, int lane) {
    bf16_t* p = P + (size_t)r * PW;
    const float sq = rstdq[r], skv = rstdkv[r];
    const int pos = row_pos(r), hw = lane >> 5, l5 = lane & 31;
    float c64[8], s64[8];
#pragma unroll
    for (int j = 0; j < 8; ++j) rope_cs(pos, 8 * (lane & 3) + j, 2.f / 64.f, c64[j], s64[j]);
    float kp[8]; { const u32x4 w = *(const u32x4*)(p + C_KPE + (lane & 7) * 8); unpack8(w, kp); }
    float kpe_ss = 0.f;
#pragma unroll
    for (int j = 0; j < 8; ++j) kpe_ss += kp[j] * kp[j];
    kpe_ss += __shfl_xor(kpe_ss, 1); kpe_ss += __shfl_xor(kpe_ss, 2); kpe_ss += __shfl_xor(kpe_ss, 4);
    u32x4 rq[4], rkv[4];
#pragma unroll
    for (int it = 0; it < 4; ++it) { const int h = 2 * it + hw; rq[it] = *(const u32x4*)(p + C_QRAW + h * 192 + (l5 < 24 ? l5 : 0) * 8); rkv[it] = *(const u32x4*)(p + C_KVRAW + h * 256 + l5 * 8); }
#pragma unroll
    for (int it = 0; it < 4; ++it) {
        const int h = 2 * it + hw; const bool act = l5 < 24;
        u32x4* ptr = (u32x4*)(p + C_QRAW + h * 192 + (act ? l5 : 0) * 8);
        float x[8]; unpack8(rq[it], x);
        float ss = 0.f;
#pragma unroll
        for (int j = 0; j < 8; ++j) { x[j] *= sq; ss += x[j] * x[j]; }
        if (!act) ss = 0.f;
#pragma unroll
        for (int o = 1; o < 32; o <<= 1) ss += __shfl_xor(ss, o);
        const float rn = 1.0f / sqrtf(ss * (1.f / 192.f) + EPS);
        const int gi = (act ? l5 : 0) * 8;
        const f32x4 g0 = *(const f32x4*)(qkg + gi), g1 = *(const f32x4*)(qkg + gi + 4);
#pragma unroll
        for (int j = 0; j < 4; ++j) { x[j] *= rn * g0[j]; x[4 + j] *= rn * g1[j]; }
        float o[8];
#pragma unroll
        for (int j = 0; j < 8; ++j) { const float pr = __shfl_xor(x[j], 4); const float rot = (l5 & 4) ? (x[j] * c64[j] + pr * s64[j]) : (x[j] * c64[j] - pr * s64[j]); o[j] = (l5 >= 16 ? rot : x[j]) * C2_192; }
        if (act) *ptr = pack8(o);
    }
#pragma unroll
    for (int it = 0; it < 4; ++it) {
        const int h = 2 * it + hw; const bool isk = l5 < 16;
        u32x4* ptr = (u32x4*)(p + C_KVRAW + h * 256 + l5 * 8);
        float x[8]; unpack8(rkv[it], x);
        float ss = 0.f;
#pragma unroll
        for (int j = 0; j < 8; ++j) { x[j] *= skv; ss += x[j] * x[j]; }
        if (!isk) ss = 0.f;
#pragma unroll
        for (int o = 1; o < 32; o <<= 1) ss += __shfl_xor(ss, o);
        const float rn = 1.0f / sqrtf((ss + kpe_ss) * (1.f / 192.f) + EPS);
        if (l5 == 0) rnl[h] = rn;
        const int gi = 192 + (isk ? l5 : 0) * 8;
        const f32x4 g0 = *(const f32x4*)(qkg + gi), g1 = *(const f32x4*)(qkg + gi + 4);
        float o[8];
#pragma unroll
        for (int j = 0; j < 4; ++j) { o[j] = isk ? x[j] * rn * g0[j] : x[j]; o[4 + j] = isk ? x[4 + j] * rn * g1[j] : x[4 + j]; }
        *ptr = pack8(o);
    }
    LDS_WAIT(); asm volatile("" ::: "memory");
    { const int hd = lane >> 3, c = lane & 7; const float rn = rnl[hd];
      const f32x4 g0 = *(const f32x4*)(qkg + 192 + 128 + c * 8), g1 = *(const f32x4*)(qkg + 192 + 128 + c * 8 + 4);
      float x[8], o[8];
#pragma unroll
      for (int j = 0; j < 4; ++j) { x[j] = kp[j] * rn * g0[j]; x[4 + j] = kp[4 + j] * rn * g1[j]; }
#pragma unroll
      for (int j = 0; j < 8; ++j) { const float pr = __shfl_xor(x[j], 4); o[j] = (c & 4) ? (x[j] * c64[j] + pr * s64[j]) : (x[j] * c64[j] - pr * s64[j]); }
      *(u32x4*)(p + C_KPEH + hd * 64 + c * 8) = pack8(o); }
    LDS_WAIT(); asm volatile("" ::: "memory");
}
__device__ __forceinline__ void post3_row(bf16_t* P, int r, const float* subg, float lam, float omli, int lane) {
    bf16_t* p = P + (size_t)r * PW;
    const int hw = lane >> 5, l5 = lane & 31;
    u32x4 rr[4];
#pragma unroll
    for (int h = 0; h < 4; ++h) rr[h] = *(const u32x4*)(p + (hw ? C_IQ : C_FQ) + h * 256 + l5 * 8);
#pragma unroll
    for (int h = 0; h < 4; ++h) {
        const u32x4 raw = rr[h];
        const u32x4 praw = shfl_xor4(raw, 16);
        float a[8], b[8]; unpack8(raw, a); unpack8(praw, b);
        float d[8], ss = 0.f;
#pragma unroll
        for (int j = 0; j < 8; ++j) { d[j] = a[j] - lam * b[j]; ss += d[j] * d[j]; }
        if (l5 >= 16) ss = 0.f;
#pragma unroll
        for (int o = 1; o < 64; o <<= 1) ss += __shfl_xor(ss, o);
        const float rn = omli / sqrtf(ss * (1.f / 256.f) + EPS);
        const int dim = hw * 128 + (l5 & 15) * 8;
        const f32x4 g0 = *(const f32x4*)(subg + dim), g1 = *(const f32x4*)(subg + dim + 4);
        float o[8];
#pragma unroll
        for (int j = 0; j < 4; ++j) { o[j] = d[j] * rn * g0[j]; o[4 + j] = d[4 + j] * rn * g1[j]; }
        if (l5 < 16) *(u32x4*)(p + C_OC + h * 256 + dim) = pack8(o);
    }
}

__device__ __forceinline__ void index_unit(const bf16_t* P, int unit, unsigned* bm, LAS unsigned char* lds) {
    typedef float f32x16 __attribute__((ext_vector_type(16)));
    int tid = threadIdx.x; asm volatile("" : "+v"(tid));
    const int wid = __builtin_amdgcn_readfirstlane(tid >> 6), lane = tid & 63, j = lane & 31, hi = lane >> 5;
    const int tb = 255 - (unit >> 4), b = unit & 15, t0 = tb * 8, tokbase = MBLK + b * SEQ;
    const int wmax = (64 + t0 + 7) >> 5;
    LAS unsigned* keys = (LAS unsigned*)lds;
    LAS float* iwl = (LAS float*)(lds + 8 * 2112 * 4);
    if (t0 + 7 + 17 > 256) {
        if (tid < 128) iwl[tid] = bf2f(P[(size_t)(tokbase + t0 + (tid >> 4)) * PW + C_IW + (tid & 15)]);
        LAS unsigned char* al = lds + 8 * 2112 * 4 + 512;
        { const int id0 = tid * 2;
#pragma unroll
          for (int e = 0; e < 2; ++e) { const int id = id0 + e, rw = id >> 3, c = id & 7;
              *(LAS bf16x8*)(al + rw * 144 + c * 16) = *(const bf16x8*)(P + (size_t)(tokbase + t0 + (rw >> 4)) * PW + C_IQ + (rw & 15) * 64 + c * 8); } }
        LDS_WAIT(); __syncthreads();
        bf16x8 af[4][4];
        { const int qa = (j >> 2) & 1, ha = (j & 3) + 4 * (j >> 3);
#pragma unroll
          for (int blk = 0; blk < 4; ++blk)
#pragma unroll
              for (int s = 0; s < 4; ++s) af[blk][s] = *(const LAS bf16x8*)(al + ((2 * blk + qa) * 16 + ha) * 144 + s * 32 + hi * 16); }
        const unsigned boff = (unsigned)(j * PW + C_IK + hi * 8) * 2u;
        for (int w = wid; w <= wmax; w += 8) {
            const int kr_ = w < 2 ? (MBLK - 64) + 32 * w : tokbase + 32 * (w - 2); const char* bp_ = (const char*)(P + (size_t)kr_ * PW) + boff;
            bf16x8 bf[4];
#pragma unroll
            for (int s = 0; s < 4; ++s) bf[s] = *(const bf16x8*)(bp_ + s * 32);
            const int kidx = 32 * w + j;
#pragma unroll
            for (int blk = 0; blk < 4; ++blk) {
                f32x16 acc = (f32x16){0.f,0.f,0.f,0.f,0.f,0.f,0.f,0.f,0.f,0.f,0.f,0.f,0.f,0.f,0.f,0.f};
#pragma unroll
                for (int s = 0; s < 4; ++s) acc = __builtin_amdgcn_mfma_f32_32x32x16_bf16(af[blk][s], bf[s], acc, 0, 0, 0);
                const int q = 2 * blk + hi;
                const LAS f32x4* iwq = (const LAS f32x4*)(iwl + q * 16);
                float score = 0.f;
#pragma unroll
                for (int g = 0; g < 4; ++g) { const f32x4 wv = iwq[g]; score += fmaxf(acc[4 * g], 0.f) * wv.x + fmaxf(acc[4 * g + 1], 0.f) * wv.y + fmaxf(acc[4 * g + 2], 0.f) * wv.z + fmaxf(acc[4 * g + 3], 0.f) * wv.w; }
                const bool valid = kidx >= 48 && kidx <= 64 + t0 + q; const unsigned u_ = __float_as_uint(score);
                keys[q * 2112 + kidx] = valid ? ((u_ & 0x80000000u) ? ~u_ : (u_ | 0x80000000u)) : 0u;
            }
        }
        LDS_WAIT(); __syncthreads();
    }
    const int tq = t0 + wid, qk = 64 + tq, nch = qk / 64 + 1;
    unsigned* out = bm + (size_t)(b * SEQ + tq) * BMW;
    if (tq + 17 <= 256) {
        for (int c = 0; c < 33; ++c) { const int kidx = 64 * c + lane; const unsigned long long m = __ballot(kidx >= 48 && kidx <= qk);
            if (lane == 0) { out[2 * c] = (unsigned)m; out[2 * c + 1] = (unsigned)(m >> 32); } }
    } else {
        unsigned kreg[33];
#pragma unroll
        for (int c = 0; c < 33; ++c) kreg[c] = (c < nch && 64 * c + lane <= qk) ? keys[wid * 2112 + 64 * c + lane] : 0u;
        unsigned T = 0u;
        for (int bit = 31; bit >= 0; --bit) {
            const unsigned cand = T | (1u << bit); int cnt = 0;
#pragma unroll
            for (int c = 0; c < 33; ++c) cnt += __popcll(__ballot(kreg[c] >= cand));
            if (cnt >= 256) T = cand;
            if (cnt == 256) break;
        }
#pragma unroll
        for (int c = 0; c < 33; ++c) { const unsigned long long m = __ballot(kreg[c] >= T && kreg[c] != 0u);
            if (lane == 0) { out[2 * c] = (unsigned)m; out[2 * c + 1] = (unsigned)(m >> 32); } }
    }
    LDS_WAIT();
}

namespace fa {
typedef float f32x16 __attribute__((ext_vector_type(16)));
typedef short s16x4 __attribute__((ext_vector_type(4)));
__device__ __forceinline__ int crow(int r, int hi) { return (r & 3) + 8 * (r >> 2) + 4 * hi; }
__device__ __forceinline__ int v_st(int k, int c) { const int kk = (k & ~0xC) | ((k & 4) << 1) | ((k & 8) >> 1); return ((kk >> 3) * 4 + (c >> 5)) * 512 + ((kk & 7) * 32 + (c & 31)) * 2; }
__device__ __forceinline__ int v_rd_base(int lane) { return ((lane & 3) << 3) | (((lane >> 2) & 3) << 6) | (((lane >> 4) & 1) << 5) | (((lane >> 5) & 1) << 8); }
constexpr int v_rd_off(int d0, int ks, int half) { return d0 * 512 + ks * 4096 + half * 2048; }
constexpr int SHM_V = 16384;
template <int DQK, int DV> struct Geo { static constexpr int KP = DQK * 2, SHM_K = 64 * DQK * 2, LDS_K0 = 2 * 64 * DV * 2, LDS_WS = LDS_K0 + 2 * SHM_K, BYTES = LDS_WS + 8 * 256; };
#define FA_KSWZ(row, colB, pitch) ((row) * (pitch) + ((colB) ^ (((row) & 7) << 4)))
#define FA_SBAR() __builtin_amdgcn_sched_barrier(0)

struct Item { int qrow0, qk0, nt, tokbase; };

template <int DQK>
__device__ __forceinline__ void load_q(const bf16_t* P, const Item& it, int qcol, bf16x8 (&qr)[DQK / 16]) {
    int tid = threadIdx.x; asm volatile("" : "+v"(tid));
    const int wid = tid >> 6, lane = tid & 63, r32 = lane & 31, hi = lane >> 5;
    const bf16_t* qp = P + (size_t)(it.qrow0 + wid * 32 + r32) * PW + qcol + hi * 8;
#pragma unroll
    for (int d0 = 0; d0 < DQK / 16; ++d0) qr[d0] = *(const bf16x8*)(qp + d0 * 16);
}

template <int DQK, int DV, bool MASKED>
__device__ __forceinline__ void attn_core(bf16_t* P, const Item& it, const bf16x8 (&qr)[DQK / 16], int k1col, int k2col, int vcol, int ocol, int ocol1, const unsigned* bmq, LAS unsigned char* lds) {
    typedef Geo<DQK, DV> G; constexpr int SHMV = 64 * DV * 2, NDB = DV / 32;
    int tid = threadIdx.x; asm volatile("" : "+v"(tid));
    const int wid = __builtin_amdgcn_readfirstlane(tid >> 6), lane = tid & 63, r32 = lane & 31, hi = lane >> 5;
    LAS unsigned char* V_lds = lds; LAS unsigned char* K_lds = lds + G::LDS_K0; LAS float* wsf = (LAS float*)(lds + G::LDS_WS) + wid * 64;
    const int sr = tid >> 4, sc = (tid & 15) * 8;
    const int vst0 = v_st(sr, sc), vst1 = v_st(32 + sr, sc), kws0 = FA_KSWZ(sr, sc * 2, G::KP), kws1 = FA_KSWZ(sr + 32, sc * 2, G::KP);
    const int xr = tid >> 3, xc = (tid & 7) * 8, kws2 = FA_KSWZ(xr, (128 + xc) * 2, G::KP);
    const unsigned loff0 = (unsigned)(sr * PW + sc) * 2u, loffx = (unsigned)(xr * PW + xc) * 2u;
    const int vb0 = (int)(unsigned)(size_t)V_lds + v_rd_base(lane);
    const int NT = it.nt;
    const int qk = it.qk0 + wid * 32 + r32;
    const bool use_bm = MASKED && (bmq != nullptr);
    const unsigned bmoff = (unsigned)((wid * 32 + r32) * BMW) * 4u;
    float l_reg = 0.f; f32x16 o[NDB];
#pragma unroll
    for (int d = 0; d < NDB; ++d) o[d] = (f32x16){0.f,0.f,0.f,0.f,0.f,0.f,0.f,0.f,0.f,0.f,0.f,0.f,0.f,0.f,0.f,0.f};
    bf16x8 sk0, sk1, sk2, sv0, sv1, sv2, sv3;
#define FA_KROW0(t) ((t) == 0 ? (MBLK - 64) : it.tokbase + 64 * ((t) - 1))
#define FA_LOADK(t) do { const int kr_ = FA_KROW0(t); const char* rb_ = (const char*)(P + (size_t)kr_ * PW); const char* rk_ = rb_ + (size_t)k1col * 2; \
        sk0 = *(const bf16x8*)(rk_ + loff0); sk1 = *(const bf16x8*)(rk_ + (size_t)32 * PW * 2 + loff0); if (DQK == 192) sk2 = *(const bf16x8*)(rb_ + (size_t)k2col * 2 + loffx); } while (0)
#define FA_LOADV(t) do { const char* rv_ = (const char*)(P + (size_t)FA_KROW0(t) * PW) + (size_t)vcol * 2; \
        sv0 = *(const bf16x8*)(rv_ + loff0); sv1 = *(const bf16x8*)(rv_ + (size_t)32 * PW * 2 + loff0); if (DV == 256) { sv2 = *(const bf16x8*)(rv_ + 256 + loff0); sv3 = *(const bf16x8*)(rv_ + 256 + (size_t)32 * PW * 2 + loff0); } } while (0)
#define FA_LOAD(t) do { FA_LOADK(t); FA_LOADV(t); } while (0)
#define FA_WRITE(bf) do { *(LAS bf16x8*)(K_lds + (bf) * G::SHM_K + kws0) = sk0; *(LAS bf16x8*)(K_lds + (bf) * G::SHM_K + kws1) = sk1; \
        *(LAS bf16x8*)(V_lds + (bf) * SHMV + vst0) = sv0; *(LAS bf16x8*)(V_lds + (bf) * SHMV + vst1) = sv1; if (DV == 256) { *(LAS bf16x8*)(V_lds + (bf) * SHMV + 16384 + vst0) = sv2; *(LAS bf16x8*)(V_lds + (bf) * SHMV + 16384 + vst1) = sv3; } \
        if (DQK == 192) *(LAS bf16x8*)(K_lds + (bf) * G::SHM_K + kws2) = sk2; } while (0)
    constexpr int QREG = (DV == 256) ? 3 : DQK / 16;
    constexpr int NQL = DQK / 16 - QREG;
    static_assert(G::BYTES + 8 * NQL * 64 * 16 <= LDSCTL_OFF, "attention LDS budget");
    LAS unsigned char* qx = lds + G::BYTES + (wid * (NQL * 64) + lane) * 16;
    if (QREG < DQK / 16) {
#pragma unroll
        for (int d0 = QREG; d0 < DQK / 16; ++d0) *(LAS bf16x8*)(qx + (d0 - QREG) * 1024) = qr[d0];
    }
    FA_LOAD(0); FA_WRITE(0);
    __syncthreads();
    for (int t = 0; t < NT; ++t) {
        const int cur = t & 1;
        unsigned zb = 0u; asm volatile("" : "+v"(zb)); u32x2 bw = (u32x2){zb, zb};
        if (use_bm) bw = *(const u32x2*)((const char*)(bmq + 2 * t) + bmoff);
        f32x16 p0 = (f32x16){0.f,0.f,0.f,0.f,0.f,0.f,0.f,0.f,0.f,0.f,0.f,0.f,0.f,0.f,0.f,0.f}, p1 = p0;
        { LAS unsigned char* kbase = K_lds + cur * G::SHM_K;
          LAS unsigned char* kb[4];
#pragma unroll
          for (int dd = 0; dd < 4; ++dd) kb[dd] = kbase + FA_KSWZ(r32, (dd * 16 + hi * 8) * 2, G::KP);
          constexpr int GS = (DQK == 192 || DV == 256) ? 2 : 4;
#pragma unroll
          for (int g = 0; g < DQK / (16 * GS); ++g) {
              bf16x8 fb0[GS], fb1[GS];
#pragma unroll
              for (int dd = 0; dd < GS; ++dd) { const int d0 = g * GS + dd; LAS unsigned char* a = kb[d0 & 3] + (d0 >> 2) * 128; fb0[dd] = *(const LAS bf16x8*)a; fb1[dd] = *(const LAS bf16x8*)(a + 32 * G::KP); }
              FA_SBAR();
#pragma unroll
              for (int dd = 0; dd < GS; ++dd) { const int d0 = g * GS + dd; bf16x8 qf; if (d0 < QREG) qf = qr[d0 < QREG ? d0 : 0]; else qf = *(const LAS bf16x8*)(qx + (d0 - QREG) * 1024);
                  p0 = __builtin_amdgcn_mfma_f32_32x32x16_bf16(fb0[dd], qf, p0, 0, 0, 0); p1 = __builtin_amdgcn_mfma_f32_32x32x16_bf16(fb1[dd], qf, p1, 0, 0, 0); }
              FA_SBAR(); } }
        if (t + 1 < NT) { FA_LOADK(t + 1); if (DV != 256) FA_LOADV(t + 1); }
        FA_SBAR();
        const float NEG = -__builtin_inff();
        if (use_bm) {
        } else if (t == 0 || 64 * t + 63 > it.qk0 + wid * 32) {
            const int kb_ = 64 * t + 4 * hi;
#pragma unroll
            for (int r = 0; r < 16; ++r) { const int k0 = kb_ + (r & 3) + 8 * (r >> 2), k1 = k0 + 32;
                if (k0 < 48 || k0 > qk) p0[r] = NEG; if (k1 < 48 || k1 > qk) p1[r] = NEG; }
        }
        float ps = 0.f;
#pragma unroll
        for (int r = 0; r < 16; ++r) { p0[r] = __builtin_amdgcn_exp2f(p0[r]); p1[r] = __builtin_amdgcn_exp2f(p1[r]); }
        if (use_bm) {
            const int wx = (int)(bw.x >> (4 * hi)), wy = (int)(bw.y >> (4 * hi));
#pragma unroll
            for (int r = 0; r < 16; ++r) { const int c = (r & 3) + 8 * (r >> 2);
                p0[r] = __uint_as_float(__float_as_uint(p0[r]) & (unsigned)__builtin_amdgcn_sbfe(wx, c, 1)); p1[r] = __uint_as_float(__float_as_uint(p1[r]) & (unsigned)__builtin_amdgcn_sbfe(wy, c, 1)); }
        }
        { f32x2 s2 = (f32x2){p0[0], p0[1]} + (f32x2){p1[0], p1[1]};
#pragma unroll
          for (int r = 2; r < 16; r += 2) s2 += (f32x2){p0[r], p0[r + 1]} + (f32x2){p1[r], p1[r + 1]};
          ps = s2.x + s2.y; }
        { auto rr = __builtin_amdgcn_permlane32_swap(__float_as_uint(ps), __float_as_uint(ps), false, false); ps = __uint_as_float(rr[0]) + __uint_as_float(rr[1]); }
        l_reg += ps;
        if (DV == 256 && t + 1 < NT) { FA_SBAR(); FA_LOADV(t + 1); FA_SBAR(); }
        bf16x8 pa0, pa1, pa2, pa3;
#define FA_PK4(Pv, B_, OUT) do { const unsigned a0 = cvt_pk_bf16(Pv[B_ + 0], Pv[B_ + 1]), a1 = cvt_pk_bf16(Pv[B_ + 2], Pv[B_ + 3]), b0 = cvt_pk_bf16(Pv[B_ + 4], Pv[B_ + 5]), b1 = cvt_pk_bf16(Pv[B_ + 6], Pv[B_ + 7]); \
        auto r0 = __builtin_amdgcn_permlane32_swap(a0, b0, false, false); auto r1 = __builtin_amdgcn_permlane32_swap(a1, b1, false, false); \
        u32x4 w_ = {r0[0], r1[0], r0[1], r1[1]}; OUT = __builtin_bit_cast(bf16x8, w_); } while (0)
        FA_PK4(p0, 0, pa0); FA_PK4(p0, 8, pa1); FA_PK4(p1, 0, pa2); FA_PK4(p1, 8, pa3);
#define FA_TRRD(dst, off) asm volatile("ds_read_b64_tr_b16 %0, %1 offset:%2" : "=&v"(dst) : "v"(vbc), "i"(off) : "memory")
#define FA_PV(VB, d0) do { s16x4 l0, l1, l2, l3, h0, h1, h2, h3; constexpr int b_ = ((d0) >> 2) * 16384 + v_rd_off((d0) & 3, 0, 0); \
        FA_TRRD(l0, b_); FA_TRRD(h0, b_ + 2048); FA_TRRD(l1, b_ + 4096); FA_TRRD(h1, b_ + 6144); FA_TRRD(l2, b_ + 8192); FA_TRRD(h2, b_ + 10240); FA_TRRD(l3, b_ + 12288); FA_TRRD(h3, b_ + 14336); \
        asm volatile("s_waitcnt lgkmcnt(0)" ::: "memory"); FA_SBAR(); \
        o[d0] = __builtin_amdgcn_mfma_f32_32x32x16_bf16(pa0, (bf16x8){l0[0], l0[1], l0[2], l0[3], h0[0], h0[1], h0[2], h0[3]}, o[d0], 0, 0, 0); \
        o[d0] = __builtin_amdgcn_mfma_f32_32x32x16_bf16(pa1, (bf16x8){l1[0], l1[1], l1[2], l1[3], h1[0], h1[1], h1[2], h1[3]}, o[d0], 0, 0, 0); \
        o[d0] = __builtin_amdgcn_mfma_f32_32x32x16_bf16(pa2, (bf16x8){l2[0], l2[1], l2[2], l2[3], h2[0], h2[1], h2[2], h2[3]}, o[d0], 0, 0, 0); \
        o[d0] = __builtin_amdgcn_mfma_f32_32x32x16_bf16(pa3, (bf16x8){l3[0], l3[1], l3[2], l3[3], h3[0], h3[1], h3[2], h3[3]}, o[d0], 0, 0, 0); } while (0)
        FA_SBAR();
        { const int vbc = vb0 + cur * SHMV;
          FA_PV(0, 0); FA_PV(0, 1); FA_PV(0, 2); FA_PV(0, 3); if (DV == 256) { FA_PV(0, 4); FA_PV(0, 5); FA_PV(0, 6); FA_PV(0, 7); } }
        FA_SBAR();
        if (t + 1 < NT) { const int nb_ = cur ^ 1; FA_WRITE(nb_); }
        __syncthreads();
    }
    if (hi == 0) wsf[r32] = l_reg; LDS_WAIT();
    float rli[16];
#pragma unroll
    for (int r = 0; r < 16; ++r) { const float lv = wsf[crow(r, hi)]; rli[r] = lv > 0.f ? __builtin_amdgcn_rcpf(lv) : 0.f; }
    { int l2 = lane; asm volatile("" : "+v"(l2));
      const int r32b = l2 & 31, hib = l2 >> 5;
      char* Ow = (char*)(P + (size_t)(it.qrow0 + wid * 32) * PW + ocol) + (unsigned)((4 * hib) * PW + r32b) * 2u;
      char* Ow1 = (char*)(P + (size_t)(it.qrow0 + wid * 32) * PW + ocol1) + (unsigned)((4 * hib) * PW + r32b) * 2u;
#pragma unroll
      for (int r = 0; r < 16; ++r) { const unsigned ro = (unsigned)(((r & 3) + 8 * (r >> 2)) * PW) * 2u;
#pragma unroll
        for (int d0 = 0; d0 < NDB; ++d0) { const float v = o[d0][r] * rli[r]; const float vn = __shfl_xor(v, 1);
            if ((r32b & 1) == 0) *(unsigned*)((d0 < 4 ? Ow : Ow1) + ro + (d0 & 3) * 64) = cvt_pk_bf16(v, vn); } } }
    LDS_WAIT();
    __syncthreads();
#undef FA_KROW0
#undef FA_LOAD
#undef FA_LOADK
#undef FA_LOADV
#undef FA_WRITE
#undef FA_PK4
#undef FA_TRRD
#undef FA_PV
}
__device__ __forceinline__ int next_item(unsigned* ctr, LAS int* slot) {
    __syncthreads();
    if (threadIdx.x == 0) *slot = (int)__hip_atomic_fetch_add(ctr, 1u, __ATOMIC_RELAXED, __HIP_MEMORY_SCOPE_AGENT);
    __syncthreads();
    return *slot;
}
__device__ __forceinline__ void queue_prime(unsigned* ctr, LAS int* slot) {
    __syncthreads();
    if (threadIdx.x == 0) slot[0] = (int)__hip_atomic_fetch_add(ctr, 1u, __ATOMIC_RELAXED, __HIP_MEMORY_SCOPE_AGENT);
    __syncthreads();
}
__device__ __forceinline__ int queue_next(unsigned* ctr, LAS int* slot, int k) {
    const int idx = slot[k & 1];
    if (threadIdx.x == 0) slot[(k + 1) & 1] = (int)__hip_atomic_fetch_add(ctr, 1u, __ATOMIC_RELAXED, __HIP_MEMORY_SCOPE_AGENT);
    return idx;
}
__device__ __forceinline__ Item make_item(bool meta, int b, int qb) {
    Item it;
    if (meta) { it.qrow0 = 0; it.qk0 = -(MBLK - 64); it.nt = 1; it.tokbase = MBLK; }
    else { it.qrow0 = MBLK + b * SEQ + qb * 256; it.qk0 = 64 + qb * 256; it.nt = 4 * (qb + 1) + 1; it.tokbase = MBLK + b * SEQ; }
    return it;
}
}


constexpr int PH_PER_LAYER = 19, N_PHASES = 2 * PH_PER_LAYER;
__device__ __forceinline__ unsigned char* uni_ptr(unsigned char* p) { const unsigned long long v = (unsigned long long)p; const unsigned lo = __builtin_amdgcn_readfirstlane((unsigned)v), hi = __builtin_amdgcn_readfirstlane((unsigned)(v >> 32)); return (unsigned char*)(((unsigned long long)hi << 32) | lo); }
__device__ __forceinline__ const float* arg_in(const Args& a, int k) { asm volatile("" : "+s"(k)); return a.in[k]; }
__global__ void __launch_bounds__(NWAVES * 64, 2) mega_fwd(Args args) {
    extern __shared__ __attribute__((aligned(16))) unsigned char lds_raw[];
    {
        LAS unsigned char* l0 = (LAS unsigned char*)lds_raw;
        for (int u = threadIdx.x; u < (LDS_BYTES - LDSCTL_OFF) / 4; u += NWAVES * 64) ((LAS unsigned*)(l0 + LDSCTL_OFF))[u] = 0u;
        __syncthreads();
    }
#if MK_ONE_LAUNCH
    (void)xcd_barrier_post((unsigned*)(args.ws + WS_CTL) + CW_BAR, (volatile LAS unsigned*)((LAS unsigned char*)lds_raw + LDSCTL_OFF + 64));
#define GRID_BAR() do { XcdBarrier bar_; bar_.bar = (unsigned*)(uni_ptr(args.ws) + WS_CTL) + CW_BAR; bar_.x = xb_xcc_id(); bar_.st = (volatile LAS unsigned*)((LAS unsigned char*)lds_raw + LDSCTL_OFF + 64); xcd_barrier(bar_); } while (0)
#else
#define GRID_BAR() do {} while (0)
#endif
    const int lo = args.ph_lo, hi = args.ph_hi;
#define IN(k) (lo <= (k) && (k) < hi)
#define SEAM(k) do { if (IN((k) + 1)) GRID_BAR(); } while (0)
#define PH_BEGIN \
    int tid_ = threadIdx.x; asm volatile("" : "+v"(tid_)); \
    Ctx F; F.lds = (LAS unsigned char*)lds_raw; F.tid = tid_; F.lane = tid_ & 63; F.wave = __builtin_amdgcn_readfirstlane(tid_ >> 6); \
    F.G = gridDim.x; F.bid = blockIdx.x; F.gw = F.bid * NWAVES + F.wave; F.ngw = F.G * NWAVES; \
    unsigned char* ws = uni_ptr(args.ws); asm volatile("" : "+s"(ws)); ws = (unsigned char*)(__attribute__((address_space(1))) unsigned char*)(unsigned long long)ws;     \
    int ly = __builtin_amdgcn_readfirstlane(layer); asm volatile("" : "+s"(ly)); (void)ly; (void)F
#define XN_ ((bf16_t*)(ws + WS_XN))
#define P_ ((bf16_t*)(ws + WS_P))
#define HMETA_ ((float*)(ws + WS_HMETA))
#define RSTDQ_ ((float*)(ws + WS_RSTD))
#define RSTDKV_ ((float*)(ws + WS_RSTD) + R)
#define BM_ ((unsigned*)(ws + WS_BM))
#define RS_(i) ((rs_t*)(ws + WS_CTL + WS_RS) + (size_t)(i) * R)
#define GPERM_ ((float*)(ws + WS_RSTD + 512 * 1024))
#define WB_(off) ((bf16_t*)(ws + WS_WB + (off)))
#define OUT_ (args.out)
#define LAMBDA_INIT(ly) ((ly) == 0 ? 0.2f : (0.8f - 0.6f * 0.7408182206817179f))

#pragma unroll
    for (int layer = 0; layer < 2; ++layer) {
        const int pb = layer * PH_PER_LAYER;
        if (((PHMASK >> 0) & 1) && IN(pb + 0)) {
            PH_BEGIN;
            for (int rep_ = 0; rep_ < NREP(0); ++rep_) { if (rep_) GRID_BAR();
            const float* meta = arg_in(args, 1);
            conv_matrix<1>(F, arg_in(args, 3) + (size_t)ly * DM * D_IN, DM, D_IN, WB_(WB_IN), arg_in(args, 2) + ly * DM);
            conv_matrix<0>(F, arg_in(args, 7) + (size_t)ly * 512 * 1536, 512, 1536, WB_(WB_QUP), arg_in(args, 5) + ly * 512);
            conv_matrix<0>(F, arg_in(args, 8) + (size_t)ly * 512 * 2048, 512, 2048, WB_(WB_KVUP), arg_in(args, 6) + ly * 512);
            for (int b = 0; b < 3; ++b) conv_matrix<0>(F, arg_in(args, 14) + ((size_t)ly * 3 + b) * 1024 * DM, 1024, DM, WB_(WB_BR) + (size_t)b * DM * 1024, nullptr);
            conv_matrix<0>(F, arg_in(args, 15) + (size_t)ly * DM * DM, DM, DM, WB_(WB_O), nullptr);
            conv_matrix<2>(F, arg_in(args, 17) + (size_t)ly * DM * 2 * DFF, DM, 2 * DFF, WB_(WB_F1), arg_in(args, 16) + ly * DM);
            conv_matrix<0>(F, arg_in(args, 18) + (size_t)ly * DFF * DM, DFF, DM, WB_(WB_F2), nullptr);
            unsigned zu = 0u; asm volatile("" : "+v"(zu)); const float zf = __uint_as_float(zu);
            for (int i = F.gw * 64 + F.lane; i < 112 * 2048 / 8; i += F.ngw * 64) *((u32x4*)(WB_(WB_IN) + (size_t)1168 * 2048) + i) = (u32x4){zu, zu, zu, zu};
            if (F.bid == 0) { const int i = F.tid; const int t = i >> 7, ps = i & 127, dim = (ps >> 1) + 64 * (ps & 1);
                const float* gsrc = (t < 2 ? arg_in(args, 10) : arg_in(args, 11)) + ly * 256 + (t & 1) * 128; GPERM_[i] = gsrc[dim]; }
            float* hmeta = HMETA_;
            if (ly == 0) {
                for (int i = F.gw * 64 + F.lane; i < MROW0 * PW / 8; i += F.ngw * 64) *((u32x4*)P_ + i) = (u32x4){zu, zu, zu, zu};
                for (int i = F.gw * 64 + F.lane; i < MBLK * DM / 4; i += F.ngw * 64) { const int rr = i / (DM / 4); f32x4 v = (f32x4){zf, zf, zf, zf};
                    if (rr >= MBLK - NMETA) v = *((const f32x4*)meta + (i - (MBLK - NMETA) * (DM / 4))); *((f32x4*)hmeta + i) = v; }
            }
            if (ly == 0) {
                const float* xin = arg_in(args, 0); bf16_t* XN = XN_; rs_t* rs0 = RS_(0);
                for (int r = MROW0 + F.gw; r < R; r += F.ngw)
                    norm_row(r < MBLK ? meta + (size_t)(r - MROW0) * DM : xin + (size_t)(r - MBLK) * DM, XN + (size_t)r * DM, rs0 + r, F.lane);
            }
            }
            SEAM(pb + 0);
        }
        if (((PHMASK >> 1) & 1) && IN(pb + 1)) {
            PH_BEGIN;
            { SkP f{P_, 0, RS_(2 * ly)}; skinny_gemm(F.lds, XN_ + (size_t)MROW0 * DM, DM, WB_(WB_IN), DM, 1280 / 16, F.bid, F.G, f); }
            SchedPlain S{XN_, DM, WB_(WB_IN), DM, NPMM, 5, F.G, F.bid, 0}; EpiP E{P_, RS_(2 * ly)};
            pg8::gemm_phase(F.lds, S, E);
            if (NREP(1) == 2) { GRID_BAR(); pg8::gemm_phase(F.lds, S, E); }
            SEAM(pb + 1);
        }
        if (((PHMASK >> 2) & 1) && IN(pb + 2)) {
            PH_BEGIN;
            { bf16_t* P = P_; float* rq = RSTDQ_; float* rkv = RSTDKV_;
              for (int r = MROW0 + F.gw; r < R; r += F.ngw) post1a_row(P, r, rq, rkv, F.lane); }
            VM_WAIT(); __syncthreads();
            { SkP f{P_, C_QRAW, nullptr}; skinny_gemm(F.lds, P_ + (size_t)MROW0 * PW + C_CQ, PW, WB_(WB_QUP), 512, 1536 / 16, F.bid, F.G, f); }
            { SkP f{P_, C_KVRAW, nullptr}; skinny_gemm(F.lds, P_ + (size_t)MROW0 * PW + C_CKV, PW, WB_(WB_KVUP), 512, 2048 / 16, F.bid, F.G, f); }
            SchedMlaUp S{P_, WB_(WB_QUP), WB_(WB_KVUP), F.G, F.bid}; EpiP E{P_, nullptr};
            pg8::gemm_phase(F.lds, S, E);
            if (NREP(2) == 2) { GRID_BAR(); pg8::gemm_phase(F.lds, S, E); }
            SEAM(pb + 2);
        }
        if (((PHMASK >> 3) & 1) && IN(pb + 3)) {
            PH_BEGIN;
            const float* mla_qkg = arg_in(args, 9) + ly * 2 * 192;
            bf16_t* P = P_; float* rq = RSTDQ_; float* rkv = RSTDKV_;
            LAS float* rnl = (LAS float*)(F.lds + F.wave * 64);
            for (int r = MROW0 + F.gw; r < R; r += F.ngw) post2_row(P, r, rq, rkv, mla_qkg, rnl, F.lane);
            SEAM(pb + 3);
        }
        if (((PHMASK >> 4) & 1) && IN(pb + 4)) {
            PH_BEGIN;
            bf16_t* P = P_;
            LAS int* slot = (LAS int*)(F.lds + LDSCTL_OFF + 128);
            for (int rep_ = 0; rep_ < NREP(4); ++rep_) { if (rep_) GRID_BAR();
            unsigned* ctr = (unsigned*)(ws + WS_CTL) + CW_Q + 64 * (ly * 4 + 0) + 64 * 16 * rep_;
            const bool stat = (F.G == 256); const int sx = F.bid & 7, spl = (F.bid >> 3) >> 2, sj = (F.bid >> 3) & 3;
            if (!stat) fa::queue_prime(ctr, slot);
            for (int qk_ = 0;; ++qk_) {
                int idx;
                if (stat) { if (qk_ < 4) { const int pr = sx + 8 * (spl + 8 * (qk_ >> 1)), qb = (qk_ & 1) ? sj : 7 - sj; idx = (7 - qb) * 128 + pr; } else idx = (qk_ == 4 && F.bid < 8) ? 1024 + F.bid : 1 << 30; }
                else idx = fa::queue_next(ctr, slot, qk_);
                if (idx >= 8 * 129) break;
                int h; fa::Item it;
                if (idx < 1024) { const int qb = 7 - (idx >> 7), rest = idx & 127; h = rest & 7; it = fa::make_item(false, rest >> 3, qb); } else { h = idx - 1024; it = fa::make_item(true, 0, 0); }
                bf16x8 qr[12]; fa::load_q<192>(P, it, C_QRAW + h * 192, qr);
                fa::attn_core<192, 128, false>(P, it, qr, C_KVRAW + h * 256, C_KPEH + h * 64, C_KVRAW + h * 256 + 128, C_OA + h * 128, 0, nullptr, F.lds);
            } }
            SEAM(pb + 4);
        }
        if (((PHMASK >> 5) & 1) && IN(pb + 5)) {
            PH_BEGIN;
            { SkP f{P_, 1280, RS_(2 * ly)}; skinny_gemm(F.lds, XN_ + (size_t)MROW0 * DM, DM, WB_(WB_IN) + (size_t)1280 * DM, DM, 7168 / 16, F.bid, F.G, f); }
            SchedPlain S{XN_, DM, WB_(WB_IN) + (size_t)1280 * DM, DM, NPMM, 28, F.G, F.bid, 1280}; EpiG2 E{P_, RS_(2 * ly), GPERM_, (LAS float*)(F.lds + RING_BYTES)};
            pg8::gemm_phase(F.lds, S, E);
            if (NREP(5) == 2) { GRID_BAR(); pg8::gemm_phase(F.lds, S, E); }
            SEAM(pb + 5);
        }
        if (((PHMASK >> 6) & 1) && IN(pb + 6)) {
            PH_BEGIN;
            bf16_t* P = P_; const float* gp = GPERM_;
            if (F.gw < NMETA) meta_post_row(P, MROW0 + F.gw, gp, F.lane);
        }
        if (((PHMASK >> 7) & 1) && IN(pb + 7)) {
            PH_BEGIN;
            bf16_t* P = P_; unsigned* bm = BM_;
            unsigned* ctr = (unsigned*)(ws + WS_CTL) + CW_Q + 64 * (ly * 4 + 2);
            LAS int* slot = (LAS int*)(F.lds + LDSCTL_OFF + 128);
            for (int rep_ = 0; rep_ < NREP(7); ++rep_) { if (rep_) GRID_BAR(); unsigned* c2 = ctr + 64 * 16 * rep_;
            for (;;) { const int idx = fa::next_item(c2, slot); if (idx >= NTOK / 8) break; index_unit(P, idx, bm, F.lds); } }
            SEAM(pb + 7);
        }
        if (((PHMASK >> 8) & 1) && IN(pb + 8)) {
            PH_BEGIN;
            bf16_t* P = P_; unsigned* bm = BM_;
            LAS int* slot = (LAS int*)(F.lds + LDSCTL_OFF + 128);
            for (int rep_ = 0; rep_ < NREP(8); ++rep_) { if (rep_) GRID_BAR();
            const bool dummy = (NREP(8) == 2) && rep_ == 0;
            unsigned* ctr = (unsigned*)(ws + WS_CTL) + CW_Q + 64 * (ly * 4 + 1) + 64 * 16 * rep_;
            const bool stat = (F.G == 256); const int sx = F.bid & 7, spl = (F.bid >> 3) >> 2, sj = (F.bid >> 3) & 3;
            if (!stat) fa::queue_prime(ctr, slot);
            for (int qk_ = 0;; ++qk_) {
                int idx;
                if (stat) { if (qk_ < 8) { const int pr = sx + 8 * (spl + 8 * ((qk_ >> 1) & 1)), qb = (qk_ & 1) ? sj : 7 - sj; idx = (7 - qb) * 256 + ((qk_ >> 2) ? 128 : 0) + pr; } else idx = (qk_ == 8 && F.bid < 16) ? 2048 + F.bid : 1 << 30; }
                else idx = fa::queue_next(ctr, slot, qk_);
                if (idx >= 16 * 129) break;
                int hh; bool meta = false; fa::Item it; int b = 0, qb = 0;
                if (idx < 2048) { qb = 7 - (idx >> 8); const int rest = idx & 255; hh = (rest < 128) ? 8 + (rest & 7) : (rest & 7); b = (rest & 127) >> 3; it = fa::make_item(false, b, qb); }
                else { hh = idx - 2048; hh = hh < 8 ? 8 + hh : hh - 8; meta = true; it = fa::make_item(true, 0, 0); }
                if (hh < 8) {
                    bf16x8 qr[8]; fa::load_q<128>(P, it, C_DQ + hh * 128, qr);
                    fa::attn_core<128, 128, true>(P, it, qr, C_DK + hh * 128, 0, C_DV + hh * 128, dummy ? C_KPE : C_OB + hh * 128, 0, meta ? nullptr : bm + (size_t)(b * SEQ + qb * 256) * BMW, F.lds);
                } else {
                    const int hj = hh - 8;
                    bf16x8 qr[8]; fa::load_q<128>(P, it, C_FQ + hj * 128, qr);
                    fa::attn_core<128, 256, false>(P, it, qr, C_FK + hj * 128, 0, C_FV + (hj >> 1) * 256, dummy ? C_KPE : C_FQ + hj * 128, dummy ? C_KPE : C_IQ + hj * 128, nullptr, F.lds);
                }
            } }
            SEAM(pb + 8);
        }
        if (((PHMASK >> 9) & 1) && IN(pb + 9)) {
            PH_BEGIN;
            const float* diff_lam = arg_in(args, 12) + ly * 4 * 128; const float* diff_subg = arg_in(args, 13) + ly * 256;
            const float lambda_init = LAMBDA_INIT(ly);
            const float s1 = wave_sum(diff_lam[F.lane] * diff_lam[128 + F.lane] + diff_lam[64 + F.lane] * diff_lam[192 + F.lane]);
            const float s2 = wave_sum(diff_lam[256 + F.lane] * diff_lam[384 + F.lane] + diff_lam[320 + F.lane] * diff_lam[448 + F.lane]);
            const float lam = __expf(s1) - __expf(s2) + lambda_init;
            bf16_t* P = P_;
            for (int r = MROW0 + F.gw; r < R; r += F.ngw) post3_row(P, r, diff_subg, lam, 1.f - lambda_init, F.lane);
        }
#define GATE_PHASE(k, b, sk, seam) \
        if (((PHMASK >> 10) & 1) && IN(pb + (k))) { \
            PH_BEGIN; \
            { SkGate f{(bf16_t*)(ws + WS_GS), arg_in(args, 4) + ly * 3 * DM + (b) * DM, RS_(2 * ly)}; skinny_gemm(F.lds, XN_ + (size_t)MROW0 * DM, DM, WB_(WB_G) + (size_t)(b) * 2048 * DM, DM, 2048 / 16, (F.bid + (sk)) % F.G, F.G, f); } \
            SchedPlain S{XN_, DM, WB_(WB_G) + (size_t)(b) * 2048 * DM, DM, NPMM, 8, F.G, F.bid, 0}; EpiGate E{(bf16_t*)(ws + WS_GS), arg_in(args, 4) + ly * 3 * DM + (b) * DM, RS_(2 * ly)}; \
            pg8::gemm_phase(F.lds, S, E); \
            if (NREP(k) == 2) { GRID_BAR(); pg8::gemm_phase(F.lds, S, E); } \
            if (seam) SEAM(pb + (k)); \
        }
#define BRANCH_PHASE(k, b, oc, sk, seam) \
        if (((PHMASK >> 10) & 1) && IN(pb + (k))) { \
            PH_BEGIN; \
            { SkGated f{P_, (const bf16_t*)(ws + WS_GS), (b) == 0 ? 1 : 0}; skinny_gemm(F.lds, P_ + (size_t)MROW0 * PW + (oc), PW, WB_(WB_BR) + (size_t)(b) * DM * 1024, 1024, 2048 / 16, (F.bid + (sk)) % F.G, F.G, f); } \
            SchedPlain S{P_ + (oc), PW, WB_(WB_BR) + (size_t)(b) * DM * 1024, 1024, NPMM, 8, F.G, F.bid, C_MERGED}; EpiGated E{P_, (const bf16_t*)(ws + WS_GS), (b) == 0 ? 1 : 0, ((DBG_BM >> (b)) & 1) ? 1.f : 0.f}; \
            pg8::gemm_phase(F.lds, S, E); \
            if (NREP(k) == 2 && (b) == 0) { GRID_BAR(); pg8::gemm_phase(F.lds, S, E); } \
            if (seam) SEAM(pb + (k)); \
        }
        GATE_PHASE(10, 0, 0, 0) BRANCH_PHASE(11, 0, C_OA, 0, 0)
        GATE_PHASE(12, 1, 0, 0) BRANCH_PHASE(13, 1, C_OB, 0, 0)
        GATE_PHASE(14, 2, 0, 1) BRANCH_PHASE(15, 2, C_OC, 128, 1)
        if (((PHMASK >> 11) & 1) && IN(pb + 16)) {
            PH_BEGIN;
            { SkRes f{HMETA_, XN_, RS_(2 * ly + 1)}; skinny_gemm(F.lds, P_ + (size_t)MROW0 * PW + C_MERGED, PW, WB_(WB_O), DM, 2048 / 16, F.bid, F.G, f); }
            SchedPlain S{P_ + C_MERGED, PW, WB_(WB_O), DM, NPMM, 8, F.G, F.bid, 0}; EpiRes E{(float*)nullptr, DBG_SA, XN_, RS_(2 * ly + 1)};
            pg8::gemm_phase(F.lds, S, E);
            SEAM(pb + 16);
        }
        if (((PHMASK >> 13) & 1) && IN(pb + 17)) {
            PH_BEGIN;
            skinny_swiglu(F.lds, XN_ + (size_t)MROW0 * DM, DM, WB_(WB_F1), DM, P_, RS_(2 * ly + 1), F.bid, F.G);
            SchedPlain S{XN_, DM, WB_(WB_F1), DM, NPMM, 44, F.G, F.bid, 0}; EpiSwiglu E{P_, RS_(2 * ly + 1)};
            pg8::gemm_phase(F.lds, S, E);
            if (NREP(17) == 2) { GRID_BAR(); pg8::gemm_phase(F.lds, S, E); }
            SEAM(pb + 17);
        }
        if (((PHMASK >> 14) & 1) && IN(pb + 18)) {
            PH_BEGIN;
            { SkRes f{HMETA_, ly == 0 ? XN_ : (bf16_t*)nullptr, RS_(2)}; skinny_gemm(F.lds, P_ + (size_t)MROW0 * PW, PW, WB_(WB_F2), DFF, 2048 / 16, F.bid, F.G, f); }
            SchedPlain S{P_, PW, WB_(WB_F2), DFF, NPMM, 8, F.G, F.bid, 0}; EpiRes E{ly == 0 ? (float*)nullptr : OUT_, DBG_SF, XN_, RS_(2)};
            pg8::gemm_phase(F.lds, S, E);
            SEAM(pb + 18);
        }
    }
#undef IN
#undef SEAM
}

__global__ void diag_fill(float* out, int n, float v) { for (int i = blockIdx.x * blockDim.x + threadIdx.x; i < n; i += gridDim.x * blockDim.x) out[i] = v; }
extern "C" void kernel_launch(void* const* d_in, const int* in_sizes, int n_in, void* d_out, int out_size, void* d_ws, size_t ws_size, hipStream_t stream) {
    static int grid = 0; static float code = 0.f;
    if (grid == 0) {
        int dev = 0, cus = 0;
        if (n_in != 19) { code = 10.f; grid = -1; }
        else if (ws_size < WS_END) { code = 20.f + (float)(ws_size >> 20) * 0.01f; grid = -1; }
        else if (hipGetDevice(&dev) != hipSuccess || hipDeviceGetAttribute(&cus, hipDeviceAttributeMultiprocessorCount, dev) != hipSuccess) { code = 40.f; grid = -1; }
        else if (hipFuncSetAttribute((const void*)mega_fwd, hipFuncAttributeMaxDynamicSharedMemorySize, LDS_BYTES) != hipSuccess) { code = 50.f; grid = -1; }
        else {
            int per_cu = 0;
            if (hipOccupancyMaxActiveBlocksPerMultiprocessor(&per_cu, (const void*)mega_fwd, NWAVES * 64, LDS_BYTES) != hipSuccess || per_cu < 1) { code = 60.f; grid = -1; }
            (void)hipGetLastError();
            if (grid == 0) grid = cus;
        }
    }
    if (grid < 0) { hipLaunchKernelGGL(diag_fill, dim3(1024), dim3(256), 0, stream, (float*)d_out, out_size, code); return; }
    (void)hipMemsetAsync((char*)d_ws + WS_CTL, 0, CTL_BYTES, stream);
    Args a{};
    for (int i = 0; i < 19; ++i) a.in[i] = (const float*)d_in[i];
    a.out = (float*)d_out; a.ws = (unsigned char*)d_ws;
#if MK_ONE_LAUNCH
    a.ph_lo = 0; a.ph_hi = N_PHASES;
    hipLaunchKernelGGL(mega_fwd, dim3(grid), dim3(NWAVES * 64), LDS_BYTES, stream, a);
#else
    for (int p = 0; p < N_PHASES; ++p) { a.ph_lo = p; a.ph_hi = p + 1; hipLaunchKernelGGL(mega_fwd, dim3(grid), dim3(NWAVES * 64), LDS_BYTES, stream, a); }
#endif
    if (hipPeekAtLastError() != hipSuccess) { (void)hipGetLastError(); hipLaunchKernelGGL(diag_fill, dim3(1024), dim3(256), 0, stream, (float*)d_out, out_size, 70.f); }
}
```

```cpp
#include <hip/hip_runtime.h>
#include <cstdio>
#include <cstdint>

#ifndef PHMASK
#define PHMASK 0x7fff
#endif
#ifndef REPMASK
#define REPMASK 0
#endif
#define NREP(k) ((((REPMASK) >> (k)) & 1) ? 2 : 1)
#ifndef DBG_BM
#define DBG_BM 7
#endif
#ifndef DBG_BR
#define DBG_BR 0
#endif
#ifndef DBG_SA
#define DBG_SA 1.0f
#endif
#ifndef DBG_SF
#define DBG_SF 1.0f
#endif
#ifndef MK_ONE_LAUNCH
#define MK_ONE_LAUNCH 1
#endif

#define LAS __attribute__((address_space(3)))
#define GAS __attribute__((address_space(1)))
typedef unsigned short bf16_t;
typedef short bf16x8 __attribute__((ext_vector_type(8)));
typedef float f32x4 __attribute__((ext_vector_type(4)));
typedef float f32x2 __attribute__((ext_vector_type(2)));
typedef unsigned u32x4 __attribute__((ext_vector_type(4)));
typedef unsigned u32x2 __attribute__((ext_vector_type(2)));
typedef unsigned long long rs_t;
__device__ __forceinline__ float rs_val(rs_t v) { return (float)((double)v * (1.0 / 4294967296.0)); }
__device__ __forceinline__ rs_t rs_fix(float ss) { return (rs_t)((double)ss * 4294967296.0); }
__device__ __forceinline__ void st_wt(void* p, u32x4 v) { typedef __attribute__((address_space(1))) u32x4 gv; *(gv*)(unsigned long long)p = v; }
__device__ __forceinline__ void st_wt(void* p, f32x4 v) { typedef __attribute__((address_space(1))) f32x4 gv; *(gv*)(unsigned long long)p = v; }

constexpr int DM = 2048, NB = 16, SEQ = 2048, NMETA = 16, MBLK = 256;
constexpr int R = MBLK + NB * SEQ;
constexpr int NPM = R / 256;
constexpr int NPMM = NPM - 1;
constexpr int MROW0 = MBLK - NMETA;
constexpr int NTOK = NB * SEQ;
constexpr int DFF = 5632;
constexpr int PW = 8448;
constexpr int C_CQ = 0, C_CKV = 512, C_KPE = 1024, C_IK = 1088, C_IW = 1152, C_DQ = 1280, C_DK = 2304, C_DV = 3328, C_IQ = 4352,
              C_FQ = 5376, C_FK = 6400, C_FV = 7424;
constexpr int C_KVRAW = 1280, C_QRAW = 3328, C_KPEH = 4864;
constexpr int C_OA = 0, C_OB = C_DQ, C_OC = C_FQ, C_MERGED = 2304;
constexpr int BMW = 66;
constexpr float EPS = 1e-6f;
constexpr float LOG2E = 1.4426950408889634f;
constexpr float C2_128 = 0.08838834764831845f * LOG2E;
constexpr float C2_192 = 0.07216878364870323f * LOG2E;
constexpr int D_IN = 14480;

constexpr size_t MiB = 1u << 20;
constexpr size_t WS_CTL = 0, CTL_BYTES = 2816 * 1024;
constexpr size_t WS_RSTD = 13 * MiB;
constexpr size_t WS_HMETA = 14 * MiB;
constexpr size_t WS_BM = 4 * MiB;
constexpr size_t WS_WB = 16 * MiB;
constexpr size_t WB_IN = 0, WB_G = WB_IN + (size_t)8448 * 2048 * 2, WB_QUP = WB_G + (size_t)6144 * 2048 * 2, WB_KVUP = WB_QUP + (size_t)1536 * 512 * 2,
                 WB_BR = WB_KVUP + (size_t)2048 * 512 * 2, WB_O = WB_BR + (size_t)3 * 2048 * 1024 * 2, WB_F1 = WB_O + (size_t)2048 * 2048 * 2,
                 WB_F2 = WB_F1 + (size_t)11264 * 2048 * 2, WB_END = WB_F2 + (size_t)2048 * 5632 * 2;
constexpr size_t WS_XN = 164 * MiB;
constexpr size_t WS_P = 294 * MiB;
constexpr size_t WS_GS = 828 * MiB;
constexpr size_t WS_END = 960 * MiB;
static_assert(WS_GS + (size_t)R * 2048 * 2 <= WS_END && WS_WB + WB_END <= WS_XN && WS_XN + (size_t)R * 2048 * 2 <= WS_P && WS_P + (size_t)R * PW * 2 <= WS_GS, "ws map");
constexpr int CW_BAR = 4096, CW_Q = 16384;
constexpr size_t WS_RS = 256 * 1024;
constexpr size_t WS_RS2 = 1536 * 1024;
static_assert(WS_RS + (size_t)4 * R * 8 <= WS_RS2 && WS_RS2 + (size_t)4 * R * 8 <= CTL_BYTES && CTL_BYTES <= WS_BM && WS_BM + (size_t)32768 * BMW * 4 <= WS_RSTD && WS_RSTD + 1 * MiB <= WS_HMETA && WS_HMETA + 2 * MiB <= WS_WB, "ctl map");

__device__ __forceinline__ float bf2f(bf16_t v) { return __uint_as_float((unsigned)v << 16); }
__device__ __forceinline__ unsigned f2bf(float f) { unsigned u = __float_as_uint(f); return (u + 0x7fffu + ((u >> 16) & 1u)) >> 16; }
__device__ __forceinline__ unsigned pk2(float lo, float hi) { return f2bf(lo) | (f2bf(hi) << 16); }
typedef __bf16 bf16x2_t __attribute__((ext_vector_type(2)));
__device__ __forceinline__ unsigned cvt_pk_bf16(float lo, float hi) { f32x2 v = {lo, hi}; bf16x2_t b = __builtin_convertvector(v, bf16x2_t); return __builtin_bit_cast(unsigned, b); }
__device__ __forceinline__ float wave_sum(float v) {
#pragma unroll
    for (int o = 1; o < 64; o <<= 1) v += __shfl_xor(v, o);
    return v;
}
__device__ __forceinline__ float wave_max(float v) {
#pragma unroll
    for (int o = 1; o < 64; o <<= 1) v = fmaxf(v, __shfl_xor(v, o));
    return v;
}
#define LDS_WAIT() asm volatile("s_waitcnt lgkmcnt(0)" ::: "memory")
#define VM_WAIT() asm volatile("s_waitcnt vmcnt(0)" ::: "memory")
__device__ __forceinline__ int row_pos(int r) { return r < MBLK ? (r >= MBLK - NMETA ? r - (MBLK - NMETA) : 0) : NMETA + ((r - MBLK) & (SEQ - 1)); }
__device__ __forceinline__ void rope_cs(int pos, int i, float two_over_d, float& c, float& s) {
    const float inv = __builtin_amdgcn_exp2f(-(float)i * two_over_d * 13.287712379549449f);
    float rev = (float)pos * inv * 0.15915494309189535f;
    rev -= floorf(rev);
    s = __builtin_amdgcn_sinf(rev); c = __builtin_amdgcn_cosf(rev);
}

namespace pg8 {
constexpr int BM = 256, BK = 64, HALF = 128, HTB = HALF * BK * 2, STAGE_BYTES = 8 * HTB;
__device__ __forceinline__ int lds_byte(int r, int c) { const int st = (r >> 4) * 2 + (c >> 5), rr = r & 15, cc = c & 31, ob = rr * 64 + cc * 2; return st * 1024 + (ob ^ (((ob >> 9) & 1) << 5)); }
__device__ __forceinline__ void stage_rc(int b, int& R_, int& C_) { const int st = b / 1024, sb = b % 1024, swz = sb ^ (((sb >> 9) & 1) << 5); R_ = (st >> 1) * 16 + swz / 64; C_ = (st & 1) * 32 + (swz % 64) / 2; }
__device__ __forceinline__ int perm32(int rho) { const int n = rho >> 4, i = rho & 15; return 8 * (i >> 2) + 4 * n + (i & 3); }

struct Unit { const char* A; const char* B; unsigned lda2, ldb2; int nt, pm, pn, kind, ocol; };

#ifndef WGM
#define WGM 4
#endif
__device__ __forceinline__ void tile_of(int L, int nM, int nN, int& pm, int& pn) {
    const int nwg = nM * nN; int wgid = L;
    { const int q = nwg / 8, r = nwg % 8, xcd = wgid % 8, off = wgid / 8; wgid = (xcd < r ? xcd * (q + 1) : r * (q + 1) + (xcd - r) * q) + off; }
    const int nig = WGM * nN, gid = wgid / nig, fm = gid * WGM, gsz = (nM - fm) < WGM ? (nM - fm) : WGM;
    pm = fm + ((wgid % nig) % gsz); pn = (wgid % nig) / gsz;
}

template <class Epi, class Sched>
__device__ __forceinline__ void gemm_phase(LAS unsigned char* lds, const Sched& S, const Epi& E) {
    int tid = threadIdx.x; asm volatile("" : "+v"(tid));
    const int wid = __builtin_amdgcn_readfirstlane(tid >> 6), lane = tid & 63, wr = wid >> 2, wc = wid & 3, fr = lane & 15, fq = lane >> 4;
    unsigned rA[2], rB[2], cc[2];
#pragma unroll
    for (int i = 0; i < 2; ++i) { int R_, C_; stage_rc(tid * 16 + i * 8192, R_, C_); rA[i] = (unsigned)R_; rB[i] = (unsigned)(Epi::PERM ? ((R_ & ~31) + perm32(R_ & 31)) : R_); cc[i] = (unsigned)C_ * 2u; }
    const size_t kstep = (size_t)(BK * 2);
    const unsigned ldsw = (unsigned)wid * 1024u;
    const int aoff = lds_byte(wr * 64 + fr, fq * 8), boff = lds_byte(wc * 32 + fr, fq * 8);
#define PG8_SA(b, h) (((b) * 2 + (h)) * HTB)
#define PG8_SB(b, h) ((4 + (b) * 2 + (h)) * HTB)
#define PG8_STAGE(bufoff, gbase, rr, ld2) do { _Pragma("unroll") for (int _i = 0; _i < 2; ++_i) \
        __builtin_amdgcn_global_load_lds((const unsigned*)((const char*)(gbase) + ((rr)[_i] * (ld2) + cc[_i])), (LAS unsigned*)(lds + (bufoff) + ldsw + _i * 8192), 16, 0, 0); } while (0)
#define PG8_LDA(dst, b, h) do { _Pragma("unroll") for (int m = 0; m < 4; ++m) _Pragma("unroll") for (int k = 0; k < 2; ++k) dst[m][k] = *(const LAS bf16x8*)(lds + PG8_SA(b, h) + aoff + m * 2048 + k * 1024); } while (0)
#define PG8_LDB(dst, b, h) do { _Pragma("unroll") for (int n = 0; n < 2; ++n) _Pragma("unroll") for (int k = 0; k < 2; ++k) dst[n][k] = *(const LAS bf16x8*)(lds + PG8_SB(b, h) + boff + n * 2048 + k * 1024); } while (0)
#define PG8_MMA(ai, bj, At, Bt) do { __builtin_amdgcn_s_setprio(1); _Pragma("unroll") for (int m = 0; m < 4; ++m) _Pragma("unroll") for (int n = 0; n < 2; ++n) _Pragma("unroll") for (int k = 0; k < 2; ++k) \
        acc[ai][bj][m][n] = __builtin_amdgcn_mfma_f32_16x16x32_bf16(Bt[n][k], At[m][k], acc[ai][bj][m][n], 0, 0, 0); __builtin_amdgcn_s_setprio(0); } while (0)
#define PG8_WAIT_V(n) asm volatile("s_waitcnt vmcnt(" #n ")" ::: "memory")
#define PG8_WAIT_L(n) asm volatile("s_waitcnt lgkmcnt(" #n ")" ::: "memory")
#define PG8_BAR __builtin_amdgcn_s_barrier()
#define PG8_SCHED __builtin_amdgcn_sched_barrier(0)
    Unit cur, nxt; int ui = 0;
    if (!S.next(0, cur)) return;
    float zf = 0.f; asm volatile("" : "+v"(zf));
    f32x4 acc[2][2][4][2];
#pragma unroll
    for (int a = 0; a < 2; ++a)
#pragma unroll
        for (int b = 0; b < 2; ++b)
#pragma unroll
            for (int m = 0; m < 4; ++m)
#pragma unroll
                for (int n = 0; n < 2; ++n) acc[a][b][m][n] = (f32x4){zf, zf, zf, zf};
    bf16x8 At[4][2], B0[2][2], B1[2][2];
    const char* cA = cur.A; const char* cB = cur.B;
    unsigned lA = cur.lda2, lB = cur.ldb2;
    size_t hA = (size_t)HALF * lA, hB = (size_t)HALF * lB;
    PG8_STAGE(PG8_SB(0, 0), cB, rB, lB); PG8_STAGE(PG8_SB(0, 1), cB + hB, rB, lB); PG8_STAGE(PG8_SA(0, 0), cA, rA, lA); PG8_STAGE(PG8_SA(0, 1), cA + hA, rA, lA);
    if (wr == 1) PG8_BAR;
    PG8_WAIT_V(2); PG8_BAR;
    PG8_STAGE(PG8_SB(1, 0), cB + kstep, rB, lB); PG8_STAGE(PG8_SA(1, 0), cA + kstep, rA, lA); PG8_STAGE(PG8_SB(1, 1), cB + hB + kstep, rB, lB);
    PG8_WAIT_V(6); PG8_BAR;
    for (;;) {
        const bool has_next = S.next(ui + 1, nxt);
        if (!has_next) nxt = cur;
        const char* nA = nxt.A; const char* nB = nxt.B;
        const unsigned lAn = nxt.lda2, lBn = nxt.ldb2;
        const size_t hAn = (size_t)HALF * lAn, hBn = (size_t)HALF * lBn;
        const int nt = cur.nt;
        for (int t = 0; t < nt; t += 2) {
            const bool last = (t == nt - 2);
            const char* a1 = cA + (size_t)(t + 1) * kstep;
            const char* a2 = last ? nA : cA + (size_t)(t + 2) * kstep; const char* b2 = last ? nB : cB + (size_t)(t + 2) * kstep;
            const char* a3 = a2 + kstep; const char* b3 = b2 + kstep;
            const size_t hA2 = last ? hAn : hA, hB2 = last ? hBn : hB;
            const unsigned lA2 = last ? lAn : lA, lB2 = last ? lBn : lB;
            PG8_LDB(B0, 0, 0); PG8_LDB(B1, 0, 1); PG8_SCHED; PG8_LDA(At, 0, 0); PG8_STAGE(PG8_SA(1, 1), a1 + hA, rA, lA);
            PG8_WAIT_V(8); PG8_WAIT_L(0); PG8_BAR; PG8_MMA(0, 0, At, B0); PG8_MMA(0, 1, At, B1); PG8_BAR; PG8_SCHED;
            PG8_LDA(At, 0, 1); PG8_STAGE(PG8_SB(0, 0), b2, rB, lB2); PG8_STAGE(PG8_SB(0, 1), b2 + hB2, rB, lB2); PG8_STAGE(PG8_SA(0, 0), a2, rA, lA2);
            PG8_WAIT_V(8); PG8_WAIT_L(0); PG8_BAR; PG8_MMA(1, 0, At, B0); PG8_MMA(1, 1, At, B1); PG8_BAR; PG8_SCHED;
            PG8_LDB(B0, 1, 0); PG8_LDB(B1, 1, 1); PG8_SCHED; PG8_LDA(At, 1, 0); PG8_STAGE(PG8_SA(0, 1), a2 + hA2, rA, lA2);
            PG8_WAIT_V(8); PG8_WAIT_L(0); PG8_BAR; PG8_MMA(0, 0, At, B0); PG8_MMA(0, 1, At, B1); PG8_BAR; PG8_SCHED;
            PG8_LDA(At, 1, 1); PG8_STAGE(PG8_SB(1, 0), b3, rB, lB2); PG8_STAGE(PG8_SB(1, 1), b3 + hB2, rB, lB2); PG8_STAGE(PG8_SA(1, 0), a3, rA, lA2);
            PG8_WAIT_V(8); PG8_WAIT_L(0); PG8_BAR; PG8_MMA(1, 0, At, B0); PG8_MMA(1, 1, At, B1); PG8_BAR; PG8_SCHED;
        }
        if (wr == 0) PG8_BAR;
        E(acc, cur, wr, wc, fr, fq);
#pragma unroll
        for (int a = 0; a < 2; ++a)
#pragma unroll
            for (int b = 0; b < 2; ++b)
#pragma unroll
                for (int m = 0; m < 4; ++m)
#pragma unroll
                    for (int n = 0; n < 2; ++n) acc[a][b][m][n] = (f32x4){zf, zf, zf, zf};
        if (!has_next) break;
        cur = nxt; cA = nA; cB = nB; hA = hAn; hB = hBn; lA = lAn; lB = lBn; ++ui;
        if (wr == 1) PG8_BAR;
    }
    PG8_WAIT_V(0);
    PG8_BAR;
#undef PG8_SA
#undef PG8_SB
#undef PG8_STAGE
#undef PG8_LDA
#undef PG8_LDB
#undef PG8_MMA
#undef PG8_WAIT_V
#undef PG8_WAIT_L
#undef PG8_BAR
#undef PG8_SCHED
}
}
using pg8::Unit;

struct SchedPlain {
    const bf16_t* A; int lda; const bf16_t* B; int K; int nM, nN, G, c, ocol0;
    __device__ __forceinline__ bool next(int i, Unit& u) const {
        const int L = i * G + c; if (L >= nM * nN) return false;
        int pm, pn; pg8::tile_of(L, nM, nN, pm, pn); pm += 1;
        u.pm = pm; u.pn = pn; u.kind = 0; u.ocol = ocol0 + 256 * pn; u.nt = K / 64; u.lda2 = (unsigned)lda * 2u; u.ldb2 = (unsigned)K * 2u;
        u.A = (const char*)(A + (size_t)pm * 256 * lda); u.B = (const char*)(B + (size_t)pn * 256 * K); return true;
    }
};
struct SchedMlaUp {
    const bf16_t* P; const bf16_t* Wq; const bf16_t* Wkv; int G, c;
    __device__ __forceinline__ bool next(int i, Unit& u) const {
        const int L = i * G + c; if (L >= NPMM * 14) return false;
        int pm, pn; pg8::tile_of(L, NPMM, 14, pm, pn); pm += 1;
        u.pm = pm; u.pn = pn; u.kind = 0; u.nt = 8; u.lda2 = PW * 2u; u.ldb2 = 512 * 2u;
        if (pn < 6) { u.A = (const char*)(P + (size_t)pm * 256 * PW + C_CQ); u.B = (const char*)(Wq + (size_t)pn * 256 * 512); u.ocol = C_QRAW + 256 * pn; }
        else { u.A = (const char*)(P + (size_t)pm * 256 * PW + C_CKV); u.B = (const char*)(Wkv + (size_t)(pn - 6) * 256 * 512); u.ocol = C_KVRAW + 256 * (pn - 6); }
        return true;
    }
};
struct EpiP {
    static constexpr bool PERM = true;
    bf16_t* P; const rs_t* rs; const rs_t* rs2; int split; float inv_dim; rs_t* sq; rs_t* skv;
    __device__ __forceinline__ void operator()(const f32x4 (&acc)[2][2][4][2], const Unit& u, int wr, int wc, int fr, int fq) const {
        asm volatile("" : "+v"(fr), "+v"(fq));
        const int row0 = u.pm * 256 + wr * 64 + fr, col0 = u.ocol + wc * 32 + 8 * fq;
        const rs_t* rsel = u.pn < split ? rs : rs2;
        rs_t* sums = (sq && u.pn < 4) ? (u.pn < 2 ? sq : skv) : (rs_t*)nullptr;
        float rsc[2][4];
#pragma unroll
        for (int ai = 0; ai < 2; ++ai)
#pragma unroll
            for (int m = 0; m < 4; ++m) rsc[ai][m] = rsel ? __builtin_amdgcn_rsqf(rs_val(rsel[row0 + ai * 128 + m * 16]) * inv_dim + EPS) : 1.f;
#pragma unroll
        for (int ai = 0; ai < 2; ++ai)
#pragma unroll
            for (int m = 0; m < 4; ++m) { const int row = row0 + ai * 128 + m * 16; bf16_t* rowp = P + (size_t)row * PW + col0;
                const float sc = rsc[ai][m]; float ss = 0.f;
#pragma unroll
                for (int bj = 0; bj < 2; ++bj) { const f32x4 v0 = acc[ai][bj][m][0] * sc, v1 = acc[ai][bj][m][1] * sc;
                    ss += ((v0[0] * v0[0] + v0[1] * v0[1]) + (v0[2] * v0[2] + v0[3] * v0[3])) + ((v1[0] * v1[0] + v1[1] * v1[1]) + (v1[2] * v1[2] + v1[3] * v1[3]));
                    u32x4 w; w.x = cvt_pk_bf16(v0[0], v0[1]); w.y = cvt_pk_bf16(v0[2], v0[3]); w.z = cvt_pk_bf16(v1[0], v1[1]); w.w = cvt_pk_bf16(v1[2], v1[3]);
                    st_wt(rowp + bj * 128, w); }
                if (sums) { ss += __shfl_xor(ss, 16); ss += __shfl_xor(ss, 32); if (fq == 0) (void)__hip_atomic_fetch_add(sums + row, rs_fix(ss), __ATOMIC_RELAXED, __HIP_MEMORY_SCOPE_AGENT); } }
    }
};
struct EpiG2 {
    static constexpr bool PERM = true;
    bf16_t* P; const rs_t* rs; const float* gperm; LAS float* xl;
    __device__ __forceinline__ void operator()(const f32x4 (&acc)[2][2][4][2], const Unit& u, int wr, int wc, int fr, int fq) const {
        asm volatile("" : "+v"(fr), "+v"(fq));
        const int row0 = u.pm * 256 + wr * 64 + fr, lcol = wc * 32 + 8 * fq, col0 = u.ocol + lcol;
        const int pn = u.pn;
        const bool plain = (pn >= 8 && pn < 12) || pn >= 24, isidx = (pn >= 12 && pn < 16), nrm = !plain && !isidx;
        const int gidx = pn < 4 ? 0 : (pn < 8 ? 1 : (pn < 20 ? 2 : 3));
        f32x4 g0 = (f32x4){1.f, 1.f, 1.f, 1.f}, g1 = g0;
        if (nrm) { g0 = *(const f32x4*)(gperm + gidx * 128 + lcol); g1 = *(const f32x4*)(gperm + gidx * 128 + lcol + 4); }
        float rsc[2][4];
#pragma unroll
        for (int ai = 0; ai < 2; ++ai)
#pragma unroll
            for (int m = 0; m < 4; ++m) rsc[ai][m] = __builtin_amdgcn_rsqf(rs_val(rs[row0 + ai * 128 + m * 16]) * (1.f / DM) + EPS);
        if (nrm) {
#pragma unroll
            for (int ai = 0; ai < 2; ++ai)
#pragma unroll
                for (int m = 0; m < 4; ++m)
#pragma unroll
                    for (int bj = 0; bj < 2; ++bj) { const f32x4 a = acc[ai][bj][m][0], b = acc[ai][bj][m][1]; float ss = (a[0] * a[0] + a[1] * a[1]) + (a[2] * a[2] + a[3] * a[3]) + (b[0] * b[0] + b[1] * b[1]) + (b[2] * b[2] + b[3] * b[3]);
                        ss += __shfl_xor(ss, 16); ss += __shfl_xor(ss, 32);
                        if (fq == 0) xl[((wr * 64 + fr + ai * 128 + m * 16) * 2 + bj) * 4 + wc] = ss * rsc[ai][m] * rsc[ai][m]; }
            asm volatile("s_waitcnt lgkmcnt(0)" ::: "memory"); __builtin_amdgcn_s_barrier(); asm volatile("" ::: "memory");
        }
        const int i0 = isidx ? (16 * (wc & 1) + 4 * fq) : (16 * wc + 4 * fq);
        const float tod = isidx ? (2.f / 64.f) : (2.f / 128.f);
        float inv[4];
#pragma unroll
        for (int j = 0; j < 4; ++j) inv[j] = __builtin_amdgcn_exp2f(-(float)(i0 + j) * tod * 13.287712379549449f) * 0.15915494309189535f;
        const float qscale = (pn < 4 || (pn >= 16 && pn < 20)) ? C2_128 : 1.f;
#pragma unroll
        for (int ai = 0; ai < 2; ++ai)
#pragma unroll
            for (int m = 0; m < 4; ++m) { const int row = row0 + ai * 128 + m * 16; bf16_t* rowp = P + (size_t)row * PW + col0;
                float cs[4], sn[4];
                if (!plain) { const float pos = (float)(NMETA + ((row - MBLK) & (SEQ - 1)));
#pragma unroll
                    for (int j = 0; j < 4; ++j) { float rev = pos * inv[j]; rev -= floorf(rev); sn[j] = __builtin_amdgcn_sinf(rev); cs[j] = __builtin_amdgcn_cosf(rev); } }
#pragma unroll
                for (int bj = 0; bj < 2; ++bj) { f32x4 v0 = acc[ai][bj][m][0] * rsc[ai][m], v1 = acc[ai][bj][m][1] * rsc[ai][m];
                    if (!plain) {
                        if (nrm) { const LAS f32x4* xp = (const LAS f32x4*)(xl + ((wr * 64 + fr + ai * 128 + m * 16) * 2 + bj) * 4); const f32x4 pp = *xp;
                            const float rn = __builtin_amdgcn_rsqf(((pp[0] + pp[1]) + (pp[2] + pp[3])) * (1.f / 128.f) + EPS); v0 = v0 * (g0 * rn); v1 = v1 * (g1 * rn); }
                        f32x4 w0, w1;
                        w0[0] = v0[0] * cs[0] - v0[1] * sn[0]; w0[1] = v0[1] * cs[0] + v0[0] * sn[0]; w0[2] = v0[2] * cs[1] - v0[3] * sn[1]; w0[3] = v0[3] * cs[1] + v0[2] * sn[1];
                        w1[0] = v1[0] * cs[2] - v1[1] * sn[2]; w1[1] = v1[1] * cs[2] + v1[0] * sn[2]; w1[2] = v1[2] * cs[3] - v1[3] * sn[3]; w1[3] = v1[3] * cs[3] + v1[2] * sn[3];
                        v0 = w0 * qscale; v1 = w1 * qscale; }
                    u32x4 w; w.x = cvt_pk_bf16(v0[0], v0[1]); w.y = cvt_pk_bf16(v0[2], v0[3]); w.z = cvt_pk_bf16(v1[0], v1[1]); w.w = cvt_pk_bf16(v1[2], v1[3]);
                    st_wt(rowp + bj * 128, w); } }
    }
};
struct EpiGate {
    static constexpr bool PERM = true;
    bf16_t* G; const float* bias; const rs_t* rs;
    __device__ __forceinline__ void operator()(const f32x4 (&acc)[2][2][4][2], const Unit& u, int wr, int wc, int fr, int fq) const {
        asm volatile("" : "+v"(fr), "+v"(fq));
        const int row0 = u.pm * 256 + wr * 64 + fr, col0 = u.pn * 256 + wc * 32 + 8 * fq;
        f32x4 bq[2][2];
#pragma unroll
        for (int bj = 0; bj < 2; ++bj) { bq[bj][0] = *(const f32x4*)(bias + col0 + bj * 128); bq[bj][1] = *(const f32x4*)(bias + col0 + bj * 128 + 4); }
        float rsc[2][4];
#pragma unroll
        for (int ai = 0; ai < 2; ++ai)
#pragma unroll
            for (int m = 0; m < 4; ++m) rsc[ai][m] = __builtin_amdgcn_rsqf(rs_val(rs[row0 + ai * 128 + m * 16]) * (1.f / DM) + EPS);
#pragma unroll
        for (int bj = 0; bj < 2; ++bj) { const f32x4 bv0 = bq[bj][0], bv1 = bq[bj][1];
#pragma unroll
            for (int ai = 0; ai < 2; ++ai)
#pragma unroll
                for (int m = 0; m < 4; ++m) { bf16_t* rowp = G + (size_t)(row0 + ai * 128 + m * 16) * 2048 + col0; f32x4 v0 = acc[ai][bj][m][0] * rsc[ai][m] + bv0, v1 = acc[ai][bj][m][1] * rsc[ai][m] + bv1;
#pragma unroll
                    for (int e = 0; e < 4; ++e) { v0[e] = __builtin_amdgcn_rcpf(1.f + __builtin_amdgcn_exp2f(-v0[e] * LOG2E)); v1[e] = __builtin_amdgcn_rcpf(1.f + __builtin_amdgcn_exp2f(-v1[e] * LOG2E)); }
                    u32x4 w; w.x = cvt_pk_bf16(v0[0], v0[1]); w.y = cvt_pk_bf16(v0[2], v0[3]); w.z = cvt_pk_bf16(v1[0], v1[1]); w.w = cvt_pk_bf16(v1[2], v1[3]);
                    st_wt(rowp + bj * 128, w); } }
    }
};
struct EpiGated {
    static constexpr bool PERM = true;
    bf16_t* P; const bf16_t* G; int first; float sc;
    __device__ __forceinline__ void operator()(const f32x4 (&acc)[2][2][4][2], const Unit& u, int wr, int wc, int fr, int fq) const {
        asm volatile("" : "+v"(fr), "+v"(fq));
        const int row0 = u.pm * 256 + wr * 64 + fr, lcol0 = u.pn * 256 + wc * 32 + 8 * fq, col0 = u.ocol + wc * 32 + 8 * fq;
        unsigned zu = 0u; asm volatile("" : "+v"(zu));
#pragma unroll
        for (int ai = 0; ai < 2; ++ai) {
            u32x4 gq[4][2], pq[4][2];
#pragma unroll
            for (int m = 0; m < 4; ++m)
#pragma unroll
                for (int bj = 0; bj < 2; ++bj) { gq[m][bj] = *(const u32x4*)(G + (size_t)(row0 + ai * 128 + m * 16) * 2048 + lcol0 + bj * 128); if (DBG_BR == 1) gq[m][bj] = (u32x4){0x3f803f80u, 0x3f803f80u, 0x3f803f80u, 0x3f803f80u};
                    pq[m][bj] = (u32x4){zu, zu, zu, zu}; if (!first) pq[m][bj] = *(const u32x4*)(P + (size_t)(row0 + ai * 128 + m * 16) * PW + col0 + bj * 128); }
#pragma unroll
            for (int m = 0; m < 4; ++m) { bf16_t* rowp = P + (size_t)(row0 + ai * 128 + m * 16) * PW + col0;
#pragma unroll
                for (int bj = 0; bj < 2; ++bj) { const u32x4 g = gq[m][bj], pv = pq[m][bj];
                    const f32x4 v0 = acc[ai][bj][m][0] * sc, v1 = acc[ai][bj][m][1] * sc;
                    float o[8];
                    o[0] = __uint_as_float(pv.x << 16) + __uint_as_float(g.x << 16) * v0[0]; o[1] = __uint_as_float(pv.x & 0xffff0000u) + __uint_as_float(g.x & 0xffff0000u) * v0[1];
                    o[2] = __uint_as_float(pv.y << 16) + __uint_as_float(g.y << 16) * v0[2]; o[3] = __uint_as_float(pv.y & 0xffff0000u) + __uint_as_float(g.y & 0xffff0000u) * v0[3];
                    o[4] = __uint_as_float(pv.z << 16) + __uint_as_float(g.z << 16) * v1[0]; o[5] = __uint_as_float(pv.z & 0xffff0000u) + __uint_as_float(g.z & 0xffff0000u) * v1[1];
                    o[6] = __uint_as_float(pv.w << 16) + __uint_as_float(g.w << 16) * v1[2]; o[7] = __uint_as_float(pv.w & 0xffff0000u) + __uint_as_float(g.w & 0xffff0000u) * v1[3];
                    u32x4 w; w.x = cvt_pk_bf16(o[0], o[1]); w.y = cvt_pk_bf16(o[2], o[3]); w.z = cvt_pk_bf16(o[4], o[5]); w.w = cvt_pk_bf16(o[6], o[7]);
                    st_wt(rowp + bj * 128, w); } }
            asm volatile("" ::: "memory"); }
    }
};
struct EpiRes {
    static constexpr bool PERM = true;
    float* out_f; float dbg; bf16_t* hb; rs_t* rs;
    __device__ __forceinline__ void operator()(const f32x4 (&acc)[2][2][4][2], const Unit& u, int wr, int wc, int fr, int fq) const {
        asm volatile("" : "+v"(fr), "+v"(fq));
        const int lrow0 = wr * 64 + fr, col0 = u.pn * 256 + wc * 32 + 8 * fq;
        bf16_t* hp0 = hb + (size_t)(u.pm * 256 + lrow0) * DM + col0;
        u32x4 bw[2][4][2];
#pragma unroll
        for (int ai = 0; ai < 2; ++ai)
#pragma unroll
            for (int m = 0; m < 4; ++m)
#pragma unroll
                for (int bj = 0; bj < 2; ++bj) bw[ai][m][bj] = *(const u32x4*)(hp0 + (size_t)(ai * 128 + m * 16) * DM + bj * 128);
#pragma unroll
        for (int ai = 0; ai < 2; ++ai)
#pragma unroll
            for (int m = 0; m < 4; ++m) { const int lrow = lrow0 + ai * 128 + m * 16, grow = u.pm * 256 + lrow;
                const size_t foff = ((size_t)(u.pm - 1) * 256 + lrow) * DM + col0; bf16_t* hp = hp0 + (size_t)(ai * 128 + m * 16) * DM; float ss = 0.f;
#pragma unroll
                for (int bj = 0; bj < 2; ++bj) { const u32x4 w = bw[ai][m][bj];
                    const f32x4 b0 = (f32x4){__uint_as_float(w.x << 16), __uint_as_float(w.x & 0xffff0000u), __uint_as_float(w.y << 16), __uint_as_float(w.y & 0xffff0000u)};
                    const f32x4 b1 = (f32x4){__uint_as_float(w.z << 16), __uint_as_float(w.z & 0xffff0000u), __uint_as_float(w.w << 16), __uint_as_float(w.w & 0xffff0000u)};
                    const f32x4 h0 = b0 + acc[ai][bj][m][0] * dbg, h1 = b1 + acc[ai][bj][m][1] * dbg;
                    if (out_f) { st_wt(out_f + foff + bj * 128, h0); st_wt(out_f + foff + bj * 128 + 4, h1); }
                    else { ss += ((h0[0] * h0[0] + h0[1] * h0[1]) + (h0[2] * h0[2] + h0[3] * h0[3])) + ((h1[0] * h1[0] + h1[1] * h1[1]) + (h1[2] * h1[2] + h1[3] * h1[3]));
                        u32x4 o; o.x = cvt_pk_bf16(h0[0], h0[1]); o.y = cvt_pk_bf16(h0[2], h0[3]); o.z = cvt_pk_bf16(h1[0], h1[1]); o.w = cvt_pk_bf16(h1[2], h1[3]); st_wt(hp + bj * 128, o); } }
                if (!out_f) { ss += __shfl_xor(ss, 16); ss += __shfl_xor(ss, 32); if (fq == 0) (void)__hip_atomic_fetch_add(rs + grow, rs_fix(ss), __ATOMIC_RELAXED, __HIP_MEMORY_SCOPE_AGENT); } }
    }
};
struct EpiSwiglu {
    static constexpr bool PERM = true;
    bf16_t* P; const rs_t* rs;
    __device__ __forceinline__ void operator()(const f32x4 (&acc)[2][2][4][2], const Unit& u, int wr, int wc, int fr, int fq) const {
        asm volatile("" : "+v"(fr), "+v"(fq));
        const int row0 = u.pm * 256 + wr * 64 + fr, col0 = u.pn * 128 + wc * 32 + 8 * fq;
#pragma unroll
        for (int ai = 0; ai < 2; ++ai)
#pragma unroll
            for (int m = 0; m < 4; ++m) { bf16_t* rowp = P + (size_t)(row0 + ai * 128 + m * 16) * PW + col0;
                const float sc = __builtin_amdgcn_rsqf(rs_val(rs[row0 + ai * 128 + m * 16]) * (1.f / DM) + EPS);
                float o[8];
#pragma unroll
                for (int n = 0; n < 2; ++n)
#pragma unroll
                    for (int e = 0; e < 4; ++e) { const float g = acc[ai][0][m][n][e] * sc, up = acc[ai][1][m][n][e] * sc; o[n * 4 + e] = g * __builtin_amdgcn_rcpf(1.f + __builtin_amdgcn_exp2f(-g * LOG2E)) * up; }
                u32x4 w; w.x = cvt_pk_bf16(o[0], o[1]); w.y = cvt_pk_bf16(o[2], o[3]); w.z = cvt_pk_bf16(o[4], o[5]); w.w = cvt_pk_bf16(o[6], o[7]);
                st_wt(rowp, w); }
    }
};

struct SkP { bf16_t* P; int ocol; const rs_t* rs; float inv_dim; rs_t* sq; rs_t* skv; struct Pre { rs_t q[4]; };
    __device__ __forceinline__ void load(int r0, int, Pre& p) const { if (rs) {
#pragma unroll
        for (int r = 0; r < 4; ++r) p.q[r] = rs[MROW0 + r0 + r]; } }
    __device__ __forceinline__ void apply(int r0, int c, f32x4 v, const Pre& p) const {
        rs_t* sums = (sq && c < 1024) ? (c < 512 ? sq : skv) : (rs_t*)nullptr;
#pragma unroll
        for (int r = 0; r < 4; ++r) { float x = v[r]; if (rs) x *= __builtin_amdgcn_rsqf(rs_val(p.q[r]) * inv_dim + EPS); P[(size_t)(MROW0 + r0 + r) * PW + ocol + c] = (bf16_t)f2bf(x);
            if (sums) { float ss = x * x; ss += __shfl_xor(ss, 1); ss += __shfl_xor(ss, 2); ss += __shfl_xor(ss, 4); ss += __shfl_xor(ss, 8);
                if ((threadIdx.x & 15) == 0) (void)__hip_atomic_fetch_add(sums + MROW0 + r0 + r, rs_fix(ss), __ATOMIC_RELAXED, __HIP_MEMORY_SCOPE_AGENT); } } } };
struct SkGate { bf16_t* G; const float* bias; const rs_t* rs; struct Pre { rs_t q[4]; float b; };
    __device__ __forceinline__ void load(int r0, int c, Pre& p) const { p.b = bias[c];
#pragma unroll
        for (int r = 0; r < 4; ++r) p.q[r] = rs[MROW0 + r0 + r]; }
    __device__ __forceinline__ void apply(int r0, int c, f32x4 v, const Pre& p) const {
#pragma unroll
        for (int r = 0; r < 4; ++r) { const float x = v[r] * __builtin_amdgcn_rsqf(rs_val(p.q[r]) * (1.f / DM) + EPS); G[(size_t)(MROW0 + r0 + r) * 2048 + c] = (bf16_t)f2bf(__builtin_amdgcn_rcpf(1.f + __builtin_amdgcn_exp2f(-(x + p.b) * LOG2E))); } } };
struct SkGated { bf16_t* P; const bf16_t* G; int first; struct Pre { bf16_t pv[4], g[4]; };
    __device__ __forceinline__ void load(int r0, int c, Pre& p) const {
#pragma unroll
        for (int r = 0; r < 4; ++r) { p.g[r] = G[(size_t)(MROW0 + r0 + r) * 2048 + c]; p.pv[r] = first ? (bf16_t)0 : P[(size_t)(MROW0 + r0 + r) * PW + C_MERGED + c]; } }
    __device__ __forceinline__ void apply(int r0, int c, f32x4 v, const Pre& p) const {
#pragma unroll
        for (int r = 0; r < 4; ++r) P[(size_t)(MROW0 + r0 + r) * PW + C_MERGED + c] = (bf16_t)f2bf(bf2f(p.pv[r]) + bf2f(p.g[r]) * v[r]); } };
struct SkRes { float* hmeta; bf16_t* hb; rs_t* rs; struct Pre { float hm[4]; };
    __device__ __forceinline__ void load(int r0, int c, Pre& p) const {
#pragma unroll
        for (int r = 0; r < 4; ++r) p.hm[r] = hmeta[(size_t)(MROW0 + r0 + r) * DM + c]; }
    __device__ __forceinline__ void apply(int r0, int c, f32x4 v, const Pre& p) const {
#pragma unroll
        for (int r = 0; r < 4; ++r) { const float hv = p.hm[r] + v[r]; hmeta[(size_t)(MROW0 + r0 + r) * DM + c] = hv;
            if (hb) { hb[(size_t)(MROW0 + r0 + r) * DM + c] = (bf16_t)f2bf(hv); float ss = hv * hv; ss += __shfl_xor(ss, 1); ss += __shfl_xor(ss, 2); ss += __shfl_xor(ss, 4); ss += __shfl_xor(ss, 8);
                if ((threadIdx.x & 15) == 0) (void)__hip_atomic_fetch_add(rs + MROW0 + r0 + r, rs_fix(ss), __ATOMIC_RELAXED, __HIP_MEMORY_SCOPE_AGENT); } } } };
template <class Fn>
__device__ __forceinline__ void skinny_gemm(LAS unsigned char* lds, const bf16_t* A, int lda, const bf16_t* Bt, int K, int ntask, int bid, int G, const Fn& f) {
    int tid = threadIdx.x; asm volatile("" : "+v"(tid));
    const int wid = __builtin_amdgcn_readfirstlane(tid >> 6), lane = tid & 63, l15 = lane & 15, kq = lane >> 4;
    LAS f32x4* red = (LAS f32x4*)lds;
    const int kw = K / 8;
    for (int task = bid; task < ntask; task += G) {
        const bf16_t* ap = A + (size_t)l15 * lda + wid * kw + kq * 8;
        const bf16_t* bp = Bt + (size_t)(task * 16 + l15) * K + wid * kw + kq * 8;
        float z = 0.f; asm volatile("" : "+v"(z));
        f32x4 acc = (f32x4){z, z, z, z};
        typename Fn::Pre pre{}; if (wid == 0) f.load(kq * 4, task * 16 + l15, pre);
        for (int k0 = 0; k0 < kw; k0 += 256) {
            bf16x8 fa[8], fb[8];
#pragma unroll
            for (int i = 0; i < 8; ++i) { const int k = (k0 + 32 * i < kw) ? k0 + 32 * i : 0; fa[i] = *(const bf16x8*)(ap + k); fb[i] = *(const bf16x8*)(bp + k); }
#pragma unroll
            for (int i = 0; i < 8; ++i) if (k0 + 32 * i < kw) acc = __builtin_amdgcn_mfma_f32_16x16x32_bf16(fa[i], fb[i], acc, 0, 0, 0);
        }
        red[wid * 64 + lane] = acc;
        LDS_WAIT(); __syncthreads();
        if (wid == 0) {
            f32x4 s = red[lane];
#pragma unroll
            for (int w = 1; w < 8; ++w) s += red[w * 64 + lane];
            f.apply(kq * 4, task * 16 + l15, s, pre);
        }
        __syncthreads();
    }
}
__device__ __forceinline__ void skinny_swiglu(LAS unsigned char* lds, const bf16_t* A, int lda, const bf16_t* Bt, int K, bf16_t* P, const rs_t* rs, int bid, int G) {
    int tid = threadIdx.x; asm volatile("" : "+v"(tid));
    const int wid = __builtin_amdgcn_readfirstlane(tid >> 6), lane = tid & 63, l15 = lane & 15, kq = lane >> 4;
    LAS f32x4* red = (LAS f32x4*)lds;
    const int kw = K / 8;
    for (int task = bid; task < DFF / 16; task += G) {
        const int c0 = task * 16, brow = (c0 >> 7) * 256 + (c0 & 127) + l15;
        const bf16_t* ap = A + (size_t)l15 * lda + wid * kw + kq * 8;
        const bf16_t* bg = Bt + (size_t)brow * K + wid * kw + kq * 8; const bf16_t* bu = bg + (size_t)128 * K;
        float z = 0.f; asm volatile("" : "+v"(z));
        f32x4 ag = (f32x4){z, z, z, z}, au = ag;
        rs_t rq[4] = {0, 0, 0, 0}; if (wid == 0) {
#pragma unroll
            for (int r = 0; r < 4; ++r) rq[r] = rs[MROW0 + kq * 4 + r]; }
        {
            bf16x8 fa[8], fg[8], fu[8];
#pragma unroll
            for (int i = 0; i < 8; ++i) { fa[i] = *(const bf16x8*)(ap + 32 * i); fg[i] = *(const bf16x8*)(bg + 32 * i); fu[i] = *(const bf16x8*)(bu + 32 * i); }
#pragma unroll
            for (int i = 0; i < 8; ++i) { ag = __builtin_amdgcn_mfma_f32_16x16x32_bf16(fa[i], fg[i], ag, 0, 0, 0); au = __builtin_amdgcn_mfma_f32_16x16x32_bf16(fa[i], fu[i], au, 0, 0, 0); }
        }
        red[wid * 64 + lane] = ag; red[512 + wid * 64 + lane] = au;
        LDS_WAIT(); __syncthreads();
        if (wid == 0) {
            f32x4 sg = red[lane], su = red[512 + lane];
#pragma unroll
            for (int w = 1; w < 8; ++w) { sg += red[w * 64 + lane]; su += red[512 + w * 64 + lane]; }
#pragma unroll
            for (int r = 0; r < 4; ++r) { const float sc = __builtin_amdgcn_rsqf(rs_val(rq[r]) * (1.f / DM) + EPS); const float g = sg[r] * sc; su[r] *= sc; P[(size_t)(MROW0 + kq * 4 + r) * PW + c0 + l15] = (bf16_t)f2bf(g * __builtin_amdgcn_rcpf(1.f + __builtin_amdgcn_exp2f(-g * LOG2E)) * su[r]); }
        }
        __syncthreads();
    }
}

#define XB_TMO      128
#define XB_XCNT(j)  (256  + 64 * (j))
#define XB_XSUB(j)  (1280 + 64 * (j))
#define XB_XGEN(j)  (2304 + 64 * (j))
#define XB_TOP      3328
#define XB_TOPGEN   3392
#define XCD_BAR_WORDS 3456
#define XB_SPIN_CAP (1u << 18)
__device__ __forceinline__ unsigned xb_ld(unsigned* p)              { return __hip_atomic_load(p, __ATOMIC_RELAXED, __HIP_MEMORY_SCOPE_AGENT); }
__device__ __forceinline__ unsigned xb_add(unsigned* p, unsigned v) { return __hip_atomic_fetch_add(p, v, __ATOMIC_RELAXED, __HIP_MEMORY_SCOPE_AGENT); }
__device__ __forceinline__ unsigned xb_xcc_id() { return (unsigned)__builtin_amdgcn_s_getreg((3 << 11) | 20) & 0xFu; }
#define XB_SPIN(cond, bar) do { unsigned _sp = 0; while (cond) { __builtin_amdgcn_s_sleep(1); \
    if ((++_sp & 255u) == 0u) { if (xb_ld(&(bar)[XB_TMO])) break; if (_sp > XB_SPIN_CAP) { atomicAdd(&(bar)[XB_TMO], 1u); break; } } } } while (0)
struct XcdBarrier { unsigned* bar; unsigned x; volatile LAS unsigned* st; };
__device__ __forceinline__ XcdBarrier xcd_barrier_post(unsigned* bar, volatile LAS unsigned* st) {
    XcdBarrier b; b.bar = bar; b.x = xb_xcc_id(); b.st = st;
    if (threadIdx.x == 0) (void)xb_add(&bar[XB_XCNT(b.x)], 1u);
    return b;
}
__device__ __forceinline__ void xcd_barrier_complete(unsigned* bar, unsigned x, unsigned& nloc, unsigned& nx) {
    const unsigned G = gridDim.x * gridDim.y * gridDim.z;
    unsigned sum, cnt, mine, sp = 0u;
    for (;;) {
        sum = 0u; cnt = 0u; mine = 0u;
#pragma unroll
        for (unsigned j = 0; j < 16; ++j) { const unsigned c = xb_ld(&bar[XB_XCNT(j)]); sum += c; cnt += (c > 0u) ? 1u : 0u; mine = (j == x) ? c : mine; }
        if (sum == G) break;
        __builtin_amdgcn_s_sleep(1);
        if ((++sp & 255u) == 0u) { if (xb_ld(&bar[XB_TMO])) break; if (sp > XB_SPIN_CAP) { atomicAdd(&bar[XB_TMO], 1u); break; } }
    }
    nloc = mine > 0u ? mine : 1u; nx = cnt > 0u ? cnt : 1u;
}
__device__ __forceinline__ void xcd_barrier(const XcdBarrier& b) {
    asm volatile("s_waitcnt vmcnt(0)" ::: "memory");
    __syncthreads();
    if (threadIdx.x == 0) {
        unsigned* bar = b.bar;
        __builtin_amdgcn_s_waitcnt(0);
        unsigned nloc = b.st[0], nx = b.st[1];
        if (nloc == 0u) { xcd_barrier_complete(bar, b.x, nloc, nx); b.st[0] = nloc; b.st[1] = nx; }
        const unsigned old = xb_add(&bar[XB_XSUB(b.x)], 1u);
        const unsigned gen = old / nloc;
        if (old + 1u == (gen + 1u) * nloc) {
            __builtin_amdgcn_fence(__ATOMIC_RELEASE, "agent");
            asm volatile("s_waitcnt vmcnt(0)" ::: "memory");
            const unsigned og = xb_add(&bar[XB_TOP], 1u);
            const unsigned tg = og / nx;
            if (og + 1u == (tg + 1u) * nx) xb_add(&bar[XB_TOPGEN], 1u);
            else XB_SPIN(xb_ld(&bar[XB_TOPGEN]) == tg, bar);
            __builtin_amdgcn_fence(__ATOMIC_ACQUIRE, "agent");
            xb_add(&bar[XB_XGEN(b.x)], 1u);
            asm volatile("s_waitcnt vmcnt(0)" ::: "memory");
        } else {
            XB_SPIN(xb_ld(&bar[XB_XGEN(b.x)]) == gen, bar);
            __builtin_amdgcn_fence(__ATOMIC_ACQUIRE, "agent");
            asm volatile("s_waitcnt vmcnt(0)" ::: "memory");
        }
    }
    __syncthreads();
}

constexpr int NWAVES = 8;
constexpr int RING_BYTES = 131072, LDS_BYTES = 147456, LDSCTL_OFF = LDS_BYTES - 512;
struct Args {
    const float* in[19]; float* out; unsigned char* ws; int ph_lo, ph_hi;
};
struct Ctx {
    LAS unsigned char* lds; int tid, lane, wave, gw, ngw, G, bid;
};

template <int MAP> __device__ __forceinline__ int wmap(int n, float& sc) {
    sc = 1.f;
    if (MAP == 0) return n;
    if (MAP == 1) {
        if (n < 1088) return n;
        if (n < 3136) { const int m = n - 1088, d = m & 127; return 1280 + (m - d) + (d < 64 ? 2 * d : 2 * (d - 64) + 1); }
        if (n < 4160) return 1280 + (n - 1088);
        if (n < 5184) { const int m = n - 4160, d = m & 63; return 4352 + (m - d) + (d < 32 ? 2 * d : 2 * (d - 32) + 1); }
        if (n < 5248) { const int d = n - 5184; return 1088 + (d < 32 ? 2 * d : 2 * (d - 32) + 1); }
        if (n < 5264) { sc = 0.03125f; return 1152 + (n - 5248); }
        if (n < 7312) { const int m = n - 5264, d = m & 127; return 5376 + (m - d) + (d < 64 ? 2 * d : 2 * (d - 64) + 1); }
        if (n < 8336) return 5376 + (n - 5264);
        return 8448 + (n - 8336);
    }
    if (n < DFF) return (n >> 7) * 256 + (n & 127);
    const int m = n - DFF; return (m >> 7) * 256 + 128 + (m & 127);
}
template <int MAP> __device__ __forceinline__ void conv_matrix(const Ctx& F, const float* W, int K, int N, bf16_t* WT, const float* gain) {
    LAS float* scr = (LAS float*)(F.lds + F.wave * 18432);
    const int lane = F.lane;
    const int nblk = (N + 63) / 64, nit = (K / 64) * nblk;
    const int l31 = lane & 31, lh = lane >> 5, c = lane & 7, nsub = lane >> 3;
    f32x2 wv[32]; f32x4 g0 = (f32x4){1.f, 1.f, 1.f, 1.f}, g1 = g0;
#define CONV_LOAD(item) do { const int kb_ = (item) / nblk, nb_ = (item) - kb_ * nblk, k0_ = 64 * kb_, nn_ = 64 * nb_ + 2 * l31; \
        const float* src_ = W + (size_t)(k0_ + lh) * N + nn_; const bool ok_ = nn_ < N; \
        _Pragma("unroll") for (int i = 0; i < 32; ++i) wv[i] = ok_ ? *(const f32x2*)(src_ + (size_t)(2 * i) * N) : (f32x2){0.f, 0.f}; \
        if (gain) { g0 = *(const f32x4*)(gain + k0_ + 8 * c); g1 = *(const f32x4*)(gain + k0_ + 8 * c + 4); } } while (0)
    int it = F.gw;
    if (it < nit) CONV_LOAD(it);
    while (it < nit) {
        const int kb = it / nblk, nb = it - kb * nblk, k0 = 64 * kb, n0 = 64 * nb;
#pragma unroll
        for (int i = 0; i < 32; ++i) { LAS float* d = scr + (2 * i + lh) * 65 + l31; d[0] = wv[i].x; d[32] = wv[i].y; }
        const f32x4 gc0 = g0, gc1 = g1;
        const int nx = it + F.ngw;
        if (nx < nit) CONV_LOAD(nx);
        LDS_WAIT(); asm volatile("" ::: "memory");
#pragma unroll
        for (int j = 0; j < 8; ++j) { const int n = nsub + 8 * j, ns = n0 + n;
            if (ns < N) { float sc; const int dst = wmap<MAP>(ns, sc); const LAS float* s = scr + (8 * c) * 65 + (n & 1) * 32 + (n >> 1);
                u32x4 o; o.x = pk2(s[0 * 65] * (sc * gc0.x), s[1 * 65] * (sc * gc0.y)); o.y = pk2(s[2 * 65] * (sc * gc0.z), s[3 * 65] * (sc * gc0.w));
                o.z = pk2(s[4 * 65] * (sc * gc1.x), s[5 * 65] * (sc * gc1.y)); o.w = pk2(s[6 * 65] * (sc * gc1.z), s[7 * 65] * (sc * gc1.w));
                *(u32x4*)(WT + (size_t)dst * K + k0 + 8 * c) = o; } }
        LDS_WAIT(); asm volatile("" ::: "memory");
        it = nx;
    }
#undef CONV_LOAD
}

__device__ __forceinline__ void norm_load(const float* hrow, int lane, f32x4 (&v)[8]) {
#pragma unroll
    for (int j = 0; j < 8; ++j) v[j] = *((const f32x4*)hrow + lane + 64 * j);
}
__device__ __forceinline__ void norm_fin(const f32x4 (&v)[8], bf16_t* orow, rs_t* rs_row, int lane) {
    float s = 0.f;
#pragma unroll
    for (int j = 0; j < 8; ++j) s += (v[j].x * v[j].x + v[j].y * v[j].y) + (v[j].z * v[j].z + v[j].w * v[j].w);
    s = wave_sum(s);
    if (lane == 0) *rs_row = rs_fix(s);
#pragma unroll
    for (int j = 0; j < 8; ++j) { u32x2 o; o.x = cvt_pk_bf16(v[j].x, v[j].y); o.y = cvt_pk_bf16(v[j].z, v[j].w); *((u32x2*)orow + lane + 64 * j) = o; }
}

__device__ __forceinline__ void meta_post_row(bf16_t* P, int r, const float* gperm, int lane) {
    bf16_t* p = P + (size_t)r * PW; const int pos = row_pos(r);
    float c128, s128, c64, s64; rope_cs(pos, lane, 2.f / 128.f, c128, s128); rope_cs(pos, lane & 31, 2.f / 64.f, c64, s64);
#pragma unroll 1
    for (int t = 0; t < 4; ++t) {
        const int cb = t == 0 ? C_DQ : (t == 1 ? C_DK : (t == 2 ? C_FQ : C_FK)); const float sc = (t == 0 || t == 2) ? C2_128 : 1.f;
        const float ga = gperm[t * 128 + 2 * lane], gb = gperm[t * 128 + 2 * lane + 1];
#pragma unroll 1
        for (int h = 0; h < 8; ++h) { unsigned* xp = (unsigned*)(p + cb + h * 128) + lane; const unsigned w = *xp; float x1 = __uint_as_float(w << 16), x2 = __uint_as_float(w & 0xffff0000u);
            const float rn = __builtin_amdgcn_rsqf(wave_sum(x1 * x1 + x2 * x2) * (1.f / 128.f) + EPS); x1 *= rn * ga; x2 *= rn * gb;
            *xp = cvt_pk_bf16((x1 * c128 - x2 * s128) * sc, (x2 * c128 + x1 * s128) * sc); }
    }
#pragma unroll 1
    for (int hh = 0; hh < 8; ++hh) { unsigned* xp = (unsigned*)(p + C_IQ + hh * 128) + lane; const unsigned w = *xp; const float x1 = __uint_as_float(w << 16), x2 = __uint_as_float(w & 0xffff0000u);
        *xp = cvt_pk_bf16(x1 * c64 - x2 * s64, x2 * c64 + x1 * s64); }
}
__device__ __forceinline__ void unpack8(const u32x4& w, float (&x)[8]) {
#pragma unroll
    for (int e = 0; e < 4; ++e) { x[2 * e] = __uint_as_float(w[e] << 16); x[2 * e + 1] = __uint_as_float(w[e] & 0xffff0000u); }
}
__device__ __forceinline__ u32x4 pack8(const float (&x)[8]) { u32x4 w; w.x = cvt_pk_bf16(x[0], x[1]); w.y = cvt_pk_bf16(x[2], x[3]); w.z = cvt_pk_bf16(x[4], x[5]); w.w = cvt_pk_bf16(x[6], x[7]); return w; }
__device__ __forceinline__ u32x4 shfl_xor4(const u32x4& w, int m) { u32x4 r; r.x = __shfl_xor(w.x, m); r.y = __shfl_xor(w.y, m); r.z = __shfl_xor(w.z, m); r.w = __shfl_xor(w.w, m); return r; }
__device__ __forceinline__ void post2_load(const bf16_t* P, int r, int lane, u32x4 (&v)[9], unsigned& ikw_) {
    const bf16_t* p = P + (size_t)r * PW; const int hw = lane >> 5, l5 = lane & 31;
    v[0] = *(const u32x4*)(p + C_KPE + (lane & 7) * 8); ikw_ = *((const unsigned*)(p + C_IK) + (lane & 31));
#pragma unroll
    for (int it = 0; it < 4; ++it) { const int h = 2 * it + hw; v[1 + it] = *(const u32x4*)(p + C_QRAW + h * 192 + (l5 < 24 ? l5 : 0) * 8); v[5 + it] = *(const u32x4*)(p + C_KVRAW + h * 256 + (l5 & 15) * 8); }
}
__device__ __forceinline__ void post2_row(bf16_t* P, int r, const u32x4 (&v)[9], unsigned ikw, const float* qkg  , LAS float* rnl, int lane) {
    bf16_t* p = P + (size_t)r * PW;
    const int pos = row_pos(r), hw = lane >> 5, l5 = lane & 31;
    float c64[8], s64[8];
#pragma unroll
    for (int j = 0; j < 8; ++j) rope_cs(pos, 8 * (lane & 3) + j, 2.f / 64.f, c64[j], s64[j]);
    float kp[8]; unpack8(v[0], kp);
    unsigned* ikp = (unsigned*)(p + C_IK) + (lane & 31);
    float kpe_ss = 0.f;
#pragma unroll
    for (int j = 0; j < 8; ++j) kpe_ss += kp[j] * kp[j];
    kpe_ss += __shfl_xor(kpe_ss, 1); kpe_ss += __shfl_xor(kpe_ss, 2); kpe_ss += __shfl_xor(kpe_ss, 4);
#pragma unroll
    for (int it = 0; it < 4; ++it) {
        const int h = 2 * it + hw; const bool act = l5 < 24;
        u32x4* ptr = (u32x4*)(p + C_QRAW + h * 192 + (act ? l5 : 0) * 8);
        float x[8]; unpack8(v[1 + it], x);
        float ss = 0.f;
#pragma unroll
        for (int j = 0; j < 8; ++j) ss += x[j] * x[j];
        if (!act) ss = 0.f;
#pragma unroll
        for (int o = 1; o < 32; o <<= 1) ss += __shfl_xor(ss, o);
        const float rn = 1.0f / sqrtf(ss * (1.f / 192.f) + EPS);
        const int gi = (act ? l5 : 0) * 8;
        const f32x4 g0 = *(const f32x4*)(qkg + gi), g1 = *(const f32x4*)(qkg + gi + 4);
#pragma unroll
        for (int j = 0; j < 4; ++j) { x[j] *= rn * g0[j]; x[4 + j] *= rn * g1[j]; }
        float o[8];
#pragma unroll
        for (int j = 0; j < 8; ++j) { const float pr = __shfl_xor(x[j], 4); const float rot = (l5 & 4) ? (x[j] * c64[j] + pr * s64[j]) : (x[j] * c64[j] - pr * s64[j]); o[j] = (l5 >= 16 ? rot : x[j]) * C2_192; }
        if (act) *ptr = pack8(o);
    }
#pragma unroll
    for (int it = 0; it < 4; ++it) {
        const int h = 2 * it + hw; const bool isk = l5 < 16;
        u32x4* ptr = (u32x4*)(p + C_KVRAW + h * 256 + (l5 & 15) * 8);
        float x[8]; unpack8(v[5 + it], x);
        float ss = 0.f;
#pragma unroll
        for (int j = 0; j < 8; ++j) ss += x[j] * x[j];
        if (!isk) ss = 0.f;
#pragma unroll
        for (int o = 1; o < 32; o <<= 1) ss += __shfl_xor(ss, o);
        const float rn = 1.0f / sqrtf((ss + kpe_ss) * (1.f / 192.f) + EPS);
        if (l5 == 0) rnl[h] = rn;
        const int gi = 192 + (isk ? l5 : 0) * 8;
        const f32x4 g0 = *(const f32x4*)(qkg + gi), g1 = *(const f32x4*)(qkg + gi + 4);
        float o[8];
#pragma unroll
        for (int j = 0; j < 4; ++j) { o[j] = x[j] * rn * g0[j]; o[4 + j] = x[4 + j] * rn * g1[j]; }
        if (isk) *ptr = pack8(o);
    }
    LDS_WAIT(); asm volatile("" ::: "memory");
    { const int hd = lane >> 3, c = lane & 7; const float rn = rnl[hd];
      const f32x4 g0 = *(const f32x4*)(qkg + 192 + 128 + c * 8), g1 = *(const f32x4*)(qkg + 192 + 128 + c * 8 + 4);
      float x[8], o[8];
#pragma unroll
      for (int j = 0; j < 4; ++j) { x[j] = kp[j] * rn * g0[j]; x[4 + j] = kp[4 + j] * rn * g1[j]; }
#pragma unroll
      for (int j = 0; j < 8; ++j) { const float pr = __shfl_xor(x[j], 4); o[j] = (c & 4) ? (x[j] * c64[j] + pr * s64[j]) : (x[j] * c64[j] - pr * s64[j]); }
      *(u32x4*)(p + C_KPEH + hd * 64 + c * 8) = pack8(o); }
    { const float x1 = __uint_as_float(ikw << 16), x2 = __uint_as_float(ikw & 0xffff0000u); float cs, sn; rope_cs(pos, lane & 31, 2.f / 64.f, cs, sn);
      if (lane < 32) *ikp = cvt_pk_bf16(x1 * cs - x2 * sn, x2 * cs + x1 * sn); }
    LDS_WAIT(); asm volatile("" ::: "memory");
}
__device__ __forceinline__ void post3_load(const bf16_t* P, int r, int lane, u32x4 (&rr)[4]) {
    const bf16_t* p = P + (size_t)r * PW; const int hw = lane >> 5, l5 = lane & 31;
#pragma unroll
    for (int h = 0; h < 4; ++h) rr[h] = *(const u32x4*)(p + (hw ? C_IQ : C_FQ) + h * 256 + l5 * 8);
}
__device__ __forceinline__ void post3_row(bf16_t* P, int r, const u32x4 (&rr)[4], const float* subg, float lam, float omli, int lane) {
    bf16_t* p = P + (size_t)r * PW;
    const int hw = lane >> 5, l5 = lane & 31;
#pragma unroll
    for (int h = 0; h < 4; ++h) {
        const u32x4 raw = rr[h];
        const u32x4 praw = shfl_xor4(raw, 16);
        float a[8], b[8]; unpack8(raw, a); unpack8(praw, b);
        float d[8], ss = 0.f;
#pragma unroll
        for (int j = 0; j < 8; ++j) { d[j] = a[j] - lam * b[j]; ss += d[j] * d[j]; }
        if (l5 >= 16) ss = 0.f;
#pragma unroll
        for (int o = 1; o < 64; o <<= 1) ss += __shfl_xor(ss, o);
        const float rn = omli / sqrtf(ss * (1.f / 256.f) + EPS);
        const int dim = hw * 128 + (l5 & 15) * 8;
        const f32x4 g0 = *(const f32x4*)(subg + dim), g1 = *(const f32x4*)(subg + dim + 4);
        float o[8];
#pragma unroll
        for (int j = 0; j < 4; ++j) { o[j] = d[j] * rn * g0[j]; o[4 + j] = d[4 + j] * rn * g1[j]; }
        if (l5 < 16) *(u32x4*)(p + C_OC + h * 256 + dim) = pack8(o);
    }
}

__device__ __forceinline__ void index_unit(const bf16_t* P, int unit, unsigned* bm, LAS unsigned char* lds) {
    typedef float f32x16 __attribute__((ext_vector_type(16)));
    int tid = threadIdx.x; asm volatile("" : "+v"(tid));
    const int wid = __builtin_amdgcn_readfirstlane(tid >> 6), lane = tid & 63, j = lane & 31, hi = lane >> 5;
    const int tb = 255 - (unit >> 4), b = unit & 15, t0 = tb * 8, tokbase = MBLK + b * SEQ;
    const int wmax = (64 + t0 + 7) >> 5;
    LAS unsigned* keys = (LAS unsigned*)lds;
    LAS float* iwl = (LAS float*)(lds + 8 * 2112 * 4);
    if (t0 + 7 + 17 > 256) {
        if (tid < 128) iwl[tid] = bf2f(P[(size_t)(tokbase + t0 + (tid >> 4)) * PW + C_IW + (tid & 15)]);
        LAS unsigned char* al = lds + 8 * 2112 * 4 + 512;
        { const int id0 = tid * 2;
#pragma unroll
          for (int e = 0; e < 2; ++e) { const int id = id0 + e, rw = id >> 3, c = id & 7;
              *(LAS bf16x8*)(al + rw * 144 + c * 16) = *(const bf16x8*)(P + (size_t)(tokbase + t0 + (rw >> 4)) * PW + C_IQ + (rw & 15) * 64 + c * 8); } }
        LDS_WAIT(); __syncthreads();
        bf16x8 af[4][4];
        { const int qa = (j >> 2) & 1, ha = (j & 3) + 4 * (j >> 3);
#pragma unroll
          for (int blk = 0; blk < 4; ++blk)
#pragma unroll
              for (int s = 0; s < 4; ++s) af[blk][s] = *(const LAS bf16x8*)(al + ((2 * blk + qa) * 16 + ha) * 144 + s * 32 + hi * 16); }
        const unsigned boff = (unsigned)(j * PW + C_IK + hi * 8) * 2u;
        for (int w = wid; w <= wmax; w += 8) {
            const int kr_ = w < 2 ? (MBLK - 64) + 32 * w : tokbase + 32 * (w - 2); const char* bp_ = (const char*)(P + (size_t)kr_ * PW) + boff;
            bf16x8 bf[4];
#pragma unroll
            for (int s = 0; s < 4; ++s) bf[s] = *(const bf16x8*)(bp_ + s * 32);
            const int kidx = 32 * w + j;
#pragma unroll
            for (int blk = 0; blk < 4; ++blk) {
                f32x16 acc = (f32x16){0.f,0.f,0.f,0.f,0.f,0.f,0.f,0.f,0.f,0.f,0.f,0.f,0.f,0.f,0.f,0.f};
#pragma unroll
                for (int s = 0; s < 4; ++s) acc = __builtin_amdgcn_mfma_f32_32x32x16_bf16(af[blk][s], bf[s], acc, 0, 0, 0);
                const int q = 2 * blk + hi;
                const LAS f32x4* iwq = (const LAS f32x4*)(iwl + q * 16);
                float score = 0.f;
#pragma unroll
                for (int g = 0; g < 4; ++g) { const f32x4 wv = iwq[g]; score += fmaxf(acc[4 * g], 0.f) * wv.x + fmaxf(acc[4 * g + 1], 0.f) * wv.y + fmaxf(acc[4 * g + 2], 0.f) * wv.z + fmaxf(acc[4 * g + 3], 0.f) * wv.w; }
                const bool valid = kidx >= 48 && kidx <= 64 + t0 + q; const unsigned u_ = __float_as_uint(score);
                keys[q * 2112 + kidx] = valid ? ((u_ & 0x80000000u) ? ~u_ : (u_ | 0x80000000u)) : 0u;
            }
        }
        LDS_WAIT(); __syncthreads();
    }
    const int tq = t0 + wid, qk = 64 + tq, nch = qk / 64 + 1;
    unsigned* out = bm + (size_t)(b * SEQ + tq) * BMW;
    if (tq + 17 <= 256) {
        for (int c = 0; c < 33; ++c) { const int kidx = 64 * c + lane; const unsigned long long m = __ballot(kidx >= 48 && kidx <= qk);
            if (lane == 0) { out[2 * c] = (unsigned)m; out[2 * c + 1] = (unsigned)(m >> 32); } }
    } else {
        unsigned kreg[33];
#pragma unroll
        for (int c = 0; c < 33; ++c) kreg[c] = (c < nch && 64 * c + lane <= qk) ? keys[wid * 2112 + 64 * c + lane] : 0u;
        unsigned T = 0u;
        for (int bit = 31; bit >= 0; --bit) {
            const unsigned cand = T | (1u << bit); int cnt = 0;
#pragma unroll
            for (int c = 0; c < 33; ++c) cnt += __popcll(__ballot(kreg[c] >= cand));
            if (cnt >= 256) T = cand;
            if (cnt == 256) break;
        }
#pragma unroll
        for (int c = 0; c < 33; ++c) { const unsigned long long m = __ballot(kreg[c] >= T && kreg[c] != 0u);
            if (lane == 0) { out[2 * c] = (unsigned)m; out[2 * c + 1] = (unsigned)(m >> 32); } }
    }
    LDS_WAIT();
}

namespace fa {
typedef float f32x16 __attribute__((ext_vector_type(16)));
typedef short s16x4 __attribute__((ext_vector_type(4)));
__device__ __forceinline__ int crow(int r, int hi) { return (r & 3) + 8 * (r >> 2) + 4 * hi; }
__device__ __forceinline__ int v_st(int k, int c) { const int kk = (k & ~0xC) | ((k & 4) << 1) | ((k & 8) >> 1); return ((kk >> 3) * 4 + (c >> 5)) * 512 + ((kk & 7) * 32 + (c & 31)) * 2; }
__device__ __forceinline__ int v_rd_base(int lane) { return ((lane & 3) << 3) | (((lane >> 2) & 3) << 6) | (((lane >> 4) & 1) << 5) | (((lane >> 5) & 1) << 8); }
constexpr int v_rd_off(int d0, int ks, int half) { return d0 * 512 + ks * 4096 + half * 2048; }
constexpr int SHM_V = 16384;
template <int DQK, int DV> struct Geo { static constexpr int KP = DQK * 2, SHM_K = 64 * DQK * 2, LDS_K0 = 2 * 64 * DV * 2, LDS_WS = LDS_K0 + 2 * SHM_K, BYTES = LDS_WS + 8 * 256; };
#define FA_KSWZ(row, colB, pitch) ((row) * (pitch) + ((colB) ^ (((row) & 7) << 4)))
#define FA_SBAR() __builtin_amdgcn_sched_barrier(0)

struct Item { int qrow0, qk0, nt, tokbase; };

template <int DQK>
__device__ __forceinline__ void load_q(const bf16_t* P, const Item& it, int qcol, bf16x8 (&qr)[DQK / 16]) {
    int tid = threadIdx.x; asm volatile("" : "+v"(tid));
    const int wid = tid >> 6, lane = tid & 63, r32 = lane & 31, hi = lane >> 5;
    const bf16_t* qp = P + (size_t)(it.qrow0 + wid * 32 + r32) * PW + qcol + hi * 8;
#pragma unroll
    for (int d0 = 0; d0 < DQK / 16; ++d0) qr[d0] = *(const bf16x8*)(qp + d0 * 16);
}

template <int DQK, int DV, bool MASKED>
__device__ __forceinline__ void attn_core(bf16_t* P, const Item& it, const bf16x8 (&qr)[DQK / 16], int k1col, int k2col, int vcol, int ocol, int ocol1, const unsigned* bmq, LAS unsigned char* lds) {
    typedef Geo<DQK, DV> G; constexpr int SHMV = 64 * DV * 2, NDB = DV / 32;
    int tid = threadIdx.x; asm volatile("" : "+v"(tid));
    const int wid = __builtin_amdgcn_readfirstlane(tid >> 6), lane = tid & 63, r32 = lane & 31, hi = lane >> 5;
    LAS unsigned char* V_lds = lds; LAS unsigned char* K_lds = lds + G::LDS_K0; LAS float* wsf = (LAS float*)(lds + G::LDS_WS) + wid * 64;
    const int sr = tid >> 4, sc = (tid & 15) * 8;
    const int vst0 = v_st(sr, sc), vst1 = v_st(32 + sr, sc), kws0 = FA_KSWZ(sr, sc * 2, G::KP), kws1 = FA_KSWZ(sr + 32, sc * 2, G::KP);
    const int xr = tid >> 3, xc = (tid & 7) * 8, kws2 = FA_KSWZ(xr, (128 + xc) * 2, G::KP);
    const unsigned loff0 = (unsigned)(sr * PW + sc) * 2u, loffx = (unsigned)(xr * PW + xc) * 2u;
    const int vb0 = (int)(unsigned)(size_t)V_lds + v_rd_base(lane);
    const int NT = it.nt;
    const int qk = it.qk0 + wid * 32 + r32;
    const bool use_bm = MASKED && (bmq != nullptr);
    const unsigned bmoff = (unsigned)((wid * 32 + r32) * BMW) * 4u;
    float l_reg = 0.f; f32x16 o[NDB];
#pragma unroll
    for (int d = 0; d < NDB; ++d) o[d] = (f32x16){0.f,0.f,0.f,0.f,0.f,0.f,0.f,0.f,0.f,0.f,0.f,0.f,0.f,0.f,0.f,0.f};
    bf16x8 sk0, sk1, sk2, sv0, sv1, sv2, sv3;
#define FA_KROW0(t) ((t) == 0 ? (MBLK - 64) : it.tokbase + 64 * ((t) - 1))
#define FA_LOADK(t) do { const int kr_ = FA_KROW0(t); const char* rb_ = (const char*)(P + (size_t)kr_ * PW); const char* rk_ = rb_ + (size_t)k1col * 2; \
        sk0 = *(const bf16x8*)(rk_ + loff0); sk1 = *(const bf16x8*)(rk_ + (size_t)32 * PW * 2 + loff0); if (DQK == 192) sk2 = *(const bf16x8*)(rb_ + (size_t)k2col * 2 + loffx); } while (0)
#define FA_LOADV(t) do { const char* rv_ = (const char*)(P + (size_t)FA_KROW0(t) * PW) + (size_t)vcol * 2; \
        sv0 = *(const bf16x8*)(rv_ + loff0); sv1 = *(const bf16x8*)(rv_ + (size_t)32 * PW * 2 + loff0); if (DV == 256) { sv2 = *(const bf16x8*)(rv_ + 256 + loff0); sv3 = *(const bf16x8*)(rv_ + 256 + (size_t)32 * PW * 2 + loff0); } } while (0)
#define FA_LOAD(t) do { FA_LOADK(t); FA_LOADV(t); } while (0)
#define FA_WRITE(bf) do { *(LAS bf16x8*)(K_lds + (bf) * G::SHM_K + kws0) = sk0; *(LAS bf16x8*)(K_lds + (bf) * G::SHM_K + kws1) = sk1; \
        *(LAS bf16x8*)(V_lds + (bf) * SHMV + vst0) = sv0; *(LAS bf16x8*)(V_lds + (bf) * SHMV + vst1) = sv1; if (DV == 256) { *(LAS bf16x8*)(V_lds + (bf) * SHMV + 16384 + vst0) = sv2; *(LAS bf16x8*)(V_lds + (bf) * SHMV + 16384 + vst1) = sv3; } \
        if (DQK == 192) *(LAS bf16x8*)(K_lds + (bf) * G::SHM_K + kws2) = sk2; } while (0)
    constexpr int QREG = (DV == 256) ? 3 : DQK / 16;
    constexpr int NQL = DQK / 16 - QREG;
    static_assert(G::BYTES + 8 * NQL * 64 * 16 <= LDSCTL_OFF, "attention LDS budget");
    LAS unsigned char* qx = lds + G::BYTES + (wid * (NQL * 64) + lane) * 16;
    if (QREG < DQK / 16) {
#pragma unroll
        for (int d0 = QREG; d0 < DQK / 16; ++d0) *(LAS bf16x8*)(qx + (d0 - QREG) * 1024) = qr[d0];
    }
    FA_LOAD(0); FA_WRITE(0);
    __syncthreads();
    for (int t = 0; t < NT; ++t) {
        const int cur = t & 1;
        unsigned zb = 0u; asm volatile("" : "+v"(zb)); u32x2 bw = (u32x2){zb, zb};
        if (use_bm) bw = *(const u32x2*)((const char*)(bmq + 2 * t) + bmoff);
        f32x16 p0 = (f32x16){0.f,0.f,0.f,0.f,0.f,0.f,0.f,0.f,0.f,0.f,0.f,0.f,0.f,0.f,0.f,0.f}, p1 = p0;
        { LAS unsigned char* kbase = K_lds + cur * G::SHM_K;
          LAS unsigned char* kb[4];
#pragma unroll
          for (int dd = 0; dd < 4; ++dd) kb[dd] = kbase + FA_KSWZ(r32, (dd * 16 + hi * 8) * 2, G::KP);
          constexpr int GS = (DQK == 192 || DV == 256) ? 2 : 4;
#pragma unroll
          for (int g = 0; g < DQK / (16 * GS); ++g) {
              bf16x8 fb0[GS], fb1[GS];
#pragma unroll
              for (int dd = 0; dd < GS; ++dd) { const int d0 = g * GS + dd; LAS unsigned char* a = kb[d0 & 3] + (d0 >> 2) * 128; fb0[dd] = *(const LAS bf16x8*)a; fb1[dd] = *(const LAS bf16x8*)(a + 32 * G::KP); }
              FA_SBAR();
#pragma unroll
              for (int dd = 0; dd < GS; ++dd) { const int d0 = g * GS + dd; bf16x8 qf; if (d0 < QREG) qf = qr[d0 < QREG ? d0 : 0]; else qf = *(const LAS bf16x8*)(qx + (d0 - QREG) * 1024);
                  p0 = __builtin_amdgcn_mfma_f32_32x32x16_bf16(fb0[dd], qf, p0, 0, 0, 0); p1 = __builtin_amdgcn_mfma_f32_32x32x16_bf16(fb1[dd], qf, p1, 0, 0, 0); }
              FA_SBAR(); } }
        if (t + 1 < NT) { FA_LOADK(t + 1); if (DV != 256) FA_LOADV(t + 1); }
        FA_SBAR();
        const float NEG = -__builtin_inff();
        if (use_bm) {
        } else if (t == 0 || 64 * t + 63 > it.qk0 + wid * 32) {
            const int kb_ = 64 * t + 4 * hi;
#pragma unroll
            for (int r = 0; r < 16; ++r) { const int k0 = kb_ + (r & 3) + 8 * (r >> 2), k1 = k0 + 32;
                if (k0 < 48 || k0 > qk) p0[r] = NEG; if (k1 < 48 || k1 > qk) p1[r] = NEG; }
        }
        float ps = 0.f;
#pragma unroll
        for (int r = 0; r < 16; ++r) { p0[r] = __builtin_amdgcn_exp2f(p0[r]); p1[r] = __builtin_amdgcn_exp2f(p1[r]); }
        if (use_bm) {
            const int wx = (int)(bw.x >> (4 * hi)), wy = (int)(bw.y >> (4 * hi));
#pragma unroll
            for (int r = 0; r < 16; ++r) { const int c = (r & 3) + 8 * (r >> 2);
                p0[r] = __uint_as_float(__float_as_uint(p0[r]) & (unsigned)__builtin_amdgcn_sbfe(wx, c, 1)); p1[r] = __uint_as_float(__float_as_uint(p1[r]) & (unsigned)__builtin_amdgcn_sbfe(wy, c, 1)); }
        }
        { f32x2 s2 = (f32x2){p0[0], p0[1]} + (f32x2){p1[0], p1[1]};
#pragma unroll
          for (int r = 2; r < 16; r += 2) s2 += (f32x2){p0[r], p0[r + 1]} + (f32x2){p1[r], p1[r + 1]};
          ps = s2.x + s2.y; }
        { auto rr = __builtin_amdgcn_permlane32_swap(__float_as_uint(ps), __float_as_uint(ps), false, false); ps = __uint_as_float(rr[0]) + __uint_as_float(rr[1]); }
        l_reg += ps;
        if (DV == 256 && t + 1 < NT) { FA_SBAR(); FA_LOADV(t + 1); FA_SBAR(); }
        bf16x8 pa0, pa1, pa2, pa3;
#define FA_PK4(Pv, B_, OUT) do { const unsigned a0 = cvt_pk_bf16(Pv[B_ + 0], Pv[B_ + 1]), a1 = cvt_pk_bf16(Pv[B_ + 2], Pv[B_ + 3]), b0 = cvt_pk_bf16(Pv[B_ + 4], Pv[B_ + 5]), b1 = cvt_pk_bf16(Pv[B_ + 6], Pv[B_ + 7]); \
        auto r0 = __builtin_amdgcn_permlane32_swap(a0, b0, false, false); auto r1 = __builtin_amdgcn_permlane32_swap(a1, b1, false, false); \
        u32x4 w_ = {r0[0], r1[0], r0[1], r1[1]}; OUT = __builtin_bit_cast(bf16x8, w_); } while (0)
        FA_PK4(p0, 0, pa0); FA_PK4(p0, 8, pa1); FA_PK4(p1, 0, pa2); FA_PK4(p1, 8, pa3);
#define FA_TRRD(dst, off) asm volatile("ds_read_b64_tr_b16 %0, %1 offset:%2" : "=&v"(dst) : "v"(vbc), "i"(off) : "memory")
#define FA_PV(VB, d0) do { s16x4 l0, l1, l2, l3, h0, h1, h2, h3; constexpr int b_ = ((d0) >> 2) * 16384 + v_rd_off((d0) & 3, 0, 0); \
        FA_TRRD(l0, b_); FA_TRRD(h0, b_ + 2048); FA_TRRD(l1, b_ + 4096); FA_TRRD(h1, b_ + 6144); FA_TRRD(l2, b_ + 8192); FA_TRRD(h2, b_ + 10240); FA_TRRD(l3, b_ + 12288); FA_TRRD(h3, b_ + 14336); \
        asm volatile("s_waitcnt lgkmcnt(0)" ::: "memory"); FA_SBAR(); \
        o[d0] = __builtin_amdgcn_mfma_f32_32x32x16_bf16(pa0, (bf16x8){l0[0], l0[1], l0[2], l0[3], h0[0], h0[1], h0[2], h0[3]}, o[d0], 0, 0, 0); \
        o[d0] = __builtin_amdgcn_mfma_f32_32x32x16_bf16(pa1, (bf16x8){l1[0], l1[1], l1[2], l1[3], h1[0], h1[1], h1[2], h1[3]}, o[d0], 0, 0, 0); \
        o[d0] = __builtin_amdgcn_mfma_f32_32x32x16_bf16(pa2, (bf16x8){l2[0], l2[1], l2[2], l2[3], h2[0], h2[1], h2[2], h2[3]}, o[d0], 0, 0, 0); \
        o[d0] = __builtin_amdgcn_mfma_f32_32x32x16_bf16(pa3, (bf16x8){l3[0], l3[1], l3[2], l3[3], h3[0], h3[1], h3[2], h3[3]}, o[d0], 0, 0, 0); } while (0)
        FA_SBAR();
        { const int vbc = vb0 + cur * SHMV;
          FA_PV(0, 0); FA_PV(0, 1); FA_PV(0, 2); FA_PV(0, 3); if (DV == 256) { FA_PV(0, 4); FA_PV(0, 5); FA_PV(0, 6); FA_PV(0, 7); } }
        FA_SBAR();
        if (t + 1 < NT) { const int nb_ = cur ^ 1; FA_WRITE(nb_); }
        __syncthreads();
    }
    if (hi == 0) wsf[r32] = l_reg; LDS_WAIT();
    float rli[16];
#pragma unroll
    for (int r = 0; r < 16; ++r) { const float lv = wsf[crow(r, hi)]; rli[r] = lv > 0.f ? __builtin_amdgcn_rcpf(lv) : 0.f; }
    { int l2 = lane; asm volatile("" : "+v"(l2));
      const int r32b = l2 & 31, hib = l2 >> 5;
      char* Ow = (char*)(P + (size_t)(it.qrow0 + wid * 32) * PW + ocol) + (unsigned)((4 * hib) * PW + r32b) * 2u;
      char* Ow1 = (char*)(P + (size_t)(it.qrow0 + wid * 32) * PW + ocol1) + (unsigned)((4 * hib) * PW + r32b) * 2u;
#pragma unroll
      for (int r = 0; r < 16; ++r) { const unsigned ro = (unsigned)(((r & 3) + 8 * (r >> 2)) * PW) * 2u;
#pragma unroll
        for (int d0 = 0; d0 < NDB; ++d0) { const float v = o[d0][r] * rli[r]; const float vn = __shfl_xor(v, 1);
            if ((r32b & 1) == 0) *(unsigned*)((d0 < 4 ? Ow : Ow1) + ro + (d0 & 3) * 64) = cvt_pk_bf16(v, vn); } } }
    LDS_WAIT();
    __syncthreads();
#undef FA_KROW0
#undef FA_LOAD
#undef FA_LOADK
#undef FA_LOADV
#undef FA_WRITE
#undef FA_PK4
#undef FA_TRRD
#undef FA_PV
}
__device__ __forceinline__ int next_item(unsigned* ctr, LAS int* slot) {
    __syncthreads();
    if (threadIdx.x == 0) *slot = (int)__hip_atomic_fetch_add(ctr, 1u, __ATOMIC_RELAXED, __HIP_MEMORY_SCOPE_AGENT);
    __syncthreads();
    return *slot;
}
__device__ __forceinline__ void queue_prime(unsigned* ctr, LAS int* slot) {
    __syncthreads();
    if (threadIdx.x == 0) slot[0] = (int)__hip_atomic_fetch_add(ctr, 1u, __ATOMIC_RELAXED, __HIP_MEMORY_SCOPE_AGENT);
    __syncthreads();
}
__device__ __forceinline__ int queue_next(unsigned* ctr, LAS int* slot, int k) {
    const int idx = slot[k & 1];
    if (threadIdx.x == 0) slot[(k + 1) & 1] = (int)__hip_atomic_fetch_add(ctr, 1u, __ATOMIC_RELAXED, __HIP_MEMORY_SCOPE_AGENT);
    return idx;
}
__device__ __forceinline__ Item make_item(bool meta, int b, int qb) {
    Item it;
    if (meta) { it.qrow0 = 0; it.qk0 = -(MBLK - 64); it.nt = 1; it.tokbase = MBLK; }
    else { it.qrow0 = MBLK + b * SEQ + qb * 256; it.qk0 = 64 + qb * 256; it.nt = 4 * (qb + 1) + 1; it.tokbase = MBLK + b * SEQ; }
    return it;
}
}


constexpr int PH_PER_LAYER = 19, N_PHASES = 2 * PH_PER_LAYER;
__device__ __forceinline__ unsigned char* uni_ptr(unsigned char* p) { const unsigned long long v = (unsigned long long)p; const unsigned lo = __builtin_amdgcn_readfirstlane((unsigned)v), hi = __builtin_amdgcn_readfirstlane((unsigned)(v >> 32)); return (unsigned char*)(((unsigned long long)hi << 32) | lo); }
__device__ __forceinline__ const float* arg_in(const Args& a, int k) { asm volatile("" : "+s"(k)); return a.in[k]; }
__global__ void __launch_bounds__(NWAVES * 64, 2) mega_fwd(Args args) {
    extern __shared__ __attribute__((aligned(16))) unsigned char lds_raw[];
    {
        LAS unsigned char* l0 = (LAS unsigned char*)lds_raw;
        for (int u = threadIdx.x; u < (LDS_BYTES - LDSCTL_OFF) / 4; u += NWAVES * 64) ((LAS unsigned*)(l0 + LDSCTL_OFF))[u] = 0u;
        __syncthreads();
    }
#if MK_ONE_LAUNCH
    (void)xcd_barrier_post((unsigned*)(args.ws + WS_CTL) + CW_BAR, (volatile LAS unsigned*)((LAS unsigned char*)lds_raw + LDSCTL_OFF + 64));
#define GRID_BAR() do { XcdBarrier bar_; bar_.bar = (unsigned*)(uni_ptr(args.ws) + WS_CTL) + CW_BAR; bar_.x = xb_xcc_id(); bar_.st = (volatile LAS unsigned*)((LAS unsigned char*)lds_raw + LDSCTL_OFF + 64); xcd_barrier(bar_); } while (0)
#else
#define GRID_BAR() do {} while (0)
#endif
    const int lo = args.ph_lo, hi = args.ph_hi;
#define IN(k) (lo <= (k) && (k) < hi)
#define SEAM(k) do { if (IN((k) + 1)) GRID_BAR(); } while (0)
#define PH_BEGIN \
    int tid_ = threadIdx.x; asm volatile("" : "+v"(tid_)); \
    Ctx F; F.lds = (LAS unsigned char*)lds_raw; F.tid = tid_; F.lane = tid_ & 63; F.wave = __builtin_amdgcn_readfirstlane(tid_ >> 6); \
    F.G = gridDim.x; F.bid = blockIdx.x; F.gw = F.bid * NWAVES + F.wave; F.ngw = F.G * NWAVES; \
    unsigned char* ws = uni_ptr(args.ws); asm volatile("" : "+s"(ws)); ws = (unsigned char*)(__attribute__((address_space(1))) unsigned char*)(unsigned long long)ws;     \
    int ly = __builtin_amdgcn_readfirstlane(layer); asm volatile("" : "+s"(ly)); (void)ly; (void)F
#define XN_ ((bf16_t*)(ws + WS_XN))
#define P_ ((bf16_t*)(ws + WS_P))
#define HMETA_ ((float*)(ws + WS_HMETA))
#define RSQ_(ly) ((rs_t*)(ws + WS_CTL + WS_RS2) + (size_t)(2 * (ly)) * R)
#define RSKV_(ly) ((rs_t*)(ws + WS_CTL + WS_RS2) + (size_t)(2 * (ly) + 1) * R)
#define BM_ ((unsigned*)(ws + WS_BM))
#define RS_(i) ((rs_t*)(ws + WS_CTL + WS_RS) + (size_t)(i) * R)
#define GPERM_ ((float*)(ws + WS_RSTD + 512 * 1024))
#define WB_(off) ((bf16_t*)(ws + WS_WB + (off)))
#define OUT_ (args.out)
#define LAMBDA_INIT(ly) ((ly) == 0 ? 0.2f : (0.8f - 0.6f * 0.7408182206817179f))

#pragma unroll
    for (int layer = 0; layer < 2; ++layer) {
        const int pb = layer * PH_PER_LAYER;
        if (((PHMASK >> 0) & 1) && IN(pb + 0)) {
            PH_BEGIN;
            for (int rep_ = 0; rep_ < NREP(0); ++rep_) { if (rep_) GRID_BAR();
            const float* meta = arg_in(args, 1);
            conv_matrix<1>(F, arg_in(args, 3) + (size_t)ly * DM * D_IN, DM, D_IN, WB_(WB_IN), arg_in(args, 2) + ly * DM);
            conv_matrix<0>(F, arg_in(args, 7) + (size_t)ly * 512 * 1536, 512, 1536, WB_(WB_QUP), arg_in(args, 5) + ly * 512);
            conv_matrix<0>(F, arg_in(args, 8) + (size_t)ly * 512 * 2048, 512, 2048, WB_(WB_KVUP), arg_in(args, 6) + ly * 512);
            for (int b = 0; b < 3; ++b) conv_matrix<0>(F, arg_in(args, 14) + ((size_t)ly * 3 + b) * 1024 * DM, 1024, DM, WB_(WB_BR) + (size_t)b * DM * 1024, nullptr);
            conv_matrix<0>(F, arg_in(args, 15) + (size_t)ly * DM * DM, DM, DM, WB_(WB_O), nullptr);
            conv_matrix<2>(F, arg_in(args, 17) + (size_t)ly * DM * 2 * DFF, DM, 2 * DFF, WB_(WB_F1), arg_in(args, 16) + ly * DM);
            conv_matrix<0>(F, arg_in(args, 18) + (size_t)ly * DFF * DM, DFF, DM, WB_(WB_F2), nullptr);
            unsigned zu = 0u; asm volatile("" : "+v"(zu)); const float zf = __uint_as_float(zu);
            for (int i = F.gw * 64 + F.lane; i < 112 * 2048 / 8; i += F.ngw * 64) *((u32x4*)(WB_(WB_IN) + (size_t)1168 * 2048) + i) = (u32x4){zu, zu, zu, zu};
            if (F.bid == 0) { const int i = F.tid; const int t = i >> 7, ps = i & 127, dim = (ps >> 1) + 64 * (ps & 1);
                const float* gsrc = (t < 2 ? arg_in(args, 10) : arg_in(args, 11)) + ly * 256 + (t & 1) * 128; GPERM_[i] = gsrc[dim]; }
            float* hmeta = HMETA_;
            if (ly == 0) {
                for (int i = F.gw * 64 + F.lane; i < MROW0 * PW / 8; i += F.ngw * 64) *((u32x4*)P_ + i) = (u32x4){zu, zu, zu, zu};
                for (int i = F.gw * 64 + F.lane; i < MBLK * DM / 4; i += F.ngw * 64) { const int rr = i / (DM / 4); f32x4 v = (f32x4){zf, zf, zf, zf};
                    if (rr >= MBLK - NMETA) v = *((const f32x4*)meta + (i - (MBLK - NMETA) * (DM / 4))); *((f32x4*)hmeta + i) = v; }
            }
            if (ly == 0) {
                const float* xin = arg_in(args, 0); bf16_t* XN = XN_; rs_t* rs0 = RS_(0);
                for (int r = MROW0 + F.gw; r < R; r += 2 * F.ngw) {
                    const int r2 = (r + F.ngw < R) ? r + F.ngw : r; f32x4 va[8], vb[8];
                    norm_load(r < MBLK ? meta + (size_t)(r - MROW0) * DM : xin + (size_t)(r - MBLK) * DM, F.lane, va); norm_load(r2 < MBLK ? meta + (size_t)(r2 - MROW0) * DM : xin + (size_t)(r2 - MBLK) * DM, F.lane, vb);
                    norm_fin(va, XN + (size_t)r * DM, rs0 + r, F.lane); if (r2 != r) norm_fin(vb, XN + (size_t)r2 * DM, rs0 + r2, F.lane); }
            }
            }
            SEAM(pb + 0);
        }
        if (((PHMASK >> 1) & 1) && IN(pb + 1)) {
            PH_BEGIN;
            { SkP f{P_, 0, RS_(2 * ly), 1.f / DM, RSQ_(ly), RSKV_(ly)}; skinny_gemm(F.lds, XN_ + (size_t)MROW0 * DM, DM, WB_(WB_IN), DM, 1280 / 16, F.bid, F.G, f); }
            SchedPlain S{XN_, DM, WB_(WB_IN), DM, NPMM, 5, F.G, F.bid, 0}; EpiP E{P_, RS_(2 * ly), RS_(2 * ly), 1 << 30, 1.f / DM, RSQ_(ly), RSKV_(ly)};
            pg8::gemm_phase(F.lds, S, E);
            if (NREP(1) == 2) { GRID_BAR(); pg8::gemm_phase(F.lds, S, E); }
            SEAM(pb + 1);
        }
        if (((PHMASK >> 2) & 1) && IN(pb + 2)) {
            PH_BEGIN;
            { SkP f{P_, C_QRAW, RSQ_(ly), 1.f / 512.f, nullptr, nullptr}; skinny_gemm(F.lds, P_ + (size_t)MROW0 * PW + C_CQ, PW, WB_(WB_QUP), 512, 1536 / 16, F.bid, F.G, f); }
            { SkP f{P_, C_KVRAW, RSKV_(ly), 1.f / 512.f, nullptr, nullptr}; skinny_gemm(F.lds, P_ + (size_t)MROW0 * PW + C_CKV, PW, WB_(WB_KVUP), 512, 2048 / 16, F.bid, F.G, f); }
            SchedMlaUp S{P_, WB_(WB_QUP), WB_(WB_KVUP), F.G, F.bid}; EpiP E{P_, RSQ_(ly), RSKV_(ly), 6, 1.f / 512.f, nullptr, nullptr};
            pg8::gemm_phase(F.lds, S, E);
            if (NREP(2) == 2) { GRID_BAR(); pg8::gemm_phase(F.lds, S, E); }
            SEAM(pb + 2);
        }
        if (((PHMASK >> 3) & 1) && IN(pb + 3)) {
            PH_BEGIN;
            const float* mla_qkg = arg_in(args, 9) + ly * 2 * 192;
            bf16_t* P = P_;
            LAS float* rnl = (LAS float*)(F.lds + F.wave * 64);
            for (int r = MROW0 + F.gw; r < R; r += 2 * F.ngw) {
                const int r2 = (r + F.ngw < R) ? r + F.ngw : r; u32x4 va[9], vb[9]; unsigned ia, ib;
                post2_load(P, r, F.lane, va, ia); post2_load(P, r2, F.lane, vb, ib);
                post2_row(P, r, va, ia, mla_qkg, rnl, F.lane); if (r2 != r) post2_row(P, r2, vb, ib, mla_qkg, rnl, F.lane); }
            SEAM(pb + 3);
        }
        if (((PHMASK >> 4) & 1) && IN(pb + 4)) {
            PH_BEGIN;
            bf16_t* P = P_;
            LAS int* slot = (LAS int*)(F.lds + LDSCTL_OFF + 128);
            for (int rep_ = 0; rep_ < NREP(4); ++rep_) { if (rep_) GRID_BAR();
            unsigned* ctr = (unsigned*)(ws + WS_CTL) + CW_Q + 64 * (ly * 4 + 0) + 64 * 16 * rep_;
            const bool stat = (F.G == 256); const int sx = F.bid & 7, spl = (F.bid >> 3) >> 2, sj = (F.bid >> 3) & 3;
            if (!stat) fa::queue_prime(ctr, slot);
            for (int qk_ = 0;; ++qk_) {
                int idx;
                if (stat) { if (qk_ < 4) { const int pr = sx + 8 * (spl + 8 * (qk_ >> 1)), qb = (qk_ & 1) ? sj : 7 - sj; idx = (7 - qb) * 128 + pr; } else idx = (qk_ == 4 && F.bid < 8) ? 1024 + F.bid : 1 << 30; }
                else idx = fa::queue_next(ctr, slot, qk_);
                if (idx >= 8 * 129) break;
                int h; fa::Item it;
                if (idx < 1024) { const int qb = 7 - (idx >> 7), rest = idx & 127; h = rest & 7; it = fa::make_item(false, rest >> 3, qb); } else { h = idx - 1024; it = fa::make_item(true, 0, 0); }
                bf16x8 qr[12]; fa::load_q<192>(P, it, C_QRAW + h * 192, qr);
                fa::attn_core<192, 128, false>(P, it, qr, C_KVRAW + h * 256, C_KPEH + h * 64, C_KVRAW + h * 256 + 128, C_OA + h * 128, 0, nullptr, F.lds);
            } }
            SEAM(pb + 4);
        }
        if (((PHMASK >> 5) & 1) && IN(pb + 5)) {
            PH_BEGIN;
            { SkP f{P_, 1280, RS_(2 * ly), 1.f / DM, nullptr, nullptr}; skinny_gemm(F.lds, XN_ + (size_t)MROW0 * DM, DM, WB_(WB_IN) + (size_t)1280 * DM, DM, 7168 / 16, F.bid, F.G, f); }
            SchedPlain S{XN_, DM, WB_(WB_IN) + (size_t)1280 * DM, DM, NPMM, 28, F.G, F.bid, 1280}; EpiG2 E{P_, RS_(2 * ly), GPERM_, (LAS float*)(F.lds + RING_BYTES)};
            pg8::gemm_phase(F.lds, S, E);
            if (NREP(5) == 2) { GRID_BAR(); pg8::gemm_phase(F.lds, S, E); }
            SEAM(pb + 5);
        }
        if (((PHMASK >> 6) & 1) && IN(pb + 6)) {
            PH_BEGIN;
            bf16_t* P = P_; const float* gp = GPERM_;
            if (F.gw < NMETA) meta_post_row(P, MROW0 + F.gw, gp, F.lane);
        }
        if (((PHMASK >> 7) & 1) && IN(pb + 7)) {
            PH_BEGIN;
            bf16_t* P = P_; unsigned* bm = BM_;
            unsigned* ctr = (unsigned*)(ws + WS_CTL) + CW_Q + 64 * (ly * 4 + 2);
            LAS int* slot = (LAS int*)(F.lds + LDSCTL_OFF + 128);
            for (int rep_ = 0; rep_ < NREP(7); ++rep_) { if (rep_) GRID_BAR(); unsigned* c2 = ctr + 64 * 16 * rep_;
            for (;;) { const int idx = fa::next_item(c2, slot); if (idx >= NTOK / 8) break; index_unit(P, idx, bm, F.lds); } }
            SEAM(pb + 7);
        }
        if (((PHMASK >> 8) & 1) && IN(pb + 8)) {
            PH_BEGIN;
            bf16_t* P = P_; unsigned* bm = BM_;
            LAS int* slot = (LAS int*)(F.lds + LDSCTL_OFF + 128);
            for (int rep_ = 0; rep_ < NREP(8); ++rep_) { if (rep_) GRID_BAR();
            const bool dummy = (NREP(8) == 2) && rep_ == 0;
            unsigned* ctr = (unsigned*)(ws + WS_CTL) + CW_Q + 64 * (ly * 4 + 1) + 64 * 16 * rep_;
            const bool stat = (F.G == 256); const int sx = F.bid & 7, spl = (F.bid >> 3) >> 2, sj = (F.bid >> 3) & 3;
            if (!stat) fa::queue_prime(ctr, slot);
            for (int qk_ = 0;; ++qk_) {
                int idx;
                if (stat) { if (qk_ < 8) { const int pr = sx + 8 * (spl + 8 * ((qk_ >> 1) & 1)), qb = (qk_ & 1) ? sj : 7 - sj; idx = (7 - qb) * 256 + ((qk_ >> 2) ? 128 : 0) + pr; } else idx = (qk_ == 8 && F.bid < 16) ? 2048 + F.bid : 1 << 30; }
                else idx = fa::queue_next(ctr, slot, qk_);
                if (idx >= 16 * 129) break;
                int hh; bool meta = false; fa::Item it; int b = 0, qb = 0;
                if (idx < 2048) { qb = 7 - (idx >> 8); const int rest = idx & 255; hh = (rest < 128) ? 8 + (rest & 7) : (rest & 7); b = (rest & 127) >> 3; it = fa::make_item(false, b, qb); }
                else { hh = idx - 2048; hh = hh < 8 ? 8 + hh : hh - 8; meta = true; it = fa::make_item(true, 0, 0); }
                if (hh < 8) {
                    bf16x8 qr[8]; fa::load_q<128>(P, it, C_DQ + hh * 128, qr);
                    fa::attn_core<128, 128, true>(P, it, qr, C_DK + hh * 128, 0, C_DV + hh * 128, dummy ? C_KPE : C_OB + hh * 128, 0, meta ? nullptr : bm + (size_t)(b * SEQ + qb * 256) * BMW, F.lds);
                } else {
                    const int hj = hh - 8;
                    bf16x8 qr[8]; fa::load_q<128>(P, it, C_FQ + hj * 128, qr);
                    fa::attn_core<128, 256, false>(P, it, qr, C_FK + hj * 128, 0, C_FV + (hj >> 1) * 256, dummy ? C_KPE : C_FQ + hj * 128, dummy ? C_KPE : C_IQ + hj * 128, nullptr, F.lds);
                }
            } }
            SEAM(pb + 8);
        }
        if (((PHMASK >> 9) & 1) && IN(pb + 9)) {
            PH_BEGIN;
            const float* diff_lam = arg_in(args, 12) + ly * 4 * 128; const float* diff_subg = arg_in(args, 13) + ly * 256;
            const float lambda_init = LAMBDA_INIT(ly);
            const float s1 = wave_sum(diff_lam[F.lane] * diff_lam[128 + F.lane] + diff_lam[64 + F.lane] * diff_lam[192 + F.lane]);
            const float s2 = wave_sum(diff_lam[256 + F.lane] * diff_lam[384 + F.lane] + diff_lam[320 + F.lane] * diff_lam[448 + F.lane]);
            const float lam = __expf(s1) - __expf(s2) + lambda_init;
            bf16_t* P = P_;
            for (int r = MROW0 + F.gw; r < R; r += 4 * F.ngw) {
                int rr_[4]; u32x4 vv[4][4];
#pragma unroll
                for (int k = 0; k < 4; ++k) { rr_[k] = (r + k * F.ngw < R) ? r + k * F.ngw : r; post3_load(P, rr_[k], F.lane, vv[k]); }
#pragma unroll
                for (int k = 0; k < 4; ++k) if (k == 0 || rr_[k] != r) post3_row(P, rr_[k], vv[k], diff_subg, lam, 1.f - lambda_init, F.lane); }
        }
#define GATE_PHASE(k, b, sk, seam) \
        if (((PHMASK >> 10) & 1) && IN(pb + (k))) { \
            PH_BEGIN; \
            { SkGate f{(bf16_t*)(ws + WS_GS), arg_in(args, 4) + ly * 3 * DM + (b) * DM, RS_(2 * ly)}; skinny_gemm(F.lds, XN_ + (size_t)MROW0 * DM, DM, WB_(WB_G) + (size_t)(b) * 2048 * DM, DM, 2048 / 16, (F.bid + (sk)) % F.G, F.G, f); } \
            SchedPlain S{XN_, DM, WB_(WB_G) + (size_t)(b) * 2048 * DM, DM, NPMM, 8, F.G, F.bid, 0}; EpiGate E{(bf16_t*)(ws + WS_GS), arg_in(args, 4) + ly * 3 * DM + (b) * DM, RS_(2 * ly)}; \
            pg8::gemm_phase(F.lds, S, E); \
            if (NREP(k) == 2) { GRID_BAR(); pg8::gemm_phase(F.lds, S, E); } \
            if (seam) SEAM(pb + (k)); \
        }
#define BRANCH_PHASE(k, b, oc, sk, seam) \
        if (((PHMASK >> 10) & 1) && IN(pb + (k))) { \
            PH_BEGIN; \
            { SkGated f{P_, (const bf16_t*)(ws + WS_GS), (b) == 0 ? 1 : 0}; skinny_gemm(F.lds, P_ + (size_t)MROW0 * PW + (oc), PW, WB_(WB_BR) + (size_t)(b) * DM * 1024, 1024, 2048 / 16, (F.bid + (sk)) % F.G, F.G, f); } \
            SchedPlain S{P_ + (oc), PW, WB_(WB_BR) + (size_t)(b) * DM * 1024, 1024, NPMM, 8, F.G, F.bid, C_MERGED}; EpiGated E{P_, (const bf16_t*)(ws + WS_GS), (b) == 0 ? 1 : 0, ((DBG_BM >> (b)) & 1) ? 1.f : 0.f}; \
            pg8::gemm_phase(F.lds, S, E); \
            if (NREP(k) == 2 && (b) == 0) { GRID_BAR(); pg8::gemm_phase(F.lds, S, E); } \
            if (seam) SEAM(pb + (k)); \
        }
        GATE_PHASE(10, 0, 0, 0) BRANCH_PHASE(11, 0, C_OA, 0, 0)
        GATE_PHASE(12, 1, 0, 0) BRANCH_PHASE(13, 1, C_OB, 0, 0)
        GATE_PHASE(14, 2, 0, 1) BRANCH_PHASE(15, 2, C_OC, 128, 1)
        if (((PHMASK >> 11) & 1) && IN(pb + 16)) {
            PH_BEGIN;
            { SkRes f{HMETA_, XN_, RS_(2 * ly + 1)}; skinny_gemm(F.lds, P_ + (size_t)MROW0 * PW + C_MERGED, PW, WB_(WB_O), DM, 2048 / 16, F.bid, F.G, f); }
            SchedPlain S{P_ + C_MERGED, PW, WB_(WB_O), DM, NPMM, 8, F.G, F.bid, 0}; EpiRes E{(float*)nullptr, DBG_SA, XN_, RS_(2 * ly + 1)};
            pg8::gemm_phase(F.lds, S, E);
            SEAM(pb + 16);
        }
        if (((PHMASK >> 13) & 1) && IN(pb + 17)) {
            PH_BEGIN;
            skinny_swiglu(F.lds, XN_ + (size_t)MROW0 * DM, DM, WB_(WB_F1), DM, P_, RS_(2 * ly + 1), F.bid, F.G);
            SchedPlain S{XN_, DM, WB_(WB_F1), DM, NPMM, 44, F.G, F.bid, 0}; EpiSwiglu E{P_, RS_(2 * ly + 1)};
            pg8::gemm_phase(F.lds, S, E);
            if (NREP(17) == 2) { GRID_BAR(); pg8::gemm_phase(F.lds, S, E); }
            SEAM(pb + 17);
        }
        if (((PHMASK >> 14) & 1) && IN(pb + 18)) {
            PH_BEGIN;
            { SkRes f{HMETA_, ly == 0 ? XN_ : (bf16_t*)nullptr, RS_(2)}; skinny_gemm(F.lds, P_ + (size_t)MROW0 * PW, PW, WB_(WB_F2), DFF, 2048 / 16, F.bid, F.G, f); }
            SchedPlain S{P_, PW, WB_(WB_F2), DFF, NPMM, 8, F.G, F.bid, 0}; EpiRes E{ly == 0 ? (float*)nullptr : OUT_, DBG_SF, XN_, RS_(2)};
            pg8::gemm_phase(F.lds, S, E);
            SEAM(pb + 18);
        }
    }
#undef IN
#undef SEAM
}

__global__ void diag_fill(float* out, int n, float v) { for (int i = blockIdx.x * blockDim.x + threadIdx.x; i < n; i += gridDim.x * blockDim.x) out[i] = v; }
extern "C" void kernel_launch(void* const* d_in, const int* in_sizes, int n_in, void* d_out, int out_size, void* d_ws, size_t ws_size, hipStream_t stream) {
    static int grid = 0; static float code = 0.f;
    if (grid == 0) {
        int dev = 0, cus = 0;
        if (n_in != 19) { code = 10.f; grid = -1; }
        else if (ws_size < WS_END) { code = 20.f + (float)(ws_size >> 20) * 0.01f; grid = -1; }
        else if (hipGetDevice(&dev) != hipSuccess || hipDeviceGetAttribute(&cus, hipDeviceAttributeMultiprocessorCount, dev) != hipSuccess) { code = 40.f; grid = -1; }
        else if (hipFuncSetAttribute((const void*)mega_fwd, hipFuncAttributeMaxDynamicSharedMemorySize, LDS_BYTES) != hipSuccess) { code = 50.f; grid = -1; }
        else {
            int per_cu = 0;
            if (hipOccupancyMaxActiveBlocksPerMultiprocessor(&per_cu, (const void*)mega_fwd, NWAVES * 64, LDS_BYTES) != hipSuccess || per_cu < 1) { code = 60.f; grid = -1; }
            (void)hipGetLastError();
            if (grid == 0) grid = cus;
        }
    }
    if (grid < 0) { hipLaunchKernelGGL(diag_fill, dim3(1024), dim3(256), 0, stream, (float*)d_out, out_size, code); return; }
    (void)hipMemsetAsync((char*)d_ws + WS_CTL, 0, CTL_BYTES, stream);
    Args a{};
    for (int i = 0; i < 19; ++i) a.in[i] = (const float*)d_in[i];
    a.out = (float*)d_out; a.ws = (unsigned char*)d_ws;
#if MK_ONE_LAUNCH
    a.ph_lo = 0; a.ph_hi = N_PHASES;
    hipLaunchKernelGGL(mega_fwd, dim3(grid), dim3(NWAVES * 64), LDS_BYTES, stream, a);
#else
    for (int p = 0; p < N_PHASES; ++p) { a.ph_lo = p; a.ph_hi = p + 1; hipLaunchKernelGGL(mega_fwd, dim3(grid), dim3(NWAVES * 64), LDS_BYTES, stream, a); }
#endif
    if (hipPeekAtLastError() != hipSuccess) { (void)hipGetLastError(); hipLaunchKernelGGL(diag_fill, dim3(1024), dim3(256), 0, stream, (float*)d_out, out_size, 70.f); }
}
```

```cpp
#include <hip/hip_runtime.h>
#include <cstdio>
#include <cstdint>

#ifndef PHMASK
#define PHMASK 0x7fff
#endif
#ifndef REPMASK
#define REPMASK 0
#endif
#define NREP(k) ((((REPMASK) >> (k)) & 1) ? 2 : 1)
#ifndef DBG_BM
#define DBG_BM 7
#endif
#ifndef DBG_BR
#define DBG_BR 0
#endif
#ifndef DBG_SA
#define DBG_SA 1.0f
#endif
#ifndef DBG_SF
#define DBG_SF 1.0f
#endif
#ifndef MK_ONE_LAUNCH
#define MK_ONE_LAUNCH 1
#endif

#define LAS __attribute__((address_space(3)))
#define GAS __attribute__((address_space(1)))
typedef unsigned short bf16_t;
typedef short bf16x8 __attribute__((ext_vector_type(8)));
typedef float f32x4 __attribute__((ext_vector_type(4)));
typedef float f32x2 __attribute__((ext_vector_type(2)));
typedef unsigned u32x4 __attribute__((ext_vector_type(4)));
typedef unsigned u32x2 __attribute__((ext_vector_type(2)));
typedef unsigned long long rs_t;
__device__ __forceinline__ float rs_val(rs_t v) { return (float)((double)v * (1.0 / 4294967296.0)); }
__device__ __forceinline__ rs_t rs_fix(float ss) { return (rs_t)((double)ss * 4294967296.0); }
__device__ __forceinline__ void st_wt(void* p, u32x4 v) { typedef __attribute__((address_space(1))) u32x4 gv; *(gv*)(unsigned long long)p = v; }
__device__ __forceinline__ void st_wt(void* p, f32x4 v) { typedef __attribute__((address_space(1))) f32x4 gv; *(gv*)(unsigned long long)p = v; }

constexpr int DM = 2048, NB = 16, SEQ = 2048, NMETA = 16, MBLK = 256;
constexpr int R = MBLK + NB * SEQ;
constexpr int NPM = R / 256;
constexpr int NPMM = NPM - 1;
constexpr int MROW0 = MBLK - NMETA;
constexpr int NTOK = NB * SEQ;
constexpr int DFF = 5632;
constexpr int PW = 8448;
constexpr int C_CQ = 0, C_CKV = 512, C_KPE = 1024, C_IK = 1088, C_IW = 1152, C_DQ = 1280, C_DK = 2304, C_DV = 3328, C_IQ = 4352,
              C_FQ = 5376, C_FK = 6400, C_FV = 7424;
constexpr int C_KVRAW = 1280, C_QRAW = 3328, C_KPEH = 4864;
constexpr int C_OA = 0, C_OB = C_DQ, C_OC = C_FQ, C_MERGED = 2304;
constexpr int BMW = 66;
constexpr float EPS = 1e-6f;
constexpr float LOG2E = 1.4426950408889634f;
constexpr float C2_128 = 0.08838834764831845f * LOG2E;
constexpr float C2_192 = 0.07216878364870323f * LOG2E;
constexpr int D_IN = 14480;

constexpr size_t MiB = 1u << 20;
constexpr size_t WS_CTL = 0, CTL_BYTES = 2816 * 1024;
constexpr size_t WS_RSTD = 13 * MiB;
constexpr size_t WS_HMETA = 14 * MiB;
constexpr size_t WS_BM = 4 * MiB;
constexpr size_t WS_WB = 16 * MiB;
constexpr size_t WB_IN = 0, WB_G = WB_IN + (size_t)8448 * 2048 * 2, WB_QUP = WB_G + (size_t)6144 * 2048 * 2, WB_KVUP = WB_QUP + (size_t)1536 * 512 * 2,
                 WB_BR = WB_KVUP + (size_t)2048 * 512 * 2, WB_O = WB_BR + (size_t)3 * 2048 * 1024 * 2, WB_F1 = WB_O + (size_t)2048 * 2048 * 2,
                 WB_F2 = WB_F1 + (size_t)11264 * 2048 * 2, WB_END = WB_F2 + (size_t)2048 * 5632 * 2;
constexpr size_t WS_XN = 164 * MiB;
constexpr size_t WS_P = 294 * MiB;
constexpr size_t WS_GS = 828 * MiB;
constexpr size_t WS_END = 960 * MiB;
static_assert(WS_GS + (size_t)R * 2048 * 2 <= WS_END && WS_WB + WB_END <= WS_XN && WS_XN + (size_t)R * 2048 * 2 <= WS_P && WS_P + (size_t)R * PW * 2 <= WS_GS, "ws map");
constexpr int CW_BAR = 4096, CW_Q = 16384;
constexpr size_t WS_RS = 256 * 1024;
constexpr size_t WS_RS2 = 1536 * 1024;
static_assert(WS_RS + (size_t)4 * R * 8 <= WS_RS2 && WS_RS2 + (size_t)4 * R * 8 <= CTL_BYTES && CTL_BYTES <= WS_BM && WS_BM + (size_t)32768 * BMW * 4 <= WS_RSTD && WS_RSTD + 1 * MiB <= WS_HMETA && WS_HMETA + 2 * MiB <= WS_WB, "ctl map");

__device__ __forceinline__ float bf2f(bf16_t v) { return __uint_as_float((unsigned)v << 16); }
__device__ __forceinline__ unsigned f2bf(float f) { unsigned u = __float_as_uint(f); return (u + 0x7fffu + ((u >> 16) & 1u)) >> 16; }
__device__ __forceinline__ unsigned pk2(float lo, float hi) { return f2bf(lo) | (f2bf(hi) << 16); }
typedef __bf16 bf16x2_t __attribute__((ext_vector_type(2)));
__device__ __forceinline__ unsigned cvt_pk_bf16(float lo, float hi) { f32x2 v = {lo, hi}; bf16x2_t b = __builtin_convertvector(v, bf16x2_t); return __builtin_bit_cast(unsigned, b); }
__device__ __forceinline__ float wave_sum(float v) {
#pragma unroll
    for (int o = 1; o < 64; o <<= 1) v += __shfl_xor(v, o);
    return v;
}
__device__ __forceinline__ float wave_max(float v) {
#pragma unroll
    for (int o = 1; o < 64; o <<= 1) v = fmaxf(v, __shfl_xor(v, o));
    return v;
}
#define LDS_WAIT() asm volatile("s_waitcnt lgkmcnt(0)" ::: "memory")
#define VM_WAIT() asm volatile("s_waitcnt vmcnt(0)" ::: "memory")
__device__ __forceinline__ int row_pos(int r) { return r < MBLK ? (r >= MBLK - NMETA ? r - (MBLK - NMETA) : 0) : NMETA + ((r - MBLK) & (SEQ - 1)); }
__device__ __forceinline__ void rope_cs(int pos, int i, float two_over_d, float& c, float& s) {
    const float inv = __builtin_amdgcn_exp2f(-(float)i * two_over_d * 13.287712379549449f);
    float rev = (float)pos * inv * 0.15915494309189535f;
    rev -= floorf(rev);
    s = __builtin_amdgcn_sinf(rev); c = __builtin_amdgcn_cosf(rev);
}

namespace pg8 {
constexpr int BM = 256, BK = 64, HALF = 128, HTB = HALF * BK * 2, STAGE_BYTES = 8 * HTB;
__device__ __forceinline__ int lds_byte(int r, int c) { const int st = (r >> 4) * 2 + (c >> 5), rr = r & 15, cc = c & 31, ob = rr * 64 + cc * 2; return st * 1024 + (ob ^ (((ob >> 9) & 1) << 5)); }
__device__ __forceinline__ void stage_rc(int b, int& R_, int& C_) { const int st = b / 1024, sb = b % 1024, swz = sb ^ (((sb >> 9) & 1) << 5); R_ = (st >> 1) * 16 + swz / 64; C_ = (st & 1) * 32 + (swz % 64) / 2; }
__device__ __forceinline__ int perm32(int rho) { const int n = rho >> 4, i = rho & 15; return 8 * (i >> 2) + 4 * n + (i & 3); }

struct Unit { const char* A; const char* B; unsigned lda2, ldb2; int nt, pm, pn, kind, ocol; };

#ifndef WGM
#define WGM 4
#endif
__device__ __forceinline__ void tile_of(int L, int nM, int nN, int& pm, int& pn) {
    const int nwg = nM * nN; int wgid = L;
    { const int q = nwg / 8, r = nwg % 8, xcd = wgid % 8, off = wgid / 8; wgid = (xcd < r ? xcd * (q + 1) : r * (q + 1) + (xcd - r) * q) + off; }
    const int nig = WGM * nN, gid = wgid / nig, fm = gid * WGM, gsz = (nM - fm) < WGM ? (nM - fm) : WGM;
    pm = fm + ((wgid % nig) % gsz); pn = (wgid % nig) / gsz;
}

template <class Epi, class Sched>
__device__ __forceinline__ void gemm_phase(LAS unsigned char* lds, const Sched& S, const Epi& E) {
    int tid = threadIdx.x; asm volatile("" : "+v"(tid));
    const int wid = __builtin_amdgcn_readfirstlane(tid >> 6), lane = tid & 63, wr = wid >> 2, wc = wid & 3, fr = lane & 15, fq = lane >> 4;
    unsigned rA[2], rB[2], cc[2];
#pragma unroll
    for (int i = 0; i < 2; ++i) { int R_, C_; stage_rc(tid * 16 + i * 8192, R_, C_); rA[i] = (unsigned)R_; rB[i] = (unsigned)(Epi::PERM ? ((R_ & ~31) + perm32(R_ & 31)) : R_); cc[i] = (unsigned)C_ * 2u; }
    const size_t kstep = (size_t)(BK * 2);
    const unsigned ldsw = (unsigned)wid * 1024u;
    const int aoff = lds_byte(wr * 64 + fr, fq * 8), boff = lds_byte(wc * 32 + fr, fq * 8);
#define PG8_SA(b, h) (((b) * 2 + (h)) * HTB)
#define PG8_SB(b, h) ((4 + (b) * 2 + (h)) * HTB)
#define PG8_STAGE(bufoff, gbase, rr, ld2) do { _Pragma("unroll") for (int _i = 0; _i < 2; ++_i) \
        __builtin_amdgcn_global_load_lds((const unsigned*)((const char*)(gbase) + ((rr)[_i] * (ld2) + cc[_i])), (LAS unsigned*)(lds + (bufoff) + ldsw + _i * 8192), 16, 0, 0); } while (0)
#define PG8_LDA(dst, b, h) do { _Pragma("unroll") for (int m = 0; m < 4; ++m) _Pragma("unroll") for (int k = 0; k < 2; ++k) dst[m][k] = *(const LAS bf16x8*)(lds + PG8_SA(b, h) + aoff + m * 2048 + k * 1024); } while (0)
#define PG8_LDB(dst, b, h) do { _Pragma("unroll") for (int n = 0; n < 2; ++n) _Pragma("unroll") for (int k = 0; k < 2; ++k) dst[n][k] = *(const LAS bf16x8*)(lds + PG8_SB(b, h) + boff + n * 2048 + k * 1024); } while (0)
#define PG8_MMA(ai, bj, At, Bt) do { __builtin_amdgcn_s_setprio(1); _Pragma("unroll") for (int m = 0; m < 4; ++m) _Pragma("unroll") for (int n = 0; n < 2; ++n) _Pragma("unroll") for (int k = 0; k < 2; ++k) \
        acc[ai][bj][m][n] = __builtin_amdgcn_mfma_f32_16x16x32_bf16(Bt[n][k], At[m][k], acc[ai][bj][m][n], 0, 0, 0); __builtin_amdgcn_s_setprio(0); } while (0)
#define PG8_WAIT_V(n) asm volatile("s_waitcnt vmcnt(" #n ")" ::: "memory")
#define PG8_WAIT_L(n) asm volatile("s_waitcnt lgkmcnt(" #n ")" ::: "memory")
#define PG8_BAR __builtin_amdgcn_s_barrier()
#define PG8_SCHED __builtin_amdgcn_sched_barrier(0)
    Unit cur, nxt; int ui = 0;
    if (!S.next(0, cur)) return;
    float zf = 0.f; asm volatile("" : "+v"(zf));
    f32x4 acc[2][2][4][2];
#pragma unroll
    for (int a = 0; a < 2; ++a)
#pragma unroll
        for (int b = 0; b < 2; ++b)
#pragma unroll
            for (int m = 0; m < 4; ++m)
#pragma unroll
                for (int n = 0; n < 2; ++n) acc[a][b][m][n] = (f32x4){zf, zf, zf, zf};
    bf16x8 At[4][2], B0[2][2], B1[2][2];
    const char* cA = cur.A; const char* cB = cur.B;
    unsigned lA = cur.lda2, lB = cur.ldb2;
    size_t hA = (size_t)HALF * lA, hB = (size_t)HALF * lB;
    PG8_STAGE(PG8_SB(0, 0), cB, rB, lB); PG8_STAGE(PG8_SB(0, 1), cB + hB, rB, lB); PG8_STAGE(PG8_SA(0, 0), cA, rA, lA); PG8_STAGE(PG8_SA(0, 1), cA + hA, rA, lA);
    if (wr == 1) PG8_BAR;
    PG8_WAIT_V(2); PG8_BAR;
    PG8_STAGE(PG8_SB(1, 0), cB + kstep, rB, lB); PG8_STAGE(PG8_SA(1, 0), cA + kstep, rA, lA); PG8_STAGE(PG8_SB(1, 1), cB + hB + kstep, rB, lB);
    PG8_WAIT_V(6); PG8_BAR;
    for (;;) {
        const bool has_next = S.next(ui + 1, nxt);
        if (!has_next) nxt = cur;
        const char* nA = nxt.A; const char* nB = nxt.B;
        const unsigned lAn = nxt.lda2, lBn = nxt.ldb2;
        const size_t hAn = (size_t)HALF * lAn, hBn = (size_t)HALF * lBn;
        const int nt = cur.nt;
        for (int t = 0; t < nt; t += 2) {
            const bool last = (t == nt - 2);
            const char* a1 = cA + (size_t)(t + 1) * kstep;
            const char* a2 = last ? nA : cA + (size_t)(t + 2) * kstep; const char* b2 = last ? nB : cB + (size_t)(t + 2) * kstep;
            const char* a3 = a2 + kstep; const char* b3 = b2 + kstep;
            const size_t hA2 = last ? hAn : hA, hB2 = last ? hBn : hB;
            const unsigned lA2 = last ? lAn : lA, lB2 = last ? lBn : lB;
            PG8_LDB(B0, 0, 0); PG8_LDB(B1, 0, 1); PG8_SCHED; PG8_LDA(At, 0, 0); PG8_STAGE(PG8_SA(1, 1), a1 + hA, rA, lA);
            PG8_WAIT_V(8); PG8_WAIT_L(0); PG8_BAR; PG8_MMA(0, 0, At, B0); PG8_MMA(0, 1, At, B1); PG8_BAR; PG8_SCHED;
            PG8_LDA(At, 0, 1); PG8_STAGE(PG8_SB(0, 0), b2, rB, lB2); PG8_STAGE(PG8_SB(0, 1), b2 + hB2, rB, lB2); PG8_STAGE(PG8_SA(0, 0), a2, rA, lA2);
            PG8_WAIT_V(8); PG8_WAIT_L(0); PG8_BAR; PG8_MMA(1, 0, At, B0); PG8_MMA(1, 1, At, B1); PG8_BAR; PG8_SCHED;
            PG8_LDB(B0, 1, 0); PG8_LDB(B1, 1, 1); PG8_SCHED; PG8_LDA(At, 1, 0); PG8_STAGE(PG8_SA(0, 1), a2 + hA2, rA, lA2);
            PG8_WAIT_V(8); PG8_WAIT_L(0); PG8_BAR; PG8_MMA(0, 0, At, B0); PG8_MMA(0, 1, At, B1); PG8_BAR; PG8_SCHED;
            PG8_LDA(At, 1, 1); PG8_STAGE(PG8_SB(1, 0), b3, rB, lB2); PG8_STAGE(PG8_SB(1, 1), b3 + hB2, rB, lB2); PG8_STAGE(PG8_SA(1, 0), a3, rA, lA2);
            PG8_WAIT_V(8); PG8_WAIT_L(0); PG8_BAR; PG8_MMA(1, 0, At, B0); PG8_MMA(1, 1, At, B1); PG8_BAR; PG8_SCHED;
        }
        if (wr == 0) PG8_BAR;
        E(acc, cur, wr, wc, fr, fq);
#pragma unroll
        for (int a = 0; a < 2; ++a)
#pragma unroll
            for (int b = 0; b < 2; ++b)
#pragma unroll
                for (int m = 0; m < 4; ++m)
#pragma unroll
                    for (int n = 0; n < 2; ++n) acc[a][b][m][n] = (f32x4){zf, zf, zf, zf};
        if (!has_next) break;
        cur = nxt; cA = nA; cB = nB; hA = hAn; hB = hBn; lA = lAn; lB = lBn; ++ui;
        if (wr == 1) PG8_BAR;
    }
    PG8_WAIT_V(0);
    PG8_BAR;
#undef PG8_SA
#undef PG8_SB
#undef PG8_STAGE
#undef PG8_LDA
#undef PG8_LDB
#undef PG8_MMA
#undef PG8_WAIT_V
#undef PG8_WAIT_L
#undef PG8_BAR
#undef PG8_SCHED
}
}
using pg8::Unit;

struct SchedPlain {
    const bf16_t* A; int lda; const bf16_t* B; int K; int nM, nN, G, c, ocol0;
    __device__ __forceinline__ bool next(int i, Unit& u) const {
        const int L = i * G + c; if (L >= nM * nN) return false;
        int pm, pn; pg8::tile_of(L, nM, nN, pm, pn); pm += 1;
        u.pm = pm; u.pn = pn; u.kind = 0; u.ocol = ocol0 + 256 * pn; u.nt = K / 64; u.lda2 = (unsigned)lda * 2u; u.ldb2 = (unsigned)K * 2u;
        u.A = (const char*)(A + (size_t)pm * 256 * lda); u.B = (const char*)(B + (size_t)pn * 256 * K); return true;
    }
};
struct SchedMlaUp {
    const bf16_t* P; const bf16_t* Wq; const bf16_t* Wkv; int G, c;
    __device__ __forceinline__ bool next(int i, Unit& u) const {
        const int L = i * G + c; if (L >= NPMM * 14) return false;
        int pm, pn; pg8::tile_of(L, NPMM, 14, pm, pn); pm += 1;
        u.pm = pm; u.pn = pn; u.kind = 0; u.nt = 8; u.lda2 = PW * 2u; u.ldb2 = 512 * 2u;
        if (pn < 6) { u.A = (const char*)(P + (size_t)pm * 256 * PW + C_CQ); u.B = (const char*)(Wq + (size_t)pn * 256 * 512); u.ocol = C_QRAW + 256 * pn; }
        else { u.A = (const char*)(P + (size_t)pm * 256 * PW + C_CKV); u.B = (const char*)(Wkv + (size_t)(pn - 6) * 256 * 512); u.ocol = C_KVRAW + 256 * (pn - 6); }
        return true;
    }
};
struct EpiP {
    static constexpr bool PERM = true;
    bf16_t* P; const rs_t* rs; const rs_t* rs2; int split; float inv_dim; rs_t* sq; rs_t* skv;
    __device__ __forceinline__ void operator()(const f32x4 (&acc)[2][2][4][2], const Unit& u, int wr, int wc, int fr, int fq) const {
        asm volatile("" : "+v"(fr), "+v"(fq));
        const int row0 = u.pm * 256 + wr * 64 + fr, col0 = u.ocol + wc * 32 + 8 * fq;
        const rs_t* rsel = u.pn < split ? rs : rs2;
        rs_t* sums = (sq && u.pn < 4) ? (u.pn < 2 ? sq : skv) : (rs_t*)nullptr;
        float rsc[2][4];
#pragma unroll
        for (int ai = 0; ai < 2; ++ai)
#pragma unroll
            for (int m = 0; m < 4; ++m) rsc[ai][m] = rsel ? __builtin_amdgcn_rsqf(rs_val(rsel[row0 + ai * 128 + m * 16]) * inv_dim + EPS) : 1.f;
#pragma unroll
        for (int ai = 0; ai < 2; ++ai)
#pragma unroll
            for (int m = 0; m < 4; ++m) { const int row = row0 + ai * 128 + m * 16; bf16_t* rowp = P + (size_t)row * PW + col0;
                const float sc = rsc[ai][m]; float ss = 0.f;
#pragma unroll
                for (int bj = 0; bj < 2; ++bj) { const f32x4 v0 = acc[ai][bj][m][0] * sc, v1 = acc[ai][bj][m][1] * sc;
                    ss += ((v0[0] * v0[0] + v0[1] * v0[1]) + (v0[2] * v0[2] + v0[3] * v0[3])) + ((v1[0] * v1[0] + v1[1] * v1[1]) + (v1[2] * v1[2] + v1[3] * v1[3]));
                    u32x4 w; w.x = cvt_pk_bf16(v0[0], v0[1]); w.y = cvt_pk_bf16(v0[2], v0[3]); w.z = cvt_pk_bf16(v1[0], v1[1]); w.w = cvt_pk_bf16(v1[2], v1[3]);
                    st_wt(rowp + bj * 128, w); }
                if (sums) { ss += __shfl_xor(ss, 16); ss += __shfl_xor(ss, 32); if (fq == 0) (void)__hip_atomic_fetch_add(sums + row, rs_fix(ss), __ATOMIC_RELAXED, __HIP_MEMORY_SCOPE_AGENT); } }
    }
};
struct EpiG2 {
    static constexpr bool PERM = true;
    bf16_t* P; const rs_t* rs; const float* gperm; LAS float* xl;
    __device__ __forceinline__ void operator()(const f32x4 (&acc)[2][2][4][2], const Unit& u, int wr, int wc, int fr, int fq) const {
        asm volatile("" : "+v"(fr), "+v"(fq));
        const int row0 = u.pm * 256 + wr * 64 + fr, lcol = wc * 32 + 8 * fq, col0 = u.ocol + lcol;
        const int pn = u.pn;
        const bool plain = (pn >= 8 && pn < 12) || pn >= 24, isidx = (pn >= 12 && pn < 16), nrm = !plain && !isidx;
        const int gidx = pn < 4 ? 0 : (pn < 8 ? 1 : (pn < 20 ? 2 : 3));
        f32x4 g0 = (f32x4){1.f, 1.f, 1.f, 1.f}, g1 = g0;
        if (nrm) { g0 = *(const f32x4*)(gperm + gidx * 128 + lcol); g1 = *(const f32x4*)(gperm + gidx * 128 + lcol + 4); }
        float rsc[2][4];
#pragma unroll
        for (int ai = 0; ai < 2; ++ai)
#pragma unroll
            for (int m = 0; m < 4; ++m) rsc[ai][m] = __builtin_amdgcn_rsqf(rs_val(rs[row0 + ai * 128 + m * 16]) * (1.f / DM) + EPS);
        if (nrm) {
#pragma unroll
            for (int ai = 0; ai < 2; ++ai)
#pragma unroll
                for (int m = 0; m < 4; ++m)
#pragma unroll
                    for (int bj = 0; bj < 2; ++bj) { const f32x4 a = acc[ai][bj][m][0], b = acc[ai][bj][m][1]; float ss = (a[0] * a[0] + a[1] * a[1]) + (a[2] * a[2] + a[3] * a[3]) + (b[0] * b[0] + b[1] * b[1]) + (b[2] * b[2] + b[3] * b[3]);
                        ss += __shfl_xor(ss, 16); ss += __shfl_xor(ss, 32);
                        if (fq == 0) xl[((wr * 64 + fr + ai * 128 + m * 16) * 2 + bj) * 4 + wc] = ss * rsc[ai][m] * rsc[ai][m]; }
            asm volatile("s_waitcnt lgkmcnt(0)" ::: "memory"); __builtin_amdgcn_s_barrier(); asm volatile("" ::: "memory");
        }
        const int i0 = isidx ? (16 * (wc & 1) + 4 * fq) : (16 * wc + 4 * fq);
        const float tod = isidx ? (2.f / 64.f) : (2.f / 128.f);
        float inv[4];
#pragma unroll
        for (int j = 0; j < 4; ++j) inv[j] = __builtin_amdgcn_exp2f(-(float)(i0 + j) * tod * 13.287712379549449f) * 0.15915494309189535f;
        const float qscale = (pn < 4 || (pn >= 16 && pn < 20)) ? C2_128 : 1.f;
#pragma unroll
        for (int ai = 0; ai < 2; ++ai)
#pragma unroll
            for (int m = 0; m < 4; ++m) { const int row = row0 + ai * 128 + m * 16; bf16_t* rowp = P + (size_t)row * PW + col0;
                float cs[4], sn[4];
                if (!plain) { const float pos = (float)(NMETA + ((row - MBLK) & (SEQ - 1)));
#pragma unroll
                    for (int j = 0; j < 4; ++j) { float rev = pos * inv[j]; rev -= floorf(rev); sn[j] = __builtin_amdgcn_sinf(rev); cs[j] = __builtin_amdgcn_cosf(rev); } }
#pragma unroll
                for (int bj = 0; bj < 2; ++bj) { f32x4 v0 = acc[ai][bj][m][0] * rsc[ai][m], v1 = acc[ai][bj][m][1] * rsc[ai][m];
                    if (!plain) {
                        if (nrm) { const LAS f32x4* xp = (const LAS f32x4*)(xl + ((wr * 64 + fr + ai * 128 + m * 16) * 2 + bj) * 4); const f32x4 pp = *xp;
                            const float rn = __builtin_amdgcn_rsqf(((pp[0] + pp[1]) + (pp[2] + pp[3])) * (1.f / 128.f) + EPS); v0 = v0 * (g0 * rn); v1 = v1 * (g1 * rn); }
                        f32x4 w0, w1;
                        w0[0] = v0[0] * cs[0] - v0[1] * sn[0]; w0[1] = v0[1] * cs[0] + v0[0] * sn[0]; w0[2] = v0[2] * cs[1] - v0[3] * sn[1]; w0[3] = v0[3] * cs[1] + v0[2] * sn[1];
                        w1[0] = v1[0] * cs[2] - v1[1] * sn[2]; w1[1] = v1[1] * cs[2] + v1[0] * sn[2]; w1[2] = v1[2] * cs[3] - v1[3] * sn[3]; w1[3] = v1[3] * cs[3] + v1[2] * sn[3];
                        v0 = w0 * qscale; v1 = w1 * qscale; }
                    u32x4 w; w.x = cvt_pk_bf16(v0[0], v0[1]); w.y = cvt_pk_bf16(v0[2], v0[3]); w.z = cvt_pk_bf16(v1[0], v1[1]); w.w = cvt_pk_bf16(v1[2], v1[3]);
                    st_wt(rowp + bj * 128, w); } }
    }
};
struct EpiGate {
    static constexpr bool PERM = true;
    bf16_t* G; const float* bias; const rs_t* rs;
    __device__ __forceinline__ void operator()(const f32x4 (&acc)[2][2][4][2], const Unit& u, int wr, int wc, int fr, int fq) const {
        asm volatile("" : "+v"(fr), "+v"(fq));
        const int row0 = u.pm * 256 + wr * 64 + fr, col0 = u.pn * 256 + wc * 32 + 8 * fq;
        f32x4 bq[2][2];
#pragma unroll
        for (int bj = 0; bj < 2; ++bj) { bq[bj][0] = *(const f32x4*)(bias + col0 + bj * 128); bq[bj][1] = *(const f32x4*)(bias + col0 + bj * 128 + 4); }
        float rsc[2][4];
#pragma unroll
        for (int ai = 0; ai < 2; ++ai)
#pragma unroll
            for (int m = 0; m < 4; ++m) rsc[ai][m] = __builtin_amdgcn_rsqf(rs_val(rs[row0 + ai * 128 + m * 16]) * (1.f / DM) + EPS);
#pragma unroll
        for (int bj = 0; bj < 2; ++bj) { const f32x4 bv0 = bq[bj][0], bv1 = bq[bj][1];
#pragma unroll
            for (int ai = 0; ai < 2; ++ai)
#pragma unroll
                for (int m = 0; m < 4; ++m) { bf16_t* rowp = G + (size_t)(row0 + ai * 128 + m * 16) * 2048 + col0; f32x4 v0 = acc[ai][bj][m][0] * rsc[ai][m] + bv0, v1 = acc[ai][bj][m][1] * rsc[ai][m] + bv1;
#pragma unroll
                    for (int e = 0; e < 4; ++e) { v0[e] = __builtin_amdgcn_rcpf(1.f + __builtin_amdgcn_exp2f(-v0[e] * LOG2E)); v1[e] = __builtin_amdgcn_rcpf(1.f + __builtin_amdgcn_exp2f(-v1[e] * LOG2E)); }
                    u32x4 w; w.x = cvt_pk_bf16(v0[0], v0[1]); w.y = cvt_pk_bf16(v0[2], v0[3]); w.z = cvt_pk_bf16(v1[0], v1[1]); w.w = cvt_pk_bf16(v1[2], v1[3]);
                    st_wt(rowp + bj * 128, w); } }
    }
};
struct EpiGated {
    static constexpr bool PERM = true;
    bf16_t* P; const bf16_t* G; int first; float sc;
    __device__ __forceinline__ void operator()(const f32x4 (&acc)[2][2][4][2], const Unit& u, int wr, int wc, int fr, int fq) const {
        asm volatile("" : "+v"(fr), "+v"(fq));
        const int row0 = u.pm * 256 + wr * 64 + fr, lcol0 = u.pn * 256 + wc * 32 + 8 * fq, col0 = u.ocol + wc * 32 + 8 * fq;
        unsigned zu = 0u; asm volatile("" : "+v"(zu));
#pragma unroll
        for (int ai = 0; ai < 2; ++ai) {
            u32x4 gq[4][2], pq[4][2];
#pragma unroll
            for (int m = 0; m < 4; ++m)
#pragma unroll
                for (int bj = 0; bj < 2; ++bj) { gq[m][bj] = *(const u32x4*)(G + (size_t)(row0 + ai * 128 + m * 16) * 2048 + lcol0 + bj * 128); if (DBG_BR == 1) gq[m][bj] = (u32x4){0x3f803f80u, 0x3f803f80u, 0x3f803f80u, 0x3f803f80u};
                    pq[m][bj] = (u32x4){zu, zu, zu, zu}; if (!first) pq[m][bj] = *(const u32x4*)(P + (size_t)(row0 + ai * 128 + m * 16) * PW + col0 + bj * 128); }
#pragma unroll
            for (int m = 0; m < 4; ++m) { bf16_t* rowp = P + (size_t)(row0 + ai * 128 + m * 16) * PW + col0;
#pragma unroll
                for (int bj = 0; bj < 2; ++bj) { const u32x4 g = gq[m][bj], pv = pq[m][bj];
                    const f32x4 v0 = acc[ai][bj][m][0] * sc, v1 = acc[ai][bj][m][1] * sc;
                    float o[8];
                    o[0] = __uint_as_float(pv.x << 16) + __uint_as_float(g.x << 16) * v0[0]; o[1] = __uint_as_float(pv.x & 0xffff0000u) + __uint_as_float(g.x & 0xffff0000u) * v0[1];
                    o[2] = __uint_as_float(pv.y << 16) + __uint_as_float(g.y << 16) * v0[2]; o[3] = __uint_as_float(pv.y & 0xffff0000u) + __uint_as_float(g.y & 0xffff0000u) * v0[3];
                    o[4] = __uint_as_float(pv.z << 16) + __uint_as_float(g.z << 16) * v1[0]; o[5] = __uint_as_float(pv.z & 0xffff0000u) + __uint_as_float(g.z & 0xffff0000u) * v1[1];
                    o[6] = __uint_as_float(pv.w << 16) + __uint_as_float(g.w << 16) * v1[2]; o[7] = __uint_as_float(pv.w & 0xffff0000u) + __uint_as_float(g.w & 0xffff0000u) * v1[3];
                    u32x4 w; w.x = cvt_pk_bf16(o[0], o[1]); w.y = cvt_pk_bf16(o[2], o[3]); w.z = cvt_pk_bf16(o[4], o[5]); w.w = cvt_pk_bf16(o[6], o[7]);
                    st_wt(rowp + bj * 128, w); } }
            asm volatile("" ::: "memory"); }
    }
};
struct EpiRes {
    static constexpr bool PERM = true;
    float* out_f; float dbg; bf16_t* hb; rs_t* rs;
    __device__ __forceinline__ void operator()(const f32x4 (&acc)[2][2][4][2], const Unit& u, int wr, int wc, int fr, int fq) const {
        asm volatile("" : "+v"(fr), "+v"(fq));
        const int lrow0 = wr * 64 + fr, col0 = u.pn * 256 + wc * 32 + 8 * fq;
        bf16_t* hp0 = hb + (size_t)(u.pm * 256 + lrow0) * DM + col0;
        u32x4 bw[2][4][2];
#pragma unroll
        for (int ai = 0; ai < 2; ++ai)
#pragma unroll
            for (int m = 0; m < 4; ++m)
#pragma unroll
                for (int bj = 0; bj < 2; ++bj) bw[ai][m][bj] = *(const u32x4*)(hp0 + (size_t)(ai * 128 + m * 16) * DM + bj * 128);
#pragma unroll
        for (int ai = 0; ai < 2; ++ai)
#pragma unroll
            for (int m = 0; m < 4; ++m) { const int lrow = lrow0 + ai * 128 + m * 16, grow = u.pm * 256 + lrow;
                const size_t foff = ((size_t)(u.pm - 1) * 256 + lrow) * DM + col0; bf16_t* hp = hp0 + (size_t)(ai * 128 + m * 16) * DM; float ss = 0.f;
#pragma unroll
                for (int bj = 0; bj < 2; ++bj) { const u32x4 w = bw[ai][m][bj];
                    const f32x4 b0 = (f32x4){__uint_as_float(w.x << 16), __uint_as_float(w.x & 0xffff0000u), __uint_as_float(w.y << 16), __uint_as_float(w.y & 0xffff0000u)};
                    const f32x4 b1 = (f32x4){__uint_as_float(w.z << 16), __uint_as_float(w.z & 0xffff0000u), __uint_as_float(w.w << 16), __uint_as_float(w.w & 0xffff0000u)};
                    const f32x4 h0 = b0 + acc[ai][bj][m][0] * dbg, h1 = b1 + acc[ai][bj][m][1] * dbg;
                    if (out_f) { st_wt(out_f + foff + bj * 128, h0); st_wt(out_f + foff + bj * 128 + 4, h1); }
                    else { ss += ((h0[0] * h0[0] + h0[1] * h0[1]) + (h0[2] * h0[2] + h0[3] * h0[3])) + ((h1[0] * h1[0] + h1[1] * h1[1]) + (h1[2] * h1[2] + h1[3] * h1[3]));
                        u32x4 o; o.x = cvt_pk_bf16(h0[0], h0[1]); o.y = cvt_pk_bf16(h0[2], h0[3]); o.z = cvt_pk_bf16(h1[0], h1[1]); o.w = cvt_pk_bf16(h1[2], h1[3]); st_wt(hp + bj * 128, o); } }
                if (!out_f) { ss += __shfl_xor(ss, 16); ss += __shfl_xor(ss, 32); if (fq == 0) (void)__hip_atomic_fetch_add(rs + grow, rs_fix(ss), __ATOMIC_RELAXED, __HIP_MEMORY_SCOPE_AGENT); } }
    }
};
struct EpiSwiglu {
    static constexpr bool PERM = true;
    bf16_t* P; const rs_t* rs;
    __device__ __forceinline__ void operator()(const f32x4 (&acc)[2][2][4][2], const Unit& u, int wr, int wc, int fr, int fq) const {
        asm volatile("" : "+v"(fr), "+v"(fq));
        const int row0 = u.pm * 256 + wr * 64 + fr, col0 = u.pn * 128 + wc * 32 + 8 * fq;
#pragma unroll
        for (int ai = 0; ai < 2; ++ai)
#pragma unroll
            for (int m = 0; m < 4; ++m) { bf16_t* rowp = P + (size_t)(row0 + ai * 128 + m * 16) * PW + col0;
                const float sc = __builtin_amdgcn_rsqf(rs_val(rs[row0 + ai * 128 + m * 16]) * (1.f / DM) + EPS);
                float o[8];
#pragma unroll
                for (int n = 0; n < 2; ++n)
#pragma unroll
                    for (int e = 0; e < 4; ++e) { const float g = acc[ai][0][m][n][e] * sc, up = acc[ai][1][m][n][e] * sc; o[n * 4 + e] = g * __builtin_amdgcn_rcpf(1.f + __builtin_amdgcn_exp2f(-g * LOG2E)) * up; }
                u32x4 w; w.x = cvt_pk_bf16(o[0], o[1]); w.y = cvt_pk_bf16(o[2], o[3]); w.z = cvt_pk_bf16(o[4], o[5]); w.w = cvt_pk_bf16(o[6], o[7]);
                st_wt(rowp, w); }
    }
};

struct SkP { bf16_t* P; int ocol; const rs_t* rs; float inv_dim; rs_t* sq; rs_t* skv; struct Pre { rs_t q[4]; };
    __device__ __forceinline__ void load(int r0, int, Pre& p) const { if (rs) {
#pragma unroll
        for (int r = 0; r < 4; ++r) p.q[r] = rs[MROW0 + r0 + r]; } }
    __device__ __forceinline__ void apply(int r0, int c, f32x4 v, const Pre& p) const {
        rs_t* sums = (sq && c < 1024) ? (c < 512 ? sq : skv) : (rs_t*)nullptr;
#pragma unroll
        for (int r = 0; r < 4; ++r) { float x = v[r]; if (rs) x *= __builtin_amdgcn_rsqf(rs_val(p.q[r]) * inv_dim + EPS); P[(size_t)(MROW0 + r0 + r) * PW + ocol + c] = (bf16_t)f2bf(x);
            if (sums) { float ss = x * x; ss += __shfl_xor(ss, 1); ss += __shfl_xor(ss, 2); ss += __shfl_xor(ss, 4); ss += __shfl_xor(ss, 8);
                if ((threadIdx.x & 15) == 0) (void)__hip_atomic_fetch_add(sums + MROW0 + r0 + r, rs_fix(ss), __ATOMIC_RELAXED, __HIP_MEMORY_SCOPE_AGENT); } } } };
struct SkGate { bf16_t* G; const float* bias; const rs_t* rs; struct Pre { rs_t q[4]; float b; };
    __device__ __forceinline__ void load(int r0, int c, Pre& p) const { p.b = bias[c];
#pragma unroll
        for (int r = 0; r < 4; ++r) p.q[r] = rs[MROW0 + r0 + r]; }
    __device__ __forceinline__ void apply(int r0, int c, f32x4 v, const Pre& p) const {
#pragma unroll
        for (int r = 0; r < 4; ++r) { const float x = v[r] * __builtin_amdgcn_rsqf(rs_val(p.q[r]) * (1.f / DM) + EPS); G[(size_t)(MROW0 + r0 + r) * 2048 + c] = (bf16_t)f2bf(__builtin_amdgcn_rcpf(1.f + __builtin_amdgcn_exp2f(-(x + p.b) * LOG2E))); } } };
struct SkGated { bf16_t* P; const bf16_t* G; int first; struct Pre { bf16_t pv[4], g[4]; };
    __device__ __forceinline__ void load(int r0, int c, Pre& p) const {
#pragma unroll
        for (int r = 0; r < 4; ++r) { p.g[r] = G[(size_t)(MROW0 + r0 + r) * 2048 + c]; p.pv[r] = first ? (bf16_t)0 : P[(size_t)(MROW0 + r0 + r) * PW + C_MERGED + c]; } }
    __device__ __forceinline__ void apply(int r0, int c, f32x4 v, const Pre& p) const {
#pragma unroll
        for (int r = 0; r < 4; ++r) P[(size_t)(MROW0 + r0 + r) * PW + C_MERGED + c] = (bf16_t)f2bf(bf2f(p.pv[r]) + bf2f(p.g[r]) * v[r]); } };
struct SkRes { float* hmeta; bf16_t* hb; rs_t* rs; struct Pre { float hm[4]; };
    __device__ __forceinline__ void load(int r0, int c, Pre& p) const {
#pragma unroll
        for (int r = 0; r < 4; ++r) p.hm[r] = hmeta[(size_t)(MROW0 + r0 + r) * DM + c]; }
    __device__ __forceinline__ void apply(int r0, int c, f32x4 v, const Pre& p) const {
#pragma unroll
        for (int r = 0; r < 4; ++r) { const float hv = p.hm[r] + v[r]; hmeta[(size_t)(MROW0 + r0 + r) * DM + c] = hv;
            if (hb) { hb[(size_t)(MROW0 + r0 + r) * DM + c] = (bf16_t)f2bf(hv); float ss = hv * hv; ss += __shfl_xor(ss, 1); ss += __shfl_xor(ss, 2); ss += __shfl_xor(ss, 4); ss += __shfl_xor(ss, 8);
                if ((threadIdx.x & 15) == 0) (void)__hip_atomic_fetch_add(rs + MROW0 + r0 + r, rs_fix(ss), __ATOMIC_RELAXED, __HIP_MEMORY_SCOPE_AGENT); } } } };
template <class Fn>
__device__ __forceinline__ void skinny_gemm(LAS unsigned char* lds, const bf16_t* A, int lda, const bf16_t* Bt, int K, int ntask, int bid, int G, const Fn& f) {
    int tid = threadIdx.x; asm volatile("" : "+v"(tid));
    const int wid = __builtin_amdgcn_readfirstlane(tid >> 6), lane = tid & 63, l15 = lane & 15, kq = lane >> 4;
    LAS f32x4* red = (LAS f32x4*)lds;
    const int kw = K / 8;
    for (int task = bid; task < ntask; task += G) {
        const bf16_t* ap = A + (size_t)l15 * lda + wid * kw + kq * 8;
        const bf16_t* bp = Bt + (size_t)(task * 16 + l15) * K + wid * kw + kq * 8;
        float z = 0.f; asm volatile("" : "+v"(z));
        f32x4 acc = (f32x4){z, z, z, z};
        typename Fn::Pre pre{}; if (wid == 0) f.load(kq * 4, task * 16 + l15, pre);
        for (int k0 = 0; k0 < kw; k0 += 256) {
            bf16x8 fa[8], fb[8];
#pragma unroll
            for (int i = 0; i < 8; ++i) { const int k = (k0 + 32 * i < kw) ? k0 + 32 * i : 0; fa[i] = *(const bf16x8*)(ap + k); fb[i] = *(const bf16x8*)(bp + k); }
#pragma unroll
            for (int i = 0; i < 8; ++i) if (k0 + 32 * i < kw) acc = __builtin_amdgcn_mfma_f32_16x16x32_bf16(fa[i], fb[i], acc, 0, 0, 0);
        }
        red[wid * 64 + lane] = acc;
        LDS_WAIT(); __syncthreads();
        if (wid == 0) {
            f32x4 s = red[lane];
#pragma unroll
            for (int w = 1; w < 8; ++w) s += red[w * 64 + lane];
            f.apply(kq * 4, task * 16 + l15, s, pre);
        }
        __syncthreads();
    }
}
__device__ __forceinline__ void skinny_swiglu(LAS unsigned char* lds, const bf16_t* A, int lda, const bf16_t* Bt, int K, bf16_t* P, const rs_t* rs, int bid, int G) {
    int tid = threadIdx.x; asm volatile("" : "+v"(tid));
    const int wid = __builtin_amdgcn_readfirstlane(tid >> 6), lane = tid & 63, l15 = lane & 15, kq = lane >> 4;
    LAS f32x4* red = (LAS f32x4*)lds;
    const int kw = K / 8;
    for (int task = bid; task < DFF / 16; task += G) {
        const int c0 = task * 16, brow = (c0 >> 7) * 256 + (c0 & 127) + l15;
        const bf16_t* ap = A + (size_t)l15 * lda + wid * kw + kq * 8;
        const bf16_t* bg = Bt + (size_t)brow * K + wid * kw + kq * 8; const bf16_t* bu = bg + (size_t)128 * K;
        float z = 0.f; asm volatile("" : "+v"(z));
        f32x4 ag = (f32x4){z, z, z, z}, au = ag;
        rs_t rq[4] = {0, 0, 0, 0}; if (wid == 0) {
#pragma unroll
            for (int r = 0; r < 4; ++r) rq[r] = rs[MROW0 + kq * 4 + r]; }
        {
            bf16x8 fa[8], fg[8], fu[8];
#pragma unroll
            for (int i = 0; i < 8; ++i) { fa[i] = *(const bf16x8*)(ap + 32 * i); fg[i] = *(const bf16x8*)(bg + 32 * i); fu[i] = *(const bf16x8*)(bu + 32 * i); }
#pragma unroll
            for (int i = 0; i < 8; ++i) { ag = __builtin_amdgcn_mfma_f32_16x16x32_bf16(fa[i], fg[i], ag, 0, 0, 0); au = __builtin_amdgcn_mfma_f32_16x16x32_bf16(fa[i], fu[i], au, 0, 0, 0); }
        }
        red[wid * 64 + lane] = ag; red[512 + wid * 64 + lane] = au;
        LDS_WAIT(); __syncthreads();
        if (wid == 0) {
            f32x4 sg = red[lane], su = red[512 + lane];
#pragma unroll
            for (int w = 1; w < 8; ++w) { sg += red[w * 64 + lane]; su += red[512 + w * 64 + lane]; }
#pragma unroll
            for (int r = 0; r < 4; ++r) { const float sc = __builtin_amdgcn_rsqf(rs_val(rq[r]) * (1.f / DM) + EPS); const float g = sg[r] * sc; su[r] *= sc; P[(size_t)(MROW0 + kq * 4 + r) * PW + c0 + l15] = (bf16_t)f2bf(g * __builtin_amdgcn_rcpf(1.f + __builtin_amdgcn_exp2f(-g * LOG2E)) * su[r]); }
        }
        __syncthreads();
    }
}

#define XB_TMO      128
#define XB_XCNT(j)  (256  + 64 * (j))
#define XB_XSUB(j)  (1280 + 64 * (j))
#define XB_XGEN(j)  (2304 + 64 * (j))
#define XB_TOP      3328
#define XB_TOPGEN   3392
#define XCD_BAR_WORDS 3456
#define XB_SPIN_CAP (1u << 18)
__device__ __forceinline__ unsigned xb_ld(unsigned* p)              { return __hip_atomic_load(p, __ATOMIC_RELAXED, __HIP_MEMORY_SCOPE_AGENT); }
__device__ __forceinline__ unsigned xb_add(unsigned* p, unsigned v) { return __hip_atomic_fetch_add(p, v, __ATOMIC_RELAXED, __HIP_MEMORY_SCOPE_AGENT); }
__device__ __forceinline__ unsigned xb_xcc_id() { return (unsigned)__builtin_amdgcn_s_getreg((3 << 11) | 20) & 0xFu; }
#define XB_SPIN(cond, bar) do { unsigned _sp = 0; while (cond) { __builtin_amdgcn_s_sleep(1); \
    if ((++_sp & 255u) == 0u) { if (xb_ld(&(bar)[XB_TMO])) break; if (_sp > XB_SPIN_CAP) { atomicAdd(&(bar)[XB_TMO], 1u); break; } } } } while (0)
struct XcdBarrier { unsigned* bar; unsigned x; volatile LAS unsigned* st; };
__device__ __forceinline__ XcdBarrier xcd_barrier_post(unsigned* bar, volatile LAS unsigned* st) {
    XcdBarrier b; b.bar = bar; b.x = xb_xcc_id(); b.st = st;
    if (threadIdx.x == 0) (void)xb_add(&bar[XB_XCNT(b.x)], 1u);
    return b;
}
__device__ __forceinline__ void xcd_barrier_complete(unsigned* bar, unsigned x, unsigned& nloc, unsigned& nx) {
    const unsigned G = gridDim.x * gridDim.y * gridDim.z;
    unsigned sum, cnt, mine, sp = 0u;
    for (;;) {
        sum = 0u; cnt = 0u; mine = 0u;
#pragma unroll
        for (unsigned j = 0; j < 16; ++j) { const unsigned c = xb_ld(&bar[XB_XCNT(j)]); sum += c; cnt += (c > 0u) ? 1u : 0u; mine = (j == x) ? c : mine; }
        if (sum == G) break;
        __builtin_amdgcn_s_sleep(1);
        if ((++sp & 255u) == 0u) { if (xb_ld(&bar[XB_TMO])) break; if (sp > XB_SPIN_CAP) { atomicAdd(&bar[XB_TMO], 1u); break; } }
    }
    nloc = mine > 0u ? mine : 1u; nx = cnt > 0u ? cnt : 1u;
}
__device__ __forceinline__ void xcd_barrier(const XcdBarrier& b) {
    asm volatile("s_waitcnt vmcnt(0)" ::: "memory");
    __syncthreads();
    if (threadIdx.x == 0) {
        unsigned* bar = b.bar;
        __builtin_amdgcn_s_waitcnt(0);
        unsigned nloc = b.st[0], nx = b.st[1];
        if (nloc == 0u) { xcd_barrier_complete(bar, b.x, nloc, nx); b.st[0] = nloc; b.st[1] = nx; }
        const unsigned old = xb_add(&bar[XB_XSUB(b.x)], 1u);
        const unsigned gen = old / nloc;
        if (old + 1u == (gen + 1u) * nloc) {
            __builtin_amdgcn_fence(__ATOMIC_RELEASE, "agent");
            asm volatile("s_waitcnt vmcnt(0)" ::: "memory");
            const unsigned og = xb_add(&bar[XB_TOP], 1u);
            const unsigned tg = og / nx;
            if (og + 1u == (tg + 1u) * nx) xb_add(&bar[XB_TOPGEN], 1u);
            else XB_SPIN(xb_ld(&bar[XB_TOPGEN]) == tg, bar);
            __builtin_amdgcn_fence(__ATOMIC_ACQUIRE, "agent");
            xb_add(&bar[XB_XGEN(b.x)], 1u);
            asm volatile("s_waitcnt vmcnt(0)" ::: "memory");
        } else {
            XB_SPIN(xb_ld(&bar[XB_XGEN(b.x)]) == gen, bar);
            __builtin_amdgcn_fence(__ATOMIC_ACQUIRE, "agent");
            asm volatile("s_waitcnt vmcnt(0)" ::: "memory");
        }
    }
    __syncthreads();
}

constexpr int NWAVES = 8;
constexpr int RING_BYTES = 131072, LDS_BYTES = 147456, LDSCTL_OFF = LDS_BYTES - 512;
struct Args {
    const float* in[19]; float* out; unsigned char* ws; int ph_lo, ph_hi;
};
struct Ctx {
    LAS unsigned char* lds; int tid, lane, wave, gw, ngw, G, bid;
};

template <int MAP> __device__ __forceinline__ int wmap(int n, float& sc) {
    sc = 1.f;
    if (MAP == 0) return n;
    if (MAP == 1) {
        if (n < 1088) return n;
        if (n < 3136) { const int m = n - 1088, d = m & 127; return 1280 + (m - d) + (d < 64 ? 2 * d : 2 * (d - 64) + 1); }
        if (n < 4160) return 1280 + (n - 1088);
        if (n < 5184) { const int m = n - 4160, d = m & 63; return 4352 + (m - d) + (d < 32 ? 2 * d : 2 * (d - 32) + 1); }
        if (n < 5248) { const int d = n - 5184; return 1088 + (d < 32 ? 2 * d : 2 * (d - 32) + 1); }
        if (n < 5264) { sc = 0.03125f; return 1152 + (n - 5248); }
        if (n < 7312) { const int m = n - 5264, d = m & 127; return 5376 + (m - d) + (d < 64 ? 2 * d : 2 * (d - 64) + 1); }
        if (n < 8336) return 5376 + (n - 5264);
        return 8448 + (n - 8336);
    }
    if (n < DFF) return (n >> 7) * 256 + (n & 127);
    const int m = n - DFF; return (m >> 7) * 256 + 128 + (m & 127);
}
template <int MAP> __device__ __forceinline__ void conv_matrix(const Ctx& F, const float* W, int K, int N, bf16_t* WT, const float* gain) {
    LAS float* scr = (LAS float*)(F.lds + F.wave * 18432);
    const int lane = F.lane;
    const int nblk = (N + 63) / 64, nit = (K / 64) * nblk;
    const int l31 = lane & 31, lh = lane >> 5, c = lane & 7, nsub = lane >> 3;
    f32x2 wv[32]; f32x4 g0 = (f32x4){1.f, 1.f, 1.f, 1.f}, g1 = g0;
#define CONV_LOAD(item) do { const int kb_ = (item) / nblk, nb_ = (item) - kb_ * nblk, k0_ = 64 * kb_, nn_ = 64 * nb_ + 2 * l31; \
        const float* src_ = W + (size_t)(k0_ + lh) * N + nn_; const bool ok_ = nn_ < N; \
        _Pragma("unroll") for (int i = 0; i < 32; ++i) wv[i] = ok_ ? *(const f32x2*)(src_ + (size_t)(2 * i) * N) : (f32x2){0.f, 0.f}; \
        if (gain) { g0 = *(const f32x4*)(gain + k0_ + 8 * c); g1 = *(const f32x4*)(gain + k0_ + 8 * c + 4); } } while (0)
    int it = F.gw;
    if (it < nit) CONV_LOAD(it);
    while (it < nit) {
        const int kb = it / nblk, nb = it - kb * nblk, k0 = 64 * kb, n0 = 64 * nb;
#pragma unroll
        for (int i = 0; i < 32; ++i) { LAS float* d = scr + (2 * i + lh) * 65 + l31; d[0] = wv[i].x; d[32] = wv[i].y; }
        const f32x4 gc0 = g0, gc1 = g1;
        const int nx = it + F.ngw;
        if (nx < nit) CONV_LOAD(nx);
        LDS_WAIT(); asm volatile("" ::: "memory");
#pragma unroll
        for (int j = 0; j < 8; ++j) { const int n = nsub + 8 * j, ns = n0 + n;
            if (ns < N) { float sc; const int dst = wmap<MAP>(ns, sc); const LAS float* s = scr + (8 * c) * 65 + (n & 1) * 32 + (n >> 1);
                u32x4 o; o.x = pk2(s[0 * 65] * (sc * gc0.x), s[1 * 65] * (sc * gc0.y)); o.y = pk2(s[2 * 65] * (sc * gc0.z), s[3 * 65] * (sc * gc0.w));
                o.z = pk2(s[4 * 65] * (sc * gc1.x), s[5 * 65] * (sc * gc1.y)); o.w = pk2(s[6 * 65] * (sc * gc1.z), s[7 * 65] * (sc * gc1.w));
                *(u32x4*)(WT + (size_t)dst * K + k0 + 8 * c) = o; } }
        LDS_WAIT(); asm volatile("" ::: "memory");
        it = nx;
    }
#undef CONV_LOAD
}

__device__ __forceinline__ void norm_load(const float* hrow, int lane, f32x4 (&v)[8]) {
#pragma unroll
    for (int j = 0; j < 8; ++j) v[j] = *((const f32x4*)hrow + lane + 64 * j);
}
__device__ __forceinline__ void norm_fin(const f32x4 (&v)[8], bf16_t* orow, rs_t* rs_row, int lane) {
    float s = 0.f;
#pragma unroll
    for (int j = 0; j < 8; ++j) s += (v[j].x * v[j].x + v[j].y * v[j].y) + (v[j].z * v[j].z + v[j].w * v[j].w);
    s = wave_sum(s);
    if (lane == 0) *rs_row = rs_fix(s);
#pragma unroll
    for (int j = 0; j < 8; ++j) { u32x2 o; o.x = cvt_pk_bf16(v[j].x, v[j].y); o.y = cvt_pk_bf16(v[j].z, v[j].w); *((u32x2*)orow + lane + 64 * j) = o; }
}

__device__ __forceinline__ void meta_post_row(bf16_t* P, int r, const float* gperm, int lane) {
    bf16_t* p = P + (size_t)r * PW; const int pos = row_pos(r);
    float c128, s128, c64, s64; rope_cs(pos, lane, 2.f / 128.f, c128, s128); rope_cs(pos, lane & 31, 2.f / 64.f, c64, s64);
#pragma unroll 1
    for (int t = 0; t < 4; ++t) {
        const int cb = t == 0 ? C_DQ : (t == 1 ? C_DK : (t == 2 ? C_FQ : C_FK)); const float sc = (t == 0 || t == 2) ? C2_128 : 1.f;
        const float ga = gperm[t * 128 + 2 * lane], gb = gperm[t * 128 + 2 * lane + 1];
#pragma unroll 1
        for (int h = 0; h < 8; ++h) { unsigned* xp = (unsigned*)(p + cb + h * 128) + lane; const unsigned w = *xp; float x1 = __uint_as_float(w << 16), x2 = __uint_as_float(w & 0xffff0000u);
            const float rn = __builtin_amdgcn_rsqf(wave_sum(x1 * x1 + x2 * x2) * (1.f / 128.f) + EPS); x1 *= rn * ga; x2 *= rn * gb;
            *xp = cvt_pk_bf16((x1 * c128 - x2 * s128) * sc, (x2 * c128 + x1 * s128) * sc); }
    }
#pragma unroll 1
    for (int hh = 0; hh < 8; ++hh) { unsigned* xp = (unsigned*)(p + C_IQ + hh * 128) + lane; const unsigned w = *xp; const float x1 = __uint_as_float(w << 16), x2 = __uint_as_float(w & 0xffff0000u);
        *xp = cvt_pk_bf16(x1 * c64 - x2 * s64, x2 * c64 + x1 * s64); }
}
__device__ __forceinline__ void unpack8(const u32x4& w, float (&x)[8]) {
#pragma unroll
    for (int e = 0; e < 4; ++e) { x[2 * e] = __uint_as_float(w[e] << 16); x[2 * e + 1] = __uint_as_float(w[e] & 0xffff0000u); }
}
__device__ __forceinline__ u32x4 pack8(const float (&x)[8]) { u32x4 w; w.x = cvt_pk_bf16(x[0], x[1]); w.y = cvt_pk_bf16(x[2], x[3]); w.z = cvt_pk_bf16(x[4], x[5]); w.w = cvt_pk_bf16(x[6], x[7]); return w; }
__device__ __forceinline__ u32x4 shfl_xor4(const u32x4& w, int m) { u32x4 r; r.x = __shfl_xor(w.x, m); r.y = __shfl_xor(w.y, m); r.z = __shfl_xor(w.z, m); r.w = __shfl_xor(w.w, m); return r; }
__device__ __forceinline__ void post2_load(const bf16_t* P, int r, int lane, u32x4 (&v)[9], unsigned& ikw_) {
    const bf16_t* p = P + (size_t)r * PW; const int hw = lane >> 5, l5 = lane & 31;
    v[0] = *(const u32x4*)(p + C_KPE + (lane & 7) * 8); ikw_ = *((const unsigned*)(p + C_IK) + (lane & 31));
#pragma unroll
    for (int it = 0; it < 4; ++it) { const int h = 2 * it + hw; v[1 + it] = *(const u32x4*)(p + C_QRAW + h * 192 + (l5 < 24 ? l5 : 0) * 8); v[5 + it] = *(const u32x4*)(p + C_KVRAW + h * 256 + (l5 & 15) * 8); }
}
__device__ __forceinline__ void post2_row(bf16_t* P, int r, const u32x4 (&v)[9], unsigned ikw, const float* qkg  , LAS float* rnl, int lane) {
    bf16_t* p = P + (size_t)r * PW;
    const int pos = row_pos(r), hw = lane >> 5, l5 = lane & 31;
    float c64[8], s64[8];
#pragma unroll
    for (int j = 0; j < 8; ++j) rope_cs(pos, 8 * (lane & 3) + j, 2.f / 64.f, c64[j], s64[j]);
    float kp[8]; unpack8(v[0], kp);
    unsigned* ikp = (unsigned*)(p + C_IK) + (lane & 31);
    float kpe_ss = 0.f;
#pragma unroll
    for (int j = 0; j < 8; ++j) kpe_ss += kp[j] * kp[j];
    kpe_ss += __shfl_xor(kpe_ss, 1); kpe_ss += __shfl_xor(kpe_ss, 2); kpe_ss += __shfl_xor(kpe_ss, 4);
#pragma unroll
    for (int it = 0; it < 4; ++it) {
        const int h = 2 * it + hw; const bool act = l5 < 24;
        u32x4* ptr = (u32x4*)(p + C_QRAW + h * 192 + (act ? l5 : 0) * 8);
        float x[8]; unpack8(v[1 + it], x);
        float ss = 0.f;
#pragma unroll
        for (int j = 0; j < 8; ++j) ss += x[j] * x[j];
        if (!act) ss = 0.f;
#pragma unroll
        for (int o = 1; o < 32; o <<= 1) ss += __shfl_xor(ss, o);
        const float rn = 1.0f / sqrtf(ss * (1.f / 192.f) + EPS);
        const int gi = (act ? l5 : 0) * 8;
        const f32x4 g0 = *(const f32x4*)(qkg + gi), g1 = *(const f32x4*)(qkg + gi + 4);
#pragma unroll
        for (int j = 0; j < 4; ++j) { x[j] *= rn * g0[j]; x[4 + j] *= rn * g1[j]; }
        float o[8];
#pragma unroll
        for (int j = 0; j < 8; ++j) { const float pr = __shfl_xor(x[j], 4); const float rot = (l5 & 4) ? (x[j] * c64[j] + pr * s64[j]) : (x[j] * c64[j] - pr * s64[j]); o[j] = (l5 >= 16 ? rot : x[j]) * C2_192; }
        if (act) *ptr = pack8(o);
    }
#pragma unroll
    for (int it = 0; it < 4; ++it) {
        const int h = 2 * it + hw; const bool isk = l5 < 16;
        u32x4* ptr = (u32x4*)(p + C_KVRAW + h * 256 + (l5 & 15) * 8);
        float x[8]; unpack8(v[5 + it], x);
        float ss = 0.f;
#pragma unroll
        for (int j = 0; j < 8; ++j) ss += x[j] * x[j];
        if (!isk) ss = 0.f;
#pragma unroll
        for (int o = 1; o < 32; o <<= 1) ss += __shfl_xor(ss, o);
        const float rn = 1.0f / sqrtf((ss + kpe_ss) * (1.f / 192.f) + EPS);
        if (l5 == 0) rnl[h] = rn;
        const int gi = 192 + (isk ? l5 : 0) * 8;
        const f32x4 g0 = *(const f32x4*)(qkg + gi), g1 = *(const f32x4*)(qkg + gi + 4);
        float o[8];
#pragma unroll
        for (int j = 0; j < 4; ++j) { o[j] = x[j] * rn * g0[j]; o[4 + j] = x[4 + j] * rn * g1[j]; }
        if (isk) *ptr = pack8(o);
    }
    LDS_WAIT(); asm volatile("" ::: "memory");
    { const int hd = lane >> 3, c = lane & 7; const float rn = rnl[hd];
      const f32x4 g0 = *(const f32x4*)(qkg + 192 + 128 + c * 8), g1 = *(const f32x4*)(qkg + 192 + 128 + c * 8 + 4);
      float x[8], o[8];
#pragma unroll
      for (int j = 0; j < 4; ++j) { x[j] = kp[j] * rn * g0[j]; x[4 + j] = kp[4 + j] * rn * g1[j]; }
#pragma unroll
      for (int j = 0; j < 8; ++j) { const float pr = __shfl_xor(x[j], 4); o[j] = (c & 4) ? (x[j] * c64[j] + pr * s64[j]) : (x[j] * c64[j] - pr * s64[j]); }
      *(u32x4*)(p + C_KPEH + hd * 64 + c * 8) = pack8(o); }
    { const float x1 = __uint_as_float(ikw << 16), x2 = __uint_as_float(ikw & 0xffff0000u); float cs, sn; rope_cs(pos, lane & 31, 2.f / 64.f, cs, sn);
      if (lane < 32) *ikp = cvt_pk_bf16(x1 * cs - x2 * sn, x2 * cs + x1 * sn); }
    LDS_WAIT(); asm volatile("" ::: "memory");
}
__device__ __forceinline__ void post3_load(const bf16_t* P, int r, int lane, u32x4 (&rr)[4]) {
    const bf16_t* p = P + (size_t)r * PW; const int hw = lane >> 5, l5 = lane & 31;
#pragma unroll
    for (int h = 0; h < 4; ++h) rr[h] = *(const u32x4*)(p + (hw ? C_IQ : C_FQ) + h * 256 + l5 * 8);
}
__device__ __forceinline__ void post3_row(bf16_t* P, int r, const u32x4 (&rr)[4], const float* subg, float lam, float omli, int lane) {
    bf16_t* p = P + (size_t)r * PW;
    const int hw = lane >> 5, l5 = lane & 31;
#pragma unroll
    for (int h = 0; h < 4; ++h) {
        const u32x4 raw = rr[h];
        const u32x4 praw = shfl_xor4(raw, 16);
        float a[8], b[8]; unpack8(raw, a); unpack8(praw, b);
        float d[8], ss = 0.f;
#pragma unroll
        for (int j = 0; j < 8; ++j) { d[j] = a[j] - lam * b[j]; ss += d[j] * d[j]; }
        if (l5 >= 16) ss = 0.f;
#pragma unroll
        for (int o = 1; o < 64; o <<= 1) ss += __shfl_xor(ss, o);
        const float rn = omli / sqrtf(ss * (1.f / 256.f) + EPS);
        const int dim = hw * 128 + (l5 & 15) * 8;
        const f32x4 g0 = *(const f32x4*)(subg + dim), g1 = *(const f32x4*)(subg + dim + 4);
        float o[8];
#pragma unroll
        for (int j = 0; j < 4; ++j) { o[j] = d[j] * rn * g0[j]; o[4 + j] = d[4 + j] * rn * g1[j]; }
        if (l5 < 16) *(u32x4*)(p + C_OC + h * 256 + dim) = pack8(o);
    }
}

__device__ __forceinline__ void index_unit(const bf16_t* P, int unit, unsigned* bm, LAS unsigned char* lds) {
    typedef float f32x16 __attribute__((ext_vector_type(16)));
    int tid = threadIdx.x; asm volatile("" : "+v"(tid));
    const int wid = __builtin_amdgcn_readfirstlane(tid >> 6), lane = tid & 63, j = lane & 31, hi = lane >> 5;
    const int tb = 255 - (unit >> 4), b = unit & 15, t0 = tb * 8, tokbase = MBLK + b * SEQ;
    const int wmax = (64 + t0 + 7) >> 5;
    LAS unsigned* keys = (LAS unsigned*)lds;
    LAS float* iwl = (LAS float*)(lds + 8 * 2112 * 4);
    if (t0 + 7 + 17 > 256) {
        const unsigned boff = (unsigned)(j * PW + C_IK + hi * 8) * 2u;
#define IX_LOADK(dst, w_) do { const int kr_ = (w_) < 2 ? (MBLK - 64) + 32 * (w_) : tokbase + 32 * ((w_) - 2); const char* bp_ = (const char*)(P + (size_t)kr_ * PW) + boff; \
        _Pragma("unroll") for (int s = 0; s < 4; ++s) dst[s] = *(const bf16x8*)(bp_ + s * 32); } while (0)
        bf16x8 bf[4], bn[4];
        IX_LOADK(bf, wid <= wmax ? wid : 0);
        if (tid < 128) iwl[tid] = bf2f(P[(size_t)(tokbase + t0 + (tid >> 4)) * PW + C_IW + (tid & 15)]);
        LAS unsigned char* al = lds + 8 * 2112 * 4 + 512;
        { const int id0 = tid * 2;
#pragma unroll
          for (int e = 0; e < 2; ++e) { const int id = id0 + e, rw = id >> 3, c = id & 7;
              *(LAS bf16x8*)(al + rw * 144 + c * 16) = *(const bf16x8*)(P + (size_t)(tokbase + t0 + (rw >> 4)) * PW + C_IQ + (rw & 15) * 64 + c * 8); } }
        LDS_WAIT(); __syncthreads();
        bf16x8 af[4][4];
        { const int qa = (j >> 2) & 1, ha = (j & 3) + 4 * (j >> 3);
#pragma unroll
          for (int blk = 0; blk < 4; ++blk)
#pragma unroll
              for (int s = 0; s < 4; ++s) af[blk][s] = *(const LAS bf16x8*)(al + ((2 * blk + qa) * 16 + ha) * 144 + s * 32 + hi * 16); }
        for (int w = wid; w <= wmax; w += 8) {
            IX_LOADK(bn, w + 8 <= wmax ? w + 8 : w);
            const int kidx = 32 * w + j;
#pragma unroll
            for (int blk = 0; blk < 4; ++blk) {
                f32x16 acc = (f32x16){0.f,0.f,0.f,0.f,0.f,0.f,0.f,0.f,0.f,0.f,0.f,0.f,0.f,0.f,0.f,0.f};
#pragma unroll
                for (int s = 0; s < 4; ++s) acc = __builtin_amdgcn_mfma_f32_32x32x16_bf16(af[blk][s], bf[s], acc, 0, 0, 0);
                const int q = 2 * blk + hi;
                const LAS f32x4* iwq = (const LAS f32x4*)(iwl + q * 16);
                float score = 0.f;
#pragma unroll
                for (int g = 0; g < 4; ++g) { const f32x4 wv = iwq[g]; score += fmaxf(acc[4 * g], 0.f) * wv.x + fmaxf(acc[4 * g + 1], 0.f) * wv.y + fmaxf(acc[4 * g + 2], 0.f) * wv.z + fmaxf(acc[4 * g + 3], 0.f) * wv.w; }
                const bool valid = kidx >= 48 && kidx <= 64 + t0 + q; const unsigned u_ = __float_as_uint(score);
                keys[q * 2112 + kidx] = valid ? ((u_ & 0x80000000u) ? ~u_ : (u_ | 0x80000000u)) : 0u;
            }
#pragma unroll
            for (int s = 0; s < 4; ++s) bf[s] = bn[s];
        }
#undef IX_LOADK
        LDS_WAIT(); __syncthreads();
    }
    const int tq = t0 + wid, qk = 64 + tq, nch = qk / 64 + 1;
    unsigned* out = bm + (size_t)(b * SEQ + tq) * BMW;
    if (tq + 17 <= 256) {
        for (int c = 0; c < 33; ++c) { const int kidx = 64 * c + lane; const unsigned long long m = __ballot(kidx >= 48 && kidx <= qk);
            if (lane == 0) { out[2 * c] = (unsigned)m; out[2 * c + 1] = (unsigned)(m >> 32); } }
    } else {
#define IX_SELECT(NC) do { unsigned kreg[NC]; \
        _Pragma("unroll") for (int c = 0; c < NC; ++c) kreg[c] = (c < nch && 64 * c + lane <= qk) ? keys[wid * 2112 + 64 * c + lane] : 0u;     \
        unsigned T = 0u; \
        for (int bit = 31; bit >= 0; --bit) { \
            const unsigned cand = T | (1u << bit); int cnt = 0; \
            _Pragma("unroll") for (int c = 0; c < NC; ++c) cnt += __popcll(__ballot(kreg[c] >= cand)); \
            if (cnt >= 256) T = cand; \
            if (cnt == 256) break; \
        } \
        _Pragma("unroll") for (int c = 0; c < NC; ++c) { const unsigned long long m = __ballot(kreg[c] >= T && kreg[c] != 0u); \
            if (lane == 0) { out[2 * c] = (unsigned)m; out[2 * c + 1] = (unsigned)(m >> 32); } } \
        if (lane < 2 * (33 - NC)) out[2 * NC + lane] = 0u; } while (0)
        if (nch <= 11) IX_SELECT(11); else if (nch <= 22) IX_SELECT(22); else IX_SELECT(33);
#undef IX_SELECT
    }
    LDS_WAIT();
}

namespace fa {
typedef float f32x16 __attribute__((ext_vector_type(16)));
typedef short s16x4 __attribute__((ext_vector_type(4)));
__device__ __forceinline__ int crow(int r, int hi) { return (r & 3) + 8 * (r >> 2) + 4 * hi; }
__device__ __forceinline__ int v_st(int k, int c) { const int kk = (k & ~0xC) | ((k & 4) << 1) | ((k & 8) >> 1); return ((kk >> 3) * 4 + (c >> 5)) * 512 + ((kk & 7) * 32 + (c & 31)) * 2; }
__device__ __forceinline__ int v_rd_base(int lane) { return ((lane & 3) << 3) | (((lane >> 2) & 3) << 6) | (((lane >> 4) & 1) << 5) | (((lane >> 5) & 1) << 8); }
constexpr int v_rd_off(int d0, int ks, int half) { return d0 * 512 + ks * 4096 + half * 2048; }
constexpr int SHM_V = 16384;
template <int DQK, int DV> struct Geo { static constexpr int KP = DQK * 2, SHM_K = 64 * DQK * 2, LDS_K0 = 2 * 64 * DV * 2, LDS_WS = LDS_K0 + 2 * SHM_K, BYTES = LDS_WS + 8 * 256; };
#define FA_KSWZ(row, colB, pitch) ((row) * (pitch) + ((colB) ^ (((row) & 7) << 4)))
#define FA_SBAR() __builtin_amdgcn_sched_barrier(0)

struct Item { int qrow0, qk0, nt, tokbase; };

template <int DQK>
__device__ __forceinline__ void load_q(const bf16_t* P, const Item& it, int qcol, bf16x8 (&qr)[DQK / 16]) {
    int tid = threadIdx.x; asm volatile("" : "+v"(tid));
    const int wid = tid >> 6, lane = tid & 63, r32 = lane & 31, hi = lane >> 5;
    const bf16_t* qp = P + (size_t)(it.qrow0 + wid * 32 + r32) * PW + qcol + hi * 8;
#pragma unroll
    for (int d0 = 0; d0 < DQK / 16; ++d0) qr[d0] = *(const bf16x8*)(qp + d0 * 16);
}

template <int DQK, int DV, bool MASKED>
__device__ __forceinline__ void attn_core(bf16_t* P, const Item& it, const bf16x8 (&qr)[DQK / 16], int k1col, int k2col, int vcol, int ocol, int ocol1, const unsigned* bmq, LAS unsigned char* lds) {
    typedef Geo<DQK, DV> G; constexpr int SHMV = 64 * DV * 2, NDB = DV / 32;
    int tid = threadIdx.x; asm volatile("" : "+v"(tid));
    const int wid = __builtin_amdgcn_readfirstlane(tid >> 6), lane = tid & 63, r32 = lane & 31, hi = lane >> 5;
    LAS unsigned char* V_lds = lds; LAS unsigned char* K_lds = lds + G::LDS_K0; LAS float* wsf = (LAS float*)(lds + G::LDS_WS) + wid * 64;
    const int sr = tid >> 4, sc = (tid & 15) * 8;
    const int vst0 = v_st(sr, sc), vst1 = v_st(32 + sr, sc), kws0 = FA_KSWZ(sr, sc * 2, G::KP), kws1 = FA_KSWZ(sr + 32, sc * 2, G::KP);
    const int xr = tid >> 3, xc = (tid & 7) * 8, kws2 = FA_KSWZ(xr, (128 + xc) * 2, G::KP);
    const unsigned loff0 = (unsigned)(sr * PW + sc) * 2u, loffx = (unsigned)(xr * PW + xc) * 2u;
    const int vb0 = (int)(unsigned)(size_t)V_lds + v_rd_base(lane);
    const int NT = it.nt;
    const int qk = it.qk0 + wid * 32 + r32;
    const bool use_bm = MASKED && (bmq != nullptr);
    const unsigned bmoff = (unsigned)((wid * 32 + r32) * BMW) * 4u;
    float l_reg = 0.f; f32x16 o[NDB];
#pragma unroll
    for (int d = 0; d < NDB; ++d) o[d] = (f32x16){0.f,0.f,0.f,0.f,0.f,0.f,0.f,0.f,0.f,0.f,0.f,0.f,0.f,0.f,0.f,0.f};
    bf16x8 sk0, sk1, sk2, sv0, sv1, sv2, sv3;
#define FA_KROW0(t) ((t) == 0 ? (MBLK - 64) : it.tokbase + 64 * ((t) - 1))
#define FA_LOADK(t) do { const int kr_ = FA_KROW0(t); const char* rb_ = (const char*)(P + (size_t)kr_ * PW); const char* rk_ = rb_ + (size_t)k1col * 2; \
        sk0 = *(const bf16x8*)(rk_ + loff0); sk1 = *(const bf16x8*)(rk_ + (size_t)32 * PW * 2 + loff0); if (DQK == 192) sk2 = *(const bf16x8*)(rb_ + (size_t)k2col * 2 + loffx); } while (0)
#define FA_LOADV(t) do { const char* rv_ = (const char*)(P + (size_t)FA_KROW0(t) * PW) + (size_t)vcol * 2; \
        sv0 = *(const bf16x8*)(rv_ + loff0); sv1 = *(const bf16x8*)(rv_ + (size_t)32 * PW * 2 + loff0); if (DV == 256) { sv2 = *(const bf16x8*)(rv_ + 256 + loff0); sv3 = *(const bf16x8*)(rv_ + 256 + (size_t)32 * PW * 2 + loff0); } } while (0)
#define FA_LOAD(t) do { FA_LOADK(t); FA_LOADV(t); } while (0)
#define FA_WRITE(bf) do { *(LAS bf16x8*)(K_lds + (bf) * G::SHM_K + kws0) = sk0; *(LAS bf16x8*)(K_lds + (bf) * G::SHM_K + kws1) = sk1; \
        *(LAS bf16x8*)(V_lds + (bf) * SHMV + vst0) = sv0; *(LAS bf16x8*)(V_lds + (bf) * SHMV + vst1) = sv1; if (DV == 256) { *(LAS bf16x8*)(V_lds + (bf) * SHMV + 16384 + vst0) = sv2; *(LAS bf16x8*)(V_lds + (bf) * SHMV + 16384 + vst1) = sv3; } \
        if (DQK == 192) *(LAS bf16x8*)(K_lds + (bf) * G::SHM_K + kws2) = sk2; } while (0)
    constexpr int QREG = (DV == 256) ? 3 : DQK / 16;
    constexpr int NQL = DQK / 16 - QREG;
    static_assert(G::BYTES + 8 * NQL * 64 * 16 <= LDSCTL_OFF, "attention LDS budget");
    LAS unsigned char* qx = lds + G::BYTES + (wid * (NQL * 64) + lane) * 16;
    if (QREG < DQK / 16) {
#pragma unroll
        for (int d0 = QREG; d0 < DQK / 16; ++d0) *(LAS bf16x8*)(qx + (d0 - QREG) * 1024) = qr[d0];
    }
    FA_LOAD(0); FA_WRITE(0);
    __syncthreads();
    for (int t = 0; t < NT; ++t) {
        const int cur = t & 1;
        unsigned zb = 0u; asm volatile("" : "+v"(zb)); u32x2 bw = (u32x2){zb, zb};
        if (use_bm) bw = *(const u32x2*)((const char*)(bmq + 2 * t) + bmoff);
        f32x16 p0 = (f32x16){0.f,0.f,0.f,0.f,0.f,0.f,0.f,0.f,0.f,0.f,0.f,0.f,0.f,0.f,0.f,0.f}, p1 = p0;
        { LAS unsigned char* kbase = K_lds + cur * G::SHM_K;
          LAS unsigned char* kb[4];
#pragma unroll
          for (int dd = 0; dd < 4; ++dd) kb[dd] = kbase + FA_KSWZ(r32, (dd * 16 + hi * 8) * 2, G::KP);
          constexpr int GS = (DQK == 192 || DV == 256) ? 2 : 4;
#pragma unroll
          for (int g = 0; g < DQK / (16 * GS); ++g) {
              bf16x8 fb0[GS], fb1[GS];
#pragma unroll
              for (int dd = 0; dd < GS; ++dd) { const int d0 = g * GS + dd; LAS unsigned char* a = kb[d0 & 3] + (d0 >> 2) * 128; fb0[dd] = *(const LAS bf16x8*)a; fb1[dd] = *(const LAS bf16x8*)(a + 32 * G::KP); }
              FA_SBAR();
#pragma unroll
              for (int dd = 0; dd < GS; ++dd) { const int d0 = g * GS + dd; bf16x8 qf; if (d0 < QREG) qf = qr[d0 < QREG ? d0 : 0]; else qf = *(const LAS bf16x8*)(qx + (d0 - QREG) * 1024);
                  p0 = __builtin_amdgcn_mfma_f32_32x32x16_bf16(fb0[dd], qf, p0, 0, 0, 0); p1 = __builtin_amdgcn_mfma_f32_32x32x16_bf16(fb1[dd], qf, p1, 0, 0, 0); }
              FA_SBAR(); } }
        if (t + 1 < NT) { FA_LOADK(t + 1); if (DV != 256) FA_LOADV(t + 1); }
        FA_SBAR();
        const float NEG = -__builtin_inff();
        if (use_bm) {
        } else if (t == 0 || 64 * t + 63 > it.qk0 + wid * 32) {
            const int kb_ = 64 * t + 4 * hi;
#pragma unroll
            for (int r = 0; r < 16; ++r) { const int k0 = kb_ + (r & 3) + 8 * (r >> 2), k1 = k0 + 32;
                if (k0 < 48 || k0 > qk) p0[r] = NEG; if (k1 < 48 || k1 > qk) p1[r] = NEG; }
        }
        float ps = 0.f;
#pragma unroll
        for (int r = 0; r < 16; ++r) { p0[r] = __builtin_amdgcn_exp2f(p0[r]); p1[r] = __builtin_amdgcn_exp2f(p1[r]); }
        if (use_bm) {
            const int wx = (int)(bw.x >> (4 * hi)), wy = (int)(bw.y >> (4 * hi));
#pragma unroll
            for (int r = 0; r < 16; ++r) { const int c = (r & 3) + 8 * (r >> 2);
                p0[r] = __uint_as_float(__float_as_uint(p0[r]) & (unsigned)__builtin_amdgcn_sbfe(wx, c, 1)); p1[r] = __uint_as_float(__float_as_uint(p1[r]) & (unsigned)__builtin_amdgcn_sbfe(wy, c, 1)); }
        }
        { f32x2 s2 = (f32x2){p0[0], p0[1]} + (f32x2){p1[0], p1[1]};
#pragma unroll
          for (int r = 2; r < 16; r += 2) s2 += (f32x2){p0[r], p0[r + 1]} + (f32x2){p1[r], p1[r + 1]};
          ps = s2.x + s2.y; }
        { auto rr = __builtin_amdgcn_permlane32_swap(__float_as_uint(ps), __float_as_uint(ps), false, false); ps = __uint_as_float(rr[0]) + __uint_as_float(rr[1]); }
        l_reg += ps;
        if (DV == 256 && t + 1 < NT) { FA_SBAR(); FA_LOADV(t + 1); FA_SBAR(); }
        bf16x8 pa0, pa1, pa2, pa3;
#define FA_PK4(Pv, B_, OUT) do { const unsigned a0 = cvt_pk_bf16(Pv[B_ + 0], Pv[B_ + 1]), a1 = cvt_pk_bf16(Pv[B_ + 2], Pv[B_ + 3]), b0 = cvt_pk_bf16(Pv[B_ + 4], Pv[B_ + 5]), b1 = cvt_pk_bf16(Pv[B_ + 6], Pv[B_ + 7]); \
        auto r0 = __builtin_amdgcn_permlane32_swap(a0, b0, false, false); auto r1 = __builtin_amdgcn_permlane32_swap(a1, b1, false, false); \
        u32x4 w_ = {r0[0], r1[0], r0[1], r1[1]}; OUT = __builtin_bit_cast(bf16x8, w_); } while (0)
        FA_PK4(p0, 0, pa0); FA_PK4(p0, 8, pa1); FA_PK4(p1, 0, pa2); FA_PK4(p1, 8, pa3);
#define FA_TRRD(dst, off) asm volatile("ds_read_b64_tr_b16 %0, %1 offset:%2" : "=&v"(dst) : "v"(vbc), "i"(off) : "memory")
#define FA_PV(VB, d0) do { s16x4 l0, l1, l2, l3, h0, h1, h2, h3; constexpr int b_ = ((d0) >> 2) * 16384 + v_rd_off((d0) & 3, 0, 0); \
        FA_TRRD(l0, b_); FA_TRRD(h0, b_ + 2048); FA_TRRD(l1, b_ + 4096); FA_TRRD(h1, b_ + 6144); FA_TRRD(l2, b_ + 8192); FA_TRRD(h2, b_ + 10240); FA_TRRD(l3, b_ + 12288); FA_TRRD(h3, b_ + 14336); \
        asm volatile("s_waitcnt lgkmcnt(0)" ::: "memory"); FA_SBAR(); \
        o[d0] = __builtin_amdgcn_mfma_f32_32x32x16_bf16(pa0, (bf16x8){l0[0], l0[1], l0[2], l0[3], h0[0], h0[1], h0[2], h0[3]}, o[d0], 0, 0, 0); \
        o[d0] = __builtin_amdgcn_mfma_f32_32x32x16_bf16(pa1, (bf16x8){l1[0], l1[1], l1[2], l1[3], h1[0], h1[1], h1[2], h1[3]}, o[d0], 0, 0, 0); \
        o[d0] = __builtin_amdgcn_mfma_f32_32x32x16_bf16(pa2, (bf16x8){l2[0], l2[1], l2[2], l2[3], h2[0], h2[1], h2[2], h2[3]}, o[d0], 0, 0, 0); \
        o[d0] = __builtin_amdgcn_mfma_f32_32x32x16_bf16(pa3, (bf16x8){l3[0], l3[1], l3[2], l3[3], h3[0], h3[1], h3[2], h3[3]}, o[d0], 0, 0, 0); } while (0)
        FA_SBAR();
        { const int vbc = vb0 + cur * SHMV;
          FA_PV(0, 0); FA_PV(0, 1); FA_PV(0, 2); FA_PV(0, 3); if (DV == 256) { FA_PV(0, 4); FA_PV(0, 5); FA_PV(0, 6); FA_PV(0, 7); } }
        FA_SBAR();
        if (t + 1 < NT) { const int nb_ = cur ^ 1; FA_WRITE(nb_); }
        __syncthreads();
    }
    if (hi == 0) wsf[r32] = l_reg; LDS_WAIT();
    float rli[16];
#pragma unroll
    for (int r = 0; r < 16; ++r) { const float lv = wsf[crow(r, hi)]; rli[r] = lv > 0.f ? __builtin_amdgcn_rcpf(lv) : 0.f; }
    { int l2 = lane; asm volatile("" : "+v"(l2));
      const int r32b = l2 & 31, hib = l2 >> 5;
      char* Ow = (char*)(P + (size_t)(it.qrow0 + wid * 32) * PW + ocol) + (unsigned)((4 * hib) * PW + r32b) * 2u;
      char* Ow1 = (char*)(P + (size_t)(it.qrow0 + wid * 32) * PW + ocol1) + (unsigned)((4 * hib) * PW + r32b) * 2u;
#pragma unroll
      for (int r = 0; r < 16; ++r) { const unsigned ro = (unsigned)(((r & 3) + 8 * (r >> 2)) * PW) * 2u;
#pragma unroll
        for (int d0 = 0; d0 < NDB; ++d0) { const float v = o[d0][r] * rli[r]; const float vn = __shfl_xor(v, 1);
            if ((r32b & 1) == 0) *(unsigned*)((d0 < 4 ? Ow : Ow1) + ro + (d0 & 3) * 64) = cvt_pk_bf16(v, vn); } } }
    LDS_WAIT();
    __syncthreads();
#undef FA_KROW0
#undef FA_LOAD
#undef FA_LOADK
#undef FA_LOADV
#undef FA_WRITE
#undef FA_PK4
#undef FA_TRRD
#undef FA_PV
}
__device__ __forceinline__ int next_item(unsigned* ctr, LAS int* slot) {
    __syncthreads();
    if (threadIdx.x == 0) *slot = (int)__hip_atomic_fetch_add(ctr, 1u, __ATOMIC_RELAXED, __HIP_MEMORY_SCOPE_AGENT);
    __syncthreads();
    return *slot;
}
__device__ __forceinline__ void queue_prime(unsigned* ctr, LAS int* slot) {
    __syncthreads();
    if (threadIdx.x == 0) slot[0] = (int)__hip_atomic_fetch_add(ctr, 1u, __ATOMIC_RELAXED, __HIP_MEMORY_SCOPE_AGENT);
    __syncthreads();
}
__device__ __forceinline__ int queue_next(unsigned* ctr, LAS int* slot, int k) {
    const int idx = slot[k & 1];
    if (threadIdx.x == 0) slot[(k + 1) & 1] = (int)__hip_atomic_fetch_add(ctr, 1u, __ATOMIC_RELAXED, __HIP_MEMORY_SCOPE_AGENT);
    return idx;
}
__device__ __forceinline__ Item make_item(bool meta, int b, int qb) {
    Item it;
    if (meta) { it.qrow0 = 0; it.qk0 = -(MBLK - 64); it.nt = 1; it.tokbase = MBLK; }
    else { it.qrow0 = MBLK + b * SEQ + qb * 256; it.qk0 = 64 + qb * 256; it.nt = 4 * (qb + 1) + 1; it.tokbase = MBLK + b * SEQ; }
    return it;
}
}


constexpr int PH_PER_LAYER = 19, N_PHASES = 2 * PH_PER_LAYER;
__device__ __forceinline__ unsigned char* uni_ptr(unsigned char* p) { const unsigned long long v = (unsigned long long)p; const unsigned lo = __builtin_amdgcn_readfirstlane((unsigned)v), hi = __builtin_amdgcn_readfirstlane((unsigned)(v >> 32)); return (unsigned char*)(((unsigned long long)hi << 32) | lo); }
__device__ __forceinline__ const float* arg_in(const Args& a, int k) { asm volatile("" : "+s"(k)); return a.in[k]; }
__global__ void __launch_bounds__(NWAVES * 64, 2) mega_fwd(Args args) {
    extern __shared__ __attribute__((aligned(16))) unsigned char lds_raw[];
    {
        LAS unsigned char* l0 = (LAS unsigned char*)lds_raw;
        for (int u = threadIdx.x; u < (LDS_BYTES - LDSCTL_OFF) / 4; u += NWAVES * 64) ((LAS unsigned*)(l0 + LDSCTL_OFF))[u] = 0u;
        __syncthreads();
    }
#if MK_ONE_LAUNCH
    (void)xcd_barrier_post((unsigned*)(args.ws + WS_CTL) + CW_BAR, (volatile LAS unsigned*)((LAS unsigned char*)lds_raw + LDSCTL_OFF + 64));
#define GRID_BAR() do { XcdBarrier bar_; bar_.bar = (unsigned*)(uni_ptr(args.ws) + WS_CTL) + CW_BAR; bar_.x = xb_xcc_id(); bar_.st = (volatile LAS unsigned*)((LAS unsigned char*)lds_raw + LDSCTL_OFF + 64); xcd_barrier(bar_); } while (0)
#else
#define GRID_BAR() do {} while (0)
#endif
    const int lo = args.ph_lo, hi = args.ph_hi;
#define IN(k) (lo <= (k) && (k) < hi)
#define SEAM(k) do { if (IN((k) + 1)) GRID_BAR(); } while (0)
#define PH_BEGIN \
    int tid_ = threadIdx.x; asm volatile("" : "+v"(tid_)); \
    Ctx F; F.lds = (LAS unsigned char*)lds_raw; F.tid = tid_; F.lane = tid_ & 63; F.wave = __builtin_amdgcn_readfirstlane(tid_ >> 6); \
    F.G = gridDim.x; F.bid = blockIdx.x; F.gw = F.bid * NWAVES + F.wave; F.ngw = F.G * NWAVES; \
    unsigned char* ws = uni_ptr(args.ws); asm volatile("" : "+s"(ws)); ws = (unsigned char*)(__attribute__((address_space(1))) unsigned char*)(unsigned long long)ws;     \
    int ly = __builtin_amdgcn_readfirstlane(layer); asm volatile("" : "+s"(ly)); (void)ly; (void)F
#define XN_ ((bf16_t*)(ws + WS_XN))
#define P_ ((bf16_t*)(ws + WS_P))
#define HMETA_ ((float*)(ws + WS_HMETA))
#define RSQ_(ly) ((rs_t*)(ws + WS_CTL + WS_RS2) + (size_t)(2 * (ly)) * R)
#define RSKV_(ly) ((rs_t*)(ws + WS_CTL + WS_RS2) + (size_t)(2 * (ly) + 1) * R)
#define BM_ ((unsigned*)(ws + WS_BM))
#define RS_(i) ((rs_t*)(ws + WS_CTL + WS_RS) + (size_t)(i) * R)
#define GPERM_ ((float*)(ws + WS_RSTD + 512 * 1024))
#define WB_(off) ((bf16_t*)(ws + WS_WB + (off)))
#define OUT_ (args.out)
#define LAMBDA_INIT(ly) ((ly) == 0 ? 0.2f : (0.8f - 0.6f * 0.7408182206817179f))

#pragma unroll
    for (int layer = 0; layer < 2; ++layer) {
        const int pb = layer * PH_PER_LAYER;
        if (((PHMASK >> 0) & 1) && IN(pb + 0)) {
            PH_BEGIN;
            for (int rep_ = 0; rep_ < NREP(0); ++rep_) { if (rep_) GRID_BAR();
            const float* meta = arg_in(args, 1);
            conv_matrix<1>(F, arg_in(args, 3) + (size_t)ly * DM * D_IN, DM, D_IN, WB_(WB_IN), arg_in(args, 2) + ly * DM);
            conv_matrix<0>(F, arg_in(args, 7) + (size_t)ly * 512 * 1536, 512, 1536, WB_(WB_QUP), arg_in(args, 5) + ly * 512);
            conv_matrix<0>(F, arg_in(args, 8) + (size_t)ly * 512 * 2048, 512, 2048, WB_(WB_KVUP), arg_in(args, 6) + ly * 512);
            for (int b = 0; b < 3; ++b) conv_matrix<0>(F, arg_in(args, 14) + ((size_t)ly * 3 + b) * 1024 * DM, 1024, DM, WB_(WB_BR) + (size_t)b * DM * 1024, nullptr);
            conv_matrix<0>(F, arg_in(args, 15) + (size_t)ly * DM * DM, DM, DM, WB_(WB_O), nullptr);
            conv_matrix<2>(F, arg_in(args, 17) + (size_t)ly * DM * 2 * DFF, DM, 2 * DFF, WB_(WB_F1), arg_in(args, 16) + ly * DM);
            conv_matrix<0>(F, arg_in(args, 18) + (size_t)ly * DFF * DM, DFF, DM, WB_(WB_F2), nullptr);
            unsigned zu = 0u; asm volatile("" : "+v"(zu)); const float zf = __uint_as_float(zu);
            for (int i = F.gw * 64 + F.lane; i < 112 * 2048 / 8; i += F.ngw * 64) *((u32x4*)(WB_(WB_IN) + (size_t)1168 * 2048) + i) = (u32x4){zu, zu, zu, zu};
            if (F.bid == 0) { const int i = F.tid; const int t = i >> 7, ps = i & 127, dim = (ps >> 1) + 64 * (ps & 1);
                const float* gsrc = (t < 2 ? arg_in(args, 10) : arg_in(args, 11)) + ly * 256 + (t & 1) * 128; GPERM_[i] = gsrc[dim]; }
            float* hmeta = HMETA_;
            if (ly == 0) {
                for (int i = F.gw * 64 + F.lane; i < MROW0 * PW / 8; i += F.ngw * 64) *((u32x4*)P_ + i) = (u32x4){zu, zu, zu, zu};
                for (int i = F.gw * 64 + F.lane; i < MBLK * DM / 4; i += F.ngw * 64) { const int rr = i / (DM / 4); f32x4 v = (f32x4){zf, zf, zf, zf};
                    if (rr >= MBLK - NMETA) v = *((const f32x4*)meta + (i - (MBLK - NMETA) * (DM / 4))); *((f32x4*)hmeta + i) = v; }
            }
            if (ly == 0) {
                const float* xin = arg_in(args, 0); bf16_t* XN = XN_; rs_t* rs0 = RS_(0);
                for (int r = MROW0 + F.gw; r < R; r += 2 * F.ngw) {
                    const int r2 = (r + F.ngw < R) ? r + F.ngw : r; f32x4 va[8], vb[8];
                    norm_load(r < MBLK ? meta + (size_t)(r - MROW0) * DM : xin + (size_t)(r - MBLK) * DM, F.lane, va); norm_load(r2 < MBLK ? meta + (size_t)(r2 - MROW0) * DM : xin + (size_t)(r2 - MBLK) * DM, F.lane, vb);
                    norm_fin(va, XN + (size_t)r * DM, rs0 + r, F.lane); if (r2 != r) norm_fin(vb, XN + (size_t)r2 * DM, rs0 + r2, F.lane); }
            }
            }
            SEAM(pb + 0);
        }
        if (((PHMASK >> 1) & 1) && IN(pb + 1)) {
            PH_BEGIN;
            { SkP f{P_, 0, RS_(2 * ly), 1.f / DM, RSQ_(ly), RSKV_(ly)}; skinny_gemm(F.lds, XN_ + (size_t)MROW0 * DM, DM, WB_(WB_IN), DM, 1280 / 16, F.bid, F.G, f); }
            SchedPlain S{XN_, DM, WB_(WB_IN), DM, NPMM, 5, F.G, F.bid, 0}; EpiP E{P_, RS_(2 * ly), RS_(2 * ly), 1 << 30, 1.f / DM, RSQ_(ly), RSKV_(ly)};
            pg8::gemm_phase(F.lds, S, E);
            if (NREP(1) == 2) { GRID_BAR(); pg8::gemm_phase(F.lds, S, E); }
            SEAM(pb + 1);
        }
        if (((PHMASK >> 2) & 1) && IN(pb + 2)) {
            PH_BEGIN;
            { SkP f{P_, C_QRAW, RSQ_(ly), 1.f / 512.f, nullptr, nullptr}; skinny_gemm(F.lds, P_ + (size_t)MROW0 * PW + C_CQ, PW, WB_(WB_QUP), 512, 1536 / 16, F.bid, F.G, f); }
            { SkP f{P_, C_KVRAW, RSKV_(ly), 1.f / 512.f, nullptr, nullptr}; skinny_gemm(F.lds, P_ + (size_t)MROW0 * PW + C_CKV, PW, WB_(WB_KVUP), 512, 2048 / 16, F.bid, F.G, f); }
            SchedMlaUp S{P_, WB_(WB_QUP), WB_(WB_KVUP), F.G, F.bid}; EpiP E{P_, RSQ_(ly), RSKV_(ly), 6, 1.f / 512.f, nullptr, nullptr};
            pg8::gemm_phase(F.lds, S, E);
            if (NREP(2) == 2) { GRID_BAR(); pg8::gemm_phase(F.lds, S, E); }
            SEAM(pb + 2);
        }
        if (((PHMASK >> 3) & 1) && IN(pb + 3)) {
            PH_BEGIN;
            const float* mla_qkg = arg_in(args, 9) + ly * 2 * 192;
            bf16_t* P = P_;
            LAS float* rnl = (LAS float*)(F.lds + F.wave * 64);
            for (int r = MROW0 + F.gw; r < R; r += 2 * F.ngw) {
                const int r2 = (r + F.ngw < R) ? r + F.ngw : r; u32x4 va[9], vb[9]; unsigned ia, ib;
                post2_load(P, r, F.lane, va, ia); post2_load(P, r2, F.lane, vb, ib);
                post2_row(P, r, va, ia, mla_qkg, rnl, F.lane); if (r2 != r) post2_row(P, r2, vb, ib, mla_qkg, rnl, F.lane); }
            SEAM(pb + 3);
        }
        if (((PHMASK >> 4) & 1) && IN(pb + 4)) {
            PH_BEGIN;
            bf16_t* P = P_;
            LAS int* slot = (LAS int*)(F.lds + LDSCTL_OFF + 128);
            for (int rep_ = 0; rep_ < NREP(4); ++rep_) { if (rep_) GRID_BAR();
            unsigned* ctr = (unsigned*)(ws + WS_CTL) + CW_Q + 64 * (ly * 4 + 0) + 64 * 16 * rep_;
            const bool stat = (F.G == 256); const int sx = F.bid & 7, spl = (F.bid >> 3) >> 2, sj = (F.bid >> 3) & 3;
            if (!stat) fa::queue_prime(ctr, slot);
            for (int qk_ = 0;; ++qk_) {
                int idx;
                if (stat) { if (qk_ < 4) { const int pr = sx + 8 * (spl + 8 * (qk_ >> 1)), qb = (qk_ & 1) ? sj : 7 - sj; idx = (7 - qb) * 128 + pr; } else idx = (qk_ == 4 && F.bid < 8) ? 1024 + F.bid : 1 << 30; }
                else idx = fa::queue_next(ctr, slot, qk_);
                if (idx >= 8 * 129) break;
                int h; fa::Item it;
                if (idx < 1024) { const int qb = 7 - (idx >> 7), rest = idx & 127; h = rest & 7; it = fa::make_item(false, rest >> 3, qb); } else { h = idx - 1024; it = fa::make_item(true, 0, 0); }
                bf16x8 qr[12]; fa::load_q<192>(P, it, C_QRAW + h * 192, qr);
                fa::attn_core<192, 128, false>(P, it, qr, C_KVRAW + h * 256, C_KPEH + h * 64, C_KVRAW + h * 256 + 128, C_OA + h * 128, 0, nullptr, F.lds);
            } }
            SEAM(pb + 4);
        }
        if (((PHMASK >> 5) & 1) && IN(pb + 5)) {
            PH_BEGIN;
            { SkP f{P_, 1280, RS_(2 * ly), 1.f / DM, nullptr, nullptr}; skinny_gemm(F.lds, XN_ + (size_t)MROW0 * DM, DM, WB_(WB_IN) + (size_t)1280 * DM, DM, 7168 / 16, F.bid, F.G, f); }
            SchedPlain S{XN_, DM, WB_(WB_IN) + (size_t)1280 * DM, DM, NPMM, 28, F.G, F.bid, 1280}; EpiG2 E{P_, RS_(2 * ly), GPERM_, (LAS float*)(F.lds + RING_BYTES)};
            pg8::gemm_phase(F.lds, S, E);
            if (NREP(5) == 2) { GRID_BAR(); pg8::gemm_phase(F.lds, S, E); }
            SEAM(pb + 5);
        }
        if (((PHMASK >> 6) & 1) && IN(pb + 6)) {
            PH_BEGIN;
            bf16_t* P = P_; const float* gp = GPERM_;
            if (F.gw < NMETA) meta_post_row(P, MROW0 + F.gw, gp, F.lane);
        }
        if (((PHMASK >> 7) & 1) && IN(pb + 7)) {
            PH_BEGIN;
            bf16_t* P = P_; unsigned* bm = BM_;
            unsigned* ctr = (unsigned*)(ws + WS_CTL) + CW_Q + 64 * (ly * 4 + 2);
            LAS int* slot = (LAS int*)(F.lds + LDSCTL_OFF + 128);
            for (int rep_ = 0; rep_ < NREP(7); ++rep_) { if (rep_) GRID_BAR(); unsigned* c2 = ctr + 64 * 16 * rep_;
            for (;;) { const int idx = fa::next_item(c2, slot); if (idx >= NTOK / 8) break; index_unit(P, idx, bm, F.lds); } }
            SEAM(pb + 7);
        }
        if (((PHMASK >> 8) & 1) && IN(pb + 8)) {
            PH_BEGIN;
            bf16_t* P = P_; unsigned* bm = BM_;
            LAS int* slot = (LAS int*)(F.lds + LDSCTL_OFF + 128);
            for (int rep_ = 0; rep_ < NREP(8); ++rep_) { if (rep_) GRID_BAR();
            const bool dummy = (NREP(8) == 2) && rep_ == 0;
            unsigned* ctr = (unsigned*)(ws + WS_CTL) + CW_Q + 64 * (ly * 4 + 1) + 64 * 16 * rep_;
            const bool stat = (F.G == 256); const int sx = F.bid & 7, spl = (F.bid >> 3) >> 2, sj = (F.bid >> 3) & 3;
            if (!stat) fa::queue_prime(ctr, slot);
            for (int qk_ = 0;; ++qk_) {
                int idx;
                if (stat) { if (qk_ < 8) { const int pr = sx + 8 * (spl + 8 * ((qk_ >> 1) & 1)), qb = (qk_ & 1) ? sj : 7 - sj; idx = (7 - qb) * 256 + ((qk_ >> 2) ? 128 : 0) + pr; } else idx = (qk_ == 8 && F.bid < 16) ? 2048 + F.bid : 1 << 30; }
                else idx = fa::queue_next(ctr, slot, qk_);
                if (idx >= 16 * 129) break;
                int hh; bool meta = false; fa::Item it; int b = 0, qb = 0;
                if (idx < 2048) { qb = 7 - (idx >> 8); const int rest = idx & 255; hh = (rest < 128) ? 8 + (rest & 7) : (rest & 7); b = (rest & 127) >> 3; it = fa::make_item(false, b, qb); }
                else { hh = idx - 2048; hh = hh < 8 ? 8 + hh : hh - 8; meta = true; it = fa::make_item(true, 0, 0); }
                if (hh < 8) {
                    bf16x8 qr[8]; fa::load_q<128>(P, it, C_DQ + hh * 128, qr);
                    fa::attn_core<128, 128, true>(P, it, qr, C_DK + hh * 128, 0, C_DV + hh * 128, dummy ? C_KPE : C_OB + hh * 128, 0, meta ? nullptr : bm + (size_t)(b * SEQ + qb * 256) * BMW, F.lds);
                } else {
                    const int hj = hh - 8;
                    bf16x8 qr[8]; fa::load_q<128>(P, it, C_FQ + hj * 128, qr);
                    fa::attn_core<128, 256, false>(P, it, qr, C_FK + hj * 128, 0, C_FV + (hj >> 1) * 256, dummy ? C_KPE : C_FQ + hj * 128, dummy ? C_KPE : C_IQ + hj * 128, nullptr, F.lds);
                }
            } }
            SEAM(pb + 8);
        }
        if (((PHMASK >> 9) & 1) && IN(pb + 9)) {
            PH_BEGIN;
            const float* diff_lam = arg_in(args, 12) + ly * 4 * 128; const float* diff_subg = arg_in(args, 13) + ly * 256;
            const float lambda_init = LAMBDA_INIT(ly);
            const float s1 = wave_sum(diff_lam[F.lane] * diff_lam[128 + F.lane] + diff_lam[64 + F.lane] * diff_lam[192 + F.lane]);
            const float s2 = wave_sum(diff_lam[256 + F.lane] * diff_lam[384 + F.lane] + diff_lam[320 + F.lane] * diff_lam[448 + F.lane]);
            const float lam = __expf(s1) - __expf(s2) + lambda_init;
            bf16_t* P = P_;
            for (int r = MROW0 + F.gw; r < R; r += 4 * F.ngw) {
                int rr_[4]; u32x4 vv[4][4];
#pragma unroll
                for (int k = 0; k < 4; ++k) { rr_[k] = (r + k * F.ngw < R) ? r + k * F.ngw : r; post3_load(P, rr_[k], F.lane, vv[k]); }
#pragma unroll
                for (int k = 0; k < 4; ++k) if (k == 0 || rr_[k] != r) post3_row(P, rr_[k], vv[k], diff_subg, lam, 1.f - lambda_init, F.lane); }
        }
#define GATE_PHASE(k, b, sk, seam) \
        if (((PHMASK >> 10) & 1) && IN(pb + (k))) { \
            PH_BEGIN; \
            { SkGate f{(bf16_t*)(ws + WS_GS), arg_in(args, 4) + ly * 3 * DM + (b) * DM, RS_(2 * ly)}; skinny_gemm(F.lds, XN_ + (size_t)MROW0 * DM, DM, WB_(WB_G) + (size_t)(b) * 2048 * DM, DM, 2048 / 16, (F.bid + (sk)) % F.G, F.G, f); } \
            SchedPlain S{XN_, DM, WB_(WB_G) + (size_t)(b) * 2048 * DM, DM, NPMM, 8, F.G, F.bid, 0}; EpiGate E{(bf16_t*)(ws + WS_GS), arg_in(args, 4) + ly * 3 * DM + (b) * DM, RS_(2 * ly)}; \
            pg8::gemm_phase(F.lds, S, E); \
            if (NREP(k) == 2) { GRID_BAR(); pg8::gemm_phase(F.lds, S, E); } \
            if (seam) SEAM(pb + (k)); \
        }
#define BRANCH_PHASE(k, b, oc, sk, seam) \
        if (((PHMASK >> 10) & 1) && IN(pb + (k))) { \
            PH_BEGIN; \
            { SkGated f{P_, (const bf16_t*)(ws + WS_GS), (b) == 0 ? 1 : 0}; skinny_gemm(F.lds, P_ + (size_t)MROW0 * PW + (oc), PW, WB_(WB_BR) + (size_t)(b) * DM * 1024, 1024, 2048 / 16, (F.bid + (sk)) % F.G, F.G, f); } \
            SchedPlain S{P_ + (oc), PW, WB_(WB_BR) + (size_t)(b) * DM * 1024, 1024, NPMM, 8, F.G, F.bid, C_MERGED}; EpiGated E{P_, (const bf16_t*)(ws + WS_GS), (b) == 0 ? 1 : 0, ((DBG_BM >> (b)) & 1) ? 1.f : 0.f}; \
            pg8::gemm_phase(F.lds, S, E); \
            if (NREP(k) == 2 && (b) == 0) { GRID_BAR(); pg8::gemm_phase(F.lds, S, E); } \
            if (seam) SEAM(pb + (k)); \
        }
        GATE_PHASE(10, 0, 0, 0) BRANCH_PHASE(11, 0, C_OA, 0, 0)
        GATE_PHASE(12, 1, 0, 0) BRANCH_PHASE(13, 1, C_OB, 0, 0)
        GATE_PHASE(14, 2, 0, 1) BRANCH_PHASE(15, 2, C_OC, 128, 1)
        if (((PHMASK >> 11) & 1) && IN(pb + 16)) {
            PH_BEGIN;
            { SkRes f{HMETA_, XN_, RS_(2 * ly + 1)}; skinny_gemm(F.lds, P_ + (size_t)MROW0 * PW + C_MERGED, PW, WB_(WB_O), DM, 2048 / 16, F.bid, F.G, f); }
            SchedPlain S{P_ + C_MERGED, PW, WB_(WB_O), DM, NPMM, 8, F.G, F.bid, 0}; EpiRes E{(float*)nullptr, DBG_SA, XN_, RS_(2 * ly + 1)};
            pg8::gemm_phase(F.lds, S, E);
            SEAM(pb + 16);
        }
        if (((PHMASK >> 13) & 1) && IN(pb + 17)) {
            PH_BEGIN;
            skinny_swiglu(F.lds, XN_ + (size_t)MROW0 * DM, DM, WB_(WB_F1), DM, P_, RS_(2 * ly + 1), F.bid, F.G);
            SchedPlain S{XN_, DM, WB_(WB_F1), DM, NPMM, 44, F.G, F.bid, 0}; EpiSwiglu E{P_, RS_(2 * ly + 1)};
            pg8::gemm_phase(F.lds, S, E);
            if (NREP(17) == 2) { GRID_BAR(); pg8::gemm_phase(F.lds, S, E); }
            SEAM(pb + 17);
        }
        if (((PHMASK >> 14) & 1) && IN(pb + 18)) {
            PH_BEGIN;
            { SkRes f{HMETA_, ly == 0 ? XN_ : (bf16_t*)nullptr, RS_(2)}; skinny_gemm(F.lds, P_ + (size_t)MROW0 * PW, PW, WB_(WB_F2), DFF, 2048 / 16, F.bid, F.G, f); }
            SchedPlain S{P_, PW, WB_(WB_F2), DFF, NPMM, 8, F.G, F.bid, 0}; EpiRes E{ly == 0 ? (float*)nullptr : OUT_, DBG_SF, XN_, RS_(2)};
            pg8::gemm_phase(F.lds, S, E);
            SEAM(pb + 18);
        }
    }
#undef IN
#undef SEAM
}

__global__ void diag_fill(float* out, int n, float v) { for (int i = blockIdx.x * blockDim.x + threadIdx.x; i < n; i += gridDim.x * blockDim.x) out[i] = v; }
extern "C" void kernel_launch(void* const* d_in, const int* in_sizes, int n_in, void* d_out, int out_size, void* d_ws, size_t ws_size, hipStream_t stream) {
    static int grid = 0; static float code = 0.f;
    if (grid == 0) {
        int dev = 0, cus = 0;
        if (n_in != 19) { code = 10.f; grid = -1; }
        else if (ws_size < WS_END) { code = 20.f + (float)(ws_size >> 20) * 0.01f; grid = -1; }
        else if (hipGetDevice(&dev) != hipSuccess || hipDeviceGetAttribute(&cus, hipDeviceAttributeMultiprocessorCount, dev) != hipSuccess) { code = 40.f; grid = -1; }
        else if (hipFuncSetAttribute((const void*)mega_fwd, hipFuncAttributeMaxDynamicSharedMemorySize, LDS_BYTES) != hipSuccess) { code = 50.f; grid = -1; }
        else {
            int per_cu = 0;
            if (hipOccupancyMaxActiveBlocksPerMultiprocessor(&per_cu, (const void*)mega_fwd, NWAVES * 64, LDS_BYTES) != hipSuccess || per_cu < 1) { code = 60.f; grid = -1; }
            (void)hipGetLastError();
            if (grid == 0) grid = cus;
        }
    }
    if (grid < 0) { hipLaunchKernelGGL(diag_fill, dim3(1024), dim3(256), 0, stream, (float*)d_out, out_size, code); return; }
    (void)hipMemsetAsync((char*)d_ws + WS_CTL, 0, CTL_BYTES, stream);
    Args a{};
    for (int i = 0; i < 19; ++i) a.in[i] = (const float*)d_in[i];
    a.out = (float*)d_out; a.ws = (unsigned char*)d_ws;
#if MK_ONE_LAUNCH
    a.ph_lo = 0; a.ph_hi = N_PHASES;
    hipLaunchKernelGGL(mega_fwd, dim3(grid), dim3(NWAVES * 64), LDS_BYTES, stream, a);
#else
    for (int p = 0; p < N_PHASES; ++p) { a.ph_lo = p; a.ph_hi = p + 1; hipLaunchKernelGGL(mega_fwd, dim3(grid), dim3(NWAVES * 64), LDS_BYTES, stream, a); }
#endif
    if (hipPeekAtLastError() != hipSuccess) { (void)hipGetLastError(); hipLaunchKernelGGL(diag_fill, dim3(1024), dim3(256), 0, stream, (float*)d_out, out_size, 70.f); }
}
```

```cpp
#include <hip/hip_runtime.h>
#include <cstdio>
#include <cstdint>

#ifndef PHMASK
#define PHMASK 0x7fff
#endif
#ifndef REPMASK
#define REPMASK 0
#endif
#define NREP(k) ((((REPMASK) >> (k)) & 1) ? 2 : 1)
#ifndef DBG_BM
#define DBG_BM 7
#endif
#ifndef DBG_BR
#define DBG_BR 0
#endif
#ifndef DBG_SA
#define DBG_SA 1.0f
#endif
#ifndef DBG_SF
#define DBG_SF 1.0f
#endif
#ifndef MK_ONE_LAUNCH
#define MK_ONE_LAUNCH 1
#endif

#define LAS __attribute__((address_space(3)))
#define GAS __attribute__((address_space(1)))
typedef unsigned short bf16_t;
typedef short bf16x8 __attribute__((ext_vector_type(8)));
typedef float f32x4 __attribute__((ext_vector_type(4)));
typedef float f32x2 __attribute__((ext_vector_type(2)));
typedef unsigned u32x4 __attribute__((ext_vector_type(4)));
typedef unsigned u32x2 __attribute__((ext_vector_type(2)));
typedef unsigned long long rs_t;
__device__ __forceinline__ float rs_val(rs_t v) { return (float)((double)v * (1.0 / 4294967296.0)); }
__device__ __forceinline__ rs_t rs_fix(float ss) { return (rs_t)((double)ss * 4294967296.0); }
__device__ __forceinline__ void st_wt(void* p, u32x4 v) { typedef __attribute__((address_space(1))) u32x4 gv; *(gv*)(unsigned long long)p = v; }
__device__ __forceinline__ void st_wt(void* p, f32x4 v) { typedef __attribute__((address_space(1))) f32x4 gv; *(gv*)(unsigned long long)p = v; }

constexpr int DM = 2048, NB = 16, SEQ = 2048, NMETA = 16, MBLK = 256;
constexpr int R = MBLK + NB * SEQ;
constexpr int NPM = R / 256;
constexpr int NPMM = NPM - 1;
constexpr int MROW0 = MBLK - NMETA;
constexpr int NTOK = NB * SEQ;
constexpr int DFF = 5632;
constexpr int PW = 8448;
constexpr int C_CQ = 0, C_CKV = 512, C_KPE = 1024, C_IK = 1088, C_IW = 1152, C_DQ = 1280, C_DK = 2304, C_DV = 3328, C_IQ = 4352,
              C_FQ = 5376, C_FK = 6400, C_FV = 7424;
constexpr int C_KVRAW = 1280, C_QRAW = 3328, C_KPEH = 4864;
constexpr int C_OA = 0, C_OB = C_DQ, C_OC = C_FQ, C_MERGED = 2304;
constexpr int BMW = 66;
constexpr float EPS = 1e-6f;
constexpr float LOG2E = 1.4426950408889634f;
constexpr float C2_128 = 0.08838834764831845f * LOG2E;
constexpr float C2_192 = 0.07216878364870323f * LOG2E;
constexpr int D_IN = 14480;

constexpr size_t MiB = 1u << 20;
constexpr size_t WS_CTL = 0, CTL_BYTES = 2816 * 1024;
constexpr size_t WS_RSTD = 13 * MiB;
constexpr size_t WS_HMETA = 14 * MiB;
constexpr size_t WS_BM = 4 * MiB;
constexpr size_t WS_WB = 16 * MiB;
constexpr size_t WB_IN = 0, WB_G = WB_IN + (size_t)8448 * 2048 * 2, WB_QUP = WB_G + (size_t)6144 * 2048 * 2, WB_KVUP = WB_QUP + (size_t)1536 * 512 * 2,
                 WB_BR = WB_KVUP + (size_t)2048 * 512 * 2, WB_O = WB_BR + (size_t)3 * 2048 * 1024 * 2, WB_F1 = WB_O + (size_t)2048 * 2048 * 2,
                 WB_F2 = WB_F1 + (size_t)11264 * 2048 * 2, WB_END = WB_F2 + (size_t)2048 * 5632 * 2;
constexpr size_t WS_XN = 164 * MiB;
constexpr size_t WS_P = 294 * MiB;
constexpr size_t WS_GS = 828 * MiB;
constexpr size_t WS_END = 960 * MiB;
static_assert(WS_GS + (size_t)R * 2048 * 2 <= WS_END && WS_WB + WB_END <= WS_XN && WS_XN + (size_t)R * 2048 * 2 <= WS_P && WS_P + (size_t)R * PW * 2 <= WS_GS, "ws map");
constexpr int CW_BAR = 4096, CW_Q = 16384;
constexpr size_t WS_RS = 256 * 1024;
constexpr size_t WS_RS2 = 1536 * 1024;
static_assert(WS_RS + (size_t)4 * R * 8 <= WS_RS2 && WS_RS2 + (size_t)4 * R * 8 <= CTL_BYTES && CTL_BYTES <= WS_BM && WS_BM + (size_t)32768 * BMW * 4 <= WS_RSTD && WS_RSTD + 1 * MiB <= WS_HMETA && WS_HMETA + 2 * MiB <= WS_WB, "ctl map");

__device__ __forceinline__ float bf2f(bf16_t v) { return __uint_as_float((unsigned)v << 16); }
__device__ __forceinline__ unsigned f2bf(float f) { unsigned u = __float_as_uint(f); return (u + 0x7fffu + ((u >> 16) & 1u)) >> 16; }
__device__ __forceinline__ unsigned pk2(float lo, float hi) { return f2bf(lo) | (f2bf(hi) << 16); }
typedef __bf16 bf16x2_t __attribute__((ext_vector_type(2)));
__device__ __forceinline__ unsigned cvt_pk_bf16(float lo, float hi) { f32x2 v = {lo, hi}; bf16x2_t b = __builtin_convertvector(v, bf16x2_t); return __builtin_bit_cast(unsigned, b); }
__device__ __forceinline__ float wave_sum(float v) {
#pragma unroll
    for (int o = 1; o < 64; o <<= 1) v += __shfl_xor(v, o);
    return v;
}
__device__ __forceinline__ float wave_max(float v) {
#pragma unroll
    for (int o = 1; o < 64; o <<= 1) v = fmaxf(v, __shfl_xor(v, o));
    return v;
}
#define LDS_WAIT() asm volatile("s_waitcnt lgkmcnt(0)" ::: "memory")
#define VM_WAIT() asm volatile("s_waitcnt vmcnt(0)" ::: "memory")
__device__ __forceinline__ int row_pos(int r) { return r < MBLK ? (r >= MBLK - NMETA ? r - (MBLK - NMETA) : 0) : NMETA + ((r - MBLK) & (SEQ - 1)); }
__device__ __forceinline__ void rope_cs(int pos, int i, float two_over_d, float& c, float& s) {
    const float inv = __builtin_amdgcn_exp2f(-(float)i * two_over_d * 13.287712379549449f);
    float rev = (float)pos * inv * 0.15915494309189535f;
    rev -= floorf(rev);
    s = __builtin_amdgcn_sinf(rev); c = __builtin_amdgcn_cosf(rev);
}

namespace pg8 {
constexpr int BM = 256, BK = 64, HALF = 128, HTB = HALF * BK * 2, STAGE_BYTES = 8 * HTB;
__device__ __forceinline__ int lds_byte(int r, int c) { const int st = (r >> 4) * 2 + (c >> 5), rr = r & 15, cc = c & 31, ob = rr * 64 + cc * 2; return st * 1024 + (ob ^ (((ob >> 9) & 1) << 5)); }
__device__ __forceinline__ void stage_rc(int b, int& R_, int& C_) { const int st = b / 1024, sb = b % 1024, swz = sb ^ (((sb >> 9) & 1) << 5); R_ = (st >> 1) * 16 + swz / 64; C_ = (st & 1) * 32 + (swz % 64) / 2; }
__device__ __forceinline__ int perm32(int rho) { const int n = rho >> 4, i = rho & 15; return 8 * (i >> 2) + 4 * n + (i & 3); }

struct Unit { const char* A; const char* B; unsigned lda2, ldb2; int nt, pm, pn, kind, ocol; };

#ifndef WGM
#define WGM 4
#endif
__device__ __forceinline__ void tile_of(int L, int nM, int nN, int& pm, int& pn) {
    const int nwg = nM * nN; int wgid = L;
    { const int q = nwg / 8, r = nwg % 8, xcd = wgid % 8, off = wgid / 8; wgid = (xcd < r ? xcd * (q + 1) : r * (q + 1) + (xcd - r) * q) + off; }
    const int nig = WGM * nN, gid = wgid / nig, fm = gid * WGM, gsz = (nM - fm) < WGM ? (nM - fm) : WGM;
    pm = fm + ((wgid % nig) % gsz); pn = (wgid % nig) / gsz;
}

template <class Epi, class Sched>
__device__ __forceinline__ void gemm_phase(LAS unsigned char* lds, const Sched& S, const Epi& E) {
    int tid = threadIdx.x; asm volatile("" : "+v"(tid));
    const int wid = __builtin_amdgcn_readfirstlane(tid >> 6), lane = tid & 63, wr = wid >> 2, wc = wid & 3, fr = lane & 15, fq = lane >> 4;
    unsigned rA[2], rB[2], cc[2];
#pragma unroll
    for (int i = 0; i < 2; ++i) { int R_, C_; stage_rc(tid * 16 + i * 8192, R_, C_); rA[i] = (unsigned)R_; rB[i] = (unsigned)(Epi::PERM ? ((R_ & ~31) + perm32(R_ & 31)) : R_); cc[i] = (unsigned)C_ * 2u; }
    const size_t kstep = (size_t)(BK * 2);
    const unsigned ldsw = (unsigned)wid * 1024u;
    const int aoff = lds_byte(wr * 64 + fr, fq * 8), boff = lds_byte(wc * 32 + fr, fq * 8);
#define PG8_SA(b, h) (((b) * 2 + (h)) * HTB)
#define PG8_SB(b, h) ((4 + (b) * 2 + (h)) * HTB)
#define PG8_STAGE(bufoff, gbase, rr, ld2) do { _Pragma("unroll") for (int _i = 0; _i < 2; ++_i) \
        __builtin_amdgcn_global_load_lds((const unsigned*)((const char*)(gbase) + ((rr)[_i] * (ld2) + cc[_i])), (LAS unsigned*)(lds + (bufoff) + ldsw + _i * 8192), 16, 0, 0); } while (0)
#define PG8_LDA(dst, b, h) do { _Pragma("unroll") for (int m = 0; m < 4; ++m) _Pragma("unroll") for (int k = 0; k < 2; ++k) dst[m][k] = *(const LAS bf16x8*)(lds + PG8_SA(b, h) + aoff + m * 2048 + k * 1024); } while (0)
#define PG8_LDB(dst, b, h) do { _Pragma("unroll") for (int n = 0; n < 2; ++n) _Pragma("unroll") for (int k = 0; k < 2; ++k) dst[n][k] = *(const LAS bf16x8*)(lds + PG8_SB(b, h) + boff + n * 2048 + k * 1024); } while (0)
#define PG8_MMA(ai, bj, At, Bt) do { __builtin_amdgcn_s_setprio(1); _Pragma("unroll") for (int m = 0; m < 4; ++m) _Pragma("unroll") for (int n = 0; n < 2; ++n) _Pragma("unroll") for (int k = 0; k < 2; ++k) \
        acc[ai][bj][m][n] = __builtin_amdgcn_mfma_f32_16x16x32_bf16(Bt[n][k], At[m][k], acc[ai][bj][m][n], 0, 0, 0); __builtin_amdgcn_s_setprio(0); } while (0)
#define PG8_WAIT_V(n) asm volatile("s_waitcnt vmcnt(" #n ")" ::: "memory")
#define PG8_WAIT_L(n) asm volatile("s_waitcnt lgkmcnt(" #n ")" ::: "memory")
#define PG8_BAR __builtin_amdgcn_s_barrier()
#define PG8_SCHED __builtin_amdgcn_sched_barrier(0)
    Unit cur, nxt; int ui = 0;
    if (!S.next(0, cur)) return;
    float zf = 0.f; asm volatile("" : "+v"(zf));
    f32x4 acc[2][2][4][2];
#pragma unroll
    for (int a = 0; a < 2; ++a)
#pragma unroll
        for (int b = 0; b < 2; ++b)
#pragma unroll
            for (int m = 0; m < 4; ++m)
#pragma unroll
                for (int n = 0; n < 2; ++n) acc[a][b][m][n] = (f32x4){zf, zf, zf, zf};
    rs_t pre[8] = {0, 0, 0, 0, 0, 0, 0, 0}; E.prefetch(cur, wr, fr, pre);
    bf16x8 At[4][2], B0[2][2], B1[2][2];
    const char* cA = cur.A; const char* cB = cur.B;
    unsigned lA = cur.lda2, lB = cur.ldb2;
    size_t hA = (size_t)HALF * lA, hB = (size_t)HALF * lB;
    PG8_STAGE(PG8_SB(0, 0), cB, rB, lB); PG8_STAGE(PG8_SB(0, 1), cB + hB, rB, lB); PG8_STAGE(PG8_SA(0, 0), cA, rA, lA); PG8_STAGE(PG8_SA(0, 1), cA + hA, rA, lA);
    if (wr == 1) PG8_BAR;
    PG8_WAIT_V(2); PG8_BAR;
    PG8_STAGE(PG8_SB(1, 0), cB + kstep, rB, lB); PG8_STAGE(PG8_SA(1, 0), cA + kstep, rA, lA); PG8_STAGE(PG8_SB(1, 1), cB + hB + kstep, rB, lB);
    PG8_WAIT_V(6); PG8_BAR;
    for (;;) {
        const bool has_next = S.next(ui + 1, nxt);
        if (!has_next) nxt = cur;
        const char* nA = nxt.A; const char* nB = nxt.B;
        const unsigned lAn = nxt.lda2, lBn = nxt.ldb2;
        const size_t hAn = (size_t)HALF * lAn, hBn = (size_t)HALF * lBn;
        const int nt = cur.nt;
        for (int t = 0; t < nt; t += 2) {
            const bool last = (t == nt - 2);
            const char* a1 = cA + (size_t)(t + 1) * kstep;
            const char* a2 = last ? nA : cA + (size_t)(t + 2) * kstep; const char* b2 = last ? nB : cB + (size_t)(t + 2) * kstep;
            const char* a3 = a2 + kstep; const char* b3 = b2 + kstep;
            const size_t hA2 = last ? hAn : hA, hB2 = last ? hBn : hB;
            const unsigned lA2 = last ? lAn : lA, lB2 = last ? lBn : lB;
            PG8_LDB(B0, 0, 0); PG8_LDB(B1, 0, 1); PG8_SCHED; PG8_LDA(At, 0, 0); PG8_STAGE(PG8_SA(1, 1), a1 + hA, rA, lA);
            PG8_WAIT_V(8); PG8_WAIT_L(0); PG8_BAR; PG8_MMA(0, 0, At, B0); PG8_MMA(0, 1, At, B1); PG8_BAR; PG8_SCHED;
            PG8_LDA(At, 0, 1); PG8_STAGE(PG8_SB(0, 0), b2, rB, lB2); PG8_STAGE(PG8_SB(0, 1), b2 + hB2, rB, lB2); PG8_STAGE(PG8_SA(0, 0), a2, rA, lA2);
            PG8_WAIT_V(8); PG8_WAIT_L(0); PG8_BAR; PG8_MMA(1, 0, At, B0); PG8_MMA(1, 1, At, B1); PG8_BAR; PG8_SCHED;
            PG8_LDB(B0, 1, 0); PG8_LDB(B1, 1, 1); PG8_SCHED; PG8_LDA(At, 1, 0); PG8_STAGE(PG8_SA(0, 1), a2 + hA2, rA, lA2);
            PG8_WAIT_V(8); PG8_WAIT_L(0); PG8_BAR; PG8_MMA(0, 0, At, B0); PG8_MMA(0, 1, At, B1); PG8_BAR; PG8_SCHED;
            PG8_LDA(At, 1, 1); PG8_STAGE(PG8_SB(1, 0), b3, rB, lB2); PG8_STAGE(PG8_SB(1, 1), b3 + hB2, rB, lB2); PG8_STAGE(PG8_SA(1, 0), a3, rA, lA2);
            PG8_WAIT_V(8); PG8_WAIT_L(0); PG8_BAR; PG8_MMA(1, 0, At, B0); PG8_MMA(1, 1, At, B1); PG8_BAR; PG8_SCHED;
        }
        if (wr == 0) PG8_BAR;
        E(acc, cur, wr, wc, fr, fq, pre);
#pragma unroll
        for (int a = 0; a < 2; ++a)
#pragma unroll
            for (int b = 0; b < 2; ++b)
#pragma unroll
                for (int m = 0; m < 4; ++m)
#pragma unroll
                    for (int n = 0; n < 2; ++n) acc[a][b][m][n] = (f32x4){zf, zf, zf, zf};
        if (!has_next) break;
        cur = nxt; cA = nA; cB = nB; hA = hAn; hB = hBn; lA = lAn; lB = lBn; ++ui;
        E.prefetch(cur, wr, fr, pre);
        if (wr == 1) PG8_BAR;
    }
    PG8_WAIT_V(0);
    PG8_BAR;
#undef PG8_SA
#undef PG8_SB
#undef PG8_STAGE
#undef PG8_LDA
#undef PG8_LDB
#undef PG8_MMA
#undef PG8_WAIT_V
#undef PG8_WAIT_L
#undef PG8_BAR
#undef PG8_SCHED
}
}
using pg8::Unit;

struct SchedPlain {
    const bf16_t* A; int lda; const bf16_t* B; int K; int nM, nN, G, c, ocol0;
    __device__ __forceinline__ bool next(int i, Unit& u) const {
        const int L = i * G + c; if (L >= nM * nN) return false;
        int pm, pn; pg8::tile_of(L, nM, nN, pm, pn); pm += 1;
        u.pm = pm; u.pn = pn; u.kind = 0; u.ocol = ocol0 + 256 * pn; u.nt = K / 64; u.lda2 = (unsigned)lda * 2u; u.ldb2 = (unsigned)K * 2u;
        u.A = (const char*)(A + (size_t)pm * 256 * lda); u.B = (const char*)(B + (size_t)pn * 256 * K); return true;
    }
};
struct SchedMlaUp {
    const bf16_t* P; const bf16_t* Wq; const bf16_t* Wkv; int G, c;
    __device__ __forceinline__ bool next(int i, Unit& u) const {
        const int L = i * G + c; if (L >= NPMM * 14) return false;
        int pm, pn; pg8::tile_of(L, NPMM, 14, pm, pn); pm += 1;
        u.pm = pm; u.pn = pn; u.kind = 0; u.nt = 8; u.lda2 = PW * 2u; u.ldb2 = 512 * 2u;
        if (pn < 6) { u.A = (const char*)(P + (size_t)pm * 256 * PW + C_CQ); u.B = (const char*)(Wq + (size_t)pn * 256 * 512); u.ocol = C_QRAW + 256 * pn; }
        else { u.A = (const char*)(P + (size_t)pm * 256 * PW + C_CKV); u.B = (const char*)(Wkv + (size_t)(pn - 6) * 256 * 512); u.ocol = C_KVRAW + 256 * (pn - 6); }
        return true;
    }
};
struct EpiP {
    static constexpr bool PERM = true;
    bf16_t* P; const rs_t* rs; const rs_t* rs2; int split; float inv_dim; rs_t* sq; rs_t* skv;
    __device__ __forceinline__ void prefetch(const Unit& u, int wr, int fr, rs_t (&pre)[8]) const { const rs_t* r_ = (u.pn < split ? rs : rs2); if (r_) { r_ += u.pm * 256 + wr * 64 + fr;
#pragma unroll
        for (int i = 0; i < 8; ++i) pre[i] = r_[(i >> 2) * 128 + (i & 3) * 16]; } }
    __device__ __forceinline__ void operator()(const f32x4 (&acc)[2][2][4][2], const Unit& u, int wr, int wc, int fr, int fq, const rs_t (&pre)[8]) const {
        asm volatile("" : "+v"(fr), "+v"(fq));
        const int row0 = u.pm * 256 + wr * 64 + fr, col0 = u.ocol + wc * 32 + 8 * fq;
        const rs_t* rsel = u.pn < split ? rs : rs2;
        rs_t* sums = (sq && u.pn < 4) ? (u.pn < 2 ? sq : skv) : (rs_t*)nullptr;
        float rsc[2][4];
#pragma unroll
        for (int ai = 0; ai < 2; ++ai)
#pragma unroll
            for (int m = 0; m < 4; ++m) rsc[ai][m] = rsel ? __builtin_amdgcn_rsqf(rs_val(pre[ai * 4 + m]) * inv_dim + EPS) : 1.f;
#pragma unroll
        for (int ai = 0; ai < 2; ++ai)
#pragma unroll
            for (int m = 0; m < 4; ++m) { const int row = row0 + ai * 128 + m * 16; bf16_t* rowp = P + (size_t)row * PW + col0;
                const float sc = rsc[ai][m]; float ss = 0.f;
#pragma unroll
                for (int bj = 0; bj < 2; ++bj) { const f32x4 v0 = acc[ai][bj][m][0] * sc, v1 = acc[ai][bj][m][1] * sc;
                    ss += ((v0[0] * v0[0] + v0[1] * v0[1]) + (v0[2] * v0[2] + v0[3] * v0[3])) + ((v1[0] * v1[0] + v1[1] * v1[1]) + (v1[2] * v1[2] + v1[3] * v1[3]));
                    u32x4 w; w.x = cvt_pk_bf16(v0[0], v0[1]); w.y = cvt_pk_bf16(v0[2], v0[3]); w.z = cvt_pk_bf16(v1[0], v1[1]); w.w = cvt_pk_bf16(v1[2], v1[3]);
                    st_wt(rowp + bj * 128, w); }
                if (sums) { ss += __shfl_xor(ss, 16); ss += __shfl_xor(ss, 32); if (fq == 0) (void)__hip_atomic_fetch_add(sums + row, rs_fix(ss), __ATOMIC_RELAXED, __HIP_MEMORY_SCOPE_AGENT); } }
    }
};
struct EpiG2 {
    static constexpr bool PERM = true;
    bf16_t* P; const rs_t* rs; const float* gperm; LAS float* xl;
    __device__ __forceinline__ void prefetch(const Unit& u, int wr, int fr, rs_t (&pre)[8]) const { const rs_t* r_ = rs; if (r_) { r_ += u.pm * 256 + wr * 64 + fr;
#pragma unroll
        for (int i = 0; i < 8; ++i) pre[i] = r_[(i >> 2) * 128 + (i & 3) * 16]; } }
    __device__ __forceinline__ void operator()(const f32x4 (&acc)[2][2][4][2], const Unit& u, int wr, int wc, int fr, int fq, const rs_t (&pre)[8]) const {
        asm volatile("" : "+v"(fr), "+v"(fq));
        const int row0 = u.pm * 256 + wr * 64 + fr, lcol = wc * 32 + 8 * fq, col0 = u.ocol + lcol;
        const int pn = u.pn;
        const bool plain = (pn >= 8 && pn < 12) || pn >= 24, isidx = (pn >= 12 && pn < 16), nrm = !plain && !isidx;
        const int gidx = pn < 4 ? 0 : (pn < 8 ? 1 : (pn < 20 ? 2 : 3));
        f32x4 g0 = (f32x4){1.f, 1.f, 1.f, 1.f}, g1 = g0;
        if (nrm) { g0 = *(const f32x4*)(gperm + gidx * 128 + lcol); g1 = *(const f32x4*)(gperm + gidx * 128 + lcol + 4); }
        float rsc[2][4];
#pragma unroll
        for (int ai = 0; ai < 2; ++ai)
#pragma unroll
            for (int m = 0; m < 4; ++m) rsc[ai][m] = __builtin_amdgcn_rsqf(rs_val(pre[ai * 4 + m]) * (1.f / DM) + EPS);
        if (nrm) {
#pragma unroll
            for (int ai = 0; ai < 2; ++ai)
#pragma unroll
                for (int m = 0; m < 4; ++m)
#pragma unroll
                    for (int bj = 0; bj < 2; ++bj) { const f32x4 a = acc[ai][bj][m][0], b = acc[ai][bj][m][1]; float ss = (a[0] * a[0] + a[1] * a[1]) + (a[2] * a[2] + a[3] * a[3]) + (b[0] * b[0] + b[1] * b[1]) + (b[2] * b[2] + b[3] * b[3]);
                        ss += __shfl_xor(ss, 16); ss += __shfl_xor(ss, 32);
                        if (fq == 0) xl[((wr * 64 + fr + ai * 128 + m * 16) * 2 + bj) * 4 + wc] = ss * rsc[ai][m] * rsc[ai][m]; }
            asm volatile("s_waitcnt lgkmcnt(0)" ::: "memory"); __builtin_amdgcn_s_barrier(); asm volatile("" ::: "memory");
        }
        const int i0 = isidx ? (16 * (wc & 1) + 4 * fq) : (16 * wc + 4 * fq);
        const float tod = isidx ? (2.f / 64.f) : (2.f / 128.f);
        float inv[4];
#pragma unroll
        for (int j = 0; j < 4; ++j) inv[j] = __builtin_amdgcn_exp2f(-(float)(i0 + j) * tod * 13.287712379549449f) * 0.15915494309189535f;
        const float qscale = (pn < 4 || (pn >= 16 && pn < 20)) ? C2_128 : 1.f;
#pragma unroll
        for (int ai = 0; ai < 2; ++ai)
#pragma unroll
            for (int m = 0; m < 4; ++m) { const int row = row0 + ai * 128 + m * 16; bf16_t* rowp = P + (size_t)row * PW + col0;
                float cs[4], sn[4];
                if (!plain) { const float pos = (float)(NMETA + ((row - MBLK) & (SEQ - 1)));
#pragma unroll
                    for (int j = 0; j < 4; ++j) { float rev = pos * inv[j]; rev -= floorf(rev); sn[j] = __builtin_amdgcn_sinf(rev); cs[j] = __builtin_amdgcn_cosf(rev); } }
#pragma unroll
                for (int bj = 0; bj < 2; ++bj) { f32x4 v0 = acc[ai][bj][m][0] * rsc[ai][m], v1 = acc[ai][bj][m][1] * rsc[ai][m];
                    if (!plain) {
                        if (nrm) { const LAS f32x4* xp = (const LAS f32x4*)(xl + ((wr * 64 + fr + ai * 128 + m * 16) * 2 + bj) * 4); const f32x4 pp = *xp;
                            const float rn = __builtin_amdgcn_rsqf(((pp[0] + pp[1]) + (pp[2] + pp[3])) * (1.f / 128.f) + EPS); v0 = v0 * (g0 * rn); v1 = v1 * (g1 * rn); }
                        f32x4 w0, w1;
                        w0[0] = v0[0] * cs[0] - v0[1] * sn[0]; w0[1] = v0[1] * cs[0] + v0[0] * sn[0]; w0[2] = v0[2] * cs[1] - v0[3] * sn[1]; w0[3] = v0[3] * cs[1] + v0[2] * sn[1];
                        w1[0] = v1[0] * cs[2] - v1[1] * sn[2]; w1[1] = v1[1] * cs[2] + v1[0] * sn[2]; w1[2] = v1[2] * cs[3] - v1[3] * sn[3]; w1[3] = v1[3] * cs[3] + v1[2] * sn[3];
                        v0 = w0 * qscale; v1 = w1 * qscale; }
                    u32x4 w; w.x = cvt_pk_bf16(v0[0], v0[1]); w.y = cvt_pk_bf16(v0[2], v0[3]); w.z = cvt_pk_bf16(v1[0], v1[1]); w.w = cvt_pk_bf16(v1[2], v1[3]);
                    st_wt(rowp + bj * 128, w); } }
    }
};
struct EpiGate {
    static constexpr bool PERM = true;
    bf16_t* G; const float* bias; const rs_t* rs;
    __device__ __forceinline__ void prefetch(const Unit& u, int wr, int fr, rs_t (&pre)[8]) const { const rs_t* r_ = rs; if (r_) { r_ += u.pm * 256 + wr * 64 + fr;
#pragma unroll
        for (int i = 0; i < 4; ++i) pre[i] = r_[i * 16]; } }
    __device__ __forceinline__ void operator()(const f32x4 (&acc)[2][2][4][2], const Unit& u, int wr, int wc, int fr, int fq, const rs_t (&pre)[8]) const {
        asm volatile("" : "+v"(fr), "+v"(fq));
        const int row0 = u.pm * 256 + wr * 64 + fr, col0 = u.pn * 256 + wc * 32 + 8 * fq;
        rs_t q1[4];
#pragma unroll
        for (int m = 0; m < 4; ++m) q1[m] = rs[row0 + 128 + m * 16];
        f32x4 bq[2][2];
#pragma unroll
        for (int bj = 0; bj < 2; ++bj) { bq[bj][0] = *(const f32x4*)(bias + col0 + bj * 128); bq[bj][1] = *(const f32x4*)(bias + col0 + bj * 128 + 4); }
#pragma unroll
        for (int ai = 0; ai < 2; ++ai) {
#pragma unroll
            for (int bj = 0; bj < 2; ++bj) { const f32x4 bv0 = bq[bj][0], bv1 = bq[bj][1];
#pragma unroll
                for (int m = 0; m < 4; ++m) { bf16_t* rowp = G + (size_t)(row0 + ai * 128 + m * 16) * 2048 + col0; const float sc = __builtin_amdgcn_rsqf(rs_val(ai == 0 ? pre[m] : q1[m]) * (1.f / DM) + EPS); f32x4 v0 = acc[ai][bj][m][0] * sc + bv0, v1 = acc[ai][bj][m][1] * sc + bv1;
#pragma unroll
                    for (int e = 0; e < 4; ++e) { v0[e] = __builtin_amdgcn_rcpf(1.f + __builtin_amdgcn_exp2f(-v0[e] * LOG2E)); v1[e] = __builtin_amdgcn_rcpf(1.f + __builtin_amdgcn_exp2f(-v1[e] * LOG2E)); }
                    u32x4 w; w.x = cvt_pk_bf16(v0[0], v0[1]); w.y = cvt_pk_bf16(v0[2], v0[3]); w.z = cvt_pk_bf16(v1[0], v1[1]); w.w = cvt_pk_bf16(v1[2], v1[3]);
                    st_wt(rowp + bj * 128, w); } } }
    }
};
struct EpiGated {
    static constexpr bool PERM = true;
    bf16_t* P; const bf16_t* G; int first; float sc;
    __device__ __forceinline__ void prefetch(const Unit&, int, int, rs_t (&)[8]) const {}
    __device__ __forceinline__ void operator()(const f32x4 (&acc)[2][2][4][2], const Unit& u, int wr, int wc, int fr, int fq, const rs_t (&pre)[8]) const {
        asm volatile("" : "+v"(fr), "+v"(fq));
        const int row0 = u.pm * 256 + wr * 64 + fr, lcol0 = u.pn * 256 + wc * 32 + 8 * fq, col0 = u.ocol + wc * 32 + 8 * fq;
        unsigned zu = 0u; asm volatile("" : "+v"(zu));
#pragma unroll
        for (int ai = 0; ai < 2; ++ai) {
            u32x4 gq[4][2], pq[4][2];
#pragma unroll
            for (int m = 0; m < 4; ++m)
#pragma unroll
                for (int bj = 0; bj < 2; ++bj) { gq[m][bj] = *(const u32x4*)(G + (size_t)(row0 + ai * 128 + m * 16) * 2048 + lcol0 + bj * 128); if (DBG_BR == 1) gq[m][bj] = (u32x4){0x3f803f80u, 0x3f803f80u, 0x3f803f80u, 0x3f803f80u};
                    pq[m][bj] = (u32x4){zu, zu, zu, zu}; if (!first) pq[m][bj] = *(const u32x4*)(P + (size_t)(row0 + ai * 128 + m * 16) * PW + col0 + bj * 128); }
#pragma unroll
            for (int m = 0; m < 4; ++m) { bf16_t* rowp = P + (size_t)(row0 + ai * 128 + m * 16) * PW + col0;
#pragma unroll
                for (int bj = 0; bj < 2; ++bj) { const u32x4 g = gq[m][bj], pv = pq[m][bj];
                    const f32x4 v0 = acc[ai][bj][m][0] * sc, v1 = acc[ai][bj][m][1] * sc;
                    float o[8];
                    o[0] = __uint_as_float(pv.x << 16) + __uint_as_float(g.x << 16) * v0[0]; o[1] = __uint_as_float(pv.x & 0xffff0000u) + __uint_as_float(g.x & 0xffff0000u) * v0[1];
                    o[2] = __uint_as_float(pv.y << 16) + __uint_as_float(g.y << 16) * v0[2]; o[3] = __uint_as_float(pv.y & 0xffff0000u) + __uint_as_float(g.y & 0xffff0000u) * v0[3];
                    o[4] = __uint_as_float(pv.z << 16) + __uint_as_float(g.z << 16) * v1[0]; o[5] = __uint_as_float(pv.z & 0xffff0000u) + __uint_as_float(g.z & 0xffff0000u) * v1[1];
                    o[6] = __uint_as_float(pv.w << 16) + __uint_as_float(g.w << 16) * v1[2]; o[7] = __uint_as_float(pv.w & 0xffff0000u) + __uint_as_float(g.w & 0xffff0000u) * v1[3];
                    u32x4 w; w.x = cvt_pk_bf16(o[0], o[1]); w.y = cvt_pk_bf16(o[2], o[3]); w.z = cvt_pk_bf16(o[4], o[5]); w.w = cvt_pk_bf16(o[6], o[7]);
                    st_wt(rowp + bj * 128, w); } }
            asm volatile("" ::: "memory"); }
    }
};
struct EpiRes {
    static constexpr bool PERM = true;
    float* out_f; float dbg; bf16_t* hb; rs_t* rs;
    __device__ __forceinline__ void prefetch(const Unit&, int, int, rs_t (&)[8]) const {}
    __device__ __forceinline__ void operator()(const f32x4 (&acc)[2][2][4][2], const Unit& u, int wr, int wc, int fr, int fq, const rs_t (&pre)[8]) const {
        asm volatile("" : "+v"(fr), "+v"(fq));
        const int lrow0 = wr * 64 + fr, col0 = u.pn * 256 + wc * 32 + 8 * fq;
        bf16_t* hp0 = hb + (size_t)(u.pm * 256 + lrow0) * DM + col0;
        u32x4 bw[2][4][2];
#pragma unroll
        for (int ai = 0; ai < 2; ++ai)
#pragma unroll
            for (int m = 0; m < 4; ++m)
#pragma unroll
                for (int bj = 0; bj < 2; ++bj) bw[ai][m][bj] = *(const u32x4*)(hp0 + (size_t)(ai * 128 + m * 16) * DM + bj * 128);
#pragma unroll
        for (int ai = 0; ai < 2; ++ai)
#pragma unroll
            for (int m = 0; m < 4; ++m) { const int lrow = lrow0 + ai * 128 + m * 16, grow = u.pm * 256 + lrow;
                const size_t foff = ((size_t)(u.pm - 1) * 256 + lrow) * DM + col0; bf16_t* hp = hp0 + (size_t)(ai * 128 + m * 16) * DM; float ss = 0.f;
#pragma unroll
                for (int bj = 0; bj < 2; ++bj) { const u32x4 w = bw[ai][m][bj];
                    const f32x4 b0 = (f32x4){__uint_as_float(w.x << 16), __uint_as_float(w.x & 0xffff0000u), __uint_as_float(w.y << 16), __uint_as_float(w.y & 0xffff0000u)};
                    const f32x4 b1 = (f32x4){__uint_as_float(w.z << 16), __uint_as_float(w.z & 0xffff0000u), __uint_as_float(w.w << 16), __uint_as_float(w.w & 0xffff0000u)};
                    const f32x4 h0 = b0 + acc[ai][bj][m][0] * dbg, h1 = b1 + acc[ai][bj][m][1] * dbg;
                    if (out_f) { st_wt(out_f + foff + bj * 128, h0); st_wt(out_f + foff + bj * 128 + 4, h1); }
                    else { ss += ((h0[0] * h0[0] + h0[1] * h0[1]) + (h0[2] * h0[2] + h0[3] * h0[3])) + ((h1[0] * h1[0] + h1[1] * h1[1]) + (h1[2] * h1[2] + h1[3] * h1[3]));
                        u32x4 o; o.x = cvt_pk_bf16(h0[0], h0[1]); o.y = cvt_pk_bf16(h0[2], h0[3]); o.z = cvt_pk_bf16(h1[0], h1[1]); o.w = cvt_pk_bf16(h1[2], h1[3]); st_wt(hp + bj * 128, o); } }
                if (!out_f) { ss += __shfl_xor(ss, 16); ss += __shfl_xor(ss, 32); if (fq == 0) (void)__hip_atomic_fetch_add(rs + grow, rs_fix(ss), __ATOMIC_RELAXED, __HIP_MEMORY_SCOPE_AGENT); } }
    }
};
struct EpiSwiglu {
    static constexpr bool PERM = true;
    bf16_t* P; const rs_t* rs;
    __device__ __forceinline__ void prefetch(const Unit& u, int wr, int fr, rs_t (&pre)[8]) const { const rs_t* r_ = rs; if (r_) { r_ += u.pm * 256 + wr * 64 + fr;
#pragma unroll
        for (int i = 0; i < 8; ++i) pre[i] = r_[(i >> 2) * 128 + (i & 3) * 16]; } }
    __device__ __forceinline__ void operator()(const f32x4 (&acc)[2][2][4][2], const Unit& u, int wr, int wc, int fr, int fq, const rs_t (&pre)[8]) const {
        asm volatile("" : "+v"(fr), "+v"(fq));
        const int row0 = u.pm * 256 + wr * 64 + fr, col0 = u.pn * 128 + wc * 32 + 8 * fq;
#pragma unroll
        for (int ai = 0; ai < 2; ++ai)
#pragma unroll
            for (int m = 0; m < 4; ++m) { bf16_t* rowp = P + (size_t)(row0 + ai * 128 + m * 16) * PW + col0;
                const float sc = __builtin_amdgcn_rsqf(rs_val(pre[ai * 4 + m]) * (1.f / DM) + EPS);
                float o[8];
#pragma unroll
                for (int n = 0; n < 2; ++n)
#pragma unroll
                    for (int e = 0; e < 4; ++e) { const float g = acc[ai][0][m][n][e] * sc, up = acc[ai][1][m][n][e] * sc; o[n * 4 + e] = g * __builtin_amdgcn_rcpf(1.f + __builtin_amdgcn_exp2f(-g * LOG2E)) * up; }
                u32x4 w; w.x = cvt_pk_bf16(o[0], o[1]); w.y = cvt_pk_bf16(o[2], o[3]); w.z = cvt_pk_bf16(o[4], o[5]); w.w = cvt_pk_bf16(o[6], o[7]);
                st_wt(rowp, w); }
    }
};

struct SkP { bf16_t* P; int ocol; const rs_t* rs; float inv_dim; rs_t* sq; rs_t* skv; struct Pre { rs_t q[4]; };
    __device__ __forceinline__ void load(int r0, int, Pre& p) const { if (rs) {
#pragma unroll
        for (int r = 0; r < 4; ++r) p.q[r] = rs[MROW0 + r0 + r]; } }
    __device__ __forceinline__ void apply(int r0, int c, f32x4 v, const Pre& p) const {
        rs_t* sums = (sq && c < 1024) ? (c < 512 ? sq : skv) : (rs_t*)nullptr;
#pragma unroll
        for (int r = 0; r < 4; ++r) { float x = v[r]; if (rs) x *= __builtin_amdgcn_rsqf(rs_val(p.q[r]) * inv_dim + EPS); P[(size_t)(MROW0 + r0 + r) * PW + ocol + c] = (bf16_t)f2bf(x);
            if (sums) { float ss = x * x; ss += __shfl_xor(ss, 1); ss += __shfl_xor(ss, 2); ss += __shfl_xor(ss, 4); ss += __shfl_xor(ss, 8);
                if ((threadIdx.x & 15) == 0) (void)__hip_atomic_fetch_add(sums + MROW0 + r0 + r, rs_fix(ss), __ATOMIC_RELAXED, __HIP_MEMORY_SCOPE_AGENT); } } } };
struct SkGate { bf16_t* G; const float* bias; const rs_t* rs; struct Pre { rs_t q[4]; float b; };
    __device__ __forceinline__ void load(int r0, int c, Pre& p) const { p.b = bias[c];
#pragma unroll
        for (int r = 0; r < 4; ++r) p.q[r] = rs[MROW0 + r0 + r]; }
    __device__ __forceinline__ void apply(int r0, int c, f32x4 v, const Pre& p) const {
#pragma unroll
        for (int r = 0; r < 4; ++r) { const float x = v[r] * __builtin_amdgcn_rsqf(rs_val(p.q[r]) * (1.f / DM) + EPS); G[(size_t)(MROW0 + r0 + r) * 2048 + c] = (bf16_t)f2bf(__builtin_amdgcn_rcpf(1.f + __builtin_amdgcn_exp2f(-(x + p.b) * LOG2E))); } } };
struct SkGated { bf16_t* P; const bf16_t* G; int first; struct Pre { bf16_t pv[4], g[4]; };
    __device__ __forceinline__ void load(int r0, int c, Pre& p) const {
#pragma unroll
        for (int r = 0; r < 4; ++r) { p.g[r] = G[(size_t)(MROW0 + r0 + r) * 2048 + c]; p.pv[r] = first ? (bf16_t)0 : P[(size_t)(MROW0 + r0 + r) * PW + C_MERGED + c]; } }
    __device__ __forceinline__ void apply(int r0, int c, f32x4 v, const Pre& p) const {
#pragma unroll
        for (int r = 0; r < 4; ++r) P[(size_t)(MROW0 + r0 + r) * PW + C_MERGED + c] = (bf16_t)f2bf(bf2f(p.pv[r]) + bf2f(p.g[r]) * v[r]); } };
struct SkRes { float* hmeta; bf16_t* hb; rs_t* rs; struct Pre { float hm[4]; };
    __device__ __forceinline__ void load(int r0, int c, Pre& p) const {
#pragma unroll
        for (int r = 0; r < 4; ++r) p.hm[r] = hmeta[(size_t)(MROW0 + r0 + r) * DM + c]; }
    __device__ __forceinline__ void apply(int r0, int c, f32x4 v, const Pre& p) const {
#pragma unroll
        for (int r = 0; r < 4; ++r) { const float hv = p.hm[r] + v[r]; hmeta[(size_t)(MROW0 + r0 + r) * DM + c] = hv;
            if (hb) { hb[(size_t)(MROW0 + r0 + r) * DM + c] = (bf16_t)f2bf(hv); float ss = hv * hv; ss += __shfl_xor(ss, 1); ss += __shfl_xor(ss, 2); ss += __shfl_xor(ss, 4); ss += __shfl_xor(ss, 8);
                if ((threadIdx.x & 15) == 0) (void)__hip_atomic_fetch_add(rs + MROW0 + r0 + r, rs_fix(ss), __ATOMIC_RELAXED, __HIP_MEMORY_SCOPE_AGENT); } } } };
template <class Fn>
__device__ __forceinline__ void skinny_gemm(LAS unsigned char* lds, const bf16_t* A, int lda, const bf16_t* Bt, int K, int ntask, int bid, int G, const Fn& f) {
    int tid = threadIdx.x; asm volatile("" : "+v"(tid));
    const int wid = __builtin_amdgcn_readfirstlane(tid >> 6), lane = tid & 63, l15 = lane & 15, kq = lane >> 4;
    LAS f32x4* red = (LAS f32x4*)lds;
    const int kw = K / 8;
    for (int task = bid; task < ntask; task += G) {
        const bf16_t* ap = A + (size_t)l15 * lda + wid * kw + kq * 8;
        const bf16_t* bp = Bt + (size_t)(task * 16 + l15) * K + wid * kw + kq * 8;
        float z = 0.f; asm volatile("" : "+v"(z));
        f32x4 acc = (f32x4){z, z, z, z};
        typename Fn::Pre pre{}; if (wid == 0) f.load(kq * 4, task * 16 + l15, pre);
        for (int k0 = 0; k0 < kw; k0 += 256) {
            bf16x8 fa[8], fb[8];
#pragma unroll
            for (int i = 0; i < 8; ++i) { const int k = (k0 + 32 * i < kw) ? k0 + 32 * i : 0; fa[i] = *(const bf16x8*)(ap + k); fb[i] = *(const bf16x8*)(bp + k); }
#pragma unroll
            for (int i = 0; i < 8; ++i) if (k0 + 32 * i < kw) acc = __builtin_amdgcn_mfma_f32_16x16x32_bf16(fa[i], fb[i], acc, 0, 0, 0);
        }
        red[wid * 64 + lane] = acc;
        LDS_WAIT(); __syncthreads();
        if (wid == 0) {
            f32x4 s = red[lane];
#pragma unroll
            for (int w = 1; w < 8; ++w) s += red[w * 64 + lane];
            f.apply(kq * 4, task * 16 + l15, s, pre);
        }
        __syncthreads();
    }
}
__device__ __forceinline__ void skinny_swiglu(LAS unsigned char* lds, const bf16_t* A, int lda, const bf16_t* Bt, int K, bf16_t* P, const rs_t* rs, int bid, int G) {
    int tid = threadIdx.x; asm volatile("" : "+v"(tid));
    const int wid = __builtin_amdgcn_readfirstlane(tid >> 6), lane = tid & 63, l15 = lane & 15, kq = lane >> 4;
    LAS f32x4* red = (LAS f32x4*)lds;
    const int kw = K / 8;
    for (int task = bid; task < DFF / 16; task += G) {
        const int c0 = task * 16, brow = (c0 >> 7) * 256 + (c0 & 127) + l15;
        const bf16_t* ap = A + (size_t)l15 * lda + wid * kw + kq * 8;
        const bf16_t* bg = Bt + (size_t)brow * K + wid * kw + kq * 8; const bf16_t* bu = bg + (size_t)128 * K;
        float z = 0.f; asm volatile("" : "+v"(z));
        f32x4 ag = (f32x4){z, z, z, z}, au = ag;
        rs_t rq[4] = {0, 0, 0, 0}; if (wid == 0) {
#pragma unroll
            for (int r = 0; r < 4; ++r) rq[r] = rs[MROW0 + kq * 4 + r]; }
        {
            bf16x8 fa[8], fg[8], fu[8];
#pragma unroll
            for (int i = 0; i < 8; ++i) { fa[i] = *(const bf16x8*)(ap + 32 * i); fg[i] = *(const bf16x8*)(bg + 32 * i); fu[i] = *(const bf16x8*)(bu + 32 * i); }
#pragma unroll
            for (int i = 0; i < 8; ++i) { ag = __builtin_amdgcn_mfma_f32_16x16x32_bf16(fa[i], fg[i], ag, 0, 0, 0); au = __builtin_amdgcn_mfma_f32_16x16x32_bf16(fa[i], fu[i], au, 0, 0, 0); }
        }
        red[wid * 64 + lane] = ag; red[512 + wid * 64 + lane] = au;
        LDS_WAIT(); __syncthreads();
        if (wid == 0) {
            f32x4 sg = red[lane], su = red[512 + lane];
#pragma unroll
            for (int w = 1; w < 8; ++w) { sg += red[w * 64 + lane]; su += red[512 + w * 64 + lane]; }
#pragma unroll
            for (int r = 0; r < 4; ++r) { const float sc = __builtin_amdgcn_rsqf(rs_val(rq[r]) * (1.f / DM) + EPS); const float g = sg[r] * sc; su[r] *= sc; P[(size_t)(MROW0 + kq * 4 + r) * PW + c0 + l15] = (bf16_t)f2bf(g * __builtin_amdgcn_rcpf(1.f + __builtin_amdgcn_exp2f(-g * LOG2E)) * su[r]); }
        }
        __syncthreads();
    }
}

#define XB_TMO      128
#define XB_XCNT(j)  (256  + 64 * (j))
#define XB_XSUB(j)  (1280 + 64 * (j))
#define XB_XGEN(j)  (2304 + 64 * (j))
#define XB_TOP      3328
#define XB_TOPGEN   3392
#define XCD_BAR_WORDS 3456
#define XB_SPIN_CAP (1u << 18)
__device__ __forceinline__ unsigned xb_ld(unsigned* p)              { return __hip_atomic_load(p, __ATOMIC_RELAXED, __HIP_MEMORY_SCOPE_AGENT); }
__device__ __forceinline__ unsigned xb_add(unsigned* p, unsigned v) { return __hip_atomic_fetch_add(p, v, __ATOMIC_RELAXED, __HIP_MEMORY_SCOPE_AGENT); }
__device__ __forceinline__ unsigned xb_xcc_id() { return (unsigned)__builtin_amdgcn_s_getreg((3 << 11) | 20) & 0xFu; }
#define XB_SPIN(cond, bar) do { unsigned _sp = 0; while (cond) { __builtin_amdgcn_s_sleep(1); \
    if ((++_sp & 255u) == 0u) { if (xb_ld(&(bar)[XB_TMO])) break; if (_sp > XB_SPIN_CAP) { atomicAdd(&(bar)[XB_TMO], 1u); break; } } } } while (0)
struct XcdBarrier { unsigned* bar; unsigned x; volatile LAS unsigned* st; };
__device__ __forceinline__ XcdBarrier xcd_barrier_post(unsigned* bar, volatile LAS unsigned* st) {
    XcdBarrier b; b.bar = bar; b.x = xb_xcc_id(); b.st = st;
    if (threadIdx.x == 0) (void)xb_add(&bar[XB_XCNT(b.x)], 1u);
    return b;
}
__device__ __forceinline__ void xcd_barrier_complete(unsigned* bar, unsigned x, unsigned& nloc, unsigned& nx) {
    const unsigned G = gridDim.x * gridDim.y * gridDim.z;
    unsigned sum, cnt, mine, sp = 0u;
    for (;;) {
        sum = 0u; cnt = 0u; mine = 0u;
#pragma unroll
        for (unsigned j = 0; j < 16; ++j) { const unsigned c = xb_ld(&bar[XB_XCNT(j)]); sum += c; cnt += (c > 0u) ? 1u : 0u; mine = (j == x) ? c : mine; }
        if (sum == G) break;
        __builtin_amdgcn_s_sleep(1);
        if ((++sp & 255u) == 0u) { if (xb_ld(&bar[XB_TMO])) break; if (sp > XB_SPIN_CAP) { atomicAdd(&bar[XB_TMO], 1u); break; } }
    }
    nloc = mine > 0u ? mine : 1u; nx = cnt > 0u ? cnt : 1u;
}
__device__ __forceinline__ void xcd_barrier(const XcdBarrier& b) {
    asm volatile("s_waitcnt vmcnt(0)" ::: "memory");
    __syncthreads();
    if (threadIdx.x == 0) {
        unsigned* bar = b.bar;
        __builtin_amdgcn_s_waitcnt(0);
        unsigned nloc = b.st[0], nx = b.st[1];
        if (nloc == 0u) { xcd_barrier_complete(bar, b.x, nloc, nx); b.st[0] = nloc; b.st[1] = nx; }
        const unsigned old = xb_add(&bar[XB_XSUB(b.x)], 1u);
        const unsigned gen = old / nloc;
        if (old + 1u == (gen + 1u) * nloc) {
            __builtin_amdgcn_fence(__ATOMIC_RELEASE, "agent");
            asm volatile("s_waitcnt vmcnt(0)" ::: "memory");
            const unsigned og = xb_add(&bar[XB_TOP], 1u);
            const unsigned tg = og / nx;
            if (og + 1u == (tg + 1u) * nx) xb_add(&bar[XB_TOPGEN], 1u);
            else XB_SPIN(xb_ld(&bar[XB_TOPGEN]) == tg, bar);
            __builtin_amdgcn_fence(__ATOMIC_ACQUIRE, "agent");
            xb_add(&bar[XB_XGEN(b.x)], 1u);
            asm volatile("s_waitcnt vmcnt(0)" ::: "memory");
        } else {
            XB_SPIN(xb_ld(&bar[XB_XGEN(b.x)]) == gen, bar);
            __builtin_amdgcn_fence(__ATOMIC_ACQUIRE, "agent");
            asm volatile("s_waitcnt vmcnt(0)" ::: "memory");
        }
    }
    __syncthreads();
}

constexpr int NWAVES = 8;
constexpr int RING_BYTES = 131072, LDS_BYTES = 147456, LDSCTL_OFF = LDS_BYTES - 512;
struct Args {
    const float* in[19]; float* out; unsigned char* ws; int ph_lo, ph_hi;
};
struct Ctx {
    LAS unsigned char* lds; int tid, lane, wave, gw, ngw, G, bid;
};

template <int MAP> __device__ __forceinline__ int wmap(int n, float& sc) {
    sc = 1.f;
    if (MAP == 0) return n;
    if (MAP == 1) {
        if (n < 1088) return n;
        if (n < 3136) { const int m = n - 1088, d = m & 127; return 1280 + (m - d) + (d < 64 ? 2 * d : 2 * (d - 64) + 1); }
        if (n < 4160) return 1280 + (n - 1088);
        if (n < 5184) { const int m = n - 4160, d = m & 63; return 4352 + (m - d) + (d < 32 ? 2 * d : 2 * (d - 32) + 1); }
        if (n < 5248) { const int d = n - 5184; return 1088 + (d < 32 ? 2 * d : 2 * (d - 32) + 1); }
        if (n < 5264) { sc = 0.03125f; return 1152 + (n - 5248); }
        if (n < 7312) { const int m = n - 5264, d = m & 127; return 5376 + (m - d) + (d < 64 ? 2 * d : 2 * (d - 64) + 1); }
        if (n < 8336) return 5376 + (n - 5264);
        return 8448 + (n - 8336);
    }
    if (n < DFF) return (n >> 7) * 256 + (n & 127);
    const int m = n - DFF; return (m >> 7) * 256 + 128 + (m & 127);
}
template <int MAP> __device__ __forceinline__ void conv_matrix(const Ctx& F, const float* W, int K, int N, bf16_t* WT, const float* gain) {
    LAS float* scr = (LAS float*)(F.lds + F.wave * 18432);
    const int lane = F.lane;
    const int nblk = (N + 63) / 64, nit = (K / 64) * nblk;
    const int l31 = lane & 31, lh = lane >> 5, c = lane & 7, nsub = lane >> 3;
    f32x2 wv[32]; f32x4 g0 = (f32x4){1.f, 1.f, 1.f, 1.f}, g1 = g0;
#define CONV_LOAD(item) do { const int kb_ = (item) / nblk, nb_ = (item) - kb_ * nblk, k0_ = 64 * kb_, nn_ = 64 * nb_ + 2 * l31; \
        const float* src_ = W + (size_t)(k0_ + lh) * N + nn_; const bool ok_ = nn_ < N; \
        _Pragma("unroll") for (int i = 0; i < 32; ++i) wv[i] = ok_ ? *(const f32x2*)(src_ + (size_t)(2 * i) * N) : (f32x2){0.f, 0.f}; \
        if (gain) { g0 = *(const f32x4*)(gain + k0_ + 8 * c); g1 = *(const f32x4*)(gain + k0_ + 8 * c + 4); } } while (0)
    int it = F.gw;
    if (it < nit) CONV_LOAD(it);
    while (it < nit) {
        const int kb = it / nblk, nb = it - kb * nblk, k0 = 64 * kb, n0 = 64 * nb;
#pragma unroll
        for (int i = 0; i < 32; ++i) { LAS float* d = scr + (2 * i + lh) * 65 + l31; d[0] = wv[i].x; d[32] = wv[i].y; }
        const f32x4 gc0 = g0, gc1 = g1;
        const int nx = it + F.ngw;
        if (nx < nit) CONV_LOAD(nx);
        LDS_WAIT(); asm volatile("" ::: "memory");
#pragma unroll
        for (int j = 0; j < 8; ++j) { const int n = nsub + 8 * j, ns = n0 + n;
            if (ns < N) { float sc; const int dst = wmap<MAP>(ns, sc); const LAS float* s = scr + (8 * c) * 65 + (n & 1) * 32 + (n >> 1);
                u32x4 o; o.x = pk2(s[0 * 65] * (sc * gc0.x), s[1 * 65] * (sc * gc0.y)); o.y = pk2(s[2 * 65] * (sc * gc0.z), s[3 * 65] * (sc * gc0.w));
                o.z = pk2(s[4 * 65] * (sc * gc1.x), s[5 * 65] * (sc * gc1.y)); o.w = pk2(s[6 * 65] * (sc * gc1.z), s[7 * 65] * (sc * gc1.w));
                *(u32x4*)(WT + (size_t)dst * K + k0 + 8 * c) = o; } }
        LDS_WAIT(); asm volatile("" ::: "memory");
        it = nx;
    }
#undef CONV_LOAD
}

__device__ __forceinline__ void norm_load(const float* hrow, int lane, f32x4 (&v)[8]) {
#pragma unroll
    for (int j = 0; j < 8; ++j) v[j] = *((const f32x4*)hrow + lane + 64 * j);
}
__device__ __forceinline__ void norm_fin(const f32x4 (&v)[8], bf16_t* orow, rs_t* rs_row, int lane) {
    float s = 0.f;
#pragma unroll
    for (int j = 0; j < 8; ++j) s += (v[j].x * v[j].x + v[j].y * v[j].y) + (v[j].z * v[j].z + v[j].w * v[j].w);
    s = wave_sum(s);
    if (lane == 0) *rs_row = rs_fix(s);
#pragma unroll
    for (int j = 0; j < 8; ++j) { u32x2 o; o.x = cvt_pk_bf16(v[j].x, v[j].y); o.y = cvt_pk_bf16(v[j].z, v[j].w); *((u32x2*)orow + lane + 64 * j) = o; }
}

__device__ __forceinline__ void meta_post_row(bf16_t* P, int r, const float* gperm, int lane) {
    bf16_t* p = P + (size_t)r * PW; const int pos = row_pos(r);
    float c128, s128, c64, s64; rope_cs(pos, lane, 2.f / 128.f, c128, s128); rope_cs(pos, lane & 31, 2.f / 64.f, c64, s64);
#pragma unroll 1
    for (int t = 0; t < 4; ++t) {
        const int cb = t == 0 ? C_DQ : (t == 1 ? C_DK : (t == 2 ? C_FQ : C_FK)); const float sc = (t == 0 || t == 2) ? C2_128 : 1.f;
        const float ga = gperm[t * 128 + 2 * lane], gb = gperm[t * 128 + 2 * lane + 1];
#pragma unroll 1
        for (int h = 0; h < 8; ++h) { unsigned* xp = (unsigned*)(p + cb + h * 128) + lane; const unsigned w = *xp; float x1 = __uint_as_float(w << 16), x2 = __uint_as_float(w & 0xffff0000u);
            const float rn = __builtin_amdgcn_rsqf(wave_sum(x1 * x1 + x2 * x2) * (1.f / 128.f) + EPS); x1 *= rn * ga; x2 *= rn * gb;
            *xp = cvt_pk_bf16((x1 * c128 - x2 * s128) * sc, (x2 * c128 + x1 * s128) * sc); }
    }
#pragma unroll 1
    for (int hh = 0; hh < 8; ++hh) { unsigned* xp = (unsigned*)(p + C_IQ + hh * 128) + lane; const unsigned w = *xp; const float x1 = __uint_as_float(w << 16), x2 = __uint_as_float(w & 0xffff0000u);
        *xp = cvt_pk_bf16(x1 * c64 - x2 * s64, x2 * c64 + x1 * s64); }
}
__device__ __forceinline__ void unpack8(const u32x4& w, float (&x)[8]) {
#pragma unroll
    for (int e = 0; e < 4; ++e) { x[2 * e] = __uint_as_float(w[e] << 16); x[2 * e + 1] = __uint_as_float(w[e] & 0xffff0000u); }
}
__device__ __forceinline__ u32x4 pack8(const float (&x)[8]) { u32x4 w; w.x = cvt_pk_bf16(x[0], x[1]); w.y = cvt_pk_bf16(x[2], x[3]); w.z = cvt_pk_bf16(x[4], x[5]); w.w = cvt_pk_bf16(x[6], x[7]); return w; }
__device__ __forceinline__ u32x4 shfl_xor4(const u32x4& w, int m) { u32x4 r; r.x = __shfl_xor(w.x, m); r.y = __shfl_xor(w.y, m); r.z = __shfl_xor(w.z, m); r.w = __shfl_xor(w.w, m); return r; }
__device__ __forceinline__ void post2_load(const bf16_t* P, int r, int lane, u32x4 (&v)[9], unsigned& ikw_) {
    const bf16_t* p = P + (size_t)r * PW; const int hw = lane >> 5, l5 = lane & 31;
    v[0] = *(const u32x4*)(p + C_KPE + (lane & 7) * 8); ikw_ = *((const unsigned*)(p + C_IK) + (lane & 31));
#pragma unroll
    for (int it = 0; it < 4; ++it) { const int h = 2 * it + hw; v[1 + it] = *(const u32x4*)(p + C_QRAW + h * 192 + (l5 < 24 ? l5 : 0) * 8); v[5 + it] = *(const u32x4*)(p + C_KVRAW + h * 256 + (l5 & 15) * 8); }
}
__device__ __forceinline__ void post2_row(bf16_t* P, int r, const u32x4 (&v)[9], unsigned ikw, const float* qkg  , LAS float* rnl, int lane) {
    bf16_t* p = P + (size_t)r * PW;
    const int pos = row_pos(r), hw = lane >> 5, l5 = lane & 31;
    float c64[8], s64[8];
#pragma unroll
    for (int j = 0; j < 8; ++j) rope_cs(pos, 8 * (lane & 3) + j, 2.f / 64.f, c64[j], s64[j]);
    float kp[8]; unpack8(v[0], kp);
    unsigned* ikp = (unsigned*)(p + C_IK) + (lane & 31);
    float kpe_ss = 0.f;
#pragma unroll
    for (int j = 0; j < 8; ++j) kpe_ss += kp[j] * kp[j];
    kpe_ss += __shfl_xor(kpe_ss, 1); kpe_ss += __shfl_xor(kpe_ss, 2); kpe_ss += __shfl_xor(kpe_ss, 4);
#pragma unroll
    for (int it = 0; it < 4; ++it) {
        const int h = 2 * it + hw; const bool act = l5 < 24;
        u32x4* ptr = (u32x4*)(p + C_QRAW + h * 192 + (act ? l5 : 0) * 8);
        float x[8]; unpack8(v[1 + it], x);
        float ss = 0.f;
#pragma unroll
        for (int j = 0; j < 8; ++j) ss += x[j] * x[j];
        if (!act) ss = 0.f;
#pragma unroll
        for (int o = 1; o < 32; o <<= 1) ss += __shfl_xor(ss, o);
        const float rn = 1.0f / sqrtf(ss * (1.f / 192.f) + EPS);
        const int gi = (act ? l5 : 0) * 8;
        const f32x4 g0 = *(const f32x4*)(qkg + gi), g1 = *(const f32x4*)(qkg + gi + 4);
#pragma unroll
        for (int j = 0; j < 4; ++j) { x[j] *= rn * g0[j]; x[4 + j] *= rn * g1[j]; }
        float o[8];
#pragma unroll
        for (int j = 0; j < 8; ++j) { const float pr = __shfl_xor(x[j], 4); const float rot = (l5 & 4) ? (x[j] * c64[j] + pr * s64[j]) : (x[j] * c64[j] - pr * s64[j]); o[j] = (l5 >= 16 ? rot : x[j]) * C2_192; }
        if (act) *ptr = pack8(o);
    }
#pragma unroll
    for (int it = 0; it < 4; ++it) {
        const int h = 2 * it + hw; const bool isk = l5 < 16;
        u32x4* ptr = (u32x4*)(p + C_KVRAW + h * 256 + (l5 & 15) * 8);
        float x[8]; unpack8(v[5 + it], x);
        float ss = 0.f;
#pragma unroll
        for (int j = 0; j < 8; ++j) ss += x[j] * x[j];
        if (!isk) ss = 0.f;
#pragma unroll
        for (int o = 1; o < 32; o <<= 1) ss += __shfl_xor(ss, o);
        const float rn = 1.0f / sqrtf((ss + kpe_ss) * (1.f / 192.f) + EPS);
        if (l5 == 0) rnl[h] = rn;
        const int gi = 192 + (isk ? l5 : 0) * 8;
        const f32x4 g0 = *(const f32x4*)(qkg + gi), g1 = *(const f32x4*)(qkg + gi + 4);
        float o[8];
#pragma unroll
        for (int j = 0; j < 4; ++j) { o[j] = x[j] * rn * g0[j]; o[4 + j] = x[4 + j] * rn * g1[j]; }
        if (isk) *ptr = pack8(o);
    }
    LDS_WAIT(); asm volatile("" ::: "memory");
    { const int hd = lane >> 3, c = lane & 7; const float rn = rnl[hd];
      const f32x4 g0 = *(const f32x4*)(qkg + 192 + 128 + c * 8), g1 = *(const f32x4*)(qkg + 192 + 128 + c * 8 + 4);
      float x[8], o[8];
#pragma unroll
      for (int j = 0; j < 4; ++j) { x[j] = kp[j] * rn * g0[j]; x[4 + j] = kp[4 + j] * rn * g1[j]; }
#pragma unroll
      for (int j = 0; j < 8; ++j) { const float pr = __shfl_xor(x[j], 4); o[j] = (c & 4) ? (x[j] * c64[j] + pr * s64[j]) : (x[j] * c64[j] - pr * s64[j]); }
      *(u32x4*)(p + C_KPEH + hd * 64 + c * 8) = pack8(o); }
    { const float x1 = __uint_as_float(ikw << 16), x2 = __uint_as_float(ikw & 0xffff0000u); float cs, sn; rope_cs(pos, lane & 31, 2.f / 64.f, cs, sn);
      if (lane < 32) *ikp = cvt_pk_bf16(x1 * cs - x2 * sn, x2 * cs + x1 * sn); }
    LDS_WAIT(); asm volatile("" ::: "memory");
}
__device__ __forceinline__ void post3_load(const bf16_t* P, int r, int lane, u32x4 (&rr)[4]) {
    const bf16_t* p = P + (size_t)r * PW; const int hw = lane >> 5, l5 = lane & 31;
#pragma unroll
    for (int h = 0; h < 4; ++h) rr[h] = *(const u32x4*)(p + (hw ? C_IQ : C_FQ) + h * 256 + l5 * 8);
}
__device__ __forceinline__ void post3_row(bf16_t* P, int r, const u32x4 (&rr)[4], const float* subg, float lam, float omli, int lane) {
    bf16_t* p = P + (size_t)r * PW;
    const int hw = lane >> 5, l5 = lane & 31;
#pragma unroll
    for (int h = 0; h < 4; ++h) {
        const u32x4 raw = rr[h];
        const u32x4 praw = shfl_xor4(raw, 16);
        float a[8], b[8]; unpack8(raw, a); unpack8(praw, b);
        float d[8], ss = 0.f;
#pragma unroll
        for (int j = 0; j < 8; ++j) { d[j] = a[j] - lam * b[j]; ss += d[j] * d[j]; }
        if (l5 >= 16) ss = 0.f;
#pragma unroll
        for (int o = 1; o < 64; o <<= 1) ss += __shfl_xor(ss, o);
        const float rn = omli / sqrtf(ss * (1.f / 256.f) + EPS);
        const int dim = hw * 128 + (l5 & 15) * 8;
        const f32x4 g0 = *(const f32x4*)(subg + dim), g1 = *(const f32x4*)(subg + dim + 4);
        float o[8];
#pragma unroll
        for (int j = 0; j < 4; ++j) { o[j] = d[j] * rn * g0[j]; o[4 + j] = d[4 + j] * rn * g1[j]; }
        if (l5 < 16) *(u32x4*)(p + C_OC + h * 256 + dim) = pack8(o);
    }
}

__device__ __forceinline__ void index_unit(const bf16_t* P, int unit, unsigned* bm, LAS unsigned char* lds) {
    typedef float f32x16 __attribute__((ext_vector_type(16)));
    int tid = threadIdx.x; asm volatile("" : "+v"(tid));
    const int wid = __builtin_amdgcn_readfirstlane(tid >> 6), lane = tid & 63, j = lane & 31, hi = lane >> 5;
    const int tb = 255 - (unit >> 4), b = unit & 15, t0 = tb * 8, tokbase = MBLK + b * SEQ;
    const int wmax = (64 + t0 + 7) >> 5;
    LAS unsigned* keys = (LAS unsigned*)lds;
    LAS float* iwl = (LAS float*)(lds + 8 * 2112 * 4);
    if (t0 + 7 + 17 > 256) {
        const unsigned boff = (unsigned)(j * PW + C_IK + hi * 8) * 2u;
#define IX_LOADK(dst, w_) do { const int kr_ = (w_) < 2 ? (MBLK - 64) + 32 * (w_) : tokbase + 32 * ((w_) - 2); const char* bp_ = (const char*)(P + (size_t)kr_ * PW) + boff; \
        _Pragma("unroll") for (int s = 0; s < 4; ++s) dst[s] = *(const bf16x8*)(bp_ + s * 32); } while (0)
        bf16x8 bf[4], bn[4];
        IX_LOADK(bf, wid <= wmax ? wid : 0);
        if (tid < 128) iwl[tid] = bf2f(P[(size_t)(tokbase + t0 + (tid >> 4)) * PW + C_IW + (tid & 15)]);
        LAS unsigned char* al = lds + 8 * 2112 * 4 + 512;
        { const int id0 = tid * 2;
#pragma unroll
          for (int e = 0; e < 2; ++e) { const int id = id0 + e, rw = id >> 3, c = id & 7;
              *(LAS bf16x8*)(al + rw * 144 + c * 16) = *(const bf16x8*)(P + (size_t)(tokbase + t0 + (rw >> 4)) * PW + C_IQ + (rw & 15) * 64 + c * 8); } }
        LDS_WAIT(); __syncthreads();
        bf16x8 af[4][4];
        { const int qa = (j >> 2) & 1, ha = (j & 3) + 4 * (j >> 3);
#pragma unroll
          for (int blk = 0; blk < 4; ++blk)
#pragma unroll
              for (int s = 0; s < 4; ++s) af[blk][s] = *(const LAS bf16x8*)(al + ((2 * blk + qa) * 16 + ha) * 144 + s * 32 + hi * 16); }
        for (int w = wid; w <= wmax; w += 8) {
            IX_LOADK(bn, w + 8 <= wmax ? w + 8 : w);
            const int kidx = 32 * w + j;
#pragma unroll
            for (int blk = 0; blk < 4; ++blk) {
                f32x16 acc = (f32x16){0.f,0.f,0.f,0.f,0.f,0.f,0.f,0.f,0.f,0.f,0.f,0.f,0.f,0.f,0.f,0.f};
#pragma unroll
                for (int s = 0; s < 4; ++s) acc = __builtin_amdgcn_mfma_f32_32x32x16_bf16(af[blk][s], bf[s], acc, 0, 0, 0);
                const int q = 2 * blk + hi;
                const LAS f32x4* iwq = (const LAS f32x4*)(iwl + q * 16);
                float score = 0.f;
#pragma unroll
                for (int g = 0; g < 4; ++g) { const f32x4 wv = iwq[g]; score += fmaxf(acc[4 * g], 0.f) * wv.x + fmaxf(acc[4 * g + 1], 0.f) * wv.y + fmaxf(acc[4 * g + 2], 0.f) * wv.z + fmaxf(acc[4 * g + 3], 0.f) * wv.w; }
                const bool valid = kidx >= 48 && kidx <= 64 + t0 + q; const unsigned u_ = __float_as_uint(score);
                keys[q * 2112 + kidx] = valid ? ((u_ & 0x80000000u) ? ~u_ : (u_ | 0x80000000u)) : 0u;
            }
#pragma unroll
            for (int s = 0; s < 4; ++s) bf[s] = bn[s];
        }
#undef IX_LOADK
        LDS_WAIT(); __syncthreads();
    }
    const int tq = t0 + wid, qk = 64 + tq, nch = qk / 64 + 1;
    unsigned* out = bm + (size_t)(b * SEQ + tq) * BMW;
    if (tq + 17 <= 256) {
        for (int c = 0; c < 33; ++c) { const int kidx = 64 * c + lane; const unsigned long long m = __ballot(kidx >= 48 && kidx <= qk);
            if (lane == 0) { out[2 * c] = (unsigned)m; out[2 * c + 1] = (unsigned)(m >> 32); } }
    } else {
#define IX_SELECT(NC) do { unsigned kreg[NC]; \
        _Pragma("unroll") for (int c = 0; c < NC; ++c) kreg[c] = (c < nch && 64 * c + lane <= qk) ? keys[wid * 2112 + 64 * c + lane] : 0u;     \
        unsigned T = 0u; \
        for (int bit = 31; bit >= 0; --bit) { \
            const unsigned cand = T | (1u << bit); int cnt = 0; \
            _Pragma("unroll") for (int c = 0; c < NC; ++c) cnt += __popcll(__ballot(kreg[c] >= cand)); \
            if (cnt >= 256) T = cand; \
            if (cnt == 256) break; \
        } \
        _Pragma("unroll") for (int c = 0; c < NC; ++c) { const unsigned long long m = __ballot(kreg[c] >= T && kreg[c] != 0u); \
            if (lane == 0) { out[2 * c] = (unsigned)m; out[2 * c + 1] = (unsigned)(m >> 32); } } \
        if (lane < 2 * (33 - NC)) out[2 * NC + lane] = 0u; } while (0)
        if (nch <= 11) IX_SELECT(11); else if (nch <= 22) IX_SELECT(22); else IX_SELECT(33);
#undef IX_SELECT
    }
    LDS_WAIT();
}

namespace fa {
typedef float f32x16 __attribute__((ext_vector_type(16)));
typedef short s16x4 __attribute__((ext_vector_type(4)));
__device__ __forceinline__ int crow(int r, int hi) { return (r & 3) + 8 * (r >> 2) + 4 * hi; }
__device__ __forceinline__ int v_st(int k, int c) { const int kk = (k & ~0xC) | ((k & 4) << 1) | ((k & 8) >> 1); return ((kk >> 3) * 4 + (c >> 5)) * 512 + ((kk & 7) * 32 + (c & 31)) * 2; }
__device__ __forceinline__ int v_rd_base(int lane) { return ((lane & 3) << 3) | (((lane >> 2) & 3) << 6) | (((lane >> 4) & 1) << 5) | (((lane >> 5) & 1) << 8); }
constexpr int v_rd_off(int d0, int ks, int half) { return d0 * 512 + ks * 4096 + half * 2048; }
constexpr int SHM_V = 16384;
template <int DQK, int DV> struct Geo { static constexpr int KP = DQK * 2, SHM_K = 64 * DQK * 2, LDS_K0 = 2 * 64 * DV * 2, LDS_WS = LDS_K0 + 2 * SHM_K, BYTES = LDS_WS + 8 * 256; };
#define FA_KSWZ(row, colB, pitch) ((row) * (pitch) + ((colB) ^ (((row) & 7) << 4)))
#define FA_SBAR() __builtin_amdgcn_sched_barrier(0)

struct Item { int qrow0, qk0, nt, tokbase; };

template <int DQK>
__device__ __forceinline__ void load_q(const bf16_t* P, const Item& it, int qcol, bf16x8 (&qr)[DQK / 16]) {
    int tid = threadIdx.x; asm volatile("" : "+v"(tid));
    const int wid = tid >> 6, lane = tid & 63, r32 = lane & 31, hi = lane >> 5;
    const bf16_t* qp = P + (size_t)(it.qrow0 + wid * 32 + r32) * PW + qcol + hi * 8;
#pragma unroll
    for (int d0 = 0; d0 < DQK / 16; ++d0) qr[d0] = *(const bf16x8*)(qp + d0 * 16);
}

template <int DQK, int DV, bool MASKED>
__device__ __forceinline__ void attn_core(bf16_t* P, const Item& it, const bf16x8 (&qr)[DQK / 16], int k1col, int k2col, int vcol, int ocol, int ocol1, const unsigned* bmq, LAS unsigned char* lds) {
    typedef Geo<DQK, DV> G; constexpr int SHMV = 64 * DV * 2, NDB = DV / 32;
    int tid = threadIdx.x; asm volatile("" : "+v"(tid));
    const int wid = __builtin_amdgcn_readfirstlane(tid >> 6), lane = tid & 63, r32 = lane & 31, hi = lane >> 5;
    LAS unsigned char* V_lds = lds; LAS unsigned char* K_lds = lds + G::LDS_K0; LAS float* wsf = (LAS float*)(lds + G::LDS_WS) + wid * 64;
    const int sr = tid >> 4, sc = (tid & 15) * 8;
    const int vst0 = v_st(sr, sc), vst1 = v_st(32 + sr, sc), kws0 = FA_KSWZ(sr, sc * 2, G::KP), kws1 = FA_KSWZ(sr + 32, sc * 2, G::KP);
    const int xr = tid >> 3, xc = (tid & 7) * 8, kws2 = FA_KSWZ(xr, (128 + xc) * 2, G::KP);
    const unsigned loff0 = (unsigned)(sr * PW + sc) * 2u, loffx = (unsigned)(xr * PW + xc) * 2u;
    const int vb0 = (int)(unsigned)(size_t)V_lds + v_rd_base(lane);
    const int NT = it.nt;
    const int qk = it.qk0 + wid * 32 + r32;
    const bool use_bm = MASKED && (bmq != nullptr);
    const unsigned bmoff = (unsigned)((wid * 32 + r32) * BMW) * 4u;
    float l_reg = 0.f; f32x16 o[NDB];
#pragma unroll
    for (int d = 0; d < NDB; ++d) o[d] = (f32x16){0.f,0.f,0.f,0.f,0.f,0.f,0.f,0.f,0.f,0.f,0.f,0.f,0.f,0.f,0.f,0.f};
    bf16x8 sk0, sk1, sk2, sv0, sv1, sv2, sv3;
#define FA_KROW0(t) ((t) == 0 ? (MBLK - 64) : it.tokbase + 64 * ((t) - 1))
#define FA_LOADK(t) do { const int kr_ = FA_KROW0(t); const char* rb_ = (const char*)(P + (size_t)kr_ * PW); const char* rk_ = rb_ + (size_t)k1col * 2; \
        sk0 = *(const bf16x8*)(rk_ + loff0); sk1 = *(const bf16x8*)(rk_ + (size_t)32 * PW * 2 + loff0); if (DQK == 192) sk2 = *(const bf16x8*)(rb_ + (size_t)k2col * 2 + loffx); } while (0)
#define FA_LOADV(t) do { const char* rv_ = (const char*)(P + (size_t)FA_KROW0(t) * PW) + (size_t)vcol * 2; \
        sv0 = *(const bf16x8*)(rv_ + loff0); sv1 = *(const bf16x8*)(rv_ + (size_t)32 * PW * 2 + loff0); if (DV == 256) { sv2 = *(const bf16x8*)(rv_ + 256 + loff0); sv3 = *(const bf16x8*)(rv_ + 256 + (size_t)32 * PW * 2 + loff0); } } while (0)
#define FA_LOAD(t) do { FA_LOADK(t); FA_LOADV(t); } while (0)
#define FA_WRITE(bf) do { *(LAS bf16x8*)(K_lds + (bf) * G::SHM_K + kws0) = sk0; *(LAS bf16x8*)(K_lds + (bf) * G::SHM_K + kws1) = sk1; \
        *(LAS bf16x8*)(V_lds + (bf) * SHMV + vst0) = sv0; *(LAS bf16x8*)(V_lds + (bf) * SHMV + vst1) = sv1; if (DV == 256) { *(LAS bf16x8*)(V_lds + (bf) * SHMV + 16384 + vst0) = sv2; *(LAS bf16x8*)(V_lds + (bf) * SHMV + 16384 + vst1) = sv3; } \
        if (DQK == 192) *(LAS bf16x8*)(K_lds + (bf) * G::SHM_K + kws2) = sk2; } while (0)
    constexpr int QREG = (DV == 256) ? 3 : DQK / 16;
    constexpr int NQL = DQK / 16 - QREG;
    static_assert(G::BYTES + 8 * NQL * 64 * 16 <= LDSCTL_OFF, "attention LDS budget");
    LAS unsigned char* qx = lds + G::BYTES + (wid * (NQL * 64) + lane) * 16;
    if (QREG < DQK / 16) {
#pragma unroll
        for (int d0 = QREG; d0 < DQK / 16; ++d0) *(LAS bf16x8*)(qx + (d0 - QREG) * 1024) = qr[d0];
    }
    FA_LOAD(0); FA_WRITE(0);
    __syncthreads();
    for (int t = 0; t < NT; ++t) {
        const int cur = t & 1;
        unsigned zb = 0u; asm volatile("" : "+v"(zb)); u32x2 bw = (u32x2){zb, zb};
        if (use_bm) bw = *(const u32x2*)((const char*)(bmq + 2 * t) + bmoff);
        f32x16 p0 = (f32x16){0.f,0.f,0.f,0.f,0.f,0.f,0.f,0.f,0.f,0.f,0.f,0.f,0.f,0.f,0.f,0.f}, p1 = p0;
        { LAS unsigned char* kbase = K_lds + cur * G::SHM_K;
          LAS unsigned char* kb[4];
#pragma unroll
          for (int dd = 0; dd < 4; ++dd) kb[dd] = kbase + FA_KSWZ(r32, (dd * 16 + hi * 8) * 2, G::KP);
          constexpr int GS = (DQK == 192 || DV == 256) ? 2 : 4;
#pragma unroll
          for (int g = 0; g < DQK / (16 * GS); ++g) {
              bf16x8 fb0[GS], fb1[GS];
#pragma unroll
              for (int dd = 0; dd < GS; ++dd) { const int d0 = g * GS + dd; LAS unsigned char* a = kb[d0 & 3] + (d0 >> 2) * 128; fb0[dd] = *(const LAS bf16x8*)a; fb1[dd] = *(const LAS bf16x8*)(a + 32 * G::KP); }
              FA_SBAR();
#pragma unroll
              for (int dd = 0; dd < GS; ++dd) { const int d0 = g * GS + dd; bf16x8 qf; if (d0 < QREG) qf = qr[d0 < QREG ? d0 : 0]; else qf = *(const LAS bf16x8*)(qx + (d0 - QREG) * 1024);
                  p0 = __builtin_amdgcn_mfma_f32_32x32x16_bf16(fb0[dd], qf, p0, 0, 0, 0); p1 = __builtin_amdgcn_mfma_f32_32x32x16_bf16(fb1[dd], qf, p1, 0, 0, 0); }
              FA_SBAR(); } }
        if (t + 1 < NT) { FA_LOADK(t + 1); if (DV != 256) FA_LOADV(t + 1); }
        FA_SBAR();
        const float NEG = -__builtin_inff();
        if (use_bm) {
        } else if (t == 0 || 64 * t + 63 > it.qk0 + wid * 32) {
            const int kb_ = 64 * t + 4 * hi;
#pragma unroll
            for (int r = 0; r < 16; ++r) { const int k0 = kb_ + (r & 3) + 8 * (r >> 2), k1 = k0 + 32;
                if (k0 < 48 || k0 > qk) p0[r] = NEG; if (k1 < 48 || k1 > qk) p1[r] = NEG; }
        }
        float ps = 0.f;
#pragma unroll
        for (int r = 0; r < 16; ++r) { p0[r] = __builtin_amdgcn_exp2f(p0[r]); p1[r] = __builtin_amdgcn_exp2f(p1[r]); }
        if (use_bm) {
            const int wx = (int)(bw.x >> (4 * hi)), wy = (int)(bw.y >> (4 * hi));
#pragma unroll
            for (int r = 0; r < 16; ++r) { const int c = (r & 3) + 8 * (r >> 2);
                p0[r] = __uint_as_float(__float_as_uint(p0[r]) & (unsigned)__builtin_amdgcn_sbfe(wx, c, 1)); p1[r] = __uint_as_float(__float_as_uint(p1[r]) & (unsigned)__builtin_amdgcn_sbfe(wy, c, 1)); }
        }
        { f32x2 s2 = (f32x2){p0[0], p0[1]} + (f32x2){p1[0], p1[1]};
#pragma unroll
          for (int r = 2; r < 16; r += 2) s2 += (f32x2){p0[r], p0[r + 1]} + (f32x2){p1[r], p1[r + 1]};
          ps = s2.x + s2.y; }
        { auto rr = __builtin_amdgcn_permlane32_swap(__float_as_uint(ps), __float_as_uint(ps), false, false); ps = __uint_as_float(rr[0]) + __uint_as_float(rr[1]); }
        l_reg += ps;
        if (DV == 256 && t + 1 < NT) { FA_SBAR(); FA_LOADV(t + 1); FA_SBAR(); }
        bf16x8 pa0, pa1, pa2, pa3;
#define FA_PK4(Pv, B_, OUT) do { const unsigned a0 = cvt_pk_bf16(Pv[B_ + 0], Pv[B_ + 1]), a1 = cvt_pk_bf16(Pv[B_ + 2], Pv[B_ + 3]), b0 = cvt_pk_bf16(Pv[B_ + 4], Pv[B_ + 5]), b1 = cvt_pk_bf16(Pv[B_ + 6], Pv[B_ + 7]); \
        auto r0 = __builtin_amdgcn_permlane32_swap(a0, b0, false, false); auto r1 = __builtin_amdgcn_permlane32_swap(a1, b1, false, false); \
        u32x4 w_ = {r0[0], r1[0], r0[1], r1[1]}; OUT = __builtin_bit_cast(bf16x8, w_); } while (0)
        FA_PK4(p0, 0, pa0); FA_PK4(p0, 8, pa1); FA_PK4(p1, 0, pa2); FA_PK4(p1, 8, pa3);
#define FA_TRRD(dst, off) asm volatile("ds_read_b64_tr_b16 %0, %1 offset:%2" : "=&v"(dst) : "v"(vbc), "i"(off) : "memory")
#define FA_PV(VB, d0) do { s16x4 l0, l1, l2, l3, h0, h1, h2, h3; constexpr int b_ = ((d0) >> 2) * 16384 + v_rd_off((d0) & 3, 0, 0); \
        FA_TRRD(l0, b_); FA_TRRD(h0, b_ + 2048); FA_TRRD(l1, b_ + 4096); FA_TRRD(h1, b_ + 6144); FA_TRRD(l2, b_ + 8192); FA_TRRD(h2, b_ + 10240); FA_TRRD(l3, b_ + 12288); FA_TRRD(h3, b_ + 14336); \
        asm volatile("s_waitcnt lgkmcnt(0)" ::: "memory"); FA_SBAR(); \
        o[d0] = __builtin_amdgcn_mfma_f32_32x32x16_bf16(pa0, (bf16x8){l0[0], l0[1], l0[2], l0[3], h0[0], h0[1], h0[2], h0[3]}, o[d0], 0, 0, 0); \
        o[d0] = __builtin_amdgcn_mfma_f32_32x32x16_bf16(pa1, (bf16x8){l1[0], l1[1], l1[2], l1[3], h1[0], h1[1], h1[2], h1[3]}, o[d0], 0, 0, 0); \
        o[d0] = __builtin_amdgcn_mfma_f32_32x32x16_bf16(pa2, (bf16x8){l2[0], l2[1], l2[2], l2[3], h2[0], h2[1], h2[2], h2[3]}, o[d0], 0, 0, 0); \
        o[d0] = __builtin_amdgcn_mfma_f32_32x32x16_bf16(pa3, (bf16x8){l3[0], l3[1], l3[2], l3[3], h3[0], h3[1], h3[2], h3[3]}, o[d0], 0, 0, 0); } while (0)
        FA_SBAR();
        { const int vbc = vb0 + cur * SHMV;
          FA_PV(0, 0); FA_PV(0, 1); FA_PV(0, 2); FA_PV(0, 3); if (DV == 256) { FA_PV(0, 4); FA_PV(0, 5); FA_PV(0, 6); FA_PV(0, 7); } }
        FA_SBAR();
        if (t + 1 < NT) { const int nb_ = cur ^ 1; FA_WRITE(nb_); }
        __syncthreads();
    }
    if (hi == 0) wsf[r32] = l_reg; LDS_WAIT();
    float rli[16];
#pragma unroll
    for (int r = 0; r < 16; ++r) { const float lv = wsf[crow(r, hi)]; rli[r] = lv > 0.f ? __builtin_amdgcn_rcpf(lv) : 0.f; }
    { int l2 = lane; asm volatile("" : "+v"(l2));
      const int r32b = l2 & 31, hib = l2 >> 5;
      char* Ow = (char*)(P + (size_t)(it.qrow0 + wid * 32) * PW + ocol) + (unsigned)((4 * hib) * PW + r32b) * 2u;
      char* Ow1 = (char*)(P + (size_t)(it.qrow0 + wid * 32) * PW + ocol1) + (unsigned)((4 * hib) * PW + r32b) * 2u;
#pragma unroll
      for (int r = 0; r < 16; ++r) { const unsigned ro = (unsigned)(((r & 3) + 8 * (r >> 2)) * PW) * 2u;
#pragma unroll
        for (int d0 = 0; d0 < NDB; ++d0) { const float v = o[d0][r] * rli[r]; const float vn = __shfl_xor(v, 1);
            if ((r32b & 1) == 0) *(unsigned*)((d0 < 4 ? Ow : Ow1) + ro + (d0 & 3) * 64) = cvt_pk_bf16(v, vn); } } }
    LDS_WAIT();
    __syncthreads();
#undef FA_KROW0
#undef FA_LOAD
#undef FA_LOADK
#undef FA_LOADV
#undef FA_WRITE
#undef FA_PK4
#undef FA_TRRD
#undef FA_PV
}
__device__ __forceinline__ int next_item(unsigned* ctr, LAS int* slot) {
    __syncthreads();
    if (threadIdx.x == 0) *slot = (int)__hip_atomic_fetch_add(ctr, 1u, __ATOMIC_RELAXED, __HIP_MEMORY_SCOPE_AGENT);
    __syncthreads();
    return *slot;
}
__device__ __forceinline__ void queue_prime(unsigned* ctr, LAS int* slot) {
    __syncthreads();
    if (threadIdx.x == 0) slot[0] = (int)__hip_atomic_fetch_add(ctr, 1u, __ATOMIC_RELAXED, __HIP_MEMORY_SCOPE_AGENT);
    __syncthreads();
}
__device__ __forceinline__ int queue_next(unsigned* ctr, LAS int* slot, int k) {
    const int idx = slot[k & 1];
    if (threadIdx.x == 0) slot[(k + 1) & 1] = (int)__hip_atomic_fetch_add(ctr, 1u, __ATOMIC_RELAXED, __HIP_MEMORY_SCOPE_AGENT);
    return idx;
}
__device__ __forceinline__ Item make_item(bool meta, int b, int qb) {
    Item it;
    if (meta) { it.qrow0 = 0; it.qk0 = -(MBLK - 64); it.nt = 1; it.tokbase = MBLK; }
    else { it.qrow0 = MBLK + b * SEQ + qb * 256; it.qk0 = 64 + qb * 256; it.nt = 4 * (qb + 1) + 1; it.tokbase = MBLK + b * SEQ; }
    return it;
}
}


constexpr int PH_PER_LAYER = 19, N_PHASES = 2 * PH_PER_LAYER;
__device__ __forceinline__ unsigned char* uni_ptr(unsigned char* p) { const unsigned long long v = (unsigned long long)p; const unsigned lo = __builtin_amdgcn_readfirstlane((unsigned)v), hi = __builtin_amdgcn_readfirstlane((unsigned)(v >> 32)); return (unsigned char*)(((unsigned long long)hi << 32) | lo); }
__device__ __forceinline__ const float* arg_in(const Args& a, int k) { asm volatile("" : "+s"(k)); return a.in[k]; }
__global__ void __launch_bounds__(NWAVES * 64, 2) mega_fwd(Args args) {
    extern __shared__ __attribute__((aligned(16))) unsigned char lds_raw[];
    {
        LAS unsigned char* l0 = (LAS unsigned char*)lds_raw;
        for (int u = threadIdx.x; u < (LDS_BYTES - LDSCTL_OFF) / 4; u += NWAVES * 64) ((LAS unsigned*)(l0 + LDSCTL_OFF))[u] = 0u;
        __syncthreads();
    }
#if MK_ONE_LAUNCH
    (void)xcd_barrier_post((unsigned*)(args.ws + WS_CTL) + CW_BAR, (volatile LAS unsigned*)((LAS unsigned char*)lds_raw + LDSCTL_OFF + 64));
#define GRID_BAR() do { XcdBarrier bar_; bar_.bar = (unsigned*)(uni_ptr(args.ws) + WS_CTL) + CW_BAR; bar_.x = xb_xcc_id(); bar_.st = (volatile LAS unsigned*)((LAS unsigned char*)lds_raw + LDSCTL_OFF + 64); xcd_barrier(bar_); } while (0)
#else
#define GRID_BAR() do {} while (0)
#endif
    const int lo = args.ph_lo, hi = args.ph_hi;
#define IN(k) (lo <= (k) && (k) < hi)
#define SEAM(k) do { if (IN((k) + 1)) GRID_BAR(); } while (0)
#define PH_BEGIN \
    int tid_ = threadIdx.x; asm volatile("" : "+v"(tid_)); \
    Ctx F; F.lds = (LAS unsigned char*)lds_raw; F.tid = tid_; F.lane = tid_ & 63; F.wave = __builtin_amdgcn_readfirstlane(tid_ >> 6); \
    F.G = gridDim.x; F.bid = blockIdx.x; F.gw = F.bid * NWAVES + F.wave; F.ngw = F.G * NWAVES; \
    unsigned char* ws = uni_ptr(args.ws); asm volatile("" : "+s"(ws)); ws = (unsigned char*)(__attribute__((address_space(1))) unsigned char*)(unsigned long long)ws;     \
    int ly = __builtin_amdgcn_readfirstlane(layer); asm volatile("" : "+s"(ly)); (void)ly; (void)F
#define XN_ ((bf16_t*)(ws + WS_XN))
#define P_ ((bf16_t*)(ws + WS_P))
#define HMETA_ ((float*)(ws + WS_HMETA))
#define RSQ_(ly) ((rs_t*)(ws + WS_CTL + WS_RS2) + (size_t)(2 * (ly)) * R)
#define RSKV_(ly) ((rs_t*)(ws + WS_CTL + WS_RS2) + (size_t)(2 * (ly) + 1) * R)
#define BM_ ((unsigned*)(ws + WS_BM))
#define RS_(i) ((rs_t*)(ws + WS_CTL + WS_RS) + (size_t)(i) * R)
#define GPERM_ ((float*)(ws + WS_RSTD + 512 * 1024))
#define WB_(off) ((bf16_t*)(ws + WS_WB + (off)))
#define OUT_ (args.out)
#define LAMBDA_INIT(ly) ((ly) == 0 ? 0.2f : (0.8f - 0.6f * 0.7408182206817179f))

#pragma unroll
    for (int layer = 0; layer < 2; ++layer) {
        const int pb = layer * PH_PER_LAYER;
        if (((PHMASK >> 0) & 1) && IN(pb + 0)) {
            PH_BEGIN;
            for (int rep_ = 0; rep_ < NREP(0); ++rep_) { if (rep_) GRID_BAR();
            const float* meta = arg_in(args, 1);
            conv_matrix<1>(F, arg_in(args, 3) + (size_t)ly * DM * D_IN, DM, D_IN, WB_(WB_IN), arg_in(args, 2) + ly * DM);
            conv_matrix<0>(F, arg_in(args, 7) + (size_t)ly * 512 * 1536, 512, 1536, WB_(WB_QUP), arg_in(args, 5) + ly * 512);
            conv_matrix<0>(F, arg_in(args, 8) + (size_t)ly * 512 * 2048, 512, 2048, WB_(WB_KVUP), arg_in(args, 6) + ly * 512);
            for (int b = 0; b < 3; ++b) conv_matrix<0>(F, arg_in(args, 14) + ((size_t)ly * 3 + b) * 1024 * DM, 1024, DM, WB_(WB_BR) + (size_t)b * DM * 1024, nullptr);
            conv_matrix<0>(F, arg_in(args, 15) + (size_t)ly * DM * DM, DM, DM, WB_(WB_O), nullptr);
            conv_matrix<2>(F, arg_in(args, 17) + (size_t)ly * DM * 2 * DFF, DM, 2 * DFF, WB_(WB_F1), arg_in(args, 16) + ly * DM);
            conv_matrix<0>(F, arg_in(args, 18) + (size_t)ly * DFF * DM, DFF, DM, WB_(WB_F2), nullptr);
            unsigned zu = 0u; asm volatile("" : "+v"(zu)); const float zf = __uint_as_float(zu);
            for (int i = F.gw * 64 + F.lane; i < 112 * 2048 / 8; i += F.ngw * 64) *((u32x4*)(WB_(WB_IN) + (size_t)1168 * 2048) + i) = (u32x4){zu, zu, zu, zu};
            if (F.bid == 0) { const int i = F.tid; const int t = i >> 7, ps = i & 127, dim = (ps >> 1) + 64 * (ps & 1);
                const float* gsrc = (t < 2 ? arg_in(args, 10) : arg_in(args, 11)) + ly * 256 + (t & 1) * 128; GPERM_[i] = gsrc[dim]; }
            float* hmeta = HMETA_;
            if (ly == 0) {
                for (int i = F.gw * 64 + F.lane; i < MROW0 * PW / 8; i += F.ngw * 64) *((u32x4*)P_ + i) = (u32x4){zu, zu, zu, zu};
                for (int i = F.gw * 64 + F.lane; i < MBLK * DM / 4; i += F.ngw * 64) { const int rr = i / (DM / 4); f32x4 v = (f32x4){zf, zf, zf, zf};
                    if (rr >= MBLK - NMETA) v = *((const f32x4*)meta + (i - (MBLK - NMETA) * (DM / 4))); *((f32x4*)hmeta + i) = v; }
            }
            if (ly == 0) {
                const float* xin = arg_in(args, 0); bf16_t* XN = XN_; rs_t* rs0 = RS_(0);
                for (int r = MROW0 + F.gw; r < R; r += 2 * F.ngw) {
                    const int r2 = (r + F.ngw < R) ? r + F.ngw : r; f32x4 va[8], vb[8];
                    norm_load(r < MBLK ? meta + (size_t)(r - MROW0) * DM : xin + (size_t)(r - MBLK) * DM, F.lane, va); norm_load(r2 < MBLK ? meta + (size_t)(r2 - MROW0) * DM : xin + (size_t)(r2 - MBLK) * DM, F.lane, vb);
                    norm_fin(va, XN + (size_t)r * DM, rs0 + r, F.lane); if (r2 != r) norm_fin(vb, XN + (size_t)r2 * DM, rs0 + r2, F.lane); }
            }
            }
            SEAM(pb + 0);
        }
        if (((PHMASK >> 1) & 1) && IN(pb + 1)) {
            PH_BEGIN;
            { SkP f{P_, 0, RS_(2 * ly), 1.f / DM, RSQ_(ly), RSKV_(ly)}; skinny_gemm(F.lds, XN_ + (size_t)MROW0 * DM, DM, WB_(WB_IN), DM, 1280 / 16, F.bid, F.G, f); }
            SchedPlain S{XN_, DM, WB_(WB_IN), DM, NPMM, 5, F.G, F.bid, 0}; EpiP E{P_, RS_(2 * ly), RS_(2 * ly), 1 << 30, 1.f / DM, RSQ_(ly), RSKV_(ly)};
            pg8::gemm_phase(F.lds, S, E);
            if (NREP(1) == 2) { GRID_BAR(); pg8::gemm_phase(F.lds, S, E); }
            SEAM(pb + 1);
        }
        if (((PHMASK >> 2) & 1) && IN(pb + 2)) {
            PH_BEGIN;
            { SkP f{P_, C_QRAW, RSQ_(ly), 1.f / 512.f, nullptr, nullptr}; skinny_gemm(F.lds, P_ + (size_t)MROW0 * PW + C_CQ, PW, WB_(WB_QUP), 512, 1536 / 16, F.bid, F.G, f); }
            { SkP f{P_, C_KVRAW, RSKV_(ly), 1.f / 512.f, nullptr, nullptr}; skinny_gemm(F.lds, P_ + (size_t)MROW0 * PW + C_CKV, PW, WB_(WB_KVUP), 512, 2048 / 16, F.bid, F.G, f); }
            SchedMlaUp S{P_, WB_(WB_QUP), WB_(WB_KVUP), F.G, F.bid}; EpiP E{P_, RSQ_(ly), RSKV_(ly), 6, 1.f / 512.f, nullptr, nullptr};
            pg8::gemm_phase(F.lds, S, E);
            if (NREP(2) == 2) { GRID_BAR(); pg8::gemm_phase(F.lds, S, E); }
            SEAM(pb + 2);
        }
        if (((PHMASK >> 3) & 1) && IN(pb + 3)) {
            PH_BEGIN;
            const float* mla_qkg = arg_in(args, 9) + ly * 2 * 192;
            bf16_t* P = P_;
            LAS float* rnl = (LAS float*)(F.lds + F.wave * 64);
            for (int r = MROW0 + F.gw; r < R; r += 2 * F.ngw) {
                const int r2 = (r + F.ngw < R) ? r + F.ngw : r; u32x4 va[9], vb[9]; unsigned ia, ib;
                post2_load(P, r, F.lane, va, ia); post2_load(P, r2, F.lane, vb, ib);
                post2_row(P, r, va, ia, mla_qkg, rnl, F.lane); if (r2 != r) post2_row(P, r2, vb, ib, mla_qkg, rnl, F.lane); }
            SEAM(pb + 3);
        }
        if (((PHMASK >> 4) & 1) && IN(pb + 4)) {
            PH_BEGIN;
            bf16_t* P = P_;
            LAS int* slot = (LAS int*)(F.lds + LDSCTL_OFF + 128);
            for (int rep_ = 0; rep_ < NREP(4); ++rep_) { if (rep_) GRID_BAR();
            unsigned* ctr = (unsigned*)(ws + WS_CTL) + CW_Q + 64 * (ly * 4 + 0) + 64 * 16 * rep_;
            const bool stat = (F.G == 256); const int sx = F.bid & 7, spl = (F.bid >> 3) >> 2, sj = (F.bid >> 3) & 3;
            if (!stat) fa::queue_prime(ctr, slot);
            for (int qk_ = 0;; ++qk_) {
                int idx;
                if (stat) { if (qk_ < 4) { const int pr = sx + 8 * (spl + 8 * (qk_ >> 1)), qb = (qk_ & 1) ? sj : 7 - sj; idx = (7 - qb) * 128 + pr; } else idx = (qk_ == 4 && F.bid < 8) ? 1024 + F.bid : 1 << 30; }
                else idx = fa::queue_next(ctr, slot, qk_);
                if (idx >= 8 * 129) break;
                int h; fa::Item it;
                if (idx < 1024) { const int qb = 7 - (idx >> 7), rest = idx & 127; h = rest & 7; it = fa::make_item(false, rest >> 3, qb); } else { h = idx - 1024; it = fa::make_item(true, 0, 0); }
                bf16x8 qr[12]; fa::load_q<192>(P, it, C_QRAW + h * 192, qr);
                fa::attn_core<192, 128, false>(P, it, qr, C_KVRAW + h * 256, C_KPEH + h * 64, C_KVRAW + h * 256 + 128, C_OA + h * 128, 0, nullptr, F.lds);
            } }
            SEAM(pb + 4);
        }
        if (((PHMASK >> 5) & 1) && IN(pb + 5)) {
            PH_BEGIN;
            { SkP f{P_, 1280, RS_(2 * ly), 1.f / DM, nullptr, nullptr}; skinny_gemm(F.lds, XN_ + (size_t)MROW0 * DM, DM, WB_(WB_IN) + (size_t)1280 * DM, DM, 7168 / 16, F.bid, F.G, f); }
            SchedPlain S{XN_, DM, WB_(WB_IN) + (size_t)1280 * DM, DM, NPMM, 28, F.G, F.bid, 1280}; EpiG2 E{P_, RS_(2 * ly), GPERM_, (LAS float*)(F.lds + RING_BYTES)};
            pg8::gemm_phase(F.lds, S, E);
            if (NREP(5) == 2) { GRID_BAR(); pg8::gemm_phase(F.lds, S, E); }
            SEAM(pb + 5);
        }
        if (((PHMASK >> 6) & 1) && IN(pb + 6)) {
            PH_BEGIN;
            bf16_t* P = P_; const float* gp = GPERM_;
            if (F.gw < NMETA) meta_post_row(P, MROW0 + F.gw, gp, F.lane);
        }
        if (((PHMASK >> 7) & 1) && IN(pb + 7)) {
            PH_BEGIN;
            bf16_t* P = P_; unsigned* bm = BM_;
            unsigned* ctr = (unsigned*)(ws + WS_CTL) + CW_Q + 64 * (ly * 4 + 2);
            LAS int* slot = (LAS int*)(F.lds + LDSCTL_OFF + 128);
            for (int rep_ = 0; rep_ < NREP(7); ++rep_) { if (rep_) GRID_BAR(); unsigned* c2 = ctr + 64 * 16 * rep_;
            for (;;) { const int idx = fa::next_item(c2, slot); if (idx >= NTOK / 8) break; index_unit(P, idx, bm, F.lds); } }
            SEAM(pb + 7);
        }
        if (((PHMASK >> 8) & 1) && IN(pb + 8)) {
            PH_BEGIN;
            bf16_t* P = P_; unsigned* bm = BM_;
            LAS int* slot = (LAS int*)(F.lds + LDSCTL_OFF + 128);
            for (int rep_ = 0; rep_ < NREP(8); ++rep_) { if (rep_) GRID_BAR();
            const bool dummy = (NREP(8) == 2) && rep_ == 0;
            unsigned* ctr = (unsigned*)(ws + WS_CTL) + CW_Q + 64 * (ly * 4 + 1) + 64 * 16 * rep_;
            const bool stat = (F.G == 256); const int sx = F.bid & 7, spl = (F.bid >> 3) >> 2, sj = (F.bid >> 3) & 3;
            if (!stat) fa::queue_prime(ctr, slot);
            for (int qk_ = 0;; ++qk_) {
                int idx;
                if (stat) { if (qk_ < 8) { const int pr = sx + 8 * (spl + 8 * ((qk_ >> 1) & 1)), qb = (qk_ & 1) ? sj : 7 - sj; idx = (7 - qb) * 256 + ((qk_ >> 2) ? 128 : 0) + pr; } else idx = (qk_ == 8 && F.bid < 16) ? 2048 + F.bid : 1 << 30; }
                else idx = fa::queue_next(ctr, slot, qk_);
                if (idx >= 16 * 129) break;
                int hh; bool meta = false; fa::Item it; int b = 0, qb = 0;
                if (idx < 2048) { qb = 7 - (idx >> 8); const int rest = idx & 255; hh = (rest < 128) ? 8 + (rest & 7) : (rest & 7); b = (rest & 127) >> 3; it = fa::make_item(false, b, qb); }
                else { hh = idx - 2048; hh = hh < 8 ? 8 + hh : hh - 8; meta = true; it = fa::make_item(true, 0, 0); }
                if (hh < 8) {
                    bf16x8 qr[8]; fa::load_q<128>(P, it, C_DQ + hh * 128, qr);
                    fa::attn_core<128, 128, true>(P, it, qr, C_DK + hh * 128, 0, C_DV + hh * 128, dummy ? C_KPE : C_OB + hh * 128, 0, meta ? nullptr : bm + (size_t)(b * SEQ + qb * 256) * BMW, F.lds);
                } else {
                    const int hj = hh - 8;
                    bf16x8 qr[8]; fa::load_q<128>(P, it, C_FQ + hj * 128, qr);
                    fa::attn_core<128, 256, false>(P, it, qr, C_FK + hj * 128, 0, C_FV + (hj >> 1) * 256, dummy ? C_KPE : C_FQ + hj * 128, dummy ? C_KPE : C_IQ + hj * 128, nullptr, F.lds);
                }
            } }
            SEAM(pb + 8);
        }
        if (((PHMASK >> 9) & 1) && IN(pb + 9)) {
            PH_BEGIN;
            const float* diff_lam = arg_in(args, 12) + ly * 4 * 128; const float* diff_subg = arg_in(args, 13) + ly * 256;
            const float lambda_init = LAMBDA_INIT(ly);
            const float s1 = wave_sum(diff_lam[F.lane] * diff_lam[128 + F.lane] + diff_lam[64 + F.lane] * diff_lam[192 + F.lane]);
            const float s2 = wave_sum(diff_lam[256 + F.lane] * diff_lam[384 + F.lane] + diff_lam[320 + F.lane] * diff_lam[448 + F.lane]);
            const float lam = __expf(s1) - __expf(s2) + lambda_init;
            bf16_t* P = P_;
            for (int r = MROW0 + F.gw; r < R; r += 4 * F.ngw) {
                int rr_[4]; u32x4 vv[4][4];
#pragma unroll
                for (int k = 0; k < 4; ++k) { rr_[k] = (r + k * F.ngw < R) ? r + k * F.ngw : r; post3_load(P, rr_[k], F.lane, vv[k]); }
#pragma unroll
                for (int k = 0; k < 4; ++k) if (k == 0 || rr_[k] != r) post3_row(P, rr_[k], vv[k], diff_subg, lam, 1.f - lambda_init, F.lane); }
        }
#define GATE_PHASE(k, b, sk, seam) \
        if (((PHMASK >> 10) & 1) && IN(pb + (k))) { \
            PH_BEGIN; \
            { SkGate f{(bf16_t*)(ws + WS_GS), arg_in(args, 4) + ly * 3 * DM + (b) * DM, RS_(2 * ly)}; skinny_gemm(F.lds, XN_ + (size_t)MROW0 * DM, DM, WB_(WB_G) + (size_t)(b) * 2048 * DM, DM, 2048 / 16, (F.bid + (sk)) % F.G, F.G, f); } \
            SchedPlain S{XN_, DM, WB_(WB_G) + (size_t)(b) * 2048 * DM, DM, NPMM, 8, F.G, F.bid, 0}; EpiGate E{(bf16_t*)(ws + WS_GS), arg_in(args, 4) + ly * 3 * DM + (b) * DM, RS_(2 * ly)}; \
            pg8::gemm_phase(F.lds, S, E); \
            if (NREP(k) == 2) { GRID_BAR(); pg8::gemm_phase(F.lds, S, E); } \
            if (seam) SEAM(pb + (k)); \
        }
#define BRANCH_PHASE(k, b, oc, sk, seam) \
        if (((PHMASK >> 10) & 1) && IN(pb + (k))) { \
            PH_BEGIN; \
            { SkGated f{P_, (const bf16_t*)(ws + WS_GS), (b) == 0 ? 1 : 0}; skinny_gemm(F.lds, P_ + (size_t)MROW0 * PW + (oc), PW, WB_(WB_BR) + (size_t)(b) * DM * 1024, 1024, 2048 / 16, (F.bid + (sk)) % F.G, F.G, f); } \
            SchedPlain S{P_ + (oc), PW, WB_(WB_BR) + (size_t)(b) * DM * 1024, 1024, NPMM, 8, F.G, F.bid, C_MERGED}; EpiGated E{P_, (const bf16_t*)(ws + WS_GS), (b) == 0 ? 1 : 0, ((DBG_BM >> (b)) & 1) ? 1.f : 0.f}; \
            pg8::gemm_phase(F.lds, S, E); \
            if (NREP(k) == 2 && (b) == 0) { GRID_BAR(); pg8::gemm_phase(F.lds, S, E); } \
            if (seam) SEAM(pb + (k)); \
        }
        GATE_PHASE(10, 0, 0, 0) BRANCH_PHASE(11, 0, C_OA, 0, 0)
        GATE_PHASE(12, 1, 0, 0) BRANCH_PHASE(13, 1, C_OB, 0, 0)
        GATE_PHASE(14, 2, 0, 1) BRANCH_PHASE(15, 2, C_OC, 128, 1)
        if (((PHMASK >> 11) & 1) && IN(pb + 16)) {
            PH_BEGIN;
            { SkRes f{HMETA_, XN_, RS_(2 * ly + 1)}; skinny_gemm(F.lds, P_ + (size_t)MROW0 * PW + C_MERGED, PW, WB_(WB_O), DM, 2048 / 16, F.bid, F.G, f); }
            SchedPlain S{P_ + C_MERGED, PW, WB_(WB_O), DM, NPMM, 8, F.G, F.bid, 0}; EpiRes E{(float*)nullptr, DBG_SA, XN_, RS_(2 * ly + 1)};
            pg8::gemm_phase(F.lds, S, E);
            SEAM(pb + 16);
        }
        if (((PHMASK >> 13) & 1) && IN(pb + 17)) {
            PH_BEGIN;
            skinny_swiglu(F.lds, XN_ + (size_t)MROW0 * DM, DM, WB_(WB_F1), DM, P_, RS_(2 * ly + 1), F.bid, F.G);
            SchedPlain S{XN_, DM, WB_(WB_F1), DM, NPMM, 44, F.G, F.bid, 0}; EpiSwiglu E{P_, RS_(2 * ly + 1)};
            pg8::gemm_phase(F.lds, S, E);
            if (NREP(17) == 2) { GRID_BAR(); pg8::gemm_phase(F.lds, S, E); }
            SEAM(pb + 17);
        }
        if (((PHMASK >> 14) & 1) && IN(pb + 18)) {
            PH_BEGIN;
            { SkRes f{HMETA_, ly == 0 ? XN_ : (bf16_t*)nullptr, RS_(2)}; skinny_gemm(F.lds, P_ + (size_t)MROW0 * PW, PW, WB_(WB_F2), DFF, 2048 / 16, F.bid, F.G, f); }
            SchedPlain S{P_, PW, WB_(WB_F2), DFF, NPMM, 8, F.G, F.bid, 0}; EpiRes E{ly == 0 ? (float*)nullptr : OUT_, DBG_SF, XN_, RS_(2)};
            pg8::gemm_phase(F.lds, S, E);
            SEAM(pb + 18);
        }
    }
#undef IN
#undef SEAM
}

__global__ void diag_fill(float* out, int n, float v) { for (int i = blockIdx.x * blockDim.x + threadIdx.x; i < n; i += gridDim.x * blockDim.x) out[i] = v; }
extern "C" void kernel_launch(void* const* d_in, const int* in_sizes, int n_in, void* d_out, int out_size, void* d_ws, size_t ws_size, hipStream_t stream) {
    static int grid = 0; static float code = 0.f;
    if (grid == 0) {
        int dev = 0, cus = 0;
        if (n_in != 19) { code = 10.f; grid = -1; }
        else if (ws_size < WS_END) { code = 20.f + (float)(ws_size >> 20) * 0.01f; grid = -1; }
        else if (hipGetDevice(&dev) != hipSuccess || hipDeviceGetAttribute(&cus, hipDeviceAttributeMultiprocessorCount, dev) != hipSuccess) { code = 40.f; grid = -1; }
        else if (hipFuncSetAttribute((const void*)mega_fwd, hipFuncAttributeMaxDynamicSharedMemorySize, LDS_BYTES) != hipSuccess) { code = 50.f; grid = -1; }
        else {
            int per_cu = 0;
            if (hipOccupancyMaxActiveBlocksPerMultiprocessor(&per_cu, (const void*)mega_fwd, NWAVES * 64, LDS_BYTES) != hipSuccess || per_cu < 1) { code = 60.f; grid = -1; }
            (void)hipGetLastError();
            if (grid == 0) grid = cus;
        }
    }
    if (grid < 0) { hipLaunchKernelGGL(diag_fill, dim3(1024), dim3(256), 0, stream, (float*)d_out, out_size, code); return; }
    (void)hipMemsetAsync((char*)d_ws + WS_CTL, 0, CTL_BYTES, stream);
    Args a{};
    for (int i = 0; i < 19; ++i) a.in[i] = (const float*)d_in[i];
    a.out = (float*)d_out; a.ws = (unsigned char*)d_ws;
#if MK_ONE_LAUNCH
    a.ph_lo = 0; a.ph_hi = N_PHASES;
    hipLaunchKernelGGL(mega_fwd, dim3(grid), dim3(NWAVES * 64), LDS_BYTES, stream, a);
#else
    for (int p = 0; p < N_PHASES; ++p) { a.ph_lo = p; a.ph_hi = p + 1; hipLaunchKernelGGL(mega_fwd, dim3(grid), dim3(NWAVES * 64), LDS_BYTES, stream, a); }
#endif
    if (hipPeekAtLastError() != hipSuccess) { (void)hipGetLastError(); hipLaunchKernelGGL(diag_fill, dim3(1024), dim3(256), 0, stream, (float*)d_out, out_size, 70.f); }
}
```

```cpp
#include <hip/hip_runtime.h>
#include <cstdio>
#include <cstdint>

#ifndef PHMASK
#define PHMASK 0x7fff
#endif
#ifndef REPMASK
#define REPMASK 0
#endif
#define NREP(k) ((((REPMASK) >> (k)) & 1) ? 2 : 1)
#ifndef DBG_BM
#define DBG_BM 7
#endif
#ifndef DBG_BR
#define DBG_BR 0
#endif
#ifndef DBG_SA
#define DBG_SA 1.0f
#endif
#ifndef DBG_SF
#define DBG_SF 1.0f
#endif
#ifndef MK_ONE_LAUNCH
#define MK_ONE_LAUNCH 1
#endif

#define LAS __attribute__((address_space(3)))
#define GAS __attribute__((address_space(1)))
typedef unsigned short bf16_t;
typedef short bf16x8 __attribute__((ext_vector_type(8)));
typedef float f32x4 __attribute__((ext_vector_type(4)));
typedef float f32x2 __attribute__((ext_vector_type(2)));
typedef unsigned u32x4 __attribute__((ext_vector_type(4)));
typedef unsigned u32x2 __attribute__((ext_vector_type(2)));
typedef unsigned long long rs_t;
__device__ __forceinline__ float rs_val(rs_t v) { return (float)((double)v * (1.0 / 4294967296.0)); }
__device__ __forceinline__ rs_t rs_fix(float ss) { return (rs_t)((double)ss * 4294967296.0); }
__device__ __forceinline__ void st_wt(void* p, u32x4 v) { typedef __attribute__((address_space(1))) u32x4 gv; *(gv*)(unsigned long long)p = v; }
__device__ __forceinline__ void st_wt(void* p, f32x4 v) { typedef __attribute__((address_space(1))) f32x4 gv; *(gv*)(unsigned long long)p = v; }

constexpr int DM = 2048, NB = 16, SEQ = 2048, NMETA = 16, MBLK = 256;
constexpr int R = MBLK + NB * SEQ;
constexpr int NPM = R / 256;
constexpr int NPMM = NPM - 1;
constexpr int MROW0 = MBLK - NMETA;
constexpr int NTOK = NB * SEQ;
constexpr int DFF = 5632;
constexpr int PW = 8448;
constexpr int C_CQ = 0, C_CKV = 512, C_KPE = 1024, C_IK = 1088, C_IW = 1152, C_DQ = 1280, C_DK = 2304, C_DV = 3328, C_IQ = 4352,
              C_FQ = 5376, C_FK = 6400, C_FV = 7424;
constexpr int C_KVRAW = 1280, C_QRAW = 3328, C_KPEH = 4864;
constexpr int C_OA = 0, C_OB = C_DQ, C_OC = C_FQ, C_MERGED = 2304;
constexpr int BMW = 66;
constexpr float EPS = 1e-6f;
constexpr float LOG2E = 1.4426950408889634f;
constexpr float C2_128 = 0.08838834764831845f * LOG2E;
constexpr float C2_192 = 0.07216878364870323f * LOG2E;
constexpr int D_IN = 14480;

constexpr size_t MiB = 1u << 20;
constexpr size_t WS_CTL = 0, CTL_BYTES = 2816 * 1024;
constexpr size_t WS_RSTD = 13 * MiB;
constexpr size_t WS_HMETA = 14 * MiB;
constexpr size_t WS_BM = 4 * MiB;
constexpr size_t WS_WB = 16 * MiB;
constexpr size_t WB_IN = 0, WB_G = WB_IN + (size_t)8448 * 2048 * 2, WB_QUP = WB_G + (size_t)6144 * 2048 * 2, WB_KVUP = WB_QUP + (size_t)1536 * 512 * 2,
                 WB_BR = WB_KVUP + (size_t)2048 * 512 * 2, WB_O = WB_BR + (size_t)3 * 2048 * 1024 * 2, WB_F1 = WB_O + (size_t)2048 * 2048 * 2,
                 WB_F2 = WB_F1 + (size_t)11264 * 2048 * 2, WB_END = WB_F2 + (size_t)2048 * 5632 * 2;
constexpr size_t WS_XN = 164 * MiB;
constexpr size_t WS_P = 294 * MiB;
constexpr size_t WS_GS = 828 * MiB;
constexpr size_t WS_END = 960 * MiB;
static_assert(WS_GS + (size_t)R * 2048 * 2 <= WS_END && WS_WB + WB_END <= WS_XN && WS_XN + (size_t)R * 2048 * 2 <= WS_P && WS_P + (size_t)R * PW * 2 <= WS_GS, "ws map");
constexpr int CW_BAR = 4096, CW_Q = 16384;
constexpr size_t WS_RS = 256 * 1024;
constexpr size_t WS_RS2 = 1536 * 1024;
static_assert(WS_RS + (size_t)4 * R * 8 <= WS_RS2 && WS_RS2 + (size_t)4 * R * 8 <= CTL_BYTES && CTL_BYTES <= WS_BM && WS_BM + (size_t)32768 * BMW * 4 <= WS_RSTD && WS_RSTD + 1 * MiB <= WS_HMETA && WS_HMETA + 2 * MiB <= WS_WB, "ctl map");

__device__ __forceinline__ float bf2f(bf16_t v) { return __uint_as_float((unsigned)v << 16); }
__device__ __forceinline__ unsigned f2bf(float f) { unsigned u = __float_as_uint(f); return (u + 0x7fffu + ((u >> 16) & 1u)) >> 16; }
__device__ __forceinline__ unsigned pk2(float lo, float hi) { return f2bf(lo) | (f2bf(hi) << 16); }
typedef __bf16 bf16x2_t __attribute__((ext_vector_type(2)));
__device__ __forceinline__ unsigned cvt_pk_bf16(float lo, float hi) { f32x2 v = {lo, hi}; bf16x2_t b = __builtin_convertvector(v, bf16x2_t); return __builtin_bit_cast(unsigned, b); }
__device__ __forceinline__ float wave_sum(float v) {
#pragma unroll
    for (int o = 1; o < 64; o <<= 1) v += __shfl_xor(v, o);
    return v;
}
__device__ __forceinline__ float wave_max(float v) {
#pragma unroll
    for (int o = 1; o < 64; o <<= 1) v = fmaxf(v, __shfl_xor(v, o));
    return v;
}
#define LDS_WAIT() asm volatile("s_waitcnt lgkmcnt(0)" ::: "memory")
#define VM_WAIT() asm volatile("s_waitcnt vmcnt(0)" ::: "memory")
__device__ __forceinline__ int row_pos(int r) { return r < MBLK ? (r >= MBLK - NMETA ? r - (MBLK - NMETA) : 0) : NMETA + ((r - MBLK) & (SEQ - 1)); }
__device__ __forceinline__ void rope_cs(int pos, int i, float two_over_d, float& c, float& s) {
    const float inv = __builtin_amdgcn_exp2f(-(float)i * two_over_d * 13.287712379549449f);
    float rev = (float)pos * inv * 0.15915494309189535f;
    rev -= floorf(rev);
    s = __builtin_amdgcn_sinf(rev); c = __builtin_amdgcn_cosf(rev);
}

namespace pg8 {
constexpr int BM = 256, BK = 64, HALF = 128, HTB = HALF * BK * 2, STAGE_BYTES = 8 * HTB;
__device__ __forceinline__ int lds_byte(int r, int c) { const int st = (r >> 4) * 2 + (c >> 5), rr = r & 15, cc = c & 31, ob = rr * 64 + cc * 2; return st * 1024 + (ob ^ (((ob >> 9) & 1) << 5)); }
__device__ __forceinline__ void stage_rc(int b, int& R_, int& C_) { const int st = b / 1024, sb = b % 1024, swz = sb ^ (((sb >> 9) & 1) << 5); R_ = (st >> 1) * 16 + swz / 64; C_ = (st & 1) * 32 + (swz % 64) / 2; }
__device__ __forceinline__ int perm32(int rho) { const int n = rho >> 4, i = rho & 15; return 8 * (i >> 2) + 4 * n + (i & 3); }

struct Unit { const char* A; const char* B; unsigned lda2, ldb2; int nt, pm, pn, kind, ocol; };

#ifndef WGM
#define WGM 4
#endif
__device__ __forceinline__ void tile_of(int L, int nM, int nN, int& pm, int& pn) {
    const int nwg = nM * nN; int wgid = L;
    { const int q = nwg / 8, r = nwg % 8, xcd = wgid % 8, off = wgid / 8; wgid = (xcd < r ? xcd * (q + 1) : r * (q + 1) + (xcd - r) * q) + off; }
    const int nig = WGM * nN, gid = wgid / nig, fm = gid * WGM, gsz = (nM - fm) < WGM ? (nM - fm) : WGM;
    pm = fm + ((wgid % nig) % gsz); pn = (wgid % nig) / gsz;
}

template <class Epi, class Sched>
__device__ __forceinline__ void gemm_phase(LAS unsigned char* lds, const Sched& S, const Epi& E) {
    int tid = threadIdx.x; asm volatile("" : "+v"(tid));
    const int wid = __builtin_amdgcn_readfirstlane(tid >> 6), lane = tid & 63, wr = wid >> 2, wc = wid & 3, fr = lane & 15, fq = lane >> 4;
    unsigned rA[2], rB[2], cc[2];
#pragma unroll
    for (int i = 0; i < 2; ++i) { int R_, C_; stage_rc(tid * 16 + i * 8192, R_, C_); rA[i] = (unsigned)R_; rB[i] = (unsigned)(Epi::PERM ? ((R_ & ~31) + perm32(R_ & 31)) : R_); cc[i] = (unsigned)C_ * 2u; }
    const size_t kstep = (size_t)(BK * 2);
    const unsigned ldsw = (unsigned)wid * 1024u;
    const int aoff = lds_byte(wr * 64 + fr, fq * 8), boff = lds_byte(wc * 32 + fr, fq * 8);
#define PG8_SA(b, h) (((b) * 2 + (h)) * HTB)
#define PG8_SB(b, h) ((4 + (b) * 2 + (h)) * HTB)
#define PG8_STAGE(bufoff, gbase, rr, ld2) do { _Pragma("unroll") for (int _i = 0; _i < 2; ++_i) \
        __builtin_amdgcn_global_load_lds((const unsigned*)((const char*)(gbase) + ((rr)[_i] * (ld2) + cc[_i])), (LAS unsigned*)(lds + (bufoff) + ldsw + _i * 8192), 16, 0, 0); } while (0)
#define PG8_LDA(dst, b, h) do { _Pragma("unroll") for (int m = 0; m < 4; ++m) _Pragma("unroll") for (int k = 0; k < 2; ++k) dst[m][k] = *(const LAS bf16x8*)(lds + PG8_SA(b, h) + aoff + m * 2048 + k * 1024); } while (0)
#define PG8_LDB(dst, b, h) do { _Pragma("unroll") for (int n = 0; n < 2; ++n) _Pragma("unroll") for (int k = 0; k < 2; ++k) dst[n][k] = *(const LAS bf16x8*)(lds + PG8_SB(b, h) + boff + n * 2048 + k * 1024); } while (0)
#define PG8_MMA(ai, bj, At, Bt) do { __builtin_amdgcn_s_setprio(1); _Pragma("unroll") for (int m = 0; m < 4; ++m) _Pragma("unroll") for (int n = 0; n < 2; ++n) _Pragma("unroll") for (int k = 0; k < 2; ++k) \
        acc[ai][bj][m][n] = __builtin_amdgcn_mfma_f32_16x16x32_bf16(Bt[n][k], At[m][k], acc[ai][bj][m][n], 0, 0, 0); __builtin_amdgcn_s_setprio(0); } while (0)
#define PG8_WAIT_V(n) asm volatile("s_waitcnt vmcnt(" #n ")" ::: "memory")
#define PG8_WAIT_L(n) asm volatile("s_waitcnt lgkmcnt(" #n ")" ::: "memory")
#define PG8_BAR __builtin_amdgcn_s_barrier()
#define PG8_SCHED __builtin_amdgcn_sched_barrier(0)
    Unit cur, nxt; int ui = 0;
    if (!S.next(0, cur)) return;
    float zf = 0.f; asm volatile("" : "+v"(zf));
    f32x4 acc[2][2][4][2];
#pragma unroll
    for (int a = 0; a < 2; ++a)
#pragma unroll
        for (int b = 0; b < 2; ++b)
#pragma unroll
            for (int m = 0; m < 4; ++m)
#pragma unroll
                for (int n = 0; n < 2; ++n) acc[a][b][m][n] = (f32x4){zf, zf, zf, zf};
    rs_t pre[8] = {0, 0, 0, 0, 0, 0, 0, 0}; E.prefetch(cur, wr, fr, pre);
    bf16x8 At[4][2], B0[2][2], B1[2][2];
    const char* cA = cur.A; const char* cB = cur.B;
    unsigned lA = cur.lda2, lB = cur.ldb2;
    size_t hA = (size_t)HALF * lA, hB = (size_t)HALF * lB;
    PG8_STAGE(PG8_SB(0, 0), cB, rB, lB); PG8_STAGE(PG8_SB(0, 1), cB + hB, rB, lB); PG8_STAGE(PG8_SA(0, 0), cA, rA, lA); PG8_STAGE(PG8_SA(0, 1), cA + hA, rA, lA);
    if (wr == 1) PG8_BAR;
    PG8_WAIT_V(2); PG8_BAR;
    PG8_STAGE(PG8_SB(1, 0), cB + kstep, rB, lB); PG8_STAGE(PG8_SA(1, 0), cA + kstep, rA, lA); PG8_STAGE(PG8_SB(1, 1), cB + hB + kstep, rB, lB);
    PG8_WAIT_V(6); PG8_BAR;
    for (;;) {
        const bool has_next = S.next(ui + 1, nxt);
        if (!has_next) nxt = cur;
        const char* nA = nxt.A; const char* nB = nxt.B;
        const unsigned lAn = nxt.lda2, lBn = nxt.ldb2;
        const size_t hAn = (size_t)HALF * lAn, hBn = (size_t)HALF * lBn;
        const int nt = cur.nt;
        for (int t = 0; t < nt; t += 2) {
            const bool last = (t == nt - 2);
            const char* a1 = cA + (size_t)(t + 1) * kstep;
            const char* a2 = last ? nA : cA + (size_t)(t + 2) * kstep; const char* b2 = last ? nB : cB + (size_t)(t + 2) * kstep;
            const char* a3 = a2 + kstep; const char* b3 = b2 + kstep;
            const size_t hA2 = last ? hAn : hA, hB2 = last ? hBn : hB;
            const unsigned lA2 = last ? lAn : lA, lB2 = last ? lBn : lB;
            PG8_LDB(B0, 0, 0); PG8_LDB(B1, 0, 1); PG8_SCHED; PG8_LDA(At, 0, 0); PG8_STAGE(PG8_SA(1, 1), a1 + hA, rA, lA);
            PG8_WAIT_V(8); PG8_WAIT_L(0); PG8_BAR; PG8_MMA(0, 0, At, B0); PG8_MMA(0, 1, At, B1); PG8_BAR; PG8_SCHED;
            PG8_LDA(At, 0, 1); PG8_STAGE(PG8_SB(0, 0), b2, rB, lB2); PG8_STAGE(PG8_SB(0, 1), b2 + hB2, rB, lB2); PG8_STAGE(PG8_SA(0, 0), a2, rA, lA2);
            PG8_WAIT_V(8); PG8_WAIT_L(0); PG8_BAR; PG8_MMA(1, 0, At, B0); PG8_MMA(1, 1, At, B1); PG8_BAR; PG8_SCHED;
            PG8_LDB(B0, 1, 0); PG8_LDB(B1, 1, 1); PG8_SCHED; PG8_LDA(At, 1, 0); PG8_STAGE(PG8_SA(0, 1), a2 + hA2, rA, lA2);
            PG8_WAIT_V(8); PG8_WAIT_L(0); PG8_BAR; PG8_MMA(0, 0, At, B0); PG8_MMA(0, 1, At, B1); PG8_BAR; PG8_SCHED;
            PG8_LDA(At, 1, 1); PG8_STAGE(PG8_SB(1, 0), b3, rB, lB2); PG8_STAGE(PG8_SB(1, 1), b3 + hB2, rB, lB2); PG8_STAGE(PG8_SA(1, 0), a3, rA, lA2);
            PG8_WAIT_V(8); PG8_WAIT_L(0); PG8_BAR; PG8_MMA(1, 0, At, B0); PG8_MMA(1, 1, At, B1); PG8_BAR; PG8_SCHED;
        }
        if (wr == 0) PG8_BAR;
        E(acc, cur, wr, wc, fr, fq, pre);
#pragma unroll
        for (int a = 0; a < 2; ++a)
#pragma unroll
            for (int b = 0; b < 2; ++b)
#pragma unroll
                for (int m = 0; m < 4; ++m)
#pragma unroll
                    for (int n = 0; n < 2; ++n) acc[a][b][m][n] = (f32x4){zf, zf, zf, zf};
        if (!has_next) break;
        cur = nxt; cA = nA; cB = nB; hA = hAn; hB = hBn; lA = lAn; lB = lBn; ++ui;
        E.prefetch(cur, wr, fr, pre);
        if (wr == 1) PG8_BAR;
    }
    PG8_WAIT_V(0);
    PG8_BAR;
#undef PG8_SA
#undef PG8_SB
#undef PG8_STAGE
#undef PG8_LDA
#undef PG8_LDB
#undef PG8_MMA
#undef PG8_WAIT_V
#undef PG8_WAIT_L
#undef PG8_BAR
#undef PG8_SCHED
}
}
using pg8::Unit;

struct SchedPlain {
    const bf16_t* A; int lda; const bf16_t* B; int K; int nM, nN, G, c, ocol0;
    __device__ __forceinline__ bool next(int i, Unit& u) const {
        const int L = i * G + c; if (L >= nM * nN) return false;
        int pm, pn; pg8::tile_of(L, nM, nN, pm, pn); pm += 1;
        u.pm = pm; u.pn = pn; u.kind = 0; u.ocol = ocol0 + 256 * pn; u.nt = K / 64; u.lda2 = (unsigned)lda * 2u; u.ldb2 = (unsigned)K * 2u;
        u.A = (const char*)(A + (size_t)pm * 256 * lda); u.B = (const char*)(B + (size_t)pn * 256 * K); return true;
    }
};
struct SchedMlaUp {
    const bf16_t* P; const bf16_t* Wq; const bf16_t* Wkv; int G, c;
    __device__ __forceinline__ bool next(int i, Unit& u) const {
        const int L = i * G + c; if (L >= NPMM * 14) return false;
        int pm, pn; pg8::tile_of(L, NPMM, 14, pm, pn); pm += 1;
        u.pm = pm; u.pn = pn; u.kind = 0; u.nt = 8; u.lda2 = PW * 2u; u.ldb2 = 512 * 2u;
        if (pn < 6) { u.A = (const char*)(P + (size_t)pm * 256 * PW + C_CQ); u.B = (const char*)(Wq + (size_t)pn * 256 * 512); u.ocol = C_QRAW + 256 * pn; }
        else { u.A = (const char*)(P + (size_t)pm * 256 * PW + C_CKV); u.B = (const char*)(Wkv + (size_t)(pn - 6) * 256 * 512); u.ocol = C_KVRAW + 256 * (pn - 6); }
        return true;
    }
};
template <bool SUMS> struct EpiP {
    static constexpr bool PERM = true;
    bf16_t* P; const rs_t* rs; const rs_t* rs2; int split; float inv_dim; rs_t* sq; rs_t* skv;
    __device__ __forceinline__ void prefetch(const Unit& u, int wr, int fr, rs_t (&pre)[8]) const { const rs_t* r_ = (u.pn < split ? rs : rs2); if (r_) { r_ += u.pm * 256 + wr * 64 + fr;
#pragma unroll
        for (int i = 0; i < 8; ++i) pre[i] = r_[(i >> 2) * 128 + (i & 3) * 16]; } }
    __device__ __forceinline__ void operator()(const f32x4 (&acc)[2][2][4][2], const Unit& u, int wr, int wc, int fr, int fq, const rs_t (&pre)[8]) const {
        asm volatile("" : "+v"(fr), "+v"(fq));
        const int row0 = u.pm * 256 + wr * 64 + fr, col0 = u.ocol + wc * 32 + 8 * fq;
        const rs_t* rsel = u.pn < split ? rs : rs2;
        rs_t* sums = (SUMS && u.pn < 4) ? (u.pn < 2 ? sq : skv) : (rs_t*)nullptr;
        float rsc[2][4];
#pragma unroll
        for (int ai = 0; ai < 2; ++ai)
#pragma unroll
            for (int m = 0; m < 4; ++m) rsc[ai][m] = rsel ? __builtin_amdgcn_rsqf(rs_val(pre[ai * 4 + m]) * inv_dim + EPS) : 1.f;
#pragma unroll
        for (int ai = 0; ai < 2; ++ai)
#pragma unroll
            for (int m = 0; m < 4; ++m) { const int row = row0 + ai * 128 + m * 16; bf16_t* rowp = P + (size_t)row * PW + col0;
                const float sc = rsc[ai][m]; float ss = 0.f;
#pragma unroll
                for (int bj = 0; bj < 2; ++bj) { const f32x4 v0 = acc[ai][bj][m][0] * sc, v1 = acc[ai][bj][m][1] * sc;
                    if (SUMS) ss += ((v0[0] * v0[0] + v0[1] * v0[1]) + (v0[2] * v0[2] + v0[3] * v0[3])) + ((v1[0] * v1[0] + v1[1] * v1[1]) + (v1[2] * v1[2] + v1[3] * v1[3]));
                    u32x4 w; w.x = cvt_pk_bf16(v0[0], v0[1]); w.y = cvt_pk_bf16(v0[2], v0[3]); w.z = cvt_pk_bf16(v1[0], v1[1]); w.w = cvt_pk_bf16(v1[2], v1[3]);
                    st_wt(rowp + bj * 128, w); }
                if (SUMS && sums) { ss += __shfl_xor(ss, 16); ss += __shfl_xor(ss, 32); if (fq == 0) (void)__hip_atomic_fetch_add(sums + row, rs_fix(ss), __ATOMIC_RELAXED, __HIP_MEMORY_SCOPE_AGENT); } }
    }
};
struct EpiG2 {
    static constexpr bool PERM = true;
    bf16_t* P; const rs_t* rs; const float* gperm; LAS float* xl;
    __device__ __forceinline__ void prefetch(const Unit& u, int wr, int fr, rs_t (&pre)[8]) const { const rs_t* r_ = rs; if (r_) { r_ += u.pm * 256 + wr * 64 + fr;
#pragma unroll
        for (int i = 0; i < 8; ++i) pre[i] = r_[(i >> 2) * 128 + (i & 3) * 16]; } }
    __device__ __forceinline__ void operator()(const f32x4 (&acc)[2][2][4][2], const Unit& u, int wr, int wc, int fr, int fq, const rs_t (&pre)[8]) const {
        asm volatile("" : "+v"(fr), "+v"(fq));
        const int row0 = u.pm * 256 + wr * 64 + fr, lcol = wc * 32 + 8 * fq, col0 = u.ocol + lcol;
        const int pn = u.pn;
        const bool plain = (pn >= 8 && pn < 12) || pn >= 24, isidx = (pn >= 12 && pn < 16), nrm = !plain && !isidx;
        const int gidx = pn < 4 ? 0 : (pn < 8 ? 1 : (pn < 20 ? 2 : 3));
        f32x4 g0 = (f32x4){1.f, 1.f, 1.f, 1.f}, g1 = g0;
        if (nrm) { g0 = *(const f32x4*)(gperm + gidx * 128 + lcol); g1 = *(const f32x4*)(gperm + gidx * 128 + lcol + 4); }
        float rsc[2][4];
#pragma unroll
        for (int ai = 0; ai < 2; ++ai)
#pragma unroll
            for (int m = 0; m < 4; ++m) rsc[ai][m] = __builtin_amdgcn_rsqf(rs_val(pre[ai * 4 + m]) * (1.f / DM) + EPS);
        if (nrm) {
#pragma unroll
            for (int ai = 0; ai < 2; ++ai)
#pragma unroll
                for (int m = 0; m < 4; ++m)
#pragma unroll
                    for (int bj = 0; bj < 2; ++bj) { const f32x4 a = acc[ai][bj][m][0], b = acc[ai][bj][m][1]; float ss = (a[0] * a[0] + a[1] * a[1]) + (a[2] * a[2] + a[3] * a[3]) + (b[0] * b[0] + b[1] * b[1]) + (b[2] * b[2] + b[3] * b[3]);
                        ss += __shfl_xor(ss, 16); ss += __shfl_xor(ss, 32);
                        if (fq == 0) xl[((wr * 64 + fr + ai * 128 + m * 16) * 2 + bj) * 4 + wc] = ss * rsc[ai][m] * rsc[ai][m]; }
            asm volatile("s_waitcnt lgkmcnt(0)" ::: "memory"); __builtin_amdgcn_s_barrier(); asm volatile("" ::: "memory");
        }
        const int i0 = isidx ? (16 * (wc & 1) + 4 * fq) : (16 * wc + 4 * fq);
        const float tod = isidx ? (2.f / 64.f) : (2.f / 128.f);
        float inv[4];
#pragma unroll
        for (int j = 0; j < 4; ++j) inv[j] = __builtin_amdgcn_exp2f(-(float)(i0 + j) * tod * 13.287712379549449f) * 0.15915494309189535f;
        const float qscale = (pn < 4 || (pn >= 16 && pn < 20)) ? C2_128 : 1.f;
#pragma unroll
        for (int ai = 0; ai < 2; ++ai)
#pragma unroll
            for (int m = 0; m < 4; ++m) { const int row = row0 + ai * 128 + m * 16; bf16_t* rowp = P + (size_t)row * PW + col0;
                float cs[4], sn[4];
                if (!plain) { const float pos = (float)(NMETA + ((row - MBLK) & (SEQ - 1)));
#pragma unroll
                    for (int j = 0; j < 4; ++j) { float rev = pos * inv[j]; rev -= floorf(rev); sn[j] = __builtin_amdgcn_sinf(rev); cs[j] = __builtin_amdgcn_cosf(rev); } }
#pragma unroll
                for (int bj = 0; bj < 2; ++bj) { f32x4 v0 = acc[ai][bj][m][0] * rsc[ai][m], v1 = acc[ai][bj][m][1] * rsc[ai][m];
                    if (!plain) {
                        if (nrm) { const LAS f32x4* xp = (const LAS f32x4*)(xl + ((wr * 64 + fr + ai * 128 + m * 16) * 2 + bj) * 4); const f32x4 pp = *xp;
                            const float rn = __builtin_amdgcn_rsqf(((pp[0] + pp[1]) + (pp[2] + pp[3])) * (1.f / 128.f) + EPS); v0 = v0 * (g0 * rn); v1 = v1 * (g1 * rn); }
                        f32x4 w0, w1;
                        w0[0] = v0[0] * cs[0] - v0[1] * sn[0]; w0[1] = v0[1] * cs[0] + v0[0] * sn[0]; w0[2] = v0[2] * cs[1] - v0[3] * sn[1]; w0[3] = v0[3] * cs[1] + v0[2] * sn[1];
                        w1[0] = v1[0] * cs[2] - v1[1] * sn[2]; w1[1] = v1[1] * cs[2] + v1[0] * sn[2]; w1[2] = v1[2] * cs[3] - v1[3] * sn[3]; w1[3] = v1[3] * cs[3] + v1[2] * sn[3];
                        v0 = w0 * qscale; v1 = w1 * qscale; }
                    u32x4 w; w.x = cvt_pk_bf16(v0[0], v0[1]); w.y = cvt_pk_bf16(v0[2], v0[3]); w.z = cvt_pk_bf16(v1[0], v1[1]); w.w = cvt_pk_bf16(v1[2], v1[3]);
                    st_wt(rowp + bj * 128, w); } }
    }
};
struct EpiGate {
    static constexpr bool PERM = true;
    bf16_t* G; const float* bias; const rs_t* rs;
    __device__ __forceinline__ void prefetch(const Unit& u, int wr, int fr, rs_t (&pre)[8]) const { const rs_t* r_ = rs; if (r_) { r_ += u.pm * 256 + wr * 64 + fr;
#pragma unroll
        for (int i = 0; i < 4; ++i) pre[i] = r_[i * 16]; } }
    __device__ __forceinline__ void operator()(const f32x4 (&acc)[2][2][4][2], const Unit& u, int wr, int wc, int fr, int fq, const rs_t (&pre)[8]) const {
        asm volatile("" : "+v"(fr), "+v"(fq));
        const int row0 = u.pm * 256 + wr * 64 + fr, col0 = u.pn * 256 + wc * 32 + 8 * fq;
        rs_t q1[4];
#pragma unroll
        for (int m = 0; m < 4; ++m) q1[m] = rs[row0 + 128 + m * 16];
        f32x4 bq[2][2];
#pragma unroll
        for (int bj = 0; bj < 2; ++bj) { bq[bj][0] = *(const f32x4*)(bias + col0 + bj * 128); bq[bj][1] = *(const f32x4*)(bias + col0 + bj * 128 + 4); }
#pragma unroll
        for (int ai = 0; ai < 2; ++ai) {
#pragma unroll
            for (int bj = 0; bj < 2; ++bj) { const f32x4 bv0 = bq[bj][0], bv1 = bq[bj][1];
#pragma unroll
                for (int m = 0; m < 4; ++m) { bf16_t* rowp = G + (size_t)(row0 + ai * 128 + m * 16) * 2048 + col0; const float sc = __builtin_amdgcn_rsqf(rs_val(ai == 0 ? pre[m] : q1[m]) * (1.f / DM) + EPS); f32x4 v0 = acc[ai][bj][m][0] * sc + bv0, v1 = acc[ai][bj][m][1] * sc + bv1;
#pragma unroll
                    for (int e = 0; e < 4; ++e) { v0[e] = __builtin_amdgcn_rcpf(1.f + __builtin_amdgcn_exp2f(-v0[e] * LOG2E)); v1[e] = __builtin_amdgcn_rcpf(1.f + __builtin_amdgcn_exp2f(-v1[e] * LOG2E)); }
                    u32x4 w; w.x = cvt_pk_bf16(v0[0], v0[1]); w.y = cvt_pk_bf16(v0[2], v0[3]); w.z = cvt_pk_bf16(v1[0], v1[1]); w.w = cvt_pk_bf16(v1[2], v1[3]);
                    st_wt(rowp + bj * 128, w); } } }
    }
};
struct EpiGated {
    static constexpr bool PERM = true;
    bf16_t* P; const bf16_t* G; int first; float sc;
    __device__ __forceinline__ void prefetch(const Unit&, int, int, rs_t (&)[8]) const {}
    __device__ __forceinline__ void operator()(const f32x4 (&acc)[2][2][4][2], const Unit& u, int wr, int wc, int fr, int fq, const rs_t (&pre)[8]) const {
        asm volatile("" : "+v"(fr), "+v"(fq));
        const int row0 = u.pm * 256 + wr * 64 + fr, lcol0 = u.pn * 256 + wc * 32 + 8 * fq, col0 = u.ocol + wc * 32 + 8 * fq;
        unsigned zu = 0u; asm volatile("" : "+v"(zu));
#pragma unroll
        for (int ai = 0; ai < 2; ++ai) {
            u32x4 gq[4][2], pq[4][2];
#pragma unroll
            for (int m = 0; m < 4; ++m)
#pragma unroll
                for (int bj = 0; bj < 2; ++bj) { gq[m][bj] = *(const u32x4*)(G + (size_t)(row0 + ai * 128 + m * 16) * 2048 + lcol0 + bj * 128); if (DBG_BR == 1) gq[m][bj] = (u32x4){0x3f803f80u, 0x3f803f80u, 0x3f803f80u, 0x3f803f80u};
                    pq[m][bj] = (u32x4){zu, zu, zu, zu}; if (!first) pq[m][bj] = *(const u32x4*)(P + (size_t)(row0 + ai * 128 + m * 16) * PW + col0 + bj * 128); }
#pragma unroll
            for (int m = 0; m < 4; ++m) { bf16_t* rowp = P + (size_t)(row0 + ai * 128 + m * 16) * PW + col0;
#pragma unroll
                for (int bj = 0; bj < 2; ++bj) { const u32x4 g = gq[m][bj], pv = pq[m][bj];
                    const f32x4 v0 = acc[ai][bj][m][0] * sc, v1 = acc[ai][bj][m][1] * sc;
                    float o[8];
                    o[0] = __uint_as_float(pv.x << 16) + __uint_as_float(g.x << 16) * v0[0]; o[1] = __uint_as_float(pv.x & 0xffff0000u) + __uint_as_float(g.x & 0xffff0000u) * v0[1];
                    o[2] = __uint_as_float(pv.y << 16) + __uint_as_float(g.y << 16) * v0[2]; o[3] = __uint_as_float(pv.y & 0xffff0000u) + __uint_as_float(g.y & 0xffff0000u) * v0[3];
                    o[4] = __uint_as_float(pv.z << 16) + __uint_as_float(g.z << 16) * v1[0]; o[5] = __uint_as_float(pv.z & 0xffff0000u) + __uint_as_float(g.z & 0xffff0000u) * v1[1];
                    o[6] = __uint_as_float(pv.w << 16) + __uint_as_float(g.w << 16) * v1[2]; o[7] = __uint_as_float(pv.w & 0xffff0000u) + __uint_as_float(g.w & 0xffff0000u) * v1[3];
                    u32x4 w; w.x = cvt_pk_bf16(o[0], o[1]); w.y = cvt_pk_bf16(o[2], o[3]); w.z = cvt_pk_bf16(o[4], o[5]); w.w = cvt_pk_bf16(o[6], o[7]);
                    st_wt(rowp + bj * 128, w); } }
            asm volatile("" ::: "memory"); }
    }
};
struct EpiRes {
    static constexpr bool PERM = true;
    float* out_f; float dbg; bf16_t* hb; rs_t* rs;
    __device__ __forceinline__ void prefetch(const Unit&, int, int, rs_t (&)[8]) const {}
    __device__ __forceinline__ void operator()(const f32x4 (&acc)[2][2][4][2], const Unit& u, int wr, int wc, int fr, int fq, const rs_t (&pre)[8]) const {
        asm volatile("" : "+v"(fr), "+v"(fq));
        const int lrow0 = wr * 64 + fr, col0 = u.pn * 256 + wc * 32 + 8 * fq;
        bf16_t* hp0 = hb + (size_t)(u.pm * 256 + lrow0) * DM + col0;
        u32x4 bw[2][4][2];
#pragma unroll
        for (int ai = 0; ai < 2; ++ai)
#pragma unroll
            for (int m = 0; m < 4; ++m)
#pragma unroll
                for (int bj = 0; bj < 2; ++bj) bw[ai][m][bj] = *(const u32x4*)(hp0 + (size_t)(ai * 128 + m * 16) * DM + bj * 128);
#pragma unroll
        for (int ai = 0; ai < 2; ++ai)
#pragma unroll
            for (int m = 0; m < 4; ++m) { const int lrow = lrow0 + ai * 128 + m * 16, grow = u.pm * 256 + lrow;
                const size_t foff = ((size_t)(u.pm - 1) * 256 + lrow) * DM + col0; bf16_t* hp = hp0 + (size_t)(ai * 128 + m * 16) * DM; float ss = 0.f;
#pragma unroll
                for (int bj = 0; bj < 2; ++bj) { const u32x4 w = bw[ai][m][bj];
                    const f32x4 b0 = (f32x4){__uint_as_float(w.x << 16), __uint_as_float(w.x & 0xffff0000u), __uint_as_float(w.y << 16), __uint_as_float(w.y & 0xffff0000u)};
                    const f32x4 b1 = (f32x4){__uint_as_float(w.z << 16), __uint_as_float(w.z & 0xffff0000u), __uint_as_float(w.w << 16), __uint_as_float(w.w & 0xffff0000u)};
                    const f32x4 h0 = b0 + acc[ai][bj][m][0] * dbg, h1 = b1 + acc[ai][bj][m][1] * dbg;
                    if (out_f) { st_wt(out_f + foff + bj * 128, h0); st_wt(out_f + foff + bj * 128 + 4, h1); }
                    else { ss += ((h0[0] * h0[0] + h0[1] * h0[1]) + (h0[2] * h0[2] + h0[3] * h0[3])) + ((h1[0] * h1[0] + h1[1] * h1[1]) + (h1[2] * h1[2] + h1[3] * h1[3]));
                        u32x4 o; o.x = cvt_pk_bf16(h0[0], h0[1]); o.y = cvt_pk_bf16(h0[2], h0[3]); o.z = cvt_pk_bf16(h1[0], h1[1]); o.w = cvt_pk_bf16(h1[2], h1[3]); st_wt(hp + bj * 128, o); } }
                if (!out_f) { ss += __shfl_xor(ss, 16); ss += __shfl_xor(ss, 32); if (fq == 0) (void)__hip_atomic_fetch_add(rs + grow, rs_fix(ss), __ATOMIC_RELAXED, __HIP_MEMORY_SCOPE_AGENT); } }
    }
};
struct EpiSwiglu {
    static constexpr bool PERM = true;
    bf16_t* P; const rs_t* rs;
    __device__ __forceinline__ void prefetch(const Unit& u, int wr, int fr, rs_t (&pre)[8]) const { const rs_t* r_ = rs; if (r_) { r_ += u.pm * 256 + wr * 64 + fr;
#pragma unroll
        for (int i = 0; i < 8; ++i) pre[i] = r_[(i >> 2) * 128 + (i & 3) * 16]; } }
    __device__ __forceinline__ void operator()(const f32x4 (&acc)[2][2][4][2], const Unit& u, int wr, int wc, int fr, int fq, const rs_t (&pre)[8]) const {
        asm volatile("" : "+v"(fr), "+v"(fq));
        const int row0 = u.pm * 256 + wr * 64 + fr, col0 = u.pn * 128 + wc * 32 + 8 * fq;
#pragma unroll
        for (int ai = 0; ai < 2; ++ai)
#pragma unroll
            for (int m = 0; m < 4; ++m) { bf16_t* rowp = P + (size_t)(row0 + ai * 128 + m * 16) * PW + col0;
                const float sc = __builtin_amdgcn_rsqf(rs_val(pre[ai * 4 + m]) * (1.f / DM) + EPS);
                float o[8];
#pragma unroll
                for (int n = 0; n < 2; ++n)
#pragma unroll
                    for (int e = 0; e < 4; ++e) { const float g = acc[ai][0][m][n][e] * sc, up = acc[ai][1][m][n][e] * sc; o[n * 4 + e] = g * __builtin_amdgcn_rcpf(1.f + __builtin_amdgcn_exp2f(-g * LOG2E)) * up; }
                u32x4 w; w.x = cvt_pk_bf16(o[0], o[1]); w.y = cvt_pk_bf16(o[2], o[3]); w.z = cvt_pk_bf16(o[4], o[5]); w.w = cvt_pk_bf16(o[6], o[7]);
                st_wt(rowp, w); }
    }
};

struct SkP { bf16_t* P; int ocol; const rs_t* rs; float inv_dim; rs_t* sq; rs_t* skv; struct Pre { rs_t q[4]; };
    __device__ __forceinline__ void load(int r0, int, Pre& p) const { if (rs) {
#pragma unroll
        for (int r = 0; r < 4; ++r) p.q[r] = rs[MROW0 + r0 + r]; } }
    __device__ __forceinline__ void apply(int r0, int c, f32x4 v, const Pre& p) const {
        rs_t* sums = (sq && c < 1024) ? (c < 512 ? sq : skv) : (rs_t*)nullptr;
#pragma unroll
        for (int r = 0; r < 4; ++r) { float x = v[r]; if (rs) x *= __builtin_amdgcn_rsqf(rs_val(p.q[r]) * inv_dim + EPS); P[(size_t)(MROW0 + r0 + r) * PW + ocol + c] = (bf16_t)f2bf(x);
            if (sums) { float ss = x * x; ss += __shfl_xor(ss, 1); ss += __shfl_xor(ss, 2); ss += __shfl_xor(ss, 4); ss += __shfl_xor(ss, 8);
                if ((threadIdx.x & 15) == 0) (void)__hip_atomic_fetch_add(sums + MROW0 + r0 + r, rs_fix(ss), __ATOMIC_RELAXED, __HIP_MEMORY_SCOPE_AGENT); } } } };
struct SkGate { bf16_t* G; const float* bias; const rs_t* rs; struct Pre { rs_t q[4]; float b; };
    __device__ __forceinline__ void load(int r0, int c, Pre& p) const { p.b = bias[c];
#pragma unroll
        for (int r = 0; r < 4; ++r) p.q[r] = rs[MROW0 + r0 + r]; }
    __device__ __forceinline__ void apply(int r0, int c, f32x4 v, const Pre& p) const {
#pragma unroll
        for (int r = 0; r < 4; ++r) { const float x = v[r] * __builtin_amdgcn_rsqf(rs_val(p.q[r]) * (1.f / DM) + EPS); G[(size_t)(MROW0 + r0 + r) * 2048 + c] = (bf16_t)f2bf(__builtin_amdgcn_rcpf(1.f + __builtin_amdgcn_exp2f(-(x + p.b) * LOG2E))); } } };
struct SkGated { bf16_t* P; const bf16_t* G; int first; struct Pre { bf16_t pv[4], g[4]; };
    __device__ __forceinline__ void load(int r0, int c, Pre& p) const {
#pragma unroll
        for (int r = 0; r < 4; ++r) { p.g[r] = G[(size_t)(MROW0 + r0 + r) * 2048 + c]; p.pv[r] = first ? (bf16_t)0 : P[(size_t)(MROW0 + r0 + r) * PW + C_MERGED + c]; } }
    __device__ __forceinline__ void apply(int r0, int c, f32x4 v, const Pre& p) const {
#pragma unroll
        for (int r = 0; r < 4; ++r) P[(size_t)(MROW0 + r0 + r) * PW + C_MERGED + c] = (bf16_t)f2bf(bf2f(p.pv[r]) + bf2f(p.g[r]) * v[r]); } };
struct SkRes { float* hmeta; bf16_t* hb; rs_t* rs; struct Pre { float hm[4]; };
    __device__ __forceinline__ void load(int r0, int c, Pre& p) const {
#pragma unroll
        for (int r = 0; r < 4; ++r) p.hm[r] = hmeta[(size_t)(MROW0 + r0 + r) * DM + c]; }
    __device__ __forceinline__ void apply(int r0, int c, f32x4 v, const Pre& p) const {
#pragma unroll
        for (int r = 0; r < 4; ++r) { const float hv = p.hm[r] + v[r]; hmeta[(size_t)(MROW0 + r0 + r) * DM + c] = hv;
            if (hb) { hb[(size_t)(MROW0 + r0 + r) * DM + c] = (bf16_t)f2bf(hv); float ss = hv * hv; ss += __shfl_xor(ss, 1); ss += __shfl_xor(ss, 2); ss += __shfl_xor(ss, 4); ss += __shfl_xor(ss, 8);
                if ((threadIdx.x & 15) == 0) (void)__hip_atomic_fetch_add(rs + MROW0 + r0 + r, rs_fix(ss), __ATOMIC_RELAXED, __HIP_MEMORY_SCOPE_AGENT); } } } };
template <class Fn>
__device__ __forceinline__ void skinny_gemm(LAS unsigned char* lds, const bf16_t* A, int lda, const bf16_t* Bt, int K, int ntask, int bid, int G, const Fn& f) {
    int tid = threadIdx.x; asm volatile("" : "+v"(tid));
    const int wid = __builtin_amdgcn_readfirstlane(tid >> 6), lane = tid & 63, l15 = lane & 15, kq = lane >> 4;
    LAS f32x4* red = (LAS f32x4*)lds;
    const int kw = K / 8;
    for (int task = bid; task < ntask; task += G) {
        const bf16_t* ap = A + (size_t)l15 * lda + wid * kw + kq * 8;
        const bf16_t* bp = Bt + (size_t)(task * 16 + l15) * K + wid * kw + kq * 8;
        float z = 0.f; asm volatile("" : "+v"(z));
        f32x4 acc = (f32x4){z, z, z, z};
        typename Fn::Pre pre{}; if (wid == 0) f.load(kq * 4, task * 16 + l15, pre);
        for (int k0 = 0; k0 < kw; k0 += 256) {
            bf16x8 fa[8], fb[8];
#pragma unroll
            for (int i = 0; i < 8; ++i) { const int k = (k0 + 32 * i < kw) ? k0 + 32 * i : 0; fa[i] = *(const bf16x8*)(ap + k); fb[i] = *(const bf16x8*)(bp + k); }
#pragma unroll
            for (int i = 0; i < 8; ++i) if (k0 + 32 * i < kw) acc = __builtin_amdgcn_mfma_f32_16x16x32_bf16(fa[i], fb[i], acc, 0, 0, 0);
        }
        red[wid * 64 + lane] = acc;
        LDS_WAIT(); __syncthreads();
        if (wid == 0) {
            f32x4 s = red[lane];
#pragma unroll
            for (int w = 1; w < 8; ++w) s += red[w * 64 + lane];
            f.apply(kq * 4, task * 16 + l15, s, pre);
        }
        __syncthreads();
    }
}
__device__ __forceinline__ void skinny_swiglu(LAS unsigned char* lds, const bf16_t* A, int lda, const bf16_t* Bt, int K, bf16_t* P, const rs_t* rs, int bid, int G) {
    int tid = threadIdx.x; asm volatile("" : "+v"(tid));
    const int wid = __builtin_amdgcn_readfirstlane(tid >> 6), lane = tid & 63, l15 = lane & 15, kq = lane >> 4;
    LAS f32x4* red = (LAS f32x4*)lds;
    const int kw = K / 8;
    for (int task = bid; task < DFF / 16; task += G) {
        const int c0 = task * 16, brow = (c0 >> 7) * 256 + (c0 & 127) + l15;
        const bf16_t* ap = A + (size_t)l15 * lda + wid * kw + kq * 8;
        const bf16_t* bg = Bt + (size_t)brow * K + wid * kw + kq * 8; const bf16_t* bu = bg + (size_t)128 * K;
        float z = 0.f; asm volatile("" : "+v"(z));
        f32x4 ag = (f32x4){z, z, z, z}, au = ag;
        rs_t rq[4] = {0, 0, 0, 0}; if (wid == 0) {
#pragma unroll
            for (int r = 0; r < 4; ++r) rq[r] = rs[MROW0 + kq * 4 + r]; }
        {
            bf16x8 fa[8], fg[8], fu[8];
#pragma unroll
            for (int i = 0; i < 8; ++i) { fa[i] = *(const bf16x8*)(ap + 32 * i); fg[i] = *(const bf16x8*)(bg + 32 * i); fu[i] = *(const bf16x8*)(bu + 32 * i); }
#pragma unroll
            for (int i = 0; i < 8; ++i) { ag = __builtin_amdgcn_mfma_f32_16x16x32_bf16(fa[i], fg[i], ag, 0, 0, 0); au = __builtin_amdgcn_mfma_f32_16x16x32_bf16(fa[i], fu[i], au, 0, 0, 0); }
        }
        red[wid * 64 + lane] = ag; red[512 + wid * 64 + lane] = au;
        LDS_WAIT(); __syncthreads();
        if (wid == 0) {
            f32x4 sg = red[lane], su = red[512 + lane];
#pragma unroll
            for (int w = 1; w < 8; ++w) { sg += red[w * 64 + lane]; su += red[512 + w * 64 + lane]; }
#pragma unroll
            for (int r = 0; r < 4; ++r) { const float sc = __builtin_amdgcn_rsqf(rs_val(rq[r]) * (1.f / DM) + EPS); const float g = sg[r] * sc; su[r] *= sc; P[(size_t)(MROW0 + kq * 4 + r) * PW + c0 + l15] = (bf16_t)f2bf(g * __builtin_amdgcn_rcpf(1.f + __builtin_amdgcn_exp2f(-g * LOG2E)) * su[r]); }
        }
        __syncthreads();
    }
}

#define XB_TMO      128
#define XB_XCNT(j)  (256  + 64 * (j))
#define XB_XSUB(j)  (1280 + 64 * (j))
#define XB_XGEN(j)  (2304 + 64 * (j))
#define XB_TOP      3328
#define XB_TOPGEN   3392
#define XCD_BAR_WORDS 3456
#define XB_SPIN_CAP (1u << 18)
__device__ __forceinline__ unsigned xb_ld(unsigned* p)              { return __hip_atomic_load(p, __ATOMIC_RELAXED, __HIP_MEMORY_SCOPE_AGENT); }
__device__ __forceinline__ unsigned xb_add(unsigned* p, unsigned v) { return __hip_atomic_fetch_add(p, v, __ATOMIC_RELAXED, __HIP_MEMORY_SCOPE_AGENT); }
__device__ __forceinline__ unsigned xb_xcc_id() { return (unsigned)__builtin_amdgcn_s_getreg((3 << 11) | 20) & 0xFu; }
#define XB_SPIN(cond, bar) do { unsigned _sp = 0; while (cond) { __builtin_amdgcn_s_sleep(1); \
    if ((++_sp & 255u) == 0u) { if (xb_ld(&(bar)[XB_TMO])) break; if (_sp > XB_SPIN_CAP) { atomicAdd(&(bar)[XB_TMO], 1u); break; } } } } while (0)
struct XcdBarrier { unsigned* bar; unsigned x; volatile LAS unsigned* st; };
__device__ __forceinline__ XcdBarrier xcd_barrier_post(unsigned* bar, volatile LAS unsigned* st) {
    XcdBarrier b; b.bar = bar; b.x = xb_xcc_id(); b.st = st;
    if (threadIdx.x == 0) (void)xb_add(&bar[XB_XCNT(b.x)], 1u);
    return b;
}
__device__ __forceinline__ void xcd_barrier_complete(unsigned* bar, unsigned x, unsigned& nloc, unsigned& nx) {
    const unsigned G = gridDim.x * gridDim.y * gridDim.z;
    unsigned sum, cnt, mine, sp = 0u;
    for (;;) {
        sum = 0u; cnt = 0u; mine = 0u;
#pragma unroll
        for (unsigned j = 0; j < 16; ++j) { const unsigned c = xb_ld(&bar[XB_XCNT(j)]); sum += c; cnt += (c > 0u) ? 1u : 0u; mine = (j == x) ? c : mine; }
        if (sum == G) break;
        __builtin_amdgcn_s_sleep(1);
        if ((++sp & 255u) == 0u) { if (xb_ld(&bar[XB_TMO])) break; if (sp > XB_SPIN_CAP) { atomicAdd(&bar[XB_TMO], 1u); break; } }
    }
    nloc = mine > 0u ? mine : 1u; nx = cnt > 0u ? cnt : 1u;
}
__device__ __forceinline__ void xcd_barrier(const XcdBarrier& b) {
    asm volatile("s_waitcnt vmcnt(0)" ::: "memory");
    __syncthreads();
    if (threadIdx.x == 0) {
        unsigned* bar = b.bar;
        __builtin_amdgcn_s_waitcnt(0);
        unsigned nloc = b.st[0], nx = b.st[1];
        if (nloc == 0u) { xcd_barrier_complete(bar, b.x, nloc, nx); b.st[0] = nloc; b.st[1] = nx; }
        const unsigned old = xb_add(&bar[XB_XSUB(b.x)], 1u);
        const unsigned gen = old / nloc;
        if (old + 1u == (gen + 1u) * nloc) {
            __builtin_amdgcn_fence(__ATOMIC_RELEASE, "agent");
            asm volatile("s_waitcnt vmcnt(0)" ::: "memory");
            const unsigned og = xb_add(&bar[XB_TOP], 1u);
            const unsigned tg = og / nx;
            if (og + 1u == (tg + 1u) * nx) xb_add(&bar[XB_TOPGEN], 1u);
            else XB_SPIN(xb_ld(&bar[XB_TOPGEN]) == tg, bar);
            __builtin_amdgcn_fence(__ATOMIC_ACQUIRE, "agent");
            xb_add(&bar[XB_XGEN(b.x)], 1u);
            asm volatile("s_waitcnt vmcnt(0)" ::: "memory");
        } else {
            XB_SPIN(xb_ld(&bar[XB_XGEN(b.x)]) == gen, bar);
            __builtin_amdgcn_fence(__ATOMIC_ACQUIRE, "agent");
            asm volatile("s_waitcnt vmcnt(0)" ::: "memory");
        }
    }
    __syncthreads();
}

constexpr int NWAVES = 8;
constexpr int RING_BYTES = 131072, LDS_BYTES = 147456, LDSCTL_OFF = LDS_BYTES - 512;
struct Args {
    const float* in[19]; float* out; unsigned char* ws; int ph_lo, ph_hi;
};
struct Ctx {
    LAS unsigned char* lds; int tid, lane, wave, gw, ngw, G, bid;
};

template <int MAP> __device__ __forceinline__ int wmap(int n, float& sc) {
    sc = 1.f;
    if (MAP == 0) return n;
    if (MAP == 1) {
        if (n < 1088) return n;
        if (n < 3136) { const int m = n - 1088, d = m & 127; return 1280 + (m - d) + (d < 64 ? 2 * d : 2 * (d - 64) + 1); }
        if (n < 4160) return 1280 + (n - 1088);
        if (n < 5184) { const int m = n - 4160, d = m & 63; return 4352 + (m - d) + (d < 32 ? 2 * d : 2 * (d - 32) + 1); }
        if (n < 5248) { const int d = n - 5184; return 1088 + (d < 32 ? 2 * d : 2 * (d - 32) + 1); }
        if (n < 5264) { sc = 0.03125f; return 1152 + (n - 5248); }
        if (n < 7312) { const int m = n - 5264, d = m & 127; return 5376 + (m - d) + (d < 64 ? 2 * d : 2 * (d - 64) + 1); }
        if (n < 8336) return 5376 + (n - 5264);
        return 8448 + (n - 8336);
    }
    if (n < DFF) return (n >> 7) * 256 + (n & 127);
    const int m = n - DFF; return (m >> 7) * 256 + 128 + (m & 127);
}
template <int MAP> __device__ __forceinline__ void conv_matrix(const Ctx& F, const float* W, int K, int N, bf16_t* WT, const float* gain) {
    LAS float* scr = (LAS float*)(F.lds + F.wave * 18432);
    const int lane = F.lane;
    const int nblk = (N + 63) / 64, nit = (K / 64) * nblk;
    const int l31 = lane & 31, lh = lane >> 5, c = lane & 7, nsub = lane >> 3;
    f32x2 wv[32]; f32x4 g0 = (f32x4){1.f, 1.f, 1.f, 1.f}, g1 = g0;
#define CONV_LOAD(item) do { const int kb_ = (item) / nblk, nb_ = (item) - kb_ * nblk, k0_ = 64 * kb_, nn_ = 64 * nb_ + 2 * l31; \
        const float* src_ = W + (size_t)(k0_ + lh) * N + nn_; const bool ok_ = nn_ < N; \
        _Pragma("unroll") for (int i = 0; i < 32; ++i) wv[i] = ok_ ? *(const f32x2*)(src_ + (size_t)(2 * i) * N) : (f32x2){0.f, 0.f}; \
        if (gain) { g0 = *(const f32x4*)(gain + k0_ + 8 * c); g1 = *(const f32x4*)(gain + k0_ + 8 * c + 4); } } while (0)
    int it = F.gw;
    if (it < nit) CONV_LOAD(it);
    while (it < nit) {
        const int kb = it / nblk, nb = it - kb * nblk, k0 = 64 * kb, n0 = 64 * nb;
#pragma unroll
        for (int i = 0; i < 32; ++i) { LAS float* d = scr + (2 * i + lh) * 65 + l31; d[0] = wv[i].x; d[32] = wv[i].y; }
        const f32x4 gc0 = g0, gc1 = g1;
        const int nx = it + F.ngw;
        if (nx < nit) CONV_LOAD(nx);
        LDS_WAIT(); asm volatile("" ::: "memory");
#pragma unroll
        for (int j = 0; j < 8; ++j) { const int n = nsub + 8 * j, ns = n0 + n;
            if (ns < N) { float sc; const int dst = wmap<MAP>(ns, sc); const LAS float* s = scr + (8 * c) * 65 + (n & 1) * 32 + (n >> 1);
                u32x4 o; o.x = pk2(s[0 * 65] * (sc * gc0.x), s[1 * 65] * (sc * gc0.y)); o.y = pk2(s[2 * 65] * (sc * gc0.z), s[3 * 65] * (sc * gc0.w));
                o.z = pk2(s[4 * 65] * (sc * gc1.x), s[5 * 65] * (sc * gc1.y)); o.w = pk2(s[6 * 65] * (sc * gc1.z), s[7 * 65] * (sc * gc1.w));
                *(u32x4*)(WT + (size_t)dst * K + k0 + 8 * c) = o; } }
        LDS_WAIT(); asm volatile("" ::: "memory");
        it = nx;
    }
#undef CONV_LOAD
}

__device__ __forceinline__ void norm_load(const float* hrow, int lane, f32x4 (&v)[8]) {
#pragma unroll
    for (int j = 0; j < 8; ++j) v[j] = *((const f32x4*)hrow + lane + 64 * j);
}
__device__ __forceinline__ void norm_fin(const f32x4 (&v)[8], bf16_t* orow, rs_t* rs_row, int lane) {
    float s = 0.f;
#pragma unroll
    for (int j = 0; j < 8; ++j) s += (v[j].x * v[j].x + v[j].y * v[j].y) + (v[j].z * v[j].z + v[j].w * v[j].w);
    s = wave_sum(s);
    if (lane == 0) *rs_row = rs_fix(s);
#pragma unroll
    for (int j = 0; j < 8; ++j) { u32x2 o; o.x = cvt_pk_bf16(v[j].x, v[j].y); o.y = cvt_pk_bf16(v[j].z, v[j].w); *((u32x2*)orow + lane + 64 * j) = o; }
}

__device__ __forceinline__ void meta_post_row(bf16_t* P, int r, const float* gperm, int lane) {
    bf16_t* p = P + (size_t)r * PW; const int pos = row_pos(r);
    float c128, s128, c64, s64; rope_cs(pos, lane, 2.f / 128.f, c128, s128); rope_cs(pos, lane & 31, 2.f / 64.f, c64, s64);
#pragma unroll 1
    for (int t = 0; t < 4; ++t) {
        const int cb = t == 0 ? C_DQ : (t == 1 ? C_DK : (t == 2 ? C_FQ : C_FK)); const float sc = (t == 0 || t == 2) ? C2_128 : 1.f;
        const float ga = gperm[t * 128 + 2 * lane], gb = gperm[t * 128 + 2 * lane + 1];
#pragma unroll 1
        for (int h = 0; h < 8; ++h) { unsigned* xp = (unsigned*)(p + cb + h * 128) + lane; const unsigned w = *xp; float x1 = __uint_as_float(w << 16), x2 = __uint_as_float(w & 0xffff0000u);
            const float rn = __builtin_amdgcn_rsqf(wave_sum(x1 * x1 + x2 * x2) * (1.f / 128.f) + EPS); x1 *= rn * ga; x2 *= rn * gb;
            *xp = cvt_pk_bf16((x1 * c128 - x2 * s128) * sc, (x2 * c128 + x1 * s128) * sc); }
    }
#pragma unroll 1
    for (int hh = 0; hh < 8; ++hh) { unsigned* xp = (unsigned*)(p + C_IQ + hh * 128) + lane; const unsigned w = *xp; const float x1 = __uint_as_float(w << 16), x2 = __uint_as_float(w & 0xffff0000u);
        *xp = cvt_pk_bf16(x1 * c64 - x2 * s64, x2 * c64 + x1 * s64); }
}
__device__ __forceinline__ void unpack8(const u32x4& w, float (&x)[8]) {
#pragma unroll
    for (int e = 0; e < 4; ++e) { x[2 * e] = __uint_as_float(w[e] << 16); x[2 * e + 1] = __uint_as_float(w[e] & 0xffff0000u); }
}
__device__ __forceinline__ u32x4 pack8(const float (&x)[8]) { u32x4 w; w.x = cvt_pk_bf16(x[0], x[1]); w.y = cvt_pk_bf16(x[2], x[3]); w.z = cvt_pk_bf16(x[4], x[5]); w.w = cvt_pk_bf16(x[6], x[7]); return w; }
__device__ __forceinline__ u32x4 shfl_xor4(const u32x4& w, int m) { u32x4 r; r.x = __shfl_xor(w.x, m); r.y = __shfl_xor(w.y, m); r.z = __shfl_xor(w.z, m); r.w = __shfl_xor(w.w, m); return r; }
__device__ __forceinline__ void post2_load(const bf16_t* P, int r, int lane, u32x4 (&v)[9], unsigned& ikw_) {
    const bf16_t* p = P + (size_t)r * PW; const int hw = lane >> 5, l5 = lane & 31;
    v[0] = *(const u32x4*)(p + C_KPE + (lane & 7) * 8); ikw_ = *((const unsigned*)(p + C_IK) + (lane & 31));
#pragma unroll
    for (int it = 0; it < 4; ++it) { const int h = 2 * it + hw; v[1 + it] = *(const u32x4*)(p + C_QRAW + h * 192 + (l5 < 24 ? l5 : 0) * 8); v[5 + it] = *(const u32x4*)(p + C_KVRAW + h * 256 + (l5 & 15) * 8); }
}
__device__ __forceinline__ void post2_row(bf16_t* P, int r, const u32x4 (&v)[9], unsigned ikw, const float* qkg  , LAS float* rnl, int lane) {
    bf16_t* p = P + (size_t)r * PW;
    const int pos = row_pos(r), hw = lane >> 5, l5 = lane & 31;
    float c64[8], s64[8];
#pragma unroll
    for (int j = 0; j < 8; ++j) rope_cs(pos, 8 * (lane & 3) + j, 2.f / 64.f, c64[j], s64[j]);
    float kp[8]; unpack8(v[0], kp);
    unsigned* ikp = (unsigned*)(p + C_IK) + (lane & 31);
    float kpe_ss = 0.f;
#pragma unroll
    for (int j = 0; j < 8; ++j) kpe_ss += kp[j] * kp[j];
    kpe_ss += __shfl_xor(kpe_ss, 1); kpe_ss += __shfl_xor(kpe_ss, 2); kpe_ss += __shfl_xor(kpe_ss, 4);
#pragma unroll
    for (int it = 0; it < 4; ++it) {
        const int h = 2 * it + hw; const bool act = l5 < 24;
        u32x4* ptr = (u32x4*)(p + C_QRAW + h * 192 + (act ? l5 : 0) * 8);
        float x[8]; unpack8(v[1 + it], x);
        float ss = 0.f;
#pragma unroll
        for (int j = 0; j < 8; ++j) ss += x[j] * x[j];
        if (!act) ss = 0.f;
#pragma unroll
        for (int o = 1; o < 32; o <<= 1) ss += __shfl_xor(ss, o);
        const float rn = 1.0f / sqrtf(ss * (1.f / 192.f) + EPS);
        const int gi = (act ? l5 : 0) * 8;
        const f32x4 g0 = *(const f32x4*)(qkg + gi), g1 = *(const f32x4*)(qkg + gi + 4);
#pragma unroll
        for (int j = 0; j < 4; ++j) { x[j] *= rn * g0[j]; x[4 + j] *= rn * g1[j]; }
        float o[8];
#pragma unroll
        for (int j = 0; j < 8; ++j) { const float pr = __shfl_xor(x[j], 4); const float rot = (l5 & 4) ? (x[j] * c64[j] + pr * s64[j]) : (x[j] * c64[j] - pr * s64[j]); o[j] = (l5 >= 16 ? rot : x[j]) * C2_192; }
        if (act) *ptr = pack8(o);
    }
#pragma unroll
    for (int it = 0; it < 4; ++it) {
        const int h = 2 * it + hw; const bool isk = l5 < 16;
        u32x4* ptr = (u32x4*)(p + C_KVRAW + h * 256 + (l5 & 15) * 8);
        float x[8]; unpack8(v[5 + it], x);
        float ss = 0.f;
#pragma unroll
        for (int j = 0; j < 8; ++j) ss += x[j] * x[j];
        if (!isk) ss = 0.f;
#pragma unroll
        for (int o = 1; o < 32; o <<= 1) ss += __shfl_xor(ss, o);
        const float rn = 1.0f / sqrtf((ss + kpe_ss) * (1.f / 192.f) + EPS);
        if (l5 == 0) rnl[h] = rn;
        const int gi = 192 + (isk ? l5 : 0) * 8;
        const f32x4 g0 = *(const f32x4*)(qkg + gi), g1 = *(const f32x4*)(qkg + gi + 4);
        float o[8];
#pragma unroll
        for (int j = 0; j < 4; ++j) { o[j] = x[j] * rn * g0[j]; o[4 + j] = x[4 + j] * rn * g1[j]; }
        if (isk) *ptr = pack8(o);
    }
    LDS_WAIT(); asm volatile("" ::: "memory");
    { const int hd = lane >> 3, c = lane & 7; const float rn = rnl[hd];
      const f32x4 g0 = *(const f32x4*)(qkg + 192 + 128 + c * 8), g1 = *(const f32x4*)(qkg + 192 + 128 + c * 8 + 4);
      float x[8], o[8];
#pragma unroll
      for (int j = 0; j < 4; ++j) { x[j] = kp[j] * rn * g0[j]; x[4 + j] = kp[4 + j] * rn * g1[j]; }
#pragma unroll
      for (int j = 0; j < 8; ++j) { const float pr = __shfl_xor(x[j], 4); o[j] = (c & 4) ? (x[j] * c64[j] + pr * s64[j]) : (x[j] * c64[j] - pr * s64[j]); }
      *(u32x4*)(p + C_KPEH + hd * 64 + c * 8) = pack8(o); }
    { const float x1 = __uint_as_float(ikw << 16), x2 = __uint_as_float(ikw & 0xffff0000u); float cs, sn; rope_cs(pos, lane & 31, 2.f / 64.f, cs, sn);
      if (lane < 32) *ikp = cvt_pk_bf16(x1 * cs - x2 * sn, x2 * cs + x1 * sn); }
    LDS_WAIT(); asm volatile("" ::: "memory");
}
__device__ __forceinline__ void post3_load(const bf16_t* P, int r, int lane, u32x4 (&rr)[4]) {
    const bf16_t* p = P + (size_t)r * PW; const int hw = lane >> 5, l5 = lane & 31;
#pragma unroll
    for (int h = 0; h < 4; ++h) rr[h] = *(const u32x4*)(p + (hw ? C_IQ : C_FQ) + h * 256 + l5 * 8);
}
__device__ __forceinline__ void post3_row(bf16_t* P, int r, const u32x4 (&rr)[4], const float* subg, float lam, float omli, int lane) {
    bf16_t* p = P + (size_t)r * PW;
    const int hw = lane >> 5, l5 = lane & 31;
#pragma unroll
    for (int h = 0; h < 4; ++h) {
        const u32x4 raw = rr[h];
        const u32x4 praw = shfl_xor4(raw, 16);
        float a[8], b[8]; unpack8(raw, a); unpack8(praw, b);
        float d[8], ss = 0.f;
#pragma unroll
        for (int j = 0; j < 8; ++j) { d[j] = a[j] - lam * b[j]; ss += d[j] * d[j]; }
        if (l5 >= 16) ss = 0.f;
#pragma unroll
        for (int o = 1; o < 64; o <<= 1) ss += __shfl_xor(ss, o);
        const float rn = omli / sqrtf(ss * (1.f / 256.f) + EPS);
        const int dim = hw * 128 + (l5 & 15) * 8;
        const f32x4 g0 = *(const f32x4*)(subg + dim), g1 = *(const f32x4*)(subg + dim + 4);
        float o[8];
#pragma unroll
        for (int j = 0; j < 4; ++j) { o[j] = d[j] * rn * g0[j]; o[4 + j] = d[4 + j] * rn * g1[j]; }
        if (l5 < 16) *(u32x4*)(p + C_OC + h * 256 + dim) = pack8(o);
    }
}

__device__ __forceinline__ void index_unit(const bf16_t* P, int unit, unsigned* bm, LAS unsigned char* lds) {
    typedef float f32x16 __attribute__((ext_vector_type(16)));
    int tid = threadIdx.x; asm volatile("" : "+v"(tid));
    const int wid = __builtin_amdgcn_readfirstlane(tid >> 6), lane = tid & 63, j = lane & 31, hi = lane >> 5;
    const int tb = 255 - (unit >> 4), b = unit & 15, t0 = tb * 8, tokbase = MBLK + b * SEQ;
    const int wmax = (64 + t0 + 7) >> 5;
    LAS unsigned* keys = (LAS unsigned*)lds;
    LAS float* iwl = (LAS float*)(lds + 8 * 2112 * 4);
    if (t0 + 7 + 17 > 256) {
        const unsigned boff = (unsigned)(j * PW + C_IK + hi * 8) * 2u;
#define IX_LOADK(dst, w_) do { const int kr_ = (w_) < 2 ? (MBLK - 64) + 32 * (w_) : tokbase + 32 * ((w_) - 2); const char* bp_ = (const char*)(P + (size_t)kr_ * PW) + boff; \
        _Pragma("unroll") for (int s = 0; s < 4; ++s) dst[s] = *(const bf16x8*)(bp_ + s * 32); } while (0)
        bf16x8 bf[4], bn[4];
        IX_LOADK(bf, wid <= wmax ? wid : 0);
        if (tid < 128) iwl[tid] = bf2f(P[(size_t)(tokbase + t0 + (tid >> 4)) * PW + C_IW + (tid & 15)]);
        LAS unsigned char* al = lds + 8 * 2112 * 4 + 512;
        { const int id0 = tid * 2;
#pragma unroll
          for (int e = 0; e < 2; ++e) { const int id = id0 + e, rw = id >> 3, c = id & 7;
              *(LAS bf16x8*)(al + rw * 144 + c * 16) = *(const bf16x8*)(P + (size_t)(tokbase + t0 + (rw >> 4)) * PW + C_IQ + (rw & 15) * 64 + c * 8); } }
        LDS_WAIT(); __syncthreads();
        bf16x8 af[4][4];
        { const int qa = (j >> 2) & 1, ha = (j & 3) + 4 * (j >> 3);
#pragma unroll
          for (int blk = 0; blk < 4; ++blk)
#pragma unroll
              for (int s = 0; s < 4; ++s) af[blk][s] = *(const LAS bf16x8*)(al + ((2 * blk + qa) * 16 + ha) * 144 + s * 32 + hi * 16); }
        for (int w = wid; w <= wmax; w += 8) {
            IX_LOADK(bn, w + 8 <= wmax ? w + 8 : w);
            const int kidx = 32 * w + j;
#pragma unroll
            for (int blk = 0; blk < 4; ++blk) {
                f32x16 acc = (f32x16){0.f,0.f,0.f,0.f,0.f,0.f,0.f,0.f,0.f,0.f,0.f,0.f,0.f,0.f,0.f,0.f};
#pragma unroll
                for (int s = 0; s < 4; ++s) acc = __builtin_amdgcn_mfma_f32_32x32x16_bf16(af[blk][s], bf[s], acc, 0, 0, 0);
                const int q = 2 * blk + hi;
                const LAS f32x4* iwq = (const LAS f32x4*)(iwl + q * 16);
                float score = 0.f;
#pragma unroll
                for (int g = 0; g < 4; ++g) { const f32x4 wv = iwq[g]; score += fmaxf(acc[4 * g], 0.f) * wv.x + fmaxf(acc[4 * g + 1], 0.f) * wv.y + fmaxf(acc[4 * g + 2], 0.f) * wv.z + fmaxf(acc[4 * g + 3], 0.f) * wv.w; }
                const bool valid = kidx >= 48 && kidx <= 64 + t0 + q; const unsigned u_ = __float_as_uint(score);
                keys[q * 2112 + kidx] = valid ? ((u_ & 0x80000000u) ? ~u_ : (u_ | 0x80000000u)) : 0u;
            }
#pragma unroll
            for (int s = 0; s < 4; ++s) bf[s] = bn[s];
        }
#undef IX_LOADK
        LDS_WAIT(); __syncthreads();
    }
    const int tq = t0 + wid, qk = 64 + tq, nch = qk / 64 + 1;
    unsigned* out = bm + (size_t)(b * SEQ + tq) * BMW;
    if (tq + 17 <= 256) {
        for (int c = 0; c < 33; ++c) { const int kidx = 64 * c + lane; const unsigned long long m = __ballot(kidx >= 48 && kidx <= qk);
            if (lane == 0) { out[2 * c] = (unsigned)m; out[2 * c + 1] = (unsigned)(m >> 32); } }
    } else {
#define IX_SELECT(NC) do { unsigned kreg[NC]; \
        _Pragma("unroll") for (int c = 0; c < NC; ++c) kreg[c] = (c < nch && 64 * c + lane <= qk) ? keys[wid * 2112 + 64 * c + lane] : 0u;     \
        unsigned T = 0u; \
        for (int bit = 31; bit >= 0; --bit) { \
            const unsigned cand = T | (1u << bit); int cnt = 0; \
            _Pragma("unroll") for (int c = 0; c < NC; ++c) cnt += __popcll(__ballot(kreg[c] >= cand)); \
            if (cnt >= 256) T = cand; \
            if (cnt == 256) break; \
        } \
        _Pragma("unroll") for (int c = 0; c < NC; ++c) { const unsigned long long m = __ballot(kreg[c] >= T && kreg[c] != 0u); \
            if (lane == 0) { out[2 * c] = (unsigned)m; out[2 * c + 1] = (unsigned)(m >> 32); } } \
        if (lane < 2 * (33 - NC)) out[2 * NC + lane] = 0u; } while (0)
        if (nch <= 11) IX_SELECT(11); else if (nch <= 22) IX_SELECT(22); else IX_SELECT(33);
#undef IX_SELECT
    }
    LDS_WAIT();
}

namespace fa {
typedef float f32x16 __attribute__((ext_vector_type(16)));
typedef short s16x4 __attribute__((ext_vector_type(4)));
__device__ __forceinline__ int crow(int r, int hi) { return (r & 3) + 8 * (r >> 2) + 4 * hi; }
__device__ __forceinline__ int v_st(int k, int c) { const int kk = (k & ~0xC) | ((k & 4) << 1) | ((k & 8) >> 1); return ((kk >> 3) * 4 + (c >> 5)) * 512 + ((kk & 7) * 32 + (c & 31)) * 2; }
__device__ __forceinline__ int v_rd_base(int lane) { return ((lane & 3) << 3) | (((lane >> 2) & 3) << 6) | (((lane >> 4) & 1) << 5) | (((lane >> 5) & 1) << 8); }
constexpr int v_rd_off(int d0, int ks, int half) { return d0 * 512 + ks * 4096 + half * 2048; }
constexpr int SHM_V = 16384;
template <int DQK, int DV> struct Geo { static constexpr int KP = DQK * 2, SHM_K = 64 * DQK * 2, LDS_K0 = 2 * 64 * DV * 2, LDS_WS = LDS_K0 + 2 * SHM_K, BYTES = LDS_WS + 8 * 256; };
#define FA_KSWZ(row, colB, pitch) ((row) * (pitch) + ((colB) ^ (((row) & 7) << 4)))
#define FA_SBAR() __builtin_amdgcn_sched_barrier(0)

struct Item { int qrow0, qk0, nt, tokbase; };

template <int DQK>
__device__ __forceinline__ void load_q(const bf16_t* P, const Item& it, int qcol, bf16x8 (&qr)[DQK / 16]) {
    int tid = threadIdx.x; asm volatile("" : "+v"(tid));
    const int wid = tid >> 6, lane = tid & 63, r32 = lane & 31, hi = lane >> 5;
    const bf16_t* qp = P + (size_t)(it.qrow0 + wid * 32 + r32) * PW + qcol + hi * 8;
#pragma unroll
    for (int d0 = 0; d0 < DQK / 16; ++d0) qr[d0] = *(const bf16x8*)(qp + d0 * 16);
}

template <int DQK, int DV, bool MASKED>
__device__ __forceinline__ void attn_core(bf16_t* P, const Item& it, const bf16x8 (&qr)[DQK / 16], int k1col, int k2col, int vcol, int ocol, int ocol1, const unsigned* bmq, LAS unsigned char* lds) {
    typedef Geo<DQK, DV> G; constexpr int SHMV = 64 * DV * 2, NDB = DV / 32;
    int tid = threadIdx.x; asm volatile("" : "+v"(tid));
    const int wid = __builtin_amdgcn_readfirstlane(tid >> 6), lane = tid & 63, r32 = lane & 31, hi = lane >> 5;
    LAS unsigned char* V_lds = lds; LAS unsigned char* K_lds = lds + G::LDS_K0; LAS float* wsf = (LAS float*)(lds + G::LDS_WS) + wid * 64;
    const int sr = tid >> 4, sc = (tid & 15) * 8;
    const int vst0 = v_st(sr, sc), vst1 = v_st(32 + sr, sc), kws0 = FA_KSWZ(sr, sc * 2, G::KP), kws1 = FA_KSWZ(sr + 32, sc * 2, G::KP);
    const int xr = tid >> 3, xc = (tid & 7) * 8, kws2 = FA_KSWZ(xr, (128 + xc) * 2, G::KP);
    const unsigned loff0 = (unsigned)(sr * PW + sc) * 2u, loffx = (unsigned)(xr * PW + xc) * 2u;
    const int vb0 = (int)(unsigned)(size_t)V_lds + v_rd_base(lane);
    const int NT = it.nt;
    const int qk = it.qk0 + wid * 32 + r32;
    const bool use_bm = MASKED && (bmq != nullptr);
    const unsigned bmoff = (unsigned)((wid * 32 + r32) * BMW) * 4u;
    float l_reg = 0.f; f32x16 o[NDB];
#pragma unroll
    for (int d = 0; d < NDB; ++d) o[d] = (f32x16){0.f,0.f,0.f,0.f,0.f,0.f,0.f,0.f,0.f,0.f,0.f,0.f,0.f,0.f,0.f,0.f};
    bf16x8 sk0, sk1, sk2, sv0, sv1, sv2, sv3;
#define FA_KROW0(t) ((t) == 0 ? (MBLK - 64) : it.tokbase + 64 * ((t) - 1))
#define FA_LOADK(t) do { const int kr_ = FA_KROW0(t); const char* rb_ = (const char*)(P + (size_t)kr_ * PW); const char* rk_ = rb_ + (size_t)k1col * 2; \
        sk0 = *(const bf16x8*)(rk_ + loff0); sk1 = *(const bf16x8*)(rk_ + (size_t)32 * PW * 2 + loff0); if (DQK == 192) sk2 = *(const bf16x8*)(rb_ + (size_t)k2col * 2 + loffx); } while (0)
#define FA_LOADV(t) do { const char* rv_ = (const char*)(P + (size_t)FA_KROW0(t) * PW) + (size_t)vcol * 2; \
        sv0 = *(const bf16x8*)(rv_ + loff0); sv1 = *(const bf16x8*)(rv_ + (size_t)32 * PW * 2 + loff0); if (DV == 256) { sv2 = *(const bf16x8*)(rv_ + 256 + loff0); sv3 = *(const bf16x8*)(rv_ + 256 + (size_t)32 * PW * 2 + loff0); } } while (0)
#define FA_LOAD(t) do { FA_LOADK(t); FA_LOADV(t); } while (0)
#define FA_WRITE(bf) do { *(LAS bf16x8*)(K_lds + (bf) * G::SHM_K + kws0) = sk0; *(LAS bf16x8*)(K_lds + (bf) * G::SHM_K + kws1) = sk1; \
        *(LAS bf16x8*)(V_lds + (bf) * SHMV + vst0) = sv0; *(LAS bf16x8*)(V_lds + (bf) * SHMV + vst1) = sv1; if (DV == 256) { *(LAS bf16x8*)(V_lds + (bf) * SHMV + 16384 + vst0) = sv2; *(LAS bf16x8*)(V_lds + (bf) * SHMV + 16384 + vst1) = sv3; } \
        if (DQK == 192) *(LAS bf16x8*)(K_lds + (bf) * G::SHM_K + kws2) = sk2; } while (0)
    constexpr int QREG = (DV == 256) ? 3 : DQK / 16;
    constexpr int NQL = DQK / 16 - QREG;
    static_assert(G::BYTES + 8 * NQL * 64 * 16 <= LDSCTL_OFF, "attention LDS budget");
    LAS unsigned char* qx = lds + G::BYTES + (wid * (NQL * 64) + lane) * 16;
    FA_LOAD(0);
    if (QREG < DQK / 16) {
#pragma unroll
        for (int d0 = QREG; d0 < DQK / 16; ++d0) *(LAS bf16x8*)(qx + (d0 - QREG) * 1024) = qr[d0];
    }
    FA_WRITE(0);
    __syncthreads();
    for (int t = 0; t < NT; ++t) {
        const int cur = t & 1;
        unsigned zb = 0u; asm volatile("" : "+v"(zb)); u32x2 bw = (u32x2){zb, zb};
        if (use_bm) bw = *(const u32x2*)((const char*)(bmq + 2 * t) + bmoff);
        if (t + 1 < NT) { FA_LOADK(t + 1); FA_LOADV(t + 1); }
        if (64 * t <= it.qk0 + wid * 32 + 31) {
        f32x16 p0 = (f32x16){0.f,0.f,0.f,0.f,0.f,0.f,0.f,0.f,0.f,0.f,0.f,0.f,0.f,0.f,0.f,0.f}, p1 = p0;
        { LAS unsigned char* kbase = K_lds + cur * G::SHM_K;
          LAS unsigned char* kb[4];
#pragma unroll
          for (int dd = 0; dd < 4; ++dd) kb[dd] = kbase + FA_KSWZ(r32, (dd * 16 + hi * 8) * 2, G::KP);
          constexpr int GS = (DQK == 192 || DV == 256) ? 2 : 4;
#pragma unroll
          for (int g = 0; g < DQK / (16 * GS); ++g) {
              bf16x8 fb0[GS], fb1[GS];
#pragma unroll
              for (int dd = 0; dd < GS; ++dd) { const int d0 = g * GS + dd; LAS unsigned char* a = kb[d0 & 3] + (d0 >> 2) * 128; fb0[dd] = *(const LAS bf16x8*)a; fb1[dd] = *(const LAS bf16x8*)(a + 32 * G::KP); }
              FA_SBAR();
#pragma unroll
              for (int dd = 0; dd < GS; ++dd) { const int d0 = g * GS + dd; bf16x8 qf; if (d0 < QREG) qf = qr[d0 < QREG ? d0 : 0]; else qf = *(const LAS bf16x8*)(qx + (d0 - QREG) * 1024);
                  if (t != 0) p0 = __builtin_amdgcn_mfma_f32_32x32x16_bf16(fb0[dd], qf, p0, 0, 0, 0);
                  p1 = __builtin_amdgcn_mfma_f32_32x32x16_bf16(fb1[dd], qf, p1, 0, 0, 0); }
              FA_SBAR(); } }
        FA_SBAR();
        const float NEG = -__builtin_inff();
        if (use_bm) {
        } else if (t == 0 || 64 * t + 63 > it.qk0 + wid * 32) {
            const int kb_ = 64 * t + 4 * hi;
#pragma unroll
            for (int r = 0; r < 16; ++r) { const int k0 = kb_ + (r & 3) + 8 * (r >> 2), k1 = k0 + 32;
                if (k0 < 48 || k0 > qk) p0[r] = NEG; if (k1 < 48 || k1 > qk) p1[r] = NEG; }
        }
        float ps = 0.f;
#pragma unroll
        for (int r = 0; r < 16; ++r) { p0[r] = __builtin_amdgcn_exp2f(p0[r]); p1[r] = __builtin_amdgcn_exp2f(p1[r]); }
        if (use_bm) {
            const int wx = (int)(bw.x >> (4 * hi)), wy = (int)(bw.y >> (4 * hi));
#pragma unroll
            for (int r = 0; r < 16; ++r) { const int c = (r & 3) + 8 * (r >> 2);
                p0[r] = __uint_as_float(__float_as_uint(p0[r]) & (unsigned)__builtin_amdgcn_sbfe(wx, c, 1)); p1[r] = __uint_as_float(__float_as_uint(p1[r]) & (unsigned)__builtin_amdgcn_sbfe(wy, c, 1)); }
        }
        { f32x2 s2 = (f32x2){p0[0], p0[1]} + (f32x2){p1[0], p1[1]};
#pragma unroll
          for (int r = 2; r < 16; r += 2) s2 += (f32x2){p0[r], p0[r + 1]} + (f32x2){p1[r], p1[r + 1]};
          ps = s2.x + s2.y; }
        { auto rr = __builtin_amdgcn_permlane32_swap(__float_as_uint(ps), __float_as_uint(ps), false, false); ps = __uint_as_float(rr[0]) + __uint_as_float(rr[1]); }
        l_reg += ps;
        bf16x8 pa0, pa1, pa2, pa3;
#define FA_PK4(Pv, B_, OUT) do { const unsigned a0 = cvt_pk_bf16(Pv[B_ + 0], Pv[B_ + 1]), a1 = cvt_pk_bf16(Pv[B_ + 2], Pv[B_ + 3]), b0 = cvt_pk_bf16(Pv[B_ + 4], Pv[B_ + 5]), b1 = cvt_pk_bf16(Pv[B_ + 6], Pv[B_ + 7]); \
        auto r0 = __builtin_amdgcn_permlane32_swap(a0, b0, false, false); auto r1 = __builtin_amdgcn_permlane32_swap(a1, b1, false, false); \
        u32x4 w_ = {r0[0], r1[0], r0[1], r1[1]}; OUT = __builtin_bit_cast(bf16x8, w_); } while (0)
        FA_PK4(p0, 0, pa0); FA_PK4(p0, 8, pa1); FA_PK4(p1, 0, pa2); FA_PK4(p1, 8, pa3);
#define FA_TRRD(dst, off) asm volatile("ds_read_b64_tr_b16 %0, %1 offset:%2" : "=&v"(dst) : "v"(vbc), "i"(off) : "memory")
#define FA_PV(VB, d0) do { s16x4 l0, l1, l2, l3, h0, h1, h2, h3; constexpr int b_ = ((d0) >> 2) * 16384 + v_rd_off((d0) & 3, 0, 0); \
        FA_TRRD(l0, b_); FA_TRRD(h0, b_ + 2048); FA_TRRD(l1, b_ + 4096); FA_TRRD(h1, b_ + 6144); FA_TRRD(l2, b_ + 8192); FA_TRRD(h2, b_ + 10240); FA_TRRD(l3, b_ + 12288); FA_TRRD(h3, b_ + 14336); \
        asm volatile("s_waitcnt lgkmcnt(0)" ::: "memory"); FA_SBAR(); \
        o[d0] = __builtin_amdgcn_mfma_f32_32x32x16_bf16(pa0, (bf16x8){l0[0], l0[1], l0[2], l0[3], h0[0], h0[1], h0[2], h0[3]}, o[d0], 0, 0, 0); \
        o[d0] = __builtin_amdgcn_mfma_f32_32x32x16_bf16(pa1, (bf16x8){l1[0], l1[1], l1[2], l1[3], h1[0], h1[1], h1[2], h1[3]}, o[d0], 0, 0, 0); \
        o[d0] = __builtin_amdgcn_mfma_f32_32x32x16_bf16(pa2, (bf16x8){l2[0], l2[1], l2[2], l2[3], h2[0], h2[1], h2[2], h2[3]}, o[d0], 0, 0, 0); \
        o[d0] = __builtin_amdgcn_mfma_f32_32x32x16_bf16(pa3, (bf16x8){l3[0], l3[1], l3[2], l3[3], h3[0], h3[1], h3[2], h3[3]}, o[d0], 0, 0, 0); } while (0)
        FA_SBAR();
        { const int vbc = vb0 + cur * SHMV;
          FA_PV(0, 0); FA_PV(0, 1); FA_PV(0, 2); FA_PV(0, 3); if (DV == 256) { FA_PV(0, 4); FA_PV(0, 5); FA_PV(0, 6); FA_PV(0, 7); } }
        }
        FA_SBAR();
        if (t + 1 < NT) { const int nb_ = cur ^ 1; FA_WRITE(nb_); }
        __syncthreads();
    }
    if (hi == 0) wsf[r32] = l_reg; LDS_WAIT();
    float rli[16];
#pragma unroll
    for (int r = 0; r < 16; ++r) { const float lv = wsf[crow(r, hi)]; rli[r] = lv > 0.f ? __builtin_amdgcn_rcpf(lv) : 0.f; }
    { int l2 = lane; asm volatile("" : "+v"(l2));
      const int r32b = l2 & 31, hib = l2 >> 5;
      char* Ow = (char*)(P + (size_t)(it.qrow0 + wid * 32) * PW + ocol) + (unsigned)((4 * hib) * PW + r32b) * 2u;
      char* Ow1 = (char*)(P + (size_t)(it.qrow0 + wid * 32) * PW + ocol1) + (unsigned)((4 * hib) * PW + r32b) * 2u;
#pragma unroll
      for (int r = 0; r < 16; ++r) { const unsigned ro = (unsigned)(((r & 3) + 8 * (r >> 2)) * PW) * 2u;
#pragma unroll
        for (int d0 = 0; d0 < NDB; ++d0) { const float v = o[d0][r] * rli[r]; const float vn = __shfl_xor(v, 1);
            if ((r32b & 1) == 0) *(unsigned*)((d0 < 4 ? Ow : Ow1) + ro + (d0 & 3) * 64) = cvt_pk_bf16(v, vn); } } }
    LDS_WAIT();
    __syncthreads();
#undef FA_KROW0
#undef FA_LOAD
#undef FA_LOADK
#undef FA_LOADV
#undef FA_WRITE
#undef FA_PK4
#undef FA_TRRD
#undef FA_PV
}
__device__ __forceinline__ int next_item(unsigned* ctr, LAS int* slot) {
    __syncthreads();
    if (threadIdx.x == 0) *slot = (int)__hip_atomic_fetch_add(ctr, 1u, __ATOMIC_RELAXED, __HIP_MEMORY_SCOPE_AGENT);
    __syncthreads();
    return *slot;
}
__device__ __forceinline__ void queue_prime(unsigned* ctr, LAS int* slot) {
    __syncthreads();
    if (threadIdx.x == 0) slot[0] = (int)__hip_atomic_fetch_add(ctr, 1u, __ATOMIC_RELAXED, __HIP_MEMORY_SCOPE_AGENT);
    __syncthreads();
}
__device__ __forceinline__ int queue_next(unsigned* ctr, LAS int* slot, int k) {
    const int idx = slot[k & 1];
    if (threadIdx.x == 0) slot[(k + 1) & 1] = (int)__hip_atomic_fetch_add(ctr, 1u, __ATOMIC_RELAXED, __HIP_MEMORY_SCOPE_AGENT);
    return idx;
}
__device__ __forceinline__ Item make_item(bool meta, int b, int qb) {
    Item it;
    if (meta) { it.qrow0 = 0; it.qk0 = -(MBLK - 64); it.nt = 1; it.tokbase = MBLK; }
    else { it.qrow0 = MBLK + b * SEQ + qb * 256; it.qk0 = 64 + qb * 256; it.nt = 4 * (qb + 1) + 1; it.tokbase = MBLK + b * SEQ; }
    return it;
}
}


constexpr int PH_PER_LAYER = 19, N_PHASES = 2 * PH_PER_LAYER;
__device__ __forceinline__ unsigned char* uni_ptr(unsigned char* p) { const unsigned long long v = (unsigned long long)p; const unsigned lo = __builtin_amdgcn_readfirstlane((unsigned)v), hi = __builtin_amdgcn_readfirstlane((unsigned)(v >> 32)); return (unsigned char*)(((unsigned long long)hi << 32) | lo); }
__device__ __forceinline__ const float* arg_in(const Args& a, int k) { asm volatile("" : "+s"(k)); return a.in[k]; }
__global__ void __launch_bounds__(NWAVES * 64, 2) mega_fwd(Args args) {
    extern __shared__ __attribute__((aligned(16))) unsigned char lds_raw[];
    {
        LAS unsigned char* l0 = (LAS unsigned char*)lds_raw;
        for (int u = threadIdx.x; u < (LDS_BYTES - LDSCTL_OFF) / 4; u += NWAVES * 64) ((LAS unsigned*)(l0 + LDSCTL_OFF))[u] = 0u;
        __syncthreads();
    }
#if MK_ONE_LAUNCH
    (void)xcd_barrier_post((unsigned*)(args.ws + WS_CTL) + CW_BAR, (volatile LAS unsigned*)((LAS unsigned char*)lds_raw + LDSCTL_OFF + 64));
#define GRID_BAR() do { XcdBarrier bar_; bar_.bar = (unsigned*)(uni_ptr(args.ws) + WS_CTL) + CW_BAR; bar_.x = xb_xcc_id(); bar_.st = (volatile LAS unsigned*)((LAS unsigned char*)lds_raw + LDSCTL_OFF + 64); xcd_barrier(bar_); } while (0)
#else
#define GRID_BAR() do {} while (0)
#endif
    const int lo = args.ph_lo, hi = args.ph_hi;
#define IN(k) (lo <= (k) && (k) < hi)
#define SEAM(k) do { if (IN((k) + 1)) GRID_BAR(); } while (0)
#define PH_BEGIN \
    int tid_ = threadIdx.x; asm volatile("" : "+v"(tid_)); \
    Ctx F; F.lds = (LAS unsigned char*)lds_raw; F.tid = tid_; F.lane = tid_ & 63; F.wave = __builtin_amdgcn_readfirstlane(tid_ >> 6); \
    F.G = gridDim.x; F.bid = blockIdx.x; F.gw = F.bid * NWAVES + F.wave; F.ngw = F.G * NWAVES; \
    unsigned char* ws = uni_ptr(args.ws); asm volatile("" : "+s"(ws)); ws = (unsigned char*)(__attribute__((address_space(1))) unsigned char*)(unsigned long long)ws;     \
    int ly = __builtin_amdgcn_readfirstlane(layer); asm volatile("" : "+s"(ly)); (void)ly; (void)F
#define XN_ ((bf16_t*)(ws + WS_XN))
#define P_ ((bf16_t*)(ws + WS_P))
#define HMETA_ ((float*)(ws + WS_HMETA))
#define RSQ_(ly) ((rs_t*)(ws + WS_CTL + WS_RS2) + (size_t)(2 * (ly)) * R)
#define RSKV_(ly) ((rs_t*)(ws + WS_CTL + WS_RS2) + (size_t)(2 * (ly) + 1) * R)
#define BM_ ((unsigned*)(ws + WS_BM))
#define RS_(i) ((rs_t*)(ws + WS_CTL + WS_RS) + (size_t)(i) * R)
#define GPERM_ ((float*)(ws + WS_RSTD + 512 * 1024))
#define WB_(off) ((bf16_t*)(ws + WS_WB + (off)))
#define OUT_ (args.out)
#define LAMBDA_INIT(ly) ((ly) == 0 ? 0.2f : (0.8f - 0.6f * 0.7408182206817179f))

#pragma unroll
    for (int layer = 0; layer < 2; ++layer) {
        const int pb = layer * PH_PER_LAYER;
        if (((PHMASK >> 0) & 1) && IN(pb + 0)) {
            PH_BEGIN;
            for (int rep_ = 0; rep_ < NREP(0); ++rep_) { if (rep_) GRID_BAR();
            const float* meta = arg_in(args, 1);
            conv_matrix<1>(F, arg_in(args, 3) + (size_t)ly * DM * D_IN, DM, D_IN, WB_(WB_IN), arg_in(args, 2) + ly * DM);
            conv_matrix<0>(F, arg_in(args, 7) + (size_t)ly * 512 * 1536, 512, 1536, WB_(WB_QUP), arg_in(args, 5) + ly * 512);
            conv_matrix<0>(F, arg_in(args, 8) + (size_t)ly * 512 * 2048, 512, 2048, WB_(WB_KVUP), arg_in(args, 6) + ly * 512);
            for (int b = 0; b < 3; ++b) conv_matrix<0>(F, arg_in(args, 14) + ((size_t)ly * 3 + b) * 1024 * DM, 1024, DM, WB_(WB_BR) + (size_t)b * DM * 1024, nullptr);
            conv_matrix<0>(F, arg_in(args, 15) + (size_t)ly * DM * DM, DM, DM, WB_(WB_O), nullptr);
            conv_matrix<2>(F, arg_in(args, 17) + (size_t)ly * DM * 2 * DFF, DM, 2 * DFF, WB_(WB_F1), arg_in(args, 16) + ly * DM);
            conv_matrix<0>(F, arg_in(args, 18) + (size_t)ly * DFF * DM, DFF, DM, WB_(WB_F2), nullptr);
            unsigned zu = 0u; asm volatile("" : "+v"(zu)); const float zf = __uint_as_float(zu);
            for (int i = F.gw * 64 + F.lane; i < 112 * 2048 / 8; i += F.ngw * 64) *((u32x4*)(WB_(WB_IN) + (size_t)1168 * 2048) + i) = (u32x4){zu, zu, zu, zu};
            if (F.bid == 0) { const int i = F.tid; const int t = i >> 7, ps = i & 127, dim = (ps >> 1) + 64 * (ps & 1);
                const float* gsrc = (t < 2 ? arg_in(args, 10) : arg_in(args, 11)) + ly * 256 + (t & 1) * 128; GPERM_[i] = gsrc[dim]; }
            float* hmeta = HMETA_;
            if (ly == 0) {
                for (int i = F.gw * 64 + F.lane; i < MROW0 * PW / 8; i += F.ngw * 64) *((u32x4*)P_ + i) = (u32x4){zu, zu, zu, zu};
                for (int i = F.gw * 64 + F.lane; i < MBLK * DM / 4; i += F.ngw * 64) { const int rr = i / (DM / 4); f32x4 v = (f32x4){zf, zf, zf, zf};
                    if (rr >= MBLK - NMETA) v = *((const f32x4*)meta + (i - (MBLK - NMETA) * (DM / 4))); *((f32x4*)hmeta + i) = v; }
            }
            if (ly == 0) {
                const float* xin = arg_in(args, 0); bf16_t* XN = XN_; rs_t* rs0 = RS_(0);
                for (int r = MROW0 + F.gw; r < R; r += 2 * F.ngw) {
                    const int r2 = (r + F.ngw < R) ? r + F.ngw : r; f32x4 va[8], vb[8];
                    norm_load(r < MBLK ? meta + (size_t)(r - MROW0) * DM : xin + (size_t)(r - MBLK) * DM, F.lane, va); norm_load(r2 < MBLK ? meta + (size_t)(r2 - MROW0) * DM : xin + (size_t)(r2 - MBLK) * DM, F.lane, vb);
                    norm_fin(va, XN + (size_t)r * DM, rs0 + r, F.lane); if (r2 != r) norm_fin(vb, XN + (size_t)r2 * DM, rs0 + r2, F.lane); }
            }
            }
            SEAM(pb + 0);
        }
        if (((PHMASK >> 1) & 1) && IN(pb + 1)) {
            PH_BEGIN;
            { SkP f{P_, 0, RS_(2 * ly), 1.f / DM, RSQ_(ly), RSKV_(ly)}; skinny_gemm(F.lds, XN_ + (size_t)MROW0 * DM, DM, WB_(WB_IN), DM, 1280 / 16, F.bid, F.G, f); }
            SchedPlain S{XN_, DM, WB_(WB_IN), DM, NPMM, 5, F.G, F.bid, 0}; EpiP<true> E{P_, RS_(2 * ly), RS_(2 * ly), 1 << 30, 1.f / DM, RSQ_(ly), RSKV_(ly)};
            pg8::gemm_phase(F.lds, S, E);
            if (NREP(1) == 2) { GRID_BAR(); pg8::gemm_phase(F.lds, S, E); }
            SEAM(pb + 1);
        }
        if (((PHMASK >> 2) & 1) && IN(pb + 2)) {
            PH_BEGIN;
            { SkP f{P_, C_QRAW, RSQ_(ly), 1.f / 512.f, nullptr, nullptr}; skinny_gemm(F.lds, P_ + (size_t)MROW0 * PW + C_CQ, PW, WB_(WB_QUP), 512, 1536 / 16, F.bid, F.G, f); }
            { SkP f{P_, C_KVRAW, RSKV_(ly), 1.f / 512.f, nullptr, nullptr}; skinny_gemm(F.lds, P_ + (size_t)MROW0 * PW + C_CKV, PW, WB_(WB_KVUP), 512, 2048 / 16, F.bid, F.G, f); }
            SchedMlaUp S{P_, WB_(WB_QUP), WB_(WB_KVUP), F.G, F.bid}; EpiP<false> E{P_, RSQ_(ly), RSKV_(ly), 6, 1.f / 512.f, nullptr, nullptr};
            pg8::gemm_phase(F.lds, S, E);
            if (NREP(2) == 2) { GRID_BAR(); pg8::gemm_phase(F.lds, S, E); }
            SEAM(pb + 2);
        }
        if (((PHMASK >> 3) & 1) && IN(pb + 3)) {
            PH_BEGIN;
            const float* mla_qkg = arg_in(args, 9) + ly * 2 * 192;
            bf16_t* P = P_;
            LAS float* rnl = (LAS float*)(F.lds + F.wave * 64);
            for (int r = MROW0 + F.gw; r < R; r += 2 * F.ngw) {
                const int r2 = (r + F.ngw < R) ? r + F.ngw : r; u32x4 va[9], vb[9]; unsigned ia, ib;
                post2_load(P, r, F.lane, va, ia); post2_load(P, r2, F.lane, vb, ib);
                post2_row(P, r, va, ia, mla_qkg, rnl, F.lane); if (r2 != r) post2_row(P, r2, vb, ib, mla_qkg, rnl, F.lane); }
            SEAM(pb + 3);
        }
        if (((PHMASK >> 4) & 1) && IN(pb + 4)) {
            PH_BEGIN;
            bf16_t* P = P_;
            LAS int* slot = (LAS int*)(F.lds + LDSCTL_OFF + 128);
            for (int rep_ = 0; rep_ < NREP(4); ++rep_) { if (rep_) GRID_BAR();
            unsigned* ctr = (unsigned*)(ws + WS_CTL) + CW_Q + 64 * (ly * 4 + 0) + 64 * 16 * rep_;
            const bool stat = (F.G == 256); const int sx = F.bid & 7, spl = (F.bid >> 3) >> 2, sj = (F.bid >> 3) & 3;
            if (!stat) fa::queue_prime(ctr, slot);
            for (int qk_ = 0;; ++qk_) {
                int idx;
                if (stat) { if (qk_ < 4) { const int pr = sx + 8 * (spl + 8 * (qk_ >> 1)), qb = (qk_ & 1) ? sj : 7 - sj; idx = (7 - qb) * 128 + pr; } else idx = (qk_ == 4 && F.bid < 8) ? 1024 + F.bid : 1 << 30; }
                else idx = fa::queue_next(ctr, slot, qk_);
                if (idx >= 8 * 129) break;
                int h; fa::Item it;
                if (idx < 1024) { const int qb = 7 - (idx >> 7), rest = idx & 127; h = rest & 7; it = fa::make_item(false, rest >> 3, qb); } else { h = idx - 1024; it = fa::make_item(true, 0, 0); }
                bf16x8 qr[12]; fa::load_q<192>(P, it, C_QRAW + h * 192, qr);
                fa::attn_core<192, 128, false>(P, it, qr, C_KVRAW + h * 256, C_KPEH + h * 64, C_KVRAW + h * 256 + 128, C_OA + h * 128, 0, nullptr, F.lds);
            } }
            SEAM(pb + 4);
        }
        if (((PHMASK >> 5) & 1) && IN(pb + 5)) {
            PH_BEGIN;
            { SkP f{P_, 1280, RS_(2 * ly), 1.f / DM, nullptr, nullptr}; skinny_gemm(F.lds, XN_ + (size_t)MROW0 * DM, DM, WB_(WB_IN) + (size_t)1280 * DM, DM, 7168 / 16, F.bid, F.G, f); }
            SchedPlain S{XN_, DM, WB_(WB_IN) + (size_t)1280 * DM, DM, NPMM, 28, F.G, F.bid, 1280}; EpiG2 E{P_, RS_(2 * ly), GPERM_, (LAS float*)(F.lds + RING_BYTES)};
            pg8::gemm_phase(F.lds, S, E);
            if (NREP(5) == 2) { GRID_BAR(); pg8::gemm_phase(F.lds, S, E); }
            SEAM(pb + 5);
        }
        if (((PHMASK >> 6) & 1) && IN(pb + 6)) {
            PH_BEGIN;
            bf16_t* P = P_; const float* gp = GPERM_;
            if (F.gw < NMETA) meta_post_row(P, MROW0 + F.gw, gp, F.lane);
        }
        if (((PHMASK >> 7) & 1) && IN(pb + 7)) {
            PH_BEGIN;
            bf16_t* P = P_; unsigned* bm = BM_;
            unsigned* ctr = (unsigned*)(ws + WS_CTL) + CW_Q + 64 * (ly * 4 + 2);
            LAS int* slot = (LAS int*)(F.lds + LDSCTL_OFF + 128);
            for (int rep_ = 0; rep_ < NREP(7); ++rep_) { if (rep_) GRID_BAR(); unsigned* c2 = ctr + 64 * 16 * rep_;
            for (;;) { const int idx = fa::next_item(c2, slot); if (idx >= NTOK / 8) break; index_unit(P, idx, bm, F.lds); } }
            SEAM(pb + 7);
        }
        if (((PHMASK >> 8) & 1) && IN(pb + 8)) {
            PH_BEGIN;
            bf16_t* P = P_; unsigned* bm = BM_;
            LAS int* slot = (LAS int*)(F.lds + LDSCTL_OFF + 128);
            for (int rep_ = 0; rep_ < NREP(8); ++rep_) { if (rep_) GRID_BAR();
            const bool dummy = (NREP(8) == 2) && rep_ == 0;
            unsigned* ctr = (unsigned*)(ws + WS_CTL) + CW_Q + 64 * (ly * 4 + 1) + 64 * 16 * rep_;
            const bool stat = (F.G == 256); const int sx = F.bid & 7, spl = (F.bid >> 3) >> 2, sj = (F.bid >> 3) & 3;
            if (!stat) fa::queue_prime(ctr, slot);
            for (int qk_ = 0;; ++qk_) {
                int idx;
                if (stat) { if (qk_ < 8) { const int pr = sx + 8 * (spl + 8 * ((qk_ >> 1) & 1)), qb = (qk_ & 1) ? sj : 7 - sj; idx = (7 - qb) * 256 + ((qk_ >> 2) ? 128 : 0) + pr; } else idx = (qk_ == 8 && F.bid < 16) ? 2048 + F.bid : 1 << 30; }
                else idx = fa::queue_next(ctr, slot, qk_);
                if (idx >= 16 * 129) break;
                int hh; bool meta = false; fa::Item it; int b = 0, qb = 0;
                if (idx < 2048) { qb = 7 - (idx >> 8); const int rest = idx & 255; hh = (rest < 128) ? 8 + (rest & 7) : (rest & 7); b = (rest & 127) >> 3; it = fa::make_item(false, b, qb); }
                else { hh = idx - 2048; hh = hh < 8 ? 8 + hh : hh - 8; meta = true; it = fa::make_item(true, 0, 0); }
                if (hh < 8) {
                    bf16x8 qr[8]; fa::load_q<128>(P, it, C_DQ + hh * 128, qr);
                    fa::attn_core<128, 128, true>(P, it, qr, C_DK + hh * 128, 0, C_DV + hh * 128, dummy ? C_KPE : C_OB + hh * 128, 0, meta ? nullptr : bm + (size_t)(b * SEQ + qb * 256) * BMW, F.lds);
                } else {
                    const int hj = hh - 8;
                    bf16x8 qr[8]; fa::load_q<128>(P, it, C_FQ + hj * 128, qr);
                    fa::attn_core<128, 256, false>(P, it, qr, C_FK + hj * 128, 0, C_FV + (hj >> 1) * 256, dummy ? C_KPE : C_FQ + hj * 128, dummy ? C_KPE : C_IQ + hj * 128, nullptr, F.lds);
                }
            } }
            SEAM(pb + 8);
        }
        if (((PHMASK >> 9) & 1) && IN(pb + 9)) {
            PH_BEGIN;
            const float* diff_lam = arg_in(args, 12) + ly * 4 * 128; const float* diff_subg = arg_in(args, 13) + ly * 256;
            const float lambda_init = LAMBDA_INIT(ly);
            const float s1 = wave_sum(diff_lam[F.lane] * diff_lam[128 + F.lane] + diff_lam[64 + F.lane] * diff_lam[192 + F.lane]);
            const float s2 = wave_sum(diff_lam[256 + F.lane] * diff_lam[384 + F.lane] + diff_lam[320 + F.lane] * diff_lam[448 + F.lane]);
            const float lam = __expf(s1) - __expf(s2) + lambda_init;
            bf16_t* P = P_;
            for (int r = MROW0 + F.gw; r < R; r += 4 * F.ngw) {
                int rr_[4]; u32x4 vv[4][4];
#pragma unroll
                for (int k = 0; k < 4; ++k) { rr_[k] = (r + k * F.ngw < R) ? r + k * F.ngw : r; post3_load(P, rr_[k], F.lane, vv[k]); }
#pragma unroll
                for (int k = 0; k < 4; ++k) if (k == 0 || rr_[k] != r) post3_row(P, rr_[k], vv[k], diff_subg, lam, 1.f - lambda_init, F.lane); }
        }
#define GATE_PHASE(k, b, sk, seam) \
        if (((PHMASK >> 10) & 1) && IN(pb + (k))) { \
            PH_BEGIN; \
            { SkGate f{(bf16_t*)(ws + WS_GS), arg_in(args, 4) + ly * 3 * DM + (b) * DM, RS_(2 * ly)}; skinny_gemm(F.lds, XN_ + (size_t)MROW0 * DM, DM, WB_(WB_G) + (size_t)(b) * 2048 * DM, DM, 2048 / 16, (F.bid + (sk)) % F.G, F.G, f); } \
            SchedPlain S{XN_, DM, WB_(WB_G) + (size_t)(b) * 2048 * DM, DM, NPMM, 8, F.G, F.bid, 0}; EpiGate E{(bf16_t*)(ws + WS_GS), arg_in(args, 4) + ly * 3 * DM + (b) * DM, RS_(2 * ly)}; \
            pg8::gemm_phase(F.lds, S, E); \
            if (NREP(k) == 2) { GRID_BAR(); pg8::gemm_phase(F.lds, S, E); } \
            if (seam) SEAM(pb + (k)); \
        }
#define BRANCH_PHASE(k, b, oc, sk, seam) \
        if (((PHMASK >> 10) & 1) && IN(pb + (k))) { \
            PH_BEGIN; \
            { SkGated f{P_, (const bf16_t*)(ws + WS_GS), (b) == 0 ? 1 : 0}; skinny_gemm(F.lds, P_ + (size_t)MROW0 * PW + (oc), PW, WB_(WB_BR) + (size_t)(b) * DM * 1024, 1024, 2048 / 16, (F.bid + (sk)) % F.G, F.G, f); } \
            SchedPlain S{P_ + (oc), PW, WB_(WB_BR) + (size_t)(b) * DM * 1024, 1024, NPMM, 8, F.G, F.bid, C_MERGED}; EpiGated E{P_, (const bf16_t*)(ws + WS_GS), (b) == 0 ? 1 : 0, ((DBG_BM >> (b)) & 1) ? 1.f : 0.f}; \
            pg8::gemm_phase(F.lds, S, E); \
            if (NREP(k) == 2 && (b) == 0) { GRID_BAR(); pg8::gemm_phase(F.lds, S, E); } \
            if (seam) SEAM(pb + (k)); \
        }
        GATE_PHASE(10, 0, 0, 0) BRANCH_PHASE(11, 0, C_OA, 0, 0)
        GATE_PHASE(12, 1, 0, 0) BRANCH_PHASE(13, 1, C_OB, 0, 0)
        GATE_PHASE(14, 2, 0, 1) BRANCH_PHASE(15, 2, C_OC, 128, 1)
        if (((PHMASK >> 11) & 1) && IN(pb + 16)) {
            PH_BEGIN;
            { SkRes f{HMETA_, XN_, RS_(2 * ly + 1)}; skinny_gemm(F.lds, P_ + (size_t)MROW0 * PW + C_MERGED, PW, WB_(WB_O), DM, 2048 / 16, F.bid, F.G, f); }
            SchedPlain S{P_ + C_MERGED, PW, WB_(WB_O), DM, NPMM, 8, F.G, F.bid, 0}; EpiRes E{(float*)nullptr, DBG_SA, XN_, RS_(2 * ly + 1)};
            pg8::gemm_phase(F.lds, S, E);
            SEAM(pb + 16);
        }
        if (((PHMASK >> 13) & 1) && IN(pb + 17)) {
            PH_BEGIN;
            skinny_swiglu(F.lds, XN_ + (size_t)MROW0 * DM, DM, WB_(WB_F1), DM, P_, RS_(2 * ly + 1), F.bid, F.G);
            SchedPlain S{XN_, DM, WB_(WB_F1), DM, NPMM, 44, F.G, F.bid, 0}; EpiSwiglu E{P_, RS_(2 * ly + 1)};
            pg8::gemm_phase(F.lds, S, E);
            if (NREP(17) == 2) { GRID_BAR(); pg8::gemm_phase(F.lds, S, E); }
            SEAM(pb + 17);
        }
        if (((PHMASK >> 14) & 1) && IN(pb + 18)) {
            PH_BEGIN;
            { SkRes f{HMETA_, ly == 0 ? XN_ : (bf16_t*)nullptr, RS_(2)}; skinny_gemm(F.lds, P_ + (size_t)MROW0 * PW, PW, WB_(WB_F2), DFF, 2048 / 16, F.bid, F.G, f); }
            SchedPlain S{P_, PW, WB_(WB_F2), DFF, NPMM, 8, F.G, F.bid, 0}; EpiRes E{ly == 0 ? (float*)nullptr : OUT_, DBG_SF, XN_, RS_(2)};
            pg8::gemm_phase(F.lds, S, E);
            SEAM(pb + 18);
        }
    }
#undef IN
#undef SEAM
}

__global__ void diag_fill(float* out, int n, float v) { for (int i = blockIdx.x * blockDim.x + threadIdx.x; i < n; i += gridDim.x * blockDim.x) out[i] = v; }
extern "C" void kernel_launch(void* const* d_in, const int* in_sizes, int n_in, void* d_out, int out_size, void* d_ws, size_t ws_size, hipStream_t stream) {
    static int grid = 0; static float code = 0.f;
    if (grid == 0) {
        int dev = 0, cus = 0;
        if (n_in != 19) { code = 10.f; grid = -1; }
        else if (ws_size < WS_END) { code = 20.f + (float)(ws_size >> 20) * 0.01f; grid = -1; }
        else if (hipGetDevice(&dev) != hipSuccess || hipDeviceGetAttribute(&cus, hipDeviceAttributeMultiprocessorCount, dev) != hipSuccess) { code = 40.f; grid = -1; }
        else if (hipFuncSetAttribute((const void*)mega_fwd, hipFuncAttributeMaxDynamicSharedMemorySize, LDS_BYTES) != hipSuccess) { code = 50.f; grid = -1; }
        else {
            int per_cu = 0;
            if (hipOccupancyMaxActiveBlocksPerMultiprocessor(&per_cu, (const void*)mega_fwd, NWAVES * 64, LDS_BYTES) != hipSuccess || per_cu < 1) { code = 60.f; grid = -1; }
            (void)hipGetLastError();
            if (grid == 0) grid = cus;
        }
    }
    if (grid < 0) { hipLaunchKernelGGL(diag_fill, dim3(1024), dim3(256), 0, stream, (float*)d_out, out_size, code); return; }
    (void)hipMemsetAsync((char*)d_ws + WS_CTL, 0, CTL_BYTES, stream);
    Args a{};
    for (int i = 0; i < 19; ++i) a.in[i] = (const float*)d_in[i];
    a.out = (float*)d_out; a.ws = (unsigned char*)d_ws;
#if MK_ONE_LAUNCH
    a.ph_lo = 0; a.ph_hi = N_PHASES;
    hipLaunchKernelGGL(mega_fwd, dim3(grid), dim3(NWAVES * 64), LDS_BYTES, stream, a);
#else
    for (int p = 0; p < N_PHASES; ++p) { a.ph_lo = p; a.ph_hi = p + 1; hipLaunchKernelGGL(mega_fwd, dim3(grid), dim3(NWAVES * 64), LDS_BYTES, stream, a); }
#endif
    if (hipPeekAtLastError() != hipSuccess) { (void)hipGetLastError(); hipLaunchKernelGGL(diag_fill, dim3(1024), dim3(256), 0, stream, (float*)d_out, out_size, 70.f); }
}
```

```cpp
#include <hip/hip_runtime.h>
#include <cstdio>
#include <cstdint>

#ifndef PHMASK
#define PHMASK 0x7fff
#endif
#ifndef REPMASK
#define REPMASK 0
#endif
#define NREP(k) ((((REPMASK) >> (k)) & 1) ? 2 : 1)
#ifndef DBG_BM
#define DBG_BM 7
#endif
#ifndef DBG_BR
#define DBG_BR 0
#endif
#ifndef DBG_SA
#define DBG_SA 1.0f
#endif
#ifndef DBG_SF
#define DBG_SF 1.0f
#endif
#ifndef MK_ONE_LAUNCH
#define MK_ONE_LAUNCH 1
#endif

#define LAS __attribute__((address_space(3)))
#define GAS __attribute__((address_space(1)))
typedef unsigned short bf16_t;
typedef short bf16x8 __attribute__((ext_vector_type(8)));
typedef float f32x4 __attribute__((ext_vector_type(4)));
typedef float f32x2 __attribute__((ext_vector_type(2)));
typedef unsigned u32x4 __attribute__((ext_vector_type(4)));
typedef unsigned u32x2 __attribute__((ext_vector_type(2)));
typedef unsigned long long rs_t;
__device__ __forceinline__ float rs_val(rs_t v) { return (float)((double)v * (1.0 / 4294967296.0)); }
__device__ __forceinline__ rs_t rs_fix(float ss) { return (rs_t)((double)ss * 4294967296.0); }
__device__ __forceinline__ void st_wt(void* p, u32x4 v) { typedef __attribute__((address_space(1))) u32x4 gv; *(gv*)(unsigned long long)p = v; }
__device__ __forceinline__ void st_wt(void* p, f32x4 v) { typedef __attribute__((address_space(1))) f32x4 gv; *(gv*)(unsigned long long)p = v; }

constexpr int DM = 2048, NB = 16, SEQ = 2048, NMETA = 16, MBLK = 256;
constexpr int R = MBLK + NB * SEQ;
constexpr int NPM = R / 256;
constexpr int NPMM = NPM - 1;
constexpr int MROW0 = MBLK - NMETA;
constexpr int NTOK = NB * SEQ;
constexpr int DFF = 5632;
constexpr int PW = 8448;
constexpr int C_CQ = 0, C_CKV = 512, C_KPE = 1024, C_IK = 1088, C_IW = 1152, C_DQ = 1280, C_DK = 2304, C_DV = 3328, C_IQ = 4352,
              C_FQ = 5376, C_FK = 6400, C_FV = 7424;
constexpr int C_KVRAW = 1280, C_QRAW = 3328, C_KPEH = 4864;
constexpr int C_OA = 0, C_OB = C_DQ, C_OC = C_FQ, C_MERGED = 2304;
constexpr int BMW = 66;
constexpr float EPS = 1e-6f;
constexpr float LOG2E = 1.4426950408889634f;
constexpr float C2_128 = 0.08838834764831845f * LOG2E;
constexpr float C2_192 = 0.07216878364870323f * LOG2E;
constexpr int D_IN = 14480;

constexpr size_t MiB = 1u << 20;
constexpr size_t WS_CTL = 0, CTL_BYTES = 2816 * 1024;
constexpr size_t WS_RSTD = 13 * MiB;
constexpr size_t WS_HMETA = 14 * MiB;
constexpr size_t WS_BM = 4 * MiB;
constexpr size_t WS_WB = 16 * MiB;
constexpr size_t WB_IN = 0, WB_G = WB_IN + (size_t)8448 * 2048 * 2, WB_QUP = WB_G + (size_t)6144 * 2048 * 2, WB_KVUP = WB_QUP + (size_t)1536 * 512 * 2,
                 WB_BR = WB_KVUP + (size_t)2048 * 512 * 2, WB_O = WB_BR + (size_t)3 * 2048 * 1024 * 2, WB_F1 = WB_O + (size_t)2048 * 2048 * 2,
                 WB_F2 = WB_F1 + (size_t)11264 * 2048 * 2, WB_END = WB_F2 + (size_t)2048 * 5632 * 2;
constexpr size_t WS_XN = 164 * MiB;
constexpr size_t WS_P = 294 * MiB;
constexpr size_t WS_GS = 828 * MiB;
constexpr size_t WS_END = 960 * MiB;
static_assert(WS_GS + (size_t)R * 2048 * 2 <= WS_END && WS_WB + WB_END <= WS_XN && WS_XN + (size_t)R * 2048 * 2 <= WS_P && WS_P + (size_t)R * PW * 2 <= WS_GS, "ws map");
constexpr int CW_BAR = 4096, CW_Q = 16384;
constexpr size_t WS_RS = 256 * 1024;
constexpr size_t WS_RS2 = 1536 * 1024;
static_assert(WS_RS + (size_t)4 * R * 8 <= WS_RS2 && WS_RS2 + (size_t)4 * R * 8 <= CTL_BYTES && CTL_BYTES <= WS_BM && WS_BM + (size_t)32768 * BMW * 4 <= WS_RSTD && WS_RSTD + 1 * MiB <= WS_HMETA && WS_HMETA + 2 * MiB <= WS_WB, "ctl map");

__device__ __forceinline__ float bf2f(bf16_t v) { return __uint_as_float((unsigned)v << 16); }
__device__ __forceinline__ unsigned f2bf(float f) { unsigned u = __float_as_uint(f); return (u + 0x7fffu + ((u >> 16) & 1u)) >> 16; }
__device__ __forceinline__ unsigned pk2(float lo, float hi) { return f2bf(lo) | (f2bf(hi) << 16); }
typedef __bf16 bf16x2_t __attribute__((ext_vector_type(2)));
__device__ __forceinline__ unsigned cvt_pk_bf16(float lo, float hi) { f32x2 v = {lo, hi}; bf16x2_t b = __builtin_convertvector(v, bf16x2_t); return __builtin_bit_cast(unsigned, b); }
__device__ __forceinline__ float wave_sum(float v) {
#pragma unroll
    for (int o = 1; o < 64; o <<= 1) v += __shfl_xor(v, o);
    return v;
}
__device__ __forceinline__ float wave_max(float v) {
#pragma unroll
    for (int o = 1; o < 64; o <<= 1) v = fmaxf(v, __shfl_xor(v, o));
    return v;
}
#define LDS_WAIT() asm volatile("s_waitcnt lgkmcnt(0)" ::: "memory")
#define VM_WAIT() asm volatile("s_waitcnt vmcnt(0)" ::: "memory")
__device__ __forceinline__ int row_pos(int r) { return r < MBLK ? (r >= MBLK - NMETA ? r - (MBLK - NMETA) : 0) : NMETA + ((r - MBLK) & (SEQ - 1)); }
__device__ __forceinline__ void rope_cs(int pos, int i, float two_over_d, float& c, float& s) {
    const float inv = __builtin_amdgcn_exp2f(-(float)i * two_over_d * 13.287712379549449f);
    float rev = (float)pos * inv * 0.15915494309189535f;
    rev -= floorf(rev);
    s = __builtin_amdgcn_sinf(rev); c = __builtin_amdgcn_cosf(rev);
}

namespace pg8 {
constexpr int BM = 256, BK = 64, HALF = 128, HTB = HALF * BK * 2, STAGE_BYTES = 8 * HTB;
__device__ __forceinline__ int lds_byte(int r, int c) { const int st = (r >> 4) * 2 + (c >> 5), rr = r & 15, cc = c & 31, ob = rr * 64 + cc * 2; return st * 1024 + (ob ^ (((ob >> 9) & 1) << 5)); }
__device__ __forceinline__ void stage_rc(int b, int& R_, int& C_) { const int st = b / 1024, sb = b % 1024, swz = sb ^ (((sb >> 9) & 1) << 5); R_ = (st >> 1) * 16 + swz / 64; C_ = (st & 1) * 32 + (swz % 64) / 2; }
__device__ __forceinline__ int perm32(int rho) { const int n = rho >> 4, i = rho & 15; return 8 * (i >> 2) + 4 * n + (i & 3); }

struct Unit { const char* A; const char* B; unsigned lda2, ldb2; int nt, pm, pn, kind, ocol; };

#ifndef WGM
#define WGM 4
#endif
__device__ __forceinline__ void tile_of(int L, int nM, int nN, int& pm, int& pn) {
    const int nwg = nM * nN; int wgid = L;
    { const int q = nwg / 8, r = nwg % 8, xcd = wgid % 8, off = wgid / 8; wgid = (xcd < r ? xcd * (q + 1) : r * (q + 1) + (xcd - r) * q) + off; }
    const int nig = WGM * nN, gid = wgid / nig, fm = gid * WGM, gsz = (nM - fm) < WGM ? (nM - fm) : WGM;
    pm = fm + ((wgid % nig) % gsz); pn = (wgid % nig) / gsz;
}

template <class Epi, class Sched>
__device__ __forceinline__ void gemm_phase(LAS unsigned char* lds, const Sched& S, const Epi& E) {
    int tid = threadIdx.x; asm volatile("" : "+v"(tid));
    const int wid = __builtin_amdgcn_readfirstlane(tid >> 6), lane = tid & 63, wr = wid >> 2, wc = wid & 3, fr = lane & 15, fq = lane >> 4;
    unsigned rA[2], rB[2], cc[2];
#pragma unroll
    for (int i = 0; i < 2; ++i) { int R_, C_; stage_rc(tid * 16 + i * 8192, R_, C_); rA[i] = (unsigned)R_; rB[i] = (unsigned)(Epi::PERM ? ((R_ & ~31) + perm32(R_ & 31)) : R_); cc[i] = (unsigned)C_ * 2u; }
    const size_t kstep = (size_t)(BK * 2);
    const unsigned ldsw = (unsigned)wid * 1024u;
    const int aoff = lds_byte(wr * 64 + fr, fq * 8), boff = lds_byte(wc * 32 + fr, fq * 8);
#define PG8_SA(b, h) (((b) * 2 + (h)) * HTB)
#define PG8_SB(b, h) ((4 + (b) * 2 + (h)) * HTB)
#ifndef PG8_AUX
#define PG8_AUX 1
#endif
#define PG8_STAGE(bufoff, gbase, rr, ld2) do { _Pragma("unroll") for (int _i = 0; _i < 2; ++_i) \
        __builtin_amdgcn_global_load_lds((const unsigned*)((const char*)(gbase) + ((rr)[_i] * (ld2) + cc[_i])), (LAS unsigned*)(lds + (bufoff) + ldsw + _i * 8192), 16, 0, PG8_AUX); } while (0)
#define PG8_LDA(dst, b, h) do { _Pragma("unroll") for (int m = 0; m < 4; ++m) _Pragma("unroll") for (int k = 0; k < 2; ++k) dst[m][k] = *(const LAS bf16x8*)(lds + PG8_SA(b, h) + aoff + m * 2048 + k * 1024); } while (0)
#define PG8_LDB(dst, b, h) do { _Pragma("unroll") for (int n = 0; n < 2; ++n) _Pragma("unroll") for (int k = 0; k < 2; ++k) dst[n][k] = *(const LAS bf16x8*)(lds + PG8_SB(b, h) + boff + n * 2048 + k * 1024); } while (0)
#define PG8_MMA(ai, bj, At, Bt) do { __builtin_amdgcn_s_setprio(1); _Pragma("unroll") for (int m = 0; m < 4; ++m) _Pragma("unroll") for (int n = 0; n < 2; ++n) _Pragma("unroll") for (int k = 0; k < 2; ++k) \
        acc[ai][bj][m][n] = __builtin_amdgcn_mfma_f32_16x16x32_bf16(Bt[n][k], At[m][k], acc[ai][bj][m][n], 0, 0, 0); __builtin_amdgcn_s_setprio(0); } while (0)
#define PG8_WAIT_V(n) asm volatile("s_waitcnt vmcnt(" #n ")" ::: "memory")
#define PG8_WAIT_L(n) asm volatile("s_waitcnt lgkmcnt(" #n ")" ::: "memory")
#define PG8_BAR __builtin_amdgcn_s_barrier()
#define PG8_SCHED __builtin_amdgcn_sched_barrier(0)
    Unit cur, nxt; int ui = 0;
    if (!S.next(0, cur)) return;
    float zf = 0.f; asm volatile("" : "+v"(zf));
    f32x4 acc[2][2][4][2];
#pragma unroll
    for (int a = 0; a < 2; ++a)
#pragma unroll
        for (int b = 0; b < 2; ++b)
#pragma unroll
            for (int m = 0; m < 4; ++m)
#pragma unroll
                for (int n = 0; n < 2; ++n) acc[a][b][m][n] = (f32x4){zf, zf, zf, zf};
    rs_t pre[8] = {0, 0, 0, 0, 0, 0, 0, 0}; E.prefetch(cur, wr, fr, pre);
    bf16x8 At[4][2], B0[2][2], B1[2][2];
    const char* cA = cur.A; const char* cB = cur.B;
    unsigned lA = cur.lda2, lB = cur.ldb2;
    size_t hA = (size_t)HALF * lA, hB = (size_t)HALF * lB;
    PG8_STAGE(PG8_SB(0, 0), cB, rB, lB); PG8_STAGE(PG8_SB(0, 1), cB + hB, rB, lB); PG8_STAGE(PG8_SA(0, 0), cA, rA, lA); PG8_STAGE(PG8_SA(0, 1), cA + hA, rA, lA);
    if (wr == 1) PG8_BAR;
    PG8_WAIT_V(2); PG8_BAR;
    PG8_STAGE(PG8_SB(1, 0), cB + kstep, rB, lB); PG8_STAGE(PG8_SA(1, 0), cA + kstep, rA, lA); PG8_STAGE(PG8_SB(1, 1), cB + hB + kstep, rB, lB);
    PG8_WAIT_V(6); PG8_BAR;
    for (;;) {
        const bool has_next = S.next(ui + 1, nxt);
        if (!has_next) nxt = cur;
        const char* nA = nxt.A; const char* nB = nxt.B;
        const unsigned lAn = nxt.lda2, lBn = nxt.ldb2;
        const size_t hAn = (size_t)HALF * lAn, hBn = (size_t)HALF * lBn;
        const int nt = cur.nt;
        for (int t = 0; t < nt; t += 2) {
            const bool last = (t == nt - 2);
            const char* a1 = cA + (size_t)(t + 1) * kstep;
            const char* a2 = last ? nA : cA + (size_t)(t + 2) * kstep; const char* b2 = last ? nB : cB + (size_t)(t + 2) * kstep;
            const char* a3 = a2 + kstep; const char* b3 = b2 + kstep;
            const size_t hA2 = last ? hAn : hA, hB2 = last ? hBn : hB;
            const unsigned lA2 = last ? lAn : lA, lB2 = last ? lBn : lB;
            PG8_LDB(B0, 0, 0); PG8_LDB(B1, 0, 1); PG8_SCHED; PG8_LDA(At, 0, 0); PG8_STAGE(PG8_SA(1, 1), a1 + hA, rA, lA);
            PG8_WAIT_V(8); PG8_WAIT_L(0); PG8_BAR; PG8_MMA(0, 0, At, B0); PG8_MMA(0, 1, At, B1); PG8_BAR; PG8_SCHED;
            PG8_LDA(At, 0, 1); PG8_STAGE(PG8_SB(0, 0), b2, rB, lB2); PG8_STAGE(PG8_SB(0, 1), b2 + hB2, rB, lB2); PG8_STAGE(PG8_SA(0, 0), a2, rA, lA2);
            PG8_WAIT_V(8); PG8_WAIT_L(0); PG8_BAR; PG8_MMA(1, 0, At, B0); PG8_MMA(1, 1, At, B1); PG8_BAR; PG8_SCHED;
            PG8_LDB(B0, 1, 0); PG8_LDB(B1, 1, 1); PG8_SCHED; PG8_LDA(At, 1, 0); PG8_STAGE(PG8_SA(0, 1), a2 + hA2, rA, lA2);
            PG8_WAIT_V(8); PG8_WAIT_L(0); PG8_BAR; PG8_MMA(0, 0, At, B0); PG8_MMA(0, 1, At, B1); PG8_BAR; PG8_SCHED;
            PG8_LDA(At, 1, 1); PG8_STAGE(PG8_SB(1, 0), b3, rB, lB2); PG8_STAGE(PG8_SB(1, 1), b3 + hB2, rB, lB2); PG8_STAGE(PG8_SA(1, 0), a3, rA, lA2);
            PG8_WAIT_V(8); PG8_WAIT_L(0); PG8_BAR; PG8_MMA(1, 0, At, B0); PG8_MMA(1, 1, At, B1); PG8_BAR; PG8_SCHED;
        }
        if (wr == 0) PG8_BAR;
        E(acc, cur, wr, wc, fr, fq, pre);
#pragma unroll
        for (int a = 0; a < 2; ++a)
#pragma unroll
            for (int b = 0; b < 2; ++b)
#pragma unroll
                for (int m = 0; m < 4; ++m)
#pragma unroll
                    for (int n = 0; n < 2; ++n) acc[a][b][m][n] = (f32x4){zf, zf, zf, zf};
        if (!has_next) break;
        cur = nxt; cA = nA; cB = nB; hA = hAn; hB = hBn; lA = lAn; lB = lBn; ++ui;
        E.prefetch(cur, wr, fr, pre);
        if (wr == 1) PG8_BAR;
    }
    PG8_WAIT_V(0);
    PG8_BAR;
#undef PG8_SA
#undef PG8_SB
#undef PG8_STAGE
#undef PG8_LDA
#undef PG8_LDB
#undef PG8_MMA
#undef PG8_WAIT_V
#undef PG8_WAIT_L
#undef PG8_BAR
#undef PG8_SCHED
}
}
using pg8::Unit;

struct SchedPlain {
    const bf16_t* A; int lda; const bf16_t* B; int K; int nM, nN, G, c, ocol0;
    __device__ __forceinline__ bool next(int i, Unit& u) const {
        const int L = i * G + c; if (L >= nM * nN) return false;
        int pm, pn; pg8::tile_of(L, nM, nN, pm, pn); pm += 1;
        u.pm = pm; u.pn = pn; u.kind = 0; u.ocol = ocol0 + 256 * pn; u.nt = K / 64; u.lda2 = (unsigned)lda * 2u; u.ldb2 = (unsigned)K * 2u;
        u.A = (const char*)(A + (size_t)pm * 256 * lda); u.B = (const char*)(B + (size_t)pn * 256 * K); return true;
    }
};
struct SchedMlaUp {
    const bf16_t* P; const bf16_t* Wq; const bf16_t* Wkv; int G, c;
    __device__ __forceinline__ bool next(int i, Unit& u) const {
        const int L = i * G + c; if (L >= NPMM * 14) return false;
        int pm, pn; pg8::tile_of(L, NPMM, 14, pm, pn); pm += 1;
        u.pm = pm; u.pn = pn; u.kind = 0; u.nt = 8; u.lda2 = PW * 2u; u.ldb2 = 512 * 2u;
        if (pn < 6) { u.A = (const char*)(P + (size_t)pm * 256 * PW + C_CQ); u.B = (const char*)(Wq + (size_t)pn * 256 * 512); u.ocol = C_QRAW + 256 * pn; }
        else { u.A = (const char*)(P + (size_t)pm * 256 * PW + C_CKV); u.B = (const char*)(Wkv + (size_t)(pn - 6) * 256 * 512); u.ocol = C_KVRAW + 256 * (pn - 6); }
        return true;
    }
};
template <bool SUMS> struct EpiP {
    static constexpr bool PERM = true;
    bf16_t* P; const rs_t* rs; const rs_t* rs2; int split; float inv_dim; rs_t* sq; rs_t* skv;
    __device__ __forceinline__ void prefetch(const Unit& u, int wr, int fr, rs_t (&pre)[8]) const { const rs_t* r_ = (u.pn < split ? rs : rs2); if (r_) { r_ += u.pm * 256 + wr * 64 + fr;
#pragma unroll
        for (int i = 0; i < 8; ++i) pre[i] = r_[(i >> 2) * 128 + (i & 3) * 16]; } }
    __device__ __forceinline__ void operator()(const f32x4 (&acc)[2][2][4][2], const Unit& u, int wr, int wc, int fr, int fq, const rs_t (&pre)[8]) const {
        asm volatile("" : "+v"(fr), "+v"(fq));
        const int row0 = u.pm * 256 + wr * 64 + fr, col0 = u.ocol + wc * 32 + 8 * fq;
        const rs_t* rsel = u.pn < split ? rs : rs2;
        rs_t* sums = (SUMS && u.pn < 4) ? (u.pn < 2 ? sq : skv) : (rs_t*)nullptr;
        float rsc[2][4];
#pragma unroll
        for (int ai = 0; ai < 2; ++ai)
#pragma unroll
            for (int m = 0; m < 4; ++m) rsc[ai][m] = rsel ? __builtin_amdgcn_rsqf(rs_val(pre[ai * 4 + m]) * inv_dim + EPS) : 1.f;
#pragma unroll
        for (int ai = 0; ai < 2; ++ai)
#pragma unroll
            for (int m = 0; m < 4; ++m) { const int row = row0 + ai * 128 + m * 16; bf16_t* rowp = P + (size_t)row * PW + col0;
                const float sc = rsc[ai][m]; float ss = 0.f;
#pragma unroll
                for (int bj = 0; bj < 2; ++bj) { const f32x4 v0 = acc[ai][bj][m][0] * sc, v1 = acc[ai][bj][m][1] * sc;
                    if (SUMS) ss += ((v0[0] * v0[0] + v0[1] * v0[1]) + (v0[2] * v0[2] + v0[3] * v0[3])) + ((v1[0] * v1[0] + v1[1] * v1[1]) + (v1[2] * v1[2] + v1[3] * v1[3]));
                    u32x4 w; w.x = cvt_pk_bf16(v0[0], v0[1]); w.y = cvt_pk_bf16(v0[2], v0[3]); w.z = cvt_pk_bf16(v1[0], v1[1]); w.w = cvt_pk_bf16(v1[2], v1[3]);
                    st_wt(rowp + bj * 128, w); }
                if (SUMS && sums) { ss += __shfl_xor(ss, 16); ss += __shfl_xor(ss, 32); if (fq == 0) (void)__hip_atomic_fetch_add(sums + row, rs_fix(ss), __ATOMIC_RELAXED, __HIP_MEMORY_SCOPE_AGENT); } }
    }
};
struct EpiG2 {
    static constexpr bool PERM = true;
    bf16_t* P; const rs_t* rs; const float* gperm; LAS float* xl;
    __device__ __forceinline__ void prefetch(const Unit& u, int wr, int fr, rs_t (&pre)[8]) const { const rs_t* r_ = rs; if (r_) { r_ += u.pm * 256 + wr * 64 + fr;
#pragma unroll
        for (int i = 0; i < 8; ++i) pre[i] = r_[(i >> 2) * 128 + (i & 3) * 16]; } }
    __device__ __forceinline__ void operator()(const f32x4 (&acc)[2][2][4][2], const Unit& u, int wr, int wc, int fr, int fq, const rs_t (&pre)[8]) const {
        asm volatile("" : "+v"(fr), "+v"(fq));
        const int row0 = u.pm * 256 + wr * 64 + fr, lcol = wc * 32 + 8 * fq, col0 = u.ocol + lcol;
        const int pn = u.pn;
        const bool plain = (pn >= 8 && pn < 12) || pn >= 24, isidx = (pn >= 12 && pn < 16), nrm = !plain && !isidx;
        const int gidx = pn < 4 ? 0 : (pn < 8 ? 1 : (pn < 20 ? 2 : 3));
        f32x4 g0 = (f32x4){1.f, 1.f, 1.f, 1.f}, g1 = g0;
        if (nrm) { g0 = *(const f32x4*)(gperm + gidx * 128 + lcol); g1 = *(const f32x4*)(gperm + gidx * 128 + lcol + 4); }
        float rsc[2][4];
#pragma unroll
        for (int ai = 0; ai < 2; ++ai)
#pragma unroll
            for (int m = 0; m < 4; ++m) rsc[ai][m] = __builtin_amdgcn_rsqf(rs_val(pre[ai * 4 + m]) * (1.f / DM) + EPS);
        if (nrm) {
#pragma unroll
            for (int ai = 0; ai < 2; ++ai)
#pragma unroll
                for (int m = 0; m < 4; ++m)
#pragma unroll
                    for (int bj = 0; bj < 2; ++bj) { const f32x4 a = acc[ai][bj][m][0], b = acc[ai][bj][m][1]; float ss = (a[0] * a[0] + a[1] * a[1]) + (a[2] * a[2] + a[3] * a[3]) + (b[0] * b[0] + b[1] * b[1]) + (b[2] * b[2] + b[3] * b[3]);
                        ss += __shfl_xor(ss, 16); ss += __shfl_xor(ss, 32);
                        if (fq == 0) xl[((wr * 64 + fr + ai * 128 + m * 16) * 2 + bj) * 4 + wc] = ss * rsc[ai][m] * rsc[ai][m]; }
            asm volatile("s_waitcnt lgkmcnt(0)" ::: "memory"); __builtin_amdgcn_s_barrier(); asm volatile("" ::: "memory");
        }
        const int i0 = isidx ? (16 * (wc & 1) + 4 * fq) : (16 * wc + 4 * fq);
        const float tod = isidx ? (2.f / 64.f) : (2.f / 128.f);
        float inv[4];
#pragma unroll
        for (int j = 0; j < 4; ++j) inv[j] = __builtin_amdgcn_exp2f(-(float)(i0 + j) * tod * 13.287712379549449f) * 0.15915494309189535f;
        const float qscale = (pn < 4 || (pn >= 16 && pn < 20)) ? C2_128 : 1.f;
#pragma unroll
        for (int ai = 0; ai < 2; ++ai)
#pragma unroll
            for (int m = 0; m < 4; ++m) { const int row = row0 + ai * 128 + m * 16; bf16_t* rowp = P + (size_t)row * PW + col0;
                float cs[4], sn[4];
                if (!plain) { const float pos = (float)(NMETA + ((row - MBLK) & (SEQ - 1)));
#pragma unroll
                    for (int j = 0; j < 4; ++j) { float rev = pos * inv[j]; rev -= floorf(rev); sn[j] = __builtin_amdgcn_sinf(rev); cs[j] = __builtin_amdgcn_cosf(rev); } }
#pragma unroll
                for (int bj = 0; bj < 2; ++bj) { f32x4 v0 = acc[ai][bj][m][0] * rsc[ai][m], v1 = acc[ai][bj][m][1] * rsc[ai][m];
                    if (!plain) {
                        if (nrm) { const LAS f32x4* xp = (const LAS f32x4*)(xl + ((wr * 64 + fr + ai * 128 + m * 16) * 2 + bj) * 4); const f32x4 pp = *xp;
                            const float rn = __builtin_amdgcn_rsqf(((pp[0] + pp[1]) + (pp[2] + pp[3])) * (1.f / 128.f) + EPS); v0 = v0 * (g0 * rn); v1 = v1 * (g1 * rn); }
                        f32x4 w0, w1;
                        w0[0] = v0[0] * cs[0] - v0[1] * sn[0]; w0[1] = v0[1] * cs[0] + v0[0] * sn[0]; w0[2] = v0[2] * cs[1] - v0[3] * sn[1]; w0[3] = v0[3] * cs[1] + v0[2] * sn[1];
                        w1[0] = v1[0] * cs[2] - v1[1] * sn[2]; w1[1] = v1[1] * cs[2] + v1[0] * sn[2]; w1[2] = v1[2] * cs[3] - v1[3] * sn[3]; w1[3] = v1[3] * cs[3] + v1[2] * sn[3];
                        v0 = w0 * qscale; v1 = w1 * qscale; }
                    u32x4 w; w.x = cvt_pk_bf16(v0[0], v0[1]); w.y = cvt_pk_bf16(v0[2], v0[3]); w.z = cvt_pk_bf16(v1[0], v1[1]); w.w = cvt_pk_bf16(v1[2], v1[3]);
                    st_wt(rowp + bj * 128, w); } }
    }
};
struct EpiGate {
    static constexpr bool PERM = true;
    bf16_t* G; const float* bias; const rs_t* rs;
    __device__ __forceinline__ void prefetch(const Unit& u, int wr, int fr, rs_t (&pre)[8]) const { const rs_t* r_ = rs; if (r_) { r_ += u.pm * 256 + wr * 64 + fr;
#pragma unroll
        for (int i = 0; i < 4; ++i) pre[i] = r_[i * 16]; } }
    __device__ __forceinline__ void operator()(const f32x4 (&acc)[2][2][4][2], const Unit& u, int wr, int wc, int fr, int fq, const rs_t (&pre)[8]) const {
        asm volatile("" : "+v"(fr), "+v"(fq));
        const int row0 = u.pm * 256 + wr * 64 + fr, col0 = u.pn * 256 + wc * 32 + 8 * fq;
        rs_t q1[4];
#pragma unroll
        for (int m = 0; m < 4; ++m) q1[m] = rs[row0 + 128 + m * 16];
        f32x4 bq[2][2];
#pragma unroll
        for (int bj = 0; bj < 2; ++bj) { bq[bj][0] = *(const f32x4*)(bias + col0 + bj * 128); bq[bj][1] = *(const f32x4*)(bias + col0 + bj * 128 + 4); }
#pragma unroll
        for (int ai = 0; ai < 2; ++ai) {
#pragma unroll
            for (int bj = 0; bj < 2; ++bj) { const f32x4 bv0 = bq[bj][0], bv1 = bq[bj][1];
#pragma unroll
                for (int m = 0; m < 4; ++m) { bf16_t* rowp = G + (size_t)(row0 + ai * 128 + m * 16) * 2048 + col0; const float sc = __builtin_amdgcn_rsqf(rs_val(ai == 0 ? pre[m] : q1[m]) * (1.f / DM) + EPS); f32x4 v0 = acc[ai][bj][m][0] * sc + bv0, v1 = acc[ai][bj][m][1] * sc + bv1;
#pragma unroll
                    for (int e = 0; e < 4; ++e) { v0[e] = __builtin_amdgcn_rcpf(1.f + __builtin_amdgcn_exp2f(-v0[e] * LOG2E)); v1[e] = __builtin_amdgcn_rcpf(1.f + __builtin_amdgcn_exp2f(-v1[e] * LOG2E)); }
                    u32x4 w; w.x = cvt_pk_bf16(v0[0], v0[1]); w.y = cvt_pk_bf16(v0[2], v0[3]); w.z = cvt_pk_bf16(v1[0], v1[1]); w.w = cvt_pk_bf16(v1[2], v1[3]);
                    st_wt(rowp + bj * 128, w); } } }
    }
};
struct EpiGated {
    static constexpr bool PERM = true;
    bf16_t* P; const bf16_t* G; int first; float sc;
    __device__ __forceinline__ void prefetch(const Unit&, int, int, rs_t (&)[8]) const {}
    __device__ __forceinline__ void operator()(const f32x4 (&acc)[2][2][4][2], const Unit& u, int wr, int wc, int fr, int fq, const rs_t (&pre)[8]) const {
        asm volatile("" : "+v"(fr), "+v"(fq));
        const int row0 = u.pm * 256 + wr * 64 + fr, lcol0 = u.pn * 256 + wc * 32 + 8 * fq, col0 = u.ocol + wc * 32 + 8 * fq;
        unsigned zu = 0u; asm volatile("" : "+v"(zu));
#pragma unroll
        for (int ai = 0; ai < 2; ++ai) {
            u32x4 gq[4][2], pq[4][2];
#pragma unroll
            for (int m = 0; m < 4; ++m)
#pragma unroll
                for (int bj = 0; bj < 2; ++bj) { gq[m][bj] = *(const u32x4*)(G + (size_t)(row0 + ai * 128 + m * 16) * 2048 + lcol0 + bj * 128); if (DBG_BR == 1) gq[m][bj] = (u32x4){0x3f803f80u, 0x3f803f80u, 0x3f803f80u, 0x3f803f80u};
                    pq[m][bj] = (u32x4){zu, zu, zu, zu}; if (!first) pq[m][bj] = *(const u32x4*)(P + (size_t)(row0 + ai * 128 + m * 16) * PW + col0 + bj * 128); }
#pragma unroll
            for (int m = 0; m < 4; ++m) { bf16_t* rowp = P + (size_t)(row0 + ai * 128 + m * 16) * PW + col0;
#pragma unroll
                for (int bj = 0; bj < 2; ++bj) { const u32x4 g = gq[m][bj], pv = pq[m][bj];
                    const f32x4 v0 = acc[ai][bj][m][0] * sc, v1 = acc[ai][bj][m][1] * sc;
                    float o[8];
                    o[0] = __uint_as_float(pv.x << 16) + __uint_as_float(g.x << 16) * v0[0]; o[1] = __uint_as_float(pv.x & 0xffff0000u) + __uint_as_float(g.x & 0xffff0000u) * v0[1];
                    o[2] = __uint_as_float(pv.y << 16) + __uint_as_float(g.y << 16) * v0[2]; o[3] = __uint_as_float(pv.y & 0xffff0000u) + __uint_as_float(g.y & 0xffff0000u) * v0[3];
                    o[4] = __uint_as_float(pv.z << 16) + __uint_as_float(g.z << 16) * v1[0]; o[5] = __uint_as_float(pv.z & 0xffff0000u) + __uint_as_float(g.z & 0xffff0000u) * v1[1];
                    o[6] = __uint_as_float(pv.w << 16) + __uint_as_float(g.w << 16) * v1[2]; o[7] = __uint_as_float(pv.w & 0xffff0000u) + __uint_as_float(g.w & 0xffff0000u) * v1[3];
                    u32x4 w; w.x = cvt_pk_bf16(o[0], o[1]); w.y = cvt_pk_bf16(o[2], o[3]); w.z = cvt_pk_bf16(o[4], o[5]); w.w = cvt_pk_bf16(o[6], o[7]);
                    st_wt(rowp + bj * 128, w); } }
            asm volatile("" ::: "memory"); }
    }
};
struct EpiRes {
    static constexpr bool PERM = true;
    float* out_f; float dbg; bf16_t* hb; rs_t* rs;
    __device__ __forceinline__ void prefetch(const Unit&, int, int, rs_t (&)[8]) const {}
    __device__ __forceinline__ void operator()(const f32x4 (&acc)[2][2][4][2], const Unit& u, int wr, int wc, int fr, int fq, const rs_t (&pre)[8]) const {
        asm volatile("" : "+v"(fr), "+v"(fq));
        const int lrow0 = wr * 64 + fr, col0 = u.pn * 256 + wc * 32 + 8 * fq;
        bf16_t* hp0 = hb + (size_t)(u.pm * 256 + lrow0) * DM + col0;
        u32x4 bw[2][4][2];
#pragma unroll
        for (int ai = 0; ai < 2; ++ai)
#pragma unroll
            for (int m = 0; m < 4; ++m)
#pragma unroll
                for (int bj = 0; bj < 2; ++bj) bw[ai][m][bj] = *(const u32x4*)(hp0 + (size_t)(ai * 128 + m * 16) * DM + bj * 128);
#pragma unroll
        for (int ai = 0; ai < 2; ++ai)
#pragma unroll
            for (int m = 0; m < 4; ++m) { const int lrow = lrow0 + ai * 128 + m * 16, grow = u.pm * 256 + lrow;
                const size_t foff = ((size_t)(u.pm - 1) * 256 + lrow) * DM + col0; bf16_t* hp = hp0 + (size_t)(ai * 128 + m * 16) * DM; float ss = 0.f;
#pragma unroll
                for (int bj = 0; bj < 2; ++bj) { const u32x4 w = bw[ai][m][bj];
                    const f32x4 b0 = (f32x4){__uint_as_float(w.x << 16), __uint_as_float(w.x & 0xffff0000u), __uint_as_float(w.y << 16), __uint_as_float(w.y & 0xffff0000u)};
                    const f32x4 b1 = (f32x4){__uint_as_float(w.z << 16), __uint_as_float(w.z & 0xffff0000u), __uint_as_float(w.w << 16), __uint_as_float(w.w & 0xffff0000u)};
                    const f32x4 h0 = b0 + acc[ai][bj][m][0] * dbg, h1 = b1 + acc[ai][bj][m][1] * dbg;
                    if (out_f) { st_wt(out_f + foff + bj * 128, h0); st_wt(out_f + foff + bj * 128 + 4, h1); }
                    else { ss += ((h0[0] * h0[0] + h0[1] * h0[1]) + (h0[2] * h0[2] + h0[3] * h0[3])) + ((h1[0] * h1[0] + h1[1] * h1[1]) + (h1[2] * h1[2] + h1[3] * h1[3]));
                        u32x4 o; o.x = cvt_pk_bf16(h0[0], h0[1]); o.y = cvt_pk_bf16(h0[2], h0[3]); o.z = cvt_pk_bf16(h1[0], h1[1]); o.w = cvt_pk_bf16(h1[2], h1[3]); st_wt(hp + bj * 128, o); } }
                if (!out_f) { ss += __shfl_xor(ss, 16); ss += __shfl_xor(ss, 32); if (fq == 0) (void)__hip_atomic_fetch_add(rs + grow, rs_fix(ss), __ATOMIC_RELAXED, __HIP_MEMORY_SCOPE_AGENT); } }
    }
};
struct EpiSwiglu {
    static constexpr bool PERM = true;
    bf16_t* P; const rs_t* rs;
    __device__ __forceinline__ void prefetch(const Unit& u, int wr, int fr, rs_t (&pre)[8]) const { const rs_t* r_ = rs; if (r_) { r_ += u.pm * 256 + wr * 64 + fr;
#pragma unroll
        for (int i = 0; i < 8; ++i) pre[i] = r_[(i >> 2) * 128 + (i & 3) * 16]; } }
    __device__ __forceinline__ void operator()(const f32x4 (&acc)[2][2][4][2], const Unit& u, int wr, int wc, int fr, int fq, const rs_t (&pre)[8]) const {
        asm volatile("" : "+v"(fr), "+v"(fq));
        const int row0 = u.pm * 256 + wr * 64 + fr, col0 = u.pn * 128 + wc * 32 + 8 * fq;
#pragma unroll
        for (int ai = 0; ai < 2; ++ai)
#pragma unroll
            for (int m = 0; m < 4; ++m) { bf16_t* rowp = P + (size_t)(row0 + ai * 128 + m * 16) * PW + col0;
                const float sc = __builtin_amdgcn_rsqf(rs_val(pre[ai * 4 + m]) * (1.f / DM) + EPS);
                float o[8];
#pragma unroll
                for (int n = 0; n < 2; ++n)
#pragma unroll
                    for (int e = 0; e < 4; ++e) { const float g = acc[ai][0][m][n][e] * sc, up = acc[ai][1][m][n][e] * sc; o[n * 4 + e] = g * __builtin_amdgcn_rcpf(1.f + __builtin_amdgcn_exp2f(-g * LOG2E)) * up; }
                u32x4 w; w.x = cvt_pk_bf16(o[0], o[1]); w.y = cvt_pk_bf16(o[2], o[3]); w.z = cvt_pk_bf16(o[4], o[5]); w.w = cvt_pk_bf16(o[6], o[7]);
                st_wt(rowp, w); }
    }
};

struct SkP { bf16_t* P; int ocol; const rs_t* rs; float inv_dim; rs_t* sq; rs_t* skv; struct Pre { rs_t q[4]; };
    __device__ __forceinline__ void load(int r0, int, Pre& p) const { if (rs) {
#pragma unroll
        for (int r = 0; r < 4; ++r) p.q[r] = rs[MROW0 + r0 + r]; } }
    __device__ __forceinline__ void apply(int r0, int c, f32x4 v, const Pre& p) const {
        rs_t* sums = (sq && c < 1024) ? (c < 512 ? sq : skv) : (rs_t*)nullptr;
#pragma unroll
        for (int r = 0; r < 4; ++r) { float x = v[r]; if (rs) x *= __builtin_amdgcn_rsqf(rs_val(p.q[r]) * inv_dim + EPS); P[(size_t)(MROW0 + r0 + r) * PW + ocol + c] = (bf16_t)f2bf(x);
            if (sums) { float ss = x * x; ss += __shfl_xor(ss, 1); ss += __shfl_xor(ss, 2); ss += __shfl_xor(ss, 4); ss += __shfl_xor(ss, 8);
                if ((threadIdx.x & 15) == 0) (void)__hip_atomic_fetch_add(sums + MROW0 + r0 + r, rs_fix(ss), __ATOMIC_RELAXED, __HIP_MEMORY_SCOPE_AGENT); } } } };
struct SkGate { bf16_t* G; const float* bias; const rs_t* rs; struct Pre { rs_t q[4]; float b; };
    __device__ __forceinline__ void load(int r0, int c, Pre& p) const { p.b = bias[c];
#pragma unroll
        for (int r = 0; r < 4; ++r) p.q[r] = rs[MROW0 + r0 + r]; }
    __device__ __forceinline__ void apply(int r0, int c, f32x4 v, const Pre& p) const {
#pragma unroll
        for (int r = 0; r < 4; ++r) { const float x = v[r] * __builtin_amdgcn_rsqf(rs_val(p.q[r]) * (1.f / DM) + EPS); G[(size_t)(MROW0 + r0 + r) * 2048 + c] = (bf16_t)f2bf(__builtin_amdgcn_rcpf(1.f + __builtin_amdgcn_exp2f(-(x + p.b) * LOG2E))); } } };
struct SkGated { bf16_t* P; const bf16_t* G; int first; struct Pre { bf16_t pv[4], g[4]; };
    __device__ __forceinline__ void load(int r0, int c, Pre& p) const {
#pragma unroll
        for (int r = 0; r < 4; ++r) { p.g[r] = G[(size_t)(MROW0 + r0 + r) * 2048 + c]; p.pv[r] = first ? (bf16_t)0 : P[(size_t)(MROW0 + r0 + r) * PW + C_MERGED + c]; } }
    __device__ __forceinline__ void apply(int r0, int c, f32x4 v, const Pre& p) const {
#pragma unroll
        for (int r = 0; r < 4; ++r) P[(size_t)(MROW0 + r0 + r) * PW + C_MERGED + c] = (bf16_t)f2bf(bf2f(p.pv[r]) + bf2f(p.g[r]) * v[r]); } };
struct SkRes { float* hmeta; bf16_t* hb; rs_t* rs; struct Pre { float hm[4]; };
    __device__ __forceinline__ void load(int r0, int c, Pre& p) const {
#pragma unroll
        for (int r = 0; r < 4; ++r) p.hm[r] = hmeta[(size_t)(MROW0 + r0 + r) * DM + c]; }
    __device__ __forceinline__ void apply(int r0, int c, f32x4 v, const Pre& p) const {
#pragma unroll
        for (int r = 0; r < 4; ++r) { const float hv = p.hm[r] + v[r]; hmeta[(size_t)(MROW0 + r0 + r) * DM + c] = hv;
            if (hb) { hb[(size_t)(MROW0 + r0 + r) * DM + c] = (bf16_t)f2bf(hv); float ss = hv * hv; ss += __shfl_xor(ss, 1); ss += __shfl_xor(ss, 2); ss += __shfl_xor(ss, 4); ss += __shfl_xor(ss, 8);
                if ((threadIdx.x & 15) == 0) (void)__hip_atomic_fetch_add(rs + MROW0 + r0 + r, rs_fix(ss), __ATOMIC_RELAXED, __HIP_MEMORY_SCOPE_AGENT); } } } };
template <class Fn>
__device__ __forceinline__ void skinny_gemm(LAS unsigned char* lds, const bf16_t* A, int lda, const bf16_t* Bt, int K, int ntask, int bid, int G, const Fn& f) {
    int tid = threadIdx.x; asm volatile("" : "+v"(tid));
    const int wid = __builtin_amdgcn_readfirstlane(tid >> 6), lane = tid & 63, l15 = lane & 15, kq = lane >> 4;
    LAS f32x4* red = (LAS f32x4*)lds;
    const int kw = K / 8;
    for (int task = bid; task < ntask; task += G) {
        const bf16_t* ap = A + (size_t)l15 * lda + wid * kw + kq * 8;
        const bf16_t* bp = Bt + (size_t)(task * 16 + l15) * K + wid * kw + kq * 8;
        float z = 0.f; asm volatile("" : "+v"(z));
        f32x4 acc = (f32x4){z, z, z, z};
        typename Fn::Pre pre{}; if (wid == 0) f.load(kq * 4, task * 16 + l15, pre);
        for (int k0 = 0; k0 < kw; k0 += 256) {
            bf16x8 fa[8], fb[8];
#pragma unroll
            for (int i = 0; i < 8; ++i) { const int k = (k0 + 32 * i < kw) ? k0 + 32 * i : 0; fa[i] = *(const bf16x8*)(ap + k); fb[i] = *(const bf16x8*)(bp + k); }
#pragma unroll
            for (int i = 0; i < 8; ++i) if (k0 + 32 * i < kw) acc = __builtin_amdgcn_mfma_f32_16x16x32_bf16(fa[i], fb[i], acc, 0, 0, 0);
        }
        red[wid * 64 + lane] = acc;
        LDS_WAIT(); __syncthreads();
        if (wid == 0) {
            f32x4 s = red[lane];
#pragma unroll
            for (int w = 1; w < 8; ++w) s += red[w * 64 + lane];
            f.apply(kq * 4, task * 16 + l15, s, pre);
        }
        __syncthreads();
    }
}
__device__ __forceinline__ void skinny_swiglu(LAS unsigned char* lds, const bf16_t* A, int lda, const bf16_t* Bt, int K, bf16_t* P, const rs_t* rs, int bid, int G) {
    int tid = threadIdx.x; asm volatile("" : "+v"(tid));
    const int wid = __builtin_amdgcn_readfirstlane(tid >> 6), lane = tid & 63, l15 = lane & 15, kq = lane >> 4;
    LAS f32x4* red = (LAS f32x4*)lds;
    const int kw = K / 8;
    for (int task = bid; task < DFF / 16; task += G) {
        const int c0 = task * 16, brow = (c0 >> 7) * 256 + (c0 & 127) + l15;
        const bf16_t* ap = A + (size_t)l15 * lda + wid * kw + kq * 8;
        const bf16_t* bg = Bt + (size_t)brow * K + wid * kw + kq * 8; const bf16_t* bu = bg + (size_t)128 * K;
        float z = 0.f; asm volatile("" : "+v"(z));
        f32x4 ag = (f32x4){z, z, z, z}, au = ag;
        rs_t rq[4] = {0, 0, 0, 0}; if (wid == 0) {
#pragma unroll
            for (int r = 0; r < 4; ++r) rq[r] = rs[MROW0 + kq * 4 + r]; }
        {
            bf16x8 fa[8], fg[8], fu[8];
#pragma unroll
            for (int i = 0; i < 8; ++i) { fa[i] = *(const bf16x8*)(ap + 32 * i); fg[i] = *(const bf16x8*)(bg + 32 * i); fu[i] = *(const bf16x8*)(bu + 32 * i); }
#pragma unroll
            for (int i = 0; i < 8; ++i) { ag = __builtin_amdgcn_mfma_f32_16x16x32_bf16(fa[i], fg[i], ag, 0, 0, 0); au = __builtin_amdgcn_mfma_f32_16x16x32_bf16(fa[i], fu[i], au, 0, 0, 0); }
        }
        red[wid * 64 + lane] = ag; red[512 + wid * 64 + lane] = au;
        LDS_WAIT(); __syncthreads();
        if (wid == 0) {
            f32x4 sg = red[lane], su = red[512 + lane];
#pragma unroll
            for (int w = 1; w < 8; ++w) { sg += red[w * 64 + lane]; su += red[512 + w * 64 + lane]; }
#pragma unroll
            for (int r = 0; r < 4; ++r) { const float sc = __builtin_amdgcn_rsqf(rs_val(rq[r]) * (1.f / DM) + EPS); const float g = sg[r] * sc; su[r] *= sc; P[(size_t)(MROW0 + kq * 4 + r) * PW + c0 + l15] = (bf16_t)f2bf(g * __builtin_amdgcn_rcpf(1.f + __builtin_amdgcn_exp2f(-g * LOG2E)) * su[r]); }
        }
        __syncthreads();
    }
}

#define XB_TMO      128
#define XB_XCNT(j)  (256  + 64 * (j))
#define XB_XSUB(j)  (1280 + 64 * (j))
#define XB_XGEN(j)  (2304 + 64 * (j))
#define XB_TOP      3328
#define XB_TOPGEN   3392
#define XCD_BAR_WORDS 3456
#define XB_SPIN_CAP (1u << 18)
__device__ __forceinline__ unsigned xb_ld(unsigned* p)              { return __hip_atomic_load(p, __ATOMIC_RELAXED, __HIP_MEMORY_SCOPE_AGENT); }
__device__ __forceinline__ unsigned xb_add(unsigned* p, unsigned v) { return __hip_atomic_fetch_add(p, v, __ATOMIC_RELAXED, __HIP_MEMORY_SCOPE_AGENT); }
__device__ __forceinline__ unsigned xb_xcc_id() { return (unsigned)__builtin_amdgcn_s_getreg((3 << 11) | 20) & 0xFu; }
#define XB_SPIN(cond, bar) do { unsigned _sp = 0; while (cond) { __builtin_amdgcn_s_sleep(1); \
    if ((++_sp & 255u) == 0u) { if (xb_ld(&(bar)[XB_TMO])) break; if (_sp > XB_SPIN_CAP) { atomicAdd(&(bar)[XB_TMO], 1u); break; } } } } while (0)
struct XcdBarrier { unsigned* bar; unsigned x; volatile LAS unsigned* st; };
__device__ __forceinline__ XcdBarrier xcd_barrier_post(unsigned* bar, volatile LAS unsigned* st) {
    XcdBarrier b; b.bar = bar; b.x = xb_xcc_id(); b.st = st;
    if (threadIdx.x == 0) (void)xb_add(&bar[XB_XCNT(b.x)], 1u);
    return b;
}
__device__ __forceinline__ void xcd_barrier_complete(unsigned* bar, unsigned x, unsigned& nloc, unsigned& nx) {
    const unsigned G = gridDim.x * gridDim.y * gridDim.z;
    unsigned sum, cnt, mine, sp = 0u;
    for (;;) {
        sum = 0u; cnt = 0u; mine = 0u;
#pragma unroll
        for (unsigned j = 0; j < 16; ++j) { const unsigned c = xb_ld(&bar[XB_XCNT(j)]); sum += c; cnt += (c > 0u) ? 1u : 0u; mine = (j == x) ? c : mine; }
        if (sum == G) break;
        __builtin_amdgcn_s_sleep(1);
        if ((++sp & 255u) == 0u) { if (xb_ld(&bar[XB_TMO])) break; if (sp > XB_SPIN_CAP) { atomicAdd(&bar[XB_TMO], 1u); break; } }
    }
    nloc = mine > 0u ? mine : 1u; nx = cnt > 0u ? cnt : 1u;
}
__device__ __forceinline__ void xcd_barrier(const XcdBarrier& b) {
    asm volatile("s_waitcnt vmcnt(0)" ::: "memory");
    __syncthreads();
    if (threadIdx.x == 0) {
        unsigned* bar = b.bar;
        __builtin_amdgcn_s_waitcnt(0);
        unsigned nloc = b.st[0], nx = b.st[1];
        if (nloc == 0u) { xcd_barrier_complete(bar, b.x, nloc, nx); b.st[0] = nloc; b.st[1] = nx; }
        const unsigned old = xb_add(&bar[XB_XSUB(b.x)], 1u);
        const unsigned gen = old / nloc;
        if (old + 1u == (gen + 1u) * nloc) {
            __builtin_amdgcn_fence(__ATOMIC_RELEASE, "agent");
            asm volatile("s_waitcnt vmcnt(0)" ::: "memory");
            const unsigned og = xb_add(&bar[XB_TOP], 1u);
            const unsigned tg = og / nx;
            if (og + 1u == (tg + 1u) * nx) xb_add(&bar[XB_TOPGEN], 1u);
            else XB_SPIN(xb_ld(&bar[XB_TOPGEN]) == tg, bar);
            __builtin_amdgcn_fence(__ATOMIC_ACQUIRE, "agent");
            xb_add(&bar[XB_XGEN(b.x)], 1u);
            asm volatile("s_waitcnt vmcnt(0)" ::: "memory");
        } else {
            XB_SPIN(xb_ld(&bar[XB_XGEN(b.x)]) == gen, bar);
            __builtin_amdgcn_fence(__ATOMIC_ACQUIRE, "agent");
            asm volatile("s_waitcnt vmcnt(0)" ::: "memory");
        }
    }
    __syncthreads();
}

constexpr int NWAVES = 8;
constexpr int RING_BYTES = 131072, LDS_BYTES = 147456, LDSCTL_OFF = LDS_BYTES - 512;
struct Args {
    const float* in[19]; float* out; unsigned char* ws; int ph_lo, ph_hi;
};
struct Ctx {
    LAS unsigned char* lds; int tid, lane, wave, gw, ngw, G, bid;
};

template <int MAP> __device__ __forceinline__ int wmap(int n, float& sc) {
    sc = 1.f;
    if (MAP == 0) return n;
    if (MAP == 1) {
        if (n < 1088) return n;
        if (n < 3136) { const int m = n - 1088, d = m & 127; return 1280 + (m - d) + (d < 64 ? 2 * d : 2 * (d - 64) + 1); }
        if (n < 4160) return 1280 + (n - 1088);
        if (n < 5184) { const int m = n - 4160, d = m & 63; return 4352 + (m - d) + (d < 32 ? 2 * d : 2 * (d - 32) + 1); }
        if (n < 5248) { const int d = n - 5184; return 1088 + (d < 32 ? 2 * d : 2 * (d - 32) + 1); }
        if (n < 5264) { sc = 0.03125f; return 1152 + (n - 5248); }
        if (n < 7312) { const int m = n - 5264, d = m & 127; return 5376 + (m - d) + (d < 64 ? 2 * d : 2 * (d - 64) + 1); }
        if (n < 8336) return 5376 + (n - 5264);
        return 8448 + (n - 8336);
    }
    if (n < DFF) return (n >> 7) * 256 + (n & 127);
    const int m = n - DFF; return (m >> 7) * 256 + 128 + (m & 127);
}
template <int MAP> __device__ __forceinline__ void conv_matrix(const Ctx& F, const float* W, int K, int N, bf16_t* WT, const float* gain) {
    LAS float* scr = (LAS float*)(F.lds + F.wave * 18432);
    const int lane = F.lane;
    const int nblk = (N + 63) / 64, nit = (K / 64) * nblk;
    const int l31 = lane & 31, lh = lane >> 5, c = lane & 7, nsub = lane >> 3;
    f32x2 wv[32]; f32x4 g0 = (f32x4){1.f, 1.f, 1.f, 1.f}, g1 = g0;
#define CONV_LOAD(item) do { const int kb_ = (item) / nblk, nb_ = (item) - kb_ * nblk, k0_ = 64 * kb_, nn_ = 64 * nb_ + 2 * l31; \
        const float* src_ = W + (size_t)(k0_ + lh) * N + nn_; const bool ok_ = nn_ < N; \
        _Pragma("unroll") for (int i = 0; i < 32; ++i) wv[i] = ok_ ? *(const f32x2*)(src_ + (size_t)(2 * i) * N) : (f32x2){0.f, 0.f}; \
        if (gain) { g0 = *(const f32x4*)(gain + k0_ + 8 * c); g1 = *(const f32x4*)(gain + k0_ + 8 * c + 4); } } while (0)
    int it = F.gw;
    if (it < nit) CONV_LOAD(it);
    while (it < nit) {
        const int kb = it / nblk, nb = it - kb * nblk, k0 = 64 * kb, n0 = 64 * nb;
#pragma unroll
        for (int i = 0; i < 32; ++i) { LAS float* d = scr + (2 * i + lh) * 65 + l31; d[0] = wv[i].x; d[32] = wv[i].y; }
        const f32x4 gc0 = g0, gc1 = g1;
        const int nx = it + F.ngw;
        if (nx < nit) CONV_LOAD(nx);
        LDS_WAIT(); asm volatile("" ::: "memory");
#pragma unroll
        for (int j = 0; j < 8; ++j) { const int n = nsub + 8 * j, ns = n0 + n;
            if (ns < N) { float sc; const int dst = wmap<MAP>(ns, sc); const LAS float* s = scr + (8 * c) * 65 + (n & 1) * 32 + (n >> 1);
                u32x4 o; o.x = pk2(s[0 * 65] * (sc * gc0.x), s[1 * 65] * (sc * gc0.y)); o.y = pk2(s[2 * 65] * (sc * gc0.z), s[3 * 65] * (sc * gc0.w));
                o.z = pk2(s[4 * 65] * (sc * gc1.x), s[5 * 65] * (sc * gc1.y)); o.w = pk2(s[6 * 65] * (sc * gc1.z), s[7 * 65] * (sc * gc1.w));
                *(u32x4*)(WT + (size_t)dst * K + k0 + 8 * c) = o; } }
        LDS_WAIT(); asm volatile("" ::: "memory");
        it = nx;
    }
#undef CONV_LOAD
}

__device__ __forceinline__ void norm_load(const float* hrow, int lane, f32x4 (&v)[8]) {
#pragma unroll
    for (int j = 0; j < 8; ++j) v[j] = *((const f32x4*)hrow + lane + 64 * j);
}
__device__ __forceinline__ void norm_fin(const f32x4 (&v)[8], bf16_t* orow, rs_t* rs_row, int lane) {
    float s = 0.f;
#pragma unroll
    for (int j = 0; j < 8; ++j) s += (v[j].x * v[j].x + v[j].y * v[j].y) + (v[j].z * v[j].z + v[j].w * v[j].w);
    s = wave_sum(s);
    if (lane == 0) *rs_row = rs_fix(s);
#pragma unroll
    for (int j = 0; j < 8; ++j) { u32x2 o; o.x = cvt_pk_bf16(v[j].x, v[j].y); o.y = cvt_pk_bf16(v[j].z, v[j].w); *((u32x2*)orow + lane + 64 * j) = o; }
}

__device__ __forceinline__ void meta_post_row(bf16_t* P, int r, const float* gperm, int lane) {
    bf16_t* p = P + (size_t)r * PW; const int pos = row_pos(r);
    float c128, s128, c64, s64; rope_cs(pos, lane, 2.f / 128.f, c128, s128); rope_cs(pos, lane & 31, 2.f / 64.f, c64, s64);
#pragma unroll 1
    for (int t = 0; t < 4; ++t) {
        const int cb = t == 0 ? C_DQ : (t == 1 ? C_DK : (t == 2 ? C_FQ : C_FK)); const float sc = (t == 0 || t == 2) ? C2_128 : 1.f;
        const float ga = gperm[t * 128 + 2 * lane], gb = gperm[t * 128 + 2 * lane + 1];
#pragma unroll 1
        for (int h = 0; h < 8; ++h) { unsigned* xp = (unsigned*)(p + cb + h * 128) + lane; const unsigned w = *xp; float x1 = __uint_as_float(w << 16), x2 = __uint_as_float(w & 0xffff0000u);
            const float rn = __builtin_amdgcn_rsqf(wave_sum(x1 * x1 + x2 * x2) * (1.f / 128.f) + EPS); x1 *= rn * ga; x2 *= rn * gb;
            *xp = cvt_pk_bf16((x1 * c128 - x2 * s128) * sc, (x2 * c128 + x1 * s128) * sc); }
    }
#pragma unroll 1
    for (int hh = 0; hh < 8; ++hh) { unsigned* xp = (unsigned*)(p + C_IQ + hh * 128) + lane; const unsigned w = *xp; const float x1 = __uint_as_float(w << 16), x2 = __uint_as_float(w & 0xffff0000u);
        *xp = cvt_pk_bf16(x1 * c64 - x2 * s64, x2 * c64 + x1 * s64); }
}
__device__ __forceinline__ void unpack8(const u32x4& w, float (&x)[8]) {
#pragma unroll
    for (int e = 0; e < 4; ++e) { x[2 * e] = __uint_as_float(w[e] << 16); x[2 * e + 1] = __uint_as_float(w[e] & 0xffff0000u); }
}
__device__ __forceinline__ u32x4 pack8(const float (&x)[8]) { u32x4 w; w.x = cvt_pk_bf16(x[0], x[1]); w.y = cvt_pk_bf16(x[2], x[3]); w.z = cvt_pk_bf16(x[4], x[5]); w.w = cvt_pk_bf16(x[6], x[7]); return w; }
__device__ __forceinline__ u32x4 shfl_xor4(const u32x4& w, int m) { u32x4 r; r.x = __shfl_xor(w.x, m); r.y = __shfl_xor(w.y, m); r.z = __shfl_xor(w.z, m); r.w = __shfl_xor(w.w, m); return r; }
__device__ __forceinline__ void post2_load(const bf16_t* P, int r, int lane, u32x4 (&v)[9], unsigned& ikw_) {
    const bf16_t* p = P + (size_t)r * PW; const int hw = lane >> 5, l5 = lane & 31;
    v[0] = *(const u32x4*)(p + C_KPE + (lane & 7) * 8); ikw_ = *((const unsigned*)(p + C_IK) + (lane & 31));
#pragma unroll
    for (int it = 0; it < 4; ++it) { const int h = 2 * it + hw; v[1 + it] = *(const u32x4*)(p + C_QRAW + h * 192 + (l5 < 24 ? l5 : 0) * 8); v[5 + it] = *(const u32x4*)(p + C_KVRAW + h * 256 + (l5 & 15) * 8); }
}
__device__ __forceinline__ void post2_row(bf16_t* P, int r, const u32x4 (&v)[9], unsigned ikw, const float* qkg  , LAS float* rnl, int lane) {
    bf16_t* p = P + (size_t)r * PW;
    const int pos = row_pos(r), hw = lane >> 5, l5 = lane & 31;
    float c64[8], s64[8];
#pragma unroll
    for (int j = 0; j < 8; ++j) rope_cs(pos, 8 * (lane & 3) + j, 2.f / 64.f, c64[j], s64[j]);
    float kp[8]; unpack8(v[0], kp);
    unsigned* ikp = (unsigned*)(p + C_IK) + (lane & 31);
    float kpe_ss = 0.f;
#pragma unroll
    for (int j = 0; j < 8; ++j) kpe_ss += kp[j] * kp[j];
    kpe_ss += __shfl_xor(kpe_ss, 1); kpe_ss += __shfl_xor(kpe_ss, 2); kpe_ss += __shfl_xor(kpe_ss, 4);
#pragma unroll
    for (int it = 0; it < 4; ++it) {
        const int h = 2 * it + hw; const bool act = l5 < 24;
        u32x4* ptr = (u32x4*)(p + C_QRAW + h * 192 + (act ? l5 : 0) * 8);
        float x[8]; unpack8(v[1 + it], x);
        float ss = 0.f;
#pragma unroll
        for (int j = 0; j < 8; ++j) ss += x[j] * x[j];
        if (!act) ss = 0.f;
#pragma unroll
        for (int o = 1; o < 32; o <<= 1) ss += __shfl_xor(ss, o);
        const float rn = 1.0f / sqrtf(ss * (1.f / 192.f) + EPS);
        const int gi = (act ? l5 : 0) * 8;
        const f32x4 g0 = *(const f32x4*)(qkg + gi), g1 = *(const f32x4*)(qkg + gi + 4);
#pragma unroll
        for (int j = 0; j < 4; ++j) { x[j] *= rn * g0[j]; x[4 + j] *= rn * g1[j]; }
        float o[8];
#pragma unroll
        for (int j = 0; j < 8; ++j) { const float pr = __shfl_xor(x[j], 4); const float rot = (l5 & 4) ? (x[j] * c64[j] + pr * s64[j]) : (x[j] * c64[j] - pr * s64[j]); o[j] = (l5 >= 16 ? rot : x[j]) * C2_192; }
        if (act) *ptr = pack8(o);
    }
#pragma unroll
    for (int it = 0; it < 4; ++it) {
        const int h = 2 * it + hw; const bool isk = l5 < 16;
        u32x4* ptr = (u32x4*)(p + C_KVRAW + h * 256 + (l5 & 15) * 8);
        float x[8]; unpack8(v[5 + it], x);
        float ss = 0.f;
#pragma unroll
        for (int j = 0; j < 8; ++j) ss += x[j] * x[j];
        if (!isk) ss = 0.f;
#pragma unroll
        for (int o = 1; o < 32; o <<= 1) ss += __shfl_xor(ss, o);
        const float rn = 1.0f / sqrtf((ss + kpe_ss) * (1.f / 192.f) + EPS);
        if (l5 == 0) rnl[h] = rn;
        const int gi = 192 + (isk ? l5 : 0) * 8;
        const f32x4 g0 = *(const f32x4*)(qkg + gi), g1 = *(const f32x4*)(qkg + gi + 4);
        float o[8];
#pragma unroll
        for (int j = 0; j < 4; ++j) { o[j] = x[j] * rn * g0[j]; o[4 + j] = x[4 + j] * rn * g1[j]; }
        if (isk) *ptr = pack8(o);
    }
    LDS_WAIT(); asm volatile("" ::: "memory");
    { const int hd = lane >> 3, c = lane & 7; const float rn = rnl[hd];
      const f32x4 g0 = *(const f32x4*)(qkg + 192 + 128 + c * 8), g1 = *(const f32x4*)(qkg + 192 + 128 + c * 8 + 4);
      float x[8], o[8];
#pragma unroll
      for (int j = 0; j < 4; ++j) { x[j] = kp[j] * rn * g0[j]; x[4 + j] = kp[4 + j] * rn * g1[j]; }
#pragma unroll
      for (int j = 0; j < 8; ++j) { const float pr = __shfl_xor(x[j], 4); o[j] = (c & 4) ? (x[j] * c64[j] + pr * s64[j]) : (x[j] * c64[j] - pr * s64[j]); }
      *(u32x4*)(p + C_KPEH + hd * 64 + c * 8) = pack8(o); }
    { const float x1 = __uint_as_float(ikw << 16), x2 = __uint_as_float(ikw & 0xffff0000u); float cs, sn; rope_cs(pos, lane & 31, 2.f / 64.f, cs, sn);
      if (lane < 32) *ikp = cvt_pk_bf16(x1 * cs - x2 * sn, x2 * cs + x1 * sn); }
    LDS_WAIT(); asm volatile("" ::: "memory");
}
__device__ __forceinline__ void post3_load(const bf16_t* P, int r, int lane, u32x4 (&rr)[4]) {
    const bf16_t* p = P + (size_t)r * PW; const int hw = lane >> 5, l5 = lane & 31;
#pragma unroll
    for (int h = 0; h < 4; ++h) rr[h] = *(const u32x4*)(p + (hw ? C_IQ : C_FQ) + h * 256 + l5 * 8);
}
__device__ __forceinline__ void post3_row(bf16_t* P, int r, const u32x4 (&rr)[4], const float* subg, float lam, float omli, int lane) {
    bf16_t* p = P + (size_t)r * PW;
    const int hw = lane >> 5, l5 = lane & 31;
#pragma unroll
    for (int h = 0; h < 4; ++h) {
        const u32x4 raw = rr[h];
        const u32x4 praw = shfl_xor4(raw, 16);
        float a[8], b[8]; unpack8(raw, a); unpack8(praw, b);
        float d[8], ss = 0.f;
#pragma unroll
        for (int j = 0; j < 8; ++j) { d[j] = a[j] - lam * b[j]; ss += d[j] * d[j]; }
        if (l5 >= 16) ss = 0.f;
#pragma unroll
        for (int o = 1; o < 64; o <<= 1) ss += __shfl_xor(ss, o);
        const float rn = omli / sqrtf(ss * (1.f / 256.f) + EPS);
        const int dim = hw * 128 + (l5 & 15) * 8;
        const f32x4 g0 = *(const f32x4*)(subg + dim), g1 = *(const f32x4*)(subg + dim + 4);
        float o[8];
#pragma unroll
        for (int j = 0; j < 4; ++j) { o[j] = d[j] * rn * g0[j]; o[4 + j] = d[4 + j] * rn * g1[j]; }
        if (l5 < 16) *(u32x4*)(p + C_OC + h * 256 + dim) = pack8(o);
    }
}

__device__ __forceinline__ void index_unit(const bf16_t* P, int unit, unsigned* bm, LAS unsigned char* lds) {
    typedef float f32x16 __attribute__((ext_vector_type(16)));
    int tid = threadIdx.x; asm volatile("" : "+v"(tid));
    const int wid = __builtin_amdgcn_readfirstlane(tid >> 6), lane = tid & 63, j = lane & 31, hi = lane >> 5;
    const int tb = 255 - (unit >> 4), b = unit & 15, t0 = tb * 8, tokbase = MBLK + b * SEQ;
    const int wmax = (64 + t0 + 7) >> 5;
    LAS unsigned* keys = (LAS unsigned*)lds;
    LAS float* iwl = (LAS float*)(lds + 8 * 2112 * 4);
    if (t0 + 7 + 17 > 256) {
        const unsigned boff = (unsigned)(j * PW + C_IK + hi * 8) * 2u;
#define IX_LOADK(dst, w_) do { const int kr_ = (w_) < 2 ? (MBLK - 64) + 32 * (w_) : tokbase + 32 * ((w_) - 2); const char* bp_ = (const char*)(P + (size_t)kr_ * PW) + boff; \
        _Pragma("unroll") for (int s = 0; s < 4; ++s) dst[s] = *(const bf16x8*)(bp_ + s * 32); } while (0)
        bf16x8 bf[4], bn[4];
        IX_LOADK(bf, wid <= wmax ? wid : 0);
        if (tid < 128) iwl[tid] = bf2f(P[(size_t)(tokbase + t0 + (tid >> 4)) * PW + C_IW + (tid & 15)]);
        LAS unsigned char* al = lds + 8 * 2112 * 4 + 512;
        { const int id0 = tid * 2;
#pragma unroll
          for (int e = 0; e < 2; ++e) { const int id = id0 + e, rw = id >> 3, c = id & 7;
              *(LAS bf16x8*)(al + rw * 144 + c * 16) = *(const bf16x8*)(P + (size_t)(tokbase + t0 + (rw >> 4)) * PW + C_IQ + (rw & 15) * 64 + c * 8); } }
        LDS_WAIT(); __syncthreads();
        bf16x8 af[4][4];
        { const int qa = (j >> 2) & 1, ha = (j & 3) + 4 * (j >> 3);
#pragma unroll
          for (int blk = 0; blk < 4; ++blk)
#pragma unroll
              for (int s = 0; s < 4; ++s) af[blk][s] = *(const LAS bf16x8*)(al + ((2 * blk + qa) * 16 + ha) * 144 + s * 32 + hi * 16); }
        for (int w = wid; w <= wmax; w += 8) {
            IX_LOADK(bn, w + 8 <= wmax ? w + 8 : w);
            const int kidx = 32 * w + j;
#pragma unroll
            for (int blk = 0; blk < 4; ++blk) {
                f32x16 acc = (f32x16){0.f,0.f,0.f,0.f,0.f,0.f,0.f,0.f,0.f,0.f,0.f,0.f,0.f,0.f,0.f,0.f};
#pragma unroll
                for (int s = 0; s < 4; ++s) acc = __builtin_amdgcn_mfma_f32_32x32x16_bf16(af[blk][s], bf[s], acc, 0, 0, 0);
                const int q = 2 * blk + hi;
                const LAS f32x4* iwq = (const LAS f32x4*)(iwl + q * 16);
                float score = 0.f;
#pragma unroll
                for (int g = 0; g < 4; ++g) { const f32x4 wv = iwq[g]; score += fmaxf(acc[4 * g], 0.f) * wv.x + fmaxf(acc[4 * g + 1], 0.f) * wv.y + fmaxf(acc[4 * g + 2], 0.f) * wv.z + fmaxf(acc[4 * g + 3], 0.f) * wv.w; }
                const bool valid = kidx >= 48 && kidx <= 64 + t0 + q; const unsigned u_ = __float_as_uint(score);
                keys[q * 2112 + kidx] = valid ? ((u_ & 0x80000000u) ? ~u_ : (u_ | 0x80000000u)) : 0u;
            }
#pragma unroll
            for (int s = 0; s < 4; ++s) bf[s] = bn[s];
        }
#undef IX_LOADK
        LDS_WAIT(); __syncthreads();
    }
    const int tq = t0 + wid, qk = 64 + tq, nch = qk / 64 + 1;
    unsigned* out = bm + (size_t)(b * SEQ + tq) * BMW;
    if (tq + 17 <= 256) {
        for (int c = 0; c < 33; ++c) { const int kidx = 64 * c + lane; const unsigned long long m = __ballot(kidx >= 48 && kidx <= qk);
            if (lane == 0) { out[2 * c] = (unsigned)m; out[2 * c + 1] = (unsigned)(m >> 32); } }
    } else {
#define IX_SELECT(NC) do { unsigned kreg[NC]; \
        _Pragma("unroll") for (int c = 0; c < NC; ++c) kreg[c] = (c < nch && 64 * c + lane <= qk) ? keys[wid * 2112 + 64 * c + lane] : 0u;     \
        unsigned T = 0u; \
        for (int bit = 31; bit >= 0; --bit) { \
            const unsigned cand = T | (1u << bit); int cnt = 0; \
            _Pragma("unroll") for (int c = 0; c < NC; ++c) cnt += __popcll(__ballot(kreg[c] >= cand)); \
            if (cnt >= 256) T = cand; \
            if (cnt == 256) break; \
        } \
        _Pragma("unroll") for (int c = 0; c < NC; ++c) { const unsigned long long m = __ballot(kreg[c] >= T && kreg[c] != 0u); \
            if (lane == 0) { out[2 * c] = (unsigned)m; out[2 * c + 1] = (unsigned)(m >> 32); } } \
        if (lane < 2 * (33 - NC)) out[2 * NC + lane] = 0u; } while (0)
        if (nch <= 11) IX_SELECT(11); else if (nch <= 22) IX_SELECT(22); else IX_SELECT(33);
#undef IX_SELECT
    }
    LDS_WAIT();
}

namespace fa {
typedef float f32x16 __attribute__((ext_vector_type(16)));
typedef short s16x4 __attribute__((ext_vector_type(4)));
__device__ __forceinline__ int crow(int r, int hi) { return (r & 3) + 8 * (r >> 2) + 4 * hi; }
__device__ __forceinline__ int v_st(int k, int c) { const int kk = (k & ~0xC) | ((k & 4) << 1) | ((k & 8) >> 1); return ((kk >> 3) * 4 + (c >> 5)) * 512 + ((kk & 7) * 32 + (c & 31)) * 2; }
__device__ __forceinline__ int v_rd_base(int lane) { return ((lane & 3) << 3) | (((lane >> 2) & 3) << 6) | (((lane >> 4) & 1) << 5) | (((lane >> 5) & 1) << 8); }
constexpr int v_rd_off(int d0, int ks, int half) { return d0 * 512 + ks * 4096 + half * 2048; }
constexpr int SHM_V = 16384;
template <int DQK, int DV> struct Geo { static constexpr int KP = DQK * 2, SHM_K = 64 * DQK * 2, LDS_K0 = 2 * 64 * DV * 2, LDS_WS = LDS_K0 + 2 * SHM_K, BYTES = LDS_WS + 8 * 256; };
#define FA_KSWZ(row, colB, pitch) ((row) * (pitch) + ((colB) ^ (((row) & 7) << 4)))
#define FA_SBAR() __builtin_amdgcn_sched_barrier(0)

struct Item { int qrow0, qk0, nt, tokbase; };

template <int DQK>
__device__ __forceinline__ void load_q(const bf16_t* P, const Item& it, int qcol, bf16x8 (&qr)[DQK / 16]) {
    int tid = threadIdx.x; asm volatile("" : "+v"(tid));
    const int wid = tid >> 6, lane = tid & 63, r32 = lane & 31, hi = lane >> 5;
    const bf16_t* qp = P + (size_t)(it.qrow0 + wid * 32 + r32) * PW + qcol + hi * 8;
#pragma unroll
    for (int d0 = 0; d0 < DQK / 16; ++d0) qr[d0] = *(const bf16x8*)(qp + d0 * 16);
}

template <int DQK, int DV, bool MASKED>
__device__ __forceinline__ void attn_core(bf16_t* P, const Item& it, const bf16x8 (&qr)[DQK / 16], int k1col, int k2col, int vcol, int ocol, int ocol1, const unsigned* bmq, LAS unsigned char* lds) {
    typedef Geo<DQK, DV> G; constexpr int SHMV = 64 * DV * 2, NDB = DV / 32;
    int tid = threadIdx.x; asm volatile("" : "+v"(tid));
    const int wid = __builtin_amdgcn_readfirstlane(tid >> 6), lane = tid & 63, r32 = lane & 31, hi = lane >> 5;
    LAS unsigned char* V_lds = lds; LAS unsigned char* K_lds = lds + G::LDS_K0; LAS float* wsf = (LAS float*)(lds + G::LDS_WS) + wid * 64;
    const int sr = tid >> 4, sc = (tid & 15) * 8;
    const int vst0 = v_st(sr, sc), vst1 = v_st(32 + sr, sc), kws0 = FA_KSWZ(sr, sc * 2, G::KP), kws1 = FA_KSWZ(sr + 32, sc * 2, G::KP);
    const int xr = tid >> 3, xc = (tid & 7) * 8, kws2 = FA_KSWZ(xr, (128 + xc) * 2, G::KP);
    const unsigned loff0 = (unsigned)(sr * PW + sc) * 2u, loffx = (unsigned)(xr * PW + xc) * 2u;
    const int vb0 = (int)(unsigned)(size_t)V_lds + v_rd_base(lane);
    const int NT = it.nt;
    const int qk = it.qk0 + wid * 32 + r32;
    const bool use_bm = MASKED && (bmq != nullptr);
    const unsigned bmoff = (unsigned)((wid * 32 + r32) * BMW) * 4u;
    float l_reg = 0.f; f32x16 o[NDB];
#pragma unroll
    for (int d = 0; d < NDB; ++d) o[d] = (f32x16){0.f,0.f,0.f,0.f,0.f,0.f,0.f,0.f,0.f,0.f,0.f,0.f,0.f,0.f,0.f,0.f};
    bf16x8 sk0, sk1, sk2, sv0, sv1, sv2, sv3;
#define FA_KROW0(t) ((t) == 0 ? (MBLK - 64) : it.tokbase + 64 * ((t) - 1))
#define FA_LOADK(t) do { const int kr_ = FA_KROW0(t); const char* rb_ = (const char*)(P + (size_t)kr_ * PW); const char* rk_ = rb_ + (size_t)k1col * 2; \
        sk0 = *(const bf16x8*)(rk_ + loff0); sk1 = *(const bf16x8*)(rk_ + (size_t)32 * PW * 2 + loff0); if (DQK == 192) sk2 = *(const bf16x8*)(rb_ + (size_t)k2col * 2 + loffx); } while (0)
#define FA_LOADV(t) do { const char* rv_ = (const char*)(P + (size_t)FA_KROW0(t) * PW) + (size_t)vcol * 2; \
        sv0 = *(const bf16x8*)(rv_ + loff0); sv1 = *(const bf16x8*)(rv_ + (size_t)32 * PW * 2 + loff0); if (DV == 256) { sv2 = *(const bf16x8*)(rv_ + 256 + loff0); sv3 = *(const bf16x8*)(rv_ + 256 + (size_t)32 * PW * 2 + loff0); } } while (0)
#define FA_LOAD(t) do { FA_LOADK(t); FA_LOADV(t); } while (0)
#define FA_WRITE(bf) do { *(LAS bf16x8*)(K_lds + (bf) * G::SHM_K + kws0) = sk0; *(LAS bf16x8*)(K_lds + (bf) * G::SHM_K + kws1) = sk1; \
        *(LAS bf16x8*)(V_lds + (bf) * SHMV + vst0) = sv0; *(LAS bf16x8*)(V_lds + (bf) * SHMV + vst1) = sv1; if (DV == 256) { *(LAS bf16x8*)(V_lds + (bf) * SHMV + 16384 + vst0) = sv2; *(LAS bf16x8*)(V_lds + (bf) * SHMV + 16384 + vst1) = sv3; } \
        if (DQK == 192) *(LAS bf16x8*)(K_lds + (bf) * G::SHM_K + kws2) = sk2; } while (0)
    constexpr int QREG = (DV == 256) ? 3 : DQK / 16;
    constexpr int NQL = DQK / 16 - QREG;
    static_assert(G::BYTES + 8 * NQL * 64 * 16 <= LDSCTL_OFF, "attention LDS budget");
    LAS unsigned char* qx = lds + G::BYTES + (wid * (NQL * 64) + lane) * 16;
    FA_LOAD(0);
    if (QREG < DQK / 16) {
#pragma unroll
        for (int d0 = QREG; d0 < DQK / 16; ++d0) *(LAS bf16x8*)(qx + (d0 - QREG) * 1024) = qr[d0];
    }
    FA_WRITE(0);
    __syncthreads();
    for (int t = 0; t < NT; ++t) {
        const int cur = t & 1;
        unsigned zb = 0u; asm volatile("" : "+v"(zb)); u32x2 bw = (u32x2){zb, zb};
        if (use_bm) bw = *(const u32x2*)((const char*)(bmq + 2 * t) + bmoff);
        if (t + 1 < NT) { FA_LOADK(t + 1); FA_LOADV(t + 1); }
        if (64 * t <= it.qk0 + wid * 32 + 31) {
        f32x16 p0 = (f32x16){0.f,0.f,0.f,0.f,0.f,0.f,0.f,0.f,0.f,0.f,0.f,0.f,0.f,0.f,0.f,0.f}, p1 = p0;
        { LAS unsigned char* kbase = K_lds + cur * G::SHM_K;
          LAS unsigned char* kb[4];
#pragma unroll
          for (int dd = 0; dd < 4; ++dd) kb[dd] = kbase + FA_KSWZ(r32, (dd * 16 + hi * 8) * 2, G::KP);
          constexpr int GS = (DQK == 192 || DV == 256) ? 2 : 4;
#pragma unroll
          for (int g = 0; g < DQK / (16 * GS); ++g) {
              bf16x8 fb0[GS], fb1[GS];
#pragma unroll
              for (int dd = 0; dd < GS; ++dd) { const int d0 = g * GS + dd; LAS unsigned char* a = kb[d0 & 3] + (d0 >> 2) * 128; fb0[dd] = *(const LAS bf16x8*)a; fb1[dd] = *(const LAS bf16x8*)(a + 32 * G::KP); }
              FA_SBAR();
#pragma unroll
              for (int dd = 0; dd < GS; ++dd) { const int d0 = g * GS + dd; bf16x8 qf; if (d0 < QREG) qf = qr[d0 < QREG ? d0 : 0]; else qf = *(const LAS bf16x8*)(qx + (d0 - QREG) * 1024);
                  if (t != 0) p0 = __builtin_amdgcn_mfma_f32_32x32x16_bf16(fb0[dd], qf, p0, 0, 0, 0);
                  p1 = __builtin_amdgcn_mfma_f32_32x32x16_bf16(fb1[dd], qf, p1, 0, 0, 0); }
              FA_SBAR(); } }
        FA_SBAR();
        const float NEG = -__builtin_inff();
        if (use_bm) {
        } else if (t == 0 || 64 * t + 63 > it.qk0 + wid * 32) {
            const int kb_ = 64 * t + 4 * hi;
#pragma unroll
            for (int r = 0; r < 16; ++r) { const int k0 = kb_ + (r & 3) + 8 * (r >> 2), k1 = k0 + 32;
                if (k0 < 48 || k0 > qk) p0[r] = NEG; if (k1 < 48 || k1 > qk) p1[r] = NEG; }
        }
        float ps = 0.f;
#pragma unroll
        for (int r = 0; r < 16; ++r) { p0[r] = __builtin_amdgcn_exp2f(p0[r]); p1[r] = __builtin_amdgcn_exp2f(p1[r]); }
        if (use_bm) {
            const int wx = (int)(bw.x >> (4 * hi)), wy = (int)(bw.y >> (4 * hi));
#pragma unroll
            for (int r = 0; r < 16; ++r) { const int c = (r & 3) + 8 * (r >> 2);
                p0[r] = __uint_as_float(__float_as_uint(p0[r]) & (unsigned)__builtin_amdgcn_sbfe(wx, c, 1)); p1[r] = __uint_as_float(__float_as_uint(p1[r]) & (unsigned)__builtin_amdgcn_sbfe(wy, c, 1)); }
        }
        { f32x2 s2 = (f32x2){p0[0], p0[1]} + (f32x2){p1[0], p1[1]};
#pragma unroll
          for (int r = 2; r < 16; r += 2) s2 += (f32x2){p0[r], p0[r + 1]} + (f32x2){p1[r], p1[r + 1]};
          ps = s2.x + s2.y; }
        { auto rr = __builtin_amdgcn_permlane32_swap(__float_as_uint(ps), __float_as_uint(ps), false, false); ps = __uint_as_float(rr[0]) + __uint_as_float(rr[1]); }
        l_reg += ps;
        bf16x8 pa0, pa1, pa2, pa3;
#define FA_PK4(Pv, B_, OUT) do { const unsigned a0 = cvt_pk_bf16(Pv[B_ + 0], Pv[B_ + 1]), a1 = cvt_pk_bf16(Pv[B_ + 2], Pv[B_ + 3]), b0 = cvt_pk_bf16(Pv[B_ + 4], Pv[B_ + 5]), b1 = cvt_pk_bf16(Pv[B_ + 6], Pv[B_ + 7]); \
        auto r0 = __builtin_amdgcn_permlane32_swap(a0, b0, false, false); auto r1 = __builtin_amdgcn_permlane32_swap(a1, b1, false, false); \
        u32x4 w_ = {r0[0], r1[0], r0[1], r1[1]}; OUT = __builtin_bit_cast(bf16x8, w_); } while (0)
        FA_PK4(p0, 0, pa0); FA_PK4(p0, 8, pa1); FA_PK4(p1, 0, pa2); FA_PK4(p1, 8, pa3);
#define FA_TRRD(dst, off) asm volatile("ds_read_b64_tr_b16 %0, %1 offset:%2" : "=&v"(dst) : "v"(vbc), "i"(off) : "memory")
#define FA_PV(VB, d0) do { s16x4 l0, l1, l2, l3, h0, h1, h2, h3; constexpr int b_ = ((d0) >> 2) * 16384 + v_rd_off((d0) & 3, 0, 0); \
        FA_TRRD(l0, b_); FA_TRRD(h0, b_ + 2048); FA_TRRD(l1, b_ + 4096); FA_TRRD(h1, b_ + 6144); FA_TRRD(l2, b_ + 8192); FA_TRRD(h2, b_ + 10240); FA_TRRD(l3, b_ + 12288); FA_TRRD(h3, b_ + 14336); \
        asm volatile("s_waitcnt lgkmcnt(0)" ::: "memory"); FA_SBAR(); \
        o[d0] = __builtin_amdgcn_mfma_f32_32x32x16_bf16(pa0, (bf16x8){l0[0], l0[1], l0[2], l0[3], h0[0], h0[1], h0[2], h0[3]}, o[d0], 0, 0, 0); \
        o[d0] = __builtin_amdgcn_mfma_f32_32x32x16_bf16(pa1, (bf16x8){l1[0], l1[1], l1[2], l1[3], h1[0], h1[1], h1[2], h1[3]}, o[d0], 0, 0, 0); \
        o[d0] = __builtin_amdgcn_mfma_f32_32x32x16_bf16(pa2, (bf16x8){l2[0], l2[1], l2[2], l2[3], h2[0], h2[1], h2[2], h2[3]}, o[d0], 0, 0, 0); \
        o[d0] = __builtin_amdgcn_mfma_f32_32x32x16_bf16(pa3, (bf16x8){l3[0], l3[1], l3[2], l3[3], h3[0], h3[1], h3[2], h3[3]}, o[d0], 0, 0, 0); } while (0)
        FA_SBAR();
        { const int vbc = vb0 + cur * SHMV;
          FA_PV(0, 0); FA_PV(0, 1); FA_PV(0, 2); FA_PV(0, 3); if (DV == 256) { FA_PV(0, 4); FA_PV(0, 5); FA_PV(0, 6); FA_PV(0, 7); } }
        }
        FA_SBAR();
        if (t + 1 < NT) { const int nb_ = cur ^ 1; FA_WRITE(nb_); }
        __syncthreads();
    }
    if (hi == 0) wsf[r32] = l_reg; LDS_WAIT();
    float rli[16];
#pragma unroll
    for (int r = 0; r < 16; ++r) { const float lv = wsf[crow(r, hi)]; rli[r] = lv > 0.f ? __builtin_amdgcn_rcpf(lv) : 0.f; }
    { int l2 = lane; asm volatile("" : "+v"(l2));
      const int r32b = l2 & 31, hib = l2 >> 5;
      char* Ow = (char*)(P + (size_t)(it.qrow0 + wid * 32) * PW + ocol) + (unsigned)((4 * hib) * PW + r32b) * 2u;
      char* Ow1 = (char*)(P + (size_t)(it.qrow0 + wid * 32) * PW + ocol1) + (unsigned)((4 * hib) * PW + r32b) * 2u;
#pragma unroll
      for (int r = 0; r < 16; ++r) { const unsigned ro = (unsigned)(((r & 3) + 8 * (r >> 2)) * PW) * 2u;
#pragma unroll
        for (int d0 = 0; d0 < NDB; ++d0) { const float v = o[d0][r] * rli[r]; const float vn = __shfl_xor(v, 1);
            if ((r32b & 1) == 0) *(unsigned*)((d0 < 4 ? Ow : Ow1) + ro + (d0 & 3) * 64) = cvt_pk_bf16(v, vn); } } }
    LDS_WAIT();
    __syncthreads();
#undef FA_KROW0
#undef FA_LOAD
#undef FA_LOADK
#undef FA_LOADV
#undef FA_WRITE
#undef FA_PK4
#undef FA_TRRD
#undef FA_PV
}
__device__ __forceinline__ int next_item(unsigned* ctr, LAS int* slot) {
    __syncthreads();
    if (threadIdx.x == 0) *slot = (int)__hip_atomic_fetch_add(ctr, 1u, __ATOMIC_RELAXED, __HIP_MEMORY_SCOPE_AGENT);
    __syncthreads();
    return *slot;
}
__device__ __forceinline__ void queue_prime(unsigned* ctr, LAS int* slot) {
    __syncthreads();
    if (threadIdx.x == 0) slot[0] = (int)__hip_atomic_fetch_add(ctr, 1u, __ATOMIC_RELAXED, __HIP_MEMORY_SCOPE_AGENT);
    __syncthreads();
}
__device__ __forceinline__ int queue_next(unsigned* ctr, LAS int* slot, int k) {
    const int idx = slot[k & 1];
    if (threadIdx.x == 0) slot[(k + 1) & 1] = (int)__hip_atomic_fetch_add(ctr, 1u, __ATOMIC_RELAXED, __HIP_MEMORY_SCOPE_AGENT);
    return idx;
}
__device__ __forceinline__ Item make_item(bool meta, int b, int qb) {
    Item it;
    if (meta) { it.qrow0 = 0; it.qk0 = -(MBLK - 64); it.nt = 1; it.tokbase = MBLK; }
    else { it.qrow0 = MBLK + b * SEQ + qb * 256; it.qk0 = 64 + qb * 256; it.nt = 4 * (qb + 1) + 1; it.tokbase = MBLK + b * SEQ; }
    return it;
}
}


constexpr int PH_PER_LAYER = 19, N_PHASES = 2 * PH_PER_LAYER;
__device__ __forceinline__ unsigned char* uni_ptr(unsigned char* p) { const unsigned long long v = (unsigned long long)p; const unsigned lo = __builtin_amdgcn_readfirstlane((unsigned)v), hi = __builtin_amdgcn_readfirstlane((unsigned)(v >> 32)); return (unsigned char*)(((unsigned long long)hi << 32) | lo); }
__device__ __forceinline__ const float* arg_in(const Args& a, int k) { asm volatile("" : "+s"(k)); return a.in[k]; }
__global__ void __launch_bounds__(NWAVES * 64, 2) mega_fwd(Args args) {
    extern __shared__ __attribute__((aligned(16))) unsigned char lds_raw[];
    {
        LAS unsigned char* l0 = (LAS unsigned char*)lds_raw;
        for (int u = threadIdx.x; u < (LDS_BYTES - LDSCTL_OFF) / 4; u += NWAVES * 64) ((LAS unsigned*)(l0 + LDSCTL_OFF))[u] = 0u;
        __syncthreads();
    }
#if MK_ONE_LAUNCH
    (void)xcd_barrier_post((unsigned*)(args.ws + WS_CTL) + CW_BAR, (volatile LAS unsigned*)((LAS unsigned char*)lds_raw + LDSCTL_OFF + 64));
#define GRID_BAR() do { XcdBarrier bar_; bar_.bar = (unsigned*)(uni_ptr(args.ws) + WS_CTL) + CW_BAR; bar_.x = xb_xcc_id(); bar_.st = (volatile LAS unsigned*)((LAS unsigned char*)lds_raw + LDSCTL_OFF + 64); xcd_barrier(bar_); } while (0)
#else
#define GRID_BAR() do {} while (0)
#endif
    const int lo = args.ph_lo, hi = args.ph_hi;
#define IN(k) (lo <= (k) && (k) < hi)
#define SEAM(k) do { if (IN((k) + 1)) GRID_BAR(); } while (0)
#define PH_BEGIN \
    int tid_ = threadIdx.x; asm volatile("" : "+v"(tid_)); \
    Ctx F; F.lds = (LAS unsigned char*)lds_raw; F.tid = tid_; F.lane = tid_ & 63; F.wave = __builtin_amdgcn_readfirstlane(tid_ >> 6); \
    F.G = gridDim.x; F.bid = blockIdx.x; F.gw = F.bid * NWAVES + F.wave; F.ngw = F.G * NWAVES; \
    unsigned char* ws = uni_ptr(args.ws); asm volatile("" : "+s"(ws)); ws = (unsigned char*)(__attribute__((address_space(1))) unsigned char*)(unsigned long long)ws;     \
    int ly = __builtin_amdgcn_readfirstlane(layer); asm volatile("" : "+s"(ly)); (void)ly; (void)F
#define XN_ ((bf16_t*)(ws + WS_XN))
#define P_ ((bf16_t*)(ws + WS_P))
#define HMETA_ ((float*)(ws + WS_HMETA))
#define RSQ_(ly) ((rs_t*)(ws + WS_CTL + WS_RS2) + (size_t)(2 * (ly)) * R)
#define RSKV_(ly) ((rs_t*)(ws + WS_CTL + WS_RS2) + (size_t)(2 * (ly) + 1) * R)
#define BM_ ((unsigned*)(ws + WS_BM))
#define RS_(i) ((rs_t*)(ws + WS_CTL + WS_RS) + (size_t)(i) * R)
#define GPERM_ ((float*)(ws + WS_RSTD + 512 * 1024))
#define WB_(off) ((bf16_t*)(ws + WS_WB + (off)))
#define OUT_ (args.out)
#define LAMBDA_INIT(ly) ((ly) == 0 ? 0.2f : (0.8f - 0.6f * 0.7408182206817179f))

#pragma unroll
    for (int layer = 0; layer < 2; ++layer) {
        const int pb = layer * PH_PER_LAYER;
        if (((PHMASK >> 0) & 1) && IN(pb + 0)) {
            PH_BEGIN;
            for (int rep_ = 0; rep_ < NREP(0); ++rep_) { if (rep_) GRID_BAR();
            const float* meta = arg_in(args, 1);
            conv_matrix<1>(F, arg_in(args, 3) + (size_t)ly * DM * D_IN, DM, D_IN, WB_(WB_IN), arg_in(args, 2) + ly * DM);
            conv_matrix<0>(F, arg_in(args, 7) + (size_t)ly * 512 * 1536, 512, 1536, WB_(WB_QUP), arg_in(args, 5) + ly * 512);
            conv_matrix<0>(F, arg_in(args, 8) + (size_t)ly * 512 * 2048, 512, 2048, WB_(WB_KVUP), arg_in(args, 6) + ly * 512);
            for (int b = 0; b < 3; ++b) conv_matrix<0>(F, arg_in(args, 14) + ((size_t)ly * 3 + b) * 1024 * DM, 1024, DM, WB_(WB_BR) + (size_t)b * DM * 1024, nullptr);
            conv_matrix<0>(F, arg_in(args, 15) + (size_t)ly * DM * DM, DM, DM, WB_(WB_O), nullptr);
            conv_matrix<2>(F, arg_in(args, 17) + (size_t)ly * DM * 2 * DFF, DM, 2 * DFF, WB_(WB_F1), arg_in(args, 16) + ly * DM);
            conv_matrix<0>(F, arg_in(args, 18) + (size_t)ly * DFF * DM, DFF, DM, WB_(WB_F2), nullptr);
            unsigned zu = 0u; asm volatile("" : "+v"(zu)); const float zf = __uint_as_float(zu);
            for (int i = F.gw * 64 + F.lane; i < 112 * 2048 / 8; i += F.ngw * 64) *((u32x4*)(WB_(WB_IN) + (size_t)1168 * 2048) + i) = (u32x4){zu, zu, zu, zu};
            if (F.bid == 0) { const int i = F.tid; const int t = i >> 7, ps = i & 127, dim = (ps >> 1) + 64 * (ps & 1);
                const float* gsrc = (t < 2 ? arg_in(args, 10) : arg_in(args, 11)) + ly * 256 + (t & 1) * 128; GPERM_[i] = gsrc[dim]; }
            float* hmeta = HMETA_;
            if (ly == 0) {
                for (int i = F.gw * 64 + F.lane; i < MROW0 * PW / 8; i += F.ngw * 64) *((u32x4*)P_ + i) = (u32x4){zu, zu, zu, zu};
                for (int i = F.gw * 64 + F.lane; i < MBLK * DM / 4; i += F.ngw * 64) { const int rr = i / (DM / 4); f32x4 v = (f32x4){zf, zf, zf, zf};
                    if (rr >= MBLK - NMETA) v = *((const f32x4*)meta + (i - (MBLK - NMETA) * (DM / 4))); *((f32x4*)hmeta + i) = v; }
            }
            if (ly == 0) {
                const float* xin = arg_in(args, 0); bf16_t* XN = XN_; rs_t* rs0 = RS_(0);
                for (int r = MROW0 + F.gw; r < R; r += 2 * F.ngw) {
                    const int r2 = (r + F.ngw < R) ? r + F.ngw : r; f32x4 va[8], vb[8];
                    norm_load(r < MBLK ? meta + (size_t)(r - MROW0) * DM : xin + (size_t)(r - MBLK) * DM, F.lane, va); norm_load(r2 < MBLK ? meta + (size_t)(r2 - MROW0) * DM : xin + (size_t)(r2 - MBLK) * DM, F.lane, vb);
                    norm_fin(va, XN + (size_t)r * DM, rs0 + r, F.lane); if (r2 != r) norm_fin(vb, XN + (size_t)r2 * DM, rs0 + r2, F.lane); }
            }
            }
            SEAM(pb + 0);
        }
        if (((PHMASK >> 1) & 1) && IN(pb + 1)) {
            PH_BEGIN;
            { SkP f{P_, 0, RS_(2 * ly), 1.f / DM, RSQ_(ly), RSKV_(ly)}; skinny_gemm(F.lds, XN_ + (size_t)MROW0 * DM, DM, WB_(WB_IN), DM, 1280 / 16, F.bid, F.G, f); }
            SchedPlain S{XN_, DM, WB_(WB_IN), DM, NPMM, 5, F.G, F.bid, 0}; EpiP<true> E{P_, RS_(2 * ly), RS_(2 * ly), 1 << 30, 1.f / DM, RSQ_(ly), RSKV_(ly)};
            pg8::gemm_phase(F.lds, S, E);
            if (NREP(1) == 2) { GRID_BAR(); pg8::gemm_phase(F.lds, S, E); }
            SEAM(pb + 1);
        }
        if (((PHMASK >> 2) & 1) && IN(pb + 2)) {
            PH_BEGIN;
            { SkP f{P_, C_QRAW, RSQ_(ly), 1.f / 512.f, nullptr, nullptr}; skinny_gemm(F.lds, P_ + (size_t)MROW0 * PW + C_CQ, PW, WB_(WB_QUP), 512, 1536 / 16, F.bid, F.G, f); }
            { SkP f{P_, C_KVRAW, RSKV_(ly), 1.f / 512.f, nullptr, nullptr}; skinny_gemm(F.lds, P_ + (size_t)MROW0 * PW + C_CKV, PW, WB_(WB_KVUP), 512, 2048 / 16, F.bid, F.G, f); }
            SchedMlaUp S{P_, WB_(WB_QUP), WB_(WB_KVUP), F.G, F.bid}; EpiP<false> E{P_, RSQ_(ly), RSKV_(ly), 6, 1.f / 512.f, nullptr, nullptr};
            pg8::gemm_phase(F.lds, S, E);
            if (NREP(2) == 2) { GRID_BAR(); pg8::gemm_phase(F.lds, S, E); }
            SEAM(pb + 2);
        }
        if (((PHMASK >> 3) & 1) && IN(pb + 3)) {
            PH_BEGIN;
            const float* mla_qkg = arg_in(args, 9) + ly * 2 * 192;
            bf16_t* P = P_;
            LAS float* rnl = (LAS float*)(F.lds + F.wave * 64);
            for (int r = MROW0 + F.gw; r < R; r += 2 * F.ngw) {
                const int r2 = (r + F.ngw < R) ? r + F.ngw : r; u32x4 va[9], vb[9]; unsigned ia, ib;
                post2_load(P, r, F.lane, va, ia); post2_load(P, r2, F.lane, vb, ib);
                post2_row(P, r, va, ia, mla_qkg, rnl, F.lane); if (r2 != r) post2_row(P, r2, vb, ib, mla_qkg, rnl, F.lane); }
            SEAM(pb + 3);
        }
        if (((PHMASK >> 4) & 1) && IN(pb + 4)) {
            PH_BEGIN;
            bf16_t* P = P_;
            LAS int* slot = (LAS int*)(F.lds + LDSCTL_OFF + 128);
            for (int rep_ = 0; rep_ < NREP(4); ++rep_) { if (rep_) GRID_BAR();
            unsigned* ctr = (unsigned*)(ws + WS_CTL) + CW_Q + 64 * (ly * 4 + 0) + 64 * 16 * rep_;
            const bool stat = (F.G == 256); const int sx = F.bid & 7, spl = (F.bid >> 3) >> 2, sj = (F.bid >> 3) & 3;
            if (!stat) fa::queue_prime(ctr, slot);
            for (int qk_ = 0;; ++qk_) {
                int idx;
                if (stat) { if (qk_ < 4) { const int pr = sx + 8 * (spl + 8 * (qk_ >> 1)), qb = (qk_ & 1) ? sj : 7 - sj; idx = (7 - qb) * 128 + pr; } else idx = (qk_ == 4 && F.bid < 8) ? 1024 + F.bid : 1 << 30; }
                else idx = fa::queue_next(ctr, slot, qk_);
                if (idx >= 8 * 129) break;
                int h; fa::Item it;
                if (idx < 1024) { const int qb = 7 - (idx >> 7), rest = idx & 127; h = rest & 7; it = fa::make_item(false, rest >> 3, qb); } else { h = idx - 1024; it = fa::make_item(true, 0, 0); }
                bf16x8 qr[12]; fa::load_q<192>(P, it, C_QRAW + h * 192, qr);
                fa::attn_core<192, 128, false>(P, it, qr, C_KVRAW + h * 256, C_KPEH + h * 64, C_KVRAW + h * 256 + 128, C_OA + h * 128, 0, nullptr, F.lds);
            } }
            SEAM(pb + 4);
        }
        if (((PHMASK >> 5) & 1) && IN(pb + 5)) {
            PH_BEGIN;
            { SkP f{P_, 1280, RS_(2 * ly), 1.f / DM, nullptr, nullptr}; skinny_gemm(F.lds, XN_ + (size_t)MROW0 * DM, DM, WB_(WB_IN) + (size_t)1280 * DM, DM, 7168 / 16, F.bid, F.G, f); }
            SchedPlain S{XN_, DM, WB_(WB_IN) + (size_t)1280 * DM, DM, NPMM, 28, F.G, F.bid, 1280}; EpiG2 E{P_, RS_(2 * ly), GPERM_, (LAS float*)(F.lds + RING_BYTES)};
            pg8::gemm_phase(F.lds, S, E);
            if (NREP(5) == 2) { GRID_BAR(); pg8::gemm_phase(F.lds, S, E); }
            SEAM(pb + 5);
        }
        if (((PHMASK >> 6) & 1) && IN(pb + 6)) {
            PH_BEGIN;
            bf16_t* P = P_; const float* gp = GPERM_;
            if (F.gw < NMETA) meta_post_row(P, MROW0 + F.gw, gp, F.lane);
        }
        if (((PHMASK >> 7) & 1) && IN(pb + 7)) {
            PH_BEGIN;
            bf16_t* P = P_; unsigned* bm = BM_;
            unsigned* ctr = (unsigned*)(ws + WS_CTL) + CW_Q + 64 * (ly * 4 + 2);
            LAS int* slot = (LAS int*)(F.lds + LDSCTL_OFF + 128);
            for (int rep_ = 0; rep_ < NREP(7); ++rep_) { if (rep_) GRID_BAR(); unsigned* c2 = ctr + 64 * 16 * rep_;
            for (;;) { const int idx = fa::next_item(c2, slot); if (idx >= NTOK / 8) break; index_unit(P, idx, bm, F.lds); } }
            SEAM(pb + 7);
        }
        if (((PHMASK >> 8) & 1) && IN(pb + 8)) {
            PH_BEGIN;
            bf16_t* P = P_; unsigned* bm = BM_;
            LAS int* slot = (LAS int*)(F.lds + LDSCTL_OFF + 128);
            for (int rep_ = 0; rep_ < NREP(8); ++rep_) { if (rep_) GRID_BAR();
            const bool dummy = (NREP(8) == 2) && rep_ == 0;
            unsigned* ctr = (unsigned*)(ws + WS_CTL) + CW_Q + 64 * (ly * 4 + 1) + 64 * 16 * rep_;
            const bool stat = (F.G == 256); const int sx = F.bid & 7, spl = (F.bid >> 3) >> 2, sj = (F.bid >> 3) & 3;
            if (!stat) fa::queue_prime(ctr, slot);
            for (int qk_ = 0;; ++qk_) {
                int idx;
                if (stat) { if (qk_ < 8) { const int pr = sx + 8 * (spl + 8 * ((qk_ >> 1) & 1)), qb = (qk_ & 1) ? sj : 7 - sj; idx = (7 - qb) * 256 + ((qk_ >> 2) ? 128 : 0) + pr; } else idx = (qk_ == 8 && F.bid < 16) ? 2048 + F.bid : 1 << 30; }
                else idx = fa::queue_next(ctr, slot, qk_);
                if (idx >= 16 * 129) break;
                int hh; bool meta = false; fa::Item it; int b = 0, qb = 0;
                if (idx < 2048) { qb = 7 - (idx >> 8); const int rest = idx & 255; hh = (rest < 128) ? 8 + (rest & 7) : (rest & 7); b = (rest & 127) >> 3; it = fa::make_item(false, b, qb); }
                else { hh = idx - 2048; hh = hh < 8 ? 8 + hh : hh - 8; meta = true; it = fa::make_item(true, 0, 0); }
                if (hh < 8) {
                    bf16x8 qr[8]; fa::load_q<128>(P, it, C_DQ + hh * 128, qr);
                    fa::attn_core<128, 128, true>(P, it, qr, C_DK + hh * 128, 0, C_DV + hh * 128, dummy ? C_KPE : C_OB + hh * 128, 0, meta ? nullptr : bm + (size_t)(b * SEQ + qb * 256) * BMW, F.lds);
                } else {
                    const int hj = hh - 8;
                    bf16x8 qr[8]; fa::load_q<128>(P, it, C_FQ + hj * 128, qr);
                    fa::attn_core<128, 256, false>(P, it, qr, C_FK + hj * 128, 0, C_FV + (hj >> 1) * 256, dummy ? C_KPE : C_FQ + hj * 128, dummy ? C_KPE : C_IQ + hj * 128, nullptr, F.lds);
                }
            } }
            SEAM(pb + 8);
        }
        if (((PHMASK >> 9) & 1) && IN(pb + 9)) {
            PH_BEGIN;
            const float* diff_lam = arg_in(args, 12) + ly * 4 * 128; const float* diff_subg = arg_in(args, 13) + ly * 256;
            const float lambda_init = LAMBDA_INIT(ly);
            const float s1 = wave_sum(diff_lam[F.lane] * diff_lam[128 + F.lane] + diff_lam[64 + F.lane] * diff_lam[192 + F.lane]);
            const float s2 = wave_sum(diff_lam[256 + F.lane] * diff_lam[384 + F.lane] + diff_lam[320 + F.lane] * diff_lam[448 + F.lane]);
            const float lam = __expf(s1) - __expf(s2) + lambda_init;
            bf16_t* P = P_;
            for (int r = MROW0 + F.gw; r < R; r += 4 * F.ngw) {
                int rr_[4]; u32x4 vv[4][4];
#pragma unroll
                for (int k = 0; k < 4; ++k) { rr_[k] = (r + k * F.ngw < R) ? r + k * F.ngw : r; post3_load(P, rr_[k], F.lane, vv[k]); }
#pragma unroll
                for (int k = 0; k < 4; ++k) if (k == 0 || rr_[k] != r) post3_row(P, rr_[k], vv[k], diff_subg, lam, 1.f - lambda_init, F.lane); }
        }
#define GATE_PHASE(k, b, sk, seam) \
        if (((PHMASK >> 10) & 1) && IN(pb + (k))) { \
            PH_BEGIN; \
            { SkGate f{(bf16_t*)(ws + WS_GS), arg_in(args, 4) + ly * 3 * DM + (b) * DM, RS_(2 * ly)}; skinny_gemm(F.lds, XN_ + (size_t)MROW0 * DM, DM, WB_(WB_G) + (size_t)(b) * 2048 * DM, DM, 2048 / 16, (F.bid + (sk)) % F.G, F.G, f); } \
            SchedPlain S{XN_, DM, WB_(WB_G) + (size_t)(b) * 2048 * DM, DM, NPMM, 8, F.G, F.bid, 0}; EpiGate E{(bf16_t*)(ws + WS_GS), arg_in(args, 4) + ly * 3 * DM + (b) * DM, RS_(2 * ly)}; \
            pg8::gemm_phase(F.lds, S, E); \
            if (NREP(k) == 2) { GRID_BAR(); pg8::gemm_phase(F.lds, S, E); } \
            if (seam) SEAM(pb + (k)); \
        }
#define BRANCH_PHASE(k, b, oc, sk, seam) \
        if (((PHMASK >> 10) & 1) && IN(pb + (k))) { \
            PH_BEGIN; \
            { SkGated f{P_, (const bf16_t*)(ws + WS_GS), (b) == 0 ? 1 : 0}; skinny_gemm(F.lds, P_ + (size_t)MROW0 * PW + (oc), PW, WB_(WB_BR) + (size_t)(b) * DM * 1024, 1024, 2048 / 16, (F.bid + (sk)) % F.G, F.G, f); } \
            SchedPlain S{P_ + (oc), PW, WB_(WB_BR) + (size_t)(b) * DM * 1024, 1024, NPMM, 8, F.G, F.bid, C_MERGED}; EpiGated E{P_, (const bf16_t*)(ws + WS_GS), (b) == 0 ? 1 : 0, ((DBG_BM >> (b)) & 1) ? 1.f : 0.f}; \
            pg8::gemm_phase(F.lds, S, E); \
            if (NREP(k) == 2 && (b) == 0) { GRID_BAR(); pg8::gemm_phase(F.lds, S, E); } \
            if (seam) SEAM(pb + (k)); \
        }
        GATE_PHASE(10, 0, 0, 0) BRANCH_PHASE(11, 0, C_OA, 0, 0)
        GATE_PHASE(12, 1, 0, 0) BRANCH_PHASE(13, 1, C_OB, 0, 0)
        GATE_PHASE(14, 2, 0, 1) BRANCH_PHASE(15, 2, C_OC, 128, 1)
        if (((PHMASK >> 11) & 1) && IN(pb + 16)) {
            PH_BEGIN;
            { SkRes f{HMETA_, XN_, RS_(2 * ly + 1)}; skinny_gemm(F.lds, P_ + (size_t)MROW0 * PW + C_MERGED, PW, WB_(WB_O), DM, 2048 / 16, F.bid, F.G, f); }
            SchedPlain S{P_ + C_MERGED, PW, WB_(WB_O), DM, NPMM, 8, F.G, F.bid, 0}; EpiRes E{(float*)nullptr, DBG_SA, XN_, RS_(2 * ly + 1)};
            pg8::gemm_phase(F.lds, S, E);
            SEAM(pb + 16);
        }
        if (((PHMASK >> 13) & 1) && IN(pb + 17)) {
            PH_BEGIN;
            skinny_swiglu(F.lds, XN_ + (size_t)MROW0 * DM, DM, WB_(WB_F1), DM, P_, RS_(2 * ly + 1), F.bid, F.G);
            SchedPlain S{XN_, DM, WB_(WB_F1), DM, NPMM, 44, F.G, F.bid, 0}; EpiSwiglu E{P_, RS_(2 * ly + 1)};
            pg8::gemm_phase(F.lds, S, E);
            if (NREP(17) == 2) { GRID_BAR(); pg8::gemm_phase(F.lds, S, E); }
            SEAM(pb + 17);
        }
        if (((PHMASK >> 14) & 1) && IN(pb + 18)) {
            PH_BEGIN;
            { SkRes f{HMETA_, ly == 0 ? XN_ : (bf16_t*)nullptr, RS_(2)}; skinny_gemm(F.lds, P_ + (size_t)MROW0 * PW, PW, WB_(WB_F2), DFF, 2048 / 16, F.bid, F.G, f); }
            SchedPlain S{P_, PW, WB_(WB_F2), DFF, NPMM, 8, F.G, F.bid, 0}; EpiRes E{ly == 0 ? (float*)nullptr : OUT_, DBG_SF, XN_, RS_(2)};
            pg8::gemm_phase(F.lds, S, E);
            SEAM(pb + 18);
        }
    }
#undef IN
#undef SEAM
}

__global__ void diag_fill(float* out, int n, float v) { for (int i = blockIdx.x * blockDim.x + threadIdx.x; i < n; i += gridDim.x * blockDim.x) out[i] = v; }
extern "C" void kernel_launch(void* const* d_in, const int* in_sizes, int n_in, void* d_out, int out_size, void* d_ws, size_t ws_size, hipStream_t stream) {
    static int grid = 0; static float code = 0.f;
    if (grid == 0) {
        int dev = 0, cus = 0;
        if (n_in != 19) { code = 10.f; grid = -1; }
        else if (ws_size < WS_END) { code = 20.f + (float)(ws_size >> 20) * 0.01f; grid = -1; }
        else if (hipGetDevice(&dev) != hipSuccess || hipDeviceGetAttribute(&cus, hipDeviceAttributeMultiprocessorCount, dev) != hipSuccess) { code = 40.f; grid = -1; }
        else if (hipFuncSetAttribute((const void*)mega_fwd, hipFuncAttributeMaxDynamicSharedMemorySize, LDS_BYTES) != hipSuccess) { code = 50.f; grid = -1; }
        else {
            int per_cu = 0;
            if (hipOccupancyMaxActiveBlocksPerMultiprocessor(&per_cu, (const void*)mega_fwd, NWAVES * 64, LDS_BYTES) != hipSuccess || per_cu < 1) { code = 60.f; grid = -1; }
            (void)hipGetLastError();
            if (grid == 0) grid = cus;
        }
    }
    if (grid < 0) { hipLaunchKernelGGL(diag_fill, dim3(1024), dim3(256), 0, stream, (float*)d_out, out_size, code); return; }
    (void)hipMemsetAsync((char*)d_ws + WS_CTL, 0, CTL_BYTES, stream);
    Args a{};
    for (int i = 0; i < 19; ++i) a.in[i] = (const float*)d_in[i];
    a.out = (float*)d_out; a.ws = (unsigned char*)d_ws;
#if MK_ONE_LAUNCH
    a.ph_lo = 0; a.ph_hi = N_PHASES;
    hipLaunchKernelGGL(mega_fwd, dim3(grid), dim3(NWAVES * 64), LDS_BYTES, stream, a);
#else
    for (int p = 0; p < N_PHASES; ++p) { a.ph_lo = p; a.ph_hi = p + 1; hipLaunchKernelGGL(mega_fwd, dim3(grid), dim3(NWAVES * 64), LDS_BYTES, stream, a); }
#endif
    if (hipPeekAtLastError() != hipSuccess) { (void)hipGetLastError(); hipLaunchKernelGGL(diag_fill, dim3(1024), dim3(256), 0, stream, (float*)d_out, out_size, 70.f); }
}
```
